# Optimizing an MI355X kernel written in HIP

```python
import math
import jax, jax.numpy as jnp
from jax import lax
import numpy as np

D_MODEL = 1024
BATCH = 16
SEQ = 4096
DEPTH = 1

HEAD_DIM = 64
SB_HEADS = 8
DIL_GROUPS = ((128, 1), (512, 4), (2048, 16))
DIL_HEADS_PER_GROUP = 4
DIL_HEADS = DIL_HEADS_PER_GROUP * len(DIL_GROUPS)
N_BRANCHES = 2
Q_BLOCK = 128
PEER_HEADS = 8
PEER_N_KEYS = 128
PEER_N_EXPERTS = PEER_N_KEYS * PEER_N_KEYS
PEER_QUERY_DIM = 256
PEER_TOPK = 16
TOKEN_CHUNK = 128
RMS_EPS = 1e-6
ALIBI_MAX_EXP = 8.0

SB_W = SB_HEADS * HEAD_DIM
DIL_W = DIL_HEADS * HEAD_DIM
DIL_OUT_W = DIL_HEADS_PER_GROUP * HEAD_DIM
IN_PROJ_W = 3 * SB_W + 3 * DIL_W + N_BRANCHES * D_MODEL

kernel_name = "hybrid_stickbreak_dilated_peer_block"


def rmsnorm(x, gain):
    xf = x.astype(jnp.float32)
    y = xf * lax.rsqrt(jnp.mean(xf * xf, axis=-1, keepdims=True) + RMS_EPS)
    return (y * gain.astype(jnp.float32)).astype(x.dtype)


def stick_breaking_attention(q, k, v):
    B, S, H, dh = q.shape
    nb = S // Q_BLOCK
    scale = dh ** -0.5
    q_blocks = q.reshape(B, nb, Q_BLOCK, H, dh).transpose(1, 0, 2, 3, 4)
    key_pos = jnp.arange(S)

    def block(args):
        qb, bi = args
        q_pos = bi * Q_BLOCK + jnp.arange(Q_BLOCK)
        z = jnp.einsum('bqhd,bshd->bhqs', qb, k).astype(jnp.float32) * scale
        causal = key_pos[None, :] < q_pos[:, None]
        log_beta = jax.nn.log_sigmoid(z)
        log_stay = jnp.where(causal, jax.nn.log_sigmoid(-z), 0.0)
        cum = jnp.cumsum(log_stay, axis=-1)
        log_a = log_beta + (cum[..., -1:] - cum)
        a = jnp.where(causal, jnp.exp(log_a), 0.0)
        return jnp.einsum('bhqs,bshd->bqhd', a.astype(v.dtype), v)

    out = lax.map(block, (q_blocks, jnp.arange(nb)))
    return out.transpose(1, 0, 2, 3, 4).reshape(B, S, H, dh)


def dilated_attention(q, k, v, slopes):
    B, S, H, dh = q.shape
    Hg = DIL_HEADS_PER_GROUP
    nb = S // Q_BLOCK
    scale = dh ** -0.5
    q_blocks = q.reshape(B, nb, Q_BLOCK, H, dh).transpose(1, 0, 2, 3, 4)
    k_groups = [k[:, :, g * Hg:(g + 1) * Hg] for g in range(len(DIL_GROUPS))]
    v_groups = [v[:, :, g * Hg:(g + 1) * Hg] for g in range(len(DIL_GROUPS))]

    def block(args):
        qb, bi = args
        q_pos = bi * Q_BLOCK + jnp.arange(Q_BLOCK)
        outs, lses = [], []
        for g, (window, dil) in enumerate(DIL_GROUPS):
            offs = dil * jnp.arange(window // dil + 1)
            idx = q_pos[:, None] - offs[None, :]
            valid = idx >= 0
            idx = jnp.maximum(idx, 0)
            kg = jnp.take(k_groups[g], idx, axis=1)
            vg = jnp.take(v_groups[g], idx, axis=1)
            qg = qb[:, :, g * Hg:(g + 1) * Hg]
            z = jnp.einsum('bqhd,bqjhd->bhqj', qg, kg).astype(jnp.float32) * scale
            z = z - slopes[g * Hg:(g + 1) * Hg][:, None, None] * offs.astype(jnp.float32)[None, None, :]
            z = jnp.where(valid[None, None], z, -1e30)
            m = jnp.max(z, axis=-1, keepdims=True)
            p = jnp.exp(z - m)
            den = jnp.sum(p, axis=-1, keepdims=True)
            o = jnp.einsum('bhqj,bqjhd->bqhd', (p / den).astype(vg.dtype), vg)
            outs.append(o)
            lses.append((m + jnp.log(den))[..., 0])
        w = jax.nn.softmax(jnp.stack(lses, axis=0), axis=0)
        w = w.transpose(0, 1, 3, 2)[..., None]
        o_all = jnp.stack(outs, axis=0)
        return jnp.sum(w.astype(o_all.dtype) * o_all, axis=0)

    out = lax.map(block, (q_blocks, jnp.arange(nb)))
    return out.transpose(1, 0, 2, 3, 4).reshape(B, S, Hg, dh)


def peer_ffn(h, w_q, sub_keys, expert_u, expert_v):
    B, S, D = h.shape
    t = h.reshape(-1, D)
    T = t.shape[0]
    chunks = t.reshape(T // TOKEN_CHUNK, TOKEN_CHUNK, D)
    K = PEER_TOPK

    def chunk(xc):
        qh = (xc @ w_q).reshape(TOKEN_CHUNK, PEER_HEADS, 2, PEER_QUERY_DIM // 2)
        s = jnp.einsum('thpc,hpnc->thpn', qh, sub_keys).astype(jnp.float32)
        s_top, i_top = lax.top_k(s, K)
        cand = (s_top[:, :, 0, :, None] + s_top[:, :, 1, None, :]).reshape(TOKEN_CHUNK, PEER_HEADS, K * K)
        best, ci = lax.top_k(cand, K)
        i1 = jnp.take_along_axis(i_top[:, :, 0], ci // K, axis=-1)
        i2 = jnp.take_along_axis(i_top[:, :, 1], ci % K, axis=-1)
        e = i1 * PEER_N_KEYS + i2
        gates = jax.nn.softmax(best, axis=-1)
        u = jnp.take(expert_u, e, axis=0)
        vv = jnp.take(expert_v, e, axis=0)
        act = jax.nn.gelu(jnp.einsum('thkd,td->thk', u, xc).astype(jnp.float32), approximate=False)
        return jnp.einsum('thk,thkd->td', (gates * act).astype(vv.dtype), vv)

    out = lax.map(chunk, chunks)
    return out.reshape(B, S, D)


def setup_inputs(seed: int = 0) -> dict:
    key = jax.random.key(seed)
    ks = jax.random.split(key, 14)
    D = D_MODEL
    f32 = jnp.float32
    nrm = lambda k, shape, s: jax.random.normal(k, shape, f32) * s
    return {
        "x": jax.random.normal(ks[0], (BATCH, SEQ, D), f32),
        "norm1_gain": 1.0 + nrm(ks[1], (DEPTH, D), 0.02),
        "w_in": nrm(ks[2], (DEPTH, D, IN_PROJ_W), D ** -0.5),
        "b_gate": nrm(ks[3], (DEPTH, N_BRANCHES * D), 0.02),
        "q_norm_gain": 1.0 + nrm(ks[4], (DEPTH, DIL_HEADS, HEAD_DIM), 0.02),
        "k_norm_gain": 1.0 + nrm(ks[5], (DEPTH, DIL_HEADS, HEAD_DIM), 0.02),
        "w_sb_out": nrm(ks[6], (DEPTH, SB_W, D), SB_W ** -0.5),
        "w_dil_out": nrm(ks[7], (DEPTH, DIL_OUT_W, D), DIL_OUT_W ** -0.5),
        "w_out": nrm(ks[8], (DEPTH, D, D), D ** -0.5),
        "norm2_gain": 1.0 + nrm(ks[9], (DEPTH, D), 0.02),
        "w_peer_q": nrm(ks[10], (DEPTH, D, PEER_HEADS * PEER_QUERY_DIM), D ** -0.5),
        "peer_sub_keys": nrm(ks[11], (DEPTH, PEER_HEADS, 2, PEER_N_KEYS, PEER_QUERY_DIM // 2), (PEER_QUERY_DIM // 2) ** -0.5),
        "peer_u": nrm(ks[12], (DEPTH, PEER_N_EXPERTS, D), D ** -0.5),
        "peer_v": nrm(ks[13], (DEPTH, PEER_N_EXPERTS, D), 0.3),
    }


def reference(x, norm1_gain, w_in, b_gate, q_norm_gain, k_norm_gain, w_sb_out, w_dil_out, w_out,
              norm2_gain, w_peer_q, peer_sub_keys, peer_u, peer_v):
    B, S, D = x.shape
    splits = [SB_W, 2 * SB_W, 3 * SB_W, 3 * SB_W + DIL_W, 3 * SB_W + 2 * DIL_W, 3 * SB_W + 3 * DIL_W]
    slopes = 2.0 ** (-ALIBI_MAX_EXP * jnp.arange(1, DIL_HEADS + 1, dtype=jnp.float32) / DIL_HEADS)
    for l in range(DEPTH):
        xn = rmsnorm(x, norm1_gain[l])
        proj = xn @ w_in[l]
        q_sb, k_sb, v_sb, q_dl, k_dl, v_dl, gate_logits = jnp.split(proj, splits, axis=-1)
        hd = lambda t, h: t.reshape(B, S, h, HEAD_DIM)
        o_sb = stick_breaking_attention(hd(q_sb, SB_HEADS), hd(k_sb, SB_HEADS), hd(v_sb, SB_HEADS))
        q_dl = rmsnorm(hd(q_dl, DIL_HEADS), q_norm_gain[l])
        k_dl = rmsnorm(hd(k_dl, DIL_HEADS), k_norm_gain[l])
        o_dl = dilated_attention(q_dl, k_dl, hd(v_dl, DIL_HEADS), slopes)
        y_sb = o_sb.reshape(B, S, SB_W) @ w_sb_out[l]
        y_dl = o_dl.reshape(B, S, DIL_OUT_W) @ w_dil_out[l]
        gates = jax.nn.sigmoid((gate_logits + b_gate[l]).astype(jnp.float32)).astype(x.dtype)
        g_sb, g_dl = jnp.split(gates, 2, axis=-1)
        x = x + (g_sb * y_sb + g_dl * y_dl) @ w_out[l]
        x = x + peer_ffn(rmsnorm(x, norm2_gain[l]), w_peer_q[l], peer_sub_keys[l], peer_u[l], peer_v[l])
    return x
```

```cpp
#include <hip/hip_runtime.h>
#include <cstdio>
#include <cstdint>
namespace pg8 {
#define PG8_LAS __attribute__((address_space(3)))
typedef unsigned short bf16_t;
typedef short bf16x8 __attribute__((ext_vector_type(8)));
typedef float f32x4 __attribute__((ext_vector_type(4)));
typedef unsigned u32x4 __attribute__((ext_vector_type(4)));
constexpr int BM = 256, BK = 64, HALF = 128, HTB = HALF * BK * 2  , STAGE_BYTES = 8 * HTB, NXCD = 8, WGM = 8;

__host__ __device__ __forceinline__ int lds_byte(int r, int c) { const int st = (r >> 4) * 2 + (c >> 5), rr = r & 15, cc = c & 31, ob = rr * 64 + cc * 2; return st * 1024 + (ob ^ (((ob >> 9) & 1) << 5)); }
__host__ __device__ __forceinline__ void stage_rc(int b, int& R, int& C) { const int st = b / 1024, sb = b % 1024, swz = sb ^ (((sb >> 9) & 1) << 5); R = (st >> 1) * 16 + swz / 64; C = (st & 1) * 32 + (swz % 64) / 2; }
__host__ __device__ __forceinline__ int perm32(int rho) { const int n = rho >> 4, i = rho & 15; return 8 * (i >> 2) + 4 * n + (i & 3); }

struct Unit { int pm, pn; };
struct Gemm { const bf16_t* A; const bf16_t* Bt; int M, N, K; };

struct StaticOrder {
    int nM, nN, nwg, G, c;
    __host__ __device__ void init(int M, int N, int G_, int c_) { nM = M / BM; nN = N / BM; nwg = nM * nN; G = G_; c = c_; }
    __host__ __device__ bool next(int i, Unit& u) const {
        const long L = (long)i * G + c; if (L >= nwg) return false;
        int wgid = (int)L; { const int q = nwg / NXCD, r = nwg % NXCD, xcd = wgid % NXCD, off = wgid / NXCD; wgid = (xcd < r ? xcd * (q + 1) : r * (q + 1) + (xcd - r) * q) + off; }
        const int nig = WGM * nN, gid = wgid / nig, fm = gid * WGM, gsz = (nM - fm) < WGM ? (nM - fm) : WGM;
        u.pm = fm + ((wgid % nig) % gsz); u.pn = (wgid % nig) / gsz; return true;
    }
    __device__ __forceinline__ void a_ready(const Unit&) const {}
    __device__ __forceinline__ void done(const Unit&) const {}
};


struct OneUnit {
    Unit u;
    __device__ __forceinline__ bool next(int i, Unit& o) const { if (i != 0) return false; o = u; return true; }
    __device__ __forceinline__ void a_ready(const Unit&) const {}
    __device__ __forceinline__ void done(const Unit&) const {}
};

typedef float f32x2 __attribute__((ext_vector_type(2)));
typedef __bf16 bf16x2_t __attribute__((ext_vector_type(2)));
typedef unsigned u32x2 __attribute__((ext_vector_type(2)));
__device__ __forceinline__ unsigned pkbf(float lo, float hi) { f32x2 v = {lo, hi}; bf16x2_t b = __builtin_convertvector(v, bf16x2_t); return __builtin_bit_cast(unsigned, b); }
__device__ __forceinline__ float bflo(unsigned w) { return __uint_as_float(w << 16); }
__device__ __forceinline__ float bfhi(unsigned w) { return __uint_as_float(w & 0xffff0000u); }
__device__ __forceinline__ u32x4 pack8(const f32x4 a, const f32x4 b) { u32x4 w; w.x = pkbf(a[0], a[1]); w.y = pkbf(a[2], a[3]); w.z = pkbf(b[0], b[1]); w.w = pkbf(b[2], b[3]); return w; }
__device__ __forceinline__ float sigmoidf_(float v) { return __builtin_amdgcn_rcpf(1.0f + __builtin_amdgcn_exp2f(-1.4426950408889634f * v)); }

struct Epi1 {
    static constexpr bool PERM = true, AFTER_DRAIN = false, HAS_MID = false; static constexpr int MID_T = -1;
    const float* rinv; const float* bgate; const float* qg; const float* kg;
    bf16_t *QS, *KS, *VS, *QD, *KD, *VD, *GT;
    __device__ __forceinline__ void mid(f32x4 (&)[2][2][4][2], const Unit&, int, int, int, int) const {}
    __device__ __forceinline__ void operator()(const f32x4 (&acc)[2][2][4][2], const Unit& u, int wr, int wc, int fr, int fq) const {
        asm volatile("" : "+v"(fr), "+v"(fq));
        const int pn = u.pn; const int row0 = u.pm * BM + wr * 64 + fr;
        if (pn >= 6 && pn < 12) {
            const bool isK = pn >= 9; const int head = (isK ? pn - 9 : pn - 6) * 4 + wc;
            const float* g = (isK ? kg : qg) + head * 64 + 8 * fq;
            f32x4 gv[2][2];
#pragma unroll
            for (int bj = 0; bj < 2; ++bj)
#pragma unroll
                for (int n = 0; n < 2; ++n) gv[bj][n] = *(const f32x4*)(g + 32 * bj + 4 * n);
            bf16_t* base = (isK ? KD : QD) + head * 64 + 8 * fq;
#pragma unroll
            for (int ai = 0; ai < 2; ++ai)
#pragma unroll
                for (int m = 0; m < 4; ++m) { const int row = row0 + ai * HALF + m * 16; const float r = rinv[row];
                    f32x4 v[2][2]; float ss = 0.f;
#pragma unroll
                    for (int bj = 0; bj < 2; ++bj)
#pragma unroll
                        for (int n = 0; n < 2; ++n) { v[bj][n] = acc[ai][bj][m][n] * r; const f32x4 q = v[bj][n] * v[bj][n]; ss += (q[0] + q[1]) + (q[2] + q[3]); }
                    ss += __shfl_xor(ss, 16); ss += __shfl_xor(ss, 32);
                    const float sc = __builtin_amdgcn_rsqf(ss * (1.0f / 64.0f) + 1e-6f);
#pragma unroll
                    for (int bj = 0; bj < 2; ++bj) *(u32x4*)(base + (size_t)row * 768 + 32 * bj) = pack8(v[bj][0] * sc * gv[bj][0], v[bj][1] * sc * gv[bj][1]);
                }
        } else if (pn < 15) {
            bf16_t* base; int ld, colt;
            if (pn < 2) { base = QS; ld = 512; colt = pn * 256; } else if (pn < 4) { base = KS; ld = 512; colt = (pn - 2) * 256; } else if (pn < 6) { base = VS; ld = 512; colt = (pn - 4) * 256; } else { base = VD; ld = 768; colt = (pn - 12) * 256; }
            base += colt + wc * 32 + 8 * fq;
#pragma unroll
            for (int ai = 0; ai < 2; ++ai)
#pragma unroll
                for (int m = 0; m < 4; ++m) { const int row = row0 + ai * HALF + m * 16; const float r = rinv[row];
#pragma unroll
                    for (int bj = 0; bj < 2; ++bj) *(u32x4*)(base + (size_t)row * ld + bj * HALF) = pack8(acc[ai][bj][m][0] * r, acc[ai][bj][m][1] * r);
                }
        } else {
            const int col0 = (pn - 15) * 256 + wc * 32 + 8 * fq;
            f32x4 bv[2][2];
#pragma unroll
            for (int bj = 0; bj < 2; ++bj)
#pragma unroll
                for (int n = 0; n < 2; ++n) bv[bj][n] = *(const f32x4*)(bgate + col0 + bj * HALF + 4 * n);
#pragma unroll
            for (int ai = 0; ai < 2; ++ai)
#pragma unroll
                for (int m = 0; m < 4; ++m) { const int row = row0 + ai * HALF + m * 16; const float r = rinv[row];
#pragma unroll
                    for (int bj = 0; bj < 2; ++bj) { f32x4 a = acc[ai][bj][m][0] * r + bv[bj][0], b = acc[ai][bj][m][1] * r + bv[bj][1];
#pragma unroll
                        for (int e = 0; e < 4; ++e) { a[e] = sigmoidf_(a[e]); b[e] = sigmoidf_(b[e]); }
                        *(u32x4*)(GT + (size_t)row * 2048 + col0 + bj * HALF) = pack8(a, b); }
                }
        }
    }
};

struct Epi2 {
    static constexpr bool PERM = true, AFTER_DRAIN = false, HAS_MID = true; static constexpr int MID_T = 8;
    const bf16_t* GT; bf16_t* MIX;
    __device__ __forceinline__ void mid(f32x4 (&acc)[2][2][4][2], const Unit& u, int wr, int wc, int fr, int fq) const {
        asm volatile("" : "+v"(fr), "+v"(fq));
        const int row0 = u.pm * BM + wr * 64 + fr, col0 = u.pn * BM + wc * 32 + 8 * fq;
#pragma unroll
        for (int ai = 0; ai < 2; ++ai)
#pragma unroll
            for (int m = 0; m < 4; ++m) { const bf16_t* gp = GT + (size_t)(row0 + ai * HALF + m * 16) * 2048 + col0;
#pragma unroll
                for (int bj = 0; bj < 2; ++bj) { const u32x4 a = *(const u32x4*)(gp + bj * HALF), b = *(const u32x4*)(gp + 1024 + bj * HALF);
                    f32x4 r0, r1;
                    r0[0] = bflo(a.x) * __builtin_amdgcn_rcpf(fmaxf(bflo(b.x), 1e-30f)); r0[1] = bfhi(a.x) * __builtin_amdgcn_rcpf(fmaxf(bfhi(b.x), 1e-30f));
                    r0[2] = bflo(a.y) * __builtin_amdgcn_rcpf(fmaxf(bflo(b.y), 1e-30f)); r0[3] = bfhi(a.y) * __builtin_amdgcn_rcpf(fmaxf(bfhi(b.y), 1e-30f));
                    r1[0] = bflo(a.z) * __builtin_amdgcn_rcpf(fmaxf(bflo(b.z), 1e-30f)); r1[1] = bfhi(a.z) * __builtin_amdgcn_rcpf(fmaxf(bfhi(b.z), 1e-30f));
                    r1[2] = bflo(a.w) * __builtin_amdgcn_rcpf(fmaxf(bflo(b.w), 1e-30f)); r1[3] = bfhi(a.w) * __builtin_amdgcn_rcpf(fmaxf(bfhi(b.w), 1e-30f));
                    acc[ai][bj][m][0] *= r0; acc[ai][bj][m][1] *= r1; }
                asm volatile("" ::: "memory");
            }
    }
    __device__ __forceinline__ void operator()(const f32x4 (&acc)[2][2][4][2], const Unit& u, int wr, int wc, int fr, int fq) const {
        asm volatile("" : "+v"(fr), "+v"(fq));
        const int row0 = u.pm * BM + wr * 64 + fr, col0 = u.pn * BM + wc * 32 + 8 * fq;
#pragma unroll
        for (int ai = 0; ai < 2; ++ai)
#pragma unroll
            for (int m = 0; m < 4; ++m) { const int row = row0 + ai * HALF + m * 16; const bf16_t* gp = GT + (size_t)row * 2048 + 1024 + col0;
#pragma unroll
                for (int bj = 0; bj < 2; ++bj) { const u32x4 b = *(const u32x4*)(gp + bj * HALF);
                    f32x4 g0, g1;
                    g0[0] = fmaxf(bflo(b.x), 1e-30f); g0[1] = fmaxf(bfhi(b.x), 1e-30f); g0[2] = fmaxf(bflo(b.y), 1e-30f); g0[3] = fmaxf(bfhi(b.y), 1e-30f);
                    g1[0] = fmaxf(bflo(b.z), 1e-30f); g1[1] = fmaxf(bfhi(b.z), 1e-30f); g1[2] = fmaxf(bflo(b.w), 1e-30f); g1[3] = fmaxf(bfhi(b.w), 1e-30f);
                    *(u32x4*)(MIX + (size_t)row * 1024 + col0 + bj * HALF) = pack8(acc[ai][bj][m][0] * g0, acc[ai][bj][m][1] * g1); }
                asm volatile("" ::: "memory");
            }
    }
};

struct Epi3 {
    static constexpr bool PERM = true, AFTER_DRAIN = false, HAS_MID = false; static constexpr int MID_T = -1;
    const float* x; float* out; bf16_t* x1b; float* ssq;
    __device__ __forceinline__ void mid(f32x4 (&)[2][2][4][2], const Unit&, int, int, int, int) const {}
    __device__ __forceinline__ void operator()(const f32x4 (&acc)[2][2][4][2], const Unit& u, int wr, int wc, int fr, int fq) const {
        asm volatile("" : "+v"(fr), "+v"(fq));
        const int row0 = u.pm * BM + wr * 64 + fr, col0 = u.pn * BM + wc * 32 + 8 * fq;
#pragma unroll
        for (int ai = 0; ai < 2; ++ai)
#pragma unroll
            for (int m = 0; m < 4; ++m) { const int row = row0 + ai * HALF + m * 16; const size_t off = (size_t)row * 1024 + col0; float ss = 0.f;
#pragma unroll
                for (int bj = 0; bj < 2; ++bj) { const f32x4 v0 = acc[ai][bj][m][0] + *(const f32x4*)(x + off + bj * HALF), v1 = acc[ai][bj][m][1] + *(const f32x4*)(x + off + bj * HALF + 4);
                    *(f32x4*)(out + off + bj * HALF) = v0; *(f32x4*)(out + off + bj * HALF + 4) = v1;
                    *(u32x4*)(x1b + off + bj * HALF) = pack8(v0, v1);
                    const f32x4 q0 = v0 * v0, q1 = v1 * v1; ss += ((q0[0] + q0[1]) + (q0[2] + q0[3])) + ((q1[0] + q1[1]) + (q1[2] + q1[3])); }
                ss += __shfl_xor(ss, 16); ss += __shfl_xor(ss, 32);
                if (fq == 0) ssq[(size_t)row * 16 + u.pn * 4 + wc] = ss;
            }
    }
};

__device__ __forceinline__ unsigned f2key(float v) { const unsigned u = __float_as_uint(v); return (u & 0x80000000u) ? ~u : (u | 0x80000000u); }
__device__ __forceinline__ float key2f(unsigned k) { return __uint_as_float((k & 0x80000000u) ? (k & 0x7fffffffu) : ~k); }
struct Epi4 {
    static constexpr bool PERM = false, AFTER_DRAIN = true, HAS_MID = false; static constexpr int MID_T = -1;
    const float* ssq; float* rinv2; unsigned short* ids; float* gw;
    __device__ __forceinline__ void mid(f32x4 (&)[2][2][4][2], const Unit&, int, int, int, int) const {}
    __device__ __forceinline__ void fused(f32x4 (&acc)[2][2][4][2], const Unit& u, int wr, int wc, int fr, int fq, PG8_LAS unsigned char* lds, int wid, int lane) const {
        asm volatile("" : "+v"(fr), "+v"(fq));
        const int tid = wid * 64 + lane;
        PG8_LAS unsigned char* ixs = lds + 135168;
#pragma unroll
        for (int pass = 0; pass < 2; ++pass) {
#pragma unroll
            for (int m = 0; m < 4; ++m)
#pragma unroll
                for (int bj = 0; bj < 2; ++bj)
#pragma unroll
                    for (int n = 0; n < 2; ++n) *(PG8_LAS f32x4*)(lds + (size_t)(wr * 64 + m * 16 + fr) * 1056 + bj * 528 + (wc * 32 + n * 16 + fq * 4) * 4) = acc[pass][bj][m][n];
            asm volatile("s_waitcnt lgkmcnt(0)" ::: "memory"); __builtin_amdgcn_s_barrier(); asm volatile("" ::: "memory");
            if (tid < 256) {
                const int rl = tid >> 1, p = tid & 1; const int row = u.pm * BM + pass * HALF + rl;
                unsigned L[16];
#pragma unroll
                for (int i = 0; i < 16; ++i) L[i] = 0u;
                const PG8_LAS unsigned char* sp = lds + (size_t)rl * 1056 + p * 528;
#pragma unroll 2
                for (int c = 0; c < 32; ++c) { const f32x4 v = *(const PG8_LAS f32x4*)(sp + c * 16);
#pragma unroll
                    for (int e = 0; e < 4; ++e) { unsigned xk = (f2key(v[e]) & ~127u) | (unsigned)(127 - (4 * c + e));
#pragma unroll
                        for (int i = 0; i < 16; ++i) { const unsigned hi_ = L[i] > xk ? L[i] : xk; xk = L[i] > xk ? xk : L[i]; L[i] = hi_; } }
                }
                unsigned O[16];
#pragma unroll
                for (int i = 0; i < 16; ++i) O[i] = (unsigned)__shfl_xor((int)L[i], 1);
                { u32x4 w;
                  w.x = (127u - (L[0] & 127u)) | ((127u - (L[1] & 127u)) << 8) | ((127u - (L[2] & 127u)) << 16) | ((127u - (L[3] & 127u)) << 24);
                  w.y = (127u - (L[4] & 127u)) | ((127u - (L[5] & 127u)) << 8) | ((127u - (L[6] & 127u)) << 16) | ((127u - (L[7] & 127u)) << 24);
                  w.z = (127u - (L[8] & 127u)) | ((127u - (L[9] & 127u)) << 8) | ((127u - (L[10] & 127u)) << 16) | ((127u - (L[11] & 127u)) << 24);
                  w.w = (127u - (L[12] & 127u)) | ((127u - (L[13] & 127u)) << 8) | ((127u - (L[14] & 127u)) << 16) | ((127u - (L[15] & 127u)) << 24);
                  *(PG8_LAS u32x4*)(ixs + tid * 16) = w; }
                float fa[16], fb[16];
#pragma unroll
                for (int i = 0; i < 16; ++i) { const float mine = key2f(L[i] & ~127u), oth = key2f(O[i] & ~127u); fa[i] = p ? oth : mine; fb[i] = p ? mine : oth; }
                unsigned C[16];
#pragma unroll
                for (int i = 0; i < 16; ++i) C[i] = 0u;
#pragma unroll
                for (int i = 0; i < 16; ++i)
#pragma unroll
                    for (int j = 0; j < 16; ++j) if ((i + 1) * (j + 1) <= 16) { unsigned xk = (f2key(fa[i] + fb[j]) & ~255u) | (unsigned)(255 - (i * 16 + j));
#pragma unroll
                        for (int q = 0; q < 16; ++q) { const unsigned hi_ = C[q] > xk ? C[q] : xk; xk = C[q] > xk ? xk : C[q]; C[q] = hi_; } }
                asm volatile("s_waitcnt lgkmcnt(0)" ::: "memory");
                float sq = 0.f;
#pragma unroll
                for (int i = 0; i < 4; ++i) { const f32x4 t = *(const f32x4*)(ssq + (size_t)row * 16 + 4 * i); sq += (t[0] + t[1]) + (t[2] + t[3]); }
                const float r2 = __builtin_amdgcn_rsqf(sq * (1.0f / 1024.0f) + 1e-6f);
                if (u.pn == 0 && p == 0) rinv2[row] = r2;
                const float b0 = key2f(C[0] & ~255u); float wsum = 0.f; float wv[16];
#pragma unroll
                for (int q = 0; q < 16; ++q) { wv[q] = __builtin_amdgcn_exp2f((key2f(C[q] & ~255u) - b0) * r2 * 1.4426950408889634f); wsum += wv[q]; }
                const float inv = 1.0f / wsum;
                const PG8_LAS unsigned char* ia = ixs + (tid & ~1) * 16; const PG8_LAS unsigned char* ib = ia + 16;
                unsigned short eo[8]; float go[8];
#pragma unroll
                for (int q = 0; q < 8; ++q) { unsigned c_lo = C[q], c_hi = C[q + 8]; float w_lo = wv[q], w_hi = wv[q + 8]; asm volatile("" : "+v"(c_lo), "+v"(c_hi), "+v"(w_lo), "+v"(w_hi));
                    const unsigned ck = p ? c_hi : c_lo; const unsigned code = 255u - (ck & 255u);
                    const unsigned i1 = ia[code >> 4], i2 = ib[code & 15u]; eo[q] = (unsigned short)(i1 * 128u + i2); go[q] = (p ? w_hi : w_lo) * inv; }
                const size_t ob = ((size_t)row * 8 + u.pn) * 16 + p * 8;
                { u32x4 w; w.x = eo[0] | ((unsigned)eo[1] << 16); w.y = eo[2] | ((unsigned)eo[3] << 16); w.z = eo[4] | ((unsigned)eo[5] << 16); w.w = eo[6] | ((unsigned)eo[7] << 16); *(u32x4*)(ids + ob) = w; }
                *(f32x4*)(gw + ob) = (f32x4){go[0], go[1], go[2], go[3]}; *(f32x4*)(gw + ob + 4) = (f32x4){go[4], go[5], go[6], go[7]};
            }
            asm volatile("s_waitcnt lgkmcnt(0)" ::: "memory"); __builtin_amdgcn_s_barrier(); asm volatile("" ::: "memory");
        }
    }
};
template <class Epi, class Sched, bool ALIGN_EPI = false, bool SP2 = false>
__device__ __forceinline__ void gemm_phase(PG8_LAS unsigned char* lds, const Gemm g, const Sched& S, const Epi& E) {
    const int tid = threadIdx.x, wid = __builtin_amdgcn_readfirstlane(tid >> 6), lane = tid & 63, wr = wid >> 2, wc = wid & 3, fr = lane & 15, fq = lane >> 4;
    const int K = g.K, nt = K / BK;
    unsigned voffA[2], voffB[2];
#pragma unroll
    for (int i = 0; i < 2; ++i) { int R, C; stage_rc(tid * 16 + i * 8192, R, C); const int Rb = Epi::PERM ? ((R & ~31) + perm32(R & 31)) : R;
        voffA[i] = (unsigned)(R * K + C) * 2u; voffB[i] = (unsigned)(Rb * K + C) * 2u; }
    const size_t kstep = (size_t)(BK * 2);
    const size_t hstep = (size_t)HALF * K * 2;
    const size_t tstep = 2 * hstep;
    const unsigned ldsw = (unsigned)wid * 1024u;
    const int aoff = lds_byte(wr * 64 + fr, fq * 8), boff = lds_byte(wc * 32 + fr, fq * 8);
#define PG8_SA(b, h) (((b) * 2 + (h)) * HTB)
#define PG8_SB(b, h) ((4 + (b) * 2 + (h)) * HTB)
#define PG8_STAGE(bufoff, gbase, voff) do { _Pragma("unroll") for (int _i = 0; _i < 2; ++_i) \
        __builtin_amdgcn_global_load_lds((const unsigned*)((const char*)(gbase) + (voff)[_i]), (PG8_LAS unsigned*)(lds + (bufoff) + ldsw + _i * 8192), 16, 0, 0); } while (0)
#define PG8_LDA(dst, b, h) do { _Pragma("unroll") for (int m = 0; m < 4; ++m) _Pragma("unroll") for (int k = 0; k < 2; ++k) dst[m][k] = *(const PG8_LAS bf16x8*)(lds + PG8_SA(b, h) + aoff + m * 2048 + k * 1024); } while (0)
#define PG8_LDB(dst, b, h) do { _Pragma("unroll") for (int n = 0; n < 2; ++n) _Pragma("unroll") for (int k = 0; k < 2; ++k) dst[n][k] = *(const PG8_LAS bf16x8*)(lds + PG8_SB(b, h) + boff + n * 2048 + k * 1024); } while (0)
#define PG8_MMA(ai, bj, At, Bt) do { __builtin_amdgcn_s_setprio(1); _Pragma("unroll") for (int m = 0; m < 4; ++m) _Pragma("unroll") for (int n = 0; n < 2; ++n) _Pragma("unroll") for (int k = 0; k < 2; ++k) \
        acc[ai][bj][m][n] = __builtin_amdgcn_mfma_f32_16x16x32_bf16(Bt[n][k], At[m][k], acc[ai][bj][m][n], 0, 0, 0); __builtin_amdgcn_s_setprio(0); } while (0)
#define PG8_WAIT_V(n) asm volatile("s_waitcnt vmcnt(" #n ")" ::: "memory")
#define PG8_WAIT_L(n) asm volatile("s_waitcnt lgkmcnt(" #n ")" ::: "memory")
#define PG8_BAR __builtin_amdgcn_s_barrier()
#define PG8_SCHED __builtin_amdgcn_sched_barrier(0)
    Unit cur, nxt; int ui = 0;
    if (!S.next(0, cur)) return;
    f32x4 acc[2][2][4][2];
#pragma unroll
    for (int a = 0; a < 2; ++a)
#pragma unroll
        for (int b = 0; b < 2; ++b)
#pragma unroll
            for (int m = 0; m < 4; ++m)
#pragma unroll
                for (int n = 0; n < 2; ++n) acc[a][b][m][n] = (f32x4){0.f, 0.f, 0.f, 0.f};
    bf16x8 At[4][2], B0[2][2], B1[2][2];
    const char* cA = (const char*)g.A + (size_t)cur.pm * tstep; const char* cB = (const char*)g.Bt + (size_t)cur.pn * tstep;
    S.a_ready(cur);
    if constexpr (SP2) {
        PG8_STAGE(PG8_SB(0, 0), cB, voffB); PG8_STAGE(PG8_SB(0, 1), cB + hstep, voffB); PG8_STAGE(PG8_SA(0, 0), cA, voffA); PG8_STAGE(PG8_SA(0, 1), cA + hstep, voffA);
        if (wr == 1) PG8_BAR;
        PG8_WAIT_V(2); PG8_BAR;
        PG8_STAGE(PG8_SB(1, 0), cB + kstep, voffB); PG8_STAGE(PG8_SA(1, 0), cA + kstep, voffA); PG8_STAGE(PG8_SB(1, 1), cB + hstep + kstep, voffB);
        PG8_WAIT_V(6); PG8_BAR;
    } else {
        PG8_STAGE(PG8_SB(0, 0), cB, voffB); PG8_STAGE(PG8_SA(0, 0), cA, voffA); PG8_STAGE(PG8_SB(0, 1), cB + hstep, voffB); PG8_STAGE(PG8_SA(0, 1), cA + hstep, voffA);
        if (wr == 1) PG8_BAR;
        PG8_WAIT_V(4); PG8_BAR;
        PG8_STAGE(PG8_SB(1, 0), cB + kstep, voffB); PG8_STAGE(PG8_SA(1, 0), cA + kstep, voffA); PG8_STAGE(PG8_SB(1, 1), cB + hstep + kstep, voffB);
        PG8_WAIT_V(6); PG8_BAR;
    }
    for (;;) {
        const bool has_next = S.next(ui + 1, nxt);
        const char* nA = has_next ? (const char*)g.A + (size_t)nxt.pm * tstep : cA; const char* nB = has_next ? (const char*)g.Bt + (size_t)nxt.pn * tstep : cB;
        for (int t = 0; t < nt; t += 2) {
            if constexpr (Epi::HAS_MID) { if (t == Epi::MID_T) E.mid(acc, cur, wr, wc, fr, fq); }
            const bool last = (t == nt - 2);
            const char* a1 = cA + (size_t)(t + 1) * kstep;
            const char* a2 = last ? nA : cA + (size_t)(t + 2) * kstep; const char* b2 = last ? nB : cB + (size_t)(t + 2) * kstep;
            const char* a3 = a2 + kstep; const char* b3 = b2 + kstep;
            if (last && has_next) S.a_ready(nxt);
            if constexpr (SP2) {
            PG8_LDB(B0, 0, 0); PG8_LDB(B1, 0, 1); PG8_SCHED; PG8_LDA(At, 0, 0); PG8_STAGE(PG8_SA(1, 1), a1 + hstep, voffA);
            PG8_WAIT_V(8); PG8_WAIT_L(0); PG8_BAR; PG8_MMA(0, 0, At, B0); PG8_MMA(0, 1, At, B1); PG8_BAR; PG8_SCHED;
            PG8_LDA(At, 0, 1); PG8_STAGE(PG8_SB(0, 0), b2, voffB); PG8_STAGE(PG8_SB(0, 1), b2 + hstep, voffB); PG8_STAGE(PG8_SA(0, 0), a2, voffA);
            PG8_WAIT_V(8); PG8_WAIT_L(0); PG8_BAR; PG8_MMA(1, 0, At, B0); PG8_MMA(1, 1, At, B1); PG8_BAR; PG8_SCHED;
            PG8_LDB(B0, 1, 0); PG8_LDB(B1, 1, 1); PG8_SCHED; PG8_LDA(At, 1, 0); PG8_STAGE(PG8_SA(0, 1), a2 + hstep, voffA);
            PG8_WAIT_V(8); PG8_WAIT_L(0); PG8_BAR; PG8_MMA(0, 0, At, B0); PG8_MMA(0, 1, At, B1); PG8_BAR; PG8_SCHED;
            PG8_LDA(At, 1, 1); PG8_STAGE(PG8_SB(1, 0), b3, voffB); PG8_STAGE(PG8_SB(1, 1), b3 + hstep, voffB); PG8_STAGE(PG8_SA(1, 0), a3, voffA);
            PG8_WAIT_V(8); PG8_WAIT_L(0); PG8_BAR; PG8_MMA(1, 0, At, B0); PG8_MMA(1, 1, At, B1); PG8_BAR; PG8_SCHED;
            } else {
            PG8_LDB(B0, 0, 0); PG8_SCHED; PG8_LDA(At, 0, 0); PG8_STAGE(PG8_SA(1, 1), a1 + hstep, voffA);
            PG8_WAIT_L(8); PG8_BAR; PG8_WAIT_L(0); PG8_MMA(0, 0, At, B0); PG8_BAR; PG8_SCHED;
            PG8_LDB(B1, 0, 1); PG8_STAGE(PG8_SB(0, 0), b2, voffB);
            PG8_BAR; PG8_WAIT_L(0); PG8_MMA(0, 1, At, B1); PG8_BAR;
            PG8_LDA(At, 0, 1); PG8_STAGE(PG8_SA(0, 0), a2, voffA);
            PG8_BAR; PG8_WAIT_L(0); PG8_MMA(1, 0, At, B0); PG8_BAR; PG8_SCHED;
            PG8_STAGE(PG8_SB(0, 1), b2 + hstep, voffB);
            PG8_WAIT_V(6); PG8_BAR; PG8_MMA(1, 1, At, B1); PG8_BAR;
            PG8_LDB(B0, 1, 0); PG8_SCHED; PG8_LDA(At, 1, 0); PG8_STAGE(PG8_SA(0, 1), a2 + hstep, voffA);
            PG8_WAIT_L(8); PG8_BAR; PG8_WAIT_L(0); PG8_MMA(0, 0, At, B0); PG8_BAR; PG8_SCHED;
            PG8_LDB(B1, 1, 1); PG8_STAGE(PG8_SB(1, 0), b3, voffB);
            PG8_BAR; PG8_WAIT_L(0); PG8_MMA(0, 1, At, B1); PG8_BAR;
            PG8_LDA(At, 1, 1); PG8_STAGE(PG8_SA(1, 0), a3, voffA);
            PG8_BAR; PG8_WAIT_L(0); PG8_MMA(1, 0, At, B0); PG8_BAR; PG8_SCHED;
            PG8_STAGE(PG8_SB(1, 1), b3 + hstep, voffB);
            PG8_WAIT_V(6); PG8_BAR; PG8_MMA(1, 1, At, B1); PG8_BAR;
            }
        }
        if constexpr (ALIGN_EPI) { if (wr == 0) PG8_BAR; }
        if constexpr (!Epi::AFTER_DRAIN) { E(acc, cur, wr, wc, fr, fq); S.done(cur); }
        if (!has_next) break;
#pragma unroll
        for (int a = 0; a < 2; ++a)
#pragma unroll
            for (int b = 0; b < 2; ++b)
#pragma unroll
                for (int m = 0; m < 4; ++m)
#pragma unroll
                    for (int n = 0; n < 2; ++n) acc[a][b][m][n] = (f32x4){0.f, 0.f, 0.f, 0.f};
        cur = nxt; cA = nA; cB = nB; ++ui;
        if constexpr (ALIGN_EPI) { if (wr == 1) PG8_BAR; }
    }
    PG8_WAIT_V(0);
    if constexpr (!ALIGN_EPI) { if (wr == 0) PG8_BAR; }
    PG8_BAR;
    if constexpr (Epi::AFTER_DRAIN) { E.fused(acc, cur, wr, wc, fr, fq, lds, wid, lane); S.done(cur); }
#undef PG8_SA
#undef PG8_SB
#undef PG8_STAGE
#undef PG8_LDA
#undef PG8_LDB
#undef PG8_MMA
#undef PG8_WAIT_V
#undef PG8_WAIT_L
#undef PG8_BAR
#undef PG8_SCHED
}
}


namespace att {
#define ALAS __attribute__((address_space(3)))
typedef unsigned short bf16;
typedef short bf16x8 __attribute__((ext_vector_type(8)));
typedef short s16x4 __attribute__((ext_vector_type(4)));
typedef float f32x16 __attribute__((ext_vector_type(16)));
typedef float f32x4 __attribute__((ext_vector_type(4)));
typedef float f32x2 __attribute__((ext_vector_type(2)));
typedef unsigned u32x4 __attribute__((ext_vector_type(4)));
typedef __bf16 bf16x2_t __attribute__((ext_vector_type(2)));
constexpr int SEQ = 4096;
constexpr int VPITCH = 144;
constexpr float LOG2E = 1.4426950408889634f, LN2 = 0.6931471805599453f;
__device__ __forceinline__ unsigned pkbf(float lo, float hi) { f32x2 v = {lo, hi}; bf16x2_t b = __builtin_convertvector(v, bf16x2_t); return __builtin_bit_cast(unsigned, b); }
__device__ __forceinline__ void wave_lds_sync() { asm volatile("s_waitcnt lgkmcnt(0)" ::: "memory"); }
__device__ __forceinline__ s16x4 vtr(const ALAS unsigned char* p) { return __builtin_bit_cast(s16x4, __builtin_amdgcn_ds_read_tr16_b64_v4i16((ALAS s16x4*)p)); }
__device__ __forceinline__ int crow(int r, int hi) { return (r & 3) + 8 * (r >> 2) + 4 * hi; }

__device__ __forceinline__ void pv_tile(f32x16& o0, f32x16& o1, const float (&a)[16], const ALAS unsigned char* vt, int lane) {
    const int g = lane >> 4, i = lane & 15, q_ = i >> 2, p_ = i & 3, h = lane >> 5;
    const ALAS unsigned char* vb = vt + (8 * h + q_) * VPITCH + (16 * (g & 1) + 4 * p_) * 2;
    u32x4 pw0, pw1;
    pw0.x = pkbf(a[0], a[1]); pw0.y = pkbf(a[2], a[3]); pw0.z = pkbf(a[4], a[5]); pw0.w = pkbf(a[6], a[7]);
    pw1.x = pkbf(a[8], a[9]); pw1.y = pkbf(a[10], a[11]); pw1.z = pkbf(a[12], a[13]); pw1.w = pkbf(a[14], a[15]);
    const bf16x8 pa0 = __builtin_bit_cast(bf16x8, pw0), pa1 = __builtin_bit_cast(bf16x8, pw1);
#pragma unroll
    for (int s = 0; s < 2; ++s) {
        const s16x4 l0 = vtr(vb + (16 * s) * VPITCH), h0 = vtr(vb + (16 * s + 4) * VPITCH);
        const s16x4 l1 = vtr(vb + (16 * s) * VPITCH + 64), h1 = vtr(vb + (16 * s + 4) * VPITCH + 64);
        const bf16x8 v0 = (bf16x8){l0[0], l0[1], l0[2], l0[3], h0[0], h0[1], h0[2], h0[3]};
        const bf16x8 v1 = (bf16x8){l1[0], l1[1], l1[2], l1[3], h1[0], h1[1], h1[2], h1[3]};
        o0 = __builtin_amdgcn_mfma_f32_32x32x16_bf16(s ? pa1 : pa0, v0, o0, 0, 0, 0);
        o1 = __builtin_amdgcn_mfma_f32_32x32x16_bf16(s ? pa1 : pa0, v1, o1, 0, 0, 0);
    }
}
__device__ __forceinline__ void bcast_rows(float v, ALAS float* sc, int r32, int hi, float (&out)[16]) {
    if (hi == 0) sc[r32] = v;
    wave_lds_sync();
#pragma unroll
    for (int g = 0; g < 4; ++g) { const f32x4 t = *(const ALAS f32x4*)(sc + 8 * g + 4 * hi); out[4 * g] = t[0]; out[4 * g + 1] = t[1]; out[4 * g + 2] = t[2]; out[4 * g + 3] = t[3]; }
    wave_lds_sync();
}
__device__ __forceinline__ void store_o(const f32x16& o0, const f32x16& o1, ALAS unsigned char* stg, bf16* dst  , size_t rstride_elems, int lane) {
    const int r32 = lane & 31, hi = lane >> 5;
    wave_lds_sync();
#pragma unroll
    for (int r = 0; r < 16; ++r) { const int q = crow(r, hi);
        *(ALAS unsigned short*)(stg + q * VPITCH + r32 * 2) = (unsigned short)(pkbf(o0[r], 0.f) & 0xffffu);
        *(ALAS unsigned short*)(stg + q * VPITCH + 64 + r32 * 2) = (unsigned short)(pkbf(o1[r], 0.f) & 0xffffu); }
    wave_lds_sync();
#pragma unroll
    for (int i = 0; i < 4; ++i) { const int row = 8 * i + (lane >> 3), ch = lane & 7; const u32x4 v = *(const ALAS u32x4*)(stg + row * VPITCH + ch * 16); *(u32x4*)(dst + (size_t)row * rstride_elems + ch * 8) = v; }
    wave_lds_sync();
}

__device__ __forceinline__ void sb_item(const bf16* QS, const bf16* KS, const bf16* VS, bf16* OC, int b, int h, int qt, ALAS unsigned char* wl, int lane) {
    const int r32 = lane & 31, hi = lane >> 5;
    const int t0 = qt * 32; const size_t rowb = (size_t)b * SEQ;
    const int kperm = (r32 & ~12) | ((r32 & 4) << 1) | ((r32 & 8) >> 1);
    bf16x8 qf[4];
    { const bf16* qp = QS + (rowb + t0 + r32) * 512 + h * 64 + hi * 8;
#pragma unroll
      for (int d0 = 0; d0 < 4; ++d0) qf[d0] = *(const bf16x8*)(qp + d0 * 16); }
    f32x16 o0 = {}, o1 = {}; float R = 0.f;
    for (int key0 = t0; key0 >= 0; key0 -= 32) {
        const bf16* kp = KS + (rowb + key0 + kperm) * 512 + h * 64 + hi * 8;
        bf16x8 kf[4];
#pragma unroll
        for (int d0 = 0; d0 < 4; ++d0) kf[d0] = *(const bf16x8*)(kp + d0 * 16);
        u32x4 vv[4];
#pragma unroll
        for (int i = 0; i < 4; ++i) vv[i] = *(const u32x4*)(VS + (rowb + key0 + 8 * i + (lane >> 3)) * 512 + h * 64 + (lane & 7) * 8);
        f32x16 p = {};
#pragma unroll
        for (int d0 = 0; d0 < 4; ++d0) p = __builtin_amdgcn_mfma_f32_32x32x16_bf16(kf[d0], qf[d0], p, 0, 0, 0);
#pragma unroll
        for (int i = 0; i < 4; ++i) *(ALAS u32x4*)(wl + (8 * i + (lane >> 3)) * VPITCH + (lane & 7) * 16) = vv[i];
        const bool diag = (key0 == t0);
        float z2[16], L2[16];
#pragma unroll
        for (int r = 0; r < 16; ++r) { const int kk = (r & 7) + 8 * hi + 16 * (r >> 3); const float zz = p[r] * (0.125f * LOG2E);
            const float sp = fmaxf(zz, 0.f) + __builtin_amdgcn_logf(1.0f + __builtin_amdgcn_exp2f(-fabsf(zz)));
            const bool valid = !diag || (kk < r32); z2[r] = zz; L2[r] = valid ? sp : 0.f; }
        float c[16];
        c[15] = L2[15];
#pragma unroll
        for (int r = 14; r >= 8; --r) c[r] = c[r + 1] + L2[r];
        c[7] = L2[7];
#pragma unroll
        for (int r = 6; r >= 0; --r) c[r] = c[r + 1] + L2[r];
        const float TB = c[8], TA = c[0];
        const float TBo = __shfl_xor(TB, 32), TAo = __shfl_xor(TA, 32);
        const float offB = R + (hi ? 0.f : TBo);
        const float offA = R + TB + TBo + (hi ? 0.f : TAo);
        float a[16];
#pragma unroll
        for (int r = 0; r < 16; ++r) { const int kk = (r & 7) + 8 * hi + 16 * (r >> 3); const bool valid = !diag || (kk < r32);
            const float e = __builtin_amdgcn_exp2f(z2[r] - (c[r] + (r < 8 ? offA : offB))); a[r] = valid ? e : 0.f; }
        R += (TA + TB) + (TAo + TBo);
        wave_lds_sync();
        pv_tile(o0, o1, a, wl, lane);
        wave_lds_sync();
        if (__all(R > 40.0f * LOG2E)) break;
    }
    store_o(o0, o1, wl, OC + (rowb + t0) * 768 + h * 64, 768, lane);
}

__device__ __forceinline__ void dl_item(const bf16* QD, const bf16* KD, const bf16* VD, bf16* OC, int b, int j, int c, int mb, ALAS unsigned char* wl, int lane) {
    const int r32 = lane & 31, hi = lane >> 5;
    const size_t rowb = (size_t)b * SEQ;
    const int tq = c + 16 * (32 * mb + r32), tmax = c + 16 * (32 * mb + 31);
    const int kperm = (r32 & ~12) | ((r32 & 4) << 1) | ((r32 & 8) >> 1);
    ALAS float* sc = (ALAS float*)(wl + 8192);
    f32x16 o0 = {}, o1 = {}; float mrun = -3.0e38f, lrun = 0.f;
    for (int g = 0; g < 3; ++g) {
        const int hh = 4 * g + j, sh = 2 * g, r = 1 << sh;
        const float slope2 = __builtin_amdgcn_exp2f(-8.0f * (float)(hh + 1) / 12.0f) * LOG2E;
        bf16x8 qf[4];
        { const bf16* qp = QD + (rowb + tq) * 768 + hh * 64 + hi * 8;
#pragma unroll
          for (int d0 = 0; d0 < 4; ++d0) qf[d0] = *(const bf16x8*)(qp + d0 * 16); }
        const int nkeys = (496 >> sh) + 129, ntile = (nkeys + 31) >> 5;
        for (int kt = 0; kt < ntile; ++kt) {
            int sk = tmax - r * (32 * kt + kperm); sk = sk < 0 ? 0 : sk;
            const bf16* kp = KD + (rowb + sk) * 768 + hh * 64 + hi * 8;
            bf16x8 kf[4];
#pragma unroll
            for (int d0 = 0; d0 < 4; ++d0) kf[d0] = *(const bf16x8*)(kp + d0 * 16);
            u32x4 vv[4];
#pragma unroll
            for (int i = 0; i < 4; ++i) { int sv = tmax - r * (32 * kt + 8 * i + (lane >> 3)); sv = sv < 0 ? 0 : sv; vv[i] = *(const u32x4*)(VD + (rowb + sv) * 768 + hh * 64 + (lane & 7) * 8); }
            f32x16 p = {};
#pragma unroll
            for (int d0 = 0; d0 < 4; ++d0) p = __builtin_amdgcn_mfma_f32_32x32x16_bf16(kf[d0], qf[d0], p, 0, 0, 0);
#pragma unroll
            for (int i = 0; i < 4; ++i) *(ALAS u32x4*)(wl + (8 * i + (lane >> 3)) * VPITCH + (lane & 7) * 16) = vv[i];
            float z2[16]; float mt = -3.0e38f; unsigned vm = 0u;
#pragma unroll
            for (int q = 0; q < 16; ++q) { const int kk = (q & 7) + 8 * hi + 16 * (q >> 3); const int s = tmax - r * (32 * kt + kk); const int off = tq - s;
                const bool valid = (off >= 0) && (off <= 128 * r) && (s >= 0); vm |= valid ? (1u << q) : 0u;
                const float zz = p[q] * (0.125f * LOG2E) - slope2 * (float)off; z2[q] = zz; mt = valid ? fmaxf(mt, zz) : mt; }
            mt = fmaxf(mt, __shfl_xor(mt, 32));
            if (__any(mt > mrun + 8.0f)) {
                const float mnew = fmaxf(mrun, mt); const float alpha = __builtin_amdgcn_exp2f(mrun - mnew);
                lrun *= alpha; float al[16]; bcast_rows(alpha, sc, r32, hi, al);
#pragma unroll
                for (int q = 0; q < 16; ++q) { o0[q] *= al[q]; o1[q] *= al[q]; }
                mrun = mnew;
            }
            float a[16]; float ls = 0.f;
#pragma unroll
            for (int q = 0; q < 16; ++q) { const float e = __builtin_amdgcn_exp2f(z2[q] - mrun); a[q] = ((vm >> q) & 1u) ? e : 0.f; ls += a[q]; }
            lrun += ls;
            wave_lds_sync();
            pv_tile(o0, o1, a, wl, lane);
            wave_lds_sync();
        }
    }
    const float ltot = lrun + __shfl_xor(lrun, 32);
    float il[16]; bcast_rows(1.0f / ltot, sc, r32, hi, il);
#pragma unroll
    for (int q = 0; q < 16; ++q) { o0[q] *= il[q]; o1[q] *= il[q]; }
    store_o(o0, o1, wl, OC + (rowb + c + 16 * 32 * mb) * 768 + 512 + j * 64, (size_t)16 * 768, lane);
}
#undef ALAS
}

constexpr int NWAVES = 8;
#ifndef MK_N_LAUNCHES
#define MK_N_LAUNCHES 1
#endif
#ifndef MK_LAST_PHASE
#define MK_LAST_PHASE 8
#endif
constexpr int N_LAUNCHES = MK_N_LAUNCHES;
constexpr int PER_PHASE = 8;

constexpr int BATCH = 16, SEQ = 4096, D = 1024, T = BATCH * SEQ;
constexpr int N1 = 5888;
constexpr int NEXP = 16384;
constexpr size_t MiB = 1u << 20;
constexpr size_t WS_CTL = 0, CTL_ZERO_BYTES = 1 * MiB;
constexpr size_t WS_WIN = 2 * MiB;
constexpr size_t WS_WCAT = 16 * MiB;
constexpr size_t WS_WOUT = 18 * MiB;
constexpr size_t WS_WC = 20 * MiB;
constexpr size_t WS_RINV1 = 24 * MiB;
constexpr size_t WS_RINV2 = 25 * MiB;
constexpr size_t WS_USC = 25 * MiB + 512 * 1024, WS_VSC = 25 * MiB + 768 * 1024;
constexpr size_t WS_SSQ = 26 * MiB;
constexpr size_t WS_U8 = 32 * MiB;
constexpr size_t WS_V8 = 64 * MiB;
constexpr size_t WS_IDS = 96 * MiB;
constexpr size_t WS_GW = 112 * MiB;
constexpr size_t WS_XB = 144 * MiB;
constexpr size_t WS_QS = 272 * MiB, WS_KS = 336 * MiB, WS_VS = 400 * MiB;
constexpr size_t WS_QD = 464 * MiB, WS_KD = 560 * MiB, WS_VD = 656 * MiB;
constexpr size_t WS_GT = 752 * MiB;
constexpr size_t WS_MIX = 272 * MiB;
constexpr size_t WS_X1B = 400 * MiB;
constexpr size_t WS_END = 1008 * MiB;
constexpr int CW_BAR = 4096;

constexpr int RING_OFF = 0, RING_BYTES = 131072;
constexpr int LDSCTL_OFF = 143360, MISC_OFF = LDSCTL_OFF + 320;
constexpr int LDS_BYTES = 147456;
static_assert(MISC_OFF + 128 <= LDS_BYTES, "LDS map");
#define GAS __attribute__((address_space(1)))
#define LAS __attribute__((address_space(3)))
typedef unsigned short bf16;
typedef unsigned v4u __attribute__((ext_vector_type(4)));
typedef float f32x4 __attribute__((ext_vector_type(4)));
typedef short bf16x8 __attribute__((ext_vector_type(8)));
typedef GAS unsigned gu32;
typedef GAS unsigned long long gu64;
#define RLX_AGENT __ATOMIC_RELAXED, __HIP_MEMORY_SCOPE_AGENT
#define LDS_WAIT() asm volatile("s_waitcnt lgkmcnt(0)" ::: "memory")
#define VM_WAIT() asm volatile("s_waitcnt vmcnt(0)" ::: "memory")
__device__ __forceinline__ unsigned long long rt() { return __builtin_amdgcn_s_memrealtime(); }
__device__ __forceinline__ unsigned f2bf(float f) { unsigned u = __builtin_bit_cast(unsigned, f); return (u + 0x7fffu + ((u >> 16) & 1u)) >> 16; }
__device__ __forceinline__ unsigned pk2(float lo, float hi) { return f2bf(lo) | (f2bf(hi) << 16); }

#define XB_TMO      128
#define XB_XCNT(j)  (256  + 64 * (j))
#define XB_XSUB(j)  (1280 + 64 * (j))
#define XB_XGEN(j)  (2304 + 64 * (j))
#define XB_TOP      3328
#define XB_TOPGEN   3392
#define XCD_BAR_WORDS 3456
#define XB_SPIN_CAP (1u << 18)

__device__ __forceinline__ unsigned xb_ld(unsigned* p)              { return __hip_atomic_load(p, __ATOMIC_RELAXED, __HIP_MEMORY_SCOPE_AGENT); }
__device__ __forceinline__ unsigned xb_add(unsigned* p, unsigned v) { return __hip_atomic_fetch_add(p, v, __ATOMIC_RELAXED, __HIP_MEMORY_SCOPE_AGENT); }
__device__ __forceinline__ unsigned xb_xcc_id() { return (unsigned)__builtin_amdgcn_s_getreg((3 << 11) | 20) & 0xFu; }
#define XB_SPIN(cond, bar) do { unsigned _sp = 0; while (cond) { __builtin_amdgcn_s_sleep(1); \
    if ((++_sp & 255u) == 0u) { if (xb_ld(&(bar)[XB_TMO])) break; if (_sp > XB_SPIN_CAP) { atomicAdd(&(bar)[XB_TMO], 1u); break; } } } } while (0)

struct XcdBarrier {
    unsigned* bar; unsigned x;
    volatile LAS unsigned* st;
};

__device__ __forceinline__ XcdBarrier xcd_barrier_post(unsigned* bar, volatile LAS unsigned* st) {
    XcdBarrier b; b.bar = bar; b.x = xb_xcc_id(); b.st = st;
    if (threadIdx.x == 0) (void)xb_add(&bar[XB_XCNT(b.x)], 1u);
    return b;
}
__device__ __forceinline__ void xcd_barrier_complete(unsigned* bar, unsigned x, unsigned& nloc, unsigned& nx) {
    const unsigned G = gridDim.x * gridDim.y * gridDim.z;
    unsigned sum, cnt, mine, sp = 0u;
    for (;;) {
        sum = 0u; cnt = 0u; mine = 0u;
#pragma unroll
        for (unsigned j = 0; j < 16; ++j) { const unsigned c = xb_ld(&bar[XB_XCNT(j)]); sum += c; cnt += (c > 0u) ? 1u : 0u; mine = (j == x) ? c : mine; }
        if (sum == G) break;
        __builtin_amdgcn_s_sleep(1);
        if ((++sp & 255u) == 0u) { if (xb_ld(&bar[XB_TMO])) break; if (sp > XB_SPIN_CAP) { atomicAdd(&bar[XB_TMO], 1u); break; } }
    }
    nloc = mine > 0u ? mine : 1u; nx = cnt > 0u ? cnt : 1u;
}

__device__ __forceinline__ void xcd_barrier(const XcdBarrier& b) {
    asm volatile("s_waitcnt vmcnt(0)" ::: "memory");
    __syncthreads();
    if (threadIdx.x == 0) {
        unsigned* bar = b.bar;
        __builtin_amdgcn_s_waitcnt(0);
        unsigned nloc = b.st[0], nx = b.st[1];
        if (nloc == 0u) { xcd_barrier_complete(bar, b.x, nloc, nx); b.st[0] = nloc; b.st[1] = nx; }
        const unsigned old = xb_add(&bar[XB_XSUB(b.x)], 1u);
        const unsigned gen = old / nloc;
        if (old + 1u == (gen + 1u) * nloc) {
            __builtin_amdgcn_fence(__ATOMIC_RELEASE, "agent");
            asm volatile("s_waitcnt vmcnt(0)" ::: "memory");
            const unsigned og = xb_add(&bar[XB_TOP], 1u);
            const unsigned tg = og / nx;
            if (og + 1u == (tg + 1u) * nx) xb_add(&bar[XB_TOPGEN], 1u);
            else XB_SPIN(xb_ld(&bar[XB_TOPGEN]) == tg, bar);
            __builtin_amdgcn_fence(__ATOMIC_ACQUIRE, "agent");
            xb_add(&bar[XB_XGEN(b.x)], 1u);
            asm volatile("s_waitcnt vmcnt(0)" ::: "memory");
        } else {
            XB_SPIN(xb_ld(&bar[XB_XGEN(b.x)]) == gen, bar);
            __builtin_amdgcn_fence(__ATOMIC_ACQUIRE, "agent");
            asm volatile("s_waitcnt vmcnt(0)" ::: "memory");
        }
    }
    __syncthreads();
}

typedef float f32x2 __attribute__((ext_vector_type(2)));
typedef unsigned v2u __attribute__((ext_vector_type(2)));
struct Frame {
    LAS unsigned char* lds;
    volatile LAS unsigned* MISC;
    gu32* ctl;
    int tid, lane, wave;
    int vcu, G;
};
__device__ __forceinline__ float wave_sum(float v) {
#pragma unroll
    for (int o = 1; o < 64; o <<= 1) v += __shfl_xor(v, o);
    return v;
}
__device__ __forceinline__ float wave_max(float v) {
#pragma unroll
    for (int o = 1; o < 64; o <<= 1) v = fmaxf(v, __shfl_xor(v, o));
    return v;
}
__device__ __forceinline__ int win_row(int n) { if (n < 1536 || n >= 3072) return n; const int t = (n - 1536) >> 8, ln = (n - 1536) & 255, hl = ln >> 6, d = ln & 63; return 1536 + t * 256 + 32 * hl + (d & 31) + 128 * (d >> 5); }
__device__ __forceinline__ void p0_transpose_item(const float* W, int N, const float* gain, bf16* WT, int ldt, int koff, int mode, LAS float* scr, int item, int lane) {
    const int nblk = N / 32, kb = item / nblk, nb = item % nblk, k0 = 64 * kb, n0 = 32 * nb;
#pragma unroll 8
    for (int i = 0; i < 32; ++i) { const int kk = 2 * i + (lane >> 5); float v = W[(size_t)(k0 + kk) * N + n0 + (lane & 31)]; if (gain) v *= gain[k0 + kk]; scr[kk * 33 + (lane & 31)] = v; }
    LDS_WAIT(); asm volatile("" ::: "memory");
    const int c = lane & 7;
#pragma unroll
    for (int j = 0; j < 4; ++j) { const int n = (lane >> 3) + 8 * j; const LAS float* s = scr + (8 * c) * 33 + n;
        v4u o; o.x = pk2(s[0 * 33], s[1 * 33]); o.y = pk2(s[2 * 33], s[3 * 33]); o.z = pk2(s[4 * 33], s[5 * 33]); o.w = pk2(s[6 * 33], s[7 * 33]);
        const int rown = mode ? win_row(n0 + n) : (n0 + n);
        *(GAS v4u*)(WT + (size_t)rown * ldt + koff + k0 + 8 * c) = o; }
    LDS_WAIT(); asm volatile("" ::: "memory");
}
__device__ __forceinline__ void quant_row_fp8(const float* src, const float* gain, unsigned char* dst, size_t slice_stride, float* scale_out, int lane) {
    f32x4 v[4]; float am = 0.f;
#pragma unroll
    for (int j = 0; j < 4; ++j) { v[j] = *(const GAS f32x4*)(src + 256 * j + 4 * lane); if (gain) v[j] = v[j] * *(const GAS f32x4*)(gain + 256 * j + 4 * lane);
        am = fmaxf(am, fmaxf(fmaxf(fabsf(v[j][0]), fabsf(v[j][1])), fmaxf(fabsf(v[j][2]), fabsf(v[j][3])))); }
    am = wave_max(am);
    const int ex = (int)((__float_as_uint(am) >> 23) & 0xffu);
    const float s = (ex == 0) ? 1.0f : __uint_as_float((unsigned)(127 + 7 - (ex - 127)) << 23);
    const float is = (ex == 0) ? 1.0f : __uint_as_float((unsigned)(127 - 7 + (ex - 127)) << 23);
    if (lane == 0) *scale_out = is;
#pragma unroll
    for (int j = 0; j < 4; ++j) { int pk = __builtin_amdgcn_cvt_pk_fp8_f32(v[j][0] * s, v[j][1] * s, 0, false); pk = __builtin_amdgcn_cvt_pk_fp8_f32(v[j][2] * s, v[j][3] * s, pk, true);
        const int col = 256 * j + 4 * lane; *(GAS int*)(dst + (size_t)(col >> 7) * slice_stride + (col & 127)) = pk; }
}
__device__ __forceinline__ float gelu_f(float v) {
    const float av = fabsf(v), t = __builtin_amdgcn_rcpf(av * 0.2316418882f + 1.0f);
    float q = t * 0.5307027145f + (-0.7265760135f); q = q * t + 0.7107068705f; q = q * t + (-0.142248368f); q = q * t + 0.127414796f; q = q * t;
    const float e = __builtin_amdgcn_exp2f((v * v) * (-0.72134752044f));
    const float m = v * (q * e);
    return v < 0.f ? m : v - m;
}

struct Args { const float* in[14]; float* out; unsigned char* ws; int ph_lo, ph_hi, li, pad; };
__global__ void __launch_bounds__(NWAVES * 64, 2) fwd_kernel(Args args) {
    extern __shared__ __attribute__((aligned(16))) unsigned char lds[];
    Frame F;
    F.lds = (LAS unsigned char*)lds;
    F.MISC = (volatile LAS unsigned*)(F.lds + MISC_OFF);
    F.tid = threadIdx.x; F.lane = F.tid & 63; F.wave = __builtin_amdgcn_readfirstlane(F.tid >> 6);
    F.G = gridDim.x; { const int bx = blockIdx.x; F.vcu = (F.G % 8 == 0) ? (bx % 8) * (F.G / 8) + bx / 8 : bx; }
    unsigned char* ws = args.ws;
    F.ctl = (gu32*)(ws + WS_CTL);
    const float* x = args.in[0]; const float* norm1_gain = args.in[1]; const float* w_in = args.in[2]; const float* b_gate = args.in[3];
    const float* q_gain = args.in[4]; const float* k_gain = args.in[5]; const float* w_sb_out = args.in[6]; const float* w_dil_out = args.in[7];
    const float* w_out = args.in[8]; const float* norm2_gain = args.in[9]; const float* w_peer_q = args.in[10]; const float* sub_keys = args.in[11];
    const float* peer_u = args.in[12]; const float* peer_v = args.in[13];
    float* out = args.out;
    bf16* WIN = (bf16*)(ws + WS_WIN); bf16* WCAT = (bf16*)(ws + WS_WCAT); bf16* WOUT = (bf16*)(ws + WS_WOUT); bf16* WC = (bf16*)(ws + WS_WC);
    float* RINV1 = (float*)(ws + WS_RINV1); float* RINV2 = (float*)(ws + WS_RINV2); float* USC = (float*)(ws + WS_USC); float* VSC = (float*)(ws + WS_VSC); float* SSQ = (float*)(ws + WS_SSQ);
    unsigned char* U8 = ws + WS_U8; unsigned char* V8 = ws + WS_V8;
    unsigned short* IDS = (unsigned short*)(ws + WS_IDS); float* GW = (float*)(ws + WS_GW);
    bf16* XB = (bf16*)(ws + WS_XB); bf16* OC = (bf16*)(ws + WS_XB);
    bf16* QS = (bf16*)(ws + WS_QS); bf16* KS = (bf16*)(ws + WS_KS); bf16* VS = (bf16*)(ws + WS_VS);
    bf16* QD = (bf16*)(ws + WS_QD); bf16* KD = (bf16*)(ws + WS_KD); bf16* VD = (bf16*)(ws + WS_VD);
    bf16* GT = (bf16*)(ws + WS_GT); bf16* MIX = (bf16*)(ws + WS_MIX); bf16* X1B = (bf16*)(ws + WS_X1B);

    for (int u = F.tid; u < (LDS_BYTES - LDSCTL_OFF) / 4; u += NWAVES * 64) ((LAS unsigned*)(F.lds + LDSCTL_OFF))[u] = 0u;
    __syncthreads();
    const int bli = (N_LAUNCHES == PER_PHASE) ? 0 : args.li;
    XcdBarrier bar; bar.bar = (unsigned*)(F.ctl + CW_BAR) + bli * XCD_BAR_WORDS; bar.x = 0; bar.st = nullptr;
    if (N_LAUNCHES != PER_PHASE) bar = xcd_barrier_post((unsigned*)(F.ctl + CW_BAR) + bli * XCD_BAR_WORDS, F.MISC + 8);
    const int lo = args.ph_lo, hi = args.ph_hi;
#ifndef PHASE_MASK
#define PHASE_MASK 0xff
#endif
#define IN(k) (((PHASE_MASK >> (k)) & 1) && lo <= (k) && (k) < hi)
#define BOTH(k) (IN(k) && IN((k) + 1))
#define GRID_BAR() do { if (N_LAUNCHES != PER_PHASE) xcd_barrier(bar); } while (0)
    const int gw = F.vcu * NWAVES + F.wave, NGW = F.G * NWAVES;

    if (IN(0)) {
        for (int it = F.vcu; it < 256; it += F.G) {
            const int hp = it >> 4, d0 = (it & 15) * 64;
            LAS float* As = (LAS float*)(F.lds);
            LAS float* Bs = (LAS float*)(F.lds + 64 * 132 * 4);
            for (int e = F.tid; e < 64 * 32; e += 512) { const int r = e >> 5, c4 = (e & 31) * 4; *(LAS f32x4*)(As + r * 132 + c4) = *(const GAS f32x4*)(w_peer_q + (size_t)(d0 + r) * 2048 + hp * 128 + c4); }
            for (int e = F.tid; e < 128 * 32; e += 512) { const int r = e >> 5, c4 = (e & 31) * 4; *(LAS f32x4*)(Bs + r * 132 + c4) = *(const GAS f32x4*)(sub_keys + ((size_t)hp * 128 + r) * 128 + c4); }
            __syncthreads();
            const int ddg = F.tid & 15, ng = F.tid >> 4;
            f32x4 acc[4];
#pragma unroll
            for (int j = 0; j < 4; ++j) acc[j] = (f32x4){0.f, 0.f, 0.f, 0.f};
            for (int c4 = 0; c4 < 128; c4 += 4) {
                f32x4 a[4], b[4];
#pragma unroll
                for (int i = 0; i < 4; ++i) { a[i] = *(const LAS f32x4*)(As + (4 * ddg + i) * 132 + c4); b[i] = *(const LAS f32x4*)(Bs + (4 * ng + i) * 132 + c4); }
#pragma unroll
                for (int j = 0; j < 4; ++j)
#pragma unroll
                    for (int i = 0; i < 4; ++i) acc[j][i] += (a[i][0] * b[j][0] + a[i][1] * b[j][1]) + (a[i][2] * b[j][2] + a[i][3] * b[j][3]);
            }
            const f32x4 g2 = *(const GAS f32x4*)(norm2_gain + d0 + 4 * ddg);
#pragma unroll
            for (int j = 0; j < 4; ++j) { v2u o; o.x = pk2(acc[j][0] * g2[0], acc[j][1] * g2[1]); o.y = pk2(acc[j][2] * g2[2], acc[j][3] * g2[3]);
                *(GAS v2u*)(WC + (size_t)(hp * 128 + 4 * ng + j) * 1024 + d0 + 4 * ddg) = o; }
            __syncthreads();
        }
        {
            LAS float* scr = (LAS float*)(F.lds + RING_OFF + F.wave * 16384);
            constexpr int I_IN = (D / 64) * (N1 / 32), I_SB = (512 / 64) * (D / 32), I_DL = (256 / 64) * (D / 32), I_OUT = (D / 64) * (D / 32);
            constexpr int NITEMS = I_IN + I_SB + I_DL + I_OUT;
            for (int it = gw; it < NITEMS; it += NGW) {
                int r = it;
                if (r < I_IN) { p0_transpose_item(w_in, N1, norm1_gain, WIN, 1024, 0, 1, scr, r, F.lane); continue; } r -= I_IN;
                if (r < I_SB) { p0_transpose_item(w_sb_out, D, nullptr, WCAT, 768, 0, 0, scr, r, F.lane); continue; } r -= I_SB;
                if (r < I_DL) { p0_transpose_item(w_dil_out, D, nullptr, WCAT, 768, 512, 0, scr, r, F.lane); continue; } r -= I_DL;
                p0_transpose_item(w_out, D, nullptr, WOUT, 1024, 0, 0, scr, r, F.lane);
            }
        }
        for (int e = gw; e < 2 * NEXP; e += NGW) {
            if (e < NEXP) quant_row_fp8(peer_u + (size_t)e * D, norm2_gain, U8 + (size_t)e * D, 128, USC + e, F.lane);
            else { const int ev = e - NEXP; quant_row_fp8(peer_v + (size_t)ev * D, nullptr, V8 + (size_t)ev * 128, (size_t)NEXP * 128, VSC + ev, F.lane); }
        }
        for (int m = gw; m < T; m += NGW) {
            const GAS f32x4* xr = (const GAS f32x4*)(x + (size_t)m * D) + F.lane;
            f32x4 v[4]; float s = 0.f;
#pragma unroll
            for (int j = 0; j < 4; ++j) { v[j] = xr[64 * j]; s += (v[j][0] * v[j][0] + v[j][1] * v[j][1]) + (v[j][2] * v[j][2] + v[j][3] * v[j][3]); }
            s = wave_sum(s);
            if (F.lane == 0) RINV1[m] = __builtin_amdgcn_rsqf(s * (1.0f / D) + 1e-6f);
            GAS unsigned long long* o8 = (GAS unsigned long long*)(XB + (size_t)m * D) + F.lane;
#pragma unroll
            for (int j = 0; j < 4; ++j) o8[64 * j] = (unsigned long long)pk2(v[j][0], v[j][1]) | ((unsigned long long)pk2(v[j][2], v[j][3]) << 32);
        }
        if (BOTH(0)) GRID_BAR();
    }

    if (IN(1)) {
        pg8::Gemm g{XB, WIN, T, N1, D}; pg8::StaticOrder S; S.init(T, N1, F.G, (int)blockIdx.x);
        pg8::Epi1 E{RINV1, b_gate, q_gain, k_gain, QS, KS, VS, QD, KD, VD, GT};
        pg8::gemm_phase<pg8::Epi1, pg8::StaticOrder, true, true>(F.lds + RING_OFF, g, S, E);
        if (BOTH(1)) GRID_BAR();
    }

    if (IN(2)) {
        LAS unsigned char* wl = F.lds + RING_OFF + F.wave * 16384;
        for (int it = gw; it < 8192; it += NGW) { const int mb = it & 7, c = (it >> 3) & 15, j = (it >> 7) & 3, b = it >> 9; att::dl_item(QD, KD, VD, OC, b, j, c, mb, wl, F.lane); }
        for (int it = gw; it < 16384; it += NGW) { const int qt = 127 - (it & 127), h = (it >> 7) & 7, b = it >> 10; att::sb_item(QS, KS, VS, OC, b, h, qt, wl, F.lane); }
        if (BOTH(2)) GRID_BAR();
    }

    if (IN(3)) {
        pg8::Gemm g{OC, WCAT, T, D, 768}; pg8::StaticOrder S; S.init(T, D, F.G, (int)blockIdx.x);
        pg8::Epi2 E{GT, MIX};
        pg8::gemm_phase<pg8::Epi2, pg8::StaticOrder, true, true>(F.lds + RING_OFF, g, S, E);
        if (BOTH(3)) GRID_BAR();
    }

    if (IN(4)) {
        pg8::Gemm g{MIX, WOUT, T, D, D}; pg8::StaticOrder S; S.init(T, D, F.G, (int)blockIdx.x);
        pg8::Epi3 E{x, out, X1B, SSQ};
        pg8::gemm_phase<pg8::Epi3, pg8::StaticOrder, true, true>(F.lds + RING_OFF, g, S, E);
        if (BOTH(4)) GRID_BAR();
    }

    if (IN(5)) {
        pg8::Gemm g{X1B, WC, T, 2048, D}; pg8::StaticOrder S; S.init(T, 2048, F.G, (int)blockIdx.x);
        pg8::Epi4 E{SSQ, RINV2, IDS, GW};
        pg8::OneUnit O1;
        for (int i = 0; S.next(i, O1.u); ++i) pg8::gemm_phase<pg8::Epi4, pg8::OneUnit, false, true>(F.lds + RING_OFF, g, O1, E);
        if (BOTH(5)) GRID_BAR();
    }

    if (IN(6)) {
        const int vx = (int)(blockIdx.x & 7), rk = (int)(blockIdx.x >> 3), nrk = (F.G + 7 - vx) / 8;
        const int p16 = F.lane & 15, sg = F.lane >> 4;
        for (int t = rk * NWAVES + F.wave; t < T; t += nrk * NWAVES) {
            float hreg[64];
#pragma unroll
            for (int i = 0; i < 4; ++i) { const v4u a = *(const GAS v4u*)(X1B + (size_t)t * D + 256 * i + 16 * p16), b = *(const GAS v4u*)(X1B + (size_t)t * D + 256 * i + 16 * p16 + 8);
                hreg[16 * i + 0] = pg8::bflo(a.x); hreg[16 * i + 1] = pg8::bfhi(a.x); hreg[16 * i + 2] = pg8::bflo(a.y); hreg[16 * i + 3] = pg8::bfhi(a.y);
                hreg[16 * i + 4] = pg8::bflo(a.z); hreg[16 * i + 5] = pg8::bfhi(a.z); hreg[16 * i + 6] = pg8::bflo(a.w); hreg[16 * i + 7] = pg8::bfhi(a.w);
                hreg[16 * i + 8] = pg8::bflo(b.x); hreg[16 * i + 9] = pg8::bfhi(b.x); hreg[16 * i + 10] = pg8::bflo(b.y); hreg[16 * i + 11] = pg8::bfhi(b.y);
                hreg[16 * i + 12] = pg8::bflo(b.z); hreg[16 * i + 13] = pg8::bfhi(b.z); hreg[16 * i + 14] = pg8::bflo(b.w); hreg[16 * i + 15] = pg8::bfhi(b.w); }
            const int id0 = (int)IDS[(size_t)t * 128 + F.lane], id1 = (int)IDS[(size_t)t * 128 + 64 + F.lane];
            const float r2 = RINV2[t];
            unsigned long long m0 = __ballot((id0 >> 11) == vx), m1 = __ballot((id1 >> 11) == vx);
            const bool in0 = ((id0 >> 11) == vx), in1 = ((id1 >> 11) == vx);
            float res0 = 0.f, res1 = 0.f;
            while (m0 | m1) {
                int es[4], ks[4];
#pragma unroll
                for (int q = 0; q < 4; ++q) {
                    if (m0) { const int k = __builtin_ctzll(m0); m0 &= m0 - 1; es[q] = __builtin_amdgcn_readlane(id0, k); ks[q] = k; }
                    else if (m1) { const int k = __builtin_ctzll(m1); m1 &= m1 - 1; es[q] = __builtin_amdgcn_readlane(id1, k); ks[q] = 64 + k; }
                    else { es[q] = -1; ks[q] = -1; }
                }
                const int mye = sg == 0 ? es[0] : sg == 1 ? es[1] : sg == 2 ? es[2] : es[3];
                float dot = 0.f;
                if (mye >= 0) {
                    const unsigned char* up = U8 + (size_t)mye * D + 16 * p16;
                    v4u w[4];
#pragma unroll
                    for (int i = 0; i < 4; ++i) w[i] = *(const GAS v4u*)(up + 256 * i);
#pragma unroll
                    for (int i = 0; i < 4; ++i) {
                        const unsigned ww[4] = {w[i].x, w[i].y, w[i].z, w[i].w};
#pragma unroll
                        for (int d = 0; d < 4; ++d) { const f32x2 lo = __builtin_amdgcn_cvt_pk_f32_fp8((int)ww[d], false), hi2 = __builtin_amdgcn_cvt_pk_f32_fp8((int)ww[d], true);
                            dot += (lo[0] * hreg[16 * i + 4 * d] + lo[1] * hreg[16 * i + 4 * d + 1]) + (hi2[0] * hreg[16 * i + 4 * d + 2] + hi2[1] * hreg[16 * i + 4 * d + 3]); }
                    }
                }
                dot += __shfl_xor(dot, 1); dot += __shfl_xor(dot, 2); dot += __shfl_xor(dot, 4); dot += __shfl_xor(dot, 8);
#pragma unroll
                for (int q = 0; q < 4; ++q) { const float dv = __int_as_float(__builtin_amdgcn_readlane(__float_as_int(dot), 16 * q));
                    res0 = (F.lane == ks[q]) ? dv : res0; res1 = (F.lane + 64 == ks[q]) ? dv : res1; }
            }
            if (in0) { const float a = gelu_f(res0 * r2 * USC[id0]); GW[(size_t)t * 128 + F.lane] = GW[(size_t)t * 128 + F.lane] * a * VSC[id0]; }
            if (in1) { const float a = gelu_f(res1 * r2 * USC[id1]); GW[(size_t)t * 128 + 64 + F.lane] = GW[(size_t)t * 128 + 64 + F.lane] * a * VSC[id1]; }
        }
        if (BOTH(6)) GRID_BAR();
    }

    if (IN(7)) {
        const int vx = (int)(blockIdx.x & 7), rk = (int)(blockIdx.x >> 3), nrk = (F.G + 7 - vx) / 8;
        const int l8 = F.lane & 7, kg = F.lane >> 3;
        const unsigned char* vbase = V8 + (size_t)vx * NEXP * 128 + 16 * l8;
        for (int t = rk * NWAVES + F.wave; t < T; t += nrk * NWAVES) {
            float acc[16];
#pragma unroll
            for (int i = 0; i < 16; ++i) acc[i] = 0.f;
#pragma unroll 4
            for (int i = 0; i < 16; ++i) {
                const int k = 8 * i + kg; const int e = (int)IDS[(size_t)t * 128 + k]; const float cf = GW[(size_t)t * 128 + k];
                const v4u w = *(const GAS v4u*)(vbase + (size_t)e * 128);
                const unsigned ww[4] = {w.x, w.y, w.z, w.w};
#pragma unroll
                for (int d = 0; d < 4; ++d) { const f32x2 lo = __builtin_amdgcn_cvt_pk_f32_fp8((int)ww[d], false), hi2 = __builtin_amdgcn_cvt_pk_f32_fp8((int)ww[d], true);
                    acc[4 * d] += cf * lo[0]; acc[4 * d + 1] += cf * lo[1]; acc[4 * d + 2] += cf * hi2[0]; acc[4 * d + 3] += cf * hi2[1]; }
            }
            float r8[8], r4[4], r2v[2];
            { const bool up = (F.lane & 8) != 0;
#pragma unroll
              for (int i = 0; i < 8; ++i) { const float keep = up ? acc[8 + i] : acc[i], send = up ? acc[i] : acc[8 + i]; r8[i] = keep + __shfl_xor(send, 8); } }
            { const bool up = (F.lane & 16) != 0;
#pragma unroll
              for (int i = 0; i < 4; ++i) { const float keep = up ? r8[4 + i] : r8[i], send = up ? r8[i] : r8[4 + i]; r4[i] = keep + __shfl_xor(send, 16); } }
            { const bool up = (F.lane & 32) != 0;
#pragma unroll
              for (int i = 0; i < 2; ++i) { const float keep = up ? r4[2 + i] : r4[i], send = up ? r4[i] : r4[2 + i]; r2v[i] = keep + __shfl_xor(send, 32); } }
            const int col = 128 * vx + 16 * l8 + ((F.lane & 8) ? 8 : 0) + ((F.lane & 16) ? 4 : 0) + ((F.lane & 32) ? 2 : 0);
            GAS f32x2* op = (GAS f32x2*)(out + (size_t)t * D + col);
            f32x2 o = *op; o[0] += r2v[0]; o[1] += r2v[1]; *op = o;
        }
    }
#undef IN
#undef BOTH
#undef GRID_BAR
}

extern "C" void kernel_launch(void* const* d_in, const int* in_sizes, int n_in, void* d_out, int out_size, void* d_ws, size_t ws_size, hipStream_t stream) {
    static int grid = 0;
    if (grid == 0) {
        if (n_in != 14 || in_sizes[0] != T * D || out_size != T * D || ws_size < WS_END) { fprintf(stderr, "kernel_launch: built for 14 inputs, x and out of %d floats, >= %zu bytes of workspace; got n_in %d, in0 %d, out %d, ws %zu; nothing launched\n", T * D, (size_t)WS_END, n_in, n_in > 0 ? in_sizes[0] : -1, out_size, ws_size); grid = -1; return; }
        int dev = 0, cus = 0, per_cu = 0;
        if (hipGetDevice(&dev) != hipSuccess || hipDeviceGetAttribute(&cus, hipDeviceAttributeMultiprocessorCount, dev) != hipSuccess) { fprintf(stderr, "kernel_launch: hipGetDevice / hipDeviceGetAttribute failed\n"); grid = -1; return; }
        if (hipFuncSetAttribute((const void*)fwd_kernel, hipFuncAttributeMaxDynamicSharedMemorySize, LDS_BYTES) != hipSuccess) { fprintf(stderr, "kernel_launch: hipFuncSetAttribute failed\n"); grid = -1; return; }
        if (hipOccupancyMaxActiveBlocksPerMultiprocessor(&per_cu, (const void*)fwd_kernel, NWAVES * 64, LDS_BYTES) != hipSuccess || per_cu < 1)
            fprintf(stderr, "kernel_launch: note: occupancy query reports %d workgroups per CU\n", per_cu);
        (void)hipGetLastError();
        grid = cus;
    }
    if (grid < 0) return;
    if (hipMemsetAsync((char*)d_ws + WS_CTL, 0, CTL_ZERO_BYTES, stream) != hipSuccess) { fprintf(stderr, "kernel_launch: hipMemsetAsync failed\n"); return; }
    Args a{};
    for (int i = 0; i < 14; ++i) a.in[i] = (const float*)d_in[i];
    a.out = (float*)d_out; a.ws = (unsigned char*)d_ws;
    for (int li = 0; li < N_LAUNCHES; ++li) {
        a.ph_lo = (N_LAUNCHES == PER_PHASE) ? li : 0; a.ph_hi = (N_LAUNCHES == PER_PHASE) ? li + 1 : MK_LAST_PHASE; a.li = li;
        if (a.ph_lo >= MK_LAST_PHASE) break;
        hipLaunchKernelGGL(fwd_kernel, dim3(grid), dim3(NWAVES * 64), LDS_BYTES, stream, a);
        const hipError_t le = hipPeekAtLastError();
        if (le != hipSuccess) { fprintf(stderr, "kernel_launch: launch %d failed: %s\n", li, hipGetErrorName(le)); break; }
    }
}
```

```cpp
#include <hip/hip_runtime.h>
#include <cstdio>
#include <cstdint>
namespace pg8 {
#define PG8_LAS __attribute__((address_space(3)))
typedef unsigned short bf16_t;
typedef short bf16x8 __attribute__((ext_vector_type(8)));
typedef float f32x4 __attribute__((ext_vector_type(4)));
typedef unsigned u32x4 __attribute__((ext_vector_type(4)));
constexpr int BM = 256, BK = 64, HALF = 128, HTB = HALF * BK * 2  , STAGE_BYTES = 8 * HTB, NXCD = 8, WGM = 8;

__host__ __device__ __forceinline__ int lds_byte(int r, int c) { const int st = (r >> 4) * 2 + (c >> 5), rr = r & 15, cc = c & 31, ob = rr * 64 + cc * 2; return st * 1024 + (ob ^ (((ob >> 9) & 1) << 5)); }
__host__ __device__ __forceinline__ void stage_rc(int b, int& R, int& C) { const int st = b / 1024, sb = b % 1024, swz = sb ^ (((sb >> 9) & 1) << 5); R = (st >> 1) * 16 + swz / 64; C = (st & 1) * 32 + (swz % 64) / 2; }
__host__ __device__ __forceinline__ int perm32(int rho) { const int n = rho >> 4, i = rho & 15; return 8 * (i >> 2) + 4 * n + (i & 3); }

struct Unit { int pm, pn; };
struct Gemm { const bf16_t* A; const bf16_t* Bt; int M, N, K; };

struct StaticOrder {
    int nM, nN, nwg, G, c;
    __host__ __device__ void init(int M, int N, int G_, int c_) { nM = M / BM; nN = N / BM; nwg = nM * nN; G = G_; c = c_; }
    __host__ __device__ bool next(int i, Unit& u) const {
        const long L = (long)i * G + c; if (L >= nwg) return false;
        int wgid = (int)L; { const int q = nwg / NXCD, r = nwg % NXCD, xcd = wgid % NXCD, off = wgid / NXCD; wgid = (xcd < r ? xcd * (q + 1) : r * (q + 1) + (xcd - r) * q) + off; }
        const int nig = WGM * nN, gid = wgid / nig, fm = gid * WGM, gsz = (nM - fm) < WGM ? (nM - fm) : WGM;
        u.pm = fm + ((wgid % nig) % gsz); u.pn = (wgid % nig) / gsz; return true;
    }
    __device__ __forceinline__ void a_ready(const Unit&) const {}
    __device__ __forceinline__ void done(const Unit&) const {}
};


struct OneUnit {
    Unit u;
    __device__ __forceinline__ bool next(int i, Unit& o) const { if (i != 0) return false; o = u; return true; }
    __device__ __forceinline__ void a_ready(const Unit&) const {}
    __device__ __forceinline__ void done(const Unit&) const {}
};

typedef float f32x2 __attribute__((ext_vector_type(2)));
typedef __bf16 bf16x2_t __attribute__((ext_vector_type(2)));
typedef unsigned u32x2 __attribute__((ext_vector_type(2)));
__device__ __forceinline__ unsigned pkbf(float lo, float hi) { f32x2 v = {lo, hi}; bf16x2_t b = __builtin_convertvector(v, bf16x2_t); return __builtin_bit_cast(unsigned, b); }
__device__ __forceinline__ float bflo(unsigned w) { return __uint_as_float(w << 16); }
__device__ __forceinline__ float bfhi(unsigned w) { return __uint_as_float(w & 0xffff0000u); }
__device__ __forceinline__ u32x4 pack8(const f32x4 a, const f32x4 b) { u32x4 w; w.x = pkbf(a[0], a[1]); w.y = pkbf(a[2], a[3]); w.z = pkbf(b[0], b[1]); w.w = pkbf(b[2], b[3]); return w; }
constexpr float QSCALE = 0.125f * 1.4426950408889634f;
__device__ __forceinline__ float sigmoidf_(float v) { return __builtin_amdgcn_rcpf(1.0f + __builtin_amdgcn_exp2f(-1.4426950408889634f * v)); }

struct Epi1 {
    static constexpr bool PERM = true, AFTER_DRAIN = false, HAS_MID = false; static constexpr int MID_T = -1;
    const float* rinv; const float* bgate; const float* qg; const float* kg;
    bf16_t *QS, *KS, *VS, *QD, *KD, *VD, *GT;
    __device__ __forceinline__ void mid(f32x4 (&)[2][2][4][2], const Unit&, int, int, int, int) const {}
    __device__ __forceinline__ void operator()(const f32x4 (&acc)[2][2][4][2], const Unit& u, int wr, int wc, int fr, int fq) const {
        asm volatile("" : "+v"(fr), "+v"(fq));
        const int pn = u.pn; const int row0 = u.pm * BM + wr * 64 + fr;
        if (pn >= 6 && pn < 12) {
            const bool isK = pn >= 9; const int head = (isK ? pn - 9 : pn - 6) * 4 + wc;
            const float* g = (isK ? kg : qg) + head * 64 + 8 * fq;
            f32x4 gv[2][2]; const float qsc = isK ? 1.0f : QSCALE;
#pragma unroll
            for (int bj = 0; bj < 2; ++bj)
#pragma unroll
                for (int n = 0; n < 2; ++n) gv[bj][n] = *(const f32x4*)(g + 32 * bj + 4 * n) * qsc;
            bf16_t* base = (isK ? KD : QD) + head * 64 + 8 * fq;
#pragma unroll
            for (int ai = 0; ai < 2; ++ai)
#pragma unroll
                for (int m = 0; m < 4; ++m) { const int row = row0 + ai * HALF + m * 16; const float r = rinv[row];
                    f32x4 v[2][2]; float ss = 0.f;
#pragma unroll
                    for (int bj = 0; bj < 2; ++bj)
#pragma unroll
                        for (int n = 0; n < 2; ++n) { v[bj][n] = acc[ai][bj][m][n] * r; const f32x4 q = v[bj][n] * v[bj][n]; ss += (q[0] + q[1]) + (q[2] + q[3]); }
                    ss += __shfl_xor(ss, 16); ss += __shfl_xor(ss, 32);
                    const float sc = __builtin_amdgcn_rsqf(ss * (1.0f / 64.0f) + 1e-6f);
#pragma unroll
                    for (int bj = 0; bj < 2; ++bj) *(u32x4*)(base + (size_t)row * 768 + 32 * bj) = pack8(v[bj][0] * sc * gv[bj][0], v[bj][1] * sc * gv[bj][1]);
                }
        } else if (pn < 15) {
            bf16_t* base; int ld, colt;
            if (pn < 2) { base = QS; ld = 512; colt = pn * 256; } else if (pn < 4) { base = KS; ld = 512; colt = (pn - 2) * 256; } else if (pn < 6) { base = VS; ld = 512; colt = (pn - 4) * 256; } else { base = VD; ld = 768; colt = (pn - 12) * 256; }
            base += colt + wc * 32 + 8 * fq;
#pragma unroll
            for (int ai = 0; ai < 2; ++ai)
#pragma unroll
                for (int m = 0; m < 4; ++m) { const int row = row0 + ai * HALF + m * 16; const float r = rinv[row] * (pn < 2 ? QSCALE : 1.0f);
#pragma unroll
                    for (int bj = 0; bj < 2; ++bj) *(u32x4*)(base + (size_t)row * ld + bj * HALF) = pack8(acc[ai][bj][m][0] * r, acc[ai][bj][m][1] * r);
                }
        } else {
            const int col0 = (pn - 15) * 256 + wc * 32 + 8 * fq;
            f32x4 bv[2][2];
#pragma unroll
            for (int bj = 0; bj < 2; ++bj)
#pragma unroll
                for (int n = 0; n < 2; ++n) bv[bj][n] = *(const f32x4*)(bgate + col0 + bj * HALF + 4 * n);
#pragma unroll
            for (int ai = 0; ai < 2; ++ai)
#pragma unroll
                for (int m = 0; m < 4; ++m) { const int row = row0 + ai * HALF + m * 16; const float r = rinv[row];
#pragma unroll
                    for (int bj = 0; bj < 2; ++bj) { f32x4 a = acc[ai][bj][m][0] * r + bv[bj][0], b = acc[ai][bj][m][1] * r + bv[bj][1];
#pragma unroll
                        for (int e = 0; e < 4; ++e) { a[e] = sigmoidf_(a[e]); b[e] = sigmoidf_(b[e]); }
                        *(u32x4*)(GT + (size_t)row * 2048 + col0 + bj * HALF) = pack8(a, b); }
                }
        }
    }
};

struct Epi2 {
    static constexpr bool PERM = true, AFTER_DRAIN = false, HAS_MID = true; static constexpr int MID_T = 8;
    const bf16_t* GT; bf16_t* MIX;
    __device__ __forceinline__ void mid(f32x4 (&acc)[2][2][4][2], const Unit& u, int wr, int wc, int fr, int fq) const {
        asm volatile("" : "+v"(fr), "+v"(fq));
        const int row0 = u.pm * BM + wr * 64 + fr, col0 = u.pn * BM + wc * 32 + 8 * fq;
#pragma unroll
        for (int ai = 0; ai < 2; ++ai)
#pragma unroll
            for (int m = 0; m < 4; ++m) { const bf16_t* gp = GT + (size_t)(row0 + ai * HALF + m * 16) * 2048 + col0;
#pragma unroll
                for (int bj = 0; bj < 2; ++bj) { const u32x4 a = *(const u32x4*)(gp + bj * HALF), b = *(const u32x4*)(gp + 1024 + bj * HALF);
                    f32x4 r0, r1;
                    r0[0] = bflo(a.x) * __builtin_amdgcn_rcpf(fmaxf(bflo(b.x), 1e-30f)); r0[1] = bfhi(a.x) * __builtin_amdgcn_rcpf(fmaxf(bfhi(b.x), 1e-30f));
                    r0[2] = bflo(a.y) * __builtin_amdgcn_rcpf(fmaxf(bflo(b.y), 1e-30f)); r0[3] = bfhi(a.y) * __builtin_amdgcn_rcpf(fmaxf(bfhi(b.y), 1e-30f));
                    r1[0] = bflo(a.z) * __builtin_amdgcn_rcpf(fmaxf(bflo(b.z), 1e-30f)); r1[1] = bfhi(a.z) * __builtin_amdgcn_rcpf(fmaxf(bfhi(b.z), 1e-30f));
                    r1[2] = bflo(a.w) * __builtin_amdgcn_rcpf(fmaxf(bflo(b.w), 1e-30f)); r1[3] = bfhi(a.w) * __builtin_amdgcn_rcpf(fmaxf(bfhi(b.w), 1e-30f));
                    acc[ai][bj][m][0] *= r0; acc[ai][bj][m][1] *= r1; }
                asm volatile("" ::: "memory");
            }
    }
    __device__ __forceinline__ void operator()(const f32x4 (&acc)[2][2][4][2], const Unit& u, int wr, int wc, int fr, int fq) const {
        asm volatile("" : "+v"(fr), "+v"(fq));
        const int row0 = u.pm * BM + wr * 64 + fr, col0 = u.pn * BM + wc * 32 + 8 * fq;
#pragma unroll
        for (int ai = 0; ai < 2; ++ai)
#pragma unroll
            for (int m = 0; m < 4; ++m) { const int row = row0 + ai * HALF + m * 16; const bf16_t* gp = GT + (size_t)row * 2048 + 1024 + col0;
#pragma unroll
                for (int bj = 0; bj < 2; ++bj) { const u32x4 b = *(const u32x4*)(gp + bj * HALF);
                    f32x4 g0, g1;
                    g0[0] = fmaxf(bflo(b.x), 1e-30f); g0[1] = fmaxf(bfhi(b.x), 1e-30f); g0[2] = fmaxf(bflo(b.y), 1e-30f); g0[3] = fmaxf(bfhi(b.y), 1e-30f);
                    g1[0] = fmaxf(bflo(b.z), 1e-30f); g1[1] = fmaxf(bfhi(b.z), 1e-30f); g1[2] = fmaxf(bflo(b.w), 1e-30f); g1[3] = fmaxf(bfhi(b.w), 1e-30f);
                    *(u32x4*)(MIX + (size_t)row * 1024 + col0 + bj * HALF) = pack8(acc[ai][bj][m][0] * g0, acc[ai][bj][m][1] * g1); }
                asm volatile("" ::: "memory");
            }
    }
};

struct Epi3 {
    static constexpr bool PERM = true, AFTER_DRAIN = false, HAS_MID = false; static constexpr int MID_T = -1;
    const float* x; bf16_t* x1b; float* ssq;
    __device__ __forceinline__ void mid(f32x4 (&)[2][2][4][2], const Unit&, int, int, int, int) const {}
    __device__ __forceinline__ void operator()(const f32x4 (&acc)[2][2][4][2], const Unit& u, int wr, int wc, int fr, int fq) const {
        asm volatile("" : "+v"(fr), "+v"(fq));
        const int row0 = u.pm * BM + wr * 64 + fr, col0 = u.pn * BM + wc * 32 + 8 * fq;
#pragma unroll
        for (int ai = 0; ai < 2; ++ai)
#pragma unroll
            for (int m = 0; m < 4; ++m) { const int row = row0 + ai * HALF + m * 16; const size_t off = (size_t)row * 1024 + col0; float ss = 0.f;
#pragma unroll
                for (int bj = 0; bj < 2; ++bj) { const f32x4 v0 = acc[ai][bj][m][0] + *(const f32x4*)(x + off + bj * HALF), v1 = acc[ai][bj][m][1] + *(const f32x4*)(x + off + bj * HALF + 4);
                    *(u32x4*)(x1b + off + bj * HALF) = pack8(v0, v1);
                    const f32x4 q0 = v0 * v0, q1 = v1 * v1; ss += ((q0[0] + q0[1]) + (q0[2] + q0[3])) + ((q1[0] + q1[1]) + (q1[2] + q1[3])); }
                ss += __shfl_xor(ss, 16); ss += __shfl_xor(ss, 32);
                if (fq == 0) ssq[(size_t)row * 16 + u.pn * 4 + wc] = ss;
            }
    }
};

__device__ __forceinline__ unsigned f2key(float v) { const unsigned u = __float_as_uint(v); return (u & 0x80000000u) ? ~u : (u | 0x80000000u); }
__device__ __forceinline__ float key2f(unsigned k) { return __uint_as_float((k & 0x80000000u) ? (k & 0x7fffffffu) : ~k); }
struct Epi4 {
    static constexpr bool PERM = false, AFTER_DRAIN = true, HAS_MID = false; static constexpr int MID_T = -1;
    const float* ssq; float* rinv2; unsigned short* ids; float* gw;
    __device__ __forceinline__ void mid(f32x4 (&)[2][2][4][2], const Unit&, int, int, int, int) const {}
    __device__ __forceinline__ void fused(f32x4 (&acc)[2][2][4][2], const Unit& u, int wr, int wc, int fr, int fq, PG8_LAS unsigned char* lds, int wid, int lane) const {
        asm volatile("" : "+v"(fr), "+v"(fq));
        const int tid = wid * 64 + lane;
        PG8_LAS unsigned char* ixs = lds + 135168;
#pragma unroll
        for (int pass = 0; pass < 2; ++pass) {
#pragma unroll
            for (int m = 0; m < 4; ++m)
#pragma unroll
                for (int bj = 0; bj < 2; ++bj)
#pragma unroll
                    for (int n = 0; n < 2; ++n) *(PG8_LAS f32x4*)(lds + (size_t)(wr * 64 + m * 16 + fr) * 1056 + bj * 528 + (wc * 32 + n * 16 + fq * 4) * 4) = acc[pass][bj][m][n];
            asm volatile("s_waitcnt lgkmcnt(0)" ::: "memory"); __builtin_amdgcn_s_barrier(); asm volatile("" ::: "memory");
            if (tid < 256) {
                const int rl = tid >> 1, p = tid & 1; const int row = u.pm * BM + pass * HALF + rl;
                unsigned L[16];
#pragma unroll
                for (int i = 0; i < 16; ++i) L[i] = 0u;
                const PG8_LAS unsigned char* sp = lds + (size_t)rl * 1056 + p * 528;
#pragma unroll 2
                for (int c = 0; c < 32; ++c) { const f32x4 v = *(const PG8_LAS f32x4*)(sp + c * 16);
#pragma unroll
                    for (int e = 0; e < 4; ++e) { unsigned xk = (f2key(v[e]) & ~127u) | (unsigned)(127 - (4 * c + e));
#pragma unroll
                        for (int i = 0; i < 16; ++i) { const unsigned hi_ = L[i] > xk ? L[i] : xk; xk = L[i] > xk ? xk : L[i]; L[i] = hi_; } }
                }
                unsigned O[16];
#pragma unroll
                for (int i = 0; i < 16; ++i) O[i] = (unsigned)__shfl_xor((int)L[i], 1);
                { u32x4 w;
                  w.x = (127u - (L[0] & 127u)) | ((127u - (L[1] & 127u)) << 8) | ((127u - (L[2] & 127u)) << 16) | ((127u - (L[3] & 127u)) << 24);
                  w.y = (127u - (L[4] & 127u)) | ((127u - (L[5] & 127u)) << 8) | ((127u - (L[6] & 127u)) << 16) | ((127u - (L[7] & 127u)) << 24);
                  w.z = (127u - (L[8] & 127u)) | ((127u - (L[9] & 127u)) << 8) | ((127u - (L[10] & 127u)) << 16) | ((127u - (L[11] & 127u)) << 24);
                  w.w = (127u - (L[12] & 127u)) | ((127u - (L[13] & 127u)) << 8) | ((127u - (L[14] & 127u)) << 16) | ((127u - (L[15] & 127u)) << 24);
                  *(PG8_LAS u32x4*)(ixs + tid * 16) = w; }
                float fa[16], fb[16];
#pragma unroll
                for (int i = 0; i < 16; ++i) { const float mine = key2f(L[i] & ~127u), oth = key2f(O[i] & ~127u); fa[i] = p ? oth : mine; fb[i] = p ? mine : oth; }
                unsigned C[16];
#pragma unroll
                for (int i = 0; i < 16; ++i) C[i] = 0u;
#pragma unroll
                for (int i = 0; i < 16; ++i)
#pragma unroll
                    for (int j = 0; j < 16; ++j) if ((i + 1) * (j + 1) <= 16) { unsigned xk = (f2key(fa[i] + fb[j]) & ~255u) | (unsigned)(255 - (i * 16 + j));
#pragma unroll
                        for (int q = 0; q < 16; ++q) { const unsigned hi_ = C[q] > xk ? C[q] : xk; xk = C[q] > xk ? xk : C[q]; C[q] = hi_; } }
                asm volatile("s_waitcnt lgkmcnt(0)" ::: "memory");
                float sq = 0.f;
#pragma unroll
                for (int i = 0; i < 4; ++i) { const f32x4 t = *(const f32x4*)(ssq + (size_t)row * 16 + 4 * i); sq += (t[0] + t[1]) + (t[2] + t[3]); }
                const float r2 = __builtin_amdgcn_rsqf(sq * (1.0f / 1024.0f) + 1e-6f);
                if (u.pn == 0 && p == 0) rinv2[row] = r2;
                const float b0 = key2f(C[0] & ~255u); float wsum = 0.f; float wv[16];
#pragma unroll
                for (int q = 0; q < 16; ++q) { wv[q] = __builtin_amdgcn_exp2f((key2f(C[q] & ~255u) - b0) * r2 * 1.4426950408889634f); wsum += wv[q]; }
                const float inv = 1.0f / wsum;
                const PG8_LAS unsigned char* ia = ixs + (tid & ~1) * 16; const PG8_LAS unsigned char* ib = ia + 16;
                unsigned short eo[8]; float go[8];
#pragma unroll
                for (int q = 0; q < 8; ++q) { unsigned c_lo = C[q], c_hi = C[q + 8]; float w_lo = wv[q], w_hi = wv[q + 8]; asm volatile("" : "+v"(c_lo), "+v"(c_hi), "+v"(w_lo), "+v"(w_hi));
                    const unsigned ck = p ? c_hi : c_lo; const unsigned code = 255u - (ck & 255u);
                    const unsigned i1 = ia[code >> 4], i2 = ib[code & 15u]; eo[q] = (unsigned short)(i1 * 128u + i2); go[q] = (p ? w_hi : w_lo) * inv; }
                const size_t ob = ((size_t)row * 8 + u.pn) * 16 + p * 8;
                { u32x4 w; w.x = eo[0] | ((unsigned)eo[1] << 16); w.y = eo[2] | ((unsigned)eo[3] << 16); w.z = eo[4] | ((unsigned)eo[5] << 16); w.w = eo[6] | ((unsigned)eo[7] << 16); *(u32x4*)(ids + ob) = w; }
                *(f32x4*)(gw + ob) = (f32x4){go[0], go[1], go[2], go[3]}; *(f32x4*)(gw + ob + 4) = (f32x4){go[4], go[5], go[6], go[7]};
            }
            asm volatile("s_waitcnt lgkmcnt(0)" ::: "memory"); __builtin_amdgcn_s_barrier(); asm volatile("" ::: "memory");
        }
    }
};
template <class Epi, class Sched, bool ALIGN_EPI = false, bool SP2 = false>
__device__ __forceinline__ void gemm_phase(PG8_LAS unsigned char* lds, const Gemm g, const Sched& S, const Epi& E) {
    const int tid = threadIdx.x, wid = __builtin_amdgcn_readfirstlane(tid >> 6), lane = tid & 63, wr = wid >> 2, wc = wid & 3, fr = lane & 15, fq = lane >> 4;
    const int K = g.K, nt = K / BK;
    unsigned voffA[2], voffB[2];
#pragma unroll
    for (int i = 0; i < 2; ++i) { int R, C; stage_rc(tid * 16 + i * 8192, R, C); const int Rb = Epi::PERM ? ((R & ~31) + perm32(R & 31)) : R;
        voffA[i] = (unsigned)(R * K + C) * 2u; voffB[i] = (unsigned)(Rb * K + C) * 2u; }
    const size_t kstep = (size_t)(BK * 2);
    const size_t hstep = (size_t)HALF * K * 2;
    const size_t tstep = 2 * hstep;
    const unsigned ldsw = (unsigned)wid * 1024u;
    const int aoff = lds_byte(wr * 64 + fr, fq * 8), boff = lds_byte(wc * 32 + fr, fq * 8);
#define PG8_SA(b, h) (((b) * 2 + (h)) * HTB)
#define PG8_SB(b, h) ((4 + (b) * 2 + (h)) * HTB)
#define PG8_STAGE(bufoff, gbase, voff) do { _Pragma("unroll") for (int _i = 0; _i < 2; ++_i) \
        __builtin_amdgcn_global_load_lds((const unsigned*)((const char*)(gbase) + (voff)[_i]), (PG8_LAS unsigned*)(lds + (bufoff) + ldsw + _i * 8192), 16, 0, 0); } while (0)
#define PG8_LDA(dst, b, h) do { _Pragma("unroll") for (int m = 0; m < 4; ++m) _Pragma("unroll") for (int k = 0; k < 2; ++k) dst[m][k] = *(const PG8_LAS bf16x8*)(lds + PG8_SA(b, h) + aoff + m * 2048 + k * 1024); } while (0)
#define PG8_LDB(dst, b, h) do { _Pragma("unroll") for (int n = 0; n < 2; ++n) _Pragma("unroll") for (int k = 0; k < 2; ++k) dst[n][k] = *(const PG8_LAS bf16x8*)(lds + PG8_SB(b, h) + boff + n * 2048 + k * 1024); } while (0)
#define PG8_MMA(ai, bj, At, Bt) do { __builtin_amdgcn_s_setprio(1); _Pragma("unroll") for (int m = 0; m < 4; ++m) _Pragma("unroll") for (int n = 0; n < 2; ++n) _Pragma("unroll") for (int k = 0; k < 2; ++k) \
        acc[ai][bj][m][n] = __builtin_amdgcn_mfma_f32_16x16x32_bf16(Bt[n][k], At[m][k], acc[ai][bj][m][n], 0, 0, 0); __builtin_amdgcn_s_setprio(0); } while (0)
#define PG8_WAIT_V(n) asm volatile("s_waitcnt vmcnt(" #n ")" ::: "memory")
#define PG8_WAIT_L(n) asm volatile("s_waitcnt lgkmcnt(" #n ")" ::: "memory")
#define PG8_BAR __builtin_amdgcn_s_barrier()
#define PG8_SCHED __builtin_amdgcn_sched_barrier(0)
    Unit cur, nxt; int ui = 0;
    if (!S.next(0, cur)) return;
    f32x4 acc[2][2][4][2];
#pragma unroll
    for (int a = 0; a < 2; ++a)
#pragma unroll
        for (int b = 0; b < 2; ++b)
#pragma unroll
            for (int m = 0; m < 4; ++m)
#pragma unroll
                for (int n = 0; n < 2; ++n) acc[a][b][m][n] = (f32x4){0.f, 0.f, 0.f, 0.f};
    bf16x8 At[4][2], B0[2][2], B1[2][2];
    const char* cA = (const char*)g.A + (size_t)cur.pm * tstep; const char* cB = (const char*)g.Bt + (size_t)cur.pn * tstep;
    S.a_ready(cur);
    if constexpr (SP2) {
        PG8_STAGE(PG8_SB(0, 0), cB, voffB); PG8_STAGE(PG8_SB(0, 1), cB + hstep, voffB); PG8_STAGE(PG8_SA(0, 0), cA, voffA); PG8_STAGE(PG8_SA(0, 1), cA + hstep, voffA);
        if (wr == 1) PG8_BAR;
        PG8_WAIT_V(2); PG8_BAR;
        PG8_STAGE(PG8_SB(1, 0), cB + kstep, voffB); PG8_STAGE(PG8_SA(1, 0), cA + kstep, voffA); PG8_STAGE(PG8_SB(1, 1), cB + hstep + kstep, voffB);
        PG8_WAIT_V(6); PG8_BAR;
    } else {
        PG8_STAGE(PG8_SB(0, 0), cB, voffB); PG8_STAGE(PG8_SA(0, 0), cA, voffA); PG8_STAGE(PG8_SB(0, 1), cB + hstep, voffB); PG8_STAGE(PG8_SA(0, 1), cA + hstep, voffA);
        if (wr == 1) PG8_BAR;
        PG8_WAIT_V(4); PG8_BAR;
        PG8_STAGE(PG8_SB(1, 0), cB + kstep, voffB); PG8_STAGE(PG8_SA(1, 0), cA + kstep, voffA); PG8_STAGE(PG8_SB(1, 1), cB + hstep + kstep, voffB);
        PG8_WAIT_V(6); PG8_BAR;
    }
    for (;;) {
        const bool has_next = S.next(ui + 1, nxt);
        const char* nA = has_next ? (const char*)g.A + (size_t)nxt.pm * tstep : cA; const char* nB = has_next ? (const char*)g.Bt + (size_t)nxt.pn * tstep : cB;
        for (int t = 0; t < nt; t += 2) {
            if constexpr (Epi::HAS_MID) { if (t == Epi::MID_T) E.mid(acc, cur, wr, wc, fr, fq); }
            const bool last = (t == nt - 2);
            const char* a1 = cA + (size_t)(t + 1) * kstep;
            const char* a2 = last ? nA : cA + (size_t)(t + 2) * kstep; const char* b2 = last ? nB : cB + (size_t)(t + 2) * kstep;
            const char* a3 = a2 + kstep; const char* b3 = b2 + kstep;
            if (last && has_next) S.a_ready(nxt);
            if constexpr (SP2) {
            PG8_LDB(B0, 0, 0); PG8_LDB(B1, 0, 1); PG8_SCHED; PG8_LDA(At, 0, 0); PG8_STAGE(PG8_SA(1, 1), a1 + hstep, voffA);
            PG8_WAIT_V(8); PG8_WAIT_L(0); PG8_BAR; PG8_MMA(0, 0, At, B0); PG8_MMA(0, 1, At, B1); PG8_BAR; PG8_SCHED;
            PG8_LDA(At, 0, 1); PG8_STAGE(PG8_SB(0, 0), b2, voffB); PG8_STAGE(PG8_SB(0, 1), b2 + hstep, voffB); PG8_STAGE(PG8_SA(0, 0), a2, voffA);
            PG8_WAIT_V(8); PG8_WAIT_L(0); PG8_BAR; PG8_MMA(1, 0, At, B0); PG8_MMA(1, 1, At, B1); PG8_BAR; PG8_SCHED;
            PG8_LDB(B0, 1, 0); PG8_LDB(B1, 1, 1); PG8_SCHED; PG8_LDA(At, 1, 0); PG8_STAGE(PG8_SA(0, 1), a2 + hstep, voffA);
            PG8_WAIT_V(8); PG8_WAIT_L(0); PG8_BAR; PG8_MMA(0, 0, At, B0); PG8_MMA(0, 1, At, B1); PG8_BAR; PG8_SCHED;
            PG8_LDA(At, 1, 1); PG8_STAGE(PG8_SB(1, 0), b3, voffB); PG8_STAGE(PG8_SB(1, 1), b3 + hstep, voffB); PG8_STAGE(PG8_SA(1, 0), a3, voffA);
            PG8_WAIT_V(8); PG8_WAIT_L(0); PG8_BAR; PG8_MMA(1, 0, At, B0); PG8_MMA(1, 1, At, B1); PG8_BAR; PG8_SCHED;
            } else {
            PG8_LDB(B0, 0, 0); PG8_SCHED; PG8_LDA(At, 0, 0); PG8_STAGE(PG8_SA(1, 1), a1 + hstep, voffA);
            PG8_WAIT_L(8); PG8_BAR; PG8_WAIT_L(0); PG8_MMA(0, 0, At, B0); PG8_BAR; PG8_SCHED;
            PG8_LDB(B1, 0, 1); PG8_STAGE(PG8_SB(0, 0), b2, voffB);
            PG8_BAR; PG8_WAIT_L(0); PG8_MMA(0, 1, At, B1); PG8_BAR;
            PG8_LDA(At, 0, 1); PG8_STAGE(PG8_SA(0, 0), a2, voffA);
            PG8_BAR; PG8_WAIT_L(0); PG8_MMA(1, 0, At, B0); PG8_BAR; PG8_SCHED;
            PG8_STAGE(PG8_SB(0, 1), b2 + hstep, voffB);
            PG8_WAIT_V(6); PG8_BAR; PG8_MMA(1, 1, At, B1); PG8_BAR;
            PG8_LDB(B0, 1, 0); PG8_SCHED; PG8_LDA(At, 1, 0); PG8_STAGE(PG8_SA(0, 1), a2 + hstep, voffA);
            PG8_WAIT_L(8); PG8_BAR; PG8_WAIT_L(0); PG8_MMA(0, 0, At, B0); PG8_BAR; PG8_SCHED;
            PG8_LDB(B1, 1, 1); PG8_STAGE(PG8_SB(1, 0), b3, voffB);
            PG8_BAR; PG8_WAIT_L(0); PG8_MMA(0, 1, At, B1); PG8_BAR;
            PG8_LDA(At, 1, 1); PG8_STAGE(PG8_SA(1, 0), a3, voffA);
            PG8_BAR; PG8_WAIT_L(0); PG8_MMA(1, 0, At, B0); PG8_BAR; PG8_SCHED;
            PG8_STAGE(PG8_SB(1, 1), b3 + hstep, voffB);
            PG8_WAIT_V(6); PG8_BAR; PG8_MMA(1, 1, At, B1); PG8_BAR;
            }
        }
        if constexpr (ALIGN_EPI) { if (wr == 0) PG8_BAR; }
        if constexpr (!Epi::AFTER_DRAIN) { E(acc, cur, wr, wc, fr, fq); S.done(cur); }
        if (!has_next) break;
#pragma unroll
        for (int a = 0; a < 2; ++a)
#pragma unroll
            for (int b = 0; b < 2; ++b)
#pragma unroll
                for (int m = 0; m < 4; ++m)
#pragma unroll
                    for (int n = 0; n < 2; ++n) acc[a][b][m][n] = (f32x4){0.f, 0.f, 0.f, 0.f};
        cur = nxt; cA = nA; cB = nB; ++ui;
        if constexpr (ALIGN_EPI) { if (wr == 1) PG8_BAR; }
    }
    PG8_WAIT_V(0);
    if constexpr (!ALIGN_EPI) { if (wr == 0) PG8_BAR; }
    PG8_BAR;
    if constexpr (Epi::AFTER_DRAIN) { E.fused(acc, cur, wr, wc, fr, fq, lds, wid, lane); S.done(cur); }
#undef PG8_SA
#undef PG8_SB
#undef PG8_STAGE
#undef PG8_LDA
#undef PG8_LDB
#undef PG8_MMA
#undef PG8_WAIT_V
#undef PG8_WAIT_L
#undef PG8_BAR
#undef PG8_SCHED
}
}


namespace att {
#define ALAS __attribute__((address_space(3)))
typedef unsigned short bf16;
typedef short bf16x8 __attribute__((ext_vector_type(8)));
typedef short s16x4 __attribute__((ext_vector_type(4)));
typedef float f32x16 __attribute__((ext_vector_type(16)));
typedef float f32x4 __attribute__((ext_vector_type(4)));
typedef float f32x2 __attribute__((ext_vector_type(2)));
typedef unsigned u32x4 __attribute__((ext_vector_type(4)));
typedef __bf16 bf16x2_t __attribute__((ext_vector_type(2)));
constexpr int SEQ = 4096;
constexpr int VPITCH = 144;
constexpr float LOG2E = 1.4426950408889634f, LN2 = 0.6931471805599453f;
__device__ __forceinline__ unsigned pkbf(float lo, float hi) { f32x2 v = {lo, hi}; bf16x2_t b = __builtin_convertvector(v, bf16x2_t); return __builtin_bit_cast(unsigned, b); }
__device__ __forceinline__ void wave_lds_sync() { asm volatile("s_waitcnt lgkmcnt(0)" ::: "memory"); }
__device__ __forceinline__ s16x4 vtr(const ALAS unsigned char* p) { return __builtin_bit_cast(s16x4, __builtin_amdgcn_ds_read_tr16_b64_v4i16((ALAS s16x4*)p)); }
__device__ __forceinline__ int crow(int r, int hi) { return (r & 3) + 8 * (r >> 2) + 4 * hi; }

__device__ __forceinline__ void pv_tile(f32x16& o0, f32x16& o1, const float (&a)[16], const ALAS unsigned char* vt, int lane) {
    const int g = lane >> 4, i = lane & 15, q_ = i >> 2, p_ = i & 3, h = lane >> 5;
    const ALAS unsigned char* vb = vt + (8 * h + q_) * VPITCH + (16 * (g & 1) + 4 * p_) * 2;
    u32x4 pw0, pw1;
    pw0.x = pkbf(a[0], a[1]); pw0.y = pkbf(a[2], a[3]); pw0.z = pkbf(a[4], a[5]); pw0.w = pkbf(a[6], a[7]);
    pw1.x = pkbf(a[8], a[9]); pw1.y = pkbf(a[10], a[11]); pw1.z = pkbf(a[12], a[13]); pw1.w = pkbf(a[14], a[15]);
    const bf16x8 pa0 = __builtin_bit_cast(bf16x8, pw0), pa1 = __builtin_bit_cast(bf16x8, pw1);
#pragma unroll
    for (int s = 0; s < 2; ++s) {
        const s16x4 l0 = vtr(vb + (16 * s) * VPITCH), h0 = vtr(vb + (16 * s + 4) * VPITCH);
        const s16x4 l1 = vtr(vb + (16 * s) * VPITCH + 64), h1 = vtr(vb + (16 * s + 4) * VPITCH + 64);
        const bf16x8 v0 = (bf16x8){l0[0], l0[1], l0[2], l0[3], h0[0], h0[1], h0[2], h0[3]};
        const bf16x8 v1 = (bf16x8){l1[0], l1[1], l1[2], l1[3], h1[0], h1[1], h1[2], h1[3]};
        o0 = __builtin_amdgcn_mfma_f32_32x32x16_bf16(s ? pa1 : pa0, v0, o0, 0, 0, 0);
        o1 = __builtin_amdgcn_mfma_f32_32x32x16_bf16(s ? pa1 : pa0, v1, o1, 0, 0, 0);
    }
}
__device__ __forceinline__ void bcast_rows(float v, ALAS float* sc, int r32, int hi, float (&out)[16]) {
    if (hi == 0) sc[r32] = v;
    wave_lds_sync();
#pragma unroll
    for (int g = 0; g < 4; ++g) { const f32x4 t = *(const ALAS f32x4*)(sc + 8 * g + 4 * hi); out[4 * g] = t[0]; out[4 * g + 1] = t[1]; out[4 * g + 2] = t[2]; out[4 * g + 3] = t[3]; }
    wave_lds_sync();
}
__device__ __forceinline__ void store_o(const f32x16& o0, const f32x16& o1, ALAS unsigned char* stg, bf16* dst  , size_t rstride_elems, int lane) {
    const int r32 = lane & 31, hi = lane >> 5;
    wave_lds_sync();
#pragma unroll
    for (int r = 0; r < 16; ++r) { const int q = crow(r, hi);
        *(ALAS unsigned short*)(stg + q * VPITCH + r32 * 2) = (unsigned short)(pkbf(o0[r], 0.f) & 0xffffu);
        *(ALAS unsigned short*)(stg + q * VPITCH + 64 + r32 * 2) = (unsigned short)(pkbf(o1[r], 0.f) & 0xffffu); }
    wave_lds_sync();
#pragma unroll
    for (int i = 0; i < 4; ++i) { const int row = 8 * i + (lane >> 3), ch = lane & 7; const u32x4 v = *(const ALAS u32x4*)(stg + row * VPITCH + ch * 16); *(u32x4*)(dst + (size_t)row * rstride_elems + ch * 8) = v; }
    wave_lds_sync();
}

__device__ __forceinline__ void sb_item(const bf16* QS, const bf16* KS, const bf16* VS, bf16* OC, int b, int h, int qt, ALAS unsigned char* wl, int lane) {
    const int r32 = lane & 31, hi = lane >> 5;
    const int t0 = qt * 32; const size_t rowb = (size_t)b * SEQ;
    const int kperm = (r32 & ~12) | ((r32 & 4) << 1) | ((r32 & 8) >> 1);
    bf16x8 qf[4];
    { const bf16* qp = QS + (rowb + t0 + r32) * 512 + h * 64 + hi * 8;
#pragma unroll
      for (int d0 = 0; d0 < 4; ++d0) qf[d0] = *(const bf16x8*)(qp + d0 * 16); }
    f32x16 o0 = {}, o1 = {}; float R = 0.f;
    for (int key0 = t0; key0 >= 0; key0 -= 32) {
        const bf16* kp = KS + (rowb + key0 + kperm) * 512 + h * 64 + hi * 8;
        bf16x8 kf[4];
#pragma unroll
        for (int d0 = 0; d0 < 4; ++d0) kf[d0] = *(const bf16x8*)(kp + d0 * 16);
        u32x4 vv[4];
#pragma unroll
        for (int i = 0; i < 4; ++i) vv[i] = *(const u32x4*)(VS + (rowb + key0 + 8 * i + (lane >> 3)) * 512 + h * 64 + (lane & 7) * 8);
        f32x16 p = {};
#pragma unroll
        for (int d0 = 0; d0 < 4; ++d0) p = __builtin_amdgcn_mfma_f32_32x32x16_bf16(kf[d0], qf[d0], p, 0, 0, 0);
#pragma unroll
        for (int i = 0; i < 4; ++i) *(ALAS u32x4*)(wl + (8 * i + (lane >> 3)) * VPITCH + (lane & 7) * 16) = vv[i];
        const bool diag = (key0 == t0);
        float z2[16], L2[16];
#pragma unroll
        for (int r = 0; r < 16; ++r) { const int kk = (r & 7) + 8 * hi + 16 * (r >> 3); const float zz = p[r];
            const float sp = fmaxf(zz, 0.f) + __builtin_amdgcn_logf(1.0f + __builtin_amdgcn_exp2f(-fabsf(zz)));
            const bool valid = !diag || (kk < r32); z2[r] = zz; L2[r] = valid ? sp : 0.f; }
        float c[16];
        c[15] = L2[15];
#pragma unroll
        for (int r = 14; r >= 8; --r) c[r] = c[r + 1] + L2[r];
        c[7] = L2[7];
#pragma unroll
        for (int r = 6; r >= 0; --r) c[r] = c[r + 1] + L2[r];
        const float TB = c[8], TA = c[0];
        const float TBo = __shfl_xor(TB, 32), TAo = __shfl_xor(TA, 32);
        const float offB = R + (hi ? 0.f : TBo);
        const float offA = R + TB + TBo + (hi ? 0.f : TAo);
        float a[16];
#pragma unroll
        for (int r = 0; r < 16; ++r) { const int kk = (r & 7) + 8 * hi + 16 * (r >> 3); const bool valid = !diag || (kk < r32);
            const float e = __builtin_amdgcn_exp2f(z2[r] - (c[r] + (r < 8 ? offA : offB))); a[r] = valid ? e : 0.f; }
        R += (TA + TB) + (TAo + TBo);
        wave_lds_sync();
        pv_tile(o0, o1, a, wl, lane);
        wave_lds_sync();
        if (__all(R > 40.0f * LOG2E)) break;
    }
    store_o(o0, o1, wl, OC + (rowb + t0) * 768 + h * 64, 768, lane);
}

__device__ __forceinline__ void dl_item(const bf16* QD, const bf16* KD, const bf16* VD, bf16* OC, int b, int j, int c, int mb, ALAS unsigned char* wl, int lane) {
    const int r32 = lane & 31, hi = lane >> 5;
    const size_t rowb = (size_t)b * SEQ;
    const int tq = c + 16 * (32 * mb + r32), tmax = c + 16 * (32 * mb + 31);
    const int kperm = (r32 & ~12) | ((r32 & 4) << 1) | ((r32 & 8) >> 1);
    ALAS float* sc = (ALAS float*)(wl + 8192);
    f32x16 o0 = {}, o1 = {}; float mrun = -3.0e38f, lrun = 0.f;
    for (int g = 0; g < 3; ++g) {
        const int hh = 4 * g + j, sh = 2 * g, r = 1 << sh;
        const float slope2 = __builtin_amdgcn_exp2f(-8.0f * (float)(hh + 1) / 12.0f) * LOG2E;
        bf16x8 qf[4];
        { const bf16* qp = QD + (rowb + tq) * 768 + hh * 64 + hi * 8;
#pragma unroll
          for (int d0 = 0; d0 < 4; ++d0) qf[d0] = *(const bf16x8*)(qp + d0 * 16); }
        const int nkeys = (496 >> sh) + 129, ntile = (nkeys + 31) >> 5;
        const int klo = (16 * (31 - r32)) >> sh; int khi = klo + 128; { const int kmaxtok = tmax >> sh; khi = khi < kmaxtok ? khi : kmaxtok; }
        const unsigned krange = (unsigned)(khi - klo);
        const float sr = slope2 * (float)r;
        for (int kt = 0; kt < ntile; ++kt) {
            int sk = tmax - r * (32 * kt + kperm); sk = sk < 0 ? 0 : sk;
            const bf16* kp = KD + (rowb + sk) * 768 + hh * 64 + hi * 8;
            bf16x8 kf[4];
#pragma unroll
            for (int d0 = 0; d0 < 4; ++d0) kf[d0] = *(const bf16x8*)(kp + d0 * 16);
            u32x4 vv[4];
#pragma unroll
            for (int i = 0; i < 4; ++i) { int sv = tmax - r * (32 * kt + 8 * i + (lane >> 3)); sv = sv < 0 ? 0 : sv; vv[i] = *(const u32x4*)(VD + (rowb + sv) * 768 + hh * 64 + (lane & 7) * 8); }
            const int dk = 32 * kt + 8 * hi - klo;
            const float tb = -sr * (float)dk;
            f32x16 p;
#pragma unroll
            for (int q = 0; q < 16; ++q) p[q] = tb - sr * (float)((q & 7) + 16 * (q >> 3));
#pragma unroll
            for (int d0 = 0; d0 < 4; ++d0) p = __builtin_amdgcn_mfma_f32_32x32x16_bf16(kf[d0], qf[d0], p, 0, 0, 0);
#pragma unroll
            for (int i = 0; i < 4; ++i) *(ALAS u32x4*)(wl + (8 * i + (lane >> 3)) * VPITCH + (lane & 7) * 16) = vv[i];
            float z2[16]; float mt = -3.0e38f;
#pragma unroll
            for (int q = 0; q < 16; ++q) { const bool valid = (unsigned)(dk + ((q & 7) + 16 * (q >> 3))) <= krange; z2[q] = valid ? p[q] : -INFINITY; mt = fmaxf(mt, z2[q]); }
            mt = fmaxf(mt, __shfl_xor(mt, 32));
            if (__any(mt > mrun + 8.0f)) {
                const float mnew = fmaxf(mrun, mt); const float alpha = __builtin_amdgcn_exp2f(mrun - mnew);
                lrun *= alpha; float al[16]; bcast_rows(alpha, sc, r32, hi, al);
#pragma unroll
                for (int q = 0; q < 16; ++q) { o0[q] *= al[q]; o1[q] *= al[q]; }
                mrun = mnew;
            }
            float a[16]; float ls = 0.f;
#pragma unroll
            for (int q = 0; q < 16; ++q) { a[q] = __builtin_amdgcn_exp2f(z2[q] - mrun); ls += a[q]; }
            lrun += ls;
            wave_lds_sync();
            pv_tile(o0, o1, a, wl, lane);
            wave_lds_sync();
        }
    }
    const float ltot = lrun + __shfl_xor(lrun, 32);
    float il[16]; bcast_rows(1.0f / ltot, sc, r32, hi, il);
#pragma unroll
    for (int q = 0; q < 16; ++q) { o0[q] *= il[q]; o1[q] *= il[q]; }
    store_o(o0, o1, wl, OC + (rowb + c + 16 * 32 * mb) * 768 + 512 + j * 64, (size_t)16 * 768, lane);
}
#undef ALAS
}

constexpr int NWAVES = 8;
#ifndef MK_N_LAUNCHES
#define MK_N_LAUNCHES 1
#endif
#ifndef MK_LAST_PHASE
#define MK_LAST_PHASE 8
#endif
constexpr int N_LAUNCHES = MK_N_LAUNCHES;
constexpr int PER_PHASE = 8;

constexpr int BATCH = 16, SEQ = 4096, D = 1024, T = BATCH * SEQ;
constexpr int N1 = 5888;
constexpr int NEXP = 16384;
constexpr size_t MiB = 1u << 20;
constexpr size_t WS_CTL = 0, CTL_ZERO_BYTES = 1 * MiB;
constexpr size_t WS_WIN = 2 * MiB;
constexpr size_t WS_WCAT = 16 * MiB;
constexpr size_t WS_WOUT = 18 * MiB;
constexpr size_t WS_WC = 20 * MiB;
constexpr size_t WS_RINV1 = 24 * MiB;
constexpr size_t WS_RINV2 = 25 * MiB;
constexpr size_t WS_USC = 25 * MiB + 512 * 1024, WS_VSC = 25 * MiB + 768 * 1024;
constexpr size_t WS_SSQ = 26 * MiB;
constexpr size_t WS_U8 = 32 * MiB;
constexpr size_t WS_V8 = 64 * MiB;
constexpr size_t WS_IDS = 96 * MiB;
constexpr size_t WS_GW = 112 * MiB;
constexpr size_t WS_XB = 144 * MiB;
constexpr size_t WS_QS = 272 * MiB, WS_KS = 336 * MiB, WS_VS = 400 * MiB;
constexpr size_t WS_QD = 464 * MiB, WS_KD = 560 * MiB, WS_VD = 656 * MiB;
constexpr size_t WS_GT = 752 * MiB;
constexpr size_t WS_COEF = 272 * MiB;
constexpr size_t WS_MIX = 272 * MiB;
constexpr size_t WS_X1B = 400 * MiB;
constexpr size_t WS_HQ = 528 * MiB;
constexpr size_t WS_HS2 = 24 * MiB + 512 * 1024;
constexpr size_t WS_END = 1008 * MiB;
constexpr int CW_BAR = 4096;
constexpr int CW_XRANK = 8192;

constexpr int RING_OFF = 0, RING_BYTES = 131072;
constexpr int LDSCTL_OFF = 143360, MISC_OFF = LDSCTL_OFF + 320;
constexpr int LDS_BYTES = 147456;
static_assert(MISC_OFF + 128 <= LDS_BYTES, "LDS map");
#define GAS __attribute__((address_space(1)))
#define LAS __attribute__((address_space(3)))
typedef unsigned short bf16;
typedef unsigned v4u __attribute__((ext_vector_type(4)));
typedef float f32x4 __attribute__((ext_vector_type(4)));
typedef short bf16x8 __attribute__((ext_vector_type(8)));
typedef GAS unsigned gu32;
typedef GAS unsigned long long gu64;
#define RLX_AGENT __ATOMIC_RELAXED, __HIP_MEMORY_SCOPE_AGENT
#define LDS_WAIT() asm volatile("s_waitcnt lgkmcnt(0)" ::: "memory")
#define VM_WAIT() asm volatile("s_waitcnt vmcnt(0)" ::: "memory")
__device__ __forceinline__ unsigned long long rt() { return __builtin_amdgcn_s_memrealtime(); }
__device__ __forceinline__ unsigned f2bf(float f) { unsigned u = __builtin_bit_cast(unsigned, f); return (u + 0x7fffu + ((u >> 16) & 1u)) >> 16; }
__device__ __forceinline__ unsigned pk2(float lo, float hi) { return f2bf(lo) | (f2bf(hi) << 16); }

#define XB_TMO      128
#define XB_XCNT(j)  (256  + 64 * (j))
#define XB_XSUB(j)  (1280 + 64 * (j))
#define XB_XGEN(j)  (2304 + 64 * (j))
#define XB_TOP      3328
#define XB_TOPGEN   3392
#define XCD_BAR_WORDS 3456
#define XB_SPIN_CAP (1u << 18)

__device__ __forceinline__ unsigned xb_ld(unsigned* p)              { return __hip_atomic_load(p, __ATOMIC_RELAXED, __HIP_MEMORY_SCOPE_AGENT); }
__device__ __forceinline__ unsigned xb_add(unsigned* p, unsigned v) { return __hip_atomic_fetch_add(p, v, __ATOMIC_RELAXED, __HIP_MEMORY_SCOPE_AGENT); }
__device__ __forceinline__ unsigned xb_xcc_id() { return (unsigned)__builtin_amdgcn_s_getreg((3 << 11) | 20) & 0xFu; }
#define XB_SPIN(cond, bar) do { unsigned _sp = 0; while (cond) { __builtin_amdgcn_s_sleep(1); \
    if ((++_sp & 255u) == 0u) { if (xb_ld(&(bar)[XB_TMO])) break; if (_sp > XB_SPIN_CAP) { atomicAdd(&(bar)[XB_TMO], 1u); break; } } } } while (0)

struct XcdBarrier {
    unsigned* bar; unsigned x;
    volatile LAS unsigned* st;
};

__device__ __forceinline__ XcdBarrier xcd_barrier_post(unsigned* bar, volatile LAS unsigned* st) {
    XcdBarrier b; b.bar = bar; b.x = xb_xcc_id(); b.st = st;
    if (threadIdx.x == 0) (void)xb_add(&bar[XB_XCNT(b.x)], 1u);
    return b;
}
__device__ __forceinline__ void xcd_barrier_complete(unsigned* bar, unsigned x, unsigned& nloc, unsigned& nx) {
    const unsigned G = gridDim.x * gridDim.y * gridDim.z;
    unsigned sum, cnt, mine, sp = 0u;
    for (;;) {
        sum = 0u; cnt = 0u; mine = 0u;
#pragma unroll
        for (unsigned j = 0; j < 16; ++j) { const unsigned c = xb_ld(&bar[XB_XCNT(j)]); sum += c; cnt += (c > 0u) ? 1u : 0u; mine = (j == x) ? c : mine; }
        if (sum == G) break;
        __builtin_amdgcn_s_sleep(1);
        if ((++sp & 255u) == 0u) { if (xb_ld(&bar[XB_TMO])) break; if (sp > XB_SPIN_CAP) { atomicAdd(&bar[XB_TMO], 1u); break; } }
    }
    nloc = mine > 0u ? mine : 1u; nx = cnt > 0u ? cnt : 1u;
}

__device__ __forceinline__ void xcd_barrier(const XcdBarrier& b) {
    asm volatile("s_waitcnt vmcnt(0)" ::: "memory");
    __syncthreads();
    if (threadIdx.x == 0) {
        unsigned* bar = b.bar;
        __builtin_amdgcn_s_waitcnt(0);
        unsigned nloc = b.st[0], nx = b.st[1];
        if (nloc == 0u) { xcd_barrier_complete(bar, b.x, nloc, nx); b.st[0] = nloc; b.st[1] = nx; }
        const unsigned old = xb_add(&bar[XB_XSUB(b.x)], 1u);
        const unsigned gen = old / nloc;
        if (old + 1u == (gen + 1u) * nloc) {
            __builtin_amdgcn_fence(__ATOMIC_RELEASE, "agent");
            asm volatile("s_waitcnt vmcnt(0)" ::: "memory");
            const unsigned og = xb_add(&bar[XB_TOP], 1u);
            const unsigned tg = og / nx;
            if (og + 1u == (tg + 1u) * nx) xb_add(&bar[XB_TOPGEN], 1u);
            else XB_SPIN(xb_ld(&bar[XB_TOPGEN]) == tg, bar);
            __builtin_amdgcn_fence(__ATOMIC_ACQUIRE, "agent");
            xb_add(&bar[XB_XGEN(b.x)], 1u);
            asm volatile("s_waitcnt vmcnt(0)" ::: "memory");
        } else {
            XB_SPIN(xb_ld(&bar[XB_XGEN(b.x)]) == gen, bar);
            __builtin_amdgcn_fence(__ATOMIC_ACQUIRE, "agent");
            asm volatile("s_waitcnt vmcnt(0)" ::: "memory");
        }
    }
    __syncthreads();
}

typedef float f32x2 __attribute__((ext_vector_type(2)));
typedef unsigned v2u __attribute__((ext_vector_type(2)));
struct Frame {
    LAS unsigned char* lds;
    volatile LAS unsigned* MISC;
    gu32* ctl;
    int tid, lane, wave;
    int vcu, G;
};
__device__ __forceinline__ float wave_sum(float v) {
#pragma unroll
    for (int o = 1; o < 64; o <<= 1) v += __shfl_xor(v, o);
    return v;
}
__device__ __forceinline__ float wave_max(float v) {
#pragma unroll
    for (int o = 1; o < 64; o <<= 1) v = fmaxf(v, __shfl_xor(v, o));
    return v;
}
__device__ __forceinline__ int win_row(int n) { if (n < 1536 || n >= 3072) return n; const int t = (n - 1536) >> 8, ln = (n - 1536) & 255, hl = ln >> 6, d = ln & 63; return 1536 + t * 256 + 32 * hl + (d & 31) + 128 * (d >> 5); }
__device__ __forceinline__ void p0_transpose_item(const float* W, int N, const float* gain, bf16* WT, int ldt, int koff, int mode, LAS float* scr, int item, int lane) {
    const int nblk = N / 32, kb = item / nblk, nb = item % nblk, k0 = 64 * kb, n0 = 32 * nb;
#pragma unroll 8
    for (int i = 0; i < 32; ++i) { const int kk = 2 * i + (lane >> 5); float v = W[(size_t)(k0 + kk) * N + n0 + (lane & 31)]; if (gain) v *= gain[k0 + kk]; scr[kk * 33 + (lane & 31)] = v; }
    LDS_WAIT(); asm volatile("" ::: "memory");
    const int c = lane & 7;
#pragma unroll
    for (int j = 0; j < 4; ++j) { const int n = (lane >> 3) + 8 * j; const LAS float* s = scr + (8 * c) * 33 + n;
        v4u o; o.x = pk2(s[0 * 33], s[1 * 33]); o.y = pk2(s[2 * 33], s[3 * 33]); o.z = pk2(s[4 * 33], s[5 * 33]); o.w = pk2(s[6 * 33], s[7 * 33]);
        const int rown = mode ? win_row(n0 + n) : (n0 + n);
        *(GAS v4u*)(WT + (size_t)rown * ldt + koff + k0 + 8 * c) = o; }
    LDS_WAIT(); asm volatile("" ::: "memory");
}
__device__ __forceinline__ void quant_row_fp8(const float* src, const float* gain, unsigned char* dst, size_t slice_stride, float* scale_out, int lane) {
    f32x4 v[4]; float am = 0.f;
#pragma unroll
    for (int j = 0; j < 4; ++j) { v[j] = *(const GAS f32x4*)(src + 256 * j + 4 * lane); if (gain) v[j] = v[j] * *(const GAS f32x4*)(gain + 256 * j + 4 * lane);
        am = fmaxf(am, fmaxf(fmaxf(fabsf(v[j][0]), fabsf(v[j][1])), fmaxf(fabsf(v[j][2]), fabsf(v[j][3])))); }
    am = wave_max(am);
    const int ex = (int)((__float_as_uint(am) >> 23) & 0xffu);
    const float s = (ex == 0) ? 1.0f : __uint_as_float((unsigned)(127 + 7 - (ex - 127)) << 23);
    const float is = (ex == 0) ? 1.0f : __uint_as_float((unsigned)(127 - 7 + (ex - 127)) << 23);
    if (lane == 0) *scale_out = is;
#pragma unroll
    for (int j = 0; j < 4; ++j) { int pk = __builtin_amdgcn_cvt_pk_fp8_f32(v[j][0] * s, v[j][1] * s, 0, false); pk = __builtin_amdgcn_cvt_pk_fp8_f32(v[j][2] * s, v[j][3] * s, pk, true);
        const int col = 256 * j + 4 * lane; *(GAS int*)(dst + (size_t)(col >> 7) * slice_stride + (col & 127)) = pk; }
}
__device__ __forceinline__ void quant_row_i8(const float* src, const float* gain, unsigned char* dst, float* scale_out, int lane) {
    f32x4 v[4]; float am = 0.f;
#pragma unroll
    for (int j = 0; j < 4; ++j) { v[j] = *(const GAS f32x4*)(src + 256 * j + 4 * lane); if (gain) v[j] = v[j] * *(const GAS f32x4*)(gain + 256 * j + 4 * lane);
        am = fmaxf(am, fmaxf(fmaxf(fabsf(v[j][0]), fabsf(v[j][1])), fmaxf(fabsf(v[j][2]), fabsf(v[j][3])))); }
    am = wave_max(am);
    const float s = am > 0.f ? 127.0f / am : 0.f;
    if (lane == 0) *scale_out = am * (1.0f / 127.0f);
#pragma unroll
    for (int j = 0; j < 4; ++j) { const int q0 = (int)__builtin_rintf(v[j][0] * s), q1 = (int)__builtin_rintf(v[j][1] * s), q2 = (int)__builtin_rintf(v[j][2] * s), q3 = (int)__builtin_rintf(v[j][3] * s);
        *(GAS int*)(dst + 256 * j + 4 * lane) = (q0 & 0xff) | ((q1 & 0xff) << 8) | ((q2 & 0xff) << 16) | (q3 << 24); }
}
__device__ __forceinline__ float gelu_f(float v) {
    const float av = fabsf(v), t = __builtin_amdgcn_rcpf(av * 0.2316418882f + 1.0f);
    float q = t * 0.5307027145f + (-0.7265760135f); q = q * t + 0.7107068705f; q = q * t + (-0.142248368f); q = q * t + 0.127414796f; q = q * t;
    const float e = __builtin_amdgcn_exp2f((v * v) * (-0.72134752044f));
    const float m = v * (q * e);
    return v < 0.f ? m : v - m;
}

struct Args { const float* in[14]; float* out; unsigned char* ws; int ph_lo, ph_hi, li, pad; };
__global__ void __launch_bounds__(NWAVES * 64, 2) fwd_kernel(Args args) {
    extern __shared__ __attribute__((aligned(16))) unsigned char lds[];
    Frame F;
    F.lds = (LAS unsigned char*)lds;
    F.MISC = (volatile LAS unsigned*)(F.lds + MISC_OFF);
    F.tid = threadIdx.x; F.lane = F.tid & 63; F.wave = __builtin_amdgcn_readfirstlane(F.tid >> 6);
    F.G = gridDim.x; { const int bx = blockIdx.x; F.vcu = (F.G % 8 == 0) ? (bx % 8) * (F.G / 8) + bx / 8 : bx; }
    unsigned char* ws = args.ws;
    F.ctl = (gu32*)(ws + WS_CTL);
    const float* x = args.in[0]; const float* norm1_gain = args.in[1]; const float* w_in = args.in[2]; const float* b_gate = args.in[3];
    const float* q_gain = args.in[4]; const float* k_gain = args.in[5]; const float* w_sb_out = args.in[6]; const float* w_dil_out = args.in[7];
    const float* w_out = args.in[8]; const float* norm2_gain = args.in[9]; const float* w_peer_q = args.in[10]; const float* sub_keys = args.in[11];
    const float* peer_u = args.in[12]; const float* peer_v = args.in[13];
    float* out = args.out;
    bf16* WIN = (bf16*)(ws + WS_WIN); bf16* WCAT = (bf16*)(ws + WS_WCAT); bf16* WOUT = (bf16*)(ws + WS_WOUT); bf16* WC = (bf16*)(ws + WS_WC);
    float* RINV1 = (float*)(ws + WS_RINV1); float* RINV2 = (float*)(ws + WS_RINV2); float* USC = (float*)(ws + WS_USC); float* VSC = (float*)(ws + WS_VSC); float* SSQ = (float*)(ws + WS_SSQ);
    unsigned char* U8 = ws + WS_U8; unsigned char* V8 = ws + WS_V8;
    unsigned short* IDS = (unsigned short*)(ws + WS_IDS); float* GW = (float*)(ws + WS_GW); float* COEF = (float*)(ws + WS_COEF); unsigned char* HQ = ws + WS_HQ; float* HS2 = (float*)(ws + WS_HS2);
    bf16* XB = (bf16*)(ws + WS_XB); bf16* OC = (bf16*)(ws + WS_XB);
    bf16* QS = (bf16*)(ws + WS_QS); bf16* KS = (bf16*)(ws + WS_KS); bf16* VS = (bf16*)(ws + WS_VS);
    bf16* QD = (bf16*)(ws + WS_QD); bf16* KD = (bf16*)(ws + WS_KD); bf16* VD = (bf16*)(ws + WS_VD);
    bf16* GT = (bf16*)(ws + WS_GT); bf16* MIX = (bf16*)(ws + WS_MIX); bf16* X1B = (bf16*)(ws + WS_X1B);

    for (int u = F.tid; u < (LDS_BYTES - LDSCTL_OFF) / 4; u += NWAVES * 64) ((LAS unsigned*)(F.lds + LDSCTL_OFF))[u] = 0u;
    __syncthreads();
    const int my_xcc = (int)xb_xcc_id();
    if (F.tid == 0) F.MISC[12] = xb_add((unsigned*)(F.ctl + CW_XRANK) + 64 * my_xcc, 1u);
    __syncthreads();
    const int my_xrank = (int)F.MISC[12];
    const int bli = (N_LAUNCHES == PER_PHASE) ? 0 : args.li;
    XcdBarrier bar; bar.bar = (unsigned*)(F.ctl + CW_BAR) + bli * XCD_BAR_WORDS; bar.x = 0; bar.st = nullptr;
    if (N_LAUNCHES != PER_PHASE) bar = xcd_barrier_post((unsigned*)(F.ctl + CW_BAR) + bli * XCD_BAR_WORDS, F.MISC + 8);
    const int lo = args.ph_lo, hi = args.ph_hi;
#ifndef PHASE_MASK
#define PHASE_MASK 0xff
#endif
#define IN(k) (((PHASE_MASK >> (k)) & 1) && lo <= (k) && (k) < hi)
#define BOTH(k) (IN(k) && IN((k) + 1))
#define GRID_BAR() do { if (N_LAUNCHES != PER_PHASE) xcd_barrier(bar); } while (0)
#ifndef PROBE_REPEAT
#define PROBE_REPEAT 0x00
#endif
#ifndef PROBE_L1
#define PROBE_L1 0x0
#endif
#define REP(k) _Pragma("unroll") for (int rep_ = 0; rep_ < (((PROBE_REPEAT >> (k)) & 1) ? 2 : 1); ++rep_)
    const int gw = F.vcu * NWAVES + F.wave, NGW = F.G * NWAVES;
#define P67_MAP() int vx = (int)(blockIdx.x & 7), rk = (int)(blockIdx.x >> 3), nrk = (F.G + 7 - vx) / 8; \
        { bool uni_ = (F.G % 8 == 0); for (int j_ = 0; j_ < 16; ++j_) { const unsigned c_ = xb_ld((unsigned*)(F.ctl + CW_XRANK) + 64 * j_); uni_ = uni_ && (c_ == (j_ < 8 ? (unsigned)(F.G / 8) : 0u)); } \
          if (uni_) { vx = my_xcc; rk = my_xrank; nrk = F.G / 8; } }

    if (IN(0)) REP(0) {
        for (int it = F.vcu; it < 256; it += F.G) {
            const int hp = it >> 4, d0 = (it & 15) * 64;
            LAS float* As = (LAS float*)(F.lds);
            LAS float* Bs = (LAS float*)(F.lds + 64 * 132 * 4);
            for (int e = F.tid; e < 64 * 32; e += 512) { const int r = e >> 5, c4 = (e & 31) * 4; *(LAS f32x4*)(As + r * 132 + c4) = *(const GAS f32x4*)(w_peer_q + (size_t)(d0 + r) * 2048 + hp * 128 + c4); }
            for (int e = F.tid; e < 128 * 32; e += 512) { const int r = e >> 5, c4 = (e & 31) * 4; *(LAS f32x4*)(Bs + r * 132 + c4) = *(const GAS f32x4*)(sub_keys + ((size_t)hp * 128 + r) * 128 + c4); }
            __syncthreads();
            const int ddg = F.tid & 15, ng = F.tid >> 4;
            f32x4 acc[4];
#pragma unroll
            for (int j = 0; j < 4; ++j) acc[j] = (f32x4){0.f, 0.f, 0.f, 0.f};
            for (int c4 = 0; c4 < 128; c4 += 4) {
                f32x4 a[4], b[4];
#pragma unroll
                for (int i = 0; i < 4; ++i) { a[i] = *(const LAS f32x4*)(As + (4 * ddg + i) * 132 + c4); b[i] = *(const LAS f32x4*)(Bs + (4 * ng + i) * 132 + c4); }
#pragma unroll
                for (int j = 0; j < 4; ++j)
#pragma unroll
                    for (int i = 0; i < 4; ++i) acc[j][i] += (a[i][0] * b[j][0] + a[i][1] * b[j][1]) + (a[i][2] * b[j][2] + a[i][3] * b[j][3]);
            }
            const f32x4 g2 = *(const GAS f32x4*)(norm2_gain + d0 + 4 * ddg);
#pragma unroll
            for (int j = 0; j < 4; ++j) { v2u o; o.x = pk2(acc[j][0] * g2[0], acc[j][1] * g2[1]); o.y = pk2(acc[j][2] * g2[2], acc[j][3] * g2[3]);
                *(GAS v2u*)(WC + (size_t)(hp * 128 + 4 * ng + j) * 1024 + d0 + 4 * ddg) = o; }
            __syncthreads();
        }
        {
            LAS float* scr = (LAS float*)(F.lds + RING_OFF + F.wave * 16384);
            constexpr int I_IN = (D / 64) * (N1 / 32), I_SB = (512 / 64) * (D / 32), I_DL = (256 / 64) * (D / 32), I_OUT = (D / 64) * (D / 32);
            constexpr int NITEMS = I_IN + I_SB + I_DL + I_OUT;
            for (int it = gw; it < NITEMS; it += NGW) {
                int r = it;
                if (r < I_IN) { p0_transpose_item(w_in, N1, norm1_gain, WIN, 1024, 0, 1, scr, r, F.lane); continue; } r -= I_IN;
                if (r < I_SB) { p0_transpose_item(w_sb_out, D, nullptr, WCAT, 768, 0, 0, scr, r, F.lane); continue; } r -= I_SB;
                if (r < I_DL) { p0_transpose_item(w_dil_out, D, nullptr, WCAT, 768, 512, 0, scr, r, F.lane); continue; } r -= I_DL;
                p0_transpose_item(w_out, D, nullptr, WOUT, 1024, 0, 0, scr, r, F.lane);
            }
        }
        for (int e = gw; e < 2 * NEXP; e += NGW) {
            if (e < NEXP) quant_row_i8(peer_u + (size_t)e * D, norm2_gain, U8 + (size_t)e * D, USC + e, F.lane);
            else { const int ev = e - NEXP; quant_row_fp8(peer_v + (size_t)ev * D, nullptr, V8 + (size_t)ev * 128, (size_t)NEXP * 128, VSC + ev, F.lane); }
        }
        for (int m = gw; m < T; m += NGW) {
            const GAS f32x4* xr = (const GAS f32x4*)(x + (size_t)m * D) + F.lane;
            f32x4 v[4]; float s = 0.f;
#pragma unroll
            for (int j = 0; j < 4; ++j) { v[j] = xr[64 * j]; s += (v[j][0] * v[j][0] + v[j][1] * v[j][1]) + (v[j][2] * v[j][2] + v[j][3] * v[j][3]); }
            s = wave_sum(s);
            if (F.lane == 0) RINV1[m] = __builtin_amdgcn_rsqf(s * (1.0f / D) + 1e-6f);
            GAS unsigned long long* o8 = (GAS unsigned long long*)(XB + (size_t)m * D) + F.lane;
#pragma unroll
            for (int j = 0; j < 4; ++j) o8[64 * j] = (unsigned long long)pk2(v[j][0], v[j][1]) | ((unsigned long long)pk2(v[j][2], v[j][3]) << 32);
        }
        if (BOTH(0)) GRID_BAR();
    }

    if (IN(1)) REP(1) {
        pg8::Gemm g{XB, WIN, T, N1, D}; pg8::StaticOrder S; S.init(T, N1, F.G, (int)blockIdx.x);
        pg8::Epi1 E{RINV1, b_gate, q_gain, k_gain, QS, KS, VS, QD, KD, VD, GT};
        pg8::gemm_phase<pg8::Epi1, pg8::StaticOrder, true, true>(F.lds + RING_OFF, g, S, E);
        if (BOTH(1)) GRID_BAR();
    }

    if (IN(2)) REP(2) {
        LAS unsigned char* wl = F.lds + RING_OFF + F.wave * 16384;
        for (int it = gw; it < 8192; it += NGW) { const int mb = it & 7, c = (it >> 3) & 15, j = (it >> 7) & 3, b = it >> 9; att::dl_item(QD, KD, VD, OC, b, j, c, mb, wl, F.lane); }
        for (int it = gw; it < 16384; it += NGW) { const int qt = 127 - (it & 127), h = (it >> 7) & 7, b = it >> 10; att::sb_item(QS, KS, VS, OC, b, h, qt, wl, F.lane); }
        if (BOTH(2)) GRID_BAR();
    }

    if (IN(3)) REP(3) {
        pg8::Gemm g{OC, WCAT, T, D, 768}; pg8::StaticOrder S; S.init(T, D, F.G, (int)blockIdx.x);
        pg8::Epi2 E{GT, MIX};
        pg8::gemm_phase<pg8::Epi2, pg8::StaticOrder, true, true>(F.lds + RING_OFF, g, S, E);
        if (BOTH(3)) GRID_BAR();
    }

    if (IN(4)) REP(4) {
        pg8::Gemm g{MIX, WOUT, T, D, D}; pg8::StaticOrder S; S.init(T, D, F.G, (int)blockIdx.x);
        pg8::Epi3 E{x, X1B, SSQ};
        pg8::gemm_phase<pg8::Epi3, pg8::StaticOrder, true, true>(F.lds + RING_OFF, g, S, E);
        if (BOTH(4)) GRID_BAR();
    }

    if (IN(5)) REP(5) {
        for (int m = gw; m < T; m += NGW) {
            const v4u a = *(const GAS v4u*)(X1B + (size_t)m * D + 8 * F.lane), b = *(const GAS v4u*)(X1B + (size_t)m * D + 512 + 8 * F.lane);
            float v[16] = {pg8::bflo(a.x), pg8::bfhi(a.x), pg8::bflo(a.y), pg8::bfhi(a.y), pg8::bflo(a.z), pg8::bfhi(a.z), pg8::bflo(a.w), pg8::bfhi(a.w),
                           pg8::bflo(b.x), pg8::bfhi(b.x), pg8::bflo(b.y), pg8::bfhi(b.y), pg8::bflo(b.z), pg8::bfhi(b.z), pg8::bflo(b.w), pg8::bfhi(b.w)};
            float am = 0.f;
#pragma unroll
            for (int i = 0; i < 16; ++i) am = fmaxf(am, fabsf(v[i]));
            am = wave_max(am);
            float sq = (F.lane < 16) ? SSQ[(size_t)m * 16 + F.lane] : 0.f; sq = wave_sum(sq);
            const float s = am > 0.f ? 127.0f / am : 0.f;
            if (F.lane == 0) HS2[m] = am * (1.0f / 127.0f) * __builtin_amdgcn_rsqf(sq * (1.0f / 1024.0f) + 1e-6f);
            int q[16];
#pragma unroll
            for (int i = 0; i < 16; ++i) q[i] = (int)__builtin_rintf(v[i] * s) & 0xff;
            v2u o0, o1; o0.x = q[0] | (q[1] << 8) | (q[2] << 16) | (q[3] << 24); o0.y = q[4] | (q[5] << 8) | (q[6] << 16) | (q[7] << 24);
            o1.x = q[8] | (q[9] << 8) | (q[10] << 16) | (q[11] << 24); o1.y = q[12] | (q[13] << 8) | (q[14] << 16) | (q[15] << 24);
            *(GAS v2u*)(HQ + (size_t)m * D + 8 * F.lane) = o0; *(GAS v2u*)(HQ + (size_t)m * D + 512 + 8 * F.lane) = o1;
        }
        pg8::Gemm g{X1B, WC, T, 2048, D}; pg8::StaticOrder S; S.init(T, 2048, F.G, (int)blockIdx.x);
        pg8::Epi4 E{SSQ, RINV2, IDS, GW};
        pg8::OneUnit O1;
        for (int i = 0; S.next(i, O1.u); ++i) pg8::gemm_phase<pg8::Epi4, pg8::OneUnit, false, true>(F.lds + RING_OFF, g, O1, E);
        if (BOTH(5)) GRID_BAR();
    }

    if (IN(6)) REP(6) {
        P67_MAP();
        const int p16 = F.lane & 15, sg = F.lane >> 4;
        const int tstep = nrk * NWAVES;
        const int tfirst = rk * NWAVES + F.wave;
        LAS unsigned* lst = (LAS unsigned*)(F.lds + RING_OFF + F.wave * 16384);
        int tcur = tfirst - tstep, n = 0, boff = 0;
        int id0 = 0, id1 = 0, id0n, id1n; bool done = (tfirst >= T);
        { const int tf = tfirst < T ? tfirst : T - 1; id0n = (int)IDS[(size_t)tf * 128 + F.lane]; id1n = (int)IDS[(size_t)tf * 128 + 64 + F.lane]; }
        const int gsel = (F.lane & 15), bpsrc = (16 * (F.lane & 3) + ((F.lane >> 2) & 3)) * 4;
#define P6_A(W, H, EB, KB, TB, GB, UB, VB, HS, NG) do { \
            if (!done && boff >= n) { tcur += tstep; if (tcur >= T) done = true; else { id0 = id0n; id1 = id1n; boff = 0; \
                const bool in0_ = ((id0 >> 11) == vx), in1_ = ((id1 >> 11) == vx); const unsigned long long m0_ = __ballot(in0_), m1_ = __ballot(in1_); \
                const int n0_ = __builtin_popcountll(m0_); n = n0_ + __builtin_popcountll(m1_); \
                const int r0_ = (int)__builtin_amdgcn_mbcnt_hi((unsigned)(m0_ >> 32), __builtin_amdgcn_mbcnt_lo((unsigned)m0_, 0u)); \
                const int r1_ = n0_ + (int)__builtin_amdgcn_mbcnt_hi((unsigned)(m1_ >> 32), __builtin_amdgcn_mbcnt_lo((unsigned)m1_, 0u)); \
                asm volatile("s_waitcnt lgkmcnt(0)" ::: "memory"); \
                if (in0_) lst[r0_] = ((unsigned)F.lane << 16) | (unsigned)id0; if (in1_) lst[r1_] = ((unsigned)(64 + F.lane) << 16) | (unsigned)id1; \
                asm volatile("s_waitcnt lgkmcnt(0)" ::: "memory"); } } \
            { int tn_ = tcur + tstep; tn_ = tn_ < T ? tn_ : T - 1; tn_ = tn_ < 0 ? 0 : tn_; id0n = (int)IDS[(size_t)tn_ * 128 + F.lane]; id1n = (int)IDS[(size_t)tn_ * 128 + 64 + F.lane]; } \
            int nb_ = done ? 0 : n - boff; nb_ = nb_ > 16 ? 16 : nb_; nb_ = nb_ < 0 ? 0 : nb_; NG = (nb_ + 3) >> 2; \
            TB = tcur < T ? tcur : T - 1; TB = TB < 0 ? 0 : TB; \
            unsigned ent_[4]; \
            _Pragma("unroll") for (int g_ = 0; g_ < 4; ++g_) { const int j_ = boff + 4 * g_ + sg; ent_[g_] = lst[j_ > 127 ? 127 : j_]; } \
            const unsigned entj_ = lst[(boff + gsel) > 127 ? 127 : (boff + gsel)]; \
            EB = (gsel < nb_ && F.lane < 16) ? (int)(entj_ & 0xffffu) : -1; KB = (int)(entj_ >> 16) & 127; \
            _Pragma("unroll") for (int g_ = 0; g_ < 4; ++g_) { const unsigned e_ = ((4 * g_ + sg) < nb_ && !(PROBE_L1 && rep_)) ? (ent_[g_] & 0xffffu) : 0u; const unsigned char* up_ = U8 + (size_t)e_ * D + 16 * p16; \
                _Pragma("unroll") for (int i_ = 0; i_ < 4; ++i_) W[g_][i_] = *(const GAS v4u*)(up_ + 256 * i_); } \
            { const unsigned char* hp_ = HQ + (size_t)TB * D + 16 * p16; _Pragma("unroll") for (int i_ = 0; i_ < 4; ++i_) H[i_] = *(const GAS v4u*)(hp_ + 256 * i_); } \
            HS = HS2[TB]; \
            { const int ec_ = EB < 0 ? 0 : EB; GB = GW[(size_t)TB * 128 + KB]; UB = USC[ec_]; VB = VSC[ec_]; } \
            boff += 16; } while (0)
#define P6_DPPADD(a_, ctrl) a_ += __builtin_amdgcn_update_dpp(0, a_, ctrl, 0xf, 0xf, false)
#define P6_B(W, H, EB, KB, TB, GB, UB, VB, HS, NG) do { int ag_[4] = {0, 0, 0, 0}; \
            _Pragma("unroll") for (int g_ = 0; g_ < 4; ++g_) if (g_ < NG) { int a_ = 0; \
                _Pragma("unroll") for (int i_ = 0; i_ < 4; ++i_) { a_ = __builtin_amdgcn_sdot4((int)W[g_][i_].x, (int)H[i_].x, a_, false); a_ = __builtin_amdgcn_sdot4((int)W[g_][i_].y, (int)H[i_].y, a_, false); \
                    a_ = __builtin_amdgcn_sdot4((int)W[g_][i_].z, (int)H[i_].z, a_, false); a_ = __builtin_amdgcn_sdot4((int)W[g_][i_].w, (int)H[i_].w, a_, false); } \
                P6_DPPADD(a_, 0xB1); P6_DPPADD(a_, 0x4E); P6_DPPADD(a_, 0x141); P6_DPPADD(a_, 0x140); ag_[g_] = a_; } \
            if (NG > 0) { const int sel_ = gsel == 0 ? ag_[0] : gsel == 1 ? ag_[1] : gsel == 2 ? ag_[2] : ag_[3];     \
                const float resv_ = (float)__builtin_amdgcn_ds_bpermute(bpsrc, sel_); \
                if (EB >= 0 && !(PROBE_L1 && rep_)) { const float act_ = gelu_f(resv_ * UB * HS); COEF[(size_t)TB * 128 + KB] = GB * act_ * VB; } } } while (0)
        v4u wA[4][4], hA[4], wB[4][4], hB[4]; int ebA, kbA, tbA, ngA, ebB, kbB, tbB, ngB;
        float gbA, ubA, vbA, hsA, gbB, ubB, vbB, hsB;
        for (;;) {
            P6_A(wA, hA, ebA, kbA, tbA, gbA, ubA, vbA, hsA, ngA);
            P6_A(wB, hB, ebB, kbB, tbB, gbB, ubB, vbB, hsB, ngB);
            P6_B(wA, hA, ebA, kbA, tbA, gbA, ubA, vbA, hsA, ngA);
            P6_B(wB, hB, ebB, kbB, tbB, gbB, ubB, vbB, hsB, ngB);
            if (done) break;
        }
#undef P6_A
#undef P6_B
#undef P6_DPPADD
        if (BOTH(6)) GRID_BAR();
    }

    if (IN(7)) REP(7) {
        P67_MAP();
        const int l8 = F.lane & 7, kg = F.lane >> 3;
        const unsigned char* vbase = V8 + (size_t)vx * NEXP * 128 + 16 * l8;
        const int tstep = nrk * NWAVES;
        const int col = 128 * vx + 16 * l8 + ((F.lane & 8) ? 8 : 0) + ((F.lane & 16) ? 4 : 0) + ((F.lane & 32) ? 2 : 0);
#define P7_CL(tt) ((tt) < T ? (tt) : T - 1)
#define P7_IDS(tt, ID) do { const int tc_ = P7_CL(tt); ID[0] = *(const GAS v4u*)(IDS + (size_t)tc_ * 128 + 16 * kg); ID[1] = *(const GAS v4u*)(IDS + (size_t)tc_ * 128 + 16 * kg + 8); } while (0)
#define P7_ISSUE(tt, ID, W, CF, OO) do { const int tc_ = P7_CL(tt); const unsigned idw_[8] = {ID[0].x, ID[0].y, ID[0].z, ID[0].w, ID[1].x, ID[1].y, ID[1].z, ID[1].w}; \
            _Pragma("unroll") for (int i_ = 0; i_ < 16; ++i_) { const unsigned e_ = (i_ & 1) ? (idw_[i_ >> 1] >> 16) : (idw_[i_ >> 1] & 0xffffu); W[i_] = *(const GAS v4u*)(vbase + (size_t)((PROBE_L1 && rep_) ? 0u : e_) * 128); } \
            _Pragma("unroll") for (int i_ = 0; i_ < 4; ++i_) CF[i_] = *(const GAS f32x4*)(COEF + (size_t)tc_ * 128 + 16 * kg + 4 * i_); \
            OO = *(const GAS unsigned*)(X1B + (size_t)tc_ * D + col); } while (0)
#define P7_FMAC(a_, b_, c_) asm("v_fmac_f32_e32 %0, %1, %2" : "+v"(a_) : "v"(b_), "v"(c_))
#define P7_COMPUTE(tt, W, CF, OO) do { float acc_[16]; \
            _Pragma("unroll") for (int i_ = 0; i_ < 16; ++i_) acc_[i_] = 0.f; \
            _Pragma("unroll") for (int i_ = 0; i_ < 16; ++i_) { const unsigned ww_[4] = {W[i_].x, W[i_].y, W[i_].z, W[i_].w}; const float c1_ = CF[i_ >> 2][i_ & 3]; \
                _Pragma("unroll") for (int d_ = 0; d_ < 4; ++d_) { const f32x2 lo_ = __builtin_amdgcn_cvt_pk_f32_fp8((int)ww_[d_], false), hi_ = __builtin_amdgcn_cvt_pk_f32_fp8((int)ww_[d_], true); \
                    const float x0_ = lo_[0], x1_ = lo_[1], x2_ = hi_[0], x3_ = hi_[1]; \
                    P7_FMAC(acc_[4 * d_], c1_, x0_); P7_FMAC(acc_[4 * d_ + 1], c1_, x1_); P7_FMAC(acc_[4 * d_ + 2], c1_, x2_); P7_FMAC(acc_[4 * d_ + 3], c1_, x3_); } } \
            float r8_[8], r4_[4], r2_[2]; \
            { const bool up_ = (F.lane & 8) != 0; _Pragma("unroll") for (int i_ = 0; i_ < 8; ++i_) { const float keep_ = up_ ? acc_[8 + i_] : acc_[i_], send_ = up_ ? acc_[i_] : acc_[8 + i_]; r8_[i_] = keep_ + __shfl_xor(send_, 8); } } \
            { const bool up_ = (F.lane & 16) != 0; _Pragma("unroll") for (int i_ = 0; i_ < 4; ++i_) { const float keep_ = up_ ? r8_[4 + i_] : r8_[i_], send_ = up_ ? r8_[i_] : r8_[4 + i_]; r4_[i_] = keep_ + __shfl_xor(send_, 16); } } \
            { const bool up_ = (F.lane & 32) != 0; _Pragma("unroll") for (int i_ = 0; i_ < 2; ++i_) { const float keep_ = up_ ? r4_[2 + i_] : r4_[i_], send_ = up_ ? r4_[i_] : r4_[2 + i_]; r2_[i_] = keep_ + __shfl_xor(send_, 32); } } \
            if ((tt) < T && rep_ == 0) *(GAS f32x2*)(out + (size_t)(tt) * D + col) = (f32x2){pg8::bflo(OO) + r2_[0], pg8::bfhi(OO) + r2_[1]}; } while (0)
        v4u idA[2], idB[2], wA[16], wB[16]; f32x4 cfA[4], cfB[4]; unsigned ooA, ooB;
        int t = rk * NWAVES + F.wave;
        P7_IDS(t, idA); P7_IDS(t + tstep, idB);
        while (t < T) {
            P7_ISSUE(t, idA, wA, cfA, ooA); P7_ISSUE(t + tstep, idB, wB, cfB, ooB);
            P7_IDS(t + 2 * tstep, idA); P7_IDS(t + 3 * tstep, idB);
            P7_COMPUTE(t, wA, cfA, ooA);
            P7_COMPUTE(t + tstep, wB, cfB, ooB);
            t += 2 * tstep;
        }
#undef P7_CL
#undef P7_IDS
#undef P7_ISSUE
#undef P7_FMAC
#undef P7_COMPUTE
    }
#undef IN
#undef BOTH
#undef GRID_BAR
}

extern "C" void kernel_launch(void* const* d_in, const int* in_sizes, int n_in, void* d_out, int out_size, void* d_ws, size_t ws_size, hipStream_t stream) {
    static int grid = 0;
    if (grid == 0) {
        if (n_in != 14 || in_sizes[0] != T * D || out_size != T * D || ws_size < WS_END) { fprintf(stderr, "kernel_launch: built for 14 inputs, x and out of %d floats, >= %zu bytes of workspace; got n_in %d, in0 %d, out %d, ws %zu; nothing launched\n", T * D, (size_t)WS_END, n_in, n_in > 0 ? in_sizes[0] : -1, out_size, ws_size); grid = -1; return; }
        int dev = 0, cus = 0, per_cu = 0;
        if (hipGetDevice(&dev) != hipSuccess || hipDeviceGetAttribute(&cus, hipDeviceAttributeMultiprocessorCount, dev) != hipSuccess) { fprintf(stderr, "kernel_launch: hipGetDevice / hipDeviceGetAttribute failed\n"); grid = -1; return; }
        if (hipFuncSetAttribute((const void*)fwd_kernel, hipFuncAttributeMaxDynamicSharedMemorySize, LDS_BYTES) != hipSuccess) { fprintf(stderr, "kernel_launch: hipFuncSetAttribute failed\n"); grid = -1; return; }
        if (hipOccupancyMaxActiveBlocksPerMultiprocessor(&per_cu, (const void*)fwd_kernel, NWAVES * 64, LDS_BYTES) != hipSuccess || per_cu < 1)
            fprintf(stderr, "kernel_launch: note: occupancy query reports %d workgroups per CU\n", per_cu);
        (void)hipGetLastError();
        grid = cus;
    }
    if (grid < 0) return;
    if (hipMemsetAsync((char*)d_ws + WS_CTL, 0, CTL_ZERO_BYTES, stream) != hipSuccess) { fprintf(stderr, "kernel_launch: hipMemsetAsync failed\n"); return; }
    Args a{};
    for (int i = 0; i < 14; ++i) a.in[i] = (const float*)d_in[i];
    a.out = (float*)d_out; a.ws = (unsigned char*)d_ws;
    for (int li = 0; li < N_LAUNCHES; ++li) {
        a.ph_lo = (N_LAUNCHES == PER_PHASE) ? li : 0; a.ph_hi = (N_LAUNCHES == PER_PHASE) ? li + 1 : MK_LAST_PHASE; a.li = li;
        if (a.ph_lo >= MK_LAST_PHASE) break;
        hipLaunchKernelGGL(fwd_kernel, dim3(grid), dim3(NWAVES * 64), LDS_BYTES, stream, a);
        const hipError_t le = hipPeekAtLastError();
        if (le != hipSuccess) { fprintf(stderr, "kernel_launch: launch %d failed: %s\n", li, hipGetErrorName(le)); break; }
    }
}
```

```cpp
#include <hip/hip_runtime.h>
#include <cstdio>
#include <cstdint>
namespace pg8 {
#define PG8_LAS __attribute__((address_space(3)))
typedef unsigned short bf16_t;
typedef short bf16x8 __attribute__((ext_vector_type(8)));
typedef float f32x4 __attribute__((ext_vector_type(4)));
typedef unsigned u32x4 __attribute__((ext_vector_type(4)));
constexpr int BM = 256, BK = 64, HALF = 128, HTB = HALF * BK * 2  , STAGE_BYTES = 8 * HTB, NXCD = 8, WGM = 8;

__host__ __device__ __forceinline__ int lds_byte(int r, int c) { const int st = (r >> 4) * 2 + (c >> 5), rr = r & 15, cc = c & 31, ob = rr * 64 + cc * 2; return st * 1024 + (ob ^ (((ob >> 9) & 1) << 5)); }
__host__ __device__ __forceinline__ void stage_rc(int b, int& R, int& C) { const int st = b / 1024, sb = b % 1024, swz = sb ^ (((sb >> 9) & 1) << 5); R = (st >> 1) * 16 + swz / 64; C = (st & 1) * 32 + (swz % 64) / 2; }
__host__ __device__ __forceinline__ int perm32(int rho) { const int n = rho >> 4, i = rho & 15; return 8 * (i >> 2) + 4 * n + (i & 3); }

struct Unit { int pm, pn; };
struct Gemm { const bf16_t* A; const bf16_t* Bt; int M, N, K; };

struct StaticOrder {
    int nM, nN, nwg, G, c;
    __host__ __device__ void init(int M, int N, int G_, int c_) { nM = M / BM; nN = N / BM; nwg = nM * nN; G = G_; c = c_; }
    __host__ __device__ bool next(int i, Unit& u) const {
        const long L = (long)i * G + c; if (L >= nwg) return false;
        int wgid = (int)L; { const int q = nwg / NXCD, r = nwg % NXCD, xcd = wgid % NXCD, off = wgid / NXCD; wgid = (xcd < r ? xcd * (q + 1) : r * (q + 1) + (xcd - r) * q) + off; }
        const int nig = WGM * nN, gid = wgid / nig, fm = gid * WGM, gsz = (nM - fm) < WGM ? (nM - fm) : WGM;
        u.pm = fm + ((wgid % nig) % gsz); u.pn = (wgid % nig) / gsz; return true;
    }
    __device__ __forceinline__ void a_ready(const Unit&) const {}
    __device__ __forceinline__ void done(const Unit&) const {}
};


struct OneUnit {
    Unit u;
    __device__ __forceinline__ bool next(int i, Unit& o) const { if (i != 0) return false; o = u; return true; }
    __device__ __forceinline__ void a_ready(const Unit&) const {}
    __device__ __forceinline__ void done(const Unit&) const {}
};

typedef float f32x2 __attribute__((ext_vector_type(2)));
typedef __bf16 bf16x2_t __attribute__((ext_vector_type(2)));
typedef unsigned u32x2 __attribute__((ext_vector_type(2)));
__device__ __forceinline__ unsigned pkbf(float lo, float hi) { f32x2 v = {lo, hi}; bf16x2_t b = __builtin_convertvector(v, bf16x2_t); return __builtin_bit_cast(unsigned, b); }
__device__ __forceinline__ float bflo(unsigned w) { return __uint_as_float(w << 16); }
__device__ __forceinline__ float bfhi(unsigned w) { return __uint_as_float(w & 0xffff0000u); }
__device__ __forceinline__ u32x4 pack8(const f32x4 a, const f32x4 b) { u32x4 w; w.x = pkbf(a[0], a[1]); w.y = pkbf(a[2], a[3]); w.z = pkbf(b[0], b[1]); w.w = pkbf(b[2], b[3]); return w; }
constexpr float QSCALE = 0.125f * 1.4426950408889634f;
__device__ __forceinline__ float sigmoidf_(float v) { return __builtin_amdgcn_rcpf(1.0f + __builtin_amdgcn_exp2f(-1.4426950408889634f * v)); }

struct Epi1 {
    static constexpr bool PERM = true, AFTER_DRAIN = false, HAS_MID = false; static constexpr int MID_T = -1;
    const float* rinv; const float* bgate; const float* qg; const float* kg;
    bf16_t *QS, *KS, *VS, *QD, *KD, *VD, *GT;
    __device__ __forceinline__ void mid(f32x4 (&)[2][2][4][2], const Unit&, int, int, int, int) const {}
    __device__ __forceinline__ void operator()(const f32x4 (&acc)[2][2][4][2], const Unit& u, int wr, int wc, int fr, int fq) const {
        asm volatile("" : "+v"(fr), "+v"(fq));
        const int pn = u.pn; const int row0 = u.pm * BM + wr * 64 + fr;
        if (pn >= 6 && pn < 12) {
            const bool isK = pn >= 9; const int head = (isK ? pn - 9 : pn - 6) * 4 + wc;
            const float* g = (isK ? kg : qg) + head * 64 + 8 * fq;
            f32x4 gv[2][2]; const float qsc = isK ? 1.0f : QSCALE;
#pragma unroll
            for (int bj = 0; bj < 2; ++bj)
#pragma unroll
                for (int n = 0; n < 2; ++n) gv[bj][n] = *(const f32x4*)(g + 32 * bj + 4 * n) * qsc;
            bf16_t* base = (isK ? KD : QD) + head * 64 + 8 * fq;
#pragma unroll
            for (int ai = 0; ai < 2; ++ai)
#pragma unroll
                for (int m = 0; m < 4; ++m) { const int row = row0 + ai * HALF + m * 16; const float r = 1.0f;
                    f32x4 v[2][2]; float ss = 0.f;
#pragma unroll
                    for (int bj = 0; bj < 2; ++bj)
#pragma unroll
                        for (int n = 0; n < 2; ++n) { v[bj][n] = acc[ai][bj][m][n] * r; const f32x4 q = v[bj][n] * v[bj][n]; ss += (q[0] + q[1]) + (q[2] + q[3]); }
                    ss += __shfl_xor(ss, 16); ss += __shfl_xor(ss, 32);
                    const float sc = __builtin_amdgcn_rsqf(ss * (1.0f / 64.0f) + 1e-6f);
#pragma unroll
                    for (int bj = 0; bj < 2; ++bj) *(u32x4*)(base + (size_t)row * 768 + 32 * bj) = pack8(v[bj][0] * sc * gv[bj][0], v[bj][1] * sc * gv[bj][1]);
                }
        } else if (pn < 15) {
            bf16_t* base; int ld, colt;
            if (pn < 2) { base = QS; ld = 512; colt = pn * 256; } else if (pn < 4) { base = KS; ld = 512; colt = (pn - 2) * 256; } else if (pn < 6) { base = VS; ld = 512; colt = (pn - 4) * 256; } else { base = VD; ld = 768; colt = (pn - 12) * 256; }
            base += colt + wc * 32 + 8 * fq;
#pragma unroll
            for (int ai = 0; ai < 2; ++ai)
#pragma unroll
                for (int m = 0; m < 4; ++m) { const int row = row0 + ai * HALF + m * 16; const float r = (pn < 2 ? QSCALE : 1.0f);
#pragma unroll
                    for (int bj = 0; bj < 2; ++bj) *(u32x4*)(base + (size_t)row * ld + bj * HALF) = pack8(acc[ai][bj][m][0] * r, acc[ai][bj][m][1] * r);
                }
        } else {
            const int col0 = (pn - 15) * 256 + wc * 32 + 8 * fq;
            f32x4 bv[2][2];
#pragma unroll
            for (int bj = 0; bj < 2; ++bj)
#pragma unroll
                for (int n = 0; n < 2; ++n) bv[bj][n] = *(const f32x4*)(bgate + col0 + bj * HALF + 4 * n);
#pragma unroll
            for (int ai = 0; ai < 2; ++ai)
#pragma unroll
                for (int m = 0; m < 4; ++m) { const int row = row0 + ai * HALF + m * 16; const float r = 1.0f;
#pragma unroll
                    for (int bj = 0; bj < 2; ++bj) { f32x4 a = acc[ai][bj][m][0] * r + bv[bj][0], b = acc[ai][bj][m][1] * r + bv[bj][1];
#pragma unroll
                        for (int e = 0; e < 4; ++e) { a[e] = sigmoidf_(a[e]); b[e] = sigmoidf_(b[e]); }
                        *(u32x4*)(GT + (size_t)row * 2048 + col0 + bj * HALF) = pack8(a, b); }
                }
        }
    }
};

struct Epi2 {
    static constexpr bool PERM = true, AFTER_DRAIN = false, HAS_MID = true; static constexpr int MID_T = 8;
    const bf16_t* GT; bf16_t* MIX;
    __device__ __forceinline__ void mid(f32x4 (&acc)[2][2][4][2], const Unit& u, int wr, int wc, int fr, int fq) const {
        asm volatile("" : "+v"(fr), "+v"(fq));
        const int row0 = u.pm * BM + wr * 64 + fr, col0 = u.pn * BM + wc * 32 + 8 * fq;
#pragma unroll
        for (int ai = 0; ai < 2; ++ai)
#pragma unroll
            for (int m = 0; m < 4; ++m) { const bf16_t* gp = GT + (size_t)(row0 + ai * HALF + m * 16) * 2048 + col0;
#pragma unroll
                for (int bj = 0; bj < 2; ++bj) { const u32x4 a = *(const u32x4*)(gp + bj * HALF), b = *(const u32x4*)(gp + 1024 + bj * HALF);
                    f32x4 r0, r1;
                    r0[0] = bflo(a.x) * __builtin_amdgcn_rcpf(fmaxf(bflo(b.x), 1e-30f)); r0[1] = bfhi(a.x) * __builtin_amdgcn_rcpf(fmaxf(bfhi(b.x), 1e-30f));
                    r0[2] = bflo(a.y) * __builtin_amdgcn_rcpf(fmaxf(bflo(b.y), 1e-30f)); r0[3] = bfhi(a.y) * __builtin_amdgcn_rcpf(fmaxf(bfhi(b.y), 1e-30f));
                    r1[0] = bflo(a.z) * __builtin_amdgcn_rcpf(fmaxf(bflo(b.z), 1e-30f)); r1[1] = bfhi(a.z) * __builtin_amdgcn_rcpf(fmaxf(bfhi(b.z), 1e-30f));
                    r1[2] = bflo(a.w) * __builtin_amdgcn_rcpf(fmaxf(bflo(b.w), 1e-30f)); r1[3] = bfhi(a.w) * __builtin_amdgcn_rcpf(fmaxf(bfhi(b.w), 1e-30f));
                    acc[ai][bj][m][0] *= r0; acc[ai][bj][m][1] *= r1; }
                asm volatile("" ::: "memory");
            }
    }
    __device__ __forceinline__ void operator()(const f32x4 (&acc)[2][2][4][2], const Unit& u, int wr, int wc, int fr, int fq) const {
        asm volatile("" : "+v"(fr), "+v"(fq));
        const int row0 = u.pm * BM + wr * 64 + fr, col0 = u.pn * BM + wc * 32 + 8 * fq;
#pragma unroll
        for (int ai = 0; ai < 2; ++ai)
#pragma unroll
            for (int m = 0; m < 4; ++m) { const int row = row0 + ai * HALF + m * 16; const bf16_t* gp = GT + (size_t)row * 2048 + 1024 + col0;
#pragma unroll
                for (int bj = 0; bj < 2; ++bj) { const u32x4 b = *(const u32x4*)(gp + bj * HALF);
                    f32x4 g0, g1;
                    g0[0] = fmaxf(bflo(b.x), 1e-30f); g0[1] = fmaxf(bfhi(b.x), 1e-30f); g0[2] = fmaxf(bflo(b.y), 1e-30f); g0[3] = fmaxf(bfhi(b.y), 1e-30f);
                    g1[0] = fmaxf(bflo(b.z), 1e-30f); g1[1] = fmaxf(bfhi(b.z), 1e-30f); g1[2] = fmaxf(bflo(b.w), 1e-30f); g1[3] = fmaxf(bfhi(b.w), 1e-30f);
                    *(u32x4*)(MIX + (size_t)row * 1024 + col0 + bj * HALF) = pack8(acc[ai][bj][m][0] * g0, acc[ai][bj][m][1] * g1); }
                asm volatile("" ::: "memory");
            }
    }
};

struct Epi3 {
    static constexpr bool PERM = true, AFTER_DRAIN = false, HAS_MID = false; static constexpr int MID_T = -1;
    const float* x; bf16_t* x1b; float* ssq;
    __device__ __forceinline__ void mid(f32x4 (&)[2][2][4][2], const Unit&, int, int, int, int) const {}
    __device__ __forceinline__ void operator()(const f32x4 (&acc)[2][2][4][2], const Unit& u, int wr, int wc, int fr, int fq) const {
        asm volatile("" : "+v"(fr), "+v"(fq));
        const int row0 = u.pm * BM + wr * 64 + fr, col0 = u.pn * BM + wc * 32 + 8 * fq;
#pragma unroll
        for (int ai = 0; ai < 2; ++ai)
#pragma unroll
            for (int m = 0; m < 4; ++m) { const int row = row0 + ai * HALF + m * 16; const size_t off = (size_t)row * 1024 + col0; float ss = 0.f;
#pragma unroll
                for (int bj = 0; bj < 2; ++bj) { const f32x4 v0 = acc[ai][bj][m][0] + *(const f32x4*)(x + off + bj * HALF), v1 = acc[ai][bj][m][1] + *(const f32x4*)(x + off + bj * HALF + 4);
                    *(u32x4*)(x1b + off + bj * HALF) = pack8(v0, v1);
                    const f32x4 q0 = v0 * v0, q1 = v1 * v1; ss += ((q0[0] + q0[1]) + (q0[2] + q0[3])) + ((q1[0] + q1[1]) + (q1[2] + q1[3])); }
                ss += __shfl_xor(ss, 16); ss += __shfl_xor(ss, 32);
                if (fq == 0) ssq[(size_t)row * 16 + u.pn * 4 + wc] = ss;
            }
    }
};

__device__ __forceinline__ unsigned f2key(float v) { const unsigned u = __float_as_uint(v); return (u & 0x80000000u) ? ~u : (u | 0x80000000u); }
__device__ __forceinline__ float key2f(unsigned k) { return __uint_as_float((k & 0x80000000u) ? (k & 0x7fffffffu) : ~k); }
#define PG8_CE(a_, b_) do { const unsigned hi__ = (a_) > (b_) ? (a_) : (b_); const unsigned lo__ = (a_) > (b_) ? (b_) : (a_); (a_) = hi__; (b_) = lo__; } while (0)
__device__ __forceinline__ void bitonic_merge16(unsigned (&v)[16]) {
#pragma unroll
    for (int j = 8; j >= 1; j >>= 1)
#pragma unroll
        for (int i = 0; i < 16; ++i) { const int l = i ^ j; if (l > i) PG8_CE(v[i], v[l]); }
}
__device__ __forceinline__ void bitonic_sort16(unsigned (&v)[16]) {
#pragma unroll
    for (int k = 2; k <= 16; k <<= 1)
#pragma unroll
        for (int j = k >> 1; j >= 1; j >>= 1)
#pragma unroll
            for (int i = 0; i < 16; ++i) { const int l = i ^ j; if (l > i) { if ((i & k) == 0 || k == 16) PG8_CE(v[i], v[l]); else PG8_CE(v[l], v[i]); } }
}
__device__ __forceinline__ void merge_top16(unsigned (&t)[16], const unsigned (&o)[16]) {
#pragma unroll
    for (int i = 0; i < 16; ++i) t[i] = t[i] > o[15 - i] ? t[i] : o[15 - i];
    bitonic_merge16(t);
}
template <int XM> __device__ __forceinline__ void merge_top16_xor(unsigned (&t)[16]) {
    unsigned o[16];
#pragma unroll
    for (int i = 0; i < 16; ++i) o[i] = (unsigned)__shfl_xor((int)t[i], XM);
    merge_top16(t, o);
}

struct Epi4 {
    static constexpr bool PERM = false, AFTER_DRAIN = true, HAS_MID = false; static constexpr int MID_T = -1;
    const float* ssq; float* rinv2; unsigned short* ids; float* gw;
    __device__ __forceinline__ void mid(f32x4 (&)[2][2][4][2], const Unit&, int, int, int, int) const {}
    __device__ __forceinline__ void fused(f32x4 (&acc)[2][2][4][2], const Unit& u, int wr, int wc, int fr, int fq, PG8_LAS unsigned char* lds, int wid, int lane) const {
        asm volatile("" : "+v"(fr), "+v"(fq));
        const int tid = wid * 64 + lane;
        const int rl = tid >> 2, p = (tid >> 1) & 1, hf = tid & 1, q4 = tid & 3;
#pragma unroll
        for (int pass = 0; pass < 2; ++pass) {
#pragma unroll
            for (int m = 0; m < 4; ++m)
#pragma unroll
                for (int bj = 0; bj < 2; ++bj)
#pragma unroll
                    for (int n = 0; n < 2; ++n) *(PG8_LAS f32x4*)(lds + (size_t)(wr * 64 + m * 16 + fr) * 1056 + bj * 528 + (wc * 32 + n * 16 + fq * 4) * 4) = acc[pass][bj][m][n];
            asm volatile("s_waitcnt lgkmcnt(0)" ::: "memory"); __builtin_amdgcn_s_barrier(); asm volatile("" ::: "memory");
            const int row = u.pm * BM + pass * HALF + rl;
            unsigned tk[16];
#pragma unroll
            for (int i = 0; i < 16; ++i) tk[i] = 0u;
            const PG8_LAS unsigned char* sp = lds + (size_t)rl * 1056 + p * 528 + hf * 256;
#pragma nounroll
            for (int c = 0; c < 4; ++c) { unsigned ch[16];
#pragma unroll
                for (int e4 = 0; e4 < 4; ++e4) { const f32x4 v = *(const PG8_LAS f32x4*)(sp + c * 64 + e4 * 16);
#pragma unroll
                    for (int e = 0; e < 4; ++e) ch[4 * e4 + e] = (f2key(v[e]) & ~127u) | (unsigned)(127 - (64 * hf + 16 * c + 4 * e4 + e)); }
                bitonic_sort16(ch);
                merge_top16(tk, ch);
            }
            merge_top16_xor<1>(tk);
            asm volatile("s_waitcnt lgkmcnt(0)" ::: "memory");
            PG8_LAS unsigned* kl = (PG8_LAS unsigned*)(lds + (size_t)(rl & ~15) * 1056) + ((rl & 15) * 2) * 16;
            if (hf == 0) {
#pragma unroll
                for (int i = 0; i < 4; ++i) *(PG8_LAS u32x4*)(kl + p * 16 + 4 * i) = (u32x4){tk[4 * i], tk[4 * i + 1], tk[4 * i + 2], tk[4 * i + 3]}; }
            asm volatile("s_waitcnt lgkmcnt(0)" ::: "memory");
            unsigned ck[16];
#define CAND_SLOT(m_, ij__) do { const unsigned i__ = (ij__) >> 4, j__ = (ij__) & 15u; \
                const unsigned ka__ = kl[(ij__) == 0xFFFFu ? 0u : i__], kb__ = kl[16 + ((ij__) == 0xFFFFu ? 0u : j__)]; \
                const float s__ = key2f(ka__ & ~127u) + key2f(kb__ & ~127u); \
                ck[m_] = (ij__) == 0xFFFFu ? 0u : ((f2key(s__) & ~255u) | (255u - (ij__))); } while (0)
                { const unsigned ij_ = q4 == 0 ? 0u : q4 == 1 ? 1u : q4 == 2 ? 2u : 3u; CAND_SLOT(0, ij_); }
                { const unsigned ij_ = q4 == 0 ? 4u : q4 == 1 ? 5u : q4 == 2 ? 6u : 7u; CAND_SLOT(1, ij_); }
                { const unsigned ij_ = q4 == 0 ? 8u : q4 == 1 ? 9u : q4 == 2 ? 10u : 11u; CAND_SLOT(2, ij_); }
                { const unsigned ij_ = q4 == 0 ? 12u : q4 == 1 ? 13u : q4 == 2 ? 14u : 15u; CAND_SLOT(3, ij_); }
                { const unsigned ij_ = q4 == 0 ? 16u : q4 == 1 ? 17u : q4 == 2 ? 18u : 19u; CAND_SLOT(4, ij_); }
                { const unsigned ij_ = q4 == 0 ? 20u : q4 == 1 ? 21u : q4 == 2 ? 22u : 23u; CAND_SLOT(5, ij_); }
                { const unsigned ij_ = q4 == 0 ? 32u : q4 == 1 ? 33u : q4 == 2 ? 34u : 35u; CAND_SLOT(6, ij_); }
                { const unsigned ij_ = q4 == 0 ? 36u : q4 == 1 ? 48u : q4 == 2 ? 49u : 50u; CAND_SLOT(7, ij_); }
                { const unsigned ij_ = q4 == 0 ? 51u : q4 == 1 ? 64u : q4 == 2 ? 65u : 66u; CAND_SLOT(8, ij_); }
                { const unsigned ij_ = q4 == 0 ? 80u : q4 == 1 ? 81u : q4 == 2 ? 96u : 97u; CAND_SLOT(9, ij_); }
                { const unsigned ij_ = q4 == 0 ? 112u : q4 == 1 ? 113u : q4 == 2 ? 128u : 144u; CAND_SLOT(10, ij_); }
                { const unsigned ij_ = q4 == 0 ? 160u : q4 == 1 ? 176u : q4 == 2 ? 192u : 208u; CAND_SLOT(11, ij_); }
                { const unsigned ij_ = q4 == 0 ? 224u : q4 == 1 ? 240u : q4 == 2 ? 65535u : 65535u; CAND_SLOT(12, ij_); }
#undef CAND_SLOT
            ck[13] = 0u; ck[14] = 0u; ck[15] = 0u;
            bitonic_sort16(ck);
            merge_top16_xor<1>(ck); merge_top16_xor<2>(ck);
            float sq = 0.f;
#pragma unroll
            for (int i = 0; i < 4; ++i) { const f32x4 t = *(const f32x4*)(ssq + (size_t)row * 16 + 4 * i); sq += (t[0] + t[1]) + (t[2] + t[3]); }
            const float r2 = __builtin_amdgcn_rsqf(sq * (1.0f / 1024.0f) + 1e-6f);
            if (u.pn == 0 && q4 == 0) rinv2[row] = r2;
            const float b0 = key2f(ck[0] & ~255u); float wsum = 0.f; float wv[16];
#pragma unroll
            for (int q = 0; q < 16; ++q) { wv[q] = __builtin_amdgcn_exp2f((key2f(ck[q] & ~255u) - b0) * r2 * 1.4426950408889634f); wsum += wv[q]; }
            const float inv = 1.0f / wsum;
            unsigned short eo[4]; float go[4];
#pragma unroll
            for (int e = 0; e < 4; ++e) { unsigned c0 = ck[e], c1 = ck[4 + e], c2 = ck[8 + e], c3 = ck[12 + e]; float w0 = wv[e], w1 = wv[4 + e], w2 = wv[8 + e], w3 = wv[12 + e];
                asm volatile("" : "+v"(c0), "+v"(c1), "+v"(c2), "+v"(c3), "+v"(w0), "+v"(w1), "+v"(w2), "+v"(w3));
                const unsigned cc = q4 == 0 ? c0 : q4 == 1 ? c1 : q4 == 2 ? c2 : c3; const float ww = q4 == 0 ? w0 : q4 == 1 ? w1 : q4 == 2 ? w2 : w3;
                const unsigned code = 255u - (cc & 255u);
                const unsigned i1 = 127u - (kl[code >> 4] & 127u), i2 = 127u - (kl[16 + (code & 15u)] & 127u);
                eo[e] = (unsigned short)(i1 * 128u + i2); go[e] = ww * inv; }
            const size_t ob = ((size_t)row * 8 + u.pn) * 16 + q4 * 4;
            { u32x2 w; w.x = eo[0] | ((unsigned)eo[1] << 16); w.y = eo[2] | ((unsigned)eo[3] << 16); *(u32x2*)(ids + ob) = w; }
            *(f32x4*)(gw + ob) = (f32x4){go[0], go[1], go[2], go[3]};
            asm volatile("s_waitcnt lgkmcnt(0)" ::: "memory"); __builtin_amdgcn_s_barrier(); asm volatile("" ::: "memory");
        }
    }
};
template <class Epi, class Sched, bool ALIGN_EPI = false, bool SP2 = false>
__device__ __forceinline__ void gemm_phase(PG8_LAS unsigned char* lds, const Gemm g, const Sched& S, const Epi& E) {
    const int tid = threadIdx.x, wid = __builtin_amdgcn_readfirstlane(tid >> 6), lane = tid & 63, wr = wid >> 2, wc = wid & 3, fr = lane & 15, fq = lane >> 4;
    const int K = g.K, nt = K / BK;
    unsigned voffA[2], voffB[2];
#pragma unroll
    for (int i = 0; i < 2; ++i) { int R, C; stage_rc(tid * 16 + i * 8192, R, C); const int Rb = Epi::PERM ? ((R & ~31) + perm32(R & 31)) : R;
        voffA[i] = (unsigned)(R * K + C) * 2u; voffB[i] = (unsigned)(Rb * K + C) * 2u; }
    const size_t kstep = (size_t)(BK * 2);
    const size_t hstep = (size_t)HALF * K * 2;
    const size_t tstep = 2 * hstep;
    const unsigned ldsw = (unsigned)wid * 1024u;
    const int aoff = lds_byte(wr * 64 + fr, fq * 8), boff = lds_byte(wc * 32 + fr, fq * 8);
#define PG8_SA(b, h) (((b) * 2 + (h)) * HTB)
#define PG8_SB(b, h) ((4 + (b) * 2 + (h)) * HTB)
#define PG8_STAGE(bufoff, gbase, voff) do { _Pragma("unroll") for (int _i = 0; _i < 2; ++_i) \
        __builtin_amdgcn_global_load_lds((const unsigned*)((const char*)(gbase) + (voff)[_i]), (PG8_LAS unsigned*)(lds + (bufoff) + ldsw + _i * 8192), 16, 0, 0); } while (0)
#define PG8_LDA(dst, b, h) do { _Pragma("unroll") for (int m = 0; m < 4; ++m) _Pragma("unroll") for (int k = 0; k < 2; ++k) dst[m][k] = *(const PG8_LAS bf16x8*)(lds + PG8_SA(b, h) + aoff + m * 2048 + k * 1024); } while (0)
#define PG8_LDB(dst, b, h) do { _Pragma("unroll") for (int n = 0; n < 2; ++n) _Pragma("unroll") for (int k = 0; k < 2; ++k) dst[n][k] = *(const PG8_LAS bf16x8*)(lds + PG8_SB(b, h) + boff + n * 2048 + k * 1024); } while (0)
#define PG8_MMA(ai, bj, At, Bt) do { __builtin_amdgcn_s_setprio(1); _Pragma("unroll") for (int m = 0; m < 4; ++m) _Pragma("unroll") for (int n = 0; n < 2; ++n) _Pragma("unroll") for (int k = 0; k < 2; ++k) \
        acc[ai][bj][m][n] = __builtin_amdgcn_mfma_f32_16x16x32_bf16(Bt[n][k], At[m][k], acc[ai][bj][m][n], 0, 0, 0); __builtin_amdgcn_s_setprio(0); } while (0)
#define PG8_WAIT_V(n) asm volatile("s_waitcnt vmcnt(" #n ")" ::: "memory")
#define PG8_WAIT_L(n) asm volatile("s_waitcnt lgkmcnt(" #n ")" ::: "memory")
#define PG8_BAR __builtin_amdgcn_s_barrier()
#define PG8_SCHED __builtin_amdgcn_sched_barrier(0)
    Unit cur, nxt; int ui = 0;
    if (!S.next(0, cur)) return;
    f32x4 acc[2][2][4][2];
#pragma unroll
    for (int a = 0; a < 2; ++a)
#pragma unroll
        for (int b = 0; b < 2; ++b)
#pragma unroll
            for (int m = 0; m < 4; ++m)
#pragma unroll
                for (int n = 0; n < 2; ++n) acc[a][b][m][n] = (f32x4){0.f, 0.f, 0.f, 0.f};
    bf16x8 At[4][2], B0[2][2], B1[2][2];
    const char* cA = (const char*)g.A + (size_t)cur.pm * tstep; const char* cB = (const char*)g.Bt + (size_t)cur.pn * tstep;
    S.a_ready(cur);
    if constexpr (SP2) {
        PG8_STAGE(PG8_SB(0, 0), cB, voffB); PG8_STAGE(PG8_SB(0, 1), cB + hstep, voffB); PG8_STAGE(PG8_SA(0, 0), cA, voffA); PG8_STAGE(PG8_SA(0, 1), cA + hstep, voffA);
        if (wr == 1) PG8_BAR;
        PG8_WAIT_V(2); PG8_BAR;
        PG8_STAGE(PG8_SB(1, 0), cB + kstep, voffB); PG8_STAGE(PG8_SA(1, 0), cA + kstep, voffA); PG8_STAGE(PG8_SB(1, 1), cB + hstep + kstep, voffB);
        PG8_WAIT_V(6); PG8_BAR;
    } else {
        PG8_STAGE(PG8_SB(0, 0), cB, voffB); PG8_STAGE(PG8_SA(0, 0), cA, voffA); PG8_STAGE(PG8_SB(0, 1), cB + hstep, voffB); PG8_STAGE(PG8_SA(0, 1), cA + hstep, voffA);
        if (wr == 1) PG8_BAR;
        PG8_WAIT_V(4); PG8_BAR;
        PG8_STAGE(PG8_SB(1, 0), cB + kstep, voffB); PG8_STAGE(PG8_SA(1, 0), cA + kstep, voffA); PG8_STAGE(PG8_SB(1, 1), cB + hstep + kstep, voffB);
        PG8_WAIT_V(6); PG8_BAR;
    }
    for (;;) {
        const bool has_next = S.next(ui + 1, nxt);
        const char* nA = has_next ? (const char*)g.A + (size_t)nxt.pm * tstep : cA; const char* nB = has_next ? (const char*)g.Bt + (size_t)nxt.pn * tstep : cB;
        for (int t = 0; t < nt; t += 2) {
            if constexpr (Epi::HAS_MID) { if (t == Epi::MID_T) E.mid(acc, cur, wr, wc, fr, fq); }
            const bool last = (t == nt - 2);
            const char* a1 = cA + (size_t)(t + 1) * kstep;
            const char* a2 = last ? nA : cA + (size_t)(t + 2) * kstep; const char* b2 = last ? nB : cB + (size_t)(t + 2) * kstep;
            const char* a3 = a2 + kstep; const char* b3 = b2 + kstep;
            if (last && has_next) S.a_ready(nxt);
            if constexpr (SP2) {
            PG8_LDB(B0, 0, 0); PG8_LDB(B1, 0, 1); PG8_SCHED; PG8_LDA(At, 0, 0); PG8_STAGE(PG8_SA(1, 1), a1 + hstep, voffA);
            PG8_WAIT_V(8); PG8_WAIT_L(0); PG8_BAR; PG8_MMA(0, 0, At, B0); PG8_MMA(0, 1, At, B1); PG8_BAR; PG8_SCHED;
            PG8_LDA(At, 0, 1); PG8_STAGE(PG8_SB(0, 0), b2, voffB); PG8_STAGE(PG8_SB(0, 1), b2 + hstep, voffB); PG8_STAGE(PG8_SA(0, 0), a2, voffA);
            PG8_WAIT_V(8); PG8_WAIT_L(0); PG8_BAR; PG8_MMA(1, 0, At, B0); PG8_MMA(1, 1, At, B1); PG8_BAR; PG8_SCHED;
            PG8_LDB(B0, 1, 0); PG8_LDB(B1, 1, 1); PG8_SCHED; PG8_LDA(At, 1, 0); PG8_STAGE(PG8_SA(0, 1), a2 + hstep, voffA);
            PG8_WAIT_V(8); PG8_WAIT_L(0); PG8_BAR; PG8_MMA(0, 0, At, B0); PG8_MMA(0, 1, At, B1); PG8_BAR; PG8_SCHED;
            PG8_LDA(At, 1, 1); PG8_STAGE(PG8_SB(1, 0), b3, voffB); PG8_STAGE(PG8_SB(1, 1), b3 + hstep, voffB); PG8_STAGE(PG8_SA(1, 0), a3, voffA);
            PG8_WAIT_V(8); PG8_WAIT_L(0); PG8_BAR; PG8_MMA(1, 0, At, B0); PG8_MMA(1, 1, At, B1); PG8_BAR; PG8_SCHED;
            } else {
            PG8_LDB(B0, 0, 0); PG8_SCHED; PG8_LDA(At, 0, 0); PG8_STAGE(PG8_SA(1, 1), a1 + hstep, voffA);
            PG8_WAIT_L(8); PG8_BAR; PG8_WAIT_L(0); PG8_MMA(0, 0, At, B0); PG8_BAR; PG8_SCHED;
            PG8_LDB(B1, 0, 1); PG8_STAGE(PG8_SB(0, 0), b2, voffB);
            PG8_BAR; PG8_WAIT_L(0); PG8_MMA(0, 1, At, B1); PG8_BAR;
            PG8_LDA(At, 0, 1); PG8_STAGE(PG8_SA(0, 0), a2, voffA);
            PG8_BAR; PG8_WAIT_L(0); PG8_MMA(1, 0, At, B0); PG8_BAR; PG8_SCHED;
            PG8_STAGE(PG8_SB(0, 1), b2 + hstep, voffB);
            PG8_WAIT_V(6); PG8_BAR; PG8_MMA(1, 1, At, B1); PG8_BAR;
            PG8_LDB(B0, 1, 0); PG8_SCHED; PG8_LDA(At, 1, 0); PG8_STAGE(PG8_SA(0, 1), a2 + hstep, voffA);
            PG8_WAIT_L(8); PG8_BAR; PG8_WAIT_L(0); PG8_MMA(0, 0, At, B0); PG8_BAR; PG8_SCHED;
            PG8_LDB(B1, 1, 1); PG8_STAGE(PG8_SB(1, 0), b3, voffB);
            PG8_BAR; PG8_WAIT_L(0); PG8_MMA(0, 1, At, B1); PG8_BAR;
            PG8_LDA(At, 1, 1); PG8_STAGE(PG8_SA(1, 0), a3, voffA);
            PG8_BAR; PG8_WAIT_L(0); PG8_MMA(1, 0, At, B0); PG8_BAR; PG8_SCHED;
            PG8_STAGE(PG8_SB(1, 1), b3 + hstep, voffB);
            PG8_WAIT_V(6); PG8_BAR; PG8_MMA(1, 1, At, B1); PG8_BAR;
            }
        }
        if constexpr (ALIGN_EPI) { if (wr == 0) PG8_BAR; }
        if constexpr (!Epi::AFTER_DRAIN) { E(acc, cur, wr, wc, fr, fq); S.done(cur); }
        if (!has_next) break;
#pragma unroll
        for (int a = 0; a < 2; ++a)
#pragma unroll
            for (int b = 0; b < 2; ++b)
#pragma unroll
                for (int m = 0; m < 4; ++m)
#pragma unroll
                    for (int n = 0; n < 2; ++n) acc[a][b][m][n] = (f32x4){0.f, 0.f, 0.f, 0.f};
        cur = nxt; cA = nA; cB = nB; ++ui;
        if constexpr (ALIGN_EPI) { if (wr == 1) PG8_BAR; }
    }
    PG8_WAIT_V(0);
    if constexpr (!ALIGN_EPI) { if (wr == 0) PG8_BAR; }
    PG8_BAR;
    if constexpr (Epi::AFTER_DRAIN) { E.fused(acc, cur, wr, wc, fr, fq, lds, wid, lane); S.done(cur); }
#undef PG8_SA
#undef PG8_SB
#undef PG8_STAGE
#undef PG8_LDA
#undef PG8_LDB
#undef PG8_MMA
#undef PG8_WAIT_V
#undef PG8_WAIT_L
#undef PG8_BAR
#undef PG8_SCHED
}
}


namespace att {
#define ALAS __attribute__((address_space(3)))
typedef unsigned short bf16;
typedef short bf16x8 __attribute__((ext_vector_type(8)));
typedef short s16x4 __attribute__((ext_vector_type(4)));
typedef float f32x16 __attribute__((ext_vector_type(16)));
typedef float f32x4 __attribute__((ext_vector_type(4)));
typedef float f32x2 __attribute__((ext_vector_type(2)));
typedef unsigned u32x4 __attribute__((ext_vector_type(4)));
typedef __bf16 bf16x2_t __attribute__((ext_vector_type(2)));
constexpr int SEQ = 4096;
constexpr int VPITCH = 144;
constexpr float LOG2E = 1.4426950408889634f, LN2 = 0.6931471805599453f;
__device__ __forceinline__ unsigned pkbf(float lo, float hi) { f32x2 v = {lo, hi}; bf16x2_t b = __builtin_convertvector(v, bf16x2_t); return __builtin_bit_cast(unsigned, b); }
__device__ __forceinline__ void wave_lds_sync() { asm volatile("s_waitcnt lgkmcnt(0)" ::: "memory"); }
__device__ __forceinline__ s16x4 vtr(const ALAS unsigned char* p) { return __builtin_bit_cast(s16x4, __builtin_amdgcn_ds_read_tr16_b64_v4i16((ALAS s16x4*)p)); }
__device__ __forceinline__ int crow(int r, int hi) { return (r & 3) + 8 * (r >> 2) + 4 * hi; }

__device__ __forceinline__ void pv_tile(f32x16& o0, f32x16& o1, const float (&a)[16], const ALAS unsigned char* vt, int lane) {
    const int g = lane >> 4, i = lane & 15, q_ = i >> 2, p_ = i & 3, h = lane >> 5;
    const ALAS unsigned char* vb = vt + (8 * h + q_) * VPITCH + (16 * (g & 1) + 4 * p_) * 2;
    u32x4 pw0, pw1;
    pw0.x = pkbf(a[0], a[1]); pw0.y = pkbf(a[2], a[3]); pw0.z = pkbf(a[4], a[5]); pw0.w = pkbf(a[6], a[7]);
    pw1.x = pkbf(a[8], a[9]); pw1.y = pkbf(a[10], a[11]); pw1.z = pkbf(a[12], a[13]); pw1.w = pkbf(a[14], a[15]);
    const bf16x8 pa0 = __builtin_bit_cast(bf16x8, pw0), pa1 = __builtin_bit_cast(bf16x8, pw1);
#pragma unroll
    for (int s = 0; s < 2; ++s) {
        const s16x4 l0 = vtr(vb + (16 * s) * VPITCH), h0 = vtr(vb + (16 * s + 4) * VPITCH);
        const s16x4 l1 = vtr(vb + (16 * s) * VPITCH + 64), h1 = vtr(vb + (16 * s + 4) * VPITCH + 64);
        const bf16x8 v0 = (bf16x8){l0[0], l0[1], l0[2], l0[3], h0[0], h0[1], h0[2], h0[3]};
        const bf16x8 v1 = (bf16x8){l1[0], l1[1], l1[2], l1[3], h1[0], h1[1], h1[2], h1[3]};
        o0 = __builtin_amdgcn_mfma_f32_32x32x16_bf16(s ? pa1 : pa0, v0, o0, 0, 0, 0);
        o1 = __builtin_amdgcn_mfma_f32_32x32x16_bf16(s ? pa1 : pa0, v1, o1, 0, 0, 0);
    }
}
__device__ __forceinline__ void bcast_rows(float v, ALAS float* sc, int r32, int hi, float (&out)[16]) {
    if (hi == 0) sc[r32] = v;
    wave_lds_sync();
#pragma unroll
    for (int g = 0; g < 4; ++g) { const f32x4 t = *(const ALAS f32x4*)(sc + 8 * g + 4 * hi); out[4 * g] = t[0]; out[4 * g + 1] = t[1]; out[4 * g + 2] = t[2]; out[4 * g + 3] = t[3]; }
    wave_lds_sync();
}
__device__ __forceinline__ void store_o(const f32x16& o0, const f32x16& o1, ALAS unsigned char* stg, bf16* dst  , size_t rstride_elems, int lane) {
    const int r32 = lane & 31, hi = lane >> 5;
    wave_lds_sync();
#pragma unroll
    for (int r = 0; r < 16; ++r) { const int q = crow(r, hi);
        *(ALAS unsigned short*)(stg + q * VPITCH + r32 * 2) = (unsigned short)(pkbf(o0[r], 0.f) & 0xffffu);
        *(ALAS unsigned short*)(stg + q * VPITCH + 64 + r32 * 2) = (unsigned short)(pkbf(o1[r], 0.f) & 0xffffu); }
    wave_lds_sync();
#pragma unroll
    for (int i = 0; i < 4; ++i) { const int row = 8 * i + (lane >> 3), ch = lane & 7; const u32x4 v = *(const ALAS u32x4*)(stg + row * VPITCH + ch * 16); *(u32x4*)(dst + (size_t)row * rstride_elems + ch * 8) = v; }
    wave_lds_sync();
}

__device__ __forceinline__ void sb_item(const bf16* QS, const bf16* KS, const bf16* VS, bf16* OC, int b, int h, int qt, ALAS unsigned char* wl, int lane) {
    const int r32 = lane & 31, hi = lane >> 5;
    const int t0 = qt * 32; const size_t rowb = (size_t)b * SEQ;
    const int kperm = (r32 & ~12) | ((r32 & 4) << 1) | ((r32 & 8) >> 1);
    bf16x8 qf[4];
    { const bf16* qp = QS + (rowb + t0 + r32) * 512 + h * 64 + hi * 8;
#pragma unroll
      for (int d0 = 0; d0 < 4; ++d0) qf[d0] = *(const bf16x8*)(qp + d0 * 16); }
    f32x16 o0 = {}, o1 = {}; float R = 0.f;
    for (int key0 = t0; key0 >= 0; key0 -= 32) {
        const bf16* kp = KS + (rowb + key0 + kperm) * 512 + h * 64 + hi * 8;
        bf16x8 kf[4];
#pragma unroll
        for (int d0 = 0; d0 < 4; ++d0) kf[d0] = *(const bf16x8*)(kp + d0 * 16);
        u32x4 vv[4];
#pragma unroll
        for (int i = 0; i < 4; ++i) vv[i] = *(const u32x4*)(VS + (rowb + key0 + 8 * i + (lane >> 3)) * 512 + h * 64 + (lane & 7) * 8);
        f32x16 p = {};
#pragma unroll
        for (int d0 = 0; d0 < 4; ++d0) p = __builtin_amdgcn_mfma_f32_32x32x16_bf16(kf[d0], qf[d0], p, 0, 0, 0);
#pragma unroll
        for (int i = 0; i < 4; ++i) *(ALAS u32x4*)(wl + (8 * i + (lane >> 3)) * VPITCH + (lane & 7) * 16) = vv[i];
        const bool diag = (key0 == t0);
        float z2[16], L2[16];
#pragma unroll
        for (int r = 0; r < 16; ++r) { const int kk = (r & 7) + 8 * hi + 16 * (r >> 3); const float zz = p[r];
            const float sp = fmaxf(zz, 0.f) + __builtin_amdgcn_logf(1.0f + __builtin_amdgcn_exp2f(-fabsf(zz)));
            const bool valid = !diag || (kk < r32); z2[r] = zz; L2[r] = valid ? sp : 0.f; }
        float c[16];
        c[15] = L2[15];
#pragma unroll
        for (int r = 14; r >= 8; --r) c[r] = c[r + 1] + L2[r];
        c[7] = L2[7];
#pragma unroll
        for (int r = 6; r >= 0; --r) c[r] = c[r + 1] + L2[r];
        const float TB = c[8], TA = c[0];
        const float TBo = __shfl_xor(TB, 32), TAo = __shfl_xor(TA, 32);
        const float offB = R + (hi ? 0.f : TBo);
        const float offA = R + TB + TBo + (hi ? 0.f : TAo);
        float a[16];
#pragma unroll
        for (int r = 0; r < 16; ++r) { const int kk = (r & 7) + 8 * hi + 16 * (r >> 3); const bool valid = !diag || (kk < r32);
            const float e = __builtin_amdgcn_exp2f(z2[r] - (c[r] + (r < 8 ? offA : offB))); a[r] = valid ? e : 0.f; }
        R += (TA + TB) + (TAo + TBo);
        wave_lds_sync();
        pv_tile(o0, o1, a, wl, lane);
        wave_lds_sync();
        if (__all(R > 40.0f * LOG2E)) break;
    }
    store_o(o0, o1, wl, OC + (rowb + t0) * 768 + h * 64, 768, lane);
}

constexpr int DLU_WAVE = 5120;
constexpr int DLU_O = 8 * DLU_WAVE, DLU_M = DLU_O + 512 * 128, DLU_L = DLU_M + 2048, DLU_BYTES = DLU_L + 2048;
__device__ __forceinline__ void dl_unit(const bf16* QD, const bf16* KD, const bf16* VD, bf16* OC, int b, int j, int blk, ALAS unsigned char* lds, int wave, int lane) {
    const int r32 = lane & 31, hi = lane >> 5;
    const size_t rowb = (size_t)b * SEQ;
    const int t0 = 512 * blk;
    const int kperm = (r32 & ~12) | ((r32 & 4) << 1) | ((r32 & 8) >> 1);
    ALAS unsigned char* wl = lds + wave * DLU_WAVE;
    ALAS float* sc = (ALAS float*)(wl + 4608);
    ALAS unsigned short* OL = (ALAS unsigned short*)(lds + DLU_O);
    ALAS float* ML = (ALAS float*)(lds + DLU_M); ALAS float* LL = (ALAS float*)(lds + DLU_L);
    for (int g = 2; g >= 0; --g) {
        const int hh = 4 * g + j, sh = 2 * g, r = 1 << sh;
        const float slope2 = __builtin_amdgcn_exp2f(-8.0f * (float)(hh + 1) / 12.0f) * LOG2E;
        const float sr = slope2 * (float)r;
        for (int it = wave; it < 16; it += 8) {
            const int q0 = g == 2 ? it : g == 1 ? (it & 3) + 128 * (it >> 2) : 32 * it;
            const int tq = t0 + q0 + r * r32, tmax = t0 + q0 + 31 * r;
            bf16x8 qf[4];
            { const bf16* qp = QD + (rowb + tq) * 768 + hh * 64 + hi * 8;
#pragma unroll
              for (int d0 = 0; d0 < 4; ++d0) qf[d0] = *(const bf16x8*)(qp + d0 * 16); }
            const int klo = 31 - r32; int khi = klo + 128; { const int kmaxtok = tmax >> sh; khi = khi < kmaxtok ? khi : kmaxtok; }
            const unsigned krange = (unsigned)(khi - klo);
            f32x16 o0 = {}, o1 = {}; float mrun = -3.0e38f, lrun = 0.f;
            if (g != 2) {
                mrun = ML[q0 + r * r32]; lrun = hi ? 0.f : LL[q0 + r * r32];
#pragma unroll
                for (int q = 0; q < 16; ++q) { const int tl = q0 + r * crow(q, hi);
                    o0[q] = __uint_as_float((unsigned)OL[tl * 64 + r32] << 16); o1[q] = __uint_as_float((unsigned)OL[tl * 64 + 32 + r32] << 16); }
            }
            for (int kt = 0; kt < 5; ++kt) {
                int sk = tmax - r * (32 * kt + kperm); sk = sk < 0 ? 0 : sk;
                const bf16* kp = KD + (rowb + sk) * 768 + hh * 64 + hi * 8;
                bf16x8 kf[4];
#pragma unroll
                for (int d0 = 0; d0 < 4; ++d0) kf[d0] = *(const bf16x8*)(kp + d0 * 16);
                u32x4 vv[4];
#pragma unroll
                for (int i = 0; i < 4; ++i) { int sv = tmax - r * (32 * kt + 8 * i + (lane >> 3)); sv = sv < 0 ? 0 : sv; vv[i] = *(const u32x4*)(VD + (rowb + sv) * 768 + hh * 64 + (lane & 7) * 8); }
                const int dk = 32 * kt + 8 * hi - klo;
                const float tb = -sr * (float)dk;
                f32x16 p;
#pragma unroll
                for (int q = 0; q < 16; ++q) p[q] = tb - sr * (float)((q & 7) + 16 * (q >> 3));
#pragma unroll
                for (int d0 = 0; d0 < 4; ++d0) p = __builtin_amdgcn_mfma_f32_32x32x16_bf16(kf[d0], qf[d0], p, 0, 0, 0);
#pragma unroll
                for (int i = 0; i < 4; ++i) *(ALAS u32x4*)(wl + (8 * i + (lane >> 3)) * VPITCH + (lane & 7) * 16) = vv[i];
                float z2[16]; float mt = -3.0e38f;
#pragma unroll
                for (int q = 0; q < 16; ++q) { const bool valid = (unsigned)(dk + ((q & 7) + 16 * (q >> 3))) <= krange; z2[q] = valid ? p[q] : -INFINITY; mt = fmaxf(mt, z2[q]); }
                mt = fmaxf(mt, __shfl_xor(mt, 32));
                if (__any(mt > mrun + 8.0f)) {
                    const float mnew = fmaxf(mrun, mt); const float alpha = __builtin_amdgcn_exp2f(mrun - mnew);
                    lrun *= alpha; float al[16]; bcast_rows(alpha, sc, r32, hi, al);
#pragma unroll
                    for (int q = 0; q < 16; ++q) { o0[q] *= al[q]; o1[q] *= al[q]; }
                    mrun = mnew;
                }
                float a[16]; float ls = 0.f;
#pragma unroll
                for (int q = 0; q < 16; ++q) { a[q] = __builtin_amdgcn_exp2f(z2[q] - mrun); ls += a[q]; }
                lrun += ls;
                wave_lds_sync();
                pv_tile(o0, o1, a, wl, lane);
                wave_lds_sync();
            }
            const float ltot = lrun + __shfl_xor(lrun, 32);
            if (g != 0) {
                if (hi == 0) { ML[q0 + r * r32] = mrun; LL[q0 + r * r32] = ltot; }
#pragma unroll
                for (int q = 0; q < 16; ++q) { const int tl = q0 + r * crow(q, hi);
                    OL[tl * 64 + r32] = (unsigned short)(pkbf(o0[q], 0.f) & 0xffffu); OL[tl * 64 + 32 + r32] = (unsigned short)(pkbf(o1[q], 0.f) & 0xffffu); }
            } else {
                float il[16]; bcast_rows(1.0f / ltot, sc, r32, hi, il);
#pragma unroll
                for (int q = 0; q < 16; ++q) { o0[q] *= il[q]; o1[q] *= il[q]; }
                store_o(o0, o1, wl, OC + (rowb + t0 + q0) * 768 + 512 + j * 64, 768, lane);
            }
        }
        asm volatile("s_waitcnt lgkmcnt(0)" ::: "memory"); __builtin_amdgcn_s_barrier(); asm volatile("" ::: "memory");
    }
}
#undef ALAS
}

constexpr int NWAVES = 8;
#ifndef MK_N_LAUNCHES
#define MK_N_LAUNCHES 1
#endif
#ifndef MK_LAST_PHASE
#define MK_LAST_PHASE 8
#endif
constexpr int N_LAUNCHES = MK_N_LAUNCHES;
constexpr int PER_PHASE = 8;

constexpr int BATCH = 16, SEQ = 4096, D = 1024, T = BATCH * SEQ;
constexpr int N1 = 5888;
constexpr int NEXP = 16384;
constexpr size_t MiB = 1u << 20;
constexpr size_t WS_CTL = 0, CTL_ZERO_BYTES = 1 * MiB;
constexpr size_t WS_WIN = 2 * MiB;
constexpr size_t WS_WCAT = 16 * MiB;
constexpr size_t WS_WOUT = 18 * MiB;
constexpr size_t WS_WC = 20 * MiB;
constexpr size_t WS_RINV1 = 24 * MiB;
constexpr size_t WS_RINV2 = 25 * MiB;
constexpr size_t WS_USC = 25 * MiB + 512 * 1024, WS_VSC = 25 * MiB + 768 * 1024;
constexpr size_t WS_SSQ = 26 * MiB;
constexpr size_t WS_U8 = 32 * MiB;
constexpr size_t WS_V8 = 64 * MiB;
constexpr size_t WS_IDS = 96 * MiB;
constexpr size_t WS_GW = 112 * MiB;
constexpr size_t WS_XB = 144 * MiB;
constexpr size_t WS_QS = 272 * MiB, WS_KS = 336 * MiB, WS_VS = 400 * MiB;
constexpr size_t WS_QD = 464 * MiB, WS_KD = 560 * MiB, WS_VD = 656 * MiB;
constexpr size_t WS_GT = 752 * MiB;
constexpr size_t WS_COEF = 272 * MiB;
constexpr size_t WS_MIX = 272 * MiB;
constexpr size_t WS_X1B = 400 * MiB;
constexpr size_t WS_HQ = 528 * MiB;
constexpr size_t WS_HS2 = 24 * MiB + 512 * 1024;
constexpr size_t WS_END = 1008 * MiB;
constexpr int CW_BAR = 4096;
constexpr int CW_XRANK = 8192;

constexpr int RING_OFF = 0, RING_BYTES = 131072;
constexpr int LDSCTL_OFF = 143360, MISC_OFF = LDSCTL_OFF + 320;
constexpr int LDS_BYTES = 147456;
static_assert(MISC_OFF + 128 <= LDS_BYTES, "LDS map");
#define GAS __attribute__((address_space(1)))
#define LAS __attribute__((address_space(3)))
typedef unsigned short bf16;
typedef unsigned v4u __attribute__((ext_vector_type(4)));
typedef float f32x4 __attribute__((ext_vector_type(4)));
typedef short bf16x8 __attribute__((ext_vector_type(8)));
typedef GAS unsigned gu32;
typedef GAS unsigned long long gu64;
#define RLX_AGENT __ATOMIC_RELAXED, __HIP_MEMORY_SCOPE_AGENT
#define LDS_WAIT() asm volatile("s_waitcnt lgkmcnt(0)" ::: "memory")
#define VM_WAIT() asm volatile("s_waitcnt vmcnt(0)" ::: "memory")
__device__ __forceinline__ unsigned long long rt() { return __builtin_amdgcn_s_memrealtime(); }
__device__ __forceinline__ unsigned f2bf(float f) { unsigned u = __builtin_bit_cast(unsigned, f); return (u + 0x7fffu + ((u >> 16) & 1u)) >> 16; }
__device__ __forceinline__ unsigned pk2(float lo, float hi) { return f2bf(lo) | (f2bf(hi) << 16); }

#define XB_TMO      128
#define XB_XCNT(j)  (256  + 64 * (j))
#define XB_XSUB(j)  (1280 + 64 * (j))
#define XB_XGEN(j)  (2304 + 64 * (j))
#define XB_TOP      3328
#define XB_TOPGEN   3392
#define XCD_BAR_WORDS 3456
#define XB_SPIN_CAP (1u << 18)

__device__ __forceinline__ unsigned xb_ld(unsigned* p)              { return __hip_atomic_load(p, __ATOMIC_RELAXED, __HIP_MEMORY_SCOPE_AGENT); }
__device__ __forceinline__ unsigned xb_add(unsigned* p, unsigned v) { return __hip_atomic_fetch_add(p, v, __ATOMIC_RELAXED, __HIP_MEMORY_SCOPE_AGENT); }
__device__ __forceinline__ unsigned xb_xcc_id() { return (unsigned)__builtin_amdgcn_s_getreg((3 << 11) | 20) & 0xFu; }
#define XB_SPIN(cond, bar) do { unsigned _sp = 0; while (cond) { __builtin_amdgcn_s_sleep(1); \
    if ((++_sp & 255u) == 0u) { if (xb_ld(&(bar)[XB_TMO])) break; if (_sp > XB_SPIN_CAP) { atomicAdd(&(bar)[XB_TMO], 1u); break; } } } } while (0)

struct XcdBarrier {
    unsigned* bar; unsigned x;
    volatile LAS unsigned* st;
};

__device__ __forceinline__ XcdBarrier xcd_barrier_post(unsigned* bar, volatile LAS unsigned* st) {
    XcdBarrier b; b.bar = bar; b.x = xb_xcc_id(); b.st = st;
    if (threadIdx.x == 0) (void)xb_add(&bar[XB_XCNT(b.x)], 1u);
    return b;
}
__device__ __forceinline__ void xcd_barrier_complete(unsigned* bar, unsigned x, unsigned& nloc, unsigned& nx) {
    const unsigned G = gridDim.x * gridDim.y * gridDim.z;
    unsigned sum, cnt, mine, sp = 0u;
    for (;;) {
        sum = 0u; cnt = 0u; mine = 0u;
#pragma unroll
        for (unsigned j = 0; j < 16; ++j) { const unsigned c = xb_ld(&bar[XB_XCNT(j)]); sum += c; cnt += (c > 0u) ? 1u : 0u; mine = (j == x) ? c : mine; }
        if (sum == G) break;
        __builtin_amdgcn_s_sleep(1);
        if ((++sp & 255u) == 0u) { if (xb_ld(&bar[XB_TMO])) break; if (sp > XB_SPIN_CAP) { atomicAdd(&bar[XB_TMO], 1u); break; } }
    }
    nloc = mine > 0u ? mine : 1u; nx = cnt > 0u ? cnt : 1u;
}

__device__ __forceinline__ void xcd_barrier(const XcdBarrier& b) {
    asm volatile("s_waitcnt vmcnt(0)" ::: "memory");
    __syncthreads();
    if (threadIdx.x == 0) {
        unsigned* bar = b.bar;
        __builtin_amdgcn_s_waitcnt(0);
        unsigned nloc = b.st[0], nx = b.st[1];
        if (nloc == 0u) { xcd_barrier_complete(bar, b.x, nloc, nx); b.st[0] = nloc; b.st[1] = nx; }
        const unsigned old = xb_add(&bar[XB_XSUB(b.x)], 1u);
        const unsigned gen = old / nloc;
        if (old + 1u == (gen + 1u) * nloc) {
            __builtin_amdgcn_fence(__ATOMIC_RELEASE, "agent");
            asm volatile("s_waitcnt vmcnt(0)" ::: "memory");
            const unsigned og = xb_add(&bar[XB_TOP], 1u);
            const unsigned tg = og / nx;
            if (og + 1u == (tg + 1u) * nx) xb_add(&bar[XB_TOPGEN], 1u);
            else XB_SPIN(xb_ld(&bar[XB_TOPGEN]) == tg, bar);
            __builtin_amdgcn_fence(__ATOMIC_ACQUIRE, "agent");
            xb_add(&bar[XB_XGEN(b.x)], 1u);
            asm volatile("s_waitcnt vmcnt(0)" ::: "memory");
        } else {
            XB_SPIN(xb_ld(&bar[XB_XGEN(b.x)]) == gen, bar);
            __builtin_amdgcn_fence(__ATOMIC_ACQUIRE, "agent");
            asm volatile("s_waitcnt vmcnt(0)" ::: "memory");
        }
    }
    __syncthreads();
}

typedef float f32x2 __attribute__((ext_vector_type(2)));
typedef unsigned v2u __attribute__((ext_vector_type(2)));
struct Frame {
    LAS unsigned char* lds;
    volatile LAS unsigned* MISC;
    gu32* ctl;
    int tid, lane, wave;
    int vcu, G;
};
__device__ __forceinline__ float wave_sum(float v) {
#pragma unroll
    for (int o = 1; o < 64; o <<= 1) v += __shfl_xor(v, o);
    return v;
}
__device__ __forceinline__ float wave_max(float v) {
#pragma unroll
    for (int o = 1; o < 64; o <<= 1) v = fmaxf(v, __shfl_xor(v, o));
    return v;
}
__device__ __forceinline__ int win_row(int n) { if (n < 1536 || n >= 3072) return n; const int t = (n - 1536) >> 8, ln = (n - 1536) & 255, hl = ln >> 6, d = ln & 63; return 1536 + t * 256 + 32 * hl + (d & 31) + 128 * (d >> 5); }
__device__ __forceinline__ void p0_transpose_item(const float* W, int N, const float* gain, bf16* WT, int ldt, int koff, int mode, LAS float* scr, int item, int lane) {
    const int nblk = N / 32, kb = item / nblk, nb = item % nblk, k0 = 64 * kb, n0 = 32 * nb;
#pragma unroll 8
    for (int i = 0; i < 32; ++i) { const int kk = 2 * i + (lane >> 5); float v = W[(size_t)(k0 + kk) * N + n0 + (lane & 31)]; if (gain) v *= gain[k0 + kk]; scr[kk * 33 + (lane & 31)] = v; }
    LDS_WAIT(); asm volatile("" ::: "memory");
    const int c = lane & 7;
#pragma unroll
    for (int j = 0; j < 4; ++j) { const int n = (lane >> 3) + 8 * j; const LAS float* s = scr + (8 * c) * 33 + n;
        v4u o; o.x = pk2(s[0 * 33], s[1 * 33]); o.y = pk2(s[2 * 33], s[3 * 33]); o.z = pk2(s[4 * 33], s[5 * 33]); o.w = pk2(s[6 * 33], s[7 * 33]);
        const int rown = mode ? win_row(n0 + n) : (n0 + n);
        *(GAS v4u*)(WT + (size_t)rown * ldt + koff + k0 + 8 * c) = o; }
    LDS_WAIT(); asm volatile("" ::: "memory");
}
__device__ __forceinline__ void quant_row_fp8(const float* src, const float* gain, unsigned char* dst, size_t slice_stride, float* scale_out, int lane) {
    f32x4 v[4]; float am = 0.f;
#pragma unroll
    for (int j = 0; j < 4; ++j) { v[j] = *(const GAS f32x4*)(src + 256 * j + 4 * lane); if (gain) v[j] = v[j] * *(const GAS f32x4*)(gain + 256 * j + 4 * lane);
        am = fmaxf(am, fmaxf(fmaxf(fabsf(v[j][0]), fabsf(v[j][1])), fmaxf(fabsf(v[j][2]), fabsf(v[j][3])))); }
    am = wave_max(am);
    const int ex = (int)((__float_as_uint(am) >> 23) & 0xffu);
    const float s = (ex == 0) ? 1.0f : __uint_as_float((unsigned)(127 + 7 - (ex - 127)) << 23);
    const float is = (ex == 0) ? 1.0f : __uint_as_float((unsigned)(127 - 7 + (ex - 127)) << 23);
    if (lane == 0) *scale_out = is;
#pragma unroll
    for (int j = 0; j < 4; ++j) { int pk = __builtin_amdgcn_cvt_pk_fp8_f32(v[j][0] * s, v[j][1] * s, 0, false); pk = __builtin_amdgcn_cvt_pk_fp8_f32(v[j][2] * s, v[j][3] * s, pk, true);
        const int col = 256 * j + 4 * lane; *(GAS int*)(dst + (size_t)(col >> 7) * slice_stride + (col & 127)) = pk; }
}
__device__ __forceinline__ void quant_row_i8(const float* src, const float* gain, unsigned char* dst, float* scale_out, int lane) {
    f32x4 v[4]; float am = 0.f;
#pragma unroll
    for (int j = 0; j < 4; ++j) { v[j] = *(const GAS f32x4*)(src + 256 * j + 4 * lane); if (gain) v[j] = v[j] * *(const GAS f32x4*)(gain + 256 * j + 4 * lane);
        am = fmaxf(am, fmaxf(fmaxf(fabsf(v[j][0]), fabsf(v[j][1])), fmaxf(fabsf(v[j][2]), fabsf(v[j][3])))); }
    am = wave_max(am);
    const float s = am > 0.f ? 127.0f / am : 0.f;
    if (lane == 0) *scale_out = am * (1.0f / 127.0f);
#pragma unroll
    for (int j = 0; j < 4; ++j) { const int q0 = (int)__builtin_rintf(v[j][0] * s), q1 = (int)__builtin_rintf(v[j][1] * s), q2 = (int)__builtin_rintf(v[j][2] * s), q3 = (int)__builtin_rintf(v[j][3] * s);
        *(GAS int*)(dst + 256 * j + 4 * lane) = (q0 & 0xff) | ((q1 & 0xff) << 8) | ((q2 & 0xff) << 16) | (q3 << 24); }
}
__device__ __forceinline__ float gelu_f(float v) {
    const float av = fabsf(v), t = __builtin_amdgcn_rcpf(av * 0.2316418882f + 1.0f);
    float q = t * 0.5307027145f + (-0.7265760135f); q = q * t + 0.7107068705f; q = q * t + (-0.142248368f); q = q * t + 0.127414796f; q = q * t;
    const float e = __builtin_amdgcn_exp2f((v * v) * (-0.72134752044f));
    const float m = v * (q * e);
    return v < 0.f ? m : v - m;
}

struct Args { const float* in[14]; float* out; unsigned char* ws; int ph_lo, ph_hi, li, pad; };
__global__ void __launch_bounds__(NWAVES * 64, 2) fwd_kernel(Args args) {
    extern __shared__ __attribute__((aligned(16))) unsigned char lds[];
    Frame F;
    F.lds = (LAS unsigned char*)lds;
    F.MISC = (volatile LAS unsigned*)(F.lds + MISC_OFF);
    F.tid = threadIdx.x; F.lane = F.tid & 63; F.wave = __builtin_amdgcn_readfirstlane(F.tid >> 6);
    F.G = gridDim.x; { const int bx = blockIdx.x; F.vcu = (F.G % 8 == 0) ? (bx % 8) * (F.G / 8) + bx / 8 : bx; }
    unsigned char* ws = args.ws;
    F.ctl = (gu32*)(ws + WS_CTL);
    const float* x = args.in[0]; const float* norm1_gain = args.in[1]; const float* w_in = args.in[2]; const float* b_gate = args.in[3];
    const float* q_gain = args.in[4]; const float* k_gain = args.in[5]; const float* w_sb_out = args.in[6]; const float* w_dil_out = args.in[7];
    const float* w_out = args.in[8]; const float* norm2_gain = args.in[9]; const float* w_peer_q = args.in[10]; const float* sub_keys = args.in[11];
    const float* peer_u = args.in[12]; const float* peer_v = args.in[13];
    float* out = args.out;
    bf16* WIN = (bf16*)(ws + WS_WIN); bf16* WCAT = (bf16*)(ws + WS_WCAT); bf16* WOUT = (bf16*)(ws + WS_WOUT); bf16* WC = (bf16*)(ws + WS_WC);
    float* RINV1 = (float*)(ws + WS_RINV1); float* RINV2 = (float*)(ws + WS_RINV2); float* USC = (float*)(ws + WS_USC); float* VSC = (float*)(ws + WS_VSC); float* SSQ = (float*)(ws + WS_SSQ);
    unsigned char* U8 = ws + WS_U8; unsigned char* V8 = ws + WS_V8;
    unsigned short* IDS = (unsigned short*)(ws + WS_IDS); float* GW = (float*)(ws + WS_GW); float* COEF = (float*)(ws + WS_COEF); unsigned char* HQ = ws + WS_HQ; float* HS2 = (float*)(ws + WS_HS2);
    bf16* XB = (bf16*)(ws + WS_XB); bf16* OC = (bf16*)(ws + WS_XB);
    bf16* QS = (bf16*)(ws + WS_QS); bf16* KS = (bf16*)(ws + WS_KS); bf16* VS = (bf16*)(ws + WS_VS);
    bf16* QD = (bf16*)(ws + WS_QD); bf16* KD = (bf16*)(ws + WS_KD); bf16* VD = (bf16*)(ws + WS_VD);
    bf16* GT = (bf16*)(ws + WS_GT); bf16* MIX = (bf16*)(ws + WS_MIX); bf16* X1B = (bf16*)(ws + WS_X1B);

    for (int u = F.tid; u < (LDS_BYTES - LDSCTL_OFF) / 4; u += NWAVES * 64) ((LAS unsigned*)(F.lds + LDSCTL_OFF))[u] = 0u;
    __syncthreads();
    const int my_xcc = (int)xb_xcc_id();
    if (F.tid == 0) F.MISC[12] = xb_add((unsigned*)(F.ctl + CW_XRANK) + 64 * my_xcc, 1u);
    __syncthreads();
    const int my_xrank = (int)F.MISC[12];
    const int bli = (N_LAUNCHES == PER_PHASE) ? 0 : args.li;
    XcdBarrier bar; bar.bar = (unsigned*)(F.ctl + CW_BAR) + bli * XCD_BAR_WORDS; bar.x = 0; bar.st = nullptr;
    if (N_LAUNCHES != PER_PHASE) bar = xcd_barrier_post((unsigned*)(F.ctl + CW_BAR) + bli * XCD_BAR_WORDS, F.MISC + 8);
    const int lo = args.ph_lo, hi = args.ph_hi;
#ifndef PHASE_MASK
#define PHASE_MASK 0xff
#endif
#define IN(k) (((PHASE_MASK >> (k)) & 1) && lo <= (k) && (k) < hi)
#define BOTH(k) (IN(k) && IN((k) + 1))
#define GRID_BAR() do { if (N_LAUNCHES != PER_PHASE) xcd_barrier(bar); } while (0)
#ifndef PROBE_REPEAT
#define PROBE_REPEAT 0x00
#endif
#ifndef PROBE_L1
#define PROBE_L1 0x0
#endif
#define REP(k) _Pragma("unroll") for (int rep_ = 0; rep_ < (((PROBE_REPEAT >> (k)) & 1) ? 2 : 1); ++rep_)
    const int gw = F.vcu * NWAVES + F.wave, NGW = F.G * NWAVES;
#define P67_MAP() int vx = (int)(blockIdx.x & 7), rk = (int)(blockIdx.x >> 3), nrk = (F.G + 7 - vx) / 8; \
        { bool uni_ = (F.G % 8 == 0); for (int j_ = 0; j_ < 16; ++j_) { const unsigned c_ = xb_ld((unsigned*)(F.ctl + CW_XRANK) + 64 * j_); uni_ = uni_ && (c_ == (j_ < 8 ? (unsigned)(F.G / 8) : 0u)); } \
          if (uni_) { vx = my_xcc; rk = my_xrank; nrk = F.G / 8; } }

    if (IN(0)) REP(0) {
        for (int it = F.vcu; it < 256; it += F.G) {
            const int hp = it >> 4, d0 = (it & 15) * 64;
            LAS float* As = (LAS float*)(F.lds);
            LAS float* Bs = (LAS float*)(F.lds + 64 * 132 * 4);
            for (int e = F.tid; e < 64 * 32; e += 512) { const int r = e >> 5, c4 = (e & 31) * 4; *(LAS f32x4*)(As + r * 132 + c4) = *(const GAS f32x4*)(w_peer_q + (size_t)(d0 + r) * 2048 + hp * 128 + c4); }
            for (int e = F.tid; e < 128 * 32; e += 512) { const int r = e >> 5, c4 = (e & 31) * 4; *(LAS f32x4*)(Bs + r * 132 + c4) = *(const GAS f32x4*)(sub_keys + ((size_t)hp * 128 + r) * 128 + c4); }
            __syncthreads();
            const int ddg = F.tid & 15, ng = F.tid >> 4;
            f32x4 acc[4];
#pragma unroll
            for (int j = 0; j < 4; ++j) acc[j] = (f32x4){0.f, 0.f, 0.f, 0.f};
            for (int c4 = 0; c4 < 128; c4 += 4) {
                f32x4 a[4], b[4];
#pragma unroll
                for (int i = 0; i < 4; ++i) { a[i] = *(const LAS f32x4*)(As + (4 * ddg + i) * 132 + c4); b[i] = *(const LAS f32x4*)(Bs + (4 * ng + i) * 132 + c4); }
#pragma unroll
                for (int j = 0; j < 4; ++j)
#pragma unroll
                    for (int i = 0; i < 4; ++i) acc[j][i] += (a[i][0] * b[j][0] + a[i][1] * b[j][1]) + (a[i][2] * b[j][2] + a[i][3] * b[j][3]);
            }
            const f32x4 g2 = *(const GAS f32x4*)(norm2_gain + d0 + 4 * ddg);
#pragma unroll
            for (int j = 0; j < 4; ++j) { v2u o; o.x = pk2(acc[j][0] * g2[0], acc[j][1] * g2[1]); o.y = pk2(acc[j][2] * g2[2], acc[j][3] * g2[3]);
                *(GAS v2u*)(WC + (size_t)(hp * 128 + 4 * ng + j) * 1024 + d0 + 4 * ddg) = o; }
            __syncthreads();
        }
        {
            LAS float* scr = (LAS float*)(F.lds + RING_OFF + F.wave * 16384);
            constexpr int I_IN = (D / 64) * (N1 / 32), I_SB = (512 / 64) * (D / 32), I_DL = (256 / 64) * (D / 32), I_OUT = (D / 64) * (D / 32);
            constexpr int NITEMS = I_IN + I_SB + I_DL + I_OUT;
            for (int it = gw; it < NITEMS; it += NGW) {
                int r = it;
                if (r < I_IN) { p0_transpose_item(w_in, N1, norm1_gain, WIN, 1024, 0, 1, scr, r, F.lane); continue; } r -= I_IN;
                if (r < I_SB) { p0_transpose_item(w_sb_out, D, nullptr, WCAT, 768, 0, 0, scr, r, F.lane); continue; } r -= I_SB;
                if (r < I_DL) { p0_transpose_item(w_dil_out, D, nullptr, WCAT, 768, 512, 0, scr, r, F.lane); continue; } r -= I_DL;
                p0_transpose_item(w_out, D, nullptr, WOUT, 1024, 0, 0, scr, r, F.lane);
            }
        }
        for (int e = gw; e < 2 * NEXP; e += NGW) {
            if (e < NEXP) quant_row_i8(peer_u + (size_t)e * D, norm2_gain, U8 + (size_t)e * D, USC + e, F.lane);
            else { const int ev = e - NEXP; quant_row_fp8(peer_v + (size_t)ev * D, nullptr, V8 + (size_t)ev * 128, (size_t)NEXP * 128, VSC + ev, F.lane); }
        }
        for (int m = gw; m < T; m += NGW) {
            const GAS f32x4* xr = (const GAS f32x4*)(x + (size_t)m * D) + F.lane;
            f32x4 v[4]; float s = 0.f;
#pragma unroll
            for (int j = 0; j < 4; ++j) { v[j] = xr[64 * j]; s += (v[j][0] * v[j][0] + v[j][1] * v[j][1]) + (v[j][2] * v[j][2] + v[j][3] * v[j][3]); }
            s = wave_sum(s);
            const float rn = __builtin_amdgcn_rsqf(s * (1.0f / D) + 1e-6f);
            GAS unsigned long long* o8 = (GAS unsigned long long*)(XB + (size_t)m * D) + F.lane;
#pragma unroll
            for (int j = 0; j < 4; ++j) o8[64 * j] = (unsigned long long)pk2(v[j][0] * rn, v[j][1] * rn) | ((unsigned long long)pk2(v[j][2] * rn, v[j][3] * rn) << 32);
        }
        if (BOTH(0)) GRID_BAR();
    }

    if (IN(1)) REP(1) {
        pg8::Gemm g{XB, WIN, T, N1, D}; pg8::StaticOrder S; S.init(T, N1, F.G, (int)blockIdx.x);
        pg8::Epi1 E{RINV1, b_gate, q_gain, k_gain, QS, KS, VS, QD, KD, VD, GT};
        pg8::gemm_phase<pg8::Epi1, pg8::StaticOrder, true, true>(F.lds + RING_OFF, g, S, E);
        if (BOTH(1)) GRID_BAR();
    }

    if (IN(2)) REP(2) {
        LAS unsigned char* wl = F.lds + RING_OFF + F.wave * 16384;
        static_assert(att::DLU_BYTES <= RING_BYTES, "dilated-attention LDS state");
        for (int un = F.vcu; un < 512; un += F.G) { const int blk = un & 7, j = (un >> 3) & 3, b = un >> 5; att::dl_unit(QD, KD, VD, OC, b, j, blk, F.lds + RING_OFF, F.wave, F.lane); }
        for (int it = gw; it < 16384; it += NGW) { const int qt = 127 - (it & 127), h = (it >> 7) & 7, b = it >> 10; att::sb_item(QS, KS, VS, OC, b, h, qt, wl, F.lane); }
        if (BOTH(2)) GRID_BAR();
    }

    if (IN(3)) REP(3) {
        pg8::Gemm g{OC, WCAT, T, D, 768}; pg8::StaticOrder S; S.init(T, D, F.G, (int)blockIdx.x);
        pg8::Epi2 E{GT, MIX};
        pg8::gemm_phase<pg8::Epi2, pg8::StaticOrder, true, true>(F.lds + RING_OFF, g, S, E);
        if (BOTH(3)) GRID_BAR();
    }

    if (IN(4)) REP(4) {
        pg8::Gemm g{MIX, WOUT, T, D, D}; pg8::StaticOrder S; S.init(T, D, F.G, (int)blockIdx.x);
        pg8::Epi3 E{x, X1B, SSQ};
        pg8::gemm_phase<pg8::Epi3, pg8::StaticOrder, true, true>(F.lds + RING_OFF, g, S, E);
        if (BOTH(4)) GRID_BAR();
    }

    if (IN(5)) REP(5) {
        for (int m = gw; m < T; m += NGW) {
            const v4u a = *(const GAS v4u*)(X1B + (size_t)m * D + 8 * F.lane), b = *(const GAS v4u*)(X1B + (size_t)m * D + 512 + 8 * F.lane);
            float v[16] = {pg8::bflo(a.x), pg8::bfhi(a.x), pg8::bflo(a.y), pg8::bfhi(a.y), pg8::bflo(a.z), pg8::bfhi(a.z), pg8::bflo(a.w), pg8::bfhi(a.w),
                           pg8::bflo(b.x), pg8::bfhi(b.x), pg8::bflo(b.y), pg8::bfhi(b.y), pg8::bflo(b.z), pg8::bfhi(b.z), pg8::bflo(b.w), pg8::bfhi(b.w)};
            float am = 0.f;
#pragma unroll
            for (int i = 0; i < 16; ++i) am = fmaxf(am, fabsf(v[i]));
            am = wave_max(am);
            float sq = (F.lane < 16) ? SSQ[(size_t)m * 16 + F.lane] : 0.f; sq = wave_sum(sq);
            const float s = am > 0.f ? 127.0f / am : 0.f;
            if (F.lane == 0) HS2[m] = am * (1.0f / 127.0f) * __builtin_amdgcn_rsqf(sq * (1.0f / 1024.0f) + 1e-6f);
            int q[16];
#pragma unroll
            for (int i = 0; i < 16; ++i) q[i] = (int)__builtin_rintf(v[i] * s) & 0xff;
            v2u o0, o1; o0.x = q[0] | (q[1] << 8) | (q[2] << 16) | (q[3] << 24); o0.y = q[4] | (q[5] << 8) | (q[6] << 16) | (q[7] << 24);
            o1.x = q[8] | (q[9] << 8) | (q[10] << 16) | (q[11] << 24); o1.y = q[12] | (q[13] << 8) | (q[14] << 16) | (q[15] << 24);
            *(GAS v2u*)(HQ + (size_t)m * D + 8 * F.lane) = o0; *(GAS v2u*)(HQ + (size_t)m * D + 512 + 8 * F.lane) = o1;
        }
        pg8::Gemm g{X1B, WC, T, 2048, D}; pg8::StaticOrder S; S.init(T, 2048, F.G, (int)blockIdx.x);
        pg8::Epi4 E{SSQ, RINV2, IDS, GW};
        pg8::OneUnit O1;
        for (int i = 0; S.next(i, O1.u); ++i) pg8::gemm_phase<pg8::Epi4, pg8::OneUnit, false, true>(F.lds + RING_OFF, g, O1, E);
        if (BOTH(5)) GRID_BAR();
    }

    if (IN(6)) REP(6) {
        P67_MAP();
        const int p16 = F.lane & 15, sg = F.lane >> 4;
        LAS unsigned char* HB = F.lds + RING_OFF;
        LAS unsigned* LIST = (LAS unsigned*)(F.lds + RING_OFF + 65536);
        LAS unsigned* CNT = (LAS unsigned*)(F.lds + RING_OFF + 98304);
        LAS float* HSs = (LAS float*)(F.lds + RING_OFF + 98304 + 256);
        const int nblk = T / 64;
        const int gsel = (F.lane & 15), bpsrc = (16 * (F.lane & 3) + ((F.lane >> 2) & 3)) * 4;
        v4u hpre[8], idpre[2]; float hspre = 0.f;
#define P6_PRE(bb) do { const int bc_ = (bb) < nblk ? (bb) : nblk - 1; const unsigned char* hsrc_ = HQ + (size_t)bc_ * 65536; \
            _Pragma("unroll") for (int i_ = 0; i_ < 8; ++i_) hpre[i_] = *(const GAS v4u*)(hsrc_ + (size_t)(i_ * 512 + F.tid) * 16); \
            const unsigned short* isrc_ = IDS + ((size_t)bc_ * 64 + (F.tid >> 3)) * 128 + 16 * (F.tid & 7); idpre[0] = *(const GAS v4u*)isrc_; idpre[1] = *(const GAS v4u*)(isrc_ + 8); \
            hspre = HS2[(size_t)bc_ * 64 + (F.tid & 63)]; } while (0)
        int blk = rk;
        P6_PRE(blk);
        for (; blk < nblk; blk += nrk) {
            const int t0 = blk * 64;
            if (F.tid == 0) *CNT = 0u;
            if (F.tid < 64) HSs[F.tid] = hspre;
#pragma unroll
            for (int i = 0; i < 8; ++i) *(LAS v4u*)(HB + (size_t)(i * 512 + F.tid) * 16) = hpre[i];
            __syncthreads();
            { const unsigned idw[8] = {idpre[0].x, idpre[0].y, idpre[0].z, idpre[0].w, idpre[1].x, idpre[1].y, idpre[1].z, idpre[1].w};
              const unsigned tl = (unsigned)(F.tid >> 3), kb0 = 16u * (unsigned)(F.tid & 7);
#pragma unroll
              for (int i = 0; i < 16; ++i) { const unsigned e = (i & 1) ? (idw[i >> 1] >> 16) : (idw[i >> 1] & 0xffffu);
                  if ((int)(e >> 11) == vx) { const unsigned pos = __hip_atomic_fetch_add(CNT, 1u, __ATOMIC_RELAXED, __HIP_MEMORY_SCOPE_WORKGROUP); LIST[pos] = (tl << 24) | ((kb0 + (unsigned)i) << 16) | e; } } }
            __syncthreads();
            const int n = (int)*CNT;
            P6_PRE(blk + nrk);
#define P6_ISSUE(W, ENT, EJ, GB, UB, VB, base_) do { \
                _Pragma("unroll") for (int g_ = 0; g_ < 4; ++g_) { const int j_ = (base_) + 4 * g_ + sg; ENT[g_] = LIST[j_ < n ? j_ : n - 1]; } \
                { const int j_ = (base_) + gsel; EJ = (j_ < n && F.lane < 16) ? (int)LIST[j_] : -1; } \
                _Pragma("unroll") for (int g_ = 0; g_ < 4; ++g_) { const unsigned char* up_ = U8 + (size_t)((PROBE_L1 && rep_) ? 0u : (ENT[g_] & 0xffffu)) * D + 16 * p16; \
                    _Pragma("unroll") for (int i_ = 0; i_ < 4; ++i_) W[g_][i_] = *(const GAS v4u*)(up_ + 256 * i_); } \
                { const unsigned ej_ = EJ < 0 ? LIST[0] : (unsigned)EJ; GB = GW[((size_t)t0 + (ej_ >> 24)) * 128 + ((ej_ >> 16) & 127u)]; UB = USC[ej_ & 0xffffu]; VB = VSC[ej_ & 0xffffu]; } } while (0)
#define P6_DPPADD(a_, ctrl) a_ += __builtin_amdgcn_update_dpp(0, a_, ctrl, 0xf, 0xf, false)
#define P6_REDUCE(W, ENT, EJ, GB, UB, VB, base_) do { if ((base_) < n) { int ag_[4]; \
                _Pragma("unroll") for (int g_ = 0; g_ < 4; ++g_) { const LAS unsigned char* hp_ = HB + (size_t)(ENT[g_] >> 24) * 1024 + 16 * p16; int a_ = 0; \
                    _Pragma("unroll") for (int i_ = 0; i_ < 4; ++i_) { const v4u h_ = *(const LAS v4u*)(hp_ + 256 * i_); \
                        a_ = __builtin_amdgcn_sdot4((int)W[g_][i_].x, (int)h_.x, a_, false); a_ = __builtin_amdgcn_sdot4((int)W[g_][i_].y, (int)h_.y, a_, false); \
                        a_ = __builtin_amdgcn_sdot4((int)W[g_][i_].z, (int)h_.z, a_, false); a_ = __builtin_amdgcn_sdot4((int)W[g_][i_].w, (int)h_.w, a_, false); } \
                    P6_DPPADD(a_, 0xB1); P6_DPPADD(a_, 0x4E); P6_DPPADD(a_, 0x141); P6_DPPADD(a_, 0x140); ag_[g_] = a_; } \
                const int sel_ = gsel == 0 ? ag_[0] : gsel == 1 ? ag_[1] : gsel == 2 ? ag_[2] : ag_[3]; \
                const float resv_ = (float)__builtin_amdgcn_ds_bpermute(bpsrc, sel_); \
                if (EJ >= 0 && !(PROBE_L1 && rep_)) { const unsigned ej_ = (unsigned)EJ; const float act_ = gelu_f(resv_ * UB * HSs[ej_ >> 24]); \
                    COEF[((size_t)t0 + (ej_ >> 24)) * 128 + ((ej_ >> 16) & 127u)] = GB * act_ * VB; } } } while (0)
            for (int base = F.wave * 32; base < n; base += NWAVES * 32) {
                v4u wA[4][4], wB[4][4]; unsigned entA[4], entB[4]; int ejA, ejB; float gbA, ubA, vbA, gbB, ubB, vbB;
                P6_ISSUE(wA, entA, ejA, gbA, ubA, vbA, base);
                P6_ISSUE(wB, entB, ejB, gbB, ubB, vbB, base + 16);
                P6_REDUCE(wA, entA, ejA, gbA, ubA, vbA, base);
                P6_REDUCE(wB, entB, ejB, gbB, ubB, vbB, base + 16);
            }
#undef P6_ISSUE
#undef P6_REDUCE
#undef P6_DPPADD
            __syncthreads();
        }
#undef P6_PRE
        if (BOTH(6)) GRID_BAR();
    }

    if (IN(7)) REP(7) {
        P67_MAP();
        const int l8 = F.lane & 7, kg = F.lane >> 3;
        const unsigned char* vbase = V8 + (size_t)vx * NEXP * 128 + 16 * l8;
        const int tstep = nrk * NWAVES;
        const int col = 128 * vx + 16 * l8 + ((F.lane & 8) ? 8 : 0) + ((F.lane & 16) ? 4 : 0) + ((F.lane & 32) ? 2 : 0);
#define P7_CL(tt) ((tt) < T ? (tt) : T - 1)
#define P7_IDS(tt, ID) do { const int tc_ = P7_CL(tt); ID[0] = *(const GAS v4u*)(IDS + (size_t)tc_ * 128 + 16 * kg); ID[1] = *(const GAS v4u*)(IDS + (size_t)tc_ * 128 + 16 * kg + 8); } while (0)
#define P7_ISSUE(tt, ID, W, CF, OO) do { const int tc_ = P7_CL(tt); const unsigned idw_[8] = {ID[0].x, ID[0].y, ID[0].z, ID[0].w, ID[1].x, ID[1].y, ID[1].z, ID[1].w}; \
            _Pragma("unroll") for (int i_ = 0; i_ < 16; ++i_) { const unsigned e_ = (i_ & 1) ? (idw_[i_ >> 1] >> 16) : (idw_[i_ >> 1] & 0xffffu); W[i_] = *(const GAS v4u*)(vbase + (size_t)((PROBE_L1 && rep_) ? 0u : e_) * 128); } \
            _Pragma("unroll") for (int i_ = 0; i_ < 4; ++i_) CF[i_] = *(const GAS f32x4*)(COEF + (size_t)tc_ * 128 + 16 * kg + 4 * i_); \
            OO = *(const GAS unsigned*)(X1B + (size_t)tc_ * D + col); } while (0)
#define P7_FMAC(a_, b_, c_) asm("v_fmac_f32_e32 %0, %1, %2" : "+v"(a_) : "v"(b_), "v"(c_))
#define P7_COMPUTE(tt, W, CF, OO) do { float acc_[16]; \
            _Pragma("unroll") for (int i_ = 0; i_ < 16; ++i_) acc_[i_] = 0.f; \
            _Pragma("unroll") for (int i_ = 0; i_ < 16; ++i_) { const unsigned ww_[4] = {W[i_].x, W[i_].y, W[i_].z, W[i_].w}; const float c1_ = CF[i_ >> 2][i_ & 3]; \
                _Pragma("unroll") for (int d_ = 0; d_ < 4; ++d_) { const f32x2 lo_ = __builtin_amdgcn_cvt_pk_f32_fp8((int)ww_[d_], false), hi_ = __builtin_amdgcn_cvt_pk_f32_fp8((int)ww_[d_], true); \
                    const float x0_ = lo_[0], x1_ = lo_[1], x2_ = hi_[0], x3_ = hi_[1]; \
                    P7_FMAC(acc_[4 * d_], c1_, x0_); P7_FMAC(acc_[4 * d_ + 1], c1_, x1_); P7_FMAC(acc_[4 * d_ + 2], c1_, x2_); P7_FMAC(acc_[4 * d_ + 3], c1_, x3_); } } \
            float r8_[8], r4_[4], r2_[2]; \
            { const bool up_ = (F.lane & 8) != 0; _Pragma("unroll") for (int i_ = 0; i_ < 8; ++i_) { const float keep_ = up_ ? acc_[8 + i_] : acc_[i_], send_ = up_ ? acc_[i_] : acc_[8 + i_]; r8_[i_] = keep_ + __shfl_xor(send_, 8); } } \
            { const bool up_ = (F.lane & 16) != 0; _Pragma("unroll") for (int i_ = 0; i_ < 4; ++i_) { const float keep_ = up_ ? r8_[4 + i_] : r8_[i_], send_ = up_ ? r8_[i_] : r8_[4 + i_]; r4_[i_] = keep_ + __shfl_xor(send_, 16); } } \
            { const bool up_ = (F.lane & 32) != 0; _Pragma("unroll") for (int i_ = 0; i_ < 2; ++i_) { const float keep_ = up_ ? r4_[2 + i_] : r4_[i_], send_ = up_ ? r4_[i_] : r4_[2 + i_]; r2_[i_] = keep_ + __shfl_xor(send_, 32); } } \
            if ((tt) < T && rep_ == 0) *(GAS f32x2*)(out + (size_t)(tt) * D + col) = (f32x2){pg8::bflo(OO) + r2_[0], pg8::bfhi(OO) + r2_[1]}; } while (0)
        v4u idA[2], idB[2], wA[16], wB[16]; f32x4 cfA[4], cfB[4]; unsigned ooA, ooB;
        int t = rk * NWAVES + F.wave;
        P7_IDS(t, idA); P7_IDS(t + tstep, idB);
        while (t < T) {
            P7_ISSUE(t, idA, wA, cfA, ooA); P7_ISSUE(t + tstep, idB, wB, cfB, ooB);
            P7_IDS(t + 2 * tstep, idA); P7_IDS(t + 3 * tstep, idB);
            P7_COMPUTE(t, wA, cfA, ooA);
            P7_COMPUTE(t + tstep, wB, cfB, ooB);
            t += 2 * tstep;
        }
#undef P7_CL
#undef P7_IDS
#undef P7_ISSUE
#undef P7_FMAC
#undef P7_COMPUTE
    }
#undef IN
#undef BOTH
#undef GRID_BAR
}

extern "C" void kernel_launch(void* const* d_in, const int* in_sizes, int n_in, void* d_out, int out_size, void* d_ws, size_t ws_size, hipStream_t stream) {
    static int grid = 0;
    if (grid == 0) {
        if (n_in != 14 || in_sizes[0] != T * D || out_size != T * D || ws_size < WS_END) { fprintf(stderr, "kernel_launch: built for 14 inputs, x and out of %d floats, >= %zu bytes of workspace; got n_in %d, in0 %d, out %d, ws %zu; nothing launched\n", T * D, (size_t)WS_END, n_in, n_in > 0 ? in_sizes[0] : -1, out_size, ws_size); grid = -1; return; }
        int dev = 0, cus = 0, per_cu = 0;
        if (hipGetDevice(&dev) != hipSuccess || hipDeviceGetAttribute(&cus, hipDeviceAttributeMultiprocessorCount, dev) != hipSuccess) { fprintf(stderr, "kernel_launch: hipGetDevice / hipDeviceGetAttribute failed\n"); grid = -1; return; }
        if (hipFuncSetAttribute((const void*)fwd_kernel, hipFuncAttributeMaxDynamicSharedMemorySize, LDS_BYTES) != hipSuccess) { fprintf(stderr, "kernel_launch: hipFuncSetAttribute failed\n"); grid = -1; return; }
        if (hipOccupancyMaxActiveBlocksPerMultiprocessor(&per_cu, (const void*)fwd_kernel, NWAVES * 64, LDS_BYTES) != hipSuccess || per_cu < 1)
            fprintf(stderr, "kernel_launch: note: occupancy query reports %d workgroups per CU\n", per_cu);
        (void)hipGetLastError();
        grid = cus;
    }
    if (grid < 0) return;
    if (hipMemsetAsync((char*)d_ws + WS_CTL, 0, CTL_ZERO_BYTES, stream) != hipSuccess) { fprintf(stderr, "kernel_launch: hipMemsetAsync failed\n"); return; }
    Args a{};
    for (int i = 0; i < 14; ++i) a.in[i] = (const float*)d_in[i];
    a.out = (float*)d_out; a.ws = (unsigned char*)d_ws;
    for (int li = 0; li < N_LAUNCHES; ++li) {
        a.ph_lo = (N_LAUNCHES == PER_PHASE) ? li : 0; a.ph_hi = (N_LAUNCHES == PER_PHASE) ? li + 1 : MK_LAST_PHASE; a.li = li;
        if (a.ph_lo >= MK_LAST_PHASE) break;
        hipLaunchKernelGGL(fwd_kernel, dim3(grid), dim3(NWAVES * 64), LDS_BYTES, stream, a);
        const hipError_t le = hipPeekAtLastError();
        if (le != hipSuccess) { fprintf(stderr, "kernel_launch: launch %d failed: %s\n", li, hipGetErrorName(le)); break; }
    }
}
```

```cpp
#include <hip/hip_runtime.h>
#include <cstdio>
#include <cstdint>
namespace pg8 {
#define PG8_LAS __attribute__((address_space(3)))
typedef unsigned short bf16_t;
typedef short bf16x8 __attribute__((ext_vector_type(8)));
typedef float f32x4 __attribute__((ext_vector_type(4)));
typedef unsigned u32x4 __attribute__((ext_vector_type(4)));
constexpr int BM = 256, BK = 64, HALF = 128, HTB = HALF * BK * 2  , STAGE_BYTES = 8 * HTB, NXCD = 8, WGM = 8;

__host__ __device__ __forceinline__ int lds_byte(int r, int c) { const int st = (r >> 4) * 2 + (c >> 5), rr = r & 15, cc = c & 31, ob = rr * 64 + cc * 2; return st * 1024 + (ob ^ (((ob >> 9) & 1) << 5)); }
__host__ __device__ __forceinline__ void stage_rc(int b, int& R, int& C) { const int st = b / 1024, sb = b % 1024, swz = sb ^ (((sb >> 9) & 1) << 5); R = (st >> 1) * 16 + swz / 64; C = (st & 1) * 32 + (swz % 64) / 2; }
__host__ __device__ __forceinline__ int perm32(int rho) { const int n = rho >> 4, i = rho & 15; return 8 * (i >> 2) + 4 * n + (i & 3); }

struct Unit { int pm, pn; };
struct Gemm { const bf16_t* A; const bf16_t* Bt; int M, N, K; };

struct StaticOrder {
    int nM, nN, nwg, G, c;
    __host__ __device__ void init(int M, int N, int G_, int c_) { nM = M / BM; nN = N / BM; nwg = nM * nN; G = G_; c = c_; }
    __host__ __device__ bool next(int i, Unit& u) const {
        const long L = (long)i * G + c; if (L >= nwg) return false;
        int wgid = (int)L; { const int q = nwg / NXCD, r = nwg % NXCD, xcd = wgid % NXCD, off = wgid / NXCD; wgid = (xcd < r ? xcd * (q + 1) : r * (q + 1) + (xcd - r) * q) + off; }
        const int nig = WGM * nN, gid = wgid / nig, fm = gid * WGM, gsz = (nM - fm) < WGM ? (nM - fm) : WGM;
        u.pm = fm + ((wgid % nig) % gsz); u.pn = (wgid % nig) / gsz; return true;
    }
    __device__ __forceinline__ void a_ready(const Unit&) const {}
    __device__ __forceinline__ void done(const Unit&) const {}
};


struct OneUnit {
    Unit u;
    __device__ __forceinline__ bool next(int i, Unit& o) const { if (i != 0) return false; o = u; return true; }
    __device__ __forceinline__ void a_ready(const Unit&) const {}
    __device__ __forceinline__ void done(const Unit&) const {}
};

typedef float f32x2 __attribute__((ext_vector_type(2)));
typedef __bf16 bf16x2_t __attribute__((ext_vector_type(2)));
typedef unsigned u32x2 __attribute__((ext_vector_type(2)));
__device__ __forceinline__ unsigned pkbf(float lo, float hi) { f32x2 v = {lo, hi}; bf16x2_t b = __builtin_convertvector(v, bf16x2_t); return __builtin_bit_cast(unsigned, b); }
__device__ __forceinline__ float bflo(unsigned w) { return __uint_as_float(w << 16); }
__device__ __forceinline__ float bfhi(unsigned w) { return __uint_as_float(w & 0xffff0000u); }
__device__ __forceinline__ u32x4 pack8(const f32x4 a, const f32x4 b) { u32x4 w; w.x = pkbf(a[0], a[1]); w.y = pkbf(a[2], a[3]); w.z = pkbf(b[0], b[1]); w.w = pkbf(b[2], b[3]); return w; }
constexpr float QSCALE = 0.125f * 1.4426950408889634f;
__device__ __forceinline__ float sigmoidf_(float v) { return __builtin_amdgcn_rcpf(1.0f + __builtin_amdgcn_exp2f(-1.4426950408889634f * v)); }

struct Epi1 {
    static constexpr bool PERM = true, AFTER_DRAIN = false, HAS_MID = false; static constexpr int MID_T = -1;
    const float* rinv; const float* bgate; const float* qg; const float* kg;
    bf16_t *QS, *KS, *VS, *QD, *KD, *VD, *GT;
    __device__ __forceinline__ void mid(f32x4 (&)[2][2][4][2], const Unit&, int, int, int, int) const {}
    __device__ __forceinline__ void operator()(const f32x4 (&acc)[2][2][4][2], const Unit& u, int wr, int wc, int fr, int fq) const {
        asm volatile("" : "+v"(fr), "+v"(fq));
        const int pn = u.pn; const int row0 = u.pm * BM + wr * 64 + fr;
        if (pn >= 6 && pn < 12) {
            const bool isK = pn >= 9; const int head = (isK ? pn - 9 : pn - 6) * 4 + wc;
            const float* g = (isK ? kg : qg) + head * 64 + 8 * fq;
            f32x4 gv[2][2]; const float qsc = isK ? 1.0f : QSCALE;
#pragma unroll
            for (int bj = 0; bj < 2; ++bj)
#pragma unroll
                for (int n = 0; n < 2; ++n) gv[bj][n] = *(const f32x4*)(g + 32 * bj + 4 * n) * qsc;
            bf16_t* base = (isK ? KD : QD) + head * 64 + 8 * fq;
#pragma unroll
            for (int ai = 0; ai < 2; ++ai)
#pragma unroll
                for (int m = 0; m < 4; ++m) { const int row = row0 + ai * HALF + m * 16; const float r = 1.0f;
                    f32x4 v[2][2]; float ss = 0.f;
#pragma unroll
                    for (int bj = 0; bj < 2; ++bj)
#pragma unroll
                        for (int n = 0; n < 2; ++n) { v[bj][n] = acc[ai][bj][m][n] * r; const f32x4 q = v[bj][n] * v[bj][n]; ss += (q[0] + q[1]) + (q[2] + q[3]); }
                    ss += __shfl_xor(ss, 16); ss += __shfl_xor(ss, 32);
                    const float sc = __builtin_amdgcn_rsqf(ss * (1.0f / 64.0f) + 1e-6f);
#pragma unroll
                    for (int bj = 0; bj < 2; ++bj) *(u32x4*)(base + (size_t)row * 768 + 32 * bj) = pack8(v[bj][0] * sc * gv[bj][0], v[bj][1] * sc * gv[bj][1]);
                }
        } else if (pn < 15) {
            bf16_t* base; int ld, colt;
            if (pn < 2) { base = QS; ld = 512; colt = pn * 256; } else if (pn < 4) { base = KS; ld = 512; colt = (pn - 2) * 256; } else if (pn < 6) { base = VS; ld = 512; colt = (pn - 4) * 256; } else { base = VD; ld = 768; colt = (pn - 12) * 256; }
            base += colt + wc * 32 + 8 * fq;
#pragma unroll
            for (int ai = 0; ai < 2; ++ai)
#pragma unroll
                for (int m = 0; m < 4; ++m) { const int row = row0 + ai * HALF + m * 16; const float r = (pn < 2 ? QSCALE : 1.0f);
#pragma unroll
                    for (int bj = 0; bj < 2; ++bj) *(u32x4*)(base + (size_t)row * ld + bj * HALF) = pack8(acc[ai][bj][m][0] * r, acc[ai][bj][m][1] * r);
                }
        } else {
            const int col0 = (pn - 15) * 256 + wc * 32 + 8 * fq;
            f32x4 bv[2][2];
#pragma unroll
            for (int bj = 0; bj < 2; ++bj)
#pragma unroll
                for (int n = 0; n < 2; ++n) bv[bj][n] = *(const f32x4*)(bgate + col0 + bj * HALF + 4 * n);
#pragma unroll
            for (int ai = 0; ai < 2; ++ai)
#pragma unroll
                for (int m = 0; m < 4; ++m) { const int row = row0 + ai * HALF + m * 16; const float r = 1.0f;
#pragma unroll
                    for (int bj = 0; bj < 2; ++bj) { f32x4 a = acc[ai][bj][m][0] * r + bv[bj][0], b = acc[ai][bj][m][1] * r + bv[bj][1];
#pragma unroll
                        for (int e = 0; e < 4; ++e) { a[e] = sigmoidf_(a[e]); b[e] = sigmoidf_(b[e]); }
                        *(u32x4*)(GT + (size_t)row * 2048 + col0 + bj * HALF) = pack8(a, b); }
                }
        }
    }
};

struct Epi2 {
    static constexpr bool PERM = true, AFTER_DRAIN = false, HAS_MID = true; static constexpr int MID_T = 8;
    const bf16_t* GT; bf16_t* MIX;
    __device__ __forceinline__ void mid(f32x4 (&acc)[2][2][4][2], const Unit& u, int wr, int wc, int fr, int fq) const {
        asm volatile("" : "+v"(fr), "+v"(fq));
        const int row0 = u.pm * BM + wr * 64 + fr, col0 = u.pn * BM + wc * 32 + 8 * fq;
#pragma unroll
        for (int ai = 0; ai < 2; ++ai)
#pragma unroll
            for (int m = 0; m < 4; ++m) { const bf16_t* gp = GT + (size_t)(row0 + ai * HALF + m * 16) * 2048 + col0;
#pragma unroll
                for (int bj = 0; bj < 2; ++bj) { const u32x4 a = *(const u32x4*)(gp + bj * HALF), b = *(const u32x4*)(gp + 1024 + bj * HALF);
                    f32x4 r0, r1;
                    r0[0] = bflo(a.x) * __builtin_amdgcn_rcpf(fmaxf(bflo(b.x), 1e-30f)); r0[1] = bfhi(a.x) * __builtin_amdgcn_rcpf(fmaxf(bfhi(b.x), 1e-30f));
                    r0[2] = bflo(a.y) * __builtin_amdgcn_rcpf(fmaxf(bflo(b.y), 1e-30f)); r0[3] = bfhi(a.y) * __builtin_amdgcn_rcpf(fmaxf(bfhi(b.y), 1e-30f));
                    r1[0] = bflo(a.z) * __builtin_amdgcn_rcpf(fmaxf(bflo(b.z), 1e-30f)); r1[1] = bfhi(a.z) * __builtin_amdgcn_rcpf(fmaxf(bfhi(b.z), 1e-30f));
                    r1[2] = bflo(a.w) * __builtin_amdgcn_rcpf(fmaxf(bflo(b.w), 1e-30f)); r1[3] = bfhi(a.w) * __builtin_amdgcn_rcpf(fmaxf(bfhi(b.w), 1e-30f));
                    acc[ai][bj][m][0] *= r0; acc[ai][bj][m][1] *= r1; }
                asm volatile("" ::: "memory");
            }
    }
    __device__ __forceinline__ void operator()(const f32x4 (&acc)[2][2][4][2], const Unit& u, int wr, int wc, int fr, int fq) const {
        asm volatile("" : "+v"(fr), "+v"(fq));
        const int row0 = u.pm * BM + wr * 64 + fr, col0 = u.pn * BM + wc * 32 + 8 * fq;
#pragma unroll
        for (int ai = 0; ai < 2; ++ai)
#pragma unroll
            for (int m = 0; m < 4; ++m) { const int row = row0 + ai * HALF + m * 16; const bf16_t* gp = GT + (size_t)row * 2048 + 1024 + col0;
#pragma unroll
                for (int bj = 0; bj < 2; ++bj) { const u32x4 b = *(const u32x4*)(gp + bj * HALF);
                    f32x4 g0, g1;
                    g0[0] = fmaxf(bflo(b.x), 1e-30f); g0[1] = fmaxf(bfhi(b.x), 1e-30f); g0[2] = fmaxf(bflo(b.y), 1e-30f); g0[3] = fmaxf(bfhi(b.y), 1e-30f);
                    g1[0] = fmaxf(bflo(b.z), 1e-30f); g1[1] = fmaxf(bfhi(b.z), 1e-30f); g1[2] = fmaxf(bflo(b.w), 1e-30f); g1[3] = fmaxf(bfhi(b.w), 1e-30f);
                    *(u32x4*)(MIX + (size_t)row * 1024 + col0 + bj * HALF) = pack8(acc[ai][bj][m][0] * g0, acc[ai][bj][m][1] * g1); }
                asm volatile("" ::: "memory");
            }
    }
};

struct Epi3 {
    static constexpr bool PERM = true, AFTER_DRAIN = false, HAS_MID = false; static constexpr int MID_T = -1;
    const float* x; bf16_t* x1b; float* ssq;
    __device__ __forceinline__ void mid(f32x4 (&)[2][2][4][2], const Unit&, int, int, int, int) const {}
    __device__ __forceinline__ void operator()(const f32x4 (&acc)[2][2][4][2], const Unit& u, int wr, int wc, int fr, int fq) const {
        asm volatile("" : "+v"(fr), "+v"(fq));
        const int row0 = u.pm * BM + wr * 64 + fr, col0 = u.pn * BM + wc * 32 + 8 * fq;
#pragma unroll
        for (int ai = 0; ai < 2; ++ai)
#pragma unroll
            for (int m = 0; m < 4; ++m) { const int row = row0 + ai * HALF + m * 16; const size_t off = (size_t)row * 1024 + col0; float ss = 0.f;
#pragma unroll
                for (int bj = 0; bj < 2; ++bj) { const f32x4 v0 = acc[ai][bj][m][0] + *(const f32x4*)(x + off + bj * HALF), v1 = acc[ai][bj][m][1] + *(const f32x4*)(x + off + bj * HALF + 4);
                    *(u32x4*)(x1b + off + bj * HALF) = pack8(v0, v1);
                    const f32x4 q0 = v0 * v0, q1 = v1 * v1; ss += ((q0[0] + q0[1]) + (q0[2] + q0[3])) + ((q1[0] + q1[1]) + (q1[2] + q1[3])); }
                ss += __shfl_xor(ss, 16); ss += __shfl_xor(ss, 32);
                if (fq == 0) ssq[(size_t)row * 16 + u.pn * 4 + wc] = ss;
            }
    }
};

__device__ __forceinline__ unsigned f2key(float v) { const unsigned u = __float_as_uint(v); return (u & 0x80000000u) ? ~u : (u | 0x80000000u); }
__device__ __forceinline__ float key2f(unsigned k) { return __uint_as_float((k & 0x80000000u) ? (k & 0x7fffffffu) : ~k); }
#define PG8_CE(a_, b_) do { const unsigned hi__ = (a_) > (b_) ? (a_) : (b_); const unsigned lo__ = (a_) > (b_) ? (b_) : (a_); (a_) = hi__; (b_) = lo__; } while (0)
__device__ __forceinline__ void bitonic_merge16(unsigned (&v)[16]) {
#pragma unroll
    for (int j = 8; j >= 1; j >>= 1)
#pragma unroll
        for (int i = 0; i < 16; ++i) { const int l = i ^ j; if (l > i) PG8_CE(v[i], v[l]); }
}
__device__ __forceinline__ void bitonic_sort16(unsigned (&v)[16]) {
#pragma unroll
    for (int k = 2; k <= 16; k <<= 1)
#pragma unroll
        for (int j = k >> 1; j >= 1; j >>= 1)
#pragma unroll
            for (int i = 0; i < 16; ++i) { const int l = i ^ j; if (l > i) { if ((i & k) == 0 || k == 16) PG8_CE(v[i], v[l]); else PG8_CE(v[l], v[i]); } }
}
__device__ __forceinline__ void merge_top16(unsigned (&t)[16], const unsigned (&o)[16]) {
#pragma unroll
    for (int i = 0; i < 16; ++i) t[i] = t[i] > o[15 - i] ? t[i] : o[15 - i];
    bitonic_merge16(t);
}
template <int XM> __device__ __forceinline__ void merge_top16_xor(unsigned (&t)[16]) {
    unsigned o[16];
#pragma unroll
    for (int i = 0; i < 16; ++i) o[i] = (unsigned)__shfl_xor((int)t[i], XM);
    merge_top16(t, o);
}

struct Epi4 {
    static constexpr bool PERM = false, AFTER_DRAIN = true, HAS_MID = false; static constexpr int MID_T = -1;
    const float* ssq; float* rinv2; unsigned short* ids; float* gw;
    __device__ __forceinline__ void mid(f32x4 (&)[2][2][4][2], const Unit&, int, int, int, int) const {}
    __device__ __forceinline__ void fused(f32x4 (&acc)[2][2][4][2], const Unit& u, int wr, int wc, int fr, int fq, PG8_LAS unsigned char* lds, int wid, int lane) const {
        asm volatile("" : "+v"(fr), "+v"(fq));
        const int tid = wid * 64 + lane;
        const int rl = tid >> 2, p = (tid >> 1) & 1, hf = tid & 1, q4 = tid & 3;
#pragma unroll
        for (int pass = 0; pass < 2; ++pass) {
#pragma unroll
            for (int m = 0; m < 4; ++m)
#pragma unroll
                for (int bj = 0; bj < 2; ++bj)
#pragma unroll
                    for (int n = 0; n < 2; ++n) *(PG8_LAS f32x4*)(lds + (size_t)(wr * 64 + m * 16 + fr) * 1056 + bj * 528 + (wc * 32 + n * 16 + fq * 4) * 4) = acc[pass][bj][m][n];
            asm volatile("s_waitcnt lgkmcnt(0)" ::: "memory"); __builtin_amdgcn_s_barrier(); asm volatile("" ::: "memory");
            const int row = u.pm * BM + pass * HALF + rl;
            unsigned tk[16];
#pragma unroll
            for (int i = 0; i < 16; ++i) tk[i] = 0u;
            const PG8_LAS unsigned char* sp = lds + (size_t)rl * 1056 + p * 528 + hf * 256;
#pragma nounroll
            for (int c = 0; c < 4; ++c) { unsigned ch[16];
#pragma unroll
                for (int e4 = 0; e4 < 4; ++e4) { const f32x4 v = *(const PG8_LAS f32x4*)(sp + c * 64 + e4 * 16);
#pragma unroll
                    for (int e = 0; e < 4; ++e) ch[4 * e4 + e] = (f2key(v[e]) & ~127u) | (unsigned)(127 - (64 * hf + 16 * c + 4 * e4 + e)); }
                bitonic_sort16(ch);
                merge_top16(tk, ch);
            }
            merge_top16_xor<1>(tk);
            asm volatile("s_waitcnt lgkmcnt(0)" ::: "memory");
            PG8_LAS unsigned* kl = (PG8_LAS unsigned*)(lds + (size_t)(rl & ~15) * 1056) + ((rl & 15) * 2) * 16;
            if (hf == 0) {
#pragma unroll
                for (int i = 0; i < 4; ++i) *(PG8_LAS u32x4*)(kl + p * 16 + 4 * i) = (u32x4){tk[4 * i], tk[4 * i + 1], tk[4 * i + 2], tk[4 * i + 3]}; }
            asm volatile("s_waitcnt lgkmcnt(0)" ::: "memory");
            unsigned ck[16];
#define CAND_SLOT(m_, ij__) do { const unsigned i__ = (ij__) >> 4, j__ = (ij__) & 15u; \
                const unsigned ka__ = kl[(ij__) == 0xFFFFu ? 0u : i__], kb__ = kl[16 + ((ij__) == 0xFFFFu ? 0u : j__)]; \
                const float s__ = key2f(ka__ & ~127u) + key2f(kb__ & ~127u); \
                ck[m_] = (ij__) == 0xFFFFu ? 0u : ((f2key(s__) & ~255u) | (255u - (ij__))); } while (0)
                { const unsigned ij_ = q4 == 0 ? 0u : q4 == 1 ? 1u : q4 == 2 ? 2u : 3u; CAND_SLOT(0, ij_); }
                { const unsigned ij_ = q4 == 0 ? 4u : q4 == 1 ? 5u : q4 == 2 ? 6u : 7u; CAND_SLOT(1, ij_); }
                { const unsigned ij_ = q4 == 0 ? 8u : q4 == 1 ? 9u : q4 == 2 ? 10u : 11u; CAND_SLOT(2, ij_); }
                { const unsigned ij_ = q4 == 0 ? 12u : q4 == 1 ? 13u : q4 == 2 ? 14u : 15u; CAND_SLOT(3, ij_); }
                { const unsigned ij_ = q4 == 0 ? 16u : q4 == 1 ? 17u : q4 == 2 ? 18u : 19u; CAND_SLOT(4, ij_); }
                { const unsigned ij_ = q4 == 0 ? 20u : q4 == 1 ? 21u : q4 == 2 ? 22u : 23u; CAND_SLOT(5, ij_); }
                { const unsigned ij_ = q4 == 0 ? 32u : q4 == 1 ? 33u : q4 == 2 ? 34u : 35u; CAND_SLOT(6, ij_); }
                { const unsigned ij_ = q4 == 0 ? 36u : q4 == 1 ? 48u : q4 == 2 ? 49u : 50u; CAND_SLOT(7, ij_); }
                { const unsigned ij_ = q4 == 0 ? 51u : q4 == 1 ? 64u : q4 == 2 ? 65u : 66u; CAND_SLOT(8, ij_); }
                { const unsigned ij_ = q4 == 0 ? 80u : q4 == 1 ? 81u : q4 == 2 ? 96u : 97u; CAND_SLOT(9, ij_); }
                { const unsigned ij_ = q4 == 0 ? 112u : q4 == 1 ? 113u : q4 == 2 ? 128u : 144u; CAND_SLOT(10, ij_); }
                { const unsigned ij_ = q4 == 0 ? 160u : q4 == 1 ? 176u : q4 == 2 ? 192u : 208u; CAND_SLOT(11, ij_); }
                { const unsigned ij_ = q4 == 0 ? 224u : q4 == 1 ? 240u : q4 == 2 ? 65535u : 65535u; CAND_SLOT(12, ij_); }
#undef CAND_SLOT
            ck[13] = 0u; ck[14] = 0u; ck[15] = 0u;
            bitonic_sort16(ck);
            merge_top16_xor<1>(ck); merge_top16_xor<2>(ck);
            float sq = 0.f;
#pragma unroll
            for (int i = 0; i < 4; ++i) { const f32x4 t = *(const f32x4*)(ssq + (size_t)row * 16 + 4 * i); sq += (t[0] + t[1]) + (t[2] + t[3]); }
            const float r2 = __builtin_amdgcn_rsqf(sq * (1.0f / 1024.0f) + 1e-6f);
            if (u.pn == 0 && q4 == 0) rinv2[row] = r2;
            const float b0 = key2f(ck[0] & ~255u); float wsum = 0.f; float wv[16];
#pragma unroll
            for (int q = 0; q < 16; ++q) { wv[q] = __builtin_amdgcn_exp2f((key2f(ck[q] & ~255u) - b0) * r2 * 1.4426950408889634f); wsum += wv[q]; }
            const float inv = 1.0f / wsum;
            unsigned short eo[4]; float go[4];
#pragma unroll
            for (int e = 0; e < 4; ++e) { unsigned c0 = ck[e], c1 = ck[4 + e], c2 = ck[8 + e], c3 = ck[12 + e]; float w0 = wv[e], w1 = wv[4 + e], w2 = wv[8 + e], w3 = wv[12 + e];
                asm volatile("" : "+v"(c0), "+v"(c1), "+v"(c2), "+v"(c3), "+v"(w0), "+v"(w1), "+v"(w2), "+v"(w3));
                const unsigned cc = q4 == 0 ? c0 : q4 == 1 ? c1 : q4 == 2 ? c2 : c3; const float ww = q4 == 0 ? w0 : q4 == 1 ? w1 : q4 == 2 ? w2 : w3;
                const unsigned code = 255u - (cc & 255u);
                const unsigned i1 = 127u - (kl[code >> 4] & 127u), i2 = 127u - (kl[16 + (code & 15u)] & 127u);
                eo[e] = (unsigned short)(i1 * 128u + i2); go[e] = ww * inv; }
            const size_t ob = ((size_t)row * 8 + u.pn) * 16 + q4 * 4;
            { u32x2 w; w.x = eo[0] | ((unsigned)eo[1] << 16); w.y = eo[2] | ((unsigned)eo[3] << 16); *(u32x2*)(ids + ob) = w; }
            *(f32x4*)(gw + ob) = (f32x4){go[0], go[1], go[2], go[3]};
            asm volatile("s_waitcnt lgkmcnt(0)" ::: "memory"); __builtin_amdgcn_s_barrier(); asm volatile("" ::: "memory");
        }
    }
};
template <class Epi, class Sched, bool ALIGN_EPI = false, bool SP2 = false>
__device__ __forceinline__ void gemm_phase(PG8_LAS unsigned char* lds, const Gemm g, const Sched& S, const Epi& E) {
    const int tid = threadIdx.x, wid = __builtin_amdgcn_readfirstlane(tid >> 6), lane = tid & 63, wr = wid >> 2, wc = wid & 3, fr = lane & 15, fq = lane >> 4;
    const int K = g.K, nt = K / BK;
    unsigned voffA[2], voffB[2];
#pragma unroll
    for (int i = 0; i < 2; ++i) { int R, C; stage_rc(tid * 16 + i * 8192, R, C); const int Rb = Epi::PERM ? ((R & ~31) + perm32(R & 31)) : R;
        voffA[i] = (unsigned)(R * K + C) * 2u; voffB[i] = (unsigned)(Rb * K + C) * 2u; }
    const size_t kstep = (size_t)(BK * 2);
    const size_t hstep = (size_t)HALF * K * 2;
    const size_t tstep = 2 * hstep;
    const unsigned ldsw = (unsigned)wid * 1024u;
    const int aoff = lds_byte(wr * 64 + fr, fq * 8), boff = lds_byte(wc * 32 + fr, fq * 8);
#define PG8_SA(b, h) (((b) * 2 + (h)) * HTB)
#define PG8_SB(b, h) ((4 + (b) * 2 + (h)) * HTB)
#define PG8_STAGE(bufoff, gbase, voff) do { _Pragma("unroll") for (int _i = 0; _i < 2; ++_i) \
        __builtin_amdgcn_global_load_lds((const unsigned*)((const char*)(gbase) + (voff)[_i]), (PG8_LAS unsigned*)(lds + (bufoff) + ldsw + _i * 8192), 16, 0, 0); } while (0)
#define PG8_LDA(dst, b, h) do { _Pragma("unroll") for (int m = 0; m < 4; ++m) _Pragma("unroll") for (int k = 0; k < 2; ++k) dst[m][k] = *(const PG8_LAS bf16x8*)(lds + PG8_SA(b, h) + aoff + m * 2048 + k * 1024); } while (0)
#define PG8_LDB(dst, b, h) do { _Pragma("unroll") for (int n = 0; n < 2; ++n) _Pragma("unroll") for (int k = 0; k < 2; ++k) dst[n][k] = *(const PG8_LAS bf16x8*)(lds + PG8_SB(b, h) + boff + n * 2048 + k * 1024); } while (0)
#define PG8_MMA(ai, bj, At, Bt) do { __builtin_amdgcn_s_setprio(1); _Pragma("unroll") for (int m = 0; m < 4; ++m) _Pragma("unroll") for (int n = 0; n < 2; ++n) _Pragma("unroll") for (int k = 0; k < 2; ++k) \
        acc[ai][bj][m][n] = __builtin_amdgcn_mfma_f32_16x16x32_bf16(Bt[n][k], At[m][k], acc[ai][bj][m][n], 0, 0, 0); __builtin_amdgcn_s_setprio(0); } while (0)
#define PG8_WAIT_V(n) asm volatile("s_waitcnt vmcnt(" #n ")" ::: "memory")
#define PG8_WAIT_L(n) asm volatile("s_waitcnt lgkmcnt(" #n ")" ::: "memory")
#define PG8_BAR __builtin_amdgcn_s_barrier()
#define PG8_SCHED __builtin_amdgcn_sched_barrier(0)
    Unit cur, nxt; int ui = 0;
    if (!S.next(0, cur)) return;
    f32x4 acc[2][2][4][2];
#pragma unroll
    for (int a = 0; a < 2; ++a)
#pragma unroll
        for (int b = 0; b < 2; ++b)
#pragma unroll
            for (int m = 0; m < 4; ++m)
#pragma unroll
                for (int n = 0; n < 2; ++n) acc[a][b][m][n] = (f32x4){0.f, 0.f, 0.f, 0.f};
    bf16x8 At[4][2], B0[2][2], B1[2][2];
    const char* cA = (const char*)g.A + (size_t)cur.pm * tstep; const char* cB = (const char*)g.Bt + (size_t)cur.pn * tstep;
    S.a_ready(cur);
    if constexpr (SP2) {
        PG8_STAGE(PG8_SB(0, 0), cB, voffB); PG8_STAGE(PG8_SB(0, 1), cB + hstep, voffB); PG8_STAGE(PG8_SA(0, 0), cA, voffA); PG8_STAGE(PG8_SA(0, 1), cA + hstep, voffA);
        if (wr == 1) PG8_BAR;
        PG8_WAIT_V(2); PG8_BAR;
        PG8_STAGE(PG8_SB(1, 0), cB + kstep, voffB); PG8_STAGE(PG8_SA(1, 0), cA + kstep, voffA); PG8_STAGE(PG8_SB(1, 1), cB + hstep + kstep, voffB);
        PG8_WAIT_V(6); PG8_BAR;
    } else {
        PG8_STAGE(PG8_SB(0, 0), cB, voffB); PG8_STAGE(PG8_SA(0, 0), cA, voffA); PG8_STAGE(PG8_SB(0, 1), cB + hstep, voffB); PG8_STAGE(PG8_SA(0, 1), cA + hstep, voffA);
        if (wr == 1) PG8_BAR;
        PG8_WAIT_V(4); PG8_BAR;
        PG8_STAGE(PG8_SB(1, 0), cB + kstep, voffB); PG8_STAGE(PG8_SA(1, 0), cA + kstep, voffA); PG8_STAGE(PG8_SB(1, 1), cB + hstep + kstep, voffB);
        PG8_WAIT_V(6); PG8_BAR;
    }
    for (;;) {
        const bool has_next = S.next(ui + 1, nxt);
        const char* nA = has_next ? (const char*)g.A + (size_t)nxt.pm * tstep : cA; const char* nB = has_next ? (const char*)g.Bt + (size_t)nxt.pn * tstep : cB;
        for (int t = 0; t < nt; t += 2) {
            if constexpr (Epi::HAS_MID) { if (t == Epi::MID_T) E.mid(acc, cur, wr, wc, fr, fq); }
            const bool last = (t == nt - 2);
            const char* a1 = cA + (size_t)(t + 1) * kstep;
            const char* a2 = last ? nA : cA + (size_t)(t + 2) * kstep; const char* b2 = last ? nB : cB + (size_t)(t + 2) * kstep;
            const char* a3 = a2 + kstep; const char* b3 = b2 + kstep;
            if (last && has_next) S.a_ready(nxt);
            if constexpr (SP2) {
            PG8_LDB(B0, 0, 0); PG8_LDB(B1, 0, 1); PG8_SCHED; PG8_LDA(At, 0, 0); PG8_STAGE(PG8_SA(1, 1), a1 + hstep, voffA);
            PG8_WAIT_V(8); PG8_WAIT_L(0); PG8_BAR; PG8_MMA(0, 0, At, B0); PG8_MMA(0, 1, At, B1); PG8_BAR; PG8_SCHED;
            PG8_LDA(At, 0, 1); PG8_STAGE(PG8_SB(0, 0), b2, voffB); PG8_STAGE(PG8_SB(0, 1), b2 + hstep, voffB); PG8_STAGE(PG8_SA(0, 0), a2, voffA);
            PG8_WAIT_V(8); PG8_WAIT_L(0); PG8_BAR; PG8_MMA(1, 0, At, B0); PG8_MMA(1, 1, At, B1); PG8_BAR; PG8_SCHED;
            PG8_LDB(B0, 1, 0); PG8_LDB(B1, 1, 1); PG8_SCHED; PG8_LDA(At, 1, 0); PG8_STAGE(PG8_SA(0, 1), a2 + hstep, voffA);
            PG8_WAIT_V(8); PG8_WAIT_L(0); PG8_BAR; PG8_MMA(0, 0, At, B0); PG8_MMA(0, 1, At, B1); PG8_BAR; PG8_SCHED;
            PG8_LDA(At, 1, 1); PG8_STAGE(PG8_SB(1, 0), b3, voffB); PG8_STAGE(PG8_SB(1, 1), b3 + hstep, voffB); PG8_STAGE(PG8_SA(1, 0), a3, voffA);
            PG8_WAIT_V(8); PG8_WAIT_L(0); PG8_BAR; PG8_MMA(1, 0, At, B0); PG8_MMA(1, 1, At, B1); PG8_BAR; PG8_SCHED;
            } else {
            PG8_LDB(B0, 0, 0); PG8_SCHED; PG8_LDA(At, 0, 0); PG8_STAGE(PG8_SA(1, 1), a1 + hstep, voffA);
            PG8_WAIT_L(8); PG8_BAR; PG8_WAIT_L(0); PG8_MMA(0, 0, At, B0); PG8_BAR; PG8_SCHED;
            PG8_LDB(B1, 0, 1); PG8_STAGE(PG8_SB(0, 0), b2, voffB);
            PG8_BAR; PG8_WAIT_L(0); PG8_MMA(0, 1, At, B1); PG8_BAR;
            PG8_LDA(At, 0, 1); PG8_STAGE(PG8_SA(0, 0), a2, voffA);
            PG8_BAR; PG8_WAIT_L(0); PG8_MMA(1, 0, At, B0); PG8_BAR; PG8_SCHED;
            PG8_STAGE(PG8_SB(0, 1), b2 + hstep, voffB);
            PG8_WAIT_V(6); PG8_BAR; PG8_MMA(1, 1, At, B1); PG8_BAR;
            PG8_LDB(B0, 1, 0); PG8_SCHED; PG8_LDA(At, 1, 0); PG8_STAGE(PG8_SA(0, 1), a2 + hstep, voffA);
            PG8_WAIT_L(8); PG8_BAR; PG8_WAIT_L(0); PG8_MMA(0, 0, At, B0); PG8_BAR; PG8_SCHED;
            PG8_LDB(B1, 1, 1); PG8_STAGE(PG8_SB(1, 0), b3, voffB);
            PG8_BAR; PG8_WAIT_L(0); PG8_MMA(0, 1, At, B1); PG8_BAR;
            PG8_LDA(At, 1, 1); PG8_STAGE(PG8_SA(1, 0), a3, voffA);
            PG8_BAR; PG8_WAIT_L(0); PG8_MMA(1, 0, At, B0); PG8_BAR; PG8_SCHED;
            PG8_STAGE(PG8_SB(1, 1), b3 + hstep, voffB);
            PG8_WAIT_V(6); PG8_BAR; PG8_MMA(1, 1, At, B1); PG8_BAR;
            }
        }
        if constexpr (ALIGN_EPI) { if (wr == 0) PG8_BAR; }
        if constexpr (!Epi::AFTER_DRAIN) { E(acc, cur, wr, wc, fr, fq); S.done(cur); }
        if (!has_next) break;
#pragma unroll
        for (int a = 0; a < 2; ++a)
#pragma unroll
            for (int b = 0; b < 2; ++b)
#pragma unroll
                for (int m = 0; m < 4; ++m)
#pragma unroll
                    for (int n = 0; n < 2; ++n) acc[a][b][m][n] = (f32x4){0.f, 0.f, 0.f, 0.f};
        cur = nxt; cA = nA; cB = nB; ++ui;
        if constexpr (ALIGN_EPI) { if (wr == 1) PG8_BAR; }
    }
    PG8_WAIT_V(0);
    if constexpr (!ALIGN_EPI) { if (wr == 0) PG8_BAR; }
    PG8_BAR;
    if constexpr (Epi::AFTER_DRAIN) { E.fused(acc, cur, wr, wc, fr, fq, lds, wid, lane); S.done(cur); }
#undef PG8_SA
#undef PG8_SB
#undef PG8_STAGE
#undef PG8_LDA
#undef PG8_LDB
#undef PG8_MMA
#undef PG8_WAIT_V
#undef PG8_WAIT_L
#undef PG8_BAR
#undef PG8_SCHED
}
}


namespace att {
#define ALAS __attribute__((address_space(3)))
typedef unsigned short bf16;
typedef short bf16x8 __attribute__((ext_vector_type(8)));
typedef short s16x4 __attribute__((ext_vector_type(4)));
typedef float f32x16 __attribute__((ext_vector_type(16)));
typedef float f32x4 __attribute__((ext_vector_type(4)));
typedef float f32x2 __attribute__((ext_vector_type(2)));
typedef unsigned u32x4 __attribute__((ext_vector_type(4)));
typedef __bf16 bf16x2_t __attribute__((ext_vector_type(2)));
constexpr int SEQ = 4096;
constexpr int VPITCH = 144;
constexpr float LOG2E = 1.4426950408889634f, LN2 = 0.6931471805599453f;
__device__ __forceinline__ unsigned pkbf(float lo, float hi) { f32x2 v = {lo, hi}; bf16x2_t b = __builtin_convertvector(v, bf16x2_t); return __builtin_bit_cast(unsigned, b); }
__device__ __forceinline__ void wave_lds_sync() { asm volatile("s_waitcnt lgkmcnt(0)" ::: "memory"); }
__device__ __forceinline__ s16x4 vtr(const ALAS unsigned char* p) { return __builtin_bit_cast(s16x4, __builtin_amdgcn_ds_read_tr16_b64_v4i16((ALAS s16x4*)p)); }
__device__ __forceinline__ int crow(int r, int hi) { return (r & 3) + 8 * (r >> 2) + 4 * hi; }

__device__ __forceinline__ void pv_tile(f32x16& o0, f32x16& o1, const float (&a)[16], const ALAS unsigned char* vt, int lane) {
    const int g = lane >> 4, i = lane & 15, q_ = i >> 2, p_ = i & 3, h = lane >> 5;
    const ALAS unsigned char* vb = vt + (8 * h + q_) * VPITCH + (16 * (g & 1) + 4 * p_) * 2;
    u32x4 pw0, pw1;
    pw0.x = pkbf(a[0], a[1]); pw0.y = pkbf(a[2], a[3]); pw0.z = pkbf(a[4], a[5]); pw0.w = pkbf(a[6], a[7]);
    pw1.x = pkbf(a[8], a[9]); pw1.y = pkbf(a[10], a[11]); pw1.z = pkbf(a[12], a[13]); pw1.w = pkbf(a[14], a[15]);
    const bf16x8 pa0 = __builtin_bit_cast(bf16x8, pw0), pa1 = __builtin_bit_cast(bf16x8, pw1);
#pragma unroll
    for (int s = 0; s < 2; ++s) {
        const s16x4 l0 = vtr(vb + (16 * s) * VPITCH), h0 = vtr(vb + (16 * s + 4) * VPITCH);
        const s16x4 l1 = vtr(vb + (16 * s) * VPITCH + 64), h1 = vtr(vb + (16 * s + 4) * VPITCH + 64);
        const bf16x8 v0 = (bf16x8){l0[0], l0[1], l0[2], l0[3], h0[0], h0[1], h0[2], h0[3]};
        const bf16x8 v1 = (bf16x8){l1[0], l1[1], l1[2], l1[3], h1[0], h1[1], h1[2], h1[3]};
        o0 = __builtin_amdgcn_mfma_f32_32x32x16_bf16(s ? pa1 : pa0, v0, o0, 0, 0, 0);
        o1 = __builtin_amdgcn_mfma_f32_32x32x16_bf16(s ? pa1 : pa0, v1, o1, 0, 0, 0);
    }
}
__device__ __forceinline__ void bcast_rows(float v, ALAS float* sc, int r32, int hi, float (&out)[16]) {
    if (hi == 0) sc[r32] = v;
    wave_lds_sync();
#pragma unroll
    for (int g = 0; g < 4; ++g) { const f32x4 t = *(const ALAS f32x4*)(sc + 8 * g + 4 * hi); out[4 * g] = t[0]; out[4 * g + 1] = t[1]; out[4 * g + 2] = t[2]; out[4 * g + 3] = t[3]; }
    wave_lds_sync();
}
__device__ __forceinline__ void store_o(const f32x16& o0, const f32x16& o1, ALAS unsigned char* stg, bf16* dst  , size_t rstride_elems, int lane) {
    const int r32 = lane & 31, hi = lane >> 5;
    wave_lds_sync();
#pragma unroll
    for (int r = 0; r < 16; ++r) { const int q = crow(r, hi);
        *(ALAS unsigned short*)(stg + q * VPITCH + r32 * 2) = (unsigned short)(pkbf(o0[r], 0.f) & 0xffffu);
        *(ALAS unsigned short*)(stg + q * VPITCH + 64 + r32 * 2) = (unsigned short)(pkbf(o1[r], 0.f) & 0xffffu); }
    wave_lds_sync();
#pragma unroll
    for (int i = 0; i < 4; ++i) { const int row = 8 * i + (lane >> 3), ch = lane & 7; const u32x4 v = *(const ALAS u32x4*)(stg + row * VPITCH + ch * 16); *(u32x4*)(dst + (size_t)row * rstride_elems + ch * 8) = v; }
    wave_lds_sync();
}

__device__ __forceinline__ void sb_item(const bf16* QS, const bf16* KS, const bf16* VS, bf16* OC, int b, int h, int qt, ALAS unsigned char* wl, int lane) {
    const int r32 = lane & 31, hi = lane >> 5;
    const int t0 = qt * 32; const size_t rowb = (size_t)b * SEQ;
    const int kperm = (r32 & ~12) | ((r32 & 4) << 1) | ((r32 & 8) >> 1);
    bf16x8 qf[4];
    { const bf16* qp = QS + (rowb + t0 + r32) * 512 + h * 64 + hi * 8;
#pragma unroll
      for (int d0 = 0; d0 < 4; ++d0) qf[d0] = *(const bf16x8*)(qp + d0 * 16); }
    f32x16 o0 = {}, o1 = {}; float R = 0.f;
    for (int key0 = t0; key0 >= 0; key0 -= 32) {
        const bf16* kp = KS + (rowb + key0 + kperm) * 512 + h * 64 + hi * 8;
        bf16x8 kf[4];
#pragma unroll
        for (int d0 = 0; d0 < 4; ++d0) kf[d0] = *(const bf16x8*)(kp + d0 * 16);
        u32x4 vv[4];
#pragma unroll
        for (int i = 0; i < 4; ++i) vv[i] = *(const u32x4*)(VS + (rowb + key0 + 8 * i + (lane >> 3)) * 512 + h * 64 + (lane & 7) * 8);
        f32x16 p = {};
#pragma unroll
        for (int d0 = 0; d0 < 4; ++d0) p = __builtin_amdgcn_mfma_f32_32x32x16_bf16(kf[d0], qf[d0], p, 0, 0, 0);
#pragma unroll
        for (int i = 0; i < 4; ++i) *(ALAS u32x4*)(wl + (8 * i + (lane >> 3)) * VPITCH + (lane & 7) * 16) = vv[i];
        const bool diag = (key0 == t0);
        float z2[16], L2[16];
#pragma unroll
        for (int r = 0; r < 16; ++r) { const int kk = (r & 7) + 8 * hi + 16 * (r >> 3); const float zz = p[r];
            const float sp = fmaxf(zz, 0.f) + __builtin_amdgcn_logf(1.0f + __builtin_amdgcn_exp2f(-fabsf(zz)));
            const bool valid = !diag || (kk < r32); z2[r] = zz; L2[r] = valid ? sp : 0.f; }
        float c[16];
        c[15] = L2[15];
#pragma unroll
        for (int r = 14; r >= 8; --r) c[r] = c[r + 1] + L2[r];
        c[7] = L2[7];
#pragma unroll
        for (int r = 6; r >= 0; --r) c[r] = c[r + 1] + L2[r];
        const float TB = c[8], TA = c[0];
        const float TBo = __shfl_xor(TB, 32), TAo = __shfl_xor(TA, 32);
        const float offB = R + (hi ? 0.f : TBo);
        const float offA = R + TB + TBo + (hi ? 0.f : TAo);
        float a[16];
#pragma unroll
        for (int r = 0; r < 16; ++r) { const int kk = (r & 7) + 8 * hi + 16 * (r >> 3); const bool valid = !diag || (kk < r32);
            const float e = __builtin_amdgcn_exp2f(z2[r] - (c[r] + (r < 8 ? offA : offB))); a[r] = valid ? e : 0.f; }
        R += (TA + TB) + (TAo + TBo);
        wave_lds_sync();
        pv_tile(o0, o1, a, wl, lane);
        wave_lds_sync();
        if (__all(R > 40.0f * LOG2E)) break;
    }
    store_o(o0, o1, wl, OC + (rowb + t0) * 768 + h * 64, 768, lane);
}

constexpr int DLU_WAVE = 5120;
constexpr int DLU_O = 8 * DLU_WAVE, DLU_M = DLU_O + 512 * 128, DLU_L = DLU_M + 2048, DLU_BYTES = DLU_L + 2048;
__device__ __forceinline__ void dl_unit(const bf16* QD, const bf16* KD, const bf16* VD, bf16* OC, int b, int j, int blk, ALAS unsigned char* lds, int wave, int lane) {
    const int r32 = lane & 31, hi = lane >> 5;
    const size_t rowb = (size_t)b * SEQ;
    const int t0 = 512 * blk;
    const int kperm = (r32 & ~12) | ((r32 & 4) << 1) | ((r32 & 8) >> 1);
    ALAS unsigned char* wl = lds + wave * DLU_WAVE;
    ALAS float* sc = (ALAS float*)(wl + 4608);
    ALAS unsigned short* OL = (ALAS unsigned short*)(lds + DLU_O);
    ALAS float* ML = (ALAS float*)(lds + DLU_M); ALAS float* LL = (ALAS float*)(lds + DLU_L);
    for (int g = 2; g >= 0; --g) {
        const int hh = 4 * g + j, sh = 2 * g, r = 1 << sh;
        const float slope2 = __builtin_amdgcn_exp2f(-8.0f * (float)(hh + 1) / 12.0f) * LOG2E;
        const float sr = slope2 * (float)r;
        for (int it = wave; it < 16; it += 8) {
            const int q0 = g == 2 ? it : g == 1 ? (it & 3) + 128 * (it >> 2) : 32 * it;
            const int tq = t0 + q0 + r * r32, tmax = t0 + q0 + 31 * r;
            bf16x8 qf[4];
            { const bf16* qp = QD + (rowb + tq) * 768 + hh * 64 + hi * 8;
#pragma unroll
              for (int d0 = 0; d0 < 4; ++d0) qf[d0] = *(const bf16x8*)(qp + d0 * 16); }
            const int klo = 31 - r32; int khi = klo + 128; { const int kmaxtok = tmax >> sh; khi = khi < kmaxtok ? khi : kmaxtok; }
            const unsigned krange = (unsigned)(khi - klo);
            f32x16 o0 = {}, o1 = {}; float mrun = -3.0e38f, lrun = 0.f;
            if (g != 2) {
                mrun = ML[q0 + r * r32]; lrun = hi ? 0.f : LL[q0 + r * r32];
#pragma unroll
                for (int q = 0; q < 16; ++q) { const int tl = q0 + r * crow(q, hi);
                    o0[q] = __uint_as_float((unsigned)OL[tl * 64 + r32] << 16); o1[q] = __uint_as_float((unsigned)OL[tl * 64 + 32 + r32] << 16); }
            }
            for (int kt = 0; kt < 5; ++kt) {
                int sk = tmax - r * (32 * kt + kperm); sk = sk < 0 ? 0 : sk;
                const bf16* kp = KD + (rowb + sk) * 768 + hh * 64 + hi * 8;
                bf16x8 kf[4];
#pragma unroll
                for (int d0 = 0; d0 < 4; ++d0) kf[d0] = *(const bf16x8*)(kp + d0 * 16);
                u32x4 vv[4];
#pragma unroll
                for (int i = 0; i < 4; ++i) { int sv = tmax - r * (32 * kt + 8 * i + (lane >> 3)); sv = sv < 0 ? 0 : sv; vv[i] = *(const u32x4*)(VD + (rowb + sv) * 768 + hh * 64 + (lane & 7) * 8); }
                const int dk = 32 * kt + 8 * hi - klo;
                const float tb = -sr * (float)dk;
                f32x16 p;
#pragma unroll
                for (int q = 0; q < 16; ++q) p[q] = tb - sr * (float)((q & 7) + 16 * (q >> 3));
#pragma unroll
                for (int d0 = 0; d0 < 4; ++d0) p = __builtin_amdgcn_mfma_f32_32x32x16_bf16(kf[d0], qf[d0], p, 0, 0, 0);
#pragma unroll
                for (int i = 0; i < 4; ++i) *(ALAS u32x4*)(wl + (8 * i + (lane >> 3)) * VPITCH + (lane & 7) * 16) = vv[i];
                float z2[16]; float mt = -3.0e38f;
#pragma unroll
                for (int q = 0; q < 16; ++q) { const bool valid = (unsigned)(dk + ((q & 7) + 16 * (q >> 3))) <= krange; z2[q] = valid ? p[q] : -INFINITY; mt = fmaxf(mt, z2[q]); }
                mt = fmaxf(mt, __shfl_xor(mt, 32));
                if (__any(mt > mrun + 8.0f)) {
                    const float mnew = fmaxf(mrun, mt); const float alpha = __builtin_amdgcn_exp2f(mrun - mnew);
                    lrun *= alpha; float al[16]; bcast_rows(alpha, sc, r32, hi, al);
#pragma unroll
                    for (int q = 0; q < 16; ++q) { o0[q] *= al[q]; o1[q] *= al[q]; }
                    mrun = mnew;
                }
                float a[16]; float ls = 0.f;
#pragma unroll
                for (int q = 0; q < 16; ++q) { a[q] = __builtin_amdgcn_exp2f(z2[q] - mrun); ls += a[q]; }
                lrun += ls;
                wave_lds_sync();
                pv_tile(o0, o1, a, wl, lane);
                wave_lds_sync();
            }
            const float ltot = lrun + __shfl_xor(lrun, 32);
            if (g != 0) {
                if (hi == 0) { ML[q0 + r * r32] = mrun; LL[q0 + r * r32] = ltot; }
#pragma unroll
                for (int q = 0; q < 16; ++q) { const int tl = q0 + r * crow(q, hi);
                    OL[tl * 64 + r32] = (unsigned short)(pkbf(o0[q], 0.f) & 0xffffu); OL[tl * 64 + 32 + r32] = (unsigned short)(pkbf(o1[q], 0.f) & 0xffffu); }
            } else {
                float il[16]; bcast_rows(1.0f / ltot, sc, r32, hi, il);
#pragma unroll
                for (int q = 0; q < 16; ++q) { o0[q] *= il[q]; o1[q] *= il[q]; }
                store_o(o0, o1, wl, OC + (rowb + t0 + q0) * 768 + 512 + j * 64, 768, lane);
            }
        }
        asm volatile("s_waitcnt lgkmcnt(0)" ::: "memory"); __builtin_amdgcn_s_barrier(); asm volatile("" ::: "memory");
    }
}
#undef ALAS
}

constexpr int NWAVES = 8;
#ifndef MK_N_LAUNCHES
#define MK_N_LAUNCHES 1
#endif
#ifndef MK_LAST_PHASE
#define MK_LAST_PHASE 8
#endif
constexpr int N_LAUNCHES = MK_N_LAUNCHES;
constexpr int PER_PHASE = 8;

constexpr int BATCH = 16, SEQ = 4096, D = 1024, T = BATCH * SEQ;
constexpr int N1 = 5888;
constexpr int NEXP = 16384;
constexpr size_t MiB = 1u << 20;
constexpr size_t WS_CTL = 0, CTL_ZERO_BYTES = 1 * MiB;
constexpr size_t WS_WIN = 2 * MiB;
constexpr size_t WS_WCAT = 16 * MiB;
constexpr size_t WS_WOUT = 18 * MiB;
constexpr size_t WS_WC = 20 * MiB;
constexpr size_t WS_RINV1 = 24 * MiB;
constexpr size_t WS_RINV2 = 25 * MiB;
constexpr size_t WS_USC = 25 * MiB + 512 * 1024, WS_VSC = 25 * MiB + 768 * 1024;
constexpr size_t WS_SSQ = 26 * MiB;
constexpr size_t WS_U8 = 32 * MiB;
constexpr size_t WS_V8 = 64 * MiB;
constexpr size_t WS_IDS = 96 * MiB;
constexpr size_t WS_GW = 112 * MiB;
constexpr size_t WS_XB = 144 * MiB;
constexpr size_t WS_QS = 272 * MiB, WS_KS = 336 * MiB, WS_VS = 400 * MiB;
constexpr size_t WS_QD = 464 * MiB, WS_KD = 560 * MiB, WS_VD = 656 * MiB;
constexpr size_t WS_GT = 752 * MiB;
constexpr size_t WS_COEF = 272 * MiB;
constexpr size_t WS_MIX = 272 * MiB;
constexpr size_t WS_X1B = 400 * MiB;
constexpr size_t WS_HQ = 528 * MiB;
constexpr size_t WS_HS2 = 24 * MiB + 512 * 1024;
constexpr size_t WS_END = 1008 * MiB;
constexpr int CW_BAR = 4096;
constexpr int CW_XRANK = 8192;

constexpr int RING_OFF = 0, RING_BYTES = 131072;
constexpr int LDSCTL_OFF = 143360, MISC_OFF = LDSCTL_OFF + 320;
constexpr int LDS_BYTES = 147456;
static_assert(MISC_OFF + 128 <= LDS_BYTES, "LDS map");
#define GAS __attribute__((address_space(1)))
#define LAS __attribute__((address_space(3)))
typedef unsigned short bf16;
typedef unsigned v4u __attribute__((ext_vector_type(4)));
typedef float f32x4 __attribute__((ext_vector_type(4)));
typedef short bf16x8 __attribute__((ext_vector_type(8)));
typedef GAS unsigned gu32;
typedef GAS unsigned long long gu64;
#define RLX_AGENT __ATOMIC_RELAXED, __HIP_MEMORY_SCOPE_AGENT
#define LDS_WAIT() asm volatile("s_waitcnt lgkmcnt(0)" ::: "memory")
#define VM_WAIT() asm volatile("s_waitcnt vmcnt(0)" ::: "memory")
__device__ __forceinline__ unsigned long long rt() { return __builtin_amdgcn_s_memrealtime(); }
__device__ __forceinline__ unsigned f2bf(float f) { unsigned u = __builtin_bit_cast(unsigned, f); return (u + 0x7fffu + ((u >> 16) & 1u)) >> 16; }
__device__ __forceinline__ unsigned pk2(float lo, float hi) { return f2bf(lo) | (f2bf(hi) << 16); }

#define XB_TMO      128
#define XB_XCNT(j)  (256  + 64 * (j))
#define XB_XSUB(j)  (1280 + 64 * (j))
#define XB_XGEN(j)  (2304 + 64 * (j))
#define XB_TOP      3328
#define XB_TOPGEN   3392
#define XCD_BAR_WORDS 3456
#define XB_SPIN_CAP (1u << 18)

__device__ __forceinline__ unsigned xb_ld(unsigned* p)              { return __hip_atomic_load(p, __ATOMIC_RELAXED, __HIP_MEMORY_SCOPE_AGENT); }
__device__ __forceinline__ unsigned xb_add(unsigned* p, unsigned v) { return __hip_atomic_fetch_add(p, v, __ATOMIC_RELAXED, __HIP_MEMORY_SCOPE_AGENT); }
__device__ __forceinline__ unsigned xb_xcc_id() { return (unsigned)__builtin_amdgcn_s_getreg((3 << 11) | 20) & 0xFu; }
#define XB_SPIN(cond, bar) do { unsigned _sp = 0; while (cond) { __builtin_amdgcn_s_sleep(1); \
    if ((++_sp & 255u) == 0u) { if (xb_ld(&(bar)[XB_TMO])) break; if (_sp > XB_SPIN_CAP) { atomicAdd(&(bar)[XB_TMO], 1u); break; } } } } while (0)

struct XcdBarrier {
    unsigned* bar; unsigned x;
    volatile LAS unsigned* st;
};

__device__ __forceinline__ XcdBarrier xcd_barrier_post(unsigned* bar, volatile LAS unsigned* st) {
    XcdBarrier b; b.bar = bar; b.x = xb_xcc_id(); b.st = st;
    if (threadIdx.x == 0) (void)xb_add(&bar[XB_XCNT(b.x)], 1u);
    return b;
}
__device__ __forceinline__ void xcd_barrier_complete(unsigned* bar, unsigned x, unsigned& nloc, unsigned& nx) {
    const unsigned G = gridDim.x * gridDim.y * gridDim.z;
    unsigned sum, cnt, mine, sp = 0u;
    for (;;) {
        sum = 0u; cnt = 0u; mine = 0u;
#pragma unroll
        for (unsigned j = 0; j < 16; ++j) { const unsigned c = xb_ld(&bar[XB_XCNT(j)]); sum += c; cnt += (c > 0u) ? 1u : 0u; mine = (j == x) ? c : mine; }
        if (sum == G) break;
        __builtin_amdgcn_s_sleep(1);
        if ((++sp & 255u) == 0u) { if (xb_ld(&bar[XB_TMO])) break; if (sp > XB_SPIN_CAP) { atomicAdd(&bar[XB_TMO], 1u); break; } }
    }
    nloc = mine > 0u ? mine : 1u; nx = cnt > 0u ? cnt : 1u;
}

__device__ __forceinline__ void xcd_barrier(const XcdBarrier& b) {
    asm volatile("s_waitcnt vmcnt(0)" ::: "memory");
    __syncthreads();
    if (threadIdx.x == 0) {
        unsigned* bar = b.bar;
        __builtin_amdgcn_s_waitcnt(0);
        unsigned nloc = b.st[0], nx = b.st[1];
        if (nloc == 0u) { xcd_barrier_complete(bar, b.x, nloc, nx); b.st[0] = nloc; b.st[1] = nx; }
        const unsigned old = xb_add(&bar[XB_XSUB(b.x)], 1u);
        const unsigned gen = old / nloc;
        if (old + 1u == (gen + 1u) * nloc) {
            __builtin_amdgcn_fence(__ATOMIC_RELEASE, "agent");
            asm volatile("s_waitcnt vmcnt(0)" ::: "memory");
            const unsigned og = xb_add(&bar[XB_TOP], 1u);
            const unsigned tg = og / nx;
            if (og + 1u == (tg + 1u) * nx) xb_add(&bar[XB_TOPGEN], 1u);
            else XB_SPIN(xb_ld(&bar[XB_TOPGEN]) == tg, bar);
            __builtin_amdgcn_fence(__ATOMIC_ACQUIRE, "agent");
            xb_add(&bar[XB_XGEN(b.x)], 1u);
            asm volatile("s_waitcnt vmcnt(0)" ::: "memory");
        } else {
            XB_SPIN(xb_ld(&bar[XB_XGEN(b.x)]) == gen, bar);
            __builtin_amdgcn_fence(__ATOMIC_ACQUIRE, "agent");
            asm volatile("s_waitcnt vmcnt(0)" ::: "memory");
        }
    }
    __syncthreads();
}

typedef float f32x2 __attribute__((ext_vector_type(2)));
typedef unsigned v2u __attribute__((ext_vector_type(2)));
typedef _Float16 h2_t __attribute__((ext_vector_type(2)));
struct Frame {
    LAS unsigned char* lds;
    volatile LAS unsigned* MISC;
    gu32* ctl;
    int tid, lane, wave;
    int vcu, G;
};
__device__ __forceinline__ float wave_sum(float v) {
#pragma unroll
    for (int o = 1; o < 64; o <<= 1) v += __shfl_xor(v, o);
    return v;
}
__device__ __forceinline__ float wave_max(float v) {
#pragma unroll
    for (int o = 1; o < 64; o <<= 1) v = fmaxf(v, __shfl_xor(v, o));
    return v;
}
__device__ __forceinline__ int win_row(int n) { if (n < 1536 || n >= 3072) return n; const int t = (n - 1536) >> 8, ln = (n - 1536) & 255, hl = ln >> 6, d = ln & 63; return 1536 + t * 256 + 32 * hl + (d & 31) + 128 * (d >> 5); }
__device__ __forceinline__ void p0_transpose_item(const float* W, int N, const float* gain, bf16* WT, int ldt, int koff, int mode, LAS float* scr, int item, int lane) {
    const int nblk = N / 32, kb = item / nblk, nb = item % nblk, k0 = 64 * kb, n0 = 32 * nb;
#pragma unroll 8
    for (int i = 0; i < 32; ++i) { const int kk = 2 * i + (lane >> 5); float v = W[(size_t)(k0 + kk) * N + n0 + (lane & 31)]; if (gain) v *= gain[k0 + kk]; scr[kk * 33 + (lane & 31)] = v; }
    LDS_WAIT(); asm volatile("" ::: "memory");
    const int c = lane & 7;
#pragma unroll
    for (int j = 0; j < 4; ++j) { const int n = (lane >> 3) + 8 * j; const LAS float* s = scr + (8 * c) * 33 + n;
        v4u o; o.x = pk2(s[0 * 33], s[1 * 33]); o.y = pk2(s[2 * 33], s[3 * 33]); o.z = pk2(s[4 * 33], s[5 * 33]); o.w = pk2(s[6 * 33], s[7 * 33]);
        const int rown = mode ? win_row(n0 + n) : (n0 + n);
        *(GAS v4u*)(WT + (size_t)rown * ldt + koff + k0 + 8 * c) = o; }
    LDS_WAIT(); asm volatile("" ::: "memory");
}
__device__ __forceinline__ void quant_row_fp8(const float* src, const float* gain, unsigned char* dst, size_t slice_stride, float* scale_out, int lane) {
    f32x4 v[4]; float am = 0.f;
#pragma unroll
    for (int j = 0; j < 4; ++j) { v[j] = *(const GAS f32x4*)(src + 256 * j + 4 * lane); if (gain) v[j] = v[j] * *(const GAS f32x4*)(gain + 256 * j + 4 * lane);
        am = fmaxf(am, fmaxf(fmaxf(fabsf(v[j][0]), fabsf(v[j][1])), fmaxf(fabsf(v[j][2]), fabsf(v[j][3])))); }
    am = wave_max(am);
    const int ex = (int)((__float_as_uint(am) >> 23) & 0xffu);
    const float s = (ex == 0) ? 1.0f : __uint_as_float((unsigned)(127 + 7 - (ex - 127)) << 23);
    const float is = (ex == 0) ? 1.0f : __uint_as_float((unsigned)(127 - 7 + (ex - 127)) << 23);
    if (lane == 0) *scale_out = is;
#pragma unroll
    for (int j = 0; j < 4; ++j) { int pk = __builtin_amdgcn_cvt_pk_fp8_f32(v[j][0] * s, v[j][1] * s, 0, false); pk = __builtin_amdgcn_cvt_pk_fp8_f32(v[j][2] * s, v[j][3] * s, pk, true);
        const int col = 256 * j + 4 * lane; *(GAS int*)(dst + (size_t)(col >> 7) * slice_stride + (col & 127)) = pk; }
}
__device__ __forceinline__ void quant_row_fp4(const float* src, unsigned char* dst, size_t slice_stride, float* scale_out, int lane) {
    f32x4 v[4]; float am = 0.f;
#pragma unroll
    for (int j = 0; j < 4; ++j) { v[j] = *(const GAS f32x4*)(src + 256 * j + 4 * lane); am = fmaxf(am, fmaxf(fmaxf(fabsf(v[j][0]), fabsf(v[j][1])), fmaxf(fabsf(v[j][2]), fabsf(v[j][3])))); }
    am = wave_max(am);
    const float s = am > 0.f ? 6.0f / am : 0.f;
    if (lane == 0) *scale_out = am * (1.0f / 6.0f);
#pragma unroll
    for (int j = 0; j < 4; ++j) { unsigned pk = __builtin_amdgcn_cvt_scalef32_pk_fp4_f32(0u, v[j][0] * s, v[j][1] * s, 1.0f, 0); pk = __builtin_amdgcn_cvt_scalef32_pk_fp4_f32(pk, v[j][2] * s, v[j][3] * s, 1.0f, 1);
        *(GAS unsigned short*)(dst + (size_t)j * slice_stride + 2 * lane) = (unsigned short)(pk & 0xffffu); }
}
__device__ __forceinline__ void quant_row_i4(const float* src, const float* gain, unsigned char* dst, float* scale_out, int lane) {
    f32x4 v[4]; float am = 0.f, ss = 0.f;
    const int p16 = (lane >> 2) & 15, wl = lane & 3;
#pragma unroll
    for (int ld = 0; ld < 2; ++ld)
#pragma unroll
        for (int sn = 0; sn < 2; ++sn) { const int hd = 2 * (4 * ld + wl) + sn; const int idx = 256 * (hd >> 2) + 16 * p16 + 4 * (hd & 3);
            f32x4 t = *(const GAS f32x4*)(src + idx); if (gain) t = t * *(const GAS f32x4*)(gain + idx); v[2 * ld + sn] = t;
            am = fmaxf(am, fmaxf(fmaxf(fabsf(t[0]), fabsf(t[1])), fmaxf(fabsf(t[2]), fabsf(t[3])))); ss += (t[0] * t[0] + t[1] * t[1]) + (t[2] * t[2] + t[3] * t[3]); }
    am = wave_max(am); ss = wave_sum(ss);
    const float clipv = fminf(am, 2.5f * sqrtf(ss * (1.0f / 1024.0f)));
    const float s = clipv > 0.f ? 7.0f / clipv : 0.f;
    if (lane == 0) *scale_out = clipv * (1.0f / (7.0f * 16.0f));
#pragma unroll
    for (int ld = 0; ld < 2; ++ld) { unsigned pk = 0u;
#pragma unroll
        for (int b4 = 0; b4 < 4; ++b4) { int q0 = (int)__builtin_rintf(v[2 * ld][b4] * s), q1 = (int)__builtin_rintf(v[2 * ld + 1][b4] * s);
            q0 = q0 < -7 ? -7 : (q0 > 7 ? 7 : q0); q1 = q1 < -7 ? -7 : (q1 > 7 ? 7 : q1);
            pk |= ((unsigned)(q0 & 15) | ((unsigned)(q1 & 15) << 4)) << (8 * b4); }
        *(GAS unsigned*)(dst + ld * 256 + 16 * p16 + 4 * wl) = pk; }
}
__device__ __forceinline__ float gelu_f(float v) {
    const float av = fabsf(v), t = __builtin_amdgcn_rcpf(av * 0.2316418882f + 1.0f);
    float q = t * 0.5307027145f + (-0.7265760135f); q = q * t + 0.7107068705f; q = q * t + (-0.142248368f); q = q * t + 0.127414796f; q = q * t;
    const float e = __builtin_amdgcn_exp2f((v * v) * (-0.72134752044f));
    const float m = v * (q * e);
    return v < 0.f ? m : v - m;
}

struct Args { const float* in[14]; float* out; unsigned char* ws; int ph_lo, ph_hi, li, pad; };
__global__ void __launch_bounds__(NWAVES * 64, 2) fwd_kernel(Args args) {
    extern __shared__ __attribute__((aligned(16))) unsigned char lds[];
    Frame F;
    F.lds = (LAS unsigned char*)lds;
    F.MISC = (volatile LAS unsigned*)(F.lds + MISC_OFF);
    F.tid = threadIdx.x; F.lane = F.tid & 63; F.wave = __builtin_amdgcn_readfirstlane(F.tid >> 6);
    F.G = gridDim.x; { const int bx = blockIdx.x; F.vcu = (F.G % 8 == 0) ? (bx % 8) * (F.G / 8) + bx / 8 : bx; }
    unsigned char* ws = args.ws;
    F.ctl = (gu32*)(ws + WS_CTL);
    const float* x = args.in[0]; const float* norm1_gain = args.in[1]; const float* w_in = args.in[2]; const float* b_gate = args.in[3];
    const float* q_gain = args.in[4]; const float* k_gain = args.in[5]; const float* w_sb_out = args.in[6]; const float* w_dil_out = args.in[7];
    const float* w_out = args.in[8]; const float* norm2_gain = args.in[9]; const float* w_peer_q = args.in[10]; const float* sub_keys = args.in[11];
    const float* peer_u = args.in[12]; const float* peer_v = args.in[13];
    float* out = args.out;
    bf16* WIN = (bf16*)(ws + WS_WIN); bf16* WCAT = (bf16*)(ws + WS_WCAT); bf16* WOUT = (bf16*)(ws + WS_WOUT); bf16* WC = (bf16*)(ws + WS_WC);
    float* RINV1 = (float*)(ws + WS_RINV1); float* RINV2 = (float*)(ws + WS_RINV2); float* USC = (float*)(ws + WS_USC); float* VSC = (float*)(ws + WS_VSC); float* SSQ = (float*)(ws + WS_SSQ);
    unsigned char* U8 = ws + WS_U8; unsigned char* V8 = ws + WS_V8;
    unsigned short* IDS = (unsigned short*)(ws + WS_IDS); float* GW = (float*)(ws + WS_GW); float* COEF = (float*)(ws + WS_COEF); unsigned char* HQ = ws + WS_HQ; float* HS2 = (float*)(ws + WS_HS2);
    bf16* XB = (bf16*)(ws + WS_XB); bf16* OC = (bf16*)(ws + WS_XB);
    bf16* QS = (bf16*)(ws + WS_QS); bf16* KS = (bf16*)(ws + WS_KS); bf16* VS = (bf16*)(ws + WS_VS);
    bf16* QD = (bf16*)(ws + WS_QD); bf16* KD = (bf16*)(ws + WS_KD); bf16* VD = (bf16*)(ws + WS_VD);
    bf16* GT = (bf16*)(ws + WS_GT); bf16* MIX = (bf16*)(ws + WS_MIX); bf16* X1B = (bf16*)(ws + WS_X1B);

    for (int u = F.tid; u < (LDS_BYTES - LDSCTL_OFF) / 4; u += NWAVES * 64) ((LAS unsigned*)(F.lds + LDSCTL_OFF))[u] = 0u;
    __syncthreads();
    const int my_xcc = (int)xb_xcc_id();
    if (F.tid == 0) F.MISC[12] = xb_add((unsigned*)(F.ctl + CW_XRANK) + 64 * my_xcc, 1u);
    __syncthreads();
    const int my_xrank = (int)F.MISC[12];
    const int bli = (N_LAUNCHES == PER_PHASE) ? 0 : args.li;
    XcdBarrier bar; bar.bar = (unsigned*)(F.ctl + CW_BAR) + bli * XCD_BAR_WORDS; bar.x = 0; bar.st = nullptr;
    if (N_LAUNCHES != PER_PHASE) bar = xcd_barrier_post((unsigned*)(F.ctl + CW_BAR) + bli * XCD_BAR_WORDS, F.MISC + 8);
    const int lo = args.ph_lo, hi = args.ph_hi;
#ifndef PHASE_MASK
#define PHASE_MASK 0xff
#endif
#define IN(k) (((PHASE_MASK >> (k)) & 1) && lo <= (k) && (k) < hi)
#define BOTH(k) (IN(k) && IN((k) + 1))
#define GRID_BAR() do { if (N_LAUNCHES != PER_PHASE) xcd_barrier(bar); } while (0)
#ifndef PROBE_REPEAT
#define PROBE_REPEAT 0x00
#endif
#ifndef PROBE_L1
#define PROBE_L1 0x0
#endif
#define REP(k) _Pragma("unroll") for (int rep_ = 0; rep_ < (((PROBE_REPEAT >> (k)) & 1) ? 2 : 1); ++rep_)
    const int gw = F.vcu * NWAVES + F.wave, NGW = F.G * NWAVES;
#define P67_MAP() int vx = (int)(blockIdx.x & 7), rk = (int)(blockIdx.x >> 3), nrk = (F.G + 7 - vx) / 8; bool p67_uni = false; \
        { bool uni_ = (F.G % 8 == 0); for (int j_ = 0; j_ < 16; ++j_) { const unsigned c_ = xb_ld((unsigned*)(F.ctl + CW_XRANK) + 64 * j_); uni_ = uni_ && (c_ == (j_ < 8 ? (unsigned)(F.G / 8) : 0u)); } \
          if (uni_) { vx = my_xcc; rk = my_xrank; nrk = F.G / 8; p67_uni = true; } }

    if (IN(0)) REP(0) {
        for (int it = F.vcu; it < 256; it += F.G) {
            const int hp = it >> 4, d0 = (it & 15) * 64;
            LAS float* As = (LAS float*)(F.lds);
            LAS float* Bs = (LAS float*)(F.lds + 64 * 132 * 4);
            for (int e = F.tid; e < 64 * 32; e += 512) { const int r = e >> 5, c4 = (e & 31) * 4; *(LAS f32x4*)(As + r * 132 + c4) = *(const GAS f32x4*)(w_peer_q + (size_t)(d0 + r) * 2048 + hp * 128 + c4); }
            for (int e = F.tid; e < 128 * 32; e += 512) { const int r = e >> 5, c4 = (e & 31) * 4; *(LAS f32x4*)(Bs + r * 132 + c4) = *(const GAS f32x4*)(sub_keys + ((size_t)hp * 128 + r) * 128 + c4); }
            __syncthreads();
            const int ddg = F.tid & 15, ng = F.tid >> 4;
            f32x4 acc[4];
#pragma unroll
            for (int j = 0; j < 4; ++j) acc[j] = (f32x4){0.f, 0.f, 0.f, 0.f};
            for (int c4 = 0; c4 < 128; c4 += 4) {
                f32x4 a[4], b[4];
#pragma unroll
                for (int i = 0; i < 4; ++i) { a[i] = *(const LAS f32x4*)(As + (4 * ddg + i) * 132 + c4); b[i] = *(const LAS f32x4*)(Bs + (4 * ng + i) * 132 + c4); }
#pragma unroll
                for (int j = 0; j < 4; ++j)
#pragma unroll
                    for (int i = 0; i < 4; ++i) acc[j][i] += (a[i][0] * b[j][0] + a[i][1] * b[j][1]) + (a[i][2] * b[j][2] + a[i][3] * b[j][3]);
            }
            const f32x4 g2 = *(const GAS f32x4*)(norm2_gain + d0 + 4 * ddg);
#pragma unroll
            for (int j = 0; j < 4; ++j) { v2u o; o.x = pk2(acc[j][0] * g2[0], acc[j][1] * g2[1]); o.y = pk2(acc[j][2] * g2[2], acc[j][3] * g2[3]);
                *(GAS v2u*)(WC + (size_t)(hp * 128 + 4 * ng + j) * 1024 + d0 + 4 * ddg) = o; }
            __syncthreads();
        }
        {
            LAS float* scr = (LAS float*)(F.lds + RING_OFF + F.wave * 16384);
            constexpr int I_IN = (D / 64) * (N1 / 32), I_SB = (512 / 64) * (D / 32), I_DL = (256 / 64) * (D / 32), I_OUT = (D / 64) * (D / 32);
            constexpr int NITEMS = I_IN + I_SB + I_DL + I_OUT;
            for (int it = gw; it < NITEMS; it += NGW) {
                int r = it;
                if (r < I_IN) { p0_transpose_item(w_in, N1, norm1_gain, WIN, 1024, 0, 1, scr, r, F.lane); continue; } r -= I_IN;
                if (r < I_SB) { p0_transpose_item(w_sb_out, D, nullptr, WCAT, 768, 0, 0, scr, r, F.lane); continue; } r -= I_SB;
                if (r < I_DL) { p0_transpose_item(w_dil_out, D, nullptr, WCAT, 768, 512, 0, scr, r, F.lane); continue; } r -= I_DL;
                p0_transpose_item(w_out, D, nullptr, WOUT, 1024, 0, 0, scr, r, F.lane);
            }
        }
        for (int e = gw; e < 2 * NEXP; e += NGW) {
            if (e < NEXP) quant_row_i4(peer_u + (size_t)e * D, norm2_gain, U8 + (size_t)e * 512, USC + e, F.lane);
            else { const int ev = e - NEXP; quant_row_fp4(peer_v + (size_t)ev * D, V8 + (size_t)ev * 128, (size_t)NEXP * 128, VSC + ev, F.lane); }
        }
        for (int m = gw; m < T; m += NGW) {
            const GAS f32x4* xr = (const GAS f32x4*)(x + (size_t)m * D) + F.lane;
            f32x4 v[4]; float s = 0.f;
#pragma unroll
            for (int j = 0; j < 4; ++j) { v[j] = xr[64 * j]; s += (v[j][0] * v[j][0] + v[j][1] * v[j][1]) + (v[j][2] * v[j][2] + v[j][3] * v[j][3]); }
            s = wave_sum(s);
            const float rn = __builtin_amdgcn_rsqf(s * (1.0f / D) + 1e-6f);
            GAS unsigned long long* o8 = (GAS unsigned long long*)(XB + (size_t)m * D) + F.lane;
#pragma unroll
            for (int j = 0; j < 4; ++j) o8[64 * j] = (unsigned long long)pk2(v[j][0] * rn, v[j][1] * rn) | ((unsigned long long)pk2(v[j][2] * rn, v[j][3] * rn) << 32);
        }
        if (BOTH(0)) GRID_BAR();
    }

    if (IN(1)) REP(1) {
        pg8::Gemm g{XB, WIN, T, N1, D}; pg8::StaticOrder S; S.init(T, N1, F.G, (int)blockIdx.x);
        pg8::Epi1 E{RINV1, b_gate, q_gain, k_gain, QS, KS, VS, QD, KD, VD, GT};
        pg8::gemm_phase<pg8::Epi1, pg8::StaticOrder, true, true>(F.lds + RING_OFF, g, S, E);
        if (BOTH(1)) GRID_BAR();
    }

    if (IN(2)) REP(2) {
        LAS unsigned char* wl = F.lds + RING_OFF + F.wave * 16384;
        static_assert(att::DLU_BYTES <= RING_BYTES, "dilated-attention LDS state");
        for (int un = F.vcu; un < 512; un += F.G) { const int blk = un & 7, j = (un >> 3) & 3, b = un >> 5; att::dl_unit(QD, KD, VD, OC, b, j, blk, F.lds + RING_OFF, F.wave, F.lane); }
        for (int it = gw; it < 16384; it += NGW) { const int qt = 127 - (it & 127), h = (it >> 7) & 7, b = it >> 10; att::sb_item(QS, KS, VS, OC, b, h, qt, wl, F.lane); }
        if (BOTH(2)) GRID_BAR();
    }

    if (IN(3)) REP(3) {
        pg8::Gemm g{OC, WCAT, T, D, 768}; pg8::StaticOrder S; S.init(T, D, F.G, (int)blockIdx.x);
        pg8::Epi2 E{GT, MIX};
        pg8::gemm_phase<pg8::Epi2, pg8::StaticOrder, true, true>(F.lds + RING_OFF, g, S, E);
        if (BOTH(3)) GRID_BAR();
    }

    if (IN(4)) REP(4) {
        pg8::Gemm g{MIX, WOUT, T, D, D}; pg8::StaticOrder S; S.init(T, D, F.G, (int)blockIdx.x);
        pg8::Epi3 E{x, X1B, SSQ};
        pg8::gemm_phase<pg8::Epi3, pg8::StaticOrder, true, true>(F.lds + RING_OFF, g, S, E);
        if (BOTH(4)) GRID_BAR();
    }

    if (IN(5)) REP(5) {
        for (int m = gw; m < T; m += NGW) {
            const v4u a = *(const GAS v4u*)(X1B + (size_t)m * D + 8 * F.lane), b = *(const GAS v4u*)(X1B + (size_t)m * D + 512 + 8 * F.lane);
            float v[16] = {pg8::bflo(a.x), pg8::bfhi(a.x), pg8::bflo(a.y), pg8::bfhi(a.y), pg8::bflo(a.z), pg8::bfhi(a.z), pg8::bflo(a.w), pg8::bfhi(a.w),
                           pg8::bflo(b.x), pg8::bfhi(b.x), pg8::bflo(b.y), pg8::bfhi(b.y), pg8::bflo(b.z), pg8::bfhi(b.z), pg8::bflo(b.w), pg8::bfhi(b.w)};
            float am = 0.f;
#pragma unroll
            for (int i = 0; i < 16; ++i) am = fmaxf(am, fabsf(v[i]));
            am = wave_max(am);
            float sq = (F.lane < 16) ? SSQ[(size_t)m * 16 + F.lane] : 0.f; sq = wave_sum(sq);
            const float s = am > 0.f ? 127.0f / am : 0.f;
            if (F.lane == 0) HS2[m] = am * (1.0f / 127.0f) * __builtin_amdgcn_rsqf(sq * (1.0f / 1024.0f) + 1e-6f);
            int q[16];
#pragma unroll
            for (int i = 0; i < 16; ++i) q[i] = (int)__builtin_rintf(v[i] * s) & 0xff;
            v2u o0, o1; o0.x = q[0] | (q[1] << 8) | (q[2] << 16) | (q[3] << 24); o0.y = q[4] | (q[5] << 8) | (q[6] << 16) | (q[7] << 24);
            o1.x = q[8] | (q[9] << 8) | (q[10] << 16) | (q[11] << 24); o1.y = q[12] | (q[13] << 8) | (q[14] << 16) | (q[15] << 24);
            *(GAS v2u*)(HQ + (size_t)m * D + 8 * F.lane) = o0; *(GAS v2u*)(HQ + (size_t)m * D + 512 + 8 * F.lane) = o1;
        }
        pg8::Gemm g{X1B, WC, T, 2048, D}; pg8::StaticOrder S; S.init(T, 2048, F.G, (int)blockIdx.x);
        pg8::Epi4 E{SSQ, RINV2, IDS, GW};
        pg8::OneUnit O1;
        for (int i = 0; S.next(i, O1.u); ++i) pg8::gemm_phase<pg8::Epi4, pg8::OneUnit, false, true>(F.lds + RING_OFF, g, O1, E);
        if (BOTH(5)) GRID_BAR();
    }

    if (IN(6)) REP(6) {
        P67_MAP();
        const int p16 = F.lane & 15, sg = F.lane >> 4;
        LAS unsigned char* HB = F.lds + RING_OFF;
        LAS unsigned* LIST = (LAS unsigned*)(F.lds + RING_OFF + 65536);
        LAS unsigned* CNT = (LAS unsigned*)(F.lds + RING_OFF + 98304);
        LAS float* HSs = (LAS float*)(F.lds + RING_OFF + 98304 + 256);
        const int nblk = T / 64;
        const int gsel = (F.lane & 15), bpsrc = (16 * (F.lane & 3) + ((F.lane >> 2) & 3)) * 4;
        v4u hpre[8], idpre[2]; float hspre = 0.f;
#define P6_PRE(bb) do { const int bc_ = (bb) < nblk ? (bb) : nblk - 1; const unsigned char* hsrc_ = HQ + (size_t)bc_ * 65536; \
            _Pragma("unroll") for (int i_ = 0; i_ < 8; ++i_) hpre[i_] = *(const GAS v4u*)(hsrc_ + (size_t)(i_ * 512 + F.tid) * 16); \
            const unsigned short* isrc_ = IDS + ((size_t)bc_ * 64 + (F.tid >> 3)) * 128 + 16 * (F.tid & 7); idpre[0] = *(const GAS v4u*)isrc_; idpre[1] = *(const GAS v4u*)(isrc_ + 8); \
            hspre = HS2[(size_t)bc_ * 64 + (F.tid & 63)]; } while (0)
        int blk = rk;
        P6_PRE(blk);
        for (; blk < nblk; blk += nrk) {
            const int t0 = blk * 64;
            if (F.tid == 0) *CNT = 0u;
            if (F.tid < 64) HSs[F.tid] = hspre;
#pragma unroll
            for (int i = 0; i < 8; ++i) *(LAS v4u*)(HB + (size_t)(i * 512 + F.tid) * 16) = hpre[i];
            __syncthreads();
            { const unsigned idw[8] = {idpre[0].x, idpre[0].y, idpre[0].z, idpre[0].w, idpre[1].x, idpre[1].y, idpre[1].z, idpre[1].w};
              const unsigned tl = (unsigned)(F.tid >> 3), kb0 = 16u * (unsigned)(F.tid & 7);
#pragma unroll
              for (int i = 0; i < 16; ++i) { const unsigned e = (i & 1) ? (idw[i >> 1] >> 16) : (idw[i >> 1] & 0xffffu);
                  if ((int)(e >> 11) == vx) { const unsigned pos = __hip_atomic_fetch_add(CNT, 1u, __ATOMIC_RELAXED, __HIP_MEMORY_SCOPE_WORKGROUP); LIST[pos] = (tl << 24) | ((kb0 + (unsigned)i) << 16) | e; } } }
            __syncthreads();
            const int n = (int)*CNT;
            P6_PRE(blk + nrk);
#define P6_ISSUE(W, ENT, EJ, GB, UB, VB, base_) do { \
                _Pragma("unroll") for (int g_ = 0; g_ < 4; ++g_) { const int j_ = (base_) + 4 * g_ + sg; ENT[g_] = LIST[j_ < n ? j_ : n - 1]; } \
                { const int j_ = (base_) + gsel; EJ = (j_ < n && F.lane < 16) ? (int)LIST[j_] : -1; } \
                _Pragma("unroll") for (int g_ = 0; g_ < 4; ++g_) { const unsigned char* up_ = U8 + (size_t)((PROBE_L1 && rep_) ? 0u : (ENT[g_] & 0xffffu)) * 512 + 16 * p16; \
                    _Pragma("unroll") for (int i_ = 0; i_ < 2; ++i_) W[g_][i_] = *(const GAS v4u*)(up_ + 256 * i_); } \
                { const unsigned ej_ = EJ < 0 ? LIST[0] : (unsigned)EJ; GB = GW[((size_t)t0 + (ej_ >> 24)) * 128 + ((ej_ >> 16) & 127u)]; UB = USC[ej_ & 0xffffu]; VB = VSC[ej_ & 0xffffu]; } } while (0)
#define P6_DPPADD(a_, ctrl) a_ += __builtin_amdgcn_update_dpp(0, a_, ctrl, 0xf, 0xf, false)
#define P6_REDUCE(W, ENT, EJ, GB, UB, VB, base_) do { if ((base_) < n) { int ag_[4]; \
                _Pragma("unroll") for (int g_ = 0; g_ < 4; ++g_) { const LAS unsigned char* hp_ = HB + (size_t)(ENT[g_] >> 24) * 1024 + 16 * p16; int a_ = 0; v4u h_[4]; \
                    _Pragma("unroll") for (int i_ = 0; i_ < 4; ++i_) h_[i_] = *(const LAS v4u*)(hp_ + 256 * i_); \
                    _Pragma("unroll") for (int ld_ = 0; ld_ < 2; ++ld_) { const unsigned x_[4] = {W[g_][ld_].x, W[g_][ld_].y, W[g_][ld_].z, W[g_][ld_].w}; \
                        _Pragma("unroll") for (int wl_ = 0; wl_ < 4; ++wl_) { const int hd_ = 2 * (4 * ld_ + wl_); const unsigned lo_ = (x_[wl_] << 4) & 0xF0F0F0F0u, hi_ = x_[wl_] & 0xF0F0F0F0u; \
                            const unsigned hA_ = (hd_ & 3) == 0 ? h_[hd_ >> 2].x : h_[hd_ >> 2].z, hB_ = (hd_ & 3) == 0 ? h_[hd_ >> 2].y : h_[hd_ >> 2].w; \
                            a_ = __builtin_amdgcn_sdot4((int)lo_, (int)hA_, a_, false); a_ = __builtin_amdgcn_sdot4((int)hi_, (int)hB_, a_, false); } } \
                    P6_DPPADD(a_, 0xB1); P6_DPPADD(a_, 0x4E); P6_DPPADD(a_, 0x141); P6_DPPADD(a_, 0x140); ag_[g_] = a_; } \
                const int sel_ = gsel == 0 ? ag_[0] : gsel == 1 ? ag_[1] : gsel == 2 ? ag_[2] : ag_[3]; \
                const float resv_ = (float)__builtin_amdgcn_ds_bpermute(bpsrc, sel_); \
                if (EJ >= 0 && !(PROBE_L1 && rep_)) { const unsigned ej_ = (unsigned)EJ; const float act_ = gelu_f(resv_ * UB * HSs[ej_ >> 24]); \
                    COEF[((size_t)t0 + (ej_ >> 24)) * 128 + ((ej_ >> 16) & 127u)] = GB * act_ * VB; } } } while (0)
            for (int base = F.wave * 32; base < n; base += NWAVES * 32) {
                v4u wA[4][2], wB[4][2]; unsigned entA[4], entB[4]; int ejA, ejB; float gbA, ubA, vbA, gbB, ubB, vbB;
                P6_ISSUE(wA, entA, ejA, gbA, ubA, vbA, base);
                P6_ISSUE(wB, entB, ejB, gbB, ubB, vbB, base + 16);
                P6_REDUCE(wA, entA, ejA, gbA, ubA, vbA, base);
                P6_REDUCE(wB, entB, ejB, gbB, ubB, vbB, base + 16);
            }
#undef P6_ISSUE
#undef P6_REDUCE
#undef P6_DPPADD
            __syncthreads();
        }
#undef P6_PRE
        if (BOTH(6)) GRID_BAR();
    }

    if (IN(7)) REP(7) {
        P67_MAP();
        const int cs = vx >> 1;
        const int n0_ = p67_uni ? F.G / 8 : (F.G + 7 - 2 * cs) / 8, n1_ = p67_uni ? F.G / 8 : (F.G + 7 - (2 * cs + 1)) / 8;
        const int rk2 = (vx & 1) ? n0_ + rk : rk, nrk2 = n0_ + n1_;
        const int l8 = F.lane & 7, kg = F.lane >> 3;
        const unsigned char* vbase = V8 + (size_t)cs * NEXP * 128 + 16 * l8;
        const int tstep = nrk2 * NWAVES;
        const int col = 256 * cs + 32 * l8 + ((F.lane & 8) ? 16 : 0) + ((F.lane & 16) ? 8 : 0) + ((F.lane & 32) ? 4 : 0);
#define P7_CL(tt) ((tt) < T ? (tt) : T - 1)
#define P7_IDS(tt, ID) do { const int tc_ = P7_CL(tt); ID[0] = *(const GAS v4u*)(IDS + (size_t)tc_ * 128 + 16 * kg); ID[1] = *(const GAS v4u*)(IDS + (size_t)tc_ * 128 + 16 * kg + 8); } while (0)
#define P7_ISSUE(tt, ID, W, CF, OO) do { const int tc_ = P7_CL(tt); const unsigned idw_[8] = {ID[0].x, ID[0].y, ID[0].z, ID[0].w, ID[1].x, ID[1].y, ID[1].z, ID[1].w}; \
            _Pragma("unroll") for (int i_ = 0; i_ < 16; ++i_) { const unsigned e_ = (i_ & 1) ? (idw_[i_ >> 1] >> 16) : (idw_[i_ >> 1] & 0xffffu); W[i_] = *(const GAS v4u*)(vbase + (size_t)((PROBE_L1 && rep_) ? 0u : e_) * 128); } \
            _Pragma("unroll") for (int i_ = 0; i_ < 4; ++i_) CF[i_] = *(const GAS f32x4*)(COEF + (size_t)tc_ * 128 + 16 * kg + 4 * i_); \
            OO = *(const GAS v2u*)(X1B + (size_t)tc_ * D + col); } while (0)
#define P7_BYTE(d_, s_) do { const h2_t r_ = __builtin_amdgcn_cvt_scalef32_pk_f16_fp4(ww_[d_], 1.0f, s_); acc_[4 * (d_) + (s_)] = r_ * c2_ + acc_[4 * (d_) + (s_)]; } while (0)
#define P7_COMPUTE(tt, W, CF, OO) do { h2_t acc_[16];                 \
            _Pragma("unroll") for (int i_ = 0; i_ < 16; ++i_) acc_[i_] = (h2_t){(_Float16)0.f, (_Float16)0.f}; \
            _Pragma("unroll") for (int i_ = 0; i_ < 16; ++i_) { const unsigned ww_[4] = {W[i_].x, W[i_].y, W[i_].z, W[i_].w}; const _Float16 ch_ = (_Float16)CF[i_ >> 2][i_ & 3]; const h2_t c2_ = {ch_, ch_}; \
                P7_BYTE(0, 0); P7_BYTE(0, 1); P7_BYTE(0, 2); P7_BYTE(0, 3); P7_BYTE(1, 0); P7_BYTE(1, 1); P7_BYTE(1, 2); P7_BYTE(1, 3); \
                P7_BYTE(2, 0); P7_BYTE(2, 1); P7_BYTE(2, 2); P7_BYTE(2, 3); P7_BYTE(3, 0); P7_BYTE(3, 1); P7_BYTE(3, 2); P7_BYTE(3, 3); } \
            float r16_[16], r8_[8], r4_[4]; \
            { const bool up_ = (F.lane & 8) != 0; _Pragma("unroll") for (int i_ = 0; i_ < 8; ++i_) { const h2_t keep_ = up_ ? acc_[8 + i_] : acc_[i_], send_ = up_ ? acc_[i_] : acc_[8 + i_]; \
                const h2_t oth_ = __builtin_bit_cast(h2_t, __shfl_xor(__builtin_bit_cast(int, send_), 8)); r16_[2 * i_] = (float)keep_[0] + (float)oth_[0]; r16_[2 * i_ + 1] = (float)keep_[1] + (float)oth_[1]; } } \
            { const bool up_ = (F.lane & 16) != 0; _Pragma("unroll") for (int i_ = 0; i_ < 8; ++i_) { const float keep_ = up_ ? r16_[8 + i_] : r16_[i_], send_ = up_ ? r16_[i_] : r16_[8 + i_]; r8_[i_] = keep_ + __shfl_xor(send_, 16); } } \
            { const bool up_ = (F.lane & 32) != 0; _Pragma("unroll") for (int i_ = 0; i_ < 4; ++i_) { const float keep_ = up_ ? r8_[4 + i_] : r8_[i_], send_ = up_ ? r8_[i_] : r8_[4 + i_]; r4_[i_] = keep_ + __shfl_xor(send_, 32); } } \
            if ((tt) < T) *(GAS f32x4*)((rep_ == 0 ? out : (float*)(ws + WS_GT)) + (size_t)(tt) * D + col) = (f32x4){pg8::bflo(OO.x) + r4_[0], pg8::bfhi(OO.x) + r4_[1], pg8::bflo(OO.y) + r4_[2], pg8::bfhi(OO.y) + r4_[3]}; } while (0)
        v4u idA[2], idB[2], wA[16], wB[16]; f32x4 cfA[4], cfB[4]; v2u ooA, ooB;
        int t = rk2 * NWAVES + F.wave;
        P7_IDS(t, idA); P7_IDS(t + tstep, idB);
        while (t < T) {
            P7_ISSUE(t, idA, wA, cfA, ooA); P7_ISSUE(t + tstep, idB, wB, cfB, ooB);
            P7_IDS(t + 2 * tstep, idA); P7_IDS(t + 3 * tstep, idB);
            P7_COMPUTE(t, wA, cfA, ooA);
            P7_COMPUTE(t + tstep, wB, cfB, ooB);
            t += 2 * tstep;
        }
#undef P7_CL
#undef P7_IDS
#undef P7_ISSUE
#undef P7_BYTE
#undef P7_COMPUTE
    }
#undef IN
#undef BOTH
#undef GRID_BAR
}

extern "C" void kernel_launch(void* const* d_in, const int* in_sizes, int n_in, void* d_out, int out_size, void* d_ws, size_t ws_size, hipStream_t stream) {
    static int grid = 0;
    if (grid == 0) {
        if (n_in != 14 || in_sizes[0] != T * D || out_size != T * D || ws_size < WS_END) { fprintf(stderr, "kernel_launch: built for 14 inputs, x and out of %d floats, >= %zu bytes of workspace; got n_in %d, in0 %d, out %d, ws %zu; nothing launched\n", T * D, (size_t)WS_END, n_in, n_in > 0 ? in_sizes[0] : -1, out_size, ws_size); grid = -1; return; }
        int dev = 0, cus = 0, per_cu = 0;
        if (hipGetDevice(&dev) != hipSuccess || hipDeviceGetAttribute(&cus, hipDeviceAttributeMultiprocessorCount, dev) != hipSuccess) { fprintf(stderr, "kernel_launch: hipGetDevice / hipDeviceGetAttribute failed\n"); grid = -1; return; }
        if (hipFuncSetAttribute((const void*)fwd_kernel, hipFuncAttributeMaxDynamicSharedMemorySize, LDS_BYTES) != hipSuccess) { fprintf(stderr, "kernel_launch: hipFuncSetAttribute failed\n"); grid = -1; return; }
        if (hipOccupancyMaxActiveBlocksPerMultiprocessor(&per_cu, (const void*)fwd_kernel, NWAVES * 64, LDS_BYTES) != hipSuccess || per_cu < 1)
            fprintf(stderr, "kernel_launch: note: occupancy query reports %d workgroups per CU\n", per_cu);
        (void)hipGetLastError();
        grid = cus;
    }
    if (grid < 0) return;
    if (hipMemsetAsync((char*)d_ws + WS_CTL, 0, CTL_ZERO_BYTES, stream) != hipSuccess) { fprintf(stderr, "kernel_launch: hipMemsetAsync failed\n"); return; }
    Args a{};
    for (int i = 0; i < 14; ++i) a.in[i] = (const float*)d_in[i];
    a.out = (float*)d_out; a.ws = (unsigned char*)d_ws;
    for (int li = 0; li < N_LAUNCHES; ++li) {
        a.ph_lo = (N_LAUNCHES == PER_PHASE) ? li : 0; a.ph_hi = (N_LAUNCHES == PER_PHASE) ? li + 1 : MK_LAST_PHASE; a.li = li;
        if (a.ph_lo >= MK_LAST_PHASE) break;
        hipLaunchKernelGGL(fwd_kernel, dim3(grid), dim3(NWAVES * 64), LDS_BYTES, stream, a);
        const hipError_t le = hipPeekAtLastError();
        if (le != hipSuccess) { fprintf(stderr, "kernel_launch: launch %d failed: %s\n", li, hipGetErrorName(le)); break; }
    }
}
```

```cpp
#include <hip/hip_runtime.h>
#include <cstdio>
#include <cstdint>
namespace pg8 {
#define PG8_LAS __attribute__((address_space(3)))
typedef unsigned short bf16_t;
typedef short bf16x8 __attribute__((ext_vector_type(8)));
typedef float f32x4 __attribute__((ext_vector_type(4)));
typedef unsigned u32x4 __attribute__((ext_vector_type(4)));
constexpr int BM = 256, BK = 64, HALF = 128, HTB = HALF * BK * 2  , STAGE_BYTES = 8 * HTB, NXCD = 8, WGM = 8;

__host__ __device__ __forceinline__ int lds_byte(int r, int c) { const int st = (r >> 4) * 2 + (c >> 5), rr = r & 15, cc = c & 31, ob = rr * 64 + cc * 2; return st * 1024 + (ob ^ (((ob >> 9) & 1) << 5)); }
__host__ __device__ __forceinline__ void stage_rc(int b, int& R, int& C) { const int st = b / 1024, sb = b % 1024, swz = sb ^ (((sb >> 9) & 1) << 5); R = (st >> 1) * 16 + swz / 64; C = (st & 1) * 32 + (swz % 64) / 2; }
__host__ __device__ __forceinline__ int perm32(int rho) { const int n = rho >> 4, i = rho & 15; return 8 * (i >> 2) + 4 * n + (i & 3); }

struct Unit { int pm, pn; };
struct Gemm { const bf16_t* A; const bf16_t* Bt; int M, N, K; };

struct StaticOrder {
    int nM, nN, nwg, G, c;
    __host__ __device__ void init(int M, int N, int G_, int c_) { nM = M / BM; nN = N / BM; nwg = nM * nN; G = G_; c = c_; }
    __host__ __device__ bool next(int i, Unit& u) const {
        const long L = (long)i * G + c; if (L >= nwg) return false;
        int wgid = (int)L; { const int q = nwg / NXCD, r = nwg % NXCD, xcd = wgid % NXCD, off = wgid / NXCD; wgid = (xcd < r ? xcd * (q + 1) : r * (q + 1) + (xcd - r) * q) + off; }
        const int nig = WGM * nN, gid = wgid / nig, fm = gid * WGM, gsz = (nM - fm) < WGM ? (nM - fm) : WGM;
        u.pm = fm + ((wgid % nig) % gsz); u.pn = (wgid % nig) / gsz; return true;
    }
    __device__ __forceinline__ void a_ready(const Unit&) const {}
    __device__ __forceinline__ void done(const Unit&) const {}
};


struct OneUnit {
    Unit u;
    __device__ __forceinline__ bool next(int i, Unit& o) const { if (i != 0) return false; o = u; return true; }
    __device__ __forceinline__ void a_ready(const Unit&) const {}
    __device__ __forceinline__ void done(const Unit&) const {}
};

typedef float f32x2 __attribute__((ext_vector_type(2)));
typedef __bf16 bf16x2_t __attribute__((ext_vector_type(2)));
typedef unsigned u32x2 __attribute__((ext_vector_type(2)));
__device__ __forceinline__ unsigned pkbf(float lo, float hi) { f32x2 v = {lo, hi}; bf16x2_t b = __builtin_convertvector(v, bf16x2_t); return __builtin_bit_cast(unsigned, b); }
__device__ __forceinline__ float bflo(unsigned w) { return __uint_as_float(w << 16); }
__device__ __forceinline__ float bfhi(unsigned w) { return __uint_as_float(w & 0xffff0000u); }
__device__ __forceinline__ u32x4 pack8(const f32x4 a, const f32x4 b) { u32x4 w; w.x = pkbf(a[0], a[1]); w.y = pkbf(a[2], a[3]); w.z = pkbf(b[0], b[1]); w.w = pkbf(b[2], b[3]); return w; }
constexpr float QSCALE = 0.125f * 1.4426950408889634f;
__device__ __forceinline__ float sigmoidf_(float v) { return __builtin_amdgcn_rcpf(1.0f + __builtin_amdgcn_exp2f(-1.4426950408889634f * v)); }

struct Epi1 {
    static constexpr bool PERM = true, AFTER_DRAIN = false, HAS_MID = false; static constexpr int MID_T = -1;
    const float* rinv; const float* bgate; const float* qg; const float* kg;
    bf16_t *QS, *KS, *VS, *QD, *KD, *VD, *GT;
    __device__ __forceinline__ void mid(f32x4 (&)[2][2][4][2], const Unit&, int, int, int, int) const {}
    __device__ __forceinline__ void operator()(const f32x4 (&acc)[2][2][4][2], const Unit& u, int wr, int wc, int fr, int fq) const {
        asm volatile("" : "+v"(fr), "+v"(fq));
        const int pn = u.pn; const int row0 = u.pm * BM + wr * 64 + fr;
        if (pn >= 6 && pn < 12) {
            const bool isK = pn >= 9; const int head = (isK ? pn - 9 : pn - 6) * 4 + wc;
            const float* g = (isK ? kg : qg) + head * 64 + 8 * fq;
            f32x4 gv[2][2]; const float qsc = isK ? 1.0f : QSCALE;
#pragma unroll
            for (int bj = 0; bj < 2; ++bj)
#pragma unroll
                for (int n = 0; n < 2; ++n) gv[bj][n] = *(const f32x4*)(g + 32 * bj + 4 * n) * qsc;
            bf16_t* base = (isK ? KD : QD) + head * 64 + 8 * fq;
#pragma unroll
            for (int ai = 0; ai < 2; ++ai)
#pragma unroll
                for (int m = 0; m < 4; ++m) { const int row = row0 + ai * HALF + m * 16; const float r = 1.0f;
                    f32x4 v[2][2]; float ss = 0.f;
#pragma unroll
                    for (int bj = 0; bj < 2; ++bj)
#pragma unroll
                        for (int n = 0; n < 2; ++n) { v[bj][n] = acc[ai][bj][m][n] * r; const f32x4 q = v[bj][n] * v[bj][n]; ss += (q[0] + q[1]) + (q[2] + q[3]); }
                    ss += __shfl_xor(ss, 16); ss += __shfl_xor(ss, 32);
                    const float sc = __builtin_amdgcn_rsqf(ss * (1.0f / 64.0f) + 1e-6f);
#pragma unroll
                    for (int bj = 0; bj < 2; ++bj) *(u32x4*)(base + (size_t)row * 768 + 32 * bj) = pack8(v[bj][0] * sc * gv[bj][0], v[bj][1] * sc * gv[bj][1]);
                }
        } else if (pn < 15) {
            bf16_t* base; int ld, colt;
            if (pn < 2) { base = QS; ld = 512; colt = pn * 256; } else if (pn < 4) { base = KS; ld = 512; colt = (pn - 2) * 256; } else if (pn < 6) { base = VS; ld = 512; colt = (pn - 4) * 256; } else { base = VD; ld = 768; colt = (pn - 12) * 256; }
            base += colt + wc * 32 + 8 * fq;
#pragma unroll
            for (int ai = 0; ai < 2; ++ai)
#pragma unroll
                for (int m = 0; m < 4; ++m) { const int row = row0 + ai * HALF + m * 16; const float r = (pn < 2 ? QSCALE : 1.0f);
#pragma unroll
                    for (int bj = 0; bj < 2; ++bj) *(u32x4*)(base + (size_t)row * ld + bj * HALF) = pack8(acc[ai][bj][m][0] * r, acc[ai][bj][m][1] * r);
                }
        } else {
            const int col0 = (pn - 15) * 256 + wc * 32 + 8 * fq;
            f32x4 bv[2][2];
#pragma unroll
            for (int bj = 0; bj < 2; ++bj)
#pragma unroll
                for (int n = 0; n < 2; ++n) bv[bj][n] = *(const f32x4*)(bgate + col0 + bj * HALF + 4 * n);
#pragma unroll
            for (int ai = 0; ai < 2; ++ai)
#pragma unroll
                for (int m = 0; m < 4; ++m) { const int row = row0 + ai * HALF + m * 16; const float r = 1.0f;
#pragma unroll
                    for (int bj = 0; bj < 2; ++bj) { f32x4 a = acc[ai][bj][m][0] * r + bv[bj][0], b = acc[ai][bj][m][1] * r + bv[bj][1];
#pragma unroll
                        for (int e = 0; e < 4; ++e) { a[e] = sigmoidf_(a[e]); b[e] = sigmoidf_(b[e]); }
                        *(u32x4*)(GT + (size_t)row * 2048 + col0 + bj * HALF) = pack8(a, b); }
                }
        }
    }
};

struct Epi2 {
    static constexpr bool PERM = true, AFTER_DRAIN = false, HAS_MID = true; static constexpr int MID_T = 8;
    const bf16_t* GT; bf16_t* MIX;
    __device__ __forceinline__ void mid(f32x4 (&acc)[2][2][4][2], const Unit& u, int wr, int wc, int fr, int fq) const {
        asm volatile("" : "+v"(fr), "+v"(fq));
        const int row0 = u.pm * BM + wr * 64 + fr, col0 = u.pn * BM + wc * 32 + 8 * fq;
#pragma unroll
        for (int ai = 0; ai < 2; ++ai) { u32x4 ga[4][2], gb[4][2];
#pragma unroll
            for (int m = 0; m < 4; ++m) { const bf16_t* gp = GT + (size_t)(row0 + ai * HALF + m * 16) * 2048 + col0;
#pragma unroll
                for (int bj = 0; bj < 2; ++bj) { ga[m][bj] = *(const u32x4*)(gp + bj * HALF); gb[m][bj] = *(const u32x4*)(gp + 1024 + bj * HALF); } }
#pragma unroll
            for (int m = 0; m < 4; ++m)
#pragma unroll
                for (int bj = 0; bj < 2; ++bj) { const u32x4 a = ga[m][bj], b = gb[m][bj];
                    f32x4 r0, r1;
                    r0[0] = bflo(a.x) * __builtin_amdgcn_rcpf(fmaxf(bflo(b.x), 1e-30f)); r0[1] = bfhi(a.x) * __builtin_amdgcn_rcpf(fmaxf(bfhi(b.x), 1e-30f));
                    r0[2] = bflo(a.y) * __builtin_amdgcn_rcpf(fmaxf(bflo(b.y), 1e-30f)); r0[3] = bfhi(a.y) * __builtin_amdgcn_rcpf(fmaxf(bfhi(b.y), 1e-30f));
                    r1[0] = bflo(a.z) * __builtin_amdgcn_rcpf(fmaxf(bflo(b.z), 1e-30f)); r1[1] = bfhi(a.z) * __builtin_amdgcn_rcpf(fmaxf(bfhi(b.z), 1e-30f));
                    r1[2] = bflo(a.w) * __builtin_amdgcn_rcpf(fmaxf(bflo(b.w), 1e-30f)); r1[3] = bfhi(a.w) * __builtin_amdgcn_rcpf(fmaxf(bfhi(b.w), 1e-30f));
                    acc[ai][bj][m][0] *= r0; acc[ai][bj][m][1] *= r1; }
            asm volatile("" ::: "memory");
        }
    }
    __device__ __forceinline__ void operator()(const f32x4 (&acc)[2][2][4][2], const Unit& u, int wr, int wc, int fr, int fq) const {
        asm volatile("" : "+v"(fr), "+v"(fq));
        const int row0 = u.pm * BM + wr * 64 + fr, col0 = u.pn * BM + wc * 32 + 8 * fq;
#pragma unroll
        for (int ai = 0; ai < 2; ++ai) { u32x4 gb[4][2];
#pragma unroll
            for (int m = 0; m < 4; ++m) { const bf16_t* gp = GT + (size_t)(row0 + ai * HALF + m * 16) * 2048 + 1024 + col0;
#pragma unroll
                for (int bj = 0; bj < 2; ++bj) gb[m][bj] = *(const u32x4*)(gp + bj * HALF); }
#pragma unroll
            for (int m = 0; m < 4; ++m) { const int row = row0 + ai * HALF + m * 16;
#pragma unroll
                for (int bj = 0; bj < 2; ++bj) { const u32x4 b = gb[m][bj];
                    f32x4 g0, g1;
                    g0[0] = fmaxf(bflo(b.x), 1e-30f); g0[1] = fmaxf(bfhi(b.x), 1e-30f); g0[2] = fmaxf(bflo(b.y), 1e-30f); g0[3] = fmaxf(bfhi(b.y), 1e-30f);
                    g1[0] = fmaxf(bflo(b.z), 1e-30f); g1[1] = fmaxf(bfhi(b.z), 1e-30f); g1[2] = fmaxf(bflo(b.w), 1e-30f); g1[3] = fmaxf(bfhi(b.w), 1e-30f);
                    *(u32x4*)(MIX + (size_t)row * 1024 + col0 + bj * HALF) = pack8(acc[ai][bj][m][0] * g0, acc[ai][bj][m][1] * g1); } }
            asm volatile("" ::: "memory");
        }
    }
};

struct Epi3 {
    static constexpr bool PERM = true, AFTER_DRAIN = false, HAS_MID = false; static constexpr int MID_T = -1;
    const float* x; bf16_t* x1b; float* ssq;
    __device__ __forceinline__ void mid(f32x4 (&)[2][2][4][2], const Unit&, int, int, int, int) const {}
    __device__ __forceinline__ void operator()(const f32x4 (&acc)[2][2][4][2], const Unit& u, int wr, int wc, int fr, int fq) const {
        asm volatile("" : "+v"(fr), "+v"(fq));
        const int row0 = u.pm * BM + wr * 64 + fr, col0 = u.pn * BM + wc * 32 + 8 * fq;
#pragma unroll
        for (int ai = 0; ai < 2; ++ai) { f32x4 xv[4][2][2];
#pragma unroll
            for (int m = 0; m < 4; ++m) { const size_t off = (size_t)(row0 + ai * HALF + m * 16) * 1024 + col0;
#pragma unroll
                for (int bj = 0; bj < 2; ++bj) { xv[m][bj][0] = *(const f32x4*)(x + off + bj * HALF); xv[m][bj][1] = *(const f32x4*)(x + off + bj * HALF + 4); } }
#pragma unroll
            for (int m = 0; m < 4; ++m) { const int row = row0 + ai * HALF + m * 16; const size_t off = (size_t)row * 1024 + col0; float ss = 0.f;
#pragma unroll
                for (int bj = 0; bj < 2; ++bj) { const f32x4 v0 = acc[ai][bj][m][0] + xv[m][bj][0], v1 = acc[ai][bj][m][1] + xv[m][bj][1];
                    *(u32x4*)(x1b + off + bj * HALF) = pack8(v0, v1);
                    const f32x4 q0 = v0 * v0, q1 = v1 * v1; ss += ((q0[0] + q0[1]) + (q0[2] + q0[3])) + ((q1[0] + q1[1]) + (q1[2] + q1[3])); }
                ss += __shfl_xor(ss, 16); ss += __shfl_xor(ss, 32);
                if (fq == 0) ssq[(size_t)row * 16 + u.pn * 4 + wc] = ss;
            }
            asm volatile("" ::: "memory");
        }
    }
};

__device__ __forceinline__ unsigned f2key(float v) { const unsigned u = __float_as_uint(v); return (u & 0x80000000u) ? ~u : (u | 0x80000000u); }
__device__ __forceinline__ float key2f(unsigned k) { return __uint_as_float((k & 0x80000000u) ? (k & 0x7fffffffu) : ~k); }
#define PG8_CE(a_, b_) do { const unsigned hi__ = (a_) > (b_) ? (a_) : (b_); const unsigned lo__ = (a_) > (b_) ? (b_) : (a_); (a_) = hi__; (b_) = lo__; } while (0)
__device__ __forceinline__ void bitonic_merge16(unsigned (&v)[16]) {
#pragma unroll
    for (int j = 8; j >= 1; j >>= 1)
#pragma unroll
        for (int i = 0; i < 16; ++i) { const int l = i ^ j; if (l > i) PG8_CE(v[i], v[l]); }
}
__device__ __forceinline__ void bitonic_sort16(unsigned (&v)[16]) {
#pragma unroll
    for (int k = 2; k <= 16; k <<= 1)
#pragma unroll
        for (int j = k >> 1; j >= 1; j >>= 1)
#pragma unroll
            for (int i = 0; i < 16; ++i) { const int l = i ^ j; if (l > i) { if ((i & k) == 0 || k == 16) PG8_CE(v[i], v[l]); else PG8_CE(v[l], v[i]); } }
}
__device__ __forceinline__ void merge_top16(unsigned (&t)[16], const unsigned (&o)[16]) {
#pragma unroll
    for (int i = 0; i < 16; ++i) t[i] = t[i] > o[15 - i] ? t[i] : o[15 - i];
    bitonic_merge16(t);
}
template <int XM> __device__ __forceinline__ void merge_top16_xor(unsigned (&t)[16]) {
    unsigned o[16];
#pragma unroll
    for (int i = 0; i < 16; ++i) o[i] = (unsigned)__shfl_xor((int)t[i], XM);
    merge_top16(t, o);
}

struct Epi4 {
    static constexpr bool PERM = false, AFTER_DRAIN = true, HAS_MID = false; static constexpr int MID_T = -1;
    const float* ssq; float* rinv2; unsigned short* ids; float* gw;
    __device__ __forceinline__ void mid(f32x4 (&)[2][2][4][2], const Unit&, int, int, int, int) const {}
    __device__ __forceinline__ void fused(f32x4 (&acc)[2][2][4][2], const Unit& u, int wr, int wc, int fr, int fq, PG8_LAS unsigned char* lds, int wid, int lane) const {
        asm volatile("" : "+v"(fr), "+v"(fq));
        const int tid = wid * 64 + lane;
        const int rl = tid >> 2, p = (tid >> 1) & 1, hf = tid & 1, q4 = tid & 3;
#pragma unroll
        for (int pass = 0; pass < 2; ++pass) {
#pragma unroll
            for (int m = 0; m < 4; ++m)
#pragma unroll
                for (int bj = 0; bj < 2; ++bj)
#pragma unroll
                    for (int n = 0; n < 2; ++n) *(PG8_LAS f32x4*)(lds + (size_t)(wr * 64 + m * 16 + fr) * 1056 + bj * 528 + (wc * 32 + n * 16 + fq * 4) * 4) = acc[pass][bj][m][n];
            asm volatile("s_waitcnt lgkmcnt(0)" ::: "memory"); __builtin_amdgcn_s_barrier(); asm volatile("" ::: "memory");
            const int row = u.pm * BM + pass * HALF + rl;
            unsigned tk[16];
#pragma unroll
            for (int i = 0; i < 16; ++i) tk[i] = 0u;
            const PG8_LAS unsigned char* sp = lds + (size_t)rl * 1056 + p * 528 + hf * 256;
#pragma nounroll
            for (int c = 0; c < 4; ++c) { unsigned ch[16];
#pragma unroll
                for (int e4 = 0; e4 < 4; ++e4) { const f32x4 v = *(const PG8_LAS f32x4*)(sp + c * 64 + e4 * 16);
#pragma unroll
                    for (int e = 0; e < 4; ++e) ch[4 * e4 + e] = (f2key(v[e]) & ~127u) | (unsigned)(127 - (64 * hf + 16 * c + 4 * e4 + e)); }
                bitonic_sort16(ch);
                merge_top16(tk, ch);
            }
            merge_top16_xor<1>(tk);
            asm volatile("s_waitcnt lgkmcnt(0)" ::: "memory");
            PG8_LAS unsigned* kl = (PG8_LAS unsigned*)(lds + (size_t)(rl & ~15) * 1056) + ((rl & 15) * 2) * 16;
            if (hf == 0) {
#pragma unroll
                for (int i = 0; i < 4; ++i) *(PG8_LAS u32x4*)(kl + p * 16 + 4 * i) = (u32x4){tk[4 * i], tk[4 * i + 1], tk[4 * i + 2], tk[4 * i + 3]}; }
            asm volatile("s_waitcnt lgkmcnt(0)" ::: "memory");
            unsigned ck[16];
#define CAND_SLOT(m_, ij__) do { const unsigned i__ = (ij__) >> 4, j__ = (ij__) & 15u; \
                const unsigned ka__ = kl[(ij__) == 0xFFFFu ? 0u : i__], kb__ = kl[16 + ((ij__) == 0xFFFFu ? 0u : j__)]; \
                const float s__ = key2f(ka__ & ~127u) + key2f(kb__ & ~127u); \
                ck[m_] = (ij__) == 0xFFFFu ? 0u : ((f2key(s__) & ~255u) | (255u - (ij__))); } while (0)
                { const unsigned ij_ = q4 == 0 ? 0u : q4 == 1 ? 1u : q4 == 2 ? 2u : 3u; CAND_SLOT(0, ij_); }
                { const unsigned ij_ = q4 == 0 ? 4u : q4 == 1 ? 5u : q4 == 2 ? 6u : 7u; CAND_SLOT(1, ij_); }
                { const unsigned ij_ = q4 == 0 ? 8u : q4 == 1 ? 9u : q4 == 2 ? 10u : 11u; CAND_SLOT(2, ij_); }
                { const unsigned ij_ = q4 == 0 ? 12u : q4 == 1 ? 13u : q4 == 2 ? 14u : 15u; CAND_SLOT(3, ij_); }
                { const unsigned ij_ = q4 == 0 ? 16u : q4 == 1 ? 17u : q4 == 2 ? 18u : 19u; CAND_SLOT(4, ij_); }
                { const unsigned ij_ = q4 == 0 ? 20u : q4 == 1 ? 21u : q4 == 2 ? 22u : 23u; CAND_SLOT(5, ij_); }
                { const unsigned ij_ = q4 == 0 ? 32u : q4 == 1 ? 33u : q4 == 2 ? 34u : 35u; CAND_SLOT(6, ij_); }
                { const unsigned ij_ = q4 == 0 ? 36u : q4 == 1 ? 48u : q4 == 2 ? 49u : 50u; CAND_SLOT(7, ij_); }
                { const unsigned ij_ = q4 == 0 ? 51u : q4 == 1 ? 64u : q4 == 2 ? 65u : 66u; CAND_SLOT(8, ij_); }
                { const unsigned ij_ = q4 == 0 ? 80u : q4 == 1 ? 81u : q4 == 2 ? 96u : 97u; CAND_SLOT(9, ij_); }
                { const unsigned ij_ = q4 == 0 ? 112u : q4 == 1 ? 113u : q4 == 2 ? 128u : 144u; CAND_SLOT(10, ij_); }
                { const unsigned ij_ = q4 == 0 ? 160u : q4 == 1 ? 176u : q4 == 2 ? 192u : 208u; CAND_SLOT(11, ij_); }
                { const unsigned ij_ = q4 == 0 ? 224u : q4 == 1 ? 240u : q4 == 2 ? 65535u : 65535u; CAND_SLOT(12, ij_); }
#undef CAND_SLOT
            ck[13] = 0u; ck[14] = 0u; ck[15] = 0u;
            bitonic_sort16(ck);
            merge_top16_xor<1>(ck); merge_top16_xor<2>(ck);
            float sq = 0.f;
#pragma unroll
            for (int i = 0; i < 4; ++i) { const f32x4 t = *(const f32x4*)(ssq + (size_t)row * 16 + 4 * i); sq += (t[0] + t[1]) + (t[2] + t[3]); }
            const float r2 = __builtin_amdgcn_rsqf(sq * (1.0f / 1024.0f) + 1e-6f);
            if (u.pn == 0 && q4 == 0) rinv2[row] = r2;
            const float b0 = key2f(ck[0] & ~255u); float wsum = 0.f; float wv[16];
#pragma unroll
            for (int q = 0; q < 16; ++q) { wv[q] = __builtin_amdgcn_exp2f((key2f(ck[q] & ~255u) - b0) * r2 * 1.4426950408889634f); wsum += wv[q]; }
            const float inv = 1.0f / wsum;
            unsigned short eo[4]; float go[4];
#pragma unroll
            for (int e = 0; e < 4; ++e) { unsigned c0 = ck[e], c1 = ck[4 + e], c2 = ck[8 + e], c3 = ck[12 + e]; float w0 = wv[e], w1 = wv[4 + e], w2 = wv[8 + e], w3 = wv[12 + e];
                asm volatile("" : "+v"(c0), "+v"(c1), "+v"(c2), "+v"(c3), "+v"(w0), "+v"(w1), "+v"(w2), "+v"(w3));
                const unsigned cc = q4 == 0 ? c0 : q4 == 1 ? c1 : q4 == 2 ? c2 : c3; const float ww = q4 == 0 ? w0 : q4 == 1 ? w1 : q4 == 2 ? w2 : w3;
                const unsigned code = 255u - (cc & 255u);
                const unsigned i1 = 127u - (kl[code >> 4] & 127u), i2 = 127u - (kl[16 + (code & 15u)] & 127u);
                eo[e] = (unsigned short)(i1 * 128u + i2); go[e] = ww * inv; }
            const size_t ob = ((size_t)row * 8 + u.pn) * 16 + q4 * 4;
            { u32x2 w; w.x = eo[0] | ((unsigned)eo[1] << 16); w.y = eo[2] | ((unsigned)eo[3] << 16); *(u32x2*)(ids + ob) = w; }
            *(f32x4*)(gw + ob) = (f32x4){go[0], go[1], go[2], go[3]};
            asm volatile("s_waitcnt lgkmcnt(0)" ::: "memory"); __builtin_amdgcn_s_barrier(); asm volatile("" ::: "memory");
        }
    }
};
template <class Epi, class Sched, bool ALIGN_EPI = false, bool SP2 = false>
__device__ __forceinline__ void gemm_phase(PG8_LAS unsigned char* lds, const Gemm g, const Sched& S, const Epi& E) {
    const int tid = threadIdx.x, wid = __builtin_amdgcn_readfirstlane(tid >> 6), lane = tid & 63, wr = wid >> 2, wc = wid & 3, fr = lane & 15, fq = lane >> 4;
    const int K = g.K, nt = K / BK;
    unsigned voffA[2], voffB[2];
#pragma unroll
    for (int i = 0; i < 2; ++i) { int R, C; stage_rc(tid * 16 + i * 8192, R, C); const int Rb = Epi::PERM ? ((R & ~31) + perm32(R & 31)) : R;
        voffA[i] = (unsigned)(R * K + C) * 2u; voffB[i] = (unsigned)(Rb * K + C) * 2u; }
    const size_t kstep = (size_t)(BK * 2);
    const size_t hstep = (size_t)HALF * K * 2;
    const size_t tstep = 2 * hstep;
    const unsigned ldsw = (unsigned)wid * 1024u;
    const int aoff = lds_byte(wr * 64 + fr, fq * 8), boff = lds_byte(wc * 32 + fr, fq * 8);
#define PG8_SA(b, h) (((b) * 2 + (h)) * HTB)
#define PG8_SB(b, h) ((4 + (b) * 2 + (h)) * HTB)
#define PG8_STAGE(bufoff, gbase, voff) do { _Pragma("unroll") for (int _i = 0; _i < 2; ++_i) \
        __builtin_amdgcn_global_load_lds((const unsigned*)((const char*)(gbase) + (voff)[_i]), (PG8_LAS unsigned*)(lds + (bufoff) + ldsw + _i * 8192), 16, 0, 0); } while (0)
#define PG8_LDA(dst, b, h) do { _Pragma("unroll") for (int m = 0; m < 4; ++m) _Pragma("unroll") for (int k = 0; k < 2; ++k) dst[m][k] = *(const PG8_LAS bf16x8*)(lds + PG8_SA(b, h) + aoff + m * 2048 + k * 1024); } while (0)
#define PG8_LDB(dst, b, h) do { _Pragma("unroll") for (int n = 0; n < 2; ++n) _Pragma("unroll") for (int k = 0; k < 2; ++k) dst[n][k] = *(const PG8_LAS bf16x8*)(lds + PG8_SB(b, h) + boff + n * 2048 + k * 1024); } while (0)
#define PG8_MMA(ai, bj, At, Bt) do { __builtin_amdgcn_s_setprio(1); _Pragma("unroll") for (int m = 0; m < 4; ++m) _Pragma("unroll") for (int n = 0; n < 2; ++n) _Pragma("unroll") for (int k = 0; k < 2; ++k) \
        acc[ai][bj][m][n] = __builtin_amdgcn_mfma_f32_16x16x32_bf16(Bt[n][k], At[m][k], acc[ai][bj][m][n], 0, 0, 0); __builtin_amdgcn_s_setprio(0); } while (0)
#define PG8_WAIT_V(n) asm volatile("s_waitcnt vmcnt(" #n ")" ::: "memory")
#define PG8_WAIT_L(n) asm volatile("s_waitcnt lgkmcnt(" #n ")" ::: "memory")
#define PG8_BAR __builtin_amdgcn_s_barrier()
#define PG8_SCHED __builtin_amdgcn_sched_barrier(0)
    Unit cur, nxt; int ui = 0;
    if (!S.next(0, cur)) return;
    f32x4 acc[2][2][4][2];
#pragma unroll
    for (int a = 0; a < 2; ++a)
#pragma unroll
        for (int b = 0; b < 2; ++b)
#pragma unroll
            for (int m = 0; m < 4; ++m)
#pragma unroll
                for (int n = 0; n < 2; ++n) acc[a][b][m][n] = (f32x4){0.f, 0.f, 0.f, 0.f};
    bf16x8 At[4][2], B0[2][2], B1[2][2];
    const char* cA = (const char*)g.A + (size_t)cur.pm * tstep; const char* cB = (const char*)g.Bt + (size_t)cur.pn * tstep;
    S.a_ready(cur);
    if constexpr (SP2) {
        PG8_STAGE(PG8_SB(0, 0), cB, voffB); PG8_STAGE(PG8_SB(0, 1), cB + hstep, voffB); PG8_STAGE(PG8_SA(0, 0), cA, voffA); PG8_STAGE(PG8_SA(0, 1), cA + hstep, voffA);
        if (wr == 1) PG8_BAR;
        PG8_WAIT_V(2); PG8_BAR;
        PG8_STAGE(PG8_SB(1, 0), cB + kstep, voffB); PG8_STAGE(PG8_SA(1, 0), cA + kstep, voffA); PG8_STAGE(PG8_SB(1, 1), cB + hstep + kstep, voffB);
        PG8_WAIT_V(6); PG8_BAR;
    } else {
        PG8_STAGE(PG8_SB(0, 0), cB, voffB); PG8_STAGE(PG8_SA(0, 0), cA, voffA); PG8_STAGE(PG8_SB(0, 1), cB + hstep, voffB); PG8_STAGE(PG8_SA(0, 1), cA + hstep, voffA);
        if (wr == 1) PG8_BAR;
        PG8_WAIT_V(4); PG8_BAR;
        PG8_STAGE(PG8_SB(1, 0), cB + kstep, voffB); PG8_STAGE(PG8_SA(1, 0), cA + kstep, voffA); PG8_STAGE(PG8_SB(1, 1), cB + hstep + kstep, voffB);
        PG8_WAIT_V(6); PG8_BAR;
    }
    for (;;) {
        const bool has_next = S.next(ui + 1, nxt);
        const char* nA = has_next ? (const char*)g.A + (size_t)nxt.pm * tstep : cA; const char* nB = has_next ? (const char*)g.Bt + (size_t)nxt.pn * tstep : cB;
        for (int t = 0; t < nt; t += 2) {
            if constexpr (Epi::HAS_MID) { if (t == Epi::MID_T) E.mid(acc, cur, wr, wc, fr, fq); }
            const bool last = (t == nt - 2);
            const char* a1 = cA + (size_t)(t + 1) * kstep;
            const char* a2 = last ? nA : cA + (size_t)(t + 2) * kstep; const char* b2 = last ? nB : cB + (size_t)(t + 2) * kstep;
            const char* a3 = a2 + kstep; const char* b3 = b2 + kstep;
            if (last && has_next) S.a_ready(nxt);
            if constexpr (SP2) {
            PG8_LDB(B0, 0, 0); PG8_LDB(B1, 0, 1); PG8_SCHED; PG8_LDA(At, 0, 0); PG8_STAGE(PG8_SA(1, 1), a1 + hstep, voffA);
            PG8_WAIT_V(8); PG8_WAIT_L(0); PG8_BAR; PG8_MMA(0, 0, At, B0); PG8_MMA(0, 1, At, B1); PG8_BAR; PG8_SCHED;
            PG8_LDA(At, 0, 1); PG8_STAGE(PG8_SB(0, 0), b2, voffB); PG8_STAGE(PG8_SB(0, 1), b2 + hstep, voffB); PG8_STAGE(PG8_SA(0, 0), a2, voffA);
            PG8_WAIT_V(8); PG8_WAIT_L(0); PG8_BAR; PG8_MMA(1, 0, At, B0); PG8_MMA(1, 1, At, B1); PG8_BAR; PG8_SCHED;
            PG8_LDB(B0, 1, 0); PG8_LDB(B1, 1, 1); PG8_SCHED; PG8_LDA(At, 1, 0); PG8_STAGE(PG8_SA(0, 1), a2 + hstep, voffA);
            PG8_WAIT_V(8); PG8_WAIT_L(0); PG8_BAR; PG8_MMA(0, 0, At, B0); PG8_MMA(0, 1, At, B1); PG8_BAR; PG8_SCHED;
            PG8_LDA(At, 1, 1); PG8_STAGE(PG8_SB(1, 0), b3, voffB); PG8_STAGE(PG8_SB(1, 1), b3 + hstep, voffB); PG8_STAGE(PG8_SA(1, 0), a3, voffA);
            PG8_WAIT_V(8); PG8_WAIT_L(0); PG8_BAR; PG8_MMA(1, 0, At, B0); PG8_MMA(1, 1, At, B1); PG8_BAR; PG8_SCHED;
            } else {
            PG8_LDB(B0, 0, 0); PG8_SCHED; PG8_LDA(At, 0, 0); PG8_STAGE(PG8_SA(1, 1), a1 + hstep, voffA);
            PG8_WAIT_L(8); PG8_BAR; PG8_WAIT_L(0); PG8_MMA(0, 0, At, B0); PG8_BAR; PG8_SCHED;
            PG8_LDB(B1, 0, 1); PG8_STAGE(PG8_SB(0, 0), b2, voffB);
            PG8_BAR; PG8_WAIT_L(0); PG8_MMA(0, 1, At, B1); PG8_BAR;
            PG8_LDA(At, 0, 1); PG8_STAGE(PG8_SA(0, 0), a2, voffA);
            PG8_BAR; PG8_WAIT_L(0); PG8_MMA(1, 0, At, B0); PG8_BAR; PG8_SCHED;
            PG8_STAGE(PG8_SB(0, 1), b2 + hstep, voffB);
            PG8_WAIT_V(6); PG8_BAR; PG8_MMA(1, 1, At, B1); PG8_BAR;
            PG8_LDB(B0, 1, 0); PG8_SCHED; PG8_LDA(At, 1, 0); PG8_STAGE(PG8_SA(0, 1), a2 + hstep, voffA);
            PG8_WAIT_L(8); PG8_BAR; PG8_WAIT_L(0); PG8_MMA(0, 0, At, B0); PG8_BAR; PG8_SCHED;
            PG8_LDB(B1, 1, 1); PG8_STAGE(PG8_SB(1, 0), b3, voffB);
            PG8_BAR; PG8_WAIT_L(0); PG8_MMA(0, 1, At, B1); PG8_BAR;
            PG8_LDA(At, 1, 1); PG8_STAGE(PG8_SA(1, 0), a3, voffA);
            PG8_BAR; PG8_WAIT_L(0); PG8_MMA(1, 0, At, B0); PG8_BAR; PG8_SCHED;
            PG8_STAGE(PG8_SB(1, 1), b3 + hstep, voffB);
            PG8_WAIT_V(6); PG8_BAR; PG8_MMA(1, 1, At, B1); PG8_BAR;
            }
        }
        if constexpr (ALIGN_EPI) { if (wr == 0) PG8_BAR; }
        if constexpr (!Epi::AFTER_DRAIN) { E(acc, cur, wr, wc, fr, fq); S.done(cur); }
        if (!has_next) break;
#pragma unroll
        for (int a = 0; a < 2; ++a)
#pragma unroll
            for (int b = 0; b < 2; ++b)
#pragma unroll
                for (int m = 0; m < 4; ++m)
#pragma unroll
                    for (int n = 0; n < 2; ++n) acc[a][b][m][n] = (f32x4){0.f, 0.f, 0.f, 0.f};
        cur = nxt; cA = nA; cB = nB; ++ui;
        if constexpr (ALIGN_EPI) { if (wr == 1) PG8_BAR; }
    }
    PG8_WAIT_V(0);
    if constexpr (!ALIGN_EPI) { if (wr == 0) PG8_BAR; }
    PG8_BAR;
    if constexpr (Epi::AFTER_DRAIN) { E.fused(acc, cur, wr, wc, fr, fq, lds, wid, lane); S.done(cur); }
#undef PG8_SA
#undef PG8_SB
#undef PG8_STAGE
#undef PG8_LDA
#undef PG8_LDB
#undef PG8_MMA
#undef PG8_WAIT_V
#undef PG8_WAIT_L
#undef PG8_BAR
#undef PG8_SCHED
}
}


namespace att {
#define ALAS __attribute__((address_space(3)))
typedef unsigned short bf16;
typedef short bf16x8 __attribute__((ext_vector_type(8)));
typedef short s16x4 __attribute__((ext_vector_type(4)));
typedef float f32x16 __attribute__((ext_vector_type(16)));
typedef float f32x4 __attribute__((ext_vector_type(4)));
typedef float f32x2 __attribute__((ext_vector_type(2)));
typedef unsigned u32x4 __attribute__((ext_vector_type(4)));
typedef __bf16 bf16x2_t __attribute__((ext_vector_type(2)));
constexpr int SEQ = 4096;
constexpr int VPITCH = 144;
constexpr float LOG2E = 1.4426950408889634f, LN2 = 0.6931471805599453f;
__device__ __forceinline__ unsigned pkbf(float lo, float hi) { f32x2 v = {lo, hi}; bf16x2_t b = __builtin_convertvector(v, bf16x2_t); return __builtin_bit_cast(unsigned, b); }
__device__ __forceinline__ void wave_lds_sync() { asm volatile("s_waitcnt lgkmcnt(0)" ::: "memory"); }
__device__ __forceinline__ s16x4 vtr(const ALAS unsigned char* p) { return __builtin_bit_cast(s16x4, __builtin_amdgcn_ds_read_tr16_b64_v4i16((ALAS s16x4*)p)); }
__device__ __forceinline__ int crow(int r, int hi) { return (r & 3) + 8 * (r >> 2) + 4 * hi; }

__device__ __forceinline__ void pv_tile(f32x16& o0, f32x16& o1, const float (&a)[16], const ALAS unsigned char* vt, int lane) {
    const int g = lane >> 4, i = lane & 15, q_ = i >> 2, p_ = i & 3, h = lane >> 5;
    const ALAS unsigned char* vb = vt + (8 * h + q_) * VPITCH + (16 * (g & 1) + 4 * p_) * 2;
    u32x4 pw0, pw1;
    pw0.x = pkbf(a[0], a[1]); pw0.y = pkbf(a[2], a[3]); pw0.z = pkbf(a[4], a[5]); pw0.w = pkbf(a[6], a[7]);
    pw1.x = pkbf(a[8], a[9]); pw1.y = pkbf(a[10], a[11]); pw1.z = pkbf(a[12], a[13]); pw1.w = pkbf(a[14], a[15]);
    const bf16x8 pa0 = __builtin_bit_cast(bf16x8, pw0), pa1 = __builtin_bit_cast(bf16x8, pw1);
#pragma unroll
    for (int s = 0; s < 2; ++s) {
        const s16x4 l0 = vtr(vb + (16 * s) * VPITCH), h0 = vtr(vb + (16 * s + 4) * VPITCH);
        const s16x4 l1 = vtr(vb + (16 * s) * VPITCH + 64), h1 = vtr(vb + (16 * s + 4) * VPITCH + 64);
        const bf16x8 v0 = (bf16x8){l0[0], l0[1], l0[2], l0[3], h0[0], h0[1], h0[2], h0[3]};
        const bf16x8 v1 = (bf16x8){l1[0], l1[1], l1[2], l1[3], h1[0], h1[1], h1[2], h1[3]};
        o0 = __builtin_amdgcn_mfma_f32_32x32x16_bf16(s ? pa1 : pa0, v0, o0, 0, 0, 0);
        o1 = __builtin_amdgcn_mfma_f32_32x32x16_bf16(s ? pa1 : pa0, v1, o1, 0, 0, 0);
    }
}
__device__ __forceinline__ void bcast_rows(float v, ALAS float* sc, int r32, int hi, float (&out)[16]) {
    if (hi == 0) sc[r32] = v;
    wave_lds_sync();
#pragma unroll
    for (int g = 0; g < 4; ++g) { const f32x4 t = *(const ALAS f32x4*)(sc + 8 * g + 4 * hi); out[4 * g] = t[0]; out[4 * g + 1] = t[1]; out[4 * g + 2] = t[2]; out[4 * g + 3] = t[3]; }
    wave_lds_sync();
}
__device__ __forceinline__ void store_o(const f32x16& o0, const f32x16& o1, ALAS unsigned char* stg, bf16* dst  , size_t rstride_elems, int lane) {
    const int r32 = lane & 31, hi = lane >> 5;
    wave_lds_sync();
#pragma unroll
    for (int r = 0; r < 16; ++r) { const int q = crow(r, hi);
        *(ALAS unsigned short*)(stg + q * VPITCH + r32 * 2) = (unsigned short)(pkbf(o0[r], 0.f) & 0xffffu);
        *(ALAS unsigned short*)(stg + q * VPITCH + 64 + r32 * 2) = (unsigned short)(pkbf(o1[r], 0.f) & 0xffffu); }
    wave_lds_sync();
#pragma unroll
    for (int i = 0; i < 4; ++i) { const int row = 8 * i + (lane >> 3), ch = lane & 7; const u32x4 v = *(const ALAS u32x4*)(stg + row * VPITCH + ch * 16); *(u32x4*)(dst + (size_t)row * rstride_elems + ch * 8) = v; }
    wave_lds_sync();
}

__device__ __forceinline__ void sb_item(const bf16* QS, const bf16* KS, const bf16* VS, bf16* OC, int b, int h, int qt, ALAS unsigned char* wl, int lane) {
    const int r32 = lane & 31, hi = lane >> 5;
    const int t0 = qt * 32; const size_t rowb = (size_t)b * SEQ;
    const int kperm = (r32 & ~12) | ((r32 & 4) << 1) | ((r32 & 8) >> 1);
    bf16x8 qf[4];
    { const bf16* qp = QS + (rowb + t0 + r32) * 512 + h * 64 + hi * 8;
#pragma unroll
      for (int d0 = 0; d0 < 4; ++d0) qf[d0] = *(const bf16x8*)(qp + d0 * 16); }
    f32x16 o0 = {}, o1 = {}; float R = 0.f;
    for (int key0 = t0; key0 >= 0; key0 -= 32) {
        const bf16* kp = KS + (rowb + key0 + kperm) * 512 + h * 64 + hi * 8;
        bf16x8 kf[4];
#pragma unroll
        for (int d0 = 0; d0 < 4; ++d0) kf[d0] = *(const bf16x8*)(kp + d0 * 16);
        u32x4 vv[4];
#pragma unroll
        for (int i = 0; i < 4; ++i) vv[i] = *(const u32x4*)(VS + (rowb + key0 + 8 * i + (lane >> 3)) * 512 + h * 64 + (lane & 7) * 8);
        f32x16 p = {};
#pragma unroll
        for (int d0 = 0; d0 < 4; ++d0) p = __builtin_amdgcn_mfma_f32_32x32x16_bf16(kf[d0], qf[d0], p, 0, 0, 0);
#pragma unroll
        for (int i = 0; i < 4; ++i) *(ALAS u32x4*)(wl + (8 * i + (lane >> 3)) * VPITCH + (lane & 7) * 16) = vv[i];
        const bool diag = (key0 == t0);
        float z2[16], L2[16];
#pragma unroll
        for (int r = 0; r < 16; ++r) { const int kk = (r & 7) + 8 * hi + 16 * (r >> 3); const float zz = p[r];
            const float sp = fmaxf(zz, 0.f) + __builtin_amdgcn_logf(1.0f + __builtin_amdgcn_exp2f(-fabsf(zz)));
            const bool valid = !diag || (kk < r32); z2[r] = zz; L2[r] = valid ? sp : 0.f; }
        float c[16];
        c[15] = L2[15];
#pragma unroll
        for (int r = 14; r >= 8; --r) c[r] = c[r + 1] + L2[r];
        c[7] = L2[7];
#pragma unroll
        for (int r = 6; r >= 0; --r) c[r] = c[r + 1] + L2[r];
        const float TB = c[8], TA = c[0];
        const float TBo = __shfl_xor(TB, 32), TAo = __shfl_xor(TA, 32);
        const float offB = R + (hi ? 0.f : TBo);
        const float offA = R + TB + TBo + (hi ? 0.f : TAo);
        float a[16];
#pragma unroll
        for (int r = 0; r < 16; ++r) { const int kk = (r & 7) + 8 * hi + 16 * (r >> 3); const bool valid = !diag || (kk < r32);
            const float e = __builtin_amdgcn_exp2f(z2[r] - (c[r] + (r < 8 ? offA : offB))); a[r] = valid ? e : 0.f; }
        R += (TA + TB) + (TAo + TBo);
        wave_lds_sync();
        pv_tile(o0, o1, a, wl, lane);
        wave_lds_sync();
        if (__all(R > 40.0f * LOG2E)) break;
    }
    store_o(o0, o1, wl, OC + (rowb + t0) * 768 + h * 64, 768, lane);
}

constexpr int DLU_WAVE = 5120;
constexpr int DLU_O = 8 * DLU_WAVE, DLU_M = DLU_O + 512 * 128, DLU_L = DLU_M + 2048, DLU_BYTES = DLU_L + 2048;
__device__ __forceinline__ void dl_unit(const bf16* QD, const bf16* KD, const bf16* VD, bf16* OC, int b, int j, int blk, ALAS unsigned char* lds, int wave, int lane) {
    const int r32 = lane & 31, hi = lane >> 5;
    const size_t rowb = (size_t)b * SEQ;
    const int t0 = 512 * blk;
    const int kperm = (r32 & ~12) | ((r32 & 4) << 1) | ((r32 & 8) >> 1);
    ALAS unsigned char* wl = lds + wave * DLU_WAVE;
    ALAS float* sc = (ALAS float*)(wl + 4608);
    ALAS unsigned short* OL = (ALAS unsigned short*)(lds + DLU_O);
    ALAS float* ML = (ALAS float*)(lds + DLU_M); ALAS float* LL = (ALAS float*)(lds + DLU_L);
    for (int g = 2; g >= 0; --g) {
        const int hh = 4 * g + j, sh = 2 * g, r = 1 << sh;
        const float slope2 = __builtin_amdgcn_exp2f(-8.0f * (float)(hh + 1) / 12.0f) * LOG2E;
        const float sr = slope2 * (float)r;
        for (int it = wave; it < 16; it += 8) {
            const int q0 = g == 2 ? it : g == 1 ? (it & 3) + 128 * (it >> 2) : 32 * it;
            const int tq = t0 + q0 + r * r32, tmax = t0 + q0 + 31 * r;
            bf16x8 qf[4];
            { const bf16* qp = QD + (rowb + tq) * 768 + hh * 64 + hi * 8;
#pragma unroll
              for (int d0 = 0; d0 < 4; ++d0) qf[d0] = *(const bf16x8*)(qp + d0 * 16); }
            const int klo = 31 - r32; int khi = klo + 128; { const int kmaxtok = tmax >> sh; khi = khi < kmaxtok ? khi : kmaxtok; }
            const unsigned krange = (unsigned)(khi - klo);
            f32x16 o0 = {}, o1 = {}; float mrun = -3.0e38f, lrun = 0.f;
            if (g != 2) {
                mrun = ML[q0 + r * r32]; lrun = hi ? 0.f : LL[q0 + r * r32];
#pragma unroll
                for (int q = 0; q < 16; ++q) { const int tl = q0 + r * crow(q, hi);
                    o0[q] = __uint_as_float((unsigned)OL[tl * 64 + r32] << 16); o1[q] = __uint_as_float((unsigned)OL[tl * 64 + 32 + r32] << 16); }
            }
            for (int kt = 0; kt < 5; ++kt) {
                int sk = tmax - r * (32 * kt + kperm); sk = sk < 0 ? 0 : sk;
                const bf16* kp = KD + (rowb + sk) * 768 + hh * 64 + hi * 8;
                bf16x8 kf[4];
#pragma unroll
                for (int d0 = 0; d0 < 4; ++d0) kf[d0] = *(const bf16x8*)(kp + d0 * 16);
                u32x4 vv[4];
#pragma unroll
                for (int i = 0; i < 4; ++i) { int sv = tmax - r * (32 * kt + 8 * i + (lane >> 3)); sv = sv < 0 ? 0 : sv; vv[i] = *(const u32x4*)(VD + (rowb + sv) * 768 + hh * 64 + (lane & 7) * 8); }
                const int dk = 32 * kt + 8 * hi - klo;
                const float tb = -sr * (float)dk;
                f32x16 p;
#pragma unroll
                for (int q = 0; q < 16; ++q) p[q] = tb - sr * (float)((q & 7) + 16 * (q >> 3));
#pragma unroll
                for (int d0 = 0; d0 < 4; ++d0) p = __builtin_amdgcn_mfma_f32_32x32x16_bf16(kf[d0], qf[d0], p, 0, 0, 0);
#pragma unroll
                for (int i = 0; i < 4; ++i) *(ALAS u32x4*)(wl + (8 * i + (lane >> 3)) * VPITCH + (lane & 7) * 16) = vv[i];
                float z2[16]; float mt = -3.0e38f;
#pragma unroll
                for (int q = 0; q < 16; ++q) { const bool valid = (unsigned)(dk + ((q & 7) + 16 * (q >> 3))) <= krange; z2[q] = valid ? p[q] : -INFINITY; mt = fmaxf(mt, z2[q]); }
                mt = fmaxf(mt, __shfl_xor(mt, 32));
                if (__any(mt > mrun + 8.0f)) {
                    const float mnew = fmaxf(mrun, mt); const float alpha = __builtin_amdgcn_exp2f(mrun - mnew);
                    lrun *= alpha; float al[16]; bcast_rows(alpha, sc, r32, hi, al);
#pragma unroll
                    for (int q = 0; q < 16; ++q) { o0[q] *= al[q]; o1[q] *= al[q]; }
                    mrun = mnew;
                }
                float a[16]; float ls = 0.f;
#pragma unroll
                for (int q = 0; q < 16; ++q) { a[q] = __builtin_amdgcn_exp2f(z2[q] - mrun); ls += a[q]; }
                lrun += ls;
                wave_lds_sync();
                pv_tile(o0, o1, a, wl, lane);
                wave_lds_sync();
            }
            const float ltot = lrun + __shfl_xor(lrun, 32);
            if (g != 0) {
                if (hi == 0) { ML[q0 + r * r32] = mrun; LL[q0 + r * r32] = ltot; }
#pragma unroll
                for (int q = 0; q < 16; ++q) { const int tl = q0 + r * crow(q, hi);
                    OL[tl * 64 + r32] = (unsigned short)(pkbf(o0[q], 0.f) & 0xffffu); OL[tl * 64 + 32 + r32] = (unsigned short)(pkbf(o1[q], 0.f) & 0xffffu); }
            } else {
                float il[16]; bcast_rows(1.0f / ltot, sc, r32, hi, il);
#pragma unroll
                for (int q = 0; q < 16; ++q) { o0[q] *= il[q]; o1[q] *= il[q]; }
                store_o(o0, o1, wl, OC + (rowb + t0 + q0) * 768 + 512 + j * 64, 768, lane);
            }
        }
        asm volatile("s_waitcnt lgkmcnt(0)" ::: "memory"); __builtin_amdgcn_s_barrier(); asm volatile("" ::: "memory");
    }
}
#undef ALAS
}

constexpr int NWAVES = 8;
#ifndef MK_N_LAUNCHES
#define MK_N_LAUNCHES 1
#endif
#ifndef MK_LAST_PHASE
#define MK_LAST_PHASE 8
#endif
constexpr int N_LAUNCHES = MK_N_LAUNCHES;
constexpr int PER_PHASE = 8;

constexpr int BATCH = 16, SEQ = 4096, D = 1024, T = BATCH * SEQ;
constexpr int N1 = 5888;
constexpr int NEXP = 16384;
constexpr size_t MiB = 1u << 20;
constexpr size_t WS_CTL = 0, CTL_ZERO_BYTES = 1 * MiB;
constexpr size_t WS_WIN = 2 * MiB;
constexpr size_t WS_WCAT = 16 * MiB;
constexpr size_t WS_WOUT = 18 * MiB;
constexpr size_t WS_WC = 20 * MiB;
constexpr size_t WS_RINV1 = 24 * MiB;
constexpr size_t WS_RINV2 = 25 * MiB;
constexpr size_t WS_USC = 25 * MiB + 512 * 1024, WS_VSC = 25 * MiB + 768 * 1024;
constexpr size_t WS_SSQ = 26 * MiB;
constexpr size_t WS_U8 = 32 * MiB;
constexpr size_t WS_V8 = 64 * MiB;
constexpr size_t WS_IDS = 96 * MiB;
constexpr size_t WS_GW = 112 * MiB;
constexpr size_t WS_XB = 144 * MiB;
constexpr size_t WS_QS = 272 * MiB, WS_KS = 336 * MiB, WS_VS = 400 * MiB;
constexpr size_t WS_QD = 464 * MiB, WS_KD = 560 * MiB, WS_VD = 656 * MiB;
constexpr size_t WS_GT = 752 * MiB;
constexpr size_t WS_COEF = 272 * MiB;
constexpr size_t WS_MIX = 272 * MiB;
constexpr size_t WS_X1B = 400 * MiB;
constexpr size_t WS_HQ = 528 * MiB;
constexpr size_t WS_HS2 = 24 * MiB + 512 * 1024;
constexpr size_t WS_END = 1008 * MiB;
constexpr int CW_BAR = 4096;
constexpr int CW_XRANK = 8192;

constexpr int RING_OFF = 0, RING_BYTES = 131072;
constexpr int LDSCTL_OFF = 143360, MISC_OFF = LDSCTL_OFF + 320;
constexpr int LDS_BYTES = 147456;
static_assert(MISC_OFF + 128 <= LDS_BYTES, "LDS map");
#define GAS __attribute__((address_space(1)))
#define LAS __attribute__((address_space(3)))
typedef unsigned short bf16;
typedef unsigned v4u __attribute__((ext_vector_type(4)));
typedef float f32x4 __attribute__((ext_vector_type(4)));
typedef short bf16x8 __attribute__((ext_vector_type(8)));
typedef GAS unsigned gu32;
typedef GAS unsigned long long gu64;
#define RLX_AGENT __ATOMIC_RELAXED, __HIP_MEMORY_SCOPE_AGENT
#define LDS_WAIT() asm volatile("s_waitcnt lgkmcnt(0)" ::: "memory")
#define VM_WAIT() asm volatile("s_waitcnt vmcnt(0)" ::: "memory")
__device__ __forceinline__ unsigned long long rt() { return __builtin_amdgcn_s_memrealtime(); }
__device__ __forceinline__ unsigned f2bf(float f) { unsigned u = __builtin_bit_cast(unsigned, f); return (u + 0x7fffu + ((u >> 16) & 1u)) >> 16; }
__device__ __forceinline__ unsigned pk2(float lo, float hi) { return f2bf(lo) | (f2bf(hi) << 16); }

#define XB_TMO      128
#define XB_XCNT(j)  (256  + 64 * (j))
#define XB_XSUB(j)  (1280 + 64 * (j))
#define XB_XGEN(j)  (2304 + 64 * (j))
#define XB_TOP      3328
#define XB_TOPGEN   3392
#define XCD_BAR_WORDS 3456
#define XB_SPIN_CAP (1u << 18)

__device__ __forceinline__ unsigned xb_ld(unsigned* p)              { return __hip_atomic_load(p, __ATOMIC_RELAXED, __HIP_MEMORY_SCOPE_AGENT); }
__device__ __forceinline__ unsigned xb_add(unsigned* p, unsigned v) { return __hip_atomic_fetch_add(p, v, __ATOMIC_RELAXED, __HIP_MEMORY_SCOPE_AGENT); }
__device__ __forceinline__ unsigned xb_xcc_id() { return (unsigned)__builtin_amdgcn_s_getreg((3 << 11) | 20) & 0xFu; }
#define XB_SPIN(cond, bar) do { unsigned _sp = 0; while (cond) { __builtin_amdgcn_s_sleep(1); \
    if ((++_sp & 255u) == 0u) { if (xb_ld(&(bar)[XB_TMO])) break; if (_sp > XB_SPIN_CAP) { atomicAdd(&(bar)[XB_TMO], 1u); break; } } } } while (0)

struct XcdBarrier {
    unsigned* bar; unsigned x;
    volatile LAS unsigned* st;
};

__device__ __forceinline__ XcdBarrier xcd_barrier_post(unsigned* bar, volatile LAS unsigned* st) {
    XcdBarrier b; b.bar = bar; b.x = xb_xcc_id(); b.st = st;
    if (threadIdx.x == 0) (void)xb_add(&bar[XB_XCNT(b.x)], 1u);
    return b;
}
__device__ __forceinline__ void xcd_barrier_complete(unsigned* bar, unsigned x, unsigned& nloc, unsigned& nx) {
    const unsigned G = gridDim.x * gridDim.y * gridDim.z;
    unsigned sum, cnt, mine, sp = 0u;
    for (;;) {
        sum = 0u; cnt = 0u; mine = 0u;
#pragma unroll
        for (unsigned j = 0; j < 16; ++j) { const unsigned c = xb_ld(&bar[XB_XCNT(j)]); sum += c; cnt += (c > 0u) ? 1u : 0u; mine = (j == x) ? c : mine; }
        if (sum == G) break;
        __builtin_amdgcn_s_sleep(1);
        if ((++sp & 255u) == 0u) { if (xb_ld(&bar[XB_TMO])) break; if (sp > XB_SPIN_CAP) { atomicAdd(&bar[XB_TMO], 1u); break; } }
    }
    nloc = mine > 0u ? mine : 1u; nx = cnt > 0u ? cnt : 1u;
}

__device__ __forceinline__ void xcd_barrier(const XcdBarrier& b) {
    asm volatile("s_waitcnt vmcnt(0)" ::: "memory");
    __syncthreads();
    if (threadIdx.x == 0) {
        unsigned* bar = b.bar;
        __builtin_amdgcn_s_waitcnt(0);
        unsigned nloc = b.st[0], nx = b.st[1];
        if (nloc == 0u) { xcd_barrier_complete(bar, b.x, nloc, nx); b.st[0] = nloc; b.st[1] = nx; }
        const unsigned old = xb_add(&bar[XB_XSUB(b.x)], 1u);
        const unsigned gen = old / nloc;
        if (old + 1u == (gen + 1u) * nloc) {
            __builtin_amdgcn_fence(__ATOMIC_RELEASE, "agent");
            asm volatile("s_waitcnt vmcnt(0)" ::: "memory");
            const unsigned og = xb_add(&bar[XB_TOP], 1u);
            const unsigned tg = og / nx;
            if (og + 1u == (tg + 1u) * nx) xb_add(&bar[XB_TOPGEN], 1u);
            else XB_SPIN(xb_ld(&bar[XB_TOPGEN]) == tg, bar);
            __builtin_amdgcn_fence(__ATOMIC_ACQUIRE, "agent");
            xb_add(&bar[XB_XGEN(b.x)], 1u);
            asm volatile("s_waitcnt vmcnt(0)" ::: "memory");
        } else {
            XB_SPIN(xb_ld(&bar[XB_XGEN(b.x)]) == gen, bar);
            __builtin_amdgcn_fence(__ATOMIC_ACQUIRE, "agent");
            asm volatile("s_waitcnt vmcnt(0)" ::: "memory");
        }
    }
    __syncthreads();
}

typedef float f32x2 __attribute__((ext_vector_type(2)));
typedef unsigned v2u __attribute__((ext_vector_type(2)));
typedef _Float16 h2_t __attribute__((ext_vector_type(2)));
struct Frame {
    LAS unsigned char* lds;
    volatile LAS unsigned* MISC;
    gu32* ctl;
    int tid, lane, wave;
    int vcu, G;
};
__device__ __forceinline__ float wave_sum(float v) {
#pragma unroll
    for (int o = 1; o < 64; o <<= 1) v += __shfl_xor(v, o);
    return v;
}
__device__ __forceinline__ float wave_max(float v) {
#pragma unroll
    for (int o = 1; o < 64; o <<= 1) v = fmaxf(v, __shfl_xor(v, o));
    return v;
}
__device__ __forceinline__ int win_row(int n) { if (n < 1536 || n >= 3072) return n; const int t = (n - 1536) >> 8, ln = (n - 1536) & 255, hl = ln >> 6, d = ln & 63; return 1536 + t * 256 + 32 * hl + (d & 31) + 128 * (d >> 5); }
__device__ __forceinline__ void p0_transpose_item(const float* W, int N, const float* gain, bf16* WT, int ldt, int koff, int mode, LAS float* scr, int item, int lane) {
    const int nblk = N / 32, kb = item / nblk, nb = item % nblk, k0 = 64 * kb, n0 = 32 * nb;
#pragma unroll 8
    for (int i = 0; i < 32; ++i) { const int kk = 2 * i + (lane >> 5); float v = W[(size_t)(k0 + kk) * N + n0 + (lane & 31)]; if (gain) v *= gain[k0 + kk]; scr[kk * 33 + (lane & 31)] = v; }
    LDS_WAIT(); asm volatile("" ::: "memory");
    const int c = lane & 7;
#pragma unroll
    for (int j = 0; j < 4; ++j) { const int n = (lane >> 3) + 8 * j; const LAS float* s = scr + (8 * c) * 33 + n;
        v4u o; o.x = pk2(s[0 * 33], s[1 * 33]); o.y = pk2(s[2 * 33], s[3 * 33]); o.z = pk2(s[4 * 33], s[5 * 33]); o.w = pk2(s[6 * 33], s[7 * 33]);
        const int rown = mode ? win_row(n0 + n) : (n0 + n);
        *(GAS v4u*)(WT + (size_t)rown * ldt + koff + k0 + 8 * c) = o; }
    LDS_WAIT(); asm volatile("" ::: "memory");
}
__device__ __forceinline__ void quant_row_fp8(const float* src, const float* gain, unsigned char* dst, size_t slice_stride, float* scale_out, int lane) {
    f32x4 v[4]; float am = 0.f;
#pragma unroll
    for (int j = 0; j < 4; ++j) { v[j] = *(const GAS f32x4*)(src + 256 * j + 4 * lane); if (gain) v[j] = v[j] * *(const GAS f32x4*)(gain + 256 * j + 4 * lane);
        am = fmaxf(am, fmaxf(fmaxf(fabsf(v[j][0]), fabsf(v[j][1])), fmaxf(fabsf(v[j][2]), fabsf(v[j][3])))); }
    am = wave_max(am);
    const int ex = (int)((__float_as_uint(am) >> 23) & 0xffu);
    const float s = (ex == 0) ? 1.0f : __uint_as_float((unsigned)(127 + 7 - (ex - 127)) << 23);
    const float is = (ex == 0) ? 1.0f : __uint_as_float((unsigned)(127 - 7 + (ex - 127)) << 23);
    if (lane == 0) *scale_out = is;
#pragma unroll
    for (int j = 0; j < 4; ++j) { int pk = __builtin_amdgcn_cvt_pk_fp8_f32(v[j][0] * s, v[j][1] * s, 0, false); pk = __builtin_amdgcn_cvt_pk_fp8_f32(v[j][2] * s, v[j][3] * s, pk, true);
        const int col = 256 * j + 4 * lane; *(GAS int*)(dst + (size_t)(col >> 7) * slice_stride + (col & 127)) = pk; }
}
__device__ __forceinline__ void quant_row_fp4(const float* src, unsigned char* dst, size_t slice_stride, float* scale_out, int lane) {
    f32x4 v[4]; float am = 0.f;
#pragma unroll
    for (int j = 0; j < 4; ++j) { v[j] = *(const GAS f32x4*)(src + 256 * j + 4 * lane); am = fmaxf(am, fmaxf(fmaxf(fabsf(v[j][0]), fabsf(v[j][1])), fmaxf(fabsf(v[j][2]), fabsf(v[j][3])))); }
    am = wave_max(am);
    const float s = am > 0.f ? 6.0f / am : 0.f;
    if (lane == 0) *scale_out = am * (1.0f / 6.0f);
#pragma unroll
    for (int j = 0; j < 4; ++j) { unsigned pk = __builtin_amdgcn_cvt_scalef32_pk_fp4_f32(0u, v[j][0] * s, v[j][1] * s, 1.0f, 0); pk = __builtin_amdgcn_cvt_scalef32_pk_fp4_f32(pk, v[j][2] * s, v[j][3] * s, 1.0f, 1);
        *(GAS unsigned short*)(dst + (size_t)j * slice_stride + 2 * lane) = (unsigned short)(pk & 0xffffu); }
}
__device__ __forceinline__ void quant_row_i4(const float* src, const float* gain, unsigned char* dst, float* scale_out, int lane) {
    f32x4 v[4]; float am = 0.f, ss = 0.f;
    const int p16 = (lane >> 2) & 15, wl = lane & 3;
#pragma unroll
    for (int ld = 0; ld < 2; ++ld)
#pragma unroll
        for (int sn = 0; sn < 2; ++sn) { const int hd = 2 * (4 * ld + wl) + sn; const int idx = 256 * (hd >> 2) + 16 * p16 + 4 * (hd & 3);
            f32x4 t = *(const GAS f32x4*)(src + idx); if (gain) t = t * *(const GAS f32x4*)(gain + idx); v[2 * ld + sn] = t;
            am = fmaxf(am, fmaxf(fmaxf(fabsf(t[0]), fabsf(t[1])), fmaxf(fabsf(t[2]), fabsf(t[3])))); ss += (t[0] * t[0] + t[1] * t[1]) + (t[2] * t[2] + t[3] * t[3]); }
    am = wave_max(am); ss = wave_sum(ss);
    const float clipv = fminf(am, 2.5f * sqrtf(ss * (1.0f / 1024.0f)));
    const float s = clipv > 0.f ? 7.0f / clipv : 0.f;
    if (lane == 0) *scale_out = clipv * (1.0f / (7.0f * 16.0f));
#pragma unroll
    for (int ld = 0; ld < 2; ++ld) { unsigned pk = 0u;
#pragma unroll
        for (int b4 = 0; b4 < 4; ++b4) { int q0 = (int)__builtin_rintf(v[2 * ld][b4] * s), q1 = (int)__builtin_rintf(v[2 * ld + 1][b4] * s);
            q0 = q0 < -7 ? -7 : (q0 > 7 ? 7 : q0); q1 = q1 < -7 ? -7 : (q1 > 7 ? 7 : q1);
            pk |= ((unsigned)(q0 & 15) | ((unsigned)(q1 & 15) << 4)) << (8 * b4); }
        *(GAS unsigned*)(dst + ld * 256 + 16 * p16 + 4 * wl) = pk; }
}
__device__ __forceinline__ float gelu_f(float v) {
    const float av = fabsf(v), t = __builtin_amdgcn_rcpf(av * 0.2316418882f + 1.0f);
    float q = t * 0.5307027145f + (-0.7265760135f); q = q * t + 0.7107068705f; q = q * t + (-0.142248368f); q = q * t + 0.127414796f; q = q * t;
    const float e = __builtin_amdgcn_exp2f((v * v) * (-0.72134752044f));
    const float m = v * (q * e);
    return v < 0.f ? m : v - m;
}

struct Args { const float* in[14]; float* out; unsigned char* ws; int ph_lo, ph_hi, li, pad; };
__global__ void __launch_bounds__(NWAVES * 64, 2) fwd_kernel(Args args) {
    extern __shared__ __attribute__((aligned(16))) unsigned char lds[];
    Frame F;
    F.lds = (LAS unsigned char*)lds;
    F.MISC = (volatile LAS unsigned*)(F.lds + MISC_OFF);
    F.tid = threadIdx.x; F.lane = F.tid & 63; F.wave = __builtin_amdgcn_readfirstlane(F.tid >> 6);
    F.G = gridDim.x; { const int bx = blockIdx.x; F.vcu = (F.G % 8 == 0) ? (bx % 8) * (F.G / 8) + bx / 8 : bx; }
    unsigned char* ws = args.ws;
    F.ctl = (gu32*)(ws + WS_CTL);
    const float* x = args.in[0]; const float* norm1_gain = args.in[1]; const float* w_in = args.in[2]; const float* b_gate = args.in[3];
    const float* q_gain = args.in[4]; const float* k_gain = args.in[5]; const float* w_sb_out = args.in[6]; const float* w_dil_out = args.in[7];
    const float* w_out = args.in[8]; const float* norm2_gain = args.in[9]; const float* w_peer_q = args.in[10]; const float* sub_keys = args.in[11];
    const float* peer_u = args.in[12]; const float* peer_v = args.in[13];
    float* out = args.out;
    bf16* WIN = (bf16*)(ws + WS_WIN); bf16* WCAT = (bf16*)(ws + WS_WCAT); bf16* WOUT = (bf16*)(ws + WS_WOUT); bf16* WC = (bf16*)(ws + WS_WC);
    float* RINV1 = (float*)(ws + WS_RINV1); float* RINV2 = (float*)(ws + WS_RINV2); float* USC = (float*)(ws + WS_USC); float* VSC = (float*)(ws + WS_VSC); float* SSQ = (float*)(ws + WS_SSQ);
    unsigned char* U8 = ws + WS_U8; unsigned char* V8 = ws + WS_V8;
    unsigned short* IDS = (unsigned short*)(ws + WS_IDS); float* GW = (float*)(ws + WS_GW); float* COEF = (float*)(ws + WS_COEF); unsigned char* HQ = ws + WS_HQ; float* HS2 = (float*)(ws + WS_HS2);
    bf16* XB = (bf16*)(ws + WS_XB); bf16* OC = (bf16*)(ws + WS_XB);
    bf16* QS = (bf16*)(ws + WS_QS); bf16* KS = (bf16*)(ws + WS_KS); bf16* VS = (bf16*)(ws + WS_VS);
    bf16* QD = (bf16*)(ws + WS_QD); bf16* KD = (bf16*)(ws + WS_KD); bf16* VD = (bf16*)(ws + WS_VD);
    bf16* GT = (bf16*)(ws + WS_GT); bf16* MIX = (bf16*)(ws + WS_MIX); bf16* X1B = (bf16*)(ws + WS_X1B);

    for (int u = F.tid; u < (LDS_BYTES - LDSCTL_OFF) / 4; u += NWAVES * 64) ((LAS unsigned*)(F.lds + LDSCTL_OFF))[u] = 0u;
    __syncthreads();
    const int my_xcc = (int)xb_xcc_id();
    if (F.tid == 0) F.MISC[12] = xb_add((unsigned*)(F.ctl + CW_XRANK) + 64 * my_xcc, 1u);
    __syncthreads();
    const int my_xrank = (int)F.MISC[12];
    const int bli = (N_LAUNCHES == PER_PHASE) ? 0 : args.li;
    XcdBarrier bar; bar.bar = (unsigned*)(F.ctl + CW_BAR) + bli * XCD_BAR_WORDS; bar.x = 0; bar.st = nullptr;
    if (N_LAUNCHES != PER_PHASE) bar = xcd_barrier_post((unsigned*)(F.ctl + CW_BAR) + bli * XCD_BAR_WORDS, F.MISC + 8);
    const int lo = args.ph_lo, hi = args.ph_hi;
#ifndef PHASE_MASK
#define PHASE_MASK 0xff
#endif
#define IN(k) (((PHASE_MASK >> (k)) & 1) && lo <= (k) && (k) < hi)
#define BOTH(k) (IN(k) && IN((k) + 1))
#define GRID_BAR() do { if (N_LAUNCHES != PER_PHASE) xcd_barrier(bar); } while (0)
#ifndef PROBE_REPEAT
#define PROBE_REPEAT 0x00
#endif
#ifndef PROBE_L1
#define PROBE_L1 0x0
#endif
#define REP(k) _Pragma("unroll") for (int rep_ = 0; rep_ < (((PROBE_REPEAT >> (k)) & 1) ? 2 : 1); ++rep_)
    const int gw = F.vcu * NWAVES + F.wave, NGW = F.G * NWAVES;
#define P67_MAP() int vx = (int)(blockIdx.x & 7), rk = (int)(blockIdx.x >> 3), nrk = (F.G + 7 - vx) / 8; bool p67_uni = false; \
        { bool uni_ = (F.G % 8 == 0); for (int j_ = 0; j_ < 16; ++j_) { const unsigned c_ = xb_ld((unsigned*)(F.ctl + CW_XRANK) + 64 * j_); uni_ = uni_ && (c_ == (j_ < 8 ? (unsigned)(F.G / 8) : 0u)); } \
          if (uni_) { vx = my_xcc; rk = my_xrank; nrk = F.G / 8; p67_uni = true; } }

    if (IN(0)) REP(0) {
        for (int it = F.vcu; it < 256; it += F.G) {
            const int hp = it >> 4, d0 = (it & 15) * 64;
            LAS float* As = (LAS float*)(F.lds);
            LAS float* Bs = (LAS float*)(F.lds + 64 * 132 * 4);
            for (int e = F.tid; e < 64 * 32; e += 512) { const int r = e >> 5, c4 = (e & 31) * 4; *(LAS f32x4*)(As + r * 132 + c4) = *(const GAS f32x4*)(w_peer_q + (size_t)(d0 + r) * 2048 + hp * 128 + c4); }
            for (int e = F.tid; e < 128 * 32; e += 512) { const int r = e >> 5, c4 = (e & 31) * 4; *(LAS f32x4*)(Bs + r * 132 + c4) = *(const GAS f32x4*)(sub_keys + ((size_t)hp * 128 + r) * 128 + c4); }
            __syncthreads();
            const int ddg = F.tid & 15, ng = F.tid >> 4;
            f32x4 acc[4];
#pragma unroll
            for (int j = 0; j < 4; ++j) acc[j] = (f32x4){0.f, 0.f, 0.f, 0.f};
            for (int c4 = 0; c4 < 128; c4 += 4) {
                f32x4 a[4], b[4];
#pragma unroll
                for (int i = 0; i < 4; ++i) { a[i] = *(const LAS f32x4*)(As + (4 * ddg + i) * 132 + c4); b[i] = *(const LAS f32x4*)(Bs + (4 * ng + i) * 132 + c4); }
#pragma unroll
                for (int j = 0; j < 4; ++j)
#pragma unroll
                    for (int i = 0; i < 4; ++i) acc[j][i] += (a[i][0] * b[j][0] + a[i][1] * b[j][1]) + (a[i][2] * b[j][2] + a[i][3] * b[j][3]);
            }
            const f32x4 g2 = *(const GAS f32x4*)(norm2_gain + d0 + 4 * ddg);
#pragma unroll
            for (int j = 0; j < 4; ++j) { v2u o; o.x = pk2(acc[j][0] * g2[0], acc[j][1] * g2[1]); o.y = pk2(acc[j][2] * g2[2], acc[j][3] * g2[3]);
                *(GAS v2u*)(WC + (size_t)(hp * 128 + 4 * ng + j) * 1024 + d0 + 4 * ddg) = o; }
            __syncthreads();
        }
        {
            LAS float* scr = (LAS float*)(F.lds + RING_OFF + F.wave * 16384);
            constexpr int I_IN = (D / 64) * (N1 / 32), I_SB = (512 / 64) * (D / 32), I_DL = (256 / 64) * (D / 32), I_OUT = (D / 64) * (D / 32);
            constexpr int NITEMS = I_IN + I_SB + I_DL + I_OUT;
            for (int it = gw; it < NITEMS; it += NGW) {
                int r = it;
                if (r < I_IN) { p0_transpose_item(w_in, N1, norm1_gain, WIN, 1024, 0, 1, scr, r, F.lane); continue; } r -= I_IN;
                if (r < I_SB) { p0_transpose_item(w_sb_out, D, nullptr, WCAT, 768, 0, 0, scr, r, F.lane); continue; } r -= I_SB;
                if (r < I_DL) { p0_transpose_item(w_dil_out, D, nullptr, WCAT, 768, 512, 0, scr, r, F.lane); continue; } r -= I_DL;
                p0_transpose_item(w_out, D, nullptr, WOUT, 1024, 0, 0, scr, r, F.lane);
            }
        }
        for (int e = gw; e < 2 * NEXP; e += NGW) {
            if (e < NEXP) quant_row_i4(peer_u + (size_t)e * D, norm2_gain, U8 + (size_t)e * 512, USC + e, F.lane);
            else { const int ev = e - NEXP; quant_row_fp4(peer_v + (size_t)ev * D, V8 + (size_t)ev * 128, (size_t)NEXP * 128, VSC + ev, F.lane); }
        }
        for (int m = gw; m < T; m += NGW) {
            const GAS f32x4* xr = (const GAS f32x4*)(x + (size_t)m * D) + F.lane;
            f32x4 v[4]; float s = 0.f;
#pragma unroll
            for (int j = 0; j < 4; ++j) { v[j] = xr[64 * j]; s += (v[j][0] * v[j][0] + v[j][1] * v[j][1]) + (v[j][2] * v[j][2] + v[j][3] * v[j][3]); }
            s = wave_sum(s);
            const float rn = __builtin_amdgcn_rsqf(s * (1.0f / D) + 1e-6f);
            GAS unsigned long long* o8 = (GAS unsigned long long*)(XB + (size_t)m * D) + F.lane;
#pragma unroll
            for (int j = 0; j < 4; ++j) o8[64 * j] = (unsigned long long)pk2(v[j][0] * rn, v[j][1] * rn) | ((unsigned long long)pk2(v[j][2] * rn, v[j][3] * rn) << 32);
        }
        if (BOTH(0)) GRID_BAR();
    }

    if (IN(1)) REP(1) {
        pg8::Gemm g{XB, WIN, T, N1, D}; pg8::StaticOrder S; S.init(T, N1, F.G, (int)blockIdx.x);
        pg8::Epi1 E{RINV1, b_gate, q_gain, k_gain, QS, KS, VS, QD, KD, VD, GT};
        pg8::gemm_phase<pg8::Epi1, pg8::StaticOrder, true, true>(F.lds + RING_OFF, g, S, E);
        if (BOTH(1)) GRID_BAR();
    }

    if (IN(2)) REP(2) {
        LAS unsigned char* wl = F.lds + RING_OFF + F.wave * 16384;
        static_assert(att::DLU_BYTES <= RING_BYTES, "dilated-attention LDS state");
        for (int un = F.vcu; un < 512; un += F.G) { const int blk = un & 7, j = (un >> 3) & 3, b = un >> 5; att::dl_unit(QD, KD, VD, OC, b, j, blk, F.lds + RING_OFF, F.wave, F.lane); }
        for (int it = gw; it < 16384; it += NGW) { const int qt = 127 - (it & 127), h = (it >> 7) & 7, b = it >> 10; att::sb_item(QS, KS, VS, OC, b, h, qt, wl, F.lane); }
        if (BOTH(2)) GRID_BAR();
    }

    if (IN(3)) REP(3) {
        pg8::Gemm g{OC, WCAT, T, D, 768}; pg8::StaticOrder S; S.init(T, D, F.G, (int)blockIdx.x);
        pg8::Epi2 E{GT, MIX};
        pg8::gemm_phase<pg8::Epi2, pg8::StaticOrder, true, true>(F.lds + RING_OFF, g, S, E);
        if (BOTH(3)) GRID_BAR();
    }

    if (IN(4)) REP(4) {
        pg8::Gemm g{MIX, WOUT, T, D, D}; pg8::StaticOrder S; S.init(T, D, F.G, (int)blockIdx.x);
        pg8::Epi3 E{x, X1B, SSQ};
        pg8::gemm_phase<pg8::Epi3, pg8::StaticOrder, true, true>(F.lds + RING_OFF, g, S, E);
        if (BOTH(4)) GRID_BAR();
    }

    if (IN(5)) REP(5) {
        for (int m = gw; m < T; m += NGW) {
            const v4u a = *(const GAS v4u*)(X1B + (size_t)m * D + 8 * F.lane), b = *(const GAS v4u*)(X1B + (size_t)m * D + 512 + 8 * F.lane);
            float v[16] = {pg8::bflo(a.x), pg8::bfhi(a.x), pg8::bflo(a.y), pg8::bfhi(a.y), pg8::bflo(a.z), pg8::bfhi(a.z), pg8::bflo(a.w), pg8::bfhi(a.w),
                           pg8::bflo(b.x), pg8::bfhi(b.x), pg8::bflo(b.y), pg8::bfhi(b.y), pg8::bflo(b.z), pg8::bfhi(b.z), pg8::bflo(b.w), pg8::bfhi(b.w)};
            float am = 0.f;
#pragma unroll
            for (int i = 0; i < 16; ++i) am = fmaxf(am, fabsf(v[i]));
            am = wave_max(am);
            float sq = (F.lane < 16) ? SSQ[(size_t)m * 16 + F.lane] : 0.f; sq = wave_sum(sq);
            const float s = am > 0.f ? 127.0f / am : 0.f;
            if (F.lane == 0) HS2[m] = am * (1.0f / 127.0f) * __builtin_amdgcn_rsqf(sq * (1.0f / 1024.0f) + 1e-6f);
            int q[16];
#pragma unroll
            for (int i = 0; i < 16; ++i) q[i] = (int)__builtin_rintf(v[i] * s) & 0xff;
            v2u o0, o1; o0.x = q[0] | (q[1] << 8) | (q[2] << 16) | (q[3] << 24); o0.y = q[4] | (q[5] << 8) | (q[6] << 16) | (q[7] << 24);
            o1.x = q[8] | (q[9] << 8) | (q[10] << 16) | (q[11] << 24); o1.y = q[12] | (q[13] << 8) | (q[14] << 16) | (q[15] << 24);
            *(GAS v2u*)(HQ + (size_t)m * D + 8 * F.lane) = o0; *(GAS v2u*)(HQ + (size_t)m * D + 512 + 8 * F.lane) = o1;
        }
        pg8::Gemm g{X1B, WC, T, 2048, D}; pg8::StaticOrder S; S.init(T, 2048, F.G, (int)blockIdx.x);
        pg8::Epi4 E{SSQ, RINV2, IDS, GW};
        pg8::OneUnit O1;
        for (int i = 0; S.next(i, O1.u); ++i) pg8::gemm_phase<pg8::Epi4, pg8::OneUnit, false, true>(F.lds + RING_OFF, g, O1, E);
        if (BOTH(5)) GRID_BAR();
    }

    if (IN(6)) REP(6) {
        P67_MAP();
        const int p16 = F.lane & 15, sg = F.lane >> 4;
        LAS unsigned char* HB = F.lds + RING_OFF;
        LAS unsigned* LIST = (LAS unsigned*)(F.lds + RING_OFF + 65536);
        LAS unsigned* CNT = (LAS unsigned*)(F.lds + RING_OFF + 98304);
        LAS float* HSs = (LAS float*)(F.lds + RING_OFF + 98304 + 256);
        const int nblk = T / 64;
        const int gsel = (F.lane & 15), bpsrc = (16 * (F.lane & 3) + ((F.lane >> 2) & 3)) * 4;
        v4u hpre[8], idpre[2]; float hspre = 0.f;
#define P6_PRE(bb) do { const int bc_ = (bb) < nblk ? (bb) : nblk - 1; const unsigned char* hsrc_ = HQ + (size_t)bc_ * 65536; \
            _Pragma("unroll") for (int i_ = 0; i_ < 8; ++i_) hpre[i_] = *(const GAS v4u*)(hsrc_ + (size_t)(i_ * 512 + F.tid) * 16); \
            const unsigned short* isrc_ = IDS + ((size_t)bc_ * 64 + (F.tid >> 3)) * 128 + 16 * (F.tid & 7); idpre[0] = *(const GAS v4u*)isrc_; idpre[1] = *(const GAS v4u*)(isrc_ + 8); \
            hspre = HS2[(size_t)bc_ * 64 + (F.tid & 63)]; } while (0)
        int blk = rk;
        P6_PRE(blk);
        for (; blk < nblk; blk += nrk) {
            const int t0 = blk * 64;
            if (F.tid == 0) *CNT = 0u;
            if (F.tid < 64) HSs[F.tid] = hspre;
#pragma unroll
            for (int i = 0; i < 8; ++i) *(LAS v4u*)(HB + (size_t)(i * 512 + F.tid) * 16) = hpre[i];
            __syncthreads();
            { const unsigned idw[8] = {idpre[0].x, idpre[0].y, idpre[0].z, idpre[0].w, idpre[1].x, idpre[1].y, idpre[1].z, idpre[1].w};
              const unsigned tl = (unsigned)(F.tid >> 3), kb0 = 16u * (unsigned)(F.tid & 7);
#pragma unroll
              for (int i = 0; i < 16; ++i) { const unsigned e = (i & 1) ? (idw[i >> 1] >> 16) : (idw[i >> 1] & 0xffffu);
                  if ((int)(e >> 11) == vx) { const unsigned pos = __hip_atomic_fetch_add(CNT, 1u, __ATOMIC_RELAXED, __HIP_MEMORY_SCOPE_WORKGROUP); LIST[pos] = (tl << 24) | ((kb0 + (unsigned)i) << 16) | e; } } }
            __syncthreads();
            const int n = (int)*CNT;
            P6_PRE(blk + nrk);
#define P6_ISSUE(W, ENT, EJ, GB, UB, VB, base_) do { \
                _Pragma("unroll") for (int g_ = 0; g_ < 4; ++g_) { const int j_ = (base_) + 4 * g_ + sg; ENT[g_] = LIST[j_ < n ? j_ : n - 1]; } \
                { const int j_ = (base_) + gsel; EJ = (j_ < n && F.lane < 16) ? (int)LIST[j_] : -1; } \
                _Pragma("unroll") for (int g_ = 0; g_ < 4; ++g_) { const unsigned char* up_ = U8 + (size_t)((PROBE_L1 && rep_) ? 0u : (ENT[g_] & 0xffffu)) * 512 + 16 * p16; \
                    _Pragma("unroll") for (int i_ = 0; i_ < 2; ++i_) W[g_][i_] = *(const GAS v4u*)(up_ + 256 * i_); } \
                { const unsigned ej_ = EJ < 0 ? LIST[0] : (unsigned)EJ; GB = GW[((size_t)t0 + (ej_ >> 24)) * 128 + ((ej_ >> 16) & 127u)]; UB = USC[ej_ & 0xffffu]; VB = VSC[ej_ & 0xffffu]; } } while (0)
#define P6_DPPADD(a_, ctrl) a_ += __builtin_amdgcn_update_dpp(0, a_, ctrl, 0xf, 0xf, false)
#define P6_REDUCE(W, ENT, EJ, GB, UB, VB, base_) do { if ((base_) < n) { int ag_[4]; \
                _Pragma("unroll") for (int g_ = 0; g_ < 4; ++g_) { const LAS unsigned char* hp_ = HB + (size_t)(ENT[g_] >> 24) * 1024 + 16 * p16; int a_ = 0; v4u h_[4]; \
                    _Pragma("unroll") for (int i_ = 0; i_ < 4; ++i_) h_[i_] = *(const LAS v4u*)(hp_ + 256 * i_); \
                    _Pragma("unroll") for (int ld_ = 0; ld_ < 2; ++ld_) { const unsigned x_[4] = {W[g_][ld_].x, W[g_][ld_].y, W[g_][ld_].z, W[g_][ld_].w}; \
                        _Pragma("unroll") for (int wl_ = 0; wl_ < 4; ++wl_) { const int hd_ = 2 * (4 * ld_ + wl_); const unsigned lo_ = (x_[wl_] << 4) & 0xF0F0F0F0u, hi_ = x_[wl_] & 0xF0F0F0F0u; \
                            const unsigned hA_ = (hd_ & 3) == 0 ? h_[hd_ >> 2].x : h_[hd_ >> 2].z, hB_ = (hd_ & 3) == 0 ? h_[hd_ >> 2].y : h_[hd_ >> 2].w; \
                            a_ = __builtin_amdgcn_sdot4((int)lo_, (int)hA_, a_, false); a_ = __builtin_amdgcn_sdot4((int)hi_, (int)hB_, a_, false); } } \
                    P6_DPPADD(a_, 0xB1); P6_DPPADD(a_, 0x4E); P6_DPPADD(a_, 0x141); P6_DPPADD(a_, 0x140); ag_[g_] = a_; } \
                const int sel_ = gsel == 0 ? ag_[0] : gsel == 1 ? ag_[1] : gsel == 2 ? ag_[2] : ag_[3]; \
                const float resv_ = (float)__builtin_amdgcn_ds_bpermute(bpsrc, sel_); \
                if (EJ >= 0 && !(PROBE_L1 && rep_)) { const unsigned ej_ = (unsigned)EJ; const float act_ = gelu_f(resv_ * UB * HSs[ej_ >> 24]); \
                    COEF[((size_t)t0 + (ej_ >> 24)) * 128 + ((ej_ >> 16) & 127u)] = GB * act_ * VB; } } } while (0)
            for (int base = F.wave * 32; base < n; base += NWAVES * 32) {
                v4u wA[4][2], wB[4][2]; unsigned entA[4], entB[4]; int ejA, ejB; float gbA, ubA, vbA, gbB, ubB, vbB;
                P6_ISSUE(wA, entA, ejA, gbA, ubA, vbA, base);
                P6_ISSUE(wB, entB, ejB, gbB, ubB, vbB, base + 16);
                P6_REDUCE(wA, entA, ejA, gbA, ubA, vbA, base);
                P6_REDUCE(wB, entB, ejB, gbB, ubB, vbB, base + 16);
            }
#undef P6_ISSUE
#undef P6_REDUCE
#undef P6_DPPADD
            __syncthreads();
        }
#undef P6_PRE
        if (BOTH(6)) GRID_BAR();
    }

    if (IN(7)) REP(7) {
        P67_MAP();
        const int cs = vx >> 1;
        const int n0_ = p67_uni ? F.G / 8 : (F.G + 7 - 2 * cs) / 8, n1_ = p67_uni ? F.G / 8 : (F.G + 7 - (2 * cs + 1)) / 8;
        const int rk2 = (vx & 1) ? n0_ + rk : rk, nrk2 = n0_ + n1_;
        const int l8 = F.lane & 7, kg = F.lane >> 3;
        const unsigned char* vbase = V8 + (size_t)cs * NEXP * 128 + 16 * l8;
        const int tstep = nrk2 * NWAVES;
        const int col = 256 * cs + 32 * l8 + ((F.lane & 8) ? 16 : 0) + ((F.lane & 16) ? 8 : 0) + ((F.lane & 32) ? 4 : 0);
#define P7_CL(tt) ((tt) < T ? (tt) : T - 1)
#define P7_IDS(tt, ID) do { const int tc_ = P7_CL(tt); ID[0] = *(const GAS v4u*)(IDS + (size_t)tc_ * 128 + 16 * kg); ID[1] = *(const GAS v4u*)(IDS + (size_t)tc_ * 128 + 16 * kg + 8); } while (0)
#define P7_ISSUE(tt, ID, W, CF, OO) do { const int tc_ = P7_CL(tt); const unsigned idw_[8] = {ID[0].x, ID[0].y, ID[0].z, ID[0].w, ID[1].x, ID[1].y, ID[1].z, ID[1].w}; \
            _Pragma("unroll") for (int i_ = 0; i_ < 16; ++i_) { const unsigned e_ = (i_ & 1) ? (idw_[i_ >> 1] >> 16) : (idw_[i_ >> 1] & 0xffffu); W[i_] = *(const GAS v4u*)(vbase + (size_t)((PROBE_L1 && rep_) ? 0u : e_) * 128); } \
            _Pragma("unroll") for (int i_ = 0; i_ < 4; ++i_) CF[i_] = *(const GAS f32x4*)(COEF + (size_t)tc_ * 128 + 16 * kg + 4 * i_); \
            OO = *(const GAS v2u*)(X1B + (size_t)tc_ * D + col); } while (0)
#define P7_BYTE(d_, s_) do { const h2_t r_ = __builtin_amdgcn_cvt_scalef32_pk_f16_fp4(ww_[d_], 1.0f, s_); acc_[4 * (d_) + (s_)] = r_ * c2_ + acc_[4 * (d_) + (s_)]; } while (0)
#define P7_COMPUTE(tt, W, CF, OO) do { h2_t acc_[16];                 \
            _Pragma("unroll") for (int i_ = 0; i_ < 16; ++i_) acc_[i_] = (h2_t){(_Float16)0.f, (_Float16)0.f}; \
            _Pragma("unroll") for (int i_ = 0; i_ < 16; ++i_) { const unsigned ww_[4] = {W[i_].x, W[i_].y, W[i_].z, W[i_].w}; const _Float16 ch_ = (_Float16)CF[i_ >> 2][i_ & 3]; const h2_t c2_ = {ch_, ch_}; \
                P7_BYTE(0, 0); P7_BYTE(0, 1); P7_BYTE(0, 2); P7_BYTE(0, 3); P7_BYTE(1, 0); P7_BYTE(1, 1); P7_BYTE(1, 2); P7_BYTE(1, 3); \
                P7_BYTE(2, 0); P7_BYTE(2, 1); P7_BYTE(2, 2); P7_BYTE(2, 3); P7_BYTE(3, 0); P7_BYTE(3, 1); P7_BYTE(3, 2); P7_BYTE(3, 3); } \
            float r16_[16], r8_[8], r4_[4]; \
            { const bool up_ = (F.lane & 8) != 0; _Pragma("unroll") for (int i_ = 0; i_ < 8; ++i_) { const h2_t keep_ = up_ ? acc_[8 + i_] : acc_[i_], send_ = up_ ? acc_[i_] : acc_[8 + i_]; \
                const h2_t oth_ = __builtin_bit_cast(h2_t, __shfl_xor(__builtin_bit_cast(int, send_), 8)); r16_[2 * i_] = (float)keep_[0] + (float)oth_[0]; r16_[2 * i_ + 1] = (float)keep_[1] + (float)oth_[1]; } } \
            { const bool up_ = (F.lane & 16) != 0; _Pragma("unroll") for (int i_ = 0; i_ < 8; ++i_) { const float keep_ = up_ ? r16_[8 + i_] : r16_[i_], send_ = up_ ? r16_[i_] : r16_[8 + i_]; r8_[i_] = keep_ + __shfl_xor(send_, 16); } } \
            { const bool up_ = (F.lane & 32) != 0; _Pragma("unroll") for (int i_ = 0; i_ < 4; ++i_) { const float keep_ = up_ ? r8_[4 + i_] : r8_[i_], send_ = up_ ? r8_[i_] : r8_[4 + i_]; r4_[i_] = keep_ + __shfl_xor(send_, 32); } } \
            if ((tt) < T) *(GAS f32x4*)((rep_ == 0 ? out : (float*)(ws + WS_GT)) + (size_t)(tt) * D + col) = (f32x4){pg8::bflo(OO.x) + r4_[0], pg8::bfhi(OO.x) + r4_[1], pg8::bflo(OO.y) + r4_[2], pg8::bfhi(OO.y) + r4_[3]}; } while (0)
        v4u idA[2], idB[2], wA[16], wB[16]; f32x4 cfA[4], cfB[4]; v2u ooA, ooB;
        int t = rk2 * NWAVES + F.wave;
        P7_IDS(t, idA); P7_IDS(t + tstep, idB);
        while (t < T) {
            P7_ISSUE(t, idA, wA, cfA, ooA); P7_ISSUE(t + tstep, idB, wB, cfB, ooB);
            P7_IDS(t + 2 * tstep, idA); P7_IDS(t + 3 * tstep, idB);
            P7_COMPUTE(t, wA, cfA, ooA);
            P7_COMPUTE(t + tstep, wB, cfB, ooB);
            t += 2 * tstep;
        }
#undef P7_CL
#undef P7_IDS
#undef P7_ISSUE
#undef P7_BYTE
#undef P7_COMPUTE
    }
#undef IN
#undef BOTH
#undef GRID_BAR
}

extern "C" void kernel_launch(void* const* d_in, const int* in_sizes, int n_in, void* d_out, int out_size, void* d_ws, size_t ws_size, hipStream_t stream) {
    static int grid = 0;
    if (grid == 0) {
        if (n_in != 14 || in_sizes[0] != T * D || out_size != T * D || ws_size < WS_END) { fprintf(stderr, "kernel_launch: built for 14 inputs, x and out of %d floats, >= %zu bytes of workspace; got n_in %d, in0 %d, out %d, ws %zu; nothing launched\n", T * D, (size_t)WS_END, n_in, n_in > 0 ? in_sizes[0] : -1, out_size, ws_size); grid = -1; return; }
        int dev = 0, cus = 0, per_cu = 0;
        if (hipGetDevice(&dev) != hipSuccess || hipDeviceGetAttribute(&cus, hipDeviceAttributeMultiprocessorCount, dev) != hipSuccess) { fprintf(stderr, "kernel_launch: hipGetDevice / hipDeviceGetAttribute failed\n"); grid = -1; return; }
        if (hipFuncSetAttribute((const void*)fwd_kernel, hipFuncAttributeMaxDynamicSharedMemorySize, LDS_BYTES) != hipSuccess) { fprintf(stderr, "kernel_launch: hipFuncSetAttribute failed\n"); grid = -1; return; }
        if (hipOccupancyMaxActiveBlocksPerMultiprocessor(&per_cu, (const void*)fwd_kernel, NWAVES * 64, LDS_BYTES) != hipSuccess || per_cu < 1)
            fprintf(stderr, "kernel_launch: note: occupancy query reports %d workgroups per CU\n", per_cu);
        (void)hipGetLastError();
        grid = cus;
    }
    if (grid < 0) return;
    if (hipMemsetAsync((char*)d_ws + WS_CTL, 0, CTL_ZERO_BYTES, stream) != hipSuccess) { fprintf(stderr, "kernel_launch: hipMemsetAsync failed\n"); return; }
    Args a{};
    for (int i = 0; i < 14; ++i) a.in[i] = (const float*)d_in[i];
    a.out = (float*)d_out; a.ws = (unsigned char*)d_ws;
    for (int li = 0; li < N_LAUNCHES; ++li) {
        a.ph_lo = (N_LAUNCHES == PER_PHASE) ? li : 0; a.ph_hi = (N_LAUNCHES == PER_PHASE) ? li + 1 : MK_LAST_PHASE; a.li = li;
        if (a.ph_lo >= MK_LAST_PHASE) break;
        hipLaunchKernelGGL(fwd_kernel, dim3(grid), dim3(NWAVES * 64), LDS_BYTES, stream, a);
        const hipError_t le = hipPeekAtLastError();
        if (le != hipSuccess) { fprintf(stderr, "kernel_launch: launch %d failed: %s\n", li, hipGetErrorName(le)); break; }
    }
}
```

```cpp
#include <hip/hip_runtime.h>
#include <cstdio>
#include <cstdint>
namespace pg8 {
#define PG8_LAS __attribute__((address_space(3)))
typedef unsigned short bf16_t;
typedef short bf16x8 __attribute__((ext_vector_type(8)));
typedef float f32x4 __attribute__((ext_vector_type(4)));
typedef unsigned u32x4 __attribute__((ext_vector_type(4)));
typedef int i32x8 __attribute__((ext_vector_type(8)));
constexpr int BM = 256, BK = 64, HALF = 128, HTB = HALF * BK * 2  , STAGE_BYTES = 8 * HTB, NXCD = 8, WGM = 8;

__host__ __device__ __forceinline__ int lds_byte(int r, int c) { const int st = (r >> 4) * 2 + (c >> 5), rr = r & 15, cc = c & 31, ob = rr * 64 + cc * 2; return st * 1024 + (ob ^ (((ob >> 9) & 1) << 5)); }
__host__ __device__ __forceinline__ void stage_rc(int b, int& R, int& C) { const int st = b / 1024, sb = b % 1024, swz = sb ^ (((sb >> 9) & 1) << 5); R = (st >> 1) * 16 + swz / 64; C = (st & 1) * 32 + (swz % 64) / 2; }
__host__ __device__ __forceinline__ int perm32(int rho) { const int n = rho >> 4, i = rho & 15; return 8 * (i >> 2) + 4 * n + (i & 3); }

struct Unit { int pm, pn; };
struct Gemm { const bf16_t* A; const bf16_t* Bt; int M, N, K; };

struct StaticOrder {
    int nM, nN, nwg, G, c;
    __host__ __device__ void init(int M, int N, int G_, int c_) { nM = M / BM; nN = N / BM; nwg = nM * nN; G = G_; c = c_; }
    __host__ __device__ bool next(int i, Unit& u) const {
        const long L = (long)i * G + c; if (L >= nwg) return false;
        int wgid = (int)L; { const int q = nwg / NXCD, r = nwg % NXCD, xcd = wgid % NXCD, off = wgid / NXCD; wgid = (xcd < r ? xcd * (q + 1) : r * (q + 1) + (xcd - r) * q) + off; }
        const int nig = WGM * nN, gid = wgid / nig, fm = gid * WGM, gsz = (nM - fm) < WGM ? (nM - fm) : WGM;
        u.pm = fm + ((wgid % nig) % gsz); u.pn = (wgid % nig) / gsz; return true;
    }
    __device__ __forceinline__ void a_ready(const Unit&) const {}
    __device__ __forceinline__ void done(const Unit&) const {}
};


struct OneUnit {
    Unit u;
    __device__ __forceinline__ bool next(int i, Unit& o) const { if (i != 0) return false; o = u; return true; }
    __device__ __forceinline__ void a_ready(const Unit&) const {}
    __device__ __forceinline__ void done(const Unit&) const {}
};

typedef float f32x2 __attribute__((ext_vector_type(2)));
typedef __bf16 bf16x2_t __attribute__((ext_vector_type(2)));
typedef unsigned u32x2 __attribute__((ext_vector_type(2)));
__device__ __forceinline__ unsigned pkbf(float lo, float hi) { f32x2 v = {lo, hi}; bf16x2_t b = __builtin_convertvector(v, bf16x2_t); return __builtin_bit_cast(unsigned, b); }
__device__ __forceinline__ float bflo(unsigned w) { return __uint_as_float(w << 16); }
__device__ __forceinline__ float bfhi(unsigned w) { return __uint_as_float(w & 0xffff0000u); }
__device__ __forceinline__ u32x4 pack8(const f32x4 a, const f32x4 b) { u32x4 w; w.x = pkbf(a[0], a[1]); w.y = pkbf(a[2], a[3]); w.z = pkbf(b[0], b[1]); w.w = pkbf(b[2], b[3]); return w; }
constexpr float QSCALE = 0.125f * 1.4426950408889634f;
__device__ __forceinline__ float sigmoidf_(float v) { return __builtin_amdgcn_rcpf(1.0f + __builtin_amdgcn_exp2f(-1.4426950408889634f * v)); }

struct Epi1 {
    static constexpr bool PERM = true, AFTER_DRAIN = false, HAS_MID = false; static constexpr int MID_T = -1;
    const float* rinv; const float* bgate; const float* qg; const float* kg;
    bf16_t *QS, *KS, *VS, *QD, *KD, *VD, *GT;
    __device__ __forceinline__ void mid(f32x4 (&)[2][2][4][2], const Unit&, int, int, int, int) const {}
    __device__ __forceinline__ void operator()(const f32x4 (&acc)[2][2][4][2], const Unit& u, int wr, int wc, int fr, int fq) const {
        asm volatile("" : "+v"(fr), "+v"(fq));
        const int pn = u.pn; const int row0 = u.pm * BM + wr * 64 + fr;
        if (pn >= 6 && pn < 12) {
            const bool isK = pn >= 9; const int head = (isK ? pn - 9 : pn - 6) * 4 + wc;
            const float* g = (isK ? kg : qg) + head * 64 + 8 * fq;
            f32x4 gv[2][2]; const float qsc = isK ? 1.0f : QSCALE;
#pragma unroll
            for (int bj = 0; bj < 2; ++bj)
#pragma unroll
                for (int n = 0; n < 2; ++n) gv[bj][n] = *(const f32x4*)(g + 32 * bj + 4 * n) * qsc;
            bf16_t* base = (isK ? KD : QD) + head * 64 + 8 * fq;
#pragma unroll
            for (int ai = 0; ai < 2; ++ai)
#pragma unroll
                for (int m = 0; m < 4; ++m) { const int row = row0 + ai * HALF + m * 16; const float r = 1.0f;
                    f32x4 v[2][2]; float ss = 0.f;
#pragma unroll
                    for (int bj = 0; bj < 2; ++bj)
#pragma unroll
                        for (int n = 0; n < 2; ++n) { v[bj][n] = acc[ai][bj][m][n] * r; const f32x4 q = v[bj][n] * v[bj][n]; ss += (q[0] + q[1]) + (q[2] + q[3]); }
                    ss += __shfl_xor(ss, 16); ss += __shfl_xor(ss, 32);
                    const float sc = __builtin_amdgcn_rsqf(ss * (1.0f / 64.0f) + 1e-6f);
#pragma unroll
                    for (int bj = 0; bj < 2; ++bj) *(u32x4*)(base + (size_t)row * 768 + 32 * bj) = pack8(v[bj][0] * sc * gv[bj][0], v[bj][1] * sc * gv[bj][1]);
                }
        } else if (pn < 15) {
            bf16_t* base; int ld, colt;
            if (pn < 2) { base = QS; ld = 512; colt = pn * 256; } else if (pn < 4) { base = KS; ld = 512; colt = (pn - 2) * 256; } else if (pn < 6) { base = VS; ld = 512; colt = (pn - 4) * 256; } else { base = VD; ld = 768; colt = (pn - 12) * 256; }
            base += colt + wc * 32 + 8 * fq;
#pragma unroll
            for (int ai = 0; ai < 2; ++ai)
#pragma unroll
                for (int m = 0; m < 4; ++m) { const int row = row0 + ai * HALF + m * 16; const float r = (pn < 2 ? QSCALE : 1.0f);
#pragma unroll
                    for (int bj = 0; bj < 2; ++bj) *(u32x4*)(base + (size_t)row * ld + bj * HALF) = pack8(acc[ai][bj][m][0] * r, acc[ai][bj][m][1] * r);
                }
        } else {
            const int col0 = (pn - 15) * 256 + wc * 32 + 8 * fq;
            f32x4 bv[2][2];
#pragma unroll
            for (int bj = 0; bj < 2; ++bj)
#pragma unroll
                for (int n = 0; n < 2; ++n) bv[bj][n] = *(const f32x4*)(bgate + col0 + bj * HALF + 4 * n);
#pragma unroll
            for (int ai = 0; ai < 2; ++ai)
#pragma unroll
                for (int m = 0; m < 4; ++m) { const int row = row0 + ai * HALF + m * 16; const float r = 1.0f;
#pragma unroll
                    for (int bj = 0; bj < 2; ++bj) { f32x4 a = acc[ai][bj][m][0] * r + bv[bj][0], b = acc[ai][bj][m][1] * r + bv[bj][1];
#pragma unroll
                        for (int e = 0; e < 4; ++e) { a[e] = sigmoidf_(a[e]); b[e] = sigmoidf_(b[e]); }
                        *(u32x4*)(GT + (size_t)row * 2048 + col0 + bj * HALF) = pack8(a, b); }
                }
        }
    }
};

struct EpiG {
    static constexpr bool PERM = true, AFTER_DRAIN = false, HAS_MID = false; static constexpr int MID_T = -1;
    const float* bgate; const float* cs; bf16_t* GT;
    __device__ __forceinline__ void mid(f32x4 (&)[2][2][4][2], const Unit&, int, int, int, int) const {}
    __device__ __forceinline__ void operator()(const f32x4 (&acc)[2][2][4][2], const Unit& u, int wr, int wc, int fr, int fq) const {
        asm volatile("" : "+v"(fr), "+v"(fq));
        const int row0 = u.pm * BM + wr * 64 + fr, col0 = u.pn * BM + wc * 32 + 8 * fq;
        f32x4 bv[2][2], sv[2][2];
#pragma unroll
        for (int bj = 0; bj < 2; ++bj)
#pragma unroll
            for (int n = 0; n < 2; ++n) { bv[bj][n] = *(const f32x4*)(bgate + col0 + bj * HALF + 4 * n); sv[bj][n] = *(const f32x4*)(cs + col0 + bj * HALF + 4 * n); }
#pragma unroll
        for (int ai = 0; ai < 2; ++ai)
#pragma unroll
            for (int m = 0; m < 4; ++m) { const int row = row0 + ai * HALF + m * 16;
#pragma unroll
                for (int bj = 0; bj < 2; ++bj) { f32x4 a = acc[ai][bj][m][0] * sv[bj][0] + bv[bj][0], b = acc[ai][bj][m][1] * sv[bj][1] + bv[bj][1];
#pragma unroll
                    for (int e = 0; e < 4; ++e) { a[e] = sigmoidf_(a[e]); b[e] = sigmoidf_(b[e]); }
                    *(u32x4*)(GT + (size_t)row * 2048 + col0 + bj * HALF) = pack8(a, b); }
            }
    }
};

struct Epi2 {
    static constexpr bool PERM = true, AFTER_DRAIN = false, HAS_MID = true; static constexpr int MID_T = 8;
    const bf16_t* GT; bf16_t* MIX;
    __device__ __forceinline__ void mid(f32x4 (&acc)[2][2][4][2], const Unit& u, int wr, int wc, int fr, int fq) const {
        asm volatile("" : "+v"(fr), "+v"(fq));
        const int row0 = u.pm * BM + wr * 64 + fr, col0 = u.pn * BM + wc * 32 + 8 * fq;
#pragma unroll
        for (int ai = 0; ai < 2; ++ai) { u32x4 ga[4][2], gb[4][2];
#pragma unroll
            for (int m = 0; m < 4; ++m) { const bf16_t* gp = GT + (size_t)(row0 + ai * HALF + m * 16) * 2048 + col0;
#pragma unroll
                for (int bj = 0; bj < 2; ++bj) { ga[m][bj] = *(const u32x4*)(gp + bj * HALF); gb[m][bj] = *(const u32x4*)(gp + 1024 + bj * HALF); } }
#pragma unroll
            for (int m = 0; m < 4; ++m)
#pragma unroll
                for (int bj = 0; bj < 2; ++bj) { const u32x4 a = ga[m][bj], b = gb[m][bj];
                    f32x4 r0, r1;
                    r0[0] = bflo(a.x) * __builtin_amdgcn_rcpf(fmaxf(bflo(b.x), 1e-30f)); r0[1] = bfhi(a.x) * __builtin_amdgcn_rcpf(fmaxf(bfhi(b.x), 1e-30f));
                    r0[2] = bflo(a.y) * __builtin_amdgcn_rcpf(fmaxf(bflo(b.y), 1e-30f)); r0[3] = bfhi(a.y) * __builtin_amdgcn_rcpf(fmaxf(bfhi(b.y), 1e-30f));
                    r1[0] = bflo(a.z) * __builtin_amdgcn_rcpf(fmaxf(bflo(b.z), 1e-30f)); r1[1] = bfhi(a.z) * __builtin_amdgcn_rcpf(fmaxf(bfhi(b.z), 1e-30f));
                    r1[2] = bflo(a.w) * __builtin_amdgcn_rcpf(fmaxf(bflo(b.w), 1e-30f)); r1[3] = bfhi(a.w) * __builtin_amdgcn_rcpf(fmaxf(bfhi(b.w), 1e-30f));
                    acc[ai][bj][m][0] *= r0; acc[ai][bj][m][1] *= r1; }
            asm volatile("" ::: "memory");
        }
    }
    __device__ __forceinline__ void operator()(const f32x4 (&acc)[2][2][4][2], const Unit& u, int wr, int wc, int fr, int fq) const {
        asm volatile("" : "+v"(fr), "+v"(fq));
        const int row0 = u.pm * BM + wr * 64 + fr, col0 = u.pn * BM + wc * 32 + 8 * fq;
#pragma unroll
        for (int ai = 0; ai < 2; ++ai) { u32x4 gb[4][2];
#pragma unroll
            for (int m = 0; m < 4; ++m) { const bf16_t* gp = GT + (size_t)(row0 + ai * HALF + m * 16) * 2048 + 1024 + col0;
#pragma unroll
                for (int bj = 0; bj < 2; ++bj) gb[m][bj] = *(const u32x4*)(gp + bj * HALF); }
#pragma unroll
            for (int m = 0; m < 4; ++m) { const int row = row0 + ai * HALF + m * 16;
#pragma unroll
                for (int bj = 0; bj < 2; ++bj) { const u32x4 b = gb[m][bj];
                    f32x4 g0, g1;
                    g0[0] = fmaxf(bflo(b.x), 1e-30f); g0[1] = fmaxf(bfhi(b.x), 1e-30f); g0[2] = fmaxf(bflo(b.y), 1e-30f); g0[3] = fmaxf(bfhi(b.y), 1e-30f);
                    g1[0] = fmaxf(bflo(b.z), 1e-30f); g1[1] = fmaxf(bfhi(b.z), 1e-30f); g1[2] = fmaxf(bflo(b.w), 1e-30f); g1[3] = fmaxf(bfhi(b.w), 1e-30f);
                    *(u32x4*)(MIX + (size_t)row * 1024 + col0 + bj * HALF) = pack8(acc[ai][bj][m][0] * g0, acc[ai][bj][m][1] * g1); } }
            asm volatile("" ::: "memory");
        }
    }
};

struct Epi3 {
    static constexpr bool PERM = true, AFTER_DRAIN = false, HAS_MID = false; static constexpr int MID_T = -1;
    const float* x; bf16_t* x1b; float* ssq;
    __device__ __forceinline__ void mid(f32x4 (&)[2][2][4][2], const Unit&, int, int, int, int) const {}
    __device__ __forceinline__ void operator()(const f32x4 (&acc)[2][2][4][2], const Unit& u, int wr, int wc, int fr, int fq) const {
        asm volatile("" : "+v"(fr), "+v"(fq));
        const int row0 = u.pm * BM + wr * 64 + fr, col0 = u.pn * BM + wc * 32 + 8 * fq;
#pragma unroll
        for (int ai = 0; ai < 2; ++ai) { f32x4 xv[4][2][2];
#pragma unroll
            for (int m = 0; m < 4; ++m) { const size_t off = (size_t)(row0 + ai * HALF + m * 16) * 1024 + col0;
#pragma unroll
                for (int bj = 0; bj < 2; ++bj) { xv[m][bj][0] = *(const f32x4*)(x + off + bj * HALF); xv[m][bj][1] = *(const f32x4*)(x + off + bj * HALF + 4); } }
#pragma unroll
            for (int m = 0; m < 4; ++m) { const int row = row0 + ai * HALF + m * 16; const size_t off = (size_t)row * 1024 + col0; float ss = 0.f;
#pragma unroll
                for (int bj = 0; bj < 2; ++bj) { const f32x4 v0 = acc[ai][bj][m][0] + xv[m][bj][0], v1 = acc[ai][bj][m][1] + xv[m][bj][1];
                    *(u32x4*)(x1b + off + bj * HALF) = pack8(v0, v1);
                    const f32x4 q0 = v0 * v0, q1 = v1 * v1; ss += ((q0[0] + q0[1]) + (q0[2] + q0[3])) + ((q1[0] + q1[1]) + (q1[2] + q1[3])); }
                ss += __shfl_xor(ss, 16); ss += __shfl_xor(ss, 32);
                if (fq == 0) ssq[(size_t)row * 16 + u.pn * 4 + wc] = ss;
            }
            asm volatile("" ::: "memory");
        }
    }
};

__device__ __forceinline__ unsigned f2key(float v) { const unsigned u = __float_as_uint(v); return (u & 0x80000000u) ? ~u : (u | 0x80000000u); }
__device__ __forceinline__ float key2f(unsigned k) { return __uint_as_float((k & 0x80000000u) ? (k & 0x7fffffffu) : ~k); }
#define PG8_CE(a_, b_) do { const unsigned hi__ = (a_) > (b_) ? (a_) : (b_); const unsigned lo__ = (a_) > (b_) ? (b_) : (a_); (a_) = hi__; (b_) = lo__; } while (0)
__device__ __forceinline__ void bitonic_merge16(unsigned (&v)[16]) {
#pragma unroll
    for (int j = 8; j >= 1; j >>= 1)
#pragma unroll
        for (int i = 0; i < 16; ++i) { const int l = i ^ j; if (l > i) PG8_CE(v[i], v[l]); }
}
__device__ __forceinline__ void bitonic_sort16(unsigned (&v)[16]) {
#pragma unroll
    for (int k = 2; k <= 16; k <<= 1)
#pragma unroll
        for (int j = k >> 1; j >= 1; j >>= 1)
#pragma unroll
            for (int i = 0; i < 16; ++i) { const int l = i ^ j; if (l > i) { if ((i & k) == 0 || k == 16) PG8_CE(v[i], v[l]); else PG8_CE(v[l], v[i]); } }
}
__device__ __forceinline__ void merge_top16(unsigned (&t)[16], const unsigned (&o)[16]) {
#pragma unroll
    for (int i = 0; i < 16; ++i) t[i] = t[i] > o[15 - i] ? t[i] : o[15 - i];
    bitonic_merge16(t);
}
template <int XM> __device__ __forceinline__ void merge_top16_xor(unsigned (&t)[16]) {
    unsigned o[16];
#pragma unroll
    for (int i = 0; i < 16; ++i) o[i] = (unsigned)__shfl_xor((int)t[i], XM);
    merge_top16(t, o);
}

struct Epi4 {
    static constexpr bool PERM = false, AFTER_DRAIN = true, HAS_MID = false; static constexpr int MID_T = -1;
    const float* ssq; float* rinv2; unsigned short* ids; float* gw;
    __device__ __forceinline__ void mid(f32x4 (&)[2][2][4][2], const Unit&, int, int, int, int) const {}
    __device__ __forceinline__ void fused(f32x4 (&acc)[2][2][4][2], const Unit& u, int wr, int wc, int fr, int fq, PG8_LAS unsigned char* lds, int wid, int lane) const {
        asm volatile("" : "+v"(fr), "+v"(fq));
        const int tid = wid * 64 + lane;
        const int rl = tid >> 2, p = (tid >> 1) & 1, hf = tid & 1, q4 = tid & 3;
#pragma unroll
        for (int pass = 0; pass < 2; ++pass) {
#pragma unroll
            for (int m = 0; m < 4; ++m)
#pragma unroll
                for (int bj = 0; bj < 2; ++bj)
#pragma unroll
                    for (int n = 0; n < 2; ++n) *(PG8_LAS f32x4*)(lds + (size_t)(wr * 64 + m * 16 + fr) * 1056 + bj * 528 + (wc * 32 + n * 16 + fq * 4) * 4) = acc[pass][bj][m][n];
            asm volatile("s_waitcnt lgkmcnt(0)" ::: "memory"); __builtin_amdgcn_s_barrier(); asm volatile("" ::: "memory");
            const int row = u.pm * BM + pass * HALF + rl;
            unsigned tk[16];
#pragma unroll
            for (int i = 0; i < 16; ++i) tk[i] = 0u;
            const PG8_LAS unsigned char* sp = lds + (size_t)rl * 1056 + p * 528 + hf * 256;
#pragma nounroll
            for (int c = 0; c < 4; ++c) { unsigned ch[16];
#pragma unroll
                for (int e4 = 0; e4 < 4; ++e4) { const f32x4 v = *(const PG8_LAS f32x4*)(sp + c * 64 + e4 * 16);
#pragma unroll
                    for (int e = 0; e < 4; ++e) ch[4 * e4 + e] = (f2key(v[e]) & ~127u) | (unsigned)(127 - (64 * hf + 16 * c + 4 * e4 + e)); }
                bitonic_sort16(ch);
                merge_top16(tk, ch);
            }
            merge_top16_xor<1>(tk);
            asm volatile("s_waitcnt lgkmcnt(0)" ::: "memory");
            PG8_LAS unsigned* kl = (PG8_LAS unsigned*)(lds + (size_t)(rl & ~15) * 1056) + ((rl & 15) * 2) * 16;
            if (hf == 0) {
#pragma unroll
                for (int i = 0; i < 4; ++i) *(PG8_LAS u32x4*)(kl + p * 16 + 4 * i) = (u32x4){tk[4 * i], tk[4 * i + 1], tk[4 * i + 2], tk[4 * i + 3]}; }
            asm volatile("s_waitcnt lgkmcnt(0)" ::: "memory");
            unsigned ck[16];
#define CAND_SLOT(m_, ij__) do { const unsigned i__ = (ij__) >> 4, j__ = (ij__) & 15u; \
                const unsigned ka__ = kl[(ij__) == 0xFFFFu ? 0u : i__], kb__ = kl[16 + ((ij__) == 0xFFFFu ? 0u : j__)]; \
                const float s__ = key2f(ka__ & ~127u) + key2f(kb__ & ~127u); \
                ck[m_] = (ij__) == 0xFFFFu ? 0u : ((f2key(s__) & ~255u) | (255u - (ij__))); } while (0)
                { const unsigned ij_ = q4 == 0 ? 0u : q4 == 1 ? 1u : q4 == 2 ? 2u : 3u; CAND_SLOT(0, ij_); }
                { const unsigned ij_ = q4 == 0 ? 4u : q4 == 1 ? 5u : q4 == 2 ? 6u : 7u; CAND_SLOT(1, ij_); }
                { const unsigned ij_ = q4 == 0 ? 8u : q4 == 1 ? 9u : q4 == 2 ? 10u : 11u; CAND_SLOT(2, ij_); }
                { const unsigned ij_ = q4 == 0 ? 12u : q4 == 1 ? 13u : q4 == 2 ? 14u : 15u; CAND_SLOT(3, ij_); }
                { const unsigned ij_ = q4 == 0 ? 16u : q4 == 1 ? 17u : q4 == 2 ? 18u : 19u; CAND_SLOT(4, ij_); }
                { const unsigned ij_ = q4 == 0 ? 20u : q4 == 1 ? 21u : q4 == 2 ? 22u : 23u; CAND_SLOT(5, ij_); }
                { const unsigned ij_ = q4 == 0 ? 32u : q4 == 1 ? 33u : q4 == 2 ? 34u : 35u; CAND_SLOT(6, ij_); }
                { const unsigned ij_ = q4 == 0 ? 36u : q4 == 1 ? 48u : q4 == 2 ? 49u : 50u; CAND_SLOT(7, ij_); }
                { const unsigned ij_ = q4 == 0 ? 51u : q4 == 1 ? 64u : q4 == 2 ? 65u : 66u; CAND_SLOT(8, ij_); }
                { const unsigned ij_ = q4 == 0 ? 80u : q4 == 1 ? 81u : q4 == 2 ? 96u : 97u; CAND_SLOT(9, ij_); }
                { const unsigned ij_ = q4 == 0 ? 112u : q4 == 1 ? 113u : q4 == 2 ? 128u : 144u; CAND_SLOT(10, ij_); }
                { const unsigned ij_ = q4 == 0 ? 160u : q4 == 1 ? 176u : q4 == 2 ? 192u : 208u; CAND_SLOT(11, ij_); }
                { const unsigned ij_ = q4 == 0 ? 224u : q4 == 1 ? 240u : q4 == 2 ? 65535u : 65535u; CAND_SLOT(12, ij_); }
#undef CAND_SLOT
            ck[13] = 0u; ck[14] = 0u; ck[15] = 0u;
            bitonic_sort16(ck);
            merge_top16_xor<1>(ck); merge_top16_xor<2>(ck);
            float sq = 0.f;
#pragma unroll
            for (int i = 0; i < 4; ++i) { const f32x4 t = *(const f32x4*)(ssq + (size_t)row * 16 + 4 * i); sq += (t[0] + t[1]) + (t[2] + t[3]); }
            const float r2 = __builtin_amdgcn_rsqf(sq * (1.0f / 1024.0f) + 1e-6f);
            if (u.pn == 0 && q4 == 0) rinv2[row] = r2;
            const float b0 = key2f(ck[0] & ~255u); float wsum = 0.f; float wv[16];
#pragma unroll
            for (int q = 0; q < 16; ++q) { wv[q] = __builtin_amdgcn_exp2f((key2f(ck[q] & ~255u) - b0) * r2 * 1.4426950408889634f); wsum += wv[q]; }
            const float inv = 1.0f / wsum;
            unsigned short eo[4]; float go[4];
#pragma unroll
            for (int e = 0; e < 4; ++e) { unsigned c0 = ck[e], c1 = ck[4 + e], c2 = ck[8 + e], c3 = ck[12 + e]; float w0 = wv[e], w1 = wv[4 + e], w2 = wv[8 + e], w3 = wv[12 + e];
                asm volatile("" : "+v"(c0), "+v"(c1), "+v"(c2), "+v"(c3), "+v"(w0), "+v"(w1), "+v"(w2), "+v"(w3));
                const unsigned cc = q4 == 0 ? c0 : q4 == 1 ? c1 : q4 == 2 ? c2 : c3; const float ww = q4 == 0 ? w0 : q4 == 1 ? w1 : q4 == 2 ? w2 : w3;
                const unsigned code = 255u - (cc & 255u);
                const unsigned i1 = 127u - (kl[code >> 4] & 127u), i2 = 127u - (kl[16 + (code & 15u)] & 127u);
                eo[e] = (unsigned short)(i1 * 128u + i2); go[e] = ww * inv; }
            const size_t ob = ((size_t)row * 8 + u.pn) * 16 + q4 * 4;
            { u32x2 w; w.x = eo[0] | ((unsigned)eo[1] << 16); w.y = eo[2] | ((unsigned)eo[3] << 16); *(u32x2*)(ids + ob) = w; }
            *(f32x4*)(gw + ob) = (f32x4){go[0], go[1], go[2], go[3]};
            asm volatile("s_waitcnt lgkmcnt(0)" ::: "memory"); __builtin_amdgcn_s_barrier(); asm volatile("" ::: "memory");
        }
    }
};
template <class Epi, class Sched, bool ALIGN_EPI = false, bool SP2 = false, bool FP8 = false>
__device__ __forceinline__ void gemm_phase(PG8_LAS unsigned char* lds, const Gemm g, const Sched& S, const Epi& E) {
    const int tid = threadIdx.x, wid = __builtin_amdgcn_readfirstlane(tid >> 6), lane = tid & 63, wr = wid >> 2, wc = wid & 3, fr = lane & 15, fq = lane >> 4;
    const int K = g.K, nt = K / BK;
    unsigned voffA[2], voffB[2];
#pragma unroll
    for (int i = 0; i < 2; ++i) { int R, C; stage_rc(tid * 16 + i * 8192, R, C); const int Rb = Epi::PERM ? ((R & ~31) + perm32(R & 31)) : R;
        voffA[i] = (unsigned)(R * K + C) * 2u; voffB[i] = (unsigned)(Rb * K + C) * 2u; }
    const size_t kstep = (size_t)(BK * 2);
    const size_t hstep = (size_t)HALF * K * 2;
    const size_t tstep = 2 * hstep;
    const unsigned ldsw = (unsigned)wid * 1024u;
    const int aoff = lds_byte(wr * 64 + fr, fq * 8), boff = lds_byte(wc * 32 + fr, fq * 8);
#define PG8_SA(b, h) (((b) * 2 + (h)) * HTB)
#define PG8_SB(b, h) ((4 + (b) * 2 + (h)) * HTB)
#define PG8_STAGE(bufoff, gbase, voff) do { _Pragma("unroll") for (int _i = 0; _i < 2; ++_i) \
        __builtin_amdgcn_global_load_lds((const unsigned*)((const char*)(gbase) + (voff)[_i]), (PG8_LAS unsigned*)(lds + (bufoff) + ldsw + _i * 8192), 16, 0, 0); } while (0)
#define PG8_LD8(lo_, hi_) __builtin_bit_cast(i32x8, __builtin_shufflevector((lo_), (hi_), 0, 1, 2, 3, 4, 5, 6, 7))
#define PG8_LDA(dst, b, h) do { if constexpr (FP8) { _Pragma("unroll") for (int m = 0; m < 4; ++m) { const u32x4 l0_ = *(const PG8_LAS u32x4*)(lds + PG8_SA(b, h) + aoff + m * 2048), l1_ = *(const PG8_LAS u32x4*)(lds + PG8_SA(b, h) + aoff + m * 2048 + 1024); dst##8[m] = PG8_LD8(l0_, l1_); } } \
        else { _Pragma("unroll") for (int m = 0; m < 4; ++m) _Pragma("unroll") for (int k = 0; k < 2; ++k) dst[m][k] = *(const PG8_LAS bf16x8*)(lds + PG8_SA(b, h) + aoff + m * 2048 + k * 1024); } } while (0)
#define PG8_LDB(dst, b, h) do { if constexpr (FP8) { _Pragma("unroll") for (int n = 0; n < 2; ++n) { const u32x4 l0_ = *(const PG8_LAS u32x4*)(lds + PG8_SB(b, h) + boff + n * 2048), l1_ = *(const PG8_LAS u32x4*)(lds + PG8_SB(b, h) + boff + n * 2048 + 1024); dst##8[n] = PG8_LD8(l0_, l1_); } } \
        else { _Pragma("unroll") for (int n = 0; n < 2; ++n) _Pragma("unroll") for (int k = 0; k < 2; ++k) dst[n][k] = *(const PG8_LAS bf16x8*)(lds + PG8_SB(b, h) + boff + n * 2048 + k * 1024); } } while (0)
#define PG8_MMA(ai, bj, At, Bt) do { __builtin_amdgcn_s_setprio(1); \
        if constexpr (FP8) { _Pragma("unroll") for (int m = 0; m < 4; ++m) _Pragma("unroll") for (int n = 0; n < 2; ++n) \
            asm volatile("v_mfma_scale_f32_16x16x128_f8f6f4 %0, %1, %2, %0, %3, %3 op_sel_hi:[0,0,0]" : "+v"(acc[ai][bj][m][n]) : "v"(Bt##8[n]), "v"(At##8[m]), "v"(sc127));     \
            } \
        else { _Pragma("unroll") for (int m = 0; m < 4; ++m) _Pragma("unroll") for (int n = 0; n < 2; ++n) _Pragma("unroll") for (int k = 0; k < 2; ++k) \
            acc[ai][bj][m][n] = __builtin_amdgcn_mfma_f32_16x16x32_bf16(Bt[n][k], At[m][k], acc[ai][bj][m][n], 0, 0, 0); } \
        __builtin_amdgcn_s_setprio(0); } while (0)
#define PG8_WAIT_V(n) asm volatile("s_waitcnt vmcnt(" #n ")" ::: "memory")
#define PG8_WAIT_L(n) asm volatile("s_waitcnt lgkmcnt(" #n ")" ::: "memory")
#define PG8_BAR __builtin_amdgcn_s_barrier()
#define PG8_SCHED __builtin_amdgcn_sched_barrier(0)
    Unit cur, nxt; int ui = 0;
    if (!S.next(0, cur)) return;
    f32x4 acc[2][2][4][2];
#pragma unroll
    for (int a = 0; a < 2; ++a)
#pragma unroll
        for (int b = 0; b < 2; ++b)
#pragma unroll
            for (int m = 0; m < 4; ++m)
#pragma unroll
                for (int n = 0; n < 2; ++n) acc[a][b][m][n] = (f32x4){0.f, 0.f, 0.f, 0.f};
    bf16x8 At[4][2], B0[2][2], B1[2][2]; i32x8 At8[4], B08[2], B18[2];
    int sc127 = 127; asm volatile("" : "+v"(sc127));
    const char* cA = (const char*)g.A + (size_t)cur.pm * tstep; const char* cB = (const char*)g.Bt + (size_t)cur.pn * tstep;
    S.a_ready(cur);
    if constexpr (SP2) {
        PG8_STAGE(PG8_SB(0, 0), cB, voffB); PG8_STAGE(PG8_SB(0, 1), cB + hstep, voffB); PG8_STAGE(PG8_SA(0, 0), cA, voffA); PG8_STAGE(PG8_SA(0, 1), cA + hstep, voffA);
        if (wr == 1) PG8_BAR;
        PG8_WAIT_V(2); PG8_BAR;
        PG8_STAGE(PG8_SB(1, 0), cB + kstep, voffB); PG8_STAGE(PG8_SA(1, 0), cA + kstep, voffA); PG8_STAGE(PG8_SB(1, 1), cB + hstep + kstep, voffB);
        PG8_WAIT_V(6); PG8_BAR;
    } else {
        PG8_STAGE(PG8_SB(0, 0), cB, voffB); PG8_STAGE(PG8_SA(0, 0), cA, voffA); PG8_STAGE(PG8_SB(0, 1), cB + hstep, voffB); PG8_STAGE(PG8_SA(0, 1), cA + hstep, voffA);
        if (wr == 1) PG8_BAR;
        PG8_WAIT_V(4); PG8_BAR;
        PG8_STAGE(PG8_SB(1, 0), cB + kstep, voffB); PG8_STAGE(PG8_SA(1, 0), cA + kstep, voffA); PG8_STAGE(PG8_SB(1, 1), cB + hstep + kstep, voffB);
        PG8_WAIT_V(6); PG8_BAR;
    }
    for (;;) {
        const bool has_next = S.next(ui + 1, nxt);
        const char* nA = has_next ? (const char*)g.A + (size_t)nxt.pm * tstep : cA; const char* nB = has_next ? (const char*)g.Bt + (size_t)nxt.pn * tstep : cB;
        for (int t = 0; t < nt; t += 2) {
            if constexpr (Epi::HAS_MID) { if (t == Epi::MID_T) E.mid(acc, cur, wr, wc, fr, fq); }
            const bool last = (t == nt - 2);
            const char* a1 = cA + (size_t)(t + 1) * kstep;
            const char* a2 = last ? nA : cA + (size_t)(t + 2) * kstep; const char* b2 = last ? nB : cB + (size_t)(t + 2) * kstep;
            const char* a3 = a2 + kstep; const char* b3 = b2 + kstep;
            if (last && has_next) S.a_ready(nxt);
            if constexpr (SP2) {
            PG8_LDB(B0, 0, 0); PG8_LDB(B1, 0, 1); PG8_SCHED; PG8_LDA(At, 0, 0); PG8_STAGE(PG8_SA(1, 1), a1 + hstep, voffA);
            PG8_WAIT_V(8); PG8_WAIT_L(0); PG8_BAR; PG8_MMA(0, 0, At, B0); PG8_MMA(0, 1, At, B1); PG8_BAR; PG8_SCHED;
            PG8_LDA(At, 0, 1); PG8_STAGE(PG8_SB(0, 0), b2, voffB); PG8_STAGE(PG8_SB(0, 1), b2 + hstep, voffB); PG8_STAGE(PG8_SA(0, 0), a2, voffA);
            PG8_WAIT_V(8); PG8_WAIT_L(0); PG8_BAR; PG8_MMA(1, 0, At, B0); PG8_MMA(1, 1, At, B1); PG8_BAR; PG8_SCHED;
            PG8_LDB(B0, 1, 0); PG8_LDB(B1, 1, 1); PG8_SCHED; PG8_LDA(At, 1, 0); PG8_STAGE(PG8_SA(0, 1), a2 + hstep, voffA);
            PG8_WAIT_V(8); PG8_WAIT_L(0); PG8_BAR; PG8_MMA(0, 0, At, B0); PG8_MMA(0, 1, At, B1); PG8_BAR; PG8_SCHED;
            PG8_LDA(At, 1, 1); PG8_STAGE(PG8_SB(1, 0), b3, voffB); PG8_STAGE(PG8_SB(1, 1), b3 + hstep, voffB); PG8_STAGE(PG8_SA(1, 0), a3, voffA);
            PG8_WAIT_V(8); PG8_WAIT_L(0); PG8_BAR; PG8_MMA(1, 0, At, B0); PG8_MMA(1, 1, At, B1); PG8_BAR; PG8_SCHED;
            } else {
            PG8_LDB(B0, 0, 0); PG8_SCHED; PG8_LDA(At, 0, 0); PG8_STAGE(PG8_SA(1, 1), a1 + hstep, voffA);
            PG8_WAIT_L(8); PG8_BAR; PG8_WAIT_L(0); PG8_MMA(0, 0, At, B0); PG8_BAR; PG8_SCHED;
            PG8_LDB(B1, 0, 1); PG8_STAGE(PG8_SB(0, 0), b2, voffB);
            PG8_BAR; PG8_WAIT_L(0); PG8_MMA(0, 1, At, B1); PG8_BAR;
            PG8_LDA(At, 0, 1); PG8_STAGE(PG8_SA(0, 0), a2, voffA);
            PG8_BAR; PG8_WAIT_L(0); PG8_MMA(1, 0, At, B0); PG8_BAR; PG8_SCHED;
            PG8_STAGE(PG8_SB(0, 1), b2 + hstep, voffB);
            PG8_WAIT_V(6); PG8_BAR; PG8_MMA(1, 1, At, B1); PG8_BAR;
            PG8_LDB(B0, 1, 0); PG8_SCHED; PG8_LDA(At, 1, 0); PG8_STAGE(PG8_SA(0, 1), a2 + hstep, voffA);
            PG8_WAIT_L(8); PG8_BAR; PG8_WAIT_L(0); PG8_MMA(0, 0, At, B0); PG8_BAR; PG8_SCHED;
            PG8_LDB(B1, 1, 1); PG8_STAGE(PG8_SB(1, 0), b3, voffB);
            PG8_BAR; PG8_WAIT_L(0); PG8_MMA(0, 1, At, B1); PG8_BAR;
            PG8_LDA(At, 1, 1); PG8_STAGE(PG8_SA(1, 0), a3, voffA);
            PG8_BAR; PG8_WAIT_L(0); PG8_MMA(1, 0, At, B0); PG8_BAR; PG8_SCHED;
            PG8_STAGE(PG8_SB(1, 1), b3 + hstep, voffB);
            PG8_WAIT_V(6); PG8_BAR; PG8_MMA(1, 1, At, B1); PG8_BAR;
            }
        }
        if constexpr (FP8) asm volatile("s_nop 15\n\ts_nop 15" ::: "memory");
        if constexpr (ALIGN_EPI) { if (wr == 0) PG8_BAR; }
        if constexpr (!Epi::AFTER_DRAIN) { E(acc, cur, wr, wc, fr, fq); S.done(cur); }
        if (!has_next) break;
#pragma unroll
        for (int a = 0; a < 2; ++a)
#pragma unroll
            for (int b = 0; b < 2; ++b)
#pragma unroll
                for (int m = 0; m < 4; ++m)
#pragma unroll
                    for (int n = 0; n < 2; ++n) acc[a][b][m][n] = (f32x4){0.f, 0.f, 0.f, 0.f};
        cur = nxt; cA = nA; cB = nB; ++ui;
        if constexpr (ALIGN_EPI) { if (wr == 1) PG8_BAR; }
    }
    PG8_WAIT_V(0);
    if constexpr (!ALIGN_EPI) { if (wr == 0) PG8_BAR; }
    PG8_BAR;
    if constexpr (Epi::AFTER_DRAIN) { E.fused(acc, cur, wr, wc, fr, fq, lds, wid, lane); S.done(cur); }
#undef PG8_SA
#undef PG8_SB
#undef PG8_STAGE
#undef PG8_LDA
#undef PG8_LD8
#undef PG8_LDB
#undef PG8_MMA
#undef PG8_WAIT_V
#undef PG8_WAIT_L
#undef PG8_BAR
#undef PG8_SCHED
}
}


namespace att {
#define ALAS __attribute__((address_space(3)))
typedef unsigned short bf16;
typedef short bf16x8 __attribute__((ext_vector_type(8)));
typedef short s16x4 __attribute__((ext_vector_type(4)));
typedef float f32x16 __attribute__((ext_vector_type(16)));
typedef float f32x4 __attribute__((ext_vector_type(4)));
typedef float f32x2 __attribute__((ext_vector_type(2)));
typedef unsigned u32x4 __attribute__((ext_vector_type(4)));
typedef __bf16 bf16x2_t __attribute__((ext_vector_type(2)));
constexpr int SEQ = 4096;
constexpr int VPITCH = 144;
constexpr float LOG2E = 1.4426950408889634f, LN2 = 0.6931471805599453f;
__device__ __forceinline__ unsigned pkbf(float lo, float hi) { f32x2 v = {lo, hi}; bf16x2_t b = __builtin_convertvector(v, bf16x2_t); return __builtin_bit_cast(unsigned, b); }
__device__ __forceinline__ void wave_lds_sync() { asm volatile("s_waitcnt lgkmcnt(0)" ::: "memory"); }
__device__ __forceinline__ s16x4 vtr(const ALAS unsigned char* p) { return __builtin_bit_cast(s16x4, __builtin_amdgcn_ds_read_tr16_b64_v4i16((ALAS s16x4*)p)); }
__device__ __forceinline__ int crow(int r, int hi) { return (r & 3) + 8 * (r >> 2) + 4 * hi; }

__device__ __forceinline__ void pv_tile(f32x16& o0, f32x16& o1, const float (&a)[16], const ALAS unsigned char* vt, int lane) {
    const int g = lane >> 4, i = lane & 15, q_ = i >> 2, p_ = i & 3, h = lane >> 5;
    const ALAS unsigned char* vb = vt + (8 * h + q_) * VPITCH + (16 * (g & 1) + 4 * p_) * 2;
    u32x4 pw0, pw1;
    pw0.x = pkbf(a[0], a[1]); pw0.y = pkbf(a[2], a[3]); pw0.z = pkbf(a[4], a[5]); pw0.w = pkbf(a[6], a[7]);
    pw1.x = pkbf(a[8], a[9]); pw1.y = pkbf(a[10], a[11]); pw1.z = pkbf(a[12], a[13]); pw1.w = pkbf(a[14], a[15]);
    const bf16x8 pa0 = __builtin_bit_cast(bf16x8, pw0), pa1 = __builtin_bit_cast(bf16x8, pw1);
#pragma unroll
    for (int s = 0; s < 2; ++s) {
        const s16x4 l0 = vtr(vb + (16 * s) * VPITCH), h0 = vtr(vb + (16 * s + 4) * VPITCH);
        const s16x4 l1 = vtr(vb + (16 * s) * VPITCH + 64), h1 = vtr(vb + (16 * s + 4) * VPITCH + 64);
        const bf16x8 v0 = (bf16x8){l0[0], l0[1], l0[2], l0[3], h0[0], h0[1], h0[2], h0[3]};
        const bf16x8 v1 = (bf16x8){l1[0], l1[1], l1[2], l1[3], h1[0], h1[1], h1[2], h1[3]};
        o0 = __builtin_amdgcn_mfma_f32_32x32x16_bf16(s ? pa1 : pa0, v0, o0, 0, 0, 0);
        o1 = __builtin_amdgcn_mfma_f32_32x32x16_bf16(s ? pa1 : pa0, v1, o1, 0, 0, 0);
    }
}
__device__ __forceinline__ void bcast_rows(float v, ALAS float* sc, int r32, int hi, float (&out)[16]) {
    if (hi == 0) sc[r32] = v;
    wave_lds_sync();
#pragma unroll
    for (int g = 0; g < 4; ++g) { const f32x4 t = *(const ALAS f32x4*)(sc + 8 * g + 4 * hi); out[4 * g] = t[0]; out[4 * g + 1] = t[1]; out[4 * g + 2] = t[2]; out[4 * g + 3] = t[3]; }
    wave_lds_sync();
}
__device__ __forceinline__ void store_o(const f32x16& o0, const f32x16& o1, ALAS unsigned char* stg, bf16* dst  , size_t rstride_elems, int lane) {
    const int r32 = lane & 31, hi = lane >> 5;
    wave_lds_sync();
#pragma unroll
    for (int r = 0; r < 16; ++r) { const int q = crow(r, hi);
        *(ALAS unsigned short*)(stg + q * VPITCH + r32 * 2) = (unsigned short)(pkbf(o0[r], 0.f) & 0xffffu);
        *(ALAS unsigned short*)(stg + q * VPITCH + 64 + r32 * 2) = (unsigned short)(pkbf(o1[r], 0.f) & 0xffffu); }
    wave_lds_sync();
#pragma unroll
    for (int i = 0; i < 4; ++i) { const int row = 8 * i + (lane >> 3), ch = lane & 7; const u32x4 v = *(const ALAS u32x4*)(stg + row * VPITCH + ch * 16); *(u32x4*)(dst + (size_t)row * rstride_elems + ch * 8) = v; }
    wave_lds_sync();
}

__device__ __forceinline__ void sb_item(const bf16* QS, const bf16* KS, const bf16* VS, bf16* OC, int b, int h, int qt, ALAS unsigned char* wl, int lane) {
    const int r32 = lane & 31, hi = lane >> 5;
    const int t0 = qt * 32; const size_t rowb = (size_t)b * SEQ;
    const int kperm = (r32 & ~12) | ((r32 & 4) << 1) | ((r32 & 8) >> 1);
    bf16x8 qf[4];
    { const bf16* qp = QS + (rowb + t0 + r32) * 512 + h * 64 + hi * 8;
#pragma unroll
      for (int d0 = 0; d0 < 4; ++d0) qf[d0] = *(const bf16x8*)(qp + d0 * 16); }
    f32x16 o0 = {}, o1 = {}; float R = 0.f;
    for (int key0 = t0; key0 >= 0; key0 -= 32) {
        const bf16* kp = KS + (rowb + key0 + kperm) * 512 + h * 64 + hi * 8;
        bf16x8 kf[4];
#pragma unroll
        for (int d0 = 0; d0 < 4; ++d0) kf[d0] = *(const bf16x8*)(kp + d0 * 16);
        u32x4 vv[4];
#pragma unroll
        for (int i = 0; i < 4; ++i) vv[i] = *(const u32x4*)(VS + (rowb + key0 + 8 * i + (lane >> 3)) * 512 + h * 64 + (lane & 7) * 8);
        f32x16 p = {};
#pragma unroll
        for (int d0 = 0; d0 < 4; ++d0) p = __builtin_amdgcn_mfma_f32_32x32x16_bf16(kf[d0], qf[d0], p, 0, 0, 0);
#pragma unroll
        for (int i = 0; i < 4; ++i) *(ALAS u32x4*)(wl + (8 * i + (lane >> 3)) * VPITCH + (lane & 7) * 16) = vv[i];
        const bool diag = (key0 == t0);
        float z2[16], L2[16];
#pragma unroll
        for (int r = 0; r < 16; ++r) { const int kk = (r & 7) + 8 * hi + 16 * (r >> 3); const float zz = p[r];
            const float sp = fmaxf(zz, 0.f) + __builtin_amdgcn_logf(1.0f + __builtin_amdgcn_exp2f(-fabsf(zz)));
            const bool valid = !diag || (kk < r32); z2[r] = zz; L2[r] = valid ? sp : 0.f; }
        float c[16];
        c[15] = L2[15];
#pragma unroll
        for (int r = 14; r >= 8; --r) c[r] = c[r + 1] + L2[r];
        c[7] = L2[7];
#pragma unroll
        for (int r = 6; r >= 0; --r) c[r] = c[r + 1] + L2[r];
        const float TB = c[8], TA = c[0];
        const float TBo = __shfl_xor(TB, 32), TAo = __shfl_xor(TA, 32);
        const float offB = R + (hi ? 0.f : TBo);
        const float offA = R + TB + TBo + (hi ? 0.f : TAo);
        float a[16];
#pragma unroll
        for (int r = 0; r < 16; ++r) { const int kk = (r & 7) + 8 * hi + 16 * (r >> 3); const bool valid = !diag || (kk < r32);
            const float e = __builtin_amdgcn_exp2f(z2[r] - (c[r] + (r < 8 ? offA : offB))); a[r] = valid ? e : 0.f; }
        R += (TA + TB) + (TAo + TBo);
        wave_lds_sync();
        pv_tile(o0, o1, a, wl, lane);
        wave_lds_sync();
        if (__all(R > 40.0f * LOG2E)) break;
    }
    store_o(o0, o1, wl, OC + (rowb + t0) * 768 + h * 64, 768, lane);
}

constexpr int DLU_WAVE = 5120;
constexpr int DLU_O = 8 * DLU_WAVE, DLU_M = DLU_O + 512 * 128, DLU_L = DLU_M + 2048, DLU_BYTES = DLU_L + 2048;
__device__ __forceinline__ void dl_unit(const bf16* QD, const bf16* KD, const bf16* VD, bf16* OC, int b, int j, int blk, ALAS unsigned char* lds, int wave, int lane) {
    const int r32 = lane & 31, hi = lane >> 5;
    const size_t rowb = (size_t)b * SEQ;
    const int t0 = 512 * blk;
    const int kperm = (r32 & ~12) | ((r32 & 4) << 1) | ((r32 & 8) >> 1);
    ALAS unsigned char* wl = lds + wave * DLU_WAVE;
    ALAS float* sc = (ALAS float*)(wl + 4608);
    ALAS unsigned short* OL = (ALAS unsigned short*)(lds + DLU_O);
    ALAS float* ML = (ALAS float*)(lds + DLU_M); ALAS float* LL = (ALAS float*)(lds + DLU_L);
    for (int g = 2; g >= 0; --g) {
        const int hh = 4 * g + j, sh = 2 * g, r = 1 << sh;
        const float slope2 = __builtin_amdgcn_exp2f(-8.0f * (float)(hh + 1) / 12.0f) * LOG2E;
        const float sr = slope2 * (float)r;
        for (int it = wave; it < 16; it += 8) {
            const int q0 = g == 2 ? it : g == 1 ? (it & 3) + 128 * (it >> 2) : 32 * it;
            const int tq = t0 + q0 + r * r32, tmax = t0 + q0 + 31 * r;
            bf16x8 qf[4];
            { const bf16* qp = QD + (rowb + tq) * 768 + hh * 64 + hi * 8;
#pragma unroll
              for (int d0 = 0; d0 < 4; ++d0) qf[d0] = *(const bf16x8*)(qp + d0 * 16); }
            const int klo = 31 - r32; int khi = klo + 128; { const int kmaxtok = tmax >> sh; khi = khi < kmaxtok ? khi : kmaxtok; }
            const unsigned krange = (unsigned)(khi - klo);
            f32x16 o0 = {}, o1 = {}; float mrun = -3.0e38f, lrun = 0.f;
            if (g != 2) {
                mrun = ML[q0 + r * r32]; lrun = hi ? 0.f : LL[q0 + r * r32];
#pragma unroll
                for (int q = 0; q < 16; ++q) { const int tl = q0 + r * crow(q, hi);
                    o0[q] = __uint_as_float((unsigned)OL[tl * 64 + r32] << 16); o1[q] = __uint_as_float((unsigned)OL[tl * 64 + 32 + r32] << 16); }
            }
            for (int kt = 0; kt < 5; ++kt) {
                int sk = tmax - r * (32 * kt + kperm); sk = sk < 0 ? 0 : sk;
                const bf16* kp = KD + (rowb + sk) * 768 + hh * 64 + hi * 8;
                bf16x8 kf[4];
#pragma unroll
                for (int d0 = 0; d0 < 4; ++d0) kf[d0] = *(const bf16x8*)(kp + d0 * 16);
                u32x4 vv[4];
#pragma unroll
                for (int i = 0; i < 4; ++i) { int sv = tmax - r * (32 * kt + 8 * i + (lane >> 3)); sv = sv < 0 ? 0 : sv; vv[i] = *(const u32x4*)(VD + (rowb + sv) * 768 + hh * 64 + (lane & 7) * 8); }
                const int dk = 32 * kt + 8 * hi - klo;
                const float tb = -sr * (float)dk;
                f32x16 p;
#pragma unroll
                for (int q = 0; q < 16; ++q) p[q] = tb - sr * (float)((q & 7) + 16 * (q >> 3));
#pragma unroll
                for (int d0 = 0; d0 < 4; ++d0) p = __builtin_amdgcn_mfma_f32_32x32x16_bf16(kf[d0], qf[d0], p, 0, 0, 0);
#pragma unroll
                for (int i = 0; i < 4; ++i) *(ALAS u32x4*)(wl + (8 * i + (lane >> 3)) * VPITCH + (lane & 7) * 16) = vv[i];
                float z2[16]; float mt = -3.0e38f;
#pragma unroll
                for (int q = 0; q < 16; ++q) { const bool valid = (unsigned)(dk + ((q & 7) + 16 * (q >> 3))) <= krange; z2[q] = valid ? p[q] : -INFINITY; mt = fmaxf(mt, z2[q]); }
                mt = fmaxf(mt, __shfl_xor(mt, 32));
                if (__any(mt > mrun + 8.0f)) {
                    const float mnew = fmaxf(mrun, mt); const float alpha = __builtin_amdgcn_exp2f(mrun - mnew);
                    lrun *= alpha; float al[16]; bcast_rows(alpha, sc, r32, hi, al);
#pragma unroll
                    for (int q = 0; q < 16; ++q) { o0[q] *= al[q]; o1[q] *= al[q]; }
                    mrun = mnew;
                }
                float a[16]; float ls = 0.f;
#pragma unroll
                for (int q = 0; q < 16; ++q) { a[q] = __builtin_amdgcn_exp2f(z2[q] - mrun); ls += a[q]; }
                lrun += ls;
                wave_lds_sync();
                pv_tile(o0, o1, a, wl, lane);
                wave_lds_sync();
            }
            const float ltot = lrun + __shfl_xor(lrun, 32);
            if (g != 0) {
                if (hi == 0) { ML[q0 + r * r32] = mrun; LL[q0 + r * r32] = ltot; }
#pragma unroll
                for (int q = 0; q < 16; ++q) { const int tl = q0 + r * crow(q, hi);
                    OL[tl * 64 + r32] = (unsigned short)(pkbf(o0[q], 0.f) & 0xffffu); OL[tl * 64 + 32 + r32] = (unsigned short)(pkbf(o1[q], 0.f) & 0xffffu); }
            } else {
                float il[16]; bcast_rows(1.0f / ltot, sc, r32, hi, il);
#pragma unroll
                for (int q = 0; q < 16; ++q) { o0[q] *= il[q]; o1[q] *= il[q]; }
                store_o(o0, o1, wl, OC + (rowb + t0 + q0) * 768 + 512 + j * 64, 768, lane);
            }
        }
        asm volatile("s_waitcnt lgkmcnt(0)" ::: "memory"); __builtin_amdgcn_s_barrier(); asm volatile("" ::: "memory");
    }
}
#undef ALAS
}

constexpr int NWAVES = 8;
#ifndef MK_N_LAUNCHES
#define MK_N_LAUNCHES 1
#endif
#ifndef MK_LAST_PHASE
#define MK_LAST_PHASE 8
#endif
constexpr int N_LAUNCHES = MK_N_LAUNCHES;
constexpr int PER_PHASE = 8;

constexpr int BATCH = 16, SEQ = 4096, D = 1024, T = BATCH * SEQ;
constexpr int N1 = 5888;
constexpr int NEXP = 16384;
constexpr size_t MiB = 1u << 20;
constexpr size_t WS_CTL = 0, CTL_ZERO_BYTES = 1 * MiB;
constexpr size_t WS_WIN = 2 * MiB;
constexpr size_t WS_WCAT = 16 * MiB;
constexpr size_t WS_WOUT = 18 * MiB;
constexpr size_t WS_WC = 20 * MiB;
constexpr size_t WS_RINV1 = 24 * MiB;
constexpr size_t WS_RINV2 = 25 * MiB;
constexpr size_t WS_USC = 25 * MiB + 512 * 1024, WS_VSC = 25 * MiB + 768 * 1024;
constexpr size_t WS_SSQ = 26 * MiB;
constexpr size_t WS_U8 = 32 * MiB;
constexpr size_t WS_V8 = 64 * MiB;
constexpr size_t WS_IDS = 96 * MiB;
constexpr size_t WS_GW = 112 * MiB;
constexpr size_t WS_XB = 144 * MiB;
constexpr size_t WS_QS = 272 * MiB, WS_KS = 336 * MiB, WS_VS = 400 * MiB;
constexpr size_t WS_QD = 464 * MiB, WS_KD = 560 * MiB, WS_VD = 656 * MiB;
constexpr size_t WS_GT = 752 * MiB;
constexpr size_t WS_COEF = 272 * MiB;
constexpr size_t WS_MIX = 272 * MiB;
constexpr size_t WS_X1B = 400 * MiB;
constexpr size_t WS_HQ = 528 * MiB;
constexpr size_t WS_HS2 = 24 * MiB + 512 * 1024;
constexpr size_t WS_XB8 = 72 * MiB;
constexpr size_t WS_WG8 = 40 * MiB;
constexpr size_t WS_GCS = 43 * MiB;
constexpr size_t WS_END = 1008 * MiB;
constexpr int CW_BAR = 4096;
constexpr int CW_GMAX = 16384;
constexpr int CW_XRANK = 8192;

constexpr int RING_OFF = 0, RING_BYTES = 131072;
constexpr int LDSCTL_OFF = 143360, MISC_OFF = LDSCTL_OFF + 320;
constexpr int LDS_BYTES = 147456;
static_assert(MISC_OFF + 128 <= LDS_BYTES, "LDS map");
#define GAS __attribute__((address_space(1)))
#define LAS __attribute__((address_space(3)))
typedef unsigned short bf16;
typedef unsigned v4u __attribute__((ext_vector_type(4)));
typedef float f32x4 __attribute__((ext_vector_type(4)));
typedef short bf16x8 __attribute__((ext_vector_type(8)));
typedef GAS unsigned gu32;
typedef GAS unsigned long long gu64;
#define RLX_AGENT __ATOMIC_RELAXED, __HIP_MEMORY_SCOPE_AGENT
#define LDS_WAIT() asm volatile("s_waitcnt lgkmcnt(0)" ::: "memory")
#define VM_WAIT() asm volatile("s_waitcnt vmcnt(0)" ::: "memory")
__device__ __forceinline__ unsigned long long rt() { return __builtin_amdgcn_s_memrealtime(); }
__device__ __forceinline__ unsigned f2bf(float f) { unsigned u = __builtin_bit_cast(unsigned, f); return (u + 0x7fffu + ((u >> 16) & 1u)) >> 16; }
__device__ __forceinline__ unsigned pk2(float lo, float hi) { return f2bf(lo) | (f2bf(hi) << 16); }

#define XB_TMO      128
#define XB_XCNT(j)  (256  + 64 * (j))
#define XB_XSUB(j)  (1280 + 64 * (j))
#define XB_XGEN(j)  (2304 + 64 * (j))
#define XB_TOP      3328
#define XB_TOPGEN   3392
#define XCD_BAR_WORDS 3456
#define XB_SPIN_CAP (1u << 18)

__device__ __forceinline__ unsigned xb_ld(unsigned* p)              { return __hip_atomic_load(p, __ATOMIC_RELAXED, __HIP_MEMORY_SCOPE_AGENT); }
__device__ __forceinline__ unsigned xb_add(unsigned* p, unsigned v) { return __hip_atomic_fetch_add(p, v, __ATOMIC_RELAXED, __HIP_MEMORY_SCOPE_AGENT); }
__device__ __forceinline__ unsigned xb_xcc_id() { return (unsigned)__builtin_amdgcn_s_getreg((3 << 11) | 20) & 0xFu; }
#define XB_SPIN(cond, bar) do { unsigned _sp = 0; while (cond) { __builtin_amdgcn_s_sleep(1); \
    if ((++_sp & 255u) == 0u) { if (xb_ld(&(bar)[XB_TMO])) break; if (_sp > XB_SPIN_CAP) { atomicAdd(&(bar)[XB_TMO], 1u); break; } } } } while (0)

struct XcdBarrier {
    unsigned* bar; unsigned x;
    volatile LAS unsigned* st;
};

__device__ __forceinline__ XcdBarrier xcd_barrier_post(unsigned* bar, volatile LAS unsigned* st) {
    XcdBarrier b; b.bar = bar; b.x = xb_xcc_id(); b.st = st;
    if (threadIdx.x == 0) (void)xb_add(&bar[XB_XCNT(b.x)], 1u);
    return b;
}
__device__ __forceinline__ void xcd_barrier_complete(unsigned* bar, unsigned x, unsigned& nloc, unsigned& nx) {
    const unsigned G = gridDim.x * gridDim.y * gridDim.z;
    unsigned sum, cnt, mine, sp = 0u;
    for (;;) {
        sum = 0u; cnt = 0u; mine = 0u;
#pragma unroll
        for (unsigned j = 0; j < 16; ++j) { const unsigned c = xb_ld(&bar[XB_XCNT(j)]); sum += c; cnt += (c > 0u) ? 1u : 0u; mine = (j == x) ? c : mine; }
        if (sum == G) break;
        __builtin_amdgcn_s_sleep(1);
        if ((++sp & 255u) == 0u) { if (xb_ld(&bar[XB_TMO])) break; if (sp > XB_SPIN_CAP) { atomicAdd(&bar[XB_TMO], 1u); break; } }
    }
    nloc = mine > 0u ? mine : 1u; nx = cnt > 0u ? cnt : 1u;
}

__device__ __forceinline__ void xcd_barrier(const XcdBarrier& b) {
    asm volatile("s_waitcnt vmcnt(0)" ::: "memory");
    __syncthreads();
    if (threadIdx.x == 0) {
        unsigned* bar = b.bar;
        __builtin_amdgcn_s_waitcnt(0);
        unsigned nloc = b.st[0], nx = b.st[1];
        if (nloc == 0u) { xcd_barrier_complete(bar, b.x, nloc, nx); b.st[0] = nloc; b.st[1] = nx; }
        const unsigned old = xb_add(&bar[XB_XSUB(b.x)], 1u);
        const unsigned gen = old / nloc;
        if (old + 1u == (gen + 1u) * nloc) {
            __builtin_amdgcn_fence(__ATOMIC_RELEASE, "agent");
            asm volatile("s_waitcnt vmcnt(0)" ::: "memory");
            const unsigned og = xb_add(&bar[XB_TOP], 1u);
            const unsigned tg = og / nx;
            if (og + 1u == (tg + 1u) * nx) xb_add(&bar[XB_TOPGEN], 1u);
            else XB_SPIN(xb_ld(&bar[XB_TOPGEN]) == tg, bar);
            __builtin_amdgcn_fence(__ATOMIC_ACQUIRE, "agent");
            xb_add(&bar[XB_XGEN(b.x)], 1u);
            asm volatile("s_waitcnt vmcnt(0)" ::: "memory");
        } else {
            XB_SPIN(xb_ld(&bar[XB_XGEN(b.x)]) == gen, bar);
            __builtin_amdgcn_fence(__ATOMIC_ACQUIRE, "agent");
            asm volatile("s_waitcnt vmcnt(0)" ::: "memory");
        }
    }
    __syncthreads();
}

typedef float f32x2 __attribute__((ext_vector_type(2)));
typedef unsigned v2u __attribute__((ext_vector_type(2)));
typedef _Float16 h2_t __attribute__((ext_vector_type(2)));
struct Frame {
    LAS unsigned char* lds;
    volatile LAS unsigned* MISC;
    gu32* ctl;
    int tid, lane, wave;
    int vcu, G;
};
__device__ __forceinline__ float wave_sum(float v) {
#pragma unroll
    for (int o = 1; o < 64; o <<= 1) v += __shfl_xor(v, o);
    return v;
}
__device__ __forceinline__ float wave_max(float v) {
#pragma unroll
    for (int o = 1; o < 64; o <<= 1) v = fmaxf(v, __shfl_xor(v, o));
    return v;
}
__device__ __forceinline__ int win_row(int n) { if (n < 1536 || n >= 3072) return n; const int t = (n - 1536) >> 8, ln = (n - 1536) & 255, hl = ln >> 6, d = ln & 63; return 1536 + t * 256 + 32 * hl + (d & 31) + 128 * (d >> 5); }
__device__ __forceinline__ void p0_transpose_item(const float* W, int N, const float* gain, bf16* WT, int ldt, int koff, int mode, LAS float* scr, int item, int lane) {
    const int nblk = N / 32, kb = item / nblk, nb = item % nblk, k0 = 64 * kb, n0 = 32 * nb;
#pragma unroll 8
    for (int i = 0; i < 32; ++i) { const int kk = 2 * i + (lane >> 5); float v = W[(size_t)(k0 + kk) * N + n0 + (lane & 31)]; if (gain) v *= gain[k0 + kk]; scr[kk * 33 + (lane & 31)] = v; }
    LDS_WAIT(); asm volatile("" ::: "memory");
    const int c = lane & 7;
#pragma unroll
    for (int j = 0; j < 4; ++j) { const int n = (lane >> 3) + 8 * j; const LAS float* s = scr + (8 * c) * 33 + n;
        v4u o; o.x = pk2(s[0 * 33], s[1 * 33]); o.y = pk2(s[2 * 33], s[3 * 33]); o.z = pk2(s[4 * 33], s[5 * 33]); o.w = pk2(s[6 * 33], s[7 * 33]);
        const int rown = mode ? win_row(n0 + n) : (n0 + n);
        *(GAS v4u*)(WT + (size_t)rown * ldt + koff + k0 + 8 * c) = o; }
    LDS_WAIT(); asm volatile("" ::: "memory");
}
__device__ __forceinline__ void p0_gate_max_item(const float* W, int N, const float* gain, unsigned* gmax, int kb, int n0, int lane) {
    const int k0 = 64 * kb; float am = 0.f;
#pragma unroll 8
    for (int i = 0; i < 32; ++i) { const int kk = 2 * i + (lane >> 5); am = fmaxf(am, fabsf(W[(size_t)(k0 + kk) * N + n0 + (lane & 31)] * gain[k0 + kk])); }
    am = fmaxf(am, __shfl_xor(am, 32));
    if (lane < 32) atomicMax(gmax + (n0 - 3840) + lane, __float_as_uint(am));
}
__device__ __forceinline__ void p0_gate_fp8_item(const float* W, int N, const float* gain, const unsigned* gmax, unsigned char* WG, float* cs, LAS float* scr, int item, int lane) {
    const int kb = item >> 6, nb = item & 63, k0 = 64 * kb, n0 = 32 * nb;
#pragma unroll 8
    for (int i = 0; i < 32; ++i) { const int kk = 2 * i + (lane >> 5); scr[kk * 33 + (lane & 31)] = W[(size_t)(k0 + kk) * N + 3840 + n0 + (lane & 31)] * gain[k0 + kk]; }
    LDS_WAIT(); asm volatile("" ::: "memory");
    const int c = lane & 7;
#pragma unroll
    for (int j = 0; j < 4; ++j) { const int n = (lane >> 3) + 8 * j; const LAS float* sp = scr + (8 * c) * 33 + n;
        const unsigned mb = xb_ld((unsigned*)gmax + n0 + n); const int ex = (int)((mb >> 23) & 0xffu);
        const float sc = (ex == 0) ? 1.0f : __uint_as_float((unsigned)(127 + 7 - (ex - 127)) << 23);
        int p0 = __builtin_amdgcn_cvt_pk_fp8_f32(sp[0 * 33] * sc, sp[1 * 33] * sc, 0, false); p0 = __builtin_amdgcn_cvt_pk_fp8_f32(sp[2 * 33] * sc, sp[3 * 33] * sc, p0, true);
        int p1 = __builtin_amdgcn_cvt_pk_fp8_f32(sp[4 * 33] * sc, sp[5 * 33] * sc, 0, false); p1 = __builtin_amdgcn_cvt_pk_fp8_f32(sp[6 * 33] * sc, sp[7 * 33] * sc, p1, true);
        *(GAS v2u*)(WG + (size_t)(n0 + n) * 1024 + k0 + 8 * c) = (v2u){(unsigned)p0, (unsigned)p1};
        if (kb == 0 && c == 0) cs[n0 + n] = (ex == 0) ? 1.0f : __uint_as_float((unsigned)(127 - 7 + (ex - 127)) << 23); }
    LDS_WAIT(); asm volatile("" ::: "memory");
}
__device__ __forceinline__ void quant_row_fp8(const float* src, const float* gain, unsigned char* dst, size_t slice_stride, float* scale_out, int lane) {
    f32x4 v[4]; float am = 0.f;
#pragma unroll
    for (int j = 0; j < 4; ++j) { v[j] = *(const GAS f32x4*)(src + 256 * j + 4 * lane); if (gain) v[j] = v[j] * *(const GAS f32x4*)(gain + 256 * j + 4 * lane);
        am = fmaxf(am, fmaxf(fmaxf(fabsf(v[j][0]), fabsf(v[j][1])), fmaxf(fabsf(v[j][2]), fabsf(v[j][3])))); }
    am = wave_max(am);
    const int ex = (int)((__float_as_uint(am) >> 23) & 0xffu);
    const float s = (ex == 0) ? 1.0f : __uint_as_float((unsigned)(127 + 7 - (ex - 127)) << 23);
    const float is = (ex == 0) ? 1.0f : __uint_as_float((unsigned)(127 - 7 + (ex - 127)) << 23);
    if (lane == 0) *scale_out = is;
#pragma unroll
    for (int j = 0; j < 4; ++j) { int pk = __builtin_amdgcn_cvt_pk_fp8_f32(v[j][0] * s, v[j][1] * s, 0, false); pk = __builtin_amdgcn_cvt_pk_fp8_f32(v[j][2] * s, v[j][3] * s, pk, true);
        const int col = 256 * j + 4 * lane; *(GAS int*)(dst + (size_t)(col >> 7) * slice_stride + (col & 127)) = pk; }
}
__device__ __forceinline__ void quant_row_fp4(const float* src, unsigned char* dst, size_t slice_stride, float* scale_out, int lane) {
    f32x4 v[4]; float am = 0.f;
#pragma unroll
    for (int j = 0; j < 4; ++j) { v[j] = *(const GAS f32x4*)(src + 256 * j + 4 * lane); am = fmaxf(am, fmaxf(fmaxf(fabsf(v[j][0]), fabsf(v[j][1])), fmaxf(fabsf(v[j][2]), fabsf(v[j][3])))); }
    am = wave_max(am);
    const float s = am > 0.f ? 6.0f / am : 0.f;
    if (lane == 0) *scale_out = am * (1.0f / 6.0f);
#pragma unroll
    for (int j = 0; j < 4; ++j) { unsigned pk = __builtin_amdgcn_cvt_scalef32_pk_fp4_f32(0u, v[j][0] * s, v[j][1] * s, 1.0f, 0); pk = __builtin_amdgcn_cvt_scalef32_pk_fp4_f32(pk, v[j][2] * s, v[j][3] * s, 1.0f, 1);
        *(GAS unsigned short*)(dst + (size_t)j * slice_stride + 2 * lane) = (unsigned short)(pk & 0xffffu); }
}
__device__ __forceinline__ void quant_row_i4(const float* src, const float* gain, unsigned char* dst, float* scale_out, int lane) {
    f32x4 v[4]; float am = 0.f, ss = 0.f;
    const int p16 = (lane >> 2) & 15, wl = lane & 3;
#pragma unroll
    for (int ld = 0; ld < 2; ++ld)
#pragma unroll
        for (int sn = 0; sn < 2; ++sn) { const int hd = 2 * (4 * ld + wl) + sn; const int idx = 256 * (hd >> 2) + 16 * p16 + 4 * (hd & 3);
            f32x4 t = *(const GAS f32x4*)(src + idx); if (gain) t = t * *(const GAS f32x4*)(gain + idx); v[2 * ld + sn] = t;
            am = fmaxf(am, fmaxf(fmaxf(fabsf(t[0]), fabsf(t[1])), fmaxf(fabsf(t[2]), fabsf(t[3])))); ss += (t[0] * t[0] + t[1] * t[1]) + (t[2] * t[2] + t[3] * t[3]); }
    am = wave_max(am); ss = wave_sum(ss);
    const float clipv = fminf(am, 2.5f * sqrtf(ss * (1.0f / 1024.0f)));
    const float s = clipv > 0.f ? 7.0f / clipv : 0.f;
    if (lane == 0) *scale_out = clipv * (1.0f / (7.0f * 16.0f));
#pragma unroll
    for (int ld = 0; ld < 2; ++ld) { unsigned pk = 0u;
#pragma unroll
        for (int b4 = 0; b4 < 4; ++b4) { int q0 = (int)__builtin_rintf(v[2 * ld][b4] * s), q1 = (int)__builtin_rintf(v[2 * ld + 1][b4] * s);
            q0 = q0 < -7 ? -7 : (q0 > 7 ? 7 : q0); q1 = q1 < -7 ? -7 : (q1 > 7 ? 7 : q1);
            pk |= ((unsigned)(q0 & 15) | ((unsigned)(q1 & 15) << 4)) << (8 * b4); }
        *(GAS unsigned*)(dst + ld * 256 + 16 * p16 + 4 * wl) = pk; }
}
__device__ __forceinline__ float gelu_f(float v) {
    const float av = fabsf(v), t = __builtin_amdgcn_rcpf(av * 0.2316418882f + 1.0f);
    float q = t * 0.5307027145f + (-0.7265760135f); q = q * t + 0.7107068705f; q = q * t + (-0.142248368f); q = q * t + 0.127414796f; q = q * t;
    const float e = __builtin_amdgcn_exp2f((v * v) * (-0.72134752044f));
    const float m = v * (q * e);
    return v < 0.f ? m : v - m;
}

struct Args { const float* in[14]; float* out; unsigned char* ws; int ph_lo, ph_hi, li, pad; };
__global__ void __launch_bounds__(NWAVES * 64, 2) fwd_kernel(Args args) {
    extern __shared__ __attribute__((aligned(16))) unsigned char lds[];
    Frame F;
    F.lds = (LAS unsigned char*)lds;
    F.MISC = (volatile LAS unsigned*)(F.lds + MISC_OFF);
    F.tid = threadIdx.x; F.lane = F.tid & 63; F.wave = __builtin_amdgcn_readfirstlane(F.tid >> 6);
    F.G = gridDim.x; { const int bx = blockIdx.x; F.vcu = (F.G % 8 == 0) ? (bx % 8) * (F.G / 8) + bx / 8 : bx; }
    unsigned char* ws = args.ws;
    F.ctl = (gu32*)(ws + WS_CTL);
    const float* x = args.in[0]; const float* norm1_gain = args.in[1]; const float* w_in = args.in[2]; const float* b_gate = args.in[3];
    const float* q_gain = args.in[4]; const float* k_gain = args.in[5]; const float* w_sb_out = args.in[6]; const float* w_dil_out = args.in[7];
    const float* w_out = args.in[8]; const float* norm2_gain = args.in[9]; const float* w_peer_q = args.in[10]; const float* sub_keys = args.in[11];
    const float* peer_u = args.in[12]; const float* peer_v = args.in[13];
    float* out = args.out;
    bf16* WIN = (bf16*)(ws + WS_WIN); bf16* WCAT = (bf16*)(ws + WS_WCAT); bf16* WOUT = (bf16*)(ws + WS_WOUT); bf16* WC = (bf16*)(ws + WS_WC);
    float* RINV1 = (float*)(ws + WS_RINV1); float* RINV2 = (float*)(ws + WS_RINV2); float* USC = (float*)(ws + WS_USC); float* VSC = (float*)(ws + WS_VSC); float* SSQ = (float*)(ws + WS_SSQ);
    unsigned char* U8 = ws + WS_U8; unsigned char* V8 = ws + WS_V8;
    unsigned short* IDS = (unsigned short*)(ws + WS_IDS); float* GW = (float*)(ws + WS_GW); float* COEF = (float*)(ws + WS_COEF); unsigned char* HQ = ws + WS_HQ; float* HS2 = (float*)(ws + WS_HS2);
    bf16* XB = (bf16*)(ws + WS_XB); bf16* OC = (bf16*)(ws + WS_XB); unsigned char* XB8 = ws + WS_XB8; unsigned char* WG8 = ws + WS_WG8; float* GCS = (float*)(ws + WS_GCS);
    bf16* QS = (bf16*)(ws + WS_QS); bf16* KS = (bf16*)(ws + WS_KS); bf16* VS = (bf16*)(ws + WS_VS);
    bf16* QD = (bf16*)(ws + WS_QD); bf16* KD = (bf16*)(ws + WS_KD); bf16* VD = (bf16*)(ws + WS_VD);
    bf16* GT = (bf16*)(ws + WS_GT); bf16* MIX = (bf16*)(ws + WS_MIX); bf16* X1B = (bf16*)(ws + WS_X1B);

    for (int u = F.tid; u < (LDS_BYTES - LDSCTL_OFF) / 4; u += NWAVES * 64) ((LAS unsigned*)(F.lds + LDSCTL_OFF))[u] = 0u;
    __syncthreads();
    const int my_xcc = (int)xb_xcc_id();
    if (F.tid == 0) F.MISC[12] = xb_add((unsigned*)(F.ctl + CW_XRANK) + 64 * my_xcc, 1u);
    __syncthreads();
    const int my_xrank = (int)F.MISC[12];
    const int bli = (N_LAUNCHES == PER_PHASE) ? 0 : args.li;
    XcdBarrier bar; bar.bar = (unsigned*)(F.ctl + CW_BAR) + bli * XCD_BAR_WORDS; bar.x = 0; bar.st = nullptr;
    if (N_LAUNCHES != PER_PHASE) bar = xcd_barrier_post((unsigned*)(F.ctl + CW_BAR) + bli * XCD_BAR_WORDS, F.MISC + 8);
    const int lo = args.ph_lo, hi = args.ph_hi;
#ifndef PHASE_MASK
#define PHASE_MASK 0xff
#endif
#define IN(k) (((PHASE_MASK >> (k)) & 1) && lo <= (k) && (k) < hi)
#define BOTH(k) (IN(k) && IN((k) + 1))
#define GRID_BAR() do { if (N_LAUNCHES != PER_PHASE) xcd_barrier(bar); } while (0)
#ifndef PROBE_REPEAT
#define PROBE_REPEAT 0x00
#endif
#ifndef PROBE_L1
#define PROBE_L1 0x0
#endif
#define REP(k) _Pragma("unroll") for (int rep_ = 0; rep_ < (((PROBE_REPEAT >> (k)) & 1) ? 2 : 1); ++rep_)
    const int gw = F.vcu * NWAVES + F.wave, NGW = F.G * NWAVES;
#define P67_MAP() int vx = (int)(blockIdx.x & 7), rk = (int)(blockIdx.x >> 3), nrk = (F.G + 7 - vx) / 8; bool p67_uni = false; \
        { bool uni_ = (F.G % 8 == 0); for (int j_ = 0; j_ < 16; ++j_) { const unsigned c_ = xb_ld((unsigned*)(F.ctl + CW_XRANK) + 64 * j_); uni_ = uni_ && (c_ == (j_ < 8 ? (unsigned)(F.G / 8) : 0u)); } \
          if (uni_) { vx = my_xcc; rk = my_xrank; nrk = F.G / 8; p67_uni = true; } }

    if (IN(0)) REP(0) {
        for (int it = F.vcu; it < 256; it += F.G) {
            const int hp = it >> 4, d0 = (it & 15) * 64;
            LAS float* As = (LAS float*)(F.lds);
            LAS float* Bs = (LAS float*)(F.lds + 64 * 132 * 4);
            for (int e = F.tid; e < 64 * 32; e += 512) { const int r = e >> 5, c4 = (e & 31) * 4; *(LAS f32x4*)(As + r * 132 + c4) = *(const GAS f32x4*)(w_peer_q + (size_t)(d0 + r) * 2048 + hp * 128 + c4); }
            for (int e = F.tid; e < 128 * 32; e += 512) { const int r = e >> 5, c4 = (e & 31) * 4; *(LAS f32x4*)(Bs + r * 132 + c4) = *(const GAS f32x4*)(sub_keys + ((size_t)hp * 128 + r) * 128 + c4); }
            __syncthreads();
            const int ddg = F.tid & 15, ng = F.tid >> 4;
            f32x4 acc[4];
#pragma unroll
            for (int j = 0; j < 4; ++j) acc[j] = (f32x4){0.f, 0.f, 0.f, 0.f};
            for (int c4 = 0; c4 < 128; c4 += 4) {
                f32x4 a[4], b[4];
#pragma unroll
                for (int i = 0; i < 4; ++i) { a[i] = *(const LAS f32x4*)(As + (4 * ddg + i) * 132 + c4); b[i] = *(const LAS f32x4*)(Bs + (4 * ng + i) * 132 + c4); }
#pragma unroll
                for (int j = 0; j < 4; ++j)
#pragma unroll
                    for (int i = 0; i < 4; ++i) acc[j][i] += (a[i][0] * b[j][0] + a[i][1] * b[j][1]) + (a[i][2] * b[j][2] + a[i][3] * b[j][3]);
            }
            const f32x4 g2 = *(const GAS f32x4*)(norm2_gain + d0 + 4 * ddg);
#pragma unroll
            for (int j = 0; j < 4; ++j) { v2u o; o.x = pk2(acc[j][0] * g2[0], acc[j][1] * g2[1]); o.y = pk2(acc[j][2] * g2[2], acc[j][3] * g2[3]);
                *(GAS v2u*)(WC + (size_t)(hp * 128 + 4 * ng + j) * 1024 + d0 + 4 * ddg) = o; }
            __syncthreads();
        }
        {
            LAS float* scr = (LAS float*)(F.lds + RING_OFF + F.wave * 16384);
            constexpr int I_IN = (D / 64) * (N1 / 32), I_SB = (512 / 64) * (D / 32), I_DL = (256 / 64) * (D / 32), I_OUT = (D / 64) * (D / 32);
            constexpr int NITEMS = I_IN + I_SB + I_DL + I_OUT;
            for (int it = gw; it < NITEMS; it += NGW) {
                int r = it;
                if (r < I_IN) { const int nb_ = r % (N1 / 32); if (nb_ >= 3840 / 32) p0_gate_max_item(w_in, N1, norm1_gain, (unsigned*)(F.ctl + CW_GMAX), r / (N1 / 32), 32 * nb_, F.lane); else p0_transpose_item(w_in, N1, norm1_gain, WIN, 1024, 0, 1, scr, r, F.lane); continue; } r -= I_IN;
                if (r < I_SB) { p0_transpose_item(w_sb_out, D, nullptr, WCAT, 768, 0, 0, scr, r, F.lane); continue; } r -= I_SB;
                if (r < I_DL) { p0_transpose_item(w_dil_out, D, nullptr, WCAT, 768, 512, 0, scr, r, F.lane); continue; } r -= I_DL;
                p0_transpose_item(w_out, D, nullptr, WOUT, 1024, 0, 0, scr, r, F.lane);
            }
        }
        for (int e = gw; e < 2 * NEXP; e += NGW) {
            if (e < NEXP) quant_row_i4(peer_u + (size_t)e * D, norm2_gain, U8 + (size_t)e * 512, USC + e, F.lane);
            else { const int ev = e - NEXP; quant_row_fp4(peer_v + (size_t)ev * D, V8 + (size_t)ev * 128, (size_t)NEXP * 128, VSC + ev, F.lane); }
        }
        for (int m = gw; m < T; m += NGW) {
            const GAS f32x4* xr = (const GAS f32x4*)(x + (size_t)m * D) + F.lane;
            f32x4 v[4]; float s = 0.f;
#pragma unroll
            for (int j = 0; j < 4; ++j) { v[j] = xr[64 * j]; s += (v[j][0] * v[j][0] + v[j][1] * v[j][1]) + (v[j][2] * v[j][2] + v[j][3] * v[j][3]); }
            s = wave_sum(s);
            const float rn = __builtin_amdgcn_rsqf(s * (1.0f / D) + 1e-6f);
            GAS unsigned long long* o8 = (GAS unsigned long long*)(XB + (size_t)m * D) + F.lane;
#pragma unroll
            for (int j = 0; j < 4; ++j) o8[64 * j] = (unsigned long long)pk2(v[j][0] * rn, v[j][1] * rn) | ((unsigned long long)pk2(v[j][2] * rn, v[j][3] * rn) << 32);
#pragma unroll
            for (int j = 0; j < 4; ++j) { int pk = __builtin_amdgcn_cvt_pk_fp8_f32(v[j][0] * rn, v[j][1] * rn, 0, false); pk = __builtin_amdgcn_cvt_pk_fp8_f32(v[j][2] * rn, v[j][3] * rn, pk, true);
                *(GAS int*)(XB8 + (size_t)m * D + 256 * j + 4 * F.lane) = pk; }
        }
        if (BOTH(0)) GRID_BAR();
    }

    if (IN(1)) REP(1) {
        { LAS float* scr = (LAS float*)(F.lds + RING_OFF + F.wave * 16384);
          for (int it = gw; it < 1024; it += NGW) p0_gate_fp8_item(w_in, N1, norm1_gain, (const unsigned*)(F.ctl + CW_GMAX), WG8, GCS, scr, it, F.lane);
          __syncthreads(); }
        { pg8::Gemm g{XB, WIN, T, 3840, D}; pg8::StaticOrder S; S.init(T, 3840, F.G, (int)blockIdx.x);
          pg8::Epi1 E{RINV1, b_gate, q_gain, k_gain, QS, KS, VS, QD, KD, VD, GT};
          pg8::gemm_phase<pg8::Epi1, pg8::StaticOrder, true, true>(F.lds + RING_OFF, g, S, E); }
        GRID_BAR();
        { pg8::Gemm g{(const bf16*)XB8, (const bf16*)WG8, T, 2048, D / 2}; pg8::StaticOrder S; S.init(T, 2048, F.G, (int)blockIdx.x);
          pg8::EpiG E{b_gate, GCS, GT};
          pg8::gemm_phase<pg8::EpiG, pg8::StaticOrder, true, true, true>(F.lds + RING_OFF, g, S, E); }
        if (BOTH(1)) GRID_BAR();
    }

    if (IN(2)) REP(2) {
        LAS unsigned char* wl = F.lds + RING_OFF + F.wave * 16384;
        static_assert(att::DLU_BYTES <= RING_BYTES, "dilated-attention LDS state");
        for (int un = F.vcu; un < 512; un += F.G) { const int blk = un & 7, j = (un >> 3) & 3, b = un >> 5; att::dl_unit(QD, KD, VD, OC, b, j, blk, F.lds + RING_OFF, F.wave, F.lane); }
        for (int it = gw; it < 16384; it += NGW) { const int qt = 127 - (it & 127), h = (it >> 7) & 7, b = it >> 10; att::sb_item(QS, KS, VS, OC, b, h, qt, wl, F.lane); }
        if (BOTH(2)) GRID_BAR();
    }

    if (IN(3)) REP(3) {
        pg8::Gemm g{OC, WCAT, T, D, 768}; pg8::StaticOrder S; S.init(T, D, F.G, (int)blockIdx.x);
        pg8::Epi2 E{GT, MIX};
        pg8::gemm_phase<pg8::Epi2, pg8::StaticOrder, true, true>(F.lds + RING_OFF, g, S, E);
        if (BOTH(3)) GRID_BAR();
    }

    if (IN(4)) REP(4) {
        pg8::Gemm g{MIX, WOUT, T, D, D}; pg8::StaticOrder S; S.init(T, D, F.G, (int)blockIdx.x);
        pg8::Epi3 E{x, X1B, SSQ};
        pg8::gemm_phase<pg8::Epi3, pg8::StaticOrder, true, true>(F.lds + RING_OFF, g, S, E);
        if (BOTH(4)) GRID_BAR();
    }

    if (IN(5)) REP(5) {
        for (int m = gw; m < T; m += NGW) {
            const v4u a = *(const GAS v4u*)(X1B + (size_t)m * D + 8 * F.lane), b = *(const GAS v4u*)(X1B + (size_t)m * D + 512 + 8 * F.lane);
            float v[16] = {pg8::bflo(a.x), pg8::bfhi(a.x), pg8::bflo(a.y), pg8::bfhi(a.y), pg8::bflo(a.z), pg8::bfhi(a.z), pg8::bflo(a.w), pg8::bfhi(a.w),
                           pg8::bflo(b.x), pg8::bfhi(b.x), pg8::bflo(b.y), pg8::bfhi(b.y), pg8::bflo(b.z), pg8::bfhi(b.z), pg8::bflo(b.w), pg8::bfhi(b.w)};
            float am = 0.f;
#pragma unroll
            for (int i = 0; i < 16; ++i) am = fmaxf(am, fabsf(v[i]));
            am = wave_max(am);
            float sq = (F.lane < 16) ? SSQ[(size_t)m * 16 + F.lane] : 0.f; sq = wave_sum(sq);
            const float s = am > 0.f ? 127.0f / am : 0.f;
            if (F.lane == 0) HS2[m] = am * (1.0f / 127.0f) * __builtin_amdgcn_rsqf(sq * (1.0f / 1024.0f) + 1e-6f);
            int q[16];
#pragma unroll
            for (int i = 0; i < 16; ++i) q[i] = (int)__builtin_rintf(v[i] * s) & 0xff;
            v2u o0, o1; o0.x = q[0] | (q[1] << 8) | (q[2] << 16) | (q[3] << 24); o0.y = q[4] | (q[5] << 8) | (q[6] << 16) | (q[7] << 24);
            o1.x = q[8] | (q[9] << 8) | (q[10] << 16) | (q[11] << 24); o1.y = q[12] | (q[13] << 8) | (q[14] << 16) | (q[15] << 24);
            *(GAS v2u*)(HQ + (size_t)m * D + 8 * F.lane) = o0; *(GAS v2u*)(HQ + (size_t)m * D + 512 + 8 * F.lane) = o1;
        }
        pg8::Gemm g{X1B, WC, T, 2048, D}; pg8::StaticOrder S; S.init(T, 2048, F.G, (int)blockIdx.x);
        pg8::Epi4 E{SSQ, RINV2, IDS, GW};
        pg8::OneUnit O1;
        for (int i = 0; S.next(i, O1.u); ++i) pg8::gemm_phase<pg8::Epi4, pg8::OneUnit, false, true>(F.lds + RING_OFF, g, O1, E);
        if (BOTH(5)) GRID_BAR();
    }

    if (IN(6)) REP(6) {
        P67_MAP();
        const int p16 = F.lane & 15, sg = F.lane >> 4;
        LAS unsigned char* HB = F.lds + RING_OFF;
        LAS unsigned* LIST = (LAS unsigned*)(F.lds + RING_OFF + 65536);
        LAS unsigned* CNT = (LAS unsigned*)(F.lds + RING_OFF + 98304);
        LAS float* HSs = (LAS float*)(F.lds + RING_OFF + 98304 + 256);
        const int nblk = T / 64;
        const int gsel = (F.lane & 15), bpsrc = (16 * (F.lane & 3) + ((F.lane >> 2) & 3)) * 4;
        v4u hpre[8], idpre[2]; float hspre = 0.f;
#define P6_PRE(bb) do { const int bc_ = (bb) < nblk ? (bb) : nblk - 1; const unsigned char* hsrc_ = HQ + (size_t)bc_ * 65536; \
            _Pragma("unroll") for (int i_ = 0; i_ < 8; ++i_) hpre[i_] = *(const GAS v4u*)(hsrc_ + (size_t)(i_ * 512 + F.tid) * 16); \
            const unsigned short* isrc_ = IDS + ((size_t)bc_ * 64 + (F.tid >> 3)) * 128 + 16 * (F.tid & 7); idpre[0] = *(const GAS v4u*)isrc_; idpre[1] = *(const GAS v4u*)(isrc_ + 8); \
            hspre = HS2[(size_t)bc_ * 64 + (F.tid & 63)]; } while (0)
        int blk = rk;
        P6_PRE(blk);
        for (; blk < nblk; blk += nrk) {
            const int t0 = blk * 64;
            if (F.tid == 0) *CNT = 0u;
            if (F.tid < 64) HSs[F.tid] = hspre;
#pragma unroll
            for (int i = 0; i < 8; ++i) *(LAS v4u*)(HB + (size_t)(i * 512 + F.tid) * 16) = hpre[i];
            __syncthreads();
            { const unsigned idw[8] = {idpre[0].x, idpre[0].y, idpre[0].z, idpre[0].w, idpre[1].x, idpre[1].y, idpre[1].z, idpre[1].w};
              const unsigned tl = (unsigned)(F.tid >> 3), kb0 = 16u * (unsigned)(F.tid & 7);
#pragma unroll
              for (int i = 0; i < 16; ++i) { const unsigned e = (i & 1) ? (idw[i >> 1] >> 16) : (idw[i >> 1] & 0xffffu);
                  if ((int)(e >> 11) == vx) { const unsigned pos = __hip_atomic_fetch_add(CNT, 1u, __ATOMIC_RELAXED, __HIP_MEMORY_SCOPE_WORKGROUP); LIST[pos] = (tl << 24) | ((kb0 + (unsigned)i) << 16) | e; } } }
            __syncthreads();
            const int n = (int)*CNT;
            P6_PRE(blk + nrk);
#define P6_ISSUE(W, ENT, EJ, GB, UB, VB, base_) do { \
                _Pragma("unroll") for (int g_ = 0; g_ < 4; ++g_) { const int j_ = (base_) + 4 * g_ + sg; ENT[g_] = LIST[j_ < n ? j_ : n - 1]; } \
                { const int j_ = (base_) + gsel; EJ = (j_ < n && F.lane < 16) ? (int)LIST[j_] : -1; } \
                _Pragma("unroll") for (int g_ = 0; g_ < 4; ++g_) { const unsigned char* up_ = U8 + (size_t)((PROBE_L1 && rep_) ? 0u : (ENT[g_] & 0xffffu)) * 512 + 16 * p16; \
                    _Pragma("unroll") for (int i_ = 0; i_ < 2; ++i_) W[g_][i_] = *(const GAS v4u*)(up_ + 256 * i_); } \
                { const unsigned ej_ = EJ < 0 ? LIST[0] : (unsigned)EJ; GB = GW[((size_t)t0 + (ej_ >> 24)) * 128 + ((ej_ >> 16) & 127u)]; UB = USC[ej_ & 0xffffu]; VB = VSC[ej_ & 0xffffu]; } } while (0)
#define P6_DPPADD(a_, ctrl) a_ += __builtin_amdgcn_update_dpp(0, a_, ctrl, 0xf, 0xf, false)
#define P6_REDUCE(W, ENT, EJ, GB, UB, VB, base_) do { if ((base_) < n) { int ag_[4]; \
                _Pragma("unroll") for (int g_ = 0; g_ < 4; ++g_) { const LAS unsigned char* hp_ = HB + (size_t)(ENT[g_] >> 24) * 1024 + 16 * p16; int a_ = 0; v4u h_[4]; \
                    _Pragma("unroll") for (int i_ = 0; i_ < 4; ++i_) h_[i_] = *(const LAS v4u*)(hp_ + 256 * i_); \
                    _Pragma("unroll") for (int ld_ = 0; ld_ < 2; ++ld_) { const unsigned x_[4] = {W[g_][ld_].x, W[g_][ld_].y, W[g_][ld_].z, W[g_][ld_].w}; \
                        _Pragma("unroll") for (int wl_ = 0; wl_ < 4; ++wl_) { const int hd_ = 2 * (4 * ld_ + wl_); const unsigned lo_ = (x_[wl_] << 4) & 0xF0F0F0F0u, hi_ = x_[wl_] & 0xF0F0F0F0u; \
                            const unsigned hA_ = (hd_ & 3) == 0 ? h_[hd_ >> 2].x : h_[hd_ >> 2].z, hB_ = (hd_ & 3) == 0 ? h_[hd_ >> 2].y : h_[hd_ >> 2].w; \
                            a_ = __builtin_amdgcn_sdot4((int)lo_, (int)hA_, a_, false); a_ = __builtin_amdgcn_sdot4((int)hi_, (int)hB_, a_, false); } } \
                    P6_DPPADD(a_, 0xB1); P6_DPPADD(a_, 0x4E); P6_DPPADD(a_, 0x141); P6_DPPADD(a_, 0x140); ag_[g_] = a_; } \
                const int sel_ = gsel == 0 ? ag_[0] : gsel == 1 ? ag_[1] : gsel == 2 ? ag_[2] : ag_[3]; \
                const float resv_ = (float)__builtin_amdgcn_ds_bpermute(bpsrc, sel_); \
                if (EJ >= 0 && !(PROBE_L1 && rep_)) { const unsigned ej_ = (unsigned)EJ; const float act_ = gelu_f(resv_ * UB * HSs[ej_ >> 24]); \
                    COEF[((size_t)t0 + (ej_ >> 24)) * 128 + ((ej_ >> 16) & 127u)] = GB * act_ * VB; } } } while (0)
            for (int base = F.wave * 32; base < n; base += NWAVES * 32) {
                v4u wA[4][2], wB[4][2]; unsigned entA[4], entB[4]; int ejA, ejB; float gbA, ubA, vbA, gbB, ubB, vbB;
                P6_ISSUE(wA, entA, ejA, gbA, ubA, vbA, base);
                P6_ISSUE(wB, entB, ejB, gbB, ubB, vbB, base + 16);
                P6_REDUCE(wA, entA, ejA, gbA, ubA, vbA, base);
                P6_REDUCE(wB, entB, ejB, gbB, ubB, vbB, base + 16);
            }
#undef P6_ISSUE
#undef P6_REDUCE
#undef P6_DPPADD
            __syncthreads();
        }
#undef P6_PRE
        if (BOTH(6)) GRID_BAR();
    }

    if (IN(7)) REP(7) {
        P67_MAP();
        const int cs = vx >> 1;
        const int n0_ = p67_uni ? F.G / 8 : (F.G + 7 - 2 * cs) / 8, n1_ = p67_uni ? F.G / 8 : (F.G + 7 - (2 * cs + 1)) / 8;
        const int rk2 = (vx & 1) ? n0_ + rk : rk, nrk2 = n0_ + n1_;
        const int l8 = F.lane & 7, kg = F.lane >> 3;
        const unsigned char* vbase = V8 + (size_t)cs * NEXP * 128 + 16 * l8;
        const int tstep = nrk2 * NWAVES;
        const int col = 256 * cs + 32 * l8 + ((F.lane & 8) ? 16 : 0) + ((F.lane & 16) ? 8 : 0) + ((F.lane & 32) ? 4 : 0);
#define P7_CL(tt) ((tt) < T ? (tt) : T - 1)
#define P7_IDS(tt, ID) do { const int tc_ = P7_CL(tt); ID[0] = *(const GAS v4u*)(IDS + (size_t)tc_ * 128 + 16 * kg); ID[1] = *(const GAS v4u*)(IDS + (size_t)tc_ * 128 + 16 * kg + 8); } while (0)
#define P7_ISSUE(tt, ID, W, CF, OO) do { const int tc_ = P7_CL(tt); const unsigned idw_[8] = {ID[0].x, ID[0].y, ID[0].z, ID[0].w, ID[1].x, ID[1].y, ID[1].z, ID[1].w}; \
            _Pragma("unroll") for (int i_ = 0; i_ < 16; ++i_) { const unsigned e_ = (i_ & 1) ? (idw_[i_ >> 1] >> 16) : (idw_[i_ >> 1] & 0xffffu); W[i_] = *(const GAS v4u*)(vbase + (size_t)((PROBE_L1 && rep_) ? 0u : e_) * 128); } \
            _Pragma("unroll") for (int i_ = 0; i_ < 4; ++i_) CF[i_] = *(const GAS f32x4*)(COEF + (size_t)tc_ * 128 + 16 * kg + 4 * i_); \
            OO = *(const GAS v2u*)(X1B + (size_t)tc_ * D + col); } while (0)
#define P7_BYTE(d_, s_) do { const h2_t r_ = __builtin_amdgcn_cvt_scalef32_pk_f16_fp4(ww_[d_], 1.0f, s_); acc_[4 * (d_) + (s_)] = r_ * c2_ + acc_[4 * (d_) + (s_)]; } while (0)
#define P7_COMPUTE(tt, W, CF, OO) do { h2_t acc_[16];                 \
            _Pragma("unroll") for (int i_ = 0; i_ < 16; ++i_) acc_[i_] = (h2_t){(_Float16)0.f, (_Float16)0.f}; \
            _Pragma("unroll") for (int i_ = 0; i_ < 16; ++i_) { const unsigned ww_[4] = {W[i_].x, W[i_].y, W[i_].z, W[i_].w}; const _Float16 ch_ = (_Float16)CF[i_ >> 2][i_ & 3]; const h2_t c2_ = {ch_, ch_}; \
                P7_BYTE(0, 0); P7_BYTE(0, 1); P7_BYTE(0, 2); P7_BYTE(0, 3); P7_BYTE(1, 0); P7_BYTE(1, 1); P7_BYTE(1, 2); P7_BYTE(1, 3); \
                P7_BYTE(2, 0); P7_BYTE(2, 1); P7_BYTE(2, 2); P7_BYTE(2, 3); P7_BYTE(3, 0); P7_BYTE(3, 1); P7_BYTE(3, 2); P7_BYTE(3, 3); } \
            float r16_[16], r8_[8], r4_[4]; \
            { const bool up_ = (F.lane & 8) != 0; _Pragma("unroll") for (int i_ = 0; i_ < 8; ++i_) { const h2_t keep_ = up_ ? acc_[8 + i_] : acc_[i_], send_ = up_ ? acc_[i_] : acc_[8 + i_]; \
                const h2_t oth_ = __builtin_bit_cast(h2_t, __shfl_xor(__builtin_bit_cast(int, send_), 8)); r16_[2 * i_] = (float)keep_[0] + (float)oth_[0]; r16_[2 * i_ + 1] = (float)keep_[1] + (float)oth_[1]; } } \
            { const bool up_ = (F.lane & 16) != 0; _Pragma("unroll") for (int i_ = 0; i_ < 8; ++i_) { const float keep_ = up_ ? r16_[8 + i_] : r16_[i_], send_ = up_ ? r16_[i_] : r16_[8 + i_]; r8_[i_] = keep_ + __shfl_xor(send_, 16); } } \
            { const bool up_ = (F.lane & 32) != 0; _Pragma("unroll") for (int i_ = 0; i_ < 4; ++i_) { const float keep_ = up_ ? r8_[4 + i_] : r8_[i_], send_ = up_ ? r8_[i_] : r8_[4 + i_]; r4_[i_] = keep_ + __shfl_xor(send_, 32); } } \
            if ((tt) < T) *(GAS f32x4*)((rep_ == 0 ? out : (float*)(ws + WS_GT)) + (size_t)(tt) * D + col) = (f32x4){pg8::bflo(OO.x) + r4_[0], pg8::bfhi(OO.x) + r4_[1], pg8::bflo(OO.y) + r4_[2], pg8::bfhi(OO.y) + r4_[3]}; } while (0)
        v4u idA[2], idB[2], wA[16], wB[16]; f32x4 cfA[4], cfB[4]; v2u ooA, ooB;
        int t = rk2 * NWAVES + F.wave;
        P7_IDS(t, idA); P7_IDS(t + tstep, idB);
        while (t < T) {
            P7_ISSUE(t, idA, wA, cfA, ooA); P7_ISSUE(t + tstep, idB, wB, cfB, ooB);
            P7_IDS(t + 2 * tstep, idA); P7_IDS(t + 3 * tstep, idB);
            P7_COMPUTE(t, wA, cfA, ooA);
            P7_COMPUTE(t + tstep, wB, cfB, ooB);
            t += 2 * tstep;
        }
#undef P7_CL
#undef P7_IDS
#undef P7_ISSUE
#undef P7_BYTE
#undef P7_COMPUTE
    }
#undef IN
#undef BOTH
#undef GRID_BAR
}

extern "C" void kernel_launch(void* const* d_in, const int* in_sizes, int n_in, void* d_out, int out_size, void* d_ws, size_t ws_size, hipStream_t stream) {
    static int grid = 0;
    if (grid == 0) {
        if (n_in != 14 || in_sizes[0] != T * D || out_size != T * D || ws_size < WS_END) { fprintf(stderr, "kernel_launch: built for 14 inputs, x and out of %d floats, >= %zu bytes of workspace; got n_in %d, in0 %d, out %d, ws %zu; nothing launched\n", T * D, (size_t)WS_END, n_in, n_in > 0 ? in_sizes[0] : -1, out_size, ws_size); grid = -1; return; }
        int dev = 0, cus = 0, per_cu = 0;
        if (hipGetDevice(&dev) != hipSuccess || hipDeviceGetAttribute(&cus, hipDeviceAttributeMultiprocessorCount, dev) != hipSuccess) { fprintf(stderr, "kernel_launch: hipGetDevice / hipDeviceGetAttribute failed\n"); grid = -1; return; }
        if (hipFuncSetAttribute((const void*)fwd_kernel, hipFuncAttributeMaxDynamicSharedMemorySize, LDS_BYTES) != hipSuccess) { fprintf(stderr, "kernel_launch: hipFuncSetAttribute failed\n"); grid = -1; return; }
        if (hipOccupancyMaxActiveBlocksPerMultiprocessor(&per_cu, (const void*)fwd_kernel, NWAVES * 64, LDS_BYTES) != hipSuccess || per_cu < 1)
            fprintf(stderr, "kernel_launch: note: occupancy query reports %d workgroups per CU\n", per_cu);
        (void)hipGetLastError();
        grid = cus;
    }
    if (grid < 0) return;
    if (hipMemsetAsync((char*)d_ws + WS_CTL, 0, CTL_ZERO_BYTES, stream) != hipSuccess) { fprintf(stderr, "kernel_launch: hipMemsetAsync failed\n"); return; }
    Args a{};
    for (int i = 0; i < 14; ++i) a.in[i] = (const float*)d_in[i];
    a.out = (float*)d_out; a.ws = (unsigned char*)d_ws;
    for (int li = 0; li < N_LAUNCHES; ++li) {
        a.ph_lo = (N_LAUNCHES == PER_PHASE) ? li : 0; a.ph_hi = (N_LAUNCHES == PER_PHASE) ? li + 1 : MK_LAST_PHASE; a.li = li;
        if (a.ph_lo >= MK_LAST_PHASE) break;
        hipLaunchKernelGGL(fwd_kernel, dim3(grid), dim3(NWAVES * 64), LDS_BYTES, stream, a);
        const hipError_t le = hipPeekAtLastError();
        if (le != hipSuccess) { fprintf(stderr, "kernel_launch: launch %d failed: %s\n", li, hipGetErrorName(le)); break; }
    }
}
```

```cpp
#include <hip/hip_runtime.h>
#include <cstdio>
#include <cstdint>
namespace pg8 {
#define PG8_LAS __attribute__((address_space(3)))
typedef unsigned short bf16_t;
typedef short bf16x8 __attribute__((ext_vector_type(8)));
typedef float f32x4 __attribute__((ext_vector_type(4)));
typedef unsigned u32x4 __attribute__((ext_vector_type(4)));
typedef int i32x8 __attribute__((ext_vector_type(8)));
constexpr int BM = 256, BK = 64, HALF = 128, HTB = HALF * BK * 2  , STAGE_BYTES = 8 * HTB, NXCD = 8, WGM = 8;

__host__ __device__ __forceinline__ int lds_byte(int r, int c) { const int st = (r >> 4) * 2 + (c >> 5), rr = r & 15, cc = c & 31, ob = rr * 64 + cc * 2; return st * 1024 + (ob ^ (((ob >> 9) & 1) << 5)); }
__host__ __device__ __forceinline__ void stage_rc(int b, int& R, int& C) { const int st = b / 1024, sb = b % 1024, swz = sb ^ (((sb >> 9) & 1) << 5); R = (st >> 1) * 16 + swz / 64; C = (st & 1) * 32 + (swz % 64) / 2; }
__host__ __device__ __forceinline__ int perm32(int rho) { const int n = rho >> 4, i = rho & 15; return 8 * (i >> 2) + 4 * n + (i & 3); }

struct Unit { int pm, pn; };
struct Gemm { const bf16_t* A; const bf16_t* Bt; int M, N, K; };

struct StaticOrder {
    int nM, nN, nwg, G, c;
    __host__ __device__ void init(int M, int N, int G_, int c_) { nM = M / BM; nN = N / BM; nwg = nM * nN; G = G_; c = c_; }
    __host__ __device__ bool next(int i, Unit& u) const {
        const long L = (long)i * G + c; if (L >= nwg) return false;
        int wgid = (int)L; { const int q = nwg / NXCD, r = nwg % NXCD, xcd = wgid % NXCD, off = wgid / NXCD; wgid = (xcd < r ? xcd * (q + 1) : r * (q + 1) + (xcd - r) * q) + off; }
        const int nig = WGM * nN, gid = wgid / nig, fm = gid * WGM, gsz = (nM - fm) < WGM ? (nM - fm) : WGM;
        u.pm = fm + ((wgid % nig) % gsz); u.pn = (wgid % nig) / gsz; return true;
    }
    __device__ __forceinline__ void a_ready(const Unit&) const {}
    __device__ __forceinline__ void done(const Unit&) const {}
};


struct OneUnit {
    Unit u;
    __device__ __forceinline__ bool next(int i, Unit& o) const { if (i != 0) return false; o = u; return true; }
    __device__ __forceinline__ void a_ready(const Unit&) const {}
    __device__ __forceinline__ void done(const Unit&) const {}
};

typedef float f32x2 __attribute__((ext_vector_type(2)));
typedef __bf16 bf16x2_t __attribute__((ext_vector_type(2)));
typedef unsigned u32x2 __attribute__((ext_vector_type(2)));
__device__ __forceinline__ unsigned pkbf(float lo, float hi) { f32x2 v = {lo, hi}; bf16x2_t b = __builtin_convertvector(v, bf16x2_t); return __builtin_bit_cast(unsigned, b); }
__device__ __forceinline__ float bflo(unsigned w) { return __uint_as_float(w << 16); }
__device__ __forceinline__ float bfhi(unsigned w) { return __uint_as_float(w & 0xffff0000u); }
__device__ __forceinline__ u32x4 pack8(const f32x4 a, const f32x4 b) { u32x4 w; w.x = pkbf(a[0], a[1]); w.y = pkbf(a[2], a[3]); w.z = pkbf(b[0], b[1]); w.w = pkbf(b[2], b[3]); return w; }
constexpr float QSCALE = 0.125f * 1.4426950408889634f;
__device__ __forceinline__ float sigmoidf_(float v) { return __builtin_amdgcn_rcpf(1.0f + __builtin_amdgcn_exp2f(-1.4426950408889634f * v)); }

struct Epi1 {
    static constexpr bool PERM = true, AFTER_DRAIN = false, HAS_MID = false; static constexpr int MID_T = -1;
    const float* rinv; const float* bgate; const float* qg; const float* kg;
    bf16_t *QS, *KS, *VS, *QD, *KD, *VD, *GT;
    __device__ __forceinline__ void mid(f32x4 (&)[2][2][4][2], const Unit&, int, int, int, int) const {}
    __device__ __forceinline__ void operator()(const f32x4 (&acc)[2][2][4][2], const Unit& u, int wr, int wc, int fr, int fq) const {
        asm volatile("" : "+v"(fr), "+v"(fq));
        const int pn = u.pn; const int row0 = u.pm * BM + wr * 64 + fr;
        if (pn >= 6 && pn < 12) {
            const bool isK = pn >= 9; const int head = (isK ? pn - 9 : pn - 6) * 4 + wc;
            const float* g = (isK ? kg : qg) + head * 64 + 8 * fq;
            f32x4 gv[2][2]; const float qsc = isK ? 1.0f : QSCALE;
#pragma unroll
            for (int bj = 0; bj < 2; ++bj)
#pragma unroll
                for (int n = 0; n < 2; ++n) gv[bj][n] = *(const f32x4*)(g + 32 * bj + 4 * n) * qsc;
            bf16_t* base = (isK ? KD : QD) + head * 64 + 8 * fq;
#pragma unroll
            for (int ai = 0; ai < 2; ++ai)
#pragma unroll
                for (int m = 0; m < 4; ++m) { const int row = row0 + ai * HALF + m * 16; const float r = 1.0f;
                    f32x4 v[2][2]; float ss = 0.f;
#pragma unroll
                    for (int bj = 0; bj < 2; ++bj)
#pragma unroll
                        for (int n = 0; n < 2; ++n) { v[bj][n] = acc[ai][bj][m][n] * r; const f32x4 q = v[bj][n] * v[bj][n]; ss += (q[0] + q[1]) + (q[2] + q[3]); }
                    ss += __shfl_xor(ss, 16); ss += __shfl_xor(ss, 32);
                    const float sc = __builtin_amdgcn_rsqf(ss * (1.0f / 64.0f) + 1e-6f);
#pragma unroll
                    for (int bj = 0; bj < 2; ++bj) *(u32x4*)(base + (size_t)row * 768 + 32 * bj) = pack8(v[bj][0] * sc * gv[bj][0], v[bj][1] * sc * gv[bj][1]);
                }
        } else if (pn < 15) {
            bf16_t* base; int ld, colt;
            if (pn < 2) { base = QS; ld = 512; colt = pn * 256; } else if (pn < 4) { base = KS; ld = 512; colt = (pn - 2) * 256; } else if (pn < 6) { base = VS; ld = 512; colt = (pn - 4) * 256; } else { base = VD; ld = 768; colt = (pn - 12) * 256; }
            base += colt + wc * 32 + 8 * fq;
#pragma unroll
            for (int ai = 0; ai < 2; ++ai)
#pragma unroll
                for (int m = 0; m < 4; ++m) { const int row = row0 + ai * HALF + m * 16; const float r = (pn < 2 ? QSCALE : 1.0f);
#pragma unroll
                    for (int bj = 0; bj < 2; ++bj) *(u32x4*)(base + (size_t)row * ld + bj * HALF) = pack8(acc[ai][bj][m][0] * r, acc[ai][bj][m][1] * r);
                }
        } else {
            const int col0 = (pn - 15) * 256 + wc * 32 + 8 * fq;
            f32x4 bv[2][2];
#pragma unroll
            for (int bj = 0; bj < 2; ++bj)
#pragma unroll
                for (int n = 0; n < 2; ++n) bv[bj][n] = *(const f32x4*)(bgate + col0 + bj * HALF + 4 * n);
#pragma unroll
            for (int ai = 0; ai < 2; ++ai)
#pragma unroll
                for (int m = 0; m < 4; ++m) { const int row = row0 + ai * HALF + m * 16; const float r = 1.0f;
#pragma unroll
                    for (int bj = 0; bj < 2; ++bj) { f32x4 a = acc[ai][bj][m][0] * r + bv[bj][0], b = acc[ai][bj][m][1] * r + bv[bj][1];
#pragma unroll
                        for (int e = 0; e < 4; ++e) { a[e] = sigmoidf_(a[e]); b[e] = sigmoidf_(b[e]); }
                        *(u32x4*)(GT + (size_t)row * 2048 + col0 + bj * HALF) = pack8(a, b); }
                }
        }
    }
};

struct EpiG {
    static constexpr bool PERM = true, AFTER_DRAIN = false, HAS_MID = false; static constexpr int MID_T = -1;
    const float* bgate; const float* cs; bf16_t* GT;
    __device__ __forceinline__ void mid(f32x4 (&)[2][2][4][2], const Unit&, int, int, int, int) const {}
    __device__ __forceinline__ void operator()(const f32x4 (&acc)[2][2][4][2], const Unit& u, int wr, int wc, int fr, int fq) const {
        asm volatile("" : "+v"(fr), "+v"(fq));
        const int row0 = u.pm * BM + wr * 64 + fr, col0 = u.pn * BM + wc * 32 + 8 * fq;
        f32x4 bv[2][2], sv[2][2];
#pragma unroll
        for (int bj = 0; bj < 2; ++bj)
#pragma unroll
            for (int n = 0; n < 2; ++n) { bv[bj][n] = *(const f32x4*)(bgate + col0 + bj * HALF + 4 * n); sv[bj][n] = *(const f32x4*)(cs + col0 + bj * HALF + 4 * n); }
#pragma unroll
        for (int ai = 0; ai < 2; ++ai)
#pragma unroll
            for (int m = 0; m < 4; ++m) { const int row = row0 + ai * HALF + m * 16;
#pragma unroll
                for (int bj = 0; bj < 2; ++bj) { f32x4 a = acc[ai][bj][m][0] * sv[bj][0] + bv[bj][0], b = acc[ai][bj][m][1] * sv[bj][1] + bv[bj][1];
#pragma unroll
                    for (int e = 0; e < 4; ++e) { a[e] = sigmoidf_(a[e]); b[e] = sigmoidf_(b[e]); }
                    *(u32x4*)(GT + (size_t)row * 2048 + col0 + bj * HALF) = pack8(a, b); }
            }
    }
};

struct Epi2 {
    static constexpr bool PERM = true, AFTER_DRAIN = false, HAS_MID = true; static constexpr int MID_T = 8;
    const bf16_t* GT; bf16_t* MIX;
    __device__ __forceinline__ void mid(f32x4 (&acc)[2][2][4][2], const Unit& u, int wr, int wc, int fr, int fq) const {
        asm volatile("" : "+v"(fr), "+v"(fq));
        const int row0 = u.pm * BM + wr * 64 + fr, col0 = u.pn * BM + wc * 32 + 8 * fq;
#pragma unroll
        for (int ai = 0; ai < 2; ++ai) { u32x4 ga[4][2], gb[4][2];
#pragma unroll
            for (int m = 0; m < 4; ++m) { const bf16_t* gp = GT + (size_t)(row0 + ai * HALF + m * 16) * 2048 + col0;
#pragma unroll
                for (int bj = 0; bj < 2; ++bj) { ga[m][bj] = *(const u32x4*)(gp + bj * HALF); gb[m][bj] = *(const u32x4*)(gp + 1024 + bj * HALF); } }
#pragma unroll
            for (int m = 0; m < 4; ++m)
#pragma unroll
                for (int bj = 0; bj < 2; ++bj) { const u32x4 a = ga[m][bj], b = gb[m][bj];
                    f32x4 r0, r1;
                    r0[0] = bflo(a.x) * __builtin_amdgcn_rcpf(fmaxf(bflo(b.x), 1e-30f)); r0[1] = bfhi(a.x) * __builtin_amdgcn_rcpf(fmaxf(bfhi(b.x), 1e-30f));
                    r0[2] = bflo(a.y) * __builtin_amdgcn_rcpf(fmaxf(bflo(b.y), 1e-30f)); r0[3] = bfhi(a.y) * __builtin_amdgcn_rcpf(fmaxf(bfhi(b.y), 1e-30f));
                    r1[0] = bflo(a.z) * __builtin_amdgcn_rcpf(fmaxf(bflo(b.z), 1e-30f)); r1[1] = bfhi(a.z) * __builtin_amdgcn_rcpf(fmaxf(bfhi(b.z), 1e-30f));
                    r1[2] = bflo(a.w) * __builtin_amdgcn_rcpf(fmaxf(bflo(b.w), 1e-30f)); r1[3] = bfhi(a.w) * __builtin_amdgcn_rcpf(fmaxf(bfhi(b.w), 1e-30f));
                    acc[ai][bj][m][0] *= r0; acc[ai][bj][m][1] *= r1; }
            asm volatile("" ::: "memory");
        }
    }
    __device__ __forceinline__ void operator()(const f32x4 (&acc)[2][2][4][2], const Unit& u, int wr, int wc, int fr, int fq) const {
        asm volatile("" : "+v"(fr), "+v"(fq));
        const int row0 = u.pm * BM + wr * 64 + fr, col0 = u.pn * BM + wc * 32 + 8 * fq;
#pragma unroll
        for (int ai = 0; ai < 2; ++ai) { u32x4 gb[4][2];
#pragma unroll
            for (int m = 0; m < 4; ++m) { const bf16_t* gp = GT + (size_t)(row0 + ai * HALF + m * 16) * 2048 + 1024 + col0;
#pragma unroll
                for (int bj = 0; bj < 2; ++bj) gb[m][bj] = *(const u32x4*)(gp + bj * HALF); }
#pragma unroll
            for (int m = 0; m < 4; ++m) { const int row = row0 + ai * HALF + m * 16;
#pragma unroll
                for (int bj = 0; bj < 2; ++bj) { const u32x4 b = gb[m][bj];
                    f32x4 g0, g1;
                    g0[0] = fmaxf(bflo(b.x), 1e-30f); g0[1] = fmaxf(bfhi(b.x), 1e-30f); g0[2] = fmaxf(bflo(b.y), 1e-30f); g0[3] = fmaxf(bfhi(b.y), 1e-30f);
                    g1[0] = fmaxf(bflo(b.z), 1e-30f); g1[1] = fmaxf(bfhi(b.z), 1e-30f); g1[2] = fmaxf(bflo(b.w), 1e-30f); g1[3] = fmaxf(bfhi(b.w), 1e-30f);
                    *(u32x4*)(MIX + (size_t)row * 1024 + col0 + bj * HALF) = pack8(acc[ai][bj][m][0] * g0, acc[ai][bj][m][1] * g1); } }
            asm volatile("" ::: "memory");
        }
    }
};

struct Epi3 {
    static constexpr bool PERM = true, AFTER_DRAIN = false, HAS_MID = false; static constexpr int MID_T = -1;
    const float* x; bf16_t* x1b; float* ssq;
    __device__ __forceinline__ void mid(f32x4 (&)[2][2][4][2], const Unit&, int, int, int, int) const {}
    __device__ __forceinline__ void operator()(const f32x4 (&acc)[2][2][4][2], const Unit& u, int wr, int wc, int fr, int fq) const {
        asm volatile("" : "+v"(fr), "+v"(fq));
        const int row0 = u.pm * BM + wr * 64 + fr, col0 = u.pn * BM + wc * 32 + 8 * fq;
#pragma unroll
        for (int ai = 0; ai < 2; ++ai) { f32x4 xv[4][2][2];
#pragma unroll
            for (int m = 0; m < 4; ++m) { const size_t off = (size_t)(row0 + ai * HALF + m * 16) * 1024 + col0;
#pragma unroll
                for (int bj = 0; bj < 2; ++bj) { xv[m][bj][0] = *(const f32x4*)(x + off + bj * HALF); xv[m][bj][1] = *(const f32x4*)(x + off + bj * HALF + 4); } }
#pragma unroll
            for (int m = 0; m < 4; ++m) { const int row = row0 + ai * HALF + m * 16; const size_t off = (size_t)row * 1024 + col0; float ss = 0.f;
#pragma unroll
                for (int bj = 0; bj < 2; ++bj) { const f32x4 v0 = acc[ai][bj][m][0] + xv[m][bj][0], v1 = acc[ai][bj][m][1] + xv[m][bj][1];
                    *(u32x4*)(x1b + off + bj * HALF) = pack8(v0, v1);
                    const f32x4 q0 = v0 * v0, q1 = v1 * v1; ss += ((q0[0] + q0[1]) + (q0[2] + q0[3])) + ((q1[0] + q1[1]) + (q1[2] + q1[3])); }
                ss += __shfl_xor(ss, 16); ss += __shfl_xor(ss, 32);
                if (fq == 0) ssq[(size_t)row * 16 + u.pn * 4 + wc] = ss;
            }
            asm volatile("" ::: "memory");
        }
    }
};

__device__ __forceinline__ unsigned f2key(float v) { const unsigned u = __float_as_uint(v); return (u & 0x80000000u) ? ~u : (u | 0x80000000u); }
__device__ __forceinline__ float key2f(unsigned k) { return __uint_as_float((k & 0x80000000u) ? (k & 0x7fffffffu) : ~k); }
#define PG8_CE(a_, b_) do { const unsigned hi__ = (a_) > (b_) ? (a_) : (b_); const unsigned lo__ = (a_) > (b_) ? (b_) : (a_); (a_) = hi__; (b_) = lo__; } while (0)
__device__ __forceinline__ void bitonic_merge16(unsigned (&v)[16]) {
#pragma unroll
    for (int j = 8; j >= 1; j >>= 1)
#pragma unroll
        for (int i = 0; i < 16; ++i) { const int l = i ^ j; if (l > i) PG8_CE(v[i], v[l]); }
}
__device__ __forceinline__ void bitonic_sort16(unsigned (&v)[16]) {
#pragma unroll
    for (int k = 2; k <= 16; k <<= 1)
#pragma unroll
        for (int j = k >> 1; j >= 1; j >>= 1)
#pragma unroll
            for (int i = 0; i < 16; ++i) { const int l = i ^ j; if (l > i) { if ((i & k) == 0 || k == 16) PG8_CE(v[i], v[l]); else PG8_CE(v[l], v[i]); } }
}
__device__ __forceinline__ void merge_top16(unsigned (&t)[16], const unsigned (&o)[16]) {
#pragma unroll
    for (int i = 0; i < 16; ++i) t[i] = t[i] > o[15 - i] ? t[i] : o[15 - i];
    bitonic_merge16(t);
}
template <int XM> __device__ __forceinline__ void merge_top16_xor(unsigned (&t)[16]) {
    unsigned o[16];
#pragma unroll
    for (int i = 0; i < 16; ++i) o[i] = (unsigned)__shfl_xor((int)t[i], XM);
    merge_top16(t, o);
}

struct Epi4 {
    static constexpr bool PERM = false, AFTER_DRAIN = true, HAS_MID = false; static constexpr int MID_T = -1;
    const float* ssq; float* rinv2; unsigned short* ids; float* gw;
    __device__ __forceinline__ void mid(f32x4 (&)[2][2][4][2], const Unit&, int, int, int, int) const {}
    __device__ __forceinline__ void fused(f32x4 (&acc)[2][2][4][2], const Unit& u, int wr, int wc, int fr, int fq, PG8_LAS unsigned char* lds, int wid, int lane) const {
        asm volatile("" : "+v"(fr), "+v"(fq));
        const int tid = wid * 64 + lane;
        const int rl = tid >> 2, p = (tid >> 1) & 1, hf = tid & 1, q4 = tid & 3;
#pragma unroll
        for (int pass = 0; pass < 2; ++pass) {
#pragma unroll
            for (int m = 0; m < 4; ++m)
#pragma unroll
                for (int bj = 0; bj < 2; ++bj)
#pragma unroll
                    for (int n = 0; n < 2; ++n) *(PG8_LAS f32x4*)(lds + (size_t)(wr * 64 + m * 16 + fr) * 1056 + bj * 528 + (wc * 32 + n * 16 + fq * 4) * 4) = acc[pass][bj][m][n];
            asm volatile("s_waitcnt lgkmcnt(0)" ::: "memory"); __builtin_amdgcn_s_barrier(); asm volatile("" ::: "memory");
            const int row = u.pm * BM + pass * HALF + rl;
            unsigned tk[16];
#pragma unroll
            for (int i = 0; i < 16; ++i) tk[i] = 0u;
            const PG8_LAS unsigned char* sp = lds + (size_t)rl * 1056 + p * 528 + hf * 256;
#pragma nounroll
            for (int c = 0; c < 4; ++c) { unsigned ch[16];
#pragma unroll
                for (int e4 = 0; e4 < 4; ++e4) { const f32x4 v = *(const PG8_LAS f32x4*)(sp + c * 64 + e4 * 16);
#pragma unroll
                    for (int e = 0; e < 4; ++e) ch[4 * e4 + e] = (f2key(v[e]) & ~127u) | (unsigned)(127 - (64 * hf + 16 * c + 4 * e4 + e)); }
                bitonic_sort16(ch);
                merge_top16(tk, ch);
            }
            merge_top16_xor<1>(tk);
            asm volatile("s_waitcnt lgkmcnt(0)" ::: "memory");
            PG8_LAS unsigned* kl = (PG8_LAS unsigned*)(lds + (size_t)(rl & ~15) * 1056) + ((rl & 15) * 2) * 16;
            if (hf == 0) {
#pragma unroll
                for (int i = 0; i < 4; ++i) *(PG8_LAS u32x4*)(kl + p * 16 + 4 * i) = (u32x4){tk[4 * i], tk[4 * i + 1], tk[4 * i + 2], tk[4 * i + 3]}; }
            asm volatile("s_waitcnt lgkmcnt(0)" ::: "memory");
            unsigned ck[16];
#define CAND_SLOT(m_, ij__) do { const unsigned i__ = (ij__) >> 4, j__ = (ij__) & 15u; \
                const unsigned ka__ = kl[(ij__) == 0xFFFFu ? 0u : i__], kb__ = kl[16 + ((ij__) == 0xFFFFu ? 0u : j__)]; \
                const float s__ = key2f(ka__ & ~127u) + key2f(kb__ & ~127u); \
                ck[m_] = (ij__) == 0xFFFFu ? 0u : ((f2key(s__) & ~255u) | (255u - (ij__))); } while (0)
                { const unsigned ij_ = q4 == 0 ? 0u : q4 == 1 ? 1u : q4 == 2 ? 2u : 3u; CAND_SLOT(0, ij_); }
                { const unsigned ij_ = q4 == 0 ? 4u : q4 == 1 ? 5u : q4 == 2 ? 6u : 7u; CAND_SLOT(1, ij_); }
                { const unsigned ij_ = q4 == 0 ? 8u : q4 == 1 ? 9u : q4 == 2 ? 10u : 11u; CAND_SLOT(2, ij_); }
                { const unsigned ij_ = q4 == 0 ? 12u : q4 == 1 ? 13u : q4 == 2 ? 14u : 15u; CAND_SLOT(3, ij_); }
                { const unsigned ij_ = q4 == 0 ? 16u : q4 == 1 ? 17u : q4 == 2 ? 18u : 19u; CAND_SLOT(4, ij_); }
                { const unsigned ij_ = q4 == 0 ? 20u : q4 == 1 ? 21u : q4 == 2 ? 22u : 23u; CAND_SLOT(5, ij_); }
                { const unsigned ij_ = q4 == 0 ? 32u : q4 == 1 ? 33u : q4 == 2 ? 34u : 35u; CAND_SLOT(6, ij_); }
                { const unsigned ij_ = q4 == 0 ? 36u : q4 == 1 ? 48u : q4 == 2 ? 49u : 50u; CAND_SLOT(7, ij_); }
                { const unsigned ij_ = q4 == 0 ? 51u : q4 == 1 ? 64u : q4 == 2 ? 65u : 66u; CAND_SLOT(8, ij_); }
                { const unsigned ij_ = q4 == 0 ? 80u : q4 == 1 ? 81u : q4 == 2 ? 96u : 97u; CAND_SLOT(9, ij_); }
                { const unsigned ij_ = q4 == 0 ? 112u : q4 == 1 ? 113u : q4 == 2 ? 128u : 144u; CAND_SLOT(10, ij_); }
                { const unsigned ij_ = q4 == 0 ? 160u : q4 == 1 ? 176u : q4 == 2 ? 192u : 208u; CAND_SLOT(11, ij_); }
                { const unsigned ij_ = q4 == 0 ? 224u : q4 == 1 ? 240u : q4 == 2 ? 65535u : 65535u; CAND_SLOT(12, ij_); }
#undef CAND_SLOT
            ck[13] = 0u; ck[14] = 0u; ck[15] = 0u;
            bitonic_sort16(ck);
            merge_top16_xor<1>(ck); merge_top16_xor<2>(ck);
            float sq = 0.f;
#pragma unroll
            for (int i = 0; i < 4; ++i) { const f32x4 t = *(const f32x4*)(ssq + (size_t)row * 16 + 4 * i); sq += (t[0] + t[1]) + (t[2] + t[3]); }
            const float r2 = __builtin_amdgcn_rsqf(sq * (1.0f / 1024.0f) + 1e-6f);
            if (u.pn == 0 && q4 == 0) rinv2[row] = r2;
            const float b0 = key2f(ck[0] & ~255u); float wsum = 0.f; float wv[16];
#pragma unroll
            for (int q = 0; q < 16; ++q) { wv[q] = __builtin_amdgcn_exp2f((key2f(ck[q] & ~255u) - b0) * r2 * 1.4426950408889634f); wsum += wv[q]; }
            const float inv = 1.0f / wsum;
            unsigned short eo[4]; float go[4];
#pragma unroll
            for (int e = 0; e < 4; ++e) { unsigned c0 = ck[e], c1 = ck[4 + e], c2 = ck[8 + e], c3 = ck[12 + e]; float w0 = wv[e], w1 = wv[4 + e], w2 = wv[8 + e], w3 = wv[12 + e];
                asm volatile("" : "+v"(c0), "+v"(c1), "+v"(c2), "+v"(c3), "+v"(w0), "+v"(w1), "+v"(w2), "+v"(w3));
                const unsigned cc = q4 == 0 ? c0 : q4 == 1 ? c1 : q4 == 2 ? c2 : c3; const float ww = q4 == 0 ? w0 : q4 == 1 ? w1 : q4 == 2 ? w2 : w3;
                const unsigned code = 255u - (cc & 255u);
                const unsigned i1 = 127u - (kl[code >> 4] & 127u), i2 = 127u - (kl[16 + (code & 15u)] & 127u);
                eo[e] = (unsigned short)(i1 * 128u + i2); go[e] = ww * inv; }
            const size_t ob = ((size_t)row * 8 + u.pn) * 16 + q4 * 4;
            { u32x2 w; w.x = eo[0] | ((unsigned)eo[1] << 16); w.y = eo[2] | ((unsigned)eo[3] << 16); *(u32x2*)(ids + ob) = w; }
            *(f32x4*)(gw + ob) = (f32x4){go[0], go[1], go[2], go[3]};
            asm volatile("s_waitcnt lgkmcnt(0)" ::: "memory"); __builtin_amdgcn_s_barrier(); asm volatile("" ::: "memory");
        }
    }
};
template <class Epi, class Sched, bool ALIGN_EPI = false, bool SP2 = false, bool FP8 = false>
__device__ __forceinline__ void gemm_phase(PG8_LAS unsigned char* lds, const Gemm g, const Sched& S, const Epi& E) {
    const int tid = threadIdx.x, wid = __builtin_amdgcn_readfirstlane(tid >> 6), lane = tid & 63, wr = wid >> 2, wc = wid & 3, fr = lane & 15, fq = lane >> 4;
    const int K = g.K, nt = K / BK;
    unsigned voffA[2], voffB[2];
#pragma unroll
    for (int i = 0; i < 2; ++i) { int R, C; stage_rc(tid * 16 + i * 8192, R, C); const int Rb = Epi::PERM ? ((R & ~31) + perm32(R & 31)) : R;
        voffA[i] = (unsigned)(R * K + C) * 2u; voffB[i] = (unsigned)(Rb * K + C) * 2u; }
    const size_t kstep = (size_t)(BK * 2);
    const size_t hstep = (size_t)HALF * K * 2;
    const size_t tstep = 2 * hstep;
    const unsigned ldsw = (unsigned)wid * 1024u;
    const int aoff = lds_byte(wr * 64 + fr, fq * 8), boff = lds_byte(wc * 32 + fr, fq * 8);
#define PG8_SA(b, h) (((b) * 2 + (h)) * HTB)
#define PG8_SB(b, h) ((4 + (b) * 2 + (h)) * HTB)
#define PG8_STAGE(bufoff, gbase, voff) do { _Pragma("unroll") for (int _i = 0; _i < 2; ++_i) \
        __builtin_amdgcn_global_load_lds((const unsigned*)((const char*)(gbase) + (voff)[_i]), (PG8_LAS unsigned*)(lds + (bufoff) + ldsw + _i * 8192), 16, 0, 0); } while (0)
#define PG8_LD8(lo_, hi_) __builtin_bit_cast(i32x8, __builtin_shufflevector((lo_), (hi_), 0, 1, 2, 3, 4, 5, 6, 7))
#define PG8_LDA(dst, b, h) do { if constexpr (FP8) { _Pragma("unroll") for (int m = 0; m < 4; ++m) { const u32x4 l0_ = *(const PG8_LAS u32x4*)(lds + PG8_SA(b, h) + aoff + m * 2048), l1_ = *(const PG8_LAS u32x4*)(lds + PG8_SA(b, h) + aoff + m * 2048 + 1024); dst##8[m] = PG8_LD8(l0_, l1_); } } \
        else { _Pragma("unroll") for (int m = 0; m < 4; ++m) _Pragma("unroll") for (int k = 0; k < 2; ++k) dst[m][k] = *(const PG8_LAS bf16x8*)(lds + PG8_SA(b, h) + aoff + m * 2048 + k * 1024); } } while (0)
#define PG8_LDB(dst, b, h) do { if constexpr (FP8) { _Pragma("unroll") for (int n = 0; n < 2; ++n) { const u32x4 l0_ = *(const PG8_LAS u32x4*)(lds + PG8_SB(b, h) + boff + n * 2048), l1_ = *(const PG8_LAS u32x4*)(lds + PG8_SB(b, h) + boff + n * 2048 + 1024); dst##8[n] = PG8_LD8(l0_, l1_); } } \
        else { _Pragma("unroll") for (int n = 0; n < 2; ++n) _Pragma("unroll") for (int k = 0; k < 2; ++k) dst[n][k] = *(const PG8_LAS bf16x8*)(lds + PG8_SB(b, h) + boff + n * 2048 + k * 1024); } } while (0)
#define PG8_MMA(ai, bj, At, Bt) do { __builtin_amdgcn_s_setprio(1); \
        if constexpr (FP8) { _Pragma("unroll") for (int m = 0; m < 4; ++m) _Pragma("unroll") for (int n = 0; n < 2; ++n) \
            asm volatile("v_mfma_scale_f32_16x16x128_f8f6f4 %0, %1, %2, %0, %3, %3 op_sel_hi:[0,0,0]" : "+v"(acc[ai][bj][m][n]) : "v"(Bt##8[n]), "v"(At##8[m]), "v"(sc127));     \
            } \
        else { _Pragma("unroll") for (int m = 0; m < 4; ++m) _Pragma("unroll") for (int n = 0; n < 2; ++n) _Pragma("unroll") for (int k = 0; k < 2; ++k) \
            acc[ai][bj][m][n] = __builtin_amdgcn_mfma_f32_16x16x32_bf16(Bt[n][k], At[m][k], acc[ai][bj][m][n], 0, 0, 0); } \
        __builtin_amdgcn_s_setprio(0); } while (0)
#define PG8_WAIT_V(n) asm volatile("s_waitcnt vmcnt(" #n ")" ::: "memory")
#define PG8_WAIT_L(n) asm volatile("s_waitcnt lgkmcnt(" #n ")" ::: "memory")
#define PG8_BAR __builtin_amdgcn_s_barrier()
#define PG8_SCHED __builtin_amdgcn_sched_barrier(0)
    Unit cur, nxt; int ui = 0;
    if (!S.next(0, cur)) return;
    f32x4 acc[2][2][4][2];
#pragma unroll
    for (int a = 0; a < 2; ++a)
#pragma unroll
        for (int b = 0; b < 2; ++b)
#pragma unroll
            for (int m = 0; m < 4; ++m)
#pragma unroll
                for (int n = 0; n < 2; ++n) acc[a][b][m][n] = (f32x4){0.f, 0.f, 0.f, 0.f};
    bf16x8 At[4][2], B0[2][2], B1[2][2]; i32x8 At8[4], B08[2], B18[2];
    int sc127 = 127; asm volatile("" : "+v"(sc127));
    const char* cA = (const char*)g.A + (size_t)cur.pm * tstep; const char* cB = (const char*)g.Bt + (size_t)cur.pn * tstep;
    S.a_ready(cur);
    if constexpr (SP2) {
        PG8_STAGE(PG8_SB(0, 0), cB, voffB); PG8_STAGE(PG8_SB(0, 1), cB + hstep, voffB); PG8_STAGE(PG8_SA(0, 0), cA, voffA); PG8_STAGE(PG8_SA(0, 1), cA + hstep, voffA);
        if (wr == 1) PG8_BAR;
        PG8_WAIT_V(2); PG8_BAR;
        PG8_STAGE(PG8_SB(1, 0), cB + kstep, voffB); PG8_STAGE(PG8_SA(1, 0), cA + kstep, voffA); PG8_STAGE(PG8_SB(1, 1), cB + hstep + kstep, voffB);
        PG8_WAIT_V(6); PG8_BAR;
    } else {
        PG8_STAGE(PG8_SB(0, 0), cB, voffB); PG8_STAGE(PG8_SA(0, 0), cA, voffA); PG8_STAGE(PG8_SB(0, 1), cB + hstep, voffB); PG8_STAGE(PG8_SA(0, 1), cA + hstep, voffA);
        if (wr == 1) PG8_BAR;
        PG8_WAIT_V(4); PG8_BAR;
        PG8_STAGE(PG8_SB(1, 0), cB + kstep, voffB); PG8_STAGE(PG8_SA(1, 0), cA + kstep, voffA); PG8_STAGE(PG8_SB(1, 1), cB + hstep + kstep, voffB);
        PG8_WAIT_V(6); PG8_BAR;
    }
    for (;;) {
        const bool has_next = S.next(ui + 1, nxt);
        const char* nA = has_next ? (const char*)g.A + (size_t)nxt.pm * tstep : cA; const char* nB = has_next ? (const char*)g.Bt + (size_t)nxt.pn * tstep : cB;
        for (int t = 0; t < nt; t += 2) {
            if constexpr (Epi::HAS_MID) { if (t == Epi::MID_T) E.mid(acc, cur, wr, wc, fr, fq); }
            const bool last = (t == nt - 2);
            const char* a1 = cA + (size_t)(t + 1) * kstep;
            const char* a2 = last ? nA : cA + (size_t)(t + 2) * kstep; const char* b2 = last ? nB : cB + (size_t)(t + 2) * kstep;
            const char* a3 = a2 + kstep; const char* b3 = b2 + kstep;
            if (last && has_next) S.a_ready(nxt);
            if constexpr (SP2) {
            PG8_LDB(B0, 0, 0); PG8_LDB(B1, 0, 1); PG8_SCHED; PG8_LDA(At, 0, 0); PG8_STAGE(PG8_SA(1, 1), a1 + hstep, voffA);
            PG8_WAIT_V(8); PG8_WAIT_L(0); PG8_BAR; PG8_MMA(0, 0, At, B0); PG8_MMA(0, 1, At, B1); PG8_BAR; PG8_SCHED;
            PG8_LDA(At, 0, 1); PG8_STAGE(PG8_SB(0, 0), b2, voffB); PG8_STAGE(PG8_SB(0, 1), b2 + hstep, voffB); PG8_STAGE(PG8_SA(0, 0), a2, voffA);
            PG8_WAIT_V(8); PG8_WAIT_L(0); PG8_BAR; PG8_MMA(1, 0, At, B0); PG8_MMA(1, 1, At, B1); PG8_BAR; PG8_SCHED;
            PG8_LDB(B0, 1, 0); PG8_LDB(B1, 1, 1); PG8_SCHED; PG8_LDA(At, 1, 0); PG8_STAGE(PG8_SA(0, 1), a2 + hstep, voffA);
            PG8_WAIT_V(8); PG8_WAIT_L(0); PG8_BAR; PG8_MMA(0, 0, At, B0); PG8_MMA(0, 1, At, B1); PG8_BAR; PG8_SCHED;
            PG8_LDA(At, 1, 1); PG8_STAGE(PG8_SB(1, 0), b3, voffB); PG8_STAGE(PG8_SB(1, 1), b3 + hstep, voffB); PG8_STAGE(PG8_SA(1, 0), a3, voffA);
            PG8_WAIT_V(8); PG8_WAIT_L(0); PG8_BAR; PG8_MMA(1, 0, At, B0); PG8_MMA(1, 1, At, B1); PG8_BAR; PG8_SCHED;
            } else {
            PG8_LDB(B0, 0, 0); PG8_SCHED; PG8_LDA(At, 0, 0); PG8_STAGE(PG8_SA(1, 1), a1 + hstep, voffA);
            PG8_WAIT_L(8); PG8_BAR; PG8_WAIT_L(0); PG8_MMA(0, 0, At, B0); PG8_BAR; PG8_SCHED;
            PG8_LDB(B1, 0, 1); PG8_STAGE(PG8_SB(0, 0), b2, voffB);
            PG8_BAR; PG8_WAIT_L(0); PG8_MMA(0, 1, At, B1); PG8_BAR;
            PG8_LDA(At, 0, 1); PG8_STAGE(PG8_SA(0, 0), a2, voffA);
            PG8_BAR; PG8_WAIT_L(0); PG8_MMA(1, 0, At, B0); PG8_BAR; PG8_SCHED;
            PG8_STAGE(PG8_SB(0, 1), b2 + hstep, voffB);
            PG8_WAIT_V(6); PG8_BAR; PG8_MMA(1, 1, At, B1); PG8_BAR;
            PG8_LDB(B0, 1, 0); PG8_SCHED; PG8_LDA(At, 1, 0); PG8_STAGE(PG8_SA(0, 1), a2 + hstep, voffA);
            PG8_WAIT_L(8); PG8_BAR; PG8_WAIT_L(0); PG8_MMA(0, 0, At, B0); PG8_BAR; PG8_SCHED;
            PG8_LDB(B1, 1, 1); PG8_STAGE(PG8_SB(1, 0), b3, voffB);
            PG8_BAR; PG8_WAIT_L(0); PG8_MMA(0, 1, At, B1); PG8_BAR;
            PG8_LDA(At, 1, 1); PG8_STAGE(PG8_SA(1, 0), a3, voffA);
            PG8_BAR; PG8_WAIT_L(0); PG8_MMA(1, 0, At, B0); PG8_BAR; PG8_SCHED;
            PG8_STAGE(PG8_SB(1, 1), b3 + hstep, voffB);
            PG8_WAIT_V(6); PG8_BAR; PG8_MMA(1, 1, At, B1); PG8_BAR;
            }
        }
        if constexpr (FP8) asm volatile("s_nop 15\n\ts_nop 15" ::: "memory");
        if constexpr (ALIGN_EPI) { if (wr == 0) PG8_BAR; }
        if constexpr (!Epi::AFTER_DRAIN) { E(acc, cur, wr, wc, fr, fq); S.done(cur); }
        if (!has_next) break;
#pragma unroll
        for (int a = 0; a < 2; ++a)
#pragma unroll
            for (int b = 0; b < 2; ++b)
#pragma unroll
                for (int m = 0; m < 4; ++m)
#pragma unroll
                    for (int n = 0; n < 2; ++n) acc[a][b][m][n] = (f32x4){0.f, 0.f, 0.f, 0.f};
        cur = nxt; cA = nA; cB = nB; ++ui;
        if constexpr (ALIGN_EPI) { if (wr == 1) PG8_BAR; }
    }
    PG8_WAIT_V(0);
    if constexpr (!ALIGN_EPI) { if (wr == 0) PG8_BAR; }
    PG8_BAR;
    if constexpr (Epi::AFTER_DRAIN) { E.fused(acc, cur, wr, wc, fr, fq, lds, wid, lane); S.done(cur); }
#undef PG8_SA
#undef PG8_SB
#undef PG8_STAGE
#undef PG8_LDA
#undef PG8_LD8
#undef PG8_LDB
#undef PG8_MMA
#undef PG8_WAIT_V
#undef PG8_WAIT_L
#undef PG8_BAR
#undef PG8_SCHED
}
}


namespace att {
#define ALAS __attribute__((address_space(3)))
typedef unsigned short bf16;
typedef short bf16x8 __attribute__((ext_vector_type(8)));
typedef short s16x4 __attribute__((ext_vector_type(4)));
typedef float f32x16 __attribute__((ext_vector_type(16)));
typedef float f32x4 __attribute__((ext_vector_type(4)));
typedef float f32x2 __attribute__((ext_vector_type(2)));
typedef unsigned u32x4 __attribute__((ext_vector_type(4)));
typedef __bf16 bf16x2_t __attribute__((ext_vector_type(2)));
constexpr int SEQ = 4096;
constexpr int VPITCH = 144;
constexpr float LOG2E = 1.4426950408889634f, LN2 = 0.6931471805599453f;
__device__ __forceinline__ unsigned pkbf(float lo, float hi) { f32x2 v = {lo, hi}; bf16x2_t b = __builtin_convertvector(v, bf16x2_t); return __builtin_bit_cast(unsigned, b); }
__device__ __forceinline__ void wave_lds_sync() { asm volatile("s_waitcnt lgkmcnt(0)" ::: "memory"); }
__device__ __forceinline__ s16x4 vtr(const ALAS unsigned char* p) { return __builtin_bit_cast(s16x4, __builtin_amdgcn_ds_read_tr16_b64_v4i16((ALAS s16x4*)p)); }
__device__ __forceinline__ int crow(int r, int hi) { return (r & 3) + 8 * (r >> 2) + 4 * hi; }

__device__ __forceinline__ void pv_tile(f32x16& o0, f32x16& o1, const float (&a)[16], const ALAS unsigned char* vt, int lane) {
    const int g = lane >> 4, i = lane & 15, q_ = i >> 2, p_ = i & 3, h = lane >> 5;
    const ALAS unsigned char* vb = vt + (8 * h + q_) * VPITCH + (16 * (g & 1) + 4 * p_) * 2;
    u32x4 pw0, pw1;
    pw0.x = pkbf(a[0], a[1]); pw0.y = pkbf(a[2], a[3]); pw0.z = pkbf(a[4], a[5]); pw0.w = pkbf(a[6], a[7]);
    pw1.x = pkbf(a[8], a[9]); pw1.y = pkbf(a[10], a[11]); pw1.z = pkbf(a[12], a[13]); pw1.w = pkbf(a[14], a[15]);
    const bf16x8 pa0 = __builtin_bit_cast(bf16x8, pw0), pa1 = __builtin_bit_cast(bf16x8, pw1);
#pragma unroll
    for (int s = 0; s < 2; ++s) {
        const s16x4 l0 = vtr(vb + (16 * s) * VPITCH), h0 = vtr(vb + (16 * s + 4) * VPITCH);
        const s16x4 l1 = vtr(vb + (16 * s) * VPITCH + 64), h1 = vtr(vb + (16 * s + 4) * VPITCH + 64);
        const bf16x8 v0 = (bf16x8){l0[0], l0[1], l0[2], l0[3], h0[0], h0[1], h0[2], h0[3]};
        const bf16x8 v1 = (bf16x8){l1[0], l1[1], l1[2], l1[3], h1[0], h1[1], h1[2], h1[3]};
        o0 = __builtin_amdgcn_mfma_f32_32x32x16_bf16(s ? pa1 : pa0, v0, o0, 0, 0, 0);
        o1 = __builtin_amdgcn_mfma_f32_32x32x16_bf16(s ? pa1 : pa0, v1, o1, 0, 0, 0);
    }
}
__device__ __forceinline__ void bcast_rows(float v, ALAS float* sc, int r32, int hi, float (&out)[16]) {
    if (hi == 0) sc[r32] = v;
    wave_lds_sync();
#pragma unroll
    for (int g = 0; g < 4; ++g) { const f32x4 t = *(const ALAS f32x4*)(sc + 8 * g + 4 * hi); out[4 * g] = t[0]; out[4 * g + 1] = t[1]; out[4 * g + 2] = t[2]; out[4 * g + 3] = t[3]; }
    wave_lds_sync();
}
__device__ __forceinline__ void store_o(const f32x16& o0, const f32x16& o1, ALAS unsigned char* stg, bf16* dst  , size_t rstride_elems, int lane) {
    const int r32 = lane & 31, hi = lane >> 5;
    wave_lds_sync();
#pragma unroll
    for (int r = 0; r < 16; ++r) { const int q = crow(r, hi);
        *(ALAS unsigned short*)(stg + q * VPITCH + r32 * 2) = (unsigned short)(pkbf(o0[r], 0.f) & 0xffffu);
        *(ALAS unsigned short*)(stg + q * VPITCH + 64 + r32 * 2) = (unsigned short)(pkbf(o1[r], 0.f) & 0xffffu); }
    wave_lds_sync();
#pragma unroll
    for (int i = 0; i < 4; ++i) { const int row = 8 * i + (lane >> 3), ch = lane & 7; const u32x4 v = *(const ALAS u32x4*)(stg + row * VPITCH + ch * 16); *(u32x4*)(dst + (size_t)row * rstride_elems + ch * 8) = v; }
    wave_lds_sync();
}

__device__ __forceinline__ void sb_item(const bf16* QS, const bf16* KS, const bf16* VS, bf16* OC, int b, int h, int qt, ALAS unsigned char* wl, int lane) {
    const int r32 = lane & 31, hi = lane >> 5;
    const int t0 = qt * 32; const size_t rowb = (size_t)b * SEQ;
    const int kperm = (r32 & ~12) | ((r32 & 4) << 1) | ((r32 & 8) >> 1);
    bf16x8 qf[4];
    { const bf16* qp = QS + (rowb + t0 + r32) * 512 + h * 64 + hi * 8;
#pragma unroll
      for (int d0 = 0; d0 < 4; ++d0) qf[d0] = *(const bf16x8*)(qp + d0 * 16); }
    f32x16 o0 = {}, o1 = {}; float R = 0.f;
    for (int key0 = t0; key0 >= 0; key0 -= 32) {
        const bf16* kp = KS + (rowb + key0 + kperm) * 512 + h * 64 + hi * 8;
        bf16x8 kf[4];
#pragma unroll
        for (int d0 = 0; d0 < 4; ++d0) kf[d0] = *(const bf16x8*)(kp + d0 * 16);
        u32x4 vv[4];
#pragma unroll
        for (int i = 0; i < 4; ++i) vv[i] = *(const u32x4*)(VS + (rowb + key0 + 8 * i + (lane >> 3)) * 512 + h * 64 + (lane & 7) * 8);
        f32x16 p = {};
#pragma unroll
        for (int d0 = 0; d0 < 4; ++d0) p = __builtin_amdgcn_mfma_f32_32x32x16_bf16(kf[d0], qf[d0], p, 0, 0, 0);
#pragma unroll
        for (int i = 0; i < 4; ++i) *(ALAS u32x4*)(wl + (8 * i + (lane >> 3)) * VPITCH + (lane & 7) * 16) = vv[i];
        const bool diag = (key0 == t0);
        float z2[16], L2[16];
#pragma unroll
        for (int r = 0; r < 16; ++r) { const int kk = (r & 7) + 8 * hi + 16 * (r >> 3); const float zz = p[r];
            const float sp = fmaxf(zz, 0.f) + __builtin_amdgcn_logf(1.0f + __builtin_amdgcn_exp2f(-fabsf(zz)));
            const bool valid = !diag || (kk < r32); z2[r] = zz; L2[r] = valid ? sp : 0.f; }
        float c[16];
        c[15] = L2[15];
#pragma unroll
        for (int r = 14; r >= 8; --r) c[r] = c[r + 1] + L2[r];
        c[7] = L2[7];
#pragma unroll
        for (int r = 6; r >= 0; --r) c[r] = c[r + 1] + L2[r];
        const float TB = c[8], TA = c[0];
        const float TBo = __shfl_xor(TB, 32), TAo = __shfl_xor(TA, 32);
        const float offB = R + (hi ? 0.f : TBo);
        const float offA = R + TB + TBo + (hi ? 0.f : TAo);
        float a[16];
#pragma unroll
        for (int r = 0; r < 16; ++r) { const int kk = (r & 7) + 8 * hi + 16 * (r >> 3); const bool valid = !diag || (kk < r32);
            const float e = __builtin_amdgcn_exp2f(z2[r] - (c[r] + (r < 8 ? offA : offB))); a[r] = valid ? e : 0.f; }
        R += (TA + TB) + (TAo + TBo);
        wave_lds_sync();
        pv_tile(o0, o1, a, wl, lane);
        wave_lds_sync();
        if (__all(R > 40.0f * LOG2E)) break;
    }
    store_o(o0, o1, wl, OC + (rowb + t0) * 768 + h * 64, 768, lane);
}

constexpr int DLU_WAVE = 5120;
constexpr int DLU_O = 8 * DLU_WAVE, DLU_M = DLU_O + 512 * 128, DLU_L = DLU_M + 2048, DLU_BYTES = DLU_L + 2048;
__device__ __forceinline__ void dl_unit(const bf16* QD, const bf16* KD, const bf16* VD, bf16* OC, int b, int j, int blk, ALAS unsigned char* lds, int wave, int lane) {
    const int r32 = lane & 31, hi = lane >> 5;
    const size_t rowb = (size_t)b * SEQ;
    const int t0 = 512 * blk;
    const int kperm = (r32 & ~12) | ((r32 & 4) << 1) | ((r32 & 8) >> 1);
    ALAS unsigned char* wl = lds + wave * DLU_WAVE;
    ALAS float* sc = (ALAS float*)(wl + 4608);
    ALAS unsigned short* OL = (ALAS unsigned short*)(lds + DLU_O);
    ALAS float* ML = (ALAS float*)(lds + DLU_M); ALAS float* LL = (ALAS float*)(lds + DLU_L);
    for (int g = 2; g >= 0; --g) {
        const int hh = 4 * g + j, sh = 2 * g, r = 1 << sh;
        const float slope2 = __builtin_amdgcn_exp2f(-8.0f * (float)(hh + 1) / 12.0f) * LOG2E;
        const float sr = slope2 * (float)r;
        for (int it = wave; it < 16; it += 8) {
            const int q0 = g == 2 ? it : g == 1 ? (it & 3) + 128 * (it >> 2) : 32 * it;
            const int tq = t0 + q0 + r * r32, tmax = t0 + q0 + 31 * r;
            bf16x8 qf[4];
            { const bf16* qp = QD + (rowb + tq) * 768 + hh * 64 + hi * 8;
#pragma unroll
              for (int d0 = 0; d0 < 4; ++d0) qf[d0] = *(const bf16x8*)(qp + d0 * 16); }
            const int klo = 31 - r32; int khi = klo + 128; { const int kmaxtok = tmax >> sh; khi = khi < kmaxtok ? khi : kmaxtok; }
            const unsigned krange = (unsigned)(khi - klo);
            f32x16 o0 = {}, o1 = {}; float mrun = -3.0e38f, lrun = 0.f;
            if (g != 2) {
                mrun = ML[q0 + r * r32]; lrun = hi ? 0.f : LL[q0 + r * r32];
#pragma unroll
                for (int q = 0; q < 16; ++q) { const int tl = q0 + r * crow(q, hi);
                    o0[q] = __uint_as_float((unsigned)OL[tl * 64 + r32] << 16); o1[q] = __uint_as_float((unsigned)OL[tl * 64 + 32 + r32] << 16); }
            }
            for (int kt = 0; kt < 5; ++kt) {
                int sk = tmax - r * (32 * kt + kperm); sk = sk < 0 ? 0 : sk;
                const bf16* kp = KD + (rowb + sk) * 768 + hh * 64 + hi * 8;
                bf16x8 kf[4];
#pragma unroll
                for (int d0 = 0; d0 < 4; ++d0) kf[d0] = *(const bf16x8*)(kp + d0 * 16);
                u32x4 vv[4];
#pragma unroll
                for (int i = 0; i < 4; ++i) { int sv = tmax - r * (32 * kt + 8 * i + (lane >> 3)); sv = sv < 0 ? 0 : sv; vv[i] = *(const u32x4*)(VD + (rowb + sv) * 768 + hh * 64 + (lane & 7) * 8); }
                const int dk = 32 * kt + 8 * hi - klo;
                const float tb = -sr * (float)dk;
                f32x16 p;
#pragma unroll
                for (int q = 0; q < 16; ++q) p[q] = tb - sr * (float)((q & 7) + 16 * (q >> 3));
#pragma unroll
                for (int d0 = 0; d0 < 4; ++d0) p = __builtin_amdgcn_mfma_f32_32x32x16_bf16(kf[d0], qf[d0], p, 0, 0, 0);
#pragma unroll
                for (int i = 0; i < 4; ++i) *(ALAS u32x4*)(wl + (8 * i + (lane >> 3)) * VPITCH + (lane & 7) * 16) = vv[i];
                float z2[16]; float mt = -3.0e38f;
#pragma unroll
                for (int q = 0; q < 16; ++q) { const bool valid = (unsigned)(dk + ((q & 7) + 16 * (q >> 3))) <= krange; z2[q] = valid ? p[q] : -INFINITY; mt = fmaxf(mt, z2[q]); }
                mt = fmaxf(mt, __shfl_xor(mt, 32));
                if (__any(mt > mrun + 8.0f)) {
                    const float mnew = fmaxf(mrun, mt); const float alpha = __builtin_amdgcn_exp2f(mrun - mnew);
                    lrun *= alpha; float al[16]; bcast_rows(alpha, sc, r32, hi, al);
#pragma unroll
                    for (int q = 0; q < 16; ++q) { o0[q] *= al[q]; o1[q] *= al[q]; }
                    mrun = mnew;
                }
                float a[16]; float ls = 0.f;
#pragma unroll
                for (int q = 0; q < 16; ++q) { a[q] = __builtin_amdgcn_exp2f(z2[q] - mrun); ls += a[q]; }
                lrun += ls;
                wave_lds_sync();
                pv_tile(o0, o1, a, wl, lane);
                wave_lds_sync();
            }
            const float ltot = lrun + __shfl_xor(lrun, 32);
            if (g != 0) {
                if (hi == 0) { ML[q0 + r * r32] = mrun; LL[q0 + r * r32] = ltot; }
#pragma unroll
                for (int q = 0; q < 16; ++q) { const int tl = q0 + r * crow(q, hi);
                    OL[tl * 64 + r32] = (unsigned short)(pkbf(o0[q], 0.f) & 0xffffu); OL[tl * 64 + 32 + r32] = (unsigned short)(pkbf(o1[q], 0.f) & 0xffffu); }
            } else {
                float il[16]; bcast_rows(1.0f / ltot, sc, r32, hi, il);
#pragma unroll
                for (int q = 0; q < 16; ++q) { o0[q] *= il[q]; o1[q] *= il[q]; }
                store_o(o0, o1, wl, OC + (rowb + t0 + q0) * 768 + 512 + j * 64, 768, lane);
            }
        }
        asm volatile("s_waitcnt lgkmcnt(0)" ::: "memory"); __builtin_amdgcn_s_barrier(); asm volatile("" ::: "memory");
    }
}
#undef ALAS
}

constexpr int NWAVES = 8;
#ifndef MK_N_LAUNCHES
#define MK_N_LAUNCHES 1
#endif
#ifndef MK_LAST_PHASE
#define MK_LAST_PHASE 8
#endif
constexpr int N_LAUNCHES = MK_N_LAUNCHES;
constexpr int PER_PHASE = 8;

constexpr int BATCH = 16, SEQ = 4096, D = 1024, T = BATCH * SEQ;
constexpr int N1 = 5888;
constexpr int NEXP = 16384;
constexpr size_t MiB = 1u << 20;
constexpr size_t WS_CTL = 0, CTL_ZERO_BYTES = 1 * MiB;
constexpr size_t WS_WIN = 2 * MiB;
constexpr size_t WS_WCAT = 16 * MiB;
constexpr size_t WS_WOUT = 18 * MiB;
constexpr size_t WS_WC = 20 * MiB;
constexpr size_t WS_RINV1 = 24 * MiB;
constexpr size_t WS_RINV2 = 25 * MiB;
constexpr size_t WS_USC = 25 * MiB + 512 * 1024, WS_VSC = 25 * MiB + 768 * 1024;
constexpr size_t WS_SSQ = 26 * MiB;
constexpr size_t WS_U8 = 32 * MiB;
constexpr size_t WS_V8 = 64 * MiB;
constexpr size_t WS_IDS = 96 * MiB;
constexpr size_t WS_GW = 112 * MiB;
constexpr size_t WS_XB = 144 * MiB;
constexpr size_t WS_QS = 272 * MiB, WS_KS = 336 * MiB, WS_VS = 400 * MiB;
constexpr size_t WS_QD = 464 * MiB, WS_KD = 560 * MiB, WS_VD = 656 * MiB;
constexpr size_t WS_GT = 752 * MiB;
constexpr size_t WS_COEF = 272 * MiB;
constexpr size_t WS_MIX = 272 * MiB;
constexpr size_t WS_X1B = 400 * MiB;
constexpr size_t WS_HQ = 528 * MiB;
constexpr size_t WS_HS2 = 24 * MiB + 512 * 1024;
constexpr size_t WS_XB8 = 72 * MiB;
constexpr size_t WS_WG8 = 40 * MiB;
constexpr size_t WS_GCS = 43 * MiB;
constexpr size_t WS_END = 1008 * MiB;
constexpr int CW_BAR = 4096;
constexpr int CW_GMAX = 16384;
constexpr int CW_XRANK = 8192;

constexpr int RING_OFF = 0, RING_BYTES = 131072;
constexpr int LDSCTL_OFF = 143360, MISC_OFF = LDSCTL_OFF + 320;
constexpr int LDS_BYTES = 147456;
static_assert(MISC_OFF + 128 <= LDS_BYTES, "LDS map");
#define GAS __attribute__((address_space(1)))
#define LAS __attribute__((address_space(3)))
typedef unsigned short bf16;
typedef unsigned v4u __attribute__((ext_vector_type(4)));
typedef float f32x4 __attribute__((ext_vector_type(4)));
typedef short bf16x8 __attribute__((ext_vector_type(8)));
typedef GAS unsigned gu32;
typedef GAS unsigned long long gu64;
#define RLX_AGENT __ATOMIC_RELAXED, __HIP_MEMORY_SCOPE_AGENT
#define LDS_WAIT() asm volatile("s_waitcnt lgkmcnt(0)" ::: "memory")
#define VM_WAIT() asm volatile("s_waitcnt vmcnt(0)" ::: "memory")
__device__ __forceinline__ unsigned long long rt() { return __builtin_amdgcn_s_memrealtime(); }
__device__ __forceinline__ unsigned f2bf(float f) { unsigned u = __builtin_bit_cast(unsigned, f); return (u + 0x7fffu + ((u >> 16) & 1u)) >> 16; }
__device__ __forceinline__ unsigned pk2(float lo, float hi) { return f2bf(lo) | (f2bf(hi) << 16); }

#define XB_TMO      128
#define XB_XCNT(j)  (256  + 64 * (j))
#define XB_XSUB(j)  (1280 + 64 * (j))
#define XB_XGEN(j)  (2304 + 64 * (j))
#define XB_TOP      3328
#define XB_TOPGEN   3392
#define XCD_BAR_WORDS 3456
#define XB_SPIN_CAP (1u << 18)

__device__ __forceinline__ unsigned xb_ld(unsigned* p)              { return __hip_atomic_load(p, __ATOMIC_RELAXED, __HIP_MEMORY_SCOPE_AGENT); }
__device__ __forceinline__ unsigned xb_add(unsigned* p, unsigned v) { return __hip_atomic_fetch_add(p, v, __ATOMIC_RELAXED, __HIP_MEMORY_SCOPE_AGENT); }
__device__ __forceinline__ unsigned xb_xcc_id() { return (unsigned)__builtin_amdgcn_s_getreg((3 << 11) | 20) & 0xFu; }
#define XB_SPIN(cond, bar) do { unsigned _sp = 0; while (cond) { __builtin_amdgcn_s_sleep(1); \
    if ((++_sp & 255u) == 0u) { if (xb_ld(&(bar)[XB_TMO])) break; if (_sp > XB_SPIN_CAP) { atomicAdd(&(bar)[XB_TMO], 1u); break; } } } } while (0)

struct XcdBarrier {
    unsigned* bar; unsigned x;
    volatile LAS unsigned* st;
};

__device__ __forceinline__ XcdBarrier xcd_barrier_post(unsigned* bar, volatile LAS unsigned* st) {
    XcdBarrier b; b.bar = bar; b.x = xb_xcc_id(); b.st = st;
    if (threadIdx.x == 0) (void)xb_add(&bar[XB_XCNT(b.x)], 1u);
    return b;
}
__device__ __forceinline__ void xcd_barrier_complete(unsigned* bar, unsigned x, unsigned& nloc, unsigned& nx) {
    const unsigned G = gridDim.x * gridDim.y * gridDim.z;
    unsigned sum, cnt, mine, sp = 0u;
    for (;;) {
        sum = 0u; cnt = 0u; mine = 0u;
#pragma unroll
        for (unsigned j = 0; j < 16; ++j) { const unsigned c = xb_ld(&bar[XB_XCNT(j)]); sum += c; cnt += (c > 0u) ? 1u : 0u; mine = (j == x) ? c : mine; }
        if (sum == G) break;
        __builtin_amdgcn_s_sleep(1);
        if ((++sp & 255u) == 0u) { if (xb_ld(&bar[XB_TMO])) break; if (sp > XB_SPIN_CAP) { atomicAdd(&bar[XB_TMO], 1u); break; } }
    }
    nloc = mine > 0u ? mine : 1u; nx = cnt > 0u ? cnt : 1u;
}

__device__ __forceinline__ void xcd_barrier(const XcdBarrier& b) {
    asm volatile("s_waitcnt vmcnt(0)" ::: "memory");
    __syncthreads();
    if (threadIdx.x == 0) {
        unsigned* bar = b.bar;
        __builtin_amdgcn_s_waitcnt(0);
        unsigned nloc = b.st[0], nx = b.st[1];
        if (nloc == 0u) { xcd_barrier_complete(bar, b.x, nloc, nx); b.st[0] = nloc; b.st[1] = nx; }
        const unsigned old = xb_add(&bar[XB_XSUB(b.x)], 1u);
        const unsigned gen = old / nloc;
        if (old + 1u == (gen + 1u) * nloc) {
            __builtin_amdgcn_fence(__ATOMIC_RELEASE, "agent");
            asm volatile("s_waitcnt vmcnt(0)" ::: "memory");
            const unsigned og = xb_add(&bar[XB_TOP], 1u);
            const unsigned tg = og / nx;
            if (og + 1u == (tg + 1u) * nx) xb_add(&bar[XB_TOPGEN], 1u);
            else XB_SPIN(xb_ld(&bar[XB_TOPGEN]) == tg, bar);
            __builtin_amdgcn_fence(__ATOMIC_ACQUIRE, "agent");
            xb_add(&bar[XB_XGEN(b.x)], 1u);
            asm volatile("s_waitcnt vmcnt(0)" ::: "memory");
        } else {
            XB_SPIN(xb_ld(&bar[XB_XGEN(b.x)]) == gen, bar);
            __builtin_amdgcn_fence(__ATOMIC_ACQUIRE, "agent");
            asm volatile("s_waitcnt vmcnt(0)" ::: "memory");
        }
    }
    __syncthreads();
}

typedef float f32x2 __attribute__((ext_vector_type(2)));
typedef unsigned v2u __attribute__((ext_vector_type(2)));
typedef _Float16 h2_t __attribute__((ext_vector_type(2)));
struct Frame {
    LAS unsigned char* lds;
    volatile LAS unsigned* MISC;
    gu32* ctl;
    int tid, lane, wave;
    int vcu, G;
};
__device__ __forceinline__ float wave_sum(float v) {
#pragma unroll
    for (int o = 1; o < 64; o <<= 1) v += __shfl_xor(v, o);
    return v;
}
__device__ __forceinline__ float wave_max(float v) {
#pragma unroll
    for (int o = 1; o < 64; o <<= 1) v = fmaxf(v, __shfl_xor(v, o));
    return v;
}
__device__ __forceinline__ int win_row(int n) { if (n < 1536 || n >= 3072) return n; const int t = (n - 1536) >> 8, ln = (n - 1536) & 255, hl = ln >> 6, d = ln & 63; return 1536 + t * 256 + 32 * hl + (d & 31) + 128 * (d >> 5); }
__device__ __forceinline__ void p0_transpose_item(const float* W, int N, const float* gain, bf16* WT, int ldt, int koff, int mode, LAS float* scr, int item, int lane) {
    const int nblk = N / 32, kb = item / nblk, nb = item % nblk, k0 = 64 * kb, n0 = 32 * nb;
#pragma unroll 8
    for (int i = 0; i < 32; ++i) { const int kk = 2 * i + (lane >> 5); float v = W[(size_t)(k0 + kk) * N + n0 + (lane & 31)]; if (gain) v *= gain[k0 + kk]; scr[kk * 33 + (lane & 31)] = v; }
    LDS_WAIT(); asm volatile("" ::: "memory");
    const int c = lane & 7;
#pragma unroll
    for (int j = 0; j < 4; ++j) { const int n = (lane >> 3) + 8 * j; const LAS float* s = scr + (8 * c) * 33 + n;
        v4u o; o.x = pk2(s[0 * 33], s[1 * 33]); o.y = pk2(s[2 * 33], s[3 * 33]); o.z = pk2(s[4 * 33], s[5 * 33]); o.w = pk2(s[6 * 33], s[7 * 33]);
        const int rown = mode ? win_row(n0 + n) : (n0 + n);
        *(GAS v4u*)(WT + (size_t)rown * ldt + koff + k0 + 8 * c) = o; }
    LDS_WAIT(); asm volatile("" ::: "memory");
}
__device__ __forceinline__ void p0_gate_max_item(const float* W, int N, const float* gain, unsigned* gmax, int kb, int n0, int lane) {
    const int k0 = 64 * kb; float am = 0.f;
#pragma unroll 8
    for (int i = 0; i < 32; ++i) { const int kk = 2 * i + (lane >> 5); am = fmaxf(am, fabsf(W[(size_t)(k0 + kk) * N + n0 + (lane & 31)] * gain[k0 + kk])); }
    am = fmaxf(am, __shfl_xor(am, 32));
    if (lane < 32) atomicMax(gmax + (n0 - 3840) + lane, __float_as_uint(am));
}
__device__ __forceinline__ void p0_gate_fp8_item(const float* W, int N, const float* gain, const unsigned* gmax, unsigned char* WG, float* cs, LAS float* scr, int item, int lane) {
    const int kb = item >> 6, nb = item & 63, k0 = 64 * kb, n0 = 32 * nb;
#pragma unroll 8
    for (int i = 0; i < 32; ++i) { const int kk = 2 * i + (lane >> 5); scr[kk * 33 + (lane & 31)] = W[(size_t)(k0 + kk) * N + 3840 + n0 + (lane & 31)] * gain[k0 + kk]; }
    LDS_WAIT(); asm volatile("" ::: "memory");
    const int c = lane & 7;
#pragma unroll
    for (int j = 0; j < 4; ++j) { const int n = (lane >> 3) + 8 * j; const LAS float* sp = scr + (8 * c) * 33 + n;
        const unsigned mb = xb_ld((unsigned*)gmax + n0 + n); const int ex = (int)((mb >> 23) & 0xffu);
        const float sc = (ex == 0) ? 1.0f : __uint_as_float((unsigned)(127 + 7 - (ex - 127)) << 23);
        int p0 = __builtin_amdgcn_cvt_pk_fp8_f32(sp[0 * 33] * sc, sp[1 * 33] * sc, 0, false); p0 = __builtin_amdgcn_cvt_pk_fp8_f32(sp[2 * 33] * sc, sp[3 * 33] * sc, p0, true);
        int p1 = __builtin_amdgcn_cvt_pk_fp8_f32(sp[4 * 33] * sc, sp[5 * 33] * sc, 0, false); p1 = __builtin_amdgcn_cvt_pk_fp8_f32(sp[6 * 33] * sc, sp[7 * 33] * sc, p1, true);
        *(GAS v2u*)(WG + (size_t)(n0 + n) * 1024 + k0 + 8 * c) = (v2u){(unsigned)p0, (unsigned)p1};
        if (kb == 0 && c == 0) cs[n0 + n] = (ex == 0) ? 1.0f : __uint_as_float((unsigned)(127 - 7 + (ex - 127)) << 23); }
    LDS_WAIT(); asm volatile("" ::: "memory");
}
__device__ __forceinline__ void quant_row_fp8(const float* src, const float* gain, unsigned char* dst, size_t slice_stride, float* scale_out, int lane) {
    f32x4 v[4]; float am = 0.f;
#pragma unroll
    for (int j = 0; j < 4; ++j) { v[j] = *(const GAS f32x4*)(src + 256 * j + 4 * lane); if (gain) v[j] = v[j] * *(const GAS f32x4*)(gain + 256 * j + 4 * lane);
        am = fmaxf(am, fmaxf(fmaxf(fabsf(v[j][0]), fabsf(v[j][1])), fmaxf(fabsf(v[j][2]), fabsf(v[j][3])))); }
    am = wave_max(am);
    const int ex = (int)((__float_as_uint(am) >> 23) & 0xffu);
    const float s = (ex == 0) ? 1.0f : __uint_as_float((unsigned)(127 + 7 - (ex - 127)) << 23);
    const float is = (ex == 0) ? 1.0f : __uint_as_float((unsigned)(127 - 7 + (ex - 127)) << 23);
    if (lane == 0) *scale_out = is;
#pragma unroll
    for (int j = 0; j < 4; ++j) { int pk = __builtin_amdgcn_cvt_pk_fp8_f32(v[j][0] * s, v[j][1] * s, 0, false); pk = __builtin_amdgcn_cvt_pk_fp8_f32(v[j][2] * s, v[j][3] * s, pk, true);
        const int col = 256 * j + 4 * lane; *(GAS int*)(dst + (size_t)(col >> 7) * slice_stride + (col & 127)) = pk; }
}
__device__ __forceinline__ void quant_row_fp4(const float* src, unsigned char* dst, size_t slice_stride, float* scale_out, int lane) {
    f32x4 v[4]; float am = 0.f;
#pragma unroll
    for (int j = 0; j < 4; ++j) { v[j] = *(const GAS f32x4*)(src + 256 * j + 4 * lane); am = fmaxf(am, fmaxf(fmaxf(fabsf(v[j][0]), fabsf(v[j][1])), fmaxf(fabsf(v[j][2]), fabsf(v[j][3])))); }
    am = wave_max(am);
    const float s = am > 0.f ? 6.0f / am : 0.f;
    if (lane == 0) *scale_out = am * (1.0f / 6.0f);
#pragma unroll
    for (int j = 0; j < 4; ++j) { unsigned pk = __builtin_amdgcn_cvt_scalef32_pk_fp4_f32(0u, v[j][0] * s, v[j][1] * s, 1.0f, 0); pk = __builtin_amdgcn_cvt_scalef32_pk_fp4_f32(pk, v[j][2] * s, v[j][3] * s, 1.0f, 1);
        *(GAS unsigned short*)(dst + (size_t)j * slice_stride + 2 * lane) = (unsigned short)(pk & 0xffffu); }
}
__device__ __forceinline__ void quant_row_i4(const float* src, const float* gain, unsigned char* dst, float* scale_out, int lane) {
    f32x4 v[4]; float am = 0.f, ss = 0.f;
    const int p16 = (lane >> 2) & 15, wl = lane & 3;
#pragma unroll
    for (int ld = 0; ld < 2; ++ld)
#pragma unroll
        for (int sn = 0; sn < 2; ++sn) { const int hd = 2 * (4 * ld + wl) + sn; const int idx = 256 * (hd >> 2) + 16 * p16 + 4 * (hd & 3);
            f32x4 t = *(const GAS f32x4*)(src + idx); if (gain) t = t * *(const GAS f32x4*)(gain + idx); v[2 * ld + sn] = t;
            am = fmaxf(am, fmaxf(fmaxf(fabsf(t[0]), fabsf(t[1])), fmaxf(fabsf(t[2]), fabsf(t[3])))); ss += (t[0] * t[0] + t[1] * t[1]) + (t[2] * t[2] + t[3] * t[3]); }
    am = wave_max(am); ss = wave_sum(ss);
    const float clipv = fminf(am, 2.5f * sqrtf(ss * (1.0f / 1024.0f)));
    const float s = clipv > 0.f ? 7.0f / clipv : 0.f;
    if (lane == 0) *scale_out = clipv * (1.0f / (7.0f * 16.0f));
#pragma unroll
    for (int ld = 0; ld < 2; ++ld) { unsigned pk = 0u;
#pragma unroll
        for (int b4 = 0; b4 < 4; ++b4) { int q0 = (int)__builtin_rintf(v[2 * ld][b4] * s), q1 = (int)__builtin_rintf(v[2 * ld + 1][b4] * s);
            q0 = q0 < -7 ? -7 : (q0 > 7 ? 7 : q0); q1 = q1 < -7 ? -7 : (q1 > 7 ? 7 : q1);
            pk |= ((unsigned)(q0 & 15) | ((unsigned)(q1 & 15) << 4)) << (8 * b4); }
        *(GAS unsigned*)(dst + ld * 256 + 16 * p16 + 4 * wl) = pk; }
}
__device__ __forceinline__ float gelu_f(float v) {
    const float av = fabsf(v), t = __builtin_amdgcn_rcpf(av * 0.2316418882f + 1.0f);
    float q = t * 0.5307027145f + (-0.7265760135f); q = q * t + 0.7107068705f; q = q * t + (-0.142248368f); q = q * t + 0.127414796f; q = q * t;
    const float e = __builtin_amdgcn_exp2f((v * v) * (-0.72134752044f));
    const float m = v * (q * e);
    return v < 0.f ? m : v - m;
}

struct Args { const float* in[14]; float* out; unsigned char* ws; int ph_lo, ph_hi, li, pad; };
__global__ void __launch_bounds__(NWAVES * 64, 2) fwd_kernel(Args args) {
    extern __shared__ __attribute__((aligned(16))) unsigned char lds[];
    Frame F;
    F.lds = (LAS unsigned char*)lds;
    F.MISC = (volatile LAS unsigned*)(F.lds + MISC_OFF);
    F.tid = threadIdx.x; F.lane = F.tid & 63; F.wave = __builtin_amdgcn_readfirstlane(F.tid >> 6);
    F.G = gridDim.x; { const int bx = blockIdx.x; F.vcu = (F.G % 8 == 0) ? (bx % 8) * (F.G / 8) + bx / 8 : bx; }
    unsigned char* ws = args.ws;
    F.ctl = (gu32*)(ws + WS_CTL);
    const float* x = args.in[0]; const float* norm1_gain = args.in[1]; const float* w_in = args.in[2]; const float* b_gate = args.in[3];
    const float* q_gain = args.in[4]; const float* k_gain = args.in[5]; const float* w_sb_out = args.in[6]; const float* w_dil_out = args.in[7];
    const float* w_out = args.in[8]; const float* norm2_gain = args.in[9]; const float* w_peer_q = args.in[10]; const float* sub_keys = args.in[11];
    const float* peer_u = args.in[12]; const float* peer_v = args.in[13];
    float* out = args.out;
    bf16* WIN = (bf16*)(ws + WS_WIN); bf16* WCAT = (bf16*)(ws + WS_WCAT); bf16* WOUT = (bf16*)(ws + WS_WOUT); bf16* WC = (bf16*)(ws + WS_WC);
    float* RINV1 = (float*)(ws + WS_RINV1); float* RINV2 = (float*)(ws + WS_RINV2); float* USC = (float*)(ws + WS_USC); float* VSC = (float*)(ws + WS_VSC); float* SSQ = (float*)(ws + WS_SSQ);
    unsigned char* U8 = ws + WS_U8; unsigned char* V8 = ws + WS_V8;
    unsigned short* IDS = (unsigned short*)(ws + WS_IDS); float* GW = (float*)(ws + WS_GW); float* COEF = (float*)(ws + WS_COEF); unsigned char* HQ = ws + WS_HQ; float* HS2 = (float*)(ws + WS_HS2);
    bf16* XB = (bf16*)(ws + WS_XB); bf16* OC = (bf16*)(ws + WS_XB); unsigned char* XB8 = ws + WS_XB8; unsigned char* WG8 = ws + WS_WG8; float* GCS = (float*)(ws + WS_GCS);
    bf16* QS = (bf16*)(ws + WS_QS); bf16* KS = (bf16*)(ws + WS_KS); bf16* VS = (bf16*)(ws + WS_VS);
    bf16* QD = (bf16*)(ws + WS_QD); bf16* KD = (bf16*)(ws + WS_KD); bf16* VD = (bf16*)(ws + WS_VD);
    bf16* GT = (bf16*)(ws + WS_GT); bf16* MIX = (bf16*)(ws + WS_MIX); bf16* X1B = (bf16*)(ws + WS_X1B);

    for (int u = F.tid; u < (LDS_BYTES - LDSCTL_OFF) / 4; u += NWAVES * 64) ((LAS unsigned*)(F.lds + LDSCTL_OFF))[u] = 0u;
    __syncthreads();
    const int my_xcc = (int)xb_xcc_id();
    if (F.tid == 0) F.MISC[12] = xb_add((unsigned*)(F.ctl + CW_XRANK) + 64 * my_xcc, 1u);
    __syncthreads();
    const int my_xrank = (int)F.MISC[12];
    const int bli = (N_LAUNCHES == PER_PHASE) ? 0 : args.li;
    XcdBarrier bar; bar.bar = (unsigned*)(F.ctl + CW_BAR) + bli * XCD_BAR_WORDS; bar.x = 0; bar.st = nullptr;
    if (N_LAUNCHES != PER_PHASE) bar = xcd_barrier_post((unsigned*)(F.ctl + CW_BAR) + bli * XCD_BAR_WORDS, F.MISC + 8);
    const int lo = args.ph_lo, hi = args.ph_hi;
#ifndef PHASE_MASK
#define PHASE_MASK 0xff
#endif
#define IN(k) (((PHASE_MASK >> (k)) & 1) && lo <= (k) && (k) < hi)
#define BOTH(k) (IN(k) && IN((k) + 1))
#define GRID_BAR() do { if (N_LAUNCHES != PER_PHASE) xcd_barrier(bar); } while (0)
#ifndef PROBE_REPEAT
#define PROBE_REPEAT 0x00
#endif
#ifndef PROBE_L1
#define PROBE_L1 0x0
#endif
#define REP(k) _Pragma("unroll") for (int rep_ = 0; rep_ < (((PROBE_REPEAT >> (k)) & 1) ? 2 : 1); ++rep_)
    const int gw = F.vcu * NWAVES + F.wave, NGW = F.G * NWAVES;
#define P67_MAP() int vx = (int)(blockIdx.x & 7), rk = (int)(blockIdx.x >> 3), nrk = (F.G + 7 - vx) / 8; bool p67_uni = false; \
        { bool uni_ = (F.G % 8 == 0); for (int j_ = 0; j_ < 16; ++j_) { const unsigned c_ = xb_ld((unsigned*)(F.ctl + CW_XRANK) + 64 * j_); uni_ = uni_ && (c_ == (j_ < 8 ? (unsigned)(F.G / 8) : 0u)); } \
          if (uni_) { vx = my_xcc; rk = my_xrank; nrk = F.G / 8; p67_uni = true; } }

    if (IN(0)) REP(0) {
        for (int it = F.vcu; it < 256; it += F.G) {
            const int hp = it >> 4, d0 = (it & 15) * 64;
            LAS float* As = (LAS float*)(F.lds);
            LAS float* Bs = (LAS float*)(F.lds + 64 * 132 * 4);
            for (int e = F.tid; e < 64 * 32; e += 512) { const int r = e >> 5, c4 = (e & 31) * 4; *(LAS f32x4*)(As + r * 132 + c4) = *(const GAS f32x4*)(w_peer_q + (size_t)(d0 + r) * 2048 + hp * 128 + c4); }
            for (int e = F.tid; e < 128 * 32; e += 512) { const int r = e >> 5, c4 = (e & 31) * 4; *(LAS f32x4*)(Bs + r * 132 + c4) = *(const GAS f32x4*)(sub_keys + ((size_t)hp * 128 + r) * 128 + c4); }
            __syncthreads();
            const int ddg = F.tid & 15, ng = F.tid >> 4;
            f32x4 acc[4];
#pragma unroll
            for (int j = 0; j < 4; ++j) acc[j] = (f32x4){0.f, 0.f, 0.f, 0.f};
            for (int c4 = 0; c4 < 128; c4 += 4) {
                f32x4 a[4], b[4];
#pragma unroll
                for (int i = 0; i < 4; ++i) { a[i] = *(const LAS f32x4*)(As + (4 * ddg + i) * 132 + c4); b[i] = *(const LAS f32x4*)(Bs + (4 * ng + i) * 132 + c4); }
#pragma unroll
                for (int j = 0; j < 4; ++j)
#pragma unroll
                    for (int i = 0; i < 4; ++i) acc[j][i] += (a[i][0] * b[j][0] + a[i][1] * b[j][1]) + (a[i][2] * b[j][2] + a[i][3] * b[j][3]);
            }
            const f32x4 g2 = *(const GAS f32x4*)(norm2_gain + d0 + 4 * ddg);
#pragma unroll
            for (int j = 0; j < 4; ++j) { v2u o; o.x = pk2(acc[j][0] * g2[0], acc[j][1] * g2[1]); o.y = pk2(acc[j][2] * g2[2], acc[j][3] * g2[3]);
                *(GAS v2u*)(WC + (size_t)(hp * 128 + 4 * ng + j) * 1024 + d0 + 4 * ddg) = o; }
            __syncthreads();
        }
        {
            LAS float* scr = (LAS float*)(F.lds + RING_OFF + F.wave * 16384);
            constexpr int I_IN = (D / 64) * (N1 / 32), I_SB = (512 / 64) * (D / 32), I_DL = (256 / 64) * (D / 32), I_OUT = (D / 64) * (D / 32);
            constexpr int NITEMS = I_IN + I_SB + I_DL + I_OUT;
            for (int it = gw; it < NITEMS; it += NGW) {
                int r = it;
                if (r < I_IN) { const int nb_ = r % (N1 / 32); if (nb_ >= 3840 / 32) p0_gate_max_item(w_in, N1, norm1_gain, (unsigned*)(F.ctl + CW_GMAX), r / (N1 / 32), 32 * nb_, F.lane); else p0_transpose_item(w_in, N1, norm1_gain, WIN, 1024, 0, 1, scr, r, F.lane); continue; } r -= I_IN;
                if (r < I_SB) { p0_transpose_item(w_sb_out, D, nullptr, WCAT, 768, 0, 0, scr, r, F.lane); continue; } r -= I_SB;
                if (r < I_DL) { p0_transpose_item(w_dil_out, D, nullptr, WCAT, 768, 512, 0, scr, r, F.lane); continue; } r -= I_DL;
                p0_transpose_item(w_out, D, nullptr, WOUT, 1024, 0, 0, scr, r, F.lane);
            }
        }
        for (int e = gw; e < 2 * NEXP; e += NGW) {
            if (e < NEXP) quant_row_i4(peer_u + (size_t)e * D, norm2_gain, U8 + (size_t)e * 512, USC + e, F.lane);
            else { const int ev = e - NEXP; quant_row_fp4(peer_v + (size_t)ev * D, V8 + (size_t)ev * 128, (size_t)NEXP * 128, VSC + ev, F.lane); }
        }
        for (int m = gw; m < T; m += NGW) {
            const GAS f32x4* xr = (const GAS f32x4*)(x + (size_t)m * D) + F.lane;
            f32x4 v[4]; float s = 0.f;
#pragma unroll
            for (int j = 0; j < 4; ++j) { v[j] = xr[64 * j]; s += (v[j][0] * v[j][0] + v[j][1] * v[j][1]) + (v[j][2] * v[j][2] + v[j][3] * v[j][3]); }
            s = wave_sum(s);
            const float rn = __builtin_amdgcn_rsqf(s * (1.0f / D) + 1e-6f);
            GAS unsigned long long* o8 = (GAS unsigned long long*)(XB + (size_t)m * D) + F.lane;
#pragma unroll
            for (int j = 0; j < 4; ++j) o8[64 * j] = (unsigned long long)pk2(v[j][0] * rn, v[j][1] * rn) | ((unsigned long long)pk2(v[j][2] * rn, v[j][3] * rn) << 32);
#pragma unroll
            for (int j = 0; j < 4; ++j) { int pk = __builtin_amdgcn_cvt_pk_fp8_f32(v[j][0] * rn, v[j][1] * rn, 0, false); pk = __builtin_amdgcn_cvt_pk_fp8_f32(v[j][2] * rn, v[j][3] * rn, pk, true);
                *(GAS int*)(XB8 + (size_t)m * D + 256 * j + 4 * F.lane) = pk; }
        }
        if (BOTH(0)) GRID_BAR();
    }

    if (IN(1)) REP(1) {
        { LAS float* scr = (LAS float*)(F.lds + RING_OFF + F.wave * 16384);
          for (int it = gw; it < 1024; it += NGW) p0_gate_fp8_item(w_in, N1, norm1_gain, (const unsigned*)(F.ctl + CW_GMAX), WG8, GCS, scr, it, F.lane);
          __syncthreads(); }
        { pg8::Gemm g{XB, WIN, T, 3840, D}; pg8::StaticOrder S; S.init(T, 3840, F.G, (int)blockIdx.x);
          pg8::Epi1 E{RINV1, b_gate, q_gain, k_gain, QS, KS, VS, QD, KD, VD, GT};
          pg8::gemm_phase<pg8::Epi1, pg8::StaticOrder, true, true>(F.lds + RING_OFF, g, S, E); }
        GRID_BAR();
        { pg8::Gemm g{(const bf16*)XB8, (const bf16*)WG8, T, 2048, D / 2}; pg8::StaticOrder S; S.init(T, 2048, F.G, (int)blockIdx.x);
          pg8::EpiG E{b_gate, GCS, GT};
          pg8::gemm_phase<pg8::EpiG, pg8::StaticOrder, true, true, true>(F.lds + RING_OFF, g, S, E); }
        if (BOTH(1)) GRID_BAR();
    }

    if (IN(2)) REP(2) {
        LAS unsigned char* wl = F.lds + RING_OFF + F.wave * 16384;
        static_assert(att::DLU_BYTES <= RING_BYTES, "dilated-attention LDS state");
        for (int un = F.vcu; un < 512; un += F.G) { const int blk = un & 7, j = (un >> 3) & 3, b = un >> 5; att::dl_unit(QD, KD, VD, OC, b, j, blk, F.lds + RING_OFF, F.wave, F.lane); }
        for (int it = gw; it < 16384; it += NGW) { const int qt = 127 - (it & 127), h = (it >> 7) & 7, b = it >> 10; att::sb_item(QS, KS, VS, OC, b, h, qt, wl, F.lane); }
        if (BOTH(2)) GRID_BAR();
    }

    if (IN(3)) REP(3) {
        pg8::Gemm g{OC, WCAT, T, D, 768}; pg8::StaticOrder S; S.init(T, D, F.G, (int)blockIdx.x);
        pg8::Epi2 E{GT, MIX};
        pg8::gemm_phase<pg8::Epi2, pg8::StaticOrder, true, true>(F.lds + RING_OFF, g, S, E);
        if (BOTH(3)) GRID_BAR();
    }

    if (IN(4)) REP(4) {
        pg8::Gemm g{MIX, WOUT, T, D, D}; pg8::StaticOrder S; S.init(T, D, F.G, (int)blockIdx.x);
        pg8::Epi3 E{x, X1B, SSQ};
        pg8::gemm_phase<pg8::Epi3, pg8::StaticOrder, true, true>(F.lds + RING_OFF, g, S, E);
        if (BOTH(4)) GRID_BAR();
    }

    if (IN(5)) REP(5) {
        for (int m = gw; m < T; m += NGW) {
            const v4u a = *(const GAS v4u*)(X1B + (size_t)m * D + 8 * F.lane), b = *(const GAS v4u*)(X1B + (size_t)m * D + 512 + 8 * F.lane);
            float v[16] = {pg8::bflo(a.x), pg8::bfhi(a.x), pg8::bflo(a.y), pg8::bfhi(a.y), pg8::bflo(a.z), pg8::bfhi(a.z), pg8::bflo(a.w), pg8::bfhi(a.w),
                           pg8::bflo(b.x), pg8::bfhi(b.x), pg8::bflo(b.y), pg8::bfhi(b.y), pg8::bflo(b.z), pg8::bfhi(b.z), pg8::bflo(b.w), pg8::bfhi(b.w)};
            float am = 0.f;
#pragma unroll
            for (int i = 0; i < 16; ++i) am = fmaxf(am, fabsf(v[i]));
            am = wave_max(am);
            float sq = (F.lane < 16) ? SSQ[(size_t)m * 16 + F.lane] : 0.f; sq = wave_sum(sq);
            const float s = am > 0.f ? 127.0f / am : 0.f;
            if (F.lane == 0) HS2[m] = am * (1.0f / 127.0f) * __builtin_amdgcn_rsqf(sq * (1.0f / 1024.0f) + 1e-6f);
            int q[16];
#pragma unroll
            for (int i = 0; i < 16; ++i) q[i] = (int)__builtin_rintf(v[i] * s) & 0xff;
            v2u o0, o1; o0.x = q[0] | (q[1] << 8) | (q[2] << 16) | (q[3] << 24); o0.y = q[4] | (q[5] << 8) | (q[6] << 16) | (q[7] << 24);
            o1.x = q[8] | (q[9] << 8) | (q[10] << 16) | (q[11] << 24); o1.y = q[12] | (q[13] << 8) | (q[14] << 16) | (q[15] << 24);
            *(GAS v2u*)(HQ + (size_t)m * D + 8 * F.lane) = o0; *(GAS v2u*)(HQ + (size_t)m * D + 512 + 8 * F.lane) = o1;
        }
        pg8::Gemm g{X1B, WC, T, 2048, D}; pg8::StaticOrder S; S.init(T, 2048, F.G, (int)blockIdx.x);
        pg8::Epi4 E{SSQ, RINV2, IDS, GW};
        pg8::OneUnit O1;
        for (int i = 0; S.next(i, O1.u); ++i) pg8::gemm_phase<pg8::Epi4, pg8::OneUnit, false, true>(F.lds + RING_OFF, g, O1, E);
        if (BOTH(5)) GRID_BAR();
    }

    if (IN(6)) REP(6) {
        P67_MAP();
        const int p16 = F.lane & 15, sg = F.lane >> 4;
        LAS unsigned char* HB = F.lds + RING_OFF + F.wave * 16384;
        LAS unsigned* LIST = (LAS unsigned*)(F.lds + RING_OFF + F.wave * 16384 + 8192);
        LAS float* HSs = (LAS float*)(F.lds + RING_OFF + F.wave * 16384 + 12288);
        const int nwb = T / 8, wstep = nrk * NWAVES;
        const int gsel = (F.lane & 15), bpsrc = (16 * (F.lane & 3) + ((F.lane >> 2) & 3)) * 4;
        v4u hpre[8], idpre[2]; float hspre = 0.f;
#define P6_PRE(bb) do { const int bc_ = (bb) < nwb ? (bb) : nwb - 1; const unsigned char* hsrc_ = HQ + (size_t)bc_ * 8192; \
            _Pragma("unroll") for (int i_ = 0; i_ < 8; ++i_) hpre[i_] = *(const GAS v4u*)(hsrc_ + (size_t)(i_ * 64 + F.lane) * 16); \
            const unsigned short* isrc_ = IDS + ((size_t)bc_ * 8 + (F.lane >> 3)) * 128 + 16 * (F.lane & 7); idpre[0] = *(const GAS v4u*)isrc_; idpre[1] = *(const GAS v4u*)(isrc_ + 8); \
            hspre = HS2[(size_t)bc_ * 8 + (F.lane & 7)]; } while (0)
#define P6_ISSUE(W, ENT, EJ, GB, UB, VB, base_) do { \
                _Pragma("unroll") for (int g_ = 0; g_ < 4; ++g_) { const int j_ = (base_) + 4 * g_ + sg; ENT[g_] = LIST[j_ < n ? j_ : nm1]; } \
                { const int j_ = (base_) + gsel; EJ = (j_ < n && F.lane < 16) ? (int)LIST[j_] : -1; } \
                _Pragma("unroll") for (int g_ = 0; g_ < 4; ++g_) { const unsigned char* up_ = U8 + (size_t)((PROBE_L1 && rep_) ? 0u : (ENT[g_] & 0xffffu)) * 512 + 16 * p16; \
                    _Pragma("unroll") for (int i_ = 0; i_ < 2; ++i_) W[g_][i_] = *(const GAS v4u*)(up_ + 256 * i_); } \
                { const unsigned ej_ = EJ < 0 ? 0u : (unsigned)EJ; GB = GW[((size_t)t0 + (ej_ >> 24)) * 128 + ((ej_ >> 16) & 127u)]; UB = USC[ej_ & 0xffffu]; VB = VSC[ej_ & 0xffffu]; } } while (0)
#define P6_DPPADD(a_, ctrl) a_ += __builtin_amdgcn_update_dpp(0, a_, ctrl, 0xf, 0xf, false)
#define P6_REDUCE(W, ENT, EJ, GB, UB, VB, base_) do { if ((base_) < n) { int ag_[4]; \
                _Pragma("unroll") for (int g_ = 0; g_ < 4; ++g_) { const LAS unsigned char* hp_ = HB + (size_t)(ENT[g_] >> 24) * 1024 + 16 * p16; int a_ = 0; v4u h_[4]; \
                    _Pragma("unroll") for (int i_ = 0; i_ < 4; ++i_) h_[i_] = *(const LAS v4u*)(hp_ + 256 * i_); \
                    _Pragma("unroll") for (int ld_ = 0; ld_ < 2; ++ld_) { const unsigned x_[4] = {W[g_][ld_].x, W[g_][ld_].y, W[g_][ld_].z, W[g_][ld_].w}; \
                        _Pragma("unroll") for (int wl_ = 0; wl_ < 4; ++wl_) { const int hd_ = 2 * (4 * ld_ + wl_); const unsigned lo_ = (x_[wl_] << 4) & 0xF0F0F0F0u, hi_ = x_[wl_] & 0xF0F0F0F0u; \
                            const unsigned hA_ = (hd_ & 3) == 0 ? h_[hd_ >> 2].x : h_[hd_ >> 2].z, hB_ = (hd_ & 3) == 0 ? h_[hd_ >> 2].y : h_[hd_ >> 2].w; \
                            a_ = __builtin_amdgcn_sdot4((int)lo_, (int)hA_, a_, false); a_ = __builtin_amdgcn_sdot4((int)hi_, (int)hB_, a_, false); } } \
                    P6_DPPADD(a_, 0xB1); P6_DPPADD(a_, 0x4E); P6_DPPADD(a_, 0x141); P6_DPPADD(a_, 0x140); ag_[g_] = a_; } \
                const int sel_ = gsel == 0 ? ag_[0] : gsel == 1 ? ag_[1] : gsel == 2 ? ag_[2] : ag_[3]; \
                const float resv_ = (float)__builtin_amdgcn_ds_bpermute(bpsrc, sel_); \
                if (EJ >= 0 && !(PROBE_L1 && rep_)) { const unsigned ej_ = (unsigned)EJ; const float act_ = gelu_f(resv_ * UB * HSs[ej_ >> 24]); \
                    COEF[((size_t)t0 + (ej_ >> 24)) * 128 + ((ej_ >> 16) & 127u)] = GB * act_ * VB; } } } while (0)
        int wb = rk * NWAVES + F.wave;
        P6_PRE(wb);
        for (; wb < nwb; wb += wstep) {
            const int t0 = wb * 8;
            asm volatile("s_waitcnt lgkmcnt(0)" ::: "memory");
            if (F.lane < 8) HSs[F.lane] = hspre;
#pragma unroll
            for (int i = 0; i < 8; ++i) *(LAS v4u*)(HB + (size_t)(i * 64 + F.lane) * 16) = hpre[i];
            int n = 0;
            { const unsigned idw[8] = {idpre[0].x, idpre[0].y, idpre[0].z, idpre[0].w, idpre[1].x, idpre[1].y, idpre[1].z, idpre[1].w};
              const unsigned tl = (unsigned)(F.lane >> 3), kb0 = 16u * (unsigned)(F.lane & 7);
#pragma unroll
              for (int i = 0; i < 16; ++i) { const unsigned e = (i & 1) ? (idw[i >> 1] >> 16) : (idw[i >> 1] & 0xffffu);
                  const bool inr = ((int)(e >> 11) == vx); const unsigned long long mk = __ballot(inr);
                  const int pos = n + (int)__builtin_amdgcn_mbcnt_hi((unsigned)(mk >> 32), __builtin_amdgcn_mbcnt_lo((unsigned)mk, 0u));
                  if (inr) LIST[pos] = (tl << 24) | ((kb0 + (unsigned)i) << 16) | e;
                  n += __builtin_popcountll(mk); } }
            asm volatile("s_waitcnt lgkmcnt(0)" ::: "memory");
            P6_PRE(wb + wstep);
            const int nm1 = n > 0 ? n - 1 : 0;
            for (int base = 0; base < n; base += 32) {
                v4u wA[4][2], wB[4][2]; unsigned entA[4], entB[4]; int ejA, ejB; float gbA, ubA, vbA, gbB, ubB, vbB;
                P6_ISSUE(wA, entA, ejA, gbA, ubA, vbA, base);
                P6_ISSUE(wB, entB, ejB, gbB, ubB, vbB, base + 16);
                P6_REDUCE(wA, entA, ejA, gbA, ubA, vbA, base);
                P6_REDUCE(wB, entB, ejB, gbB, ubB, vbB, base + 16);
            }
        }
#undef P6_PRE
#undef P6_ISSUE
#undef P6_REDUCE
#undef P6_DPPADD
        if (BOTH(6)) GRID_BAR();
    }

    if (IN(7)) REP(7) {
        P67_MAP();
        const int cs = vx >> 1;
        const int n0_ = p67_uni ? F.G / 8 : (F.G + 7 - 2 * cs) / 8, n1_ = p67_uni ? F.G / 8 : (F.G + 7 - (2 * cs + 1)) / 8;
        const int rk2 = (vx & 1) ? n0_ + rk : rk, nrk2 = n0_ + n1_;
        const int l8 = F.lane & 7, kg = F.lane >> 3;
        const unsigned char* vbase = V8 + (size_t)cs * NEXP * 128 + 16 * l8;
        const int tstep = nrk2 * NWAVES;
        const int col = 256 * cs + 32 * l8 + ((F.lane & 8) ? 16 : 0) + ((F.lane & 16) ? 8 : 0) + ((F.lane & 32) ? 4 : 0);
#define P7_CL(tt) ((tt) < T ? (tt) : T - 1)
#define P7_IDS(tt, ID) do { const int tc_ = P7_CL(tt); ID[0] = *(const GAS v4u*)(IDS + (size_t)tc_ * 128 + 16 * kg); ID[1] = *(const GAS v4u*)(IDS + (size_t)tc_ * 128 + 16 * kg + 8); } while (0)
#define P7_ISSUE(tt, ID, W, CF, OO) do { const int tc_ = P7_CL(tt); const unsigned idw_[8] = {ID[0].x, ID[0].y, ID[0].z, ID[0].w, ID[1].x, ID[1].y, ID[1].z, ID[1].w}; \
            _Pragma("unroll") for (int i_ = 0; i_ < 16; ++i_) { const unsigned e_ = (i_ & 1) ? (idw_[i_ >> 1] >> 16) : (idw_[i_ >> 1] & 0xffffu); W[i_] = *(const GAS v4u*)(vbase + (size_t)((PROBE_L1 && rep_) ? 0u : e_) * 128); } \
            _Pragma("unroll") for (int i_ = 0; i_ < 4; ++i_) CF[i_] = *(const GAS f32x4*)(COEF + (size_t)tc_ * 128 + 16 * kg + 4 * i_); \
            OO = *(const GAS v2u*)(X1B + (size_t)tc_ * D + col); } while (0)
#define P7_BYTE(d_, s_) do { const h2_t r_ = __builtin_amdgcn_cvt_scalef32_pk_f16_fp4(ww_[d_], 1.0f, s_); acc_[4 * (d_) + (s_)] = r_ * c2_ + acc_[4 * (d_) + (s_)]; } while (0)
#define P7_COMPUTE(tt, W, CF, OO) do { h2_t acc_[16];                 \
            _Pragma("unroll") for (int i_ = 0; i_ < 16; ++i_) acc_[i_] = (h2_t){(_Float16)0.f, (_Float16)0.f}; \
            _Pragma("unroll") for (int i_ = 0; i_ < 16; ++i_) { const unsigned ww_[4] = {W[i_].x, W[i_].y, W[i_].z, W[i_].w}; const _Float16 ch_ = (_Float16)CF[i_ >> 2][i_ & 3]; const h2_t c2_ = {ch_, ch_}; \
                P7_BYTE(0, 0); P7_BYTE(0, 1); P7_BYTE(0, 2); P7_BYTE(0, 3); P7_BYTE(1, 0); P7_BYTE(1, 1); P7_BYTE(1, 2); P7_BYTE(1, 3); \
                P7_BYTE(2, 0); P7_BYTE(2, 1); P7_BYTE(2, 2); P7_BYTE(2, 3); P7_BYTE(3, 0); P7_BYTE(3, 1); P7_BYTE(3, 2); P7_BYTE(3, 3); } \
            float r16_[16], r8_[8], r4_[4]; \
            { const bool up_ = (F.lane & 8) != 0; _Pragma("unroll") for (int i_ = 0; i_ < 8; ++i_) { const h2_t keep_ = up_ ? acc_[8 + i_] : acc_[i_], send_ = up_ ? acc_[i_] : acc_[8 + i_]; \
                const h2_t oth_ = __builtin_bit_cast(h2_t, __shfl_xor(__builtin_bit_cast(int, send_), 8)); r16_[2 * i_] = (float)keep_[0] + (float)oth_[0]; r16_[2 * i_ + 1] = (float)keep_[1] + (float)oth_[1]; } } \
            { const bool up_ = (F.lane & 16) != 0; _Pragma("unroll") for (int i_ = 0; i_ < 8; ++i_) { const float keep_ = up_ ? r16_[8 + i_] : r16_[i_], send_ = up_ ? r16_[i_] : r16_[8 + i_]; r8_[i_] = keep_ + __shfl_xor(send_, 16); } } \
            { const bool up_ = (F.lane & 32) != 0; _Pragma("unroll") for (int i_ = 0; i_ < 4; ++i_) { const float keep_ = up_ ? r8_[4 + i_] : r8_[i_], send_ = up_ ? r8_[i_] : r8_[4 + i_]; r4_[i_] = keep_ + __shfl_xor(send_, 32); } } \
            if ((tt) < T) *(GAS f32x4*)((rep_ == 0 ? out : (float*)(ws + WS_GT)) + (size_t)(tt) * D + col) = (f32x4){pg8::bflo(OO.x) + r4_[0], pg8::bfhi(OO.x) + r4_[1], pg8::bflo(OO.y) + r4_[2], pg8::bfhi(OO.y) + r4_[3]}; } while (0)
        v4u idA[2], idB[2], wA[16], wB[16]; f32x4 cfA[4], cfB[4]; v2u ooA, ooB;
        int t = rk2 * NWAVES + F.wave;
        P7_IDS(t, idA); P7_IDS(t + tstep, idB);
        while (t < T) {
            P7_ISSUE(t, idA, wA, cfA, ooA); P7_ISSUE(t + tstep, idB, wB, cfB, ooB);
            P7_IDS(t + 2 * tstep, idA); P7_IDS(t + 3 * tstep, idB);
            P7_COMPUTE(t, wA, cfA, ooA);
            P7_COMPUTE(t + tstep, wB, cfB, ooB);
            t += 2 * tstep;
        }
#undef P7_CL
#undef P7_IDS
#undef P7_ISSUE
#undef P7_BYTE
#undef P7_COMPUTE
    }
#undef IN
#undef BOTH
#undef GRID_BAR
}

extern "C" void kernel_launch(void* const* d_in, const int* in_sizes, int n_in, void* d_out, int out_size, void* d_ws, size_t ws_size, hipStream_t stream) {
    static int grid = 0;
    if (grid == 0) {
        if (n_in != 14 || in_sizes[0] != T * D || out_size != T * D || ws_size < WS_END) { fprintf(stderr, "kernel_launch: built for 14 inputs, x and out of %d floats, >= %zu bytes of workspace; got n_in %d, in0 %d, out %d, ws %zu; nothing launched\n", T * D, (size_t)WS_END, n_in, n_in > 0 ? in_sizes[0] : -1, out_size, ws_size); grid = -1; return; }
        int dev = 0, cus = 0, per_cu = 0;
        if (hipGetDevice(&dev) != hipSuccess || hipDeviceGetAttribute(&cus, hipDeviceAttributeMultiprocessorCount, dev) != hipSuccess) { fprintf(stderr, "kernel_launch: hipGetDevice / hipDeviceGetAttribute failed\n"); grid = -1; return; }
        if (hipFuncSetAttribute((const void*)fwd_kernel, hipFuncAttributeMaxDynamicSharedMemorySize, LDS_BYTES) != hipSuccess) { fprintf(stderr, "kernel_launch: hipFuncSetAttribute failed\n"); grid = -1; return; }
        if (hipOccupancyMaxActiveBlocksPerMultiprocessor(&per_cu, (const void*)fwd_kernel, NWAVES * 64, LDS_BYTES) != hipSuccess || per_cu < 1)
            fprintf(stderr, "kernel_launch: note: occupancy query reports %d workgroups per CU\n", per_cu);
        (void)hipGetLastError();
        grid = cus;
    }
    if (grid < 0) return;
    if (hipMemsetAsync((char*)d_ws + WS_CTL, 0, CTL_ZERO_BYTES, stream) != hipSuccess) { fprintf(stderr, "kernel_launch: hipMemsetAsync failed\n"); return; }
    Args a{};
    for (int i = 0; i < 14; ++i) a.in[i] = (const float*)d_in[i];
    a.out = (float*)d_out; a.ws = (unsigned char*)d_ws;
    for (int li = 0; li < N_LAUNCHES; ++li) {
        a.ph_lo = (N_LAUNCHES == PER_PHASE) ? li : 0; a.ph_hi = (N_LAUNCHES == PER_PHASE) ? li + 1 : MK_LAST_PHASE; a.li = li;
        if (a.ph_lo >= MK_LAST_PHASE) break;
        hipLaunchKernelGGL(fwd_kernel, dim3(grid), dim3(NWAVES * 64), LDS_BYTES, stream, a);
        const hipError_t le = hipPeekAtLastError();
        if (le != hipSuccess) { fprintf(stderr, "kernel_launch: launch %d failed: %s\n", li, hipGetErrorName(le)); break; }
    }
}
```

```cpp
#include <hip/hip_runtime.h>
#include <cstdio>
#include <cstdint>
namespace pg8 {
#define PG8_LAS __attribute__((address_space(3)))
typedef unsigned short bf16_t;
typedef short bf16x8 __attribute__((ext_vector_type(8)));
typedef float f32x4 __attribute__((ext_vector_type(4)));
typedef unsigned u32x4 __attribute__((ext_vector_type(4)));
typedef int i32x8 __attribute__((ext_vector_type(8)));
constexpr int BM = 256, BK = 64, HALF = 128, HTB = HALF * BK * 2  , STAGE_BYTES = 8 * HTB, NXCD = 8, WGM = 8;

__host__ __device__ __forceinline__ int lds_byte(int r, int c) { const int st = (r >> 4) * 2 + (c >> 5), rr = r & 15, cc = c & 31, ob = rr * 64 + cc * 2; return st * 1024 + (ob ^ (((ob >> 9) & 1) << 5)); }
__host__ __device__ __forceinline__ void stage_rc(int b, int& R, int& C) { const int st = b / 1024, sb = b % 1024, swz = sb ^ (((sb >> 9) & 1) << 5); R = (st >> 1) * 16 + swz / 64; C = (st & 1) * 32 + (swz % 64) / 2; }
__host__ __device__ __forceinline__ int perm32(int rho) { const int n = rho >> 4, i = rho & 15; return 8 * (i >> 2) + 4 * n + (i & 3); }

struct Unit { int pm, pn; };
struct Gemm { const bf16_t* A; const bf16_t* Bt; int M, N, K; };

struct StaticOrder {
    int nM, nN, nwg, G, c;
    __host__ __device__ void init(int M, int N, int G_, int c_) { nM = M / BM; nN = N / BM; nwg = nM * nN; G = G_; c = c_; }
    __host__ __device__ bool next(int i, Unit& u) const {
        const long L = (long)i * G + c; if (L >= nwg) return false;
        int wgid = (int)L; { const int q = nwg / NXCD, r = nwg % NXCD, xcd = wgid % NXCD, off = wgid / NXCD; wgid = (xcd < r ? xcd * (q + 1) : r * (q + 1) + (xcd - r) * q) + off; }
        const int nig = WGM * nN, gid = wgid / nig, fm = gid * WGM, gsz = (nM - fm) < WGM ? (nM - fm) : WGM;
        u.pm = fm + ((wgid % nig) % gsz); u.pn = (wgid % nig) / gsz; return true;
    }
    __device__ __forceinline__ void a_ready(const Unit&) const {}
    __device__ __forceinline__ void done(const Unit&) const {}
};


struct OneUnit {
    Unit u;
    __device__ __forceinline__ bool next(int i, Unit& o) const { if (i != 0) return false; o = u; return true; }
    __device__ __forceinline__ void a_ready(const Unit&) const {}
    __device__ __forceinline__ void done(const Unit&) const {}
};

typedef float f32x2 __attribute__((ext_vector_type(2)));
typedef __bf16 bf16x2_t __attribute__((ext_vector_type(2)));
typedef unsigned u32x2 __attribute__((ext_vector_type(2)));
__device__ __forceinline__ unsigned pkbf(float lo, float hi) { f32x2 v = {lo, hi}; bf16x2_t b = __builtin_convertvector(v, bf16x2_t); return __builtin_bit_cast(unsigned, b); }
__device__ __forceinline__ float bflo(unsigned w) { return __uint_as_float(w << 16); }
__device__ __forceinline__ float bfhi(unsigned w) { return __uint_as_float(w & 0xffff0000u); }
__device__ __forceinline__ u32x4 pack8(const f32x4 a, const f32x4 b) { u32x4 w; w.x = pkbf(a[0], a[1]); w.y = pkbf(a[2], a[3]); w.z = pkbf(b[0], b[1]); w.w = pkbf(b[2], b[3]); return w; }
constexpr float QSCALE = 0.125f * 1.4426950408889634f;
__device__ __forceinline__ float sigmoidf_(float v) { return __builtin_amdgcn_rcpf(1.0f + __builtin_amdgcn_exp2f(-1.4426950408889634f * v)); }

struct Epi1 {
    static constexpr bool PERM = true, AFTER_DRAIN = false, HAS_MID = false; static constexpr int MID_T = -1;
    const float* rinv; const float* bgate; const float* qg; const float* kg;
    bf16_t *QS, *KS, *VS, *QD, *KD, *VD, *GT;
    __device__ __forceinline__ void mid(f32x4 (&)[2][2][4][2], const Unit&, int, int, int, int) const {}
    __device__ __forceinline__ void operator()(const f32x4 (&acc)[2][2][4][2], const Unit& u, int wr, int wc, int fr, int fq) const {
        asm volatile("" : "+v"(fr), "+v"(fq));
        const int pn = u.pn; const int row0 = u.pm * BM + wr * 64 + fr;
        {
            bf16_t* base; int ld, colt;
            if (pn < 2) { base = QS; ld = 512; colt = pn * 256; } else if (pn < 4) { base = KS; ld = 512; colt = (pn - 2) * 256; } else { base = VS; ld = 512; colt = (pn - 4) * 256; }
            base += colt + wc * 32 + 8 * fq;
#pragma unroll
            for (int ai = 0; ai < 2; ++ai)
#pragma unroll
                for (int m = 0; m < 4; ++m) { const int row = row0 + ai * HALF + m * 16; const float r = (pn < 2 ? QSCALE : 1.0f);
#pragma unroll
                    for (int bj = 0; bj < 2; ++bj) *(u32x4*)(base + (size_t)row * ld + bj * HALF) = pack8(acc[ai][bj][m][0] * r, acc[ai][bj][m][1] * r);
                }
        }
    }
};

struct EpiG {
    static constexpr bool PERM = true, AFTER_DRAIN = false, HAS_MID = false; static constexpr int MID_T = -1;
    const float* bgate; const float* cs; const float* qg; const float* kg; bf16_t *QD, *KD, *VD, *GT;
    __device__ __forceinline__ void mid(f32x4 (&)[2][2][4][2], const Unit&, int, int, int, int) const {}
    __device__ __forceinline__ void operator()(const f32x4 (&acc)[2][2][4][2], const Unit& u, int wr, int wc, int fr, int fq) const {
        asm volatile("" : "+v"(fr), "+v"(fq));
        const int pn = u.pn; const int row0 = u.pm * BM + wr * 64 + fr, colp = pn * BM + wc * 32 + 8 * fq;
        f32x4 sv[2][2];
#pragma unroll
        for (int bj = 0; bj < 2; ++bj)
#pragma unroll
            for (int n = 0; n < 2; ++n) sv[bj][n] = *(const f32x4*)(cs + colp + bj * HALF + 4 * n);
        if (pn < 6) {
            const bool isK = pn >= 3; const int head = (isK ? pn - 3 : pn) * 4 + wc;
            const float* g = (isK ? kg : qg) + head * 64 + 8 * fq;
            f32x4 gv[2][2]; const float qsc = isK ? 1.0f : QSCALE;
#pragma unroll
            for (int bj = 0; bj < 2; ++bj)
#pragma unroll
                for (int n = 0; n < 2; ++n) gv[bj][n] = *(const f32x4*)(g + 32 * bj + 4 * n) * qsc;
            bf16_t* base = (isK ? KD : QD) + head * 64 + 8 * fq;
#pragma unroll
            for (int ai = 0; ai < 2; ++ai)
#pragma unroll
                for (int m = 0; m < 4; ++m) { const int row = row0 + ai * HALF + m * 16;
                    f32x4 v[2][2]; float ss = 0.f;
#pragma unroll
                    for (int bj = 0; bj < 2; ++bj)
#pragma unroll
                        for (int n = 0; n < 2; ++n) { v[bj][n] = acc[ai][bj][m][n] * sv[bj][n]; const f32x4 q = v[bj][n] * v[bj][n]; ss += (q[0] + q[1]) + (q[2] + q[3]); }
                    ss += __shfl_xor(ss, 16); ss += __shfl_xor(ss, 32);
                    const float sc = __builtin_amdgcn_rsqf(ss * (1.0f / 64.0f) + 1e-6f);
#pragma unroll
                    for (int bj = 0; bj < 2; ++bj) *(u32x4*)(base + (size_t)row * 768 + 32 * bj) = pack8(v[bj][0] * sc * gv[bj][0], v[bj][1] * sc * gv[bj][1]);
                }
        } else if (pn < 9) {
            bf16_t* base = VD + (pn - 6) * 256 + wc * 32 + 8 * fq;
#pragma unroll
            for (int ai = 0; ai < 2; ++ai)
#pragma unroll
                for (int m = 0; m < 4; ++m) { const int row = row0 + ai * HALF + m * 16;
#pragma unroll
                    for (int bj = 0; bj < 2; ++bj) *(u32x4*)(base + (size_t)row * 768 + bj * HALF) = pack8(acc[ai][bj][m][0] * sv[bj][0], acc[ai][bj][m][1] * sv[bj][1]);
                }
        } else {
            const int col0 = (pn - 9) * 256 + wc * 32 + 8 * fq;
            f32x4 bv[2][2];
#pragma unroll
            for (int bj = 0; bj < 2; ++bj)
#pragma unroll
                for (int n = 0; n < 2; ++n) bv[bj][n] = *(const f32x4*)(bgate + col0 + bj * HALF + 4 * n);
#pragma unroll
            for (int ai = 0; ai < 2; ++ai)
#pragma unroll
                for (int m = 0; m < 4; ++m) { const int row = row0 + ai * HALF + m * 16;
#pragma unroll
                    for (int bj = 0; bj < 2; ++bj) { f32x4 a = acc[ai][bj][m][0] * sv[bj][0] + bv[bj][0], b = acc[ai][bj][m][1] * sv[bj][1] + bv[bj][1];
#pragma unroll
                        for (int e = 0; e < 4; ++e) { a[e] = sigmoidf_(a[e]); b[e] = sigmoidf_(b[e]); }
                        *(u32x4*)(GT + (size_t)row * 2048 + col0 + bj * HALF) = pack8(a, b); }
                }
        }
    }
};

struct Epi2 {
    static constexpr bool PERM = true, AFTER_DRAIN = false, HAS_MID = true; static constexpr int MID_T = 8;
    const bf16_t* GT; bf16_t* MIX;
    __device__ __forceinline__ void mid(f32x4 (&acc)[2][2][4][2], const Unit& u, int wr, int wc, int fr, int fq) const {
        asm volatile("" : "+v"(fr), "+v"(fq));
        const int row0 = u.pm * BM + wr * 64 + fr, col0 = u.pn * BM + wc * 32 + 8 * fq;
#pragma unroll
        for (int ai = 0; ai < 2; ++ai) { u32x4 ga[4][2], gb[4][2];
#pragma unroll
            for (int m = 0; m < 4; ++m) { const bf16_t* gp = GT + (size_t)(row0 + ai * HALF + m * 16) * 2048 + col0;
#pragma unroll
                for (int bj = 0; bj < 2; ++bj) { ga[m][bj] = *(const u32x4*)(gp + bj * HALF); gb[m][bj] = *(const u32x4*)(gp + 1024 + bj * HALF); } }
#pragma unroll
            for (int m = 0; m < 4; ++m)
#pragma unroll
                for (int bj = 0; bj < 2; ++bj) { const u32x4 a = ga[m][bj], b = gb[m][bj];
                    f32x4 r0, r1;
                    r0[0] = bflo(a.x) * __builtin_amdgcn_rcpf(fmaxf(bflo(b.x), 1e-30f)); r0[1] = bfhi(a.x) * __builtin_amdgcn_rcpf(fmaxf(bfhi(b.x), 1e-30f));
                    r0[2] = bflo(a.y) * __builtin_amdgcn_rcpf(fmaxf(bflo(b.y), 1e-30f)); r0[3] = bfhi(a.y) * __builtin_amdgcn_rcpf(fmaxf(bfhi(b.y), 1e-30f));
                    r1[0] = bflo(a.z) * __builtin_amdgcn_rcpf(fmaxf(bflo(b.z), 1e-30f)); r1[1] = bfhi(a.z) * __builtin_amdgcn_rcpf(fmaxf(bfhi(b.z), 1e-30f));
                    r1[2] = bflo(a.w) * __builtin_amdgcn_rcpf(fmaxf(bflo(b.w), 1e-30f)); r1[3] = bfhi(a.w) * __builtin_amdgcn_rcpf(fmaxf(bfhi(b.w), 1e-30f));
                    acc[ai][bj][m][0] *= r0; acc[ai][bj][m][1] *= r1; }
            asm volatile("" ::: "memory");
        }
    }
    __device__ __forceinline__ void operator()(const f32x4 (&acc)[2][2][4][2], const Unit& u, int wr, int wc, int fr, int fq) const {
        asm volatile("" : "+v"(fr), "+v"(fq));
        const int row0 = u.pm * BM + wr * 64 + fr, col0 = u.pn * BM + wc * 32 + 8 * fq;
#pragma unroll
        for (int ai = 0; ai < 2; ++ai) { u32x4 gb[4][2];
#pragma unroll
            for (int m = 0; m < 4; ++m) { const bf16_t* gp = GT + (size_t)(row0 + ai * HALF + m * 16) * 2048 + 1024 + col0;
#pragma unroll
                for (int bj = 0; bj < 2; ++bj) gb[m][bj] = *(const u32x4*)(gp + bj * HALF); }
#pragma unroll
            for (int m = 0; m < 4; ++m) { const int row = row0 + ai * HALF + m * 16;
#pragma unroll
                for (int bj = 0; bj < 2; ++bj) { const u32x4 b = gb[m][bj];
                    f32x4 g0, g1;
                    g0[0] = fmaxf(bflo(b.x), 1e-30f); g0[1] = fmaxf(bfhi(b.x), 1e-30f); g0[2] = fmaxf(bflo(b.y), 1e-30f); g0[3] = fmaxf(bfhi(b.y), 1e-30f);
                    g1[0] = fmaxf(bflo(b.z), 1e-30f); g1[1] = fmaxf(bfhi(b.z), 1e-30f); g1[2] = fmaxf(bflo(b.w), 1e-30f); g1[3] = fmaxf(bfhi(b.w), 1e-30f);
                    *(u32x4*)(MIX + (size_t)row * 1024 + col0 + bj * HALF) = pack8(acc[ai][bj][m][0] * g0, acc[ai][bj][m][1] * g1); } }
            asm volatile("" ::: "memory");
        }
    }
};

struct Epi3 {
    static constexpr bool PERM = true, AFTER_DRAIN = false, HAS_MID = false; static constexpr int MID_T = -1;
    const float* x; bf16_t* x1b; float* ssq;
    __device__ __forceinline__ void mid(f32x4 (&)[2][2][4][2], const Unit&, int, int, int, int) const {}
    __device__ __forceinline__ void operator()(const f32x4 (&acc)[2][2][4][2], const Unit& u, int wr, int wc, int fr, int fq) const {
        asm volatile("" : "+v"(fr), "+v"(fq));
        const int row0 = u.pm * BM + wr * 64 + fr, col0 = u.pn * BM + wc * 32 + 8 * fq;
#pragma unroll
        for (int ai = 0; ai < 2; ++ai) { f32x4 xv[4][2][2];
#pragma unroll
            for (int m = 0; m < 4; ++m) { const size_t off = (size_t)(row0 + ai * HALF + m * 16) * 1024 + col0;
#pragma unroll
                for (int bj = 0; bj < 2; ++bj) { xv[m][bj][0] = *(const f32x4*)(x + off + bj * HALF); xv[m][bj][1] = *(const f32x4*)(x + off + bj * HALF + 4); } }
#pragma unroll
            for (int m = 0; m < 4; ++m) { const int row = row0 + ai * HALF + m * 16; const size_t off = (size_t)row * 1024 + col0; float ss = 0.f;
#pragma unroll
                for (int bj = 0; bj < 2; ++bj) { const f32x4 v0 = acc[ai][bj][m][0] + xv[m][bj][0], v1 = acc[ai][bj][m][1] + xv[m][bj][1];
                    *(u32x4*)(x1b + off + bj * HALF) = pack8(v0, v1);
                    const f32x4 q0 = v0 * v0, q1 = v1 * v1; ss += ((q0[0] + q0[1]) + (q0[2] + q0[3])) + ((q1[0] + q1[1]) + (q1[2] + q1[3])); }
                ss += __shfl_xor(ss, 16); ss += __shfl_xor(ss, 32);
                if (fq == 0) ssq[(size_t)row * 16 + u.pn * 4 + wc] = ss;
            }
            asm volatile("" ::: "memory");
        }
    }
};

__device__ __forceinline__ unsigned f2key(float v) { const unsigned u = __float_as_uint(v); return (u & 0x80000000u) ? ~u : (u | 0x80000000u); }
__device__ __forceinline__ float key2f(unsigned k) { return __uint_as_float((k & 0x80000000u) ? (k & 0x7fffffffu) : ~k); }
#define PG8_CE(a_, b_) do { const unsigned hi__ = (a_) > (b_) ? (a_) : (b_); const unsigned lo__ = (a_) > (b_) ? (b_) : (a_); (a_) = hi__; (b_) = lo__; } while (0)
__device__ __forceinline__ void bitonic_merge16(unsigned (&v)[16]) {
#pragma unroll
    for (int j = 8; j >= 1; j >>= 1)
#pragma unroll
        for (int i = 0; i < 16; ++i) { const int l = i ^ j; if (l > i) PG8_CE(v[i], v[l]); }
}
__device__ __forceinline__ void bitonic_sort16(unsigned (&v)[16]) {
#pragma unroll
    for (int k = 2; k <= 16; k <<= 1)
#pragma unroll
        for (int j = k >> 1; j >= 1; j >>= 1)
#pragma unroll
            for (int i = 0; i < 16; ++i) { const int l = i ^ j; if (l > i) { if ((i & k) == 0 || k == 16) PG8_CE(v[i], v[l]); else PG8_CE(v[l], v[i]); } }
}
__device__ __forceinline__ void merge_top16(unsigned (&t)[16], const unsigned (&o)[16]) {
#pragma unroll
    for (int i = 0; i < 16; ++i) t[i] = t[i] > o[15 - i] ? t[i] : o[15 - i];
    bitonic_merge16(t);
}
template <int XM> __device__ __forceinline__ void merge_top16_xor(unsigned (&t)[16]) {
    unsigned o[16];
#pragma unroll
    for (int i = 0; i < 16; ++i) o[i] = (unsigned)__shfl_xor((int)t[i], XM);
    merge_top16(t, o);
}

struct Epi4 {
    static constexpr bool PERM = false, AFTER_DRAIN = true, HAS_MID = false; static constexpr int MID_T = -1;
    const float* ssq; float* rinv2; unsigned short* ids; float* gw;
    __device__ __forceinline__ void mid(f32x4 (&)[2][2][4][2], const Unit&, int, int, int, int) const {}
    __device__ __forceinline__ void fused(f32x4 (&acc)[2][2][4][2], const Unit& u, int wr, int wc, int fr, int fq, PG8_LAS unsigned char* lds, int wid, int lane) const {
        asm volatile("" : "+v"(fr), "+v"(fq));
        const int tid = wid * 64 + lane;
        const int rl = tid >> 2, p = (tid >> 1) & 1, hf = tid & 1, q4 = tid & 3;
#pragma unroll
        for (int pass = 0; pass < 2; ++pass) {
#pragma unroll
            for (int m = 0; m < 4; ++m)
#pragma unroll
                for (int bj = 0; bj < 2; ++bj)
#pragma unroll
                    for (int n = 0; n < 2; ++n) *(PG8_LAS f32x4*)(lds + (size_t)(wr * 64 + m * 16 + fr) * 1056 + bj * 528 + (wc * 32 + n * 16 + fq * 4) * 4) = acc[pass][bj][m][n];
            asm volatile("s_waitcnt lgkmcnt(0)" ::: "memory"); __builtin_amdgcn_s_barrier(); asm volatile("" ::: "memory");
            const int row = u.pm * BM + pass * HALF + rl;
            unsigned tk[16];
#pragma unroll
            for (int i = 0; i < 16; ++i) tk[i] = 0u;
            const PG8_LAS unsigned char* sp = lds + (size_t)rl * 1056 + p * 528 + hf * 256;
#pragma nounroll
            for (int c = 0; c < 4; ++c) { unsigned ch[16];
#pragma unroll
                for (int e4 = 0; e4 < 4; ++e4) { const f32x4 v = *(const PG8_LAS f32x4*)(sp + c * 64 + e4 * 16);
#pragma unroll
                    for (int e = 0; e < 4; ++e) ch[4 * e4 + e] = (f2key(v[e]) & ~127u) | (unsigned)(127 - (64 * hf + 16 * c + 4 * e4 + e)); }
                bitonic_sort16(ch);
                merge_top16(tk, ch);
            }
            merge_top16_xor<1>(tk);
            asm volatile("s_waitcnt lgkmcnt(0)" ::: "memory");
            PG8_LAS unsigned* kl = (PG8_LAS unsigned*)(lds + (size_t)(rl & ~15) * 1056) + ((rl & 15) * 2) * 16;
            if (hf == 0) {
#pragma unroll
                for (int i = 0; i < 4; ++i) *(PG8_LAS u32x4*)(kl + p * 16 + 4 * i) = (u32x4){tk[4 * i], tk[4 * i + 1], tk[4 * i + 2], tk[4 * i + 3]}; }
            asm volatile("s_waitcnt lgkmcnt(0)" ::: "memory");
            unsigned ck[16];
#define CAND_SLOT(m_, ij__) do { const unsigned i__ = (ij__) >> 4, j__ = (ij__) & 15u; \
                const unsigned ka__ = kl[(ij__) == 0xFFFFu ? 0u : i__], kb__ = kl[16 + ((ij__) == 0xFFFFu ? 0u : j__)]; \
                const float s__ = key2f(ka__ & ~127u) + key2f(kb__ & ~127u); \
                ck[m_] = (ij__) == 0xFFFFu ? 0u : ((f2key(s__) & ~255u) | (255u - (ij__))); } while (0)
                { const unsigned ij_ = q4 == 0 ? 0u : q4 == 1 ? 1u : q4 == 2 ? 2u : 3u; CAND_SLOT(0, ij_); }
                { const unsigned ij_ = q4 == 0 ? 4u : q4 == 1 ? 5u : q4 == 2 ? 6u : 7u; CAND_SLOT(1, ij_); }
                { const unsigned ij_ = q4 == 0 ? 8u : q4 == 1 ? 9u : q4 == 2 ? 10u : 11u; CAND_SLOT(2, ij_); }
                { const unsigned ij_ = q4 == 0 ? 12u : q4 == 1 ? 13u : q4 == 2 ? 14u : 15u; CAND_SLOT(3, ij_); }
                { const unsigned ij_ = q4 == 0 ? 16u : q4 == 1 ? 17u : q4 == 2 ? 18u : 19u; CAND_SLOT(4, ij_); }
                { const unsigned ij_ = q4 == 0 ? 20u : q4 == 1 ? 21u : q4 == 2 ? 22u : 23u; CAND_SLOT(5, ij_); }
                { const unsigned ij_ = q4 == 0 ? 32u : q4 == 1 ? 33u : q4 == 2 ? 34u : 35u; CAND_SLOT(6, ij_); }
                { const unsigned ij_ = q4 == 0 ? 36u : q4 == 1 ? 48u : q4 == 2 ? 49u : 50u; CAND_SLOT(7, ij_); }
                { const unsigned ij_ = q4 == 0 ? 51u : q4 == 1 ? 64u : q4 == 2 ? 65u : 66u; CAND_SLOT(8, ij_); }
                { const unsigned ij_ = q4 == 0 ? 80u : q4 == 1 ? 81u : q4 == 2 ? 96u : 97u; CAND_SLOT(9, ij_); }
                { const unsigned ij_ = q4 == 0 ? 112u : q4 == 1 ? 113u : q4 == 2 ? 128u : 144u; CAND_SLOT(10, ij_); }
                { const unsigned ij_ = q4 == 0 ? 160u : q4 == 1 ? 176u : q4 == 2 ? 192u : 208u; CAND_SLOT(11, ij_); }
                { const unsigned ij_ = q4 == 0 ? 224u : q4 == 1 ? 240u : q4 == 2 ? 65535u : 65535u; CAND_SLOT(12, ij_); }
#undef CAND_SLOT
            ck[13] = 0u; ck[14] = 0u; ck[15] = 0u;
            bitonic_sort16(ck);
            merge_top16_xor<1>(ck); merge_top16_xor<2>(ck);
            float sq = 0.f;
#pragma unroll
            for (int i = 0; i < 4; ++i) { const f32x4 t = *(const f32x4*)(ssq + (size_t)row * 16 + 4 * i); sq += (t[0] + t[1]) + (t[2] + t[3]); }
            const float r2 = __builtin_amdgcn_rsqf(sq * (1.0f / 1024.0f) + 1e-6f);
            if (u.pn == 0 && q4 == 0) rinv2[row] = r2;
            const float b0 = key2f(ck[0] & ~255u); float wsum = 0.f; float wv[16];
#pragma unroll
            for (int q = 0; q < 16; ++q) { wv[q] = __builtin_amdgcn_exp2f((key2f(ck[q] & ~255u) - b0) * r2 * 1.4426950408889634f); wsum += wv[q]; }
            const float inv = 1.0f / wsum;
            unsigned short eo[4]; float go[4];
#pragma unroll
            for (int e = 0; e < 4; ++e) { unsigned c0 = ck[e], c1 = ck[4 + e], c2 = ck[8 + e], c3 = ck[12 + e]; float w0 = wv[e], w1 = wv[4 + e], w2 = wv[8 + e], w3 = wv[12 + e];
                asm volatile("" : "+v"(c0), "+v"(c1), "+v"(c2), "+v"(c3), "+v"(w0), "+v"(w1), "+v"(w2), "+v"(w3));
                const unsigned cc = q4 == 0 ? c0 : q4 == 1 ? c1 : q4 == 2 ? c2 : c3; const float ww = q4 == 0 ? w0 : q4 == 1 ? w1 : q4 == 2 ? w2 : w3;
                const unsigned code = 255u - (cc & 255u);
                const unsigned i1 = 127u - (kl[code >> 4] & 127u), i2 = 127u - (kl[16 + (code & 15u)] & 127u);
                eo[e] = (unsigned short)(i1 * 128u + i2); go[e] = ww * inv; }
            const size_t ob = ((size_t)row * 8 + u.pn) * 16 + q4 * 4;
            { u32x2 w; w.x = eo[0] | ((unsigned)eo[1] << 16); w.y = eo[2] | ((unsigned)eo[3] << 16); *(u32x2*)(ids + ob) = w; }
            *(f32x4*)(gw + ob) = (f32x4){go[0], go[1], go[2], go[3]};
            asm volatile("s_waitcnt lgkmcnt(0)" ::: "memory"); __builtin_amdgcn_s_barrier(); asm volatile("" ::: "memory");
        }
    }
};
template <class Epi, class Sched, bool ALIGN_EPI = false, bool SP2 = false, bool FP8 = false>
__device__ __forceinline__ void gemm_phase(PG8_LAS unsigned char* lds, const Gemm g, const Sched& S, const Epi& E) {
    const int tid = threadIdx.x, wid = __builtin_amdgcn_readfirstlane(tid >> 6), lane = tid & 63, wr = wid >> 2, wc = wid & 3, fr = lane & 15, fq = lane >> 4;
    const int K = g.K, nt = K / BK;
    unsigned voffA[2], voffB[2];
#pragma unroll
    for (int i = 0; i < 2; ++i) { int R, C; stage_rc(tid * 16 + i * 8192, R, C); const int Rb = Epi::PERM ? ((R & ~31) + perm32(R & 31)) : R;
        voffA[i] = (unsigned)(R * K + C) * 2u; voffB[i] = (unsigned)(Rb * K + C) * 2u; }
    const size_t kstep = (size_t)(BK * 2);
    const size_t hstep = (size_t)HALF * K * 2;
    const size_t tstep = 2 * hstep;
    const unsigned ldsw = (unsigned)wid * 1024u;
    const int aoff = lds_byte(wr * 64 + fr, fq * 8), boff = lds_byte(wc * 32 + fr, fq * 8);
#define PG8_SA(b, h) (((b) * 2 + (h)) * HTB)
#define PG8_SB(b, h) ((4 + (b) * 2 + (h)) * HTB)
#define PG8_STAGE(bufoff, gbase, voff) do { _Pragma("unroll") for (int _i = 0; _i < 2; ++_i) \
        __builtin_amdgcn_global_load_lds((const unsigned*)((const char*)(gbase) + (voff)[_i]), (PG8_LAS unsigned*)(lds + (bufoff) + ldsw + _i * 8192), 16, 0, 0); } while (0)
#define PG8_LD8(lo_, hi_) __builtin_bit_cast(i32x8, __builtin_shufflevector((lo_), (hi_), 0, 1, 2, 3, 4, 5, 6, 7))
#define PG8_LDA(dst, b, h) do { if constexpr (FP8) { _Pragma("unroll") for (int m = 0; m < 4; ++m) { const u32x4 l0_ = *(const PG8_LAS u32x4*)(lds + PG8_SA(b, h) + aoff + m * 2048), l1_ = *(const PG8_LAS u32x4*)(lds + PG8_SA(b, h) + aoff + m * 2048 + 1024); dst##8[m] = PG8_LD8(l0_, l1_); } } \
        else { _Pragma("unroll") for (int m = 0; m < 4; ++m) _Pragma("unroll") for (int k = 0; k < 2; ++k) dst[m][k] = *(const PG8_LAS bf16x8*)(lds + PG8_SA(b, h) + aoff + m * 2048 + k * 1024); } } while (0)
#define PG8_LDB(dst, b, h) do { if constexpr (FP8) { _Pragma("unroll") for (int n = 0; n < 2; ++n) { const u32x4 l0_ = *(const PG8_LAS u32x4*)(lds + PG8_SB(b, h) + boff + n * 2048), l1_ = *(const PG8_LAS u32x4*)(lds + PG8_SB(b, h) + boff + n * 2048 + 1024); dst##8[n] = PG8_LD8(l0_, l1_); } } \
        else { _Pragma("unroll") for (int n = 0; n < 2; ++n) _Pragma("unroll") for (int k = 0; k < 2; ++k) dst[n][k] = *(const PG8_LAS bf16x8*)(lds + PG8_SB(b, h) + boff + n * 2048 + k * 1024); } } while (0)
#define PG8_MMA(ai, bj, At, Bt) do { __builtin_amdgcn_s_setprio(1); \
        if constexpr (FP8) { _Pragma("unroll") for (int m = 0; m < 4; ++m) _Pragma("unroll") for (int n = 0; n < 2; ++n) \
            asm volatile("v_mfma_scale_f32_16x16x128_f8f6f4 %0, %1, %2, %0, %3, %3 op_sel_hi:[0,0,0]" : "+v"(acc[ai][bj][m][n]) : "v"(Bt##8[n]), "v"(At##8[m]), "v"(sc127));     \
            } \
        else { _Pragma("unroll") for (int m = 0; m < 4; ++m) _Pragma("unroll") for (int n = 0; n < 2; ++n) _Pragma("unroll") for (int k = 0; k < 2; ++k) \
            acc[ai][bj][m][n] = __builtin_amdgcn_mfma_f32_16x16x32_bf16(Bt[n][k], At[m][k], acc[ai][bj][m][n], 0, 0, 0); } \
        __builtin_amdgcn_s_setprio(0); } while (0)
#define PG8_WAIT_V(n) asm volatile("s_waitcnt vmcnt(" #n ")" ::: "memory")
#define PG8_WAIT_L(n) asm volatile("s_waitcnt lgkmcnt(" #n ")" ::: "memory")
#define PG8_BAR __builtin_amdgcn_s_barrier()
#define PG8_SCHED __builtin_amdgcn_sched_barrier(0)
    Unit cur, nxt; int ui = 0;
    if (!S.next(0, cur)) return;
    f32x4 acc[2][2][4][2];
#pragma unroll
    for (int a = 0; a < 2; ++a)
#pragma unroll
        for (int b = 0; b < 2; ++b)
#pragma unroll
            for (int m = 0; m < 4; ++m)
#pragma unroll
                for (int n = 0; n < 2; ++n) acc[a][b][m][n] = (f32x4){0.f, 0.f, 0.f, 0.f};
    bf16x8 At[4][2], B0[2][2], B1[2][2]; i32x8 At8[4], B08[2], B18[2];
    int sc127 = 127; asm volatile("" : "+v"(sc127));
    const char* cA = (const char*)g.A + (size_t)cur.pm * tstep; const char* cB = (const char*)g.Bt + (size_t)cur.pn * tstep;
    S.a_ready(cur);
    if constexpr (SP2) {
        PG8_STAGE(PG8_SB(0, 0), cB, voffB); PG8_STAGE(PG8_SB(0, 1), cB + hstep, voffB); PG8_STAGE(PG8_SA(0, 0), cA, voffA); PG8_STAGE(PG8_SA(0, 1), cA + hstep, voffA);
        if (wr == 1) PG8_BAR;
        PG8_WAIT_V(2); PG8_BAR;
        PG8_STAGE(PG8_SB(1, 0), cB + kstep, voffB); PG8_STAGE(PG8_SA(1, 0), cA + kstep, voffA); PG8_STAGE(PG8_SB(1, 1), cB + hstep + kstep, voffB);
        PG8_WAIT_V(6); PG8_BAR;
    } else {
        PG8_STAGE(PG8_SB(0, 0), cB, voffB); PG8_STAGE(PG8_SA(0, 0), cA, voffA); PG8_STAGE(PG8_SB(0, 1), cB + hstep, voffB); PG8_STAGE(PG8_SA(0, 1), cA + hstep, voffA);
        if (wr == 1) PG8_BAR;
        PG8_WAIT_V(4); PG8_BAR;
        PG8_STAGE(PG8_SB(1, 0), cB + kstep, voffB); PG8_STAGE(PG8_SA(1, 0), cA + kstep, voffA); PG8_STAGE(PG8_SB(1, 1), cB + hstep + kstep, voffB);
        PG8_WAIT_V(6); PG8_BAR;
    }
    for (;;) {
        const bool has_next = S.next(ui + 1, nxt);
        const char* nA = has_next ? (const char*)g.A + (size_t)nxt.pm * tstep : cA; const char* nB = has_next ? (const char*)g.Bt + (size_t)nxt.pn * tstep : cB;
        for (int t = 0; t < nt; t += 2) {
            if constexpr (Epi::HAS_MID) { if (t == Epi::MID_T) E.mid(acc, cur, wr, wc, fr, fq); }
            const bool last = (t == nt - 2);
            const char* a1 = cA + (size_t)(t + 1) * kstep;
            const char* a2 = last ? nA : cA + (size_t)(t + 2) * kstep; const char* b2 = last ? nB : cB + (size_t)(t + 2) * kstep;
            const char* a3 = a2 + kstep; const char* b3 = b2 + kstep;
            if (last && has_next) S.a_ready(nxt);
            if constexpr (SP2) {
            PG8_LDB(B0, 0, 0); PG8_LDB(B1, 0, 1); PG8_SCHED; PG8_LDA(At, 0, 0); PG8_STAGE(PG8_SA(1, 1), a1 + hstep, voffA);
            PG8_WAIT_V(8); PG8_WAIT_L(0); PG8_BAR; PG8_MMA(0, 0, At, B0); PG8_MMA(0, 1, At, B1); PG8_BAR; PG8_SCHED;
            PG8_LDA(At, 0, 1); PG8_STAGE(PG8_SB(0, 0), b2, voffB); PG8_STAGE(PG8_SB(0, 1), b2 + hstep, voffB); PG8_STAGE(PG8_SA(0, 0), a2, voffA);
            PG8_WAIT_V(8); PG8_WAIT_L(0); PG8_BAR; PG8_MMA(1, 0, At, B0); PG8_MMA(1, 1, At, B1); PG8_BAR; PG8_SCHED;
            PG8_LDB(B0, 1, 0); PG8_LDB(B1, 1, 1); PG8_SCHED; PG8_LDA(At, 1, 0); PG8_STAGE(PG8_SA(0, 1), a2 + hstep, voffA);
            PG8_WAIT_V(8); PG8_WAIT_L(0); PG8_BAR; PG8_MMA(0, 0, At, B0); PG8_MMA(0, 1, At, B1); PG8_BAR; PG8_SCHED;
            PG8_LDA(At, 1, 1); PG8_STAGE(PG8_SB(1, 0), b3, voffB); PG8_STAGE(PG8_SB(1, 1), b3 + hstep, voffB); PG8_STAGE(PG8_SA(1, 0), a3, voffA);
            PG8_WAIT_V(8); PG8_WAIT_L(0); PG8_BAR; PG8_MMA(1, 0, At, B0); PG8_MMA(1, 1, At, B1); PG8_BAR; PG8_SCHED;
            } else {
            PG8_LDB(B0, 0, 0); PG8_SCHED; PG8_LDA(At, 0, 0); PG8_STAGE(PG8_SA(1, 1), a1 + hstep, voffA);
            PG8_WAIT_L(8); PG8_BAR; PG8_WAIT_L(0); PG8_MMA(0, 0, At, B0); PG8_BAR; PG8_SCHED;
            PG8_LDB(B1, 0, 1); PG8_STAGE(PG8_SB(0, 0), b2, voffB);
            PG8_BAR; PG8_WAIT_L(0); PG8_MMA(0, 1, At, B1); PG8_BAR;
            PG8_LDA(At, 0, 1); PG8_STAGE(PG8_SA(0, 0), a2, voffA);
            PG8_BAR; PG8_WAIT_L(0); PG8_MMA(1, 0, At, B0); PG8_BAR; PG8_SCHED;
            PG8_STAGE(PG8_SB(0, 1), b2 + hstep, voffB);
            PG8_WAIT_V(6); PG8_BAR; PG8_MMA(1, 1, At, B1); PG8_BAR;
            PG8_LDB(B0, 1, 0); PG8_SCHED; PG8_LDA(At, 1, 0); PG8_STAGE(PG8_SA(0, 1), a2 + hstep, voffA);
            PG8_WAIT_L(8); PG8_BAR; PG8_WAIT_L(0); PG8_MMA(0, 0, At, B0); PG8_BAR; PG8_SCHED;
            PG8_LDB(B1, 1, 1); PG8_STAGE(PG8_SB(1, 0), b3, voffB);
            PG8_BAR; PG8_WAIT_L(0); PG8_MMA(0, 1, At, B1); PG8_BAR;
            PG8_LDA(At, 1, 1); PG8_STAGE(PG8_SA(1, 0), a3, voffA);
            PG8_BAR; PG8_WAIT_L(0); PG8_MMA(1, 0, At, B0); PG8_BAR; PG8_SCHED;
            PG8_STAGE(PG8_SB(1, 1), b3 + hstep, voffB);
            PG8_WAIT_V(6); PG8_BAR; PG8_MMA(1, 1, At, B1); PG8_BAR;
            }
        }
        if constexpr (FP8) asm volatile("s_nop 15\n\ts_nop 15" ::: "memory");
        if constexpr (ALIGN_EPI) { if (wr == 0) PG8_BAR; }
        if constexpr (!Epi::AFTER_DRAIN) { E(acc, cur, wr, wc, fr, fq); S.done(cur); }
        if (!has_next) break;
#pragma unroll
        for (int a = 0; a < 2; ++a)
#pragma unroll
            for (int b = 0; b < 2; ++b)
#pragma unroll
                for (int m = 0; m < 4; ++m)
#pragma unroll
                    for (int n = 0; n < 2; ++n) acc[a][b][m][n] = (f32x4){0.f, 0.f, 0.f, 0.f};
        cur = nxt; cA = nA; cB = nB; ++ui;
        if constexpr (ALIGN_EPI) { if (wr == 1) PG8_BAR; }
    }
    PG8_WAIT_V(0);
    if constexpr (!ALIGN_EPI) { if (wr == 0) PG8_BAR; }
    PG8_BAR;
    if constexpr (Epi::AFTER_DRAIN) { E.fused(acc, cur, wr, wc, fr, fq, lds, wid, lane); S.done(cur); }
#undef PG8_SA
#undef PG8_SB
#undef PG8_STAGE
#undef PG8_LDA
#undef PG8_LD8
#undef PG8_LDB
#undef PG8_MMA
#undef PG8_WAIT_V
#undef PG8_WAIT_L
#undef PG8_BAR
#undef PG8_SCHED
}
}


namespace att {
#define ALAS __attribute__((address_space(3)))
typedef unsigned short bf16;
typedef short bf16x8 __attribute__((ext_vector_type(8)));
typedef short s16x4 __attribute__((ext_vector_type(4)));
typedef float f32x16 __attribute__((ext_vector_type(16)));
typedef float f32x4 __attribute__((ext_vector_type(4)));
typedef float f32x2 __attribute__((ext_vector_type(2)));
typedef unsigned u32x4 __attribute__((ext_vector_type(4)));
typedef __bf16 bf16x2_t __attribute__((ext_vector_type(2)));
constexpr int SEQ = 4096;
constexpr int VPITCH = 144;
constexpr float LOG2E = 1.4426950408889634f, LN2 = 0.6931471805599453f;
__device__ __forceinline__ unsigned pkbf(float lo, float hi) { f32x2 v = {lo, hi}; bf16x2_t b = __builtin_convertvector(v, bf16x2_t); return __builtin_bit_cast(unsigned, b); }
__device__ __forceinline__ void wave_lds_sync() { asm volatile("s_waitcnt lgkmcnt(0)" ::: "memory"); }
__device__ __forceinline__ s16x4 vtr(const ALAS unsigned char* p) { return __builtin_bit_cast(s16x4, __builtin_amdgcn_ds_read_tr16_b64_v4i16((ALAS s16x4*)p)); }
__device__ __forceinline__ int crow(int r, int hi) { return (r & 3) + 8 * (r >> 2) + 4 * hi; }

__device__ __forceinline__ void pv_tile(f32x16& o0, f32x16& o1, const float (&a)[16], const ALAS unsigned char* vt, int lane) {
    const int g = lane >> 4, i = lane & 15, q_ = i >> 2, p_ = i & 3, h = lane >> 5;
    const ALAS unsigned char* vb = vt + (8 * h + q_) * VPITCH + (16 * (g & 1) + 4 * p_) * 2;
    u32x4 pw0, pw1;
    pw0.x = pkbf(a[0], a[1]); pw0.y = pkbf(a[2], a[3]); pw0.z = pkbf(a[4], a[5]); pw0.w = pkbf(a[6], a[7]);
    pw1.x = pkbf(a[8], a[9]); pw1.y = pkbf(a[10], a[11]); pw1.z = pkbf(a[12], a[13]); pw1.w = pkbf(a[14], a[15]);
    const bf16x8 pa0 = __builtin_bit_cast(bf16x8, pw0), pa1 = __builtin_bit_cast(bf16x8, pw1);
#pragma unroll
    for (int s = 0; s < 2; ++s) {
        const s16x4 l0 = vtr(vb + (16 * s) * VPITCH), h0 = vtr(vb + (16 * s + 4) * VPITCH);
        const s16x4 l1 = vtr(vb + (16 * s) * VPITCH + 64), h1 = vtr(vb + (16 * s + 4) * VPITCH + 64);
        const bf16x8 v0 = (bf16x8){l0[0], l0[1], l0[2], l0[3], h0[0], h0[1], h0[2], h0[3]};
        const bf16x8 v1 = (bf16x8){l1[0], l1[1], l1[2], l1[3], h1[0], h1[1], h1[2], h1[3]};
        o0 = __builtin_amdgcn_mfma_f32_32x32x16_bf16(s ? pa1 : pa0, v0, o0, 0, 0, 0);
        o1 = __builtin_amdgcn_mfma_f32_32x32x16_bf16(s ? pa1 : pa0, v1, o1, 0, 0, 0);
    }
}
__device__ __forceinline__ void bcast_rows(float v, ALAS float* sc, int r32, int hi, float (&out)[16]) {
    if (hi == 0) sc[r32] = v;
    wave_lds_sync();
#pragma unroll
    for (int g = 0; g < 4; ++g) { const f32x4 t = *(const ALAS f32x4*)(sc + 8 * g + 4 * hi); out[4 * g] = t[0]; out[4 * g + 1] = t[1]; out[4 * g + 2] = t[2]; out[4 * g + 3] = t[3]; }
    wave_lds_sync();
}
__device__ __forceinline__ void store_o(const f32x16& o0, const f32x16& o1, ALAS unsigned char* stg, bf16* dst  , size_t rstride_elems, int lane) {
    const int r32 = lane & 31, hi = lane >> 5;
    wave_lds_sync();
#pragma unroll
    for (int r = 0; r < 16; ++r) { const int q = crow(r, hi);
        *(ALAS unsigned short*)(stg + q * VPITCH + r32 * 2) = (unsigned short)(pkbf(o0[r], 0.f) & 0xffffu);
        *(ALAS unsigned short*)(stg + q * VPITCH + 64 + r32 * 2) = (unsigned short)(pkbf(o1[r], 0.f) & 0xffffu); }
    wave_lds_sync();
#pragma unroll
    for (int i = 0; i < 4; ++i) { const int row = 8 * i + (lane >> 3), ch = lane & 7; const u32x4 v = *(const ALAS u32x4*)(stg + row * VPITCH + ch * 16); *(u32x4*)(dst + (size_t)row * rstride_elems + ch * 8) = v; }
    wave_lds_sync();
}

__device__ __forceinline__ void sb_item(const bf16* QS, const bf16* KS, const bf16* VS, bf16* OC, int b, int h, int qt, ALAS unsigned char* wl, int lane) {
    const int r32 = lane & 31, hi = lane >> 5;
    const int t0 = qt * 32; const size_t rowb = (size_t)b * SEQ;
    const int kperm = (r32 & ~12) | ((r32 & 4) << 1) | ((r32 & 8) >> 1);
    bf16x8 qf[4];
    { const bf16* qp = QS + (rowb + t0 + r32) * 512 + h * 64 + hi * 8;
#pragma unroll
      for (int d0 = 0; d0 < 4; ++d0) qf[d0] = *(const bf16x8*)(qp + d0 * 16); }
    f32x16 o0 = {}, o1 = {}; float R = 0.f;
    for (int key0 = t0; key0 >= 0; key0 -= 32) {
        const bf16* kp = KS + (rowb + key0 + kperm) * 512 + h * 64 + hi * 8;
        bf16x8 kf[4];
#pragma unroll
        for (int d0 = 0; d0 < 4; ++d0) kf[d0] = *(const bf16x8*)(kp + d0 * 16);
        u32x4 vv[4];
#pragma unroll
        for (int i = 0; i < 4; ++i) vv[i] = *(const u32x4*)(VS + (rowb + key0 + 8 * i + (lane >> 3)) * 512 + h * 64 + (lane & 7) * 8);
        f32x16 p = {};
#pragma unroll
        for (int d0 = 0; d0 < 4; ++d0) p = __builtin_amdgcn_mfma_f32_32x32x16_bf16(kf[d0], qf[d0], p, 0, 0, 0);
#pragma unroll
        for (int i = 0; i < 4; ++i) *(ALAS u32x4*)(wl + (8 * i + (lane >> 3)) * VPITCH + (lane & 7) * 16) = vv[i];
        const bool diag = (key0 == t0);
        float z2[16], L2[16];
#pragma unroll
        for (int r = 0; r < 16; ++r) { const int kk = (r & 7) + 8 * hi + 16 * (r >> 3); const float zz = p[r];
            const float sp = fmaxf(zz, 0.f) + __builtin_amdgcn_logf(1.0f + __builtin_amdgcn_exp2f(-fabsf(zz)));
            const bool valid = !diag || (kk < r32); z2[r] = zz; L2[r] = valid ? sp : 0.f; }
        float c[16];
        c[15] = L2[15];
#pragma unroll
        for (int r = 14; r >= 8; --r) c[r] = c[r + 1] + L2[r];
        c[7] = L2[7];
#pragma unroll
        for (int r = 6; r >= 0; --r) c[r] = c[r + 1] + L2[r];
        const float TB = c[8], TA = c[0];
        const float TBo = __shfl_xor(TB, 32), TAo = __shfl_xor(TA, 32);
        const float offB = R + (hi ? 0.f : TBo);
        const float offA = R + TB + TBo + (hi ? 0.f : TAo);
        float a[16];
#pragma unroll
        for (int r = 0; r < 16; ++r) { const int kk = (r & 7) + 8 * hi + 16 * (r >> 3); const bool valid = !diag || (kk < r32);
            const float e = __builtin_amdgcn_exp2f(z2[r] - (c[r] + (r < 8 ? offA : offB))); a[r] = valid ? e : 0.f; }
        R += (TA + TB) + (TAo + TBo);
        wave_lds_sync();
        pv_tile(o0, o1, a, wl, lane);
        wave_lds_sync();
        if (__all(R > 40.0f * LOG2E)) break;
    }
    store_o(o0, o1, wl, OC + (rowb + t0) * 768 + h * 64, 768, lane);
}

constexpr int DLU_WAVE = 5120;
constexpr int DLU_O = 8 * DLU_WAVE, DLU_M = DLU_O + 512 * 128, DLU_L = DLU_M + 2048, DLU_BYTES = DLU_L + 2048;
__device__ __forceinline__ void dl_unit(const bf16* QD, const bf16* KD, const bf16* VD, bf16* OC, int b, int j, int blk, ALAS unsigned char* lds, int wave, int lane) {
    const int r32 = lane & 31, hi = lane >> 5;
    const size_t rowb = (size_t)b * SEQ;
    const int t0 = 512 * blk;
    const int kperm = (r32 & ~12) | ((r32 & 4) << 1) | ((r32 & 8) >> 1);
    ALAS unsigned char* wl = lds + wave * DLU_WAVE;
    ALAS float* sc = (ALAS float*)(wl + 4608);
    ALAS unsigned short* OL = (ALAS unsigned short*)(lds + DLU_O);
    ALAS float* ML = (ALAS float*)(lds + DLU_M); ALAS float* LL = (ALAS float*)(lds + DLU_L);
    for (int g = 2; g >= 0; --g) {
        const int hh = 4 * g + j, sh = 2 * g, r = 1 << sh;
        const float slope2 = __builtin_amdgcn_exp2f(-8.0f * (float)(hh + 1) / 12.0f) * LOG2E;
        const float sr = slope2 * (float)r;
        for (int it = wave; it < 16; it += 8) {
            const int q0 = g == 2 ? it : g == 1 ? (it & 3) + 128 * (it >> 2) : 32 * it;
            const int tq = t0 + q0 + r * r32, tmax = t0 + q0 + 31 * r;
            bf16x8 qf[4];
            { const bf16* qp = QD + (rowb + tq) * 768 + hh * 64 + hi * 8;
#pragma unroll
              for (int d0 = 0; d0 < 4; ++d0) qf[d0] = *(const bf16x8*)(qp + d0 * 16); }
            const int klo = 31 - r32; int khi = klo + 128; { const int kmaxtok = tmax >> sh; khi = khi < kmaxtok ? khi : kmaxtok; }
            const unsigned krange = (unsigned)(khi - klo);
            f32x16 o0 = {}, o1 = {}; float mrun = -3.0e38f, lrun = 0.f;
            if (g != 2) {
                mrun = ML[q0 + r * r32]; lrun = hi ? 0.f : LL[q0 + r * r32];
#pragma unroll
                for (int q = 0; q < 16; ++q) { const int tl = q0 + r * crow(q, hi);
                    o0[q] = __uint_as_float((unsigned)OL[tl * 64 + r32] << 16); o1[q] = __uint_as_float((unsigned)OL[tl * 64 + 32 + r32] << 16); }
            }
            for (int kt = 0; kt < 5; ++kt) {
                int sk = tmax - r * (32 * kt + kperm); sk = sk < 0 ? 0 : sk;
                const bf16* kp = KD + (rowb + sk) * 768 + hh * 64 + hi * 8;
                bf16x8 kf[4];
#pragma unroll
                for (int d0 = 0; d0 < 4; ++d0) kf[d0] = *(const bf16x8*)(kp + d0 * 16);
                u32x4 vv[4];
#pragma unroll
                for (int i = 0; i < 4; ++i) { int sv = tmax - r * (32 * kt + 8 * i + (lane >> 3)); sv = sv < 0 ? 0 : sv; vv[i] = *(const u32x4*)(VD + (rowb + sv) * 768 + hh * 64 + (lane & 7) * 8); }
                const int dk = 32 * kt + 8 * hi - klo;
                const float tb = -sr * (float)dk;
                f32x16 p;
#pragma unroll
                for (int q = 0; q < 16; ++q) p[q] = tb - sr * (float)((q & 7) + 16 * (q >> 3));
#pragma unroll
                for (int d0 = 0; d0 < 4; ++d0) p = __builtin_amdgcn_mfma_f32_32x32x16_bf16(kf[d0], qf[d0], p, 0, 0, 0);
#pragma unroll
                for (int i = 0; i < 4; ++i) *(ALAS u32x4*)(wl + (8 * i + (lane >> 3)) * VPITCH + (lane & 7) * 16) = vv[i];
                float z2[16]; float mt = -3.0e38f;
#pragma unroll
                for (int q = 0; q < 16; ++q) { const bool valid = (unsigned)(dk + ((q & 7) + 16 * (q >> 3))) <= krange; z2[q] = valid ? p[q] : -INFINITY; mt = fmaxf(mt, z2[q]); }
                mt = fmaxf(mt, __shfl_xor(mt, 32));
                if (__any(mt > mrun + 8.0f)) {
                    const float mnew = fmaxf(mrun, mt); const float alpha = __builtin_amdgcn_exp2f(mrun - mnew);
                    lrun *= alpha; float al[16]; bcast_rows(alpha, sc, r32, hi, al);
#pragma unroll
                    for (int q = 0; q < 16; ++q) { o0[q] *= al[q]; o1[q] *= al[q]; }
                    mrun = mnew;
                }
                float a[16]; float ls = 0.f;
#pragma unroll
                for (int q = 0; q < 16; ++q) { a[q] = __builtin_amdgcn_exp2f(z2[q] - mrun); ls += a[q]; }
                lrun += ls;
                wave_lds_sync();
                pv_tile(o0, o1, a, wl, lane);
                wave_lds_sync();
            }
            const float ltot = lrun + __shfl_xor(lrun, 32);
            if (g != 0) {
                if (hi == 0) { ML[q0 + r * r32] = mrun; LL[q0 + r * r32] = ltot; }
#pragma unroll
                for (int q = 0; q < 16; ++q) { const int tl = q0 + r * crow(q, hi);
                    OL[tl * 64 + r32] = (unsigned short)(pkbf(o0[q], 0.f) & 0xffffu); OL[tl * 64 + 32 + r32] = (unsigned short)(pkbf(o1[q], 0.f) & 0xffffu); }
            } else {
                float il[16]; bcast_rows(1.0f / ltot, sc, r32, hi, il);
#pragma unroll
                for (int q = 0; q < 16; ++q) { o0[q] *= il[q]; o1[q] *= il[q]; }
                store_o(o0, o1, wl, OC + (rowb + t0 + q0) * 768 + 512 + j * 64, 768, lane);
            }
        }
        asm volatile("s_waitcnt lgkmcnt(0)" ::: "memory"); __builtin_amdgcn_s_barrier(); asm volatile("" ::: "memory");
    }
}
#undef ALAS
}

constexpr int NWAVES = 8;
#ifndef MK_N_LAUNCHES
#define MK_N_LAUNCHES 1
#endif
#ifndef MK_LAST_PHASE
#define MK_LAST_PHASE 8
#endif
constexpr int N_LAUNCHES = MK_N_LAUNCHES;
constexpr int PER_PHASE = 8;

constexpr int BATCH = 16, SEQ = 4096, D = 1024, T = BATCH * SEQ;
constexpr int N1 = 5888;
constexpr int NEXP = 16384;
constexpr size_t MiB = 1u << 20;
constexpr size_t WS_CTL = 0, CTL_ZERO_BYTES = 1 * MiB;
constexpr size_t WS_WIN = 2 * MiB;
constexpr size_t WS_WCAT = 16 * MiB;
constexpr size_t WS_WOUT = 18 * MiB;
constexpr size_t WS_WC = 20 * MiB;
constexpr size_t WS_RINV1 = 24 * MiB;
constexpr size_t WS_RINV2 = 25 * MiB;
constexpr size_t WS_USC = 25 * MiB + 512 * 1024, WS_VSC = 25 * MiB + 768 * 1024;
constexpr size_t WS_SSQ = 26 * MiB;
constexpr size_t WS_U8 = 32 * MiB;
constexpr size_t WS_V8 = 64 * MiB;
constexpr size_t WS_IDS = 96 * MiB;
constexpr size_t WS_GW = 112 * MiB;
constexpr size_t WS_XB = 144 * MiB;
constexpr size_t WS_QS = 272 * MiB, WS_KS = 336 * MiB, WS_VS = 400 * MiB;
constexpr size_t WS_QD = 464 * MiB, WS_KD = 560 * MiB, WS_VD = 656 * MiB;
constexpr size_t WS_GT = 752 * MiB;
constexpr size_t WS_COEF = 272 * MiB;
constexpr size_t WS_MIX = 272 * MiB;
constexpr size_t WS_X1B = 400 * MiB;
constexpr size_t WS_HQ = 528 * MiB;
constexpr size_t WS_HS2 = 24 * MiB + 512 * 1024;
constexpr size_t WS_XB8 = 72 * MiB;
constexpr size_t WS_WG8 = 40 * MiB;
constexpr size_t WS_GCS = 45 * MiB;
constexpr size_t WS_END = 1008 * MiB;
constexpr int CW_BAR = 4096;
constexpr int CW_GMAX = 16384;
constexpr int CW_XRANK = 8192;

constexpr int RING_OFF = 0, RING_BYTES = 131072;
constexpr int LDSCTL_OFF = 143360, MISC_OFF = LDSCTL_OFF + 320;
constexpr int LDS_BYTES = 147456;
static_assert(MISC_OFF + 128 <= LDS_BYTES, "LDS map");
#define GAS __attribute__((address_space(1)))
#define LAS __attribute__((address_space(3)))
typedef unsigned short bf16;
typedef unsigned v4u __attribute__((ext_vector_type(4)));
typedef float f32x4 __attribute__((ext_vector_type(4)));
typedef short bf16x8 __attribute__((ext_vector_type(8)));
typedef GAS unsigned gu32;
typedef GAS unsigned long long gu64;
#define RLX_AGENT __ATOMIC_RELAXED, __HIP_MEMORY_SCOPE_AGENT
#define LDS_WAIT() asm volatile("s_waitcnt lgkmcnt(0)" ::: "memory")
#define VM_WAIT() asm volatile("s_waitcnt vmcnt(0)" ::: "memory")
__device__ __forceinline__ unsigned long long rt() { return __builtin_amdgcn_s_memrealtime(); }
__device__ __forceinline__ unsigned f2bf(float f) { unsigned u = __builtin_bit_cast(unsigned, f); return (u + 0x7fffu + ((u >> 16) & 1u)) >> 16; }
__device__ __forceinline__ unsigned pk2(float lo, float hi) { return f2bf(lo) | (f2bf(hi) << 16); }

#define XB_TMO      128
#define XB_XCNT(j)  (256  + 64 * (j))
#define XB_XSUB(j)  (1280 + 64 * (j))
#define XB_XGEN(j)  (2304 + 64 * (j))
#define XB_TOP      3328
#define XB_TOPGEN   3392
#define XCD_BAR_WORDS 3456
#define XB_SPIN_CAP (1u << 18)

__device__ __forceinline__ unsigned xb_ld(unsigned* p)              { return __hip_atomic_load(p, __ATOMIC_RELAXED, __HIP_MEMORY_SCOPE_AGENT); }
__device__ __forceinline__ unsigned xb_add(unsigned* p, unsigned v) { return __hip_atomic_fetch_add(p, v, __ATOMIC_RELAXED, __HIP_MEMORY_SCOPE_AGENT); }
__device__ __forceinline__ unsigned xb_xcc_id() { return (unsigned)__builtin_amdgcn_s_getreg((3 << 11) | 20) & 0xFu; }
#define XB_SPIN(cond, bar) do { unsigned _sp = 0; while (cond) { __builtin_amdgcn_s_sleep(1); \
    if ((++_sp & 255u) == 0u) { if (xb_ld(&(bar)[XB_TMO])) break; if (_sp > XB_SPIN_CAP) { atomicAdd(&(bar)[XB_TMO], 1u); break; } } } } while (0)

struct XcdBarrier {
    unsigned* bar; unsigned x;
    volatile LAS unsigned* st;
};

__device__ __forceinline__ XcdBarrier xcd_barrier_post(unsigned* bar, volatile LAS unsigned* st) {
    XcdBarrier b; b.bar = bar; b.x = xb_xcc_id(); b.st = st;
    if (threadIdx.x == 0) (void)xb_add(&bar[XB_XCNT(b.x)], 1u);
    return b;
}
__device__ __forceinline__ void xcd_barrier_complete(unsigned* bar, unsigned x, unsigned& nloc, unsigned& nx) {
    const unsigned G = gridDim.x * gridDim.y * gridDim.z;
    unsigned sum, cnt, mine, sp = 0u;
    for (;;) {
        sum = 0u; cnt = 0u; mine = 0u;
#pragma unroll
        for (unsigned j = 0; j < 16; ++j) { const unsigned c = xb_ld(&bar[XB_XCNT(j)]); sum += c; cnt += (c > 0u) ? 1u : 0u; mine = (j == x) ? c : mine; }
        if (sum == G) break;
        __builtin_amdgcn_s_sleep(1);
        if ((++sp & 255u) == 0u) { if (xb_ld(&bar[XB_TMO])) break; if (sp > XB_SPIN_CAP) { atomicAdd(&bar[XB_TMO], 1u); break; } }
    }
    nloc = mine > 0u ? mine : 1u; nx = cnt > 0u ? cnt : 1u;
}

__device__ __forceinline__ void xcd_barrier(const XcdBarrier& b) {
    asm volatile("s_waitcnt vmcnt(0)" ::: "memory");
    __syncthreads();
    if (threadIdx.x == 0) {
        unsigned* bar = b.bar;
        __builtin_amdgcn_s_waitcnt(0);
        unsigned nloc = b.st[0], nx = b.st[1];
        if (nloc == 0u) { xcd_barrier_complete(bar, b.x, nloc, nx); b.st[0] = nloc; b.st[1] = nx; }
        const unsigned old = xb_add(&bar[XB_XSUB(b.x)], 1u);
        const unsigned gen = old / nloc;
        if (old + 1u == (gen + 1u) * nloc) {
            __builtin_amdgcn_fence(__ATOMIC_RELEASE, "agent");
            asm volatile("s_waitcnt vmcnt(0)" ::: "memory");
            const unsigned og = xb_add(&bar[XB_TOP], 1u);
            const unsigned tg = og / nx;
            if (og + 1u == (tg + 1u) * nx) xb_add(&bar[XB_TOPGEN], 1u);
            else XB_SPIN(xb_ld(&bar[XB_TOPGEN]) == tg, bar);
            __builtin_amdgcn_fence(__ATOMIC_ACQUIRE, "agent");
            xb_add(&bar[XB_XGEN(b.x)], 1u);
            asm volatile("s_waitcnt vmcnt(0)" ::: "memory");
        } else {
            XB_SPIN(xb_ld(&bar[XB_XGEN(b.x)]) == gen, bar);
            __builtin_amdgcn_fence(__ATOMIC_ACQUIRE, "agent");
            asm volatile("s_waitcnt vmcnt(0)" ::: "memory");
        }
    }
    __syncthreads();
}

typedef float f32x2 __attribute__((ext_vector_type(2)));
typedef unsigned v2u __attribute__((ext_vector_type(2)));
typedef _Float16 h2_t __attribute__((ext_vector_type(2)));
struct Frame {
    LAS unsigned char* lds;
    volatile LAS unsigned* MISC;
    gu32* ctl;
    int tid, lane, wave;
    int vcu, G;
};
__device__ __forceinline__ float wave_sum(float v) {
#pragma unroll
    for (int o = 1; o < 64; o <<= 1) v += __shfl_xor(v, o);
    return v;
}
__device__ __forceinline__ float wave_max(float v) {
#pragma unroll
    for (int o = 1; o < 64; o <<= 1) v = fmaxf(v, __shfl_xor(v, o));
    return v;
}
constexpr int NB16 = 1536, N8 = 5888 - NB16;
__device__ __forceinline__ int win_row(int n) { if (n < 1536 || n >= 3072) return n; const int t = (n - 1536) >> 8, ln = (n - 1536) & 255, hl = ln >> 6, d = ln & 63; return 1536 + t * 256 + 32 * hl + (d & 31) + 128 * (d >> 5); }
__device__ __forceinline__ void p0_transpose_item(const float* W, int N, const float* gain, bf16* WT, int ldt, int koff, int mode, LAS float* scr, int item, int lane) {
    const int nblk = N / 32, kb = item / nblk, nb = item % nblk, k0 = 64 * kb, n0 = 32 * nb;
#pragma unroll 8
    for (int i = 0; i < 32; ++i) { const int kk = 2 * i + (lane >> 5); float v = W[(size_t)(k0 + kk) * N + n0 + (lane & 31)]; if (gain) v *= gain[k0 + kk]; scr[kk * 33 + (lane & 31)] = v; }
    LDS_WAIT(); asm volatile("" ::: "memory");
    const int c = lane & 7;
#pragma unroll
    for (int j = 0; j < 4; ++j) { const int n = (lane >> 3) + 8 * j; const LAS float* s = scr + (8 * c) * 33 + n;
        v4u o; o.x = pk2(s[0 * 33], s[1 * 33]); o.y = pk2(s[2 * 33], s[3 * 33]); o.z = pk2(s[4 * 33], s[5 * 33]); o.w = pk2(s[6 * 33], s[7 * 33]);
        const int rown = mode ? win_row(n0 + n) : (n0 + n);
        *(GAS v4u*)(WT + (size_t)rown * ldt + koff + k0 + 8 * c) = o; }
    LDS_WAIT(); asm volatile("" ::: "memory");
}
__device__ __forceinline__ void p0_gate_max_item(const float* W, int N, const float* gain, unsigned* gmax, int kb, int n0, int lane) {
    const int k0 = 64 * kb; float am = 0.f;
#pragma unroll 8
    for (int i = 0; i < 32; ++i) { const int kk = 2 * i + (lane >> 5); am = fmaxf(am, fabsf(W[(size_t)(k0 + kk) * N + n0 + (lane & 31)] * gain[k0 + kk])); }
    am = fmaxf(am, __shfl_xor(am, 32));
    if (lane < 32) atomicMax(gmax + (n0 - NB16) + lane, __float_as_uint(am));
}
__device__ __forceinline__ void p0_gate_fp8_item(const float* W, int N, const float* gain, const unsigned* gmax, unsigned char* WG, float* cs, LAS float* scr, int item, int lane) {
    const int kb = item / (N8 / 32), nb = item % (N8 / 32), k0 = 64 * kb, n0 = 32 * nb;
#pragma unroll 8
    for (int i = 0; i < 32; ++i) { const int kk = 2 * i + (lane >> 5); scr[kk * 33 + (lane & 31)] = W[(size_t)(k0 + kk) * N + NB16 + n0 + (lane & 31)] * gain[k0 + kk]; }
    LDS_WAIT(); asm volatile("" ::: "memory");
    const int c = lane & 7;
#pragma unroll
    for (int j = 0; j < 4; ++j) { const int n = (lane >> 3) + 8 * j; const LAS float* sp = scr + (8 * c) * 33 + n;
        const unsigned mb = xb_ld((unsigned*)gmax + n0 + n); const int ex = (int)((mb >> 23) & 0xffu);
        const float sc = (ex == 0) ? 1.0f : __uint_as_float((unsigned)(127 + 7 - (ex - 127)) << 23);
        int p0 = __builtin_amdgcn_cvt_pk_fp8_f32(sp[0 * 33] * sc, sp[1 * 33] * sc, 0, false); p0 = __builtin_amdgcn_cvt_pk_fp8_f32(sp[2 * 33] * sc, sp[3 * 33] * sc, p0, true);
        int p1 = __builtin_amdgcn_cvt_pk_fp8_f32(sp[4 * 33] * sc, sp[5 * 33] * sc, 0, false); p1 = __builtin_amdgcn_cvt_pk_fp8_f32(sp[6 * 33] * sc, sp[7 * 33] * sc, p1, true);
        const int prow = win_row(NB16 + n0 + n) - NB16;
        *(GAS v2u*)(WG + (size_t)prow * 1024 + k0 + 8 * c) = (v2u){(unsigned)p0, (unsigned)p1};
        if (kb == 0 && c == 0) cs[prow] = (ex == 0) ? 1.0f : __uint_as_float((unsigned)(127 - 7 + (ex - 127)) << 23); }
    LDS_WAIT(); asm volatile("" ::: "memory");
}
__device__ __forceinline__ void quant_row_fp8(const float* src, const float* gain, unsigned char* dst, size_t slice_stride, float* scale_out, int lane) {
    f32x4 v[4]; float am = 0.f;
#pragma unroll
    for (int j = 0; j < 4; ++j) { v[j] = *(const GAS f32x4*)(src + 256 * j + 4 * lane); if (gain) v[j] = v[j] * *(const GAS f32x4*)(gain + 256 * j + 4 * lane);
        am = fmaxf(am, fmaxf(fmaxf(fabsf(v[j][0]), fabsf(v[j][1])), fmaxf(fabsf(v[j][2]), fabsf(v[j][3])))); }
    am = wave_max(am);
    const int ex = (int)((__float_as_uint(am) >> 23) & 0xffu);
    const float s = (ex == 0) ? 1.0f : __uint_as_float((unsigned)(127 + 7 - (ex - 127)) << 23);
    const float is = (ex == 0) ? 1.0f : __uint_as_float((unsigned)(127 - 7 + (ex - 127)) << 23);
    if (lane == 0) *scale_out = is;
#pragma unroll
    for (int j = 0; j < 4; ++j) { int pk = __builtin_amdgcn_cvt_pk_fp8_f32(v[j][0] * s, v[j][1] * s, 0, false); pk = __builtin_amdgcn_cvt_pk_fp8_f32(v[j][2] * s, v[j][3] * s, pk, true);
        const int col = 256 * j + 4 * lane; *(GAS int*)(dst + (size_t)(col >> 7) * slice_stride + (col & 127)) = pk; }
}
__device__ __forceinline__ void quant_row_fp4(const float* src, unsigned char* dst, size_t slice_stride, float* scale_out, int lane) {
    f32x4 v[4]; float am = 0.f;
#pragma unroll
    for (int j = 0; j < 4; ++j) { v[j] = *(const GAS f32x4*)(src + 256 * j + 4 * lane); am = fmaxf(am, fmaxf(fmaxf(fabsf(v[j][0]), fabsf(v[j][1])), fmaxf(fabsf(v[j][2]), fabsf(v[j][3])))); }
    am = wave_max(am);
    const float s = am > 0.f ? 6.0f / am : 0.f;
    if (lane == 0) *scale_out = am * (1.0f / 6.0f);
#pragma unroll
    for (int j = 0; j < 4; ++j) { unsigned pk = __builtin_amdgcn_cvt_scalef32_pk_fp4_f32(0u, v[j][0] * s, v[j][1] * s, 1.0f, 0); pk = __builtin_amdgcn_cvt_scalef32_pk_fp4_f32(pk, v[j][2] * s, v[j][3] * s, 1.0f, 1);
        *(GAS unsigned short*)(dst + (size_t)j * slice_stride + 2 * lane) = (unsigned short)(pk & 0xffffu); }
}
__device__ __forceinline__ void quant_row_i4(const float* src, const float* gain, unsigned char* dst, float* scale_out, int lane) {
    f32x4 v[4]; float am = 0.f, ss = 0.f;
    const int p16 = (lane >> 2) & 15, wl = lane & 3;
#pragma unroll
    for (int ld = 0; ld < 2; ++ld)
#pragma unroll
        for (int sn = 0; sn < 2; ++sn) { const int hd = 2 * (4 * ld + wl) + sn; const int idx = 256 * (hd >> 2) + 16 * p16 + 4 * (hd & 3);
            f32x4 t = *(const GAS f32x4*)(src + idx); if (gain) t = t * *(const GAS f32x4*)(gain + idx); v[2 * ld + sn] = t;
            am = fmaxf(am, fmaxf(fmaxf(fabsf(t[0]), fabsf(t[1])), fmaxf(fabsf(t[2]), fabsf(t[3])))); ss += (t[0] * t[0] + t[1] * t[1]) + (t[2] * t[2] + t[3] * t[3]); }
    am = wave_max(am); ss = wave_sum(ss);
    const float clipv = fminf(am, 2.5f * sqrtf(ss * (1.0f / 1024.0f)));
    const float s = clipv > 0.f ? 7.0f / clipv : 0.f;
    if (lane == 0) *scale_out = clipv * (1.0f / (7.0f * 16.0f));
#pragma unroll
    for (int ld = 0; ld < 2; ++ld) { unsigned pk = 0u;
#pragma unroll
        for (int b4 = 0; b4 < 4; ++b4) { int q0 = (int)__builtin_rintf(v[2 * ld][b4] * s), q1 = (int)__builtin_rintf(v[2 * ld + 1][b4] * s);
            q0 = q0 < -7 ? -7 : (q0 > 7 ? 7 : q0); q1 = q1 < -7 ? -7 : (q1 > 7 ? 7 : q1);
            pk |= ((unsigned)(q0 & 15) | ((unsigned)(q1 & 15) << 4)) << (8 * b4); }
        *(GAS unsigned*)(dst + ld * 256 + 16 * p16 + 4 * wl) = pk; }
}
__device__ __forceinline__ float gelu_f(float v) {
    const float av = fabsf(v), t = __builtin_amdgcn_rcpf(av * 0.2316418882f + 1.0f);
    float q = t * 0.5307027145f + (-0.7265760135f); q = q * t + 0.7107068705f; q = q * t + (-0.142248368f); q = q * t + 0.127414796f; q = q * t;
    const float e = __builtin_amdgcn_exp2f((v * v) * (-0.72134752044f));
    const float m = v * (q * e);
    return v < 0.f ? m : v - m;
}

struct Args { const float* in[14]; float* out; unsigned char* ws; int ph_lo, ph_hi, li, pad; };
__global__ void __launch_bounds__(NWAVES * 64, 2) fwd_kernel(Args args) {
    extern __shared__ __attribute__((aligned(16))) unsigned char lds[];
    Frame F;
    F.lds = (LAS unsigned char*)lds;
    F.MISC = (volatile LAS unsigned*)(F.lds + MISC_OFF);
    F.tid = threadIdx.x; F.lane = F.tid & 63; F.wave = __builtin_amdgcn_readfirstlane(F.tid >> 6);
    F.G = gridDim.x; { const int bx = blockIdx.x; F.vcu = (F.G % 8 == 0) ? (bx % 8) * (F.G / 8) + bx / 8 : bx; }
    unsigned char* ws = args.ws;
    F.ctl = (gu32*)(ws + WS_CTL);
    const float* x = args.in[0]; const float* norm1_gain = args.in[1]; const float* w_in = args.in[2]; const float* b_gate = args.in[3];
    const float* q_gain = args.in[4]; const float* k_gain = args.in[5]; const float* w_sb_out = args.in[6]; const float* w_dil_out = args.in[7];
    const float* w_out = args.in[8]; const float* norm2_gain = args.in[9]; const float* w_peer_q = args.in[10]; const float* sub_keys = args.in[11];
    const float* peer_u = args.in[12]; const float* peer_v = args.in[13];
    float* out = args.out;
    bf16* WIN = (bf16*)(ws + WS_WIN); bf16* WCAT = (bf16*)(ws + WS_WCAT); bf16* WOUT = (bf16*)(ws + WS_WOUT); bf16* WC = (bf16*)(ws + WS_WC);
    float* RINV1 = (float*)(ws + WS_RINV1); float* RINV2 = (float*)(ws + WS_RINV2); float* USC = (float*)(ws + WS_USC); float* VSC = (float*)(ws + WS_VSC); float* SSQ = (float*)(ws + WS_SSQ);
    unsigned char* U8 = ws + WS_U8; unsigned char* V8 = ws + WS_V8;
    unsigned short* IDS = (unsigned short*)(ws + WS_IDS); float* GW = (float*)(ws + WS_GW); float* COEF = (float*)(ws + WS_COEF); unsigned char* HQ = ws + WS_HQ; float* HS2 = (float*)(ws + WS_HS2);
    bf16* XB = (bf16*)(ws + WS_XB); bf16* OC = (bf16*)(ws + WS_XB); unsigned char* XB8 = ws + WS_XB8; unsigned char* WG8 = ws + WS_WG8; float* GCS = (float*)(ws + WS_GCS);
    bf16* QS = (bf16*)(ws + WS_QS); bf16* KS = (bf16*)(ws + WS_KS); bf16* VS = (bf16*)(ws + WS_VS);
    bf16* QD = (bf16*)(ws + WS_QD); bf16* KD = (bf16*)(ws + WS_KD); bf16* VD = (bf16*)(ws + WS_VD);
    bf16* GT = (bf16*)(ws + WS_GT); bf16* MIX = (bf16*)(ws + WS_MIX); bf16* X1B = (bf16*)(ws + WS_X1B);

    for (int u = F.tid; u < (LDS_BYTES - LDSCTL_OFF) / 4; u += NWAVES * 64) ((LAS unsigned*)(F.lds + LDSCTL_OFF))[u] = 0u;
    __syncthreads();
    const int my_xcc = (int)xb_xcc_id();
    if (F.tid == 0) F.MISC[12] = xb_add((unsigned*)(F.ctl + CW_XRANK) + 64 * my_xcc, 1u);
    __syncthreads();
    const int my_xrank = (int)F.MISC[12];
    const int bli = (N_LAUNCHES == PER_PHASE) ? 0 : args.li;
    XcdBarrier bar; bar.bar = (unsigned*)(F.ctl + CW_BAR) + bli * XCD_BAR_WORDS; bar.x = 0; bar.st = nullptr;
    if (N_LAUNCHES != PER_PHASE) bar = xcd_barrier_post((unsigned*)(F.ctl + CW_BAR) + bli * XCD_BAR_WORDS, F.MISC + 8);
    const int lo = args.ph_lo, hi = args.ph_hi;
#ifndef PHASE_MASK
#define PHASE_MASK 0xff
#endif
#define IN(k) (((PHASE_MASK >> (k)) & 1) && lo <= (k) && (k) < hi)
#define BOTH(k) (IN(k) && IN((k) + 1))
#define GRID_BAR() do { if (N_LAUNCHES != PER_PHASE) xcd_barrier(bar); } while (0)
#ifndef PROBE_REPEAT
#define PROBE_REPEAT 0x00
#endif
#ifndef PROBE_L1
#define PROBE_L1 0x0
#endif
#define REP(k) _Pragma("unroll") for (int rep_ = 0; rep_ < (((PROBE_REPEAT >> (k)) & 1) ? 2 : 1); ++rep_)
    const int gw = F.vcu * NWAVES + F.wave, NGW = F.G * NWAVES;
#define P67_MAP() int vx = (int)(blockIdx.x & 7), rk = (int)(blockIdx.x >> 3), nrk = (F.G + 7 - vx) / 8; bool p67_uni = false; \
        { bool uni_ = (F.G % 8 == 0); for (int j_ = 0; j_ < 16; ++j_) { const unsigned c_ = xb_ld((unsigned*)(F.ctl + CW_XRANK) + 64 * j_); uni_ = uni_ && (c_ == (j_ < 8 ? (unsigned)(F.G / 8) : 0u)); } \
          if (uni_) { vx = my_xcc; rk = my_xrank; nrk = F.G / 8; p67_uni = true; } }

    if (IN(0)) REP(0) {
        for (int it = F.vcu; it < 256; it += F.G) {
            const int hp = it >> 4, d0 = (it & 15) * 64;
            LAS float* As = (LAS float*)(F.lds);
            LAS float* Bs = (LAS float*)(F.lds + 64 * 132 * 4);
            for (int e = F.tid; e < 64 * 32; e += 512) { const int r = e >> 5, c4 = (e & 31) * 4; *(LAS f32x4*)(As + r * 132 + c4) = *(const GAS f32x4*)(w_peer_q + (size_t)(d0 + r) * 2048 + hp * 128 + c4); }
            for (int e = F.tid; e < 128 * 32; e += 512) { const int r = e >> 5, c4 = (e & 31) * 4; *(LAS f32x4*)(Bs + r * 132 + c4) = *(const GAS f32x4*)(sub_keys + ((size_t)hp * 128 + r) * 128 + c4); }
            __syncthreads();
            const int ddg = F.tid & 15, ng = F.tid >> 4;
            f32x4 acc[4];
#pragma unroll
            for (int j = 0; j < 4; ++j) acc[j] = (f32x4){0.f, 0.f, 0.f, 0.f};
            for (int c4 = 0; c4 < 128; c4 += 4) {
                f32x4 a[4], b[4];
#pragma unroll
                for (int i = 0; i < 4; ++i) { a[i] = *(const LAS f32x4*)(As + (4 * ddg + i) * 132 + c4); b[i] = *(const LAS f32x4*)(Bs + (4 * ng + i) * 132 + c4); }
#pragma unroll
                for (int j = 0; j < 4; ++j)
#pragma unroll
                    for (int i = 0; i < 4; ++i) acc[j][i] += (a[i][0] * b[j][0] + a[i][1] * b[j][1]) + (a[i][2] * b[j][2] + a[i][3] * b[j][3]);
            }
            const f32x4 g2 = *(const GAS f32x4*)(norm2_gain + d0 + 4 * ddg);
#pragma unroll
            for (int j = 0; j < 4; ++j) { v2u o; o.x = pk2(acc[j][0] * g2[0], acc[j][1] * g2[1]); o.y = pk2(acc[j][2] * g2[2], acc[j][3] * g2[3]);
                *(GAS v2u*)(WC + (size_t)(hp * 128 + 4 * ng + j) * 1024 + d0 + 4 * ddg) = o; }
            __syncthreads();
        }
        {
            LAS float* scr = (LAS float*)(F.lds + RING_OFF + F.wave * 16384);
            constexpr int I_IN = (D / 64) * (N1 / 32), I_SB = (512 / 64) * (D / 32), I_DL = (256 / 64) * (D / 32), I_OUT = (D / 64) * (D / 32);
            constexpr int NITEMS = I_IN + I_SB + I_DL + I_OUT;
            for (int it = gw; it < NITEMS; it += NGW) {
                int r = it;
                if (r < I_IN) { const int nb_ = r % (N1 / 32); if (nb_ >= NB16 / 32) p0_gate_max_item(w_in, N1, norm1_gain, (unsigned*)(F.ctl + CW_GMAX), r / (N1 / 32), 32 * nb_, F.lane); else p0_transpose_item(w_in, N1, norm1_gain, WIN, 1024, 0, 1, scr, r, F.lane); continue; } r -= I_IN;
                if (r < I_SB) { p0_transpose_item(w_sb_out, D, nullptr, WCAT, 768, 0, 0, scr, r, F.lane); continue; } r -= I_SB;
                if (r < I_DL) { p0_transpose_item(w_dil_out, D, nullptr, WCAT, 768, 512, 0, scr, r, F.lane); continue; } r -= I_DL;
                p0_transpose_item(w_out, D, nullptr, WOUT, 1024, 0, 0, scr, r, F.lane);
            }
        }
        for (int e = gw; e < 2 * NEXP; e += NGW) {
            if (e < NEXP) quant_row_i4(peer_u + (size_t)e * D, norm2_gain, U8 + (size_t)e * 512, USC + e, F.lane);
            else { const int ev = e - NEXP; quant_row_fp4(peer_v + (size_t)ev * D, V8 + (size_t)ev * 128, (size_t)NEXP * 128, VSC + ev, F.lane); }
        }
        for (int m = gw; m < T; m += NGW) {
            const GAS f32x4* xr = (const GAS f32x4*)(x + (size_t)m * D) + F.lane;
            f32x4 v[4]; float s = 0.f;
#pragma unroll
            for (int j = 0; j < 4; ++j) { v[j] = xr[64 * j]; s += (v[j][0] * v[j][0] + v[j][1] * v[j][1]) + (v[j][2] * v[j][2] + v[j][3] * v[j][3]); }
            s = wave_sum(s);
            const float rn = __builtin_amdgcn_rsqf(s * (1.0f / D) + 1e-6f);
            GAS unsigned long long* o8 = (GAS unsigned long long*)(XB + (size_t)m * D) + F.lane;
#pragma unroll
            for (int j = 0; j < 4; ++j) o8[64 * j] = (unsigned long long)pk2(v[j][0] * rn, v[j][1] * rn) | ((unsigned long long)pk2(v[j][2] * rn, v[j][3] * rn) << 32);
#pragma unroll
            for (int j = 0; j < 4; ++j) { int pk = __builtin_amdgcn_cvt_pk_fp8_f32(v[j][0] * rn, v[j][1] * rn, 0, false); pk = __builtin_amdgcn_cvt_pk_fp8_f32(v[j][2] * rn, v[j][3] * rn, pk, true);
                *(GAS int*)(XB8 + (size_t)m * D + 256 * j + 4 * F.lane) = pk; }
        }
        if (BOTH(0)) GRID_BAR();
    }

    if (IN(1)) REP(1) {
        { LAS float* scr = (LAS float*)(F.lds + RING_OFF + F.wave * 16384);
          for (int it = gw; it < 16 * (N8 / 32); it += NGW) p0_gate_fp8_item(w_in, N1, norm1_gain, (const unsigned*)(F.ctl + CW_GMAX), WG8, GCS, scr, it, F.lane);
          __syncthreads(); }
        { pg8::Gemm g{XB, WIN, T, NB16, D}; pg8::StaticOrder S; S.init(T, NB16, F.G, (int)blockIdx.x);
          pg8::Epi1 E{RINV1, b_gate, q_gain, k_gain, QS, KS, VS, QD, KD, VD, GT};
          pg8::gemm_phase<pg8::Epi1, pg8::StaticOrder, true, true>(F.lds + RING_OFF, g, S, E); }
        GRID_BAR();
        { pg8::Gemm g{(const bf16*)XB8, (const bf16*)WG8, T, N8, D / 2}; pg8::StaticOrder S; S.init(T, N8, F.G, (int)blockIdx.x);
          pg8::EpiG E{b_gate, GCS, q_gain, k_gain, QD, KD, VD, GT};
          pg8::gemm_phase<pg8::EpiG, pg8::StaticOrder, true, true, true>(F.lds + RING_OFF, g, S, E); }
        if (BOTH(1)) GRID_BAR();
    }

    if (IN(2)) REP(2) {
        LAS unsigned char* wl = F.lds + RING_OFF + F.wave * 16384;
        static_assert(att::DLU_BYTES <= RING_BYTES, "dilated-attention LDS state");
        for (int un = F.vcu; un < 512; un += F.G) { const int blk = un & 7, j = (un >> 3) & 3, b = un >> 5; att::dl_unit(QD, KD, VD, OC, b, j, blk, F.lds + RING_OFF, F.wave, F.lane); }
        for (int it = gw; it < 16384; it += NGW) { const int qt = 127 - (it & 127), h = (it >> 7) & 7, b = it >> 10; att::sb_item(QS, KS, VS, OC, b, h, qt, wl, F.lane); }
        if (BOTH(2)) GRID_BAR();
    }

    if (IN(3)) REP(3) {
        pg8::Gemm g{OC, WCAT, T, D, 768}; pg8::StaticOrder S; S.init(T, D, F.G, (int)blockIdx.x);
        pg8::Epi2 E{GT, MIX};
        pg8::gemm_phase<pg8::Epi2, pg8::StaticOrder, true, true>(F.lds + RING_OFF, g, S, E);
        if (BOTH(3)) GRID_BAR();
    }

    if (IN(4)) REP(4) {
        pg8::Gemm g{MIX, WOUT, T, D, D}; pg8::StaticOrder S; S.init(T, D, F.G, (int)blockIdx.x);
        pg8::Epi3 E{x, X1B, SSQ};
        pg8::gemm_phase<pg8::Epi3, pg8::StaticOrder, true, true>(F.lds + RING_OFF, g, S, E);
        if (BOTH(4)) GRID_BAR();
    }

    if (IN(5)) REP(5) {
        for (int m = gw; m < T; m += NGW) {
            const v4u a = *(const GAS v4u*)(X1B + (size_t)m * D + 8 * F.lane), b = *(const GAS v4u*)(X1B + (size_t)m * D + 512 + 8 * F.lane);
            float v[16] = {pg8::bflo(a.x), pg8::bfhi(a.x), pg8::bflo(a.y), pg8::bfhi(a.y), pg8::bflo(a.z), pg8::bfhi(a.z), pg8::bflo(a.w), pg8::bfhi(a.w),
                           pg8::bflo(b.x), pg8::bfhi(b.x), pg8::bflo(b.y), pg8::bfhi(b.y), pg8::bflo(b.z), pg8::bfhi(b.z), pg8::bflo(b.w), pg8::bfhi(b.w)};
            float am = 0.f;
#pragma unroll
            for (int i = 0; i < 16; ++i) am = fmaxf(am, fabsf(v[i]));
            am = wave_max(am);
            float sq = (F.lane < 16) ? SSQ[(size_t)m * 16 + F.lane] : 0.f; sq = wave_sum(sq);
            const float s = am > 0.f ? 127.0f / am : 0.f;
            if (F.lane == 0) HS2[m] = am * (1.0f / 127.0f) * __builtin_amdgcn_rsqf(sq * (1.0f / 1024.0f) + 1e-6f);
            int q[16];
#pragma unroll
            for (int i = 0; i < 16; ++i) q[i] = (int)__builtin_rintf(v[i] * s) & 0xff;
            v2u o0, o1; o0.x = q[0] | (q[1] << 8) | (q[2] << 16) | (q[3] << 24); o0.y = q[4] | (q[5] << 8) | (q[6] << 16) | (q[7] << 24);
            o1.x = q[8] | (q[9] << 8) | (q[10] << 16) | (q[11] << 24); o1.y = q[12] | (q[13] << 8) | (q[14] << 16) | (q[15] << 24);
            *(GAS v2u*)(HQ + (size_t)m * D + 8 * F.lane) = o0; *(GAS v2u*)(HQ + (size_t)m * D + 512 + 8 * F.lane) = o1;
        }
        pg8::Gemm g{X1B, WC, T, 2048, D}; pg8::StaticOrder S; S.init(T, 2048, F.G, (int)blockIdx.x);
        pg8::Epi4 E{SSQ, RINV2, IDS, GW};
        pg8::OneUnit O1;
        for (int i = 0; S.next(i, O1.u); ++i) pg8::gemm_phase<pg8::Epi4, pg8::OneUnit, false, true>(F.lds + RING_OFF, g, O1, E);
        if (BOTH(5)) GRID_BAR();
    }

    if (IN(6)) REP(6) {
        P67_MAP();
        const int p16 = F.lane & 15, sg = F.lane >> 4;
        LAS unsigned char* HB = F.lds + RING_OFF + F.wave * 16384;
        LAS unsigned* LIST = (LAS unsigned*)(F.lds + RING_OFF + F.wave * 16384 + 8192);
        LAS float* HSs = (LAS float*)(F.lds + RING_OFF + F.wave * 16384 + 12288);
        const int nwb = T / 8, wstep = nrk * NWAVES;
        const int gsel = (F.lane & 15), bpsrc = (16 * (F.lane & 3) + ((F.lane >> 2) & 3)) * 4;
        v4u hpre[8], idpre[2]; float hspre = 0.f;
#define P6_PRE(bb) do { const int bc_ = (bb) < nwb ? (bb) : nwb - 1; const unsigned char* hsrc_ = HQ + (size_t)bc_ * 8192; \
            _Pragma("unroll") for (int i_ = 0; i_ < 8; ++i_) hpre[i_] = *(const GAS v4u*)(hsrc_ + (size_t)(i_ * 64 + F.lane) * 16); \
            const unsigned short* isrc_ = IDS + ((size_t)bc_ * 8 + (F.lane >> 3)) * 128 + 16 * (F.lane & 7); idpre[0] = *(const GAS v4u*)isrc_; idpre[1] = *(const GAS v4u*)(isrc_ + 8); \
            hspre = HS2[(size_t)bc_ * 8 + (F.lane & 7)]; } while (0)
#define P6_ISSUE(W, ENT, EJ, GB, UB, VB, base_) do { \
                _Pragma("unroll") for (int g_ = 0; g_ < 4; ++g_) { const int j_ = (base_) + 4 * g_ + sg; ENT[g_] = LIST[j_ < n ? j_ : nm1]; } \
                { const int j_ = (base_) + gsel; EJ = (j_ < n && F.lane < 16) ? (int)LIST[j_] : -1; } \
                _Pragma("unroll") for (int g_ = 0; g_ < 4; ++g_) { const unsigned char* up_ = U8 + (size_t)((PROBE_L1 && rep_) ? 0u : (ENT[g_] & 0xffffu)) * 512 + 16 * p16; \
                    _Pragma("unroll") for (int i_ = 0; i_ < 2; ++i_) W[g_][i_] = *(const GAS v4u*)(up_ + 256 * i_); } \
                { const unsigned ej_ = EJ < 0 ? 0u : (unsigned)EJ; GB = GW[((size_t)t0 + (ej_ >> 24)) * 128 + ((ej_ >> 16) & 127u)]; UB = USC[ej_ & 0xffffu]; VB = VSC[ej_ & 0xffffu]; } } while (0)
#define P6_DPPADD(a_, ctrl) a_ += __builtin_amdgcn_update_dpp(0, a_, ctrl, 0xf, 0xf, false)
#define P6_REDUCE(W, ENT, EJ, GB, UB, VB, base_) do { if ((base_) < n) { int ag_[4]; \
                _Pragma("unroll") for (int g_ = 0; g_ < 4; ++g_) { const LAS unsigned char* hp_ = HB + (size_t)(ENT[g_] >> 24) * 1024 + 16 * p16; int a_ = 0; v4u h_[4]; \
                    _Pragma("unroll") for (int i_ = 0; i_ < 4; ++i_) h_[i_] = *(const LAS v4u*)(hp_ + 256 * i_); \
                    _Pragma("unroll") for (int ld_ = 0; ld_ < 2; ++ld_) { const unsigned x_[4] = {W[g_][ld_].x, W[g_][ld_].y, W[g_][ld_].z, W[g_][ld_].w}; \
                        _Pragma("unroll") for (int wl_ = 0; wl_ < 4; ++wl_) { const int hd_ = 2 * (4 * ld_ + wl_); const unsigned lo_ = (x_[wl_] << 4) & 0xF0F0F0F0u, hi_ = x_[wl_] & 0xF0F0F0F0u; \
                            const unsigned hA_ = (hd_ & 3) == 0 ? h_[hd_ >> 2].x : h_[hd_ >> 2].z, hB_ = (hd_ & 3) == 0 ? h_[hd_ >> 2].y : h_[hd_ >> 2].w; \
                            a_ = __builtin_amdgcn_sdot4((int)lo_, (int)hA_, a_, false); a_ = __builtin_amdgcn_sdot4((int)hi_, (int)hB_, a_, false); } } \
                    P6_DPPADD(a_, 0xB1); P6_DPPADD(a_, 0x4E); P6_DPPADD(a_, 0x141); P6_DPPADD(a_, 0x140); ag_[g_] = a_; } \
                const int sel_ = gsel == 0 ? ag_[0] : gsel == 1 ? ag_[1] : gsel == 2 ? ag_[2] : ag_[3]; \
                const float resv_ = (float)__builtin_amdgcn_ds_bpermute(bpsrc, sel_); \
                if (EJ >= 0 && !(PROBE_L1 && rep_)) { const unsigned ej_ = (unsigned)EJ; const float act_ = gelu_f(resv_ * UB * HSs[ej_ >> 24]); \
                    COEF[((size_t)t0 + (ej_ >> 24)) * 128 + ((ej_ >> 16) & 127u)] = GB * act_ * VB; } } } while (0)
        int wb = rk * NWAVES + F.wave;
        P6_PRE(wb);
        for (; wb < nwb; wb += wstep) {
            const int t0 = wb * 8;
            asm volatile("s_waitcnt lgkmcnt(0)" ::: "memory");
            if (F.lane < 8) HSs[F.lane] = hspre;
#pragma unroll
            for (int i = 0; i < 8; ++i) *(LAS v4u*)(HB + (size_t)(i * 64 + F.lane) * 16) = hpre[i];
            int n = 0;
            { const unsigned idw[8] = {idpre[0].x, idpre[0].y, idpre[0].z, idpre[0].w, idpre[1].x, idpre[1].y, idpre[1].z, idpre[1].w};
              const unsigned tl = (unsigned)(F.lane >> 3), kb0 = 16u * (unsigned)(F.lane & 7);
#pragma unroll
              for (int i = 0; i < 16; ++i) { const unsigned e = (i & 1) ? (idw[i >> 1] >> 16) : (idw[i >> 1] & 0xffffu);
                  const bool inr = ((int)(e >> 11) == vx); const unsigned long long mk = __ballot(inr);
                  const int pos = n + (int)__builtin_amdgcn_mbcnt_hi((unsigned)(mk >> 32), __builtin_amdgcn_mbcnt_lo((unsigned)mk, 0u));
                  if (inr) LIST[pos] = (tl << 24) | ((kb0 + (unsigned)i) << 16) | e;
                  n += __builtin_popcountll(mk); } }
            asm volatile("s_waitcnt lgkmcnt(0)" ::: "memory");
            P6_PRE(wb + wstep);
            const int nm1 = n > 0 ? n - 1 : 0;
            for (int base = 0; base < n; base += 32) {
                v4u wA[4][2], wB[4][2]; unsigned entA[4], entB[4]; int ejA, ejB; float gbA, ubA, vbA, gbB, ubB, vbB;
                P6_ISSUE(wA, entA, ejA, gbA, ubA, vbA, base);
                P6_ISSUE(wB, entB, ejB, gbB, ubB, vbB, base + 16);
                P6_REDUCE(wA, entA, ejA, gbA, ubA, vbA, base);
                P6_REDUCE(wB, entB, ejB, gbB, ubB, vbB, base + 16);
            }
        }
#undef P6_PRE
#undef P6_ISSUE
#undef P6_REDUCE
#undef P6_DPPADD
        if (BOTH(6)) GRID_BAR();
    }

    if (IN(7)) REP(7) {
        P67_MAP();
        const int cs = vx >> 1;
        const int n0_ = p67_uni ? F.G / 8 : (F.G + 7 - 2 * cs) / 8, n1_ = p67_uni ? F.G / 8 : (F.G + 7 - (2 * cs + 1)) / 8;
        const int rk2 = (vx & 1) ? n0_ + rk : rk, nrk2 = n0_ + n1_;
        const int l8 = F.lane & 7, kg = F.lane >> 3;
        const unsigned char* vbase = V8 + (size_t)cs * NEXP * 128 + 16 * l8;
        const int tstep = nrk2 * NWAVES;
        const int col = 256 * cs + 32 * l8 + ((F.lane & 8) ? 16 : 0) + ((F.lane & 16) ? 8 : 0) + ((F.lane & 32) ? 4 : 0);
#define P7_CL(tt) ((tt) < T ? (tt) : T - 1)
#define P7_IDS(tt, ID) do { const int tc_ = P7_CL(tt); ID[0] = *(const GAS v4u*)(IDS + (size_t)tc_ * 128 + 16 * kg); ID[1] = *(const GAS v4u*)(IDS + (size_t)tc_ * 128 + 16 * kg + 8); } while (0)
#define P7_ISSUE(tt, ID, W, CF, OO) do { const int tc_ = P7_CL(tt); const unsigned idw_[8] = {ID[0].x, ID[0].y, ID[0].z, ID[0].w, ID[1].x, ID[1].y, ID[1].z, ID[1].w}; \
            _Pragma("unroll") for (int i_ = 0; i_ < 16; ++i_) { const unsigned e_ = (i_ & 1) ? (idw_[i_ >> 1] >> 16) : (idw_[i_ >> 1] & 0xffffu); W[i_] = *(const GAS v4u*)(vbase + (size_t)((PROBE_L1 && rep_) ? 0u : e_) * 128); } \
            _Pragma("unroll") for (int i_ = 0; i_ < 4; ++i_) CF[i_] = *(const GAS f32x4*)(COEF + (size_t)tc_ * 128 + 16 * kg + 4 * i_); \
            OO = *(const GAS v2u*)(X1B + (size_t)tc_ * D + col); } while (0)
#define P7_BYTE(d_, s_) do { const h2_t r_ = __builtin_amdgcn_cvt_scalef32_pk_f16_fp4(ww_[d_], 1.0f, s_); acc_[4 * (d_) + (s_)] = r_ * c2_ + acc_[4 * (d_) + (s_)]; } while (0)
#define P7_COMPUTE(tt, W, CF, OO) do { h2_t acc_[16];                 \
            _Pragma("unroll") for (int i_ = 0; i_ < 16; ++i_) acc_[i_] = (h2_t){(_Float16)0.f, (_Float16)0.f}; \
            _Pragma("unroll") for (int i_ = 0; i_ < 16; ++i_) { const unsigned ww_[4] = {W[i_].x, W[i_].y, W[i_].z, W[i_].w}; const _Float16 ch_ = (_Float16)CF[i_ >> 2][i_ & 3]; const h2_t c2_ = {ch_, ch_}; \
                P7_BYTE(0, 0); P7_BYTE(0, 1); P7_BYTE(0, 2); P7_BYTE(0, 3); P7_BYTE(1, 0); P7_BYTE(1, 1); P7_BYTE(1, 2); P7_BYTE(1, 3); \
                P7_BYTE(2, 0); P7_BYTE(2, 1); P7_BYTE(2, 2); P7_BYTE(2, 3); P7_BYTE(3, 0); P7_BYTE(3, 1); P7_BYTE(3, 2); P7_BYTE(3, 3); } \
            float r16_[16], r8_[8], r4_[4]; \
            { const bool up_ = (F.lane & 8) != 0; _Pragma("unroll") for (int i_ = 0; i_ < 8; ++i_) { const h2_t keep_ = up_ ? acc_[8 + i_] : acc_[i_], send_ = up_ ? acc_[i_] : acc_[8 + i_]; \
                const h2_t oth_ = __builtin_bit_cast(h2_t, __shfl_xor(__builtin_bit_cast(int, send_), 8)); r16_[2 * i_] = (float)keep_[0] + (float)oth_[0]; r16_[2 * i_ + 1] = (float)keep_[1] + (float)oth_[1]; } } \
            { const bool up_ = (F.lane & 16) != 0; _Pragma("unroll") for (int i_ = 0; i_ < 8; ++i_) { const float keep_ = up_ ? r16_[8 + i_] : r16_[i_], send_ = up_ ? r16_[i_] : r16_[8 + i_]; r8_[i_] = keep_ + __shfl_xor(send_, 16); } } \
            { const bool up_ = (F.lane & 32) != 0; _Pragma("unroll") for (int i_ = 0; i_ < 4; ++i_) { const float keep_ = up_ ? r8_[4 + i_] : r8_[i_], send_ = up_ ? r8_[i_] : r8_[4 + i_]; r4_[i_] = keep_ + __shfl_xor(send_, 32); } } \
            if ((tt) < T) *(GAS f32x4*)((rep_ == 0 ? out : (float*)(ws + WS_GT)) + (size_t)(tt) * D + col) = (f32x4){pg8::bflo(OO.x) + r4_[0], pg8::bfhi(OO.x) + r4_[1], pg8::bflo(OO.y) + r4_[2], pg8::bfhi(OO.y) + r4_[3]}; } while (0)
        v4u idA[2], idB[2], wA[16], wB[16]; f32x4 cfA[4], cfB[4]; v2u ooA, ooB;
        int t = rk2 * NWAVES + F.wave;
        P7_IDS(t, idA); P7_IDS(t + tstep, idB);
        while (t < T) {
            P7_ISSUE(t, idA, wA, cfA, ooA); P7_ISSUE(t + tstep, idB, wB, cfB, ooB);
            P7_IDS(t + 2 * tstep, idA); P7_IDS(t + 3 * tstep, idB);
            P7_COMPUTE(t, wA, cfA, ooA);
            P7_COMPUTE(t + tstep, wB, cfB, ooB);
            t += 2 * tstep;
        }
#undef P7_CL
#undef P7_IDS
#undef P7_ISSUE
#undef P7_BYTE
#undef P7_COMPUTE
    }
#undef IN
#undef BOTH
#undef GRID_BAR
}

extern "C" void kernel_launch(void* const* d_in, const int* in_sizes, int n_in, void* d_out, int out_size, void* d_ws, size_t ws_size, hipStream_t stream) {
    static int grid = 0;
    if (grid == 0) {
        if (n_in != 14 || in_sizes[0] != T * D || out_size != T * D || ws_size < WS_END) { fprintf(stderr, "kernel_launch: built for 14 inputs, x and out of %d floats, >= %zu bytes of workspace; got n_in %d, in0 %d, out %d, ws %zu; nothing launched\n", T * D, (size_t)WS_END, n_in, n_in > 0 ? in_sizes[0] : -1, out_size, ws_size); grid = -1; return; }
        int dev = 0, cus = 0, per_cu = 0;
        if (hipGetDevice(&dev) != hipSuccess || hipDeviceGetAttribute(&cus, hipDeviceAttributeMultiprocessorCount, dev) != hipSuccess) { fprintf(stderr, "kernel_launch: hipGetDevice / hipDeviceGetAttribute failed\n"); grid = -1; return; }
        if (hipFuncSetAttribute((const void*)fwd_kernel, hipFuncAttributeMaxDynamicSharedMemorySize, LDS_BYTES) != hipSuccess) { fprintf(stderr, "kernel_launch: hipFuncSetAttribute failed\n"); grid = -1; return; }
        if (hipOccupancyMaxActiveBlocksPerMultiprocessor(&per_cu, (const void*)fwd_kernel, NWAVES * 64, LDS_BYTES) != hipSuccess || per_cu < 1)
            fprintf(stderr, "kernel_launch: note: occupancy query reports %d workgroups per CU\n", per_cu);
        (void)hipGetLastError();
        grid = cus;
    }
    if (grid < 0) return;
    if (hipMemsetAsync((char*)d_ws + WS_CTL, 0, CTL_ZERO_BYTES, stream) != hipSuccess) { fprintf(stderr, "kernel_launch: hipMemsetAsync failed\n"); return; }
    Args a{};
    for (int i = 0; i < 14; ++i) a.in[i] = (const float*)d_in[i];
    a.out = (float*)d_out; a.ws = (unsigned char*)d_ws;
    for (int li = 0; li < N_LAUNCHES; ++li) {
        a.ph_lo = (N_LAUNCHES == PER_PHASE) ? li : 0; a.ph_hi = (N_LAUNCHES == PER_PHASE) ? li + 1 : MK_LAST_PHASE; a.li = li;
        if (a.ph_lo >= MK_LAST_PHASE) break;
        hipLaunchKernelGGL(fwd_kernel, dim3(grid), dim3(NWAVES * 64), LDS_BYTES, stream, a);
        const hipError_t le = hipPeekAtLastError();
        if (le != hipSuccess) { fprintf(stderr, "kernel_launch: launch %d failed: %s\n", li, hipGetErrorName(le)); break; }
    }
}
```

```cpp
#include <hip/hip_runtime.h>
#include <cstdio>
#include <cstdint>
namespace pg8 {
#define PG8_LAS __attribute__((address_space(3)))
typedef unsigned short bf16_t;
typedef short bf16x8 __attribute__((ext_vector_type(8)));
typedef float f32x4 __attribute__((ext_vector_type(4)));
typedef unsigned u32x4 __attribute__((ext_vector_type(4)));
typedef int i32x8 __attribute__((ext_vector_type(8)));
constexpr int BM = 256, BK = 64, HALF = 128, HTB = HALF * BK * 2  , STAGE_BYTES = 8 * HTB, NXCD = 8, WGM = 8;

__host__ __device__ __forceinline__ int lds_byte(int r, int c) { const int st = (r >> 4) * 2 + (c >> 5), rr = r & 15, cc = c & 31, ob = rr * 64 + cc * 2; return st * 1024 + (ob ^ (((ob >> 9) & 1) << 5)); }
__host__ __device__ __forceinline__ void stage_rc(int b, int& R, int& C) { const int st = b / 1024, sb = b % 1024, swz = sb ^ (((sb >> 9) & 1) << 5); R = (st >> 1) * 16 + swz / 64; C = (st & 1) * 32 + (swz % 64) / 2; }
__host__ __device__ __forceinline__ int perm32(int rho) { const int n = rho >> 4, i = rho & 15; return 8 * (i >> 2) + 4 * n + (i & 3); }

struct Unit { int pm, pn; };
struct Gemm { const bf16_t* A; const bf16_t* Bt; int M, N, K; };

struct StaticOrder {
    int nM, nN, nwg, G, c;
    __host__ __device__ void init(int M, int N, int G_, int c_) { nM = M / BM; nN = N / BM; nwg = nM * nN; G = G_; c = c_; }
    __host__ __device__ bool next(int i, Unit& u) const {
        const long L = (long)i * G + c; if (L >= nwg) return false;
        int wgid = (int)L; { const int q = nwg / NXCD, r = nwg % NXCD, xcd = wgid % NXCD, off = wgid / NXCD; wgid = (xcd < r ? xcd * (q + 1) : r * (q + 1) + (xcd - r) * q) + off; }
        const int nig = WGM * nN, gid = wgid / nig, fm = gid * WGM, gsz = (nM - fm) < WGM ? (nM - fm) : WGM;
        u.pm = fm + ((wgid % nig) % gsz); u.pn = (wgid % nig) / gsz; return true;
    }
    __device__ __forceinline__ void a_ready(const Unit&) const {}
    __device__ __forceinline__ void done(const Unit&) const {}
};


struct OneUnit {
    Unit u;
    __device__ __forceinline__ bool next(int i, Unit& o) const { if (i != 0) return false; o = u; return true; }
    __device__ __forceinline__ void a_ready(const Unit&) const {}
    __device__ __forceinline__ void done(const Unit&) const {}
};

typedef float f32x2 __attribute__((ext_vector_type(2)));
typedef __bf16 bf16x2_t __attribute__((ext_vector_type(2)));
typedef unsigned u32x2 __attribute__((ext_vector_type(2)));
__device__ __forceinline__ unsigned pkbf(float lo, float hi) { f32x2 v = {lo, hi}; bf16x2_t b = __builtin_convertvector(v, bf16x2_t); return __builtin_bit_cast(unsigned, b); }
__device__ __forceinline__ float bflo(unsigned w) { return __uint_as_float(w << 16); }
__device__ __forceinline__ float bfhi(unsigned w) { return __uint_as_float(w & 0xffff0000u); }
__device__ __forceinline__ u32x4 pack8(const f32x4 a, const f32x4 b) { u32x4 w; w.x = pkbf(a[0], a[1]); w.y = pkbf(a[2], a[3]); w.z = pkbf(b[0], b[1]); w.w = pkbf(b[2], b[3]); return w; }
constexpr float QSCALE = 0.125f * 1.4426950408889634f;
__device__ __forceinline__ float sigmoidf_(float v) { return __builtin_amdgcn_rcpf(1.0f + __builtin_amdgcn_exp2f(-1.4426950408889634f * v)); }

struct Epi1 {
    static constexpr bool PERM = true, AFTER_DRAIN = false, HAS_MID = false; static constexpr int MID_T = -1;
    const float* rinv; const float* bgate; const float* qg; const float* kg;
    bf16_t *QS, *KS, *VS;
    __device__ __forceinline__ void mid(f32x4 (&)[2][2][4][2], const Unit&, int, int, int, int) const {}
    __device__ __forceinline__ void operator()(const f32x4 (&acc)[2][2][4][2], const Unit& u, int wr, int wc, int fr, int fq) const {
        asm volatile("" : "+v"(fr), "+v"(fq));
        const int pn = u.pn; const int row0 = u.pm * BM + wr * 64 + fr;
        {
            bf16_t* base; int ld, colt;
            if (pn < 2) { base = QS; ld = 512; colt = pn * 256; } else if (pn < 4) { base = KS; ld = 512; colt = (pn - 2) * 256; } else { base = VS; ld = 512; colt = (pn - 4) * 256; }
            base += colt + wc * 32 + 8 * fq;
#pragma unroll
            for (int ai = 0; ai < 2; ++ai)
#pragma unroll
                for (int m = 0; m < 4; ++m) { const int row = row0 + ai * HALF + m * 16; const float r = (pn < 2 ? QSCALE : 1.0f);
#pragma unroll
                    for (int bj = 0; bj < 2; ++bj) *(u32x4*)(base + (size_t)row * ld + bj * HALF) = pack8(acc[ai][bj][m][0] * r, acc[ai][bj][m][1] * r);
                }
        }
    }
};

struct EpiG {
    static constexpr bool PERM = true, AFTER_DRAIN = false, HAS_MID = false; static constexpr int MID_T = -1;
    const float* bgate; const float* cs; const float* qg; const float* kg; bf16_t *QD, *KD, *VD; unsigned char* GT;
    __device__ __forceinline__ void mid(f32x4 (&)[2][2][4][2], const Unit&, int, int, int, int) const {}
    __device__ __forceinline__ void operator()(const f32x4 (&acc)[2][2][4][2], const Unit& u, int wr, int wc, int fr, int fq) const {
        asm volatile("" : "+v"(fr), "+v"(fq));
        const int pn = u.pn; const int row0 = u.pm * BM + wr * 64 + fr, colp = pn * BM + wc * 32 + 8 * fq;
        f32x4 sv[2][2];
#pragma unroll
        for (int bj = 0; bj < 2; ++bj)
#pragma unroll
            for (int n = 0; n < 2; ++n) sv[bj][n] = *(const f32x4*)(cs + colp + bj * HALF + 4 * n);
        if (pn < 6) {
            const bool isK = pn >= 3; const int head = (isK ? pn - 3 : pn) * 4 + wc;
            const float* g = (isK ? kg : qg) + head * 64 + 8 * fq;
            f32x4 gv[2][2]; const float qsc = isK ? 1.0f : QSCALE;
#pragma unroll
            for (int bj = 0; bj < 2; ++bj)
#pragma unroll
                for (int n = 0; n < 2; ++n) gv[bj][n] = *(const f32x4*)(g + 32 * bj + 4 * n) * qsc;
            bf16_t* base = (isK ? KD : QD) + head * 64 + 8 * fq;
#pragma unroll
            for (int ai = 0; ai < 2; ++ai)
#pragma unroll
                for (int m = 0; m < 4; ++m) { const int row = row0 + ai * HALF + m * 16;
                    f32x4 v[2][2]; float ss = 0.f;
#pragma unroll
                    for (int bj = 0; bj < 2; ++bj)
#pragma unroll
                        for (int n = 0; n < 2; ++n) { v[bj][n] = acc[ai][bj][m][n] * sv[bj][n]; const f32x4 q = v[bj][n] * v[bj][n]; ss += (q[0] + q[1]) + (q[2] + q[3]); }
                    ss += __shfl_xor(ss, 16); ss += __shfl_xor(ss, 32);
                    const float sc = __builtin_amdgcn_rsqf(ss * (1.0f / 64.0f) + 1e-6f);
#pragma unroll
                    for (int bj = 0; bj < 2; ++bj) *(u32x4*)(base + (size_t)row * 768 + 32 * bj) = pack8(v[bj][0] * sc * gv[bj][0], v[bj][1] * sc * gv[bj][1]);
                }
        } else if (pn < 9) {
            bf16_t* base = VD + (pn - 6) * 256 + wc * 32 + 8 * fq;
#pragma unroll
            for (int ai = 0; ai < 2; ++ai)
#pragma unroll
                for (int m = 0; m < 4; ++m) { const int row = row0 + ai * HALF + m * 16;
#pragma unroll
                    for (int bj = 0; bj < 2; ++bj) *(u32x4*)(base + (size_t)row * 768 + bj * HALF) = pack8(acc[ai][bj][m][0] * sv[bj][0], acc[ai][bj][m][1] * sv[bj][1]);
                }
        } else {
            const int col0 = (pn - 9) * 256 + wc * 32 + 8 * fq;
            f32x4 bv[2][2];
#pragma unroll
            for (int bj = 0; bj < 2; ++bj)
#pragma unroll
                for (int n = 0; n < 2; ++n) bv[bj][n] = *(const f32x4*)(bgate + col0 + bj * HALF + 4 * n);
#pragma unroll
            for (int ai = 0; ai < 2; ++ai)
#pragma unroll
                for (int m = 0; m < 4; ++m) { const int row = row0 + ai * HALF + m * 16;
#pragma unroll
                    for (int bj = 0; bj < 2; ++bj) { f32x4 a = acc[ai][bj][m][0] * sv[bj][0] + bv[bj][0], b = acc[ai][bj][m][1] * sv[bj][1] + bv[bj][1];
#pragma unroll
                        for (int e = 0; e < 4; ++e) { a[e] = sigmoidf_(a[e]) * 255.0f; b[e] = sigmoidf_(b[e]) * 255.0f; }
                        unsigned w0 = 0, w1 = 0;
                        w0 = __builtin_amdgcn_cvt_pk_u8_f32(a[0], 0, w0); w0 = __builtin_amdgcn_cvt_pk_u8_f32(a[1], 1, w0); w0 = __builtin_amdgcn_cvt_pk_u8_f32(a[2], 2, w0); w0 = __builtin_amdgcn_cvt_pk_u8_f32(a[3], 3, w0);
                        w1 = __builtin_amdgcn_cvt_pk_u8_f32(b[0], 0, w1); w1 = __builtin_amdgcn_cvt_pk_u8_f32(b[1], 1, w1); w1 = __builtin_amdgcn_cvt_pk_u8_f32(b[2], 2, w1); w1 = __builtin_amdgcn_cvt_pk_u8_f32(b[3], 3, w1);
                        *(u32x2*)(GT + (size_t)row * 2048 + col0 + bj * HALF) = (u32x2){w0, w1}; }
                }
        }
    }
};

struct Epi2 {
    static constexpr bool PERM = true, AFTER_DRAIN = false, HAS_MID = true; static constexpr int MID_T = 8;
    const unsigned char* GT; bf16_t* MIX;
    static __device__ __forceinline__ float ub(unsigned w, int e) { return (float)((w >> (8 * e)) & 0xffu); }
    static __device__ __forceinline__ float gcv(unsigned w, int e) { return fmaxf(ub(w, e) * (1.0f / 255.0f), 1e-30f); }
    __device__ __forceinline__ void mid(f32x4 (&acc)[2][2][4][2], const Unit& u, int wr, int wc, int fr, int fq) const {
        asm volatile("" : "+v"(fr), "+v"(fq));
        const int row0 = u.pm * BM + wr * 64 + fr, col0 = u.pn * BM + wc * 32 + 8 * fq;
#pragma unroll
        for (int ai = 0; ai < 2; ++ai) { u32x2 ga[4][2], gb[4][2];
#pragma unroll
            for (int m = 0; m < 4; ++m) { const unsigned char* gp = GT + (size_t)(row0 + ai * HALF + m * 16) * 2048 + col0;
#pragma unroll
                for (int bj = 0; bj < 2; ++bj) { ga[m][bj] = *(const u32x2*)(gp + bj * HALF); gb[m][bj] = *(const u32x2*)(gp + 1024 + bj * HALF); } }
#pragma unroll
            for (int m = 0; m < 4; ++m)
#pragma unroll
                for (int bj = 0; bj < 2; ++bj) { const u32x2 a = ga[m][bj], b = gb[m][bj];
                    f32x4 r0, r1;
#pragma unroll
                    for (int e = 0; e < 4; ++e) { r0[e] = ub(a.x, e) * (1.0f / 255.0f) * __builtin_amdgcn_rcpf(gcv(b.x, e)); r1[e] = ub(a.y, e) * (1.0f / 255.0f) * __builtin_amdgcn_rcpf(gcv(b.y, e)); }
                    acc[ai][bj][m][0] *= r0; acc[ai][bj][m][1] *= r1; }
            asm volatile("" ::: "memory");
        }
    }
    __device__ __forceinline__ void operator()(const f32x4 (&acc)[2][2][4][2], const Unit& u, int wr, int wc, int fr, int fq) const {
        asm volatile("" : "+v"(fr), "+v"(fq));
        const int row0 = u.pm * BM + wr * 64 + fr, col0 = u.pn * BM + wc * 32 + 8 * fq;
#pragma unroll
        for (int ai = 0; ai < 2; ++ai) { u32x2 gb[4][2];
#pragma unroll
            for (int m = 0; m < 4; ++m) { const unsigned char* gp = GT + (size_t)(row0 + ai * HALF + m * 16) * 2048 + 1024 + col0;
#pragma unroll
                for (int bj = 0; bj < 2; ++bj) gb[m][bj] = *(const u32x2*)(gp + bj * HALF); }
#pragma unroll
            for (int m = 0; m < 4; ++m) { const int row = row0 + ai * HALF + m * 16;
#pragma unroll
                for (int bj = 0; bj < 2; ++bj) { const u32x2 b = gb[m][bj];
                    f32x4 g0, g1;
#pragma unroll
                    for (int e = 0; e < 4; ++e) { g0[e] = gcv(b.x, e); g1[e] = gcv(b.y, e); }
                    *(u32x4*)(MIX + (size_t)row * 1024 + col0 + bj * HALF) = pack8(acc[ai][bj][m][0] * g0, acc[ai][bj][m][1] * g1); } }
            asm volatile("" ::: "memory");
        }
    }
};

struct Epi3 {
    static constexpr bool PERM = true, AFTER_DRAIN = false, HAS_MID = false; static constexpr int MID_T = -1;
    const float* x; bf16_t* x1b; float* ssq;
    __device__ __forceinline__ void mid(f32x4 (&)[2][2][4][2], const Unit&, int, int, int, int) const {}
    __device__ __forceinline__ void operator()(const f32x4 (&acc)[2][2][4][2], const Unit& u, int wr, int wc, int fr, int fq) const {
        asm volatile("" : "+v"(fr), "+v"(fq));
        const int row0 = u.pm * BM + wr * 64 + fr, col0 = u.pn * BM + wc * 32 + 8 * fq;
#pragma unroll
        for (int ai = 0; ai < 2; ++ai) { f32x4 xv[4][2][2];
#pragma unroll
            for (int m = 0; m < 4; ++m) { const size_t off = (size_t)(row0 + ai * HALF + m * 16) * 1024 + col0;
#pragma unroll
                for (int bj = 0; bj < 2; ++bj) { xv[m][bj][0] = *(const f32x4*)(x + off + bj * HALF); xv[m][bj][1] = *(const f32x4*)(x + off + bj * HALF + 4); } }
#pragma unroll
            for (int m = 0; m < 4; ++m) { const int row = row0 + ai * HALF + m * 16; const size_t off = (size_t)row * 1024 + col0; float ss = 0.f;
#pragma unroll
                for (int bj = 0; bj < 2; ++bj) { const f32x4 v0 = acc[ai][bj][m][0] + xv[m][bj][0], v1 = acc[ai][bj][m][1] + xv[m][bj][1];
                    *(u32x4*)(x1b + off + bj * HALF) = pack8(v0, v1);
                    const f32x4 q0 = v0 * v0, q1 = v1 * v1; ss += ((q0[0] + q0[1]) + (q0[2] + q0[3])) + ((q1[0] + q1[1]) + (q1[2] + q1[3])); }
                ss += __shfl_xor(ss, 16); ss += __shfl_xor(ss, 32);
                if (fq == 0) ssq[(size_t)row * 16 + u.pn * 4 + wc] = ss;
            }
            asm volatile("" ::: "memory");
        }
    }
};

__device__ __forceinline__ unsigned f2key(float v) { const unsigned u = __float_as_uint(v); return (u & 0x80000000u) ? ~u : (u | 0x80000000u); }
__device__ __forceinline__ float key2f(unsigned k) { return __uint_as_float((k & 0x80000000u) ? (k & 0x7fffffffu) : ~k); }
#define PG8_CE(a_, b_) do { const unsigned hi__ = (a_) > (b_) ? (a_) : (b_); const unsigned lo__ = (a_) > (b_) ? (b_) : (a_); (a_) = hi__; (b_) = lo__; } while (0)
__device__ __forceinline__ void bitonic_merge16(unsigned (&v)[16]) {
#pragma unroll
    for (int j = 8; j >= 1; j >>= 1)
#pragma unroll
        for (int i = 0; i < 16; ++i) { const int l = i ^ j; if (l > i) PG8_CE(v[i], v[l]); }
}
__device__ __forceinline__ void bitonic_sort16(unsigned (&v)[16]) {
#pragma unroll
    for (int k = 2; k <= 16; k <<= 1)
#pragma unroll
        for (int j = k >> 1; j >= 1; j >>= 1)
#pragma unroll
            for (int i = 0; i < 16; ++i) { const int l = i ^ j; if (l > i) { if ((i & k) == 0 || k == 16) PG8_CE(v[i], v[l]); else PG8_CE(v[l], v[i]); } }
}
__device__ __forceinline__ void merge_top16(unsigned (&t)[16], const unsigned (&o)[16]) {
#pragma unroll
    for (int i = 0; i < 16; ++i) t[i] = t[i] > o[15 - i] ? t[i] : o[15 - i];
    bitonic_merge16(t);
}
template <int XM> __device__ __forceinline__ void merge_top16_xor(unsigned (&t)[16]) {
    unsigned o[16];
#pragma unroll
    for (int i = 0; i < 16; ++i) o[i] = (unsigned)__shfl_xor((int)t[i], XM);
    merge_top16(t, o);
}

struct Epi4 {
    static constexpr bool PERM = false, AFTER_DRAIN = true, HAS_MID = false; static constexpr int MID_T = -1;
    const float* ssq; float* rinv2; unsigned short* ids; float* gw;
    __device__ __forceinline__ void mid(f32x4 (&)[2][2][4][2], const Unit&, int, int, int, int) const {}
    __device__ __forceinline__ void fused(f32x4 (&acc)[2][2][4][2], const Unit& u, int wr, int wc, int fr, int fq, PG8_LAS unsigned char* lds, int wid, int lane) const {
        asm volatile("" : "+v"(fr), "+v"(fq));
        const int tid = wid * 64 + lane;
        const int rl = tid >> 2, p = (tid >> 1) & 1, hf = tid & 1, q4 = tid & 3;
#pragma unroll
        for (int pass = 0; pass < 2; ++pass) {
#pragma unroll
            for (int m = 0; m < 4; ++m)
#pragma unroll
                for (int bj = 0; bj < 2; ++bj)
#pragma unroll
                    for (int n = 0; n < 2; ++n) *(PG8_LAS f32x4*)(lds + (size_t)(wr * 64 + m * 16 + fr) * 1056 + bj * 528 + (wc * 32 + n * 16 + fq * 4) * 4) = acc[pass][bj][m][n];
            asm volatile("s_waitcnt lgkmcnt(0)" ::: "memory"); __builtin_amdgcn_s_barrier(); asm volatile("" ::: "memory");
            const int row = u.pm * BM + pass * HALF + rl;
            unsigned tk[16];
#pragma unroll
            for (int i = 0; i < 16; ++i) tk[i] = 0u;
            const PG8_LAS unsigned char* sp = lds + (size_t)rl * 1056 + p * 528 + hf * 256;
#pragma nounroll
            for (int c = 0; c < 4; ++c) { unsigned ch[16];
#pragma unroll
                for (int e4 = 0; e4 < 4; ++e4) { const f32x4 v = *(const PG8_LAS f32x4*)(sp + c * 64 + e4 * 16);
#pragma unroll
                    for (int e = 0; e < 4; ++e) ch[4 * e4 + e] = (f2key(v[e]) & ~127u) | (unsigned)(127 - (64 * hf + 16 * c + 4 * e4 + e)); }
                bitonic_sort16(ch);
                merge_top16(tk, ch);
            }
            merge_top16_xor<1>(tk);
            asm volatile("s_waitcnt lgkmcnt(0)" ::: "memory");
            PG8_LAS unsigned* kl = (PG8_LAS unsigned*)(lds + (size_t)(rl & ~15) * 1056) + ((rl & 15) * 2) * 16;
            if (hf == 0) {
#pragma unroll
                for (int i = 0; i < 4; ++i) *(PG8_LAS u32x4*)(kl + p * 16 + 4 * i) = (u32x4){tk[4 * i], tk[4 * i + 1], tk[4 * i + 2], tk[4 * i + 3]}; }
            asm volatile("s_waitcnt lgkmcnt(0)" ::: "memory");
            unsigned ck[16];
#define CAND_SLOT(m_, ij__) do { const unsigned i__ = (ij__) >> 4, j__ = (ij__) & 15u; \
                const unsigned ka__ = kl[(ij__) == 0xFFFFu ? 0u : i__], kb__ = kl[16 + ((ij__) == 0xFFFFu ? 0u : j__)]; \
                const float s__ = key2f(ka__ & ~127u) + key2f(kb__ & ~127u); \
                ck[m_] = (ij__) == 0xFFFFu ? 0u : ((f2key(s__) & ~255u) | (255u - (ij__))); } while (0)
                { const unsigned ij_ = q4 == 0 ? 0u : q4 == 1 ? 1u : q4 == 2 ? 2u : 3u; CAND_SLOT(0, ij_); }
                { const unsigned ij_ = q4 == 0 ? 4u : q4 == 1 ? 5u : q4 == 2 ? 6u : 7u; CAND_SLOT(1, ij_); }
                { const unsigned ij_ = q4 == 0 ? 8u : q4 == 1 ? 9u : q4 == 2 ? 10u : 11u; CAND_SLOT(2, ij_); }
                { const unsigned ij_ = q4 == 0 ? 12u : q4 == 1 ? 13u : q4 == 2 ? 14u : 15u; CAND_SLOT(3, ij_); }
                { const unsigned ij_ = q4 == 0 ? 16u : q4 == 1 ? 17u : q4 == 2 ? 18u : 19u; CAND_SLOT(4, ij_); }
                { const unsigned ij_ = q4 == 0 ? 20u : q4 == 1 ? 21u : q4 == 2 ? 22u : 23u; CAND_SLOT(5, ij_); }
                { const unsigned ij_ = q4 == 0 ? 32u : q4 == 1 ? 33u : q4 == 2 ? 34u : 35u; CAND_SLOT(6, ij_); }
                { const unsigned ij_ = q4 == 0 ? 36u : q4 == 1 ? 48u : q4 == 2 ? 49u : 50u; CAND_SLOT(7, ij_); }
                { const unsigned ij_ = q4 == 0 ? 51u : q4 == 1 ? 64u : q4 == 2 ? 65u : 66u; CAND_SLOT(8, ij_); }
                { const unsigned ij_ = q4 == 0 ? 80u : q4 == 1 ? 81u : q4 == 2 ? 96u : 97u; CAND_SLOT(9, ij_); }
                { const unsigned ij_ = q4 == 0 ? 112u : q4 == 1 ? 113u : q4 == 2 ? 128u : 144u; CAND_SLOT(10, ij_); }
                { const unsigned ij_ = q4 == 0 ? 160u : q4 == 1 ? 176u : q4 == 2 ? 192u : 208u; CAND_SLOT(11, ij_); }
                { const unsigned ij_ = q4 == 0 ? 224u : q4 == 1 ? 240u : q4 == 2 ? 65535u : 65535u; CAND_SLOT(12, ij_); }
#undef CAND_SLOT
            ck[13] = 0u; ck[14] = 0u; ck[15] = 0u;
            bitonic_sort16(ck);
            merge_top16_xor<1>(ck); merge_top16_xor<2>(ck);
            float sq = 0.f;
#pragma unroll
            for (int i = 0; i < 4; ++i) { const f32x4 t = *(const f32x4*)(ssq + (size_t)row * 16 + 4 * i); sq += (t[0] + t[1]) + (t[2] + t[3]); }
            const float r2 = __builtin_amdgcn_rsqf(sq * (1.0f / 1024.0f) + 1e-6f);
            if (u.pn == 0 && q4 == 0) rinv2[row] = r2;
            const float b0 = key2f(ck[0] & ~255u); float wsum = 0.f; float wv[16];
#pragma unroll
            for (int q = 0; q < 16; ++q) { wv[q] = __builtin_amdgcn_exp2f((key2f(ck[q] & ~255u) - b0) * r2 * 1.4426950408889634f); wsum += wv[q]; }
            const float inv = 1.0f / wsum;
            unsigned short eo[4]; float go[4];
#pragma unroll
            for (int e = 0; e < 4; ++e) { unsigned c0 = ck[e], c1 = ck[4 + e], c2 = ck[8 + e], c3 = ck[12 + e]; float w0 = wv[e], w1 = wv[4 + e], w2 = wv[8 + e], w3 = wv[12 + e];
                asm volatile("" : "+v"(c0), "+v"(c1), "+v"(c2), "+v"(c3), "+v"(w0), "+v"(w1), "+v"(w2), "+v"(w3));
                const unsigned cc = q4 == 0 ? c0 : q4 == 1 ? c1 : q4 == 2 ? c2 : c3; const float ww = q4 == 0 ? w0 : q4 == 1 ? w1 : q4 == 2 ? w2 : w3;
                const unsigned code = 255u - (cc & 255u);
                const unsigned i1 = 127u - (kl[code >> 4] & 127u), i2 = 127u - (kl[16 + (code & 15u)] & 127u);
                eo[e] = (unsigned short)(i1 * 128u + i2); go[e] = ww * inv; }
            const size_t ob = ((size_t)row * 8 + u.pn) * 16 + q4 * 4;
            { u32x2 w; w.x = eo[0] | ((unsigned)eo[1] << 16); w.y = eo[2] | ((unsigned)eo[3] << 16); *(u32x2*)(ids + ob) = w; }
            *(f32x4*)(gw + ob) = (f32x4){go[0], go[1], go[2], go[3]};
            asm volatile("s_waitcnt lgkmcnt(0)" ::: "memory"); __builtin_amdgcn_s_barrier(); asm volatile("" ::: "memory");
        }
    }
};
template <class Epi, class Sched, bool ALIGN_EPI = false, bool SP2 = false, bool FP8 = false>
__device__ __forceinline__ void gemm_phase(PG8_LAS unsigned char* lds, const Gemm g, const Sched& S, const Epi& E) {
    const int tid = threadIdx.x, wid = __builtin_amdgcn_readfirstlane(tid >> 6), lane = tid & 63, wr = wid >> 2, wc = wid & 3, fr = lane & 15, fq = lane >> 4;
    const int K = g.K, nt = K / BK;
    unsigned voffA[2], voffB[2];
#pragma unroll
    for (int i = 0; i < 2; ++i) { int R, C; stage_rc(tid * 16 + i * 8192, R, C); const int Rb = Epi::PERM ? ((R & ~31) + perm32(R & 31)) : R;
        voffA[i] = (unsigned)(R * K + C) * 2u; voffB[i] = (unsigned)(Rb * K + C) * 2u; }
    const size_t kstep = (size_t)(BK * 2);
    const size_t hstep = (size_t)HALF * K * 2;
    const size_t tstep = 2 * hstep;
    const unsigned ldsw = (unsigned)wid * 1024u;
    const int aoff = lds_byte(wr * 64 + fr, fq * 8), boff = lds_byte(wc * 32 + fr, fq * 8);
#define PG8_SA(b, h) (((b) * 2 + (h)) * HTB)
#define PG8_SB(b, h) ((4 + (b) * 2 + (h)) * HTB)
#define PG8_STAGE(bufoff, gbase, voff) do { _Pragma("unroll") for (int _i = 0; _i < 2; ++_i) \
        __builtin_amdgcn_global_load_lds((const unsigned*)((const char*)(gbase) + (voff)[_i]), (PG8_LAS unsigned*)(lds + (bufoff) + ldsw + _i * 8192), 16, 0, 0); } while (0)
#define PG8_LD8(lo_, hi_) __builtin_bit_cast(i32x8, __builtin_shufflevector((lo_), (hi_), 0, 1, 2, 3, 4, 5, 6, 7))
#define PG8_LDA(dst, b, h) do { if constexpr (FP8) { _Pragma("unroll") for (int m = 0; m < 4; ++m) { const u32x4 l0_ = *(const PG8_LAS u32x4*)(lds + PG8_SA(b, h) + aoff + m * 2048), l1_ = *(const PG8_LAS u32x4*)(lds + PG8_SA(b, h) + aoff + m * 2048 + 1024); dst##8[m] = PG8_LD8(l0_, l1_); } } \
        else { _Pragma("unroll") for (int m = 0; m < 4; ++m) _Pragma("unroll") for (int k = 0; k < 2; ++k) dst[m][k] = *(const PG8_LAS bf16x8*)(lds + PG8_SA(b, h) + aoff + m * 2048 + k * 1024); } } while (0)
#define PG8_LDB(dst, b, h) do { if constexpr (FP8) { _Pragma("unroll") for (int n = 0; n < 2; ++n) { const u32x4 l0_ = *(const PG8_LAS u32x4*)(lds + PG8_SB(b, h) + boff + n * 2048), l1_ = *(const PG8_LAS u32x4*)(lds + PG8_SB(b, h) + boff + n * 2048 + 1024); dst##8[n] = PG8_LD8(l0_, l1_); } } \
        else { _Pragma("unroll") for (int n = 0; n < 2; ++n) _Pragma("unroll") for (int k = 0; k < 2; ++k) dst[n][k] = *(const PG8_LAS bf16x8*)(lds + PG8_SB(b, h) + boff + n * 2048 + k * 1024); } } while (0)
#define PG8_MMA(ai, bj, At, Bt) do { __builtin_amdgcn_s_setprio(1); \
        if constexpr (FP8) { _Pragma("unroll") for (int m = 0; m < 4; ++m) _Pragma("unroll") for (int n = 0; n < 2; ++n) \
            asm volatile("v_mfma_scale_f32_16x16x128_f8f6f4 %0, %1, %2, %0, %3, %3 op_sel_hi:[0,0,0]" : "+v"(acc[ai][bj][m][n]) : "v"(Bt##8[n]), "v"(At##8[m]), "v"(sc127));     \
            } \
        else { _Pragma("unroll") for (int m = 0; m < 4; ++m) _Pragma("unroll") for (int n = 0; n < 2; ++n) _Pragma("unroll") for (int k = 0; k < 2; ++k) \
            acc[ai][bj][m][n] = __builtin_amdgcn_mfma_f32_16x16x32_bf16(Bt[n][k], At[m][k], acc[ai][bj][m][n], 0, 0, 0); } \
        __builtin_amdgcn_s_setprio(0); } while (0)
#define PG8_WAIT_V(n) asm volatile("s_waitcnt vmcnt(" #n ")" ::: "memory")
#define PG8_WAIT_L(n) asm volatile("s_waitcnt lgkmcnt(" #n ")" ::: "memory")
#define PG8_BAR __builtin_amdgcn_s_barrier()
#define PG8_SCHED __builtin_amdgcn_sched_barrier(0)
    Unit cur, nxt; int ui = 0;
    if (!S.next(0, cur)) return;
    f32x4 acc[2][2][4][2];
#pragma unroll
    for (int a = 0; a < 2; ++a)
#pragma unroll
        for (int b = 0; b < 2; ++b)
#pragma unroll
            for (int m = 0; m < 4; ++m)
#pragma unroll
                for (int n = 0; n < 2; ++n) acc[a][b][m][n] = (f32x4){0.f, 0.f, 0.f, 0.f};
    bf16x8 At[4][2], B0[2][2], B1[2][2]; i32x8 At8[4], B08[2], B18[2];
    int sc127 = 127; asm volatile("" : "+v"(sc127));
    const char* cA = (const char*)g.A + (size_t)cur.pm * tstep; const char* cB = (const char*)g.Bt + (size_t)cur.pn * tstep;
    S.a_ready(cur);
    if constexpr (SP2) {
        PG8_STAGE(PG8_SB(0, 0), cB, voffB); PG8_STAGE(PG8_SB(0, 1), cB + hstep, voffB); PG8_STAGE(PG8_SA(0, 0), cA, voffA); PG8_STAGE(PG8_SA(0, 1), cA + hstep, voffA);
        if (wr == 1) PG8_BAR;
        PG8_WAIT_V(2); PG8_BAR;
        PG8_STAGE(PG8_SB(1, 0), cB + kstep, voffB); PG8_STAGE(PG8_SA(1, 0), cA + kstep, voffA); PG8_STAGE(PG8_SB(1, 1), cB + hstep + kstep, voffB);
        PG8_WAIT_V(6); PG8_BAR;
    } else {
        PG8_STAGE(PG8_SB(0, 0), cB, voffB); PG8_STAGE(PG8_SA(0, 0), cA, voffA); PG8_STAGE(PG8_SB(0, 1), cB + hstep, voffB); PG8_STAGE(PG8_SA(0, 1), cA + hstep, voffA);
        if (wr == 1) PG8_BAR;
        PG8_WAIT_V(4); PG8_BAR;
        PG8_STAGE(PG8_SB(1, 0), cB + kstep, voffB); PG8_STAGE(PG8_SA(1, 0), cA + kstep, voffA); PG8_STAGE(PG8_SB(1, 1), cB + hstep + kstep, voffB);
        PG8_WAIT_V(6); PG8_BAR;
    }
    for (;;) {
        const bool has_next = S.next(ui + 1, nxt);
        const char* nA = has_next ? (const char*)g.A + (size_t)nxt.pm * tstep : cA; const char* nB = has_next ? (const char*)g.Bt + (size_t)nxt.pn * tstep : cB;
        for (int t = 0; t < nt; t += 2) {
            if constexpr (Epi::HAS_MID) { if (t == Epi::MID_T) E.mid(acc, cur, wr, wc, fr, fq); }
            const bool last = (t == nt - 2);
            const char* a1 = cA + (size_t)(t + 1) * kstep;
            const char* a2 = last ? nA : cA + (size_t)(t + 2) * kstep; const char* b2 = last ? nB : cB + (size_t)(t + 2) * kstep;
            const char* a3 = a2 + kstep; const char* b3 = b2 + kstep;
            if (last && has_next) S.a_ready(nxt);
            if constexpr (SP2) {
            PG8_LDB(B0, 0, 0); PG8_LDB(B1, 0, 1); PG8_SCHED; PG8_LDA(At, 0, 0); PG8_STAGE(PG8_SA(1, 1), a1 + hstep, voffA);
            PG8_WAIT_V(8); PG8_WAIT_L(0); PG8_BAR; PG8_MMA(0, 0, At, B0); PG8_MMA(0, 1, At, B1); PG8_BAR; PG8_SCHED;
            PG8_LDA(At, 0, 1); PG8_STAGE(PG8_SB(0, 0), b2, voffB); PG8_STAGE(PG8_SB(0, 1), b2 + hstep, voffB); PG8_STAGE(PG8_SA(0, 0), a2, voffA);
            PG8_WAIT_V(8); PG8_WAIT_L(0); PG8_BAR; PG8_MMA(1, 0, At, B0); PG8_MMA(1, 1, At, B1); PG8_BAR; PG8_SCHED;
            PG8_LDB(B0, 1, 0); PG8_LDB(B1, 1, 1); PG8_SCHED; PG8_LDA(At, 1, 0); PG8_STAGE(PG8_SA(0, 1), a2 + hstep, voffA);
            PG8_WAIT_V(8); PG8_WAIT_L(0); PG8_BAR; PG8_MMA(0, 0, At, B0); PG8_MMA(0, 1, At, B1); PG8_BAR; PG8_SCHED;
            PG8_LDA(At, 1, 1); PG8_STAGE(PG8_SB(1, 0), b3, voffB); PG8_STAGE(PG8_SB(1, 1), b3 + hstep, voffB); PG8_STAGE(PG8_SA(1, 0), a3, voffA);
            PG8_WAIT_V(8); PG8_WAIT_L(0); PG8_BAR; PG8_MMA(1, 0, At, B0); PG8_MMA(1, 1, At, B1); PG8_BAR; PG8_SCHED;
            } else {
            PG8_LDB(B0, 0, 0); PG8_SCHED; PG8_LDA(At, 0, 0); PG8_STAGE(PG8_SA(1, 1), a1 + hstep, voffA);
            PG8_WAIT_L(8); PG8_BAR; PG8_WAIT_L(0); PG8_MMA(0, 0, At, B0); PG8_BAR; PG8_SCHED;
            PG8_LDB(B1, 0, 1); PG8_STAGE(PG8_SB(0, 0), b2, voffB);
            PG8_BAR; PG8_WAIT_L(0); PG8_MMA(0, 1, At, B1); PG8_BAR;
            PG8_LDA(At, 0, 1); PG8_STAGE(PG8_SA(0, 0), a2, voffA);
            PG8_BAR; PG8_WAIT_L(0); PG8_MMA(1, 0, At, B0); PG8_BAR; PG8_SCHED;
            PG8_STAGE(PG8_SB(0, 1), b2 + hstep, voffB);
            PG8_WAIT_V(6); PG8_BAR; PG8_MMA(1, 1, At, B1); PG8_BAR;
            PG8_LDB(B0, 1, 0); PG8_SCHED; PG8_LDA(At, 1, 0); PG8_STAGE(PG8_SA(0, 1), a2 + hstep, voffA);
            PG8_WAIT_L(8); PG8_BAR; PG8_WAIT_L(0); PG8_MMA(0, 0, At, B0); PG8_BAR; PG8_SCHED;
            PG8_LDB(B1, 1, 1); PG8_STAGE(PG8_SB(1, 0), b3, voffB);
            PG8_BAR; PG8_WAIT_L(0); PG8_MMA(0, 1, At, B1); PG8_BAR;
            PG8_LDA(At, 1, 1); PG8_STAGE(PG8_SA(1, 0), a3, voffA);
            PG8_BAR; PG8_WAIT_L(0); PG8_MMA(1, 0, At, B0); PG8_BAR; PG8_SCHED;
            PG8_STAGE(PG8_SB(1, 1), b3 + hstep, voffB);
            PG8_WAIT_V(6); PG8_BAR; PG8_MMA(1, 1, At, B1); PG8_BAR;
            }
        }
        if constexpr (FP8) asm volatile("s_nop 15\n\ts_nop 15" ::: "memory");
        if constexpr (ALIGN_EPI) { if (wr == 0) PG8_BAR; }
        if constexpr (!Epi::AFTER_DRAIN) { E(acc, cur, wr, wc, fr, fq); S.done(cur); }
        if (!has_next) break;
#pragma unroll
        for (int a = 0; a < 2; ++a)
#pragma unroll
            for (int b = 0; b < 2; ++b)
#pragma unroll
                for (int m = 0; m < 4; ++m)
#pragma unroll
                    for (int n = 0; n < 2; ++n) acc[a][b][m][n] = (f32x4){0.f, 0.f, 0.f, 0.f};
        cur = nxt; cA = nA; cB = nB; ++ui;
        if constexpr (ALIGN_EPI) { if (wr == 1) PG8_BAR; }
    }
    PG8_WAIT_V(0);
    if constexpr (!ALIGN_EPI) { if (wr == 0) PG8_BAR; }
    PG8_BAR;
    if constexpr (Epi::AFTER_DRAIN) { E.fused(acc, cur, wr, wc, fr, fq, lds, wid, lane); S.done(cur); }
#undef PG8_SA
#undef PG8_SB
#undef PG8_STAGE
#undef PG8_LDA
#undef PG8_LD8
#undef PG8_LDB
#undef PG8_MMA
#undef PG8_WAIT_V
#undef PG8_WAIT_L
#undef PG8_BAR
#undef PG8_SCHED
}
}


namespace att {
#define ALAS __attribute__((address_space(3)))
typedef unsigned short bf16;
typedef short bf16x8 __attribute__((ext_vector_type(8)));
typedef short s16x4 __attribute__((ext_vector_type(4)));
typedef float f32x16 __attribute__((ext_vector_type(16)));
typedef float f32x4 __attribute__((ext_vector_type(4)));
typedef float f32x2 __attribute__((ext_vector_type(2)));
typedef unsigned u32x4 __attribute__((ext_vector_type(4)));
typedef __bf16 bf16x2_t __attribute__((ext_vector_type(2)));
constexpr int SEQ = 4096;
constexpr int VPITCH = 144;
constexpr float LOG2E = 1.4426950408889634f, LN2 = 0.6931471805599453f;
__device__ __forceinline__ unsigned pkbf(float lo, float hi) { f32x2 v = {lo, hi}; bf16x2_t b = __builtin_convertvector(v, bf16x2_t); return __builtin_bit_cast(unsigned, b); }
__device__ __forceinline__ void wave_lds_sync() { asm volatile("s_waitcnt lgkmcnt(0)" ::: "memory"); }
__device__ __forceinline__ s16x4 vtr(const ALAS unsigned char* p) { return __builtin_bit_cast(s16x4, __builtin_amdgcn_ds_read_tr16_b64_v4i16((ALAS s16x4*)p)); }
__device__ __forceinline__ int crow(int r, int hi) { return (r & 3) + 8 * (r >> 2) + 4 * hi; }

__device__ __forceinline__ void pv_tile(f32x16& o0, f32x16& o1, const float (&a)[16], const ALAS unsigned char* vt, int lane) {
    const int g = lane >> 4, i = lane & 15, q_ = i >> 2, p_ = i & 3, h = lane >> 5;
    const ALAS unsigned char* vb = vt + (8 * h + q_) * VPITCH + (16 * (g & 1) + 4 * p_) * 2;
    u32x4 pw0, pw1;
    pw0.x = pkbf(a[0], a[1]); pw0.y = pkbf(a[2], a[3]); pw0.z = pkbf(a[4], a[5]); pw0.w = pkbf(a[6], a[7]);
    pw1.x = pkbf(a[8], a[9]); pw1.y = pkbf(a[10], a[11]); pw1.z = pkbf(a[12], a[13]); pw1.w = pkbf(a[14], a[15]);
    const bf16x8 pa0 = __builtin_bit_cast(bf16x8, pw0), pa1 = __builtin_bit_cast(bf16x8, pw1);
#pragma unroll
    for (int s = 0; s < 2; ++s) {
        const s16x4 l0 = vtr(vb + (16 * s) * VPITCH), h0 = vtr(vb + (16 * s + 4) * VPITCH);
        const s16x4 l1 = vtr(vb + (16 * s) * VPITCH + 64), h1 = vtr(vb + (16 * s + 4) * VPITCH + 64);
        const bf16x8 v0 = (bf16x8){l0[0], l0[1], l0[2], l0[3], h0[0], h0[1], h0[2], h0[3]};
        const bf16x8 v1 = (bf16x8){l1[0], l1[1], l1[2], l1[3], h1[0], h1[1], h1[2], h1[3]};
        o0 = __builtin_amdgcn_mfma_f32_32x32x16_bf16(s ? pa1 : pa0, v0, o0, 0, 0, 0);
        o1 = __builtin_amdgcn_mfma_f32_32x32x16_bf16(s ? pa1 : pa0, v1, o1, 0, 0, 0);
    }
}
__device__ __forceinline__ void bcast_rows(float v, ALAS float* sc, int r32, int hi, float (&out)[16]) {
    if (hi == 0) sc[r32] = v;
    wave_lds_sync();
#pragma unroll
    for (int g = 0; g < 4; ++g) { const f32x4 t = *(const ALAS f32x4*)(sc + 8 * g + 4 * hi); out[4 * g] = t[0]; out[4 * g + 1] = t[1]; out[4 * g + 2] = t[2]; out[4 * g + 3] = t[3]; }
    wave_lds_sync();
}
__device__ __forceinline__ void store_o(const f32x16& o0, const f32x16& o1, ALAS unsigned char* stg, bf16* dst  , size_t rstride_elems, int lane) {
    const int r32 = lane & 31, hi = lane >> 5;
    wave_lds_sync();
#pragma unroll
    for (int r = 0; r < 16; ++r) { const int q = crow(r, hi);
        *(ALAS unsigned short*)(stg + q * VPITCH + r32 * 2) = (unsigned short)(pkbf(o0[r], 0.f) & 0xffffu);
        *(ALAS unsigned short*)(stg + q * VPITCH + 64 + r32 * 2) = (unsigned short)(pkbf(o1[r], 0.f) & 0xffffu); }
    wave_lds_sync();
#pragma unroll
    for (int i = 0; i < 4; ++i) { const int row = 8 * i + (lane >> 3), ch = lane & 7; const u32x4 v = *(const ALAS u32x4*)(stg + row * VPITCH + ch * 16); *(u32x4*)(dst + (size_t)row * rstride_elems + ch * 8) = v; }
    wave_lds_sync();
}

__device__ __forceinline__ void sb_item(const bf16* QS, const bf16* KS, const bf16* VS, bf16* OC, int b, int h, int qt, ALAS unsigned char* wl, int lane) {
    const int r32 = lane & 31, hi = lane >> 5;
    const int t0 = qt * 32; const size_t rowb = (size_t)b * SEQ;
    const int kperm = (r32 & ~12) | ((r32 & 4) << 1) | ((r32 & 8) >> 1);
    bf16x8 qf[4];
    { const bf16* qp = QS + (rowb + t0 + r32) * 512 + h * 64 + hi * 8;
#pragma unroll
      for (int d0 = 0; d0 < 4; ++d0) qf[d0] = *(const bf16x8*)(qp + d0 * 16); }
    f32x16 o0 = {}, o1 = {}; float R = 0.f;
    for (int key0 = t0; key0 >= 0; key0 -= 32) {
        const bf16* kp = KS + (rowb + key0 + kperm) * 512 + h * 64 + hi * 8;
        bf16x8 kf[4];
#pragma unroll
        for (int d0 = 0; d0 < 4; ++d0) kf[d0] = *(const bf16x8*)(kp + d0 * 16);
        u32x4 vv[4];
#pragma unroll
        for (int i = 0; i < 4; ++i) vv[i] = *(const u32x4*)(VS + (rowb + key0 + 8 * i + (lane >> 3)) * 512 + h * 64 + (lane & 7) * 8);
        f32x16 p = {};
#pragma unroll
        for (int d0 = 0; d0 < 4; ++d0) p = __builtin_amdgcn_mfma_f32_32x32x16_bf16(kf[d0], qf[d0], p, 0, 0, 0);
#pragma unroll
        for (int i = 0; i < 4; ++i) *(ALAS u32x4*)(wl + (8 * i + (lane >> 3)) * VPITCH + (lane & 7) * 16) = vv[i];
        const bool diag = (key0 == t0);
        float z2[16], L2[16];
#pragma unroll
        for (int r = 0; r < 16; ++r) { const int kk = (r & 7) + 8 * hi + 16 * (r >> 3); const float zz = p[r];
            const float sp = fmaxf(zz, 0.f) + __builtin_amdgcn_logf(1.0f + __builtin_amdgcn_exp2f(-fabsf(zz)));
            const bool valid = !diag || (kk < r32); z2[r] = zz; L2[r] = valid ? sp : 0.f; }
        float c[16];
        c[15] = L2[15];
#pragma unroll
        for (int r = 14; r >= 8; --r) c[r] = c[r + 1] + L2[r];
        c[7] = L2[7];
#pragma unroll
        for (int r = 6; r >= 0; --r) c[r] = c[r + 1] + L2[r];
        const float TB = c[8], TA = c[0];
        const float TBo = __shfl_xor(TB, 32), TAo = __shfl_xor(TA, 32);
        const float offB = R + (hi ? 0.f : TBo);
        const float offA = R + TB + TBo + (hi ? 0.f : TAo);
        float a[16];
#pragma unroll
        for (int r = 0; r < 16; ++r) { const int kk = (r & 7) + 8 * hi + 16 * (r >> 3); const bool valid = !diag || (kk < r32);
            const float e = __builtin_amdgcn_exp2f(z2[r] - (c[r] + (r < 8 ? offA : offB))); a[r] = valid ? e : 0.f; }
        R += (TA + TB) + (TAo + TBo);
        wave_lds_sync();
        pv_tile(o0, o1, a, wl, lane);
        wave_lds_sync();
        if (__all(R > 40.0f * LOG2E)) break;
    }
    store_o(o0, o1, wl, OC + (rowb + t0) * 768 + h * 64, 768, lane);
}

constexpr int DLU_WAVE = 5120;
constexpr int DLU_O = 8 * DLU_WAVE, DLU_M = DLU_O + 512 * 128, DLU_L = DLU_M + 2048, DLU_BYTES = DLU_L + 2048;
__device__ __forceinline__ void dl_unit(const bf16* QD, const bf16* KD, const bf16* VD, bf16* OC, int b, int j, int blk, ALAS unsigned char* lds, int wave, int lane) {
    const int r32 = lane & 31, hi = lane >> 5;
    const size_t rowb = (size_t)b * SEQ;
    const int t0 = 512 * blk;
    const int kperm = (r32 & ~12) | ((r32 & 4) << 1) | ((r32 & 8) >> 1);
    ALAS unsigned char* wl = lds + wave * DLU_WAVE;
    ALAS float* sc = (ALAS float*)(wl + 4608);
    ALAS unsigned short* OL = (ALAS unsigned short*)(lds + DLU_O);
    ALAS float* ML = (ALAS float*)(lds + DLU_M); ALAS float* LL = (ALAS float*)(lds + DLU_L);
    for (int g = 2; g >= 0; --g) {
        const int hh = 4 * g + j, sh = 2 * g, r = 1 << sh;
        const float slope2 = __builtin_amdgcn_exp2f(-8.0f * (float)(hh + 1) / 12.0f) * LOG2E;
        const float sr = slope2 * (float)r;
        for (int it = wave; it < 16; it += 8) {
            const int q0 = g == 2 ? it : g == 1 ? (it & 3) + 128 * (it >> 2) : 32 * it;
            const int tq = t0 + q0 + r * r32, tmax = t0 + q0 + 31 * r;
            bf16x8 qf[4];
            { const bf16* qp = QD + (rowb + tq) * 768 + hh * 64 + hi * 8;
#pragma unroll
              for (int d0 = 0; d0 < 4; ++d0) qf[d0] = *(const bf16x8*)(qp + d0 * 16); }
            const int klo = 31 - r32; int khi = klo + 128; { const int kmaxtok = tmax >> sh; khi = khi < kmaxtok ? khi : kmaxtok; }
            const unsigned krange = (unsigned)(khi - klo);
            f32x16 o0 = {}, o1 = {}; float mrun = -3.0e38f, lrun = 0.f;
            if (g != 2) {
                mrun = ML[q0 + r * r32]; lrun = hi ? 0.f : LL[q0 + r * r32];
#pragma unroll
                for (int q = 0; q < 16; ++q) { const int tl = q0 + r * crow(q, hi);
                    o0[q] = __uint_as_float((unsigned)OL[tl * 64 + r32] << 16); o1[q] = __uint_as_float((unsigned)OL[tl * 64 + 32 + r32] << 16); }
            }
            for (int kt = 0; kt < 5; ++kt) {
                int sk = tmax - r * (32 * kt + kperm); sk = sk < 0 ? 0 : sk;
                const bf16* kp = KD + (rowb + sk) * 768 + hh * 64 + hi * 8;
                bf16x8 kf[4];
#pragma unroll
                for (int d0 = 0; d0 < 4; ++d0) kf[d0] = *(const bf16x8*)(kp + d0 * 16);
                u32x4 vv[4];
#pragma unroll
                for (int i = 0; i < 4; ++i) { int sv = tmax - r * (32 * kt + 8 * i + (lane >> 3)); sv = sv < 0 ? 0 : sv; vv[i] = *(const u32x4*)(VD + (rowb + sv) * 768 + hh * 64 + (lane & 7) * 8); }
                const int dk = 32 * kt + 8 * hi - klo;
                const float tb = -sr * (float)dk;
                f32x16 p;
#pragma unroll
                for (int q = 0; q < 16; ++q) p[q] = tb - sr * (float)((q & 7) + 16 * (q >> 3));
#pragma unroll
                for (int d0 = 0; d0 < 4; ++d0) p = __builtin_amdgcn_mfma_f32_32x32x16_bf16(kf[d0], qf[d0], p, 0, 0, 0);
#pragma unroll
                for (int i = 0; i < 4; ++i) *(ALAS u32x4*)(wl + (8 * i + (lane >> 3)) * VPITCH + (lane & 7) * 16) = vv[i];
                float z2[16]; float mt = -3.0e38f;
#pragma unroll
                for (int q = 0; q < 16; ++q) { const bool valid = (unsigned)(dk + ((q & 7) + 16 * (q >> 3))) <= krange; z2[q] = valid ? p[q] : -INFINITY; mt = fmaxf(mt, z2[q]); }
                mt = fmaxf(mt, __shfl_xor(mt, 32));
                if (__any(mt > mrun + 8.0f)) {
                    const float mnew = fmaxf(mrun, mt); const float alpha = __builtin_amdgcn_exp2f(mrun - mnew);
                    lrun *= alpha; float al[16]; bcast_rows(alpha, sc, r32, hi, al);
#pragma unroll
                    for (int q = 0; q < 16; ++q) { o0[q] *= al[q]; o1[q] *= al[q]; }
                    mrun = mnew;
                }
                float a[16]; float ls = 0.f;
#pragma unroll
                for (int q = 0; q < 16; ++q) { a[q] = __builtin_amdgcn_exp2f(z2[q] - mrun); ls += a[q]; }
                lrun += ls;
                wave_lds_sync();
                pv_tile(o0, o1, a, wl, lane);
                wave_lds_sync();
            }
            const float ltot = lrun + __shfl_xor(lrun, 32);
            if (g != 0) {
                if (hi == 0) { ML[q0 + r * r32] = mrun; LL[q0 + r * r32] = ltot; }
#pragma unroll
                for (int q = 0; q < 16; ++q) { const int tl = q0 + r * crow(q, hi);
                    OL[tl * 64 + r32] = (unsigned short)(pkbf(o0[q], 0.f) & 0xffffu); OL[tl * 64 + 32 + r32] = (unsigned short)(pkbf(o1[q], 0.f) & 0xffffu); }
            } else {
                float il[16]; bcast_rows(1.0f / ltot, sc, r32, hi, il);
#pragma unroll
                for (int q = 0; q < 16; ++q) { o0[q] *= il[q]; o1[q] *= il[q]; }
                store_o(o0, o1, wl, OC + (rowb + t0 + q0) * 768 + 512 + j * 64, 768, lane);
            }
        }
        asm volatile("s_waitcnt lgkmcnt(0)" ::: "memory"); __builtin_amdgcn_s_barrier(); asm volatile("" ::: "memory");
    }
}
#undef ALAS
}

constexpr int NWAVES = 8;
#ifndef MK_N_LAUNCHES
#define MK_N_LAUNCHES 1
#endif
#ifndef MK_LAST_PHASE
#define MK_LAST_PHASE 8
#endif
constexpr int N_LAUNCHES = MK_N_LAUNCHES;
constexpr int PER_PHASE = 8;

constexpr int BATCH = 16, SEQ = 4096, D = 1024, T = BATCH * SEQ;
constexpr int N1 = 5888;
constexpr int NEXP = 16384;
constexpr size_t MiB = 1u << 20;
constexpr size_t WS_CTL = 0, CTL_ZERO_BYTES = 1 * MiB;
constexpr size_t WS_WIN = 2 * MiB;
constexpr size_t WS_WCAT = 16 * MiB;
constexpr size_t WS_WOUT = 18 * MiB;
constexpr size_t WS_WC = 20 * MiB;
constexpr size_t WS_RINV1 = 24 * MiB;
constexpr size_t WS_RINV2 = 25 * MiB;
constexpr size_t WS_USC = 25 * MiB + 512 * 1024, WS_VSC = 25 * MiB + 768 * 1024;
constexpr size_t WS_SSQ = 26 * MiB;
constexpr size_t WS_U8 = 32 * MiB;
constexpr size_t WS_V8 = 64 * MiB;
constexpr size_t WS_IDS = 96 * MiB;
constexpr size_t WS_GW = 112 * MiB;
constexpr size_t WS_XB = 144 * MiB;
constexpr size_t WS_QS = 272 * MiB, WS_KS = 336 * MiB, WS_VS = 400 * MiB;
constexpr size_t WS_QD = 464 * MiB, WS_KD = 560 * MiB, WS_VD = 656 * MiB;
constexpr size_t WS_GT = 752 * MiB;
constexpr size_t WS_COEF = 272 * MiB;
constexpr size_t WS_MIX = 272 * MiB;
constexpr size_t WS_X1B = 400 * MiB;
constexpr size_t WS_HQ = 528 * MiB;
constexpr size_t WS_HS2 = 24 * MiB + 512 * 1024;
constexpr size_t WS_XB8 = 72 * MiB;
constexpr size_t WS_WG8 = 40 * MiB;
constexpr size_t WS_GCS = 45 * MiB;
constexpr size_t WS_END = 1008 * MiB;
constexpr int CW_BAR = 4096;
constexpr int CW_GMAX = 16384;
constexpr int CW_XRANK = 8192;

constexpr int RING_OFF = 0, RING_BYTES = 131072;
constexpr int LDSCTL_OFF = 143360, MISC_OFF = LDSCTL_OFF + 320;
constexpr int LDS_BYTES = 147456;
static_assert(MISC_OFF + 128 <= LDS_BYTES, "LDS map");
#define GAS __attribute__((address_space(1)))
#define LAS __attribute__((address_space(3)))
typedef unsigned short bf16;
typedef unsigned v4u __attribute__((ext_vector_type(4)));
typedef float f32x4 __attribute__((ext_vector_type(4)));
typedef short bf16x8 __attribute__((ext_vector_type(8)));
typedef GAS unsigned gu32;
typedef GAS unsigned long long gu64;
#define RLX_AGENT __ATOMIC_RELAXED, __HIP_MEMORY_SCOPE_AGENT
#define LDS_WAIT() asm volatile("s_waitcnt lgkmcnt(0)" ::: "memory")
#define VM_WAIT() asm volatile("s_waitcnt vmcnt(0)" ::: "memory")
__device__ __forceinline__ unsigned long long rt() { return __builtin_amdgcn_s_memrealtime(); }
__device__ __forceinline__ unsigned f2bf(float f) { unsigned u = __builtin_bit_cast(unsigned, f); return (u + 0x7fffu + ((u >> 16) & 1u)) >> 16; }
__device__ __forceinline__ unsigned pk2(float lo, float hi) { return f2bf(lo) | (f2bf(hi) << 16); }

#define XB_TMO      128
#define XB_XCNT(j)  (256  + 64 * (j))
#define XB_XSUB(j)  (1280 + 64 * (j))
#define XB_XGEN(j)  (2304 + 64 * (j))
#define XB_TOP      3328
#define XB_TOPGEN   3392
#define XCD_BAR_WORDS 3456
#define XB_SPIN_CAP (1u << 18)

__device__ __forceinline__ unsigned xb_ld(unsigned* p)              { return __hip_atomic_load(p, __ATOMIC_RELAXED, __HIP_MEMORY_SCOPE_AGENT); }
__device__ __forceinline__ unsigned xb_add(unsigned* p, unsigned v) { return __hip_atomic_fetch_add(p, v, __ATOMIC_RELAXED, __HIP_MEMORY_SCOPE_AGENT); }
__device__ __forceinline__ unsigned xb_xcc_id() { return (unsigned)__builtin_amdgcn_s_getreg((3 << 11) | 20) & 0xFu; }
#define XB_SPIN(cond, bar) do { unsigned _sp = 0; while (cond) { __builtin_amdgcn_s_sleep(1); \
    if ((++_sp & 255u) == 0u) { if (xb_ld(&(bar)[XB_TMO])) break; if (_sp > XB_SPIN_CAP) { atomicAdd(&(bar)[XB_TMO], 1u); break; } } } } while (0)

struct XcdBarrier {
    unsigned* bar; unsigned x;
    volatile LAS unsigned* st;
};

__device__ __forceinline__ XcdBarrier xcd_barrier_post(unsigned* bar, volatile LAS unsigned* st) {
    XcdBarrier b; b.bar = bar; b.x = xb_xcc_id(); b.st = st;
    if (threadIdx.x == 0) (void)xb_add(&bar[XB_XCNT(b.x)], 1u);
    return b;
}
__device__ __forceinline__ void xcd_barrier_complete(unsigned* bar, unsigned x, unsigned& nloc, unsigned& nx) {
    const unsigned G = gridDim.x * gridDim.y * gridDim.z;
    unsigned sum, cnt, mine, sp = 0u;
    for (;;) {
        sum = 0u; cnt = 0u; mine = 0u;
#pragma unroll
        for (unsigned j = 0; j < 16; ++j) { const unsigned c = xb_ld(&bar[XB_XCNT(j)]); sum += c; cnt += (c > 0u) ? 1u : 0u; mine = (j == x) ? c : mine; }
        if (sum == G) break;
        __builtin_amdgcn_s_sleep(1);
        if ((++sp & 255u) == 0u) { if (xb_ld(&bar[XB_TMO])) break; if (sp > XB_SPIN_CAP) { atomicAdd(&bar[XB_TMO], 1u); break; } }
    }
    nloc = mine > 0u ? mine : 1u; nx = cnt > 0u ? cnt : 1u;
}

__device__ __forceinline__ void xcd_barrier(const XcdBarrier& b) {
    asm volatile("s_waitcnt vmcnt(0)" ::: "memory");
    __syncthreads();
    if (threadIdx.x == 0) {
        unsigned* bar = b.bar;
        __builtin_amdgcn_s_waitcnt(0);
        unsigned nloc = b.st[0], nx = b.st[1];
        if (nloc == 0u) { xcd_barrier_complete(bar, b.x, nloc, nx); b.st[0] = nloc; b.st[1] = nx; }
        const unsigned old = xb_add(&bar[XB_XSUB(b.x)], 1u);
        const unsigned gen = old / nloc;
        if (old + 1u == (gen + 1u) * nloc) {
            __builtin_amdgcn_fence(__ATOMIC_RELEASE, "agent");
            asm volatile("s_waitcnt vmcnt(0)" ::: "memory");
            const unsigned og = xb_add(&bar[XB_TOP], 1u);
            const unsigned tg = og / nx;
            if (og + 1u == (tg + 1u) * nx) xb_add(&bar[XB_TOPGEN], 1u);
            else XB_SPIN(xb_ld(&bar[XB_TOPGEN]) == tg, bar);
            __builtin_amdgcn_fence(__ATOMIC_ACQUIRE, "agent");
            xb_add(&bar[XB_XGEN(b.x)], 1u);
            asm volatile("s_waitcnt vmcnt(0)" ::: "memory");
        } else {
            XB_SPIN(xb_ld(&bar[XB_XGEN(b.x)]) == gen, bar);
            __builtin_amdgcn_fence(__ATOMIC_ACQUIRE, "agent");
            asm volatile("s_waitcnt vmcnt(0)" ::: "memory");
        }
    }
    __syncthreads();
}

typedef float f32x2 __attribute__((ext_vector_type(2)));
typedef unsigned v2u __attribute__((ext_vector_type(2)));
typedef _Float16 h2_t __attribute__((ext_vector_type(2)));
struct Frame {
    LAS unsigned char* lds;
    volatile LAS unsigned* MISC;
    gu32* ctl;
    int tid, lane, wave;
    int vcu, G;
};
__device__ __forceinline__ float wave_sum(float v) {
#pragma unroll
    for (int o = 1; o < 64; o <<= 1) v += __shfl_xor(v, o);
    return v;
}
__device__ __forceinline__ float wave_max(float v) {
#pragma unroll
    for (int o = 1; o < 64; o <<= 1) v = fmaxf(v, __shfl_xor(v, o));
    return v;
}
constexpr int NB16 = 1536, N8 = 5888 - NB16;
__device__ __forceinline__ int win_row(int n) { if (n < 1536 || n >= 3072) return n; const int t = (n - 1536) >> 8, ln = (n - 1536) & 255, hl = ln >> 6, d = ln & 63; return 1536 + t * 256 + 32 * hl + (d & 31) + 128 * (d >> 5); }
__device__ __forceinline__ void p0_transpose_item(const float* W, int N, const float* gain, bf16* WT, int ldt, int koff, int mode, LAS float* scr, int item, int lane) {
    const int nblk = N / 32, kb = item / nblk, nb = item % nblk, k0 = 64 * kb, n0 = 32 * nb;
#pragma unroll 8
    for (int i = 0; i < 32; ++i) { const int kk = 2 * i + (lane >> 5); float v = W[(size_t)(k0 + kk) * N + n0 + (lane & 31)]; if (gain) v *= gain[k0 + kk]; scr[kk * 33 + (lane & 31)] = v; }
    LDS_WAIT(); asm volatile("" ::: "memory");
    const int c = lane & 7;
#pragma unroll
    for (int j = 0; j < 4; ++j) { const int n = (lane >> 3) + 8 * j; const LAS float* s = scr + (8 * c) * 33 + n;
        v4u o; o.x = pk2(s[0 * 33], s[1 * 33]); o.y = pk2(s[2 * 33], s[3 * 33]); o.z = pk2(s[4 * 33], s[5 * 33]); o.w = pk2(s[6 * 33], s[7 * 33]);
        const int rown = mode ? win_row(n0 + n) : (n0 + n);
        *(GAS v4u*)(WT + (size_t)rown * ldt + koff + k0 + 8 * c) = o; }
    LDS_WAIT(); asm volatile("" ::: "memory");
}
__device__ __forceinline__ void p0_gate_max_item(const float* W, int N, const float* gain, unsigned* gmax, int kb, int n0, int lane) {
    const int k0 = 64 * kb; float am = 0.f;
#pragma unroll 8
    for (int i = 0; i < 32; ++i) { const int kk = 2 * i + (lane >> 5); am = fmaxf(am, fabsf(W[(size_t)(k0 + kk) * N + n0 + (lane & 31)] * gain[k0 + kk])); }
    am = fmaxf(am, __shfl_xor(am, 32));
    if (lane < 32) atomicMax(gmax + (n0 - NB16) + lane, __float_as_uint(am));
}
__device__ __forceinline__ void p0_gate_fp8_item(const float* W, int N, const float* gain, const unsigned* gmax, unsigned char* WG, float* cs, LAS float* scr, int item, int lane) {
    const int kb = item / (N8 / 32), nb = item % (N8 / 32), k0 = 64 * kb, n0 = 32 * nb;
#pragma unroll 8
    for (int i = 0; i < 32; ++i) { const int kk = 2 * i + (lane >> 5); scr[kk * 33 + (lane & 31)] = W[(size_t)(k0 + kk) * N + NB16 + n0 + (lane & 31)] * gain[k0 + kk]; }
    LDS_WAIT(); asm volatile("" ::: "memory");
    const int c = lane & 7;
#pragma unroll
    for (int j = 0; j < 4; ++j) { const int n = (lane >> 3) + 8 * j; const LAS float* sp = scr + (8 * c) * 33 + n;
        const unsigned mb = xb_ld((unsigned*)gmax + n0 + n); const int ex = (int)((mb >> 23) & 0xffu);
        const float sc = (ex == 0) ? 1.0f : __uint_as_float((unsigned)(127 + 7 - (ex - 127)) << 23);
        int p0 = __builtin_amdgcn_cvt_pk_fp8_f32(sp[0 * 33] * sc, sp[1 * 33] * sc, 0, false); p0 = __builtin_amdgcn_cvt_pk_fp8_f32(sp[2 * 33] * sc, sp[3 * 33] * sc, p0, true);
        int p1 = __builtin_amdgcn_cvt_pk_fp8_f32(sp[4 * 33] * sc, sp[5 * 33] * sc, 0, false); p1 = __builtin_amdgcn_cvt_pk_fp8_f32(sp[6 * 33] * sc, sp[7 * 33] * sc, p1, true);
        const int prow = win_row(NB16 + n0 + n) - NB16;
        *(GAS v2u*)(WG + (size_t)prow * 1024 + k0 + 8 * c) = (v2u){(unsigned)p0, (unsigned)p1};
        if (kb == 0 && c == 0) cs[prow] = (ex == 0) ? 1.0f : __uint_as_float((unsigned)(127 - 7 + (ex - 127)) << 23); }
    LDS_WAIT(); asm volatile("" ::: "memory");
}
__device__ __forceinline__ void quant_row_fp8(const float* src, const float* gain, unsigned char* dst, size_t slice_stride, float* scale_out, int lane) {
    f32x4 v[4]; float am = 0.f;
#pragma unroll
    for (int j = 0; j < 4; ++j) { v[j] = *(const GAS f32x4*)(src + 256 * j + 4 * lane); if (gain) v[j] = v[j] * *(const GAS f32x4*)(gain + 256 * j + 4 * lane);
        am = fmaxf(am, fmaxf(fmaxf(fabsf(v[j][0]), fabsf(v[j][1])), fmaxf(fabsf(v[j][2]), fabsf(v[j][3])))); }
    am = wave_max(am);
    const int ex = (int)((__float_as_uint(am) >> 23) & 0xffu);
    const float s = (ex == 0) ? 1.0f : __uint_as_float((unsigned)(127 + 7 - (ex - 127)) << 23);
    const float is = (ex == 0) ? 1.0f : __uint_as_float((unsigned)(127 - 7 + (ex - 127)) << 23);
    if (lane == 0) *scale_out = is;
#pragma unroll
    for (int j = 0; j < 4; ++j) { int pk = __builtin_amdgcn_cvt_pk_fp8_f32(v[j][0] * s, v[j][1] * s, 0, false); pk = __builtin_amdgcn_cvt_pk_fp8_f32(v[j][2] * s, v[j][3] * s, pk, true);
        const int col = 256 * j + 4 * lane; *(GAS int*)(dst + (size_t)(col >> 7) * slice_stride + (col & 127)) = pk; }
}
__device__ __forceinline__ void quant_row_fp4(const float* src, unsigned char* dst, size_t slice_stride, float* scale_out, int lane) {
    f32x4 v[4]; float am = 0.f;
#pragma unroll
    for (int j = 0; j < 4; ++j) { v[j] = *(const GAS f32x4*)(src + 256 * j + 4 * lane); am = fmaxf(am, fmaxf(fmaxf(fabsf(v[j][0]), fabsf(v[j][1])), fmaxf(fabsf(v[j][2]), fabsf(v[j][3])))); }
    am = wave_max(am);
    const float s = am > 0.f ? 6.0f / am : 0.f;
    if (lane == 0) *scale_out = am * (1.0f / 6.0f);
#pragma unroll
    for (int j = 0; j < 4; ++j) { unsigned pk = __builtin_amdgcn_cvt_scalef32_pk_fp4_f32(0u, v[j][0] * s, v[j][1] * s, 1.0f, 0); pk = __builtin_amdgcn_cvt_scalef32_pk_fp4_f32(pk, v[j][2] * s, v[j][3] * s, 1.0f, 1);
        *(GAS unsigned short*)(dst + (size_t)j * slice_stride + 2 * lane) = (unsigned short)(pk & 0xffffu); }
}
__device__ __forceinline__ void quant_row_i4(const float* src, const float* gain, unsigned char* dst, float* scale_out, int lane) {
    f32x4 v[4]; float am = 0.f, ss = 0.f;
    const int p16 = (lane >> 2) & 15, wl = lane & 3;
#pragma unroll
    for (int ld = 0; ld < 2; ++ld)
#pragma unroll
        for (int sn = 0; sn < 2; ++sn) { const int hd = 2 * (4 * ld + wl) + sn; const int idx = 256 * (hd >> 2) + 16 * p16 + 4 * (hd & 3);
            f32x4 t = *(const GAS f32x4*)(src + idx); if (gain) t = t * *(const GAS f32x4*)(gain + idx); v[2 * ld + sn] = t;
            am = fmaxf(am, fmaxf(fmaxf(fabsf(t[0]), fabsf(t[1])), fmaxf(fabsf(t[2]), fabsf(t[3])))); ss += (t[0] * t[0] + t[1] * t[1]) + (t[2] * t[2] + t[3] * t[3]); }
    am = wave_max(am); ss = wave_sum(ss);
    const float clipv = fminf(am, 2.5f * sqrtf(ss * (1.0f / 1024.0f)));
    const float s = clipv > 0.f ? 7.0f / clipv : 0.f;
    if (lane == 0) *scale_out = clipv * (1.0f / (7.0f * 16.0f));
#pragma unroll
    for (int ld = 0; ld < 2; ++ld) { unsigned pk = 0u;
#pragma unroll
        for (int b4 = 0; b4 < 4; ++b4) { int q0 = (int)__builtin_rintf(v[2 * ld][b4] * s), q1 = (int)__builtin_rintf(v[2 * ld + 1][b4] * s);
            q0 = q0 < -7 ? -7 : (q0 > 7 ? 7 : q0); q1 = q1 < -7 ? -7 : (q1 > 7 ? 7 : q1);
            pk |= ((unsigned)(q0 & 15) | ((unsigned)(q1 & 15) << 4)) << (8 * b4); }
        *(GAS unsigned*)(dst + ld * 256 + 16 * p16 + 4 * wl) = pk; }
}
__device__ __forceinline__ float gelu_f(float v) {
    const float av = fabsf(v), t = __builtin_amdgcn_rcpf(av * 0.2316418882f + 1.0f);
    float q = t * 0.5307027145f + (-0.7265760135f); q = q * t + 0.7107068705f; q = q * t + (-0.142248368f); q = q * t + 0.127414796f; q = q * t;
    const float e = __builtin_amdgcn_exp2f((v * v) * (-0.72134752044f));
    const float m = v * (q * e);
    return v < 0.f ? m : v - m;
}

struct Args { const float* in[14]; float* out; unsigned char* ws; int ph_lo, ph_hi, li, pad; };
__global__ void __launch_bounds__(NWAVES * 64, 2) fwd_kernel(Args args) {
    extern __shared__ __attribute__((aligned(16))) unsigned char lds[];
    Frame F;
    F.lds = (LAS unsigned char*)lds;
    F.MISC = (volatile LAS unsigned*)(F.lds + MISC_OFF);
    F.tid = threadIdx.x; F.lane = F.tid & 63; F.wave = __builtin_amdgcn_readfirstlane(F.tid >> 6);
    F.G = gridDim.x; { const int bx = blockIdx.x; F.vcu = (F.G % 8 == 0) ? (bx % 8) * (F.G / 8) + bx / 8 : bx; }
    unsigned char* ws = args.ws;
    F.ctl = (gu32*)(ws + WS_CTL);
    const float* x = args.in[0]; const float* norm1_gain = args.in[1]; const float* w_in = args.in[2]; const float* b_gate = args.in[3];
    const float* q_gain = args.in[4]; const float* k_gain = args.in[5]; const float* w_sb_out = args.in[6]; const float* w_dil_out = args.in[7];
    const float* w_out = args.in[8]; const float* norm2_gain = args.in[9]; const float* w_peer_q = args.in[10]; const float* sub_keys = args.in[11];
    const float* peer_u = args.in[12]; const float* peer_v = args.in[13];
    float* out = args.out;
    bf16* WIN = (bf16*)(ws + WS_WIN); bf16* WCAT = (bf16*)(ws + WS_WCAT); bf16* WOUT = (bf16*)(ws + WS_WOUT); bf16* WC = (bf16*)(ws + WS_WC);
    float* RINV1 = (float*)(ws + WS_RINV1); float* RINV2 = (float*)(ws + WS_RINV2); float* USC = (float*)(ws + WS_USC); float* VSC = (float*)(ws + WS_VSC); float* SSQ = (float*)(ws + WS_SSQ);
    unsigned char* U8 = ws + WS_U8; unsigned char* V8 = ws + WS_V8;
    unsigned short* IDS = (unsigned short*)(ws + WS_IDS); float* GW = (float*)(ws + WS_GW); float* COEF = (float*)(ws + WS_COEF); unsigned char* HQ = ws + WS_HQ; float* HS2 = (float*)(ws + WS_HS2);
    bf16* XB = (bf16*)(ws + WS_XB); bf16* OC = (bf16*)(ws + WS_XB); unsigned char* XB8 = ws + WS_XB8; unsigned char* WG8 = ws + WS_WG8; float* GCS = (float*)(ws + WS_GCS);
    bf16* QS = (bf16*)(ws + WS_QS); bf16* KS = (bf16*)(ws + WS_KS); bf16* VS = (bf16*)(ws + WS_VS);
    bf16* QD = (bf16*)(ws + WS_QD); bf16* KD = (bf16*)(ws + WS_KD); bf16* VD = (bf16*)(ws + WS_VD);
    unsigned char* GT = ws + WS_GT; bf16* MIX = (bf16*)(ws + WS_MIX); bf16* X1B = (bf16*)(ws + WS_X1B);

    for (int u = F.tid; u < (LDS_BYTES - LDSCTL_OFF) / 4; u += NWAVES * 64) ((LAS unsigned*)(F.lds + LDSCTL_OFF))[u] = 0u;
    __syncthreads();
    const int my_xcc = (int)xb_xcc_id();
    if (F.tid == 0) F.MISC[12] = xb_add((unsigned*)(F.ctl + CW_XRANK) + 64 * my_xcc, 1u);
    __syncthreads();
    const int my_xrank = (int)F.MISC[12];
    const int bli = (N_LAUNCHES == PER_PHASE) ? 0 : args.li;
    XcdBarrier bar; bar.bar = (unsigned*)(F.ctl + CW_BAR) + bli * XCD_BAR_WORDS; bar.x = 0; bar.st = nullptr;
    if (N_LAUNCHES != PER_PHASE) bar = xcd_barrier_post((unsigned*)(F.ctl + CW_BAR) + bli * XCD_BAR_WORDS, F.MISC + 8);
    const int lo = args.ph_lo, hi = args.ph_hi;
#ifndef PHASE_MASK
#define PHASE_MASK 0xff
#endif
#define IN(k) (((PHASE_MASK >> (k)) & 1) && lo <= (k) && (k) < hi)
#define BOTH(k) (IN(k) && IN((k) + 1))
#define GRID_BAR() do { if (N_LAUNCHES != PER_PHASE) xcd_barrier(bar); } while (0)
#ifndef PROBE_REPEAT
#define PROBE_REPEAT 0x00
#endif
#ifndef PROBE_L1
#define PROBE_L1 0x0
#endif
#define REP(k) _Pragma("unroll") for (int rep_ = 0; rep_ < (((PROBE_REPEAT >> (k)) & 1) ? 2 : 1); ++rep_)
    const int gw = F.vcu * NWAVES + F.wave, NGW = F.G * NWAVES;
#define P67_MAP() int vx = (int)(blockIdx.x & 7), rk = (int)(blockIdx.x >> 3), nrk = (F.G + 7 - vx) / 8; bool p67_uni = false; \
        { bool uni_ = (F.G % 8 == 0); for (int j_ = 0; j_ < 16; ++j_) { const unsigned c_ = xb_ld((unsigned*)(F.ctl + CW_XRANK) + 64 * j_); uni_ = uni_ && (c_ == (j_ < 8 ? (unsigned)(F.G / 8) : 0u)); } \
          if (uni_) { vx = my_xcc; rk = my_xrank; nrk = F.G / 8; p67_uni = true; } }

    if (IN(0)) REP(0) {
        for (int it = F.vcu; it < 256; it += F.G) {
            const int hp = it >> 4, d0 = (it & 15) * 64;
            LAS float* As = (LAS float*)(F.lds);
            LAS float* Bs = (LAS float*)(F.lds + 64 * 132 * 4);
            for (int e = F.tid; e < 64 * 32; e += 512) { const int r = e >> 5, c4 = (e & 31) * 4; *(LAS f32x4*)(As + r * 132 + c4) = *(const GAS f32x4*)(w_peer_q + (size_t)(d0 + r) * 2048 + hp * 128 + c4); }
            for (int e = F.tid; e < 128 * 32; e += 512) { const int r = e >> 5, c4 = (e & 31) * 4; *(LAS f32x4*)(Bs + r * 132 + c4) = *(const GAS f32x4*)(sub_keys + ((size_t)hp * 128 + r) * 128 + c4); }
            __syncthreads();
            const int ddg = F.tid & 15, ng = F.tid >> 4;
            f32x4 acc[4];
#pragma unroll
            for (int j = 0; j < 4; ++j) acc[j] = (f32x4){0.f, 0.f, 0.f, 0.f};
            for (int c4 = 0; c4 < 128; c4 += 4) {
                f32x4 a[4], b[4];
#pragma unroll
                for (int i = 0; i < 4; ++i) { a[i] = *(const LAS f32x4*)(As + (4 * ddg + i) * 132 + c4); b[i] = *(const LAS f32x4*)(Bs + (4 * ng + i) * 132 + c4); }
#pragma unroll
                for (int j = 0; j < 4; ++j)
#pragma unroll
                    for (int i = 0; i < 4; ++i) acc[j][i] += (a[i][0] * b[j][0] + a[i][1] * b[j][1]) + (a[i][2] * b[j][2] + a[i][3] * b[j][3]);
            }
            const f32x4 g2 = *(const GAS f32x4*)(norm2_gain + d0 + 4 * ddg);
#pragma unroll
            for (int j = 0; j < 4; ++j) { v2u o; o.x = pk2(acc[j][0] * g2[0], acc[j][1] * g2[1]); o.y = pk2(acc[j][2] * g2[2], acc[j][3] * g2[3]);
                *(GAS v2u*)(WC + (size_t)(hp * 128 + 4 * ng + j) * 1024 + d0 + 4 * ddg) = o; }
            __syncthreads();
        }
        {
            LAS float* scr = (LAS float*)(F.lds + RING_OFF + F.wave * 16384);
            constexpr int I_IN = (D / 64) * (N1 / 32), I_SB = (512 / 64) * (D / 32), I_DL = (256 / 64) * (D / 32), I_OUT = (D / 64) * (D / 32);
            constexpr int NITEMS = I_IN + I_SB + I_DL + I_OUT;
            for (int it = gw; it < NITEMS; it += NGW) {
                int r = it;
                if (r < I_IN) { const int nb_ = r % (N1 / 32); if (nb_ >= NB16 / 32) p0_gate_max_item(w_in, N1, norm1_gain, (unsigned*)(F.ctl + CW_GMAX), r / (N1 / 32), 32 * nb_, F.lane); else p0_transpose_item(w_in, N1, norm1_gain, WIN, 1024, 0, 1, scr, r, F.lane); continue; } r -= I_IN;
                if (r < I_SB) { p0_transpose_item(w_sb_out, D, nullptr, WCAT, 768, 0, 0, scr, r, F.lane); continue; } r -= I_SB;
                if (r < I_DL) { p0_transpose_item(w_dil_out, D, nullptr, WCAT, 768, 512, 0, scr, r, F.lane); continue; } r -= I_DL;
                p0_transpose_item(w_out, D, nullptr, WOUT, 1024, 0, 0, scr, r, F.lane);
            }
        }
        for (int e = gw; e < 2 * NEXP; e += NGW) {
            if (e < NEXP) quant_row_i4(peer_u + (size_t)e * D, norm2_gain, U8 + (size_t)e * 512, USC + e, F.lane);
            else { const int ev = e - NEXP; quant_row_fp4(peer_v + (size_t)ev * D, V8 + (size_t)ev * 128, (size_t)NEXP * 128, VSC + ev, F.lane); }
        }
        for (int m = gw; m < T; m += NGW) {
            const GAS f32x4* xr = (const GAS f32x4*)(x + (size_t)m * D) + F.lane;
            f32x4 v[4]; float s = 0.f;
#pragma unroll
            for (int j = 0; j < 4; ++j) { v[j] = xr[64 * j]; s += (v[j][0] * v[j][0] + v[j][1] * v[j][1]) + (v[j][2] * v[j][2] + v[j][3] * v[j][3]); }
            s = wave_sum(s);
            const float rn = __builtin_amdgcn_rsqf(s * (1.0f / D) + 1e-6f);
            GAS unsigned long long* o8 = (GAS unsigned long long*)(XB + (size_t)m * D) + F.lane;
#pragma unroll
            for (int j = 0; j < 4; ++j) o8[64 * j] = (unsigned long long)pk2(v[j][0] * rn, v[j][1] * rn) | ((unsigned long long)pk2(v[j][2] * rn, v[j][3] * rn) << 32);
#pragma unroll
            for (int j = 0; j < 4; ++j) { int pk = __builtin_amdgcn_cvt_pk_fp8_f32(v[j][0] * rn, v[j][1] * rn, 0, false); pk = __builtin_amdgcn_cvt_pk_fp8_f32(v[j][2] * rn, v[j][3] * rn, pk, true);
                *(GAS int*)(XB8 + (size_t)m * D + 256 * j + 4 * F.lane) = pk; }
        }
        if (BOTH(0)) GRID_BAR();
    }

    if (IN(1)) REP(1) {
        { LAS float* scr = (LAS float*)(F.lds + RING_OFF + F.wave * 16384);
          for (int it = gw; it < 16 * (N8 / 32); it += NGW) p0_gate_fp8_item(w_in, N1, norm1_gain, (const unsigned*)(F.ctl + CW_GMAX), WG8, GCS, scr, it, F.lane);
          __syncthreads(); }
        { pg8::Gemm g{XB, WIN, T, NB16, D}; pg8::StaticOrder S; S.init(T, NB16, F.G, (int)blockIdx.x);
          pg8::Epi1 E{RINV1, b_gate, q_gain, k_gain, QS, KS, VS};
          pg8::gemm_phase<pg8::Epi1, pg8::StaticOrder, true, true>(F.lds + RING_OFF, g, S, E); }
        GRID_BAR();
        { pg8::Gemm g{(const bf16*)XB8, (const bf16*)WG8, T, N8, D / 2}; pg8::StaticOrder S; S.init(T, N8, F.G, (int)blockIdx.x);
          pg8::EpiG E{b_gate, GCS, q_gain, k_gain, QD, KD, VD, GT};
          pg8::gemm_phase<pg8::EpiG, pg8::StaticOrder, true, true, true>(F.lds + RING_OFF, g, S, E); }
        if (BOTH(1)) GRID_BAR();
    }

    if (IN(2)) REP(2) {
        LAS unsigned char* wl = F.lds + RING_OFF + F.wave * 16384;
        static_assert(att::DLU_BYTES <= RING_BYTES, "dilated-attention LDS state");
        for (int un = F.vcu; un < 512; un += F.G) { const int blk = un & 7, j = (un >> 3) & 3, b = un >> 5; att::dl_unit(QD, KD, VD, OC, b, j, blk, F.lds + RING_OFF, F.wave, F.lane); }
        for (int it = gw; it < 16384; it += NGW) { const int qt = 127 - (it & 127), h = (it >> 7) & 7, b = it >> 10; att::sb_item(QS, KS, VS, OC, b, h, qt, wl, F.lane); }
        if (BOTH(2)) GRID_BAR();
    }

    if (IN(3)) REP(3) {
        pg8::Gemm g{OC, WCAT, T, D, 768}; pg8::StaticOrder S; S.init(T, D, F.G, (int)blockIdx.x);
        pg8::Epi2 E{GT, MIX};
        pg8::gemm_phase<pg8::Epi2, pg8::StaticOrder, true, true>(F.lds + RING_OFF, g, S, E);
        if (BOTH(3)) GRID_BAR();
    }

    if (IN(4)) REP(4) {
        pg8::Gemm g{MIX, WOUT, T, D, D}; pg8::StaticOrder S; S.init(T, D, F.G, (int)blockIdx.x);
        pg8::Epi3 E{x, X1B, SSQ};
        pg8::gemm_phase<pg8::Epi3, pg8::StaticOrder, true, true>(F.lds + RING_OFF, g, S, E);
        if (BOTH(4)) GRID_BAR();
    }

    if (IN(5)) REP(5) {
        for (int m = gw; m < T; m += NGW) {
            const v4u a = *(const GAS v4u*)(X1B + (size_t)m * D + 8 * F.lane), b = *(const GAS v4u*)(X1B + (size_t)m * D + 512 + 8 * F.lane);
            float v[16] = {pg8::bflo(a.x), pg8::bfhi(a.x), pg8::bflo(a.y), pg8::bfhi(a.y), pg8::bflo(a.z), pg8::bfhi(a.z), pg8::bflo(a.w), pg8::bfhi(a.w),
                           pg8::bflo(b.x), pg8::bfhi(b.x), pg8::bflo(b.y), pg8::bfhi(b.y), pg8::bflo(b.z), pg8::bfhi(b.z), pg8::bflo(b.w), pg8::bfhi(b.w)};
            float am = 0.f;
#pragma unroll
            for (int i = 0; i < 16; ++i) am = fmaxf(am, fabsf(v[i]));
            am = wave_max(am);
            float sq = (F.lane < 16) ? SSQ[(size_t)m * 16 + F.lane] : 0.f; sq = wave_sum(sq);
            const float s = am > 0.f ? 127.0f / am : 0.f;
            if (F.lane == 0) HS2[m] = am * (1.0f / 127.0f) * __builtin_amdgcn_rsqf(sq * (1.0f / 1024.0f) + 1e-6f);
            int q[16];
#pragma unroll
            for (int i = 0; i < 16; ++i) q[i] = (int)__builtin_rintf(v[i] * s) & 0xff;
            v2u o0, o1; o0.x = q[0] | (q[1] << 8) | (q[2] << 16) | (q[3] << 24); o0.y = q[4] | (q[5] << 8) | (q[6] << 16) | (q[7] << 24);
            o1.x = q[8] | (q[9] << 8) | (q[10] << 16) | (q[11] << 24); o1.y = q[12] | (q[13] << 8) | (q[14] << 16) | (q[15] << 24);
            *(GAS v2u*)(HQ + (size_t)m * D + 8 * F.lane) = o0; *(GAS v2u*)(HQ + (size_t)m * D + 512 + 8 * F.lane) = o1;
        }
        pg8::Gemm g{X1B, WC, T, 2048, D}; pg8::StaticOrder S; S.init(T, 2048, F.G, (int)blockIdx.x);
        pg8::Epi4 E{SSQ, RINV2, IDS, GW};
        pg8::OneUnit O1;
        for (int i = 0; S.next(i, O1.u); ++i) pg8::gemm_phase<pg8::Epi4, pg8::OneUnit, false, true>(F.lds + RING_OFF, g, O1, E);
        if (BOTH(5)) GRID_BAR();
    }

    if (IN(6)) REP(6) {
        P67_MAP();
        const int p16 = F.lane & 15, sg = F.lane >> 4;
        LAS unsigned char* HB = F.lds + RING_OFF + F.wave * 16384;
        LAS unsigned* LIST = (LAS unsigned*)(F.lds + RING_OFF + F.wave * 16384 + 8192);
        LAS float* HSs = (LAS float*)(F.lds + RING_OFF + F.wave * 16384 + 12288);
        const int nwb = T / 8, wstep = nrk * NWAVES;
        const int gsel = (F.lane & 15), bpsrc = (16 * (F.lane & 3) + ((F.lane >> 2) & 3)) * 4;
        v4u hpre[8], idpre[2]; float hspre = 0.f;
#define P6_PRE(bb) do { const int bc_ = (bb) < nwb ? (bb) : nwb - 1; const unsigned char* hsrc_ = HQ + (size_t)bc_ * 8192; \
            _Pragma("unroll") for (int i_ = 0; i_ < 8; ++i_) hpre[i_] = *(const GAS v4u*)(hsrc_ + (size_t)(i_ * 64 + F.lane) * 16); \
            const unsigned short* isrc_ = IDS + ((size_t)bc_ * 8 + (F.lane >> 3)) * 128 + 16 * (F.lane & 7); idpre[0] = *(const GAS v4u*)isrc_; idpre[1] = *(const GAS v4u*)(isrc_ + 8); \
            hspre = HS2[(size_t)bc_ * 8 + (F.lane & 7)]; } while (0)
#define P6_ISSUE(W, ENT, EJ, GB, UB, VB, base_) do { \
                _Pragma("unroll") for (int g_ = 0; g_ < 4; ++g_) { const int j_ = (base_) + 4 * g_ + sg; ENT[g_] = LIST[j_ < n ? j_ : nm1]; } \
                { const int j_ = (base_) + gsel; EJ = (j_ < n && F.lane < 16) ? (int)LIST[j_] : -1; } \
                _Pragma("unroll") for (int g_ = 0; g_ < 4; ++g_) { const unsigned char* up_ = U8 + (size_t)((PROBE_L1 && rep_) ? 0u : (ENT[g_] & 0xffffu)) * 512 + 16 * p16; \
                    _Pragma("unroll") for (int i_ = 0; i_ < 2; ++i_) W[g_][i_] = *(const GAS v4u*)(up_ + 256 * i_); } \
                { const unsigned ej_ = EJ < 0 ? 0u : (unsigned)EJ; GB = GW[((size_t)t0 + (ej_ >> 24)) * 128 + ((ej_ >> 16) & 127u)]; UB = USC[ej_ & 0xffffu]; VB = VSC[ej_ & 0xffffu]; } } while (0)
#define P6_DPPADD(a_, ctrl) a_ += __builtin_amdgcn_update_dpp(0, a_, ctrl, 0xf, 0xf, false)
#define P6_REDUCE(W, ENT, EJ, GB, UB, VB, base_) do { if ((base_) < n) { int ag_[4]; \
                _Pragma("unroll") for (int g_ = 0; g_ < 4; ++g_) { const LAS unsigned char* hp_ = HB + (size_t)(ENT[g_] >> 24) * 1024 + 16 * p16; int a_ = 0; v4u h_[4]; \
                    _Pragma("unroll") for (int i_ = 0; i_ < 4; ++i_) h_[i_] = *(const LAS v4u*)(hp_ + 256 * i_); \
                    _Pragma("unroll") for (int ld_ = 0; ld_ < 2; ++ld_) { const unsigned x_[4] = {W[g_][ld_].x, W[g_][ld_].y, W[g_][ld_].z, W[g_][ld_].w}; \
                        _Pragma("unroll") for (int wl_ = 0; wl_ < 4; ++wl_) { const int hd_ = 2 * (4 * ld_ + wl_); const unsigned lo_ = (x_[wl_] << 4) & 0xF0F0F0F0u, hi_ = x_[wl_] & 0xF0F0F0F0u; \
                            const unsigned hA_ = (hd_ & 3) == 0 ? h_[hd_ >> 2].x : h_[hd_ >> 2].z, hB_ = (hd_ & 3) == 0 ? h_[hd_ >> 2].y : h_[hd_ >> 2].w; \
                            a_ = __builtin_amdgcn_sdot4((int)lo_, (int)hA_, a_, false); a_ = __builtin_amdgcn_sdot4((int)hi_, (int)hB_, a_, false); } } \
                    P6_DPPADD(a_, 0xB1); P6_DPPADD(a_, 0x4E); P6_DPPADD(a_, 0x141); P6_DPPADD(a_, 0x140); ag_[g_] = a_; } \
                const int sel_ = gsel == 0 ? ag_[0] : gsel == 1 ? ag_[1] : gsel == 2 ? ag_[2] : ag_[3]; \
                const float resv_ = (float)__builtin_amdgcn_ds_bpermute(bpsrc, sel_); \
                if (EJ >= 0 && !(PROBE_L1 && rep_)) { const unsigned ej_ = (unsigned)EJ; const float act_ = gelu_f(resv_ * UB * HSs[ej_ >> 24]); \
                    COEF[((size_t)t0 + (ej_ >> 24)) * 128 + ((ej_ >> 16) & 127u)] = GB * act_ * VB; } } } while (0)
        int wb = rk * NWAVES + F.wave;
        P6_PRE(wb);
        for (; wb < nwb; wb += wstep) {
            const int t0 = wb * 8;
            asm volatile("s_waitcnt lgkmcnt(0)" ::: "memory");
            if (F.lane < 8) HSs[F.lane] = hspre;
#pragma unroll
            for (int i = 0; i < 8; ++i) *(LAS v4u*)(HB + (size_t)(i * 64 + F.lane) * 16) = hpre[i];
            int n = 0;
            { const unsigned idw[8] = {idpre[0].x, idpre[0].y, idpre[0].z, idpre[0].w, idpre[1].x, idpre[1].y, idpre[1].z, idpre[1].w};
              const unsigned tl = (unsigned)(F.lane >> 3), kb0 = 16u * (unsigned)(F.lane & 7);
#pragma unroll
              for (int i = 0; i < 16; ++i) { const unsigned e = (i & 1) ? (idw[i >> 1] >> 16) : (idw[i >> 1] & 0xffffu);
                  const bool inr = ((int)(e >> 11) == vx); const unsigned long long mk = __ballot(inr);
                  const int pos = n + (int)__builtin_amdgcn_mbcnt_hi((unsigned)(mk >> 32), __builtin_amdgcn_mbcnt_lo((unsigned)mk, 0u));
                  if (inr) LIST[pos] = (tl << 24) | ((kb0 + (unsigned)i) << 16) | e;
                  n += __builtin_popcountll(mk); } }
            asm volatile("s_waitcnt lgkmcnt(0)" ::: "memory");
            P6_PRE(wb + wstep);
            const int nm1 = n > 0 ? n - 1 : 0;
            for (int base = 0; base < n; base += 32) {
                v4u wA[4][2], wB[4][2]; unsigned entA[4], entB[4]; int ejA, ejB; float gbA, ubA, vbA, gbB, ubB, vbB;
                P6_ISSUE(wA, entA, ejA, gbA, ubA, vbA, base);
                P6_ISSUE(wB, entB, ejB, gbB, ubB, vbB, base + 16);
                P6_REDUCE(wA, entA, ejA, gbA, ubA, vbA, base);
                P6_REDUCE(wB, entB, ejB, gbB, ubB, vbB, base + 16);
            }
        }
#undef P6_PRE
#undef P6_ISSUE
#undef P6_REDUCE
#undef P6_DPPADD
        if (BOTH(6)) GRID_BAR();
    }

    if (IN(7)) REP(7) {
        P67_MAP();
        const int cs = vx >> 1;
        const int n0_ = p67_uni ? F.G / 8 : (F.G + 7 - 2 * cs) / 8, n1_ = p67_uni ? F.G / 8 : (F.G + 7 - (2 * cs + 1)) / 8;
        const int rk2 = (vx & 1) ? n0_ + rk : rk, nrk2 = n0_ + n1_;
        const int l8 = F.lane & 7, kg = F.lane >> 3;
        const unsigned char* vbase = V8 + (size_t)cs * NEXP * 128 + 16 * l8;
        const int tstep = nrk2 * NWAVES;
        const int col = 256 * cs + 32 * l8 + ((F.lane & 8) ? 16 : 0) + ((F.lane & 16) ? 8 : 0) + ((F.lane & 32) ? 4 : 0);
#define P7_CL(tt) ((tt) < T ? (tt) : T - 1)
#define P7_IDS(tt, ID) do { const int tc_ = P7_CL(tt); ID[0] = *(const GAS v4u*)(IDS + (size_t)tc_ * 128 + 16 * kg); ID[1] = *(const GAS v4u*)(IDS + (size_t)tc_ * 128 + 16 * kg + 8); } while (0)
#define P7_ISSUE(tt, ID, W, CF, OO) do { const int tc_ = P7_CL(tt); const unsigned idw_[8] = {ID[0].x, ID[0].y, ID[0].z, ID[0].w, ID[1].x, ID[1].y, ID[1].z, ID[1].w}; \
            _Pragma("unroll") for (int i_ = 0; i_ < 16; ++i_) { const unsigned e_ = (i_ & 1) ? (idw_[i_ >> 1] >> 16) : (idw_[i_ >> 1] & 0xffffu); W[i_] = *(const GAS v4u*)(vbase + (size_t)((PROBE_L1 && rep_) ? 0u : e_) * 128); } \
            _Pragma("unroll") for (int i_ = 0; i_ < 4; ++i_) CF[i_] = *(const GAS f32x4*)(COEF + (size_t)tc_ * 128 + 16 * kg + 4 * i_); \
            OO = *(const GAS v2u*)(X1B + (size_t)tc_ * D + col); } while (0)
#define P7_BYTE(d_, s_) do { const h2_t r_ = __builtin_amdgcn_cvt_scalef32_pk_f16_fp4(ww_[d_], 1.0f, s_); acc_[4 * (d_) + (s_)] = r_ * c2_ + acc_[4 * (d_) + (s_)]; } while (0)
#define P7_COMPUTE(tt, W, CF, OO) do { h2_t acc_[16];                 \
            _Pragma("unroll") for (int i_ = 0; i_ < 16; ++i_) acc_[i_] = (h2_t){(_Float16)0.f, (_Float16)0.f}; \
            _Pragma("unroll") for (int i_ = 0; i_ < 16; ++i_) { const unsigned ww_[4] = {W[i_].x, W[i_].y, W[i_].z, W[i_].w}; const _Float16 ch_ = (_Float16)CF[i_ >> 2][i_ & 3]; const h2_t c2_ = {ch_, ch_}; \
                P7_BYTE(0, 0); P7_BYTE(0, 1); P7_BYTE(0, 2); P7_BYTE(0, 3); P7_BYTE(1, 0); P7_BYTE(1, 1); P7_BYTE(1, 2); P7_BYTE(1, 3); \
                P7_BYTE(2, 0); P7_BYTE(2, 1); P7_BYTE(2, 2); P7_BYTE(2, 3); P7_BYTE(3, 0); P7_BYTE(3, 1); P7_BYTE(3, 2); P7_BYTE(3, 3); } \
            float r16_[16], r8_[8], r4_[4]; \
            { const bool up_ = (F.lane & 8) != 0; _Pragma("unroll") for (int i_ = 0; i_ < 8; ++i_) { const h2_t keep_ = up_ ? acc_[8 + i_] : acc_[i_], send_ = up_ ? acc_[i_] : acc_[8 + i_]; \
                const h2_t oth_ = __builtin_bit_cast(h2_t, __shfl_xor(__builtin_bit_cast(int, send_), 8)); r16_[2 * i_] = (float)keep_[0] + (float)oth_[0]; r16_[2 * i_ + 1] = (float)keep_[1] + (float)oth_[1]; } } \
            { const bool up_ = (F.lane & 16) != 0; _Pragma("unroll") for (int i_ = 0; i_ < 8; ++i_) { const float keep_ = up_ ? r16_[8 + i_] : r16_[i_], send_ = up_ ? r16_[i_] : r16_[8 + i_]; r8_[i_] = keep_ + __shfl_xor(send_, 16); } } \
            { const bool up_ = (F.lane & 32) != 0; _Pragma("unroll") for (int i_ = 0; i_ < 4; ++i_) { const float keep_ = up_ ? r8_[4 + i_] : r8_[i_], send_ = up_ ? r8_[i_] : r8_[4 + i_]; r4_[i_] = keep_ + __shfl_xor(send_, 32); } } \
            if ((tt) < T) *(GAS f32x4*)((rep_ == 0 ? out : (float*)(ws + WS_GT)) + (size_t)(tt) * D + col) = (f32x4){pg8::bflo(OO.x) + r4_[0], pg8::bfhi(OO.x) + r4_[1], pg8::bflo(OO.y) + r4_[2], pg8::bfhi(OO.y) + r4_[3]}; } while (0)
        v4u idA[2], idB[2], wA[16], wB[16]; f32x4 cfA[4], cfB[4]; v2u ooA, ooB;
        int t = rk2 * NWAVES + F.wave;
        P7_IDS(t, idA); P7_IDS(t + tstep, idB);
        while (t < T) {
            P7_ISSUE(t, idA, wA, cfA, ooA); P7_ISSUE(t + tstep, idB, wB, cfB, ooB);
            P7_IDS(t + 2 * tstep, idA); P7_IDS(t + 3 * tstep, idB);
            P7_COMPUTE(t, wA, cfA, ooA);
            P7_COMPUTE(t + tstep, wB, cfB, ooB);
            t += 2 * tstep;
        }
#undef P7_CL
#undef P7_IDS
#undef P7_ISSUE
#undef P7_BYTE
#undef P7_COMPUTE
    }
#undef IN
#undef BOTH
#undef GRID_BAR
}

extern "C" void kernel_launch(void* const* d_in, const int* in_sizes, int n_in, void* d_out, int out_size, void* d_ws, size_t ws_size, hipStream_t stream) {
    static int grid = 0;
    if (grid == 0) {
        if (n_in != 14 || in_sizes[0] != T * D || out_size != T * D || ws_size < WS_END) { fprintf(stderr, "kernel_launch: built for 14 inputs, x and out of %d floats, >= %zu bytes of workspace; got n_in %d, in0 %d, out %d, ws %zu; nothing launched\n", T * D, (size_t)WS_END, n_in, n_in > 0 ? in_sizes[0] : -1, out_size, ws_size); grid = -1; return; }
        int dev = 0, cus = 0, per_cu = 0;
        if (hipGetDevice(&dev) != hipSuccess || hipDeviceGetAttribute(&cus, hipDeviceAttributeMultiprocessorCount, dev) != hipSuccess) { fprintf(stderr, "kernel_launch: hipGetDevice / hipDeviceGetAttribute failed\n"); grid = -1; return; }
        if (hipFuncSetAttribute((const void*)fwd_kernel, hipFuncAttributeMaxDynamicSharedMemorySize, LDS_BYTES) != hipSuccess) { fprintf(stderr, "kernel_launch: hipFuncSetAttribute failed\n"); grid = -1; return; }
        if (hipOccupancyMaxActiveBlocksPerMultiprocessor(&per_cu, (const void*)fwd_kernel, NWAVES * 64, LDS_BYTES) != hipSuccess || per_cu < 1)
            fprintf(stderr, "kernel_launch: note: occupancy query reports %d workgroups per CU\n", per_cu);
        (void)hipGetLastError();
        grid = cus;
    }
    if (grid < 0) return;
    if (hipMemsetAsync((char*)d_ws + WS_CTL, 0, CTL_ZERO_BYTES, stream) != hipSuccess) { fprintf(stderr, "kernel_launch: hipMemsetAsync failed\n"); return; }
    Args a{};
    for (int i = 0; i < 14; ++i) a.in[i] = (const float*)d_in[i];
    a.out = (float*)d_out; a.ws = (unsigned char*)d_ws;
    for (int li = 0; li < N_LAUNCHES; ++li) {
        a.ph_lo = (N_LAUNCHES == PER_PHASE) ? li : 0; a.ph_hi = (N_LAUNCHES == PER_PHASE) ? li + 1 : MK_LAST_PHASE; a.li = li;
        if (a.ph_lo >= MK_LAST_PHASE) break;
        hipLaunchKernelGGL(fwd_kernel, dim3(grid), dim3(NWAVES * 64), LDS_BYTES, stream, a);
        const hipError_t le = hipPeekAtLastError();
        if (le != hipSuccess) { fprintf(stderr, "kernel_launch: launch %d failed: %s\n", li, hipGetErrorName(le)); break; }
    }
}
```

```cpp
#include <hip/hip_runtime.h>
#include <cstdio>
#include <cstdint>
namespace pg8 {
#define PG8_LAS __attribute__((address_space(3)))
typedef unsigned short bf16_t;
typedef short bf16x8 __attribute__((ext_vector_type(8)));
typedef float f32x4 __attribute__((ext_vector_type(4)));
typedef unsigned u32x4 __attribute__((ext_vector_type(4)));
typedef int i32x8 __attribute__((ext_vector_type(8)));
constexpr int BM = 256, BK = 64, HALF = 128, HTB = HALF * BK * 2  , STAGE_BYTES = 8 * HTB, NXCD = 8, WGM = 8;

__host__ __device__ __forceinline__ int lds_byte(int r, int c) { const int st = (r >> 4) * 2 + (c >> 5), rr = r & 15, cc = c & 31, ob = rr * 64 + cc * 2; return st * 1024 + (ob ^ (((ob >> 9) & 1) << 5)); }
__host__ __device__ __forceinline__ void stage_rc(int b, int& R, int& C) { const int st = b / 1024, sb = b % 1024, swz = sb ^ (((sb >> 9) & 1) << 5); R = (st >> 1) * 16 + swz / 64; C = (st & 1) * 32 + (swz % 64) / 2; }
__host__ __device__ __forceinline__ int perm32(int rho) { const int n = rho >> 4, i = rho & 15; return 8 * (i >> 2) + 4 * n + (i & 3); }

struct Unit { int pm, pn; };
struct Gemm { const bf16_t* A; const bf16_t* Bt; int M, N, K; };

struct StaticOrder {
    int nM, nN, nwg, G, c;
    __host__ __device__ void init(int M, int N, int G_, int c_) { nM = M / BM; nN = N / BM; nwg = nM * nN; G = G_; c = c_; }
    __host__ __device__ bool next(int i, Unit& u) const {
        const long L = (long)i * G + c; if (L >= nwg) return false;
        int wgid = (int)L; { const int q = nwg / NXCD, r = nwg % NXCD, xcd = wgid % NXCD, off = wgid / NXCD; wgid = (xcd < r ? xcd * (q + 1) : r * (q + 1) + (xcd - r) * q) + off; }
        const int nig = WGM * nN, gid = wgid / nig, fm = gid * WGM, gsz = (nM - fm) < WGM ? (nM - fm) : WGM;
        u.pm = fm + ((wgid % nig) % gsz); u.pn = (wgid % nig) / gsz; return true;
    }
    __device__ __forceinline__ void a_ready(const Unit&) const {}
    __device__ __forceinline__ void done(const Unit&) const {}
};


struct OneUnit {
    Unit u;
    __device__ __forceinline__ bool next(int i, Unit& o) const { if (i != 0) return false; o = u; return true; }
    __device__ __forceinline__ void a_ready(const Unit&) const {}
    __device__ __forceinline__ void done(const Unit&) const {}
};

typedef float f32x2 __attribute__((ext_vector_type(2)));
typedef __bf16 bf16x2_t __attribute__((ext_vector_type(2)));
typedef unsigned u32x2 __attribute__((ext_vector_type(2)));
__device__ __forceinline__ unsigned pkbf(float lo, float hi) { f32x2 v = {lo, hi}; bf16x2_t b = __builtin_convertvector(v, bf16x2_t); return __builtin_bit_cast(unsigned, b); }
__device__ __forceinline__ float bflo(unsigned w) { return __uint_as_float(w << 16); }
__device__ __forceinline__ float bfhi(unsigned w) { return __uint_as_float(w & 0xffff0000u); }
__device__ __forceinline__ u32x4 pack8(const f32x4 a, const f32x4 b) { u32x4 w; w.x = pkbf(a[0], a[1]); w.y = pkbf(a[2], a[3]); w.z = pkbf(b[0], b[1]); w.w = pkbf(b[2], b[3]); return w; }
constexpr float QSCALE = 0.125f * 1.4426950408889634f;
__device__ __forceinline__ float sigmoidf_(float v) { return __builtin_amdgcn_rcpf(1.0f + __builtin_amdgcn_exp2f(-1.4426950408889634f * v)); }

struct Epi1 {
    static constexpr bool PERM = true, AFTER_DRAIN = false, HAS_MID = false; static constexpr int MID_T = -1;
    const float* rinv; const float* bgate; const float* qg; const float* kg;
    bf16_t *QS, *KS, *VS;
    __device__ __forceinline__ void mid(f32x4 (&)[2][2][4][2], const Unit&, int, int, int, int) const {}
    __device__ __forceinline__ void operator()(const f32x4 (&acc)[2][2][4][2], const Unit& u, int wr, int wc, int fr, int fq) const {
        asm volatile("" : "+v"(fr), "+v"(fq));
        const int pn = u.pn; const int row0 = u.pm * BM + wr * 64 + fr;
        {
            bf16_t* base; int ld, colt;
            if (pn < 2) { base = QS; ld = 512; colt = pn * 256; } else if (pn < 4) { base = KS; ld = 512; colt = (pn - 2) * 256; } else { base = VS; ld = 512; colt = (pn - 4) * 256; }
            base += colt + wc * 32 + 8 * fq;
#pragma unroll
            for (int ai = 0; ai < 2; ++ai)
#pragma unroll
                for (int m = 0; m < 4; ++m) { const int row = row0 + ai * HALF + m * 16; const float r = (pn < 2 ? QSCALE : 1.0f);
#pragma unroll
                    for (int bj = 0; bj < 2; ++bj) *(u32x4*)(base + (size_t)row * ld + bj * HALF) = pack8(acc[ai][bj][m][0] * r, acc[ai][bj][m][1] * r);
                }
        }
    }
};

struct EpiG {
    static constexpr bool PERM = true, AFTER_DRAIN = false, HAS_MID = false; static constexpr int MID_T = -1;
    const float* bgate; const float* cs; const float* qg; const float* kg; bf16_t *QD, *KD, *VD; unsigned char* GT;
    __device__ __forceinline__ void mid(f32x4 (&)[2][2][4][2], const Unit&, int, int, int, int) const {}
    __device__ __forceinline__ void operator()(const f32x4 (&acc)[2][2][4][2], const Unit& u, int wr, int wc, int fr, int fq) const {
        asm volatile("" : "+v"(fr), "+v"(fq));
        const int pn = u.pn; const int row0 = u.pm * BM + wr * 64 + fr, colp = pn * BM + wc * 32 + 8 * fq;
        f32x4 sv[2][2];
#pragma unroll
        for (int bj = 0; bj < 2; ++bj)
#pragma unroll
            for (int n = 0; n < 2; ++n) sv[bj][n] = *(const f32x4*)(cs + colp + bj * HALF + 4 * n);
        if (pn < 6) {
            const bool isK = pn >= 3; const int head = (isK ? pn - 3 : pn) * 4 + wc;
            const float* g = (isK ? kg : qg) + head * 64 + 8 * fq;
            f32x4 gv[2][2]; const float qsc = isK ? 1.0f : QSCALE;
#pragma unroll
            for (int bj = 0; bj < 2; ++bj)
#pragma unroll
                for (int n = 0; n < 2; ++n) gv[bj][n] = *(const f32x4*)(g + 32 * bj + 4 * n) * qsc;
            bf16_t* base = (isK ? KD : QD) + head * 64 + 8 * fq;
#pragma unroll
            for (int ai = 0; ai < 2; ++ai)
#pragma unroll
                for (int m = 0; m < 4; ++m) { const int row = row0 + ai * HALF + m * 16;
                    f32x4 v[2][2]; float ss = 0.f;
#pragma unroll
                    for (int bj = 0; bj < 2; ++bj)
#pragma unroll
                        for (int n = 0; n < 2; ++n) { v[bj][n] = acc[ai][bj][m][n] * sv[bj][n]; const f32x4 q = v[bj][n] * v[bj][n]; ss += (q[0] + q[1]) + (q[2] + q[3]); }
                    ss += __shfl_xor(ss, 16); ss += __shfl_xor(ss, 32);
                    const float sc = __builtin_amdgcn_rsqf(ss * (1.0f / 64.0f) + 1e-6f);
#pragma unroll
                    for (int bj = 0; bj < 2; ++bj) *(u32x4*)(base + (size_t)row * 768 + 32 * bj) = pack8(v[bj][0] * sc * gv[bj][0], v[bj][1] * sc * gv[bj][1]);
                }
        } else if (pn < 9) {
            bf16_t* base = VD + (pn - 6) * 256 + wc * 32 + 8 * fq;
#pragma unroll
            for (int ai = 0; ai < 2; ++ai)
#pragma unroll
                for (int m = 0; m < 4; ++m) { const int row = row0 + ai * HALF + m * 16;
#pragma unroll
                    for (int bj = 0; bj < 2; ++bj) *(u32x4*)(base + (size_t)row * 768 + bj * HALF) = pack8(acc[ai][bj][m][0] * sv[bj][0], acc[ai][bj][m][1] * sv[bj][1]);
                }
        } else {
            const int col0 = (pn - 9) * 256 + wc * 32 + 8 * fq;
            f32x4 bv[2][2];
#pragma unroll
            for (int bj = 0; bj < 2; ++bj)
#pragma unroll
                for (int n = 0; n < 2; ++n) bv[bj][n] = *(const f32x4*)(bgate + col0 + bj * HALF + 4 * n);
#pragma unroll
            for (int ai = 0; ai < 2; ++ai)
#pragma unroll
                for (int m = 0; m < 4; ++m) { const int row = row0 + ai * HALF + m * 16;
#pragma unroll
                    for (int bj = 0; bj < 2; ++bj) { f32x4 a = acc[ai][bj][m][0] * sv[bj][0] + bv[bj][0], b = acc[ai][bj][m][1] * sv[bj][1] + bv[bj][1];
#pragma unroll
                        for (int e = 0; e < 4; ++e) { a[e] = sigmoidf_(a[e]) * 255.0f; b[e] = sigmoidf_(b[e]) * 255.0f; }
                        unsigned w0 = 0, w1 = 0;
                        w0 = __builtin_amdgcn_cvt_pk_u8_f32(a[0], 0, w0); w0 = __builtin_amdgcn_cvt_pk_u8_f32(a[1], 1, w0); w0 = __builtin_amdgcn_cvt_pk_u8_f32(a[2], 2, w0); w0 = __builtin_amdgcn_cvt_pk_u8_f32(a[3], 3, w0);
                        w1 = __builtin_amdgcn_cvt_pk_u8_f32(b[0], 0, w1); w1 = __builtin_amdgcn_cvt_pk_u8_f32(b[1], 1, w1); w1 = __builtin_amdgcn_cvt_pk_u8_f32(b[2], 2, w1); w1 = __builtin_amdgcn_cvt_pk_u8_f32(b[3], 3, w1);
                        *(u32x2*)(GT + (size_t)row * 2048 + col0 + bj * HALF) = (u32x2){w0, w1}; }
                }
        }
    }
};

struct Epi2 {
    static constexpr bool PERM = true, AFTER_DRAIN = false, HAS_MID = true; static constexpr int MID_T = 8;
    const unsigned char* GT; bf16_t* MIX;
    static __device__ __forceinline__ float ub(unsigned w, int e) { return (float)((w >> (8 * e)) & 0xffu); }
    static __device__ __forceinline__ float gcv(unsigned w, int e) { return fmaxf(ub(w, e) * (1.0f / 255.0f), 1e-30f); }
    __device__ __forceinline__ void mid(f32x4 (&acc)[2][2][4][2], const Unit& u, int wr, int wc, int fr, int fq) const {
        asm volatile("" : "+v"(fr), "+v"(fq));
        const int row0 = u.pm * BM + wr * 64 + fr, col0 = u.pn * BM + wc * 32 + 8 * fq;
#pragma unroll
        for (int ai = 0; ai < 2; ++ai) { u32x2 ga[4][2], gb[4][2];
#pragma unroll
            for (int m = 0; m < 4; ++m) { const unsigned char* gp = GT + (size_t)(row0 + ai * HALF + m * 16) * 2048 + col0;
#pragma unroll
                for (int bj = 0; bj < 2; ++bj) { ga[m][bj] = *(const u32x2*)(gp + bj * HALF); gb[m][bj] = *(const u32x2*)(gp + 1024 + bj * HALF); } }
#pragma unroll
            for (int m = 0; m < 4; ++m)
#pragma unroll
                for (int bj = 0; bj < 2; ++bj) { const u32x2 a = ga[m][bj], b = gb[m][bj];
                    f32x4 r0, r1;
#pragma unroll
                    for (int e = 0; e < 4; ++e) { r0[e] = ub(a.x, e) * (1.0f / 255.0f) * __builtin_amdgcn_rcpf(gcv(b.x, e)); r1[e] = ub(a.y, e) * (1.0f / 255.0f) * __builtin_amdgcn_rcpf(gcv(b.y, e)); }
                    acc[ai][bj][m][0] *= r0; acc[ai][bj][m][1] *= r1; }
            asm volatile("" ::: "memory");
        }
    }
    __device__ __forceinline__ void operator()(const f32x4 (&acc)[2][2][4][2], const Unit& u, int wr, int wc, int fr, int fq) const {
        asm volatile("" : "+v"(fr), "+v"(fq));
        const int row0 = u.pm * BM + wr * 64 + fr, col0 = u.pn * BM + wc * 32 + 8 * fq;
#pragma unroll
        for (int ai = 0; ai < 2; ++ai) { u32x2 gb[4][2];
#pragma unroll
            for (int m = 0; m < 4; ++m) { const unsigned char* gp = GT + (size_t)(row0 + ai * HALF + m * 16) * 2048 + 1024 + col0;
#pragma unroll
                for (int bj = 0; bj < 2; ++bj) gb[m][bj] = *(const u32x2*)(gp + bj * HALF); }
#pragma unroll
            for (int m = 0; m < 4; ++m) { const int row = row0 + ai * HALF + m * 16;
#pragma unroll
                for (int bj = 0; bj < 2; ++bj) { const u32x2 b = gb[m][bj];
                    f32x4 g0, g1;
#pragma unroll
                    for (int e = 0; e < 4; ++e) { g0[e] = gcv(b.x, e); g1[e] = gcv(b.y, e); }
                    *(u32x4*)(MIX + (size_t)row * 1024 + col0 + bj * HALF) = pack8(acc[ai][bj][m][0] * g0, acc[ai][bj][m][1] * g1); } }
            asm volatile("" ::: "memory");
        }
    }
};

struct Epi3 {
    static constexpr bool PERM = true, AFTER_DRAIN = false, HAS_MID = false; static constexpr int MID_T = -1;
    const bf16_t* xb; const float* rms; bf16_t* x1b; float* ssq;
    __device__ __forceinline__ void mid(f32x4 (&)[2][2][4][2], const Unit&, int, int, int, int) const {}
    __device__ __forceinline__ void operator()(const f32x4 (&acc)[2][2][4][2], const Unit& u, int wr, int wc, int fr, int fq) const {
        asm volatile("" : "+v"(fr), "+v"(fq));
        const int row0 = u.pm * BM + wr * 64 + fr, col0 = u.pn * BM + wc * 32 + 8 * fq;
#pragma unroll
        for (int ai = 0; ai < 2; ++ai) { u32x4 xv[4][2]; float rm[4];
#pragma unroll
            for (int m = 0; m < 4; ++m) { const size_t off = (size_t)(row0 + ai * HALF + m * 16) * 1024 + col0; rm[m] = rms[row0 + ai * HALF + m * 16];
#pragma unroll
                for (int bj = 0; bj < 2; ++bj) xv[m][bj] = *(const u32x4*)(xb + off + bj * HALF); }
#pragma unroll
            for (int m = 0; m < 4; ++m) { const int row = row0 + ai * HALF + m * 16; const size_t off = (size_t)row * 1024 + col0; float ss = 0.f; const float r = rm[m];
#pragma unroll
                for (int bj = 0; bj < 2; ++bj) { const u32x4 w = xv[m][bj];
                    const f32x4 x0 = (f32x4){bflo(w.x), bfhi(w.x), bflo(w.y), bfhi(w.y)}, x1 = (f32x4){bflo(w.z), bfhi(w.z), bflo(w.w), bfhi(w.w)};
                    const f32x4 v0 = acc[ai][bj][m][0] + x0 * r, v1 = acc[ai][bj][m][1] + x1 * r;
                    *(u32x4*)(x1b + off + bj * HALF) = pack8(v0, v1);
                    const f32x4 q0 = v0 * v0, q1 = v1 * v1; ss += ((q0[0] + q0[1]) + (q0[2] + q0[3])) + ((q1[0] + q1[1]) + (q1[2] + q1[3])); }
                ss += __shfl_xor(ss, 16); ss += __shfl_xor(ss, 32);
                if (fq == 0) ssq[(size_t)row * 16 + u.pn * 4 + wc] = ss;
            }
            asm volatile("" ::: "memory");
        }
    }
};

__device__ __forceinline__ unsigned f2key(float v) { const unsigned u = __float_as_uint(v); return (u & 0x80000000u) ? ~u : (u | 0x80000000u); }
__device__ __forceinline__ float key2f(unsigned k) { return __uint_as_float((k & 0x80000000u) ? (k & 0x7fffffffu) : ~k); }
#define PG8_CE(a_, b_) do { const unsigned hi__ = (a_) > (b_) ? (a_) : (b_); const unsigned lo__ = (a_) > (b_) ? (b_) : (a_); (a_) = hi__; (b_) = lo__; } while (0)
__device__ __forceinline__ void bitonic_merge16(unsigned (&v)[16]) {
#pragma unroll
    for (int j = 8; j >= 1; j >>= 1)
#pragma unroll
        for (int i = 0; i < 16; ++i) { const int l = i ^ j; if (l > i) PG8_CE(v[i], v[l]); }
}
__device__ __forceinline__ void bitonic_sort16(unsigned (&v)[16]) {
#pragma unroll
    for (int k = 2; k <= 16; k <<= 1)
#pragma unroll
        for (int j = k >> 1; j >= 1; j >>= 1)
#pragma unroll
            for (int i = 0; i < 16; ++i) { const int l = i ^ j; if (l > i) { if ((i & k) == 0 || k == 16) PG8_CE(v[i], v[l]); else PG8_CE(v[l], v[i]); } }
}
__device__ __forceinline__ void merge_top16(unsigned (&t)[16], const unsigned (&o)[16]) {
#pragma unroll
    for (int i = 0; i < 16; ++i) t[i] = t[i] > o[15 - i] ? t[i] : o[15 - i];
    bitonic_merge16(t);
}
template <int XM> __device__ __forceinline__ void merge_top16_xor(unsigned (&t)[16]) {
    unsigned o[16];
#pragma unroll
    for (int i = 0; i < 16; ++i) o[i] = (unsigned)__shfl_xor((int)t[i], XM);
    merge_top16(t, o);
}

struct Epi4 {
    static constexpr bool PERM = false, AFTER_DRAIN = true, HAS_MID = false; static constexpr int MID_T = -1;
    const float* ssq; float* rinv2; unsigned short* ids; float* gw;
    __device__ __forceinline__ void mid(f32x4 (&)[2][2][4][2], const Unit&, int, int, int, int) const {}
    __device__ __forceinline__ void fused(f32x4 (&acc)[2][2][4][2], const Unit& u, int wr, int wc, int fr, int fq, PG8_LAS unsigned char* lds, int wid, int lane) const {
        asm volatile("" : "+v"(fr), "+v"(fq));
        const int tid = wid * 64 + lane;
        const int rl = tid >> 2, p = (tid >> 1) & 1, hf = tid & 1, q4 = tid & 3;
#pragma unroll
        for (int pass = 0; pass < 2; ++pass) {
#pragma unroll
            for (int m = 0; m < 4; ++m)
#pragma unroll
                for (int bj = 0; bj < 2; ++bj)
#pragma unroll
                    for (int n = 0; n < 2; ++n) *(PG8_LAS f32x4*)(lds + (size_t)(wr * 64 + m * 16 + fr) * 1056 + bj * 528 + (wc * 32 + n * 16 + fq * 4) * 4) = acc[pass][bj][m][n];
            asm volatile("s_waitcnt lgkmcnt(0)" ::: "memory"); __builtin_amdgcn_s_barrier(); asm volatile("" ::: "memory");
            const int row = u.pm * BM + pass * HALF + rl;
            unsigned tk[16];
#pragma unroll
            for (int i = 0; i < 16; ++i) tk[i] = 0u;
            const PG8_LAS unsigned char* sp = lds + (size_t)rl * 1056 + p * 528 + hf * 256;
#pragma nounroll
            for (int c = 0; c < 4; ++c) { unsigned ch[16];
#pragma unroll
                for (int e4 = 0; e4 < 4; ++e4) { const f32x4 v = *(const PG8_LAS f32x4*)(sp + c * 64 + e4 * 16);
#pragma unroll
                    for (int e = 0; e < 4; ++e) ch[4 * e4 + e] = (f2key(v[e]) & ~127u) | (unsigned)(127 - (64 * hf + 16 * c + 4 * e4 + e)); }
                bitonic_sort16(ch);
                merge_top16(tk, ch);
            }
            merge_top16_xor<1>(tk);
            asm volatile("s_waitcnt lgkmcnt(0)" ::: "memory");
            PG8_LAS unsigned* kl = (PG8_LAS unsigned*)(lds + (size_t)(rl & ~15) * 1056) + ((rl & 15) * 2) * 16;
            if (hf == 0) {
#pragma unroll
                for (int i = 0; i < 4; ++i) *(PG8_LAS u32x4*)(kl + p * 16 + 4 * i) = (u32x4){tk[4 * i], tk[4 * i + 1], tk[4 * i + 2], tk[4 * i + 3]}; }
            asm volatile("s_waitcnt lgkmcnt(0)" ::: "memory");
            unsigned ck[16];
#define CAND_SLOT(m_, ij__) do { const unsigned i__ = (ij__) >> 4, j__ = (ij__) & 15u; \
                const unsigned ka__ = kl[(ij__) == 0xFFFFu ? 0u : i__], kb__ = kl[16 + ((ij__) == 0xFFFFu ? 0u : j__)]; \
                const float s__ = key2f(ka__ & ~127u) + key2f(kb__ & ~127u); \
                ck[m_] = (ij__) == 0xFFFFu ? 0u : ((f2key(s__) & ~255u) | (255u - (ij__))); } while (0)
                { const unsigned ij_ = q4 == 0 ? 0u : q4 == 1 ? 1u : q4 == 2 ? 2u : 3u; CAND_SLOT(0, ij_); }
                { const unsigned ij_ = q4 == 0 ? 4u : q4 == 1 ? 5u : q4 == 2 ? 6u : 7u; CAND_SLOT(1, ij_); }
                { const unsigned ij_ = q4 == 0 ? 8u : q4 == 1 ? 9u : q4 == 2 ? 10u : 11u; CAND_SLOT(2, ij_); }
                { const unsigned ij_ = q4 == 0 ? 12u : q4 == 1 ? 13u : q4 == 2 ? 14u : 15u; CAND_SLOT(3, ij_); }
                { const unsigned ij_ = q4 == 0 ? 16u : q4 == 1 ? 17u : q4 == 2 ? 18u : 19u; CAND_SLOT(4, ij_); }
                { const unsigned ij_ = q4 == 0 ? 20u : q4 == 1 ? 21u : q4 == 2 ? 22u : 23u; CAND_SLOT(5, ij_); }
                { const unsigned ij_ = q4 == 0 ? 32u : q4 == 1 ? 33u : q4 == 2 ? 34u : 35u; CAND_SLOT(6, ij_); }
                { const unsigned ij_ = q4 == 0 ? 36u : q4 == 1 ? 48u : q4 == 2 ? 49u : 50u; CAND_SLOT(7, ij_); }
                { const unsigned ij_ = q4 == 0 ? 51u : q4 == 1 ? 64u : q4 == 2 ? 65u : 66u; CAND_SLOT(8, ij_); }
                { const unsigned ij_ = q4 == 0 ? 80u : q4 == 1 ? 81u : q4 == 2 ? 96u : 97u; CAND_SLOT(9, ij_); }
                { const unsigned ij_ = q4 == 0 ? 112u : q4 == 1 ? 113u : q4 == 2 ? 128u : 144u; CAND_SLOT(10, ij_); }
                { const unsigned ij_ = q4 == 0 ? 160u : q4 == 1 ? 176u : q4 == 2 ? 192u : 208u; CAND_SLOT(11, ij_); }
                { const unsigned ij_ = q4 == 0 ? 224u : q4 == 1 ? 240u : q4 == 2 ? 65535u : 65535u; CAND_SLOT(12, ij_); }
#undef CAND_SLOT
            ck[13] = 0u; ck[14] = 0u; ck[15] = 0u;
            bitonic_sort16(ck);
            merge_top16_xor<1>(ck); merge_top16_xor<2>(ck);
            float sq = 0.f;
#pragma unroll
            for (int i = 0; i < 4; ++i) { const f32x4 t = *(const f32x4*)(ssq + (size_t)row * 16 + 4 * i); sq += (t[0] + t[1]) + (t[2] + t[3]); }
            const float r2 = __builtin_amdgcn_rsqf(sq * (1.0f / 1024.0f) + 1e-6f);
            if (u.pn == 0 && q4 == 0) rinv2[row] = r2;
            const float b0 = key2f(ck[0] & ~255u); float wsum = 0.f; float wv[16];
#pragma unroll
            for (int q = 0; q < 16; ++q) { wv[q] = __builtin_amdgcn_exp2f((key2f(ck[q] & ~255u) - b0) * r2 * 1.4426950408889634f); wsum += wv[q]; }
            const float inv = 1.0f / wsum;
            unsigned short eo[4]; float go[4];
#pragma unroll
            for (int e = 0; e < 4; ++e) { unsigned c0 = ck[e], c1 = ck[4 + e], c2 = ck[8 + e], c3 = ck[12 + e]; float w0 = wv[e], w1 = wv[4 + e], w2 = wv[8 + e], w3 = wv[12 + e];
                asm volatile("" : "+v"(c0), "+v"(c1), "+v"(c2), "+v"(c3), "+v"(w0), "+v"(w1), "+v"(w2), "+v"(w3));
                const unsigned cc = q4 == 0 ? c0 : q4 == 1 ? c1 : q4 == 2 ? c2 : c3; const float ww = q4 == 0 ? w0 : q4 == 1 ? w1 : q4 == 2 ? w2 : w3;
                const unsigned code = 255u - (cc & 255u);
                const unsigned i1 = 127u - (kl[code >> 4] & 127u), i2 = 127u - (kl[16 + (code & 15u)] & 127u);
                eo[e] = (unsigned short)(i1 * 128u + i2); go[e] = ww * inv; }
            const size_t ob = ((size_t)row * 8 + u.pn) * 16 + q4 * 4;
            { u32x2 w; w.x = eo[0] | ((unsigned)eo[1] << 16); w.y = eo[2] | ((unsigned)eo[3] << 16); *(u32x2*)(ids + ob) = w; }
            *(f32x4*)(gw + ob) = (f32x4){go[0], go[1], go[2], go[3]};
            asm volatile("s_waitcnt lgkmcnt(0)" ::: "memory"); __builtin_amdgcn_s_barrier(); asm volatile("" ::: "memory");
        }
    }
};
template <class Epi, class Sched, bool ALIGN_EPI = false, bool SP2 = false, bool FP8 = false>
__device__ __forceinline__ void gemm_phase(PG8_LAS unsigned char* lds, const Gemm g, const Sched& S, const Epi& E) {
    const int tid = threadIdx.x, wid = __builtin_amdgcn_readfirstlane(tid >> 6), lane = tid & 63, wr = wid >> 2, wc = wid & 3, fr = lane & 15, fq = lane >> 4;
    const int K = g.K, nt = K / BK;
    unsigned voffA[2], voffB[2];
#pragma unroll
    for (int i = 0; i < 2; ++i) { int R, C; stage_rc(tid * 16 + i * 8192, R, C); const int Rb = Epi::PERM ? ((R & ~31) + perm32(R & 31)) : R;
        voffA[i] = (unsigned)(R * K + C) * 2u; voffB[i] = (unsigned)(Rb * K + C) * 2u; }
    const size_t kstep = (size_t)(BK * 2);
    const size_t hstep = (size_t)HALF * K * 2;
    const size_t tstep = 2 * hstep;
    const unsigned ldsw = (unsigned)wid * 1024u;
    const int aoff = lds_byte(wr * 64 + fr, fq * 8), boff = lds_byte(wc * 32 + fr, fq * 8);
#define PG8_SA(b, h) (((b) * 2 + (h)) * HTB)
#define PG8_SB(b, h) ((4 + (b) * 2 + (h)) * HTB)
#define PG8_STAGE(bufoff, gbase, voff) do { _Pragma("unroll") for (int _i = 0; _i < 2; ++_i) \
        __builtin_amdgcn_global_load_lds((const unsigned*)((const char*)(gbase) + (voff)[_i]), (PG8_LAS unsigned*)(lds + (bufoff) + ldsw + _i * 8192), 16, 0, 0); } while (0)
#define PG8_LD8(lo_, hi_) __builtin_bit_cast(i32x8, __builtin_shufflevector((lo_), (hi_), 0, 1, 2, 3, 4, 5, 6, 7))
#define PG8_LDA(dst, b, h) do { if constexpr (FP8) { _Pragma("unroll") for (int m = 0; m < 4; ++m) { const u32x4 l0_ = *(const PG8_LAS u32x4*)(lds + PG8_SA(b, h) + aoff + m * 2048), l1_ = *(const PG8_LAS u32x4*)(lds + PG8_SA(b, h) + aoff + m * 2048 + 1024); dst##8[m] = PG8_LD8(l0_, l1_); } } \
        else { _Pragma("unroll") for (int m = 0; m < 4; ++m) _Pragma("unroll") for (int k = 0; k < 2; ++k) dst[m][k] = *(const PG8_LAS bf16x8*)(lds + PG8_SA(b, h) + aoff + m * 2048 + k * 1024); } } while (0)
#define PG8_LDB(dst, b, h) do { if constexpr (FP8) { _Pragma("unroll") for (int n = 0; n < 2; ++n) { const u32x4 l0_ = *(const PG8_LAS u32x4*)(lds + PG8_SB(b, h) + boff + n * 2048), l1_ = *(const PG8_LAS u32x4*)(lds + PG8_SB(b, h) + boff + n * 2048 + 1024); dst##8[n] = PG8_LD8(l0_, l1_); } } \
        else { _Pragma("unroll") for (int n = 0; n < 2; ++n) _Pragma("unroll") for (int k = 0; k < 2; ++k) dst[n][k] = *(const PG8_LAS bf16x8*)(lds + PG8_SB(b, h) + boff + n * 2048 + k * 1024); } } while (0)
#define PG8_MMA(ai, bj, At, Bt) do { __builtin_amdgcn_s_setprio(1); \
        if constexpr (FP8) { _Pragma("unroll") for (int m = 0; m < 4; ++m) _Pragma("unroll") for (int n = 0; n < 2; ++n) \
            asm volatile("v_mfma_scale_f32_16x16x128_f8f6f4 %0, %1, %2, %0, %3, %3 op_sel_hi:[0,0,0]" : "+v"(acc[ai][bj][m][n]) : "v"(Bt##8[n]), "v"(At##8[m]), "v"(sc127));     \
            } \
        else { _Pragma("unroll") for (int m = 0; m < 4; ++m) _Pragma("unroll") for (int n = 0; n < 2; ++n) _Pragma("unroll") for (int k = 0; k < 2; ++k) \
            acc[ai][bj][m][n] = __builtin_amdgcn_mfma_f32_16x16x32_bf16(Bt[n][k], At[m][k], acc[ai][bj][m][n], 0, 0, 0); } \
        __builtin_amdgcn_s_setprio(0); } while (0)
#define PG8_WAIT_V(n) asm volatile("s_waitcnt vmcnt(" #n ")" ::: "memory")
#define PG8_WAIT_L(n) asm volatile("s_waitcnt lgkmcnt(" #n ")" ::: "memory")
#define PG8_BAR __builtin_amdgcn_s_barrier()
#define PG8_SCHED __builtin_amdgcn_sched_barrier(0)
    Unit cur, nxt; int ui = 0;
    if (!S.next(0, cur)) return;
    f32x4 acc[2][2][4][2];
#pragma unroll
    for (int a = 0; a < 2; ++a)
#pragma unroll
        for (int b = 0; b < 2; ++b)
#pragma unroll
            for (int m = 0; m < 4; ++m)
#pragma unroll
                for (int n = 0; n < 2; ++n) acc[a][b][m][n] = (f32x4){0.f, 0.f, 0.f, 0.f};
    bf16x8 At[4][2], B0[2][2], B1[2][2]; i32x8 At8[4], B08[2], B18[2];
    int sc127 = 127; asm volatile("" : "+v"(sc127));
    const char* cA = (const char*)g.A + (size_t)cur.pm * tstep; const char* cB = (const char*)g.Bt + (size_t)cur.pn * tstep;
    S.a_ready(cur);
    if constexpr (SP2) {
        PG8_STAGE(PG8_SB(0, 0), cB, voffB); PG8_STAGE(PG8_SB(0, 1), cB + hstep, voffB); PG8_STAGE(PG8_SA(0, 0), cA, voffA); PG8_STAGE(PG8_SA(0, 1), cA + hstep, voffA);
        if (wr == 1) PG8_BAR;
        PG8_WAIT_V(2); PG8_BAR;
        PG8_STAGE(PG8_SB(1, 0), cB + kstep, voffB); PG8_STAGE(PG8_SA(1, 0), cA + kstep, voffA); PG8_STAGE(PG8_SB(1, 1), cB + hstep + kstep, voffB);
        PG8_WAIT_V(6); PG8_BAR;
    } else {
        PG8_STAGE(PG8_SB(0, 0), cB, voffB); PG8_STAGE(PG8_SA(0, 0), cA, voffA); PG8_STAGE(PG8_SB(0, 1), cB + hstep, voffB); PG8_STAGE(PG8_SA(0, 1), cA + hstep, voffA);
        if (wr == 1) PG8_BAR;
        PG8_WAIT_V(4); PG8_BAR;
        PG8_STAGE(PG8_SB(1, 0), cB + kstep, voffB); PG8_STAGE(PG8_SA(1, 0), cA + kstep, voffA); PG8_STAGE(PG8_SB(1, 1), cB + hstep + kstep, voffB);
        PG8_WAIT_V(6); PG8_BAR;
    }
    for (;;) {
        const bool has_next = S.next(ui + 1, nxt);
        const char* nA = has_next ? (const char*)g.A + (size_t)nxt.pm * tstep : cA; const char* nB = has_next ? (const char*)g.Bt + (size_t)nxt.pn * tstep : cB;
        for (int t = 0; t < nt; t += 2) {
            if constexpr (Epi::HAS_MID) { if (t == Epi::MID_T) E.mid(acc, cur, wr, wc, fr, fq); }
            const bool last = (t == nt - 2);
            const char* a1 = cA + (size_t)(t + 1) * kstep;
            const char* a2 = last ? nA : cA + (size_t)(t + 2) * kstep; const char* b2 = last ? nB : cB + (size_t)(t + 2) * kstep;
            const char* a3 = a2 + kstep; const char* b3 = b2 + kstep;
            if (last && has_next) S.a_ready(nxt);
            if constexpr (SP2) {
            PG8_LDB(B0, 0, 0); PG8_LDB(B1, 0, 1); PG8_SCHED; PG8_LDA(At, 0, 0); PG8_STAGE(PG8_SA(1, 1), a1 + hstep, voffA);
            PG8_WAIT_V(8); PG8_WAIT_L(0); PG8_BAR; PG8_MMA(0, 0, At, B0); PG8_MMA(0, 1, At, B1); PG8_BAR; PG8_SCHED;
            PG8_LDA(At, 0, 1); PG8_STAGE(PG8_SB(0, 0), b2, voffB); PG8_STAGE(PG8_SB(0, 1), b2 + hstep, voffB); PG8_STAGE(PG8_SA(0, 0), a2, voffA);
            PG8_WAIT_V(8); PG8_WAIT_L(0); PG8_BAR; PG8_MMA(1, 0, At, B0); PG8_MMA(1, 1, At, B1); PG8_BAR; PG8_SCHED;
            PG8_LDB(B0, 1, 0); PG8_LDB(B1, 1, 1); PG8_SCHED; PG8_LDA(At, 1, 0); PG8_STAGE(PG8_SA(0, 1), a2 + hstep, voffA);
            PG8_WAIT_V(8); PG8_WAIT_L(0); PG8_BAR; PG8_MMA(0, 0, At, B0); PG8_MMA(0, 1, At, B1); PG8_BAR; PG8_SCHED;
            PG8_LDA(At, 1, 1); PG8_STAGE(PG8_SB(1, 0), b3, voffB); PG8_STAGE(PG8_SB(1, 1), b3 + hstep, voffB); PG8_STAGE(PG8_SA(1, 0), a3, voffA);
            PG8_WAIT_V(8); PG8_WAIT_L(0); PG8_BAR; PG8_MMA(1, 0, At, B0); PG8_MMA(1, 1, At, B1); PG8_BAR; PG8_SCHED;
            } else {
            PG8_LDB(B0, 0, 0); PG8_SCHED; PG8_LDA(At, 0, 0); PG8_STAGE(PG8_SA(1, 1), a1 + hstep, voffA);
            PG8_WAIT_L(8); PG8_BAR; PG8_WAIT_L(0); PG8_MMA(0, 0, At, B0); PG8_BAR; PG8_SCHED;
            PG8_LDB(B1, 0, 1); PG8_STAGE(PG8_SB(0, 0), b2, voffB);
            PG8_BAR; PG8_WAIT_L(0); PG8_MMA(0, 1, At, B1); PG8_BAR;
            PG8_LDA(At, 0, 1); PG8_STAGE(PG8_SA(0, 0), a2, voffA);
            PG8_BAR; PG8_WAIT_L(0); PG8_MMA(1, 0, At, B0); PG8_BAR; PG8_SCHED;
            PG8_STAGE(PG8_SB(0, 1), b2 + hstep, voffB);
            PG8_WAIT_V(6); PG8_BAR; PG8_MMA(1, 1, At, B1); PG8_BAR;
            PG8_LDB(B0, 1, 0); PG8_SCHED; PG8_LDA(At, 1, 0); PG8_STAGE(PG8_SA(0, 1), a2 + hstep, voffA);
            PG8_WAIT_L(8); PG8_BAR; PG8_WAIT_L(0); PG8_MMA(0, 0, At, B0); PG8_BAR; PG8_SCHED;
            PG8_LDB(B1, 1, 1); PG8_STAGE(PG8_SB(1, 0), b3, voffB);
            PG8_BAR; PG8_WAIT_L(0); PG8_MMA(0, 1, At, B1); PG8_BAR;
            PG8_LDA(At, 1, 1); PG8_STAGE(PG8_SA(1, 0), a3, voffA);
            PG8_BAR; PG8_WAIT_L(0); PG8_MMA(1, 0, At, B0); PG8_BAR; PG8_SCHED;
            PG8_STAGE(PG8_SB(1, 1), b3 + hstep, voffB);
            PG8_WAIT_V(6); PG8_BAR; PG8_MMA(1, 1, At, B1); PG8_BAR;
            }
        }
        if constexpr (FP8) asm volatile("s_nop 15\n\ts_nop 15" ::: "memory");
        if constexpr (ALIGN_EPI) { if (wr == 0) PG8_BAR; }
        if constexpr (!Epi::AFTER_DRAIN) { E(acc, cur, wr, wc, fr, fq); S.done(cur); }
        if (!has_next) break;
#pragma unroll
        for (int a = 0; a < 2; ++a)
#pragma unroll
            for (int b = 0; b < 2; ++b)
#pragma unroll
                for (int m = 0; m < 4; ++m)
#pragma unroll
                    for (int n = 0; n < 2; ++n) acc[a][b][m][n] = (f32x4){0.f, 0.f, 0.f, 0.f};
        cur = nxt; cA = nA; cB = nB; ++ui;
        if constexpr (ALIGN_EPI) { if (wr == 1) PG8_BAR; }
    }
    PG8_WAIT_V(0);
    if constexpr (!ALIGN_EPI) { if (wr == 0) PG8_BAR; }
    PG8_BAR;
    if constexpr (Epi::AFTER_DRAIN) { E.fused(acc, cur, wr, wc, fr, fq, lds, wid, lane); S.done(cur); }
#undef PG8_SA
#undef PG8_SB
#undef PG8_STAGE
#undef PG8_LDA
#undef PG8_LD8
#undef PG8_LDB
#undef PG8_MMA
#undef PG8_WAIT_V
#undef PG8_WAIT_L
#undef PG8_BAR
#undef PG8_SCHED
}
}


namespace att {
#define ALAS __attribute__((address_space(3)))
typedef unsigned short bf16;
typedef short bf16x8 __attribute__((ext_vector_type(8)));
typedef short s16x4 __attribute__((ext_vector_type(4)));
typedef float f32x16 __attribute__((ext_vector_type(16)));
typedef float f32x4 __attribute__((ext_vector_type(4)));
typedef float f32x2 __attribute__((ext_vector_type(2)));
typedef unsigned u32x4 __attribute__((ext_vector_type(4)));
typedef __bf16 bf16x2_t __attribute__((ext_vector_type(2)));
constexpr int SEQ = 4096;
constexpr int VPITCH = 144;
constexpr float LOG2E = 1.4426950408889634f, LN2 = 0.6931471805599453f;
__device__ __forceinline__ unsigned pkbf(float lo, float hi) { f32x2 v = {lo, hi}; bf16x2_t b = __builtin_convertvector(v, bf16x2_t); return __builtin_bit_cast(unsigned, b); }
__device__ __forceinline__ void wave_lds_sync() { asm volatile("s_waitcnt lgkmcnt(0)" ::: "memory"); }
__device__ __forceinline__ s16x4 vtr(const ALAS unsigned char* p) { return __builtin_bit_cast(s16x4, __builtin_amdgcn_ds_read_tr16_b64_v4i16((ALAS s16x4*)p)); }
__device__ __forceinline__ int crow(int r, int hi) { return (r & 3) + 8 * (r >> 2) + 4 * hi; }

__device__ __forceinline__ void pv_tile(f32x16& o0, f32x16& o1, const float (&a)[16], const ALAS unsigned char* vt, int lane) {
    const int g = lane >> 4, i = lane & 15, q_ = i >> 2, p_ = i & 3, h = lane >> 5;
    const ALAS unsigned char* vb = vt + (8 * h + q_) * VPITCH + (16 * (g & 1) + 4 * p_) * 2;
    u32x4 pw0, pw1;
    pw0.x = pkbf(a[0], a[1]); pw0.y = pkbf(a[2], a[3]); pw0.z = pkbf(a[4], a[5]); pw0.w = pkbf(a[6], a[7]);
    pw1.x = pkbf(a[8], a[9]); pw1.y = pkbf(a[10], a[11]); pw1.z = pkbf(a[12], a[13]); pw1.w = pkbf(a[14], a[15]);
    const bf16x8 pa0 = __builtin_bit_cast(bf16x8, pw0), pa1 = __builtin_bit_cast(bf16x8, pw1);
#pragma unroll
    for (int s = 0; s < 2; ++s) {
        const s16x4 l0 = vtr(vb + (16 * s) * VPITCH), h0 = vtr(vb + (16 * s + 4) * VPITCH);
        const s16x4 l1 = vtr(vb + (16 * s) * VPITCH + 64), h1 = vtr(vb + (16 * s + 4) * VPITCH + 64);
        const bf16x8 v0 = (bf16x8){l0[0], l0[1], l0[2], l0[3], h0[0], h0[1], h0[2], h0[3]};
        const bf16x8 v1 = (bf16x8){l1[0], l1[1], l1[2], l1[3], h1[0], h1[1], h1[2], h1[3]};
        o0 = __builtin_amdgcn_mfma_f32_32x32x16_bf16(s ? pa1 : pa0, v0, o0, 0, 0, 0);
        o1 = __builtin_amdgcn_mfma_f32_32x32x16_bf16(s ? pa1 : pa0, v1, o1, 0, 0, 0);
    }
}
__device__ __forceinline__ void bcast_rows(float v, ALAS float* sc, int r32, int hi, float (&out)[16]) {
    if (hi == 0) sc[r32] = v;
    wave_lds_sync();
#pragma unroll
    for (int g = 0; g < 4; ++g) { const f32x4 t = *(const ALAS f32x4*)(sc + 8 * g + 4 * hi); out[4 * g] = t[0]; out[4 * g + 1] = t[1]; out[4 * g + 2] = t[2]; out[4 * g + 3] = t[3]; }
    wave_lds_sync();
}
__device__ __forceinline__ void store_o(const f32x16& o0, const f32x16& o1, ALAS unsigned char* stg, bf16* dst  , size_t rstride_elems, int lane) {
    const int r32 = lane & 31, hi = lane >> 5;
    wave_lds_sync();
#pragma unroll
    for (int r = 0; r < 16; ++r) { const int q = crow(r, hi);
        *(ALAS unsigned short*)(stg + q * VPITCH + r32 * 2) = (unsigned short)(pkbf(o0[r], 0.f) & 0xffffu);
        *(ALAS unsigned short*)(stg + q * VPITCH + 64 + r32 * 2) = (unsigned short)(pkbf(o1[r], 0.f) & 0xffffu); }
    wave_lds_sync();
#pragma unroll
    for (int i = 0; i < 4; ++i) { const int row = 8 * i + (lane >> 3), ch = lane & 7; const u32x4 v = *(const ALAS u32x4*)(stg + row * VPITCH + ch * 16); *(u32x4*)(dst + (size_t)row * rstride_elems + ch * 8) = v; }
    wave_lds_sync();
}

__device__ __forceinline__ void sb_item(const bf16* QS, const bf16* KS, const bf16* VS, bf16* OC, int b, int h, int qt, ALAS unsigned char* wl, int lane) {
    const int r32 = lane & 31, hi = lane >> 5;
    const int t0 = qt * 32; const size_t rowb = (size_t)b * SEQ;
    const int kperm = (r32 & ~12) | ((r32 & 4) << 1) | ((r32 & 8) >> 1);
    bf16x8 qf[4];
    { const bf16* qp = QS + (rowb + t0 + r32) * 512 + h * 64 + hi * 8;
#pragma unroll
      for (int d0 = 0; d0 < 4; ++d0) qf[d0] = *(const bf16x8*)(qp + d0 * 16); }
    f32x16 o0 = {}, o1 = {}; float R = 0.f;
    for (int key0 = t0; key0 >= 0; key0 -= 32) {
        const bf16* kp = KS + (rowb + key0 + kperm) * 512 + h * 64 + hi * 8;
        bf16x8 kf[4];
#pragma unroll
        for (int d0 = 0; d0 < 4; ++d0) kf[d0] = *(const bf16x8*)(kp + d0 * 16);
        u32x4 vv[4];
#pragma unroll
        for (int i = 0; i < 4; ++i) vv[i] = *(const u32x4*)(VS + (rowb + key0 + 8 * i + (lane >> 3)) * 512 + h * 64 + (lane & 7) * 8);
        f32x16 p = {};
#pragma unroll
        for (int d0 = 0; d0 < 4; ++d0) p = __builtin_amdgcn_mfma_f32_32x32x16_bf16(kf[d0], qf[d0], p, 0, 0, 0);
#pragma unroll
        for (int i = 0; i < 4; ++i) *(ALAS u32x4*)(wl + (8 * i + (lane >> 3)) * VPITCH + (lane & 7) * 16) = vv[i];
        const bool diag = (key0 == t0);
        float z2[16], L2[16];
#pragma unroll
        for (int r = 0; r < 16; ++r) { const int kk = (r & 7) + 8 * hi + 16 * (r >> 3); const float zz = p[r];
            const float sp = fmaxf(zz, 0.f) + __builtin_amdgcn_logf(1.0f + __builtin_amdgcn_exp2f(-fabsf(zz)));
            const bool valid = !diag || (kk < r32); z2[r] = zz; L2[r] = valid ? sp : 0.f; }
        float c[16];
        c[15] = L2[15];
#pragma unroll
        for (int r = 14; r >= 8; --r) c[r] = c[r + 1] + L2[r];
        c[7] = L2[7];
#pragma unroll
        for (int r = 6; r >= 0; --r) c[r] = c[r + 1] + L2[r];
        const float TB = c[8], TA = c[0];
        const float TBo = __shfl_xor(TB, 32), TAo = __shfl_xor(TA, 32);
        const float offB = R + (hi ? 0.f : TBo);
        const float offA = R + TB + TBo + (hi ? 0.f : TAo);
        float a[16];
#pragma unroll
        for (int r = 0; r < 16; ++r) { const int kk = (r & 7) + 8 * hi + 16 * (r >> 3); const bool valid = !diag || (kk < r32);
            const float e = __builtin_amdgcn_exp2f(z2[r] - (c[r] + (r < 8 ? offA : offB))); a[r] = valid ? e : 0.f; }
        R += (TA + TB) + (TAo + TBo);
        wave_lds_sync();
        pv_tile(o0, o1, a, wl, lane);
        wave_lds_sync();
        if (__all(R > 40.0f * LOG2E)) break;
    }
    store_o(o0, o1, wl, OC + (rowb + t0) * 768 + h * 64, 768, lane);
}

constexpr int DLU_WAVE = 5120;
constexpr int DLU_O = 8 * DLU_WAVE, DLU_M = DLU_O + 512 * 128, DLU_L = DLU_M + 2048, DLU_BYTES = DLU_L + 2048;
__device__ __forceinline__ void dl_unit(const bf16* QD, const bf16* KD, const bf16* VD, bf16* OC, int b, int j, int blk, ALAS unsigned char* lds, int wave, int lane) {
    const int r32 = lane & 31, hi = lane >> 5;
    const size_t rowb = (size_t)b * SEQ;
    const int t0 = 512 * blk;
    const int kperm = (r32 & ~12) | ((r32 & 4) << 1) | ((r32 & 8) >> 1);
    ALAS unsigned char* wl = lds + wave * DLU_WAVE;
    ALAS float* sc = (ALAS float*)(wl + 4608);
    ALAS unsigned short* OL = (ALAS unsigned short*)(lds + DLU_O);
    ALAS float* ML = (ALAS float*)(lds + DLU_M); ALAS float* LL = (ALAS float*)(lds + DLU_L);
    for (int g = 2; g >= 0; --g) {
        const int hh = 4 * g + j, sh = 2 * g, r = 1 << sh;
        const float slope2 = __builtin_amdgcn_exp2f(-8.0f * (float)(hh + 1) / 12.0f) * LOG2E;
        const float sr = slope2 * (float)r;
        for (int it = wave; it < 16; it += 8) {
            const int q0 = g == 2 ? it : g == 1 ? (it & 3) + 128 * (it >> 2) : 32 * it;
            const int tq = t0 + q0 + r * r32, tmax = t0 + q0 + 31 * r;
            bf16x8 qf[4];
            { const bf16* qp = QD + (rowb + tq) * 768 + hh * 64 + hi * 8;
#pragma unroll
              for (int d0 = 0; d0 < 4; ++d0) qf[d0] = *(const bf16x8*)(qp + d0 * 16); }
            const int klo = 31 - r32; int khi = klo + 128; { const int kmaxtok = tmax >> sh; khi = khi < kmaxtok ? khi : kmaxtok; }
            const unsigned krange = (unsigned)(khi - klo);
            f32x16 o0 = {}, o1 = {}; float mrun = -3.0e38f, lrun = 0.f;
            if (g != 2) {
                mrun = ML[q0 + r * r32]; lrun = hi ? 0.f : LL[q0 + r * r32];
#pragma unroll
                for (int q = 0; q < 16; ++q) { const int tl = q0 + r * crow(q, hi);
                    o0[q] = __uint_as_float((unsigned)OL[tl * 64 + r32] << 16); o1[q] = __uint_as_float((unsigned)OL[tl * 64 + 32 + r32] << 16); }
            }
            for (int kt = 0; kt < 5; ++kt) {
                int sk = tmax - r * (32 * kt + kperm); sk = sk < 0 ? 0 : sk;
                const bf16* kp = KD + (rowb + sk) * 768 + hh * 64 + hi * 8;
                bf16x8 kf[4];
#pragma unroll
                for (int d0 = 0; d0 < 4; ++d0) kf[d0] = *(const bf16x8*)(kp + d0 * 16);
                u32x4 vv[4];
#pragma unroll
                for (int i = 0; i < 4; ++i) { int sv = tmax - r * (32 * kt + 8 * i + (lane >> 3)); sv = sv < 0 ? 0 : sv; vv[i] = *(const u32x4*)(VD + (rowb + sv) * 768 + hh * 64 + (lane & 7) * 8); }
                const int dk = 32 * kt + 8 * hi - klo;
                const float tb = -sr * (float)dk;
                f32x16 p;
#pragma unroll
                for (int q = 0; q < 16; ++q) p[q] = tb - sr * (float)((q & 7) + 16 * (q >> 3));
#pragma unroll
                for (int d0 = 0; d0 < 4; ++d0) p = __builtin_amdgcn_mfma_f32_32x32x16_bf16(kf[d0], qf[d0], p, 0, 0, 0);
#pragma unroll
                for (int i = 0; i < 4; ++i) *(ALAS u32x4*)(wl + (8 * i + (lane >> 3)) * VPITCH + (lane & 7) * 16) = vv[i];
                float z2[16]; float mt = -3.0e38f;
#pragma unroll
                for (int q = 0; q < 16; ++q) { const bool valid = (unsigned)(dk + ((q & 7) + 16 * (q >> 3))) <= krange; z2[q] = valid ? p[q] : -INFINITY; mt = fmaxf(mt, z2[q]); }
                mt = fmaxf(mt, __shfl_xor(mt, 32));
                if (__any(mt > mrun + 8.0f)) {
                    const float mnew = fmaxf(mrun, mt); const float alpha = __builtin_amdgcn_exp2f(mrun - mnew);
                    lrun *= alpha; float al[16]; bcast_rows(alpha, sc, r32, hi, al);
#pragma unroll
                    for (int q = 0; q < 16; ++q) { o0[q] *= al[q]; o1[q] *= al[q]; }
                    mrun = mnew;
                }
                float a[16]; float ls = 0.f;
#pragma unroll
                for (int q = 0; q < 16; ++q) { a[q] = __builtin_amdgcn_exp2f(z2[q] - mrun); ls += a[q]; }
                lrun += ls;
                wave_lds_sync();
                pv_tile(o0, o1, a, wl, lane);
                wave_lds_sync();
            }
            const float ltot = lrun + __shfl_xor(lrun, 32);
            if (g != 0) {
                if (hi == 0) { ML[q0 + r * r32] = mrun; LL[q0 + r * r32] = ltot; }
#pragma unroll
                for (int q = 0; q < 16; ++q) { const int tl = q0 + r * crow(q, hi);
                    OL[tl * 64 + r32] = (unsigned short)(pkbf(o0[q], 0.f) & 0xffffu); OL[tl * 64 + 32 + r32] = (unsigned short)(pkbf(o1[q], 0.f) & 0xffffu); }
            } else {
                float il[16]; bcast_rows(1.0f / ltot, sc, r32, hi, il);
#pragma unroll
                for (int q = 0; q < 16; ++q) { o0[q] *= il[q]; o1[q] *= il[q]; }
                store_o(o0, o1, wl, OC + (rowb + t0 + q0) * 768 + 512 + j * 64, 768, lane);
            }
        }
        asm volatile("s_waitcnt lgkmcnt(0)" ::: "memory"); __builtin_amdgcn_s_barrier(); asm volatile("" ::: "memory");
    }
}
#undef ALAS
}

constexpr int NWAVES = 8;
#ifndef MK_N_LAUNCHES
#define MK_N_LAUNCHES 1
#endif
#ifndef MK_LAST_PHASE
#define MK_LAST_PHASE 8
#endif
constexpr int N_LAUNCHES = MK_N_LAUNCHES;
constexpr int PER_PHASE = 8;

constexpr int BATCH = 16, SEQ = 4096, D = 1024, T = BATCH * SEQ;
constexpr int N1 = 5888;
constexpr int NEXP = 16384;
constexpr size_t MiB = 1u << 20;
constexpr size_t WS_CTL = 0, CTL_ZERO_BYTES = 1 * MiB;
constexpr size_t WS_WIN = 2 * MiB;
constexpr size_t WS_WCAT = 16 * MiB;
constexpr size_t WS_WOUT = 18 * MiB;
constexpr size_t WS_WC = 20 * MiB;
constexpr size_t WS_RINV1 = 24 * MiB;
constexpr size_t WS_RINV2 = 25 * MiB;
constexpr size_t WS_USC = 25 * MiB + 512 * 1024, WS_VSC = 25 * MiB + 768 * 1024;
constexpr size_t WS_SSQ = 26 * MiB;
constexpr size_t WS_U8 = 32 * MiB;
constexpr size_t WS_V8 = 64 * MiB;
constexpr size_t WS_IDS = 96 * MiB;
constexpr size_t WS_GW = 112 * MiB;
constexpr size_t WS_XB = 144 * MiB;
constexpr size_t WS_OC = 880 * MiB;
constexpr size_t WS_QS = 272 * MiB, WS_KS = 336 * MiB, WS_VS = 400 * MiB;
constexpr size_t WS_QD = 464 * MiB, WS_KD = 560 * MiB, WS_VD = 656 * MiB;
constexpr size_t WS_GT = 752 * MiB;
constexpr size_t WS_COEF = 272 * MiB;
constexpr size_t WS_MIX = 272 * MiB;
constexpr size_t WS_X1B = 400 * MiB;
constexpr size_t WS_HQ = 528 * MiB;
constexpr size_t WS_HS2 = 24 * MiB + 512 * 1024;
constexpr size_t WS_XB8 = 72 * MiB;
constexpr size_t WS_WG8 = 40 * MiB;
constexpr size_t WS_GCS = 45 * MiB;
constexpr size_t WS_END = 1008 * MiB;
constexpr int CW_BAR = 4096;
constexpr int CW_GMAX = 16384;
constexpr int CW_XRANK = 8192;

constexpr int RING_OFF = 0, RING_BYTES = 131072;
constexpr int LDSCTL_OFF = 143360, MISC_OFF = LDSCTL_OFF + 320;
constexpr int LDS_BYTES = 147456;
static_assert(MISC_OFF + 128 <= LDS_BYTES, "LDS map");
#define GAS __attribute__((address_space(1)))
#define LAS __attribute__((address_space(3)))
typedef unsigned short bf16;
typedef unsigned v4u __attribute__((ext_vector_type(4)));
typedef float f32x4 __attribute__((ext_vector_type(4)));
typedef short bf16x8 __attribute__((ext_vector_type(8)));
typedef GAS unsigned gu32;
typedef GAS unsigned long long gu64;
#define RLX_AGENT __ATOMIC_RELAXED, __HIP_MEMORY_SCOPE_AGENT
#define LDS_WAIT() asm volatile("s_waitcnt lgkmcnt(0)" ::: "memory")
#define VM_WAIT() asm volatile("s_waitcnt vmcnt(0)" ::: "memory")
__device__ __forceinline__ unsigned long long rt() { return __builtin_amdgcn_s_memrealtime(); }
__device__ __forceinline__ unsigned f2bf(float f) { unsigned u = __builtin_bit_cast(unsigned, f); return (u + 0x7fffu + ((u >> 16) & 1u)) >> 16; }
__device__ __forceinline__ unsigned pk2(float lo, float hi) { return f2bf(lo) | (f2bf(hi) << 16); }

#define XB_TMO      128
#define XB_XCNT(j)  (256  + 64 * (j))
#define XB_XSUB(j)  (1280 + 64 * (j))
#define XB_XGEN(j)  (2304 + 64 * (j))
#define XB_TOP      3328
#define XB_TOPGEN   3392
#define XCD_BAR_WORDS 3456
#define XB_SPIN_CAP (1u << 18)

__device__ __forceinline__ unsigned xb_ld(unsigned* p)              { return __hip_atomic_load(p, __ATOMIC_RELAXED, __HIP_MEMORY_SCOPE_AGENT); }
__device__ __forceinline__ unsigned xb_add(unsigned* p, unsigned v) { return __hip_atomic_fetch_add(p, v, __ATOMIC_RELAXED, __HIP_MEMORY_SCOPE_AGENT); }
__device__ __forceinline__ unsigned xb_xcc_id() { return (unsigned)__builtin_amdgcn_s_getreg((3 << 11) | 20) & 0xFu; }
#define XB_SPIN(cond, bar) do { unsigned _sp = 0; while (cond) { __builtin_amdgcn_s_sleep(1); \
    if ((++_sp & 255u) == 0u) { if (xb_ld(&(bar)[XB_TMO])) break; if (_sp > XB_SPIN_CAP) { atomicAdd(&(bar)[XB_TMO], 1u); break; } } } } while (0)

struct XcdBarrier {
    unsigned* bar; unsigned x;
    volatile LAS unsigned* st;
};

__device__ __forceinline__ XcdBarrier xcd_barrier_post(unsigned* bar, volatile LAS unsigned* st) {
    XcdBarrier b; b.bar = bar; b.x = xb_xcc_id(); b.st = st;
    if (threadIdx.x == 0) (void)xb_add(&bar[XB_XCNT(b.x)], 1u);
    return b;
}
__device__ __forceinline__ void xcd_barrier_complete(unsigned* bar, unsigned x, unsigned& nloc, unsigned& nx) {
    const unsigned G = gridDim.x * gridDim.y * gridDim.z;
    unsigned sum, cnt, mine, sp = 0u;
    for (;;) {
        sum = 0u; cnt = 0u; mine = 0u;
#pragma unroll
        for (unsigned j = 0; j < 16; ++j) { const unsigned c = xb_ld(&bar[XB_XCNT(j)]); sum += c; cnt += (c > 0u) ? 1u : 0u; mine = (j == x) ? c : mine; }
        if (sum == G) break;
        __builtin_amdgcn_s_sleep(1);
        if ((++sp & 255u) == 0u) { if (xb_ld(&bar[XB_TMO])) break; if (sp > XB_SPIN_CAP) { atomicAdd(&bar[XB_TMO], 1u); break; } }
    }
    nloc = mine > 0u ? mine : 1u; nx = cnt > 0u ? cnt : 1u;
}

__device__ __forceinline__ void xcd_barrier(const XcdBarrier& b) {
    asm volatile("s_waitcnt vmcnt(0)" ::: "memory");
    __syncthreads();
    if (threadIdx.x == 0) {
        unsigned* bar = b.bar;
        __builtin_amdgcn_s_waitcnt(0);
        unsigned nloc = b.st[0], nx = b.st[1];
        if (nloc == 0u) { xcd_barrier_complete(bar, b.x, nloc, nx); b.st[0] = nloc; b.st[1] = nx; }
        const unsigned old = xb_add(&bar[XB_XSUB(b.x)], 1u);
        const unsigned gen = old / nloc;
        if (old + 1u == (gen + 1u) * nloc) {
            __builtin_amdgcn_fence(__ATOMIC_RELEASE, "agent");
            asm volatile("s_waitcnt vmcnt(0)" ::: "memory");
            const unsigned og = xb_add(&bar[XB_TOP], 1u);
            const unsigned tg = og / nx;
            if (og + 1u == (tg + 1u) * nx) xb_add(&bar[XB_TOPGEN], 1u);
            else XB_SPIN(xb_ld(&bar[XB_TOPGEN]) == tg, bar);
            __builtin_amdgcn_fence(__ATOMIC_ACQUIRE, "agent");
            xb_add(&bar[XB_XGEN(b.x)], 1u);
            asm volatile("s_waitcnt vmcnt(0)" ::: "memory");
        } else {
            XB_SPIN(xb_ld(&bar[XB_XGEN(b.x)]) == gen, bar);
            __builtin_amdgcn_fence(__ATOMIC_ACQUIRE, "agent");
            asm volatile("s_waitcnt vmcnt(0)" ::: "memory");
        }
    }
    __syncthreads();
}

typedef float f32x2 __attribute__((ext_vector_type(2)));
typedef unsigned v2u __attribute__((ext_vector_type(2)));
typedef _Float16 h2_t __attribute__((ext_vector_type(2)));
struct Frame {
    LAS unsigned char* lds;
    volatile LAS unsigned* MISC;
    gu32* ctl;
    int tid, lane, wave;
    int vcu, G;
};
__device__ __forceinline__ float wave_sum(float v) {
#pragma unroll
    for (int o = 1; o < 64; o <<= 1) v += __shfl_xor(v, o);
    return v;
}
__device__ __forceinline__ float wave_max(float v) {
#pragma unroll
    for (int o = 1; o < 64; o <<= 1) v = fmaxf(v, __shfl_xor(v, o));
    return v;
}
constexpr int NB16 = 1536, N8 = 5888 - NB16;
__device__ __forceinline__ int win_row(int n) { if (n < 1536 || n >= 3072) return n; const int t = (n - 1536) >> 8, ln = (n - 1536) & 255, hl = ln >> 6, d = ln & 63; return 1536 + t * 256 + 32 * hl + (d & 31) + 128 * (d >> 5); }
__device__ __forceinline__ void p0_transpose_item(const float* W, int N, const float* gain, bf16* WT, int ldt, int koff, int mode, LAS float* scr, int item, int lane) {
    const int nblk = N / 32, kb = item / nblk, nb = item % nblk, k0 = 64 * kb, n0 = 32 * nb;
#pragma unroll 8
    for (int i = 0; i < 32; ++i) { const int kk = 2 * i + (lane >> 5); float v = W[(size_t)(k0 + kk) * N + n0 + (lane & 31)]; if (gain) v *= gain[k0 + kk]; scr[kk * 33 + (lane & 31)] = v; }
    LDS_WAIT(); asm volatile("" ::: "memory");
    const int c = lane & 7;
#pragma unroll
    for (int j = 0; j < 4; ++j) { const int n = (lane >> 3) + 8 * j; const LAS float* s = scr + (8 * c) * 33 + n;
        v4u o; o.x = pk2(s[0 * 33], s[1 * 33]); o.y = pk2(s[2 * 33], s[3 * 33]); o.z = pk2(s[4 * 33], s[5 * 33]); o.w = pk2(s[6 * 33], s[7 * 33]);
        const int rown = mode ? win_row(n0 + n) : (n0 + n);
        *(GAS v4u*)(WT + (size_t)rown * ldt + koff + k0 + 8 * c) = o; }
    LDS_WAIT(); asm volatile("" ::: "memory");
}
__device__ __forceinline__ void p0_gate_max_item(const float* W, int N, const float* gain, unsigned* gmax, int kb, int n0, int lane) {
    const int k0 = 64 * kb; float am = 0.f;
#pragma unroll 8
    for (int i = 0; i < 32; ++i) { const int kk = 2 * i + (lane >> 5); am = fmaxf(am, fabsf(W[(size_t)(k0 + kk) * N + n0 + (lane & 31)] * gain[k0 + kk])); }
    am = fmaxf(am, __shfl_xor(am, 32));
    if (lane < 32) atomicMax(gmax + (n0 - NB16) + lane, __float_as_uint(am));
}
__device__ __forceinline__ void p0_gate_fp8_item(const float* W, int N, const float* gain, const unsigned* gmax, unsigned char* WG, float* cs, LAS float* scr, int item, int lane) {
    const int kb = item / (N8 / 32), nb = item % (N8 / 32), k0 = 64 * kb, n0 = 32 * nb;
#pragma unroll 8
    for (int i = 0; i < 32; ++i) { const int kk = 2 * i + (lane >> 5); scr[kk * 33 + (lane & 31)] = W[(size_t)(k0 + kk) * N + NB16 + n0 + (lane & 31)] * gain[k0 + kk]; }
    LDS_WAIT(); asm volatile("" ::: "memory");
    const int c = lane & 7;
#pragma unroll
    for (int j = 0; j < 4; ++j) { const int n = (lane >> 3) + 8 * j; const LAS float* sp = scr + (8 * c) * 33 + n;
        const unsigned mb = xb_ld((unsigned*)gmax + n0 + n); const int ex = (int)((mb >> 23) & 0xffu);
        const float sc = (ex == 0) ? 1.0f : __uint_as_float((unsigned)(127 + 7 - (ex - 127)) << 23);
        int p0 = __builtin_amdgcn_cvt_pk_fp8_f32(sp[0 * 33] * sc, sp[1 * 33] * sc, 0, false); p0 = __builtin_amdgcn_cvt_pk_fp8_f32(sp[2 * 33] * sc, sp[3 * 33] * sc, p0, true);
        int p1 = __builtin_amdgcn_cvt_pk_fp8_f32(sp[4 * 33] * sc, sp[5 * 33] * sc, 0, false); p1 = __builtin_amdgcn_cvt_pk_fp8_f32(sp[6 * 33] * sc, sp[7 * 33] * sc, p1, true);
        const int prow = win_row(NB16 + n0 + n) - NB16;
        *(GAS v2u*)(WG + (size_t)prow * 1024 + k0 + 8 * c) = (v2u){(unsigned)p0, (unsigned)p1};
        if (kb == 0 && c == 0) cs[prow] = (ex == 0) ? 1.0f : __uint_as_float((unsigned)(127 - 7 + (ex - 127)) << 23); }
    LDS_WAIT(); asm volatile("" ::: "memory");
}
__device__ __forceinline__ void quant_row_fp8(const float* src, const float* gain, unsigned char* dst, size_t slice_stride, float* scale_out, int lane) {
    f32x4 v[4]; float am = 0.f;
#pragma unroll
    for (int j = 0; j < 4; ++j) { v[j] = *(const GAS f32x4*)(src + 256 * j + 4 * lane); if (gain) v[j] = v[j] * *(const GAS f32x4*)(gain + 256 * j + 4 * lane);
        am = fmaxf(am, fmaxf(fmaxf(fabsf(v[j][0]), fabsf(v[j][1])), fmaxf(fabsf(v[j][2]), fabsf(v[j][3])))); }
    am = wave_max(am);
    const int ex = (int)((__float_as_uint(am) >> 23) & 0xffu);
    const float s = (ex == 0) ? 1.0f : __uint_as_float((unsigned)(127 + 7 - (ex - 127)) << 23);
    const float is = (ex == 0) ? 1.0f : __uint_as_float((unsigned)(127 - 7 + (ex - 127)) << 23);
    if (lane == 0) *scale_out = is;
#pragma unroll
    for (int j = 0; j < 4; ++j) { int pk = __builtin_amdgcn_cvt_pk_fp8_f32(v[j][0] * s, v[j][1] * s, 0, false); pk = __builtin_amdgcn_cvt_pk_fp8_f32(v[j][2] * s, v[j][3] * s, pk, true);
        const int col = 256 * j + 4 * lane; *(GAS int*)(dst + (size_t)(col >> 7) * slice_stride + (col & 127)) = pk; }
}
__device__ __forceinline__ void quant_row_fp4(const float* src, unsigned char* dst, size_t slice_stride, float* scale_out, int lane) {
    f32x4 v[4]; float am = 0.f;
#pragma unroll
    for (int j = 0; j < 4; ++j) { v[j] = *(const GAS f32x4*)(src + 256 * j + 4 * lane); am = fmaxf(am, fmaxf(fmaxf(fabsf(v[j][0]), fabsf(v[j][1])), fmaxf(fabsf(v[j][2]), fabsf(v[j][3])))); }
    am = wave_max(am);
    const float s = am > 0.f ? 6.0f / am : 0.f;
    if (lane == 0) *scale_out = am * (1.0f / 6.0f);
#pragma unroll
    for (int j = 0; j < 4; ++j) { unsigned pk = __builtin_amdgcn_cvt_scalef32_pk_fp4_f32(0u, v[j][0] * s, v[j][1] * s, 1.0f, 0); pk = __builtin_amdgcn_cvt_scalef32_pk_fp4_f32(pk, v[j][2] * s, v[j][3] * s, 1.0f, 1);
        *(GAS unsigned short*)(dst + (size_t)j * slice_stride + 2 * lane) = (unsigned short)(pk & 0xffffu); }
}
__device__ __forceinline__ void quant_row_i4(const float* src, const float* gain, unsigned char* dst, float* scale_out, int lane) {
    f32x4 v[4]; float am = 0.f, ss = 0.f;
    const int p16 = (lane >> 2) & 15, wl = lane & 3;
#pragma unroll
    for (int ld = 0; ld < 2; ++ld)
#pragma unroll
        for (int sn = 0; sn < 2; ++sn) { const int hd = 2 * (4 * ld + wl) + sn; const int idx = 256 * (hd >> 2) + 16 * p16 + 4 * (hd & 3);
            f32x4 t = *(const GAS f32x4*)(src + idx); if (gain) t = t * *(const GAS f32x4*)(gain + idx); v[2 * ld + sn] = t;
            am = fmaxf(am, fmaxf(fmaxf(fabsf(t[0]), fabsf(t[1])), fmaxf(fabsf(t[2]), fabsf(t[3])))); ss += (t[0] * t[0] + t[1] * t[1]) + (t[2] * t[2] + t[3] * t[3]); }
    am = wave_max(am); ss = wave_sum(ss);
    const float clipv = fminf(am, 2.5f * sqrtf(ss * (1.0f / 1024.0f)));
    const float s = clipv > 0.f ? 7.0f / clipv : 0.f;
    if (lane == 0) *scale_out = clipv * (1.0f / (7.0f * 16.0f));
#pragma unroll
    for (int ld = 0; ld < 2; ++ld) { unsigned pk = 0u;
#pragma unroll
        for (int b4 = 0; b4 < 4; ++b4) { int q0 = (int)__builtin_rintf(v[2 * ld][b4] * s), q1 = (int)__builtin_rintf(v[2 * ld + 1][b4] * s);
            q0 = q0 < -7 ? -7 : (q0 > 7 ? 7 : q0); q1 = q1 < -7 ? -7 : (q1 > 7 ? 7 : q1);
            pk |= ((unsigned)(q0 & 15) | ((unsigned)(q1 & 15) << 4)) << (8 * b4); }
        *(GAS unsigned*)(dst + ld * 256 + 16 * p16 + 4 * wl) = pk; }
}
__device__ __forceinline__ float gelu_f(float v) {
    const float av = fabsf(v), t = __builtin_amdgcn_rcpf(av * 0.2316418882f + 1.0f);
    float q = t * 0.5307027145f + (-0.7265760135f); q = q * t + 0.7107068705f; q = q * t + (-0.142248368f); q = q * t + 0.127414796f; q = q * t;
    const float e = __builtin_amdgcn_exp2f((v * v) * (-0.72134752044f));
    const float m = v * (q * e);
    return v < 0.f ? m : v - m;
}

struct Args { const float* in[14]; float* out; unsigned char* ws; int ph_lo, ph_hi, li, pad; };
__global__ void __launch_bounds__(NWAVES * 64, 2) fwd_kernel(Args args) {
    extern __shared__ __attribute__((aligned(16))) unsigned char lds[];
    Frame F;
    F.lds = (LAS unsigned char*)lds;
    F.MISC = (volatile LAS unsigned*)(F.lds + MISC_OFF);
    F.tid = threadIdx.x; F.lane = F.tid & 63; F.wave = __builtin_amdgcn_readfirstlane(F.tid >> 6);
    F.G = gridDim.x; { const int bx = blockIdx.x; F.vcu = (F.G % 8 == 0) ? (bx % 8) * (F.G / 8) + bx / 8 : bx; }
    unsigned char* ws = args.ws;
    F.ctl = (gu32*)(ws + WS_CTL);
    const float* x = args.in[0]; const float* norm1_gain = args.in[1]; const float* w_in = args.in[2]; const float* b_gate = args.in[3];
    const float* q_gain = args.in[4]; const float* k_gain = args.in[5]; const float* w_sb_out = args.in[6]; const float* w_dil_out = args.in[7];
    const float* w_out = args.in[8]; const float* norm2_gain = args.in[9]; const float* w_peer_q = args.in[10]; const float* sub_keys = args.in[11];
    const float* peer_u = args.in[12]; const float* peer_v = args.in[13];
    float* out = args.out;
    bf16* WIN = (bf16*)(ws + WS_WIN); bf16* WCAT = (bf16*)(ws + WS_WCAT); bf16* WOUT = (bf16*)(ws + WS_WOUT); bf16* WC = (bf16*)(ws + WS_WC);
    float* RINV1 = (float*)(ws + WS_RINV1); float* RINV2 = (float*)(ws + WS_RINV2); float* USC = (float*)(ws + WS_USC); float* VSC = (float*)(ws + WS_VSC); float* SSQ = (float*)(ws + WS_SSQ);
    unsigned char* U8 = ws + WS_U8; unsigned char* V8 = ws + WS_V8;
    unsigned short* IDS = (unsigned short*)(ws + WS_IDS); float* GW = (float*)(ws + WS_GW); float* COEF = (float*)(ws + WS_COEF); unsigned char* HQ = ws + WS_HQ; float* HS2 = (float*)(ws + WS_HS2);
    bf16* XB = (bf16*)(ws + WS_XB); bf16* OC = (bf16*)(ws + WS_OC); unsigned char* XB8 = ws + WS_XB8; unsigned char* WG8 = ws + WS_WG8; float* GCS = (float*)(ws + WS_GCS);
    bf16* QS = (bf16*)(ws + WS_QS); bf16* KS = (bf16*)(ws + WS_KS); bf16* VS = (bf16*)(ws + WS_VS);
    bf16* QD = (bf16*)(ws + WS_QD); bf16* KD = (bf16*)(ws + WS_KD); bf16* VD = (bf16*)(ws + WS_VD);
    unsigned char* GT = ws + WS_GT; bf16* MIX = (bf16*)(ws + WS_MIX); bf16* X1B = (bf16*)(ws + WS_X1B);

    for (int u = F.tid; u < (LDS_BYTES - LDSCTL_OFF) / 4; u += NWAVES * 64) ((LAS unsigned*)(F.lds + LDSCTL_OFF))[u] = 0u;
    __syncthreads();
    const int my_xcc = (int)xb_xcc_id();
    if (F.tid == 0) F.MISC[12] = xb_add((unsigned*)(F.ctl + CW_XRANK) + 64 * my_xcc, 1u);
    __syncthreads();
    const int my_xrank = (int)F.MISC[12];
    const int bli = (N_LAUNCHES == PER_PHASE) ? 0 : args.li;
    XcdBarrier bar; bar.bar = (unsigned*)(F.ctl + CW_BAR) + bli * XCD_BAR_WORDS; bar.x = 0; bar.st = nullptr;
    if (N_LAUNCHES != PER_PHASE) bar = xcd_barrier_post((unsigned*)(F.ctl + CW_BAR) + bli * XCD_BAR_WORDS, F.MISC + 8);
    const int lo = args.ph_lo, hi = args.ph_hi;
#ifndef PHASE_MASK
#define PHASE_MASK 0xff
#endif
#define IN(k) (((PHASE_MASK >> (k)) & 1) && lo <= (k) && (k) < hi)
#define BOTH(k) (IN(k) && IN((k) + 1))
#define GRID_BAR() do { if (N_LAUNCHES != PER_PHASE) xcd_barrier(bar); } while (0)
#ifndef PROBE_REPEAT
#define PROBE_REPEAT 0x00
#endif
#ifndef PROBE_L1
#define PROBE_L1 0x0
#endif
#define REP(k) _Pragma("unroll") for (int rep_ = 0; rep_ < (((PROBE_REPEAT >> (k)) & 1) ? 2 : 1); ++rep_)
    const int gw = F.vcu * NWAVES + F.wave, NGW = F.G * NWAVES;
#define P67_MAP() int vx = (int)(blockIdx.x & 7), rk = (int)(blockIdx.x >> 3), nrk = (F.G + 7 - vx) / 8; bool p67_uni = false; \
        { bool uni_ = (F.G % 8 == 0); for (int j_ = 0; j_ < 16; ++j_) { const unsigned c_ = xb_ld((unsigned*)(F.ctl + CW_XRANK) + 64 * j_); uni_ = uni_ && (c_ == (j_ < 8 ? (unsigned)(F.G / 8) : 0u)); } \
          if (uni_) { vx = my_xcc; rk = my_xrank; nrk = F.G / 8; p67_uni = true; } }

    if (IN(0)) REP(0) {
        for (int it = F.vcu; it < 256; it += F.G) {
            const int hp = it >> 4, d0 = (it & 15) * 64;
            LAS float* As = (LAS float*)(F.lds);
            LAS float* Bs = (LAS float*)(F.lds + 64 * 132 * 4);
            for (int e = F.tid; e < 64 * 32; e += 512) { const int r = e >> 5, c4 = (e & 31) * 4; *(LAS f32x4*)(As + r * 132 + c4) = *(const GAS f32x4*)(w_peer_q + (size_t)(d0 + r) * 2048 + hp * 128 + c4); }
            for (int e = F.tid; e < 128 * 32; e += 512) { const int r = e >> 5, c4 = (e & 31) * 4; *(LAS f32x4*)(Bs + r * 132 + c4) = *(const GAS f32x4*)(sub_keys + ((size_t)hp * 128 + r) * 128 + c4); }
            __syncthreads();
            const int ddg = F.tid & 15, ng = F.tid >> 4;
            f32x4 acc[4];
#pragma unroll
            for (int j = 0; j < 4; ++j) acc[j] = (f32x4){0.f, 0.f, 0.f, 0.f};
            for (int c4 = 0; c4 < 128; c4 += 4) {
                f32x4 a[4], b[4];
#pragma unroll
                for (int i = 0; i < 4; ++i) { a[i] = *(const LAS f32x4*)(As + (4 * ddg + i) * 132 + c4); b[i] = *(const LAS f32x4*)(Bs + (4 * ng + i) * 132 + c4); }
#pragma unroll
                for (int j = 0; j < 4; ++j)
#pragma unroll
                    for (int i = 0; i < 4; ++i) acc[j][i] += (a[i][0] * b[j][0] + a[i][1] * b[j][1]) + (a[i][2] * b[j][2] + a[i][3] * b[j][3]);
            }
            const f32x4 g2 = *(const GAS f32x4*)(norm2_gain + d0 + 4 * ddg);
#pragma unroll
            for (int j = 0; j < 4; ++j) { v2u o; o.x = pk2(acc[j][0] * g2[0], acc[j][1] * g2[1]); o.y = pk2(acc[j][2] * g2[2], acc[j][3] * g2[3]);
                *(GAS v2u*)(WC + (size_t)(hp * 128 + 4 * ng + j) * 1024 + d0 + 4 * ddg) = o; }
            __syncthreads();
        }
        {
            LAS float* scr = (LAS float*)(F.lds + RING_OFF + F.wave * 16384);
            constexpr int I_IN = (D / 64) * (N1 / 32), I_SB = (512 / 64) * (D / 32), I_DL = (256 / 64) * (D / 32), I_OUT = (D / 64) * (D / 32);
            constexpr int NITEMS = I_IN + I_SB + I_DL + I_OUT;
            for (int it = gw; it < NITEMS; it += NGW) {
                int r = it;
                if (r < I_IN) { const int nb_ = r % (N1 / 32); if (nb_ >= NB16 / 32) p0_gate_max_item(w_in, N1, norm1_gain, (unsigned*)(F.ctl + CW_GMAX), r / (N1 / 32), 32 * nb_, F.lane); else p0_transpose_item(w_in, N1, norm1_gain, WIN, 1024, 0, 1, scr, r, F.lane); continue; } r -= I_IN;
                if (r < I_SB) { p0_transpose_item(w_sb_out, D, nullptr, WCAT, 768, 0, 0, scr, r, F.lane); continue; } r -= I_SB;
                if (r < I_DL) { p0_transpose_item(w_dil_out, D, nullptr, WCAT, 768, 512, 0, scr, r, F.lane); continue; } r -= I_DL;
                p0_transpose_item(w_out, D, nullptr, WOUT, 1024, 0, 0, scr, r, F.lane);
            }
        }
        for (int e = gw; e < 2 * NEXP; e += NGW) {
            if (e < NEXP) quant_row_i4(peer_u + (size_t)e * D, norm2_gain, U8 + (size_t)e * 512, USC + e, F.lane);
            else { const int ev = e - NEXP; quant_row_fp4(peer_v + (size_t)ev * D, V8 + (size_t)ev * 128, (size_t)NEXP * 128, VSC + ev, F.lane); }
        }
        for (int m = gw; m < T; m += NGW) {
            const GAS f32x4* xr = (const GAS f32x4*)(x + (size_t)m * D) + F.lane;
            f32x4 v[4]; float s = 0.f;
#pragma unroll
            for (int j = 0; j < 4; ++j) { v[j] = xr[64 * j]; s += (v[j][0] * v[j][0] + v[j][1] * v[j][1]) + (v[j][2] * v[j][2] + v[j][3] * v[j][3]); }
            s = wave_sum(s);
            const float rn = __builtin_amdgcn_rsqf(s * (1.0f / D) + 1e-6f);
            if (F.lane == 0) RINV1[m] = 1.0f / rn;
            GAS unsigned long long* o8 = (GAS unsigned long long*)(XB + (size_t)m * D) + F.lane;
#pragma unroll
            for (int j = 0; j < 4; ++j) o8[64 * j] = (unsigned long long)pk2(v[j][0] * rn, v[j][1] * rn) | ((unsigned long long)pk2(v[j][2] * rn, v[j][3] * rn) << 32);
#pragma unroll
            for (int j = 0; j < 4; ++j) { int pk = __builtin_amdgcn_cvt_pk_fp8_f32(v[j][0] * rn, v[j][1] * rn, 0, false); pk = __builtin_amdgcn_cvt_pk_fp8_f32(v[j][2] * rn, v[j][3] * rn, pk, true);
                *(GAS int*)(XB8 + (size_t)m * D + 256 * j + 4 * F.lane) = pk; }
        }
        if (BOTH(0)) GRID_BAR();
    }

    if (IN(1)) REP(1) {
        { LAS float* scr = (LAS float*)(F.lds + RING_OFF + F.wave * 16384);
          for (int it = gw; it < 16 * (N8 / 32); it += NGW) p0_gate_fp8_item(w_in, N1, norm1_gain, (const unsigned*)(F.ctl + CW_GMAX), WG8, GCS, scr, it, F.lane);
          __syncthreads(); }
        { pg8::Gemm g{XB, WIN, T, NB16, D}; pg8::StaticOrder S; S.init(T, NB16, F.G, (int)blockIdx.x);
          pg8::Epi1 E{RINV1, b_gate, q_gain, k_gain, QS, KS, VS};
          pg8::gemm_phase<pg8::Epi1, pg8::StaticOrder, true, true>(F.lds + RING_OFF, g, S, E); }
        GRID_BAR();
        { pg8::Gemm g{(const bf16*)XB8, (const bf16*)WG8, T, N8, D / 2}; pg8::StaticOrder S; S.init(T, N8, F.G, (int)blockIdx.x);
          pg8::EpiG E{b_gate, GCS, q_gain, k_gain, QD, KD, VD, GT};
          pg8::gemm_phase<pg8::EpiG, pg8::StaticOrder, true, true, true>(F.lds + RING_OFF, g, S, E); }
        if (BOTH(1)) GRID_BAR();
    }

    if (IN(2)) REP(2) {
        LAS unsigned char* wl = F.lds + RING_OFF + F.wave * 16384;
        static_assert(att::DLU_BYTES <= RING_BYTES, "dilated-attention LDS state");
        for (int un = F.vcu; un < 512; un += F.G) { const int blk = un & 7, j = (un >> 3) & 3, b = un >> 5; att::dl_unit(QD, KD, VD, OC, b, j, blk, F.lds + RING_OFF, F.wave, F.lane); }
        for (int it = gw; it < 16384; it += NGW) { const int qt = 127 - (it & 127), h = (it >> 7) & 7, b = it >> 10; att::sb_item(QS, KS, VS, OC, b, h, qt, wl, F.lane); }
        if (BOTH(2)) GRID_BAR();
    }

    if (IN(3)) REP(3) {
        pg8::Gemm g{OC, WCAT, T, D, 768}; pg8::StaticOrder S; S.init(T, D, F.G, (int)blockIdx.x);
        pg8::Epi2 E{GT, MIX};
        pg8::gemm_phase<pg8::Epi2, pg8::StaticOrder, true, true>(F.lds + RING_OFF, g, S, E);
        if (BOTH(3)) GRID_BAR();
    }

    if (IN(4)) REP(4) {
        pg8::Gemm g{MIX, WOUT, T, D, D}; pg8::StaticOrder S; S.init(T, D, F.G, (int)blockIdx.x);
        pg8::Epi3 E{XB, RINV1, X1B, SSQ};
        pg8::gemm_phase<pg8::Epi3, pg8::StaticOrder, true, true>(F.lds + RING_OFF, g, S, E);
        if (BOTH(4)) GRID_BAR();
    }

    if (IN(5)) REP(5) {
        for (int m = gw; m < T; m += NGW) {
            const v4u a = *(const GAS v4u*)(X1B + (size_t)m * D + 8 * F.lane), b = *(const GAS v4u*)(X1B + (size_t)m * D + 512 + 8 * F.lane);
            float v[16] = {pg8::bflo(a.x), pg8::bfhi(a.x), pg8::bflo(a.y), pg8::bfhi(a.y), pg8::bflo(a.z), pg8::bfhi(a.z), pg8::bflo(a.w), pg8::bfhi(a.w),
                           pg8::bflo(b.x), pg8::bfhi(b.x), pg8::bflo(b.y), pg8::bfhi(b.y), pg8::bflo(b.z), pg8::bfhi(b.z), pg8::bflo(b.w), pg8::bfhi(b.w)};
            float am = 0.f;
#pragma unroll
            for (int i = 0; i < 16; ++i) am = fmaxf(am, fabsf(v[i]));
            am = wave_max(am);
            float sq = (F.lane < 16) ? SSQ[(size_t)m * 16 + F.lane] : 0.f; sq = wave_sum(sq);
            const float s = am > 0.f ? 127.0f / am : 0.f;
            if (F.lane == 0) HS2[m] = am * (1.0f / 127.0f) * __builtin_amdgcn_rsqf(sq * (1.0f / 1024.0f) + 1e-6f);
            int q[16];
#pragma unroll
            for (int i = 0; i < 16; ++i) q[i] = (int)__builtin_rintf(v[i] * s) & 0xff;
            v2u o0, o1; o0.x = q[0] | (q[1] << 8) | (q[2] << 16) | (q[3] << 24); o0.y = q[4] | (q[5] << 8) | (q[6] << 16) | (q[7] << 24);
            o1.x = q[8] | (q[9] << 8) | (q[10] << 16) | (q[11] << 24); o1.y = q[12] | (q[13] << 8) | (q[14] << 16) | (q[15] << 24);
            *(GAS v2u*)(HQ + (size_t)m * D + 8 * F.lane) = o0; *(GAS v2u*)(HQ + (size_t)m * D + 512 + 8 * F.lane) = o1;
        }
        pg8::Gemm g{X1B, WC, T, 2048, D}; pg8::StaticOrder S; S.init(T, 2048, F.G, (int)blockIdx.x);
        pg8::Epi4 E{SSQ, RINV2, IDS, GW};
        pg8::OneUnit O1;
        for (int i = 0; S.next(i, O1.u); ++i) pg8::gemm_phase<pg8::Epi4, pg8::OneUnit, false, true>(F.lds + RING_OFF, g, O1, E);
        if (BOTH(5)) GRID_BAR();
    }

    if (IN(6)) REP(6) {
        P67_MAP();
        const int p16 = F.lane & 15, sg = F.lane >> 4;
        LAS unsigned char* HB = F.lds + RING_OFF + F.wave * 16384;
        LAS unsigned* LIST = (LAS unsigned*)(F.lds + RING_OFF + F.wave * 16384 + 8192);
        LAS float* HSs = (LAS float*)(F.lds + RING_OFF + F.wave * 16384 + 12288);
        const int nwb = T / 8, wstep = nrk * NWAVES;
        const int gsel = (F.lane & 15), bpsrc = (16 * (F.lane & 3) + ((F.lane >> 2) & 3)) * 4;
        v4u hpre[8], idpre[2]; float hspre = 0.f;
#define P6_PRE(bb) do { const int bc_ = (bb) < nwb ? (bb) : nwb - 1; const unsigned char* hsrc_ = HQ + (size_t)bc_ * 8192; \
            _Pragma("unroll") for (int i_ = 0; i_ < 8; ++i_) hpre[i_] = *(const GAS v4u*)(hsrc_ + (size_t)(i_ * 64 + F.lane) * 16); \
            const unsigned short* isrc_ = IDS + ((size_t)bc_ * 8 + (F.lane >> 3)) * 128 + 16 * (F.lane & 7); idpre[0] = *(const GAS v4u*)isrc_; idpre[1] = *(const GAS v4u*)(isrc_ + 8); \
            hspre = HS2[(size_t)bc_ * 8 + (F.lane & 7)]; } while (0)
#define P6_ISSUE(W, ENT, EJ, GB, UB, VB, base_) do { \
                _Pragma("unroll") for (int g_ = 0; g_ < 4; ++g_) { const int j_ = (base_) + 4 * g_ + sg; ENT[g_] = LIST[j_ < n ? j_ : nm1]; } \
                { const int j_ = (base_) + gsel; EJ = (j_ < n && F.lane < 16) ? (int)LIST[j_] : -1; } \
                _Pragma("unroll") for (int g_ = 0; g_ < 4; ++g_) { const unsigned char* up_ = U8 + (size_t)((PROBE_L1 && rep_) ? 0u : (ENT[g_] & 0xffffu)) * 512 + 16 * p16; \
                    _Pragma("unroll") for (int i_ = 0; i_ < 2; ++i_) W[g_][i_] = *(const GAS v4u*)(up_ + 256 * i_); } \
                { const unsigned ej_ = EJ < 0 ? 0u : (unsigned)EJ; GB = GW[((size_t)t0 + (ej_ >> 24)) * 128 + ((ej_ >> 16) & 127u)]; UB = USC[ej_ & 0xffffu]; VB = VSC[ej_ & 0xffffu]; } } while (0)
#define P6_DPPADD(a_, ctrl) a_ += __builtin_amdgcn_update_dpp(0, a_, ctrl, 0xf, 0xf, false)
#define P6_REDUCE(W, ENT, EJ, GB, UB, VB, base_) do { if ((base_) < n) { int ag_[4]; \
                _Pragma("unroll") for (int g_ = 0; g_ < 4; ++g_) { const LAS unsigned char* hp_ = HB + (size_t)(ENT[g_] >> 24) * 1024 + 16 * p16; int a_ = 0; v4u h_[4]; \
                    _Pragma("unroll") for (int i_ = 0; i_ < 4; ++i_) h_[i_] = *(const LAS v4u*)(hp_ + 256 * i_); \
                    _Pragma("unroll") for (int ld_ = 0; ld_ < 2; ++ld_) { const unsigned x_[4] = {W[g_][ld_].x, W[g_][ld_].y, W[g_][ld_].z, W[g_][ld_].w}; \
                        _Pragma("unroll") for (int wl_ = 0; wl_ < 4; ++wl_) { const int hd_ = 2 * (4 * ld_ + wl_); const unsigned lo_ = (x_[wl_] << 4) & 0xF0F0F0F0u, hi_ = x_[wl_] & 0xF0F0F0F0u; \
                            const unsigned hA_ = (hd_ & 3) == 0 ? h_[hd_ >> 2].x : h_[hd_ >> 2].z, hB_ = (hd_ & 3) == 0 ? h_[hd_ >> 2].y : h_[hd_ >> 2].w; \
                            a_ = __builtin_amdgcn_sdot4((int)lo_, (int)hA_, a_, false); a_ = __builtin_amdgcn_sdot4((int)hi_, (int)hB_, a_, false); } } \
                    P6_DPPADD(a_, 0xB1); P6_DPPADD(a_, 0x4E); P6_DPPADD(a_, 0x141); P6_DPPADD(a_, 0x140); ag_[g_] = a_; } \
                const int sel_ = gsel == 0 ? ag_[0] : gsel == 1 ? ag_[1] : gsel == 2 ? ag_[2] : ag_[3]; \
                const float resv_ = (float)__builtin_amdgcn_ds_bpermute(bpsrc, sel_); \
                if (EJ >= 0 && !(PROBE_L1 && rep_)) { const unsigned ej_ = (unsigned)EJ; const float act_ = gelu_f(resv_ * UB * HSs[ej_ >> 24]); \
                    COEF[((size_t)t0 + (ej_ >> 24)) * 128 + ((ej_ >> 16) & 127u)] = GB * act_ * VB; } } } while (0)
        int wb = rk * NWAVES + F.wave;
        P6_PRE(wb);
        for (; wb < nwb; wb += wstep) {
            const int t0 = wb * 8;
            asm volatile("s_waitcnt lgkmcnt(0)" ::: "memory");
            if (F.lane < 8) HSs[F.lane] = hspre;
#pragma unroll
            for (int i = 0; i < 8; ++i) *(LAS v4u*)(HB + (size_t)(i * 64 + F.lane) * 16) = hpre[i];
            int n = 0;
            { const unsigned idw[8] = {idpre[0].x, idpre[0].y, idpre[0].z, idpre[0].w, idpre[1].x, idpre[1].y, idpre[1].z, idpre[1].w};
              const unsigned tl = (unsigned)(F.lane >> 3), kb0 = 16u * (unsigned)(F.lane & 7);
#pragma unroll
              for (int i = 0; i < 16; ++i) { const unsigned e = (i & 1) ? (idw[i >> 1] >> 16) : (idw[i >> 1] & 0xffffu);
                  const bool inr = ((int)(e >> 11) == vx); const unsigned long long mk = __ballot(inr);
                  const int pos = n + (int)__builtin_amdgcn_mbcnt_hi((unsigned)(mk >> 32), __builtin_amdgcn_mbcnt_lo((unsigned)mk, 0u));
                  if (inr) LIST[pos] = (tl << 24) | ((kb0 + (unsigned)i) << 16) | e;
                  n += __builtin_popcountll(mk); } }
            asm volatile("s_waitcnt lgkmcnt(0)" ::: "memory");
            P6_PRE(wb + wstep);
            const int nm1 = n > 0 ? n - 1 : 0;
            for (int base = 0; base < n; base += 32) {
                v4u wA[4][2], wB[4][2]; unsigned entA[4], entB[4]; int ejA, ejB; float gbA, ubA, vbA, gbB, ubB, vbB;
                P6_ISSUE(wA, entA, ejA, gbA, ubA, vbA, base);
                P6_ISSUE(wB, entB, ejB, gbB, ubB, vbB, base + 16);
                P6_REDUCE(wA, entA, ejA, gbA, ubA, vbA, base);
                P6_REDUCE(wB, entB, ejB, gbB, ubB, vbB, base + 16);
            }
        }
#undef P6_PRE
#undef P6_ISSUE
#undef P6_REDUCE
#undef P6_DPPADD
        if (BOTH(6)) GRID_BAR();
    }

    if (IN(7)) REP(7) {
        P67_MAP();
        const int cs = vx >> 1;
        const int n0_ = p67_uni ? F.G / 8 : (F.G + 7 - 2 * cs) / 8, n1_ = p67_uni ? F.G / 8 : (F.G + 7 - (2 * cs + 1)) / 8;
        const int rk2 = (vx & 1) ? n0_ + rk : rk, nrk2 = n0_ + n1_;
        const int l8 = F.lane & 7, kg = F.lane >> 3;
        const unsigned char* vbase = V8 + (size_t)cs * NEXP * 128 + 16 * l8;
        const int tstep = nrk2 * NWAVES;
        const int col = 256 * cs + 32 * l8 + ((F.lane & 8) ? 16 : 0) + ((F.lane & 16) ? 8 : 0) + ((F.lane & 32) ? 4 : 0);
#define P7_CL(tt) ((tt) < T ? (tt) : T - 1)
#define P7_IDS(tt, ID) do { const int tc_ = P7_CL(tt); ID[0] = *(const GAS v4u*)(IDS + (size_t)tc_ * 128 + 16 * kg); ID[1] = *(const GAS v4u*)(IDS + (size_t)tc_ * 128 + 16 * kg + 8); } while (0)
#define P7_ISSUE(tt, ID, W, CF, OO) do { const int tc_ = P7_CL(tt); const unsigned idw_[8] = {ID[0].x, ID[0].y, ID[0].z, ID[0].w, ID[1].x, ID[1].y, ID[1].z, ID[1].w}; \
            _Pragma("unroll") for (int i_ = 0; i_ < 16; ++i_) { const unsigned e_ = (i_ & 1) ? (idw_[i_ >> 1] >> 16) : (idw_[i_ >> 1] & 0xffffu); W[i_] = *(const GAS v4u*)(vbase + (size_t)((PROBE_L1 && rep_) ? 0u : e_) * 128); } \
            _Pragma("unroll") for (int i_ = 0; i_ < 4; ++i_) CF[i_] = *(const GAS f32x4*)(COEF + (size_t)tc_ * 128 + 16 * kg + 4 * i_); \
            OO = *(const GAS v2u*)(X1B + (size_t)tc_ * D + col); } while (0)
#define P7_BYTE(d_, s_) do { const h2_t r_ = __builtin_amdgcn_cvt_scalef32_pk_f16_fp4(ww_[d_], 1.0f, s_); acc_[4 * (d_) + (s_)] = r_ * c2_ + acc_[4 * (d_) + (s_)]; } while (0)
#define P7_COMPUTE(tt, W, CF, OO) do { h2_t acc_[16];                 \
            _Pragma("unroll") for (int i_ = 0; i_ < 16; ++i_) acc_[i_] = (h2_t){(_Float16)0.f, (_Float16)0.f}; \
            _Pragma("unroll") for (int i_ = 0; i_ < 16; ++i_) { const unsigned ww_[4] = {W[i_].x, W[i_].y, W[i_].z, W[i_].w}; const _Float16 ch_ = (_Float16)CF[i_ >> 2][i_ & 3]; const h2_t c2_ = {ch_, ch_}; \
                P7_BYTE(0, 0); P7_BYTE(0, 1); P7_BYTE(0, 2); P7_BYTE(0, 3); P7_BYTE(1, 0); P7_BYTE(1, 1); P7_BYTE(1, 2); P7_BYTE(1, 3); \
                P7_BYTE(2, 0); P7_BYTE(2, 1); P7_BYTE(2, 2); P7_BYTE(2, 3); P7_BYTE(3, 0); P7_BYTE(3, 1); P7_BYTE(3, 2); P7_BYTE(3, 3); } \
            float r16_[16], r8_[8], r4_[4]; \
            { const bool up_ = (F.lane & 8) != 0; _Pragma("unroll") for (int i_ = 0; i_ < 8; ++i_) { const h2_t keep_ = up_ ? acc_[8 + i_] : acc_[i_], send_ = up_ ? acc_[i_] : acc_[8 + i_]; \
                const h2_t oth_ = __builtin_bit_cast(h2_t, __shfl_xor(__builtin_bit_cast(int, send_), 8)); r16_[2 * i_] = (float)keep_[0] + (float)oth_[0]; r16_[2 * i_ + 1] = (float)keep_[1] + (float)oth_[1]; } } \
            { const bool up_ = (F.lane & 16) != 0; _Pragma("unroll") for (int i_ = 0; i_ < 8; ++i_) { const float keep_ = up_ ? r16_[8 + i_] : r16_[i_], send_ = up_ ? r16_[i_] : r16_[8 + i_]; r8_[i_] = keep_ + __shfl_xor(send_, 16); } } \
            { const bool up_ = (F.lane & 32) != 0; _Pragma("unroll") for (int i_ = 0; i_ < 4; ++i_) { const float keep_ = up_ ? r8_[4 + i_] : r8_[i_], send_ = up_ ? r8_[i_] : r8_[4 + i_]; r4_[i_] = keep_ + __shfl_xor(send_, 32); } } \
            if ((tt) < T) *(GAS f32x4*)((rep_ == 0 ? out : (float*)(ws + WS_GT)) + (size_t)(tt) * D + col) = (f32x4){pg8::bflo(OO.x) + r4_[0], pg8::bfhi(OO.x) + r4_[1], pg8::bflo(OO.y) + r4_[2], pg8::bfhi(OO.y) + r4_[3]}; } while (0)
        v4u idA[2], idB[2], wA[16], wB[16]; f32x4 cfA[4], cfB[4]; v2u ooA, ooB;
        int t = rk2 * NWAVES + F.wave;
        P7_IDS(t, idA); P7_IDS(t + tstep, idB);
        while (t < T) {
            P7_ISSUE(t, idA, wA, cfA, ooA); P7_ISSUE(t + tstep, idB, wB, cfB, ooB);
            P7_IDS(t + 2 * tstep, idA); P7_IDS(t + 3 * tstep, idB);
            P7_COMPUTE(t, wA, cfA, ooA);
            P7_COMPUTE(t + tstep, wB, cfB, ooB);
            t += 2 * tstep;
        }
#undef P7_CL
#undef P7_IDS
#undef P7_ISSUE
#undef P7_BYTE
#undef P7_COMPUTE
    }
#undef IN
#undef BOTH
#undef GRID_BAR
}

extern "C" void kernel_launch(void* const* d_in, const int* in_sizes, int n_in, void* d_out, int out_size, void* d_ws, size_t ws_size, hipStream_t stream) {
    static int grid = 0;
    if (grid == 0) {
        if (n_in != 14 || in_sizes[0] != T * D || out_size != T * D || ws_size < WS_END) { fprintf(stderr, "kernel_launch: built for 14 inputs, x and out of %d floats, >= %zu bytes of workspace; got n_in %d, in0 %d, out %d, ws %zu; nothing launched\n", T * D, (size_t)WS_END, n_in, n_in > 0 ? in_sizes[0] : -1, out_size, ws_size); grid = -1; return; }
        int dev = 0, cus = 0, per_cu = 0;
        if (hipGetDevice(&dev) != hipSuccess || hipDeviceGetAttribute(&cus, hipDeviceAttributeMultiprocessorCount, dev) != hipSuccess) { fprintf(stderr, "kernel_launch: hipGetDevice / hipDeviceGetAttribute failed\n"); grid = -1; return; }
        if (hipFuncSetAttribute((const void*)fwd_kernel, hipFuncAttributeMaxDynamicSharedMemorySize, LDS_BYTES) != hipSuccess) { fprintf(stderr, "kernel_launch: hipFuncSetAttribute failed\n"); grid = -1; return; }
        if (hipOccupancyMaxActiveBlocksPerMultiprocessor(&per_cu, (const void*)fwd_kernel, NWAVES * 64, LDS_BYTES) != hipSuccess || per_cu < 1)
            fprintf(stderr, "kernel_launch: note: occupancy query reports %d workgroups per CU\n", per_cu);
        (void)hipGetLastError();
        grid = cus;
    }
    if (grid < 0) return;
    if (hipMemsetAsync((char*)d_ws + WS_CTL, 0, CTL_ZERO_BYTES, stream) != hipSuccess) { fprintf(stderr, "kernel_launch: hipMemsetAsync failed\n"); return; }
    Args a{};
    for (int i = 0; i < 14; ++i) a.in[i] = (const float*)d_in[i];
    a.out = (float*)d_out; a.ws = (unsigned char*)d_ws;
    for (int li = 0; li < N_LAUNCHES; ++li) {
        a.ph_lo = (N_LAUNCHES == PER_PHASE) ? li : 0; a.ph_hi = (N_LAUNCHES == PER_PHASE) ? li + 1 : MK_LAST_PHASE; a.li = li;
        if (a.ph_lo >= MK_LAST_PHASE) break;
        hipLaunchKernelGGL(fwd_kernel, dim3(grid), dim3(NWAVES * 64), LDS_BYTES, stream, a);
        const hipError_t le = hipPeekAtLastError();
        if (le != hipSuccess) { fprintf(stderr, "kernel_launch: launch %d failed: %s\n", li, hipGetErrorName(le)); break; }
    }
}
```

```cpp
#include <hip/hip_runtime.h>
#include <cstdio>
#include <cstdint>
namespace pg8 {
#define PG8_LAS __attribute__((address_space(3)))
typedef unsigned short bf16_t;
typedef short bf16x8 __attribute__((ext_vector_type(8)));
typedef float f32x4 __attribute__((ext_vector_type(4)));
typedef unsigned u32x4 __attribute__((ext_vector_type(4)));
typedef int i32x8 __attribute__((ext_vector_type(8)));
typedef int i32x4 __attribute__((ext_vector_type(4)));
constexpr int BM = 256, BK = 64, HALF = 128, HTB = HALF * BK * 2  , STAGE_BYTES = 8 * HTB, NXCD = 8, WGM = 8;

__host__ __device__ __forceinline__ int lds_byte(int r, int c) { const int st = (r >> 4) * 2 + (c >> 5), rr = r & 15, cc = c & 31, ob = rr * 64 + cc * 2; return st * 1024 + (ob ^ (((ob >> 9) & 1) << 5)); }
__host__ __device__ __forceinline__ void stage_rc(int b, int& R, int& C) { const int st = b / 1024, sb = b % 1024, swz = sb ^ (((sb >> 9) & 1) << 5); R = (st >> 1) * 16 + swz / 64; C = (st & 1) * 32 + (swz % 64) / 2; }
__host__ __device__ __forceinline__ int perm32(int rho) { const int n = rho >> 4, i = rho & 15; return 8 * (i >> 2) + 4 * n + (i & 3); }

struct Unit { int pm, pn; };
struct Gemm { const bf16_t* A; const bf16_t* Bt; int M, N, K; };

struct StaticOrder {
    int nM, nN, nwg, G, c;
    __host__ __device__ void init(int M, int N, int G_, int c_) { nM = M / BM; nN = N / BM; nwg = nM * nN; G = G_; c = c_; }
    __host__ __device__ bool next(int i, Unit& u) const {
        const long L = (long)i * G + c; if (L >= nwg) return false;
        int wgid = (int)L; { const int q = nwg / NXCD, r = nwg % NXCD, xcd = wgid % NXCD, off = wgid / NXCD; wgid = (xcd < r ? xcd * (q + 1) : r * (q + 1) + (xcd - r) * q) + off; }
        const int nig = WGM * nN, gid = wgid / nig, fm = gid * WGM, gsz = (nM - fm) < WGM ? (nM - fm) : WGM;
        u.pm = fm + ((wgid % nig) % gsz); u.pn = (wgid % nig) / gsz; return true;
    }
    __device__ __forceinline__ void a_ready(const Unit&) const {}
    __device__ __forceinline__ void done(const Unit&) const {}
};


struct OneUnit {
    Unit u;
    __device__ __forceinline__ bool next(int i, Unit& o) const { if (i != 0) return false; o = u; return true; }
    __device__ __forceinline__ void a_ready(const Unit&) const {}
    __device__ __forceinline__ void done(const Unit&) const {}
};

typedef float f32x2 __attribute__((ext_vector_type(2)));
typedef __bf16 bf16x2_t __attribute__((ext_vector_type(2)));
typedef unsigned u32x2 __attribute__((ext_vector_type(2)));
__device__ __forceinline__ unsigned pkbf(float lo, float hi) { f32x2 v = {lo, hi}; bf16x2_t b = __builtin_convertvector(v, bf16x2_t); return __builtin_bit_cast(unsigned, b); }
__device__ __forceinline__ float bflo(unsigned w) { return __uint_as_float(w << 16); }
__device__ __forceinline__ float bfhi(unsigned w) { return __uint_as_float(w & 0xffff0000u); }
__device__ __forceinline__ u32x4 pack8(const f32x4 a, const f32x4 b) { u32x4 w; w.x = pkbf(a[0], a[1]); w.y = pkbf(a[2], a[3]); w.z = pkbf(b[0], b[1]); w.w = pkbf(b[2], b[3]); return w; }
constexpr float QSCALE = 0.125f * 1.4426950408889634f;
__device__ __forceinline__ float sigmoidf_(float v) { return __builtin_amdgcn_rcpf(1.0f + __builtin_amdgcn_exp2f(-1.4426950408889634f * v)); }

struct Epi1 {
    static constexpr bool PERM = true, AFTER_DRAIN = false, HAS_MID = false; static constexpr int MID_T = -1;
    const float* rinv; const float* bgate; const float* qg; const float* kg;
    bf16_t *QS, *KS, *VS;
    __device__ __forceinline__ void mid(f32x4 (&)[2][2][4][2], const Unit&, int, int, int, int) const {}
    __device__ __forceinline__ void operator()(const f32x4 (&acc)[2][2][4][2], const Unit& u, int wr, int wc, int fr, int fq) const {
        asm volatile("" : "+v"(fr), "+v"(fq));
        const int pn = u.pn; const int row0 = u.pm * BM + wr * 64 + fr;
        {
            bf16_t* base; int ld, colt;
            if (pn < 2) { base = QS; ld = 512; colt = pn * 256; } else if (pn < 4) { base = KS; ld = 512; colt = (pn - 2) * 256; } else { base = VS; ld = 512; colt = (pn - 4) * 256; }
            base += colt + wc * 32 + 8 * fq;
#pragma unroll
            for (int ai = 0; ai < 2; ++ai)
#pragma unroll
                for (int m = 0; m < 4; ++m) { const int row = row0 + ai * HALF + m * 16; const float r = (pn < 2 ? QSCALE : 1.0f);
#pragma unroll
                    for (int bj = 0; bj < 2; ++bj) *(u32x4*)(base + (size_t)row * ld + bj * HALF) = pack8(acc[ai][bj][m][0] * r, acc[ai][bj][m][1] * r);
                }
        }
    }
};

struct EpiG {
    static constexpr bool PERM = true, AFTER_DRAIN = false, HAS_MID = false; static constexpr int MID_T = -1;
    const float* bgate; const float* cs; const float* qg; const float* kg; bf16_t *QD, *KD, *VD; unsigned char* GT;
    __device__ __forceinline__ void mid(f32x4 (&)[2][2][4][2], const Unit&, int, int, int, int) const {}
    __device__ __forceinline__ void operator()(const f32x4 (&acc)[2][2][4][2], const Unit& u, int wr, int wc, int fr, int fq) const {
        asm volatile("" : "+v"(fr), "+v"(fq));
        const int pn = u.pn; const int row0 = u.pm * BM + wr * 64 + fr, colp = pn * BM + wc * 32 + 8 * fq;
        f32x4 sv[2][2];
#pragma unroll
        for (int bj = 0; bj < 2; ++bj)
#pragma unroll
            for (int n = 0; n < 2; ++n) sv[bj][n] = *(const f32x4*)(cs + colp + bj * HALF + 4 * n);
        if (pn < 6) {
            const bool isK = pn >= 3; const int head = (isK ? pn - 3 : pn) * 4 + wc;
            const float* g = (isK ? kg : qg) + head * 64 + 8 * fq;
            f32x4 gv[2][2]; const float qsc = isK ? 1.0f : QSCALE;
#pragma unroll
            for (int bj = 0; bj < 2; ++bj)
#pragma unroll
                for (int n = 0; n < 2; ++n) gv[bj][n] = *(const f32x4*)(g + 32 * bj + 4 * n) * qsc;
            bf16_t* base = (isK ? KD : QD) + head * 64 + 8 * fq;
#pragma unroll
            for (int ai = 0; ai < 2; ++ai)
#pragma unroll
                for (int m = 0; m < 4; ++m) { const int row = row0 + ai * HALF + m * 16;
                    f32x4 v[2][2]; float ss = 0.f;
#pragma unroll
                    for (int bj = 0; bj < 2; ++bj)
#pragma unroll
                        for (int n = 0; n < 2; ++n) { v[bj][n] = acc[ai][bj][m][n] * sv[bj][n]; const f32x4 q = v[bj][n] * v[bj][n]; ss += (q[0] + q[1]) + (q[2] + q[3]); }
                    ss += __shfl_xor(ss, 16); ss += __shfl_xor(ss, 32);
                    const float sc = __builtin_amdgcn_rsqf(ss * (1.0f / 64.0f) + 1e-6f);
#pragma unroll
                    for (int bj = 0; bj < 2; ++bj) *(u32x4*)(base + (size_t)row * 768 + 32 * bj) = pack8(v[bj][0] * sc * gv[bj][0], v[bj][1] * sc * gv[bj][1]);
                }
        } else if (pn < 9) {
            bf16_t* base = VD + (pn - 6) * 256 + wc * 32 + 8 * fq;
#pragma unroll
            for (int ai = 0; ai < 2; ++ai)
#pragma unroll
                for (int m = 0; m < 4; ++m) { const int row = row0 + ai * HALF + m * 16;
#pragma unroll
                    for (int bj = 0; bj < 2; ++bj) *(u32x4*)(base + (size_t)row * 768 + bj * HALF) = pack8(acc[ai][bj][m][0] * sv[bj][0], acc[ai][bj][m][1] * sv[bj][1]);
                }
        } else {
            const int col0 = (pn - 9) * 256 + wc * 32 + 8 * fq;
            f32x4 bv[2][2];
#pragma unroll
            for (int bj = 0; bj < 2; ++bj)
#pragma unroll
                for (int n = 0; n < 2; ++n) bv[bj][n] = *(const f32x4*)(bgate + col0 + bj * HALF + 4 * n);
#pragma unroll
            for (int ai = 0; ai < 2; ++ai)
#pragma unroll
                for (int m = 0; m < 4; ++m) { const int row = row0 + ai * HALF + m * 16;
#pragma unroll
                    for (int bj = 0; bj < 2; ++bj) { f32x4 a = acc[ai][bj][m][0] * sv[bj][0] + bv[bj][0], b = acc[ai][bj][m][1] * sv[bj][1] + bv[bj][1];
#pragma unroll
                        for (int e = 0; e < 4; ++e) { a[e] = sigmoidf_(a[e]) * 255.0f; b[e] = sigmoidf_(b[e]) * 255.0f; }
                        unsigned w0 = 0, w1 = 0;
                        w0 = __builtin_amdgcn_cvt_pk_u8_f32(a[0], 0, w0); w0 = __builtin_amdgcn_cvt_pk_u8_f32(a[1], 1, w0); w0 = __builtin_amdgcn_cvt_pk_u8_f32(a[2], 2, w0); w0 = __builtin_amdgcn_cvt_pk_u8_f32(a[3], 3, w0);
                        w1 = __builtin_amdgcn_cvt_pk_u8_f32(b[0], 0, w1); w1 = __builtin_amdgcn_cvt_pk_u8_f32(b[1], 1, w1); w1 = __builtin_amdgcn_cvt_pk_u8_f32(b[2], 2, w1); w1 = __builtin_amdgcn_cvt_pk_u8_f32(b[3], 3, w1);
                        *(u32x2*)(GT + (size_t)row * 2048 + col0 + bj * HALF) = (u32x2){w0, w1}; }
                }
        }
    }
};

struct Epi2 {
    static constexpr bool PERM = true, AFTER_DRAIN = false, HAS_MID = true; static constexpr int MID_T = 8;
    const unsigned char* GT; bf16_t* MIX;
    static __device__ __forceinline__ float ub(unsigned w, int e) { return (float)((w >> (8 * e)) & 0xffu); }
    static __device__ __forceinline__ float gcv(unsigned w, int e) { return fmaxf(ub(w, e) * (1.0f / 255.0f), 1e-30f); }
    __device__ __forceinline__ void mid(f32x4 (&acc)[2][2][4][2], const Unit& u, int wr, int wc, int fr, int fq) const {
        asm volatile("" : "+v"(fr), "+v"(fq));
        const int row0 = u.pm * BM + wr * 64 + fr, col0 = u.pn * BM + wc * 32 + 8 * fq;
        u32x2 ga[2][4][2], gb[2][4][2];
#pragma unroll
        for (int ai = 0; ai < 2; ++ai)
#pragma unroll
            for (int m = 0; m < 4; ++m) { const unsigned char* gp = GT + (size_t)(row0 + ai * HALF + m * 16) * 2048 + col0;
#pragma unroll
                for (int bj = 0; bj < 2; ++bj) { ga[ai][m][bj] = *(const u32x2*)(gp + bj * HALF); gb[ai][m][bj] = *(const u32x2*)(gp + 1024 + bj * HALF); } }
        asm volatile("" ::: "memory");
#pragma unroll
        for (int ai = 0; ai < 2; ++ai)
#pragma unroll
            for (int m = 0; m < 4; ++m)
#pragma unroll
                for (int bj = 0; bj < 2; ++bj) { const u32x2 a = ga[ai][m][bj], b = gb[ai][m][bj];
                    f32x4 r0, r1;
#pragma unroll
                    for (int e = 0; e < 4; ++e) { r0[e] = ub(a.x, e) * (1.0f / 255.0f) * __builtin_amdgcn_rcpf(gcv(b.x, e)); r1[e] = ub(a.y, e) * (1.0f / 255.0f) * __builtin_amdgcn_rcpf(gcv(b.y, e)); }
                    acc[ai][bj][m][0] *= r0; acc[ai][bj][m][1] *= r1; }
        asm volatile("" ::: "memory");
    }
    __device__ __forceinline__ void operator()(const f32x4 (&acc)[2][2][4][2], const Unit& u, int wr, int wc, int fr, int fq) const {
        asm volatile("" : "+v"(fr), "+v"(fq));
        const int row0 = u.pm * BM + wr * 64 + fr, col0 = u.pn * BM + wc * 32 + 8 * fq;
        u32x2 gb[2][4][2];
#pragma unroll
        for (int ai = 0; ai < 2; ++ai)
#pragma unroll
            for (int m = 0; m < 4; ++m) { const unsigned char* gp = GT + (size_t)(row0 + ai * HALF + m * 16) * 2048 + 1024 + col0;
#pragma unroll
                for (int bj = 0; bj < 2; ++bj) gb[ai][m][bj] = *(const u32x2*)(gp + bj * HALF); }
        asm volatile("" ::: "memory");
#pragma unroll
        for (int ai = 0; ai < 2; ++ai)
#pragma unroll
            for (int m = 0; m < 4; ++m) { const int row = row0 + ai * HALF + m * 16;
#pragma unroll
                for (int bj = 0; bj < 2; ++bj) { const u32x2 b = gb[ai][m][bj];
                    f32x4 g0, g1;
#pragma unroll
                    for (int e = 0; e < 4; ++e) { g0[e] = gcv(b.x, e); g1[e] = gcv(b.y, e); }
                    *(u32x4*)(MIX + (size_t)row * 1024 + col0 + bj * HALF) = pack8(acc[ai][bj][m][0] * g0, acc[ai][bj][m][1] * g1); } }
    }
};

struct Epi3 {
    static constexpr bool PERM = true, AFTER_DRAIN = false, HAS_MID = false; static constexpr int MID_T = -1;
    const bf16_t* xb; const float* rms; bf16_t* x1b; float* ssq;
    __device__ __forceinline__ void mid(f32x4 (&)[2][2][4][2], const Unit&, int, int, int, int) const {}
    __device__ __forceinline__ void operator()(const f32x4 (&acc)[2][2][4][2], const Unit& u, int wr, int wc, int fr, int fq) const {
        asm volatile("" : "+v"(fr), "+v"(fq));
        const int row0 = u.pm * BM + wr * 64 + fr, col0 = u.pn * BM + wc * 32 + 8 * fq;
        u32x4 xv[2][4][2]; float rm[2][4];
#pragma unroll
        for (int ai = 0; ai < 2; ++ai)
#pragma unroll
            for (int m = 0; m < 4; ++m) { const size_t off = (size_t)(row0 + ai * HALF + m * 16) * 1024 + col0; rm[ai][m] = rms[row0 + ai * HALF + m * 16];
#pragma unroll
                for (int bj = 0; bj < 2; ++bj) xv[ai][m][bj] = *(const u32x4*)(xb + off + bj * HALF); }
        asm volatile("" ::: "memory");
#pragma unroll
        for (int ai = 0; ai < 2; ++ai)
#pragma unroll
            for (int m = 0; m < 4; ++m) { const int row = row0 + ai * HALF + m * 16; const size_t off = (size_t)row * 1024 + col0; float ss = 0.f; const float r = rm[ai][m];
#pragma unroll
                for (int bj = 0; bj < 2; ++bj) { const u32x4 w = xv[ai][m][bj];
                    const f32x4 x0 = (f32x4){bflo(w.x), bfhi(w.x), bflo(w.y), bfhi(w.y)}, x1 = (f32x4){bflo(w.z), bfhi(w.z), bflo(w.w), bfhi(w.w)};
                    const f32x4 v0 = acc[ai][bj][m][0] + x0 * r, v1 = acc[ai][bj][m][1] + x1 * r;
                    *(u32x4*)(x1b + off + bj * HALF) = pack8(v0, v1);
                    const f32x4 q0 = v0 * v0, q1 = v1 * v1; ss += ((q0[0] + q0[1]) + (q0[2] + q0[3])) + ((q1[0] + q1[1]) + (q1[2] + q1[3])); }
                ss += __shfl_xor(ss, 16); ss += __shfl_xor(ss, 32);
                if (fq == 0) ssq[(size_t)row * 16 + u.pn * 4 + wc] = ss;
            }
    }
};

__device__ __forceinline__ unsigned f2key(float v) { const unsigned u = __float_as_uint(v); return (u & 0x80000000u) ? ~u : (u | 0x80000000u); }
__device__ __forceinline__ float key2f(unsigned k) { return __uint_as_float((k & 0x80000000u) ? (k & 0x7fffffffu) : ~k); }
#define PG8_CE(a_, b_) do { const unsigned hi__ = (a_) > (b_) ? (a_) : (b_); const unsigned lo__ = (a_) > (b_) ? (b_) : (a_); (a_) = hi__; (b_) = lo__; } while (0)
__device__ __forceinline__ void bitonic_merge16(unsigned (&v)[16]) {
#pragma unroll
    for (int j = 8; j >= 1; j >>= 1)
#pragma unroll
        for (int i = 0; i < 16; ++i) { const int l = i ^ j; if (l > i) PG8_CE(v[i], v[l]); }
}
__device__ __forceinline__ void bitonic_sort16(unsigned (&v)[16]) {
#pragma unroll
    for (int k = 2; k <= 16; k <<= 1)
#pragma unroll
        for (int j = k >> 1; j >= 1; j >>= 1)
#pragma unroll
            for (int i = 0; i < 16; ++i) { const int l = i ^ j; if (l > i) { if ((i & k) == 0 || k == 16) PG8_CE(v[i], v[l]); else PG8_CE(v[l], v[i]); } }
}
__device__ __forceinline__ void merge_top16(unsigned (&t)[16], const unsigned (&o)[16]) {
#pragma unroll
    for (int i = 0; i < 16; ++i) t[i] = t[i] > o[15 - i] ? t[i] : o[15 - i];
    bitonic_merge16(t);
}
template <int XM> __device__ __forceinline__ void merge_top16_xor(unsigned (&t)[16]) {
    unsigned o[16];
#pragma unroll
    for (int i = 0; i < 16; ++i) o[i] = (unsigned)__shfl_xor((int)t[i], XM);
    merge_top16(t, o);
}

struct Epi4 {
    static constexpr bool PERM = false, AFTER_DRAIN = true, HAS_MID = false; static constexpr int MID_T = -1;
    const float* ssq; float* rinv2; unsigned short* ids; float* gw;
    const float* hs; const float* wcs;
    __device__ __forceinline__ void mid(f32x4 (&)[2][2][4][2], const Unit&, int, int, int, int) const {}
    __device__ __forceinline__ void fused(f32x4 (&acc)[2][2][4][2], const Unit& u, int wr, int wc, int fr, int fq, PG8_LAS unsigned char* lds, int wid, int lane) const {
        asm volatile("" : "+v"(fr), "+v"(fq));
        const int tid = wid * 64 + lane;
        const int rl = tid >> 2, p = (tid >> 1) & 1, hf = tid & 1, q4 = tid & 3;
#pragma unroll
        for (int pass = 0; pass < 2; ++pass) {
            f32x4 wsv[2][2]; float hsv[4];
#pragma unroll
            for (int bj = 0; bj < 2; ++bj)
#pragma unroll
                for (int n = 0; n < 2; ++n) wsv[bj][n] = *(const f32x4*)(wcs + u.pn * BM + bj * HALF + wc * 32 + n * 16 + fq * 4);
#pragma unroll
            for (int m = 0; m < 4; ++m) hsv[m] = hs[u.pm * BM + pass * HALF + wr * 64 + m * 16 + fr];
#pragma unroll
            for (int m = 0; m < 4; ++m)
#pragma unroll
                for (int bj = 0; bj < 2; ++bj)
#pragma unroll
                    for (int n = 0; n < 2; ++n) { const i32x4 ia = __builtin_bit_cast(i32x4, acc[pass][bj][m][n]); f32x4 sv;
#pragma unroll
                        for (int e = 0; e < 4; ++e) sv[e] = (float)ia[e] * hsv[m] * wsv[bj][n][e];
                        *(PG8_LAS f32x4*)(lds + (size_t)(wr * 64 + m * 16 + fr) * 1056 + bj * 528 + (wc * 32 + n * 16 + fq * 4) * 4) = sv; }
            asm volatile("s_waitcnt lgkmcnt(0)" ::: "memory"); __builtin_amdgcn_s_barrier(); asm volatile("" ::: "memory");
            const int row = u.pm * BM + pass * HALF + rl;
            unsigned tk[16];
#pragma unroll
            for (int i = 0; i < 16; ++i) tk[i] = 0u;
            const PG8_LAS unsigned char* sp = lds + (size_t)rl * 1056 + p * 528 + hf * 256;
#pragma nounroll
            for (int c = 0; c < 4; ++c) { unsigned ch[16];
#pragma unroll
                for (int e4 = 0; e4 < 4; ++e4) { const f32x4 v = *(const PG8_LAS f32x4*)(sp + c * 64 + e4 * 16);
#pragma unroll
                    for (int e = 0; e < 4; ++e) ch[4 * e4 + e] = (f2key(v[e]) & ~127u) | (unsigned)(127 - (64 * hf + 16 * c + 4 * e4 + e)); }
                bitonic_sort16(ch);
                merge_top16(tk, ch);
            }
            merge_top16_xor<1>(tk);
            asm volatile("s_waitcnt lgkmcnt(0)" ::: "memory");
            PG8_LAS unsigned* kl = (PG8_LAS unsigned*)(lds + (size_t)(rl & ~15) * 1056) + ((rl & 15) * 2) * 16;
            if (hf == 0) {
#pragma unroll
                for (int i = 0; i < 4; ++i) *(PG8_LAS u32x4*)(kl + p * 16 + 4 * i) = (u32x4){tk[4 * i], tk[4 * i + 1], tk[4 * i + 2], tk[4 * i + 3]}; }
            asm volatile("s_waitcnt lgkmcnt(0)" ::: "memory");
            unsigned ck[16];
#define CAND_SLOT(m_, ij__) do { const unsigned i__ = (ij__) >> 4, j__ = (ij__) & 15u; \
                const unsigned ka__ = kl[(ij__) == 0xFFFFu ? 0u : i__], kb__ = kl[16 + ((ij__) == 0xFFFFu ? 0u : j__)]; \
                const float s__ = key2f(ka__ & ~127u) + key2f(kb__ & ~127u); \
                ck[m_] = (ij__) == 0xFFFFu ? 0u : ((f2key(s__) & ~255u) | (255u - (ij__))); } while (0)
                { const unsigned ij_ = q4 == 0 ? 0u : q4 == 1 ? 1u : q4 == 2 ? 2u : 3u; CAND_SLOT(0, ij_); }
                { const unsigned ij_ = q4 == 0 ? 4u : q4 == 1 ? 5u : q4 == 2 ? 6u : 7u; CAND_SLOT(1, ij_); }
                { const unsigned ij_ = q4 == 0 ? 8u : q4 == 1 ? 9u : q4 == 2 ? 10u : 11u; CAND_SLOT(2, ij_); }
                { const unsigned ij_ = q4 == 0 ? 12u : q4 == 1 ? 13u : q4 == 2 ? 14u : 15u; CAND_SLOT(3, ij_); }
                { const unsigned ij_ = q4 == 0 ? 16u : q4 == 1 ? 17u : q4 == 2 ? 18u : 19u; CAND_SLOT(4, ij_); }
                { const unsigned ij_ = q4 == 0 ? 20u : q4 == 1 ? 21u : q4 == 2 ? 22u : 23u; CAND_SLOT(5, ij_); }
                { const unsigned ij_ = q4 == 0 ? 32u : q4 == 1 ? 33u : q4 == 2 ? 34u : 35u; CAND_SLOT(6, ij_); }
                { const unsigned ij_ = q4 == 0 ? 36u : q4 == 1 ? 48u : q4 == 2 ? 49u : 50u; CAND_SLOT(7, ij_); }
                { const unsigned ij_ = q4 == 0 ? 51u : q4 == 1 ? 64u : q4 == 2 ? 65u : 66u; CAND_SLOT(8, ij_); }
                { const unsigned ij_ = q4 == 0 ? 80u : q4 == 1 ? 81u : q4 == 2 ? 96u : 97u; CAND_SLOT(9, ij_); }
                { const unsigned ij_ = q4 == 0 ? 112u : q4 == 1 ? 113u : q4 == 2 ? 128u : 144u; CAND_SLOT(10, ij_); }
                { const unsigned ij_ = q4 == 0 ? 160u : q4 == 1 ? 176u : q4 == 2 ? 192u : 208u; CAND_SLOT(11, ij_); }
                { const unsigned ij_ = q4 == 0 ? 224u : q4 == 1 ? 240u : q4 == 2 ? 65535u : 65535u; CAND_SLOT(12, ij_); }
#undef CAND_SLOT
            ck[13] = 0u; ck[14] = 0u; ck[15] = 0u;
            bitonic_sort16(ck);
            merge_top16_xor<1>(ck); merge_top16_xor<2>(ck);
            float sq = 0.f;
#pragma unroll
            for (int i = 0; i < 4; ++i) { const f32x4 t = *(const f32x4*)(ssq + (size_t)row * 16 + 4 * i); sq += (t[0] + t[1]) + (t[2] + t[3]); }
            const float r2 = __builtin_amdgcn_rsqf(sq * (1.0f / 1024.0f) + 1e-6f);
            if (u.pn == 0 && q4 == 0) rinv2[row] = r2;
            const float b0 = key2f(ck[0] & ~255u); float wsum = 0.f; float wv[16];
#pragma unroll
            for (int q = 0; q < 16; ++q) { wv[q] = __builtin_amdgcn_exp2f((key2f(ck[q] & ~255u) - b0) * r2 * 1.4426950408889634f); wsum += wv[q]; }
            const float inv = 1.0f / wsum;
            unsigned short eo[4]; float go[4];
#pragma unroll
            for (int e = 0; e < 4; ++e) { unsigned c0 = ck[e], c1 = ck[4 + e], c2 = ck[8 + e], c3 = ck[12 + e]; float w0 = wv[e], w1 = wv[4 + e], w2 = wv[8 + e], w3 = wv[12 + e];
                asm volatile("" : "+v"(c0), "+v"(c1), "+v"(c2), "+v"(c3), "+v"(w0), "+v"(w1), "+v"(w2), "+v"(w3));
                const unsigned cc = q4 == 0 ? c0 : q4 == 1 ? c1 : q4 == 2 ? c2 : c3; const float ww = q4 == 0 ? w0 : q4 == 1 ? w1 : q4 == 2 ? w2 : w3;
                const unsigned code = 255u - (cc & 255u);
                const unsigned i1 = 127u - (kl[code >> 4] & 127u), i2 = 127u - (kl[16 + (code & 15u)] & 127u);
                eo[e] = (unsigned short)(i1 * 128u + i2); go[e] = ww * inv; }
            const size_t ob = ((size_t)row * 8 + u.pn) * 16 + q4 * 4;
            { u32x2 w; w.x = eo[0] | ((unsigned)eo[1] << 16); w.y = eo[2] | ((unsigned)eo[3] << 16); *(u32x2*)(ids + ob) = w; }
            *(f32x4*)(gw + ob) = (f32x4){go[0], go[1], go[2], go[3]};
            asm volatile("s_waitcnt lgkmcnt(0)" ::: "memory"); __builtin_amdgcn_s_barrier(); asm volatile("" ::: "memory");
        }
    }
};
template <class Epi, class Sched, bool ALIGN_EPI = false, bool SP2 = false, bool FP8 = false, bool I8 = false>
__device__ __forceinline__ void gemm_phase(PG8_LAS unsigned char* lds, const Gemm g, const Sched& S, const Epi& E) {
    const int tid = threadIdx.x, wid = __builtin_amdgcn_readfirstlane(tid >> 6), lane = tid & 63, wr = wid >> 2, wc = wid & 3, fr = lane & 15, fq = lane >> 4;
    const int K = g.K, nt = K / BK;
    unsigned voffA[2], voffB[2];
#pragma unroll
    for (int i = 0; i < 2; ++i) { int R, C; stage_rc(tid * 16 + i * 8192, R, C); const int Rb = Epi::PERM ? ((R & ~31) + perm32(R & 31)) : R;
        voffA[i] = (unsigned)(R * K + C) * 2u; voffB[i] = (unsigned)(Rb * K + C) * 2u; }
    const size_t kstep = (size_t)(BK * 2);
    const size_t hstep = (size_t)HALF * K * 2;
    const size_t tstep = 2 * hstep;
    const unsigned ldsw = (unsigned)wid * 1024u;
    const int aoff = lds_byte(wr * 64 + fr, fq * 8), boff = lds_byte(wc * 32 + fr, fq * 8);
#define PG8_SA(b, h) (((b) * 2 + (h)) * HTB)
#define PG8_SB(b, h) ((4 + (b) * 2 + (h)) * HTB)
#define PG8_STAGE(bufoff, gbase, voff) do { _Pragma("unroll") for (int _i = 0; _i < 2; ++_i) \
        __builtin_amdgcn_global_load_lds((const unsigned*)((const char*)(gbase) + (voff)[_i]), (PG8_LAS unsigned*)(lds + (bufoff) + ldsw + _i * 8192), 16, 0, 0); } while (0)
#define PG8_LD8(lo_, hi_) __builtin_bit_cast(i32x8, __builtin_shufflevector((lo_), (hi_), 0, 1, 2, 3, 4, 5, 6, 7))
#define PG8_LDA(dst, b, h) do { if constexpr (FP8) { _Pragma("unroll") for (int m = 0; m < 4; ++m) { const u32x4 l0_ = *(const PG8_LAS u32x4*)(lds + PG8_SA(b, h) + aoff + m * 2048), l1_ = *(const PG8_LAS u32x4*)(lds + PG8_SA(b, h) + aoff + m * 2048 + 1024); dst##8[m] = PG8_LD8(l0_, l1_); } } \
        else { _Pragma("unroll") for (int m = 0; m < 4; ++m) _Pragma("unroll") for (int k = 0; k < 2; ++k) dst[m][k] = *(const PG8_LAS bf16x8*)(lds + PG8_SA(b, h) + aoff + m * 2048 + k * 1024); } } while (0)
#define PG8_LDB(dst, b, h) do { if constexpr (FP8) { _Pragma("unroll") for (int n = 0; n < 2; ++n) { const u32x4 l0_ = *(const PG8_LAS u32x4*)(lds + PG8_SB(b, h) + boff + n * 2048), l1_ = *(const PG8_LAS u32x4*)(lds + PG8_SB(b, h) + boff + n * 2048 + 1024); dst##8[n] = PG8_LD8(l0_, l1_); } } \
        else { _Pragma("unroll") for (int n = 0; n < 2; ++n) _Pragma("unroll") for (int k = 0; k < 2; ++k) dst[n][k] = *(const PG8_LAS bf16x8*)(lds + PG8_SB(b, h) + boff + n * 2048 + k * 1024); } } while (0)
#define PG8_MMA(ai, bj, At, Bt) do { __builtin_amdgcn_s_setprio(1); \
        if constexpr (FP8) { _Pragma("unroll") for (int m = 0; m < 4; ++m) _Pragma("unroll") for (int n = 0; n < 2; ++n) \
            asm volatile("v_mfma_scale_f32_16x16x128_f8f6f4 %0, %1, %2, %0, %3, %3 op_sel_hi:[0,0,0]" : "+v"(acc[ai][bj][m][n]) : "v"(Bt##8[n]), "v"(At##8[m]), "v"(sc127));     \
            } \
        else if constexpr (I8) { _Pragma("unroll") for (int m = 0; m < 4; ++m) _Pragma("unroll") for (int n = 0; n < 2; ++n) _Pragma("unroll") for (int k = 0; k < 2; ++k) \
            acc[ai][bj][m][n] = __builtin_bit_cast(f32x4, __builtin_amdgcn_mfma_i32_16x16x64_i8(__builtin_bit_cast(i32x4, Bt[n][k]), __builtin_bit_cast(i32x4, At[m][k]), __builtin_bit_cast(i32x4, acc[ai][bj][m][n]), 0, 0, 0)); } \
        else { _Pragma("unroll") for (int m = 0; m < 4; ++m) _Pragma("unroll") for (int n = 0; n < 2; ++n) _Pragma("unroll") for (int k = 0; k < 2; ++k) \
            acc[ai][bj][m][n] = __builtin_amdgcn_mfma_f32_16x16x32_bf16(Bt[n][k], At[m][k], acc[ai][bj][m][n], 0, 0, 0); } \
        __builtin_amdgcn_s_setprio(0); } while (0)
#define PG8_WAIT_V(n) asm volatile("s_waitcnt vmcnt(" #n ")" ::: "memory")
#define PG8_WAIT_L(n) asm volatile("s_waitcnt lgkmcnt(" #n ")" ::: "memory")
#define PG8_BAR __builtin_amdgcn_s_barrier()
#define PG8_SCHED __builtin_amdgcn_sched_barrier(0)
    Unit cur, nxt; int ui = 0;
    if (!S.next(0, cur)) return;
    f32x4 acc[2][2][4][2];
#pragma unroll
    for (int a = 0; a < 2; ++a)
#pragma unroll
        for (int b = 0; b < 2; ++b)
#pragma unroll
            for (int m = 0; m < 4; ++m)
#pragma unroll
                for (int n = 0; n < 2; ++n) acc[a][b][m][n] = (f32x4){0.f, 0.f, 0.f, 0.f};
    bf16x8 At[4][2], B0[2][2], B1[2][2]; i32x8 At8[4], B08[2], B18[2];
    int sc127 = 127; asm volatile("" : "+v"(sc127));
    const char* cA = (const char*)g.A + (size_t)cur.pm * tstep; const char* cB = (const char*)g.Bt + (size_t)cur.pn * tstep;
    S.a_ready(cur);
    if constexpr (SP2) {
        PG8_STAGE(PG8_SB(0, 0), cB, voffB); PG8_STAGE(PG8_SB(0, 1), cB + hstep, voffB); PG8_STAGE(PG8_SA(0, 0), cA, voffA); PG8_STAGE(PG8_SA(0, 1), cA + hstep, voffA);
        if (wr == 1) PG8_BAR;
        PG8_WAIT_V(2); PG8_BAR;
        PG8_STAGE(PG8_SB(1, 0), cB + kstep, voffB); PG8_STAGE(PG8_SA(1, 0), cA + kstep, voffA); PG8_STAGE(PG8_SB(1, 1), cB + hstep + kstep, voffB);
        PG8_WAIT_V(6); PG8_BAR;
    } else {
        PG8_STAGE(PG8_SB(0, 0), cB, voffB); PG8_STAGE(PG8_SA(0, 0), cA, voffA); PG8_STAGE(PG8_SB(0, 1), cB + hstep, voffB); PG8_STAGE(PG8_SA(0, 1), cA + hstep, voffA);
        if (wr == 1) PG8_BAR;
        PG8_WAIT_V(4); PG8_BAR;
        PG8_STAGE(PG8_SB(1, 0), cB + kstep, voffB); PG8_STAGE(PG8_SA(1, 0), cA + kstep, voffA); PG8_STAGE(PG8_SB(1, 1), cB + hstep + kstep, voffB);
        PG8_WAIT_V(6); PG8_BAR;
    }
    for (;;) {
        const bool has_next = S.next(ui + 1, nxt);
        const char* nA = has_next ? (const char*)g.A + (size_t)nxt.pm * tstep : cA; const char* nB = has_next ? (const char*)g.Bt + (size_t)nxt.pn * tstep : cB;
        for (int t = 0; t < nt; t += 2) {
            if constexpr (Epi::HAS_MID) { if (t == Epi::MID_T) E.mid(acc, cur, wr, wc, fr, fq); }
            const bool last = (t == nt - 2);
            const char* a1 = cA + (size_t)(t + 1) * kstep;
            const char* a2 = last ? nA : cA + (size_t)(t + 2) * kstep; const char* b2 = last ? nB : cB + (size_t)(t + 2) * kstep;
            const char* a3 = a2 + kstep; const char* b3 = b2 + kstep;
            if (last && has_next) S.a_ready(nxt);
            if constexpr (SP2) {
            PG8_LDB(B0, 0, 0); PG8_LDB(B1, 0, 1); PG8_SCHED; PG8_LDA(At, 0, 0); PG8_STAGE(PG8_SA(1, 1), a1 + hstep, voffA);
            PG8_WAIT_V(8); PG8_WAIT_L(0); PG8_BAR; PG8_MMA(0, 0, At, B0); PG8_MMA(0, 1, At, B1); PG8_BAR; PG8_SCHED;
            PG8_LDA(At, 0, 1); PG8_STAGE(PG8_SB(0, 0), b2, voffB); PG8_STAGE(PG8_SB(0, 1), b2 + hstep, voffB); PG8_STAGE(PG8_SA(0, 0), a2, voffA);
            PG8_WAIT_V(8); PG8_WAIT_L(0); PG8_BAR; PG8_MMA(1, 0, At, B0); PG8_MMA(1, 1, At, B1); PG8_BAR; PG8_SCHED;
            PG8_LDB(B0, 1, 0); PG8_LDB(B1, 1, 1); PG8_SCHED; PG8_LDA(At, 1, 0); PG8_STAGE(PG8_SA(0, 1), a2 + hstep, voffA);
            PG8_WAIT_V(8); PG8_WAIT_L(0); PG8_BAR; PG8_MMA(0, 0, At, B0); PG8_MMA(0, 1, At, B1); PG8_BAR; PG8_SCHED;
            PG8_LDA(At, 1, 1); PG8_STAGE(PG8_SB(1, 0), b3, voffB); PG8_STAGE(PG8_SB(1, 1), b3 + hstep, voffB); PG8_STAGE(PG8_SA(1, 0), a3, voffA);
            PG8_WAIT_V(8); PG8_WAIT_L(0); PG8_BAR; PG8_MMA(1, 0, At, B0); PG8_MMA(1, 1, At, B1); PG8_BAR; PG8_SCHED;
            } else {
            PG8_LDB(B0, 0, 0); PG8_SCHED; PG8_LDA(At, 0, 0); PG8_STAGE(PG8_SA(1, 1), a1 + hstep, voffA);
            PG8_WAIT_L(8); PG8_BAR; PG8_WAIT_L(0); PG8_MMA(0, 0, At, B0); PG8_BAR; PG8_SCHED;
            PG8_LDB(B1, 0, 1); PG8_STAGE(PG8_SB(0, 0), b2, voffB);
            PG8_BAR; PG8_WAIT_L(0); PG8_MMA(0, 1, At, B1); PG8_BAR;
            PG8_LDA(At, 0, 1); PG8_STAGE(PG8_SA(0, 0), a2, voffA);
            PG8_BAR; PG8_WAIT_L(0); PG8_MMA(1, 0, At, B0); PG8_BAR; PG8_SCHED;
            PG8_STAGE(PG8_SB(0, 1), b2 + hstep, voffB);
            PG8_WAIT_V(6); PG8_BAR; PG8_MMA(1, 1, At, B1); PG8_BAR;
            PG8_LDB(B0, 1, 0); PG8_SCHED; PG8_LDA(At, 1, 0); PG8_STAGE(PG8_SA(0, 1), a2 + hstep, voffA);
            PG8_WAIT_L(8); PG8_BAR; PG8_WAIT_L(0); PG8_MMA(0, 0, At, B0); PG8_BAR; PG8_SCHED;
            PG8_LDB(B1, 1, 1); PG8_STAGE(PG8_SB(1, 0), b3, voffB);
            PG8_BAR; PG8_WAIT_L(0); PG8_MMA(0, 1, At, B1); PG8_BAR;
            PG8_LDA(At, 1, 1); PG8_STAGE(PG8_SA(1, 0), a3, voffA);
            PG8_BAR; PG8_WAIT_L(0); PG8_MMA(1, 0, At, B0); PG8_BAR; PG8_SCHED;
            PG8_STAGE(PG8_SB(1, 1), b3 + hstep, voffB);
            PG8_WAIT_V(6); PG8_BAR; PG8_MMA(1, 1, At, B1); PG8_BAR;
            }
        }
        if constexpr (FP8) asm volatile("s_nop 15\n\ts_nop 15" ::: "memory");
        if constexpr (ALIGN_EPI) { if (wr == 0) PG8_BAR; }
        if constexpr (!Epi::AFTER_DRAIN) { E(acc, cur, wr, wc, fr, fq); S.done(cur); }
        if (!has_next) break;
#pragma unroll
        for (int a = 0; a < 2; ++a)
#pragma unroll
            for (int b = 0; b < 2; ++b)
#pragma unroll
                for (int m = 0; m < 4; ++m)
#pragma unroll
                    for (int n = 0; n < 2; ++n) acc[a][b][m][n] = (f32x4){0.f, 0.f, 0.f, 0.f};
        cur = nxt; cA = nA; cB = nB; ++ui;
        if constexpr (ALIGN_EPI) { if (wr == 1) PG8_BAR; }
    }
    PG8_WAIT_V(0);
    if constexpr (!ALIGN_EPI) { if (wr == 0) PG8_BAR; }
    PG8_BAR;
    if constexpr (Epi::AFTER_DRAIN) { E.fused(acc, cur, wr, wc, fr, fq, lds, wid, lane); S.done(cur); }
#undef PG8_SA
#undef PG8_SB
#undef PG8_STAGE
#undef PG8_LDA
#undef PG8_LD8
#undef PG8_LDB
#undef PG8_MMA
#undef PG8_WAIT_V
#undef PG8_WAIT_L
#undef PG8_BAR
#undef PG8_SCHED
}
}


namespace att {
#define ALAS __attribute__((address_space(3)))
typedef unsigned short bf16;
typedef short bf16x8 __attribute__((ext_vector_type(8)));
typedef short s16x4 __attribute__((ext_vector_type(4)));
typedef float f32x16 __attribute__((ext_vector_type(16)));
typedef float f32x4 __attribute__((ext_vector_type(4)));
typedef float f32x2 __attribute__((ext_vector_type(2)));
typedef unsigned u32x4 __attribute__((ext_vector_type(4)));
typedef __bf16 bf16x2_t __attribute__((ext_vector_type(2)));
constexpr int SEQ = 4096;
constexpr int VPITCH = 144;
constexpr float LOG2E = 1.4426950408889634f, LN2 = 0.6931471805599453f;
__device__ __forceinline__ unsigned pkbf(float lo, float hi) { f32x2 v = {lo, hi}; bf16x2_t b = __builtin_convertvector(v, bf16x2_t); return __builtin_bit_cast(unsigned, b); }
__device__ __forceinline__ void wave_lds_sync() { asm volatile("s_waitcnt lgkmcnt(0)" ::: "memory"); }
__device__ __forceinline__ s16x4 vtr(const ALAS unsigned char* p) { return __builtin_bit_cast(s16x4, __builtin_amdgcn_ds_read_tr16_b64_v4i16((ALAS s16x4*)p)); }
__device__ __forceinline__ int crow(int r, int hi) { return (r & 3) + 8 * (r >> 2) + 4 * hi; }

__device__ __forceinline__ void pv_tile(f32x16& o0, f32x16& o1, const float (&a)[16], const ALAS unsigned char* vt, int lane) {
    const int g = lane >> 4, i = lane & 15, q_ = i >> 2, p_ = i & 3, h = lane >> 5;
    const ALAS unsigned char* vb = vt + (8 * h + q_) * VPITCH + (16 * (g & 1) + 4 * p_) * 2;
    u32x4 pw0, pw1;
    pw0.x = pkbf(a[0], a[1]); pw0.y = pkbf(a[2], a[3]); pw0.z = pkbf(a[4], a[5]); pw0.w = pkbf(a[6], a[7]);
    pw1.x = pkbf(a[8], a[9]); pw1.y = pkbf(a[10], a[11]); pw1.z = pkbf(a[12], a[13]); pw1.w = pkbf(a[14], a[15]);
    const bf16x8 pa0 = __builtin_bit_cast(bf16x8, pw0), pa1 = __builtin_bit_cast(bf16x8, pw1);
#pragma unroll
    for (int s = 0; s < 2; ++s) {
        const s16x4 l0 = vtr(vb + (16 * s) * VPITCH), h0 = vtr(vb + (16 * s + 4) * VPITCH);
        const s16x4 l1 = vtr(vb + (16 * s) * VPITCH + 64), h1 = vtr(vb + (16 * s + 4) * VPITCH + 64);
        const bf16x8 v0 = (bf16x8){l0[0], l0[1], l0[2], l0[3], h0[0], h0[1], h0[2], h0[3]};
        const bf16x8 v1 = (bf16x8){l1[0], l1[1], l1[2], l1[3], h1[0], h1[1], h1[2], h1[3]};
        o0 = __builtin_amdgcn_mfma_f32_32x32x16_bf16(s ? pa1 : pa0, v0, o0, 0, 0, 0);
        o1 = __builtin_amdgcn_mfma_f32_32x32x16_bf16(s ? pa1 : pa0, v1, o1, 0, 0, 0);
    }
}
__device__ __forceinline__ void bcast_rows(float v, ALAS float* sc, int r32, int hi, float (&out)[16]) {
    if (hi == 0) sc[r32] = v;
    wave_lds_sync();
#pragma unroll
    for (int g = 0; g < 4; ++g) { const f32x4 t = *(const ALAS f32x4*)(sc + 8 * g + 4 * hi); out[4 * g] = t[0]; out[4 * g + 1] = t[1]; out[4 * g + 2] = t[2]; out[4 * g + 3] = t[3]; }
    wave_lds_sync();
}
__device__ __forceinline__ void store_o(const f32x16& o0, const f32x16& o1, ALAS unsigned char* stg, bf16* dst  , size_t rstride_elems, int lane) {
    const int r32 = lane & 31, hi = lane >> 5;
    wave_lds_sync();
#pragma unroll
    for (int r = 0; r < 16; ++r) { const int q = crow(r, hi);
        *(ALAS unsigned short*)(stg + q * VPITCH + r32 * 2) = (unsigned short)(pkbf(o0[r], 0.f) & 0xffffu);
        *(ALAS unsigned short*)(stg + q * VPITCH + 64 + r32 * 2) = (unsigned short)(pkbf(o1[r], 0.f) & 0xffffu); }
    wave_lds_sync();
#pragma unroll
    for (int i = 0; i < 4; ++i) { const int row = 8 * i + (lane >> 3), ch = lane & 7; const u32x4 v = *(const ALAS u32x4*)(stg + row * VPITCH + ch * 16); *(u32x4*)(dst + (size_t)row * rstride_elems + ch * 8) = v; }
    wave_lds_sync();
}

__device__ __forceinline__ void sb_item(const bf16* QS, const bf16* KS, const bf16* VS, bf16* OC, int b, int h, int qt, ALAS unsigned char* wl, int lane) {
    const int r32 = lane & 31, hi = lane >> 5;
    const int t0 = qt * 32; const size_t rowb = (size_t)b * SEQ;
    const int kperm = (r32 & ~12) | ((r32 & 4) << 1) | ((r32 & 8) >> 1);
    bf16x8 qf[4];
    { const bf16* qp = QS + (rowb + t0 + r32) * 512 + h * 64 + hi * 8;
#pragma unroll
      for (int d0 = 0; d0 < 4; ++d0) qf[d0] = *(const bf16x8*)(qp + d0 * 16); }
    f32x16 o0 = {}, o1 = {}; float R = 0.f;
    for (int key0 = t0; key0 >= 0; key0 -= 32) {
        const bf16* kp = KS + (rowb + key0 + kperm) * 512 + h * 64 + hi * 8;
        bf16x8 kf[4];
#pragma unroll
        for (int d0 = 0; d0 < 4; ++d0) kf[d0] = *(const bf16x8*)(kp + d0 * 16);
        u32x4 vv[4];
#pragma unroll
        for (int i = 0; i < 4; ++i) vv[i] = *(const u32x4*)(VS + (rowb + key0 + 8 * i + (lane >> 3)) * 512 + h * 64 + (lane & 7) * 8);
        f32x16 p = {};
#pragma unroll
        for (int d0 = 0; d0 < 4; ++d0) p = __builtin_amdgcn_mfma_f32_32x32x16_bf16(kf[d0], qf[d0], p, 0, 0, 0);
#pragma unroll
        for (int i = 0; i < 4; ++i) *(ALAS u32x4*)(wl + (8 * i + (lane >> 3)) * VPITCH + (lane & 7) * 16) = vv[i];
        const bool diag = (key0 == t0);
        float z2[16], L2[16];
#pragma unroll
        for (int r = 0; r < 16; ++r) { const int kk = (r & 7) + 8 * hi + 16 * (r >> 3); const float zz = p[r];
            const float sp = fmaxf(zz, 0.f) + __builtin_amdgcn_logf(1.0f + __builtin_amdgcn_exp2f(-fabsf(zz)));
            const bool valid = !diag || (kk < r32); z2[r] = zz; L2[r] = valid ? sp : 0.f; }
        float c[16];
        c[15] = L2[15];
#pragma unroll
        for (int r = 14; r >= 8; --r) c[r] = c[r + 1] + L2[r];
        c[7] = L2[7];
#pragma unroll
        for (int r = 6; r >= 0; --r) c[r] = c[r + 1] + L2[r];
        const float TB = c[8], TA = c[0];
        const float TBo = __shfl_xor(TB, 32), TAo = __shfl_xor(TA, 32);
        const float offB = R + (hi ? 0.f : TBo);
        const float offA = R + TB + TBo + (hi ? 0.f : TAo);
        float a[16];
#pragma unroll
        for (int r = 0; r < 16; ++r) { const int kk = (r & 7) + 8 * hi + 16 * (r >> 3); const bool valid = !diag || (kk < r32);
            const float e = __builtin_amdgcn_exp2f(z2[r] - (c[r] + (r < 8 ? offA : offB))); a[r] = valid ? e : 0.f; }
        R += (TA + TB) + (TAo + TBo);
        wave_lds_sync();
        pv_tile(o0, o1, a, wl, lane);
        wave_lds_sync();
        if (__all(R > 40.0f * LOG2E)) break;
    }
    store_o(o0, o1, wl, OC + (rowb + t0) * 768 + h * 64, 768, lane);
}

constexpr int DLU_WAVE = 5120;
constexpr int DLU_O = 8 * DLU_WAVE, DLU_M = DLU_O + 512 * 128, DLU_L = DLU_M + 2048, DLU_BYTES = DLU_L + 2048;
__device__ __forceinline__ void dl_unit(const bf16* QD, const bf16* KD, const bf16* VD, bf16* OC, int b, int j, int blk, ALAS unsigned char* lds, int wave, int lane) {
    const int r32 = lane & 31, hi = lane >> 5;
    const size_t rowb = (size_t)b * SEQ;
    const int t0 = 512 * blk;
    const int kperm = (r32 & ~12) | ((r32 & 4) << 1) | ((r32 & 8) >> 1);
    ALAS unsigned char* wl = lds + wave * DLU_WAVE;
    ALAS float* sc = (ALAS float*)(wl + 4608);
    ALAS unsigned short* OL = (ALAS unsigned short*)(lds + DLU_O);
    ALAS float* ML = (ALAS float*)(lds + DLU_M); ALAS float* LL = (ALAS float*)(lds + DLU_L);
    for (int g = 2; g >= 0; --g) {
        const int hh = 4 * g + j, sh = 2 * g, r = 1 << sh;
        const float slope2 = __builtin_amdgcn_exp2f(-8.0f * (float)(hh + 1) / 12.0f) * LOG2E;
        const float sr = slope2 * (float)r;
        for (int it = wave; it < 16; it += 8) {
            const int q0 = g == 2 ? it : g == 1 ? (it & 3) + 128 * (it >> 2) : 32 * it;
            const int tq = t0 + q0 + r * r32, tmax = t0 + q0 + 31 * r;
            bf16x8 qf[4];
            { const bf16* qp = QD + (rowb + tq) * 768 + hh * 64 + hi * 8;
#pragma unroll
              for (int d0 = 0; d0 < 4; ++d0) qf[d0] = *(const bf16x8*)(qp + d0 * 16); }
            const int klo = 31 - r32; int khi = klo + 128; { const int kmaxtok = tmax >> sh; khi = khi < kmaxtok ? khi : kmaxtok; }
            const unsigned krange = (unsigned)(khi - klo);
            f32x16 o0 = {}, o1 = {}; float mrun = -3.0e38f, lrun = 0.f;
            if (g != 2) {
                mrun = ML[q0 + r * r32]; lrun = hi ? 0.f : LL[q0 + r * r32];
#pragma unroll
                for (int q = 0; q < 16; ++q) { const int tl = q0 + r * crow(q, hi);
                    o0[q] = __uint_as_float((unsigned)OL[tl * 64 + r32] << 16); o1[q] = __uint_as_float((unsigned)OL[tl * 64 + 32 + r32] << 16); }
            }
            for (int kt = 0; kt < 5; ++kt) {
                int sk = tmax - r * (32 * kt + kperm); sk = sk < 0 ? 0 : sk;
                const bf16* kp = KD + (rowb + sk) * 768 + hh * 64 + hi * 8;
                bf16x8 kf[4];
#pragma unroll
                for (int d0 = 0; d0 < 4; ++d0) kf[d0] = *(const bf16x8*)(kp + d0 * 16);
                u32x4 vv[4];
#pragma unroll
                for (int i = 0; i < 4; ++i) { int sv = tmax - r * (32 * kt + 8 * i + (lane >> 3)); sv = sv < 0 ? 0 : sv; vv[i] = *(const u32x4*)(VD + (rowb + sv) * 768 + hh * 64 + (lane & 7) * 8); }
                const int dk = 32 * kt + 8 * hi - klo;
                const float tb = -sr * (float)dk;
                f32x16 p;
#pragma unroll
                for (int q = 0; q < 16; ++q) p[q] = tb - sr * (float)((q & 7) + 16 * (q >> 3));
#pragma unroll
                for (int d0 = 0; d0 < 4; ++d0) p = __builtin_amdgcn_mfma_f32_32x32x16_bf16(kf[d0], qf[d0], p, 0, 0, 0);
#pragma unroll
                for (int i = 0; i < 4; ++i) *(ALAS u32x4*)(wl + (8 * i + (lane >> 3)) * VPITCH + (lane & 7) * 16) = vv[i];
                float z2[16]; float mt = -3.0e38f;
#pragma unroll
                for (int q = 0; q < 16; ++q) { const bool valid = (unsigned)(dk + ((q & 7) + 16 * (q >> 3))) <= krange; z2[q] = valid ? p[q] : -INFINITY; mt = fmaxf(mt, z2[q]); }
                mt = fmaxf(mt, __shfl_xor(mt, 32));
                if (__any(mt > mrun + 8.0f)) {
                    const float mnew = fmaxf(mrun, mt); const float alpha = __builtin_amdgcn_exp2f(mrun - mnew);
                    lrun *= alpha; float al[16]; bcast_rows(alpha, sc, r32, hi, al);
#pragma unroll
                    for (int q = 0; q < 16; ++q) { o0[q] *= al[q]; o1[q] *= al[q]; }
                    mrun = mnew;
                }
                float a[16]; float ls = 0.f;
#pragma unroll
                for (int q = 0; q < 16; ++q) { a[q] = __builtin_amdgcn_exp2f(z2[q] - mrun); ls += a[q]; }
                lrun += ls;
                wave_lds_sync();
                pv_tile(o0, o1, a, wl, lane);
                wave_lds_sync();
            }
            const float ltot = lrun + __shfl_xor(lrun, 32);
            if (g != 0) {
                if (hi == 0) { ML[q0 + r * r32] = mrun; LL[q0 + r * r32] = ltot; }
#pragma unroll
                for (int q = 0; q < 16; ++q) { const int tl = q0 + r * crow(q, hi);
                    OL[tl * 64 + r32] = (unsigned short)(pkbf(o0[q], 0.f) & 0xffffu); OL[tl * 64 + 32 + r32] = (unsigned short)(pkbf(o1[q], 0.f) & 0xffffu); }
            } else {
                float il[16]; bcast_rows(1.0f / ltot, sc, r32, hi, il);
#pragma unroll
                for (int q = 0; q < 16; ++q) { o0[q] *= il[q]; o1[q] *= il[q]; }
                store_o(o0, o1, wl, OC + (rowb + t0 + q0) * 768 + 512 + j * 64, 768, lane);
            }
        }
        asm volatile("s_waitcnt lgkmcnt(0)" ::: "memory"); __builtin_amdgcn_s_barrier(); asm volatile("" ::: "memory");
    }
}
#undef ALAS
}

constexpr int NWAVES = 8;
#ifndef MK_N_LAUNCHES
#define MK_N_LAUNCHES 1
#endif
#ifndef MK_LAST_PHASE
#define MK_LAST_PHASE 8
#endif
constexpr int N_LAUNCHES = MK_N_LAUNCHES;
constexpr int PER_PHASE = 8;

constexpr int BATCH = 16, SEQ = 4096, D = 1024, T = BATCH * SEQ;
constexpr int N1 = 5888;
constexpr int NEXP = 16384;
constexpr size_t MiB = 1u << 20;
constexpr size_t WS_CTL = 0, CTL_ZERO_BYTES = 1 * MiB;
constexpr size_t WS_WIN = 2 * MiB;
constexpr size_t WS_WCAT = 16 * MiB;
constexpr size_t WS_WOUT = 18 * MiB;
constexpr size_t WS_WC = 20 * MiB;
constexpr size_t WS_RINV1 = 24 * MiB;
constexpr size_t WS_RINV2 = 25 * MiB;
constexpr size_t WS_USC = 25 * MiB + 512 * 1024, WS_VSC = 25 * MiB + 768 * 1024;
constexpr size_t WS_SSQ = 26 * MiB;
constexpr size_t WS_U8 = 32 * MiB;
constexpr size_t WS_V8 = 64 * MiB;
constexpr size_t WS_IDS = 96 * MiB;
constexpr size_t WS_GW = 112 * MiB;
constexpr size_t WS_XB = 144 * MiB;
constexpr size_t WS_OC = 880 * MiB;
constexpr size_t WS_QS = 272 * MiB, WS_KS = 336 * MiB, WS_VS = 400 * MiB;
constexpr size_t WS_QD = 464 * MiB, WS_KD = 560 * MiB, WS_VD = 656 * MiB;
constexpr size_t WS_GT = 752 * MiB;
constexpr size_t WS_COEF = 272 * MiB;
constexpr size_t WS_MIX = 272 * MiB;
constexpr size_t WS_X1B = 400 * MiB;
constexpr size_t WS_HQ = 528 * MiB;
constexpr size_t WS_HS2 = 24 * MiB + 512 * 1024;
constexpr size_t WS_XB8 = 72 * MiB;
constexpr size_t WS_WG8 = 40 * MiB;
constexpr size_t WS_WCS = 46 * MiB;
constexpr size_t WS_WCF = 48 * MiB;
constexpr size_t WS_GCS = 45 * MiB;
constexpr size_t WS_END = 1008 * MiB;
constexpr int CW_BAR = 4096;
constexpr int CW_WMAX = 24576;
constexpr int CW_GMAX = 16384;
constexpr int CW_XRANK = 8192;

constexpr int RING_OFF = 0, RING_BYTES = 131072;
constexpr int LDSCTL_OFF = 143360, MISC_OFF = LDSCTL_OFF + 320;
constexpr int LDS_BYTES = 147456;
static_assert(MISC_OFF + 128 <= LDS_BYTES, "LDS map");
#define GAS __attribute__((address_space(1)))
#define LAS __attribute__((address_space(3)))
typedef unsigned short bf16;
typedef unsigned v4u __attribute__((ext_vector_type(4)));
typedef float f32x4 __attribute__((ext_vector_type(4)));
typedef short bf16x8 __attribute__((ext_vector_type(8)));
typedef GAS unsigned gu32;
typedef GAS unsigned long long gu64;
#define RLX_AGENT __ATOMIC_RELAXED, __HIP_MEMORY_SCOPE_AGENT
#define LDS_WAIT() asm volatile("s_waitcnt lgkmcnt(0)" ::: "memory")
#define VM_WAIT() asm volatile("s_waitcnt vmcnt(0)" ::: "memory")
__device__ __forceinline__ unsigned long long rt() { return __builtin_amdgcn_s_memrealtime(); }
__device__ __forceinline__ unsigned f2bf(float f) { unsigned u = __builtin_bit_cast(unsigned, f); return (u + 0x7fffu + ((u >> 16) & 1u)) >> 16; }
__device__ __forceinline__ unsigned pk2(float lo, float hi) { return f2bf(lo) | (f2bf(hi) << 16); }

#define XB_TMO      128
#define XB_XCNT(j)  (256  + 64 * (j))
#define XB_XSUB(j)  (1280 + 64 * (j))
#define XB_XGEN(j)  (2304 + 64 * (j))
#define XB_TOP      3328
#define XB_TOPGEN   3392
#define XCD_BAR_WORDS 3456
#define XB_SPIN_CAP (1u << 18)

__device__ __forceinline__ unsigned xb_ld(unsigned* p)              { return __hip_atomic_load(p, __ATOMIC_RELAXED, __HIP_MEMORY_SCOPE_AGENT); }
__device__ __forceinline__ unsigned xb_add(unsigned* p, unsigned v) { return __hip_atomic_fetch_add(p, v, __ATOMIC_RELAXED, __HIP_MEMORY_SCOPE_AGENT); }
__device__ __forceinline__ unsigned xb_xcc_id() { return (unsigned)__builtin_amdgcn_s_getreg((3 << 11) | 20) & 0xFu; }
#define XB_SPIN(cond, bar) do { unsigned _sp = 0; while (cond) { __builtin_amdgcn_s_sleep(1); \
    if ((++_sp & 255u) == 0u) { if (xb_ld(&(bar)[XB_TMO])) break; if (_sp > XB_SPIN_CAP) { atomicAdd(&(bar)[XB_TMO], 1u); break; } } } } while (0)

struct XcdBarrier {
    unsigned* bar; unsigned x;
    volatile LAS unsigned* st;
};

__device__ __forceinline__ XcdBarrier xcd_barrier_post(unsigned* bar, volatile LAS unsigned* st) {
    XcdBarrier b; b.bar = bar; b.x = xb_xcc_id(); b.st = st;
    if (threadIdx.x == 0) (void)xb_add(&bar[XB_XCNT(b.x)], 1u);
    return b;
}
__device__ __forceinline__ void xcd_barrier_complete(unsigned* bar, unsigned x, unsigned& nloc, unsigned& nx) {
    const unsigned G = gridDim.x * gridDim.y * gridDim.z;
    unsigned sum, cnt, mine, sp = 0u;
    for (;;) {
        sum = 0u; cnt = 0u; mine = 0u;
#pragma unroll
        for (unsigned j = 0; j < 16; ++j) { const unsigned c = xb_ld(&bar[XB_XCNT(j)]); sum += c; cnt += (c > 0u) ? 1u : 0u; mine = (j == x) ? c : mine; }
        if (sum == G) break;
        __builtin_amdgcn_s_sleep(1);
        if ((++sp & 255u) == 0u) { if (xb_ld(&bar[XB_TMO])) break; if (sp > XB_SPIN_CAP) { atomicAdd(&bar[XB_TMO], 1u); break; } }
    }
    nloc = mine > 0u ? mine : 1u; nx = cnt > 0u ? cnt : 1u;
}

__device__ __forceinline__ void xcd_barrier(const XcdBarrier& b) {
    asm volatile("s_waitcnt vmcnt(0)" ::: "memory");
    __syncthreads();
    if (threadIdx.x == 0) {
        unsigned* bar = b.bar;
        __builtin_amdgcn_s_waitcnt(0);
        unsigned nloc = b.st[0], nx = b.st[1];
        if (nloc == 0u) { xcd_barrier_complete(bar, b.x, nloc, nx); b.st[0] = nloc; b.st[1] = nx; }
        const unsigned old = xb_add(&bar[XB_XSUB(b.x)], 1u);
        const unsigned gen = old / nloc;
        if (old + 1u == (gen + 1u) * nloc) {
            __builtin_amdgcn_fence(__ATOMIC_RELEASE, "agent");
            asm volatile("s_waitcnt vmcnt(0)" ::: "memory");
            const unsigned og = xb_add(&bar[XB_TOP], 1u);
            const unsigned tg = og / nx;
            if (og + 1u == (tg + 1u) * nx) xb_add(&bar[XB_TOPGEN], 1u);
            else XB_SPIN(xb_ld(&bar[XB_TOPGEN]) == tg, bar);
            __builtin_amdgcn_fence(__ATOMIC_ACQUIRE, "agent");
            xb_add(&bar[XB_XGEN(b.x)], 1u);
            asm volatile("s_waitcnt vmcnt(0)" ::: "memory");
        } else {
            XB_SPIN(xb_ld(&bar[XB_XGEN(b.x)]) == gen, bar);
            __builtin_amdgcn_fence(__ATOMIC_ACQUIRE, "agent");
            asm volatile("s_waitcnt vmcnt(0)" ::: "memory");
        }
    }
    __syncthreads();
}

typedef float f32x2 __attribute__((ext_vector_type(2)));
typedef unsigned v2u __attribute__((ext_vector_type(2)));
typedef _Float16 h2_t __attribute__((ext_vector_type(2)));
struct Frame {
    LAS unsigned char* lds;
    volatile LAS unsigned* MISC;
    gu32* ctl;
    int tid, lane, wave;
    int vcu, G;
};
__device__ __forceinline__ float wave_sum(float v) {
#pragma unroll
    for (int o = 1; o < 64; o <<= 1) v += __shfl_xor(v, o);
    return v;
}
__device__ __forceinline__ float wave_max(float v) {
#pragma unroll
    for (int o = 1; o < 64; o <<= 1) v = fmaxf(v, __shfl_xor(v, o));
    return v;
}
constexpr int NB16 = 1536, N8 = 5888 - NB16;
__device__ __forceinline__ int win_row(int n) { if (n < 1536 || n >= 3072) return n; const int t = (n - 1536) >> 8, ln = (n - 1536) & 255, hl = ln >> 6, d = ln & 63; return 1536 + t * 256 + 32 * hl + (d & 31) + 128 * (d >> 5); }
__device__ __forceinline__ void p0_transpose_item(const float* W, int N, const float* gain, bf16* WT, int ldt, int koff, int mode, LAS float* scr, int item, int lane) {
    const int nblk = N / 32, kb = item / nblk, nb = item % nblk, k0 = 64 * kb, n0 = 32 * nb;
#pragma unroll 8
    for (int i = 0; i < 32; ++i) { const int kk = 2 * i + (lane >> 5); float v = W[(size_t)(k0 + kk) * N + n0 + (lane & 31)]; if (gain) v *= gain[k0 + kk]; scr[kk * 33 + (lane & 31)] = v; }
    LDS_WAIT(); asm volatile("" ::: "memory");
    const int c = lane & 7;
#pragma unroll
    for (int j = 0; j < 4; ++j) { const int n = (lane >> 3) + 8 * j; const LAS float* s = scr + (8 * c) * 33 + n;
        v4u o; o.x = pk2(s[0 * 33], s[1 * 33]); o.y = pk2(s[2 * 33], s[3 * 33]); o.z = pk2(s[4 * 33], s[5 * 33]); o.w = pk2(s[6 * 33], s[7 * 33]);
        const int rown = mode ? win_row(n0 + n) : (n0 + n);
        *(GAS v4u*)(WT + (size_t)rown * ldt + koff + k0 + 8 * c) = o; }
    LDS_WAIT(); asm volatile("" ::: "memory");
}
__device__ __forceinline__ void p0_gate_max_item(const float* W, int N, const float* gain, unsigned* gmax, int kb, int n0, int lane) {
    const int k0 = 64 * kb; float am = 0.f;
#pragma unroll 8
    for (int i = 0; i < 32; ++i) { const int kk = 2 * i + (lane >> 5); am = fmaxf(am, fabsf(W[(size_t)(k0 + kk) * N + n0 + (lane & 31)] * gain[k0 + kk])); }
    am = fmaxf(am, __shfl_xor(am, 32));
    if (lane < 32) atomicMax(gmax + (n0 - NB16) + lane, __float_as_uint(am));
}
__device__ __forceinline__ void p0_gate_fp8_item(const float* W, int N, const float* gain, const unsigned* gmax, unsigned char* WG, float* cs, LAS float* scr, int item, int lane) {
    const int kb = item / (N8 / 32), nb = item % (N8 / 32), k0 = 64 * kb, n0 = 32 * nb;
#pragma unroll 8
    for (int i = 0; i < 32; ++i) { const int kk = 2 * i + (lane >> 5); scr[kk * 33 + (lane & 31)] = W[(size_t)(k0 + kk) * N + NB16 + n0 + (lane & 31)] * gain[k0 + kk]; }
    LDS_WAIT(); asm volatile("" ::: "memory");
    const int c = lane & 7;
#pragma unroll
    for (int j = 0; j < 4; ++j) { const int n = (lane >> 3) + 8 * j; const LAS float* sp = scr + (8 * c) * 33 + n;
        const unsigned mb = xb_ld((unsigned*)gmax + n0 + n); const int ex = (int)((mb >> 23) & 0xffu);
        const float sc = (ex == 0) ? 1.0f : __uint_as_float((unsigned)(127 + 7 - (ex - 127)) << 23);
        int p0 = __builtin_amdgcn_cvt_pk_fp8_f32(sp[0 * 33] * sc, sp[1 * 33] * sc, 0, false); p0 = __builtin_amdgcn_cvt_pk_fp8_f32(sp[2 * 33] * sc, sp[3 * 33] * sc, p0, true);
        int p1 = __builtin_amdgcn_cvt_pk_fp8_f32(sp[4 * 33] * sc, sp[5 * 33] * sc, 0, false); p1 = __builtin_amdgcn_cvt_pk_fp8_f32(sp[6 * 33] * sc, sp[7 * 33] * sc, p1, true);
        const int prow = win_row(NB16 + n0 + n) - NB16;
        *(GAS v2u*)(WG + (size_t)prow * 1024 + k0 + 8 * c) = (v2u){(unsigned)p0, (unsigned)p1};
        if (kb == 0 && c == 0) cs[prow] = (ex == 0) ? 1.0f : __uint_as_float((unsigned)(127 - 7 + (ex - 127)) << 23); }
    LDS_WAIT(); asm volatile("" ::: "memory");
}
__device__ __forceinline__ void quant_row_fp8(const float* src, const float* gain, unsigned char* dst, size_t slice_stride, float* scale_out, int lane) {
    f32x4 v[4]; float am = 0.f;
#pragma unroll
    for (int j = 0; j < 4; ++j) { v[j] = *(const GAS f32x4*)(src + 256 * j + 4 * lane); if (gain) v[j] = v[j] * *(const GAS f32x4*)(gain + 256 * j + 4 * lane);
        am = fmaxf(am, fmaxf(fmaxf(fabsf(v[j][0]), fabsf(v[j][1])), fmaxf(fabsf(v[j][2]), fabsf(v[j][3])))); }
    am = wave_max(am);
    const int ex = (int)((__float_as_uint(am) >> 23) & 0xffu);
    const float s = (ex == 0) ? 1.0f : __uint_as_float((unsigned)(127 + 7 - (ex - 127)) << 23);
    const float is = (ex == 0) ? 1.0f : __uint_as_float((unsigned)(127 - 7 + (ex - 127)) << 23);
    if (lane == 0) *scale_out = is;
#pragma unroll
    for (int j = 0; j < 4; ++j) { int pk = __builtin_amdgcn_cvt_pk_fp8_f32(v[j][0] * s, v[j][1] * s, 0, false); pk = __builtin_amdgcn_cvt_pk_fp8_f32(v[j][2] * s, v[j][3] * s, pk, true);
        const int col = 256 * j + 4 * lane; *(GAS int*)(dst + (size_t)(col >> 7) * slice_stride + (col & 127)) = pk; }
}
__device__ __forceinline__ void quant_row_fp4(const float* src, unsigned char* dst, size_t slice_stride, float* scale_out, int lane) {
    f32x4 v[4]; float am = 0.f;
#pragma unroll
    for (int j = 0; j < 4; ++j) { v[j] = *(const GAS f32x4*)(src + 256 * j + 4 * lane); am = fmaxf(am, fmaxf(fmaxf(fabsf(v[j][0]), fabsf(v[j][1])), fmaxf(fabsf(v[j][2]), fabsf(v[j][3])))); }
    am = wave_max(am);
    const float s = am > 0.f ? 6.0f / am : 0.f;
    if (lane == 0) *scale_out = am * (1.0f / 6.0f);
#pragma unroll
    for (int j = 0; j < 4; ++j) { unsigned pk = __builtin_amdgcn_cvt_scalef32_pk_fp4_f32(0u, v[j][0] * s, v[j][1] * s, 1.0f, 0); pk = __builtin_amdgcn_cvt_scalef32_pk_fp4_f32(pk, v[j][2] * s, v[j][3] * s, 1.0f, 1);
        *(GAS unsigned short*)(dst + (size_t)j * slice_stride + 2 * lane) = (unsigned short)(pk & 0xffffu); }
}
__device__ __forceinline__ void quant_row_i4(const float* src, const float* gain, unsigned char* dst, float* scale_out, int lane) {
    f32x4 v[4]; float am = 0.f, ss = 0.f;
    const int p16 = (lane >> 2) & 15, wl = lane & 3;
#pragma unroll
    for (int ld = 0; ld < 2; ++ld)
#pragma unroll
        for (int sn = 0; sn < 2; ++sn) { const int hd = 2 * (4 * ld + wl) + sn; const int idx = 256 * (hd >> 2) + 16 * p16 + 4 * (hd & 3);
            f32x4 t = *(const GAS f32x4*)(src + idx); if (gain) t = t * *(const GAS f32x4*)(gain + idx); v[2 * ld + sn] = t;
            am = fmaxf(am, fmaxf(fmaxf(fabsf(t[0]), fabsf(t[1])), fmaxf(fabsf(t[2]), fabsf(t[3])))); ss += (t[0] * t[0] + t[1] * t[1]) + (t[2] * t[2] + t[3] * t[3]); }
    am = wave_max(am); ss = wave_sum(ss);
    const float clipv = fminf(am, 2.5f * sqrtf(ss * (1.0f / 1024.0f)));
    const float s = clipv > 0.f ? 7.0f / clipv : 0.f;
    if (lane == 0) *scale_out = clipv * (1.0f / (7.0f * 16.0f));
#pragma unroll
    for (int ld = 0; ld < 2; ++ld) { unsigned pk = 0u;
#pragma unroll
        for (int b4 = 0; b4 < 4; ++b4) { int q0 = (int)__builtin_rintf(v[2 * ld][b4] * s), q1 = (int)__builtin_rintf(v[2 * ld + 1][b4] * s);
            q0 = q0 < -7 ? -7 : (q0 > 7 ? 7 : q0); q1 = q1 < -7 ? -7 : (q1 > 7 ? 7 : q1);
            pk |= ((unsigned)(q0 & 15) | ((unsigned)(q1 & 15) << 4)) << (8 * b4); }
        *(GAS unsigned*)(dst + ld * 256 + 16 * p16 + 4 * wl) = pk; }
}
__device__ __forceinline__ float gelu_f(float v) {
    const float av = fabsf(v), t = __builtin_amdgcn_rcpf(av * 0.2316418882f + 1.0f);
    float q = t * 0.5307027145f + (-0.7265760135f); q = q * t + 0.7107068705f; q = q * t + (-0.142248368f); q = q * t + 0.127414796f; q = q * t;
    const float e = __builtin_amdgcn_exp2f((v * v) * (-0.72134752044f));
    const float m = v * (q * e);
    return v < 0.f ? m : v - m;
}

struct Args { const float* in[14]; float* out; unsigned char* ws; int ph_lo, ph_hi, li, pad; };
__global__ void __launch_bounds__(NWAVES * 64, 2) fwd_kernel(Args args) {
    extern __shared__ __attribute__((aligned(16))) unsigned char lds[];
    Frame F;
    F.lds = (LAS unsigned char*)lds;
    F.MISC = (volatile LAS unsigned*)(F.lds + MISC_OFF);
    F.tid = threadIdx.x; F.lane = F.tid & 63; F.wave = __builtin_amdgcn_readfirstlane(F.tid >> 6);
    F.G = gridDim.x; { const int bx = blockIdx.x; F.vcu = (F.G % 8 == 0) ? (bx % 8) * (F.G / 8) + bx / 8 : bx; }
    unsigned char* ws = args.ws;
    F.ctl = (gu32*)(ws + WS_CTL);
    const float* x = args.in[0]; const float* norm1_gain = args.in[1]; const float* w_in = args.in[2]; const float* b_gate = args.in[3];
    const float* q_gain = args.in[4]; const float* k_gain = args.in[5]; const float* w_sb_out = args.in[6]; const float* w_dil_out = args.in[7];
    const float* w_out = args.in[8]; const float* norm2_gain = args.in[9]; const float* w_peer_q = args.in[10]; const float* sub_keys = args.in[11];
    const float* peer_u = args.in[12]; const float* peer_v = args.in[13];
    float* out = args.out;
    bf16* WIN = (bf16*)(ws + WS_WIN); bf16* WCAT = (bf16*)(ws + WS_WCAT); bf16* WOUT = (bf16*)(ws + WS_WOUT); bf16* WC = (bf16*)(ws + WS_WC);
    float* RINV1 = (float*)(ws + WS_RINV1); float* RINV2 = (float*)(ws + WS_RINV2); float* USC = (float*)(ws + WS_USC); float* VSC = (float*)(ws + WS_VSC); float* SSQ = (float*)(ws + WS_SSQ);
    unsigned char* U8 = ws + WS_U8; unsigned char* V8 = ws + WS_V8;
    unsigned short* IDS = (unsigned short*)(ws + WS_IDS); float* GW = (float*)(ws + WS_GW); float* COEF = (float*)(ws + WS_COEF); unsigned char* HQ = ws + WS_HQ; unsigned char* WC8 = ws + WS_WC; float* WCF = (float*)(ws + WS_WCF); float* WCS = (float*)(ws + WS_WCS); float* HS2 = (float*)(ws + WS_HS2);
    bf16* XB = (bf16*)(ws + WS_XB); bf16* OC = (bf16*)(ws + WS_OC); unsigned char* XB8 = ws + WS_XB8; unsigned char* WG8 = ws + WS_WG8; float* GCS = (float*)(ws + WS_GCS);
    bf16* QS = (bf16*)(ws + WS_QS); bf16* KS = (bf16*)(ws + WS_KS); bf16* VS = (bf16*)(ws + WS_VS);
    bf16* QD = (bf16*)(ws + WS_QD); bf16* KD = (bf16*)(ws + WS_KD); bf16* VD = (bf16*)(ws + WS_VD);
    unsigned char* GT = ws + WS_GT; bf16* MIX = (bf16*)(ws + WS_MIX); bf16* X1B = (bf16*)(ws + WS_X1B);

    for (int u = F.tid; u < (LDS_BYTES - LDSCTL_OFF) / 4; u += NWAVES * 64) ((LAS unsigned*)(F.lds + LDSCTL_OFF))[u] = 0u;
    __syncthreads();
    const int my_xcc = (int)xb_xcc_id();
    if (F.tid == 0) F.MISC[12] = xb_add((unsigned*)(F.ctl + CW_XRANK) + 64 * my_xcc, 1u);
    __syncthreads();
    const int my_xrank = (int)F.MISC[12];
    const int bli = (N_LAUNCHES == PER_PHASE) ? 0 : args.li;
    XcdBarrier bar; bar.bar = (unsigned*)(F.ctl + CW_BAR) + bli * XCD_BAR_WORDS; bar.x = 0; bar.st = nullptr;
    if (N_LAUNCHES != PER_PHASE) bar = xcd_barrier_post((unsigned*)(F.ctl + CW_BAR) + bli * XCD_BAR_WORDS, F.MISC + 8);
    const int lo = args.ph_lo, hi = args.ph_hi;
#ifndef PHASE_MASK
#define PHASE_MASK 0xff
#endif
#define IN(k) (((PHASE_MASK >> (k)) & 1) && lo <= (k) && (k) < hi)
#define BOTH(k) (IN(k) && IN((k) + 1))
#define GRID_BAR() do { if (N_LAUNCHES != PER_PHASE) xcd_barrier(bar); } while (0)
#ifndef PROBE_REPEAT
#define PROBE_REPEAT 0x00
#endif
#ifndef PROBE_L1
#define PROBE_L1 0x0
#endif
#define REP(k) _Pragma("unroll") for (int rep_ = 0; rep_ < (((PROBE_REPEAT >> (k)) & 1) ? 2 : 1); ++rep_)
    const int gw = F.vcu * NWAVES + F.wave, NGW = F.G * NWAVES;
#define P67_MAP() int vx = (int)(blockIdx.x & 7), rk = (int)(blockIdx.x >> 3), nrk = (F.G + 7 - vx) / 8; bool p67_uni = false; \
        { bool uni_ = (F.G % 8 == 0); for (int j_ = 0; j_ < 16; ++j_) { const unsigned c_ = xb_ld((unsigned*)(F.ctl + CW_XRANK) + 64 * j_); uni_ = uni_ && (c_ == (j_ < 8 ? (unsigned)(F.G / 8) : 0u)); } \
          if (uni_) { vx = my_xcc; rk = my_xrank; nrk = F.G / 8; p67_uni = true; } }

    if (IN(0)) REP(0) {
        for (int it = F.vcu; it < 256; it += F.G) {
            const int hp = it >> 4, d0 = (it & 15) * 64;
            LAS float* As = (LAS float*)(F.lds);
            LAS float* Bs = (LAS float*)(F.lds + 64 * 132 * 4);
            for (int e = F.tid; e < 64 * 32; e += 512) { const int r = e >> 5, c4 = (e & 31) * 4; *(LAS f32x4*)(As + r * 132 + c4) = *(const GAS f32x4*)(w_peer_q + (size_t)(d0 + r) * 2048 + hp * 128 + c4); }
            for (int e = F.tid; e < 128 * 32; e += 512) { const int r = e >> 5, c4 = (e & 31) * 4; *(LAS f32x4*)(Bs + r * 132 + c4) = *(const GAS f32x4*)(sub_keys + ((size_t)hp * 128 + r) * 128 + c4); }
            __syncthreads();
            const int ddg = F.tid & 15, ng = F.tid >> 4;
            f32x4 acc[4];
#pragma unroll
            for (int j = 0; j < 4; ++j) acc[j] = (f32x4){0.f, 0.f, 0.f, 0.f};
            for (int c4 = 0; c4 < 128; c4 += 4) {
                f32x4 a[4], b[4];
#pragma unroll
                for (int i = 0; i < 4; ++i) { a[i] = *(const LAS f32x4*)(As + (4 * ddg + i) * 132 + c4); b[i] = *(const LAS f32x4*)(Bs + (4 * ng + i) * 132 + c4); }
#pragma unroll
                for (int j = 0; j < 4; ++j)
#pragma unroll
                    for (int i = 0; i < 4; ++i) acc[j][i] += (a[i][0] * b[j][0] + a[i][1] * b[j][1]) + (a[i][2] * b[j][2] + a[i][3] * b[j][3]);
            }
            const f32x4 g2 = *(const GAS f32x4*)(norm2_gain + d0 + 4 * ddg);
#pragma unroll
            for (int j = 0; j < 4; ++j) { const f32x4 o = acc[j] * g2;
                *(GAS f32x4*)(WCF + (size_t)(hp * 128 + 4 * ng + j) * 1024 + d0 + 4 * ddg) = o;
                float am = fmaxf(fmaxf(fabsf(o[0]), fabsf(o[1])), fmaxf(fabsf(o[2]), fabsf(o[3])));
                am = fmaxf(am, __shfl_xor(am, 1)); am = fmaxf(am, __shfl_xor(am, 2)); am = fmaxf(am, __shfl_xor(am, 4)); am = fmaxf(am, __shfl_xor(am, 8));
                if (ddg == 0) atomicMax((unsigned*)(F.ctl + CW_WMAX) + hp * 128 + 4 * ng + j, __float_as_uint(am)); }
            __syncthreads();
        }
        {
            LAS float* scr = (LAS float*)(F.lds + RING_OFF + F.wave * 16384);
            constexpr int I_IN = (D / 64) * (N1 / 32), I_SB = (512 / 64) * (D / 32), I_DL = (256 / 64) * (D / 32), I_OUT = (D / 64) * (D / 32);
            constexpr int NITEMS = I_IN + I_SB + I_DL + I_OUT;
            for (int it = gw; it < NITEMS; it += NGW) {
                int r = it;
                if (r < I_IN) { const int nb_ = r % (N1 / 32); if (nb_ >= NB16 / 32) p0_gate_max_item(w_in, N1, norm1_gain, (unsigned*)(F.ctl + CW_GMAX), r / (N1 / 32), 32 * nb_, F.lane); else p0_transpose_item(w_in, N1, norm1_gain, WIN, 1024, 0, 1, scr, r, F.lane); continue; } r -= I_IN;
                if (r < I_SB) { p0_transpose_item(w_sb_out, D, nullptr, WCAT, 768, 0, 0, scr, r, F.lane); continue; } r -= I_SB;
                if (r < I_DL) { p0_transpose_item(w_dil_out, D, nullptr, WCAT, 768, 512, 0, scr, r, F.lane); continue; } r -= I_DL;
                p0_transpose_item(w_out, D, nullptr, WOUT, 1024, 0, 0, scr, r, F.lane);
            }
        }
        for (int e = gw; e < 2 * NEXP; e += NGW) {
            if (e < NEXP) quant_row_i4(peer_u + (size_t)e * D, norm2_gain, U8 + (size_t)e * 512, USC + e, F.lane);
            else { const int ev = e - NEXP; quant_row_fp4(peer_v + (size_t)ev * D, V8 + (size_t)ev * 128, (size_t)NEXP * 128, VSC + ev, F.lane); }
        }
        for (int m = gw; m < T; m += NGW) {
            const GAS f32x4* xr = (const GAS f32x4*)(x + (size_t)m * D) + F.lane;
            f32x4 v[4]; float s = 0.f;
#pragma unroll
            for (int j = 0; j < 4; ++j) { v[j] = xr[64 * j]; s += (v[j][0] * v[j][0] + v[j][1] * v[j][1]) + (v[j][2] * v[j][2] + v[j][3] * v[j][3]); }
            s = wave_sum(s);
            const float rn = __builtin_amdgcn_rsqf(s * (1.0f / D) + 1e-6f);
            if (F.lane == 0) RINV1[m] = 1.0f / rn;
            GAS unsigned long long* o8 = (GAS unsigned long long*)(XB + (size_t)m * D) + F.lane;
#pragma unroll
            for (int j = 0; j < 4; ++j) o8[64 * j] = (unsigned long long)pk2(v[j][0] * rn, v[j][1] * rn) | ((unsigned long long)pk2(v[j][2] * rn, v[j][3] * rn) << 32);
#pragma unroll
            for (int j = 0; j < 4; ++j) { int pk = __builtin_amdgcn_cvt_pk_fp8_f32(v[j][0] * rn, v[j][1] * rn, 0, false); pk = __builtin_amdgcn_cvt_pk_fp8_f32(v[j][2] * rn, v[j][3] * rn, pk, true);
                *(GAS int*)(XB8 + (size_t)m * D + 256 * j + 4 * F.lane) = pk; }
        }
        if (BOTH(0)) GRID_BAR();
    }

    if (IN(1)) REP(1) {
        { LAS float* scr = (LAS float*)(F.lds + RING_OFF + F.wave * 16384);
          for (int it = gw; it < 16 * (N8 / 32); it += NGW) p0_gate_fp8_item(w_in, N1, norm1_gain, (const unsigned*)(F.ctl + CW_GMAX), WG8, GCS, scr, it, F.lane);
          for (int r = gw; r < 2048; r += NGW) {
              const float am = __uint_as_float(xb_ld((unsigned*)(F.ctl + CW_WMAX) + r)); const float sc = am > 0.f ? 127.0f / am : 0.f;
              unsigned w[4];
#pragma unroll
              for (int j = 0; j < 4; ++j) { const f32x4 v = *(const GAS f32x4*)(WCF + (size_t)r * 1024 + 16 * F.lane + 4 * j);
                  w[j] = ((unsigned)(int)__builtin_rintf(v[0] * sc) & 0xffu) | (((unsigned)(int)__builtin_rintf(v[1] * sc) & 0xffu) << 8) | (((unsigned)(int)__builtin_rintf(v[2] * sc) & 0xffu) << 16) | (((unsigned)(int)__builtin_rintf(v[3] * sc) & 0xffu) << 24); }
              *(GAS v4u*)(WC8 + (size_t)r * 1024 + 16 * F.lane) = (v4u){w[0], w[1], w[2], w[3]};
              if (F.lane == 0) WCS[r] = am * (1.0f / 127.0f); }
          __syncthreads(); }
        { pg8::Gemm g{XB, WIN, T, NB16, D}; pg8::StaticOrder S; S.init(T, NB16, F.G, (int)blockIdx.x);
          pg8::Epi1 E{RINV1, b_gate, q_gain, k_gain, QS, KS, VS};
          pg8::gemm_phase<pg8::Epi1, pg8::StaticOrder, true, true>(F.lds + RING_OFF, g, S, E); }
        GRID_BAR();
        { pg8::Gemm g{(const bf16*)XB8, (const bf16*)WG8, T, N8, D / 2}; pg8::StaticOrder S; S.init(T, N8, F.G, (int)blockIdx.x);
          pg8::EpiG E{b_gate, GCS, q_gain, k_gain, QD, KD, VD, GT};
          pg8::gemm_phase<pg8::EpiG, pg8::StaticOrder, true, true, true>(F.lds + RING_OFF, g, S, E); }
        if (BOTH(1)) GRID_BAR();
    }

    if (IN(2)) REP(2) {
        LAS unsigned char* wl = F.lds + RING_OFF + F.wave * 16384;
        static_assert(att::DLU_BYTES <= RING_BYTES, "dilated-attention LDS state");
        for (int un = F.vcu; un < 512; un += F.G) { const int blk = un & 7, j = (un >> 3) & 3, b = un >> 5; att::dl_unit(QD, KD, VD, OC, b, j, blk, F.lds + RING_OFF, F.wave, F.lane); }
        for (int it = gw; it < 16384; it += NGW) { const int qt = 127 - (it & 127), h = (it >> 7) & 7, b = it >> 10; att::sb_item(QS, KS, VS, OC, b, h, qt, wl, F.lane); }
        if (BOTH(2)) GRID_BAR();
    }

    if (IN(3)) REP(3) {
        pg8::Gemm g{OC, WCAT, T, D, 768}; pg8::StaticOrder S; S.init(T, D, F.G, (int)blockIdx.x);
        pg8::Epi2 E{GT, MIX};
        pg8::gemm_phase<pg8::Epi2, pg8::StaticOrder, true, true>(F.lds + RING_OFF, g, S, E);
        if (BOTH(3)) GRID_BAR();
    }

    if (IN(4)) REP(4) {
        pg8::Gemm g{MIX, WOUT, T, D, D}; pg8::StaticOrder S; S.init(T, D, F.G, (int)blockIdx.x);
        pg8::Epi3 E{XB, RINV1, X1B, SSQ};
        pg8::gemm_phase<pg8::Epi3, pg8::StaticOrder, true, true>(F.lds + RING_OFF, g, S, E);
        if (BOTH(4)) GRID_BAR();
    }

    if (IN(5)) REP(5) {
        for (int m = gw; m < T; m += NGW) {
            const v4u a = *(const GAS v4u*)(X1B + (size_t)m * D + 8 * F.lane), b = *(const GAS v4u*)(X1B + (size_t)m * D + 512 + 8 * F.lane);
            float v[16] = {pg8::bflo(a.x), pg8::bfhi(a.x), pg8::bflo(a.y), pg8::bfhi(a.y), pg8::bflo(a.z), pg8::bfhi(a.z), pg8::bflo(a.w), pg8::bfhi(a.w),
                           pg8::bflo(b.x), pg8::bfhi(b.x), pg8::bflo(b.y), pg8::bfhi(b.y), pg8::bflo(b.z), pg8::bfhi(b.z), pg8::bflo(b.w), pg8::bfhi(b.w)};
            float am = 0.f;
#pragma unroll
            for (int i = 0; i < 16; ++i) am = fmaxf(am, fabsf(v[i]));
            am = wave_max(am);
            float sq = (F.lane < 16) ? SSQ[(size_t)m * 16 + F.lane] : 0.f; sq = wave_sum(sq);
            const float s = am > 0.f ? 127.0f / am : 0.f;
            if (F.lane == 0) HS2[m] = am * (1.0f / 127.0f) * __builtin_amdgcn_rsqf(sq * (1.0f / 1024.0f) + 1e-6f);
            int q[16];
#pragma unroll
            for (int i = 0; i < 16; ++i) q[i] = (int)__builtin_rintf(v[i] * s) & 0xff;
            v2u o0, o1; o0.x = q[0] | (q[1] << 8) | (q[2] << 16) | (q[3] << 24); o0.y = q[4] | (q[5] << 8) | (q[6] << 16) | (q[7] << 24);
            o1.x = q[8] | (q[9] << 8) | (q[10] << 16) | (q[11] << 24); o1.y = q[12] | (q[13] << 8) | (q[14] << 16) | (q[15] << 24);
            *(GAS v2u*)(HQ + (size_t)m * D + 8 * F.lane) = o0; *(GAS v2u*)(HQ + (size_t)m * D + 512 + 8 * F.lane) = o1;
        }
        GRID_BAR();
        pg8::Gemm g{(const bf16*)HQ, (const bf16*)WC8, T, 2048, D / 2}; pg8::StaticOrder S; S.init(T, 2048, F.G, (int)blockIdx.x);
        pg8::Epi4 E{SSQ, RINV2, IDS, GW, HS2, WCS};
        pg8::OneUnit O1;
        for (int i = 0; S.next(i, O1.u); ++i) pg8::gemm_phase<pg8::Epi4, pg8::OneUnit, false, true, false, true>(F.lds + RING_OFF, g, O1, E);
        if (BOTH(5)) GRID_BAR();
    }

    if (IN(6)) REP(6) {
        P67_MAP();
        const int p16 = F.lane & 15, sg = F.lane >> 4;
        LAS unsigned char* HB = F.lds + RING_OFF + F.wave * 16384;
        LAS unsigned* LIST = (LAS unsigned*)(F.lds + RING_OFF + F.wave * 16384 + 8192);
        LAS float* HSs = (LAS float*)(F.lds + RING_OFF + F.wave * 16384 + 12288);
        const int nwb = T / 8, wstep = nrk * NWAVES;
        const int gsel = (F.lane & 15), bpsrc = (16 * (F.lane & 3) + ((F.lane >> 2) & 3)) * 4;
        v4u hpre[8], idpre[2]; float hspre = 0.f;
#define P6_PRE(bb) do { const int bc_ = (bb) < nwb ? (bb) : nwb - 1; const unsigned char* hsrc_ = HQ + (size_t)bc_ * 8192; \
            _Pragma("unroll") for (int i_ = 0; i_ < 8; ++i_) hpre[i_] = *(const GAS v4u*)(hsrc_ + (size_t)(i_ * 64 + F.lane) * 16); \
            const unsigned short* isrc_ = IDS + ((size_t)bc_ * 8 + (F.lane >> 3)) * 128 + 16 * (F.lane & 7); idpre[0] = *(const GAS v4u*)isrc_; idpre[1] = *(const GAS v4u*)(isrc_ + 8); \
            hspre = HS2[(size_t)bc_ * 8 + (F.lane & 7)]; } while (0)
#define P6_ISSUE(W, ENT, EJ, GB, UB, VB, base_) do { \
                _Pragma("unroll") for (int g_ = 0; g_ < 4; ++g_) { const int j_ = (base_) + 4 * g_ + sg; ENT[g_] = LIST[j_ < n ? j_ : nm1]; } \
                { const int j_ = (base_) + gsel; EJ = (j_ < n && F.lane < 16) ? (int)LIST[j_] : -1; } \
                _Pragma("unroll") for (int g_ = 0; g_ < 4; ++g_) { const unsigned char* up_ = U8 + (size_t)((PROBE_L1 && rep_) ? 0u : (ENT[g_] & 0xffffu)) * 512 + 16 * p16; \
                    _Pragma("unroll") for (int i_ = 0; i_ < 2; ++i_) W[g_][i_] = *(const GAS v4u*)(up_ + 256 * i_); } \
                { const unsigned ej_ = EJ < 0 ? 0u : (unsigned)EJ; GB = GW[((size_t)t0 + (ej_ >> 24)) * 128 + ((ej_ >> 16) & 127u)]; UB = USC[ej_ & 0xffffu]; VB = VSC[ej_ & 0xffffu]; } } while (0)
#define P6_DPPADD(a_, ctrl) a_ += __builtin_amdgcn_update_dpp(0, a_, ctrl, 0xf, 0xf, false)
#define P6_REDUCE(W, ENT, EJ, GB, UB, VB, base_) do { if ((base_) < n) { int ag_[4]; \
                _Pragma("unroll") for (int g_ = 0; g_ < 4; ++g_) { const LAS unsigned char* hp_ = HB + (size_t)(ENT[g_] >> 24) * 1024 + 16 * p16; int a_ = 0; v4u h_[4]; \
                    _Pragma("unroll") for (int i_ = 0; i_ < 4; ++i_) h_[i_] = *(const LAS v4u*)(hp_ + 256 * i_); \
                    _Pragma("unroll") for (int ld_ = 0; ld_ < 2; ++ld_) { const unsigned x_[4] = {W[g_][ld_].x, W[g_][ld_].y, W[g_][ld_].z, W[g_][ld_].w}; \
                        _Pragma("unroll") for (int wl_ = 0; wl_ < 4; ++wl_) { const int hd_ = 2 * (4 * ld_ + wl_); const unsigned lo_ = (x_[wl_] << 4) & 0xF0F0F0F0u, hi_ = x_[wl_] & 0xF0F0F0F0u; \
                            const unsigned hA_ = (hd_ & 3) == 0 ? h_[hd_ >> 2].x : h_[hd_ >> 2].z, hB_ = (hd_ & 3) == 0 ? h_[hd_ >> 2].y : h_[hd_ >> 2].w; \
                            a_ = __builtin_amdgcn_sdot4((int)lo_, (int)hA_, a_, false); a_ = __builtin_amdgcn_sdot4((int)hi_, (int)hB_, a_, false); } } \
                    P6_DPPADD(a_, 0xB1); P6_DPPADD(a_, 0x4E); P6_DPPADD(a_, 0x141); P6_DPPADD(a_, 0x140); ag_[g_] = a_; } \
                const int sel_ = gsel == 0 ? ag_[0] : gsel == 1 ? ag_[1] : gsel == 2 ? ag_[2] : ag_[3]; \
                const float resv_ = (float)__builtin_amdgcn_ds_bpermute(bpsrc, sel_); \
                if (EJ >= 0 && !(PROBE_L1 && rep_)) { const unsigned ej_ = (unsigned)EJ; const float act_ = gelu_f(resv_ * UB * HSs[ej_ >> 24]); \
                    COEF[((size_t)t0 + (ej_ >> 24)) * 128 + ((ej_ >> 16) & 127u)] = GB * act_ * VB; } } } while (0)
        int wb = rk * NWAVES + F.wave;
        P6_PRE(wb);
        for (; wb < nwb; wb += wstep) {
            const int t0 = wb * 8;
            asm volatile("s_waitcnt lgkmcnt(0)" ::: "memory");
            if (F.lane < 8) HSs[F.lane] = hspre;
#pragma unroll
            for (int i = 0; i < 8; ++i) *(LAS v4u*)(HB + (size_t)(i * 64 + F.lane) * 16) = hpre[i];
            int n = 0;
            { const unsigned idw[8] = {idpre[0].x, idpre[0].y, idpre[0].z, idpre[0].w, idpre[1].x, idpre[1].y, idpre[1].z, idpre[1].w};
              const unsigned tl = (unsigned)(F.lane >> 3), kb0 = 16u * (unsigned)(F.lane & 7);
#pragma unroll
              for (int i = 0; i < 16; ++i) { const unsigned e = (i & 1) ? (idw[i >> 1] >> 16) : (idw[i >> 1] & 0xffffu);
                  const bool inr = ((int)(e >> 11) == vx); const unsigned long long mk = __ballot(inr);
                  const int pos = n + (int)__builtin_amdgcn_mbcnt_hi((unsigned)(mk >> 32), __builtin_amdgcn_mbcnt_lo((unsigned)mk, 0u));
                  if (inr) LIST[pos] = (tl << 24) | ((kb0 + (unsigned)i) << 16) | e;
                  n += __builtin_popcountll(mk); } }
            asm volatile("s_waitcnt lgkmcnt(0)" ::: "memory");
            P6_PRE(wb + wstep);
            const int nm1 = n > 0 ? n - 1 : 0;
            for (int base = 0; base < n; base += 32) {
                v4u wA[4][2], wB[4][2]; unsigned entA[4], entB[4]; int ejA, ejB; float gbA, ubA, vbA, gbB, ubB, vbB;
                P6_ISSUE(wA, entA, ejA, gbA, ubA, vbA, base);
                P6_ISSUE(wB, entB, ejB, gbB, ubB, vbB, base + 16);
                P6_REDUCE(wA, entA, ejA, gbA, ubA, vbA, base);
                P6_REDUCE(wB, entB, ejB, gbB, ubB, vbB, base + 16);
            }
        }
#undef P6_PRE
#undef P6_ISSUE
#undef P6_REDUCE
#undef P6_DPPADD
        if (BOTH(6)) GRID_BAR();
    }

    if (IN(7)) REP(7) {
        P67_MAP();
        const int cs = vx >> 1;
        const int n0_ = p67_uni ? F.G / 8 : (F.G + 7 - 2 * cs) / 8, n1_ = p67_uni ? F.G / 8 : (F.G + 7 - (2 * cs + 1)) / 8;
        const int rk2 = (vx & 1) ? n0_ + rk : rk, nrk2 = n0_ + n1_;
        const int l8 = F.lane & 7, kg = F.lane >> 3;
        const unsigned char* vbase = V8 + (size_t)cs * NEXP * 128 + 16 * l8;
        const int tstep = nrk2 * NWAVES;
        const int col = 256 * cs + 32 * l8 + ((F.lane & 8) ? 16 : 0) + ((F.lane & 16) ? 8 : 0) + ((F.lane & 32) ? 4 : 0);
#define P7_CL(tt) ((tt) < T ? (tt) : T - 1)
#define P7_IDS(tt, ID) do { const int tc_ = P7_CL(tt); ID[0] = *(const GAS v4u*)(IDS + (size_t)tc_ * 128 + 16 * kg); ID[1] = *(const GAS v4u*)(IDS + (size_t)tc_ * 128 + 16 * kg + 8); } while (0)
#define P7_ISSUE(tt, ID, W, CF, OO) do { const int tc_ = P7_CL(tt); const unsigned idw_[8] = {ID[0].x, ID[0].y, ID[0].z, ID[0].w, ID[1].x, ID[1].y, ID[1].z, ID[1].w}; \
            _Pragma("unroll") for (int i_ = 0; i_ < 16; ++i_) { const unsigned e_ = (i_ & 1) ? (idw_[i_ >> 1] >> 16) : (idw_[i_ >> 1] & 0xffffu); W[i_] = *(const GAS v4u*)(vbase + (size_t)((PROBE_L1 && rep_) ? 0u : e_) * 128); } \
            _Pragma("unroll") for (int i_ = 0; i_ < 4; ++i_) CF[i_] = *(const GAS f32x4*)(COEF + (size_t)tc_ * 128 + 16 * kg + 4 * i_); \
            OO = *(const GAS v2u*)(X1B + (size_t)tc_ * D + col); } while (0)
#define P7_BYTE(d_, s_) do { const h2_t r_ = __builtin_amdgcn_cvt_scalef32_pk_f16_fp4(ww_[d_], 1.0f, s_); acc_[4 * (d_) + (s_)] = r_ * c2_ + acc_[4 * (d_) + (s_)]; } while (0)
#define P7_COMPUTE(tt, W, CF, OO) do { h2_t acc_[16];                 \
            _Pragma("unroll") for (int i_ = 0; i_ < 16; ++i_) acc_[i_] = (h2_t){(_Float16)0.f, (_Float16)0.f}; \
            _Pragma("unroll") for (int i_ = 0; i_ < 16; ++i_) { const unsigned ww_[4] = {W[i_].x, W[i_].y, W[i_].z, W[i_].w}; const _Float16 ch_ = (_Float16)CF[i_ >> 2][i_ & 3]; const h2_t c2_ = {ch_, ch_}; \
                P7_BYTE(0, 0); P7_BYTE(0, 1); P7_BYTE(0, 2); P7_BYTE(0, 3); P7_BYTE(1, 0); P7_BYTE(1, 1); P7_BYTE(1, 2); P7_BYTE(1, 3); \
                P7_BYTE(2, 0); P7_BYTE(2, 1); P7_BYTE(2, 2); P7_BYTE(2, 3); P7_BYTE(3, 0); P7_BYTE(3, 1); P7_BYTE(3, 2); P7_BYTE(3, 3); } \
            float r16_[16], r8_[8], r4_[4]; \
            { const bool up_ = (F.lane & 8) != 0; _Pragma("unroll") for (int i_ = 0; i_ < 8; ++i_) { const h2_t keep_ = up_ ? acc_[8 + i_] : acc_[i_], send_ = up_ ? acc_[i_] : acc_[8 + i_]; \
                const h2_t oth_ = __builtin_bit_cast(h2_t, __shfl_xor(__builtin_bit_cast(int, send_), 8)); r16_[2 * i_] = (float)keep_[0] + (float)oth_[0]; r16_[2 * i_ + 1] = (float)keep_[1] + (float)oth_[1]; } } \
            { const bool up_ = (F.lane & 16) != 0; _Pragma("unroll") for (int i_ = 0; i_ < 8; ++i_) { const float keep_ = up_ ? r16_[8 + i_] : r16_[i_], send_ = up_ ? r16_[i_] : r16_[8 + i_]; r8_[i_] = keep_ + __shfl_xor(send_, 16); } } \
            { const bool up_ = (F.lane & 32) != 0; _Pragma("unroll") for (int i_ = 0; i_ < 4; ++i_) { const float keep_ = up_ ? r8_[4 + i_] : r8_[i_], send_ = up_ ? r8_[i_] : r8_[4 + i_]; r4_[i_] = keep_ + __shfl_xor(send_, 32); } } \
            if ((tt) < T) *(GAS f32x4*)((rep_ == 0 ? out : (float*)(ws + WS_GT)) + (size_t)(tt) * D + col) = (f32x4){pg8::bflo(OO.x) + r4_[0], pg8::bfhi(OO.x) + r4_[1], pg8::bflo(OO.y) + r4_[2], pg8::bfhi(OO.y) + r4_[3]}; } while (0)
        v4u idA[2], idB[2], wA[16], wB[16]; f32x4 cfA[4], cfB[4]; v2u ooA, ooB;
        int t = rk2 * NWAVES + F.wave;
        P7_IDS(t, idA); P7_IDS(t + tstep, idB);
        while (t < T) {
            P7_ISSUE(t, idA, wA, cfA, ooA); P7_ISSUE(t + tstep, idB, wB, cfB, ooB);
            P7_IDS(t + 2 * tstep, idA); P7_IDS(t + 3 * tstep, idB);
            P7_COMPUTE(t, wA, cfA, ooA);
            P7_COMPUTE(t + tstep, wB, cfB, ooB);
            t += 2 * tstep;
        }
#undef P7_CL
#undef P7_IDS
#undef P7_ISSUE
#undef P7_BYTE
#undef P7_COMPUTE
    }
#undef IN
#undef BOTH
#undef GRID_BAR
}

extern "C" void kernel_launch(void* const* d_in, const int* in_sizes, int n_in, void* d_out, int out_size, void* d_ws, size_t ws_size, hipStream_t stream) {
    static int grid = 0;
    if (grid == 0) {
        if (n_in != 14 || in_sizes[0] != T * D || out_size != T * D || ws_size < WS_END) { fprintf(stderr, "kernel_launch: built for 14 inputs, x and out of %d floats, >= %zu bytes of workspace; got n_in %d, in0 %d, out %d, ws %zu; nothing launched\n", T * D, (size_t)WS_END, n_in, n_in > 0 ? in_sizes[0] : -1, out_size, ws_size); grid = -1; return; }
        int dev = 0, cus = 0, per_cu = 0;
        if (hipGetDevice(&dev) != hipSuccess || hipDeviceGetAttribute(&cus, hipDeviceAttributeMultiprocessorCount, dev) != hipSuccess) { fprintf(stderr, "kernel_launch: hipGetDevice / hipDeviceGetAttribute failed\n"); grid = -1; return; }
        if (hipFuncSetAttribute((const void*)fwd_kernel, hipFuncAttributeMaxDynamicSharedMemorySize, LDS_BYTES) != hipSuccess) { fprintf(stderr, "kernel_launch: hipFuncSetAttribute failed\n"); grid = -1; return; }
        if (hipOccupancyMaxActiveBlocksPerMultiprocessor(&per_cu, (const void*)fwd_kernel, NWAVES * 64, LDS_BYTES) != hipSuccess || per_cu < 1)
            fprintf(stderr, "kernel_launch: note: occupancy query reports %d workgroups per CU\n", per_cu);
        (void)hipGetLastError();
        grid = cus;
    }
    if (grid < 0) return;
    if (hipMemsetAsync((char*)d_ws + WS_CTL, 0, CTL_ZERO_BYTES, stream) != hipSuccess) { fprintf(stderr, "kernel_launch: hipMemsetAsync failed\n"); return; }
    Args a{};
    for (int i = 0; i < 14; ++i) a.in[i] = (const float*)d_in[i];
    a.out = (float*)d_out; a.ws = (unsigned char*)d_ws;
    for (int li = 0; li < N_LAUNCHES; ++li) {
        a.ph_lo = (N_LAUNCHES == PER_PHASE) ? li : 0; a.ph_hi = (N_LAUNCHES == PER_PHASE) ? li + 1 : MK_LAST_PHASE; a.li = li;
        if (a.ph_lo >= MK_LAST_PHASE) break;
        hipLaunchKernelGGL(fwd_kernel, dim3(grid), dim3(NWAVES * 64), LDS_BYTES, stream, a);
        const hipError_t le = hipPeekAtLastError();
        if (le != hipSuccess) { fprintf(stderr, "kernel_launch: launch %d failed: %s\n", li, hipGetErrorName(le)); break; }
    }
}
```

```cpp
#include <hip/hip_runtime.h>
#include <cstdio>
#include <cstdint>
namespace pg8 {
#define PG8_LAS __attribute__((address_space(3)))
typedef unsigned short bf16_t;
typedef short bf16x8 __attribute__((ext_vector_type(8)));
typedef float f32x4 __attribute__((ext_vector_type(4)));
typedef unsigned u32x4 __attribute__((ext_vector_type(4)));
typedef int i32x8 __attribute__((ext_vector_type(8)));
typedef int i32x4 __attribute__((ext_vector_type(4)));
constexpr int BM = 256, BK = 64, HALF = 128, HTB = HALF * BK * 2  , STAGE_BYTES = 8 * HTB, NXCD = 8, WGM = 8;

__host__ __device__ __forceinline__ int lds_byte(int r, int c) { const int st = (r >> 4) * 2 + (c >> 5), rr = r & 15, cc = c & 31, ob = rr * 64 + cc * 2; return st * 1024 + (ob ^ (((ob >> 9) & 1) << 5)); }
__host__ __device__ __forceinline__ void stage_rc(int b, int& R, int& C) { const int st = b / 1024, sb = b % 1024, swz = sb ^ (((sb >> 9) & 1) << 5); R = (st >> 1) * 16 + swz / 64; C = (st & 1) * 32 + (swz % 64) / 2; }
__host__ __device__ __forceinline__ int perm32(int rho) { const int n = rho >> 4, i = rho & 15; return 8 * (i >> 2) + 4 * n + (i & 3); }

struct Unit { int pm, pn; };
struct Gemm { const bf16_t* A; const bf16_t* Bt; int M, N, K; };

struct StaticOrder {
    int nM, nN, nwg, G, c;
    __host__ __device__ void init(int M, int N, int G_, int c_) { nM = M / BM; nN = N / BM; nwg = nM * nN; G = G_; c = c_; }
    __host__ __device__ bool next(int i, Unit& u) const {
        const long L = (long)i * G + c; if (L >= nwg) return false;
        int wgid = (int)L; { const int q = nwg / NXCD, r = nwg % NXCD, xcd = wgid % NXCD, off = wgid / NXCD; wgid = (xcd < r ? xcd * (q + 1) : r * (q + 1) + (xcd - r) * q) + off; }
        const int nig = WGM * nN, gid = wgid / nig, fm = gid * WGM, gsz = (nM - fm) < WGM ? (nM - fm) : WGM;
        u.pm = fm + ((wgid % nig) % gsz); u.pn = (wgid % nig) / gsz; return true;
    }
    __device__ __forceinline__ void a_ready(const Unit&) const {}
    __device__ __forceinline__ void done(const Unit&) const {}
};


struct OneUnit {
    Unit u;
    __device__ __forceinline__ bool next(int i, Unit& o) const { if (i != 0) return false; o = u; return true; }
    __device__ __forceinline__ void a_ready(const Unit&) const {}
    __device__ __forceinline__ void done(const Unit&) const {}
};

typedef float f32x2 __attribute__((ext_vector_type(2)));
typedef __bf16 bf16x2_t __attribute__((ext_vector_type(2)));
typedef unsigned u32x2 __attribute__((ext_vector_type(2)));
__device__ __forceinline__ unsigned pkbf(float lo, float hi) { f32x2 v = {lo, hi}; bf16x2_t b = __builtin_convertvector(v, bf16x2_t); return __builtin_bit_cast(unsigned, b); }
__device__ __forceinline__ float bflo(unsigned w) { return __uint_as_float(w << 16); }
__device__ __forceinline__ float bfhi(unsigned w) { return __uint_as_float(w & 0xffff0000u); }
__device__ __forceinline__ u32x4 pack8(const f32x4 a, const f32x4 b) { u32x4 w; w.x = pkbf(a[0], a[1]); w.y = pkbf(a[2], a[3]); w.z = pkbf(b[0], b[1]); w.w = pkbf(b[2], b[3]); return w; }
constexpr float QSCALE = 0.125f * 1.4426950408889634f;
__device__ __forceinline__ float sigmoidf_(float v) { return __builtin_amdgcn_rcpf(1.0f + __builtin_amdgcn_exp2f(-1.4426950408889634f * v)); }

struct EpiG {
    static constexpr bool PERM = true, AFTER_DRAIN = false, HAS_MID = false; static constexpr int MID_T = -1;
    const float* bgate; const float* cs; const float* xs; const float* qg; const float* kg; bf16_t *QS, *KS, *VS, *QD, *KD, *VD; unsigned char* GT;
    __device__ __forceinline__ void mid(f32x4 (&)[2][2][4][2], const Unit&, int, int, int, int) const {}
    static __device__ __forceinline__ f32x4 cvt(const f32x4 a, const f32x4 sc) { const i32x4 ia = __builtin_bit_cast(i32x4, a); return (f32x4){(float)ia[0], (float)ia[1], (float)ia[2], (float)ia[3]} * sc; }
    __device__ __forceinline__ void operator()(const f32x4 (&acc)[2][2][4][2], const Unit& u, int wr, int wc, int fr, int fq) const {
        asm volatile("" : "+v"(fr), "+v"(fq));
        const int pn = u.pn; const int row0 = u.pm * BM + wr * 64 + fr, colp = pn * BM + wc * 32 + 8 * fq;
        f32x4 sv[2][2];
#pragma unroll
        for (int bj = 0; bj < 2; ++bj)
#pragma unroll
            for (int n = 0; n < 2; ++n) sv[bj][n] = *(const f32x4*)(cs + colp + bj * HALF + 4 * n);
        if (pn < 6) {
            bf16_t* base; int colt;
            if (pn < 2) { base = QS; colt = pn * 256; } else if (pn < 4) { base = KS; colt = (pn - 2) * 256; } else { base = VS; colt = (pn - 4) * 256; }
            base += colt + wc * 32 + 8 * fq;
            const float qs = (pn < 2 ? QSCALE : 1.0f);
#pragma unroll
            for (int ai = 0; ai < 2; ++ai)
#pragma unroll
                for (int m = 0; m < 4; ++m) { const int row = row0 + ai * HALF + m * 16; const float r = xs[row] * qs;
#pragma unroll
                    for (int bj = 0; bj < 2; ++bj) *(u32x4*)(base + (size_t)row * 512 + bj * HALF) = pack8(cvt(acc[ai][bj][m][0], sv[bj][0]) * r, cvt(acc[ai][bj][m][1], sv[bj][1]) * r);
                }
        } else if (pn < 12) {
            const bool isK = pn >= 9; const int head = (isK ? pn - 9 : pn - 6) * 4 + wc;
            const float* g = (isK ? kg : qg) + head * 64 + 8 * fq;
            f32x4 gv[2][2]; const float qsc = isK ? 1.0f : QSCALE;
#pragma unroll
            for (int bj = 0; bj < 2; ++bj)
#pragma unroll
                for (int n = 0; n < 2; ++n) gv[bj][n] = *(const f32x4*)(g + 32 * bj + 4 * n) * qsc;
            bf16_t* base = (isK ? KD : QD) + head * 64 + 8 * fq;
#pragma unroll
            for (int ai = 0; ai < 2; ++ai)
#pragma unroll
                for (int m = 0; m < 4; ++m) { const int row = row0 + ai * HALF + m * 16; const float r = xs[row];
                    f32x4 v[2][2]; float ss = 0.f;
#pragma unroll
                    for (int bj = 0; bj < 2; ++bj)
#pragma unroll
                        for (int n = 0; n < 2; ++n) { v[bj][n] = cvt(acc[ai][bj][m][n], sv[bj][n]) * r; const f32x4 q = v[bj][n] * v[bj][n]; ss += (q[0] + q[1]) + (q[2] + q[3]); }
                    ss += __shfl_xor(ss, 16); ss += __shfl_xor(ss, 32);
                    const float sc = __builtin_amdgcn_rsqf(ss * (1.0f / 64.0f) + 1e-6f);
#pragma unroll
                    for (int bj = 0; bj < 2; ++bj) *(u32x4*)(base + (size_t)row * 768 + 32 * bj) = pack8(v[bj][0] * sc * gv[bj][0], v[bj][1] * sc * gv[bj][1]);
                }
        } else if (pn < 15) {
            bf16_t* base = VD + (pn - 12) * 256 + wc * 32 + 8 * fq;
#pragma unroll
            for (int ai = 0; ai < 2; ++ai)
#pragma unroll
                for (int m = 0; m < 4; ++m) { const int row = row0 + ai * HALF + m * 16; const float r = xs[row];
#pragma unroll
                    for (int bj = 0; bj < 2; ++bj) *(u32x4*)(base + (size_t)row * 768 + bj * HALF) = pack8(cvt(acc[ai][bj][m][0], sv[bj][0]) * r, cvt(acc[ai][bj][m][1], sv[bj][1]) * r);
                }
        } else {
            const int col0 = (pn - 15) * 256 + wc * 32 + 8 * fq;
            f32x4 bv[2][2];
#pragma unroll
            for (int bj = 0; bj < 2; ++bj)
#pragma unroll
                for (int n = 0; n < 2; ++n) bv[bj][n] = *(const f32x4*)(bgate + col0 + bj * HALF + 4 * n);
#pragma unroll
            for (int ai = 0; ai < 2; ++ai)
#pragma unroll
                for (int m = 0; m < 4; ++m) { const int row = row0 + ai * HALF + m * 16; const float r = xs[row];
#pragma unroll
                    for (int bj = 0; bj < 2; ++bj) { f32x4 a = cvt(acc[ai][bj][m][0], sv[bj][0]) * r + bv[bj][0], b = cvt(acc[ai][bj][m][1], sv[bj][1]) * r + bv[bj][1];
#pragma unroll
                        for (int e = 0; e < 4; ++e) { a[e] = sigmoidf_(a[e]) * 255.0f; b[e] = sigmoidf_(b[e]) * 255.0f; }
                        unsigned w0 = 0, w1 = 0;
                        w0 = __builtin_amdgcn_cvt_pk_u8_f32(a[0], 0, w0); w0 = __builtin_amdgcn_cvt_pk_u8_f32(a[1], 1, w0); w0 = __builtin_amdgcn_cvt_pk_u8_f32(a[2], 2, w0); w0 = __builtin_amdgcn_cvt_pk_u8_f32(a[3], 3, w0);
                        w1 = __builtin_amdgcn_cvt_pk_u8_f32(b[0], 0, w1); w1 = __builtin_amdgcn_cvt_pk_u8_f32(b[1], 1, w1); w1 = __builtin_amdgcn_cvt_pk_u8_f32(b[2], 2, w1); w1 = __builtin_amdgcn_cvt_pk_u8_f32(b[3], 3, w1);
                        *(u32x2*)(GT + (size_t)row * 2048 + col0 + bj * HALF) = (u32x2){w0, w1}; }
                }
        }
    }
};

struct Epi2 {
    static constexpr bool PERM = true, AFTER_DRAIN = false, HAS_MID = true; static constexpr int MID_T = 8;
    const unsigned char* GT; bf16_t* MIX;
    static __device__ __forceinline__ float ub(unsigned w, int e) { return (float)((w >> (8 * e)) & 0xffu); }
    static __device__ __forceinline__ float gcv(unsigned w, int e) { return fmaxf(ub(w, e) * (1.0f / 255.0f), 1e-30f); }
    __device__ __forceinline__ void mid(f32x4 (&acc)[2][2][4][2], const Unit& u, int wr, int wc, int fr, int fq) const {
        asm volatile("" : "+v"(fr), "+v"(fq));
        const int row0 = u.pm * BM + wr * 64 + fr, col0 = u.pn * BM + wc * 32 + 8 * fq;
        u32x2 ga[2][4][2], gb[2][4][2];
#pragma unroll
        for (int ai = 0; ai < 2; ++ai)
#pragma unroll
            for (int m = 0; m < 4; ++m) { const unsigned char* gp = GT + (size_t)(row0 + ai * HALF + m * 16) * 2048 + col0;
#pragma unroll
                for (int bj = 0; bj < 2; ++bj) { ga[ai][m][bj] = *(const u32x2*)(gp + bj * HALF); gb[ai][m][bj] = *(const u32x2*)(gp + 1024 + bj * HALF); } }
        asm volatile("" ::: "memory");
#pragma unroll
        for (int ai = 0; ai < 2; ++ai)
#pragma unroll
            for (int m = 0; m < 4; ++m)
#pragma unroll
                for (int bj = 0; bj < 2; ++bj) { const u32x2 a = ga[ai][m][bj], b = gb[ai][m][bj];
                    f32x4 r0, r1;
#pragma unroll
                    for (int e = 0; e < 4; ++e) { r0[e] = ub(a.x, e) * (1.0f / 255.0f) * __builtin_amdgcn_rcpf(gcv(b.x, e)); r1[e] = ub(a.y, e) * (1.0f / 255.0f) * __builtin_amdgcn_rcpf(gcv(b.y, e)); }
                    acc[ai][bj][m][0] *= r0; acc[ai][bj][m][1] *= r1; }
        asm volatile("" ::: "memory");
    }
    __device__ __forceinline__ void operator()(const f32x4 (&acc)[2][2][4][2], const Unit& u, int wr, int wc, int fr, int fq) const {
        asm volatile("" : "+v"(fr), "+v"(fq));
        const int row0 = u.pm * BM + wr * 64 + fr, col0 = u.pn * BM + wc * 32 + 8 * fq;
        u32x2 gb[2][4][2];
#pragma unroll
        for (int ai = 0; ai < 2; ++ai)
#pragma unroll
            for (int m = 0; m < 4; ++m) { const unsigned char* gp = GT + (size_t)(row0 + ai * HALF + m * 16) * 2048 + 1024 + col0;
#pragma unroll
                for (int bj = 0; bj < 2; ++bj) gb[ai][m][bj] = *(const u32x2*)(gp + bj * HALF); }
        asm volatile("" ::: "memory");
#pragma unroll
        for (int ai = 0; ai < 2; ++ai)
#pragma unroll
            for (int m = 0; m < 4; ++m) { const int row = row0 + ai * HALF + m * 16;
#pragma unroll
                for (int bj = 0; bj < 2; ++bj) { const u32x2 b = gb[ai][m][bj];
                    f32x4 g0, g1;
#pragma unroll
                    for (int e = 0; e < 4; ++e) { g0[e] = gcv(b.x, e); g1[e] = gcv(b.y, e); }
                    *(u32x4*)(MIX + (size_t)row * 1024 + col0 + bj * HALF) = pack8(acc[ai][bj][m][0] * g0, acc[ai][bj][m][1] * g1); } }
    }
};

struct Epi3 {
    static constexpr bool PERM = true, AFTER_DRAIN = false, HAS_MID = false; static constexpr int MID_T = -1;
    const bf16_t* xb; const float* rms; bf16_t* x1b; float* ssq;
    __device__ __forceinline__ void mid(f32x4 (&)[2][2][4][2], const Unit&, int, int, int, int) const {}
    __device__ __forceinline__ void operator()(const f32x4 (&acc)[2][2][4][2], const Unit& u, int wr, int wc, int fr, int fq) const {
        asm volatile("" : "+v"(fr), "+v"(fq));
        const int row0 = u.pm * BM + wr * 64 + fr, col0 = u.pn * BM + wc * 32 + 8 * fq;
        u32x4 xv[2][4][2]; float rm[2][4];
#pragma unroll
        for (int ai = 0; ai < 2; ++ai)
#pragma unroll
            for (int m = 0; m < 4; ++m) { const size_t off = (size_t)(row0 + ai * HALF + m * 16) * 1024 + col0; rm[ai][m] = rms[row0 + ai * HALF + m * 16];
#pragma unroll
                for (int bj = 0; bj < 2; ++bj) xv[ai][m][bj] = *(const u32x4*)(xb + off + bj * HALF); }
        asm volatile("" ::: "memory");
#pragma unroll
        for (int ai = 0; ai < 2; ++ai)
#pragma unroll
            for (int m = 0; m < 4; ++m) { const int row = row0 + ai * HALF + m * 16; const size_t off = (size_t)row * 1024 + col0; float ss = 0.f; const float r = rm[ai][m];
#pragma unroll
                for (int bj = 0; bj < 2; ++bj) { const u32x4 w = xv[ai][m][bj];
                    const f32x4 x0 = (f32x4){bflo(w.x), bfhi(w.x), bflo(w.y), bfhi(w.y)}, x1 = (f32x4){bflo(w.z), bfhi(w.z), bflo(w.w), bfhi(w.w)};
                    const f32x4 v0 = acc[ai][bj][m][0] + x0 * r, v1 = acc[ai][bj][m][1] + x1 * r;
                    *(u32x4*)(x1b + off + bj * HALF) = pack8(v0, v1);
                    const f32x4 q0 = v0 * v0, q1 = v1 * v1; ss += ((q0[0] + q0[1]) + (q0[2] + q0[3])) + ((q1[0] + q1[1]) + (q1[2] + q1[3])); }
                ss += __shfl_xor(ss, 16); ss += __shfl_xor(ss, 32);
                if (fq == 0) ssq[(size_t)row * 16 + u.pn * 4 + wc] = ss;
            }
    }
};

__device__ __forceinline__ unsigned f2key(float v) { const unsigned u = __float_as_uint(v); return (u & 0x80000000u) ? ~u : (u | 0x80000000u); }
__device__ __forceinline__ float key2f(unsigned k) { return __uint_as_float((k & 0x80000000u) ? (k & 0x7fffffffu) : ~k); }
#define PG8_CE(a_, b_) do { const unsigned hi__ = (a_) > (b_) ? (a_) : (b_); const unsigned lo__ = (a_) > (b_) ? (b_) : (a_); (a_) = hi__; (b_) = lo__; } while (0)
__device__ __forceinline__ void bitonic_merge16(unsigned (&v)[16]) {
#pragma unroll
    for (int j = 8; j >= 1; j >>= 1)
#pragma unroll
        for (int i = 0; i < 16; ++i) { const int l = i ^ j; if (l > i) PG8_CE(v[i], v[l]); }
}
__device__ __forceinline__ void bitonic_sort16(unsigned (&v)[16]) {
#pragma unroll
    for (int k = 2; k <= 16; k <<= 1)
#pragma unroll
        for (int j = k >> 1; j >= 1; j >>= 1)
#pragma unroll
            for (int i = 0; i < 16; ++i) { const int l = i ^ j; if (l > i) { if ((i & k) == 0 || k == 16) PG8_CE(v[i], v[l]); else PG8_CE(v[l], v[i]); } }
}
__device__ __forceinline__ void merge_top16(unsigned (&t)[16], const unsigned (&o)[16]) {
#pragma unroll
    for (int i = 0; i < 16; ++i) t[i] = t[i] > o[15 - i] ? t[i] : o[15 - i];
    bitonic_merge16(t);
}
template <int XM> __device__ __forceinline__ void merge_top16_xor(unsigned (&t)[16]) {
    unsigned o[16];
#pragma unroll
    for (int i = 0; i < 16; ++i) o[i] = (unsigned)__shfl_xor((int)t[i], XM);
    merge_top16(t, o);
}

struct Epi4 {
    static constexpr bool PERM = false, AFTER_DRAIN = true, HAS_MID = false; static constexpr int MID_T = -1;
    const float* ssq; float* rinv2; unsigned short* ids; float* gw;
    const float* hs; const float* wcs;
    __device__ __forceinline__ void mid(f32x4 (&)[2][2][4][2], const Unit&, int, int, int, int) const {}
    __device__ __forceinline__ void fused(f32x4 (&acc)[2][2][4][2], const Unit& u, int wr, int wc, int fr, int fq, PG8_LAS unsigned char* lds, int wid, int lane) const {
        asm volatile("" : "+v"(fr), "+v"(fq));
        const int tid = wid * 64 + lane;
        const int rl = tid >> 2, p = (tid >> 1) & 1, hf = tid & 1, q4 = tid & 3;
#pragma unroll
        for (int pass = 0; pass < 2; ++pass) {
            f32x4 wsv[2][2]; float hsv[4];
#pragma unroll
            for (int bj = 0; bj < 2; ++bj)
#pragma unroll
                for (int n = 0; n < 2; ++n) wsv[bj][n] = *(const f32x4*)(wcs + u.pn * BM + bj * HALF + wc * 32 + n * 16 + fq * 4);
#pragma unroll
            for (int m = 0; m < 4; ++m) hsv[m] = hs[u.pm * BM + pass * HALF + wr * 64 + m * 16 + fr];
#pragma unroll
            for (int m = 0; m < 4; ++m)
#pragma unroll
                for (int bj = 0; bj < 2; ++bj)
#pragma unroll
                    for (int n = 0; n < 2; ++n) { const i32x4 ia = __builtin_bit_cast(i32x4, acc[pass][bj][m][n]); f32x4 sv;
#pragma unroll
                        for (int e = 0; e < 4; ++e) sv[e] = (float)ia[e] * hsv[m] * wsv[bj][n][e];
                        *(PG8_LAS f32x4*)(lds + (size_t)(wr * 64 + m * 16 + fr) * 1056 + bj * 528 + (wc * 32 + n * 16 + fq * 4) * 4) = sv; }
            asm volatile("s_waitcnt lgkmcnt(0)" ::: "memory"); __builtin_amdgcn_s_barrier(); asm volatile("" ::: "memory");
            const int row = u.pm * BM + pass * HALF + rl;
            unsigned tk[16];
#pragma unroll
            for (int i = 0; i < 16; ++i) tk[i] = 0u;
            const PG8_LAS unsigned char* sp = lds + (size_t)rl * 1056 + p * 528 + hf * 256;
#pragma nounroll
            for (int c = 0; c < 4; ++c) { unsigned ch[16];
#pragma unroll
                for (int e4 = 0; e4 < 4; ++e4) { const f32x4 v = *(const PG8_LAS f32x4*)(sp + c * 64 + e4 * 16);
#pragma unroll
                    for (int e = 0; e < 4; ++e) ch[4 * e4 + e] = (f2key(v[e]) & ~127u) | (unsigned)(127 - (64 * hf + 16 * c + 4 * e4 + e)); }
                bitonic_sort16(ch);
                merge_top16(tk, ch);
            }
            merge_top16_xor<1>(tk);
            asm volatile("s_waitcnt lgkmcnt(0)" ::: "memory");
            PG8_LAS unsigned* kl = (PG8_LAS unsigned*)(lds + (size_t)(rl & ~15) * 1056) + ((rl & 15) * 2) * 16;
            if (hf == 0) {
#pragma unroll
                for (int i = 0; i < 4; ++i) *(PG8_LAS u32x4*)(kl + p * 16 + 4 * i) = (u32x4){tk[4 * i], tk[4 * i + 1], tk[4 * i + 2], tk[4 * i + 3]}; }
            asm volatile("s_waitcnt lgkmcnt(0)" ::: "memory");
            unsigned ck[16];
#define CAND_SLOT(m_, ij__) do { const unsigned i__ = (ij__) >> 4, j__ = (ij__) & 15u; \
                const unsigned ka__ = kl[(ij__) == 0xFFFFu ? 0u : i__], kb__ = kl[16 + ((ij__) == 0xFFFFu ? 0u : j__)]; \
                const float s__ = key2f(ka__ & ~127u) + key2f(kb__ & ~127u); \
                ck[m_] = (ij__) == 0xFFFFu ? 0u : ((f2key(s__) & ~255u) | (255u - (ij__))); } while (0)
                { const unsigned ij_ = q4 == 0 ? 0u : q4 == 1 ? 1u : q4 == 2 ? 2u : 3u; CAND_SLOT(0, ij_); }
                { const unsigned ij_ = q4 == 0 ? 4u : q4 == 1 ? 5u : q4 == 2 ? 6u : 7u; CAND_SLOT(1, ij_); }
                { const unsigned ij_ = q4 == 0 ? 8u : q4 == 1 ? 9u : q4 == 2 ? 10u : 11u; CAND_SLOT(2, ij_); }
                { const unsigned ij_ = q4 == 0 ? 12u : q4 == 1 ? 13u : q4 == 2 ? 14u : 15u; CAND_SLOT(3, ij_); }
                { const unsigned ij_ = q4 == 0 ? 16u : q4 == 1 ? 17u : q4 == 2 ? 18u : 19u; CAND_SLOT(4, ij_); }
                { const unsigned ij_ = q4 == 0 ? 20u : q4 == 1 ? 21u : q4 == 2 ? 22u : 23u; CAND_SLOT(5, ij_); }
                { const unsigned ij_ = q4 == 0 ? 32u : q4 == 1 ? 33u : q4 == 2 ? 34u : 35u; CAND_SLOT(6, ij_); }
                { const unsigned ij_ = q4 == 0 ? 36u : q4 == 1 ? 48u : q4 == 2 ? 49u : 50u; CAND_SLOT(7, ij_); }
                { const unsigned ij_ = q4 == 0 ? 51u : q4 == 1 ? 64u : q4 == 2 ? 65u : 66u; CAND_SLOT(8, ij_); }
                { const unsigned ij_ = q4 == 0 ? 80u : q4 == 1 ? 81u : q4 == 2 ? 96u : 97u; CAND_SLOT(9, ij_); }
                { const unsigned ij_ = q4 == 0 ? 112u : q4 == 1 ? 113u : q4 == 2 ? 128u : 144u; CAND_SLOT(10, ij_); }
                { const unsigned ij_ = q4 == 0 ? 160u : q4 == 1 ? 176u : q4 == 2 ? 192u : 208u; CAND_SLOT(11, ij_); }
                { const unsigned ij_ = q4 == 0 ? 224u : q4 == 1 ? 240u : q4 == 2 ? 65535u : 65535u; CAND_SLOT(12, ij_); }
#undef CAND_SLOT
            ck[13] = 0u; ck[14] = 0u; ck[15] = 0u;
            bitonic_sort16(ck);
            merge_top16_xor<1>(ck); merge_top16_xor<2>(ck);
            float sq = 0.f;
#pragma unroll
            for (int i = 0; i < 4; ++i) { const f32x4 t = *(const f32x4*)(ssq + (size_t)row * 16 + 4 * i); sq += (t[0] + t[1]) + (t[2] + t[3]); }
            const float r2 = __builtin_amdgcn_rsqf(sq * (1.0f / 1024.0f) + 1e-6f);
            if (u.pn == 0 && q4 == 0) rinv2[row] = r2;
            const float b0 = key2f(ck[0] & ~255u); float wsum = 0.f; float wv[16];
#pragma unroll
            for (int q = 0; q < 16; ++q) { wv[q] = __builtin_amdgcn_exp2f((key2f(ck[q] & ~255u) - b0) * r2 * 1.4426950408889634f); wsum += wv[q]; }
            const float inv = 1.0f / wsum;
            unsigned short eo[4]; float go[4];
#pragma unroll
            for (int e = 0; e < 4; ++e) { unsigned c0 = ck[e], c1 = ck[4 + e], c2 = ck[8 + e], c3 = ck[12 + e]; float w0 = wv[e], w1 = wv[4 + e], w2 = wv[8 + e], w3 = wv[12 + e];
                asm volatile("" : "+v"(c0), "+v"(c1), "+v"(c2), "+v"(c3), "+v"(w0), "+v"(w1), "+v"(w2), "+v"(w3));
                const unsigned cc = q4 == 0 ? c0 : q4 == 1 ? c1 : q4 == 2 ? c2 : c3; const float ww = q4 == 0 ? w0 : q4 == 1 ? w1 : q4 == 2 ? w2 : w3;
                const unsigned code = 255u - (cc & 255u);
                const unsigned i1 = 127u - (kl[code >> 4] & 127u), i2 = 127u - (kl[16 + (code & 15u)] & 127u);
                eo[e] = (unsigned short)(i1 * 128u + i2); go[e] = ww * inv; }
            const size_t ob = ((size_t)row * 8 + u.pn) * 16 + q4 * 4;
            { u32x2 w; w.x = eo[0] | ((unsigned)eo[1] << 16); w.y = eo[2] | ((unsigned)eo[3] << 16); *(u32x2*)(ids + ob) = w; }
            *(f32x4*)(gw + ob) = (f32x4){go[0], go[1], go[2], go[3]};
            asm volatile("s_waitcnt lgkmcnt(0)" ::: "memory"); __builtin_amdgcn_s_barrier(); asm volatile("" ::: "memory");
        }
    }
};
template <class Epi, class Sched, bool ALIGN_EPI = false, bool SP2 = false, bool FP8 = false, bool I8 = false>
__device__ __forceinline__ void gemm_phase(PG8_LAS unsigned char* lds, const Gemm g, const Sched& S, const Epi& E) {
    const int tid = threadIdx.x, wid = __builtin_amdgcn_readfirstlane(tid >> 6), lane = tid & 63, wr = wid >> 2, wc = wid & 3, fr = lane & 15, fq = lane >> 4;
    const int K = g.K, nt = K / BK;
    unsigned voffA[2], voffB[2];
#pragma unroll
    for (int i = 0; i < 2; ++i) { int R, C; stage_rc(tid * 16 + i * 8192, R, C); const int Rb = Epi::PERM ? ((R & ~31) + perm32(R & 31)) : R;
        voffA[i] = (unsigned)(R * K + C) * 2u; voffB[i] = (unsigned)(Rb * K + C) * 2u; }
    const size_t kstep = (size_t)(BK * 2);
    const size_t hstep = (size_t)HALF * K * 2;
    const size_t tstep = 2 * hstep;
    const unsigned ldsw = (unsigned)wid * 1024u;
    const int aoff = lds_byte(wr * 64 + fr, fq * 8), boff = lds_byte(wc * 32 + fr, fq * 8);
#define PG8_SA(b, h) (((b) * 2 + (h)) * HTB)
#define PG8_SB(b, h) ((4 + (b) * 2 + (h)) * HTB)
#define PG8_STAGE(bufoff, gbase, voff) do { _Pragma("unroll") for (int _i = 0; _i < 2; ++_i) \
        __builtin_amdgcn_global_load_lds((const unsigned*)((const char*)(gbase) + (voff)[_i]), (PG8_LAS unsigned*)(lds + (bufoff) + ldsw + _i * 8192), 16, 0, 0); } while (0)
#define PG8_LD8(lo_, hi_) __builtin_bit_cast(i32x8, __builtin_shufflevector((lo_), (hi_), 0, 1, 2, 3, 4, 5, 6, 7))
#define PG8_LDA(dst, b, h) do { if constexpr (FP8) { _Pragma("unroll") for (int m = 0; m < 4; ++m) { const u32x4 l0_ = *(const PG8_LAS u32x4*)(lds + PG8_SA(b, h) + aoff + m * 2048), l1_ = *(const PG8_LAS u32x4*)(lds + PG8_SA(b, h) + aoff + m * 2048 + 1024); dst##8[m] = PG8_LD8(l0_, l1_); } } \
        else { _Pragma("unroll") for (int m = 0; m < 4; ++m) _Pragma("unroll") for (int k = 0; k < 2; ++k) dst[m][k] = *(const PG8_LAS bf16x8*)(lds + PG8_SA(b, h) + aoff + m * 2048 + k * 1024); } } while (0)
#define PG8_LDB(dst, b, h) do { if constexpr (FP8) { _Pragma("unroll") for (int n = 0; n < 2; ++n) { const u32x4 l0_ = *(const PG8_LAS u32x4*)(lds + PG8_SB(b, h) + boff + n * 2048), l1_ = *(const PG8_LAS u32x4*)(lds + PG8_SB(b, h) + boff + n * 2048 + 1024); dst##8[n] = PG8_LD8(l0_, l1_); } } \
        else { _Pragma("unroll") for (int n = 0; n < 2; ++n) _Pragma("unroll") for (int k = 0; k < 2; ++k) dst[n][k] = *(const PG8_LAS bf16x8*)(lds + PG8_SB(b, h) + boff + n * 2048 + k * 1024); } } while (0)
#define PG8_MMA(ai, bj, At, Bt) do { __builtin_amdgcn_s_setprio(1); \
        if constexpr (FP8) { _Pragma("unroll") for (int m = 0; m < 4; ++m) _Pragma("unroll") for (int n = 0; n < 2; ++n) \
            asm volatile("v_mfma_scale_f32_16x16x128_f8f6f4 %0, %1, %2, %0, %3, %3 op_sel_hi:[0,0,0]" : "+v"(acc[ai][bj][m][n]) : "v"(Bt##8[n]), "v"(At##8[m]), "v"(sc127));     \
            } \
        else if constexpr (I8) { _Pragma("unroll") for (int m = 0; m < 4; ++m) _Pragma("unroll") for (int n = 0; n < 2; ++n) _Pragma("unroll") for (int k = 0; k < 2; ++k) \
            acc[ai][bj][m][n] = __builtin_bit_cast(f32x4, __builtin_amdgcn_mfma_i32_16x16x64_i8(__builtin_bit_cast(i32x4, Bt[n][k]), __builtin_bit_cast(i32x4, At[m][k]), __builtin_bit_cast(i32x4, acc[ai][bj][m][n]), 0, 0, 0)); } \
        else { _Pragma("unroll") for (int m = 0; m < 4; ++m) _Pragma("unroll") for (int n = 0; n < 2; ++n) _Pragma("unroll") for (int k = 0; k < 2; ++k) \
            acc[ai][bj][m][n] = __builtin_amdgcn_mfma_f32_16x16x32_bf16(Bt[n][k], At[m][k], acc[ai][bj][m][n], 0, 0, 0); } \
        __builtin_amdgcn_s_setprio(0); } while (0)
#define PG8_WAIT_V(n) asm volatile("s_waitcnt vmcnt(" #n ")" ::: "memory")
#define PG8_WAIT_L(n) asm volatile("s_waitcnt lgkmcnt(" #n ")" ::: "memory")
#define PG8_BAR __builtin_amdgcn_s_barrier()
#define PG8_SCHED __builtin_amdgcn_sched_barrier(0)
    Unit cur, nxt; int ui = 0;
    if (!S.next(0, cur)) return;
    f32x4 acc[2][2][4][2];
#pragma unroll
    for (int a = 0; a < 2; ++a)
#pragma unroll
        for (int b = 0; b < 2; ++b)
#pragma unroll
            for (int m = 0; m < 4; ++m)
#pragma unroll
                for (int n = 0; n < 2; ++n) acc[a][b][m][n] = (f32x4){0.f, 0.f, 0.f, 0.f};
    bf16x8 At[4][2], B0[2][2], B1[2][2]; i32x8 At8[4], B08[2], B18[2];
    int sc127 = 127; asm volatile("" : "+v"(sc127));
    const char* cA = (const char*)g.A + (size_t)cur.pm * tstep; const char* cB = (const char*)g.Bt + (size_t)cur.pn * tstep;
    S.a_ready(cur);
    if constexpr (SP2) {
        PG8_STAGE(PG8_SB(0, 0), cB, voffB); PG8_STAGE(PG8_SB(0, 1), cB + hstep, voffB); PG8_STAGE(PG8_SA(0, 0), cA, voffA); PG8_STAGE(PG8_SA(0, 1), cA + hstep, voffA);
        if (wr == 1) PG8_BAR;
        PG8_WAIT_V(2); PG8_BAR;
        PG8_STAGE(PG8_SB(1, 0), cB + kstep, voffB); PG8_STAGE(PG8_SA(1, 0), cA + kstep, voffA); PG8_STAGE(PG8_SB(1, 1), cB + hstep + kstep, voffB);
        PG8_WAIT_V(6); PG8_BAR;
    } else {
        PG8_STAGE(PG8_SB(0, 0), cB, voffB); PG8_STAGE(PG8_SA(0, 0), cA, voffA); PG8_STAGE(PG8_SB(0, 1), cB + hstep, voffB); PG8_STAGE(PG8_SA(0, 1), cA + hstep, voffA);
        if (wr == 1) PG8_BAR;
        PG8_WAIT_V(4); PG8_BAR;
        PG8_STAGE(PG8_SB(1, 0), cB + kstep, voffB); PG8_STAGE(PG8_SA(1, 0), cA + kstep, voffA); PG8_STAGE(PG8_SB(1, 1), cB + hstep + kstep, voffB);
        PG8_WAIT_V(6); PG8_BAR;
    }
    for (;;) {
        const bool has_next = S.next(ui + 1, nxt);
        const char* nA = has_next ? (const char*)g.A + (size_t)nxt.pm * tstep : cA; const char* nB = has_next ? (const char*)g.Bt + (size_t)nxt.pn * tstep : cB;
        for (int t = 0; t < nt; t += 2) {
            if constexpr (Epi::HAS_MID) { if (t == Epi::MID_T) E.mid(acc, cur, wr, wc, fr, fq); }
            const bool last = (t == nt - 2);
            const char* a1 = cA + (size_t)(t + 1) * kstep;
            const char* a2 = last ? nA : cA + (size_t)(t + 2) * kstep; const char* b2 = last ? nB : cB + (size_t)(t + 2) * kstep;
            const char* a3 = a2 + kstep; const char* b3 = b2 + kstep;
            if (last && has_next) S.a_ready(nxt);
            if constexpr (SP2) {
            PG8_LDB(B0, 0, 0); PG8_LDB(B1, 0, 1); PG8_SCHED; PG8_LDA(At, 0, 0); PG8_STAGE(PG8_SA(1, 1), a1 + hstep, voffA);
            PG8_WAIT_V(8); PG8_WAIT_L(0); PG8_BAR; PG8_MMA(0, 0, At, B0); PG8_MMA(0, 1, At, B1); PG8_BAR; PG8_SCHED;
            PG8_LDA(At, 0, 1); PG8_STAGE(PG8_SB(0, 0), b2, voffB); PG8_STAGE(PG8_SB(0, 1), b2 + hstep, voffB); PG8_STAGE(PG8_SA(0, 0), a2, voffA);
            PG8_WAIT_V(8); PG8_WAIT_L(0); PG8_BAR; PG8_MMA(1, 0, At, B0); PG8_MMA(1, 1, At, B1); PG8_BAR; PG8_SCHED;
            PG8_LDB(B0, 1, 0); PG8_LDB(B1, 1, 1); PG8_SCHED; PG8_LDA(At, 1, 0); PG8_STAGE(PG8_SA(0, 1), a2 + hstep, voffA);
            PG8_WAIT_V(8); PG8_WAIT_L(0); PG8_BAR; PG8_MMA(0, 0, At, B0); PG8_MMA(0, 1, At, B1); PG8_BAR; PG8_SCHED;
            PG8_LDA(At, 1, 1); PG8_STAGE(PG8_SB(1, 0), b3, voffB); PG8_STAGE(PG8_SB(1, 1), b3 + hstep, voffB); PG8_STAGE(PG8_SA(1, 0), a3, voffA);
            PG8_WAIT_V(8); PG8_WAIT_L(0); PG8_BAR; PG8_MMA(1, 0, At, B0); PG8_MMA(1, 1, At, B1); PG8_BAR; PG8_SCHED;
            } else {
            PG8_LDB(B0, 0, 0); PG8_SCHED; PG8_LDA(At, 0, 0); PG8_STAGE(PG8_SA(1, 1), a1 + hstep, voffA);
            PG8_WAIT_L(8); PG8_BAR; PG8_WAIT_L(0); PG8_MMA(0, 0, At, B0); PG8_BAR; PG8_SCHED;
            PG8_LDB(B1, 0, 1); PG8_STAGE(PG8_SB(0, 0), b2, voffB);
            PG8_BAR; PG8_WAIT_L(0); PG8_MMA(0, 1, At, B1); PG8_BAR;
            PG8_LDA(At, 0, 1); PG8_STAGE(PG8_SA(0, 0), a2, voffA);
            PG8_BAR; PG8_WAIT_L(0); PG8_MMA(1, 0, At, B0); PG8_BAR; PG8_SCHED;
            PG8_STAGE(PG8_SB(0, 1), b2 + hstep, voffB);
            PG8_WAIT_V(6); PG8_BAR; PG8_MMA(1, 1, At, B1); PG8_BAR;
            PG8_LDB(B0, 1, 0); PG8_SCHED; PG8_LDA(At, 1, 0); PG8_STAGE(PG8_SA(0, 1), a2 + hstep, voffA);
            PG8_WAIT_L(8); PG8_BAR; PG8_WAIT_L(0); PG8_MMA(0, 0, At, B0); PG8_BAR; PG8_SCHED;
            PG8_LDB(B1, 1, 1); PG8_STAGE(PG8_SB(1, 0), b3, voffB);
            PG8_BAR; PG8_WAIT_L(0); PG8_MMA(0, 1, At, B1); PG8_BAR;
            PG8_LDA(At, 1, 1); PG8_STAGE(PG8_SA(1, 0), a3, voffA);
            PG8_BAR; PG8_WAIT_L(0); PG8_MMA(1, 0, At, B0); PG8_BAR; PG8_SCHED;
            PG8_STAGE(PG8_SB(1, 1), b3 + hstep, voffB);
            PG8_WAIT_V(6); PG8_BAR; PG8_MMA(1, 1, At, B1); PG8_BAR;
            }
        }
        if constexpr (FP8) asm volatile("s_nop 15\n\ts_nop 15" ::: "memory");
        if constexpr (ALIGN_EPI) { if (wr == 0) PG8_BAR; }
        if constexpr (!Epi::AFTER_DRAIN) { E(acc, cur, wr, wc, fr, fq); S.done(cur); }
        if (!has_next) break;
#pragma unroll
        for (int a = 0; a < 2; ++a)
#pragma unroll
            for (int b = 0; b < 2; ++b)
#pragma unroll
                for (int m = 0; m < 4; ++m)
#pragma unroll
                    for (int n = 0; n < 2; ++n) acc[a][b][m][n] = (f32x4){0.f, 0.f, 0.f, 0.f};
        cur = nxt; cA = nA; cB = nB; ++ui;
        if constexpr (ALIGN_EPI) { if (wr == 1) PG8_BAR; }
    }
    PG8_WAIT_V(0);
    if constexpr (!ALIGN_EPI) { if (wr == 0) PG8_BAR; }
    PG8_BAR;
    if constexpr (Epi::AFTER_DRAIN) { E.fused(acc, cur, wr, wc, fr, fq, lds, wid, lane); S.done(cur); }
#undef PG8_SA
#undef PG8_SB
#undef PG8_STAGE
#undef PG8_LDA
#undef PG8_LD8
#undef PG8_LDB
#undef PG8_MMA
#undef PG8_WAIT_V
#undef PG8_WAIT_L
#undef PG8_BAR
#undef PG8_SCHED
}
}


namespace att {
#define ALAS __attribute__((address_space(3)))
typedef unsigned short bf16;
typedef short bf16x8 __attribute__((ext_vector_type(8)));
typedef short s16x4 __attribute__((ext_vector_type(4)));
typedef float f32x16 __attribute__((ext_vector_type(16)));
typedef float f32x4 __attribute__((ext_vector_type(4)));
typedef float f32x2 __attribute__((ext_vector_type(2)));
typedef unsigned u32x4 __attribute__((ext_vector_type(4)));
typedef __bf16 bf16x2_t __attribute__((ext_vector_type(2)));
constexpr int SEQ = 4096;
constexpr int VPITCH = 144;
constexpr float LOG2E = 1.4426950408889634f, LN2 = 0.6931471805599453f;
__device__ __forceinline__ unsigned pkbf(float lo, float hi) { f32x2 v = {lo, hi}; bf16x2_t b = __builtin_convertvector(v, bf16x2_t); return __builtin_bit_cast(unsigned, b); }
__device__ __forceinline__ void wave_lds_sync() { asm volatile("s_waitcnt lgkmcnt(0)" ::: "memory"); }
__device__ __forceinline__ s16x4 vtr(const ALAS unsigned char* p) { return __builtin_bit_cast(s16x4, __builtin_amdgcn_ds_read_tr16_b64_v4i16((ALAS s16x4*)p)); }
__device__ __forceinline__ int crow(int r, int hi) { return (r & 3) + 8 * (r >> 2) + 4 * hi; }

__device__ __forceinline__ void pv_tile(f32x16& o0, f32x16& o1, const float (&a)[16], const ALAS unsigned char* vt, int lane) {
    const int g = lane >> 4, i = lane & 15, q_ = i >> 2, p_ = i & 3, h = lane >> 5;
    const ALAS unsigned char* vb = vt + (8 * h + q_) * VPITCH + (16 * (g & 1) + 4 * p_) * 2;
    u32x4 pw0, pw1;
    pw0.x = pkbf(a[0], a[1]); pw0.y = pkbf(a[2], a[3]); pw0.z = pkbf(a[4], a[5]); pw0.w = pkbf(a[6], a[7]);
    pw1.x = pkbf(a[8], a[9]); pw1.y = pkbf(a[10], a[11]); pw1.z = pkbf(a[12], a[13]); pw1.w = pkbf(a[14], a[15]);
    const bf16x8 pa0 = __builtin_bit_cast(bf16x8, pw0), pa1 = __builtin_bit_cast(bf16x8, pw1);
#pragma unroll
    for (int s = 0; s < 2; ++s) {
        const s16x4 l0 = vtr(vb + (16 * s) * VPITCH), h0 = vtr(vb + (16 * s + 4) * VPITCH);
        const s16x4 l1 = vtr(vb + (16 * s) * VPITCH + 64), h1 = vtr(vb + (16 * s + 4) * VPITCH + 64);
        const bf16x8 v0 = (bf16x8){l0[0], l0[1], l0[2], l0[3], h0[0], h0[1], h0[2], h0[3]};
        const bf16x8 v1 = (bf16x8){l1[0], l1[1], l1[2], l1[3], h1[0], h1[1], h1[2], h1[3]};
        o0 = __builtin_amdgcn_mfma_f32_32x32x16_bf16(s ? pa1 : pa0, v0, o0, 0, 0, 0);
        o1 = __builtin_amdgcn_mfma_f32_32x32x16_bf16(s ? pa1 : pa0, v1, o1, 0, 0, 0);
    }
}
__device__ __forceinline__ void bcast_rows(float v, ALAS float* sc, int r32, int hi, float (&out)[16]) {
    if (hi == 0) sc[r32] = v;
    wave_lds_sync();
#pragma unroll
    for (int g = 0; g < 4; ++g) { const f32x4 t = *(const ALAS f32x4*)(sc + 8 * g + 4 * hi); out[4 * g] = t[0]; out[4 * g + 1] = t[1]; out[4 * g + 2] = t[2]; out[4 * g + 3] = t[3]; }
    wave_lds_sync();
}
__device__ __forceinline__ void store_o(const f32x16& o0, const f32x16& o1, ALAS unsigned char* stg, bf16* dst  , size_t rstride_elems, int lane) {
    const int r32 = lane & 31, hi = lane >> 5;
    wave_lds_sync();
#pragma unroll
    for (int r = 0; r < 16; ++r) { const int q = crow(r, hi);
        *(ALAS unsigned short*)(stg + q * VPITCH + r32 * 2) = (unsigned short)(pkbf(o0[r], 0.f) & 0xffffu);
        *(ALAS unsigned short*)(stg + q * VPITCH + 64 + r32 * 2) = (unsigned short)(pkbf(o1[r], 0.f) & 0xffffu); }
    wave_lds_sync();
#pragma unroll
    for (int i = 0; i < 4; ++i) { const int row = 8 * i + (lane >> 3), ch = lane & 7; const u32x4 v = *(const ALAS u32x4*)(stg + row * VPITCH + ch * 16); *(u32x4*)(dst + (size_t)row * rstride_elems + ch * 8) = v; }
    wave_lds_sync();
}

__device__ __forceinline__ void sb_item(const bf16* QS, const bf16* KS, const bf16* VS, bf16* OC, int b, int h, int qt, ALAS unsigned char* wl, int lane) {
    const int r32 = lane & 31, hi = lane >> 5;
    const int t0 = qt * 32; const size_t rowb = (size_t)b * SEQ;
    const int kperm = (r32 & ~12) | ((r32 & 4) << 1) | ((r32 & 8) >> 1);
    bf16x8 qf[4];
    { const bf16* qp = QS + (rowb + t0 + r32) * 512 + h * 64 + hi * 8;
#pragma unroll
      for (int d0 = 0; d0 < 4; ++d0) qf[d0] = *(const bf16x8*)(qp + d0 * 16); }
    f32x16 o0 = {}, o1 = {}; float R = 0.f;
    for (int key0 = t0; key0 >= 0; key0 -= 32) {
        const bf16* kp = KS + (rowb + key0 + kperm) * 512 + h * 64 + hi * 8;
        bf16x8 kf[4];
#pragma unroll
        for (int d0 = 0; d0 < 4; ++d0) kf[d0] = *(const bf16x8*)(kp + d0 * 16);
        u32x4 vv[4];
#pragma unroll
        for (int i = 0; i < 4; ++i) vv[i] = *(const u32x4*)(VS + (rowb + key0 + 8 * i + (lane >> 3)) * 512 + h * 64 + (lane & 7) * 8);
        f32x16 p = {};
#pragma unroll
        for (int d0 = 0; d0 < 4; ++d0) p = __builtin_amdgcn_mfma_f32_32x32x16_bf16(kf[d0], qf[d0], p, 0, 0, 0);
#pragma unroll
        for (int i = 0; i < 4; ++i) *(ALAS u32x4*)(wl + (8 * i + (lane >> 3)) * VPITCH + (lane & 7) * 16) = vv[i];
        const bool diag = (key0 == t0);
        float z2[16], L2[16];
#pragma unroll
        for (int r = 0; r < 16; ++r) { const int kk = (r & 7) + 8 * hi + 16 * (r >> 3); const float zz = p[r];
            const float sp = fmaxf(zz, 0.f) + __builtin_amdgcn_logf(1.0f + __builtin_amdgcn_exp2f(-fabsf(zz)));
            const bool valid = !diag || (kk < r32); z2[r] = zz; L2[r] = valid ? sp : 0.f; }
        float c[16];
        c[15] = L2[15];
#pragma unroll
        for (int r = 14; r >= 8; --r) c[r] = c[r + 1] + L2[r];
        c[7] = L2[7];
#pragma unroll
        for (int r = 6; r >= 0; --r) c[r] = c[r + 1] + L2[r];
        const float TB = c[8], TA = c[0];
        const float TBo = __shfl_xor(TB, 32), TAo = __shfl_xor(TA, 32);
        const float offB = R + (hi ? 0.f : TBo);
        const float offA = R + TB + TBo + (hi ? 0.f : TAo);
        float a[16];
#pragma unroll
        for (int r = 0; r < 16; ++r) { const int kk = (r & 7) + 8 * hi + 16 * (r >> 3); const bool valid = !diag || (kk < r32);
            const float e = __builtin_amdgcn_exp2f(z2[r] - (c[r] + (r < 8 ? offA : offB))); a[r] = valid ? e : 0.f; }
        R += (TA + TB) + (TAo + TBo);
        wave_lds_sync();
        pv_tile(o0, o1, a, wl, lane);
        wave_lds_sync();
        if (__all(R > 40.0f * LOG2E)) break;
    }
    store_o(o0, o1, wl, OC + (rowb + t0) * 768 + h * 64, 768, lane);
}

constexpr int DLU_WAVE = 5120;
constexpr int DLU_O = 8 * DLU_WAVE, DLU_M = DLU_O + 512 * 128, DLU_L = DLU_M + 2048, DLU_BYTES = DLU_L + 2048;
__device__ __forceinline__ void dl_unit(const bf16* QD, const bf16* KD, const bf16* VD, bf16* OC, int b, int j, int blk, ALAS unsigned char* lds, int wave, int lane) {
    const int r32 = lane & 31, hi = lane >> 5;
    const size_t rowb = (size_t)b * SEQ;
    const int t0 = 512 * blk;
    const int kperm = (r32 & ~12) | ((r32 & 4) << 1) | ((r32 & 8) >> 1);
    ALAS unsigned char* wl = lds + wave * DLU_WAVE;
    ALAS float* sc = (ALAS float*)(wl + 4608);
    ALAS unsigned short* OL = (ALAS unsigned short*)(lds + DLU_O);
    ALAS float* ML = (ALAS float*)(lds + DLU_M); ALAS float* LL = (ALAS float*)(lds + DLU_L);
    for (int g = 2; g >= 0; --g) {
        const int hh = 4 * g + j, sh = 2 * g, r = 1 << sh;
        const float slope2 = __builtin_amdgcn_exp2f(-8.0f * (float)(hh + 1) / 12.0f) * LOG2E;
        const float sr = slope2 * (float)r;
        for (int it = wave; it < 16; it += 8) {
            const int q0 = g == 2 ? it : g == 1 ? (it & 3) + 128 * (it >> 2) : 32 * it;
            const int tq = t0 + q0 + r * r32, tmax = t0 + q0 + 31 * r;
            bf16x8 qf[4];
            { const bf16* qp = QD + (rowb + tq) * 768 + hh * 64 + hi * 8;
#pragma unroll
              for (int d0 = 0; d0 < 4; ++d0) qf[d0] = *(const bf16x8*)(qp + d0 * 16); }
            const int klo = 31 - r32; int khi = klo + 128; { const int kmaxtok = tmax >> sh; khi = khi < kmaxtok ? khi : kmaxtok; }
            const unsigned krange = (unsigned)(khi - klo);
            f32x16 o0 = {}, o1 = {}; float mrun = -3.0e38f, lrun = 0.f;
            if (g != 2) {
                mrun = ML[q0 + r * r32]; lrun = hi ? 0.f : LL[q0 + r * r32];
#pragma unroll
                for (int q = 0; q < 16; ++q) { const int tl = q0 + r * crow(q, hi);
                    o0[q] = __uint_as_float((unsigned)OL[tl * 64 + r32] << 16); o1[q] = __uint_as_float((unsigned)OL[tl * 64 + 32 + r32] << 16); }
            }
            for (int kt = 0; kt < 5; ++kt) {
                int sk = tmax - r * (32 * kt + kperm); sk = sk < 0 ? 0 : sk;
                const bf16* kp = KD + (rowb + sk) * 768 + hh * 64 + hi * 8;
                bf16x8 kf[4];
#pragma unroll
                for (int d0 = 0; d0 < 4; ++d0) kf[d0] = *(const bf16x8*)(kp + d0 * 16);
                u32x4 vv[4];
#pragma unroll
                for (int i = 0; i < 4; ++i) { int sv = tmax - r * (32 * kt + 8 * i + (lane >> 3)); sv = sv < 0 ? 0 : sv; vv[i] = *(const u32x4*)(VD + (rowb + sv) * 768 + hh * 64 + (lane & 7) * 8); }
                const int dk = 32 * kt + 8 * hi - klo;
                const float tb = -sr * (float)dk;
                f32x16 p;
#pragma unroll
                for (int q = 0; q < 16; ++q) p[q] = tb - sr * (float)((q & 7) + 16 * (q >> 3));
#pragma unroll
                for (int d0 = 0; d0 < 4; ++d0) p = __builtin_amdgcn_mfma_f32_32x32x16_bf16(kf[d0], qf[d0], p, 0, 0, 0);
#pragma unroll
                for (int i = 0; i < 4; ++i) *(ALAS u32x4*)(wl + (8 * i + (lane >> 3)) * VPITCH + (lane & 7) * 16) = vv[i];
                float z2[16]; float mt = -3.0e38f;
#pragma unroll
                for (int q = 0; q < 16; ++q) { const bool valid = (unsigned)(dk + ((q & 7) + 16 * (q >> 3))) <= krange; z2[q] = valid ? p[q] : -INFINITY; mt = fmaxf(mt, z2[q]); }
                mt = fmaxf(mt, __shfl_xor(mt, 32));
                if (__any(mt > mrun + 8.0f)) {
                    const float mnew = fmaxf(mrun, mt); const float alpha = __builtin_amdgcn_exp2f(mrun - mnew);
                    lrun *= alpha; float al[16]; bcast_rows(alpha, sc, r32, hi, al);
#pragma unroll
                    for (int q = 0; q < 16; ++q) { o0[q] *= al[q]; o1[q] *= al[q]; }
                    mrun = mnew;
                }
                float a[16]; float ls = 0.f;
#pragma unroll
                for (int q = 0; q < 16; ++q) { a[q] = __builtin_amdgcn_exp2f(z2[q] - mrun); ls += a[q]; }
                lrun += ls;
                wave_lds_sync();
                pv_tile(o0, o1, a, wl, lane);
                wave_lds_sync();
            }
            const float ltot = lrun + __shfl_xor(lrun, 32);
            if (g != 0) {
                if (hi == 0) { ML[q0 + r * r32] = mrun; LL[q0 + r * r32] = ltot; }
#pragma unroll
                for (int q = 0; q < 16; ++q) { const int tl = q0 + r * crow(q, hi);
                    OL[tl * 64 + r32] = (unsigned short)(pkbf(o0[q], 0.f) & 0xffffu); OL[tl * 64 + 32 + r32] = (unsigned short)(pkbf(o1[q], 0.f) & 0xffffu); }
            } else {
                float il[16]; bcast_rows(1.0f / ltot, sc, r32, hi, il);
#pragma unroll
                for (int q = 0; q < 16; ++q) { o0[q] *= il[q]; o1[q] *= il[q]; }
                store_o(o0, o1, wl, OC + (rowb + t0 + q0) * 768 + 512 + j * 64, 768, lane);
            }
        }
        asm volatile("s_waitcnt lgkmcnt(0)" ::: "memory"); __builtin_amdgcn_s_barrier(); asm volatile("" ::: "memory");
    }
}
#undef ALAS
}

constexpr int NWAVES = 8;
#ifndef MK_N_LAUNCHES
#define MK_N_LAUNCHES 1
#endif
#ifndef MK_LAST_PHASE
#define MK_LAST_PHASE 8
#endif
constexpr int N_LAUNCHES = MK_N_LAUNCHES;
constexpr int PER_PHASE = 8;

constexpr int BATCH = 16, SEQ = 4096, D = 1024, T = BATCH * SEQ;
constexpr int N1 = 5888;
constexpr int NEXP = 16384;
constexpr size_t MiB = 1u << 20;
constexpr size_t WS_CTL = 0, CTL_ZERO_BYTES = 1 * MiB;
constexpr size_t WS_WIN = 2 * MiB;
constexpr size_t WS_WCAT = 16 * MiB;
constexpr size_t WS_WOUT = 18 * MiB;
constexpr size_t WS_WC = 20 * MiB;
constexpr size_t WS_RINV1 = 24 * MiB;
constexpr size_t WS_RINV2 = 25 * MiB;
constexpr size_t WS_USC = 25 * MiB + 512 * 1024, WS_VSC = 25 * MiB + 768 * 1024;
constexpr size_t WS_SSQ = 26 * MiB;
constexpr size_t WS_U8 = 32 * MiB;
constexpr size_t WS_V8 = 64 * MiB;
constexpr size_t WS_IDS = 96 * MiB;
constexpr size_t WS_GW = 112 * MiB;
constexpr size_t WS_XB = 144 * MiB;
constexpr size_t WS_OC = 880 * MiB;
constexpr size_t WS_QS = 272 * MiB, WS_KS = 336 * MiB, WS_VS = 400 * MiB;
constexpr size_t WS_QD = 464 * MiB, WS_KD = 560 * MiB, WS_VD = 656 * MiB;
constexpr size_t WS_GT = 752 * MiB;
constexpr size_t WS_COEF = 272 * MiB;
constexpr size_t WS_MIX = 272 * MiB;
constexpr size_t WS_X1B = 400 * MiB;
constexpr size_t WS_HQ = 528 * MiB;
constexpr size_t WS_HS2 = 24 * MiB + 512 * 1024;
constexpr size_t WS_XB8 = 72 * MiB;
constexpr size_t WS_WG8 = 40 * MiB;
constexpr size_t WS_WCS = 46 * MiB;
constexpr size_t WS_WCF = 48 * MiB;
constexpr size_t WS_XS = 24 * MiB + 256 * 1024;
constexpr size_t WS_GCS = 47 * MiB;
constexpr size_t WS_END = 1008 * MiB;
constexpr int CW_BAR = 4096;
constexpr int CW_WMAX = 24576;
constexpr int CW_GMAX = 16384;
constexpr int CW_XRANK = 8192;

constexpr int RING_OFF = 0, RING_BYTES = 131072;
constexpr int LDSCTL_OFF = 143360, MISC_OFF = LDSCTL_OFF + 320;
constexpr int LDS_BYTES = 147456;
static_assert(MISC_OFF + 128 <= LDS_BYTES, "LDS map");
#define GAS __attribute__((address_space(1)))
#define LAS __attribute__((address_space(3)))
typedef unsigned short bf16;
typedef unsigned v4u __attribute__((ext_vector_type(4)));
typedef float f32x4 __attribute__((ext_vector_type(4)));
typedef short bf16x8 __attribute__((ext_vector_type(8)));
typedef GAS unsigned gu32;
typedef GAS unsigned long long gu64;
#define RLX_AGENT __ATOMIC_RELAXED, __HIP_MEMORY_SCOPE_AGENT
#define LDS_WAIT() asm volatile("s_waitcnt lgkmcnt(0)" ::: "memory")
#define VM_WAIT() asm volatile("s_waitcnt vmcnt(0)" ::: "memory")
__device__ __forceinline__ unsigned long long rt() { return __builtin_amdgcn_s_memrealtime(); }
__device__ __forceinline__ unsigned f2bf(float f) { unsigned u = __builtin_bit_cast(unsigned, f); return (u + 0x7fffu + ((u >> 16) & 1u)) >> 16; }
__device__ __forceinline__ unsigned pk2(float lo, float hi) { return f2bf(lo) | (f2bf(hi) << 16); }

#define XB_TMO      128
#define XB_XCNT(j)  (256  + 64 * (j))
#define XB_XSUB(j)  (1280 + 64 * (j))
#define XB_XGEN(j)  (2304 + 64 * (j))
#define XB_TOP      3328
#define XB_TOPGEN   3392
#define XCD_BAR_WORDS 3456
#define XB_SPIN_CAP (1u << 18)

__device__ __forceinline__ unsigned xb_ld(unsigned* p)              { return __hip_atomic_load(p, __ATOMIC_RELAXED, __HIP_MEMORY_SCOPE_AGENT); }
__device__ __forceinline__ unsigned xb_add(unsigned* p, unsigned v) { return __hip_atomic_fetch_add(p, v, __ATOMIC_RELAXED, __HIP_MEMORY_SCOPE_AGENT); }
__device__ __forceinline__ unsigned xb_xcc_id() { return (unsigned)__builtin_amdgcn_s_getreg((3 << 11) | 20) & 0xFu; }
#define XB_SPIN(cond, bar) do { unsigned _sp = 0; while (cond) { __builtin_amdgcn_s_sleep(1); \
    if ((++_sp & 255u) == 0u) { if (xb_ld(&(bar)[XB_TMO])) break; if (_sp > XB_SPIN_CAP) { atomicAdd(&(bar)[XB_TMO], 1u); break; } } } } while (0)

struct XcdBarrier {
    unsigned* bar; unsigned x;
    volatile LAS unsigned* st;
};

__device__ __forceinline__ XcdBarrier xcd_barrier_post(unsigned* bar, volatile LAS unsigned* st) {
    XcdBarrier b; b.bar = bar; b.x = xb_xcc_id(); b.st = st;
    if (threadIdx.x == 0) (void)xb_add(&bar[XB_XCNT(b.x)], 1u);
    return b;
}
__device__ __forceinline__ void xcd_barrier_complete(unsigned* bar, unsigned x, unsigned& nloc, unsigned& nx) {
    const unsigned G = gridDim.x * gridDim.y * gridDim.z;
    unsigned sum, cnt, mine, sp = 0u;
    for (;;) {
        sum = 0u; cnt = 0u; mine = 0u;
#pragma unroll
        for (unsigned j = 0; j < 16; ++j) { const unsigned c = xb_ld(&bar[XB_XCNT(j)]); sum += c; cnt += (c > 0u) ? 1u : 0u; mine = (j == x) ? c : mine; }
        if (sum == G) break;
        __builtin_amdgcn_s_sleep(1);
        if ((++sp & 255u) == 0u) { if (xb_ld(&bar[XB_TMO])) break; if (sp > XB_SPIN_CAP) { atomicAdd(&bar[XB_TMO], 1u); break; } }
    }
    nloc = mine > 0u ? mine : 1u; nx = cnt > 0u ? cnt : 1u;
}

__device__ __forceinline__ void xcd_barrier(const XcdBarrier& b) {
    asm volatile("s_waitcnt vmcnt(0)" ::: "memory");
    __syncthreads();
    if (threadIdx.x == 0) {
        unsigned* bar = b.bar;
        __builtin_amdgcn_s_waitcnt(0);
        unsigned nloc = b.st[0], nx = b.st[1];
        if (nloc == 0u) { xcd_barrier_complete(bar, b.x, nloc, nx); b.st[0] = nloc; b.st[1] = nx; }
        const unsigned old = xb_add(&bar[XB_XSUB(b.x)], 1u);
        const unsigned gen = old / nloc;
        if (old + 1u == (gen + 1u) * nloc) {
            __builtin_amdgcn_fence(__ATOMIC_RELEASE, "agent");
            asm volatile("s_waitcnt vmcnt(0)" ::: "memory");
            const unsigned og = xb_add(&bar[XB_TOP], 1u);
            const unsigned tg = og / nx;
            if (og + 1u == (tg + 1u) * nx) xb_add(&bar[XB_TOPGEN], 1u);
            else XB_SPIN(xb_ld(&bar[XB_TOPGEN]) == tg, bar);
            __builtin_amdgcn_fence(__ATOMIC_ACQUIRE, "agent");
            xb_add(&bar[XB_XGEN(b.x)], 1u);
            asm volatile("s_waitcnt vmcnt(0)" ::: "memory");
        } else {
            XB_SPIN(xb_ld(&bar[XB_XGEN(b.x)]) == gen, bar);
            __builtin_amdgcn_fence(__ATOMIC_ACQUIRE, "agent");
            asm volatile("s_waitcnt vmcnt(0)" ::: "memory");
        }
    }
    __syncthreads();
}

typedef float f32x2 __attribute__((ext_vector_type(2)));
typedef unsigned v2u __attribute__((ext_vector_type(2)));
typedef _Float16 h2_t __attribute__((ext_vector_type(2)));
struct Frame {
    LAS unsigned char* lds;
    volatile LAS unsigned* MISC;
    gu32* ctl;
    int tid, lane, wave;
    int vcu, G;
};
__device__ __forceinline__ float wave_sum(float v) {
#pragma unroll
    for (int o = 1; o < 64; o <<= 1) v += __shfl_xor(v, o);
    return v;
}
__device__ __forceinline__ float wave_max(float v) {
#pragma unroll
    for (int o = 1; o < 64; o <<= 1) v = fmaxf(v, __shfl_xor(v, o));
    return v;
}
constexpr int NB16 = 0, N8 = 5888 - NB16;
__device__ __forceinline__ int win_row(int n) { if (n < 1536 || n >= 3072) return n; const int t = (n - 1536) >> 8, ln = (n - 1536) & 255, hl = ln >> 6, d = ln & 63; return 1536 + t * 256 + 32 * hl + (d & 31) + 128 * (d >> 5); }
__device__ __forceinline__ void p0_transpose_item(const float* W, int N, const float* gain, bf16* WT, int ldt, int koff, int mode, LAS float* scr, int item, int lane) {
    const int nblk = N / 32, kb = item / nblk, nb = item % nblk, k0 = 64 * kb, n0 = 32 * nb;
#pragma unroll 8
    for (int i = 0; i < 32; ++i) { const int kk = 2 * i + (lane >> 5); float v = W[(size_t)(k0 + kk) * N + n0 + (lane & 31)]; if (gain) v *= gain[k0 + kk]; scr[kk * 33 + (lane & 31)] = v; }
    LDS_WAIT(); asm volatile("" ::: "memory");
    const int c = lane & 7;
#pragma unroll
    for (int j = 0; j < 4; ++j) { const int n = (lane >> 3) + 8 * j; const LAS float* s = scr + (8 * c) * 33 + n;
        v4u o; o.x = pk2(s[0 * 33], s[1 * 33]); o.y = pk2(s[2 * 33], s[3 * 33]); o.z = pk2(s[4 * 33], s[5 * 33]); o.w = pk2(s[6 * 33], s[7 * 33]);
        const int rown = mode ? win_row(n0 + n) : (n0 + n);
        *(GAS v4u*)(WT + (size_t)rown * ldt + koff + k0 + 8 * c) = o; }
    LDS_WAIT(); asm volatile("" ::: "memory");
}
__device__ __forceinline__ void p0_gate_max_item(const float* W, int N, const float* gain, unsigned* gmax, int kb, int n0, int lane) {
    const int k0 = 64 * kb; float am = 0.f;
#pragma unroll 8
    for (int i = 0; i < 32; ++i) { const int kk = 2 * i + (lane >> 5); am = fmaxf(am, fabsf(W[(size_t)(k0 + kk) * N + n0 + (lane & 31)] * gain[k0 + kk])); }
    am = fmaxf(am, __shfl_xor(am, 32));
    if (lane < 32) atomicMax(gmax + (n0 - NB16) + lane, __float_as_uint(am));
}
__device__ __forceinline__ void p0_gate_fp8_item(const float* W, int N, const float* gain, const unsigned* gmax, unsigned char* WG, float* cs, LAS float* scr, int item, int lane) {
    const int kb = item / (N8 / 32), nb = item % (N8 / 32), k0 = 64 * kb, n0 = 32 * nb;
#pragma unroll 8
    for (int i = 0; i < 32; ++i) { const int kk = 2 * i + (lane >> 5); scr[kk * 33 + (lane & 31)] = W[(size_t)(k0 + kk) * N + NB16 + n0 + (lane & 31)] * gain[k0 + kk]; }
    LDS_WAIT(); asm volatile("" ::: "memory");
    const int c = lane & 7;
#pragma unroll
    for (int j = 0; j < 4; ++j) { const int n = (lane >> 3) + 8 * j; const LAS float* sp = scr + (8 * c) * 33 + n;
        const float am = __uint_as_float(xb_ld((unsigned*)gmax + n0 + n)); const float sc = am > 0.f ? 127.0f / am : 0.f;
        unsigned p0 = 0, p1 = 0;
#pragma unroll
        for (int e = 0; e < 4; ++e) { p0 |= ((unsigned)(int)__builtin_rintf(sp[e * 33] * sc) & 0xffu) << (8 * e); p1 |= ((unsigned)(int)__builtin_rintf(sp[(4 + e) * 33] * sc) & 0xffu) << (8 * e); }
        const int prow = win_row(NB16 + n0 + n) - NB16;
        *(GAS v2u*)(WG + (size_t)prow * 1024 + k0 + 8 * c) = (v2u){p0, p1};
        if (kb == 0 && c == 0) cs[prow] = am * (1.0f / 127.0f); }
    LDS_WAIT(); asm volatile("" ::: "memory");
}
__device__ __forceinline__ void quant_row_fp8(const float* src, const float* gain, unsigned char* dst, size_t slice_stride, float* scale_out, int lane) {
    f32x4 v[4]; float am = 0.f;
#pragma unroll
    for (int j = 0; j < 4; ++j) { v[j] = *(const GAS f32x4*)(src + 256 * j + 4 * lane); if (gain) v[j] = v[j] * *(const GAS f32x4*)(gain + 256 * j + 4 * lane);
        am = fmaxf(am, fmaxf(fmaxf(fabsf(v[j][0]), fabsf(v[j][1])), fmaxf(fabsf(v[j][2]), fabsf(v[j][3])))); }
    am = wave_max(am);
    const int ex = (int)((__float_as_uint(am) >> 23) & 0xffu);
    const float s = (ex == 0) ? 1.0f : __uint_as_float((unsigned)(127 + 7 - (ex - 127)) << 23);
    const float is = (ex == 0) ? 1.0f : __uint_as_float((unsigned)(127 - 7 + (ex - 127)) << 23);
    if (lane == 0) *scale_out = is;
#pragma unroll
    for (int j = 0; j < 4; ++j) { int pk = __builtin_amdgcn_cvt_pk_fp8_f32(v[j][0] * s, v[j][1] * s, 0, false); pk = __builtin_amdgcn_cvt_pk_fp8_f32(v[j][2] * s, v[j][3] * s, pk, true);
        const int col = 256 * j + 4 * lane; *(GAS int*)(dst + (size_t)(col >> 7) * slice_stride + (col & 127)) = pk; }
}
__device__ __forceinline__ void quant_row_fp4(const float* src, unsigned char* dst, size_t slice_stride, float* scale_out, int lane) {
    f32x4 v[4]; float am = 0.f;
#pragma unroll
    for (int j = 0; j < 4; ++j) { v[j] = *(const GAS f32x4*)(src + 256 * j + 4 * lane); am = fmaxf(am, fmaxf(fmaxf(fabsf(v[j][0]), fabsf(v[j][1])), fmaxf(fabsf(v[j][2]), fabsf(v[j][3])))); }
    am = wave_max(am);
    const float s = am > 0.f ? 6.0f / am : 0.f;
    if (lane == 0) *scale_out = am * (1.0f / 6.0f);
#pragma unroll
    for (int j = 0; j < 4; ++j) { unsigned pk = __builtin_amdgcn_cvt_scalef32_pk_fp4_f32(0u, v[j][0] * s, v[j][1] * s, 1.0f, 0); pk = __builtin_amdgcn_cvt_scalef32_pk_fp4_f32(pk, v[j][2] * s, v[j][3] * s, 1.0f, 1);
        *(GAS unsigned short*)(dst + (size_t)j * slice_stride + 2 * lane) = (unsigned short)(pk & 0xffffu); }
}
__device__ __forceinline__ void quant_row_i4(const float* src, const float* gain, unsigned char* dst, float* scale_out, int lane) {
    f32x4 v[4]; float am = 0.f, ss = 0.f;
    const int p16 = (lane >> 2) & 15, wl = lane & 3;
#pragma unroll
    for (int ld = 0; ld < 2; ++ld)
#pragma unroll
        for (int sn = 0; sn < 2; ++sn) { const int hd = 2 * (4 * ld + wl) + sn; const int idx = 256 * (hd >> 2) + 16 * p16 + 4 * (hd & 3);
            f32x4 t = *(const GAS f32x4*)(src + idx); if (gain) t = t * *(const GAS f32x4*)(gain + idx); v[2 * ld + sn] = t;
            am = fmaxf(am, fmaxf(fmaxf(fabsf(t[0]), fabsf(t[1])), fmaxf(fabsf(t[2]), fabsf(t[3])))); ss += (t[0] * t[0] + t[1] * t[1]) + (t[2] * t[2] + t[3] * t[3]); }
    am = wave_max(am); ss = wave_sum(ss);
    const float clipv = fminf(am, 2.5f * sqrtf(ss * (1.0f / 1024.0f)));
    const float s = clipv > 0.f ? 7.0f / clipv : 0.f;
    if (lane == 0) *scale_out = clipv * (1.0f / (7.0f * 16.0f));
#pragma unroll
    for (int ld = 0; ld < 2; ++ld) { unsigned pk = 0u;
#pragma unroll
        for (int b4 = 0; b4 < 4; ++b4) { int q0 = (int)__builtin_rintf(v[2 * ld][b4] * s), q1 = (int)__builtin_rintf(v[2 * ld + 1][b4] * s);
            q0 = q0 < -7 ? -7 : (q0 > 7 ? 7 : q0); q1 = q1 < -7 ? -7 : (q1 > 7 ? 7 : q1);
            pk |= ((unsigned)(q0 & 15) | ((unsigned)(q1 & 15) << 4)) << (8 * b4); }
        *(GAS unsigned*)(dst + ld * 256 + 16 * p16 + 4 * wl) = pk; }
}
__device__ __forceinline__ float gelu_f(float v) {
    const float av = fabsf(v), t = __builtin_amdgcn_rcpf(av * 0.2316418882f + 1.0f);
    float q = t * 0.5307027145f + (-0.7265760135f); q = q * t + 0.7107068705f; q = q * t + (-0.142248368f); q = q * t + 0.127414796f; q = q * t;
    const float e = __builtin_amdgcn_exp2f((v * v) * (-0.72134752044f));
    const float m = v * (q * e);
    return v < 0.f ? m : v - m;
}

struct Args { const float* in[14]; float* out; unsigned char* ws; int ph_lo, ph_hi, li, pad; };
__global__ void __launch_bounds__(NWAVES * 64, 2) fwd_kernel(Args args) {
    extern __shared__ __attribute__((aligned(16))) unsigned char lds[];
    Frame F;
    F.lds = (LAS unsigned char*)lds;
    F.MISC = (volatile LAS unsigned*)(F.lds + MISC_OFF);
    F.tid = threadIdx.x; F.lane = F.tid & 63; F.wave = __builtin_amdgcn_readfirstlane(F.tid >> 6);
    F.G = gridDim.x; { const int bx = blockIdx.x; F.vcu = (F.G % 8 == 0) ? (bx % 8) * (F.G / 8) + bx / 8 : bx; }
    unsigned char* ws = args.ws;
    F.ctl = (gu32*)(ws + WS_CTL);
    const float* x = args.in[0]; const float* norm1_gain = args.in[1]; const float* w_in = args.in[2]; const float* b_gate = args.in[3];
    const float* q_gain = args.in[4]; const float* k_gain = args.in[5]; const float* w_sb_out = args.in[6]; const float* w_dil_out = args.in[7];
    const float* w_out = args.in[8]; const float* norm2_gain = args.in[9]; const float* w_peer_q = args.in[10]; const float* sub_keys = args.in[11];
    const float* peer_u = args.in[12]; const float* peer_v = args.in[13];
    float* out = args.out;
    bf16* WIN = (bf16*)(ws + WS_WIN); bf16* WCAT = (bf16*)(ws + WS_WCAT); bf16* WOUT = (bf16*)(ws + WS_WOUT); bf16* WC = (bf16*)(ws + WS_WC);
    float* RINV1 = (float*)(ws + WS_RINV1); float* RINV2 = (float*)(ws + WS_RINV2); float* USC = (float*)(ws + WS_USC); float* VSC = (float*)(ws + WS_VSC); float* SSQ = (float*)(ws + WS_SSQ);
    unsigned char* U8 = ws + WS_U8; unsigned char* V8 = ws + WS_V8;
    unsigned short* IDS = (unsigned short*)(ws + WS_IDS); float* GW = (float*)(ws + WS_GW); float* COEF = (float*)(ws + WS_COEF); unsigned char* HQ = ws + WS_HQ; unsigned char* WC8 = ws + WS_WC; float* WCF = (float*)(ws + WS_WCF); float* WCS = (float*)(ws + WS_WCS); float* HS2 = (float*)(ws + WS_HS2);
    bf16* XB = (bf16*)(ws + WS_XB); bf16* OC = (bf16*)(ws + WS_OC); unsigned char* XB8 = ws + WS_XB8; unsigned char* WG8 = ws + WS_WG8; float* GCS = (float*)(ws + WS_GCS); float* XS = (float*)(ws + WS_XS);
    bf16* QS = (bf16*)(ws + WS_QS); bf16* KS = (bf16*)(ws + WS_KS); bf16* VS = (bf16*)(ws + WS_VS);
    bf16* QD = (bf16*)(ws + WS_QD); bf16* KD = (bf16*)(ws + WS_KD); bf16* VD = (bf16*)(ws + WS_VD);
    unsigned char* GT = ws + WS_GT; bf16* MIX = (bf16*)(ws + WS_MIX); bf16* X1B = (bf16*)(ws + WS_X1B);

    for (int u = F.tid; u < (LDS_BYTES - LDSCTL_OFF) / 4; u += NWAVES * 64) ((LAS unsigned*)(F.lds + LDSCTL_OFF))[u] = 0u;
    __syncthreads();
    const int my_xcc = (int)xb_xcc_id();
    if (F.tid == 0) F.MISC[12] = xb_add((unsigned*)(F.ctl + CW_XRANK) + 64 * my_xcc, 1u);
    __syncthreads();
    const int my_xrank = (int)F.MISC[12];
    const int bli = (N_LAUNCHES == PER_PHASE) ? 0 : args.li;
    XcdBarrier bar; bar.bar = (unsigned*)(F.ctl + CW_BAR) + bli * XCD_BAR_WORDS; bar.x = 0; bar.st = nullptr;
    if (N_LAUNCHES != PER_PHASE) bar = xcd_barrier_post((unsigned*)(F.ctl + CW_BAR) + bli * XCD_BAR_WORDS, F.MISC + 8);
    const int lo = args.ph_lo, hi = args.ph_hi;
#ifndef PHASE_MASK
#define PHASE_MASK 0xff
#endif
#define IN(k) (((PHASE_MASK >> (k)) & 1) && lo <= (k) && (k) < hi)
#define BOTH(k) (IN(k) && IN((k) + 1))
#define GRID_BAR() do { if (N_LAUNCHES != PER_PHASE) xcd_barrier(bar); } while (0)
#ifndef PROBE_REPEAT
#define PROBE_REPEAT 0x00
#endif
#ifndef PROBE_L1
#define PROBE_L1 0x0
#endif
#define REP(k) _Pragma("unroll") for (int rep_ = 0; rep_ < (((PROBE_REPEAT >> (k)) & 1) ? 2 : 1); ++rep_)
    const int gw = F.vcu * NWAVES + F.wave, NGW = F.G * NWAVES;
#define P67_MAP() int vx = (int)(blockIdx.x & 7), rk = (int)(blockIdx.x >> 3), nrk = (F.G + 7 - vx) / 8; bool p67_uni = false; \
        { bool uni_ = (F.G % 8 == 0); for (int j_ = 0; j_ < 16; ++j_) { const unsigned c_ = xb_ld((unsigned*)(F.ctl + CW_XRANK) + 64 * j_); uni_ = uni_ && (c_ == (j_ < 8 ? (unsigned)(F.G / 8) : 0u)); } \
          if (uni_) { vx = my_xcc; rk = my_xrank; nrk = F.G / 8; p67_uni = true; } }

    if (IN(0)) REP(0) {
        for (int it = F.vcu; it < 256; it += F.G) {
            const int hp = it >> 4, d0 = (it & 15) * 64;
            LAS float* As = (LAS float*)(F.lds);
            LAS float* Bs = (LAS float*)(F.lds + 64 * 132 * 4);
            for (int e = F.tid; e < 64 * 32; e += 512) { const int r = e >> 5, c4 = (e & 31) * 4; *(LAS f32x4*)(As + r * 132 + c4) = *(const GAS f32x4*)(w_peer_q + (size_t)(d0 + r) * 2048 + hp * 128 + c4); }
            for (int e = F.tid; e < 128 * 32; e += 512) { const int r = e >> 5, c4 = (e & 31) * 4; *(LAS f32x4*)(Bs + r * 132 + c4) = *(const GAS f32x4*)(sub_keys + ((size_t)hp * 128 + r) * 128 + c4); }
            __syncthreads();
            const int ddg = F.tid & 15, ng = F.tid >> 4;
            f32x4 acc[4];
#pragma unroll
            for (int j = 0; j < 4; ++j) acc[j] = (f32x4){0.f, 0.f, 0.f, 0.f};
            for (int c4 = 0; c4 < 128; c4 += 4) {
                f32x4 a[4], b[4];
#pragma unroll
                for (int i = 0; i < 4; ++i) { a[i] = *(const LAS f32x4*)(As + (4 * ddg + i) * 132 + c4); b[i] = *(const LAS f32x4*)(Bs + (4 * ng + i) * 132 + c4); }
#pragma unroll
                for (int j = 0; j < 4; ++j)
#pragma unroll
                    for (int i = 0; i < 4; ++i) acc[j][i] += (a[i][0] * b[j][0] + a[i][1] * b[j][1]) + (a[i][2] * b[j][2] + a[i][3] * b[j][3]);
            }
            const f32x4 g2 = *(const GAS f32x4*)(norm2_gain + d0 + 4 * ddg);
#pragma unroll
            for (int j = 0; j < 4; ++j) { const f32x4 o = acc[j] * g2;
                *(GAS f32x4*)(WCF + (size_t)(hp * 128 + 4 * ng + j) * 1024 + d0 + 4 * ddg) = o;
                float am = fmaxf(fmaxf(fabsf(o[0]), fabsf(o[1])), fmaxf(fabsf(o[2]), fabsf(o[3])));
                am = fmaxf(am, __shfl_xor(am, 1)); am = fmaxf(am, __shfl_xor(am, 2)); am = fmaxf(am, __shfl_xor(am, 4)); am = fmaxf(am, __shfl_xor(am, 8));
                if (ddg == 0) atomicMax((unsigned*)(F.ctl + CW_WMAX) + hp * 128 + 4 * ng + j, __float_as_uint(am)); }
            __syncthreads();
        }
        {
            LAS float* scr = (LAS float*)(F.lds + RING_OFF + F.wave * 16384);
            constexpr int I_IN = (D / 64) * (N1 / 32), I_SB = (512 / 64) * (D / 32), I_DL = (256 / 64) * (D / 32), I_OUT = (D / 64) * (D / 32);
            constexpr int NITEMS = I_IN + I_SB + I_DL + I_OUT;
            for (int it = gw; it < NITEMS; it += NGW) {
                int r = it;
                if (r < I_IN) { const int nb_ = r % (N1 / 32); p0_gate_max_item(w_in, N1, norm1_gain, (unsigned*)(F.ctl + CW_GMAX), r / (N1 / 32), 32 * nb_, F.lane); continue; } r -= I_IN;
                if (r < I_SB) { p0_transpose_item(w_sb_out, D, nullptr, WCAT, 768, 0, 0, scr, r, F.lane); continue; } r -= I_SB;
                if (r < I_DL) { p0_transpose_item(w_dil_out, D, nullptr, WCAT, 768, 512, 0, scr, r, F.lane); continue; } r -= I_DL;
                p0_transpose_item(w_out, D, nullptr, WOUT, 1024, 0, 0, scr, r, F.lane);
            }
        }
        for (int e = gw; e < 2 * NEXP; e += NGW) {
            if (e < NEXP) quant_row_i4(peer_u + (size_t)e * D, norm2_gain, U8 + (size_t)e * 512, USC + e, F.lane);
            else { const int ev = e - NEXP; quant_row_fp4(peer_v + (size_t)ev * D, V8 + (size_t)ev * 128, (size_t)NEXP * 128, VSC + ev, F.lane); }
        }
        for (int m = gw; m < T; m += NGW) {
            const GAS f32x4* xr = (const GAS f32x4*)(x + (size_t)m * D) + F.lane;
            f32x4 v[4]; float s = 0.f;
#pragma unroll
            for (int j = 0; j < 4; ++j) { v[j] = xr[64 * j]; s += (v[j][0] * v[j][0] + v[j][1] * v[j][1]) + (v[j][2] * v[j][2] + v[j][3] * v[j][3]); }
            s = wave_sum(s);
            const float rn = __builtin_amdgcn_rsqf(s * (1.0f / D) + 1e-6f);
            if (F.lane == 0) RINV1[m] = 1.0f / rn;
            GAS unsigned long long* o8 = (GAS unsigned long long*)(XB + (size_t)m * D) + F.lane;
#pragma unroll
            for (int j = 0; j < 4; ++j) o8[64 * j] = (unsigned long long)pk2(v[j][0] * rn, v[j][1] * rn) | ((unsigned long long)pk2(v[j][2] * rn, v[j][3] * rn) << 32);
            float am = 0.f;
#pragma unroll
            for (int j = 0; j < 4; ++j) am = fmaxf(am, fmaxf(fmaxf(fabsf(v[j][0]), fabsf(v[j][1])), fmaxf(fabsf(v[j][2]), fabsf(v[j][3]))));
            am = wave_max(am) * rn;
            const float qs = am > 0.f ? 127.0f / am * rn : 0.f;
            if (F.lane == 0) XS[m] = am * (1.0f / 127.0f);
#pragma unroll
            for (int j = 0; j < 4; ++j) { const unsigned pk = ((unsigned)(int)__builtin_rintf(v[j][0] * qs) & 0xffu) | (((unsigned)(int)__builtin_rintf(v[j][1] * qs) & 0xffu) << 8) | (((unsigned)(int)__builtin_rintf(v[j][2] * qs) & 0xffu) << 16) | (((unsigned)(int)__builtin_rintf(v[j][3] * qs) & 0xffu) << 24);
                *(GAS unsigned*)(XB8 + (size_t)m * D + 256 * j + 4 * F.lane) = pk; }
        }
        if (BOTH(0)) GRID_BAR();
    }

    if (IN(1)) REP(1) {
        { LAS float* scr = (LAS float*)(F.lds + RING_OFF + F.wave * 16384);
          for (int it = gw; it < 16 * (N8 / 32); it += NGW) p0_gate_fp8_item(w_in, N1, norm1_gain, (const unsigned*)(F.ctl + CW_GMAX), WG8, GCS, scr, it, F.lane);
          for (int r = gw; r < 2048; r += NGW) {
              const float am = __uint_as_float(xb_ld((unsigned*)(F.ctl + CW_WMAX) + r)); const float sc = am > 0.f ? 127.0f / am : 0.f;
              unsigned w[4];
#pragma unroll
              for (int j = 0; j < 4; ++j) { const f32x4 v = *(const GAS f32x4*)(WCF + (size_t)r * 1024 + 16 * F.lane + 4 * j);
                  w[j] = ((unsigned)(int)__builtin_rintf(v[0] * sc) & 0xffu) | (((unsigned)(int)__builtin_rintf(v[1] * sc) & 0xffu) << 8) | (((unsigned)(int)__builtin_rintf(v[2] * sc) & 0xffu) << 16) | (((unsigned)(int)__builtin_rintf(v[3] * sc) & 0xffu) << 24); }
              *(GAS v4u*)(WC8 + (size_t)r * 1024 + 16 * F.lane) = (v4u){w[0], w[1], w[2], w[3]};
              if (F.lane == 0) WCS[r] = am * (1.0f / 127.0f); }
          __syncthreads(); }
        GRID_BAR();
        { pg8::Gemm g{(const bf16*)XB8, (const bf16*)WG8, T, N8, D / 2}; pg8::StaticOrder S; S.init(T, N8, F.G, (int)blockIdx.x);
          pg8::EpiG E{b_gate, GCS, XS, q_gain, k_gain, QS, KS, VS, QD, KD, VD, GT};
          pg8::gemm_phase<pg8::EpiG, pg8::StaticOrder, true, true, false, true>(F.lds + RING_OFF, g, S, E); }
        if (BOTH(1)) GRID_BAR();
    }

    if (IN(2)) REP(2) {
        LAS unsigned char* wl = F.lds + RING_OFF + F.wave * 16384;
        static_assert(att::DLU_BYTES <= RING_BYTES, "dilated-attention LDS state");
        for (int un = F.vcu; un < 512; un += F.G) { const int blk = un & 7, j = (un >> 3) & 3, b = un >> 5; att::dl_unit(QD, KD, VD, OC, b, j, blk, F.lds + RING_OFF, F.wave, F.lane); }
        for (int it = gw; it < 16384; it += NGW) { const int qt = 127 - (it & 127), h = (it >> 7) & 7, b = it >> 10; att::sb_item(QS, KS, VS, OC, b, h, qt, wl, F.lane); }
        if (BOTH(2)) GRID_BAR();
    }

    if (IN(3)) REP(3) {
        pg8::Gemm g{OC, WCAT, T, D, 768}; pg8::StaticOrder S; S.init(T, D, F.G, (int)blockIdx.x);
        pg8::Epi2 E{GT, MIX};
        pg8::gemm_phase<pg8::Epi2, pg8::StaticOrder, true, true>(F.lds + RING_OFF, g, S, E);
        if (BOTH(3)) GRID_BAR();
    }

    if (IN(4)) REP(4) {
        pg8::Gemm g{MIX, WOUT, T, D, D}; pg8::StaticOrder S; S.init(T, D, F.G, (int)blockIdx.x);
        pg8::Epi3 E{XB, RINV1, X1B, SSQ};
        pg8::gemm_phase<pg8::Epi3, pg8::StaticOrder, true, true>(F.lds + RING_OFF, g, S, E);
        if (BOTH(4)) GRID_BAR();
    }

    if (IN(5)) REP(5) {
        for (int m = gw; m < T; m += NGW) {
            const v4u a = *(const GAS v4u*)(X1B + (size_t)m * D + 8 * F.lane), b = *(const GAS v4u*)(X1B + (size_t)m * D + 512 + 8 * F.lane);
            float v[16] = {pg8::bflo(a.x), pg8::bfhi(a.x), pg8::bflo(a.y), pg8::bfhi(a.y), pg8::bflo(a.z), pg8::bfhi(a.z), pg8::bflo(a.w), pg8::bfhi(a.w),
                           pg8::bflo(b.x), pg8::bfhi(b.x), pg8::bflo(b.y), pg8::bfhi(b.y), pg8::bflo(b.z), pg8::bfhi(b.z), pg8::bflo(b.w), pg8::bfhi(b.w)};
            float am = 0.f;
#pragma unroll
            for (int i = 0; i < 16; ++i) am = fmaxf(am, fabsf(v[i]));
            am = wave_max(am);
            float sq = (F.lane < 16) ? SSQ[(size_t)m * 16 + F.lane] : 0.f; sq = wave_sum(sq);
            const float s = am > 0.f ? 127.0f / am : 0.f;
            if (F.lane == 0) HS2[m] = am * (1.0f / 127.0f) * __builtin_amdgcn_rsqf(sq * (1.0f / 1024.0f) + 1e-6f);
            int q[16];
#pragma unroll
            for (int i = 0; i < 16; ++i) q[i] = (int)__builtin_rintf(v[i] * s) & 0xff;
            v2u o0, o1; o0.x = q[0] | (q[1] << 8) | (q[2] << 16) | (q[3] << 24); o0.y = q[4] | (q[5] << 8) | (q[6] << 16) | (q[7] << 24);
            o1.x = q[8] | (q[9] << 8) | (q[10] << 16) | (q[11] << 24); o1.y = q[12] | (q[13] << 8) | (q[14] << 16) | (q[15] << 24);
            *(GAS v2u*)(HQ + (size_t)m * D + 8 * F.lane) = o0; *(GAS v2u*)(HQ + (size_t)m * D + 512 + 8 * F.lane) = o1;
        }
        GRID_BAR();
        pg8::Gemm g{(const bf16*)HQ, (const bf16*)WC8, T, 2048, D / 2}; pg8::StaticOrder S; S.init(T, 2048, F.G, (int)blockIdx.x);
        pg8::Epi4 E{SSQ, RINV2, IDS, GW, HS2, WCS};
        pg8::OneUnit O1;
        for (int i = 0; S.next(i, O1.u); ++i) pg8::gemm_phase<pg8::Epi4, pg8::OneUnit, false, true, false, true>(F.lds + RING_OFF, g, O1, E);
        if (BOTH(5)) GRID_BAR();
    }

    if (IN(6)) REP(6) {
        P67_MAP();
        const int p16 = F.lane & 15, sg = F.lane >> 4;
        LAS unsigned char* HB = F.lds + RING_OFF + F.wave * 16384;
        LAS unsigned* LIST = (LAS unsigned*)(F.lds + RING_OFF + F.wave * 16384 + 8192);
        LAS float* HSs = (LAS float*)(F.lds + RING_OFF + F.wave * 16384 + 12288);
        const int nwb = T / 8, wstep = nrk * NWAVES;
        const int gsel = (F.lane & 15), bpsrc = (16 * (F.lane & 3) + ((F.lane >> 2) & 3)) * 4;
        v4u hpre[8], idpre[2]; float hspre = 0.f;
#define P6_PRE(bb) do { const int bc_ = (bb) < nwb ? (bb) : nwb - 1; const unsigned char* hsrc_ = HQ + (size_t)bc_ * 8192; \
            _Pragma("unroll") for (int i_ = 0; i_ < 8; ++i_) hpre[i_] = *(const GAS v4u*)(hsrc_ + (size_t)(i_ * 64 + F.lane) * 16); \
            const unsigned short* isrc_ = IDS + ((size_t)bc_ * 8 + (F.lane >> 3)) * 128 + 16 * (F.lane & 7); idpre[0] = *(const GAS v4u*)isrc_; idpre[1] = *(const GAS v4u*)(isrc_ + 8); \
            hspre = HS2[(size_t)bc_ * 8 + (F.lane & 7)]; } while (0)
#define P6_ISSUE(W, ENT, EJ, GB, UB, VB, base_) do { \
                _Pragma("unroll") for (int g_ = 0; g_ < 4; ++g_) { const int j_ = (base_) + 4 * g_ + sg; ENT[g_] = LIST[j_ < n ? j_ : nm1]; } \
                { const int j_ = (base_) + gsel; EJ = (j_ < n && F.lane < 16) ? (int)LIST[j_] : -1; } \
                _Pragma("unroll") for (int g_ = 0; g_ < 4; ++g_) { const unsigned char* up_ = U8 + (size_t)((PROBE_L1 && rep_) ? 0u : (ENT[g_] & 0xffffu)) * 512 + 16 * p16; \
                    _Pragma("unroll") for (int i_ = 0; i_ < 2; ++i_) W[g_][i_] = *(const GAS v4u*)(up_ + 256 * i_); } \
                { const unsigned ej_ = EJ < 0 ? 0u : (unsigned)EJ; GB = GW[((size_t)t0 + (ej_ >> 24)) * 128 + ((ej_ >> 16) & 127u)]; UB = USC[ej_ & 0xffffu]; VB = VSC[ej_ & 0xffffu]; } } while (0)
#define P6_DPPADD(a_, ctrl) a_ += __builtin_amdgcn_update_dpp(0, a_, ctrl, 0xf, 0xf, false)
#define P6_REDUCE(W, ENT, EJ, GB, UB, VB, base_) do { if ((base_) < n) { int ag_[4]; \
                _Pragma("unroll") for (int g_ = 0; g_ < 4; ++g_) { const LAS unsigned char* hp_ = HB + (size_t)(ENT[g_] >> 24) * 1024 + 16 * p16; int a_ = 0; v4u h_[4]; \
                    _Pragma("unroll") for (int i_ = 0; i_ < 4; ++i_) h_[i_] = *(const LAS v4u*)(hp_ + 256 * i_); \
                    _Pragma("unroll") for (int ld_ = 0; ld_ < 2; ++ld_) { const unsigned x_[4] = {W[g_][ld_].x, W[g_][ld_].y, W[g_][ld_].z, W[g_][ld_].w}; \
                        _Pragma("unroll") for (int wl_ = 0; wl_ < 4; ++wl_) { const int hd_ = 2 * (4 * ld_ + wl_); const unsigned lo_ = (x_[wl_] << 4) & 0xF0F0F0F0u, hi_ = x_[wl_] & 0xF0F0F0F0u; \
                            const unsigned hA_ = (hd_ & 3) == 0 ? h_[hd_ >> 2].x : h_[hd_ >> 2].z, hB_ = (hd_ & 3) == 0 ? h_[hd_ >> 2].y : h_[hd_ >> 2].w; \
                            a_ = __builtin_amdgcn_sdot4((int)lo_, (int)hA_, a_, false); a_ = __builtin_amdgcn_sdot4((int)hi_, (int)hB_, a_, false); } } \
                    P6_DPPADD(a_, 0xB1); P6_DPPADD(a_, 0x4E); P6_DPPADD(a_, 0x141); P6_DPPADD(a_, 0x140); ag_[g_] = a_; } \
                const int sel_ = gsel == 0 ? ag_[0] : gsel == 1 ? ag_[1] : gsel == 2 ? ag_[2] : ag_[3]; \
                const float resv_ = (float)__builtin_amdgcn_ds_bpermute(bpsrc, sel_); \
                if (EJ >= 0 && !(PROBE_L1 && rep_)) { const unsigned ej_ = (unsigned)EJ; const float act_ = gelu_f(resv_ * UB * HSs[ej_ >> 24]); \
                    COEF[((size_t)t0 + (ej_ >> 24)) * 128 + ((ej_ >> 16) & 127u)] = GB * act_ * VB; } } } while (0)
        int wb = rk * NWAVES + F.wave;
        P6_PRE(wb);
        for (; wb < nwb; wb += wstep) {
            const int t0 = wb * 8;
            asm volatile("s_waitcnt lgkmcnt(0)" ::: "memory");
            if (F.lane < 8) HSs[F.lane] = hspre;
#pragma unroll
            for (int i = 0; i < 8; ++i) *(LAS v4u*)(HB + (size_t)(i * 64 + F.lane) * 16) = hpre[i];
            int n = 0;
            { const unsigned idw[8] = {idpre[0].x, idpre[0].y, idpre[0].z, idpre[0].w, idpre[1].x, idpre[1].y, idpre[1].z, idpre[1].w};
              const unsigned tl = (unsigned)(F.lane >> 3), kb0 = 16u * (unsigned)(F.lane & 7);
#pragma unroll
              for (int i = 0; i < 16; ++i) { const unsigned e = (i & 1) ? (idw[i >> 1] >> 16) : (idw[i >> 1] & 0xffffu);
                  const bool inr = ((int)(e >> 11) == vx); const unsigned long long mk = __ballot(inr);
                  const int pos = n + (int)__builtin_amdgcn_mbcnt_hi((unsigned)(mk >> 32), __builtin_amdgcn_mbcnt_lo((unsigned)mk, 0u));
                  if (inr) LIST[pos] = (tl << 24) | ((kb0 + (unsigned)i) << 16) | e;
                  n += __builtin_popcountll(mk); } }
            asm volatile("s_waitcnt lgkmcnt(0)" ::: "memory");
            P6_PRE(wb + wstep);
            const int nm1 = n > 0 ? n - 1 : 0;
            for (int base = 0; base < n; base += 32) {
                v4u wA[4][2], wB[4][2]; unsigned entA[4], entB[4]; int ejA, ejB; float gbA, ubA, vbA, gbB, ubB, vbB;
                P6_ISSUE(wA, entA, ejA, gbA, ubA, vbA, base);
                P6_ISSUE(wB, entB, ejB, gbB, ubB, vbB, base + 16);
                P6_REDUCE(wA, entA, ejA, gbA, ubA, vbA, base);
                P6_REDUCE(wB, entB, ejB, gbB, ubB, vbB, base + 16);
            }
        }
#undef P6_PRE
#undef P6_ISSUE
#undef P6_REDUCE
#undef P6_DPPADD
        if (BOTH(6)) GRID_BAR();
    }

    if (IN(7)) REP(7) {
        P67_MAP();
        const int cs = vx >> 1;
        const int n0_ = p67_uni ? F.G / 8 : (F.G + 7 - 2 * cs) / 8, n1_ = p67_uni ? F.G / 8 : (F.G + 7 - (2 * cs + 1)) / 8;
        const int rk2 = (vx & 1) ? n0_ + rk : rk, nrk2 = n0_ + n1_;
        const int l8 = F.lane & 7, kg = F.lane >> 3;
        const unsigned char* vbase = V8 + (size_t)cs * NEXP * 128 + 16 * l8;
        const int tstep = nrk2 * NWAVES;
        const int col = 256 * cs + 32 * l8 + ((F.lane & 8) ? 16 : 0) + ((F.lane & 16) ? 8 : 0) + ((F.lane & 32) ? 4 : 0);
#define P7_CL(tt) ((tt) < T ? (tt) : T - 1)
#define P7_IDS(tt, ID) do { const int tc_ = P7_CL(tt); ID[0] = *(const GAS v4u*)(IDS + (size_t)tc_ * 128 + 16 * kg); ID[1] = *(const GAS v4u*)(IDS + (size_t)tc_ * 128 + 16 * kg + 8); } while (0)
#define P7_ISSUE(tt, ID, W, CF, OO) do { const int tc_ = P7_CL(tt); const unsigned idw_[8] = {ID[0].x, ID[0].y, ID[0].z, ID[0].w, ID[1].x, ID[1].y, ID[1].z, ID[1].w}; \
            _Pragma("unroll") for (int i_ = 0; i_ < 16; ++i_) { const unsigned e_ = (i_ & 1) ? (idw_[i_ >> 1] >> 16) : (idw_[i_ >> 1] & 0xffffu); W[i_] = *(const GAS v4u*)(vbase + (size_t)((PROBE_L1 && rep_) ? 0u : e_) * 128); } \
            _Pragma("unroll") for (int i_ = 0; i_ < 4; ++i_) CF[i_] = *(const GAS f32x4*)(COEF + (size_t)tc_ * 128 + 16 * kg + 4 * i_); \
            OO = *(const GAS v2u*)(X1B + (size_t)tc_ * D + col); } while (0)
#define P7_BYTE(d_, s_) do { const h2_t r_ = __builtin_amdgcn_cvt_scalef32_pk_f16_fp4(ww_[d_], 1.0f, s_); acc_[4 * (d_) + (s_)] = r_ * c2_ + acc_[4 * (d_) + (s_)]; } while (0)
#define P7_COMPUTE(tt, W, CF, OO) do { h2_t acc_[16];                 \
            _Pragma("unroll") for (int i_ = 0; i_ < 16; ++i_) acc_[i_] = (h2_t){(_Float16)0.f, (_Float16)0.f}; \
            _Pragma("unroll") for (int i_ = 0; i_ < 16; ++i_) { const unsigned ww_[4] = {W[i_].x, W[i_].y, W[i_].z, W[i_].w}; const _Float16 ch_ = (_Float16)CF[i_ >> 2][i_ & 3]; const h2_t c2_ = {ch_, ch_}; \
                P7_BYTE(0, 0); P7_BYTE(0, 1); P7_BYTE(0, 2); P7_BYTE(0, 3); P7_BYTE(1, 0); P7_BYTE(1, 1); P7_BYTE(1, 2); P7_BYTE(1, 3); \
                P7_BYTE(2, 0); P7_BYTE(2, 1); P7_BYTE(2, 2); P7_BYTE(2, 3); P7_BYTE(3, 0); P7_BYTE(3, 1); P7_BYTE(3, 2); P7_BYTE(3, 3); } \
            float r16_[16], r8_[8], r4_[4]; \
            { const bool up_ = (F.lane & 8) != 0; _Pragma("unroll") for (int i_ = 0; i_ < 8; ++i_) { const h2_t keep_ = up_ ? acc_[8 + i_] : acc_[i_], send_ = up_ ? acc_[i_] : acc_[8 + i_]; \
                const h2_t oth_ = __builtin_bit_cast(h2_t, __shfl_xor(__builtin_bit_cast(int, send_), 8)); r16_[2 * i_] = (float)keep_[0] + (float)oth_[0]; r16_[2 * i_ + 1] = (float)keep_[1] + (float)oth_[1]; } } \
            { const bool up_ = (F.lane & 16) != 0; _Pragma("unroll") for (int i_ = 0; i_ < 8; ++i_) { const float keep_ = up_ ? r16_[8 + i_] : r16_[i_], send_ = up_ ? r16_[i_] : r16_[8 + i_]; r8_[i_] = keep_ + __shfl_xor(send_, 16); } } \
            { const bool up_ = (F.lane & 32) != 0; _Pragma("unroll") for (int i_ = 0; i_ < 4; ++i_) { const float keep_ = up_ ? r8_[4 + i_] : r8_[i_], send_ = up_ ? r8_[i_] : r8_[4 + i_]; r4_[i_] = keep_ + __shfl_xor(send_, 32); } } \
            if ((tt) < T) *(GAS f32x4*)((rep_ == 0 ? out : (float*)(ws + WS_GT)) + (size_t)(tt) * D + col) = (f32x4){pg8::bflo(OO.x) + r4_[0], pg8::bfhi(OO.x) + r4_[1], pg8::bflo(OO.y) + r4_[2], pg8::bfhi(OO.y) + r4_[3]}; } while (0)
        v4u idA[2], idB[2], wA[16], wB[16]; f32x4 cfA[4], cfB[4]; v2u ooA, ooB;
        int t = rk2 * NWAVES + F.wave;
        P7_IDS(t, idA); P7_IDS(t + tstep, idB);
        while (t < T) {
            P7_ISSUE(t, idA, wA, cfA, ooA); P7_ISSUE(t + tstep, idB, wB, cfB, ooB);
            P7_IDS(t + 2 * tstep, idA); P7_IDS(t + 3 * tstep, idB);
            P7_COMPUTE(t, wA, cfA, ooA);
            P7_COMPUTE(t + tstep, wB, cfB, ooB);
            t += 2 * tstep;
        }
#undef P7_CL
#undef P7_IDS
#undef P7_ISSUE
#undef P7_BYTE
#undef P7_COMPUTE
    }
#undef IN
#undef BOTH
#undef GRID_BAR
}

extern "C" void kernel_launch(void* const* d_in, const int* in_sizes, int n_in, void* d_out, int out_size, void* d_ws, size_t ws_size, hipStream_t stream) {
    static int grid = 0;
    if (grid == 0) {
        if (n_in != 14 || in_sizes[0] != T * D || out_size != T * D || ws_size < WS_END) { fprintf(stderr, "kernel_launch: built for 14 inputs, x and out of %d floats, >= %zu bytes of workspace; got n_in %d, in0 %d, out %d, ws %zu; nothing launched\n", T * D, (size_t)WS_END, n_in, n_in > 0 ? in_sizes[0] : -1, out_size, ws_size); grid = -1; return; }
        int dev = 0, cus = 0, per_cu = 0;
        if (hipGetDevice(&dev) != hipSuccess || hipDeviceGetAttribute(&cus, hipDeviceAttributeMultiprocessorCount, dev) != hipSuccess) { fprintf(stderr, "kernel_launch: hipGetDevice / hipDeviceGetAttribute failed\n"); grid = -1; return; }
        if (hipFuncSetAttribute((const void*)fwd_kernel, hipFuncAttributeMaxDynamicSharedMemorySize, LDS_BYTES) != hipSuccess) { fprintf(stderr, "kernel_launch: hipFuncSetAttribute failed\n"); grid = -1; return; }
        if (hipOccupancyMaxActiveBlocksPerMultiprocessor(&per_cu, (const void*)fwd_kernel, NWAVES * 64, LDS_BYTES) != hipSuccess || per_cu < 1)
            fprintf(stderr, "kernel_launch: note: occupancy query reports %d workgroups per CU\n", per_cu);
        (void)hipGetLastError();
        grid = cus;
    }
    if (grid < 0) return;
    if (hipMemsetAsync((char*)d_ws + WS_CTL, 0, CTL_ZERO_BYTES, stream) != hipSuccess) { fprintf(stderr, "kernel_launch: hipMemsetAsync failed\n"); return; }
    Args a{};
    for (int i = 0; i < 14; ++i) a.in[i] = (const float*)d_in[i];
    a.out = (float*)d_out; a.ws = (unsigned char*)d_ws;
    for (int li = 0; li < N_LAUNCHES; ++li) {
        a.ph_lo = (N_LAUNCHES == PER_PHASE) ? li : 0; a.ph_hi = (N_LAUNCHES == PER_PHASE) ? li + 1 : MK_LAST_PHASE; a.li = li;
        if (a.ph_lo >= MK_LAST_PHASE) break;
        hipLaunchKernelGGL(fwd_kernel, dim3(grid), dim3(NWAVES * 64), LDS_BYTES, stream, a);
        const hipError_t le = hipPeekAtLastError();
        if (le != hipSuccess) { fprintf(stderr, "kernel_launch: launch %d failed: %s\n", li, hipGetErrorName(le)); break; }
    }
}
```

```cpp
#include <hip/hip_runtime.h>
#include <cstdio>
#include <cstdint>
namespace pg8 {
#define PG8_LAS __attribute__((address_space(3)))
typedef unsigned short bf16_t;
typedef short bf16x8 __attribute__((ext_vector_type(8)));
typedef float f32x4 __attribute__((ext_vector_type(4)));
typedef unsigned u32x4 __attribute__((ext_vector_type(4)));
typedef int i32x8 __attribute__((ext_vector_type(8)));
typedef int i32x4 __attribute__((ext_vector_type(4)));
constexpr int BM = 256, BK = 64, HALF = 128, HTB = HALF * BK * 2  , STAGE_BYTES = 8 * HTB, NXCD = 8, WGM = 8;

__host__ __device__ __forceinline__ int lds_byte(int r, int c) { const int st = (r >> 4) * 2 + (c >> 5), rr = r & 15, cc = c & 31, ob = rr * 64 + cc * 2; return st * 1024 + (ob ^ (((ob >> 9) & 1) << 5)); }
__host__ __device__ __forceinline__ void stage_rc(int b, int& R, int& C) { const int st = b / 1024, sb = b % 1024, swz = sb ^ (((sb >> 9) & 1) << 5); R = (st >> 1) * 16 + swz / 64; C = (st & 1) * 32 + (swz % 64) / 2; }
__host__ __device__ __forceinline__ int perm32(int rho) { const int n = rho >> 4, i = rho & 15; return 8 * (i >> 2) + 4 * n + (i & 3); }

struct Unit { int pm, pn; };
struct Gemm { const bf16_t* A; const bf16_t* Bt; int M, N, K; };

struct StaticOrder {
    int nM, nN, nwg, G, c;
    __host__ __device__ void init(int M, int N, int G_, int c_) { nM = M / BM; nN = N / BM; nwg = nM * nN; G = G_; c = c_; }
    __host__ __device__ bool next(int i, Unit& u) const {
        const long L = (long)i * G + c; if (L >= nwg) return false;
        int wgid = (int)L; { const int q = nwg / NXCD, r = nwg % NXCD, xcd = wgid % NXCD, off = wgid / NXCD; wgid = (xcd < r ? xcd * (q + 1) : r * (q + 1) + (xcd - r) * q) + off; }
        const int nig = WGM * nN, gid = wgid / nig, fm = gid * WGM, gsz = (nM - fm) < WGM ? (nM - fm) : WGM;
        u.pm = fm + ((wgid % nig) % gsz); u.pn = (wgid % nig) / gsz; return true;
    }
    __device__ __forceinline__ void a_ready(const Unit&) const {}
    __device__ __forceinline__ void done(const Unit&) const {}
};


struct OneUnit {
    Unit u;
    __device__ __forceinline__ bool next(int i, Unit& o) const { if (i != 0) return false; o = u; return true; }
    __device__ __forceinline__ void a_ready(const Unit&) const {}
    __device__ __forceinline__ void done(const Unit&) const {}
};

typedef float f32x2 __attribute__((ext_vector_type(2)));
typedef __bf16 bf16x2_t __attribute__((ext_vector_type(2)));
typedef unsigned u32x2 __attribute__((ext_vector_type(2)));
__device__ __forceinline__ unsigned pkbf(float lo, float hi) { f32x2 v = {lo, hi}; bf16x2_t b = __builtin_convertvector(v, bf16x2_t); return __builtin_bit_cast(unsigned, b); }
__device__ __forceinline__ float bflo(unsigned w) { return __uint_as_float(w << 16); }
__device__ __forceinline__ float bfhi(unsigned w) { return __uint_as_float(w & 0xffff0000u); }
__device__ __forceinline__ u32x4 pack8(const f32x4 a, const f32x4 b) { u32x4 w; w.x = pkbf(a[0], a[1]); w.y = pkbf(a[2], a[3]); w.z = pkbf(b[0], b[1]); w.w = pkbf(b[2], b[3]); return w; }
constexpr float QSCALE = 0.125f * 1.4426950408889634f;
__device__ __forceinline__ float sigmoidf_(float v) { return __builtin_amdgcn_rcpf(1.0f + __builtin_amdgcn_exp2f(-1.4426950408889634f * v)); }

struct EpiG {
    static constexpr bool PERM = true, AFTER_DRAIN = false, HAS_MID = false; static constexpr int MID_T = -1;
    const float* bgate; const float* cs; const float* xs; const float* qg; const float* kg; bf16_t *QS, *KS, *VS, *QD, *KD, *VD; unsigned char* GT;
    __device__ __forceinline__ void mid(f32x4 (&)[2][2][4][2], const Unit&, int, int, int, int) const {}
    static __device__ __forceinline__ f32x4 cvt(const f32x4 a, const f32x4 sc) { const i32x4 ia = __builtin_bit_cast(i32x4, a); return (f32x4){(float)ia[0], (float)ia[1], (float)ia[2], (float)ia[3]} * sc; }
    __device__ __forceinline__ void operator()(const f32x4 (&acc)[2][2][4][2], const Unit& u, int wr, int wc, int fr, int fq) const {
        asm volatile("" : "+v"(fr), "+v"(fq));
        const int pn = u.pn; const int row0 = u.pm * BM + wr * 64 + fr, colp = pn * BM + wc * 32 + 8 * fq;
        f32x4 sv[2][2];
#pragma unroll
        for (int bj = 0; bj < 2; ++bj)
#pragma unroll
            for (int n = 0; n < 2; ++n) sv[bj][n] = *(const f32x4*)(cs + colp + bj * HALF + 4 * n);
        if (pn < 6) {
            bf16_t* base; int colt;
            if (pn < 2) { base = QS; colt = pn * 256; } else if (pn < 4) { base = KS; colt = (pn - 2) * 256; } else { base = VS; colt = (pn - 4) * 256; }
            base += colt + wc * 32 + 8 * fq;
            const float qs = (pn < 2 ? QSCALE : 1.0f);
#pragma unroll
            for (int ai = 0; ai < 2; ++ai)
#pragma unroll
                for (int m = 0; m < 4; ++m) { const int row = row0 + ai * HALF + m * 16; const float r = xs[row] * qs;
#pragma unroll
                    for (int bj = 0; bj < 2; ++bj) *(u32x4*)(base + (size_t)row * 512 + bj * HALF) = pack8(cvt(acc[ai][bj][m][0], sv[bj][0]) * r, cvt(acc[ai][bj][m][1], sv[bj][1]) * r);
                }
        } else if (pn < 12) {
            const bool isK = pn >= 9; const int head = (isK ? pn - 9 : pn - 6) * 4 + wc;
            const float* g = (isK ? kg : qg) + head * 64 + 8 * fq;
            f32x4 gv[2][2]; const float qsc = isK ? 1.0f : QSCALE;
#pragma unroll
            for (int bj = 0; bj < 2; ++bj)
#pragma unroll
                for (int n = 0; n < 2; ++n) gv[bj][n] = *(const f32x4*)(g + 32 * bj + 4 * n) * qsc;
            bf16_t* base = (isK ? KD : QD) + head * 64 + 8 * fq;
#pragma unroll
            for (int ai = 0; ai < 2; ++ai)
#pragma unroll
                for (int m = 0; m < 4; ++m) { const int row = row0 + ai * HALF + m * 16; const float r = xs[row];
                    f32x4 v[2][2]; float ss = 0.f;
#pragma unroll
                    for (int bj = 0; bj < 2; ++bj)
#pragma unroll
                        for (int n = 0; n < 2; ++n) { v[bj][n] = cvt(acc[ai][bj][m][n], sv[bj][n]) * r; const f32x4 q = v[bj][n] * v[bj][n]; ss += (q[0] + q[1]) + (q[2] + q[3]); }
                    ss += __shfl_xor(ss, 16); ss += __shfl_xor(ss, 32);
                    const float sc = __builtin_amdgcn_rsqf(ss * (1.0f / 64.0f) + 1e-6f);
#pragma unroll
                    for (int bj = 0; bj < 2; ++bj) *(u32x4*)(base + (size_t)row * 768 + 32 * bj) = pack8(v[bj][0] * sc * gv[bj][0], v[bj][1] * sc * gv[bj][1]);
                }
        } else if (pn < 15) {
            bf16_t* base = VD + (pn - 12) * 256 + wc * 32 + 8 * fq;
#pragma unroll
            for (int ai = 0; ai < 2; ++ai)
#pragma unroll
                for (int m = 0; m < 4; ++m) { const int row = row0 + ai * HALF + m * 16; const float r = xs[row];
#pragma unroll
                    for (int bj = 0; bj < 2; ++bj) *(u32x4*)(base + (size_t)row * 768 + bj * HALF) = pack8(cvt(acc[ai][bj][m][0], sv[bj][0]) * r, cvt(acc[ai][bj][m][1], sv[bj][1]) * r);
                }
        } else {
            const int col0 = (pn - 15) * 256 + wc * 32 + 8 * fq;
            f32x4 bv[2][2];
#pragma unroll
            for (int bj = 0; bj < 2; ++bj)
#pragma unroll
                for (int n = 0; n < 2; ++n) bv[bj][n] = *(const f32x4*)(bgate + col0 + bj * HALF + 4 * n);
#pragma unroll
            for (int ai = 0; ai < 2; ++ai)
#pragma unroll
                for (int m = 0; m < 4; ++m) { const int row = row0 + ai * HALF + m * 16; const float r = xs[row];
#pragma unroll
                    for (int bj = 0; bj < 2; ++bj) { f32x4 a = cvt(acc[ai][bj][m][0], sv[bj][0]) * r + bv[bj][0], b = cvt(acc[ai][bj][m][1], sv[bj][1]) * r + bv[bj][1];
#pragma unroll
                        for (int e = 0; e < 4; ++e) { a[e] = sigmoidf_(a[e]) * 255.0f; b[e] = sigmoidf_(b[e]) * 255.0f; }
                        unsigned w0 = 0, w1 = 0;
                        w0 = __builtin_amdgcn_cvt_pk_u8_f32(a[0], 0, w0); w0 = __builtin_amdgcn_cvt_pk_u8_f32(a[1], 1, w0); w0 = __builtin_amdgcn_cvt_pk_u8_f32(a[2], 2, w0); w0 = __builtin_amdgcn_cvt_pk_u8_f32(a[3], 3, w0);
                        w1 = __builtin_amdgcn_cvt_pk_u8_f32(b[0], 0, w1); w1 = __builtin_amdgcn_cvt_pk_u8_f32(b[1], 1, w1); w1 = __builtin_amdgcn_cvt_pk_u8_f32(b[2], 2, w1); w1 = __builtin_amdgcn_cvt_pk_u8_f32(b[3], 3, w1);
                        *(u32x2*)(GT + (size_t)row * 2048 + col0 + bj * HALF) = (u32x2){w0, w1}; }
                }
        }
    }
};

struct Epi2 {
    static constexpr bool PERM = true, AFTER_DRAIN = false, HAS_MID = true; static constexpr int MID_T = 8;
    const unsigned char* GT; unsigned char* MIX8; unsigned* part; unsigned* rcnt; float* rmaxf; PG8_LAS unsigned char* red_lds;
    static __device__ __forceinline__ float ub(unsigned w, int e) { return (float)((w >> (8 * e)) & 0xffu); }
    static __device__ __forceinline__ float gcv(unsigned w, int e) { return fmaxf(ub(w, e) * (1.0f / 255.0f), 1e-30f); }
    __device__ __forceinline__ void mid(f32x4 (&acc)[2][2][4][2], const Unit& u, int wr, int wc, int fr, int fq) const {
        asm volatile("" : "+v"(fr), "+v"(fq));
        const int row0 = u.pm * BM + wr * 64 + fr, col0 = u.pn * BM + wc * 32 + 8 * fq;
        u32x2 ga[2][4][2], gb[2][4][2];
#pragma unroll
        for (int ai = 0; ai < 2; ++ai)
#pragma unroll
            for (int m = 0; m < 4; ++m) { const unsigned char* gp = GT + (size_t)(row0 + ai * HALF + m * 16) * 2048 + col0;
#pragma unroll
                for (int bj = 0; bj < 2; ++bj) { ga[ai][m][bj] = *(const u32x2*)(gp + bj * HALF); gb[ai][m][bj] = *(const u32x2*)(gp + 1024 + bj * HALF); } }
        asm volatile("" ::: "memory");
#pragma unroll
        for (int ai = 0; ai < 2; ++ai)
#pragma unroll
            for (int m = 0; m < 4; ++m)
#pragma unroll
                for (int bj = 0; bj < 2; ++bj) { const u32x2 a = ga[ai][m][bj], b = gb[ai][m][bj];
                    f32x4 r0, r1;
#pragma unroll
                    for (int e = 0; e < 4; ++e) { r0[e] = ub(a.x, e) * (1.0f / 255.0f) * __builtin_amdgcn_rcpf(gcv(b.x, e)); r1[e] = ub(a.y, e) * (1.0f / 255.0f) * __builtin_amdgcn_rcpf(gcv(b.y, e)); }
                    acc[ai][bj][m][0] *= r0; acc[ai][bj][m][1] *= r1; }
        asm volatile("" ::: "memory");
    }
    __device__ __forceinline__ void operator()(f32x4 (&acc)[2][2][4][2], const Unit& u, int wr, int wc, int fr, int fq) const {
        asm volatile("" : "+v"(fr), "+v"(fq));
        const int row0 = u.pm * BM + wr * 64 + fr, col0 = u.pn * BM + wc * 32 + 8 * fq;
        PG8_LAS float* red = (PG8_LAS float*)red_lds; PG8_LAS float* red2 = red + 1024;
#pragma unroll
        for (int ai = 0; ai < 2; ++ai) { u32x2 gb[4][2];
#pragma unroll
            for (int m = 0; m < 4; ++m) { const unsigned char* gp = GT + (size_t)(row0 + ai * HALF + m * 16) * 2048 + 1024 + col0;
#pragma unroll
                for (int bj = 0; bj < 2; ++bj) gb[m][bj] = *(const u32x2*)(gp + bj * HALF); }
#pragma unroll
            for (int m = 0; m < 4; ++m) { float a = 0.f;
#pragma unroll
                for (int bj = 0; bj < 2; ++bj) { const u32x2 b = gb[m][bj];
#pragma unroll
                    for (int e = 0; e < 4; ++e) { acc[ai][bj][m][0][e] *= gcv(b.x, e); acc[ai][bj][m][1][e] *= gcv(b.y, e); a = fmaxf(a, fmaxf(fabsf(acc[ai][bj][m][0][e]), fabsf(acc[ai][bj][m][1][e]))); } }
                a = fmaxf(a, __shfl_xor(a, 16)); a = fmaxf(a, __shfl_xor(a, 32));
                if (fq == 0) red[(wr * 64 + fr + ai * HALF + m * 16) * 4 + wc] = a; }
            asm volatile("" ::: "memory");
        }
        asm volatile("s_waitcnt lgkmcnt(0)" ::: "memory"); __builtin_amdgcn_s_barrier(); asm volatile("" ::: "memory");
        const int tid = (wr * 4 + wc) * 64 + fr + 16 * fq;
        if (tid < 256) {
            const f32x4 p4 = *(const PG8_LAS f32x4*)(red + tid * 4);
            const float v = fmaxf(fmaxf(p4[0], p4[1]), fmaxf(p4[2], p4[3]));
            unsigned* pr = part + (size_t)(u.pm * BM + tid) * 4;
            __hip_atomic_store(pr + u.pn, __float_as_uint(v), __ATOMIC_RELAXED, __HIP_MEMORY_SCOPE_AGENT);
            asm volatile("s_waitcnt vmcnt(0)" ::: "memory");
            if ((tid & 63) == 0) (void)__hip_atomic_fetch_add(rcnt + u.pm, 1u, __ATOMIC_RELAXED, __HIP_MEMORY_SCOPE_AGENT);
            { unsigned sp = 0; while (__hip_atomic_load(rcnt + u.pm, __ATOMIC_RELAXED, __HIP_MEMORY_SCOPE_AGENT) < 16u) { __builtin_amdgcn_s_sleep(4); if (++sp > (1u << 21)) break; } }
            asm volatile("" ::: "memory");
            float f = 0.f;
#pragma unroll
            for (int j = 0; j < 4; ++j) f = fmaxf(f, __uint_as_float(__hip_atomic_load(pr + j, __ATOMIC_RELAXED, __HIP_MEMORY_SCOPE_AGENT)));
            red2[tid] = f;
            if (u.pn == 0) rmaxf[u.pm * BM + tid] = f;
        }
        asm volatile("s_waitcnt lgkmcnt(0)" ::: "memory"); __builtin_amdgcn_s_barrier(); asm volatile("" ::: "memory");
#pragma unroll
        for (int ai = 0; ai < 2; ++ai)
#pragma unroll
            for (int m = 0; m < 4; ++m) { const int row = row0 + ai * HALF + m * 16;
                const float rm = red2[wr * 64 + fr + ai * HALF + m * 16]; const float sc = rm > 0.f ? 127.0f / rm : 0.f;
#pragma unroll
                for (int bj = 0; bj < 2; ++bj) { unsigned w0 = 0, w1 = 0;
#pragma unroll
                    for (int e = 0; e < 4; ++e) { w0 |= ((unsigned)(int)__builtin_rintf(acc[ai][bj][m][0][e] * sc) & 0xffu) << (8 * e); w1 |= ((unsigned)(int)__builtin_rintf(acc[ai][bj][m][1][e] * sc) & 0xffu) << (8 * e); }
                    *(u32x2*)(MIX8 + (size_t)row * 1024 + col0 + bj * HALF) = (u32x2){w0, w1}; } }
    }
};

struct Epi3 {
    static constexpr bool PERM = true, AFTER_DRAIN = false, HAS_MID = false; static constexpr int MID_T = -1;
    const bf16_t* xb; const float* rms; const unsigned* rmax; const float* wos; bf16_t* x1b; float* ssq;
    __device__ __forceinline__ void mid(f32x4 (&)[2][2][4][2], const Unit&, int, int, int, int) const {}
    static __device__ __forceinline__ f32x4 cvt(const f32x4 a, const f32x4 sc) { const i32x4 ia = __builtin_bit_cast(i32x4, a); return (f32x4){(float)ia[0], (float)ia[1], (float)ia[2], (float)ia[3]} * sc; }
    __device__ __forceinline__ void operator()(const f32x4 (&acc)[2][2][4][2], const Unit& u, int wr, int wc, int fr, int fq) const {
        asm volatile("" : "+v"(fr), "+v"(fq));
        const int row0 = u.pm * BM + wr * 64 + fr, col0 = u.pn * BM + wc * 32 + 8 * fq;
        f32x4 wsv[2][2];
#pragma unroll
        for (int bj = 0; bj < 2; ++bj)
#pragma unroll
            for (int n = 0; n < 2; ++n) wsv[bj][n] = *(const f32x4*)(wos + col0 + bj * HALF + 4 * n);
#pragma unroll
        for (int ai = 0; ai < 2; ++ai) { u32x4 xv[4][2]; float rm[4], ms[4];
#pragma unroll
            for (int m = 0; m < 4; ++m) { const int row = row0 + ai * HALF + m * 16; const size_t off = (size_t)row * 1024 + col0; rm[m] = rms[row]; ms[m] = __uint_as_float(rmax[row]) * (1.0f / 127.0f);
#pragma unroll
                for (int bj = 0; bj < 2; ++bj) xv[m][bj] = *(const u32x4*)(xb + off + bj * HALF); }
#pragma unroll
            for (int m = 0; m < 4; ++m) { const int row = row0 + ai * HALF + m * 16; const size_t off = (size_t)row * 1024 + col0; float ss = 0.f; const float r = rm[m], mr = ms[m];
#pragma unroll
                for (int bj = 0; bj < 2; ++bj) { const u32x4 w = xv[m][bj];
                    const f32x4 x0 = (f32x4){bflo(w.x), bfhi(w.x), bflo(w.y), bfhi(w.y)}, x1 = (f32x4){bflo(w.z), bfhi(w.z), bflo(w.w), bfhi(w.w)};
                    const f32x4 v0 = cvt(acc[ai][bj][m][0], wsv[bj][0]) * mr + x0 * r, v1 = cvt(acc[ai][bj][m][1], wsv[bj][1]) * mr + x1 * r;
                    *(u32x4*)(x1b + off + bj * HALF) = pack8(v0, v1);
                    const f32x4 q0 = v0 * v0, q1 = v1 * v1; ss += ((q0[0] + q0[1]) + (q0[2] + q0[3])) + ((q1[0] + q1[1]) + (q1[2] + q1[3])); }
                ss += __shfl_xor(ss, 16); ss += __shfl_xor(ss, 32);
                if (fq == 0) ssq[(size_t)row * 16 + u.pn * 4 + wc] = ss;
            }
            asm volatile("" ::: "memory");
        }
    }
};

__device__ __forceinline__ unsigned f2key(float v) { const unsigned u = __float_as_uint(v); return (u & 0x80000000u) ? ~u : (u | 0x80000000u); }
__device__ __forceinline__ float key2f(unsigned k) { return __uint_as_float((k & 0x80000000u) ? (k & 0x7fffffffu) : ~k); }
#define PG8_CE(a_, b_) do { const unsigned hi__ = (a_) > (b_) ? (a_) : (b_); const unsigned lo__ = (a_) > (b_) ? (b_) : (a_); (a_) = hi__; (b_) = lo__; } while (0)
__device__ __forceinline__ void bitonic_merge16(unsigned (&v)[16]) {
#pragma unroll
    for (int j = 8; j >= 1; j >>= 1)
#pragma unroll
        for (int i = 0; i < 16; ++i) { const int l = i ^ j; if (l > i) PG8_CE(v[i], v[l]); }
}
__device__ __forceinline__ void bitonic_sort16(unsigned (&v)[16]) {
#pragma unroll
    for (int k = 2; k <= 16; k <<= 1)
#pragma unroll
        for (int j = k >> 1; j >= 1; j >>= 1)
#pragma unroll
            for (int i = 0; i < 16; ++i) { const int l = i ^ j; if (l > i) { if ((i & k) == 0 || k == 16) PG8_CE(v[i], v[l]); else PG8_CE(v[l], v[i]); } }
}
__device__ __forceinline__ void merge_top16(unsigned (&t)[16], const unsigned (&o)[16]) {
#pragma unroll
    for (int i = 0; i < 16; ++i) t[i] = t[i] > o[15 - i] ? t[i] : o[15 - i];
    bitonic_merge16(t);
}
template <int XM> __device__ __forceinline__ void merge_top16_xor(unsigned (&t)[16]) {
    unsigned o[16];
#pragma unroll
    for (int i = 0; i < 16; ++i) o[i] = (unsigned)__shfl_xor((int)t[i], XM);
    merge_top16(t, o);
}

struct Epi4 {
    static constexpr bool PERM = false, AFTER_DRAIN = true, HAS_MID = false; static constexpr int MID_T = -1;
    const float* ssq; float* rinv2; unsigned short* ids; float* gw;
    const float* hs; const float* wcs;
    __device__ __forceinline__ void mid(f32x4 (&)[2][2][4][2], const Unit&, int, int, int, int) const {}
    __device__ __forceinline__ void fused(f32x4 (&acc)[2][2][4][2], const Unit& u, int wr, int wc, int fr, int fq, PG8_LAS unsigned char* lds, int wid, int lane) const {
        asm volatile("" : "+v"(fr), "+v"(fq));
        const int tid = wid * 64 + lane;
        const int rl = tid >> 2, p = (tid >> 1) & 1, hf = tid & 1, q4 = tid & 3;
#pragma unroll
        for (int pass = 0; pass < 2; ++pass) {
            f32x4 wsv[2][2]; float hsv[4];
#pragma unroll
            for (int bj = 0; bj < 2; ++bj)
#pragma unroll
                for (int n = 0; n < 2; ++n) wsv[bj][n] = *(const f32x4*)(wcs + u.pn * BM + bj * HALF + wc * 32 + n * 16 + fq * 4);
#pragma unroll
            for (int m = 0; m < 4; ++m) hsv[m] = hs[u.pm * BM + pass * HALF + wr * 64 + m * 16 + fr];
#pragma unroll
            for (int m = 0; m < 4; ++m)
#pragma unroll
                for (int bj = 0; bj < 2; ++bj)
#pragma unroll
                    for (int n = 0; n < 2; ++n) { const i32x4 ia = __builtin_bit_cast(i32x4, acc[pass][bj][m][n]); f32x4 sv;
#pragma unroll
                        for (int e = 0; e < 4; ++e) sv[e] = (float)ia[e] * hsv[m] * wsv[bj][n][e];
                        *(PG8_LAS f32x4*)(lds + (size_t)(wr * 64 + m * 16 + fr) * 1056 + bj * 528 + (wc * 32 + n * 16 + fq * 4) * 4) = sv; }
            asm volatile("s_waitcnt lgkmcnt(0)" ::: "memory"); __builtin_amdgcn_s_barrier(); asm volatile("" ::: "memory");
            const int row = u.pm * BM + pass * HALF + rl;
            unsigned tk[16];
#pragma unroll
            for (int i = 0; i < 16; ++i) tk[i] = 0u;
            const PG8_LAS unsigned char* sp = lds + (size_t)rl * 1056 + p * 528 + hf * 256;
#pragma nounroll
            for (int c = 0; c < 4; ++c) { unsigned ch[16];
#pragma unroll
                for (int e4 = 0; e4 < 4; ++e4) { const f32x4 v = *(const PG8_LAS f32x4*)(sp + c * 64 + e4 * 16);
#pragma unroll
                    for (int e = 0; e < 4; ++e) ch[4 * e4 + e] = (f2key(v[e]) & ~127u) | (unsigned)(127 - (64 * hf + 16 * c + 4 * e4 + e)); }
                bitonic_sort16(ch);
                merge_top16(tk, ch);
            }
            merge_top16_xor<1>(tk);
            asm volatile("s_waitcnt lgkmcnt(0)" ::: "memory");
            PG8_LAS unsigned* kl = (PG8_LAS unsigned*)(lds + (size_t)(rl & ~15) * 1056) + ((rl & 15) * 2) * 16;
            if (hf == 0) {
#pragma unroll
                for (int i = 0; i < 4; ++i) *(PG8_LAS u32x4*)(kl + p * 16 + 4 * i) = (u32x4){tk[4 * i], tk[4 * i + 1], tk[4 * i + 2], tk[4 * i + 3]}; }
            asm volatile("s_waitcnt lgkmcnt(0)" ::: "memory");
            unsigned ck[16];
#define CAND_SLOT(m_, ij__) do { const unsigned i__ = (ij__) >> 4, j__ = (ij__) & 15u; \
                const unsigned ka__ = kl[(ij__) == 0xFFFFu ? 0u : i__], kb__ = kl[16 + ((ij__) == 0xFFFFu ? 0u : j__)]; \
                const float s__ = key2f(ka__ & ~127u) + key2f(kb__ & ~127u); \
                ck[m_] = (ij__) == 0xFFFFu ? 0u : ((f2key(s__) & ~255u) | (255u - (ij__))); } while (0)
                { const unsigned ij_ = q4 == 0 ? 0u : q4 == 1 ? 1u : q4 == 2 ? 2u : 3u; CAND_SLOT(0, ij_); }
                { const unsigned ij_ = q4 == 0 ? 4u : q4 == 1 ? 5u : q4 == 2 ? 6u : 7u; CAND_SLOT(1, ij_); }
                { const unsigned ij_ = q4 == 0 ? 8u : q4 == 1 ? 9u : q4 == 2 ? 10u : 11u; CAND_SLOT(2, ij_); }
                { const unsigned ij_ = q4 == 0 ? 12u : q4 == 1 ? 13u : q4 == 2 ? 14u : 15u; CAND_SLOT(3, ij_); }
                { const unsigned ij_ = q4 == 0 ? 16u : q4 == 1 ? 17u : q4 == 2 ? 18u : 19u; CAND_SLOT(4, ij_); }
                { const unsigned ij_ = q4 == 0 ? 20u : q4 == 1 ? 21u : q4 == 2 ? 22u : 23u; CAND_SLOT(5, ij_); }
                { const unsigned ij_ = q4 == 0 ? 32u : q4 == 1 ? 33u : q4 == 2 ? 34u : 35u; CAND_SLOT(6, ij_); }
                { const unsigned ij_ = q4 == 0 ? 36u : q4 == 1 ? 48u : q4 == 2 ? 49u : 50u; CAND_SLOT(7, ij_); }
                { const unsigned ij_ = q4 == 0 ? 51u : q4 == 1 ? 64u : q4 == 2 ? 65u : 66u; CAND_SLOT(8, ij_); }
                { const unsigned ij_ = q4 == 0 ? 80u : q4 == 1 ? 81u : q4 == 2 ? 96u : 97u; CAND_SLOT(9, ij_); }
                { const unsigned ij_ = q4 == 0 ? 112u : q4 == 1 ? 113u : q4 == 2 ? 128u : 144u; CAND_SLOT(10, ij_); }
                { const unsigned ij_ = q4 == 0 ? 160u : q4 == 1 ? 176u : q4 == 2 ? 192u : 208u; CAND_SLOT(11, ij_); }
                { const unsigned ij_ = q4 == 0 ? 224u : q4 == 1 ? 240u : q4 == 2 ? 65535u : 65535u; CAND_SLOT(12, ij_); }
#undef CAND_SLOT
            ck[13] = 0u; ck[14] = 0u; ck[15] = 0u;
            bitonic_sort16(ck);
            merge_top16_xor<1>(ck); merge_top16_xor<2>(ck);
            float sq = 0.f;
#pragma unroll
            for (int i = 0; i < 4; ++i) { const f32x4 t = *(const f32x4*)(ssq + (size_t)row * 16 + 4 * i); sq += (t[0] + t[1]) + (t[2] + t[3]); }
            const float r2 = __builtin_amdgcn_rsqf(sq * (1.0f / 1024.0f) + 1e-6f);
            if (u.pn == 0 && q4 == 0) rinv2[row] = r2;
            const float b0 = key2f(ck[0] & ~255u); float wsum = 0.f; float wv[16];
#pragma unroll
            for (int q = 0; q < 16; ++q) { wv[q] = __builtin_amdgcn_exp2f((key2f(ck[q] & ~255u) - b0) * r2 * 1.4426950408889634f); wsum += wv[q]; }
            const float inv = 1.0f / wsum;
            unsigned short eo[4]; float go[4];
#pragma unroll
            for (int e = 0; e < 4; ++e) { unsigned c0 = ck[e], c1 = ck[4 + e], c2 = ck[8 + e], c3 = ck[12 + e]; float w0 = wv[e], w1 = wv[4 + e], w2 = wv[8 + e], w3 = wv[12 + e];
                asm volatile("" : "+v"(c0), "+v"(c1), "+v"(c2), "+v"(c3), "+v"(w0), "+v"(w1), "+v"(w2), "+v"(w3));
                const unsigned cc = q4 == 0 ? c0 : q4 == 1 ? c1 : q4 == 2 ? c2 : c3; const float ww = q4 == 0 ? w0 : q4 == 1 ? w1 : q4 == 2 ? w2 : w3;
                const unsigned code = 255u - (cc & 255u);
                const unsigned i1 = 127u - (kl[code >> 4] & 127u), i2 = 127u - (kl[16 + (code & 15u)] & 127u);
                eo[e] = (unsigned short)(i1 * 128u + i2); go[e] = ww * inv; }
            const size_t ob = ((size_t)row * 8 + u.pn) * 16 + q4 * 4;
            { u32x2 w; w.x = eo[0] | ((unsigned)eo[1] << 16); w.y = eo[2] | ((unsigned)eo[3] << 16); *(u32x2*)(ids + ob) = w; }
            *(f32x4*)(gw + ob) = (f32x4){go[0], go[1], go[2], go[3]};
            asm volatile("s_waitcnt lgkmcnt(0)" ::: "memory"); __builtin_amdgcn_s_barrier(); asm volatile("" ::: "memory");
        }
    }
};
template <class Epi, class Sched, bool ALIGN_EPI = false, bool SP2 = false, bool FP8 = false, bool I8 = false>
__device__ __forceinline__ void gemm_phase(PG8_LAS unsigned char* lds, const Gemm g, const Sched& S, const Epi& E) {
    const int tid = threadIdx.x, wid = __builtin_amdgcn_readfirstlane(tid >> 6), lane = tid & 63, wr = wid >> 2, wc = wid & 3, fr = lane & 15, fq = lane >> 4;
    const int K = g.K, nt = K / BK;
    unsigned voffA[2], voffB[2];
#pragma unroll
    for (int i = 0; i < 2; ++i) { int R, C; stage_rc(tid * 16 + i * 8192, R, C); const int Rb = Epi::PERM ? ((R & ~31) + perm32(R & 31)) : R;
        voffA[i] = (unsigned)(R * K + C) * 2u; voffB[i] = (unsigned)(Rb * K + C) * 2u; }
    const size_t kstep = (size_t)(BK * 2);
    const size_t hstep = (size_t)HALF * K * 2;
    const size_t tstep = 2 * hstep;
    const unsigned ldsw = (unsigned)wid * 1024u;
    const int aoff = lds_byte(wr * 64 + fr, fq * 8), boff = lds_byte(wc * 32 + fr, fq * 8);
#define PG8_SA(b, h) (((b) * 2 + (h)) * HTB)
#define PG8_SB(b, h) ((4 + (b) * 2 + (h)) * HTB)
#define PG8_STAGE(bufoff, gbase, voff) do { _Pragma("unroll") for (int _i = 0; _i < 2; ++_i) \
        __builtin_amdgcn_global_load_lds((const unsigned*)((const char*)(gbase) + (voff)[_i]), (PG8_LAS unsigned*)(lds + (bufoff) + ldsw + _i * 8192), 16, 0, 0); } while (0)
#define PG8_LD8(lo_, hi_) __builtin_bit_cast(i32x8, __builtin_shufflevector((lo_), (hi_), 0, 1, 2, 3, 4, 5, 6, 7))
#define PG8_LDA(dst, b, h) do { if constexpr (FP8) { _Pragma("unroll") for (int m = 0; m < 4; ++m) { const u32x4 l0_ = *(const PG8_LAS u32x4*)(lds + PG8_SA(b, h) + aoff + m * 2048), l1_ = *(const PG8_LAS u32x4*)(lds + PG8_SA(b, h) + aoff + m * 2048 + 1024); dst##8[m] = PG8_LD8(l0_, l1_); } } \
        else { _Pragma("unroll") for (int m = 0; m < 4; ++m) _Pragma("unroll") for (int k = 0; k < 2; ++k) dst[m][k] = *(const PG8_LAS bf16x8*)(lds + PG8_SA(b, h) + aoff + m * 2048 + k * 1024); } } while (0)
#define PG8_LDB(dst, b, h) do { if constexpr (FP8) { _Pragma("unroll") for (int n = 0; n < 2; ++n) { const u32x4 l0_ = *(const PG8_LAS u32x4*)(lds + PG8_SB(b, h) + boff + n * 2048), l1_ = *(const PG8_LAS u32x4*)(lds + PG8_SB(b, h) + boff + n * 2048 + 1024); dst##8[n] = PG8_LD8(l0_, l1_); } } \
        else { _Pragma("unroll") for (int n = 0; n < 2; ++n) _Pragma("unroll") for (int k = 0; k < 2; ++k) dst[n][k] = *(const PG8_LAS bf16x8*)(lds + PG8_SB(b, h) + boff + n * 2048 + k * 1024); } } while (0)
#define PG8_MMA(ai, bj, At, Bt) do { __builtin_amdgcn_s_setprio(1); \
        if constexpr (FP8) { _Pragma("unroll") for (int m = 0; m < 4; ++m) _Pragma("unroll") for (int n = 0; n < 2; ++n) \
            asm volatile("v_mfma_scale_f32_16x16x128_f8f6f4 %0, %1, %2, %0, %3, %3 op_sel_hi:[0,0,0]" : "+v"(acc[ai][bj][m][n]) : "v"(Bt##8[n]), "v"(At##8[m]), "v"(sc127));     \
            } \
        else if constexpr (I8) { _Pragma("unroll") for (int m = 0; m < 4; ++m) _Pragma("unroll") for (int n = 0; n < 2; ++n) _Pragma("unroll") for (int k = 0; k < 2; ++k) \
            acc[ai][bj][m][n] = __builtin_bit_cast(f32x4, __builtin_amdgcn_mfma_i32_16x16x64_i8(__builtin_bit_cast(i32x4, Bt[n][k]), __builtin_bit_cast(i32x4, At[m][k]), __builtin_bit_cast(i32x4, acc[ai][bj][m][n]), 0, 0, 0)); } \
        else { _Pragma("unroll") for (int m = 0; m < 4; ++m) _Pragma("unroll") for (int n = 0; n < 2; ++n) _Pragma("unroll") for (int k = 0; k < 2; ++k) \
            acc[ai][bj][m][n] = __builtin_amdgcn_mfma_f32_16x16x32_bf16(Bt[n][k], At[m][k], acc[ai][bj][m][n], 0, 0, 0); } \
        __builtin_amdgcn_s_setprio(0); } while (0)
#define PG8_WAIT_V(n) asm volatile("s_waitcnt vmcnt(" #n ")" ::: "memory")
#define PG8_WAIT_L(n) asm volatile("s_waitcnt lgkmcnt(" #n ")" ::: "memory")
#define PG8_BAR __builtin_amdgcn_s_barrier()
#define PG8_SCHED __builtin_amdgcn_sched_barrier(0)
    Unit cur, nxt; int ui = 0;
    if (!S.next(0, cur)) return;
    f32x4 acc[2][2][4][2];
#pragma unroll
    for (int a = 0; a < 2; ++a)
#pragma unroll
        for (int b = 0; b < 2; ++b)
#pragma unroll
            for (int m = 0; m < 4; ++m)
#pragma unroll
                for (int n = 0; n < 2; ++n) acc[a][b][m][n] = (f32x4){0.f, 0.f, 0.f, 0.f};
    bf16x8 At[4][2], B0[2][2], B1[2][2]; i32x8 At8[4], B08[2], B18[2];
    int sc127 = 127; asm volatile("" : "+v"(sc127));
    const char* cA = (const char*)g.A + (size_t)cur.pm * tstep; const char* cB = (const char*)g.Bt + (size_t)cur.pn * tstep;
    S.a_ready(cur);
    if constexpr (SP2) {
        PG8_STAGE(PG8_SB(0, 0), cB, voffB); PG8_STAGE(PG8_SB(0, 1), cB + hstep, voffB); PG8_STAGE(PG8_SA(0, 0), cA, voffA); PG8_STAGE(PG8_SA(0, 1), cA + hstep, voffA);
        if (wr == 1) PG8_BAR;
        PG8_WAIT_V(2); PG8_BAR;
        PG8_STAGE(PG8_SB(1, 0), cB + kstep, voffB); PG8_STAGE(PG8_SA(1, 0), cA + kstep, voffA); PG8_STAGE(PG8_SB(1, 1), cB + hstep + kstep, voffB);
        PG8_WAIT_V(6); PG8_BAR;
    } else {
        PG8_STAGE(PG8_SB(0, 0), cB, voffB); PG8_STAGE(PG8_SA(0, 0), cA, voffA); PG8_STAGE(PG8_SB(0, 1), cB + hstep, voffB); PG8_STAGE(PG8_SA(0, 1), cA + hstep, voffA);
        if (wr == 1) PG8_BAR;
        PG8_WAIT_V(4); PG8_BAR;
        PG8_STAGE(PG8_SB(1, 0), cB + kstep, voffB); PG8_STAGE(PG8_SA(1, 0), cA + kstep, voffA); PG8_STAGE(PG8_SB(1, 1), cB + hstep + kstep, voffB);
        PG8_WAIT_V(6); PG8_BAR;
    }
    for (;;) {
        const bool has_next = S.next(ui + 1, nxt);
        const char* nA = has_next ? (const char*)g.A + (size_t)nxt.pm * tstep : cA; const char* nB = has_next ? (const char*)g.Bt + (size_t)nxt.pn * tstep : cB;
        for (int t = 0; t < nt; t += 2) {
            if constexpr (Epi::HAS_MID) { if (t == Epi::MID_T) E.mid(acc, cur, wr, wc, fr, fq); }
            const bool last = (t == nt - 2);
            const char* a1 = cA + (size_t)(t + 1) * kstep;
            const char* a2 = last ? nA : cA + (size_t)(t + 2) * kstep; const char* b2 = last ? nB : cB + (size_t)(t + 2) * kstep;
            const char* a3 = a2 + kstep; const char* b3 = b2 + kstep;
            if (last && has_next) S.a_ready(nxt);
            if constexpr (SP2) {
            PG8_LDB(B0, 0, 0); PG8_LDB(B1, 0, 1); PG8_SCHED; PG8_LDA(At, 0, 0); PG8_STAGE(PG8_SA(1, 1), a1 + hstep, voffA);
            PG8_WAIT_V(8); PG8_WAIT_L(0); PG8_BAR; PG8_MMA(0, 0, At, B0); PG8_MMA(0, 1, At, B1); PG8_BAR; PG8_SCHED;
            PG8_LDA(At, 0, 1); PG8_STAGE(PG8_SB(0, 0), b2, voffB); PG8_STAGE(PG8_SB(0, 1), b2 + hstep, voffB); PG8_STAGE(PG8_SA(0, 0), a2, voffA);
            PG8_WAIT_V(8); PG8_WAIT_L(0); PG8_BAR; PG8_MMA(1, 0, At, B0); PG8_MMA(1, 1, At, B1); PG8_BAR; PG8_SCHED;
            PG8_LDB(B0, 1, 0); PG8_LDB(B1, 1, 1); PG8_SCHED; PG8_LDA(At, 1, 0); PG8_STAGE(PG8_SA(0, 1), a2 + hstep, voffA);
            PG8_WAIT_V(8); PG8_WAIT_L(0); PG8_BAR; PG8_MMA(0, 0, At, B0); PG8_MMA(0, 1, At, B1); PG8_BAR; PG8_SCHED;
            PG8_LDA(At, 1, 1); PG8_STAGE(PG8_SB(1, 0), b3, voffB); PG8_STAGE(PG8_SB(1, 1), b3 + hstep, voffB); PG8_STAGE(PG8_SA(1, 0), a3, voffA);
            PG8_WAIT_V(8); PG8_WAIT_L(0); PG8_BAR; PG8_MMA(1, 0, At, B0); PG8_MMA(1, 1, At, B1); PG8_BAR; PG8_SCHED;
            } else {
            PG8_LDB(B0, 0, 0); PG8_SCHED; PG8_LDA(At, 0, 0); PG8_STAGE(PG8_SA(1, 1), a1 + hstep, voffA);
            PG8_WAIT_L(8); PG8_BAR; PG8_WAIT_L(0); PG8_MMA(0, 0, At, B0); PG8_BAR; PG8_SCHED;
            PG8_LDB(B1, 0, 1); PG8_STAGE(PG8_SB(0, 0), b2, voffB);
            PG8_BAR; PG8_WAIT_L(0); PG8_MMA(0, 1, At, B1); PG8_BAR;
            PG8_LDA(At, 0, 1); PG8_STAGE(PG8_SA(0, 0), a2, voffA);
            PG8_BAR; PG8_WAIT_L(0); PG8_MMA(1, 0, At, B0); PG8_BAR; PG8_SCHED;
            PG8_STAGE(PG8_SB(0, 1), b2 + hstep, voffB);
            PG8_WAIT_V(6); PG8_BAR; PG8_MMA(1, 1, At, B1); PG8_BAR;
            PG8_LDB(B0, 1, 0); PG8_SCHED; PG8_LDA(At, 1, 0); PG8_STAGE(PG8_SA(0, 1), a2 + hstep, voffA);
            PG8_WAIT_L(8); PG8_BAR; PG8_WAIT_L(0); PG8_MMA(0, 0, At, B0); PG8_BAR; PG8_SCHED;
            PG8_LDB(B1, 1, 1); PG8_STAGE(PG8_SB(1, 0), b3, voffB);
            PG8_BAR; PG8_WAIT_L(0); PG8_MMA(0, 1, At, B1); PG8_BAR;
            PG8_LDA(At, 1, 1); PG8_STAGE(PG8_SA(1, 0), a3, voffA);
            PG8_BAR; PG8_WAIT_L(0); PG8_MMA(1, 0, At, B0); PG8_BAR; PG8_SCHED;
            PG8_STAGE(PG8_SB(1, 1), b3 + hstep, voffB);
            PG8_WAIT_V(6); PG8_BAR; PG8_MMA(1, 1, At, B1); PG8_BAR;
            }
        }
        if constexpr (FP8) asm volatile("s_nop 15\n\ts_nop 15" ::: "memory");
        if constexpr (ALIGN_EPI) { if (wr == 0) PG8_BAR; }
        if constexpr (!Epi::AFTER_DRAIN) { E(acc, cur, wr, wc, fr, fq); S.done(cur); }
        if (!has_next) break;
#pragma unroll
        for (int a = 0; a < 2; ++a)
#pragma unroll
            for (int b = 0; b < 2; ++b)
#pragma unroll
                for (int m = 0; m < 4; ++m)
#pragma unroll
                    for (int n = 0; n < 2; ++n) acc[a][b][m][n] = (f32x4){0.f, 0.f, 0.f, 0.f};
        cur = nxt; cA = nA; cB = nB; ++ui;
        if constexpr (ALIGN_EPI) { if (wr == 1) PG8_BAR; }
    }
    PG8_WAIT_V(0);
    if constexpr (!ALIGN_EPI) { if (wr == 0) PG8_BAR; }
    PG8_BAR;
    if constexpr (Epi::AFTER_DRAIN) { E.fused(acc, cur, wr, wc, fr, fq, lds, wid, lane); S.done(cur); }
#undef PG8_SA
#undef PG8_SB
#undef PG8_STAGE
#undef PG8_LDA
#undef PG8_LD8
#undef PG8_LDB
#undef PG8_MMA
#undef PG8_WAIT_V
#undef PG8_WAIT_L
#undef PG8_BAR
#undef PG8_SCHED
}
}


namespace att {
#define ALAS __attribute__((address_space(3)))
typedef unsigned short bf16;
typedef short bf16x8 __attribute__((ext_vector_type(8)));
typedef short s16x4 __attribute__((ext_vector_type(4)));
typedef float f32x16 __attribute__((ext_vector_type(16)));
typedef float f32x4 __attribute__((ext_vector_type(4)));
typedef float f32x2 __attribute__((ext_vector_type(2)));
typedef unsigned u32x4 __attribute__((ext_vector_type(4)));
typedef __bf16 bf16x2_t __attribute__((ext_vector_type(2)));
constexpr int SEQ = 4096;
constexpr int VPITCH = 144;
constexpr float LOG2E = 1.4426950408889634f, LN2 = 0.6931471805599453f;
__device__ __forceinline__ unsigned pkbf(float lo, float hi) { f32x2 v = {lo, hi}; bf16x2_t b = __builtin_convertvector(v, bf16x2_t); return __builtin_bit_cast(unsigned, b); }
__device__ __forceinline__ void wave_lds_sync() { asm volatile("s_waitcnt lgkmcnt(0)" ::: "memory"); }
__device__ __forceinline__ s16x4 vtr(const ALAS unsigned char* p) { return __builtin_bit_cast(s16x4, __builtin_amdgcn_ds_read_tr16_b64_v4i16((ALAS s16x4*)p)); }
__device__ __forceinline__ int crow(int r, int hi) { return (r & 3) + 8 * (r >> 2) + 4 * hi; }

__device__ __forceinline__ void pv_tile(f32x16& o0, f32x16& o1, const float (&a)[16], const ALAS unsigned char* vt, int lane) {
    const int g = lane >> 4, i = lane & 15, q_ = i >> 2, p_ = i & 3, h = lane >> 5;
    const ALAS unsigned char* vb = vt + (8 * h + q_) * VPITCH + (16 * (g & 1) + 4 * p_) * 2;
    u32x4 pw0, pw1;
    pw0.x = pkbf(a[0], a[1]); pw0.y = pkbf(a[2], a[3]); pw0.z = pkbf(a[4], a[5]); pw0.w = pkbf(a[6], a[7]);
    pw1.x = pkbf(a[8], a[9]); pw1.y = pkbf(a[10], a[11]); pw1.z = pkbf(a[12], a[13]); pw1.w = pkbf(a[14], a[15]);
    const bf16x8 pa0 = __builtin_bit_cast(bf16x8, pw0), pa1 = __builtin_bit_cast(bf16x8, pw1);
#pragma unroll
    for (int s = 0; s < 2; ++s) {
        const s16x4 l0 = vtr(vb + (16 * s) * VPITCH), h0 = vtr(vb + (16 * s + 4) * VPITCH);
        const s16x4 l1 = vtr(vb + (16 * s) * VPITCH + 64), h1 = vtr(vb + (16 * s + 4) * VPITCH + 64);
        const bf16x8 v0 = (bf16x8){l0[0], l0[1], l0[2], l0[3], h0[0], h0[1], h0[2], h0[3]};
        const bf16x8 v1 = (bf16x8){l1[0], l1[1], l1[2], l1[3], h1[0], h1[1], h1[2], h1[3]};
        o0 = __builtin_amdgcn_mfma_f32_32x32x16_bf16(s ? pa1 : pa0, v0, o0, 0, 0, 0);
        o1 = __builtin_amdgcn_mfma_f32_32x32x16_bf16(s ? pa1 : pa0, v1, o1, 0, 0, 0);
    }
}
__device__ __forceinline__ void bcast_rows(float v, ALAS float* sc, int r32, int hi, float (&out)[16]) {
    if (hi == 0) sc[r32] = v;
    wave_lds_sync();
#pragma unroll
    for (int g = 0; g < 4; ++g) { const f32x4 t = *(const ALAS f32x4*)(sc + 8 * g + 4 * hi); out[4 * g] = t[0]; out[4 * g + 1] = t[1]; out[4 * g + 2] = t[2]; out[4 * g + 3] = t[3]; }
    wave_lds_sync();
}
__device__ __forceinline__ void store_o(const f32x16& o0, const f32x16& o1, ALAS unsigned char* stg, bf16* dst  , size_t rstride_elems, int lane) {
    const int r32 = lane & 31, hi = lane >> 5;
    wave_lds_sync();
#pragma unroll
    for (int r = 0; r < 16; ++r) { const int q = crow(r, hi);
        *(ALAS unsigned short*)(stg + q * VPITCH + r32 * 2) = (unsigned short)(pkbf(o0[r], 0.f) & 0xffffu);
        *(ALAS unsigned short*)(stg + q * VPITCH + 64 + r32 * 2) = (unsigned short)(pkbf(o1[r], 0.f) & 0xffffu); }
    wave_lds_sync();
#pragma unroll
    for (int i = 0; i < 4; ++i) { const int row = 8 * i + (lane >> 3), ch = lane & 7; const u32x4 v = *(const ALAS u32x4*)(stg + row * VPITCH + ch * 16); *(u32x4*)(dst + (size_t)row * rstride_elems + ch * 8) = v; }
    wave_lds_sync();
}

__device__ __forceinline__ void sb_item(const bf16* QS, const bf16* KS, const bf16* VS, bf16* OC, int b, int h, int qt, ALAS unsigned char* wl, int lane) {
    const int r32 = lane & 31, hi = lane >> 5;
    const int t0 = qt * 32; const size_t rowb = (size_t)b * SEQ;
    const int kperm = (r32 & ~12) | ((r32 & 4) << 1) | ((r32 & 8) >> 1);
    bf16x8 qf[4];
    { const bf16* qp = QS + (rowb + t0 + r32) * 512 + h * 64 + hi * 8;
#pragma unroll
      for (int d0 = 0; d0 < 4; ++d0) qf[d0] = *(const bf16x8*)(qp + d0 * 16); }
    f32x16 o0 = {}, o1 = {}; float R = 0.f;
    for (int key0 = t0; key0 >= 0; key0 -= 32) {
        const bf16* kp = KS + (rowb + key0 + kperm) * 512 + h * 64 + hi * 8;
        bf16x8 kf[4];
#pragma unroll
        for (int d0 = 0; d0 < 4; ++d0) kf[d0] = *(const bf16x8*)(kp + d0 * 16);
        u32x4 vv[4];
#pragma unroll
        for (int i = 0; i < 4; ++i) vv[i] = *(const u32x4*)(VS + (rowb + key0 + 8 * i + (lane >> 3)) * 512 + h * 64 + (lane & 7) * 8);
        f32x16 p = {};
#pragma unroll
        for (int d0 = 0; d0 < 4; ++d0) p = __builtin_amdgcn_mfma_f32_32x32x16_bf16(kf[d0], qf[d0], p, 0, 0, 0);
#pragma unroll
        for (int i = 0; i < 4; ++i) *(ALAS u32x4*)(wl + (8 * i + (lane >> 3)) * VPITCH + (lane & 7) * 16) = vv[i];
        const bool diag = (key0 == t0);
        float z2[16], L2[16];
#pragma unroll
        for (int r = 0; r < 16; ++r) { const int kk = (r & 7) + 8 * hi + 16 * (r >> 3); const float zz = p[r];
            const float sp = fmaxf(zz, 0.f) + __builtin_amdgcn_logf(1.0f + __builtin_amdgcn_exp2f(-fabsf(zz)));
            const bool valid = !diag || (kk < r32); z2[r] = zz; L2[r] = valid ? sp : 0.f; }
        float c[16];
        c[15] = L2[15];
#pragma unroll
        for (int r = 14; r >= 8; --r) c[r] = c[r + 1] + L2[r];
        c[7] = L2[7];
#pragma unroll
        for (int r = 6; r >= 0; --r) c[r] = c[r + 1] + L2[r];
        const float TB = c[8], TA = c[0];
        const float TBo = __shfl_xor(TB, 32), TAo = __shfl_xor(TA, 32);
        const float offB = R + (hi ? 0.f : TBo);
        const float offA = R + TB + TBo + (hi ? 0.f : TAo);
        float a[16];
#pragma unroll
        for (int r = 0; r < 16; ++r) { const int kk = (r & 7) + 8 * hi + 16 * (r >> 3); const bool valid = !diag || (kk < r32);
            const float e = __builtin_amdgcn_exp2f(z2[r] - (c[r] + (r < 8 ? offA : offB))); a[r] = valid ? e : 0.f; }
        R += (TA + TB) + (TAo + TBo);
        wave_lds_sync();
        pv_tile(o0, o1, a, wl, lane);
        wave_lds_sync();
        if (__all(R > 40.0f * LOG2E)) break;
    }
    store_o(o0, o1, wl, OC + (rowb + t0) * 768 + h * 64, 768, lane);
}

constexpr int DLU_WAVE = 5120;
constexpr int DLU_O = 8 * DLU_WAVE, DLU_M = DLU_O + 512 * 128, DLU_L = DLU_M + 2048, DLU_BYTES = DLU_L + 2048;
__device__ __forceinline__ void dl_unit(const bf16* QD, const bf16* KD, const bf16* VD, bf16* OC, int b, int j, int blk, ALAS unsigned char* lds, int wave, int lane) {
    const int r32 = lane & 31, hi = lane >> 5;
    const size_t rowb = (size_t)b * SEQ;
    const int t0 = 512 * blk;
    const int kperm = (r32 & ~12) | ((r32 & 4) << 1) | ((r32 & 8) >> 1);
    ALAS unsigned char* wl = lds + wave * DLU_WAVE;
    ALAS float* sc = (ALAS float*)(wl + 4608);
    ALAS unsigned short* OL = (ALAS unsigned short*)(lds + DLU_O);
    ALAS float* ML = (ALAS float*)(lds + DLU_M); ALAS float* LL = (ALAS float*)(lds + DLU_L);
    for (int g = 2; g >= 0; --g) {
        const int hh = 4 * g + j, sh = 2 * g, r = 1 << sh;
        const float slope2 = __builtin_amdgcn_exp2f(-8.0f * (float)(hh + 1) / 12.0f) * LOG2E;
        const float sr = slope2 * (float)r;
        for (int it = wave; it < 16; it += 8) {
            const int q0 = g == 2 ? it : g == 1 ? (it & 3) + 128 * (it >> 2) : 32 * it;
            const int tq = t0 + q0 + r * r32, tmax = t0 + q0 + 31 * r;
            bf16x8 qf[4];
            { const bf16* qp = QD + (rowb + tq) * 768 + hh * 64 + hi * 8;
#pragma unroll
              for (int d0 = 0; d0 < 4; ++d0) qf[d0] = *(const bf16x8*)(qp + d0 * 16); }
            const int klo = 31 - r32; int khi = klo + 128; { const int kmaxtok = tmax >> sh; khi = khi < kmaxtok ? khi : kmaxtok; }
            const unsigned krange = (unsigned)(khi - klo);
            f32x16 o0 = {}, o1 = {}; float mrun = -3.0e38f, lrun = 0.f;
            if (g != 2) {
                mrun = ML[q0 + r * r32]; lrun = hi ? 0.f : LL[q0 + r * r32];
#pragma unroll
                for (int q = 0; q < 16; ++q) { const int tl = q0 + r * crow(q, hi);
                    o0[q] = __uint_as_float((unsigned)OL[tl * 64 + r32] << 16); o1[q] = __uint_as_float((unsigned)OL[tl * 64 + 32 + r32] << 16); }
            }
            for (int kt = 0; kt < 5; ++kt) {
                int sk = tmax - r * (32 * kt + kperm); sk = sk < 0 ? 0 : sk;
                const bf16* kp = KD + (rowb + sk) * 768 + hh * 64 + hi * 8;
                bf16x8 kf[4];
#pragma unroll
                for (int d0 = 0; d0 < 4; ++d0) kf[d0] = *(const bf16x8*)(kp + d0 * 16);
                u32x4 vv[4];
#pragma unroll
                for (int i = 0; i < 4; ++i) { int sv = tmax - r * (32 * kt + 8 * i + (lane >> 3)); sv = sv < 0 ? 0 : sv; vv[i] = *(const u32x4*)(VD + (rowb + sv) * 768 + hh * 64 + (lane & 7) * 8); }
                const int dk = 32 * kt + 8 * hi - klo;
                const float tb = -sr * (float)dk;
                f32x16 p;
#pragma unroll
                for (int q = 0; q < 16; ++q) p[q] = tb - sr * (float)((q & 7) + 16 * (q >> 3));
#pragma unroll
                for (int d0 = 0; d0 < 4; ++d0) p = __builtin_amdgcn_mfma_f32_32x32x16_bf16(kf[d0], qf[d0], p, 0, 0, 0);
#pragma unroll
                for (int i = 0; i < 4; ++i) *(ALAS u32x4*)(wl + (8 * i + (lane >> 3)) * VPITCH + (lane & 7) * 16) = vv[i];
                float z2[16]; float mt = -3.0e38f;
#pragma unroll
                for (int q = 0; q < 16; ++q) { const bool valid = (unsigned)(dk + ((q & 7) + 16 * (q >> 3))) <= krange; z2[q] = valid ? p[q] : -INFINITY; mt = fmaxf(mt, z2[q]); }
                mt = fmaxf(mt, __shfl_xor(mt, 32));
                if (__any(mt > mrun + 8.0f)) {
                    const float mnew = fmaxf(mrun, mt); const float alpha = __builtin_amdgcn_exp2f(mrun - mnew);
                    lrun *= alpha; float al[16]; bcast_rows(alpha, sc, r32, hi, al);
#pragma unroll
                    for (int q = 0; q < 16; ++q) { o0[q] *= al[q]; o1[q] *= al[q]; }
                    mrun = mnew;
                }
                float a[16]; float ls = 0.f;
#pragma unroll
                for (int q = 0; q < 16; ++q) { a[q] = __builtin_amdgcn_exp2f(z2[q] - mrun); ls += a[q]; }
                lrun += ls;
                wave_lds_sync();
                pv_tile(o0, o1, a, wl, lane);
                wave_lds_sync();
            }
            const float ltot = lrun + __shfl_xor(lrun, 32);
            if (g != 0) {
                if (hi == 0) { ML[q0 + r * r32] = mrun; LL[q0 + r * r32] = ltot; }
#pragma unroll
                for (int q = 0; q < 16; ++q) { const int tl = q0 + r * crow(q, hi);
                    OL[tl * 64 + r32] = (unsigned short)(pkbf(o0[q], 0.f) & 0xffffu); OL[tl * 64 + 32 + r32] = (unsigned short)(pkbf(o1[q], 0.f) & 0xffffu); }
            } else {
                float il[16]; bcast_rows(1.0f / ltot, sc, r32, hi, il);
#pragma unroll
                for (int q = 0; q < 16; ++q) { o0[q] *= il[q]; o1[q] *= il[q]; }
                store_o(o0, o1, wl, OC + (rowb + t0 + q0) * 768 + 512 + j * 64, 768, lane);
            }
        }
        asm volatile("s_waitcnt lgkmcnt(0)" ::: "memory"); __builtin_amdgcn_s_barrier(); asm volatile("" ::: "memory");
    }
}
#undef ALAS
}

constexpr int NWAVES = 8;
#ifndef MK_N_LAUNCHES
#define MK_N_LAUNCHES 1
#endif
#ifndef MK_LAST_PHASE
#define MK_LAST_PHASE 8
#endif
constexpr int N_LAUNCHES = MK_N_LAUNCHES;
constexpr int PER_PHASE = 8;

constexpr int BATCH = 16, SEQ = 4096, D = 1024, T = BATCH * SEQ;
constexpr int N1 = 5888;
constexpr int NEXP = 16384;
constexpr size_t MiB = 1u << 20;
constexpr size_t WS_CTL = 0, CTL_ZERO_BYTES = 1 * MiB;
constexpr size_t WS_WIN = 2 * MiB;
constexpr size_t WS_WCAT = 16 * MiB;
constexpr size_t WS_WOUT = 18 * MiB;
constexpr size_t WS_WC = 20 * MiB;
constexpr size_t WS_RINV1 = 24 * MiB;
constexpr size_t WS_RINV2 = 25 * MiB;
constexpr size_t WS_USC = 25 * MiB + 512 * 1024, WS_VSC = 25 * MiB + 768 * 1024;
constexpr size_t WS_SSQ = 26 * MiB;
constexpr size_t WS_U8 = 32 * MiB;
constexpr size_t WS_V8 = 64 * MiB;
constexpr size_t WS_IDS = 96 * MiB;
constexpr size_t WS_GW = 112 * MiB;
constexpr size_t WS_XB = 144 * MiB;
constexpr size_t WS_OC = 880 * MiB;
constexpr size_t WS_QS = 272 * MiB, WS_KS = 336 * MiB, WS_VS = 400 * MiB;
constexpr size_t WS_QD = 464 * MiB, WS_KD = 560 * MiB, WS_VD = 656 * MiB;
constexpr size_t WS_GT = 752 * MiB;
constexpr size_t WS_COEF = 272 * MiB;
constexpr size_t WS_MIX = 272 * MiB;
constexpr size_t WS_X1B = 400 * MiB;
constexpr size_t WS_HQ = 528 * MiB;
constexpr size_t WS_HS2 = 24 * MiB + 512 * 1024;
constexpr size_t WS_XB8 = 72 * MiB;
constexpr size_t WS_WG8 = 40 * MiB;
constexpr size_t WS_PART = 56 * MiB;
constexpr size_t WS_RMAXF = 24 * MiB + 768 * 1024;
constexpr size_t WS_WOS = 46 * MiB + 512 * 1024;
constexpr size_t WS_WCS = 46 * MiB;
constexpr size_t WS_WCF = 48 * MiB;
constexpr size_t WS_XS = 24 * MiB + 256 * 1024;
constexpr size_t WS_GCS = 47 * MiB;
constexpr size_t WS_END = 1008 * MiB;
constexpr int CW_BAR = 4096;
constexpr int CW_OMAX = 28672;
constexpr int CW_RMAX = 65536;
constexpr int CW_RCNT = 131072;
constexpr int CW_WMAX = 24576;
constexpr int CW_GMAX = 16384;
constexpr int CW_XRANK = 8192;

constexpr int RING_OFF = 0, RING_BYTES = 131072;
constexpr int LDSCTL_OFF = 143360, MISC_OFF = LDSCTL_OFF + 320;
constexpr int LDS_BYTES = 147456;
static_assert(MISC_OFF + 128 <= LDS_BYTES, "LDS map");
#define GAS __attribute__((address_space(1)))
#define LAS __attribute__((address_space(3)))
typedef unsigned short bf16;
typedef unsigned v4u __attribute__((ext_vector_type(4)));
typedef float f32x4 __attribute__((ext_vector_type(4)));
typedef short bf16x8 __attribute__((ext_vector_type(8)));
typedef GAS unsigned gu32;
typedef GAS unsigned long long gu64;
#define RLX_AGENT __ATOMIC_RELAXED, __HIP_MEMORY_SCOPE_AGENT
#define LDS_WAIT() asm volatile("s_waitcnt lgkmcnt(0)" ::: "memory")
#define VM_WAIT() asm volatile("s_waitcnt vmcnt(0)" ::: "memory")
__device__ __forceinline__ unsigned long long rt() { return __builtin_amdgcn_s_memrealtime(); }
__device__ __forceinline__ unsigned f2bf(float f) { unsigned u = __builtin_bit_cast(unsigned, f); return (u + 0x7fffu + ((u >> 16) & 1u)) >> 16; }
__device__ __forceinline__ unsigned pk2(float lo, float hi) { return f2bf(lo) | (f2bf(hi) << 16); }

#define XB_TMO      128
#define XB_XCNT(j)  (256  + 64 * (j))
#define XB_XSUB(j)  (1280 + 64 * (j))
#define XB_XGEN(j)  (2304 + 64 * (j))
#define XB_TOP      3328
#define XB_TOPGEN   3392
#define XCD_BAR_WORDS 3456
#define XB_SPIN_CAP (1u << 18)

__device__ __forceinline__ unsigned xb_ld(unsigned* p)              { return __hip_atomic_load(p, __ATOMIC_RELAXED, __HIP_MEMORY_SCOPE_AGENT); }
__device__ __forceinline__ unsigned xb_add(unsigned* p, unsigned v) { return __hip_atomic_fetch_add(p, v, __ATOMIC_RELAXED, __HIP_MEMORY_SCOPE_AGENT); }
__device__ __forceinline__ unsigned xb_xcc_id() { return (unsigned)__builtin_amdgcn_s_getreg((3 << 11) | 20) & 0xFu; }
#define XB_SPIN(cond, bar) do { unsigned _sp = 0; while (cond) { __builtin_amdgcn_s_sleep(1); \
    if ((++_sp & 255u) == 0u) { if (xb_ld(&(bar)[XB_TMO])) break; if (_sp > XB_SPIN_CAP) { atomicAdd(&(bar)[XB_TMO], 1u); break; } } } } while (0)

struct XcdBarrier {
    unsigned* bar; unsigned x;
    volatile LAS unsigned* st;
};

__device__ __forceinline__ XcdBarrier xcd_barrier_post(unsigned* bar, volatile LAS unsigned* st) {
    XcdBarrier b; b.bar = bar; b.x = xb_xcc_id(); b.st = st;
    if (threadIdx.x == 0) (void)xb_add(&bar[XB_XCNT(b.x)], 1u);
    return b;
}
__device__ __forceinline__ void xcd_barrier_complete(unsigned* bar, unsigned x, unsigned& nloc, unsigned& nx) {
    const unsigned G = gridDim.x * gridDim.y * gridDim.z;
    unsigned sum, cnt, mine, sp = 0u;
    for (;;) {
        sum = 0u; cnt = 0u; mine = 0u;
#pragma unroll
        for (unsigned j = 0; j < 16; ++j) { const unsigned c = xb_ld(&bar[XB_XCNT(j)]); sum += c; cnt += (c > 0u) ? 1u : 0u; mine = (j == x) ? c : mine; }
        if (sum == G) break;
        __builtin_amdgcn_s_sleep(1);
        if ((++sp & 255u) == 0u) { if (xb_ld(&bar[XB_TMO])) break; if (sp > XB_SPIN_CAP) { atomicAdd(&bar[XB_TMO], 1u); break; } }
    }
    nloc = mine > 0u ? mine : 1u; nx = cnt > 0u ? cnt : 1u;
}

__device__ __forceinline__ void xcd_barrier(const XcdBarrier& b) {
    asm volatile("s_waitcnt vmcnt(0)" ::: "memory");
    __syncthreads();
    if (threadIdx.x == 0) {
        unsigned* bar = b.bar;
        __builtin_amdgcn_s_waitcnt(0);
        unsigned nloc = b.st[0], nx = b.st[1];
        if (nloc == 0u) { xcd_barrier_complete(bar, b.x, nloc, nx); b.st[0] = nloc; b.st[1] = nx; }
        const unsigned old = xb_add(&bar[XB_XSUB(b.x)], 1u);
        const unsigned gen = old / nloc;
        if (old + 1u == (gen + 1u) * nloc) {
            __builtin_amdgcn_fence(__ATOMIC_RELEASE, "agent");
            asm volatile("s_waitcnt vmcnt(0)" ::: "memory");
            const unsigned og = xb_add(&bar[XB_TOP], 1u);
            const unsigned tg = og / nx;
            if (og + 1u == (tg + 1u) * nx) xb_add(&bar[XB_TOPGEN], 1u);
            else XB_SPIN(xb_ld(&bar[XB_TOPGEN]) == tg, bar);
            __builtin_amdgcn_fence(__ATOMIC_ACQUIRE, "agent");
            xb_add(&bar[XB_XGEN(b.x)], 1u);
            asm volatile("s_waitcnt vmcnt(0)" ::: "memory");
        } else {
            XB_SPIN(xb_ld(&bar[XB_XGEN(b.x)]) == gen, bar);
            __builtin_amdgcn_fence(__ATOMIC_ACQUIRE, "agent");
            asm volatile("s_waitcnt vmcnt(0)" ::: "memory");
        }
    }
    __syncthreads();
}

typedef float f32x2 __attribute__((ext_vector_type(2)));
typedef unsigned v2u __attribute__((ext_vector_type(2)));
typedef _Float16 h2_t __attribute__((ext_vector_type(2)));
struct Frame {
    LAS unsigned char* lds;
    volatile LAS unsigned* MISC;
    gu32* ctl;
    int tid, lane, wave;
    int vcu, G;
};
__device__ __forceinline__ float wave_sum(float v) {
#pragma unroll
    for (int o = 1; o < 64; o <<= 1) v += __shfl_xor(v, o);
    return v;
}
__device__ __forceinline__ float wave_max(float v) {
#pragma unroll
    for (int o = 1; o < 64; o <<= 1) v = fmaxf(v, __shfl_xor(v, o));
    return v;
}
constexpr int NB16 = 0, N8 = 5888 - NB16;
__device__ __forceinline__ int win_row(int n) { if (n < 1536 || n >= 3072) return n; const int t = (n - 1536) >> 8, ln = (n - 1536) & 255, hl = ln >> 6, d = ln & 63; return 1536 + t * 256 + 32 * hl + (d & 31) + 128 * (d >> 5); }
__device__ __forceinline__ void p0_transpose_item(const float* W, int N, const float* gain, bf16* WT, int ldt, int koff, int mode, LAS float* scr, int item, int lane) {
    const int nblk = N / 32, kb = item / nblk, nb = item % nblk, k0 = 64 * kb, n0 = 32 * nb;
#pragma unroll 8
    for (int i = 0; i < 32; ++i) { const int kk = 2 * i + (lane >> 5); float v = W[(size_t)(k0 + kk) * N + n0 + (lane & 31)]; if (gain) v *= gain[k0 + kk]; scr[kk * 33 + (lane & 31)] = v; }
    LDS_WAIT(); asm volatile("" ::: "memory");
    const int c = lane & 7;
#pragma unroll
    for (int j = 0; j < 4; ++j) { const int n = (lane >> 3) + 8 * j; const LAS float* s = scr + (8 * c) * 33 + n;
        v4u o; o.x = pk2(s[0 * 33], s[1 * 33]); o.y = pk2(s[2 * 33], s[3 * 33]); o.z = pk2(s[4 * 33], s[5 * 33]); o.w = pk2(s[6 * 33], s[7 * 33]);
        const int rown = mode ? win_row(n0 + n) : (n0 + n);
        *(GAS v4u*)(WT + (size_t)rown * ldt + koff + k0 + 8 * c) = o; }
    LDS_WAIT(); asm volatile("" ::: "memory");
}
__device__ __forceinline__ void p0_gate_max_item(const float* W, int N, const float* gain, unsigned* gmax, int kb, int n0, int lane) {
    const int k0 = 64 * kb; float am = 0.f;
#pragma unroll 8
    for (int i = 0; i < 32; ++i) { const int kk = 2 * i + (lane >> 5); am = fmaxf(am, fabsf(W[(size_t)(k0 + kk) * N + n0 + (lane & 31)] * (gain ? gain[k0 + kk] : 1.0f))); }
    am = fmaxf(am, __shfl_xor(am, 32));
    if (lane < 32) atomicMax(gmax + (n0 - NB16) + lane, __float_as_uint(am));
}
__device__ __forceinline__ void p0_gate_fp8_item(const float* W, int N, const float* gain, const unsigned* gmax, unsigned char* WG, float* cs, LAS float* scr, int item, int lane, int ncols = N8, bool perm = true) {
    const int kb = item / (ncols / 32), nb = item % (ncols / 32), k0 = 64 * kb, n0 = 32 * nb;
#pragma unroll 8
    for (int i = 0; i < 32; ++i) { const int kk = 2 * i + (lane >> 5); scr[kk * 33 + (lane & 31)] = W[(size_t)(k0 + kk) * N + NB16 + n0 + (lane & 31)] * (gain ? gain[k0 + kk] : 1.0f); }
    LDS_WAIT(); asm volatile("" ::: "memory");
    const int c = lane & 7;
#pragma unroll
    for (int j = 0; j < 4; ++j) { const int n = (lane >> 3) + 8 * j; const LAS float* sp = scr + (8 * c) * 33 + n;
        const float am = __uint_as_float(xb_ld((unsigned*)gmax + n0 + n)); const float sc = am > 0.f ? 127.0f / am : 0.f;
        unsigned p0 = 0, p1 = 0;
#pragma unroll
        for (int e = 0; e < 4; ++e) { p0 |= ((unsigned)(int)__builtin_rintf(sp[e * 33] * sc) & 0xffu) << (8 * e); p1 |= ((unsigned)(int)__builtin_rintf(sp[(4 + e) * 33] * sc) & 0xffu) << (8 * e); }
        const int prow = perm ? win_row(NB16 + n0 + n) - NB16 : n0 + n;
        *(GAS v2u*)(WG + (size_t)prow * 1024 + k0 + 8 * c) = (v2u){p0, p1};
        if (kb == 0 && c == 0) cs[prow] = am * (1.0f / 127.0f); }
    LDS_WAIT(); asm volatile("" ::: "memory");
}
__device__ __forceinline__ void quant_row_fp8(const float* src, const float* gain, unsigned char* dst, size_t slice_stride, float* scale_out, int lane) {
    f32x4 v[4]; float am = 0.f;
#pragma unroll
    for (int j = 0; j < 4; ++j) { v[j] = *(const GAS f32x4*)(src + 256 * j + 4 * lane); if (gain) v[j] = v[j] * *(const GAS f32x4*)(gain + 256 * j + 4 * lane);
        am = fmaxf(am, fmaxf(fmaxf(fabsf(v[j][0]), fabsf(v[j][1])), fmaxf(fabsf(v[j][2]), fabsf(v[j][3])))); }
    am = wave_max(am);
    const int ex = (int)((__float_as_uint(am) >> 23) & 0xffu);
    const float s = (ex == 0) ? 1.0f : __uint_as_float((unsigned)(127 + 7 - (ex - 127)) << 23);
    const float is = (ex == 0) ? 1.0f : __uint_as_float((unsigned)(127 - 7 + (ex - 127)) << 23);
    if (lane == 0) *scale_out = is;
#pragma unroll
    for (int j = 0; j < 4; ++j) { int pk = __builtin_amdgcn_cvt_pk_fp8_f32(v[j][0] * s, v[j][1] * s, 0, false); pk = __builtin_amdgcn_cvt_pk_fp8_f32(v[j][2] * s, v[j][3] * s, pk, true);
        const int col = 256 * j + 4 * lane; *(GAS int*)(dst + (size_t)(col >> 7) * slice_stride + (col & 127)) = pk; }
}
__device__ __forceinline__ void quant_row_fp4(const float* src, unsigned char* dst, size_t slice_stride, float* scale_out, int lane) {
    f32x4 v[4]; float am = 0.f;
#pragma unroll
    for (int j = 0; j < 4; ++j) { v[j] = *(const GAS f32x4*)(src + 256 * j + 4 * lane); am = fmaxf(am, fmaxf(fmaxf(fabsf(v[j][0]), fabsf(v[j][1])), fmaxf(fabsf(v[j][2]), fabsf(v[j][3])))); }
    am = wave_max(am);
    const float s = am > 0.f ? 6.0f / am : 0.f;
    if (lane == 0) *scale_out = am * (1.0f / 6.0f);
#pragma unroll
    for (int j = 0; j < 4; ++j) { unsigned pk = __builtin_amdgcn_cvt_scalef32_pk_fp4_f32(0u, v[j][0] * s, v[j][1] * s, 1.0f, 0); pk = __builtin_amdgcn_cvt_scalef32_pk_fp4_f32(pk, v[j][2] * s, v[j][3] * s, 1.0f, 1);
        *(GAS unsigned short*)(dst + (size_t)j * slice_stride + 2 * lane) = (unsigned short)(pk & 0xffffu); }
}
__device__ __forceinline__ void quant_row_i4(const float* src, const float* gain, unsigned char* dst, float* scale_out, int lane) {
    f32x4 v[4]; float am = 0.f, ss = 0.f;
    const int p16 = (lane >> 2) & 15, wl = lane & 3;
#pragma unroll
    for (int ld = 0; ld < 2; ++ld)
#pragma unroll
        for (int sn = 0; sn < 2; ++sn) { const int hd = 2 * (4 * ld + wl) + sn; const int idx = 256 * (hd >> 2) + 16 * p16 + 4 * (hd & 3);
            f32x4 t = *(const GAS f32x4*)(src + idx); if (gain) t = t * *(const GAS f32x4*)(gain + idx); v[2 * ld + sn] = t;
            am = fmaxf(am, fmaxf(fmaxf(fabsf(t[0]), fabsf(t[1])), fmaxf(fabsf(t[2]), fabsf(t[3])))); ss += (t[0] * t[0] + t[1] * t[1]) + (t[2] * t[2] + t[3] * t[3]); }
    am = wave_max(am); ss = wave_sum(ss);
    const float clipv = fminf(am, 2.5f * sqrtf(ss * (1.0f / 1024.0f)));
    const float s = clipv > 0.f ? 7.0f / clipv : 0.f;
    if (lane == 0) *scale_out = clipv * (1.0f / (7.0f * 16.0f));
#pragma unroll
    for (int ld = 0; ld < 2; ++ld) { unsigned pk = 0u;
#pragma unroll
        for (int b4 = 0; b4 < 4; ++b4) { int q0 = (int)__builtin_rintf(v[2 * ld][b4] * s), q1 = (int)__builtin_rintf(v[2 * ld + 1][b4] * s);
            q0 = q0 < -7 ? -7 : (q0 > 7 ? 7 : q0); q1 = q1 < -7 ? -7 : (q1 > 7 ? 7 : q1);
            pk |= ((unsigned)(q0 & 15) | ((unsigned)(q1 & 15) << 4)) << (8 * b4); }
        *(GAS unsigned*)(dst + ld * 256 + 16 * p16 + 4 * wl) = pk; }
}
__device__ __forceinline__ float gelu_f(float v) {
    const float av = fabsf(v), t = __builtin_amdgcn_rcpf(av * 0.2316418882f + 1.0f);
    float q = t * 0.5307027145f + (-0.7265760135f); q = q * t + 0.7107068705f; q = q * t + (-0.142248368f); q = q * t + 0.127414796f; q = q * t;
    const float e = __builtin_amdgcn_exp2f((v * v) * (-0.72134752044f));
    const float m = v * (q * e);
    return v < 0.f ? m : v - m;
}

struct Args { const float* in[14]; float* out; unsigned char* ws; int ph_lo, ph_hi, li, pad; };
__global__ void __launch_bounds__(NWAVES * 64, 2) fwd_kernel(Args args) {
    extern __shared__ __attribute__((aligned(16))) unsigned char lds[];
    Frame F;
    F.lds = (LAS unsigned char*)lds;
    F.MISC = (volatile LAS unsigned*)(F.lds + MISC_OFF);
    F.tid = threadIdx.x; F.lane = F.tid & 63; F.wave = __builtin_amdgcn_readfirstlane(F.tid >> 6);
    F.G = gridDim.x; { const int bx = blockIdx.x; F.vcu = (F.G % 8 == 0) ? (bx % 8) * (F.G / 8) + bx / 8 : bx; }
    unsigned char* ws = args.ws;
    F.ctl = (gu32*)(ws + WS_CTL);
    const float* x = args.in[0]; const float* norm1_gain = args.in[1]; const float* w_in = args.in[2]; const float* b_gate = args.in[3];
    const float* q_gain = args.in[4]; const float* k_gain = args.in[5]; const float* w_sb_out = args.in[6]; const float* w_dil_out = args.in[7];
    const float* w_out = args.in[8]; const float* norm2_gain = args.in[9]; const float* w_peer_q = args.in[10]; const float* sub_keys = args.in[11];
    const float* peer_u = args.in[12]; const float* peer_v = args.in[13];
    float* out = args.out;
    bf16* WIN = (bf16*)(ws + WS_WIN); bf16* WCAT = (bf16*)(ws + WS_WCAT); bf16* WOUT = (bf16*)(ws + WS_WOUT); bf16* WC = (bf16*)(ws + WS_WC);
    float* RINV1 = (float*)(ws + WS_RINV1); float* RINV2 = (float*)(ws + WS_RINV2); float* USC = (float*)(ws + WS_USC); float* VSC = (float*)(ws + WS_VSC); float* SSQ = (float*)(ws + WS_SSQ);
    unsigned char* U8 = ws + WS_U8; unsigned char* V8 = ws + WS_V8;
    unsigned short* IDS = (unsigned short*)(ws + WS_IDS); float* GW = (float*)(ws + WS_GW); float* COEF = (float*)(ws + WS_COEF); unsigned char* HQ = ws + WS_HQ; unsigned char* WC8 = ws + WS_WC; unsigned char* WOUT8 = ws + WS_WOUT; float* WOS = (float*)(ws + WS_WOS); float* RMAXF = (float*)(ws + WS_RMAXF); unsigned char* MIX8 = ws + WS_MIX; float* WCF = (float*)(ws + WS_WCF); float* WCS = (float*)(ws + WS_WCS); float* HS2 = (float*)(ws + WS_HS2);
    bf16* XB = (bf16*)(ws + WS_XB); bf16* OC = (bf16*)(ws + WS_OC); unsigned char* XB8 = ws + WS_XB8; unsigned char* WG8 = ws + WS_WG8; float* GCS = (float*)(ws + WS_GCS); float* XS = (float*)(ws + WS_XS);
    bf16* QS = (bf16*)(ws + WS_QS); bf16* KS = (bf16*)(ws + WS_KS); bf16* VS = (bf16*)(ws + WS_VS);
    bf16* QD = (bf16*)(ws + WS_QD); bf16* KD = (bf16*)(ws + WS_KD); bf16* VD = (bf16*)(ws + WS_VD);
    unsigned char* GT = ws + WS_GT; bf16* MIX = (bf16*)(ws + WS_MIX); bf16* X1B = (bf16*)(ws + WS_X1B);

    for (int u = F.tid; u < (LDS_BYTES - LDSCTL_OFF) / 4; u += NWAVES * 64) ((LAS unsigned*)(F.lds + LDSCTL_OFF))[u] = 0u;
    __syncthreads();
    const int my_xcc = (int)xb_xcc_id();
    if (F.tid == 0) F.MISC[12] = xb_add((unsigned*)(F.ctl + CW_XRANK) + 64 * my_xcc, 1u);
    __syncthreads();
    const int my_xrank = (int)F.MISC[12];
    const int bli = (N_LAUNCHES == PER_PHASE) ? 0 : args.li;
    XcdBarrier bar; bar.bar = (unsigned*)(F.ctl + CW_BAR) + bli * XCD_BAR_WORDS; bar.x = 0; bar.st = nullptr;
    if (N_LAUNCHES != PER_PHASE) bar = xcd_barrier_post((unsigned*)(F.ctl + CW_BAR) + bli * XCD_BAR_WORDS, F.MISC + 8);
    const int lo = args.ph_lo, hi = args.ph_hi;
#ifndef PHASE_MASK
#define PHASE_MASK 0xff
#endif
#define IN(k) (((PHASE_MASK >> (k)) & 1) && lo <= (k) && (k) < hi)
#define BOTH(k) (IN(k) && IN((k) + 1))
#define GRID_BAR() do { if (N_LAUNCHES != PER_PHASE) xcd_barrier(bar); } while (0)
#ifndef PROBE_REPEAT
#define PROBE_REPEAT 0x00
#endif
#ifndef PROBE_L1
#define PROBE_L1 0x0
#endif
#define REP(k) _Pragma("unroll") for (int rep_ = 0; rep_ < (((PROBE_REPEAT >> (k)) & 1) ? 2 : 1); ++rep_)
    const int gw = F.vcu * NWAVES + F.wave, NGW = F.G * NWAVES;
#define P67_MAP() int vx = (int)(blockIdx.x & 7), rk = (int)(blockIdx.x >> 3), nrk = (F.G + 7 - vx) / 8; bool p67_uni = false; \
        { bool uni_ = (F.G % 8 == 0); for (int j_ = 0; j_ < 16; ++j_) { const unsigned c_ = xb_ld((unsigned*)(F.ctl + CW_XRANK) + 64 * j_); uni_ = uni_ && (c_ == (j_ < 8 ? (unsigned)(F.G / 8) : 0u)); } \
          if (uni_) { vx = my_xcc; rk = my_xrank; nrk = F.G / 8; p67_uni = true; } }

    if (IN(0)) REP(0) {
        for (int it = F.vcu; it < 256; it += F.G) {
            const int hp = it >> 4, d0 = (it & 15) * 64;
            LAS float* As = (LAS float*)(F.lds);
            LAS float* Bs = (LAS float*)(F.lds + 64 * 132 * 4);
            for (int e = F.tid; e < 64 * 32; e += 512) { const int r = e >> 5, c4 = (e & 31) * 4; *(LAS f32x4*)(As + r * 132 + c4) = *(const GAS f32x4*)(w_peer_q + (size_t)(d0 + r) * 2048 + hp * 128 + c4); }
            for (int e = F.tid; e < 128 * 32; e += 512) { const int r = e >> 5, c4 = (e & 31) * 4; *(LAS f32x4*)(Bs + r * 132 + c4) = *(const GAS f32x4*)(sub_keys + ((size_t)hp * 128 + r) * 128 + c4); }
            __syncthreads();
            const int ddg = F.tid & 15, ng = F.tid >> 4;
            f32x4 acc[4];
#pragma unroll
            for (int j = 0; j < 4; ++j) acc[j] = (f32x4){0.f, 0.f, 0.f, 0.f};
            for (int c4 = 0; c4 < 128; c4 += 4) {
                f32x4 a[4], b[4];
#pragma unroll
                for (int i = 0; i < 4; ++i) { a[i] = *(const LAS f32x4*)(As + (4 * ddg + i) * 132 + c4); b[i] = *(const LAS f32x4*)(Bs + (4 * ng + i) * 132 + c4); }
#pragma unroll
                for (int j = 0; j < 4; ++j)
#pragma unroll
                    for (int i = 0; i < 4; ++i) acc[j][i] += (a[i][0] * b[j][0] + a[i][1] * b[j][1]) + (a[i][2] * b[j][2] + a[i][3] * b[j][3]);
            }
            const f32x4 g2 = *(const GAS f32x4*)(norm2_gain + d0 + 4 * ddg);
#pragma unroll
            for (int j = 0; j < 4; ++j) { const f32x4 o = acc[j] * g2;
                *(GAS f32x4*)(WCF + (size_t)(hp * 128 + 4 * ng + j) * 1024 + d0 + 4 * ddg) = o;
                float am = fmaxf(fmaxf(fabsf(o[0]), fabsf(o[1])), fmaxf(fabsf(o[2]), fabsf(o[3])));
                am = fmaxf(am, __shfl_xor(am, 1)); am = fmaxf(am, __shfl_xor(am, 2)); am = fmaxf(am, __shfl_xor(am, 4)); am = fmaxf(am, __shfl_xor(am, 8));
                if (ddg == 0) atomicMax((unsigned*)(F.ctl + CW_WMAX) + hp * 128 + 4 * ng + j, __float_as_uint(am)); }
            __syncthreads();
        }
        {
            LAS float* scr = (LAS float*)(F.lds + RING_OFF + F.wave * 16384);
            constexpr int I_IN = (D / 64) * (N1 / 32), I_SB = (512 / 64) * (D / 32), I_DL = (256 / 64) * (D / 32), I_OUT = (D / 64) * (D / 32);
            constexpr int NITEMS = I_IN + I_SB + I_DL + I_OUT;
            for (int it = gw; it < NITEMS; it += NGW) {
                int r = it;
                if (r < I_IN) { const int nb_ = r % (N1 / 32); p0_gate_max_item(w_in, N1, norm1_gain, (unsigned*)(F.ctl + CW_GMAX), r / (N1 / 32), 32 * nb_, F.lane); continue; } r -= I_IN;
                if (r < I_SB) { p0_transpose_item(w_sb_out, D, nullptr, WCAT, 768, 0, 0, scr, r, F.lane); continue; } r -= I_SB;
                if (r < I_DL) { p0_transpose_item(w_dil_out, D, nullptr, WCAT, 768, 512, 0, scr, r, F.lane); continue; } r -= I_DL;
                p0_gate_max_item(w_out, D, nullptr, (unsigned*)(F.ctl + CW_OMAX), r / (D / 32), 32 * (r % (D / 32)), F.lane);
            }
        }
        for (int e = gw; e < 2 * NEXP; e += NGW) {
            if (e < NEXP) quant_row_i4(peer_u + (size_t)e * D, norm2_gain, U8 + (size_t)e * 512, USC + e, F.lane);
            else { const int ev = e - NEXP; quant_row_fp4(peer_v + (size_t)ev * D, V8 + (size_t)ev * 128, (size_t)NEXP * 128, VSC + ev, F.lane); }
        }
        for (int m = gw; m < T; m += NGW) {
            const GAS f32x4* xr = (const GAS f32x4*)(x + (size_t)m * D) + F.lane;
            f32x4 v[4]; float s = 0.f;
#pragma unroll
            for (int j = 0; j < 4; ++j) { v[j] = xr[64 * j]; s += (v[j][0] * v[j][0] + v[j][1] * v[j][1]) + (v[j][2] * v[j][2] + v[j][3] * v[j][3]); }
            s = wave_sum(s);
            const float rn = __builtin_amdgcn_rsqf(s * (1.0f / D) + 1e-6f);
            if (F.lane == 0) RINV1[m] = 1.0f / rn;
            GAS unsigned long long* o8 = (GAS unsigned long long*)(XB + (size_t)m * D) + F.lane;
#pragma unroll
            for (int j = 0; j < 4; ++j) o8[64 * j] = (unsigned long long)pk2(v[j][0] * rn, v[j][1] * rn) | ((unsigned long long)pk2(v[j][2] * rn, v[j][3] * rn) << 32);
            float am = 0.f;
#pragma unroll
            for (int j = 0; j < 4; ++j) am = fmaxf(am, fmaxf(fmaxf(fabsf(v[j][0]), fabsf(v[j][1])), fmaxf(fabsf(v[j][2]), fabsf(v[j][3]))));
            am = wave_max(am) * rn;
            const float qs = am > 0.f ? 127.0f / am * rn : 0.f;
            if (F.lane == 0) XS[m] = am * (1.0f / 127.0f);
#pragma unroll
            for (int j = 0; j < 4; ++j) { const unsigned pk = ((unsigned)(int)__builtin_rintf(v[j][0] * qs) & 0xffu) | (((unsigned)(int)__builtin_rintf(v[j][1] * qs) & 0xffu) << 8) | (((unsigned)(int)__builtin_rintf(v[j][2] * qs) & 0xffu) << 16) | (((unsigned)(int)__builtin_rintf(v[j][3] * qs) & 0xffu) << 24);
                *(GAS unsigned*)(XB8 + (size_t)m * D + 256 * j + 4 * F.lane) = pk; }
        }
        if (BOTH(0)) GRID_BAR();
    }

    if (IN(1)) REP(1) {
        { LAS float* scr = (LAS float*)(F.lds + RING_OFF + F.wave * 16384);
          for (int it = gw; it < 16 * (N8 / 32); it += NGW) p0_gate_fp8_item(w_in, N1, norm1_gain, (const unsigned*)(F.ctl + CW_GMAX), WG8, GCS, scr, it, F.lane);
          for (int it = gw; it < 16 * (D / 32); it += NGW) p0_gate_fp8_item(w_out, D, nullptr, (const unsigned*)(F.ctl + CW_OMAX), WOUT8, WOS, scr, it, F.lane, D, false);
          for (int r = gw; r < 2048; r += NGW) {
              const float am = __uint_as_float(xb_ld((unsigned*)(F.ctl + CW_WMAX) + r)); const float sc = am > 0.f ? 127.0f / am : 0.f;
              unsigned w[4];
#pragma unroll
              for (int j = 0; j < 4; ++j) { const f32x4 v = *(const GAS f32x4*)(WCF + (size_t)r * 1024 + 16 * F.lane + 4 * j);
                  w[j] = ((unsigned)(int)__builtin_rintf(v[0] * sc) & 0xffu) | (((unsigned)(int)__builtin_rintf(v[1] * sc) & 0xffu) << 8) | (((unsigned)(int)__builtin_rintf(v[2] * sc) & 0xffu) << 16) | (((unsigned)(int)__builtin_rintf(v[3] * sc) & 0xffu) << 24); }
              *(GAS v4u*)(WC8 + (size_t)r * 1024 + 16 * F.lane) = (v4u){w[0], w[1], w[2], w[3]};
              if (F.lane == 0) WCS[r] = am * (1.0f / 127.0f); }
          __syncthreads(); }
        GRID_BAR();
        { pg8::Gemm g{(const bf16*)XB8, (const bf16*)WG8, T, N8, D / 2}; pg8::StaticOrder S; S.init(T, N8, F.G, (int)blockIdx.x);
          pg8::EpiG E{b_gate, GCS, XS, q_gain, k_gain, QS, KS, VS, QD, KD, VD, GT};
          pg8::gemm_phase<pg8::EpiG, pg8::StaticOrder, true, true, false, true>(F.lds + RING_OFF, g, S, E); }
        if (BOTH(1)) GRID_BAR();
    }

    if (IN(2)) REP(2) {
        LAS unsigned char* wl = F.lds + RING_OFF + F.wave * 16384;
        static_assert(att::DLU_BYTES <= RING_BYTES, "dilated-attention LDS state");
        for (int un = F.vcu; un < 512; un += F.G) { const int blk = un & 7, j = (un >> 3) & 3, b = un >> 5; att::dl_unit(QD, KD, VD, OC, b, j, blk, F.lds + RING_OFF, F.wave, F.lane); }
        for (int it = gw; it < 16384; it += NGW) { const int qt = 127 - (it & 127), h = (it >> 7) & 7, b = it >> 10; att::sb_item(QS, KS, VS, OC, b, h, qt, wl, F.lane); }
        if (BOTH(2)) GRID_BAR();
    }

    if (IN(3)) REP(3) {
        pg8::Gemm g{OC, WCAT, T, D, 768}; pg8::StaticOrder S; S.init(T, D, F.G, (int)blockIdx.x);
        pg8::Epi2 E{GT, MIX8, (unsigned*)(ws + WS_PART), (unsigned*)(F.ctl + CW_RCNT), RMAXF, F.lds + RING_OFF + RING_BYTES};
        pg8::gemm_phase<pg8::Epi2, pg8::StaticOrder, true, true>(F.lds + RING_OFF, g, S, E);
        if (BOTH(3)) GRID_BAR();
    }

    if (IN(4)) REP(4) {
        pg8::Gemm g{(const bf16*)MIX8, (const bf16*)WOUT8, T, D, D / 2}; pg8::StaticOrder S; S.init(T, D, F.G, (int)blockIdx.x);
        pg8::Epi3 E{XB, RINV1, (const unsigned*)RMAXF, WOS, X1B, SSQ};
        pg8::gemm_phase<pg8::Epi3, pg8::StaticOrder, true, true, false, true>(F.lds + RING_OFF, g, S, E);
        if (BOTH(4)) GRID_BAR();
    }

    if (IN(5)) REP(5) {
        for (int m = gw; m < T; m += NGW) {
            const v4u a = *(const GAS v4u*)(X1B + (size_t)m * D + 8 * F.lane), b = *(const GAS v4u*)(X1B + (size_t)m * D + 512 + 8 * F.lane);
            float v[16] = {pg8::bflo(a.x), pg8::bfhi(a.x), pg8::bflo(a.y), pg8::bfhi(a.y), pg8::bflo(a.z), pg8::bfhi(a.z), pg8::bflo(a.w), pg8::bfhi(a.w),
                           pg8::bflo(b.x), pg8::bfhi(b.x), pg8::bflo(b.y), pg8::bfhi(b.y), pg8::bflo(b.z), pg8::bfhi(b.z), pg8::bflo(b.w), pg8::bfhi(b.w)};
            float am = 0.f;
#pragma unroll
            for (int i = 0; i < 16; ++i) am = fmaxf(am, fabsf(v[i]));
            am = wave_max(am);
            float sq = (F.lane < 16) ? SSQ[(size_t)m * 16 + F.lane] : 0.f; sq = wave_sum(sq);
            const float s = am > 0.f ? 127.0f / am : 0.f;
            if (F.lane == 0) HS2[m] = am * (1.0f / 127.0f) * __builtin_amdgcn_rsqf(sq * (1.0f / 1024.0f) + 1e-6f);
            int q[16];
#pragma unroll
            for (int i = 0; i < 16; ++i) q[i] = (int)__builtin_rintf(v[i] * s) & 0xff;
            v2u o0, o1; o0.x = q[0] | (q[1] << 8) | (q[2] << 16) | (q[3] << 24); o0.y = q[4] | (q[5] << 8) | (q[6] << 16) | (q[7] << 24);
            o1.x = q[8] | (q[9] << 8) | (q[10] << 16) | (q[11] << 24); o1.y = q[12] | (q[13] << 8) | (q[14] << 16) | (q[15] << 24);
            *(GAS v2u*)(HQ + (size_t)m * D + 8 * F.lane) = o0; *(GAS v2u*)(HQ + (size_t)m * D + 512 + 8 * F.lane) = o1;
        }
        GRID_BAR();
        pg8::Gemm g{(const bf16*)HQ, (const bf16*)WC8, T, 2048, D / 2}; pg8::StaticOrder S; S.init(T, 2048, F.G, (int)blockIdx.x);
        pg8::Epi4 E{SSQ, RINV2, IDS, GW, HS2, WCS};
        pg8::OneUnit O1;
        for (int i = 0; S.next(i, O1.u); ++i) pg8::gemm_phase<pg8::Epi4, pg8::OneUnit, false, true, false, true>(F.lds + RING_OFF, g, O1, E);
        if (BOTH(5)) GRID_BAR();
    }

    if (IN(6)) REP(6) {
        P67_MAP();
        const int p16 = F.lane & 15, sg = F.lane >> 4;
        LAS unsigned char* HB = F.lds + RING_OFF + F.wave * 16384;
        LAS unsigned* LIST = (LAS unsigned*)(F.lds + RING_OFF + F.wave * 16384 + 8192);
        LAS float* HSs = (LAS float*)(F.lds + RING_OFF + F.wave * 16384 + 12288);
        const int nwb = T / 8, wstep = nrk * NWAVES;
        const int gsel = (F.lane & 15), bpsrc = (16 * (F.lane & 3) + ((F.lane >> 2) & 3)) * 4;
        v4u hpre[8], idpre[2]; float hspre = 0.f;
#define P6_PRE(bb) do { const int bc_ = (bb) < nwb ? (bb) : nwb - 1; const unsigned char* hsrc_ = HQ + (size_t)bc_ * 8192; \
            _Pragma("unroll") for (int i_ = 0; i_ < 8; ++i_) hpre[i_] = *(const GAS v4u*)(hsrc_ + (size_t)(i_ * 64 + F.lane) * 16); \
            const unsigned short* isrc_ = IDS + ((size_t)bc_ * 8 + (F.lane >> 3)) * 128 + 16 * (F.lane & 7); idpre[0] = *(const GAS v4u*)isrc_; idpre[1] = *(const GAS v4u*)(isrc_ + 8); \
            hspre = HS2[(size_t)bc_ * 8 + (F.lane & 7)]; } while (0)
#define P6_ISSUE(W, ENT, EJ, GB, UB, VB, base_) do { \
                _Pragma("unroll") for (int g_ = 0; g_ < 4; ++g_) { const int j_ = (base_) + 4 * g_ + sg; ENT[g_] = LIST[j_ < n ? j_ : nm1]; } \
                { const int j_ = (base_) + gsel; EJ = (j_ < n && F.lane < 16) ? (int)LIST[j_] : -1; } \
                _Pragma("unroll") for (int g_ = 0; g_ < 4; ++g_) { const unsigned char* up_ = U8 + (size_t)((PROBE_L1 && rep_) ? 0u : (ENT[g_] & 0xffffu)) * 512 + 16 * p16; \
                    _Pragma("unroll") for (int i_ = 0; i_ < 2; ++i_) W[g_][i_] = *(const GAS v4u*)(up_ + 256 * i_); } \
                { const unsigned ej_ = EJ < 0 ? 0u : (unsigned)EJ; GB = GW[((size_t)t0 + (ej_ >> 24)) * 128 + ((ej_ >> 16) & 127u)]; UB = USC[ej_ & 0xffffu]; VB = VSC[ej_ & 0xffffu]; } } while (0)
#define P6_DPPADD(a_, ctrl) a_ += __builtin_amdgcn_update_dpp(0, a_, ctrl, 0xf, 0xf, false)
#define P6_REDUCE(W, ENT, EJ, GB, UB, VB, base_) do { if ((base_) < n) { int ag_[4]; \
                _Pragma("unroll") for (int g_ = 0; g_ < 4; ++g_) { const LAS unsigned char* hp_ = HB + (size_t)(ENT[g_] >> 24) * 1024 + 16 * p16; int a_ = 0; v4u h_[4]; \
                    _Pragma("unroll") for (int i_ = 0; i_ < 4; ++i_) h_[i_] = *(const LAS v4u*)(hp_ + 256 * i_); \
                    _Pragma("unroll") for (int ld_ = 0; ld_ < 2; ++ld_) { const unsigned x_[4] = {W[g_][ld_].x, W[g_][ld_].y, W[g_][ld_].z, W[g_][ld_].w}; \
                        _Pragma("unroll") for (int wl_ = 0; wl_ < 4; ++wl_) { const int hd_ = 2 * (4 * ld_ + wl_); const unsigned lo_ = (x_[wl_] << 4) & 0xF0F0F0F0u, hi_ = x_[wl_] & 0xF0F0F0F0u; \
                            const unsigned hA_ = (hd_ & 3) == 0 ? h_[hd_ >> 2].x : h_[hd_ >> 2].z, hB_ = (hd_ & 3) == 0 ? h_[hd_ >> 2].y : h_[hd_ >> 2].w; \
                            a_ = __builtin_amdgcn_sdot4((int)lo_, (int)hA_, a_, false); a_ = __builtin_amdgcn_sdot4((int)hi_, (int)hB_, a_, false); } } \
                    P6_DPPADD(a_, 0xB1); P6_DPPADD(a_, 0x4E); P6_DPPADD(a_, 0x141); P6_DPPADD(a_, 0x140); ag_[g_] = a_; } \
                const int sel_ = gsel == 0 ? ag_[0] : gsel == 1 ? ag_[1] : gsel == 2 ? ag_[2] : ag_[3]; \
                const float resv_ = (float)__builtin_amdgcn_ds_bpermute(bpsrc, sel_); \
                if (EJ >= 0 && !(PROBE_L1 && rep_)) { const unsigned ej_ = (unsigned)EJ; const float act_ = gelu_f(resv_ * UB * HSs[ej_ >> 24]); \
                    COEF[((size_t)t0 + (ej_ >> 24)) * 128 + ((ej_ >> 16) & 127u)] = GB * act_ * VB; } } } while (0)
        int wb = rk * NWAVES + F.wave;
        P6_PRE(wb);
        for (; wb < nwb; wb += wstep) {
            const int t0 = wb * 8;
            asm volatile("s_waitcnt lgkmcnt(0)" ::: "memory");
            if (F.lane < 8) HSs[F.lane] = hspre;
#pragma unroll
            for (int i = 0; i < 8; ++i) *(LAS v4u*)(HB + (size_t)(i * 64 + F.lane) * 16) = hpre[i];
            int n = 0;
            { const unsigned idw[8] = {idpre[0].x, idpre[0].y, idpre[0].z, idpre[0].w, idpre[1].x, idpre[1].y, idpre[1].z, idpre[1].w};
              const unsigned tl = (unsigned)(F.lane >> 3), kb0 = 16u * (unsigned)(F.lane & 7);
#pragma unroll
              for (int i = 0; i < 16; ++i) { const unsigned e = (i & 1) ? (idw[i >> 1] >> 16) : (idw[i >> 1] & 0xffffu);
                  const bool inr = ((int)(e >> 11) == vx); const unsigned long long mk = __ballot(inr);
                  const int pos = n + (int)__builtin_amdgcn_mbcnt_hi((unsigned)(mk >> 32), __builtin_amdgcn_mbcnt_lo((unsigned)mk, 0u));
                  if (inr) LIST[pos] = (tl << 24) | ((kb0 + (unsigned)i) << 16) | e;
                  n += __builtin_popcountll(mk); } }
            asm volatile("s_waitcnt lgkmcnt(0)" ::: "memory");
            P6_PRE(wb + wstep);
            const int nm1 = n > 0 ? n - 1 : 0;
            for (int base = 0; base < n; base += 32) {
                v4u wA[4][2], wB[4][2]; unsigned entA[4], entB[4]; int ejA, ejB; float gbA, ubA, vbA, gbB, ubB, vbB;
                P6_ISSUE(wA, entA, ejA, gbA, ubA, vbA, base);
                P6_ISSUE(wB, entB, ejB, gbB, ubB, vbB, base + 16);
                P6_REDUCE(wA, entA, ejA, gbA, ubA, vbA, base);
                P6_REDUCE(wB, entB, ejB, gbB, ubB, vbB, base + 16);
            }
        }
#undef P6_PRE
#undef P6_ISSUE
#undef P6_REDUCE
#undef P6_DPPADD
        if (BOTH(6)) GRID_BAR();
    }

    if (IN(7)) REP(7) {
        P67_MAP();
        const int cs = vx >> 1;
        const int n0_ = p67_uni ? F.G / 8 : (F.G + 7 - 2 * cs) / 8, n1_ = p67_uni ? F.G / 8 : (F.G + 7 - (2 * cs + 1)) / 8;
        const int rk2 = (vx & 1) ? n0_ + rk : rk, nrk2 = n0_ + n1_;
        const int l8 = F.lane & 7, kg = F.lane >> 3;
        const unsigned char* vbase = V8 + (size_t)cs * NEXP * 128 + 16 * l8;
        const int tstep = nrk2 * NWAVES;
        const int col = 256 * cs + 32 * l8 + ((F.lane & 8) ? 16 : 0) + ((F.lane & 16) ? 8 : 0) + ((F.lane & 32) ? 4 : 0);
#define P7_CL(tt) ((tt) < T ? (tt) : T - 1)
#define P7_IDS(tt, ID) do { const int tc_ = P7_CL(tt); ID[0] = *(const GAS v4u*)(IDS + (size_t)tc_ * 128 + 16 * kg); ID[1] = *(const GAS v4u*)(IDS + (size_t)tc_ * 128 + 16 * kg + 8); } while (0)
#define P7_ISSUE(tt, ID, W, CF, OO) do { const int tc_ = P7_CL(tt); const unsigned idw_[8] = {ID[0].x, ID[0].y, ID[0].z, ID[0].w, ID[1].x, ID[1].y, ID[1].z, ID[1].w}; \
            _Pragma("unroll") for (int i_ = 0; i_ < 16; ++i_) { const unsigned e_ = (i_ & 1) ? (idw_[i_ >> 1] >> 16) : (idw_[i_ >> 1] & 0xffffu); W[i_] = *(const GAS v4u*)(vbase + (size_t)((PROBE_L1 && rep_) ? 0u : e_) * 128); } \
            _Pragma("unroll") for (int i_ = 0; i_ < 4; ++i_) CF[i_] = *(const GAS f32x4*)(COEF + (size_t)tc_ * 128 + 16 * kg + 4 * i_); \
            OO = *(const GAS v2u*)(X1B + (size_t)tc_ * D + col); } while (0)
#define P7_BYTE(d_, s_) do { const h2_t r_ = __builtin_amdgcn_cvt_scalef32_pk_f16_fp4(ww_[d_], 1.0f, s_); acc_[4 * (d_) + (s_)] = r_ * c2_ + acc_[4 * (d_) + (s_)]; } while (0)
#define P7_COMPUTE(tt, W, CF, OO) do { h2_t acc_[16];                 \
            _Pragma("unroll") for (int i_ = 0; i_ < 16; ++i_) acc_[i_] = (h2_t){(_Float16)0.f, (_Float16)0.f}; \
            _Pragma("unroll") for (int i_ = 0; i_ < 16; ++i_) { const unsigned ww_[4] = {W[i_].x, W[i_].y, W[i_].z, W[i_].w}; const _Float16 ch_ = (_Float16)CF[i_ >> 2][i_ & 3]; const h2_t c2_ = {ch_, ch_}; \
                P7_BYTE(0, 0); P7_BYTE(0, 1); P7_BYTE(0, 2); P7_BYTE(0, 3); P7_BYTE(1, 0); P7_BYTE(1, 1); P7_BYTE(1, 2); P7_BYTE(1, 3); \
                P7_BYTE(2, 0); P7_BYTE(2, 1); P7_BYTE(2, 2); P7_BYTE(2, 3); P7_BYTE(3, 0); P7_BYTE(3, 1); P7_BYTE(3, 2); P7_BYTE(3, 3); } \
            float r16_[16], r8_[8], r4_[4]; \
            { const bool up_ = (F.lane & 8) != 0; _Pragma("unroll") for (int i_ = 0; i_ < 8; ++i_) { const h2_t keep_ = up_ ? acc_[8 + i_] : acc_[i_], send_ = up_ ? acc_[i_] : acc_[8 + i_]; \
                const h2_t oth_ = __builtin_bit_cast(h2_t, __shfl_xor(__builtin_bit_cast(int, send_), 8)); r16_[2 * i_] = (float)keep_[0] + (float)oth_[0]; r16_[2 * i_ + 1] = (float)keep_[1] + (float)oth_[1]; } } \
            { const bool up_ = (F.lane & 16) != 0; _Pragma("unroll") for (int i_ = 0; i_ < 8; ++i_) { const float keep_ = up_ ? r16_[8 + i_] : r16_[i_], send_ = up_ ? r16_[i_] : r16_[8 + i_]; r8_[i_] = keep_ + __shfl_xor(send_, 16); } } \
            { const bool up_ = (F.lane & 32) != 0; _Pragma("unroll") for (int i_ = 0; i_ < 4; ++i_) { const float keep_ = up_ ? r8_[4 + i_] : r8_[i_], send_ = up_ ? r8_[i_] : r8_[4 + i_]; r4_[i_] = keep_ + __shfl_xor(send_, 32); } } \
            if ((tt) < T) *(GAS f32x4*)((rep_ == 0 ? out : (float*)(ws + WS_GT)) + (size_t)(tt) * D + col) = (f32x4){pg8::bflo(OO.x) + r4_[0], pg8::bfhi(OO.x) + r4_[1], pg8::bflo(OO.y) + r4_[2], pg8::bfhi(OO.y) + r4_[3]}; } while (0)
        v4u idA[2], idB[2], wA[16], wB[16]; f32x4 cfA[4], cfB[4]; v2u ooA, ooB;
        int t = rk2 * NWAVES + F.wave;
        P7_IDS(t, idA); P7_IDS(t + tstep, idB);
        while (t < T) {
            P7_ISSUE(t, idA, wA, cfA, ooA); P7_ISSUE(t + tstep, idB, wB, cfB, ooB);
            P7_IDS(t + 2 * tstep, idA); P7_IDS(t + 3 * tstep, idB);
            P7_COMPUTE(t, wA, cfA, ooA);
            P7_COMPUTE(t + tstep, wB, cfB, ooB);
            t += 2 * tstep;
        }
#undef P7_CL
#undef P7_IDS
#undef P7_ISSUE
#undef P7_BYTE
#undef P7_COMPUTE
    }
#undef IN
#undef BOTH
#undef GRID_BAR
}

extern "C" void kernel_launch(void* const* d_in, const int* in_sizes, int n_in, void* d_out, int out_size, void* d_ws, size_t ws_size, hipStream_t stream) {
    static int grid = 0;
    if (grid == 0) {
        if (n_in != 14 || in_sizes[0] != T * D || out_size != T * D || ws_size < WS_END) { fprintf(stderr, "kernel_launch: built for 14 inputs, x and out of %d floats, >= %zu bytes of workspace; got n_in %d, in0 %d, out %d, ws %zu; nothing launched\n", T * D, (size_t)WS_END, n_in, n_in > 0 ? in_sizes[0] : -1, out_size, ws_size); grid = -1; return; }
        int dev = 0, cus = 0, per_cu = 0;
        if (hipGetDevice(&dev) != hipSuccess || hipDeviceGetAttribute(&cus, hipDeviceAttributeMultiprocessorCount, dev) != hipSuccess) { fprintf(stderr, "kernel_launch: hipGetDevice / hipDeviceGetAttribute failed\n"); grid = -1; return; }
        if (hipFuncSetAttribute((const void*)fwd_kernel, hipFuncAttributeMaxDynamicSharedMemorySize, LDS_BYTES) != hipSuccess) { fprintf(stderr, "kernel_launch: hipFuncSetAttribute failed\n"); grid = -1; return; }
        if (hipOccupancyMaxActiveBlocksPerMultiprocessor(&per_cu, (const void*)fwd_kernel, NWAVES * 64, LDS_BYTES) != hipSuccess || per_cu < 1)
            fprintf(stderr, "kernel_launch: note: occupancy query reports %d workgroups per CU\n", per_cu);
        (void)hipGetLastError();
        grid = cus;
    }
    if (grid < 0) return;
    if (hipMemsetAsync((char*)d_ws + WS_CTL, 0, CTL_ZERO_BYTES, stream) != hipSuccess) { fprintf(stderr, "kernel_launch: hipMemsetAsync failed\n"); return; }
    Args a{};
    for (int i = 0; i < 14; ++i) a.in[i] = (const float*)d_in[i];
    a.out = (float*)d_out; a.ws = (unsigned char*)d_ws;
    for (int li = 0; li < N_LAUNCHES; ++li) {
        a.ph_lo = (N_LAUNCHES == PER_PHASE) ? li : 0; a.ph_hi = (N_LAUNCHES == PER_PHASE) ? li + 1 : MK_LAST_PHASE; a.li = li;
        if (a.ph_lo >= MK_LAST_PHASE) break;
        hipLaunchKernelGGL(fwd_kernel, dim3(grid), dim3(NWAVES * 64), LDS_BYTES, stream, a);
        const hipError_t le = hipPeekAtLastError();
        if (le != hipSuccess) { fprintf(stderr, "kernel_launch: launch %d failed: %s\n", li, hipGetErrorName(le)); break; }
    }
}
```

```cpp
#include <hip/hip_runtime.h>
#include <cstdio>
#include <cstdint>
namespace pg8 {
#define PG8_LAS __attribute__((address_space(3)))
typedef unsigned short bf16_t;
typedef short bf16x8 __attribute__((ext_vector_type(8)));
typedef float f32x4 __attribute__((ext_vector_type(4)));
typedef unsigned u32x4 __attribute__((ext_vector_type(4)));
typedef int i32x8 __attribute__((ext_vector_type(8)));
typedef int i32x4 __attribute__((ext_vector_type(4)));
constexpr int BM = 256, BK = 64, HALF = 128, HTB = HALF * BK * 2  , STAGE_BYTES = 8 * HTB, NXCD = 8, WGM = 8;

__host__ __device__ __forceinline__ int lds_byte(int r, int c) { const int st = (r >> 4) * 2 + (c >> 5), rr = r & 15, cc = c & 31, ob = rr * 64 + cc * 2; return st * 1024 + (ob ^ (((ob >> 9) & 1) << 5)); }
__host__ __device__ __forceinline__ void stage_rc(int b, int& R, int& C) { const int st = b / 1024, sb = b % 1024, swz = sb ^ (((sb >> 9) & 1) << 5); R = (st >> 1) * 16 + swz / 64; C = (st & 1) * 32 + (swz % 64) / 2; }
__host__ __device__ __forceinline__ int perm32(int rho) { const int n = rho >> 4, i = rho & 15; return 8 * (i >> 2) + 4 * n + (i & 3); }

struct Unit { int pm, pn; };
struct Gemm { const bf16_t* A; const bf16_t* Bt; int M, N, K; };

struct StaticOrder {
    int nM, nN, nwg, G, c;
    __host__ __device__ void init(int M, int N, int G_, int c_) { nM = M / BM; nN = N / BM; nwg = nM * nN; G = G_; c = c_; }
    __host__ __device__ bool next(int i, Unit& u) const {
        const long L = (long)i * G + c; if (L >= nwg) return false;
        int wgid = (int)L; { const int q = nwg / NXCD, r = nwg % NXCD, xcd = wgid % NXCD, off = wgid / NXCD; wgid = (xcd < r ? xcd * (q + 1) : r * (q + 1) + (xcd - r) * q) + off; }
        const int nig = WGM * nN, gid = wgid / nig, fm = gid * WGM, gsz = (nM - fm) < WGM ? (nM - fm) : WGM;
        u.pm = fm + ((wgid % nig) % gsz); u.pn = (wgid % nig) / gsz; return true;
    }
    __device__ __forceinline__ void a_ready(const Unit&) const {}
    __device__ __forceinline__ void done(const Unit&) const {}
};


struct OneUnit {
    Unit u;
    __device__ __forceinline__ bool next(int i, Unit& o) const { if (i != 0) return false; o = u; return true; }
    __device__ __forceinline__ void a_ready(const Unit&) const {}
    __device__ __forceinline__ void done(const Unit&) const {}
};

typedef float f32x2 __attribute__((ext_vector_type(2)));
typedef __bf16 bf16x2_t __attribute__((ext_vector_type(2)));
typedef unsigned u32x2 __attribute__((ext_vector_type(2)));
__device__ __forceinline__ unsigned pkbf(float lo, float hi) { f32x2 v = {lo, hi}; bf16x2_t b = __builtin_convertvector(v, bf16x2_t); return __builtin_bit_cast(unsigned, b); }
__device__ __forceinline__ float bflo(unsigned w) { return __uint_as_float(w << 16); }
__device__ __forceinline__ float bfhi(unsigned w) { return __uint_as_float(w & 0xffff0000u); }
__device__ __forceinline__ u32x4 pack8(const f32x4 a, const f32x4 b) { u32x4 w; w.x = pkbf(a[0], a[1]); w.y = pkbf(a[2], a[3]); w.z = pkbf(b[0], b[1]); w.w = pkbf(b[2], b[3]); return w; }
constexpr float QSCALE = 0.125f * 1.4426950408889634f;
__device__ __forceinline__ float sigmoidf_(float v) { return __builtin_amdgcn_rcpf(1.0f + __builtin_amdgcn_exp2f(-1.4426950408889634f * v)); }

struct EpiG {
    static constexpr bool PERM = true, AFTER_DRAIN = false, HAS_MID = false; static constexpr int MID_T = -1;
    const float* bgate; const float* cs; const float* xs; const float* qg; const float* kg; bf16_t *QS, *KS, *VS, *QD, *KD, *VD; unsigned char* GT;
    __device__ __forceinline__ void mid(f32x4 (&)[2][2][4][2], const Unit&, int, int, int, int) const {}
    static __device__ __forceinline__ f32x4 cvt(const f32x4 a, const f32x4 sc) { const i32x4 ia = __builtin_bit_cast(i32x4, a); return (f32x4){(float)ia[0], (float)ia[1], (float)ia[2], (float)ia[3]} * sc; }
    __device__ __forceinline__ void operator()(const f32x4 (&acc)[2][2][4][2], const Unit& u, int wr, int wc, int fr, int fq) const {
        asm volatile("" : "+v"(fr), "+v"(fq));
        const int pn = u.pn; const int row0 = u.pm * BM + wr * 64 + fr, colp = pn * BM + wc * 32 + 8 * fq;
        f32x4 sv[2][2];
#pragma unroll
        for (int bj = 0; bj < 2; ++bj)
#pragma unroll
            for (int n = 0; n < 2; ++n) sv[bj][n] = *(const f32x4*)(cs + colp + bj * HALF + 4 * n);
        if (pn < 6) {
            bf16_t* base; int colt;
            if (pn < 2) { base = QS; colt = pn * 256; } else if (pn < 4) { base = KS; colt = (pn - 2) * 256; } else { base = VS; colt = (pn - 4) * 256; }
            base += colt + wc * 32 + 8 * fq;
            const float qs = (pn < 2 ? QSCALE : 1.0f);
#pragma unroll
            for (int ai = 0; ai < 2; ++ai)
#pragma unroll
                for (int m = 0; m < 4; ++m) { const int row = row0 + ai * HALF + m * 16; const float r = xs[row] * qs;
#pragma unroll
                    for (int bj = 0; bj < 2; ++bj) *(u32x4*)(base + (size_t)row * 512 + bj * HALF) = pack8(cvt(acc[ai][bj][m][0], sv[bj][0]) * r, cvt(acc[ai][bj][m][1], sv[bj][1]) * r);
                }
        } else if (pn < 12) {
            const bool isK = pn >= 9; const int head = (isK ? pn - 9 : pn - 6) * 4 + wc;
            const float* g = (isK ? kg : qg) + head * 64 + 8 * fq;
            f32x4 gv[2][2]; const float qsc = isK ? 1.0f : QSCALE;
#pragma unroll
            for (int bj = 0; bj < 2; ++bj)
#pragma unroll
                for (int n = 0; n < 2; ++n) gv[bj][n] = *(const f32x4*)(g + 32 * bj + 4 * n) * qsc;
            bf16_t* base = (isK ? KD : QD) + head * 64 + 8 * fq;
#pragma unroll
            for (int ai = 0; ai < 2; ++ai)
#pragma unroll
                for (int m = 0; m < 4; ++m) { const int row = row0 + ai * HALF + m * 16; const float r = xs[row];
                    f32x4 v[2][2]; float ss = 0.f;
#pragma unroll
                    for (int bj = 0; bj < 2; ++bj)
#pragma unroll
                        for (int n = 0; n < 2; ++n) { v[bj][n] = cvt(acc[ai][bj][m][n], sv[bj][n]) * r; const f32x4 q = v[bj][n] * v[bj][n]; ss += (q[0] + q[1]) + (q[2] + q[3]); }
                    ss += __shfl_xor(ss, 16); ss += __shfl_xor(ss, 32);
                    const float sc = __builtin_amdgcn_rsqf(ss * (1.0f / 64.0f) + 1e-6f);
#pragma unroll
                    for (int bj = 0; bj < 2; ++bj) *(u32x4*)(base + (size_t)row * 768 + 32 * bj) = pack8(v[bj][0] * sc * gv[bj][0], v[bj][1] * sc * gv[bj][1]);
                }
        } else if (pn < 15) {
            bf16_t* base = VD + (pn - 12) * 256 + wc * 32 + 8 * fq;
#pragma unroll
            for (int ai = 0; ai < 2; ++ai)
#pragma unroll
                for (int m = 0; m < 4; ++m) { const int row = row0 + ai * HALF + m * 16; const float r = xs[row];
#pragma unroll
                    for (int bj = 0; bj < 2; ++bj) *(u32x4*)(base + (size_t)row * 768 + bj * HALF) = pack8(cvt(acc[ai][bj][m][0], sv[bj][0]) * r, cvt(acc[ai][bj][m][1], sv[bj][1]) * r);
                }
        } else {
            const int col0 = (pn - 15) * 256 + wc * 32 + 8 * fq;
            f32x4 bv[2][2];
#pragma unroll
            for (int bj = 0; bj < 2; ++bj)
#pragma unroll
                for (int n = 0; n < 2; ++n) bv[bj][n] = *(const f32x4*)(bgate + col0 + bj * HALF + 4 * n);
#pragma unroll
            for (int ai = 0; ai < 2; ++ai)
#pragma unroll
                for (int m = 0; m < 4; ++m) { const int row = row0 + ai * HALF + m * 16; const float r = xs[row];
#pragma unroll
                    for (int bj = 0; bj < 2; ++bj) { f32x4 a = cvt(acc[ai][bj][m][0], sv[bj][0]) * r + bv[bj][0], b = cvt(acc[ai][bj][m][1], sv[bj][1]) * r + bv[bj][1];
#pragma unroll
                        for (int e = 0; e < 4; ++e) { a[e] = sigmoidf_(a[e]) * 255.0f; b[e] = sigmoidf_(b[e]) * 255.0f; }
                        unsigned w0 = 0, w1 = 0;
                        w0 = __builtin_amdgcn_cvt_pk_u8_f32(a[0], 0, w0); w0 = __builtin_amdgcn_cvt_pk_u8_f32(a[1], 1, w0); w0 = __builtin_amdgcn_cvt_pk_u8_f32(a[2], 2, w0); w0 = __builtin_amdgcn_cvt_pk_u8_f32(a[3], 3, w0);
                        w1 = __builtin_amdgcn_cvt_pk_u8_f32(b[0], 0, w1); w1 = __builtin_amdgcn_cvt_pk_u8_f32(b[1], 1, w1); w1 = __builtin_amdgcn_cvt_pk_u8_f32(b[2], 2, w1); w1 = __builtin_amdgcn_cvt_pk_u8_f32(b[3], 3, w1);
                        *(u32x2*)(GT + (size_t)row * 2048 + col0 + bj * HALF) = (u32x2){w0, w1}; }
                }
        }
    }
};

struct Epi2 {
    static constexpr bool PERM = true, AFTER_DRAIN = false, HAS_MID = true; static constexpr int MID_T = 8;
    const unsigned char* GT; unsigned char* MIX8; unsigned* part; unsigned* rcnt; float* rmaxf; PG8_LAS unsigned char* red_lds;
    static __device__ __forceinline__ float ub(unsigned w, int e) { return (float)((w >> (8 * e)) & 0xffu); }
    static __device__ __forceinline__ float gcv(unsigned w, int e) { return fmaxf(ub(w, e) * (1.0f / 255.0f), 1e-30f); }
    __device__ __forceinline__ void mid(f32x4 (&acc)[2][2][4][2], const Unit& u, int wr, int wc, int fr, int fq) const {
        asm volatile("" : "+v"(fr), "+v"(fq));
        const int row0 = u.pm * BM + wr * 64 + fr, col0 = u.pn * BM + wc * 32 + 8 * fq;
        u32x2 ga[2][4][2], gb[2][4][2];
#pragma unroll
        for (int ai = 0; ai < 2; ++ai)
#pragma unroll
            for (int m = 0; m < 4; ++m) { const unsigned char* gp = GT + (size_t)(row0 + ai * HALF + m * 16) * 2048 + col0;
#pragma unroll
                for (int bj = 0; bj < 2; ++bj) { ga[ai][m][bj] = *(const u32x2*)(gp + bj * HALF); gb[ai][m][bj] = *(const u32x2*)(gp + 1024 + bj * HALF); } }
        asm volatile("" ::: "memory");
#pragma unroll
        for (int ai = 0; ai < 2; ++ai)
#pragma unroll
            for (int m = 0; m < 4; ++m)
#pragma unroll
                for (int bj = 0; bj < 2; ++bj) { const u32x2 a = ga[ai][m][bj], b = gb[ai][m][bj];
                    f32x4 r0, r1;
#pragma unroll
                    for (int e = 0; e < 4; ++e) { r0[e] = ub(a.x, e) * (1.0f / 255.0f) * __builtin_amdgcn_rcpf(gcv(b.x, e)); r1[e] = ub(a.y, e) * (1.0f / 255.0f) * __builtin_amdgcn_rcpf(gcv(b.y, e)); }
                    acc[ai][bj][m][0] *= r0; acc[ai][bj][m][1] *= r1; }
        asm volatile("" ::: "memory");
    }
    __device__ __forceinline__ void operator()(f32x4 (&acc)[2][2][4][2], const Unit& u, int wr, int wc, int fr, int fq) const {
        asm volatile("" : "+v"(fr), "+v"(fq));
        const int row0 = u.pm * BM + wr * 64 + fr, col0 = u.pn * BM + wc * 32 + 8 * fq;
        PG8_LAS float* red = (PG8_LAS float*)red_lds; PG8_LAS float* red2 = red + 1024;
#pragma unroll
        for (int ai = 0; ai < 2; ++ai) { u32x2 gb[4][2];
#pragma unroll
            for (int m = 0; m < 4; ++m) { const unsigned char* gp = GT + (size_t)(row0 + ai * HALF + m * 16) * 2048 + 1024 + col0;
#pragma unroll
                for (int bj = 0; bj < 2; ++bj) gb[m][bj] = *(const u32x2*)(gp + bj * HALF); }
#pragma unroll
            for (int m = 0; m < 4; ++m) { float a = 0.f;
#pragma unroll
                for (int bj = 0; bj < 2; ++bj) { const u32x2 b = gb[m][bj];
#pragma unroll
                    for (int e = 0; e < 4; ++e) { acc[ai][bj][m][0][e] *= gcv(b.x, e); acc[ai][bj][m][1][e] *= gcv(b.y, e); a = fmaxf(a, fmaxf(fabsf(acc[ai][bj][m][0][e]), fabsf(acc[ai][bj][m][1][e]))); } }
                a = fmaxf(a, __shfl_xor(a, 16)); a = fmaxf(a, __shfl_xor(a, 32));
                if (fq == 0) red[(wr * 64 + fr + ai * HALF + m * 16) * 4 + wc] = a; }
            asm volatile("" ::: "memory");
        }
        asm volatile("s_waitcnt lgkmcnt(0)" ::: "memory"); __builtin_amdgcn_s_barrier(); asm volatile("" ::: "memory");
        const int tid = (wr * 4 + wc) * 64 + fr + 16 * fq;
        if (tid < 256) {
            const f32x4 p4 = *(const PG8_LAS f32x4*)(red + tid * 4);
            const float v = fmaxf(fmaxf(p4[0], p4[1]), fmaxf(p4[2], p4[3]));
            unsigned* pr = part + (size_t)(u.pm * BM + tid) * 4;
            __hip_atomic_store(pr + u.pn, __float_as_uint(v), __ATOMIC_RELAXED, __HIP_MEMORY_SCOPE_AGENT);
            asm volatile("s_waitcnt vmcnt(0)" ::: "memory");
            if ((tid & 63) == 0) (void)__hip_atomic_fetch_add(rcnt + u.pm, 1u, __ATOMIC_RELAXED, __HIP_MEMORY_SCOPE_AGENT);
            { unsigned sp = 0; while (__hip_atomic_load(rcnt + u.pm, __ATOMIC_RELAXED, __HIP_MEMORY_SCOPE_AGENT) < 16u) { __builtin_amdgcn_s_sleep(4); if (++sp > (1u << 21)) break; } }
            asm volatile("" ::: "memory");
            float f = 0.f;
#pragma unroll
            for (int j = 0; j < 4; ++j) f = fmaxf(f, __uint_as_float(__hip_atomic_load(pr + j, __ATOMIC_RELAXED, __HIP_MEMORY_SCOPE_AGENT)));
            red2[tid] = f;
            if (u.pn == 0) rmaxf[u.pm * BM + tid] = f;
        }
        asm volatile("s_waitcnt lgkmcnt(0)" ::: "memory"); __builtin_amdgcn_s_barrier(); asm volatile("" ::: "memory");
#pragma unroll
        for (int ai = 0; ai < 2; ++ai)
#pragma unroll
            for (int m = 0; m < 4; ++m) { const int row = row0 + ai * HALF + m * 16;
                const float rm = red2[wr * 64 + fr + ai * HALF + m * 16]; const float sc = rm > 0.f ? 127.0f / rm : 0.f;
#pragma unroll
                for (int bj = 0; bj < 2; ++bj) { unsigned w0 = 0, w1 = 0;
#pragma unroll
                    for (int e = 0; e < 4; ++e) { w0 |= ((unsigned)(int)__builtin_rintf(acc[ai][bj][m][0][e] * sc) & 0xffu) << (8 * e); w1 |= ((unsigned)(int)__builtin_rintf(acc[ai][bj][m][1][e] * sc) & 0xffu) << (8 * e); }
                    *(u32x2*)(MIX8 + (size_t)row * 1024 + col0 + bj * HALF) = (u32x2){w0, w1}; } }
    }
};

struct Epi3 {
    static constexpr bool PERM = true, AFTER_DRAIN = false, HAS_MID = false; static constexpr int MID_T = -1;
    const bf16_t* xb; const float* rms; const unsigned* rmax; const float* wos; bf16_t* x1b; float* ssq;
    __device__ __forceinline__ void mid(f32x4 (&)[2][2][4][2], const Unit&, int, int, int, int) const {}
    static __device__ __forceinline__ f32x4 cvt(const f32x4 a, const f32x4 sc) { const i32x4 ia = __builtin_bit_cast(i32x4, a); return (f32x4){(float)ia[0], (float)ia[1], (float)ia[2], (float)ia[3]} * sc; }
    __device__ __forceinline__ void operator()(const f32x4 (&acc)[2][2][4][2], const Unit& u, int wr, int wc, int fr, int fq) const {
        asm volatile("" : "+v"(fr), "+v"(fq));
        const int row0 = u.pm * BM + wr * 64 + fr, col0 = u.pn * BM + wc * 32 + 8 * fq;
        f32x4 wsv[2][2];
#pragma unroll
        for (int bj = 0; bj < 2; ++bj)
#pragma unroll
            for (int n = 0; n < 2; ++n) wsv[bj][n] = *(const f32x4*)(wos + col0 + bj * HALF + 4 * n);
#pragma unroll
        for (int ai = 0; ai < 2; ++ai) { u32x4 xv[4][2]; float rm[4], ms[4];
#pragma unroll
            for (int m = 0; m < 4; ++m) { const int row = row0 + ai * HALF + m * 16; const size_t off = (size_t)row * 1024 + col0; rm[m] = rms[row]; ms[m] = __uint_as_float(rmax[row]) * (1.0f / 127.0f);
#pragma unroll
                for (int bj = 0; bj < 2; ++bj) xv[m][bj] = *(const u32x4*)(xb + off + bj * HALF); }
#pragma unroll
            for (int m = 0; m < 4; ++m) { const int row = row0 + ai * HALF + m * 16; const size_t off = (size_t)row * 1024 + col0; float ss = 0.f; const float r = rm[m], mr = ms[m];
#pragma unroll
                for (int bj = 0; bj < 2; ++bj) { const u32x4 w = xv[m][bj];
                    const f32x4 x0 = (f32x4){bflo(w.x), bfhi(w.x), bflo(w.y), bfhi(w.y)}, x1 = (f32x4){bflo(w.z), bfhi(w.z), bflo(w.w), bfhi(w.w)};
                    const f32x4 v0 = cvt(acc[ai][bj][m][0], wsv[bj][0]) * mr + x0 * r, v1 = cvt(acc[ai][bj][m][1], wsv[bj][1]) * mr + x1 * r;
                    *(u32x4*)(x1b + off + bj * HALF) = pack8(v0, v1);
                    const f32x4 q0 = v0 * v0, q1 = v1 * v1; ss += ((q0[0] + q0[1]) + (q0[2] + q0[3])) + ((q1[0] + q1[1]) + (q1[2] + q1[3])); }
                ss += __shfl_xor(ss, 16); ss += __shfl_xor(ss, 32);
                if (fq == 0) ssq[(size_t)row * 16 + u.pn * 4 + wc] = ss;
            }
            asm volatile("" ::: "memory");
        }
    }
};

__device__ __forceinline__ unsigned f2key(float v) { const unsigned u = __float_as_uint(v); return (u & 0x80000000u) ? ~u : (u | 0x80000000u); }
__device__ __forceinline__ float key2f(unsigned k) { return __uint_as_float((k & 0x80000000u) ? (k & 0x7fffffffu) : ~k); }
#define PG8_CE(a_, b_) do { const unsigned hi__ = (a_) > (b_) ? (a_) : (b_); const unsigned lo__ = (a_) > (b_) ? (b_) : (a_); (a_) = hi__; (b_) = lo__; } while (0)
__device__ __forceinline__ void bitonic_merge16(unsigned (&v)[16]) {
#pragma unroll
    for (int j = 8; j >= 1; j >>= 1)
#pragma unroll
        for (int i = 0; i < 16; ++i) { const int l = i ^ j; if (l > i) PG8_CE(v[i], v[l]); }
}
__device__ __forceinline__ void bitonic_sort16(unsigned (&v)[16]) {
#pragma unroll
    for (int k = 2; k <= 16; k <<= 1)
#pragma unroll
        for (int j = k >> 1; j >= 1; j >>= 1)
#pragma unroll
            for (int i = 0; i < 16; ++i) { const int l = i ^ j; if (l > i) { if ((i & k) == 0 || k == 16) PG8_CE(v[i], v[l]); else PG8_CE(v[l], v[i]); } }
}
__device__ __forceinline__ void merge_top16(unsigned (&t)[16], const unsigned (&o)[16]) {
#pragma unroll
    for (int i = 0; i < 16; ++i) t[i] = t[i] > o[15 - i] ? t[i] : o[15 - i];
    bitonic_merge16(t);
}
template <int XM> __device__ __forceinline__ void merge_top16_xor(unsigned (&t)[16]) {
    unsigned o[16];
#pragma unroll
    for (int i = 0; i < 16; ++i) o[i] = (unsigned)__shfl_xor((int)t[i], XM);
    merge_top16(t, o);
}

struct Epi4 {
    static constexpr bool PERM = false, AFTER_DRAIN = true, HAS_MID = false; static constexpr int MID_T = -1;
    const float* ssq; float* rinv2; unsigned short* ids; float* gw;
    const float* hs; const float* wcs;
    __device__ __forceinline__ void mid(f32x4 (&)[2][2][4][2], const Unit&, int, int, int, int) const {}
    __device__ __forceinline__ void fused(f32x4 (&acc)[2][2][4][2], const Unit& u, int wr, int wc, int fr, int fq, PG8_LAS unsigned char* lds, int wid, int lane) const {
        asm volatile("" : "+v"(fr), "+v"(fq));
        const int tid = wid * 64 + lane;
        const int rl = tid >> 2, p = (tid >> 1) & 1, hf = tid & 1, q4 = tid & 3;
#pragma unroll
        for (int pass = 0; pass < 2; ++pass) {
            f32x4 wsv[2][2]; float hsv[4];
#pragma unroll
            for (int bj = 0; bj < 2; ++bj)
#pragma unroll
                for (int n = 0; n < 2; ++n) wsv[bj][n] = *(const f32x4*)(wcs + u.pn * BM + bj * HALF + wc * 32 + n * 16 + fq * 4);
#pragma unroll
            for (int m = 0; m < 4; ++m) hsv[m] = hs[u.pm * BM + pass * HALF + wr * 64 + m * 16 + fr];
#pragma unroll
            for (int m = 0; m < 4; ++m)
#pragma unroll
                for (int bj = 0; bj < 2; ++bj)
#pragma unroll
                    for (int n = 0; n < 2; ++n) { const i32x4 ia = __builtin_bit_cast(i32x4, acc[pass][bj][m][n]); f32x4 sv;
#pragma unroll
                        for (int e = 0; e < 4; ++e) sv[e] = (float)ia[e] * hsv[m] * wsv[bj][n][e];
                        *(PG8_LAS f32x4*)(lds + (size_t)(wr * 64 + m * 16 + fr) * 1056 + bj * 528 + (wc * 32 + n * 16 + fq * 4) * 4) = sv; }
            asm volatile("s_waitcnt lgkmcnt(0)" ::: "memory"); __builtin_amdgcn_s_barrier(); asm volatile("" ::: "memory");
            const int row = u.pm * BM + pass * HALF + rl;
            unsigned tk[16];
#pragma unroll
            for (int i = 0; i < 16; ++i) tk[i] = 0u;
            const PG8_LAS unsigned char* sp = lds + (size_t)rl * 1056 + p * 528 + hf * 256;
#pragma nounroll
            for (int c = 0; c < 4; ++c) { unsigned ch[16];
#pragma unroll
                for (int e4 = 0; e4 < 4; ++e4) { const f32x4 v = *(const PG8_LAS f32x4*)(sp + c * 64 + e4 * 16);
#pragma unroll
                    for (int e = 0; e < 4; ++e) ch[4 * e4 + e] = (f2key(v[e]) & ~127u) | (unsigned)(127 - (64 * hf + 16 * c + 4 * e4 + e)); }
                bitonic_sort16(ch);
                merge_top16(tk, ch);
            }
            merge_top16_xor<1>(tk);
            asm volatile("s_waitcnt lgkmcnt(0)" ::: "memory");
            PG8_LAS unsigned* kl = (PG8_LAS unsigned*)(lds + (size_t)(rl & ~15) * 1056) + ((rl & 15) * 2) * 16;
            if (hf == 0) {
#pragma unroll
                for (int i = 0; i < 4; ++i) *(PG8_LAS u32x4*)(kl + p * 16 + 4 * i) = (u32x4){tk[4 * i], tk[4 * i + 1], tk[4 * i + 2], tk[4 * i + 3]}; }
            asm volatile("s_waitcnt lgkmcnt(0)" ::: "memory");
            unsigned ck[16];
#define CAND_SLOT(m_, ij__) do { const unsigned i__ = (ij__) >> 4, j__ = (ij__) & 15u; \
                const unsigned ka__ = kl[(ij__) == 0xFFFFu ? 0u : i__], kb__ = kl[16 + ((ij__) == 0xFFFFu ? 0u : j__)]; \
                const float s__ = key2f(ka__ & ~127u) + key2f(kb__ & ~127u); \
                ck[m_] = (ij__) == 0xFFFFu ? 0u : ((f2key(s__) & ~255u) | (255u - (ij__))); } while (0)
                { const unsigned ij_ = q4 == 0 ? 0u : q4 == 1 ? 1u : q4 == 2 ? 2u : 3u; CAND_SLOT(0, ij_); }
                { const unsigned ij_ = q4 == 0 ? 4u : q4 == 1 ? 5u : q4 == 2 ? 6u : 7u; CAND_SLOT(1, ij_); }
                { const unsigned ij_ = q4 == 0 ? 8u : q4 == 1 ? 9u : q4 == 2 ? 10u : 11u; CAND_SLOT(2, ij_); }
                { const unsigned ij_ = q4 == 0 ? 12u : q4 == 1 ? 13u : q4 == 2 ? 14u : 15u; CAND_SLOT(3, ij_); }
                { const unsigned ij_ = q4 == 0 ? 16u : q4 == 1 ? 17u : q4 == 2 ? 18u : 19u; CAND_SLOT(4, ij_); }
                { const unsigned ij_ = q4 == 0 ? 20u : q4 == 1 ? 21u : q4 == 2 ? 22u : 23u; CAND_SLOT(5, ij_); }
                { const unsigned ij_ = q4 == 0 ? 32u : q4 == 1 ? 33u : q4 == 2 ? 34u : 35u; CAND_SLOT(6, ij_); }
                { const unsigned ij_ = q4 == 0 ? 36u : q4 == 1 ? 48u : q4 == 2 ? 49u : 50u; CAND_SLOT(7, ij_); }
                { const unsigned ij_ = q4 == 0 ? 51u : q4 == 1 ? 64u : q4 == 2 ? 65u : 66u; CAND_SLOT(8, ij_); }
                { const unsigned ij_ = q4 == 0 ? 80u : q4 == 1 ? 81u : q4 == 2 ? 96u : 97u; CAND_SLOT(9, ij_); }
                { const unsigned ij_ = q4 == 0 ? 112u : q4 == 1 ? 113u : q4 == 2 ? 128u : 144u; CAND_SLOT(10, ij_); }
                { const unsigned ij_ = q4 == 0 ? 160u : q4 == 1 ? 176u : q4 == 2 ? 192u : 208u; CAND_SLOT(11, ij_); }
                { const unsigned ij_ = q4 == 0 ? 224u : q4 == 1 ? 240u : q4 == 2 ? 65535u : 65535u; CAND_SLOT(12, ij_); }
#undef CAND_SLOT
            ck[13] = 0u; ck[14] = 0u; ck[15] = 0u;
            bitonic_sort16(ck);
            merge_top16_xor<1>(ck); merge_top16_xor<2>(ck);
            float sq = 0.f;
#pragma unroll
            for (int i = 0; i < 4; ++i) { const f32x4 t = *(const f32x4*)(ssq + (size_t)row * 16 + 4 * i); sq += (t[0] + t[1]) + (t[2] + t[3]); }
            const float r2 = __builtin_amdgcn_rsqf(sq * (1.0f / 1024.0f) + 1e-6f);
            if (u.pn == 0 && q4 == 0) rinv2[row] = r2;
            const float b0 = key2f(ck[0] & ~255u); float wsum = 0.f; float wv[16];
#pragma unroll
            for (int q = 0; q < 16; ++q) { wv[q] = __builtin_amdgcn_exp2f((key2f(ck[q] & ~255u) - b0) * r2 * 1.4426950408889634f); wsum += wv[q]; }
            const float inv = 1.0f / wsum;
            unsigned short eo[4]; float go[4];
#pragma unroll
            for (int e = 0; e < 4; ++e) { unsigned c0 = ck[e], c1 = ck[4 + e], c2 = ck[8 + e], c3 = ck[12 + e]; float w0 = wv[e], w1 = wv[4 + e], w2 = wv[8 + e], w3 = wv[12 + e];
                asm volatile("" : "+v"(c0), "+v"(c1), "+v"(c2), "+v"(c3), "+v"(w0), "+v"(w1), "+v"(w2), "+v"(w3));
                const unsigned cc = q4 == 0 ? c0 : q4 == 1 ? c1 : q4 == 2 ? c2 : c3; const float ww = q4 == 0 ? w0 : q4 == 1 ? w1 : q4 == 2 ? w2 : w3;
                const unsigned code = 255u - (cc & 255u);
                const unsigned i1 = 127u - (kl[code >> 4] & 127u), i2 = 127u - (kl[16 + (code & 15u)] & 127u);
                eo[e] = (unsigned short)(i1 * 128u + i2); go[e] = ww * inv; }
            const size_t ob = ((size_t)row * 8 + u.pn) * 16 + q4 * 4;
            { u32x2 w; w.x = eo[0] | ((unsigned)eo[1] << 16); w.y = eo[2] | ((unsigned)eo[3] << 16); *(u32x2*)(ids + ob) = w; }
            *(f32x4*)(gw + ob) = (f32x4){go[0], go[1], go[2], go[3]};
            asm volatile("s_waitcnt lgkmcnt(0)" ::: "memory"); __builtin_amdgcn_s_barrier(); asm volatile("" ::: "memory");
        }
    }
};
template <class Epi, class Sched, bool ALIGN_EPI = false, bool SP2 = false, bool FP8 = false, bool I8 = false>
__device__ __forceinline__ void gemm_phase(PG8_LAS unsigned char* lds, const Gemm g, const Sched& S, const Epi& E) {
    const int tid = threadIdx.x, wid = __builtin_amdgcn_readfirstlane(tid >> 6), lane = tid & 63, wr = wid >> 2, wc = wid & 3, fr = lane & 15, fq = lane >> 4;
    const int K = g.K, nt = K / BK;
    unsigned voffA[2], voffB[2];
#pragma unroll
    for (int i = 0; i < 2; ++i) { int R, C; stage_rc(tid * 16 + i * 8192, R, C); const int Rb = Epi::PERM ? ((R & ~31) + perm32(R & 31)) : R;
        voffA[i] = (unsigned)(R * K + C) * 2u; voffB[i] = (unsigned)(Rb * K + C) * 2u; }
    const size_t kstep = (size_t)(BK * 2);
    const size_t hstep = (size_t)HALF * K * 2;
    const size_t tstep = 2 * hstep;
    const unsigned ldsw = (unsigned)wid * 1024u;
    const int aoff = lds_byte(wr * 64 + fr, fq * 8), boff = lds_byte(wc * 32 + fr, fq * 8);
#define PG8_SA(b, h) (((b) * 2 + (h)) * HTB)
#define PG8_SB(b, h) ((4 + (b) * 2 + (h)) * HTB)
#define PG8_STAGE(bufoff, gbase, voff) do { _Pragma("unroll") for (int _i = 0; _i < 2; ++_i) \
        __builtin_amdgcn_global_load_lds((const unsigned*)((const char*)(gbase) + (voff)[_i]), (PG8_LAS unsigned*)(lds + (bufoff) + ldsw + _i * 8192), 16, 0, 0); } while (0)
#define PG8_LD8(lo_, hi_) __builtin_bit_cast(i32x8, __builtin_shufflevector((lo_), (hi_), 0, 1, 2, 3, 4, 5, 6, 7))
#define PG8_LDA(dst, b, h) do { if constexpr (FP8) { _Pragma("unroll") for (int m = 0; m < 4; ++m) { const u32x4 l0_ = *(const PG8_LAS u32x4*)(lds + PG8_SA(b, h) + aoff + m * 2048), l1_ = *(const PG8_LAS u32x4*)(lds + PG8_SA(b, h) + aoff + m * 2048 + 1024); dst##8[m] = PG8_LD8(l0_, l1_); } } \
        else { _Pragma("unroll") for (int m = 0; m < 4; ++m) _Pragma("unroll") for (int k = 0; k < 2; ++k) dst[m][k] = *(const PG8_LAS bf16x8*)(lds + PG8_SA(b, h) + aoff + m * 2048 + k * 1024); } } while (0)
#define PG8_LDB(dst, b, h) do { if constexpr (FP8) { _Pragma("unroll") for (int n = 0; n < 2; ++n) { const u32x4 l0_ = *(const PG8_LAS u32x4*)(lds + PG8_SB(b, h) + boff + n * 2048), l1_ = *(const PG8_LAS u32x4*)(lds + PG8_SB(b, h) + boff + n * 2048 + 1024); dst##8[n] = PG8_LD8(l0_, l1_); } } \
        else { _Pragma("unroll") for (int n = 0; n < 2; ++n) _Pragma("unroll") for (int k = 0; k < 2; ++k) dst[n][k] = *(const PG8_LAS bf16x8*)(lds + PG8_SB(b, h) + boff + n * 2048 + k * 1024); } } while (0)
#define PG8_MMA(ai, bj, At, Bt) do { __builtin_amdgcn_s_setprio(1); \
        if constexpr (FP8) { _Pragma("unroll") for (int m = 0; m < 4; ++m) _Pragma("unroll") for (int n = 0; n < 2; ++n) \
            asm volatile("v_mfma_scale_f32_16x16x128_f8f6f4 %0, %1, %2, %0, %3, %3 op_sel_hi:[0,0,0]" : "+v"(acc[ai][bj][m][n]) : "v"(Bt##8[n]), "v"(At##8[m]), "v"(sc127));     \
            } \
        else if constexpr (I8) { _Pragma("unroll") for (int m = 0; m < 4; ++m) _Pragma("unroll") for (int n = 0; n < 2; ++n) _Pragma("unroll") for (int k = 0; k < 2; ++k) \
            acc[ai][bj][m][n] = __builtin_bit_cast(f32x4, __builtin_amdgcn_mfma_i32_16x16x64_i8(__builtin_bit_cast(i32x4, Bt[n][k]), __builtin_bit_cast(i32x4, At[m][k]), __builtin_bit_cast(i32x4, acc[ai][bj][m][n]), 0, 0, 0)); } \
        else { _Pragma("unroll") for (int m = 0; m < 4; ++m) _Pragma("unroll") for (int n = 0; n < 2; ++n) _Pragma("unroll") for (int k = 0; k < 2; ++k) \
            acc[ai][bj][m][n] = __builtin_amdgcn_mfma_f32_16x16x32_bf16(Bt[n][k], At[m][k], acc[ai][bj][m][n], 0, 0, 0); } \
        __builtin_amdgcn_s_setprio(0); } while (0)
#define PG8_WAIT_V(n) asm volatile("s_waitcnt vmcnt(" #n ")" ::: "memory")
#define PG8_WAIT_L(n) asm volatile("s_waitcnt lgkmcnt(" #n ")" ::: "memory")
#define PG8_BAR __builtin_amdgcn_s_barrier()
#define PG8_SCHED __builtin_amdgcn_sched_barrier(0)
    Unit cur, nxt; int ui = 0;
    if (!S.next(0, cur)) return;
    f32x4 acc[2][2][4][2];
#pragma unroll
    for (int a = 0; a < 2; ++a)
#pragma unroll
        for (int b = 0; b < 2; ++b)
#pragma unroll
            for (int m = 0; m < 4; ++m)
#pragma unroll
                for (int n = 0; n < 2; ++n) acc[a][b][m][n] = (f32x4){0.f, 0.f, 0.f, 0.f};
    bf16x8 At[4][2], B0[2][2], B1[2][2]; i32x8 At8[4], B08[2], B18[2];
    int sc127 = 127; asm volatile("" : "+v"(sc127));
    const char* cA = (const char*)g.A + (size_t)cur.pm * tstep; const char* cB = (const char*)g.Bt + (size_t)cur.pn * tstep;
    S.a_ready(cur);
    if constexpr (SP2) {
        PG8_STAGE(PG8_SB(0, 0), cB, voffB); PG8_STAGE(PG8_SB(0, 1), cB + hstep, voffB); PG8_STAGE(PG8_SA(0, 0), cA, voffA); PG8_STAGE(PG8_SA(0, 1), cA + hstep, voffA);
        if (wr == 1) PG8_BAR;
        PG8_WAIT_V(2); PG8_BAR;
        PG8_STAGE(PG8_SB(1, 0), cB + kstep, voffB); PG8_STAGE(PG8_SA(1, 0), cA + kstep, voffA); PG8_STAGE(PG8_SB(1, 1), cB + hstep + kstep, voffB);
        PG8_WAIT_V(6); PG8_BAR;
    } else {
        PG8_STAGE(PG8_SB(0, 0), cB, voffB); PG8_STAGE(PG8_SA(0, 0), cA, voffA); PG8_STAGE(PG8_SB(0, 1), cB + hstep, voffB); PG8_STAGE(PG8_SA(0, 1), cA + hstep, voffA);
        if (wr == 1) PG8_BAR;
        PG8_WAIT_V(4); PG8_BAR;
        PG8_STAGE(PG8_SB(1, 0), cB + kstep, voffB); PG8_STAGE(PG8_SA(1, 0), cA + kstep, voffA); PG8_STAGE(PG8_SB(1, 1), cB + hstep + kstep, voffB);
        PG8_WAIT_V(6); PG8_BAR;
    }
    for (;;) {
        const bool has_next = S.next(ui + 1, nxt);
        const char* nA = has_next ? (const char*)g.A + (size_t)nxt.pm * tstep : cA; const char* nB = has_next ? (const char*)g.Bt + (size_t)nxt.pn * tstep : cB;
        for (int t = 0; t < nt; t += 2) {
            if constexpr (Epi::HAS_MID) { if (t == Epi::MID_T) E.mid(acc, cur, wr, wc, fr, fq); }
            const bool last = (t == nt - 2);
            const char* a1 = cA + (size_t)(t + 1) * kstep;
            const char* a2 = last ? nA : cA + (size_t)(t + 2) * kstep; const char* b2 = last ? nB : cB + (size_t)(t + 2) * kstep;
            const char* a3 = a2 + kstep; const char* b3 = b2 + kstep;
            if (last && has_next) S.a_ready(nxt);
            if constexpr (SP2) {
            PG8_LDB(B0, 0, 0); PG8_LDB(B1, 0, 1); PG8_SCHED; PG8_LDA(At, 0, 0); PG8_STAGE(PG8_SA(1, 1), a1 + hstep, voffA);
            PG8_WAIT_V(8); PG8_WAIT_L(0); PG8_BAR; PG8_MMA(0, 0, At, B0); PG8_MMA(0, 1, At, B1); PG8_BAR; PG8_SCHED;
            PG8_LDA(At, 0, 1); PG8_STAGE(PG8_SB(0, 0), b2, voffB); PG8_STAGE(PG8_SB(0, 1), b2 + hstep, voffB); PG8_STAGE(PG8_SA(0, 0), a2, voffA);
            PG8_WAIT_V(8); PG8_WAIT_L(0); PG8_BAR; PG8_MMA(1, 0, At, B0); PG8_MMA(1, 1, At, B1); PG8_BAR; PG8_SCHED;
            PG8_LDB(B0, 1, 0); PG8_LDB(B1, 1, 1); PG8_SCHED; PG8_LDA(At, 1, 0); PG8_STAGE(PG8_SA(0, 1), a2 + hstep, voffA);
            PG8_WAIT_V(8); PG8_WAIT_L(0); PG8_BAR; PG8_MMA(0, 0, At, B0); PG8_MMA(0, 1, At, B1); PG8_BAR; PG8_SCHED;
            PG8_LDA(At, 1, 1); PG8_STAGE(PG8_SB(1, 0), b3, voffB); PG8_STAGE(PG8_SB(1, 1), b3 + hstep, voffB); PG8_STAGE(PG8_SA(1, 0), a3, voffA);
            PG8_WAIT_V(8); PG8_WAIT_L(0); PG8_BAR; PG8_MMA(1, 0, At, B0); PG8_MMA(1, 1, At, B1); PG8_BAR; PG8_SCHED;
            } else {
            PG8_LDB(B0, 0, 0); PG8_SCHED; PG8_LDA(At, 0, 0); PG8_STAGE(PG8_SA(1, 1), a1 + hstep, voffA);
            PG8_WAIT_L(8); PG8_BAR; PG8_WAIT_L(0); PG8_MMA(0, 0, At, B0); PG8_BAR; PG8_SCHED;
            PG8_LDB(B1, 0, 1); PG8_STAGE(PG8_SB(0, 0), b2, voffB);
            PG8_BAR; PG8_WAIT_L(0); PG8_MMA(0, 1, At, B1); PG8_BAR;
            PG8_LDA(At, 0, 1); PG8_STAGE(PG8_SA(0, 0), a2, voffA);
            PG8_BAR; PG8_WAIT_L(0); PG8_MMA(1, 0, At, B0); PG8_BAR; PG8_SCHED;
            PG8_STAGE(PG8_SB(0, 1), b2 + hstep, voffB);
            PG8_WAIT_V(6); PG8_BAR; PG8_MMA(1, 1, At, B1); PG8_BAR;
            PG8_LDB(B0, 1, 0); PG8_SCHED; PG8_LDA(At, 1, 0); PG8_STAGE(PG8_SA(0, 1), a2 + hstep, voffA);
            PG8_WAIT_L(8); PG8_BAR; PG8_WAIT_L(0); PG8_MMA(0, 0, At, B0); PG8_BAR; PG8_SCHED;
            PG8_LDB(B1, 1, 1); PG8_STAGE(PG8_SB(1, 0), b3, voffB);
            PG8_BAR; PG8_WAIT_L(0); PG8_MMA(0, 1, At, B1); PG8_BAR;
            PG8_LDA(At, 1, 1); PG8_STAGE(PG8_SA(1, 0), a3, voffA);
            PG8_BAR; PG8_WAIT_L(0); PG8_MMA(1, 0, At, B0); PG8_BAR; PG8_SCHED;
            PG8_STAGE(PG8_SB(1, 1), b3 + hstep, voffB);
            PG8_WAIT_V(6); PG8_BAR; PG8_MMA(1, 1, At, B1); PG8_BAR;
            }
        }
        if constexpr (FP8) asm volatile("s_nop 15\n\ts_nop 15" ::: "memory");
        if constexpr (ALIGN_EPI) { if (wr == 0) PG8_BAR; }
        if constexpr (!Epi::AFTER_DRAIN) { E(acc, cur, wr, wc, fr, fq); S.done(cur); }
        if (!has_next) break;
#pragma unroll
        for (int a = 0; a < 2; ++a)
#pragma unroll
            for (int b = 0; b < 2; ++b)
#pragma unroll
                for (int m = 0; m < 4; ++m)
#pragma unroll
                    for (int n = 0; n < 2; ++n) acc[a][b][m][n] = (f32x4){0.f, 0.f, 0.f, 0.f};
        cur = nxt; cA = nA; cB = nB; ++ui;
        if constexpr (ALIGN_EPI) { if (wr == 1) PG8_BAR; }
    }
    PG8_WAIT_V(0);
    if constexpr (!ALIGN_EPI) { if (wr == 0) PG8_BAR; }
    PG8_BAR;
    if constexpr (Epi::AFTER_DRAIN) { E.fused(acc, cur, wr, wc, fr, fq, lds, wid, lane); S.done(cur); }
#undef PG8_SA
#undef PG8_SB
#undef PG8_STAGE
#undef PG8_LDA
#undef PG8_LD8
#undef PG8_LDB
#undef PG8_MMA
#undef PG8_WAIT_V
#undef PG8_WAIT_L
#undef PG8_BAR
#undef PG8_SCHED
}
}


namespace att {
#define ALAS __attribute__((address_space(3)))
typedef unsigned short bf16;
typedef short bf16x8 __attribute__((ext_vector_type(8)));
typedef short s16x4 __attribute__((ext_vector_type(4)));
typedef float f32x16 __attribute__((ext_vector_type(16)));
typedef float f32x4 __attribute__((ext_vector_type(4)));
typedef float f32x2 __attribute__((ext_vector_type(2)));
typedef unsigned u32x4 __attribute__((ext_vector_type(4)));
typedef __bf16 bf16x2_t __attribute__((ext_vector_type(2)));
constexpr int SEQ = 4096;
constexpr int VPITCH = 144;
constexpr float LOG2E = 1.4426950408889634f, LN2 = 0.6931471805599453f;
__device__ __forceinline__ unsigned pkbf(float lo, float hi) { f32x2 v = {lo, hi}; bf16x2_t b = __builtin_convertvector(v, bf16x2_t); return __builtin_bit_cast(unsigned, b); }
__device__ __forceinline__ void wave_lds_sync() { asm volatile("s_waitcnt lgkmcnt(0)" ::: "memory"); }
__device__ __forceinline__ s16x4 vtr(const ALAS unsigned char* p) { return __builtin_bit_cast(s16x4, __builtin_amdgcn_ds_read_tr16_b64_v4i16((ALAS s16x4*)p)); }
__device__ __forceinline__ int crow(int r, int hi) { return (r & 3) + 8 * (r >> 2) + 4 * hi; }

__device__ __forceinline__ void pv_tile(f32x16& o0, f32x16& o1, const float (&a)[16], const ALAS unsigned char* vt, int lane) {
    const int g = lane >> 4, i = lane & 15, q_ = i >> 2, p_ = i & 3, h = lane >> 5;
    const ALAS unsigned char* vb = vt + (8 * h + q_) * VPITCH + (16 * (g & 1) + 4 * p_) * 2;
    u32x4 pw0, pw1;
    pw0.x = pkbf(a[0], a[1]); pw0.y = pkbf(a[2], a[3]); pw0.z = pkbf(a[4], a[5]); pw0.w = pkbf(a[6], a[7]);
    pw1.x = pkbf(a[8], a[9]); pw1.y = pkbf(a[10], a[11]); pw1.z = pkbf(a[12], a[13]); pw1.w = pkbf(a[14], a[15]);
    const bf16x8 pa0 = __builtin_bit_cast(bf16x8, pw0), pa1 = __builtin_bit_cast(bf16x8, pw1);
#pragma unroll
    for (int s = 0; s < 2; ++s) {
        const s16x4 l0 = vtr(vb + (16 * s) * VPITCH), h0 = vtr(vb + (16 * s + 4) * VPITCH);
        const s16x4 l1 = vtr(vb + (16 * s) * VPITCH + 64), h1 = vtr(vb + (16 * s + 4) * VPITCH + 64);
        const bf16x8 v0 = (bf16x8){l0[0], l0[1], l0[2], l0[3], h0[0], h0[1], h0[2], h0[3]};
        const bf16x8 v1 = (bf16x8){l1[0], l1[1], l1[2], l1[3], h1[0], h1[1], h1[2], h1[3]};
        o0 = __builtin_amdgcn_mfma_f32_32x32x16_bf16(s ? pa1 : pa0, v0, o0, 0, 0, 0);
        o1 = __builtin_amdgcn_mfma_f32_32x32x16_bf16(s ? pa1 : pa0, v1, o1, 0, 0, 0);
    }
}
__device__ __forceinline__ void bcast_rows(float v, ALAS float* sc, int r32, int hi, float (&out)[16]) {
    if (hi == 0) sc[r32] = v;
    wave_lds_sync();
#pragma unroll
    for (int g = 0; g < 4; ++g) { const f32x4 t = *(const ALAS f32x4*)(sc + 8 * g + 4 * hi); out[4 * g] = t[0]; out[4 * g + 1] = t[1]; out[4 * g + 2] = t[2]; out[4 * g + 3] = t[3]; }
    wave_lds_sync();
}
__device__ __forceinline__ void store_o(const f32x16& o0, const f32x16& o1, ALAS unsigned char* stg, bf16* dst  , size_t rstride_elems, int lane) {
    const int r32 = lane & 31, hi = lane >> 5;
    wave_lds_sync();
#pragma unroll
    for (int r = 0; r < 16; ++r) { const int q = crow(r, hi);
        *(ALAS unsigned short*)(stg + q * VPITCH + r32 * 2) = (unsigned short)(pkbf(o0[r], 0.f) & 0xffffu);
        *(ALAS unsigned short*)(stg + q * VPITCH + 64 + r32 * 2) = (unsigned short)(pkbf(o1[r], 0.f) & 0xffffu); }
    wave_lds_sync();
#pragma unroll
    for (int i = 0; i < 4; ++i) { const int row = 8 * i + (lane >> 3), ch = lane & 7; const u32x4 v = *(const ALAS u32x4*)(stg + row * VPITCH + ch * 16); *(u32x4*)(dst + (size_t)row * rstride_elems + ch * 8) = v; }
    wave_lds_sync();
}

__device__ __forceinline__ void sb_item(const bf16* QS, const bf16* KS, const bf16* VS, bf16* OC, int b, int h, int qt, ALAS unsigned char* wl, int lane) {
    const int r32 = lane & 31, hi = lane >> 5;
    const int t0 = qt * 32; const size_t rowb = (size_t)b * SEQ;
    const int kperm = (r32 & ~12) | ((r32 & 4) << 1) | ((r32 & 8) >> 1);
    bf16x8 qf[4];
    { const bf16* qp = QS + (rowb + t0 + r32) * 512 + h * 64 + hi * 8;
#pragma unroll
      for (int d0 = 0; d0 < 4; ++d0) qf[d0] = *(const bf16x8*)(qp + d0 * 16); }
    f32x16 o0 = {}, o1 = {}; float R = 0.f;
    for (int key0 = t0; key0 >= 0; key0 -= 32) {
        const bf16* kp = KS + (rowb + key0 + kperm) * 512 + h * 64 + hi * 8;
        bf16x8 kf[4];
#pragma unroll
        for (int d0 = 0; d0 < 4; ++d0) kf[d0] = *(const bf16x8*)(kp + d0 * 16);
        u32x4 vv[4];
#pragma unroll
        for (int i = 0; i < 4; ++i) vv[i] = *(const u32x4*)(VS + (rowb + key0 + 8 * i + (lane >> 3)) * 512 + h * 64 + (lane & 7) * 8);
        f32x16 p = {};
#pragma unroll
        for (int d0 = 0; d0 < 4; ++d0) p = __builtin_amdgcn_mfma_f32_32x32x16_bf16(kf[d0], qf[d0], p, 0, 0, 0);
#pragma unroll
        for (int i = 0; i < 4; ++i) *(ALAS u32x4*)(wl + (8 * i + (lane >> 3)) * VPITCH + (lane & 7) * 16) = vv[i];
        const bool diag = (key0 == t0);
        float z2[16], L2[16];
#pragma unroll
        for (int r = 0; r < 16; ++r) { const int kk = (r & 7) + 8 * hi + 16 * (r >> 3); const float zz = p[r];
            const float sp = fmaxf(zz, 0.f) + __builtin_amdgcn_logf(1.0f + __builtin_amdgcn_exp2f(-fabsf(zz)));
            const bool valid = !diag || (kk < r32); z2[r] = zz; L2[r] = valid ? sp : 0.f; }
        float c[16];
        c[15] = L2[15];
#pragma unroll
        for (int r = 14; r >= 8; --r) c[r] = c[r + 1] + L2[r];
        c[7] = L2[7];
#pragma unroll
        for (int r = 6; r >= 0; --r) c[r] = c[r + 1] + L2[r];
        const float TB = c[8], TA = c[0];
        const float TBo = __shfl_xor(TB, 32), TAo = __shfl_xor(TA, 32);
        const float offB = R + (hi ? 0.f : TBo);
        const float offA = R + TB + TBo + (hi ? 0.f : TAo);
        float a[16];
#pragma unroll
        for (int r = 0; r < 16; ++r) { const int kk = (r & 7) + 8 * hi + 16 * (r >> 3); const bool valid = !diag || (kk < r32);
            const float e = __builtin_amdgcn_exp2f(z2[r] - (c[r] + (r < 8 ? offA : offB))); a[r] = valid ? e : 0.f; }
        R += (TA + TB) + (TAo + TBo);
        wave_lds_sync();
        pv_tile(o0, o1, a, wl, lane);
        wave_lds_sync();
        if (__all(R > 40.0f * LOG2E)) break;
    }
    store_o(o0, o1, wl, OC + (rowb + t0) * 768 + h * 64, 768, lane);
}

constexpr int DLU_WAVE = 5120;
constexpr int DLU_O = 8 * DLU_WAVE, DLU_M = DLU_O + 512 * 128, DLU_L = DLU_M + 2048, DLU_BYTES = DLU_L + 2048;
__device__ __forceinline__ void dl_unit(const bf16* QD, const bf16* KD, const bf16* VD, bf16* OC, int b, int j, int blk, ALAS unsigned char* lds, int wave, int lane) {
    const int r32 = lane & 31, hi = lane >> 5;
    const size_t rowb = (size_t)b * SEQ;
    const int t0 = 512 * blk;
    const int kperm = (r32 & ~12) | ((r32 & 4) << 1) | ((r32 & 8) >> 1);
    ALAS unsigned char* wl = lds + wave * DLU_WAVE;
    ALAS float* sc = (ALAS float*)(wl + 4608);
    ALAS unsigned short* OL = (ALAS unsigned short*)(lds + DLU_O);
    ALAS float* ML = (ALAS float*)(lds + DLU_M); ALAS float* LL = (ALAS float*)(lds + DLU_L);
    for (int g = 2; g >= 0; --g) {
        const int hh = 4 * g + j, sh = 2 * g, r = 1 << sh;
        const float slope2 = __builtin_amdgcn_exp2f(-8.0f * (float)(hh + 1) / 12.0f) * LOG2E;
        const float sr = slope2 * (float)r;
        for (int it = wave; it < 16; it += 8) {
            const int q0 = g == 2 ? it : g == 1 ? (it & 3) + 128 * (it >> 2) : 32 * it;
            const int tq = t0 + q0 + r * r32, tmax = t0 + q0 + 31 * r;
            bf16x8 qf[4];
            { const bf16* qp = QD + (rowb + tq) * 768 + hh * 64 + hi * 8;
#pragma unroll
              for (int d0 = 0; d0 < 4; ++d0) qf[d0] = *(const bf16x8*)(qp + d0 * 16); }
            const int klo = 31 - r32; int khi = klo + 128; { const int kmaxtok = tmax >> sh; khi = khi < kmaxtok ? khi : kmaxtok; }
            const unsigned krange = (unsigned)(khi - klo);
            f32x16 o0 = {}, o1 = {}; float mrun = -3.0e38f, lrun = 0.f;
            if (g != 2) {
                mrun = ML[q0 + r * r32]; lrun = hi ? 0.f : LL[q0 + r * r32];
#pragma unroll
                for (int q = 0; q < 16; ++q) { const int tl = q0 + r * crow(q, hi);
                    o0[q] = __uint_as_float((unsigned)OL[tl * 64 + r32] << 16); o1[q] = __uint_as_float((unsigned)OL[tl * 64 + 32 + r32] << 16); }
            }
            for (int kt = 0; kt < 5; ++kt) {
                int sk = tmax - r * (32 * kt + kperm); sk = sk < 0 ? 0 : sk;
                const bf16* kp = KD + (rowb + sk) * 768 + hh * 64 + hi * 8;
                bf16x8 kf[4];
#pragma unroll
                for (int d0 = 0; d0 < 4; ++d0) kf[d0] = *(const bf16x8*)(kp + d0 * 16);
                u32x4 vv[4];
#pragma unroll
                for (int i = 0; i < 4; ++i) { int sv = tmax - r * (32 * kt + 8 * i + (lane >> 3)); sv = sv < 0 ? 0 : sv; vv[i] = *(const u32x4*)(VD + (rowb + sv) * 768 + hh * 64 + (lane & 7) * 8); }
                const int dk = 32 * kt + 8 * hi - klo;
                const float tb = -sr * (float)dk;
                f32x16 p;
#pragma unroll
                for (int q = 0; q < 16; ++q) p[q] = tb - sr * (float)((q & 7) + 16 * (q >> 3));
#pragma unroll
                for (int d0 = 0; d0 < 4; ++d0) p = __builtin_amdgcn_mfma_f32_32x32x16_bf16(kf[d0], qf[d0], p, 0, 0, 0);
#pragma unroll
                for (int i = 0; i < 4; ++i) *(ALAS u32x4*)(wl + (8 * i + (lane >> 3)) * VPITCH + (lane & 7) * 16) = vv[i];
                float z2[16]; float mt = -3.0e38f;
#pragma unroll
                for (int q = 0; q < 16; ++q) { const bool valid = (unsigned)(dk + ((q & 7) + 16 * (q >> 3))) <= krange; z2[q] = valid ? p[q] : -INFINITY; mt = fmaxf(mt, z2[q]); }
                mt = fmaxf(mt, __shfl_xor(mt, 32));
                if (__any(mt > mrun + 8.0f)) {
                    const float mnew = fmaxf(mrun, mt); const float alpha = __builtin_amdgcn_exp2f(mrun - mnew);
                    lrun *= alpha; float al[16]; bcast_rows(alpha, sc, r32, hi, al);
#pragma unroll
                    for (int q = 0; q < 16; ++q) { o0[q] *= al[q]; o1[q] *= al[q]; }
                    mrun = mnew;
                }
                float a[16]; float ls = 0.f;
#pragma unroll
                for (int q = 0; q < 16; ++q) { a[q] = __builtin_amdgcn_exp2f(z2[q] - mrun); ls += a[q]; }
                lrun += ls;
                wave_lds_sync();
                pv_tile(o0, o1, a, wl, lane);
                wave_lds_sync();
            }
            const float ltot = lrun + __shfl_xor(lrun, 32);
            if (g != 0) {
                if (hi == 0) { ML[q0 + r * r32] = mrun; LL[q0 + r * r32] = ltot; }
#pragma unroll
                for (int q = 0; q < 16; ++q) { const int tl = q0 + r * crow(q, hi);
                    OL[tl * 64 + r32] = (unsigned short)(pkbf(o0[q], 0.f) & 0xffffu); OL[tl * 64 + 32 + r32] = (unsigned short)(pkbf(o1[q], 0.f) & 0xffffu); }
            } else {
                float il[16]; bcast_rows(1.0f / ltot, sc, r32, hi, il);
#pragma unroll
                for (int q = 0; q < 16; ++q) { o0[q] *= il[q]; o1[q] *= il[q]; }
                store_o(o0, o1, wl, OC + (rowb + t0 + q0) * 768 + 512 + j * 64, 768, lane);
            }
        }
        asm volatile("s_waitcnt lgkmcnt(0)" ::: "memory"); __builtin_amdgcn_s_barrier(); asm volatile("" ::: "memory");
    }
}
#undef ALAS
}

constexpr int NWAVES = 8;
#ifndef MK_N_LAUNCHES
#define MK_N_LAUNCHES 1
#endif
#ifndef MK_LAST_PHASE
#define MK_LAST_PHASE 8
#endif
constexpr int N_LAUNCHES = MK_N_LAUNCHES;
constexpr int PER_PHASE = 8;

constexpr int BATCH = 16, SEQ = 4096, D = 1024, T = BATCH * SEQ;
constexpr int N1 = 5888;
constexpr int NEXP = 16384;
constexpr size_t MiB = 1u << 20;
constexpr size_t WS_CTL = 0, CTL_ZERO_BYTES = 1 * MiB;
constexpr size_t WS_WIN = 2 * MiB;
constexpr size_t WS_WCAT = 16 * MiB;
constexpr size_t WS_WOUT = 18 * MiB;
constexpr size_t WS_WC = 20 * MiB;
constexpr size_t WS_RINV1 = 24 * MiB;
constexpr size_t WS_RINV2 = 25 * MiB;
constexpr size_t WS_USC = 25 * MiB + 512 * 1024, WS_VSC = 25 * MiB + 768 * 1024;
constexpr size_t WS_SSQ = 26 * MiB;
constexpr size_t WS_U8 = 32 * MiB;
constexpr size_t WS_V8 = 64 * MiB;
constexpr size_t WS_IDS = 96 * MiB;
constexpr size_t WS_GW = 112 * MiB;
constexpr size_t WS_XB = 144 * MiB;
constexpr size_t WS_OC = 880 * MiB;
constexpr size_t WS_QS = 272 * MiB, WS_KS = 336 * MiB, WS_VS = 400 * MiB;
constexpr size_t WS_QD = 464 * MiB, WS_KD = 560 * MiB, WS_VD = 656 * MiB;
constexpr size_t WS_GT = 752 * MiB;
constexpr size_t WS_COEF = 272 * MiB;
constexpr size_t WS_MIX = 272 * MiB;
constexpr size_t WS_X1B = 400 * MiB;
constexpr size_t WS_HQ = 528 * MiB;
constexpr size_t WS_HS2 = 24 * MiB + 512 * 1024;
constexpr size_t WS_XB8 = 72 * MiB;
constexpr size_t WS_WG8 = 40 * MiB;
constexpr size_t WS_PART = 56 * MiB;
constexpr size_t WS_RMAXF = 24 * MiB + 768 * 1024;
constexpr size_t WS_WOS = 46 * MiB + 512 * 1024;
constexpr size_t WS_WCS = 46 * MiB;
constexpr size_t WS_WCF = 48 * MiB;
constexpr size_t WS_XS = 24 * MiB + 256 * 1024;
constexpr size_t WS_GCS = 47 * MiB;
constexpr size_t WS_END = 1008 * MiB;
constexpr int CW_BAR = 4096;
constexpr int CW_OMAX = 28672;
constexpr int CW_RMAX = 65536;
constexpr int CW_RCNT = 131072;
constexpr int CW_WMAX = 24576;
constexpr int CW_GMAX = 16384;
constexpr int CW_XRANK = 8192;

constexpr int RING_OFF = 0, RING_BYTES = 131072;
constexpr int LDSCTL_OFF = 143360, MISC_OFF = LDSCTL_OFF + 320;
constexpr int LDS_BYTES = 147456;
static_assert(MISC_OFF + 128 <= LDS_BYTES, "LDS map");
#define GAS __attribute__((address_space(1)))
#define LAS __attribute__((address_space(3)))
typedef unsigned short bf16;
typedef unsigned v4u __attribute__((ext_vector_type(4)));
typedef float f32x4 __attribute__((ext_vector_type(4)));
typedef short bf16x8 __attribute__((ext_vector_type(8)));
typedef GAS unsigned gu32;
typedef GAS unsigned long long gu64;
#define RLX_AGENT __ATOMIC_RELAXED, __HIP_MEMORY_SCOPE_AGENT
#define LDS_WAIT() asm volatile("s_waitcnt lgkmcnt(0)" ::: "memory")
#define VM_WAIT() asm volatile("s_waitcnt vmcnt(0)" ::: "memory")
__device__ __forceinline__ unsigned long long rt() { return __builtin_amdgcn_s_memrealtime(); }
__device__ __forceinline__ unsigned f2bf(float f) { unsigned u = __builtin_bit_cast(unsigned, f); return (u + 0x7fffu + ((u >> 16) & 1u)) >> 16; }
__device__ __forceinline__ unsigned pk2(float lo, float hi) { return f2bf(lo) | (f2bf(hi) << 16); }

#define XB_TMO      128
#define XB_XCNT(j)  (256  + 64 * (j))
#define XB_XSUB(j)  (1280 + 64 * (j))
#define XB_XGEN(j)  (2304 + 64 * (j))
#define XB_TOP      3328
#define XB_TOPGEN   3392
#define XCD_BAR_WORDS 3456
#define XB_SPIN_CAP (1u << 18)

__device__ __forceinline__ unsigned xb_ld(unsigned* p)              { return __hip_atomic_load(p, __ATOMIC_RELAXED, __HIP_MEMORY_SCOPE_AGENT); }
__device__ __forceinline__ unsigned xb_add(unsigned* p, unsigned v) { return __hip_atomic_fetch_add(p, v, __ATOMIC_RELAXED, __HIP_MEMORY_SCOPE_AGENT); }
__device__ __forceinline__ unsigned xb_xcc_id() { return (unsigned)__builtin_amdgcn_s_getreg((3 << 11) | 20) & 0xFu; }
#define XB_SPIN(cond, bar) do { unsigned _sp = 0; while (cond) { __builtin_amdgcn_s_sleep(1); \
    if ((++_sp & 255u) == 0u) { if (xb_ld(&(bar)[XB_TMO])) break; if (_sp > XB_SPIN_CAP) { atomicAdd(&(bar)[XB_TMO], 1u); break; } } } } while (0)

struct XcdBarrier {
    unsigned* bar; unsigned x;
    volatile LAS unsigned* st;
};

__device__ __forceinline__ XcdBarrier xcd_barrier_post(unsigned* bar, volatile LAS unsigned* st) {
    XcdBarrier b; b.bar = bar; b.x = xb_xcc_id(); b.st = st;
    if (threadIdx.x == 0) (void)xb_add(&bar[XB_XCNT(b.x)], 1u);
    return b;
}
__device__ __forceinline__ void xcd_barrier_complete(unsigned* bar, unsigned x, unsigned& nloc, unsigned& nx) {
    const unsigned G = gridDim.x * gridDim.y * gridDim.z;
    unsigned sum, cnt, mine, sp = 0u;
    for (;;) {
        sum = 0u; cnt = 0u; mine = 0u;
#pragma unroll
        for (unsigned j = 0; j < 16; ++j) { const unsigned c = xb_ld(&bar[XB_XCNT(j)]); sum += c; cnt += (c > 0u) ? 1u : 0u; mine = (j == x) ? c : mine; }
        if (sum == G) break;
        __builtin_amdgcn_s_sleep(1);
        if ((++sp & 255u) == 0u) { if (xb_ld(&bar[XB_TMO])) break; if (sp > XB_SPIN_CAP) { atomicAdd(&bar[XB_TMO], 1u); break; } }
    }
    nloc = mine > 0u ? mine : 1u; nx = cnt > 0u ? cnt : 1u;
}

__device__ __forceinline__ void xcd_barrier(const XcdBarrier& b) {
    asm volatile("s_waitcnt vmcnt(0)" ::: "memory");
    __syncthreads();
    if (threadIdx.x == 0) {
        unsigned* bar = b.bar;
        __builtin_amdgcn_s_waitcnt(0);
        unsigned nloc = b.st[0], nx = b.st[1];
        if (nloc == 0u) { xcd_barrier_complete(bar, b.x, nloc, nx); b.st[0] = nloc; b.st[1] = nx; }
        const unsigned old = xb_add(&bar[XB_XSUB(b.x)], 1u);
        const unsigned gen = old / nloc;
        if (old + 1u == (gen + 1u) * nloc) {
            __builtin_amdgcn_fence(__ATOMIC_RELEASE, "agent");
            asm volatile("s_waitcnt vmcnt(0)" ::: "memory");
            const unsigned og = xb_add(&bar[XB_TOP], 1u);
            const unsigned tg = og / nx;
            if (og + 1u == (tg + 1u) * nx) xb_add(&bar[XB_TOPGEN], 1u);
            else XB_SPIN(xb_ld(&bar[XB_TOPGEN]) == tg, bar);
            __builtin_amdgcn_fence(__ATOMIC_ACQUIRE, "agent");
            xb_add(&bar[XB_XGEN(b.x)], 1u);
            asm volatile("s_waitcnt vmcnt(0)" ::: "memory");
        } else {
            XB_SPIN(xb_ld(&bar[XB_XGEN(b.x)]) == gen, bar);
            __builtin_amdgcn_fence(__ATOMIC_ACQUIRE, "agent");
            asm volatile("s_waitcnt vmcnt(0)" ::: "memory");
        }
    }
    __syncthreads();
}

typedef float f32x2 __attribute__((ext_vector_type(2)));
typedef unsigned v2u __attribute__((ext_vector_type(2)));
typedef _Float16 h2_t __attribute__((ext_vector_type(2)));
struct Frame {
    LAS unsigned char* lds;
    volatile LAS unsigned* MISC;
    gu32* ctl;
    int tid, lane, wave;
    int vcu, G;
};
__device__ __forceinline__ float wave_sum(float v) {
#pragma unroll
    for (int o = 1; o < 64; o <<= 1) v += __shfl_xor(v, o);
    return v;
}
__device__ __forceinline__ float wave_max(float v) {
#pragma unroll
    for (int o = 1; o < 64; o <<= 1) v = fmaxf(v, __shfl_xor(v, o));
    return v;
}
constexpr int NB16 = 0, N8 = 5888 - NB16;
__device__ __forceinline__ int win_row(int n) { if (n < 1536 || n >= 3072) return n; const int t = (n - 1536) >> 8, ln = (n - 1536) & 255, hl = ln >> 6, d = ln & 63; return 1536 + t * 256 + 32 * hl + (d & 31) + 128 * (d >> 5); }
__device__ __forceinline__ void p0_transpose_item(const float* W, int N, const float* gain, bf16* WT, int ldt, int koff, int mode, LAS float* scr, int item, int lane) {
    const int nblk = N / 32, kb = item / nblk, nb = item % nblk, k0 = 64 * kb, n0 = 32 * nb;
#pragma unroll 8
    for (int i = 0; i < 32; ++i) { const int kk = 2 * i + (lane >> 5); float v = W[(size_t)(k0 + kk) * N + n0 + (lane & 31)]; if (gain) v *= gain[k0 + kk]; scr[kk * 33 + (lane & 31)] = v; }
    LDS_WAIT(); asm volatile("" ::: "memory");
    const int c = lane & 7;
#pragma unroll
    for (int j = 0; j < 4; ++j) { const int n = (lane >> 3) + 8 * j; const LAS float* s = scr + (8 * c) * 33 + n;
        v4u o; o.x = pk2(s[0 * 33], s[1 * 33]); o.y = pk2(s[2 * 33], s[3 * 33]); o.z = pk2(s[4 * 33], s[5 * 33]); o.w = pk2(s[6 * 33], s[7 * 33]);
        const int rown = mode ? win_row(n0 + n) : (n0 + n);
        *(GAS v4u*)(WT + (size_t)rown * ldt + koff + k0 + 8 * c) = o; }
    LDS_WAIT(); asm volatile("" ::: "memory");
}
__device__ __forceinline__ void p0_gate_max_item(const float* W, int N, const float* gain, unsigned* gmax, int kb, int n0, int lane) {
    const int k0 = 64 * kb; float am = 0.f;
#pragma unroll 8
    for (int i = 0; i < 32; ++i) { const int kk = 2 * i + (lane >> 5); am = fmaxf(am, fabsf(W[(size_t)(k0 + kk) * N + n0 + (lane & 31)] * (gain ? gain[k0 + kk] : 1.0f))); }
    am = fmaxf(am, __shfl_xor(am, 32));
    if (lane < 32) atomicMax(gmax + (n0 - NB16) + lane, __float_as_uint(am));
}
__device__ __forceinline__ void p0_gate_fp8_item(const float* W, int N, const float* gain, const unsigned* gmax, unsigned char* WG, float* cs, LAS float* scr, int item, int lane, int ncols = N8, bool perm = true) {
    const int kb = item / (ncols / 32), nb = item % (ncols / 32), k0 = 64 * kb, n0 = 32 * nb;
#pragma unroll 8
    for (int i = 0; i < 32; ++i) { const int kk = 2 * i + (lane >> 5); scr[kk * 33 + (lane & 31)] = W[(size_t)(k0 + kk) * N + NB16 + n0 + (lane & 31)] * (gain ? gain[k0 + kk] : 1.0f); }
    LDS_WAIT(); asm volatile("" ::: "memory");
    const int c = lane & 7;
#pragma unroll
    for (int j = 0; j < 4; ++j) { const int n = (lane >> 3) + 8 * j; const LAS float* sp = scr + (8 * c) * 33 + n;
        const float am = __uint_as_float(xb_ld((unsigned*)gmax + n0 + n)); const float sc = am > 0.f ? 127.0f / am : 0.f;
        unsigned p0 = 0, p1 = 0;
#pragma unroll
        for (int e = 0; e < 4; ++e) { p0 |= ((unsigned)(int)__builtin_rintf(sp[e * 33] * sc) & 0xffu) << (8 * e); p1 |= ((unsigned)(int)__builtin_rintf(sp[(4 + e) * 33] * sc) & 0xffu) << (8 * e); }
        const int prow = perm ? win_row(NB16 + n0 + n) - NB16 : n0 + n;
        *(GAS v2u*)(WG + (size_t)prow * 1024 + k0 + 8 * c) = (v2u){p0, p1};
        if (kb == 0 && c == 0) cs[prow] = am * (1.0f / 127.0f); }
    LDS_WAIT(); asm volatile("" ::: "memory");
}
__device__ __forceinline__ void quant_row_fp8(const float* src, const float* gain, unsigned char* dst, size_t slice_stride, float* scale_out, int lane) {
    f32x4 v[4]; float am = 0.f;
#pragma unroll
    for (int j = 0; j < 4; ++j) { v[j] = *(const GAS f32x4*)(src + 256 * j + 4 * lane); if (gain) v[j] = v[j] * *(const GAS f32x4*)(gain + 256 * j + 4 * lane);
        am = fmaxf(am, fmaxf(fmaxf(fabsf(v[j][0]), fabsf(v[j][1])), fmaxf(fabsf(v[j][2]), fabsf(v[j][3])))); }
    am = wave_max(am);
    const int ex = (int)((__float_as_uint(am) >> 23) & 0xffu);
    const float s = (ex == 0) ? 1.0f : __uint_as_float((unsigned)(127 + 7 - (ex - 127)) << 23);
    const float is = (ex == 0) ? 1.0f : __uint_as_float((unsigned)(127 - 7 + (ex - 127)) << 23);
    if (lane == 0) *scale_out = is;
#pragma unroll
    for (int j = 0; j < 4; ++j) { int pk = __builtin_amdgcn_cvt_pk_fp8_f32(v[j][0] * s, v[j][1] * s, 0, false); pk = __builtin_amdgcn_cvt_pk_fp8_f32(v[j][2] * s, v[j][3] * s, pk, true);
        const int col = 256 * j + 4 * lane; *(GAS int*)(dst + (size_t)(col >> 7) * slice_stride + (col & 127)) = pk; }
}
__device__ __forceinline__ void quant_row_fp4(const float* src, unsigned char* dst, size_t slice_stride, float* scale_out, int lane) {
    f32x4 v[4]; float am = 0.f;
#pragma unroll
    for (int j = 0; j < 4; ++j) { v[j] = *(const GAS f32x4*)(src + 256 * j + 4 * lane); am = fmaxf(am, fmaxf(fmaxf(fabsf(v[j][0]), fabsf(v[j][1])), fmaxf(fabsf(v[j][2]), fabsf(v[j][3])))); }
    am = wave_max(am);
    const float s = am > 0.f ? 6.0f / am : 0.f;
    if (lane == 0) *scale_out = am * (1.0f / 6.0f);
#pragma unroll
    for (int j = 0; j < 4; ++j) { unsigned pk = __builtin_amdgcn_cvt_scalef32_pk_fp4_f32(0u, v[j][0] * s, v[j][1] * s, 1.0f, 0); pk = __builtin_amdgcn_cvt_scalef32_pk_fp4_f32(pk, v[j][2] * s, v[j][3] * s, 1.0f, 1);
        *(GAS unsigned short*)(dst + (size_t)j * slice_stride + 2 * lane) = (unsigned short)(pk & 0xffffu); }
}
__device__ __forceinline__ void quant_row_i4(const float* src, const float* gain, unsigned char* dst, float* scale_out, int lane) {
    f32x4 v[4]; float am = 0.f, ss = 0.f;
    const int p16 = (lane >> 2) & 15, wl = lane & 3;
#pragma unroll
    for (int ld = 0; ld < 2; ++ld)
#pragma unroll
        for (int sn = 0; sn < 2; ++sn) { const int hd = 2 * (4 * ld + wl) + sn; const int idx = 256 * (hd >> 2) + 16 * p16 + 4 * (hd & 3);
            f32x4 t = *(const GAS f32x4*)(src + idx); if (gain) t = t * *(const GAS f32x4*)(gain + idx); v[2 * ld + sn] = t;
            am = fmaxf(am, fmaxf(fmaxf(fabsf(t[0]), fabsf(t[1])), fmaxf(fabsf(t[2]), fabsf(t[3])))); ss += (t[0] * t[0] + t[1] * t[1]) + (t[2] * t[2] + t[3] * t[3]); }
    am = wave_max(am); ss = wave_sum(ss);
    const float clipv = fminf(am, 2.5f * sqrtf(ss * (1.0f / 1024.0f)));
    const float s = clipv > 0.f ? 7.0f / clipv : 0.f;
    if (lane == 0) *scale_out = clipv * (1.0f / (7.0f * 16.0f));
#pragma unroll
    for (int ld = 0; ld < 2; ++ld) { unsigned pk = 0u;
#pragma unroll
        for (int b4 = 0; b4 < 4; ++b4) { int q0 = (int)__builtin_rintf(v[2 * ld][b4] * s), q1 = (int)__builtin_rintf(v[2 * ld + 1][b4] * s);
            q0 = q0 < -7 ? -7 : (q0 > 7 ? 7 : q0); q1 = q1 < -7 ? -7 : (q1 > 7 ? 7 : q1);
            pk |= ((unsigned)(q0 & 15) | ((unsigned)(q1 & 15) << 4)) << (8 * b4); }
        *(GAS unsigned*)(dst + ld * 256 + 16 * p16 + 4 * wl) = pk; }
}
__device__ __forceinline__ float gelu_f(float v) {
    const float av = fabsf(v), t = __builtin_amdgcn_rcpf(av * 0.2316418882f + 1.0f);
    float q = t * 0.5307027145f + (-0.7265760135f); q = q * t + 0.7107068705f; q = q * t + (-0.142248368f); q = q * t + 0.127414796f; q = q * t;
    const float e = __builtin_amdgcn_exp2f((v * v) * (-0.72134752044f));
    const float m = v * (q * e);
    return v < 0.f ? m : v - m;
}

struct Args { const float* in[14]; float* out; unsigned char* ws; int ph_lo, ph_hi, li, pad; };
__global__ void __launch_bounds__(NWAVES * 64, 2) fwd_kernel(Args args) {
    extern __shared__ __attribute__((aligned(16))) unsigned char lds[];
    Frame F;
    F.lds = (LAS unsigned char*)lds;
    F.MISC = (volatile LAS unsigned*)(F.lds + MISC_OFF);
    F.tid = threadIdx.x; F.lane = F.tid & 63; F.wave = __builtin_amdgcn_readfirstlane(F.tid >> 6);
    F.G = gridDim.x; { const int bx = blockIdx.x; F.vcu = (F.G % 8 == 0) ? (bx % 8) * (F.G / 8) + bx / 8 : bx; }
    unsigned char* ws = args.ws;
    F.ctl = (gu32*)(ws + WS_CTL);
    const float* x = args.in[0]; const float* norm1_gain = args.in[1]; const float* w_in = args.in[2]; const float* b_gate = args.in[3];
    const float* q_gain = args.in[4]; const float* k_gain = args.in[5]; const float* w_sb_out = args.in[6]; const float* w_dil_out = args.in[7];
    const float* w_out = args.in[8]; const float* norm2_gain = args.in[9]; const float* w_peer_q = args.in[10]; const float* sub_keys = args.in[11];
    const float* peer_u = args.in[12]; const float* peer_v = args.in[13];
    float* out = args.out;
    bf16* WIN = (bf16*)(ws + WS_WIN); bf16* WCAT = (bf16*)(ws + WS_WCAT); bf16* WOUT = (bf16*)(ws + WS_WOUT); bf16* WC = (bf16*)(ws + WS_WC);
    float* RINV1 = (float*)(ws + WS_RINV1); float* RINV2 = (float*)(ws + WS_RINV2); float* USC = (float*)(ws + WS_USC); float* VSC = (float*)(ws + WS_VSC); float* SSQ = (float*)(ws + WS_SSQ);
    unsigned char* U8 = ws + WS_U8; unsigned char* V8 = ws + WS_V8;
    unsigned short* IDS = (unsigned short*)(ws + WS_IDS); float* GW = (float*)(ws + WS_GW); float* COEF = (float*)(ws + WS_COEF); unsigned char* HQ = ws + WS_HQ; unsigned char* WC8 = ws + WS_WC; unsigned char* WOUT8 = ws + WS_WOUT; float* WOS = (float*)(ws + WS_WOS); float* RMAXF = (float*)(ws + WS_RMAXF); unsigned char* MIX8 = ws + WS_MIX; float* WCF = (float*)(ws + WS_WCF); float* WCS = (float*)(ws + WS_WCS); float* HS2 = (float*)(ws + WS_HS2);
    bf16* XB = (bf16*)(ws + WS_XB); bf16* OC = (bf16*)(ws + WS_OC); unsigned char* XB8 = ws + WS_XB8; unsigned char* WG8 = ws + WS_WG8; float* GCS = (float*)(ws + WS_GCS); float* XS = (float*)(ws + WS_XS);
    bf16* QS = (bf16*)(ws + WS_QS); bf16* KS = (bf16*)(ws + WS_KS); bf16* VS = (bf16*)(ws + WS_VS);
    bf16* QD = (bf16*)(ws + WS_QD); bf16* KD = (bf16*)(ws + WS_KD); bf16* VD = (bf16*)(ws + WS_VD);
    unsigned char* GT = ws + WS_GT; bf16* MIX = (bf16*)(ws + WS_MIX); bf16* X1B = (bf16*)(ws + WS_X1B);

    for (int u = F.tid; u < (LDS_BYTES - LDSCTL_OFF) / 4; u += NWAVES * 64) ((LAS unsigned*)(F.lds + LDSCTL_OFF))[u] = 0u;
    __syncthreads();
    const int my_xcc = (int)xb_xcc_id();
    if (F.tid == 0) F.MISC[12] = xb_add((unsigned*)(F.ctl + CW_XRANK) + 64 * my_xcc, 1u);
    __syncthreads();
    const int my_xrank = (int)F.MISC[12];
    const int bli = (N_LAUNCHES == PER_PHASE) ? 0 : args.li;
    XcdBarrier bar; bar.bar = (unsigned*)(F.ctl + CW_BAR) + bli * XCD_BAR_WORDS; bar.x = 0; bar.st = nullptr;
    if (N_LAUNCHES != PER_PHASE) bar = xcd_barrier_post((unsigned*)(F.ctl + CW_BAR) + bli * XCD_BAR_WORDS, F.MISC + 8);
    const int lo = args.ph_lo, hi = args.ph_hi;
#ifndef PHASE_MASK
#define PHASE_MASK 0xff
#endif
#define IN(k) (((PHASE_MASK >> (k)) & 1) && lo <= (k) && (k) < hi)
#define BOTH(k) (IN(k) && IN((k) + 1))
#define GRID_BAR() do { if (N_LAUNCHES != PER_PHASE) xcd_barrier(bar); } while (0)
#ifndef PROBE_REPEAT
#define PROBE_REPEAT 0x00
#endif
#ifndef PROBE_L1
#define PROBE_L1 0x0
#endif
#define REP(k) _Pragma("unroll") for (int rep_ = 0; rep_ < (((PROBE_REPEAT >> (k)) & 1) ? 2 : 1); ++rep_)
    const int gw = F.vcu * NWAVES + F.wave, NGW = F.G * NWAVES;
#define P67_MAP() int vx = (int)(blockIdx.x & 7), rk = (int)(blockIdx.x >> 3), nrk = (F.G + 7 - vx) / 8; bool p67_uni = false; \
        { bool uni_ = (F.G % 8 == 0); for (int j_ = 0; j_ < 16; ++j_) { const unsigned c_ = xb_ld((unsigned*)(F.ctl + CW_XRANK) + 64 * j_); uni_ = uni_ && (c_ == (j_ < 8 ? (unsigned)(F.G / 8) : 0u)); } \
          if (uni_) { vx = my_xcc; rk = my_xrank; nrk = F.G / 8; p67_uni = true; } }

    if (IN(0)) REP(0) {
        for (int it = F.vcu; it < 256; it += F.G) {
            const int hp = it >> 4, d0 = (it & 15) * 64;
            LAS float* As = (LAS float*)(F.lds);
            LAS float* Bs = (LAS float*)(F.lds + 64 * 132 * 4);
            for (int e = F.tid; e < 64 * 32; e += 512) { const int r = e >> 5, c4 = (e & 31) * 4; *(LAS f32x4*)(As + r * 132 + c4) = *(const GAS f32x4*)(w_peer_q + (size_t)(d0 + r) * 2048 + hp * 128 + c4); }
            for (int e = F.tid; e < 128 * 32; e += 512) { const int r = e >> 5, c4 = (e & 31) * 4; *(LAS f32x4*)(Bs + r * 132 + c4) = *(const GAS f32x4*)(sub_keys + ((size_t)hp * 128 + r) * 128 + c4); }
            __syncthreads();
            const int ddg = F.tid & 15, ng = F.tid >> 4;
            f32x4 acc[4];
#pragma unroll
            for (int j = 0; j < 4; ++j) acc[j] = (f32x4){0.f, 0.f, 0.f, 0.f};
            for (int c4 = 0; c4 < 128; c4 += 4) {
                f32x4 a[4], b[4];
#pragma unroll
                for (int i = 0; i < 4; ++i) { a[i] = *(const LAS f32x4*)(As + (4 * ddg + i) * 132 + c4); b[i] = *(const LAS f32x4*)(Bs + (4 * ng + i) * 132 + c4); }
#pragma unroll
                for (int j = 0; j < 4; ++j)
#pragma unroll
                    for (int i = 0; i < 4; ++i) acc[j][i] += (a[i][0] * b[j][0] + a[i][1] * b[j][1]) + (a[i][2] * b[j][2] + a[i][3] * b[j][3]);
            }
            const f32x4 g2 = *(const GAS f32x4*)(norm2_gain + d0 + 4 * ddg);
#pragma unroll
            for (int j = 0; j < 4; ++j) { const f32x4 o = acc[j] * g2;
                *(GAS f32x4*)(WCF + (size_t)(hp * 128 + 4 * ng + j) * 1024 + d0 + 4 * ddg) = o;
                float am = fmaxf(fmaxf(fabsf(o[0]), fabsf(o[1])), fmaxf(fabsf(o[2]), fabsf(o[3])));
                am = fmaxf(am, __shfl_xor(am, 1)); am = fmaxf(am, __shfl_xor(am, 2)); am = fmaxf(am, __shfl_xor(am, 4)); am = fmaxf(am, __shfl_xor(am, 8));
                if (ddg == 0) atomicMax((unsigned*)(F.ctl + CW_WMAX) + hp * 128 + 4 * ng + j, __float_as_uint(am)); }
            __syncthreads();
        }
        {
            LAS float* scr = (LAS float*)(F.lds + RING_OFF + F.wave * 16384);
            constexpr int I_IN = (D / 64) * (N1 / 32), I_SB = (512 / 64) * (D / 32), I_DL = (256 / 64) * (D / 32), I_OUT = (D / 64) * (D / 32);
            constexpr int NITEMS = I_IN + I_SB + I_DL + I_OUT;
            for (int it = gw; it < NITEMS; it += NGW) {
                int r = it;
                if (r < I_IN) { const int nb_ = r % (N1 / 32); p0_gate_max_item(w_in, N1, norm1_gain, (unsigned*)(F.ctl + CW_GMAX), r / (N1 / 32), 32 * nb_, F.lane); continue; } r -= I_IN;
                if (r < I_SB) { p0_transpose_item(w_sb_out, D, nullptr, WCAT, 768, 0, 0, scr, r, F.lane); continue; } r -= I_SB;
                if (r < I_DL) { p0_transpose_item(w_dil_out, D, nullptr, WCAT, 768, 512, 0, scr, r, F.lane); continue; } r -= I_DL;
                p0_gate_max_item(w_out, D, nullptr, (unsigned*)(F.ctl + CW_OMAX), r / (D / 32), 32 * (r % (D / 32)), F.lane);
            }
        }
        for (int e = gw; e < 2 * NEXP; e += NGW) {
            if (e < NEXP) quant_row_i4(peer_u + (size_t)e * D, norm2_gain, U8 + (size_t)e * 512, USC + e, F.lane);
            else { const int ev = e - NEXP; quant_row_fp4(peer_v + (size_t)ev * D, V8 + (size_t)ev * 128, (size_t)NEXP * 128, VSC + ev, F.lane); }
        }
        for (int m = gw; m < T; m += NGW) {
            const GAS f32x4* xr = (const GAS f32x4*)(x + (size_t)m * D) + F.lane;
            f32x4 v[4]; float s = 0.f;
#pragma unroll
            for (int j = 0; j < 4; ++j) { v[j] = xr[64 * j]; s += (v[j][0] * v[j][0] + v[j][1] * v[j][1]) + (v[j][2] * v[j][2] + v[j][3] * v[j][3]); }
            s = wave_sum(s);
            const float rn = __builtin_amdgcn_rsqf(s * (1.0f / D) + 1e-6f);
            if (F.lane == 0) RINV1[m] = 1.0f / rn;
            GAS unsigned long long* o8 = (GAS unsigned long long*)(XB + (size_t)m * D) + F.lane;
#pragma unroll
            for (int j = 0; j < 4; ++j) o8[64 * j] = (unsigned long long)pk2(v[j][0] * rn, v[j][1] * rn) | ((unsigned long long)pk2(v[j][2] * rn, v[j][3] * rn) << 32);
            float am = 0.f;
#pragma unroll
            for (int j = 0; j < 4; ++j) am = fmaxf(am, fmaxf(fmaxf(fabsf(v[j][0]), fabsf(v[j][1])), fmaxf(fabsf(v[j][2]), fabsf(v[j][3]))));
            am = wave_max(am) * rn;
            const float qs = am > 0.f ? 127.0f / am * rn : 0.f;
            if (F.lane == 0) XS[m] = am * (1.0f / 127.0f);
#pragma unroll
            for (int j = 0; j < 4; ++j) { const unsigned pk = ((unsigned)(int)__builtin_rintf(v[j][0] * qs) & 0xffu) | (((unsigned)(int)__builtin_rintf(v[j][1] * qs) & 0xffu) << 8) | (((unsigned)(int)__builtin_rintf(v[j][2] * qs) & 0xffu) << 16) | (((unsigned)(int)__builtin_rintf(v[j][3] * qs) & 0xffu) << 24);
                *(GAS unsigned*)(XB8 + (size_t)m * D + 256 * j + 4 * F.lane) = pk; }
        }
        if (BOTH(0)) GRID_BAR();
    }

    if (IN(1)) REP(1) {
        { LAS float* scr = (LAS float*)(F.lds + RING_OFF + F.wave * 16384);
          for (int it = gw; it < 16 * (N8 / 32); it += NGW) p0_gate_fp8_item(w_in, N1, norm1_gain, (const unsigned*)(F.ctl + CW_GMAX), WG8, GCS, scr, it, F.lane);
          for (int it = gw; it < 16 * (D / 32); it += NGW) p0_gate_fp8_item(w_out, D, nullptr, (const unsigned*)(F.ctl + CW_OMAX), WOUT8, WOS, scr, it, F.lane, D, false);
          for (int r = gw; r < 2048; r += NGW) {
              const float am = __uint_as_float(xb_ld((unsigned*)(F.ctl + CW_WMAX) + r)); const float sc = am > 0.f ? 127.0f / am : 0.f;
              unsigned w[4];
#pragma unroll
              for (int j = 0; j < 4; ++j) { const f32x4 v = *(const GAS f32x4*)(WCF + (size_t)r * 1024 + 16 * F.lane + 4 * j);
                  w[j] = ((unsigned)(int)__builtin_rintf(v[0] * sc) & 0xffu) | (((unsigned)(int)__builtin_rintf(v[1] * sc) & 0xffu) << 8) | (((unsigned)(int)__builtin_rintf(v[2] * sc) & 0xffu) << 16) | (((unsigned)(int)__builtin_rintf(v[3] * sc) & 0xffu) << 24); }
              *(GAS v4u*)(WC8 + (size_t)r * 1024 + 16 * F.lane) = (v4u){w[0], w[1], w[2], w[3]};
              if (F.lane == 0) WCS[r] = am * (1.0f / 127.0f); }
          __syncthreads(); }
        GRID_BAR();
        { pg8::Gemm g{(const bf16*)XB8, (const bf16*)WG8, T, N8, D / 2}; pg8::StaticOrder S; S.init(T, N8, F.G, (int)blockIdx.x);
          pg8::EpiG E{b_gate, GCS, XS, q_gain, k_gain, QS, KS, VS, QD, KD, VD, GT};
          pg8::gemm_phase<pg8::EpiG, pg8::StaticOrder, true, true, false, true>(F.lds + RING_OFF, g, S, E); }
        if (BOTH(1)) GRID_BAR();
    }

    if (IN(2)) REP(2) {
        LAS unsigned char* wl = F.lds + RING_OFF + F.wave * 16384;
        static_assert(att::DLU_BYTES <= RING_BYTES, "dilated-attention LDS state");
        for (int un = F.vcu; un < 512; un += F.G) { const int blk = un & 7, j = (un >> 3) & 3, b = un >> 5; att::dl_unit(QD, KD, VD, OC, b, j, blk, F.lds + RING_OFF, F.wave, F.lane); }
        for (int it = gw; it < 16384; it += NGW) { const int qt = 127 - (it & 127), h = (it >> 7) & 7, b = it >> 10; att::sb_item(QS, KS, VS, OC, b, h, qt, wl, F.lane); }
        if (BOTH(2)) GRID_BAR();
    }

    if (IN(3)) REP(3) {
        pg8::Gemm g{OC, WCAT, T, D, 768}; pg8::StaticOrder S; S.init(T, D, F.G, (int)blockIdx.x);
        pg8::Epi2 E{GT, MIX8, (unsigned*)(ws + WS_PART), (unsigned*)(F.ctl + CW_RCNT), RMAXF, F.lds + RING_OFF + RING_BYTES};
        pg8::gemm_phase<pg8::Epi2, pg8::StaticOrder, true, true>(F.lds + RING_OFF, g, S, E);
        if (BOTH(3)) GRID_BAR();
    }

    if (IN(4)) REP(4) {
        pg8::Gemm g{(const bf16*)MIX8, (const bf16*)WOUT8, T, D, D / 2}; pg8::StaticOrder S; S.init(T, D, F.G, (int)blockIdx.x);
        pg8::Epi3 E{XB, RINV1, (const unsigned*)RMAXF, WOS, X1B, SSQ};
        pg8::gemm_phase<pg8::Epi3, pg8::StaticOrder, true, true, false, true>(F.lds + RING_OFF, g, S, E);
        if (BOTH(4)) GRID_BAR();
    }

    if (IN(5)) REP(5) {
        for (int m = gw; m < T; m += NGW) {
            const v4u a = *(const GAS v4u*)(X1B + (size_t)m * D + 8 * F.lane), b = *(const GAS v4u*)(X1B + (size_t)m * D + 512 + 8 * F.lane);
            float v[16] = {pg8::bflo(a.x), pg8::bfhi(a.x), pg8::bflo(a.y), pg8::bfhi(a.y), pg8::bflo(a.z), pg8::bfhi(a.z), pg8::bflo(a.w), pg8::bfhi(a.w),
                           pg8::bflo(b.x), pg8::bfhi(b.x), pg8::bflo(b.y), pg8::bfhi(b.y), pg8::bflo(b.z), pg8::bfhi(b.z), pg8::bflo(b.w), pg8::bfhi(b.w)};
            float am = 0.f;
#pragma unroll
            for (int i = 0; i < 16; ++i) am = fmaxf(am, fabsf(v[i]));
            am = wave_max(am);
            float sq = (F.lane < 16) ? SSQ[(size_t)m * 16 + F.lane] : 0.f; sq = wave_sum(sq);
            const float s = am > 0.f ? 127.0f / am : 0.f;
            if (F.lane == 0) HS2[m] = am * (1.0f / 127.0f) * __builtin_amdgcn_rsqf(sq * (1.0f / 1024.0f) + 1e-6f);
            int q[16];
#pragma unroll
            for (int i = 0; i < 16; ++i) q[i] = (int)__builtin_rintf(v[i] * s) & 0xff;
            v2u o0, o1; o0.x = q[0] | (q[1] << 8) | (q[2] << 16) | (q[3] << 24); o0.y = q[4] | (q[5] << 8) | (q[6] << 16) | (q[7] << 24);
            o1.x = q[8] | (q[9] << 8) | (q[10] << 16) | (q[11] << 24); o1.y = q[12] | (q[13] << 8) | (q[14] << 16) | (q[15] << 24);
            *(GAS v2u*)(HQ + (size_t)m * D + 8 * F.lane) = o0; *(GAS v2u*)(HQ + (size_t)m * D + 512 + 8 * F.lane) = o1;
        }
        GRID_BAR();
        pg8::Gemm g{(const bf16*)HQ, (const bf16*)WC8, T, 2048, D / 2}; pg8::StaticOrder S; S.init(T, 2048, F.G, (int)blockIdx.x);
        pg8::Epi4 E{SSQ, RINV2, IDS, GW, HS2, WCS};
        pg8::OneUnit O1;
        for (int i = 0; S.next(i, O1.u); ++i) pg8::gemm_phase<pg8::Epi4, pg8::OneUnit, false, true, false, true>(F.lds + RING_OFF, g, O1, E);
        if (BOTH(5)) GRID_BAR();
    }

    if (IN(6)) REP(6) {
        P67_MAP();
        const int p16 = F.lane & 15, sg = F.lane >> 4;
        LAS unsigned char* HB = F.lds + RING_OFF + F.wave * 16384;
        LAS unsigned* LIST = (LAS unsigned*)(F.lds + RING_OFF + F.wave * 16384 + 8192);
        LAS float* HSs = (LAS float*)(F.lds + RING_OFF + F.wave * 16384 + 12288);
        const int nwb = T / 8, wstep = nrk * NWAVES;
        const int gsel = (F.lane & 15), bpsrc = (16 * (F.lane & 3) + ((F.lane >> 2) & 3)) * 4;
        v4u hpre[8], idpre[2]; float hspre = 0.f;
#define P6_PRE(bb) do { const int bc_ = (bb) < nwb ? (bb) : nwb - 1; const unsigned char* hsrc_ = HQ + (size_t)bc_ * 8192; \
            _Pragma("unroll") for (int i_ = 0; i_ < 8; ++i_) hpre[i_] = *(const GAS v4u*)(hsrc_ + (size_t)(i_ * 64 + F.lane) * 16); \
            const unsigned short* isrc_ = IDS + ((size_t)bc_ * 8 + (F.lane >> 3)) * 128 + 16 * (F.lane & 7); idpre[0] = *(const GAS v4u*)isrc_; idpre[1] = *(const GAS v4u*)(isrc_ + 8); \
            hspre = HS2[(size_t)bc_ * 8 + (F.lane & 7)]; } while (0)
#define P6_ISSUE(W, ENT, EJ, GB, UB, VB, base_) do { \
                _Pragma("unroll") for (int g_ = 0; g_ < 4; ++g_) { const int j_ = (base_) + 4 * g_ + sg; ENT[g_] = LIST[j_ < n ? j_ : nm1]; } \
                { const int j_ = (base_) + gsel; EJ = (j_ < n && F.lane < 16) ? (int)LIST[j_] : -1; } \
                _Pragma("unroll") for (int g_ = 0; g_ < 4; ++g_) { const unsigned char* up_ = U8 + (size_t)((PROBE_L1 && rep_) ? 0u : (ENT[g_] & 0xffffu)) * 512 + 16 * p16; \
                    _Pragma("unroll") for (int i_ = 0; i_ < 2; ++i_) W[g_][i_] = *(const GAS v4u*)(up_ + 256 * i_); } \
                { const unsigned ej_ = EJ < 0 ? 0u : (unsigned)EJ; GB = GW[((size_t)t0 + (ej_ >> 24)) * 128 + ((ej_ >> 16) & 127u)]; UB = USC[ej_ & 0xffffu]; VB = VSC[ej_ & 0xffffu]; } } while (0)
#define P6_DPPADD(a_, ctrl) a_ += __builtin_amdgcn_update_dpp(0, a_, ctrl, 0xf, 0xf, false)
#define P6_REDUCE(W, ENT, EJ, GB, UB, VB, base_) do { if ((base_) < n) { int ag_[4]; \
                _Pragma("unroll") for (int g_ = 0; g_ < 4; ++g_) { const LAS unsigned char* hp_ = HB + (size_t)(ENT[g_] >> 24) * 1024 + 16 * p16; int a_ = 0; v4u h_[4]; \
                    _Pragma("unroll") for (int i_ = 0; i_ < 4; ++i_) h_[i_] = *(const LAS v4u*)(hp_ + 256 * i_); \
                    _Pragma("unroll") for (int ld_ = 0; ld_ < 2; ++ld_) { const unsigned x_[4] = {W[g_][ld_].x, W[g_][ld_].y, W[g_][ld_].z, W[g_][ld_].w}; \
                        _Pragma("unroll") for (int wl_ = 0; wl_ < 4; ++wl_) { const int hd_ = 2 * (4 * ld_ + wl_); const unsigned lo_ = (x_[wl_] << 4) & 0xF0F0F0F0u, hi_ = x_[wl_] & 0xF0F0F0F0u; \
                            const unsigned hA_ = (hd_ & 3) == 0 ? h_[hd_ >> 2].x : h_[hd_ >> 2].z, hB_ = (hd_ & 3) == 0 ? h_[hd_ >> 2].y : h_[hd_ >> 2].w; \
                            a_ = __builtin_amdgcn_sdot4((int)lo_, (int)hA_, a_, false); a_ = __builtin_amdgcn_sdot4((int)hi_, (int)hB_, a_, false); } } \
                    P6_DPPADD(a_, 0xB1); P6_DPPADD(a_, 0x4E); P6_DPPADD(a_, 0x141); P6_DPPADD(a_, 0x140); ag_[g_] = a_; } \
                const int sel_ = gsel == 0 ? ag_[0] : gsel == 1 ? ag_[1] : gsel == 2 ? ag_[2] : ag_[3]; \
                const float resv_ = (float)__builtin_amdgcn_ds_bpermute(bpsrc, sel_); \
                if (EJ >= 0 && !(PROBE_L1 && rep_)) { const unsigned ej_ = (unsigned)EJ; const float act_ = gelu_f(resv_ * UB * HSs[ej_ >> 24]); \
                    COEF[((size_t)t0 + (ej_ >> 24)) * 128 + ((ej_ >> 16) & 127u)] = GB * act_ * VB; } } } while (0)
        int wb = rk * NWAVES + F.wave;
        P6_PRE(wb);
        for (; wb < nwb; wb += wstep) {
            const int t0 = wb * 8;
            asm volatile("s_waitcnt lgkmcnt(0)" ::: "memory");
            if (F.lane < 8) HSs[F.lane] = hspre;
#pragma unroll
            for (int i = 0; i < 8; ++i) *(LAS v4u*)(HB + (size_t)(i * 64 + F.lane) * 16) = hpre[i];
            int n = 0;
            { const unsigned idw[8] = {idpre[0].x, idpre[0].y, idpre[0].z, idpre[0].w, idpre[1].x, idpre[1].y, idpre[1].z, idpre[1].w};
              const unsigned tl = (unsigned)(F.lane >> 3), kb0 = 16u * (unsigned)(F.lane & 7);
#pragma unroll
              for (int i = 0; i < 16; ++i) { const unsigned e = (i & 1) ? (idw[i >> 1] >> 16) : (idw[i >> 1] & 0xffffu);
                  const bool inr = ((int)(e >> 11) == vx); const unsigned long long mk = __ballot(inr);
                  const int pos = n + (int)__builtin_amdgcn_mbcnt_hi((unsigned)(mk >> 32), __builtin_amdgcn_mbcnt_lo((unsigned)mk, 0u));
                  if (inr) LIST[pos] = (tl << 24) | ((kb0 + (unsigned)i) << 16) | e;
                  n += __builtin_popcountll(mk); } }
            asm volatile("s_waitcnt lgkmcnt(0)" ::: "memory");
            P6_PRE(wb + wstep);
            const int nm1 = n > 0 ? n - 1 : 0;
            for (int base = 0; base < n; base += 32) {
                v4u wA[4][2], wB[4][2]; unsigned entA[4], entB[4]; int ejA, ejB; float gbA, ubA, vbA, gbB, ubB, vbB;
                P6_ISSUE(wA, entA, ejA, gbA, ubA, vbA, base);
                P6_ISSUE(wB, entB, ejB, gbB, ubB, vbB, base + 16);
                P6_REDUCE(wA, entA, ejA, gbA, ubA, vbA, base);
                P6_REDUCE(wB, entB, ejB, gbB, ubB, vbB, base + 16);
            }
        }
#undef P6_PRE
#undef P6_ISSUE
#undef P6_REDUCE
#undef P6_DPPADD
        if (BOTH(6)) GRID_BAR();
    }

    if (IN(7)) REP(7) {
        P67_MAP();
        const int cs = vx >> 1;
        const int n0_ = p67_uni ? F.G / 8 : (F.G + 7 - 2 * cs) / 8, n1_ = p67_uni ? F.G / 8 : (F.G + 7 - (2 * cs + 1)) / 8;
        const int rk2 = (vx & 1) ? n0_ + rk : rk, nrk2 = n0_ + n1_;
        const int l8 = F.lane & 7, kg = F.lane >> 3;
        const unsigned char* vbase = V8 + (size_t)cs * NEXP * 128 + 16 * l8;
        const int tstep = nrk2 * NWAVES;
        const int col = 256 * cs + 32 * l8 + ((F.lane & 8) ? 16 : 0) + ((F.lane & 16) ? 8 : 0) + ((F.lane & 32) ? 4 : 0);
#define P7_CL(tt) ((tt) < T ? (tt) : T - 1)
#define P7_IDS(tt, ID) do { const int tc_ = P7_CL(tt); ID[0] = *(const GAS v4u*)(IDS + (size_t)tc_ * 128 + 16 * kg); ID[1] = *(const GAS v4u*)(IDS + (size_t)tc_ * 128 + 16 * kg + 8); } while (0)
#define P7_ISSUE(tt, ID, W, CF, OO) do { const int tc_ = P7_CL(tt); const unsigned idw_[8] = {ID[0].x, ID[0].y, ID[0].z, ID[0].w, ID[1].x, ID[1].y, ID[1].z, ID[1].w}; \
            _Pragma("unroll") for (int i_ = 0; i_ < 16; ++i_) { const unsigned e_ = (i_ & 1) ? (idw_[i_ >> 1] >> 16) : (idw_[i_ >> 1] & 0xffffu); W[i_] = *(const GAS v4u*)(vbase + (size_t)((PROBE_L1 && rep_) ? 0u : e_) * 128); } \
            _Pragma("unroll") for (int i_ = 0; i_ < 4; ++i_) CF[i_] = *(const GAS f32x4*)(COEF + (size_t)tc_ * 128 + 16 * kg + 4 * i_); \
            OO = *(const GAS v2u*)(X1B + (size_t)tc_ * D + col); } while (0)
#define P7_BYTE(d_, s_) do { const h2_t r_ = __builtin_amdgcn_cvt_scalef32_pk_f16_fp4(ww_[d_], 1.0f, s_); acc_[4 * (d_) + (s_)] = r_ * c2_ + acc_[4 * (d_) + (s_)]; } while (0)
#define P7_COMPUTE(tt, W, CF, OO) do { h2_t acc_[16];                 \
            _Pragma("unroll") for (int i_ = 0; i_ < 16; ++i_) acc_[i_] = (h2_t){(_Float16)0.f, (_Float16)0.f}; \
            _Pragma("unroll") for (int i_ = 0; i_ < 16; ++i_) { const unsigned ww_[4] = {W[i_].x, W[i_].y, W[i_].z, W[i_].w}; const _Float16 ch_ = (_Float16)CF[i_ >> 2][i_ & 3]; const h2_t c2_ = {ch_, ch_}; \
                P7_BYTE(0, 0); P7_BYTE(0, 1); P7_BYTE(0, 2); P7_BYTE(0, 3); P7_BYTE(1, 0); P7_BYTE(1, 1); P7_BYTE(1, 2); P7_BYTE(1, 3); \
                P7_BYTE(2, 0); P7_BYTE(2, 1); P7_BYTE(2, 2); P7_BYTE(2, 3); P7_BYTE(3, 0); P7_BYTE(3, 1); P7_BYTE(3, 2); P7_BYTE(3, 3); } \
            float r16_[16], r8_[8], r4_[4]; \
            { const bool up_ = (F.lane & 8) != 0; _Pragma("unroll") for (int i_ = 0; i_ < 8; ++i_) { const h2_t keep_ = up_ ? acc_[8 + i_] : acc_[i_], send_ = up_ ? acc_[i_] : acc_[8 + i_]; \
                const h2_t oth_ = __builtin_bit_cast(h2_t, __shfl_xor(__builtin_bit_cast(int, send_), 8)); r16_[2 * i_] = (float)keep_[0] + (float)oth_[0]; r16_[2 * i_ + 1] = (float)keep_[1] + (float)oth_[1]; } } \
            { const bool up_ = (F.lane & 16) != 0; _Pragma("unroll") for (int i_ = 0; i_ < 8; ++i_) { const float keep_ = up_ ? r16_[8 + i_] : r16_[i_], send_ = up_ ? r16_[i_] : r16_[8 + i_]; r8_[i_] = keep_ + __shfl_xor(send_, 16); } } \
            { const bool up_ = (F.lane & 32) != 0; _Pragma("unroll") for (int i_ = 0; i_ < 4; ++i_) { const float keep_ = up_ ? r8_[4 + i_] : r8_[i_], send_ = up_ ? r8_[i_] : r8_[4 + i_]; r4_[i_] = keep_ + __shfl_xor(send_, 32); } } \
            if ((tt) < T) *(GAS f32x4*)((rep_ == 0 ? out : (float*)(ws + WS_GT)) + (size_t)(tt) * D + col) = (f32x4){pg8::bflo(OO.x) + r4_[0], pg8::bfhi(OO.x) + r4_[1], pg8::bflo(OO.y) + r4_[2], pg8::bfhi(OO.y) + r4_[3]}; } while (0)
        v4u idA[2], idB[2], wA[16], wB[16]; f32x4 cfA[4], cfB[4]; v2u ooA, ooB;
        int t = rk2 * NWAVES + F.wave;
        P7_IDS(t, idA); P7_IDS(t + tstep, idB);
        while (t < T) {
            P7_ISSUE(t, idA, wA, cfA, ooA); P7_ISSUE(t + tstep, idB, wB, cfB, ooB);
            P7_IDS(t + 2 * tstep, idA); P7_IDS(t + 3 * tstep, idB);
            P7_COMPUTE(t, wA, cfA, ooA);
            P7_COMPUTE(t + tstep, wB, cfB, ooB);
            t += 2 * tstep;
        }
#undef P7_CL
#undef P7_IDS
#undef P7_ISSUE
#undef P7_BYTE
#undef P7_COMPUTE
    }
#undef IN
#undef BOTH
#undef GRID_BAR
}

extern "C" void kernel_launch(void* const* d_in, const int* in_sizes, int n_in, void* d_out, int out_size, void* d_ws, size_t ws_size, hipStream_t stream) {
    static int grid = 0;
    if (grid == 0) {
        if (n_in != 14 || in_sizes[0] != T * D || out_size != T * D || ws_size < WS_END) { fprintf(stderr, "kernel_launch: built for 14 inputs, x and out of %d floats, >= %zu bytes of workspace; got n_in %d, in0 %d, out %d, ws %zu; nothing launched\n", T * D, (size_t)WS_END, n_in, n_in > 0 ? in_sizes[0] : -1, out_size, ws_size); grid = -1; return; }
        int dev = 0, cus = 0, per_cu = 0;
        if (hipGetDevice(&dev) != hipSuccess || hipDeviceGetAttribute(&cus, hipDeviceAttributeMultiprocessorCount, dev) != hipSuccess) { fprintf(stderr, "kernel_launch: hipGetDevice / hipDeviceGetAttribute failed\n"); grid = -1; return; }
        if (hipFuncSetAttribute((const void*)fwd_kernel, hipFuncAttributeMaxDynamicSharedMemorySize, LDS_BYTES) != hipSuccess) { fprintf(stderr, "kernel_launch: hipFuncSetAttribute failed\n"); grid = -1; return; }
        if (hipOccupancyMaxActiveBlocksPerMultiprocessor(&per_cu, (const void*)fwd_kernel, NWAVES * 64, LDS_BYTES) != hipSuccess || per_cu < 1)
            fprintf(stderr, "kernel_launch: note: occupancy query reports %d workgroups per CU\n", per_cu);
        (void)hipGetLastError();
        grid = cus;
        if (cus != 256) fprintf(stderr, "kernel_launch: built for 256 CUs (MI355X); %d found -- the P3 row-max exchange assumes a 256-workgroup grid\n", cus);
    }
    if (grid < 0) return;
    if (hipMemsetAsync((char*)d_ws + WS_CTL, 0, CTL_ZERO_BYTES, stream) != hipSuccess) { fprintf(stderr, "kernel_launch: hipMemsetAsync failed\n"); return; }
    Args a{};
    for (int i = 0; i < 14; ++i) a.in[i] = (const float*)d_in[i];
    a.out = (float*)d_out; a.ws = (unsigned char*)d_ws;
    for (int li = 0; li < N_LAUNCHES; ++li) {
        a.ph_lo = (N_LAUNCHES == PER_PHASE) ? li : 0; a.ph_hi = (N_LAUNCHES == PER_PHASE) ? li + 1 : MK_LAST_PHASE; a.li = li;
        if (a.ph_lo >= MK_LAST_PHASE) break;
        hipLaunchKernelGGL(fwd_kernel, dim3(grid), dim3(NWAVES * 64), LDS_BYTES, stream, a);
        const hipError_t le = hipPeekAtLastError();
        if (le != hipSuccess) { fprintf(stderr, "kernel_launch: launch %d failed: %s\n", li, hipGetErrorName(le)); break; }
    }
}
```

```cpp
#include <hip/hip_runtime.h>
#include <cstdio>
#include <cstdint>
namespace pg8 {
#define PG8_LAS __attribute__((address_space(3)))
typedef unsigned short bf16_t;
typedef short bf16x8 __attribute__((ext_vector_type(8)));
typedef float f32x4 __attribute__((ext_vector_type(4)));
typedef unsigned u32x4 __attribute__((ext_vector_type(4)));
typedef int i32x8 __attribute__((ext_vector_type(8)));
typedef int i32x4 __attribute__((ext_vector_type(4)));
constexpr int BM = 256, BK = 64, HALF = 128, HTB = HALF * BK * 2  , STAGE_BYTES = 8 * HTB, NXCD = 8, WGM = 8;

__host__ __device__ __forceinline__ int lds_byte(int r, int c) { const int st = (r >> 4) * 2 + (c >> 5), rr = r & 15, cc = c & 31, ob = rr * 64 + cc * 2; return st * 1024 + (ob ^ (((ob >> 9) & 1) << 5)); }
__host__ __device__ __forceinline__ void stage_rc(int b, int& R, int& C) { const int st = b / 1024, sb = b % 1024, swz = sb ^ (((sb >> 9) & 1) << 5); R = (st >> 1) * 16 + swz / 64; C = (st & 1) * 32 + (swz % 64) / 2; }
__host__ __device__ __forceinline__ int perm32(int rho) { const int n = rho >> 4, i = rho & 15; return 8 * (i >> 2) + 4 * n + (i & 3); }

struct Unit { int pm, pn; };
struct Gemm { const bf16_t* A; const bf16_t* Bt; int M, N, K; };

struct StaticOrder {
    int nM, nN, nwg, G, c;
    __host__ __device__ void init(int M, int N, int G_, int c_) { nM = M / BM; nN = N / BM; nwg = nM * nN; G = G_; c = c_; }
    __host__ __device__ bool next(int i, Unit& u) const {
        const long L = (long)i * G + c; if (L >= nwg) return false;
        int wgid = (int)L; { const int q = nwg / NXCD, r = nwg % NXCD, xcd = wgid % NXCD, off = wgid / NXCD; wgid = (xcd < r ? xcd * (q + 1) : r * (q + 1) + (xcd - r) * q) + off; }
        const int nig = WGM * nN, gid = wgid / nig, fm = gid * WGM, gsz = (nM - fm) < WGM ? (nM - fm) : WGM;
        u.pm = fm + ((wgid % nig) % gsz); u.pn = (wgid % nig) / gsz; return true;
    }
    __device__ __forceinline__ void a_ready(const Unit&) const {}
    __device__ __forceinline__ void done(const Unit&) const {}
};


struct OneUnit {
    Unit u;
    __device__ __forceinline__ bool next(int i, Unit& o) const { if (i != 0) return false; o = u; return true; }
    __device__ __forceinline__ void a_ready(const Unit&) const {}
    __device__ __forceinline__ void done(const Unit&) const {}
};

typedef float f32x2 __attribute__((ext_vector_type(2)));
typedef __bf16 bf16x2_t __attribute__((ext_vector_type(2)));
typedef unsigned u32x2 __attribute__((ext_vector_type(2)));
__device__ __forceinline__ unsigned pkbf(float lo, float hi) { f32x2 v = {lo, hi}; bf16x2_t b = __builtin_convertvector(v, bf16x2_t); return __builtin_bit_cast(unsigned, b); }
__device__ __forceinline__ float bflo(unsigned w) { return __uint_as_float(w << 16); }
__device__ __forceinline__ float bfhi(unsigned w) { return __uint_as_float(w & 0xffff0000u); }
__device__ __forceinline__ u32x4 pack8(const f32x4 a, const f32x4 b) { u32x4 w; w.x = pkbf(a[0], a[1]); w.y = pkbf(a[2], a[3]); w.z = pkbf(b[0], b[1]); w.w = pkbf(b[2], b[3]); return w; }
constexpr float QSCALE = 0.125f * 1.4426950408889634f;
__device__ __forceinline__ float sigmoidf_(float v) { return __builtin_amdgcn_rcpf(1.0f + __builtin_amdgcn_exp2f(-1.4426950408889634f * v)); }

struct EpiG {
    static constexpr bool PERM = true, AFTER_DRAIN = false, HAS_MID = false; static constexpr int MID_T = -1;
    const float* bgate; const float* cs; const float* xs; const float* qg; const float* kg; bf16_t *QS, *KS, *VS, *QD, *KD, *VD; unsigned char* GT;
    __device__ __forceinline__ void mid(f32x4 (&)[2][2][4][2], const Unit&, int, int, int, int) const {}
    static __device__ __forceinline__ f32x4 cvt(const f32x4 a, const f32x4 sc) { const i32x4 ia = __builtin_bit_cast(i32x4, a); return (f32x4){(float)ia[0], (float)ia[1], (float)ia[2], (float)ia[3]} * sc; }
    __device__ __forceinline__ void operator()(const f32x4 (&acc)[2][2][4][2], const Unit& u, int wr, int wc, int fr, int fq) const {
        asm volatile("" : "+v"(fr), "+v"(fq));
        const int pn = u.pn; const int row0 = u.pm * BM + wr * 64 + fr, colp = pn * BM + wc * 32 + 8 * fq;
        f32x4 sv[2][2];
#pragma unroll
        for (int bj = 0; bj < 2; ++bj)
#pragma unroll
            for (int n = 0; n < 2; ++n) sv[bj][n] = *(const f32x4*)(cs + colp + bj * HALF + 4 * n);
        if (pn < 6) {
            bf16_t* base; int colt;
            if (pn < 2) { base = QS; colt = pn * 256; } else if (pn < 4) { base = KS; colt = (pn - 2) * 256; } else { base = VS; colt = (pn - 4) * 256; }
            base += colt + wc * 32 + 8 * fq;
            const float qs = (pn < 2 ? QSCALE : 1.0f);
#pragma unroll
            for (int ai = 0; ai < 2; ++ai)
#pragma unroll
                for (int m = 0; m < 4; ++m) { const int row = row0 + ai * HALF + m * 16; const float r = xs[row] * qs;
#pragma unroll
                    for (int bj = 0; bj < 2; ++bj) *(u32x4*)(base + (size_t)row * 512 + bj * HALF) = pack8(cvt(acc[ai][bj][m][0], sv[bj][0]) * r, cvt(acc[ai][bj][m][1], sv[bj][1]) * r);
                }
        } else if (pn < 12) {
            const bool isK = pn >= 9; const int head = (isK ? pn - 9 : pn - 6) * 4 + wc;
            const float* g = (isK ? kg : qg) + head * 64 + 8 * fq;
            f32x4 gv[2][2]; const float qsc = isK ? 1.0f : QSCALE;
#pragma unroll
            for (int bj = 0; bj < 2; ++bj)
#pragma unroll
                for (int n = 0; n < 2; ++n) gv[bj][n] = *(const f32x4*)(g + 32 * bj + 4 * n) * qsc;
            bf16_t* base = (isK ? KD : QD) + head * 64 + 8 * fq;
#pragma unroll
            for (int ai = 0; ai < 2; ++ai)
#pragma unroll
                for (int m = 0; m < 4; ++m) { const int row = row0 + ai * HALF + m * 16; const float r = xs[row];
                    f32x4 v[2][2]; float ss = 0.f;
#pragma unroll
                    for (int bj = 0; bj < 2; ++bj)
#pragma unroll
                        for (int n = 0; n < 2; ++n) { v[bj][n] = cvt(acc[ai][bj][m][n], sv[bj][n]) * r; const f32x4 q = v[bj][n] * v[bj][n]; ss += (q[0] + q[1]) + (q[2] + q[3]); }
                    ss += __shfl_xor(ss, 16); ss += __shfl_xor(ss, 32);
                    const float sc = __builtin_amdgcn_rsqf(ss * (1.0f / 64.0f) + 1e-6f);
#pragma unroll
                    for (int bj = 0; bj < 2; ++bj) *(u32x4*)(base + (size_t)row * 768 + 32 * bj) = pack8(v[bj][0] * sc * gv[bj][0], v[bj][1] * sc * gv[bj][1]);
                }
        } else if (pn < 15) {
            bf16_t* base = VD + (pn - 12) * 256 + wc * 32 + 8 * fq;
#pragma unroll
            for (int ai = 0; ai < 2; ++ai)
#pragma unroll
                for (int m = 0; m < 4; ++m) { const int row = row0 + ai * HALF + m * 16; const float r = xs[row];
#pragma unroll
                    for (int bj = 0; bj < 2; ++bj) *(u32x4*)(base + (size_t)row * 768 + bj * HALF) = pack8(cvt(acc[ai][bj][m][0], sv[bj][0]) * r, cvt(acc[ai][bj][m][1], sv[bj][1]) * r);
                }
        } else {
            const int col0 = (pn - 15) * 256 + wc * 32 + 8 * fq;
            f32x4 bv[2][2];
#pragma unroll
            for (int bj = 0; bj < 2; ++bj)
#pragma unroll
                for (int n = 0; n < 2; ++n) bv[bj][n] = *(const f32x4*)(bgate + col0 + bj * HALF + 4 * n);
#pragma unroll
            for (int ai = 0; ai < 2; ++ai)
#pragma unroll
                for (int m = 0; m < 4; ++m) { const int row = row0 + ai * HALF + m * 16; const float r = xs[row];
#pragma unroll
                    for (int bj = 0; bj < 2; ++bj) { f32x4 a = cvt(acc[ai][bj][m][0], sv[bj][0]) * r + bv[bj][0], b = cvt(acc[ai][bj][m][1], sv[bj][1]) * r + bv[bj][1];
#pragma unroll
                        for (int e = 0; e < 4; ++e) { a[e] = sigmoidf_(a[e]) * 255.0f; b[e] = sigmoidf_(b[e]) * 255.0f; }
                        unsigned w0 = 0, w1 = 0;
                        w0 = __builtin_amdgcn_cvt_pk_u8_f32(a[0], 0, w0); w0 = __builtin_amdgcn_cvt_pk_u8_f32(a[1], 1, w0); w0 = __builtin_amdgcn_cvt_pk_u8_f32(a[2], 2, w0); w0 = __builtin_amdgcn_cvt_pk_u8_f32(a[3], 3, w0);
                        w1 = __builtin_amdgcn_cvt_pk_u8_f32(b[0], 0, w1); w1 = __builtin_amdgcn_cvt_pk_u8_f32(b[1], 1, w1); w1 = __builtin_amdgcn_cvt_pk_u8_f32(b[2], 2, w1); w1 = __builtin_amdgcn_cvt_pk_u8_f32(b[3], 3, w1);
                        *(u32x2*)(GT + (size_t)row * 2048 + col0 + bj * HALF) = (u32x2){w0, w1}; }
                }
        }
    }
};

struct Epi2 {
    static constexpr bool PERM = true, AFTER_DRAIN = false, HAS_MID = true; static constexpr int MID_T = 8;
    const unsigned char* GT; unsigned char* MIX8; unsigned* part; unsigned* rcnt; float* rmaxf; PG8_LAS unsigned char* red_lds;
    static __device__ __forceinline__ float ub(unsigned w, int e) { return (float)((w >> (8 * e)) & 0xffu); }
    static __device__ __forceinline__ float gcv(unsigned w, int e) { return fmaxf(ub(w, e) * (1.0f / 255.0f), 1e-30f); }
    __device__ __forceinline__ void mid(f32x4 (&acc)[2][2][4][2], const Unit& u, int wr, int wc, int fr, int fq) const {
        asm volatile("" : "+v"(fr), "+v"(fq));
        const int row0 = u.pm * BM + wr * 64 + fr, col0 = u.pn * BM + wc * 32 + 8 * fq;
        u32x2 ga[2][4][2], gb[2][4][2];
#pragma unroll
        for (int ai = 0; ai < 2; ++ai)
#pragma unroll
            for (int m = 0; m < 4; ++m) { const unsigned char* gp = GT + (size_t)(row0 + ai * HALF + m * 16) * 2048 + col0;
#pragma unroll
                for (int bj = 0; bj < 2; ++bj) { ga[ai][m][bj] = *(const u32x2*)(gp + bj * HALF); gb[ai][m][bj] = *(const u32x2*)(gp + 1024 + bj * HALF); } }
        asm volatile("" ::: "memory");
#pragma unroll
        for (int ai = 0; ai < 2; ++ai)
#pragma unroll
            for (int m = 0; m < 4; ++m)
#pragma unroll
                for (int bj = 0; bj < 2; ++bj) { const u32x2 a = ga[ai][m][bj], b = gb[ai][m][bj];
                    f32x4 r0, r1;
#pragma unroll
                    for (int e = 0; e < 4; ++e) { r0[e] = ub(a.x, e) * (1.0f / 255.0f) * __builtin_amdgcn_rcpf(gcv(b.x, e)); r1[e] = ub(a.y, e) * (1.0f / 255.0f) * __builtin_amdgcn_rcpf(gcv(b.y, e)); }
                    acc[ai][bj][m][0] *= r0; acc[ai][bj][m][1] *= r1; }
        asm volatile("" ::: "memory");
    }
    __device__ __forceinline__ void operator()(f32x4 (&acc)[2][2][4][2], const Unit& u, int wr, int wc, int fr, int fq) const {
        asm volatile("" : "+v"(fr), "+v"(fq));
        const int row0 = u.pm * BM + wr * 64 + fr, col0 = u.pn * BM + wc * 32 + 8 * fq;
        PG8_LAS float* red = (PG8_LAS float*)red_lds; PG8_LAS float* red2 = red + 1024;
#pragma unroll
        for (int ai = 0; ai < 2; ++ai) { u32x2 gb[4][2];
#pragma unroll
            for (int m = 0; m < 4; ++m) { const unsigned char* gp = GT + (size_t)(row0 + ai * HALF + m * 16) * 2048 + 1024 + col0;
#pragma unroll
                for (int bj = 0; bj < 2; ++bj) gb[m][bj] = *(const u32x2*)(gp + bj * HALF); }
#pragma unroll
            for (int m = 0; m < 4; ++m) { float a = 0.f;
#pragma unroll
                for (int bj = 0; bj < 2; ++bj) { const u32x2 b = gb[m][bj];
#pragma unroll
                    for (int e = 0; e < 4; ++e) { acc[ai][bj][m][0][e] *= gcv(b.x, e); acc[ai][bj][m][1][e] *= gcv(b.y, e); a = fmaxf(a, fmaxf(fabsf(acc[ai][bj][m][0][e]), fabsf(acc[ai][bj][m][1][e]))); } }
                a = fmaxf(a, __shfl_xor(a, 16)); a = fmaxf(a, __shfl_xor(a, 32));
                if (fq == 0) red[(wr * 64 + fr + ai * HALF + m * 16) * 4 + wc] = a; }
            asm volatile("" ::: "memory");
        }
        asm volatile("s_waitcnt lgkmcnt(0)" ::: "memory"); __builtin_amdgcn_s_barrier(); asm volatile("" ::: "memory");
        const int tid = (wr * 4 + wc) * 64 + fr + 16 * fq;
        if (tid < 256) {
            const f32x4 p4 = *(const PG8_LAS f32x4*)(red + tid * 4);
            const float v = fmaxf(fmaxf(p4[0], p4[1]), fmaxf(p4[2], p4[3]));
            unsigned* pr = part + (size_t)(u.pm * BM + tid) * 4;
            __hip_atomic_store(pr + u.pn, __float_as_uint(v), __ATOMIC_RELAXED, __HIP_MEMORY_SCOPE_AGENT);
            asm volatile("s_waitcnt vmcnt(0)" ::: "memory");
            if ((tid & 63) == 0) (void)__hip_atomic_fetch_add(rcnt + u.pm, 1u, __ATOMIC_RELAXED, __HIP_MEMORY_SCOPE_AGENT);
            { unsigned sp = 0; while (__hip_atomic_load(rcnt + u.pm, __ATOMIC_RELAXED, __HIP_MEMORY_SCOPE_AGENT) < 16u) { __builtin_amdgcn_s_sleep(4); if (++sp > (1u << 21)) break; } }
            asm volatile("" ::: "memory");
            float f = 0.f;
#pragma unroll
            for (int j = 0; j < 4; ++j) f = fmaxf(f, __uint_as_float(__hip_atomic_load(pr + j, __ATOMIC_RELAXED, __HIP_MEMORY_SCOPE_AGENT)));
            red2[tid] = f;
            if (u.pn == 0) rmaxf[u.pm * BM + tid] = f;
        }
        asm volatile("s_waitcnt lgkmcnt(0)" ::: "memory"); __builtin_amdgcn_s_barrier(); asm volatile("" ::: "memory");
#pragma unroll
        for (int ai = 0; ai < 2; ++ai)
#pragma unroll
            for (int m = 0; m < 4; ++m) { const int row = row0 + ai * HALF + m * 16;
                const float rm = red2[wr * 64 + fr + ai * HALF + m * 16]; const float sc = rm > 0.f ? 127.0f / rm : 0.f;
#pragma unroll
                for (int bj = 0; bj < 2; ++bj) { unsigned w0 = 0, w1 = 0;
#pragma unroll
                    for (int e = 0; e < 4; ++e) { w0 |= ((unsigned)(int)__builtin_rintf(acc[ai][bj][m][0][e] * sc) & 0xffu) << (8 * e); w1 |= ((unsigned)(int)__builtin_rintf(acc[ai][bj][m][1][e] * sc) & 0xffu) << (8 * e); }
                    *(u32x2*)(MIX8 + (size_t)row * 1024 + col0 + bj * HALF) = (u32x2){w0, w1}; } }
    }
};

struct Epi3 {
    static constexpr bool PERM = true, AFTER_DRAIN = false, HAS_MID = false; static constexpr int MID_T = -1;
    const bf16_t* xb; const float* rms; const unsigned* rmax; const float* wos; bf16_t* x1b; float* ssq;
    __device__ __forceinline__ void mid(f32x4 (&)[2][2][4][2], const Unit&, int, int, int, int) const {}
    static __device__ __forceinline__ f32x4 cvt(const f32x4 a, const f32x4 sc) { const i32x4 ia = __builtin_bit_cast(i32x4, a); return (f32x4){(float)ia[0], (float)ia[1], (float)ia[2], (float)ia[3]} * sc; }
    __device__ __forceinline__ void operator()(const f32x4 (&acc)[2][2][4][2], const Unit& u, int wr, int wc, int fr, int fq) const {
        asm volatile("" : "+v"(fr), "+v"(fq));
        const int row0 = u.pm * BM + wr * 64 + fr, col0 = u.pn * BM + wc * 32 + 8 * fq;
        f32x4 wsv[2][2];
#pragma unroll
        for (int bj = 0; bj < 2; ++bj)
#pragma unroll
            for (int n = 0; n < 2; ++n) wsv[bj][n] = *(const f32x4*)(wos + col0 + bj * HALF + 4 * n);
#pragma unroll
        for (int ai = 0; ai < 2; ++ai) { u32x4 xv[4][2]; float rm[4], ms[4];
#pragma unroll
            for (int m = 0; m < 4; ++m) { const int row = row0 + ai * HALF + m * 16; const size_t off = (size_t)row * 1024 + col0; rm[m] = rms[row]; ms[m] = __uint_as_float(rmax[row]) * (1.0f / 127.0f);
#pragma unroll
                for (int bj = 0; bj < 2; ++bj) xv[m][bj] = *(const u32x4*)(xb + off + bj * HALF); }
#pragma unroll
            for (int m = 0; m < 4; ++m) { const int row = row0 + ai * HALF + m * 16; const size_t off = (size_t)row * 1024 + col0; float ss = 0.f; const float r = rm[m], mr = ms[m];
#pragma unroll
                for (int bj = 0; bj < 2; ++bj) { const u32x4 w = xv[m][bj];
                    const f32x4 x0 = (f32x4){bflo(w.x), bfhi(w.x), bflo(w.y), bfhi(w.y)}, x1 = (f32x4){bflo(w.z), bfhi(w.z), bflo(w.w), bfhi(w.w)};
                    const f32x4 v0 = cvt(acc[ai][bj][m][0], wsv[bj][0]) * mr + x0 * r, v1 = cvt(acc[ai][bj][m][1], wsv[bj][1]) * mr + x1 * r;
                    *(u32x4*)(x1b + off + bj * HALF) = pack8(v0, v1);
                    const f32x4 q0 = v0 * v0, q1 = v1 * v1; ss += ((q0[0] + q0[1]) + (q0[2] + q0[3])) + ((q1[0] + q1[1]) + (q1[2] + q1[3])); }
                ss += __shfl_xor(ss, 16); ss += __shfl_xor(ss, 32);
                if (fq == 0) ssq[(size_t)row * 16 + u.pn * 4 + wc] = ss;
            }
            asm volatile("" ::: "memory");
        }
    }
};

__device__ __forceinline__ unsigned f2key(float v) { const unsigned u = __float_as_uint(v); return (u & 0x80000000u) ? ~u : (u | 0x80000000u); }
__device__ __forceinline__ float key2f(unsigned k) { return __uint_as_float((k & 0x80000000u) ? (k & 0x7fffffffu) : ~k); }
#define PG8_CE(a_, b_) do { const unsigned hi__ = (a_) > (b_) ? (a_) : (b_); const unsigned lo__ = (a_) > (b_) ? (b_) : (a_); (a_) = hi__; (b_) = lo__; } while (0)
__device__ __forceinline__ void bitonic_merge16(unsigned (&v)[16]) {
#pragma unroll
    for (int j = 8; j >= 1; j >>= 1)
#pragma unroll
        for (int i = 0; i < 16; ++i) { const int l = i ^ j; if (l > i) PG8_CE(v[i], v[l]); }
}
__device__ __forceinline__ void bitonic_sort16(unsigned (&v)[16]) {
#pragma unroll
    for (int k = 2; k <= 16; k <<= 1)
#pragma unroll
        for (int j = k >> 1; j >= 1; j >>= 1)
#pragma unroll
            for (int i = 0; i < 16; ++i) { const int l = i ^ j; if (l > i) { if ((i & k) == 0 || k == 16) PG8_CE(v[i], v[l]); else PG8_CE(v[l], v[i]); } }
}
__device__ __forceinline__ void merge_top16(unsigned (&t)[16], const unsigned (&o)[16]) {
#pragma unroll
    for (int i = 0; i < 16; ++i) t[i] = t[i] > o[15 - i] ? t[i] : o[15 - i];
    bitonic_merge16(t);
}
template <int XM> __device__ __forceinline__ void merge_top16_xor(unsigned (&t)[16]) {
    unsigned o[16];
#pragma unroll
    for (int i = 0; i < 16; ++i) o[i] = (unsigned)__shfl_xor((int)t[i], XM);
    merge_top16(t, o);
}

struct Epi4 {
    static constexpr bool PERM = false, AFTER_DRAIN = true, HAS_MID = false; static constexpr int MID_T = -1;
    const float* ssq; float* rinv2; unsigned short* ids; float* gw;
    const float* hs; const float* wcs;
    __device__ __forceinline__ void mid(f32x4 (&)[2][2][4][2], const Unit&, int, int, int, int) const {}
    __device__ __forceinline__ void fused(f32x4 (&acc)[2][2][4][2], const Unit& u, int wr, int wc, int fr, int fq, PG8_LAS unsigned char* lds, int wid, int lane) const {
        asm volatile("" : "+v"(fr), "+v"(fq));
        const int tid = wid * 64 + lane;
        const int rl = tid >> 2, p = (tid >> 1) & 1, hf = tid & 1, q4 = tid & 3;
#pragma unroll
        for (int pass = 0; pass < 2; ++pass) {
            f32x4 wsv[2][2]; float hsv[4];
#pragma unroll
            for (int bj = 0; bj < 2; ++bj)
#pragma unroll
                for (int n = 0; n < 2; ++n) wsv[bj][n] = *(const f32x4*)(wcs + u.pn * BM + bj * HALF + wc * 32 + n * 16 + fq * 4);
#pragma unroll
            for (int m = 0; m < 4; ++m) hsv[m] = hs[u.pm * BM + pass * HALF + wr * 64 + m * 16 + fr];
#pragma unroll
            for (int m = 0; m < 4; ++m)
#pragma unroll
                for (int bj = 0; bj < 2; ++bj)
#pragma unroll
                    for (int n = 0; n < 2; ++n) { const i32x4 ia = __builtin_bit_cast(i32x4, acc[pass][bj][m][n]); f32x4 sv;
#pragma unroll
                        for (int e = 0; e < 4; ++e) sv[e] = (float)ia[e] * hsv[m] * wsv[bj][n][e];
                        *(PG8_LAS f32x4*)(lds + (size_t)(wr * 64 + m * 16 + fr) * 1056 + bj * 528 + (wc * 32 + n * 16 + fq * 4) * 4) = sv; }
            asm volatile("s_waitcnt lgkmcnt(0)" ::: "memory"); __builtin_amdgcn_s_barrier(); asm volatile("" ::: "memory");
            const int row = u.pm * BM + pass * HALF + rl;
            unsigned tk[16];
#pragma unroll
            for (int i = 0; i < 16; ++i) tk[i] = 0u;
            const PG8_LAS unsigned char* sp = lds + (size_t)rl * 1056 + p * 528 + hf * 256;
#pragma nounroll
            for (int c = 0; c < 4; ++c) { unsigned ch[16];
#pragma unroll
                for (int e4 = 0; e4 < 4; ++e4) { const f32x4 v = *(const PG8_LAS f32x4*)(sp + c * 64 + e4 * 16);
#pragma unroll
                    for (int e = 0; e < 4; ++e) ch[4 * e4 + e] = (f2key(v[e]) & ~127u) | (unsigned)(127 - (64 * hf + 16 * c + 4 * e4 + e)); }
                bitonic_sort16(ch);
                merge_top16(tk, ch);
            }
            merge_top16_xor<1>(tk);
            asm volatile("s_waitcnt lgkmcnt(0)" ::: "memory");
            PG8_LAS unsigned* kl = (PG8_LAS unsigned*)(lds + (size_t)(rl & ~15) * 1056) + ((rl & 15) * 2) * 16;
            if (hf == 0) {
#pragma unroll
                for (int i = 0; i < 4; ++i) *(PG8_LAS u32x4*)(kl + p * 16 + 4 * i) = (u32x4){tk[4 * i], tk[4 * i + 1], tk[4 * i + 2], tk[4 * i + 3]}; }
            asm volatile("s_waitcnt lgkmcnt(0)" ::: "memory");
            unsigned ck[16];
#define CAND_SLOT(m_, ij__) do { const unsigned i__ = (ij__) >> 4, j__ = (ij__) & 15u; \
                const unsigned ka__ = kl[(ij__) == 0xFFFFu ? 0u : i__], kb__ = kl[16 + ((ij__) == 0xFFFFu ? 0u : j__)]; \
                const float s__ = key2f(ka__ & ~127u) + key2f(kb__ & ~127u); \
                ck[m_] = (ij__) == 0xFFFFu ? 0u : ((f2key(s__) & ~255u) | (255u - (ij__))); } while (0)
                { const unsigned ij_ = q4 == 0 ? 0u : q4 == 1 ? 1u : q4 == 2 ? 2u : 3u; CAND_SLOT(0, ij_); }
                { const unsigned ij_ = q4 == 0 ? 4u : q4 == 1 ? 5u : q4 == 2 ? 6u : 7u; CAND_SLOT(1, ij_); }
                { const unsigned ij_ = q4 == 0 ? 8u : q4 == 1 ? 9u : q4 == 2 ? 10u : 11u; CAND_SLOT(2, ij_); }
                { const unsigned ij_ = q4 == 0 ? 12u : q4 == 1 ? 13u : q4 == 2 ? 14u : 15u; CAND_SLOT(3, ij_); }
                { const unsigned ij_ = q4 == 0 ? 16u : q4 == 1 ? 17u : q4 == 2 ? 18u : 19u; CAND_SLOT(4, ij_); }
                { const unsigned ij_ = q4 == 0 ? 20u : q4 == 1 ? 21u : q4 == 2 ? 22u : 23u; CAND_SLOT(5, ij_); }
                { const unsigned ij_ = q4 == 0 ? 32u : q4 == 1 ? 33u : q4 == 2 ? 34u : 35u; CAND_SLOT(6, ij_); }
                { const unsigned ij_ = q4 == 0 ? 36u : q4 == 1 ? 48u : q4 == 2 ? 49u : 50u; CAND_SLOT(7, ij_); }
                { const unsigned ij_ = q4 == 0 ? 51u : q4 == 1 ? 64u : q4 == 2 ? 65u : 66u; CAND_SLOT(8, ij_); }
                { const unsigned ij_ = q4 == 0 ? 80u : q4 == 1 ? 81u : q4 == 2 ? 96u : 97u; CAND_SLOT(9, ij_); }
                { const unsigned ij_ = q4 == 0 ? 112u : q4 == 1 ? 113u : q4 == 2 ? 128u : 144u; CAND_SLOT(10, ij_); }
                { const unsigned ij_ = q4 == 0 ? 160u : q4 == 1 ? 176u : q4 == 2 ? 192u : 208u; CAND_SLOT(11, ij_); }
                { const unsigned ij_ = q4 == 0 ? 224u : q4 == 1 ? 240u : q4 == 2 ? 65535u : 65535u; CAND_SLOT(12, ij_); }
#undef CAND_SLOT
            ck[13] = 0u; ck[14] = 0u; ck[15] = 0u;
            bitonic_sort16(ck);
            merge_top16_xor<1>(ck); merge_top16_xor<2>(ck);
            float sq = 0.f;
#pragma unroll
            for (int i = 0; i < 4; ++i) { const f32x4 t = *(const f32x4*)(ssq + (size_t)row * 16 + 4 * i); sq += (t[0] + t[1]) + (t[2] + t[3]); }
            const float r2 = __builtin_amdgcn_rsqf(sq * (1.0f / 1024.0f) + 1e-6f);
            if (u.pn == 0 && q4 == 0) rinv2[row] = r2;
            const float b0 = key2f(ck[0] & ~255u); float wsum = 0.f; float wv[16];
#pragma unroll
            for (int q = 0; q < 16; ++q) { wv[q] = __builtin_amdgcn_exp2f((key2f(ck[q] & ~255u) - b0) * r2 * 1.4426950408889634f); wsum += wv[q]; }
            const float inv = 1.0f / wsum;
            unsigned short eo[4]; float go[4];
#pragma unroll
            for (int e = 0; e < 4; ++e) { unsigned c0 = ck[e], c1 = ck[4 + e], c2 = ck[8 + e], c3 = ck[12 + e]; float w0 = wv[e], w1 = wv[4 + e], w2 = wv[8 + e], w3 = wv[12 + e];
                asm volatile("" : "+v"(c0), "+v"(c1), "+v"(c2), "+v"(c3), "+v"(w0), "+v"(w1), "+v"(w2), "+v"(w3));
                const unsigned cc = q4 == 0 ? c0 : q4 == 1 ? c1 : q4 == 2 ? c2 : c3; const float ww = q4 == 0 ? w0 : q4 == 1 ? w1 : q4 == 2 ? w2 : w3;
                const unsigned code = 255u - (cc & 255u);
                const unsigned i1 = 127u - (kl[code >> 4] & 127u), i2 = 127u - (kl[16 + (code & 15u)] & 127u);
                eo[e] = (unsigned short)(i1 * 128u + i2); go[e] = ww * inv; }
            const size_t ob = ((size_t)row * 8 + u.pn) * 16 + q4 * 4;
            { u32x2 w; w.x = eo[0] | ((unsigned)eo[1] << 16); w.y = eo[2] | ((unsigned)eo[3] << 16); *(u32x2*)(ids + ob) = w; }
            *(f32x4*)(gw + ob) = (f32x4){go[0], go[1], go[2], go[3]};
            asm volatile("s_waitcnt lgkmcnt(0)" ::: "memory"); __builtin_amdgcn_s_barrier(); asm volatile("" ::: "memory");
        }
    }
};
template <class Epi, class Sched, bool ALIGN_EPI = false, bool SP2 = false, bool FP8 = false, bool I8 = false>
__device__ __forceinline__ void gemm_phase(PG8_LAS unsigned char* lds, const Gemm g, const Sched& S, const Epi& E) {
    const int tid = threadIdx.x, wid = __builtin_amdgcn_readfirstlane(tid >> 6), lane = tid & 63, wr = wid >> 2, wc = wid & 3, fr = lane & 15, fq = lane >> 4;
    const int K = g.K, nt = K / BK;
    unsigned voffA[2], voffB[2];
#pragma unroll
    for (int i = 0; i < 2; ++i) { int R, C; stage_rc(tid * 16 + i * 8192, R, C); const int Rb = Epi::PERM ? ((R & ~31) + perm32(R & 31)) : R;
        voffA[i] = (unsigned)(R * K + C) * 2u; voffB[i] = (unsigned)(Rb * K + C) * 2u; }
    const size_t kstep = (size_t)(BK * 2);
    const size_t hstep = (size_t)HALF * K * 2;
    const size_t tstep = 2 * hstep;
    const unsigned ldsw = (unsigned)wid * 1024u;
    const int aoff = lds_byte(wr * 64 + fr, fq * 8), boff = lds_byte(wc * 32 + fr, fq * 8);
#define PG8_SA(b, h) (((b) * 2 + (h)) * HTB)
#define PG8_SB(b, h) ((4 + (b) * 2 + (h)) * HTB)
#define PG8_STAGE(bufoff, gbase, voff) do { _Pragma("unroll") for (int _i = 0; _i < 2; ++_i) \
        __builtin_amdgcn_global_load_lds((const unsigned*)((const char*)(gbase) + (voff)[_i]), (PG8_LAS unsigned*)(lds + (bufoff) + ldsw + _i * 8192), 16, 0, 0); } while (0)
#define PG8_LD8(lo_, hi_) __builtin_bit_cast(i32x8, __builtin_shufflevector((lo_), (hi_), 0, 1, 2, 3, 4, 5, 6, 7))
#define PG8_LDA(dst, b, h) do { if constexpr (FP8) { _Pragma("unroll") for (int m = 0; m < 4; ++m) { const u32x4 l0_ = *(const PG8_LAS u32x4*)(lds + PG8_SA(b, h) + aoff + m * 2048), l1_ = *(const PG8_LAS u32x4*)(lds + PG8_SA(b, h) + aoff + m * 2048 + 1024); dst##8[m] = PG8_LD8(l0_, l1_); } } \
        else { _Pragma("unroll") for (int m = 0; m < 4; ++m) _Pragma("unroll") for (int k = 0; k < 2; ++k) dst[m][k] = *(const PG8_LAS bf16x8*)(lds + PG8_SA(b, h) + aoff + m * 2048 + k * 1024); } } while (0)
#define PG8_LDB(dst, b, h) do { if constexpr (FP8) { _Pragma("unroll") for (int n = 0; n < 2; ++n) { const u32x4 l0_ = *(const PG8_LAS u32x4*)(lds + PG8_SB(b, h) + boff + n * 2048), l1_ = *(const PG8_LAS u32x4*)(lds + PG8_SB(b, h) + boff + n * 2048 + 1024); dst##8[n] = PG8_LD8(l0_, l1_); } } \
        else { _Pragma("unroll") for (int n = 0; n < 2; ++n) _Pragma("unroll") for (int k = 0; k < 2; ++k) dst[n][k] = *(const PG8_LAS bf16x8*)(lds + PG8_SB(b, h) + boff + n * 2048 + k * 1024); } } while (0)
#define PG8_MMA(ai, bj, At, Bt) do { __builtin_amdgcn_s_setprio(1); \
        if constexpr (FP8) { _Pragma("unroll") for (int m = 0; m < 4; ++m) _Pragma("unroll") for (int n = 0; n < 2; ++n) \
            asm volatile("v_mfma_scale_f32_16x16x128_f8f6f4 %0, %1, %2, %0, %3, %3 op_sel_hi:[0,0,0]" : "+v"(acc[ai][bj][m][n]) : "v"(Bt##8[n]), "v"(At##8[m]), "v"(sc127));     \
            } \
        else if constexpr (I8) { _Pragma("unroll") for (int m = 0; m < 4; ++m) _Pragma("unroll") for (int n = 0; n < 2; ++n) _Pragma("unroll") for (int k = 0; k < 2; ++k) \
            acc[ai][bj][m][n] = __builtin_bit_cast(f32x4, __builtin_amdgcn_mfma_i32_16x16x64_i8(__builtin_bit_cast(i32x4, Bt[n][k]), __builtin_bit_cast(i32x4, At[m][k]), __builtin_bit_cast(i32x4, acc[ai][bj][m][n]), 0, 0, 0)); } \
        else { _Pragma("unroll") for (int m = 0; m < 4; ++m) _Pragma("unroll") for (int n = 0; n < 2; ++n) _Pragma("unroll") for (int k = 0; k < 2; ++k) \
            acc[ai][bj][m][n] = __builtin_amdgcn_mfma_f32_16x16x32_bf16(Bt[n][k], At[m][k], acc[ai][bj][m][n], 0, 0, 0); } \
        __builtin_amdgcn_s_setprio(0); } while (0)
#define PG8_WAIT_V(n) asm volatile("s_waitcnt vmcnt(" #n ")" ::: "memory")
#define PG8_WAIT_L(n) asm volatile("s_waitcnt lgkmcnt(" #n ")" ::: "memory")
#define PG8_BAR __builtin_amdgcn_s_barrier()
#define PG8_SCHED __builtin_amdgcn_sched_barrier(0)
    Unit cur, nxt; int ui = 0;
    if (!S.next(0, cur)) return;
    f32x4 acc[2][2][4][2];
#pragma unroll
    for (int a = 0; a < 2; ++a)
#pragma unroll
        for (int b = 0; b < 2; ++b)
#pragma unroll
            for (int m = 0; m < 4; ++m)
#pragma unroll
                for (int n = 0; n < 2; ++n) acc[a][b][m][n] = (f32x4){0.f, 0.f, 0.f, 0.f};
    bf16x8 At[4][2], B0[2][2], B1[2][2]; i32x8 At8[4], B08[2], B18[2];
    int sc127 = 127; asm volatile("" : "+v"(sc127));
    const char* cA = (const char*)g.A + (size_t)cur.pm * tstep; const char* cB = (const char*)g.Bt + (size_t)cur.pn * tstep;
    S.a_ready(cur);
    if constexpr (SP2) {
        PG8_STAGE(PG8_SB(0, 0), cB, voffB); PG8_STAGE(PG8_SB(0, 1), cB + hstep, voffB); PG8_STAGE(PG8_SA(0, 0), cA, voffA); PG8_STAGE(PG8_SA(0, 1), cA + hstep, voffA);
        if (wr == 1) PG8_BAR;
        PG8_WAIT_V(2); PG8_BAR;
        PG8_STAGE(PG8_SB(1, 0), cB + kstep, voffB); PG8_STAGE(PG8_SA(1, 0), cA + kstep, voffA); PG8_STAGE(PG8_SB(1, 1), cB + hstep + kstep, voffB);
        PG8_WAIT_V(6); PG8_BAR;
    } else {
        PG8_STAGE(PG8_SB(0, 0), cB, voffB); PG8_STAGE(PG8_SA(0, 0), cA, voffA); PG8_STAGE(PG8_SB(0, 1), cB + hstep, voffB); PG8_STAGE(PG8_SA(0, 1), cA + hstep, voffA);
        if (wr == 1) PG8_BAR;
        PG8_WAIT_V(4); PG8_BAR;
        PG8_STAGE(PG8_SB(1, 0), cB + kstep, voffB); PG8_STAGE(PG8_SA(1, 0), cA + kstep, voffA); PG8_STAGE(PG8_SB(1, 1), cB + hstep + kstep, voffB);
        PG8_WAIT_V(6); PG8_BAR;
    }
    for (;;) {
        const bool has_next = S.next(ui + 1, nxt);
        const char* nA = has_next ? (const char*)g.A + (size_t)nxt.pm * tstep : cA; const char* nB = has_next ? (const char*)g.Bt + (size_t)nxt.pn * tstep : cB;
        for (int t = 0; t < nt; t += 2) {
            if constexpr (Epi::HAS_MID) { if (t == Epi::MID_T) E.mid(acc, cur, wr, wc, fr, fq); }
            const bool last = (t == nt - 2);
            const char* a1 = cA + (size_t)(t + 1) * kstep;
            const char* a2 = last ? nA : cA + (size_t)(t + 2) * kstep; const char* b2 = last ? nB : cB + (size_t)(t + 2) * kstep;
            const char* a3 = a2 + kstep; const char* b3 = b2 + kstep;
            if (last && has_next) S.a_ready(nxt);
            if constexpr (SP2) {
            PG8_LDB(B0, 0, 0); PG8_LDB(B1, 0, 1); PG8_SCHED; PG8_LDA(At, 0, 0); PG8_STAGE(PG8_SA(1, 1), a1 + hstep, voffA);
            PG8_WAIT_V(8); PG8_WAIT_L(0); PG8_BAR; PG8_MMA(0, 0, At, B0); PG8_MMA(0, 1, At, B1); PG8_BAR; PG8_SCHED;
            PG8_LDA(At, 0, 1); PG8_STAGE(PG8_SB(0, 0), b2, voffB); PG8_STAGE(PG8_SB(0, 1), b2 + hstep, voffB); PG8_STAGE(PG8_SA(0, 0), a2, voffA);
            PG8_WAIT_V(8); PG8_WAIT_L(0); PG8_BAR; PG8_MMA(1, 0, At, B0); PG8_MMA(1, 1, At, B1); PG8_BAR; PG8_SCHED;
            PG8_LDB(B0, 1, 0); PG8_LDB(B1, 1, 1); PG8_SCHED; PG8_LDA(At, 1, 0); PG8_STAGE(PG8_SA(0, 1), a2 + hstep, voffA);
            PG8_WAIT_V(8); PG8_WAIT_L(0); PG8_BAR; PG8_MMA(0, 0, At, B0); PG8_MMA(0, 1, At, B1); PG8_BAR; PG8_SCHED;
            PG8_LDA(At, 1, 1); PG8_STAGE(PG8_SB(1, 0), b3, voffB); PG8_STAGE(PG8_SB(1, 1), b3 + hstep, voffB); PG8_STAGE(PG8_SA(1, 0), a3, voffA);
            PG8_WAIT_V(8); PG8_WAIT_L(0); PG8_BAR; PG8_MMA(1, 0, At, B0); PG8_MMA(1, 1, At, B1); PG8_BAR; PG8_SCHED;
            } else {
            PG8_LDB(B0, 0, 0); PG8_SCHED; PG8_LDA(At, 0, 0); PG8_STAGE(PG8_SA(1, 1), a1 + hstep, voffA);
            PG8_WAIT_L(8); PG8_BAR; PG8_WAIT_L(0); PG8_MMA(0, 0, At, B0); PG8_BAR; PG8_SCHED;
            PG8_LDB(B1, 0, 1); PG8_STAGE(PG8_SB(0, 0), b2, voffB);
            PG8_BAR; PG8_WAIT_L(0); PG8_MMA(0, 1, At, B1); PG8_BAR;
            PG8_LDA(At, 0, 1); PG8_STAGE(PG8_SA(0, 0), a2, voffA);
            PG8_BAR; PG8_WAIT_L(0); PG8_MMA(1, 0, At, B0); PG8_BAR; PG8_SCHED;
            PG8_STAGE(PG8_SB(0, 1), b2 + hstep, voffB);
            PG8_WAIT_V(6); PG8_BAR; PG8_MMA(1, 1, At, B1); PG8_BAR;
            PG8_LDB(B0, 1, 0); PG8_SCHED; PG8_LDA(At, 1, 0); PG8_STAGE(PG8_SA(0, 1), a2 + hstep, voffA);
            PG8_WAIT_L(8); PG8_BAR; PG8_WAIT_L(0); PG8_MMA(0, 0, At, B0); PG8_BAR; PG8_SCHED;
            PG8_LDB(B1, 1, 1); PG8_STAGE(PG8_SB(1, 0), b3, voffB);
            PG8_BAR; PG8_WAIT_L(0); PG8_MMA(0, 1, At, B1); PG8_BAR;
            PG8_LDA(At, 1, 1); PG8_STAGE(PG8_SA(1, 0), a3, voffA);
            PG8_BAR; PG8_WAIT_L(0); PG8_MMA(1, 0, At, B0); PG8_BAR; PG8_SCHED;
            PG8_STAGE(PG8_SB(1, 1), b3 + hstep, voffB);
            PG8_WAIT_V(6); PG8_BAR; PG8_MMA(1, 1, At, B1); PG8_BAR;
            }
        }
        if constexpr (FP8) asm volatile("s_nop 15\n\ts_nop 15" ::: "memory");
        if constexpr (ALIGN_EPI) { if (wr == 0) PG8_BAR; }
        if constexpr (!Epi::AFTER_DRAIN) { E(acc, cur, wr, wc, fr, fq); S.done(cur); }
        if (!has_next) break;
#pragma unroll
        for (int a = 0; a < 2; ++a)
#pragma unroll
            for (int b = 0; b < 2; ++b)
#pragma unroll
                for (int m = 0; m < 4; ++m)
#pragma unroll
                    for (int n = 0; n < 2; ++n) acc[a][b][m][n] = (f32x4){0.f, 0.f, 0.f, 0.f};
        cur = nxt; cA = nA; cB = nB; ++ui;
        if constexpr (ALIGN_EPI) { if (wr == 1) PG8_BAR; }
    }
    PG8_WAIT_V(0);
    if constexpr (!ALIGN_EPI) { if (wr == 0) PG8_BAR; }
    PG8_BAR;
    if constexpr (Epi::AFTER_DRAIN) { E.fused(acc, cur, wr, wc, fr, fq, lds, wid, lane); S.done(cur); }
#undef PG8_SA
#undef PG8_SB
#undef PG8_STAGE
#undef PG8_LDA
#undef PG8_LD8
#undef PG8_LDB
#undef PG8_MMA
#undef PG8_WAIT_V
#undef PG8_WAIT_L
#undef PG8_BAR
#undef PG8_SCHED
}
}


namespace att {
#define ALAS __attribute__((address_space(3)))
typedef unsigned short bf16;
typedef short bf16x8 __attribute__((ext_vector_type(8)));
typedef short s16x4 __attribute__((ext_vector_type(4)));
typedef float f32x16 __attribute__((ext_vector_type(16)));
typedef float f32x4 __attribute__((ext_vector_type(4)));
typedef float f32x2 __attribute__((ext_vector_type(2)));
typedef unsigned u32x4 __attribute__((ext_vector_type(4)));
typedef __bf16 bf16x2_t __attribute__((ext_vector_type(2)));
constexpr int SEQ = 4096;
constexpr int VPITCH = 144;
constexpr float LOG2E = 1.4426950408889634f, LN2 = 0.6931471805599453f;
__device__ __forceinline__ unsigned pkbf(float lo, float hi) { f32x2 v = {lo, hi}; bf16x2_t b = __builtin_convertvector(v, bf16x2_t); return __builtin_bit_cast(unsigned, b); }
__device__ __forceinline__ void wave_lds_sync() { asm volatile("s_waitcnt lgkmcnt(0)" ::: "memory"); }
__device__ __forceinline__ s16x4 vtr(const ALAS unsigned char* p) { return __builtin_bit_cast(s16x4, __builtin_amdgcn_ds_read_tr16_b64_v4i16((ALAS s16x4*)p)); }
__device__ __forceinline__ int crow(int r, int hi) { return (r & 3) + 8 * (r >> 2) + 4 * hi; }

__device__ __forceinline__ void pv_tile(f32x16& o0, f32x16& o1, const float (&a)[16], const ALAS unsigned char* vt, int lane) {
    const int g = lane >> 4, i = lane & 15, q_ = i >> 2, p_ = i & 3, h = lane >> 5;
    const ALAS unsigned char* vb = vt + (8 * h + q_) * VPITCH + (16 * (g & 1) + 4 * p_) * 2;
    u32x4 pw0, pw1;
    pw0.x = pkbf(a[0], a[1]); pw0.y = pkbf(a[2], a[3]); pw0.z = pkbf(a[4], a[5]); pw0.w = pkbf(a[6], a[7]);
    pw1.x = pkbf(a[8], a[9]); pw1.y = pkbf(a[10], a[11]); pw1.z = pkbf(a[12], a[13]); pw1.w = pkbf(a[14], a[15]);
    const bf16x8 pa0 = __builtin_bit_cast(bf16x8, pw0), pa1 = __builtin_bit_cast(bf16x8, pw1);
#pragma unroll
    for (int s = 0; s < 2; ++s) {
        const s16x4 l0 = vtr(vb + (16 * s) * VPITCH), h0 = vtr(vb + (16 * s + 4) * VPITCH);
        const s16x4 l1 = vtr(vb + (16 * s) * VPITCH + 64), h1 = vtr(vb + (16 * s + 4) * VPITCH + 64);
        const bf16x8 v0 = (bf16x8){l0[0], l0[1], l0[2], l0[3], h0[0], h0[1], h0[2], h0[3]};
        const bf16x8 v1 = (bf16x8){l1[0], l1[1], l1[2], l1[3], h1[0], h1[1], h1[2], h1[3]};
        o0 = __builtin_amdgcn_mfma_f32_32x32x16_bf16(s ? pa1 : pa0, v0, o0, 0, 0, 0);
        o1 = __builtin_amdgcn_mfma_f32_32x32x16_bf16(s ? pa1 : pa0, v1, o1, 0, 0, 0);
    }
}
__device__ __forceinline__ void bcast_rows(float v, ALAS float* sc, int r32, int hi, float (&out)[16]) {
    if (hi == 0) sc[r32] = v;
    wave_lds_sync();
#pragma unroll
    for (int g = 0; g < 4; ++g) { const f32x4 t = *(const ALAS f32x4*)(sc + 8 * g + 4 * hi); out[4 * g] = t[0]; out[4 * g + 1] = t[1]; out[4 * g + 2] = t[2]; out[4 * g + 3] = t[3]; }
    wave_lds_sync();
}
__device__ __forceinline__ void store_o(const f32x16& o0, const f32x16& o1, ALAS unsigned char* stg, bf16* dst  , size_t rstride_elems, int lane) {
    const int r32 = lane & 31, hi = lane >> 5;
    wave_lds_sync();
#pragma unroll
    for (int r = 0; r < 16; ++r) { const int q = crow(r, hi);
        *(ALAS unsigned short*)(stg + q * VPITCH + r32 * 2) = (unsigned short)(pkbf(o0[r], 0.f) & 0xffffu);
        *(ALAS unsigned short*)(stg + q * VPITCH + 64 + r32 * 2) = (unsigned short)(pkbf(o1[r], 0.f) & 0xffffu); }
    wave_lds_sync();
#pragma unroll
    for (int i = 0; i < 4; ++i) { const int row = 8 * i + (lane >> 3), ch = lane & 7; const u32x4 v = *(const ALAS u32x4*)(stg + row * VPITCH + ch * 16); *(u32x4*)(dst + (size_t)row * rstride_elems + ch * 8) = v; }
    wave_lds_sync();
}

__device__ __forceinline__ void sb_item(const bf16* QS, const bf16* KS, const bf16* VS, bf16* OC, int b, int h, int qt, ALAS unsigned char* wl, int lane) {
    const int r32 = lane & 31, hi = lane >> 5;
    const int t0 = qt * 32; const size_t rowb = (size_t)b * SEQ;
    const int kperm = (r32 & ~12) | ((r32 & 4) << 1) | ((r32 & 8) >> 1);
    bf16x8 qf[4];
    { const bf16* qp = QS + (rowb + t0 + r32) * 512 + h * 64 + hi * 8;
#pragma unroll
      for (int d0 = 0; d0 < 4; ++d0) qf[d0] = *(const bf16x8*)(qp + d0 * 16); }
    f32x16 o0 = {}, o1 = {}; float R = 0.f;
    for (int key0 = t0; key0 >= 0; key0 -= 32) {
        const bf16* kp = KS + (rowb + key0 + kperm) * 512 + h * 64 + hi * 8;
        bf16x8 kf[4];
#pragma unroll
        for (int d0 = 0; d0 < 4; ++d0) kf[d0] = *(const bf16x8*)(kp + d0 * 16);
        u32x4 vv[4];
#pragma unroll
        for (int i = 0; i < 4; ++i) vv[i] = *(const u32x4*)(VS + (rowb + key0 + 8 * i + (lane >> 3)) * 512 + h * 64 + (lane & 7) * 8);
        f32x16 p = {};
#pragma unroll
        for (int d0 = 0; d0 < 4; ++d0) p = __builtin_amdgcn_mfma_f32_32x32x16_bf16(kf[d0], qf[d0], p, 0, 0, 0);
#pragma unroll
        for (int i = 0; i < 4; ++i) *(ALAS u32x4*)(wl + (8 * i + (lane >> 3)) * VPITCH + (lane & 7) * 16) = vv[i];
        const bool diag = (key0 == t0);
        float z2[16], L2[16];
#pragma unroll
        for (int r = 0; r < 16; ++r) { const int kk = (r & 7) + 8 * hi + 16 * (r >> 3); const float zz = p[r];
            const float sp = fmaxf(zz, 0.f) + __builtin_amdgcn_logf(1.0f + __builtin_amdgcn_exp2f(-fabsf(zz)));
            const bool valid = !diag || (kk < r32); z2[r] = zz; L2[r] = valid ? sp : 0.f; }
        float c[16];
        c[15] = L2[15];
#pragma unroll
        for (int r = 14; r >= 8; --r) c[r] = c[r + 1] + L2[r];
        c[7] = L2[7];
#pragma unroll
        for (int r = 6; r >= 0; --r) c[r] = c[r + 1] + L2[r];
        const float TB = c[8], TA = c[0];
        const float TBo = __shfl_xor(TB, 32), TAo = __shfl_xor(TA, 32);
        const float offB = R + (hi ? 0.f : TBo);
        const float offA = R + TB + TBo + (hi ? 0.f : TAo);
        float a[16];
#pragma unroll
        for (int r = 0; r < 16; ++r) { const int kk = (r & 7) + 8 * hi + 16 * (r >> 3); const bool valid = !diag || (kk < r32);
            const float e = __builtin_amdgcn_exp2f(z2[r] - (c[r] + (r < 8 ? offA : offB))); a[r] = valid ? e : 0.f; }
        R += (TA + TB) + (TAo + TBo);
        wave_lds_sync();
        pv_tile(o0, o1, a, wl, lane);
        wave_lds_sync();
        if (__all(R > 40.0f * LOG2E)) break;
    }
    store_o(o0, o1, wl, OC + (rowb + t0) * 768 + h * 64, 768, lane);
}

constexpr int DLU_WAVE = 5120;
constexpr int DLU_O = 8 * DLU_WAVE, DLU_M = DLU_O + 512 * 128, DLU_L = DLU_M + 2048, DLU_BYTES = DLU_L + 2048;
__device__ __forceinline__ void dl_unit(const bf16* QD, const bf16* KD, const bf16* VD, bf16* OC, int b, int j, int blk, ALAS unsigned char* lds, int wave, int lane) {
    const int r32 = lane & 31, hi = lane >> 5;
    const size_t rowb = (size_t)b * SEQ;
    const int t0 = 512 * blk;
    const int kperm = (r32 & ~12) | ((r32 & 4) << 1) | ((r32 & 8) >> 1);
    ALAS unsigned char* wl = lds + wave * DLU_WAVE;
    ALAS float* sc = (ALAS float*)(wl + 4608);
    ALAS unsigned short* OL = (ALAS unsigned short*)(lds + DLU_O);
    ALAS float* ML = (ALAS float*)(lds + DLU_M); ALAS float* LL = (ALAS float*)(lds + DLU_L);
    for (int g = 2; g >= 0; --g) {
        const int hh = 4 * g + j, sh = 2 * g, r = 1 << sh;
        const float slope2 = __builtin_amdgcn_exp2f(-8.0f * (float)(hh + 1) / 12.0f) * LOG2E;
        const float sr = slope2 * (float)r;
        for (int it = wave; it < 16; it += 8) {
            const int q0 = g == 2 ? it : g == 1 ? (it & 3) + 128 * (it >> 2) : 32 * it;
            const int tq = t0 + q0 + r * r32, tmax = t0 + q0 + 31 * r;
            bf16x8 qf[4];
            { const bf16* qp = QD + (rowb + tq) * 768 + hh * 64 + hi * 8;
#pragma unroll
              for (int d0 = 0; d0 < 4; ++d0) qf[d0] = *(const bf16x8*)(qp + d0 * 16); }
            const int klo = 31 - r32; int khi = klo + 128; { const int kmaxtok = tmax >> sh; khi = khi < kmaxtok ? khi : kmaxtok; }
            const unsigned krange = (unsigned)(khi - klo);
            f32x16 o0 = {}, o1 = {}; float mrun = -3.0e38f, lrun = 0.f;
            if (g != 2) {
                mrun = ML[q0 + r * r32]; lrun = hi ? 0.f : LL[q0 + r * r32];
#pragma unroll
                for (int q = 0; q < 16; ++q) { const int tl = q0 + r * crow(q, hi);
                    o0[q] = __uint_as_float((unsigned)OL[tl * 64 + r32] << 16); o1[q] = __uint_as_float((unsigned)OL[tl * 64 + 32 + r32] << 16); }
            }
            for (int kt = 0; kt < 5; ++kt) {
                int sk = tmax - r * (32 * kt + kperm); sk = sk < 0 ? 0 : sk;
                const bf16* kp = KD + (rowb + sk) * 768 + hh * 64 + hi * 8;
                bf16x8 kf[4];
#pragma unroll
                for (int d0 = 0; d0 < 4; ++d0) kf[d0] = *(const bf16x8*)(kp + d0 * 16);
                u32x4 vv[4];
#pragma unroll
                for (int i = 0; i < 4; ++i) { int sv = tmax - r * (32 * kt + 8 * i + (lane >> 3)); sv = sv < 0 ? 0 : sv; vv[i] = *(const u32x4*)(VD + (rowb + sv) * 768 + hh * 64 + (lane & 7) * 8); }
                const int dk = 32 * kt + 8 * hi - klo;
                const float tb = -sr * (float)dk;
                f32x16 p;
#pragma unroll
                for (int q = 0; q < 16; ++q) p[q] = tb - sr * (float)((q & 7) + 16 * (q >> 3));
#pragma unroll
                for (int d0 = 0; d0 < 4; ++d0) p = __builtin_amdgcn_mfma_f32_32x32x16_bf16(kf[d0], qf[d0], p, 0, 0, 0);
#pragma unroll
                for (int i = 0; i < 4; ++i) *(ALAS u32x4*)(wl + (8 * i + (lane >> 3)) * VPITCH + (lane & 7) * 16) = vv[i];
                float z2[16]; float mt = -3.0e38f;
#pragma unroll
                for (int q = 0; q < 16; ++q) { const bool valid = (unsigned)(dk + ((q & 7) + 16 * (q >> 3))) <= krange; z2[q] = valid ? p[q] : -INFINITY; mt = fmaxf(mt, z2[q]); }
                mt = fmaxf(mt, __shfl_xor(mt, 32));
                if (__any(mt > mrun + 8.0f)) {
                    const float mnew = fmaxf(mrun, mt); const float alpha = __builtin_amdgcn_exp2f(mrun - mnew);
                    lrun *= alpha; float al[16]; bcast_rows(alpha, sc, r32, hi, al);
#pragma unroll
                    for (int q = 0; q < 16; ++q) { o0[q] *= al[q]; o1[q] *= al[q]; }
                    mrun = mnew;
                }
                float a[16]; float ls = 0.f;
#pragma unroll
                for (int q = 0; q < 16; ++q) { a[q] = __builtin_amdgcn_exp2f(z2[q] - mrun); ls += a[q]; }
                lrun += ls;
                wave_lds_sync();
                pv_tile(o0, o1, a, wl, lane);
                wave_lds_sync();
            }
            const float ltot = lrun + __shfl_xor(lrun, 32);
            if (g != 0) {
                if (hi == 0) { ML[q0 + r * r32] = mrun; LL[q0 + r * r32] = ltot; }
#pragma unroll
                for (int q = 0; q < 16; ++q) { const int tl = q0 + r * crow(q, hi);
                    OL[tl * 64 + r32] = (unsigned short)(pkbf(o0[q], 0.f) & 0xffffu); OL[tl * 64 + 32 + r32] = (unsigned short)(pkbf(o1[q], 0.f) & 0xffffu); }
            } else {
                float il[16]; bcast_rows(1.0f / ltot, sc, r32, hi, il);
#pragma unroll
                for (int q = 0; q < 16; ++q) { o0[q] *= il[q]; o1[q] *= il[q]; }
                store_o(o0, o1, wl, OC + (rowb + t0 + q0) * 768 + 512 + j * 64, 768, lane);
            }
        }
        asm volatile("s_waitcnt lgkmcnt(0)" ::: "memory"); __builtin_amdgcn_s_barrier(); asm volatile("" ::: "memory");
    }
}
#undef ALAS
}

constexpr int NWAVES = 8;
#ifndef MK_N_LAUNCHES
#define MK_N_LAUNCHES 1
#endif
#ifndef MK_LAST_PHASE
#define MK_LAST_PHASE 8
#endif
constexpr int N_LAUNCHES = MK_N_LAUNCHES;
constexpr int PER_PHASE = 8;

constexpr int BATCH = 16, SEQ = 4096, D = 1024, T = BATCH * SEQ;
constexpr int N1 = 5888;
constexpr int NEXP = 16384;
constexpr size_t MiB = 1u << 20;
constexpr size_t WS_CTL = 0, CTL_ZERO_BYTES = 1 * MiB;
constexpr size_t WS_WIN = 2 * MiB;
constexpr size_t WS_WCAT = 16 * MiB;
constexpr size_t WS_WOUT = 18 * MiB;
constexpr size_t WS_WC = 20 * MiB;
constexpr size_t WS_RINV1 = 24 * MiB;
constexpr size_t WS_RINV2 = 25 * MiB;
constexpr size_t WS_USC = 25 * MiB + 512 * 1024, WS_VSC = 25 * MiB + 768 * 1024;
constexpr size_t WS_SSQ = 26 * MiB;
constexpr size_t WS_U8 = 32 * MiB;
constexpr size_t WS_V8 = 64 * MiB;
constexpr size_t WS_IDS = 96 * MiB;
constexpr size_t WS_GW = 112 * MiB;
constexpr size_t WS_XB = 144 * MiB;
constexpr size_t WS_OC = 880 * MiB;
constexpr size_t WS_QS = 272 * MiB, WS_KS = 336 * MiB, WS_VS = 400 * MiB;
constexpr size_t WS_QD = 464 * MiB, WS_KD = 560 * MiB, WS_VD = 656 * MiB;
constexpr size_t WS_GT = 752 * MiB;
constexpr size_t WS_COEF = 272 * MiB;
constexpr size_t WS_MIX = 272 * MiB;
constexpr size_t WS_X1B = 400 * MiB;
constexpr size_t WS_HQ = 528 * MiB;
constexpr size_t WS_HS2 = 24 * MiB + 512 * 1024;
constexpr size_t WS_XB8 = 72 * MiB;
constexpr size_t WS_WG8 = 40 * MiB;
constexpr size_t WS_PART = 56 * MiB;
constexpr size_t WS_RMAXF = 24 * MiB + 768 * 1024;
constexpr size_t WS_WOS = 46 * MiB + 512 * 1024;
constexpr size_t WS_WCS = 46 * MiB;
constexpr size_t WS_WCF = 48 * MiB;
constexpr size_t WS_XS = 24 * MiB + 256 * 1024;
constexpr size_t WS_GCS = 47 * MiB;
constexpr size_t WS_END = 1008 * MiB;
constexpr int CW_BAR = 4096;
constexpr int CW_OMAX = 28672;
constexpr int CW_RMAX = 65536;
constexpr int CW_RCNT = 131072;
constexpr int CW_WMAX = 24576;
constexpr int CW_GMAX = 16384;
constexpr int CW_XRANK = 8192;

constexpr int RING_OFF = 0, RING_BYTES = 131072;
constexpr int LDSCTL_OFF = 143360, MISC_OFF = LDSCTL_OFF + 320;
constexpr int LDS_BYTES = 147456;
static_assert(MISC_OFF + 128 <= LDS_BYTES, "LDS map");
#define GAS __attribute__((address_space(1)))
#define LAS __attribute__((address_space(3)))
typedef unsigned short bf16;
typedef unsigned v4u __attribute__((ext_vector_type(4)));
typedef float f32x4 __attribute__((ext_vector_type(4)));
typedef short bf16x8 __attribute__((ext_vector_type(8)));
typedef GAS unsigned gu32;
typedef GAS unsigned long long gu64;
#define RLX_AGENT __ATOMIC_RELAXED, __HIP_MEMORY_SCOPE_AGENT
#define LDS_WAIT() asm volatile("s_waitcnt lgkmcnt(0)" ::: "memory")
#define VM_WAIT() asm volatile("s_waitcnt vmcnt(0)" ::: "memory")
__device__ __forceinline__ unsigned long long rt() { return __builtin_amdgcn_s_memrealtime(); }
__device__ __forceinline__ unsigned f2bf(float f) { unsigned u = __builtin_bit_cast(unsigned, f); return (u + 0x7fffu + ((u >> 16) & 1u)) >> 16; }
__device__ __forceinline__ unsigned pk2(float lo, float hi) { return f2bf(lo) | (f2bf(hi) << 16); }

#define XB_TMO      128
#define XB_XCNT(j)  (256  + 64 * (j))
#define XB_XSUB(j)  (1280 + 64 * (j))
#define XB_XGEN(j)  (2304 + 64 * (j))
#define XB_TOP      3328
#define XB_TOPGEN   3392
#define XCD_BAR_WORDS 3456
#define XB_SPIN_CAP (1u << 18)

__device__ __forceinline__ unsigned xb_ld(unsigned* p)              { return __hip_atomic_load(p, __ATOMIC_RELAXED, __HIP_MEMORY_SCOPE_AGENT); }
__device__ __forceinline__ unsigned xb_add(unsigned* p, unsigned v) { return __hip_atomic_fetch_add(p, v, __ATOMIC_RELAXED, __HIP_MEMORY_SCOPE_AGENT); }
__device__ __forceinline__ unsigned xb_xcc_id() { return (unsigned)__builtin_amdgcn_s_getreg((3 << 11) | 20) & 0xFu; }
#define XB_SPIN(cond, bar) do { unsigned _sp = 0; while (cond) { __builtin_amdgcn_s_sleep(1); \
    if ((++_sp & 255u) == 0u) { if (xb_ld(&(bar)[XB_TMO])) break; if (_sp > XB_SPIN_CAP) { atomicAdd(&(bar)[XB_TMO], 1u); break; } } } } while (0)

struct XcdBarrier {
    unsigned* bar; unsigned x;
    volatile LAS unsigned* st;
};

__device__ __forceinline__ XcdBarrier xcd_barrier_post(unsigned* bar, volatile LAS unsigned* st) {
    XcdBarrier b; b.bar = bar; b.x = xb_xcc_id(); b.st = st;
    if (threadIdx.x == 0) (void)xb_add(&bar[XB_XCNT(b.x)], 1u);
    return b;
}
__device__ __forceinline__ void xcd_barrier_complete(unsigned* bar, unsigned x, unsigned& nloc, unsigned& nx) {
    const unsigned G = gridDim.x * gridDim.y * gridDim.z;
    unsigned sum, cnt, mine, sp = 0u;
    for (;;) {
        sum = 0u; cnt = 0u; mine = 0u;
#pragma unroll
        for (unsigned j = 0; j < 16; ++j) { const unsigned c = xb_ld(&bar[XB_XCNT(j)]); sum += c; cnt += (c > 0u) ? 1u : 0u; mine = (j == x) ? c : mine; }
        if (sum == G) break;
        __builtin_amdgcn_s_sleep(1);
        if ((++sp & 255u) == 0u) { if (xb_ld(&bar[XB_TMO])) break; if (sp > XB_SPIN_CAP) { atomicAdd(&bar[XB_TMO], 1u); break; } }
    }
    nloc = mine > 0u ? mine : 1u; nx = cnt > 0u ? cnt : 1u;
}

__device__ __forceinline__ void xcd_barrier(const XcdBarrier& b) {
    asm volatile("s_waitcnt vmcnt(0)" ::: "memory");
    __syncthreads();
    if (threadIdx.x == 0) {
        unsigned* bar = b.bar;
        __builtin_amdgcn_s_waitcnt(0);
        unsigned nloc = b.st[0], nx = b.st[1];
        if (nloc == 0u) { xcd_barrier_complete(bar, b.x, nloc, nx); b.st[0] = nloc; b.st[1] = nx; }
        const unsigned old = xb_add(&bar[XB_XSUB(b.x)], 1u);
        const unsigned gen = old / nloc;
        if (old + 1u == (gen + 1u) * nloc) {
            __builtin_amdgcn_fence(__ATOMIC_RELEASE, "agent");
            asm volatile("s_waitcnt vmcnt(0)" ::: "memory");
            const unsigned og = xb_add(&bar[XB_TOP], 1u);
            const unsigned tg = og / nx;
            if (og + 1u == (tg + 1u) * nx) xb_add(&bar[XB_TOPGEN], 1u);
            else XB_SPIN(xb_ld(&bar[XB_TOPGEN]) == tg, bar);
            __builtin_amdgcn_fence(__ATOMIC_ACQUIRE, "agent");
            xb_add(&bar[XB_XGEN(b.x)], 1u);
            asm volatile("s_waitcnt vmcnt(0)" ::: "memory");
        } else {
            XB_SPIN(xb_ld(&bar[XB_XGEN(b.x)]) == gen, bar);
            __builtin_amdgcn_fence(__ATOMIC_ACQUIRE, "agent");
            asm volatile("s_waitcnt vmcnt(0)" ::: "memory");
        }
    }
    __syncthreads();
}

typedef float f32x2 __attribute__((ext_vector_type(2)));
typedef unsigned v2u __attribute__((ext_vector_type(2)));
typedef int v4i __attribute__((ext_vector_type(4)));
typedef _Float16 h2_t __attribute__((ext_vector_type(2)));
struct Frame {
    LAS unsigned char* lds;
    volatile LAS unsigned* MISC;
    gu32* ctl;
    int tid, lane, wave;
    int vcu, G;
};
__device__ __forceinline__ float wave_sum(float v) {
#pragma unroll
    for (int o = 1; o < 64; o <<= 1) v += __shfl_xor(v, o);
    return v;
}
__device__ __forceinline__ float wave_max(float v) {
#pragma unroll
    for (int o = 1; o < 64; o <<= 1) v = fmaxf(v, __shfl_xor(v, o));
    return v;
}
constexpr int NB16 = 0, N8 = 5888 - NB16;
__device__ __forceinline__ int win_row(int n) { if (n < 1536 || n >= 3072) return n; const int t = (n - 1536) >> 8, ln = (n - 1536) & 255, hl = ln >> 6, d = ln & 63; return 1536 + t * 256 + 32 * hl + (d & 31) + 128 * (d >> 5); }
__device__ __forceinline__ void p0_transpose_item(const float* W, int N, const float* gain, bf16* WT, int ldt, int koff, int mode, LAS float* scr, int item, int lane) {
    const int nblk = N / 32, kb = item / nblk, nb = item % nblk, k0 = 64 * kb, n0 = 32 * nb;
#pragma unroll 8
    for (int i = 0; i < 32; ++i) { const int kk = 2 * i + (lane >> 5); float v = W[(size_t)(k0 + kk) * N + n0 + (lane & 31)]; if (gain) v *= gain[k0 + kk]; scr[kk * 33 + (lane & 31)] = v; }
    LDS_WAIT(); asm volatile("" ::: "memory");
    const int c = lane & 7;
#pragma unroll
    for (int j = 0; j < 4; ++j) { const int n = (lane >> 3) + 8 * j; const LAS float* s = scr + (8 * c) * 33 + n;
        v4u o; o.x = pk2(s[0 * 33], s[1 * 33]); o.y = pk2(s[2 * 33], s[3 * 33]); o.z = pk2(s[4 * 33], s[5 * 33]); o.w = pk2(s[6 * 33], s[7 * 33]);
        const int rown = mode ? win_row(n0 + n) : (n0 + n);
        *(GAS v4u*)(WT + (size_t)rown * ldt + koff + k0 + 8 * c) = o; }
    LDS_WAIT(); asm volatile("" ::: "memory");
}
__device__ __forceinline__ void p0_gate_max_item(const float* W, int N, const float* gain, unsigned* gmax, int kb, int n0, int lane) {
    const int k0 = 64 * kb; float am = 0.f;
#pragma unroll 8
    for (int i = 0; i < 32; ++i) { const int kk = 2 * i + (lane >> 5); am = fmaxf(am, fabsf(W[(size_t)(k0 + kk) * N + n0 + (lane & 31)] * (gain ? gain[k0 + kk] : 1.0f))); }
    am = fmaxf(am, __shfl_xor(am, 32));
    if (lane < 32) atomicMax(gmax + (n0 - NB16) + lane, __float_as_uint(am));
}
__device__ __forceinline__ void p0_gate_fp8_item(const float* W, int N, const float* gain, const unsigned* gmax, unsigned char* WG, float* cs, LAS float* scr, int item, int lane, int ncols = N8, bool perm = true) {
    const int kb = item / (ncols / 32), nb = item % (ncols / 32), k0 = 64 * kb, n0 = 32 * nb;
#pragma unroll 8
    for (int i = 0; i < 32; ++i) { const int kk = 2 * i + (lane >> 5); scr[kk * 33 + (lane & 31)] = W[(size_t)(k0 + kk) * N + NB16 + n0 + (lane & 31)] * (gain ? gain[k0 + kk] : 1.0f); }
    LDS_WAIT(); asm volatile("" ::: "memory");
    const int c = lane & 7;
#pragma unroll
    for (int j = 0; j < 4; ++j) { const int n = (lane >> 3) + 8 * j; const LAS float* sp = scr + (8 * c) * 33 + n;
        const float am = __uint_as_float(xb_ld((unsigned*)gmax + n0 + n)); const float sc = am > 0.f ? 127.0f / am : 0.f;
        unsigned p0 = 0, p1 = 0;
#pragma unroll
        for (int e = 0; e < 4; ++e) { p0 |= ((unsigned)(int)__builtin_rintf(sp[e * 33] * sc) & 0xffu) << (8 * e); p1 |= ((unsigned)(int)__builtin_rintf(sp[(4 + e) * 33] * sc) & 0xffu) << (8 * e); }
        const int prow = perm ? win_row(NB16 + n0 + n) - NB16 : n0 + n;
        *(GAS v2u*)(WG + (size_t)prow * 1024 + k0 + 8 * c) = (v2u){p0, p1};
        if (kb == 0 && c == 0) cs[prow] = am * (1.0f / 127.0f); }
    LDS_WAIT(); asm volatile("" ::: "memory");
}
__device__ __forceinline__ void quant_row_fp8(const float* src, const float* gain, unsigned char* dst, size_t slice_stride, float* scale_out, int lane) {
    f32x4 v[4]; float am = 0.f;
#pragma unroll
    for (int j = 0; j < 4; ++j) { v[j] = *(const GAS f32x4*)(src + 256 * j + 4 * lane); if (gain) v[j] = v[j] * *(const GAS f32x4*)(gain + 256 * j + 4 * lane);
        am = fmaxf(am, fmaxf(fmaxf(fabsf(v[j][0]), fabsf(v[j][1])), fmaxf(fabsf(v[j][2]), fabsf(v[j][3])))); }
    am = wave_max(am);
    const int ex = (int)((__float_as_uint(am) >> 23) & 0xffu);
    const float s = (ex == 0) ? 1.0f : __uint_as_float((unsigned)(127 + 7 - (ex - 127)) << 23);
    const float is = (ex == 0) ? 1.0f : __uint_as_float((unsigned)(127 - 7 + (ex - 127)) << 23);
    if (lane == 0) *scale_out = is;
#pragma unroll
    for (int j = 0; j < 4; ++j) { int pk = __builtin_amdgcn_cvt_pk_fp8_f32(v[j][0] * s, v[j][1] * s, 0, false); pk = __builtin_amdgcn_cvt_pk_fp8_f32(v[j][2] * s, v[j][3] * s, pk, true);
        const int col = 256 * j + 4 * lane; *(GAS int*)(dst + (size_t)(col >> 7) * slice_stride + (col & 127)) = pk; }
}
__device__ __forceinline__ void quant_row_i4v(const float* src, unsigned char* dst, size_t slice_stride, float* scale_out, int lane) {
    f32x4 v[4]; float am = 0.f, ss = 0.f;
#pragma unroll
    for (int i = 0; i < 4; ++i) { const f32x4 t = *(const GAS f32x4*)(src + 16 * lane + 4 * i); v[i] = t;
        am = fmaxf(am, fmaxf(fmaxf(fabsf(t[0]), fabsf(t[1])), fmaxf(fabsf(t[2]), fabsf(t[3])))); ss += (t[0] * t[0] + t[1] * t[1]) + (t[2] * t[2] + t[3] * t[3]); }
    am = wave_max(am); ss = wave_sum(ss);
    const float clipv = fminf(am, 2.75f * sqrtf(ss * (1.0f / 1024.0f)));
    const float s = clipv > 0.f ? 7.0f / clipv : 0.f;
    if (lane == 0) *scale_out = clipv * (1.0f / (7.0f * 16.0f));
    unsigned pk[2];
#pragma unroll
    for (int d = 0; d < 2; ++d) { pk[d] = 0u;
#pragma unroll
        for (int n8 = 0; n8 < 8; ++n8) { int q0 = (int)__builtin_rintf(v[2 * d + (n8 >> 2)][n8 & 3] * s); q0 = q0 < -7 ? -7 : (q0 > 7 ? 7 : q0); pk[d] |= (unsigned)(q0 & 15) << (4 * n8); } }
    *(GAS v2u*)(dst + (size_t)(lane >> 4) * slice_stride + 8 * (lane & 15)) = (v2u){pk[0], pk[1]};
}
__device__ __forceinline__ void quant_row_fp4(const float* src, unsigned char* dst, size_t slice_stride, float* scale_out, int lane) {
    f32x4 v[4]; float am = 0.f;
#pragma unroll
    for (int j = 0; j < 4; ++j) { v[j] = *(const GAS f32x4*)(src + 256 * j + 4 * lane); am = fmaxf(am, fmaxf(fmaxf(fabsf(v[j][0]), fabsf(v[j][1])), fmaxf(fabsf(v[j][2]), fabsf(v[j][3])))); }
    am = wave_max(am);
    const float s = am > 0.f ? 6.0f / am : 0.f;
    if (lane == 0) *scale_out = am * (1.0f / 6.0f);
#pragma unroll
    for (int j = 0; j < 4; ++j) { unsigned pk = __builtin_amdgcn_cvt_scalef32_pk_fp4_f32(0u, v[j][0] * s, v[j][1] * s, 1.0f, 0); pk = __builtin_amdgcn_cvt_scalef32_pk_fp4_f32(pk, v[j][2] * s, v[j][3] * s, 1.0f, 1);
        *(GAS unsigned short*)(dst + (size_t)j * slice_stride + 2 * lane) = (unsigned short)(pk & 0xffffu); }
}
__device__ __forceinline__ void quant_row_i4(const float* src, const float* gain, unsigned char* dst, float* scale_out, int lane) {
    f32x4 v[4]; float am = 0.f, ss = 0.f;
    const int p16 = (lane >> 2) & 15, wl = lane & 3;
#pragma unroll
    for (int ld = 0; ld < 2; ++ld)
#pragma unroll
        for (int sn = 0; sn < 2; ++sn) { const int hd = 2 * (4 * ld + wl) + sn; const int idx = 256 * (hd >> 2) + 16 * p16 + 4 * (hd & 3);
            f32x4 t = *(const GAS f32x4*)(src + idx); if (gain) t = t * *(const GAS f32x4*)(gain + idx); v[2 * ld + sn] = t;
            am = fmaxf(am, fmaxf(fmaxf(fabsf(t[0]), fabsf(t[1])), fmaxf(fabsf(t[2]), fabsf(t[3])))); ss += (t[0] * t[0] + t[1] * t[1]) + (t[2] * t[2] + t[3] * t[3]); }
    am = wave_max(am); ss = wave_sum(ss);
    const float clipv = fminf(am, 2.5f * sqrtf(ss * (1.0f / 1024.0f)));
    const float s = clipv > 0.f ? 7.0f / clipv : 0.f;
    if (lane == 0) *scale_out = clipv * (1.0f / (7.0f * 16.0f));
#pragma unroll
    for (int ld = 0; ld < 2; ++ld) { unsigned pk = 0u;
#pragma unroll
        for (int b4 = 0; b4 < 4; ++b4) { int q0 = (int)__builtin_rintf(v[2 * ld][b4] * s), q1 = (int)__builtin_rintf(v[2 * ld + 1][b4] * s);
            q0 = q0 < -7 ? -7 : (q0 > 7 ? 7 : q0); q1 = q1 < -7 ? -7 : (q1 > 7 ? 7 : q1);
            pk |= ((unsigned)(q0 & 15) | ((unsigned)(q1 & 15) << 4)) << (8 * b4); }
        *(GAS unsigned*)(dst + ld * 256 + 16 * p16 + 4 * wl) = pk; }
}
__device__ __forceinline__ float gelu_f(float v) {
    const float av = fabsf(v), t = __builtin_amdgcn_rcpf(av * 0.2316418882f + 1.0f);
    float q = t * 0.5307027145f + (-0.7265760135f); q = q * t + 0.7107068705f; q = q * t + (-0.142248368f); q = q * t + 0.127414796f; q = q * t;
    const float e = __builtin_amdgcn_exp2f((v * v) * (-0.72134752044f));
    const float m = v * (q * e);
    return v < 0.f ? m : v - m;
}

struct Args { const float* in[14]; float* out; unsigned char* ws; int ph_lo, ph_hi, li, pad; };
__global__ void __launch_bounds__(NWAVES * 64, 2) fwd_kernel(Args args) {
    extern __shared__ __attribute__((aligned(16))) unsigned char lds[];
    Frame F;
    F.lds = (LAS unsigned char*)lds;
    F.MISC = (volatile LAS unsigned*)(F.lds + MISC_OFF);
    F.tid = threadIdx.x; F.lane = F.tid & 63; F.wave = __builtin_amdgcn_readfirstlane(F.tid >> 6);
    F.G = gridDim.x; { const int bx = blockIdx.x; F.vcu = (F.G % 8 == 0) ? (bx % 8) * (F.G / 8) + bx / 8 : bx; }
    unsigned char* ws = args.ws;
    F.ctl = (gu32*)(ws + WS_CTL);
    const float* x = args.in[0]; const float* norm1_gain = args.in[1]; const float* w_in = args.in[2]; const float* b_gate = args.in[3];
    const float* q_gain = args.in[4]; const float* k_gain = args.in[5]; const float* w_sb_out = args.in[6]; const float* w_dil_out = args.in[7];
    const float* w_out = args.in[8]; const float* norm2_gain = args.in[9]; const float* w_peer_q = args.in[10]; const float* sub_keys = args.in[11];
    const float* peer_u = args.in[12]; const float* peer_v = args.in[13];
    float* out = args.out;
    bf16* WIN = (bf16*)(ws + WS_WIN); bf16* WCAT = (bf16*)(ws + WS_WCAT); bf16* WOUT = (bf16*)(ws + WS_WOUT); bf16* WC = (bf16*)(ws + WS_WC);
    float* RINV1 = (float*)(ws + WS_RINV1); float* RINV2 = (float*)(ws + WS_RINV2); float* USC = (float*)(ws + WS_USC); float* VSC = (float*)(ws + WS_VSC); float* SSQ = (float*)(ws + WS_SSQ);
    unsigned char* U8 = ws + WS_U8; unsigned char* V8 = ws + WS_V8;
    unsigned short* IDS = (unsigned short*)(ws + WS_IDS); float* GW = (float*)(ws + WS_GW); unsigned short* COEF = (unsigned short*)(ws + WS_COEF); unsigned char* HQ = ws + WS_HQ; unsigned char* WC8 = ws + WS_WC; unsigned char* WOUT8 = ws + WS_WOUT; float* WOS = (float*)(ws + WS_WOS); float* RMAXF = (float*)(ws + WS_RMAXF); unsigned char* MIX8 = ws + WS_MIX; float* WCF = (float*)(ws + WS_WCF); float* WCS = (float*)(ws + WS_WCS); float* HS2 = (float*)(ws + WS_HS2);
    bf16* XB = (bf16*)(ws + WS_XB); bf16* OC = (bf16*)(ws + WS_OC); unsigned char* XB8 = ws + WS_XB8; unsigned char* WG8 = ws + WS_WG8; float* GCS = (float*)(ws + WS_GCS); float* XS = (float*)(ws + WS_XS);
    bf16* QS = (bf16*)(ws + WS_QS); bf16* KS = (bf16*)(ws + WS_KS); bf16* VS = (bf16*)(ws + WS_VS);
    bf16* QD = (bf16*)(ws + WS_QD); bf16* KD = (bf16*)(ws + WS_KD); bf16* VD = (bf16*)(ws + WS_VD);
    unsigned char* GT = ws + WS_GT; bf16* MIX = (bf16*)(ws + WS_MIX); bf16* X1B = (bf16*)(ws + WS_X1B);

    for (int u = F.tid; u < (LDS_BYTES - LDSCTL_OFF) / 4; u += NWAVES * 64) ((LAS unsigned*)(F.lds + LDSCTL_OFF))[u] = 0u;
    __syncthreads();
    const int my_xcc = (int)xb_xcc_id();
    if (F.tid == 0) F.MISC[12] = xb_add((unsigned*)(F.ctl + CW_XRANK) + 64 * my_xcc, 1u);
    __syncthreads();
    const int my_xrank = (int)F.MISC[12];
    const int bli = (N_LAUNCHES == PER_PHASE) ? 0 : args.li;
    XcdBarrier bar; bar.bar = (unsigned*)(F.ctl + CW_BAR) + bli * XCD_BAR_WORDS; bar.x = 0; bar.st = nullptr;
    if (N_LAUNCHES != PER_PHASE) bar = xcd_barrier_post((unsigned*)(F.ctl + CW_BAR) + bli * XCD_BAR_WORDS, F.MISC + 8);
    const int lo = args.ph_lo, hi = args.ph_hi;
#ifndef PHASE_MASK
#define PHASE_MASK 0xff
#endif
#define IN(k) (((PHASE_MASK >> (k)) & 1) && lo <= (k) && (k) < hi)
#define BOTH(k) (IN(k) && IN((k) + 1))
#define GRID_BAR() do { if (N_LAUNCHES != PER_PHASE) xcd_barrier(bar); } while (0)
#ifndef PROBE_REPEAT
#define PROBE_REPEAT 0x00
#endif
#ifndef PROBE_L1
#define PROBE_L1 0x0
#endif
#define REP(k) _Pragma("unroll") for (int rep_ = 0; rep_ < (((PROBE_REPEAT >> (k)) & 1) ? 2 : 1); ++rep_)
    const int gw = F.vcu * NWAVES + F.wave, NGW = F.G * NWAVES;
#define P67_MAP() int vx = (int)(blockIdx.x & 7), rk = (int)(blockIdx.x >> 3), nrk = (F.G + 7 - vx) / 8; bool p67_uni = false; \
        { bool uni_ = (F.G % 8 == 0); for (int j_ = 0; j_ < 16; ++j_) { const unsigned c_ = xb_ld((unsigned*)(F.ctl + CW_XRANK) + 64 * j_); uni_ = uni_ && (c_ == (j_ < 8 ? (unsigned)(F.G / 8) : 0u)); } \
          if (uni_) { vx = my_xcc; rk = my_xrank; nrk = F.G / 8; p67_uni = true; } }

    if (IN(0)) REP(0) {
        for (int it = F.vcu; it < 256; it += F.G) {
            const int hp = it >> 4, d0 = (it & 15) * 64;
            LAS float* As = (LAS float*)(F.lds);
            LAS float* Bs = (LAS float*)(F.lds + 64 * 132 * 4);
            for (int e = F.tid; e < 64 * 32; e += 512) { const int r = e >> 5, c4 = (e & 31) * 4; *(LAS f32x4*)(As + r * 132 + c4) = *(const GAS f32x4*)(w_peer_q + (size_t)(d0 + r) * 2048 + hp * 128 + c4); }
            for (int e = F.tid; e < 128 * 32; e += 512) { const int r = e >> 5, c4 = (e & 31) * 4; *(LAS f32x4*)(Bs + r * 132 + c4) = *(const GAS f32x4*)(sub_keys + ((size_t)hp * 128 + r) * 128 + c4); }
            __syncthreads();
            const int ddg = F.tid & 15, ng = F.tid >> 4;
            f32x4 acc[4];
#pragma unroll
            for (int j = 0; j < 4; ++j) acc[j] = (f32x4){0.f, 0.f, 0.f, 0.f};
            for (int c4 = 0; c4 < 128; c4 += 4) {
                f32x4 a[4], b[4];
#pragma unroll
                for (int i = 0; i < 4; ++i) { a[i] = *(const LAS f32x4*)(As + (4 * ddg + i) * 132 + c4); b[i] = *(const LAS f32x4*)(Bs + (4 * ng + i) * 132 + c4); }
#pragma unroll
                for (int j = 0; j < 4; ++j)
#pragma unroll
                    for (int i = 0; i < 4; ++i) acc[j][i] += (a[i][0] * b[j][0] + a[i][1] * b[j][1]) + (a[i][2] * b[j][2] + a[i][3] * b[j][3]);
            }
            const f32x4 g2 = *(const GAS f32x4*)(norm2_gain + d0 + 4 * ddg);
#pragma unroll
            for (int j = 0; j < 4; ++j) { const f32x4 o = acc[j] * g2;
                *(GAS f32x4*)(WCF + (size_t)(hp * 128 + 4 * ng + j) * 1024 + d0 + 4 * ddg) = o;
                float am = fmaxf(fmaxf(fabsf(o[0]), fabsf(o[1])), fmaxf(fabsf(o[2]), fabsf(o[3])));
                am = fmaxf(am, __shfl_xor(am, 1)); am = fmaxf(am, __shfl_xor(am, 2)); am = fmaxf(am, __shfl_xor(am, 4)); am = fmaxf(am, __shfl_xor(am, 8));
                if (ddg == 0) atomicMax((unsigned*)(F.ctl + CW_WMAX) + hp * 128 + 4 * ng + j, __float_as_uint(am)); }
            __syncthreads();
        }
        {
            LAS float* scr = (LAS float*)(F.lds + RING_OFF + F.wave * 16384);
            constexpr int I_IN = (D / 64) * (N1 / 32), I_SB = (512 / 64) * (D / 32), I_DL = (256 / 64) * (D / 32), I_OUT = (D / 64) * (D / 32);
            constexpr int NITEMS = I_IN + I_SB + I_DL + I_OUT;
            for (int it = gw; it < NITEMS; it += NGW) {
                int r = it;
                if (r < I_IN) { const int nb_ = r % (N1 / 32); p0_gate_max_item(w_in, N1, norm1_gain, (unsigned*)(F.ctl + CW_GMAX), r / (N1 / 32), 32 * nb_, F.lane); continue; } r -= I_IN;
                if (r < I_SB) { p0_transpose_item(w_sb_out, D, nullptr, WCAT, 768, 0, 0, scr, r, F.lane); continue; } r -= I_SB;
                if (r < I_DL) { p0_transpose_item(w_dil_out, D, nullptr, WCAT, 768, 512, 0, scr, r, F.lane); continue; } r -= I_DL;
                p0_gate_max_item(w_out, D, nullptr, (unsigned*)(F.ctl + CW_OMAX), r / (D / 32), 32 * (r % (D / 32)), F.lane);
            }
        }
        for (int e = gw; e < 2 * NEXP; e += NGW) {
            if (e < NEXP) quant_row_i4(peer_u + (size_t)e * D, norm2_gain, U8 + (size_t)e * 512, USC + e, F.lane);
            else { const int ev = e - NEXP; quant_row_i4v(peer_v + (size_t)ev * D, V8 + (size_t)ev * 128, (size_t)NEXP * 128, VSC + ev, F.lane); }
        }
        for (int m = gw; m < T; m += NGW) {
            const GAS f32x4* xr = (const GAS f32x4*)(x + (size_t)m * D) + F.lane;
            f32x4 v[4]; float s = 0.f;
#pragma unroll
            for (int j = 0; j < 4; ++j) { v[j] = xr[64 * j]; s += (v[j][0] * v[j][0] + v[j][1] * v[j][1]) + (v[j][2] * v[j][2] + v[j][3] * v[j][3]); }
            s = wave_sum(s);
            const float rn = __builtin_amdgcn_rsqf(s * (1.0f / D) + 1e-6f);
            if (F.lane == 0) RINV1[m] = 1.0f / rn;
            GAS unsigned long long* o8 = (GAS unsigned long long*)(XB + (size_t)m * D) + F.lane;
#pragma unroll
            for (int j = 0; j < 4; ++j) o8[64 * j] = (unsigned long long)pk2(v[j][0] * rn, v[j][1] * rn) | ((unsigned long long)pk2(v[j][2] * rn, v[j][3] * rn) << 32);
            float am = 0.f;
#pragma unroll
            for (int j = 0; j < 4; ++j) am = fmaxf(am, fmaxf(fmaxf(fabsf(v[j][0]), fabsf(v[j][1])), fmaxf(fabsf(v[j][2]), fabsf(v[j][3]))));
            am = wave_max(am) * rn;
            const float qs = am > 0.f ? 127.0f / am * rn : 0.f;
            if (F.lane == 0) XS[m] = am * (1.0f / 127.0f);
#pragma unroll
            for (int j = 0; j < 4; ++j) { const unsigned pk = ((unsigned)(int)__builtin_rintf(v[j][0] * qs) & 0xffu) | (((unsigned)(int)__builtin_rintf(v[j][1] * qs) & 0xffu) << 8) | (((unsigned)(int)__builtin_rintf(v[j][2] * qs) & 0xffu) << 16) | (((unsigned)(int)__builtin_rintf(v[j][3] * qs) & 0xffu) << 24);
                *(GAS unsigned*)(XB8 + (size_t)m * D + 256 * j + 4 * F.lane) = pk; }
        }
        if (BOTH(0)) GRID_BAR();
    }

    if (IN(1)) REP(1) {
        { LAS float* scr = (LAS float*)(F.lds + RING_OFF + F.wave * 16384);
          for (int it = gw; it < 16 * (N8 / 32); it += NGW) p0_gate_fp8_item(w_in, N1, norm1_gain, (const unsigned*)(F.ctl + CW_GMAX), WG8, GCS, scr, it, F.lane);
          for (int it = gw; it < 16 * (D / 32); it += NGW) p0_gate_fp8_item(w_out, D, nullptr, (const unsigned*)(F.ctl + CW_OMAX), WOUT8, WOS, scr, it, F.lane, D, false);
          for (int r = gw; r < 2048; r += NGW) {
              const float am = __uint_as_float(xb_ld((unsigned*)(F.ctl + CW_WMAX) + r)); const float sc = am > 0.f ? 127.0f / am : 0.f;
              unsigned w[4];
#pragma unroll
              for (int j = 0; j < 4; ++j) { const f32x4 v = *(const GAS f32x4*)(WCF + (size_t)r * 1024 + 16 * F.lane + 4 * j);
                  w[j] = ((unsigned)(int)__builtin_rintf(v[0] * sc) & 0xffu) | (((unsigned)(int)__builtin_rintf(v[1] * sc) & 0xffu) << 8) | (((unsigned)(int)__builtin_rintf(v[2] * sc) & 0xffu) << 16) | (((unsigned)(int)__builtin_rintf(v[3] * sc) & 0xffu) << 24); }
              *(GAS v4u*)(WC8 + (size_t)r * 1024 + 16 * F.lane) = (v4u){w[0], w[1], w[2], w[3]};
              if (F.lane == 0) WCS[r] = am * (1.0f / 127.0f); }
          __syncthreads(); }
        GRID_BAR();
        { pg8::Gemm g{(const bf16*)XB8, (const bf16*)WG8, T, N8, D / 2}; pg8::StaticOrder S; S.init(T, N8, F.G, (int)blockIdx.x);
          pg8::EpiG E{b_gate, GCS, XS, q_gain, k_gain, QS, KS, VS, QD, KD, VD, GT};
          pg8::gemm_phase<pg8::EpiG, pg8::StaticOrder, true, true, false, true>(F.lds + RING_OFF, g, S, E); }
        if (BOTH(1)) GRID_BAR();
    }

    if (IN(2)) REP(2) {
        LAS unsigned char* wl = F.lds + RING_OFF + F.wave * 16384;
        static_assert(att::DLU_BYTES <= RING_BYTES, "dilated-attention LDS state");
        for (int un = F.vcu; un < 512; un += F.G) { const int blk = un & 7, j = (un >> 3) & 3, b = un >> 5; att::dl_unit(QD, KD, VD, OC, b, j, blk, F.lds + RING_OFF, F.wave, F.lane); }
        for (int it = gw; it < 16384; it += NGW) { const int qt = 127 - (it & 127), h = (it >> 7) & 7, b = it >> 10; att::sb_item(QS, KS, VS, OC, b, h, qt, wl, F.lane); }
        if (BOTH(2)) GRID_BAR();
    }

    if (IN(3)) REP(3) {
        pg8::Gemm g{OC, WCAT, T, D, 768}; pg8::StaticOrder S; S.init(T, D, F.G, (int)blockIdx.x);
        pg8::Epi2 E{GT, MIX8, (unsigned*)(ws + WS_PART), (unsigned*)(F.ctl + CW_RCNT), RMAXF, F.lds + RING_OFF + RING_BYTES};
        pg8::gemm_phase<pg8::Epi2, pg8::StaticOrder, true, true>(F.lds + RING_OFF, g, S, E);
        if (BOTH(3)) GRID_BAR();
    }

    if (IN(4)) REP(4) {
        pg8::Gemm g{(const bf16*)MIX8, (const bf16*)WOUT8, T, D, D / 2}; pg8::StaticOrder S; S.init(T, D, F.G, (int)blockIdx.x);
        pg8::Epi3 E{XB, RINV1, (const unsigned*)RMAXF, WOS, X1B, SSQ};
        pg8::gemm_phase<pg8::Epi3, pg8::StaticOrder, true, true, false, true>(F.lds + RING_OFF, g, S, E);
        if (BOTH(4)) GRID_BAR();
    }

    if (IN(5)) REP(5) {
        for (int m = gw; m < T; m += NGW) {
            const v4u a = *(const GAS v4u*)(X1B + (size_t)m * D + 8 * F.lane), b = *(const GAS v4u*)(X1B + (size_t)m * D + 512 + 8 * F.lane);
            float v[16] = {pg8::bflo(a.x), pg8::bfhi(a.x), pg8::bflo(a.y), pg8::bfhi(a.y), pg8::bflo(a.z), pg8::bfhi(a.z), pg8::bflo(a.w), pg8::bfhi(a.w),
                           pg8::bflo(b.x), pg8::bfhi(b.x), pg8::bflo(b.y), pg8::bfhi(b.y), pg8::bflo(b.z), pg8::bfhi(b.z), pg8::bflo(b.w), pg8::bfhi(b.w)};
            float am = 0.f;
#pragma unroll
            for (int i = 0; i < 16; ++i) am = fmaxf(am, fabsf(v[i]));
            am = wave_max(am);
            float sq = (F.lane < 16) ? SSQ[(size_t)m * 16 + F.lane] : 0.f; sq = wave_sum(sq);
            const float s = am > 0.f ? 127.0f / am : 0.f;
            if (F.lane == 0) HS2[m] = am * (1.0f / 127.0f) * __builtin_amdgcn_rsqf(sq * (1.0f / 1024.0f) + 1e-6f);
            int q[16];
#pragma unroll
            for (int i = 0; i < 16; ++i) q[i] = (int)__builtin_rintf(v[i] * s) & 0xff;
            v2u o0, o1; o0.x = q[0] | (q[1] << 8) | (q[2] << 16) | (q[3] << 24); o0.y = q[4] | (q[5] << 8) | (q[6] << 16) | (q[7] << 24);
            o1.x = q[8] | (q[9] << 8) | (q[10] << 16) | (q[11] << 24); o1.y = q[12] | (q[13] << 8) | (q[14] << 16) | (q[15] << 24);
            *(GAS v2u*)(HQ + (size_t)m * D + 8 * F.lane) = o0; *(GAS v2u*)(HQ + (size_t)m * D + 512 + 8 * F.lane) = o1;
        }
        GRID_BAR();
        pg8::Gemm g{(const bf16*)HQ, (const bf16*)WC8, T, 2048, D / 2}; pg8::StaticOrder S; S.init(T, 2048, F.G, (int)blockIdx.x);
        pg8::Epi4 E{SSQ, RINV2, IDS, GW, HS2, WCS};
        pg8::OneUnit O1;
        for (int i = 0; S.next(i, O1.u); ++i) pg8::gemm_phase<pg8::Epi4, pg8::OneUnit, false, true, false, true>(F.lds + RING_OFF, g, O1, E);
        if (BOTH(5)) GRID_BAR();
    }

    if (IN(6)) REP(6) {
        P67_MAP();
        const int p16 = F.lane & 15, sg = F.lane >> 4;
        LAS unsigned char* HB = F.lds + RING_OFF + F.wave * 16384;
        LAS unsigned* LIST = (LAS unsigned*)(F.lds + RING_OFF + F.wave * 16384 + 8192);
        LAS float* HSs = (LAS float*)(F.lds + RING_OFF + F.wave * 16384 + 12288);
        const int nwb = T / 8, wstep = nrk * NWAVES;
        const int gsel = (F.lane & 15), bpsrc = (16 * (F.lane & 3) + ((F.lane >> 2) & 3)) * 4;
        v4u hpre[8], idpre[2]; float hspre = 0.f;
#define P6_PRE(bb) do { const int bc_ = (bb) < nwb ? (bb) : nwb - 1; const unsigned char* hsrc_ = HQ + (size_t)bc_ * 8192; \
            _Pragma("unroll") for (int i_ = 0; i_ < 8; ++i_) hpre[i_] = *(const GAS v4u*)(hsrc_ + (size_t)(i_ * 64 + F.lane) * 16); \
            const unsigned short* isrc_ = IDS + ((size_t)bc_ * 8 + (F.lane >> 3)) * 128 + 16 * (F.lane & 7); idpre[0] = *(const GAS v4u*)isrc_; idpre[1] = *(const GAS v4u*)(isrc_ + 8); \
            hspre = HS2[(size_t)bc_ * 8 + (F.lane & 7)]; } while (0)
#define P6_ISSUE(W, ENT, EJ, GB, UB, VB, base_) do { \
                _Pragma("unroll") for (int g_ = 0; g_ < 4; ++g_) { const int j_ = (base_) + 4 * g_ + sg; ENT[g_] = LIST[j_ < n ? j_ : nm1]; } \
                { const int j_ = (base_) + gsel; EJ = (j_ < n && F.lane < 16) ? (int)LIST[j_] : -1; } \
                _Pragma("unroll") for (int g_ = 0; g_ < 4; ++g_) { const unsigned char* up_ = U8 + (size_t)((PROBE_L1 && rep_) ? 0u : (ENT[g_] & 0xffffu)) * 512 + 16 * p16; \
                    _Pragma("unroll") for (int i_ = 0; i_ < 2; ++i_) W[g_][i_] = *(const GAS v4u*)(up_ + 256 * i_); } \
                { const unsigned ej_ = EJ < 0 ? 0u : (unsigned)EJ; GB = GW[((size_t)t0 + (ej_ >> 24)) * 128 + ((ej_ >> 16) & 127u)]; UB = USC[ej_ & 0xffffu]; VB = VSC[ej_ & 0xffffu]; } } while (0)
#define P6_DPPADD(a_, ctrl) a_ += __builtin_amdgcn_update_dpp(0, a_, ctrl, 0xf, 0xf, false)
#define P6_REDUCE(W, ENT, EJ, GB, UB, VB, base_) do { if ((base_) < n) { int ag_[4]; \
                _Pragma("unroll") for (int g_ = 0; g_ < 4; ++g_) { const LAS unsigned char* hp_ = HB + (size_t)(ENT[g_] >> 24) * 1024 + 16 * p16; int a_ = 0; v4u h_[4]; \
                    _Pragma("unroll") for (int i_ = 0; i_ < 4; ++i_) h_[i_] = *(const LAS v4u*)(hp_ + 256 * i_); \
                    _Pragma("unroll") for (int ld_ = 0; ld_ < 2; ++ld_) { const unsigned x_[4] = {W[g_][ld_].x, W[g_][ld_].y, W[g_][ld_].z, W[g_][ld_].w}; \
                        _Pragma("unroll") for (int wl_ = 0; wl_ < 4; ++wl_) { const int hd_ = 2 * (4 * ld_ + wl_); const unsigned lo_ = (x_[wl_] << 4) & 0xF0F0F0F0u, hi_ = x_[wl_] & 0xF0F0F0F0u; \
                            const unsigned hA_ = (hd_ & 3) == 0 ? h_[hd_ >> 2].x : h_[hd_ >> 2].z, hB_ = (hd_ & 3) == 0 ? h_[hd_ >> 2].y : h_[hd_ >> 2].w; \
                            a_ = __builtin_amdgcn_sdot4((int)lo_, (int)hA_, a_, false); a_ = __builtin_amdgcn_sdot4((int)hi_, (int)hB_, a_, false); } } \
                    P6_DPPADD(a_, 0xB1); P6_DPPADD(a_, 0x4E); P6_DPPADD(a_, 0x141); P6_DPPADD(a_, 0x140); ag_[g_] = a_; } \
                const int sel_ = gsel == 0 ? ag_[0] : gsel == 1 ? ag_[1] : gsel == 2 ? ag_[2] : ag_[3]; \
                const float resv_ = (float)__builtin_amdgcn_ds_bpermute(bpsrc, sel_); \
                if (EJ >= 0 && !(PROBE_L1 && rep_)) { const unsigned ej_ = (unsigned)EJ; const float act_ = gelu_f(resv_ * UB * HSs[ej_ >> 24]); \
                    COEF[((size_t)t0 + (ej_ >> 24)) * 128 + ((ej_ >> 16) & 127u)] = (unsigned short)(pg8::pkbf(GB * act_ * VB, 0.f) & 0xffffu); } } } while (0)
        int wb = rk * NWAVES + F.wave;
        P6_PRE(wb);
        for (; wb < nwb; wb += wstep) {
            const int t0 = wb * 8;
            asm volatile("s_waitcnt lgkmcnt(0)" ::: "memory");
            if (F.lane < 8) HSs[F.lane] = hspre;
#pragma unroll
            for (int i = 0; i < 8; ++i) *(LAS v4u*)(HB + (size_t)(i * 64 + F.lane) * 16) = hpre[i];
            int n = 0;
            { const unsigned idw[8] = {idpre[0].x, idpre[0].y, idpre[0].z, idpre[0].w, idpre[1].x, idpre[1].y, idpre[1].z, idpre[1].w};
              const unsigned tl = (unsigned)(F.lane >> 3), kb0 = 16u * (unsigned)(F.lane & 7);
#pragma unroll
              for (int i = 0; i < 16; ++i) { const unsigned e = (i & 1) ? (idw[i >> 1] >> 16) : (idw[i >> 1] & 0xffffu);
                  const bool inr = ((int)(e >> 11) == vx); const unsigned long long mk = __ballot(inr);
                  const int pos = n + (int)__builtin_amdgcn_mbcnt_hi((unsigned)(mk >> 32), __builtin_amdgcn_mbcnt_lo((unsigned)mk, 0u));
                  if (inr) LIST[pos] = (tl << 24) | ((kb0 + (unsigned)i) << 16) | e;
                  n += __builtin_popcountll(mk); } }
            asm volatile("s_waitcnt lgkmcnt(0)" ::: "memory");
            P6_PRE(wb + wstep);
            const int nm1 = n > 0 ? n - 1 : 0;
            for (int base = 0; base < n; base += 32) {
                v4u wA[4][2], wB[4][2]; unsigned entA[4], entB[4]; int ejA, ejB; float gbA, ubA, vbA, gbB, ubB, vbB;
                P6_ISSUE(wA, entA, ejA, gbA, ubA, vbA, base);
                P6_ISSUE(wB, entB, ejB, gbB, ubB, vbB, base + 16);
                P6_REDUCE(wA, entA, ejA, gbA, ubA, vbA, base);
                P6_REDUCE(wB, entB, ejB, gbB, ubB, vbB, base + 16);
            }
        }
#undef P6_PRE
#undef P6_ISSUE
#undef P6_REDUCE
#undef P6_DPPADD
        if (BOTH(6)) GRID_BAR();
    }

    if (IN(7)) REP(7) {
        P67_MAP();
        const int cs = vx >> 1;
        const int n0_ = p67_uni ? F.G / 8 : (F.G + 7 - 2 * cs) / 8, n1_ = p67_uni ? F.G / 8 : (F.G + 7 - (2 * cs + 1)) / 8;
        const int rk2 = (vx & 1) ? n0_ + rk : rk, nrk2 = n0_ + n1_;
        const int l8 = F.lane & 7, kg = F.lane >> 3, i16 = F.lane & 15, kq = F.lane >> 4;
        const unsigned char* vbase = V8 + (size_t)cs * NEXP * 128 + 16 * l8;
        const int tstep = nrk2 * NWAVES;
        const int col = 256 * cs + 4 * F.lane;
        LAS unsigned char* tile = F.lds + RING_OFF + F.wave * 16384;
        typedef int v2i_ __attribute__((ext_vector_type(2)));
        const int wrb = kg * 2048 + 16 * l8, rdb = (16 * kq + i16) * 128 + 16 * (i16 & 7) + 8 * (i16 >> 3);
        LAS float* obuf = (LAS float*)(F.lds + RING_OFF + RING_BYTES + F.wave * 1024);
#define P7_CL(tt) ((tt) < T ? (tt) : T - 1)
#define P7_IDS(tt, ID) do { const int tc_ = P7_CL(tt); ID[0] = *(const GAS v4u*)(IDS + (size_t)tc_ * 128 + 16 * kg); ID[1] = *(const GAS v4u*)(IDS + (size_t)tc_ * 128 + 16 * kg + 8); } while (0)
#define P7_ISSUE(tt, ID, W, CF, OO) do { const int tc_ = P7_CL(tt); const unsigned idw_[8] = {ID[0].x, ID[0].y, ID[0].z, ID[0].w, ID[1].x, ID[1].y, ID[1].z, ID[1].w}; \
            _Pragma("unroll") for (int i_ = 0; i_ < 16; ++i_) { const unsigned e_ = (i_ & 1) ? (idw_[i_ >> 1] >> 16) : (idw_[i_ >> 1] & 0xffffu); W[i_] = *(const GAS v4u*)(vbase + (size_t)((PROBE_L1 && rep_) ? 0u : e_) * 128); } \
            CF[0] = *(const GAS v4u*)(COEF + (size_t)tc_ * 128 + 16 * kg); CF[1] = *(const GAS v4u*)(COEF + (size_t)tc_ * 128 + 16 * kg + 8); \
            OO = *(const GAS v2u*)(X1B + (size_t)tc_ * D + col); } while (0)
#define P7_COMPUTE(tt, W, CF, OO, NX) do { \
              \
            const unsigned cw_[8] = {CF[0].x, CF[0].y, CF[0].z, CF[0].w, CF[1].x, CF[1].y, CF[1].z, CF[1].w};      \
            float am_ = 0.f; _Pragma("unroll") for (int j_ = 0; j_ < 8; ++j_) am_ = fmaxf(am_, fmaxf(fabsf(pg8::bflo(cw_[j_])), fabsf(pg8::bfhi(cw_[j_])))); \
            am_ = fmaxf(am_, __shfl_xor(am_, 8)); am_ = fmaxf(am_, __shfl_xor(am_, 16)); am_ = fmaxf(am_, __shfl_xor(am_, 32)); \
            const float cq_ = am_ > 0.f ? 127.0f / am_ : 0.f, cstep_ = am_ * (1.0f / 127.0f); \
              \
            int cpk_[4]; _Pragma("unroll") for (int d_ = 0; d_ < 4; ++d_) { const int j0_ = 4 * (d_ >> 1); \
                const float f0_ = (d_ & 1) ? pg8::bfhi(cw_[j0_]) : pg8::bflo(cw_[j0_]), f1_ = (d_ & 1) ? pg8::bfhi(cw_[j0_ + 1]) : pg8::bflo(cw_[j0_ + 1]), f2_ = (d_ & 1) ? pg8::bfhi(cw_[j0_ + 2]) : pg8::bflo(cw_[j0_ + 2]), f3_ = (d_ & 1) ? pg8::bfhi(cw_[j0_ + 3]) : pg8::bflo(cw_[j0_ + 3]); \
                cpk_[d_] = (int)(((unsigned)(int)__builtin_rintf(f0_ * cq_) & 0xffu) | (((unsigned)(int)__builtin_rintf(f1_ * cq_) & 0xffu) << 8) | (((unsigned)(int)__builtin_rintf(f2_ * cq_) & 0xffu) << 16) | (((unsigned)(int)__builtin_rintf(f3_ * cq_) & 0xffu) << 24)); } \
              \
            v4i a0_, a1_; { const int sa0_ = (8 * kq) * 4, sa1_ = (32 + 8 * kq) * 4; const bool m0_ = (i16 == 0); \
                _Pragma("unroll") for (int d_ = 0; d_ < 4; ++d_) { const int x0_ = __builtin_amdgcn_ds_bpermute(sa0_, cpk_[d_]), x1_ = __builtin_amdgcn_ds_bpermute(sa1_, cpk_[d_]); a0_[d_] = m0_ ? x0_ : 0; a1_[d_] = m0_ ? x1_ : 0; } } \
            _Pragma("unroll") for (int i_ = 0; i_ < 16; ++i_) { const v4u x_ = W[i_]; *(LAS v4u*)(tile + (wrb ^ (16 * (i_ & 7))) + 128 * i_) = (i_ & 8) ? (v4u){x_.z, x_.w, x_.x, x_.y} : x_; } \
            const v2u oc_ = OO; \
            asm volatile("" ::: "memory"); \
            NX;                                                                      \
            asm volatile("" ::: "memory"); \
            _Pragma("unroll") for (int g_ = 0; g_ < 4; ++g_) { \
                v4i dd_[4]; _Pragma("unroll") for (int j_ = 0; j_ < 4; ++j_) dd_[j_] = (v4i){0, 0, 0, 0}; \
                _Pragma("unroll") for (int s_ = 0; s_ < 2; ++s_) _Pragma("unroll") for (int j_ = 0; j_ < 4; ++j_) { const int nb_ = 4 * g_ + j_; \
                    const v2i_ r_ = __builtin_amdgcn_ds_read_tr4_b64_v2i32((LAS v2i_*)(tile + ((rdb ^ (16 * (nb_ >> 1))) ^ (8 * (nb_ & 1))) + 8192 * s_)); \
                    const v4i b_ = {(int)(((unsigned)r_.x << 4) & 0xF0F0F0F0u), (int)((unsigned)r_.x & 0xF0F0F0F0u), (int)(((unsigned)r_.y << 4) & 0xF0F0F0F0u), (int)((unsigned)r_.y & 0xF0F0F0F0u)}; \
                    dd_[j_] = __builtin_amdgcn_mfma_i32_16x16x64_i8(s_ == 0 ? a0_ : a1_, b_, dd_[j_], 0, 0, 0); } \
                __builtin_amdgcn_sched_barrier(0); \
                  \
                if (F.lane < 16) { _Pragma("unroll") for (int j_ = 0; j_ < 4; ++j_) obuf[16 * (4 * g_ + j_) + F.lane] = (float)dd_[j_][0] * cstep_; } \
                asm volatile("" ::: "memory"); } \
            const f32x4 r4_ = *(const LAS f32x4*)(obuf + 4 * F.lane); \
            asm volatile("" ::: "memory"); \
            if ((tt) < T) *(GAS f32x4*)((rep_ == 0 ? out : (float*)(ws + WS_GT)) + (size_t)(tt) * D + col) = (f32x4){pg8::bflo(oc_.x) + r4_[0], pg8::bfhi(oc_.x) + r4_[1], pg8::bflo(oc_.y) + r4_[2], pg8::bfhi(oc_.y) + r4_[3]}; } while (0)
        v4u idA[2], idB[2], wA[16], wB[16], cfA[2], cfB[2]; v2u ooA, ooB;
        int t = rk2 * NWAVES + F.wave;
        P7_IDS(t, idA); P7_IDS(t + tstep, idB);
        P7_ISSUE(t, idA, wA, cfA, ooA); P7_ISSUE(t + tstep, idB, wB, cfB, ooB);
        P7_IDS(t + 2 * tstep, idA); P7_IDS(t + 3 * tstep, idB);
        while (t < T) {
            P7_COMPUTE(t, wA, cfA, ooA, { P7_ISSUE(t + 2 * tstep, idA, wA, cfA, ooA); P7_IDS(t + 4 * tstep, idA); });
            P7_COMPUTE(t + tstep, wB, cfB, ooB, { P7_ISSUE(t + 3 * tstep, idB, wB, cfB, ooB); P7_IDS(t + 5 * tstep, idB); });
            t += 2 * tstep;
        }
#undef P7_CL
#undef P7_IDS
#undef P7_ISSUE
#undef P7_COMPUTE
    }
#undef IN
#undef BOTH
#undef GRID_BAR
}

extern "C" void kernel_launch(void* const* d_in, const int* in_sizes, int n_in, void* d_out, int out_size, void* d_ws, size_t ws_size, hipStream_t stream) {
    static int grid = 0;
    if (grid == 0) {
        if (n_in != 14 || in_sizes[0] != T * D || out_size != T * D || ws_size < WS_END) { fprintf(stderr, "kernel_launch: built for 14 inputs, x and out of %d floats, >= %zu bytes of workspace; got n_in %d, in0 %d, out %d, ws %zu; nothing launched\n", T * D, (size_t)WS_END, n_in, n_in > 0 ? in_sizes[0] : -1, out_size, ws_size); grid = -1; return; }
        int dev = 0, cus = 0, per_cu = 0;
        if (hipGetDevice(&dev) != hipSuccess || hipDeviceGetAttribute(&cus, hipDeviceAttributeMultiprocessorCount, dev) != hipSuccess) { fprintf(stderr, "kernel_launch: hipGetDevice / hipDeviceGetAttribute failed\n"); grid = -1; return; }
        if (hipFuncSetAttribute((const void*)fwd_kernel, hipFuncAttributeMaxDynamicSharedMemorySize, LDS_BYTES) != hipSuccess) { fprintf(stderr, "kernel_launch: hipFuncSetAttribute failed\n"); grid = -1; return; }
        if (hipOccupancyMaxActiveBlocksPerMultiprocessor(&per_cu, (const void*)fwd_kernel, NWAVES * 64, LDS_BYTES) != hipSuccess || per_cu < 1)
            fprintf(stderr, "kernel_launch: note: occupancy query reports %d workgroups per CU\n", per_cu);
        (void)hipGetLastError();
        grid = cus;
        if (cus != 256) fprintf(stderr, "kernel_launch: built for 256 CUs (MI355X); %d found -- the P3 row-max exchange assumes a 256-workgroup grid\n", cus);
    }
    if (grid < 0) return;
    if (hipMemsetAsync((char*)d_ws + WS_CTL, 0, CTL_ZERO_BYTES, stream) != hipSuccess) { fprintf(stderr, "kernel_launch: hipMemsetAsync failed\n"); return; }
    Args a{};
    for (int i = 0; i < 14; ++i) a.in[i] = (const float*)d_in[i];
    a.out = (float*)d_out; a.ws = (unsigned char*)d_ws;
    for (int li = 0; li < N_LAUNCHES; ++li) {
        a.ph_lo = (N_LAUNCHES == PER_PHASE) ? li : 0; a.ph_hi = (N_LAUNCHES == PER_PHASE) ? li + 1 : MK_LAST_PHASE; a.li = li;
        if (a.ph_lo >= MK_LAST_PHASE) break;
        hipLaunchKernelGGL(fwd_kernel, dim3(grid), dim3(NWAVES * 64), LDS_BYTES, stream, a);
        const hipError_t le = hipPeekAtLastError();
        if (le != hipSuccess) { fprintf(stderr, "kernel_launch: launch %d failed: %s\n", li, hipGetErrorName(le)); break; }
    }
}
```

```cpp
#include <hip/hip_runtime.h>
#include <cstdio>
#include <cstdint>
namespace pg8 {
#define PG8_LAS __attribute__((address_space(3)))
typedef unsigned short bf16_t;
typedef short bf16x8 __attribute__((ext_vector_type(8)));
typedef float f32x4 __attribute__((ext_vector_type(4)));
typedef unsigned u32x4 __attribute__((ext_vector_type(4)));
typedef int i32x8 __attribute__((ext_vector_type(8)));
typedef int i32x4 __attribute__((ext_vector_type(4)));
constexpr int BM = 256, BK = 64, HALF = 128, HTB = HALF * BK * 2  , STAGE_BYTES = 8 * HTB, NXCD = 8, WGM = 8;

__host__ __device__ __forceinline__ int lds_byte(int r, int c) { const int st = (r >> 4) * 2 + (c >> 5), rr = r & 15, cc = c & 31, ob = rr * 64 + cc * 2; return st * 1024 + (ob ^ (((ob >> 9) & 1) << 5)); }
__host__ __device__ __forceinline__ void stage_rc(int b, int& R, int& C) { const int st = b / 1024, sb = b % 1024, swz = sb ^ (((sb >> 9) & 1) << 5); R = (st >> 1) * 16 + swz / 64; C = (st & 1) * 32 + (swz % 64) / 2; }
__host__ __device__ __forceinline__ int perm32(int rho) { const int n = rho >> 4, i = rho & 15; return 8 * (i >> 2) + 4 * n + (i & 3); }

struct Unit { int pm, pn; };
struct Gemm { const bf16_t* A; const bf16_t* Bt; int M, N, K; };

struct StaticOrder {
    int nM, nN, nwg, G, c;
    __host__ __device__ void init(int M, int N, int G_, int c_) { nM = M / BM; nN = N / BM; nwg = nM * nN; G = G_; c = c_; }
    __host__ __device__ bool next(int i, Unit& u) const {
        const long L = (long)i * G + c; if (L >= nwg) return false;
        int wgid = (int)L; { const int q = nwg / NXCD, r = nwg % NXCD, xcd = wgid % NXCD, off = wgid / NXCD; wgid = (xcd < r ? xcd * (q + 1) : r * (q + 1) + (xcd - r) * q) + off; }
        const int nig = WGM * nN, gid = wgid / nig, fm = gid * WGM, gsz = (nM - fm) < WGM ? (nM - fm) : WGM;
        u.pm = fm + ((wgid % nig) % gsz); u.pn = (wgid % nig) / gsz; return true;
    }
    __device__ __forceinline__ void a_ready(const Unit&) const {}
    __device__ __forceinline__ void done(const Unit&) const {}
};


struct OneUnit {
    Unit u;
    __device__ __forceinline__ bool next(int i, Unit& o) const { if (i != 0) return false; o = u; return true; }
    __device__ __forceinline__ void a_ready(const Unit&) const {}
    __device__ __forceinline__ void done(const Unit&) const {}
};

typedef float f32x2 __attribute__((ext_vector_type(2)));
typedef __bf16 bf16x2_t __attribute__((ext_vector_type(2)));
typedef unsigned u32x2 __attribute__((ext_vector_type(2)));
__device__ __forceinline__ unsigned pkbf(float lo, float hi) { f32x2 v = {lo, hi}; bf16x2_t b = __builtin_convertvector(v, bf16x2_t); return __builtin_bit_cast(unsigned, b); }
__device__ __forceinline__ float bflo(unsigned w) { return __uint_as_float(w << 16); }
__device__ __forceinline__ float bfhi(unsigned w) { return __uint_as_float(w & 0xffff0000u); }
__device__ __forceinline__ u32x4 pack8(const f32x4 a, const f32x4 b) { u32x4 w; w.x = pkbf(a[0], a[1]); w.y = pkbf(a[2], a[3]); w.z = pkbf(b[0], b[1]); w.w = pkbf(b[2], b[3]); return w; }
constexpr float QSCALE = 0.125f * 1.4426950408889634f;
__device__ __forceinline__ float sigmoidf_(float v) { return __builtin_amdgcn_rcpf(1.0f + __builtin_amdgcn_exp2f(-1.4426950408889634f * v)); }

struct EpiG {
    static constexpr bool PERM = true, AFTER_DRAIN = false, HAS_MID = false; static constexpr int MID_T = -1;
    const float* bgate; const float* cs; const float* xs; const float* qg; const float* kg; bf16_t *QS, *KS, *VS, *QD, *KD, *VD; unsigned char* GT;
    __device__ __forceinline__ void mid(f32x4 (&)[2][2][4][2], const Unit&, int, int, int, int) const {}
    static __device__ __forceinline__ f32x4 cvt(const f32x4 a, const f32x4 sc) { const i32x4 ia = __builtin_bit_cast(i32x4, a); return (f32x4){(float)ia[0], (float)ia[1], (float)ia[2], (float)ia[3]} * sc; }
    __device__ __forceinline__ void operator()(const f32x4 (&acc)[2][2][4][2], const Unit& u, int wr, int wc, int fr, int fq) const {
        asm volatile("" : "+v"(fr), "+v"(fq));
        const int pn = u.pn; const int row0 = u.pm * BM + wr * 64 + fr, colp = pn * BM + wc * 32 + 8 * fq;
        f32x4 sv[2][2];
#pragma unroll
        for (int bj = 0; bj < 2; ++bj)
#pragma unroll
            for (int n = 0; n < 2; ++n) sv[bj][n] = *(const f32x4*)(cs + colp + bj * HALF + 4 * n);
        if (pn < 6) {
            bf16_t* base; int colt;
            if (pn < 2) { base = QS; colt = pn * 256; } else if (pn < 4) { base = KS; colt = (pn - 2) * 256; } else { base = VS; colt = (pn - 4) * 256; }
            base += colt + wc * 32 + 8 * fq;
            const float qs = (pn < 2 ? QSCALE : 1.0f);
#pragma unroll
            for (int ai = 0; ai < 2; ++ai)
#pragma unroll
                for (int m = 0; m < 4; ++m) { const int row = row0 + ai * HALF + m * 16; const float r = xs[row] * qs;
#pragma unroll
                    for (int bj = 0; bj < 2; ++bj) *(u32x4*)(base + (size_t)row * 512 + bj * HALF) = pack8(cvt(acc[ai][bj][m][0], sv[bj][0]) * r, cvt(acc[ai][bj][m][1], sv[bj][1]) * r);
                }
        } else if (pn < 12) {
            const bool isK = pn >= 9; const int head = (isK ? pn - 9 : pn - 6) * 4 + wc;
            const float* g = (isK ? kg : qg) + head * 64 + 8 * fq;
            f32x4 gv[2][2]; const float qsc = isK ? 1.0f : QSCALE;
#pragma unroll
            for (int bj = 0; bj < 2; ++bj)
#pragma unroll
                for (int n = 0; n < 2; ++n) gv[bj][n] = *(const f32x4*)(g + 32 * bj + 4 * n) * qsc;
            bf16_t* base = (isK ? KD : QD) + head * 64 + 8 * fq;
#pragma unroll
            for (int ai = 0; ai < 2; ++ai)
#pragma unroll
                for (int m = 0; m < 4; ++m) { const int row = row0 + ai * HALF + m * 16; const float r = xs[row];
                    f32x4 v[2][2]; float ss = 0.f;
#pragma unroll
                    for (int bj = 0; bj < 2; ++bj)
#pragma unroll
                        for (int n = 0; n < 2; ++n) { v[bj][n] = cvt(acc[ai][bj][m][n], sv[bj][n]) * r; const f32x4 q = v[bj][n] * v[bj][n]; ss += (q[0] + q[1]) + (q[2] + q[3]); }
                    ss += __shfl_xor(ss, 16); ss += __shfl_xor(ss, 32);
                    const float sc = __builtin_amdgcn_rsqf(ss * (1.0f / 64.0f) + 1e-6f);
#pragma unroll
                    for (int bj = 0; bj < 2; ++bj) *(u32x4*)(base + (size_t)row * 768 + 32 * bj) = pack8(v[bj][0] * sc * gv[bj][0], v[bj][1] * sc * gv[bj][1]);
                }
        } else if (pn < 15) {
            bf16_t* base = VD + (pn - 12) * 256 + wc * 32 + 8 * fq;
#pragma unroll
            for (int ai = 0; ai < 2; ++ai)
#pragma unroll
                for (int m = 0; m < 4; ++m) { const int row = row0 + ai * HALF + m * 16; const float r = xs[row];
#pragma unroll
                    for (int bj = 0; bj < 2; ++bj) *(u32x4*)(base + (size_t)row * 768 + bj * HALF) = pack8(cvt(acc[ai][bj][m][0], sv[bj][0]) * r, cvt(acc[ai][bj][m][1], sv[bj][1]) * r);
                }
        } else {
            const int col0 = (pn - 15) * 256 + wc * 32 + 8 * fq;
            f32x4 bv[2][2];
#pragma unroll
            for (int bj = 0; bj < 2; ++bj)
#pragma unroll
                for (int n = 0; n < 2; ++n) bv[bj][n] = *(const f32x4*)(bgate + col0 + bj * HALF + 4 * n);
#pragma unroll
            for (int ai = 0; ai < 2; ++ai)
#pragma unroll
                for (int m = 0; m < 4; ++m) { const int row = row0 + ai * HALF + m * 16; const float r = xs[row];
#pragma unroll
                    for (int bj = 0; bj < 2; ++bj) { f32x4 a = cvt(acc[ai][bj][m][0], sv[bj][0]) * r + bv[bj][0], b = cvt(acc[ai][bj][m][1], sv[bj][1]) * r + bv[bj][1];
#pragma unroll
                        for (int e = 0; e < 4; ++e) { a[e] = sigmoidf_(a[e]) * 255.0f; b[e] = sigmoidf_(b[e]) * 255.0f; }
                        unsigned w0 = 0, w1 = 0;
                        w0 = __builtin_amdgcn_cvt_pk_u8_f32(a[0], 0, w0); w0 = __builtin_amdgcn_cvt_pk_u8_f32(a[1], 1, w0); w0 = __builtin_amdgcn_cvt_pk_u8_f32(a[2], 2, w0); w0 = __builtin_amdgcn_cvt_pk_u8_f32(a[3], 3, w0);
                        w1 = __builtin_amdgcn_cvt_pk_u8_f32(b[0], 0, w1); w1 = __builtin_amdgcn_cvt_pk_u8_f32(b[1], 1, w1); w1 = __builtin_amdgcn_cvt_pk_u8_f32(b[2], 2, w1); w1 = __builtin_amdgcn_cvt_pk_u8_f32(b[3], 3, w1);
                        *(u32x2*)(GT + (size_t)row * 2048 + col0 + bj * HALF) = (u32x2){w0, w1}; }
                }
        }
    }
};

struct Epi2 {
    static constexpr bool PERM = true, AFTER_DRAIN = false, HAS_MID = true; static constexpr int MID_T = 8;
    const unsigned char* GT; unsigned char* MIX8; unsigned* part; unsigned* rcnt; float* rmaxf; PG8_LAS unsigned char* red_lds;
    static __device__ __forceinline__ float ub(unsigned w, int e) { return (float)((w >> (8 * e)) & 0xffu); }
    static __device__ __forceinline__ float gcv(unsigned w, int e) { return fmaxf(ub(w, e) * (1.0f / 255.0f), 1e-30f); }
    __device__ __forceinline__ void mid(f32x4 (&acc)[2][2][4][2], const Unit& u, int wr, int wc, int fr, int fq) const {
        asm volatile("" : "+v"(fr), "+v"(fq));
        const int row0 = u.pm * BM + wr * 64 + fr, col0 = u.pn * BM + wc * 32 + 8 * fq;
        u32x2 ga[2][4][2], gb[2][4][2];
#pragma unroll
        for (int ai = 0; ai < 2; ++ai)
#pragma unroll
            for (int m = 0; m < 4; ++m) { const unsigned char* gp = GT + (size_t)(row0 + ai * HALF + m * 16) * 2048 + col0;
#pragma unroll
                for (int bj = 0; bj < 2; ++bj) { ga[ai][m][bj] = *(const u32x2*)(gp + bj * HALF); gb[ai][m][bj] = *(const u32x2*)(gp + 1024 + bj * HALF); } }
        asm volatile("" ::: "memory");
#pragma unroll
        for (int ai = 0; ai < 2; ++ai)
#pragma unroll
            for (int m = 0; m < 4; ++m)
#pragma unroll
                for (int bj = 0; bj < 2; ++bj) { const u32x2 a = ga[ai][m][bj], b = gb[ai][m][bj];
                    f32x4 r0, r1;
#pragma unroll
                    for (int e = 0; e < 4; ++e) { r0[e] = ub(a.x, e) * (1.0f / 255.0f) * __builtin_amdgcn_rcpf(gcv(b.x, e)); r1[e] = ub(a.y, e) * (1.0f / 255.0f) * __builtin_amdgcn_rcpf(gcv(b.y, e)); }
                    acc[ai][bj][m][0] *= r0; acc[ai][bj][m][1] *= r1; }
        asm volatile("" ::: "memory");
    }
    __device__ __forceinline__ void operator()(f32x4 (&acc)[2][2][4][2], const Unit& u, int wr, int wc, int fr, int fq) const {
        asm volatile("" : "+v"(fr), "+v"(fq));
        const int row0 = u.pm * BM + wr * 64 + fr, col0 = u.pn * BM + wc * 32 + 8 * fq;
        PG8_LAS float* red = (PG8_LAS float*)red_lds; PG8_LAS float* red2 = red + 1024;
#pragma unroll
        for (int ai = 0; ai < 2; ++ai) { u32x2 gb[4][2];
#pragma unroll
            for (int m = 0; m < 4; ++m) { const unsigned char* gp = GT + (size_t)(row0 + ai * HALF + m * 16) * 2048 + 1024 + col0;
#pragma unroll
                for (int bj = 0; bj < 2; ++bj) gb[m][bj] = *(const u32x2*)(gp + bj * HALF); }
#pragma unroll
            for (int m = 0; m < 4; ++m) { float a = 0.f;
#pragma unroll
                for (int bj = 0; bj < 2; ++bj) { const u32x2 b = gb[m][bj];
#pragma unroll
                    for (int e = 0; e < 4; ++e) { acc[ai][bj][m][0][e] *= gcv(b.x, e); acc[ai][bj][m][1][e] *= gcv(b.y, e); a = fmaxf(a, fmaxf(fabsf(acc[ai][bj][m][0][e]), fabsf(acc[ai][bj][m][1][e]))); } }
                a = fmaxf(a, __shfl_xor(a, 16)); a = fmaxf(a, __shfl_xor(a, 32));
                if (fq == 0) red[(wr * 64 + fr + ai * HALF + m * 16) * 4 + wc] = a; }
            asm volatile("" ::: "memory");
        }
        asm volatile("s_waitcnt lgkmcnt(0)" ::: "memory"); __builtin_amdgcn_s_barrier(); asm volatile("" ::: "memory");
        const int tid = (wr * 4 + wc) * 64 + fr + 16 * fq;
        if (tid < 256) {
            const f32x4 p4 = *(const PG8_LAS f32x4*)(red + tid * 4);
            const float v = fmaxf(fmaxf(p4[0], p4[1]), fmaxf(p4[2], p4[3]));
            unsigned* pr = part + (size_t)(u.pm * BM + tid) * 4;
            __hip_atomic_store(pr + u.pn, __float_as_uint(v), __ATOMIC_RELAXED, __HIP_MEMORY_SCOPE_AGENT);
            asm volatile("s_waitcnt vmcnt(0)" ::: "memory");
            if ((tid & 63) == 0) (void)__hip_atomic_fetch_add(rcnt + u.pm, 1u, __ATOMIC_RELAXED, __HIP_MEMORY_SCOPE_AGENT);
            { unsigned sp = 0; while (__hip_atomic_load(rcnt + u.pm, __ATOMIC_RELAXED, __HIP_MEMORY_SCOPE_AGENT) < 16u) { __builtin_amdgcn_s_sleep(4); if (++sp > (1u << 21)) break; } }
            asm volatile("" ::: "memory");
            float f = 0.f;
#pragma unroll
            for (int j = 0; j < 4; ++j) f = fmaxf(f, __uint_as_float(__hip_atomic_load(pr + j, __ATOMIC_RELAXED, __HIP_MEMORY_SCOPE_AGENT)));
            red2[tid] = f;
            if (u.pn == 0) rmaxf[u.pm * BM + tid] = f;
        }
        asm volatile("s_waitcnt lgkmcnt(0)" ::: "memory"); __builtin_amdgcn_s_barrier(); asm volatile("" ::: "memory");
#pragma unroll
        for (int ai = 0; ai < 2; ++ai)
#pragma unroll
            for (int m = 0; m < 4; ++m) { const int row = row0 + ai * HALF + m * 16;
                const float rm = red2[wr * 64 + fr + ai * HALF + m * 16]; const float sc = rm > 0.f ? 127.0f / rm : 0.f;
#pragma unroll
                for (int bj = 0; bj < 2; ++bj) { unsigned w0 = 0, w1 = 0;
#pragma unroll
                    for (int e = 0; e < 4; ++e) { w0 |= ((unsigned)(int)__builtin_rintf(acc[ai][bj][m][0][e] * sc) & 0xffu) << (8 * e); w1 |= ((unsigned)(int)__builtin_rintf(acc[ai][bj][m][1][e] * sc) & 0xffu) << (8 * e); }
                    *(u32x2*)(MIX8 + (size_t)row * 1024 + col0 + bj * HALF) = (u32x2){w0, w1}; } }
    }
};

struct Epi3 {
    static constexpr bool PERM = true, AFTER_DRAIN = false, HAS_MID = false; static constexpr int MID_T = -1;
    const bf16_t* xb; const float* rms; const unsigned* rmax; const float* wos; bf16_t* x1b; float* ssq;
    __device__ __forceinline__ void mid(f32x4 (&)[2][2][4][2], const Unit&, int, int, int, int) const {}
    static __device__ __forceinline__ f32x4 cvt(const f32x4 a, const f32x4 sc) { const i32x4 ia = __builtin_bit_cast(i32x4, a); return (f32x4){(float)ia[0], (float)ia[1], (float)ia[2], (float)ia[3]} * sc; }
    __device__ __forceinline__ void operator()(const f32x4 (&acc)[2][2][4][2], const Unit& u, int wr, int wc, int fr, int fq) const {
        asm volatile("" : "+v"(fr), "+v"(fq));
        const int row0 = u.pm * BM + wr * 64 + fr, col0 = u.pn * BM + wc * 32 + 8 * fq;
        f32x4 wsv[2][2];
#pragma unroll
        for (int bj = 0; bj < 2; ++bj)
#pragma unroll
            for (int n = 0; n < 2; ++n) wsv[bj][n] = *(const f32x4*)(wos + col0 + bj * HALF + 4 * n);
#pragma unroll
        for (int ai = 0; ai < 2; ++ai) { u32x4 xv[4][2]; float rm[4], ms[4];
#pragma unroll
            for (int m = 0; m < 4; ++m) { const int row = row0 + ai * HALF + m * 16; const size_t off = (size_t)row * 1024 + col0; rm[m] = rms[row]; ms[m] = __uint_as_float(rmax[row]) * (1.0f / 127.0f);
#pragma unroll
                for (int bj = 0; bj < 2; ++bj) xv[m][bj] = *(const u32x4*)(xb + off + bj * HALF); }
#pragma unroll
            for (int m = 0; m < 4; ++m) { const int row = row0 + ai * HALF + m * 16; const size_t off = (size_t)row * 1024 + col0; float ss = 0.f; const float r = rm[m], mr = ms[m];
#pragma unroll
                for (int bj = 0; bj < 2; ++bj) { const u32x4 w = xv[m][bj];
                    const f32x4 x0 = (f32x4){bflo(w.x), bfhi(w.x), bflo(w.y), bfhi(w.y)}, x1 = (f32x4){bflo(w.z), bfhi(w.z), bflo(w.w), bfhi(w.w)};
                    const f32x4 v0 = cvt(acc[ai][bj][m][0], wsv[bj][0]) * mr + x0 * r, v1 = cvt(acc[ai][bj][m][1], wsv[bj][1]) * mr + x1 * r;
                    *(u32x4*)(x1b + off + bj * HALF) = pack8(v0, v1);
                    const f32x4 q0 = v0 * v0, q1 = v1 * v1; ss += ((q0[0] + q0[1]) + (q0[2] + q0[3])) + ((q1[0] + q1[1]) + (q1[2] + q1[3])); }
                ss += __shfl_xor(ss, 16); ss += __shfl_xor(ss, 32);
                if (fq == 0) ssq[(size_t)row * 16 + u.pn * 4 + wc] = ss;
            }
            asm volatile("" ::: "memory");
        }
    }
};

__device__ __forceinline__ unsigned f2key(float v) { const unsigned u = __float_as_uint(v); return (u & 0x80000000u) ? ~u : (u | 0x80000000u); }
__device__ __forceinline__ float key2f(unsigned k) { return __uint_as_float((k & 0x80000000u) ? (k & 0x7fffffffu) : ~k); }
#define PG8_CE(a_, b_) do { const unsigned hi__ = (a_) > (b_) ? (a_) : (b_); const unsigned lo__ = (a_) > (b_) ? (b_) : (a_); (a_) = hi__; (b_) = lo__; } while (0)
__device__ __forceinline__ void bitonic_merge16(unsigned (&v)[16]) {
#pragma unroll
    for (int j = 8; j >= 1; j >>= 1)
#pragma unroll
        for (int i = 0; i < 16; ++i) { const int l = i ^ j; if (l > i) PG8_CE(v[i], v[l]); }
}
__device__ __forceinline__ void bitonic_sort16(unsigned (&v)[16]) {
#pragma unroll
    for (int k = 2; k <= 16; k <<= 1)
#pragma unroll
        for (int j = k >> 1; j >= 1; j >>= 1)
#pragma unroll
            for (int i = 0; i < 16; ++i) { const int l = i ^ j; if (l > i) { if ((i & k) == 0 || k == 16) PG8_CE(v[i], v[l]); else PG8_CE(v[l], v[i]); } }
}
__device__ __forceinline__ void merge_top16(unsigned (&t)[16], const unsigned (&o)[16]) {
#pragma unroll
    for (int i = 0; i < 16; ++i) t[i] = t[i] > o[15 - i] ? t[i] : o[15 - i];
    bitonic_merge16(t);
}
template <int XM> __device__ __forceinline__ void merge_top16_xor(unsigned (&t)[16]) {
    unsigned o[16];
#pragma unroll
    for (int i = 0; i < 16; ++i) o[i] = (unsigned)__shfl_xor((int)t[i], XM);
    merge_top16(t, o);
}

struct Epi4 {
    static constexpr bool PERM = false, AFTER_DRAIN = true, HAS_MID = false; static constexpr int MID_T = -1;
    const float* ssq; float* rinv2; unsigned short* ids; float* gw;
    const float* hs; const float* wcs;
    __device__ __forceinline__ void mid(f32x4 (&)[2][2][4][2], const Unit&, int, int, int, int) const {}
    __device__ __forceinline__ void fused(f32x4 (&acc)[2][2][4][2], const Unit& u, int wr, int wc, int fr, int fq, PG8_LAS unsigned char* lds, int wid, int lane) const {
        asm volatile("" : "+v"(fr), "+v"(fq));
        const int tid = wid * 64 + lane;
        const int rl = tid >> 2, p = (tid >> 1) & 1, hf = tid & 1, q4 = tid & 3;
#pragma unroll
        for (int pass = 0; pass < 2; ++pass) {
            f32x4 wsv[2][2]; float hsv[4];
#pragma unroll
            for (int bj = 0; bj < 2; ++bj)
#pragma unroll
                for (int n = 0; n < 2; ++n) wsv[bj][n] = *(const f32x4*)(wcs + u.pn * BM + bj * HALF + wc * 32 + n * 16 + fq * 4);
#pragma unroll
            for (int m = 0; m < 4; ++m) hsv[m] = hs[u.pm * BM + pass * HALF + wr * 64 + m * 16 + fr];
#pragma unroll
            for (int m = 0; m < 4; ++m)
#pragma unroll
                for (int bj = 0; bj < 2; ++bj)
#pragma unroll
                    for (int n = 0; n < 2; ++n) { const i32x4 ia = __builtin_bit_cast(i32x4, acc[pass][bj][m][n]); f32x4 sv;
#pragma unroll
                        for (int e = 0; e < 4; ++e) sv[e] = (float)ia[e] * hsv[m] * wsv[bj][n][e];
                        *(PG8_LAS f32x4*)(lds + (size_t)(wr * 64 + m * 16 + fr) * 1056 + bj * 528 + (wc * 32 + n * 16 + fq * 4) * 4) = sv; }
            asm volatile("s_waitcnt lgkmcnt(0)" ::: "memory"); __builtin_amdgcn_s_barrier(); asm volatile("" ::: "memory");
            const int row = u.pm * BM + pass * HALF + rl;
            unsigned tk[16];
#pragma unroll
            for (int i = 0; i < 16; ++i) tk[i] = 0u;
            const PG8_LAS unsigned char* sp = lds + (size_t)rl * 1056 + p * 528 + hf * 256;
#pragma nounroll
            for (int c = 0; c < 4; ++c) { unsigned ch[16];
#pragma unroll
                for (int e4 = 0; e4 < 4; ++e4) { const f32x4 v = *(const PG8_LAS f32x4*)(sp + c * 64 + e4 * 16);
#pragma unroll
                    for (int e = 0; e < 4; ++e) ch[4 * e4 + e] = (f2key(v[e]) & ~127u) | (unsigned)(127 - (64 * hf + 16 * c + 4 * e4 + e)); }
                bitonic_sort16(ch);
                merge_top16(tk, ch);
            }
            merge_top16_xor<1>(tk);
            asm volatile("s_waitcnt lgkmcnt(0)" ::: "memory");
            PG8_LAS unsigned* kl = (PG8_LAS unsigned*)(lds + (size_t)(rl & ~15) * 1056) + ((rl & 15) * 2) * 16;
            if (hf == 0) {
#pragma unroll
                for (int i = 0; i < 4; ++i) *(PG8_LAS u32x4*)(kl + p * 16 + 4 * i) = (u32x4){tk[4 * i], tk[4 * i + 1], tk[4 * i + 2], tk[4 * i + 3]}; }
            asm volatile("s_waitcnt lgkmcnt(0)" ::: "memory");
            unsigned ck[16];
#define CAND_SLOT(m_, ij__) do { const unsigned i__ = (ij__) >> 4, j__ = (ij__) & 15u; \
                const unsigned ka__ = kl[(ij__) == 0xFFFFu ? 0u : i__], kb__ = kl[16 + ((ij__) == 0xFFFFu ? 0u : j__)]; \
                const float s__ = key2f(ka__ & ~127u) + key2f(kb__ & ~127u); \
                ck[m_] = (ij__) == 0xFFFFu ? 0u : ((f2key(s__) & ~255u) | (255u - (ij__))); } while (0)
                { const unsigned ij_ = q4 == 0 ? 0u : q4 == 1 ? 1u : q4 == 2 ? 2u : 3u; CAND_SLOT(0, ij_); }
                { const unsigned ij_ = q4 == 0 ? 4u : q4 == 1 ? 5u : q4 == 2 ? 6u : 7u; CAND_SLOT(1, ij_); }
                { const unsigned ij_ = q4 == 0 ? 8u : q4 == 1 ? 9u : q4 == 2 ? 10u : 11u; CAND_SLOT(2, ij_); }
                { const unsigned ij_ = q4 == 0 ? 12u : q4 == 1 ? 13u : q4 == 2 ? 14u : 15u; CAND_SLOT(3, ij_); }
                { const unsigned ij_ = q4 == 0 ? 16u : q4 == 1 ? 17u : q4 == 2 ? 18u : 19u; CAND_SLOT(4, ij_); }
                { const unsigned ij_ = q4 == 0 ? 20u : q4 == 1 ? 21u : q4 == 2 ? 22u : 23u; CAND_SLOT(5, ij_); }
                { const unsigned ij_ = q4 == 0 ? 32u : q4 == 1 ? 33u : q4 == 2 ? 34u : 35u; CAND_SLOT(6, ij_); }
                { const unsigned ij_ = q4 == 0 ? 36u : q4 == 1 ? 48u : q4 == 2 ? 49u : 50u; CAND_SLOT(7, ij_); }
                { const unsigned ij_ = q4 == 0 ? 51u : q4 == 1 ? 64u : q4 == 2 ? 65u : 66u; CAND_SLOT(8, ij_); }
                { const unsigned ij_ = q4 == 0 ? 80u : q4 == 1 ? 81u : q4 == 2 ? 96u : 97u; CAND_SLOT(9, ij_); }
                { const unsigned ij_ = q4 == 0 ? 112u : q4 == 1 ? 113u : q4 == 2 ? 128u : 144u; CAND_SLOT(10, ij_); }
                { const unsigned ij_ = q4 == 0 ? 160u : q4 == 1 ? 176u : q4 == 2 ? 192u : 208u; CAND_SLOT(11, ij_); }
                { const unsigned ij_ = q4 == 0 ? 224u : q4 == 1 ? 240u : q4 == 2 ? 65535u : 65535u; CAND_SLOT(12, ij_); }
#undef CAND_SLOT
            ck[13] = 0u; ck[14] = 0u; ck[15] = 0u;
            bitonic_sort16(ck);
            merge_top16_xor<1>(ck); merge_top16_xor<2>(ck);
            float sq = 0.f;
#pragma unroll
            for (int i = 0; i < 4; ++i) { const f32x4 t = *(const f32x4*)(ssq + (size_t)row * 16 + 4 * i); sq += (t[0] + t[1]) + (t[2] + t[3]); }
            const float r2 = __builtin_amdgcn_rsqf(sq * (1.0f / 1024.0f) + 1e-6f);
            if (u.pn == 0 && q4 == 0) rinv2[row] = r2;
            const float b0 = key2f(ck[0] & ~255u); float wsum = 0.f; float wv[16];
#pragma unroll
            for (int q = 0; q < 16; ++q) { wv[q] = __builtin_amdgcn_exp2f((key2f(ck[q] & ~255u) - b0) * r2 * 1.4426950408889634f); wsum += wv[q]; }
            const float inv = 1.0f / wsum;
            unsigned short eo[4]; float go[4];
#pragma unroll
            for (int e = 0; e < 4; ++e) { unsigned c0 = ck[e], c1 = ck[4 + e], c2 = ck[8 + e], c3 = ck[12 + e]; float w0 = wv[e], w1 = wv[4 + e], w2 = wv[8 + e], w3 = wv[12 + e];
                asm volatile("" : "+v"(c0), "+v"(c1), "+v"(c2), "+v"(c3), "+v"(w0), "+v"(w1), "+v"(w2), "+v"(w3));
                const unsigned cc = q4 == 0 ? c0 : q4 == 1 ? c1 : q4 == 2 ? c2 : c3; const float ww = q4 == 0 ? w0 : q4 == 1 ? w1 : q4 == 2 ? w2 : w3;
                const unsigned code = 255u - (cc & 255u);
                const unsigned i1 = 127u - (kl[code >> 4] & 127u), i2 = 127u - (kl[16 + (code & 15u)] & 127u);
                eo[e] = (unsigned short)(i1 * 128u + i2); go[e] = ww * inv; }
            const size_t ob = ((size_t)row * 8 + u.pn) * 16 + q4 * 4;
            { u32x2 w; w.x = eo[0] | ((unsigned)eo[1] << 16); w.y = eo[2] | ((unsigned)eo[3] << 16); *(u32x2*)(ids + ob) = w; }
            *(f32x4*)(gw + ob) = (f32x4){go[0], go[1], go[2], go[3]};
            asm volatile("s_waitcnt lgkmcnt(0)" ::: "memory"); __builtin_amdgcn_s_barrier(); asm volatile("" ::: "memory");
        }
    }
};
template <class Epi, class Sched, bool ALIGN_EPI = false, bool SP2 = false, bool FP8 = false, bool I8 = false>
__device__ __forceinline__ void gemm_phase(PG8_LAS unsigned char* lds, const Gemm g, const Sched& S, const Epi& E) {
    const int tid = threadIdx.x, wid = __builtin_amdgcn_readfirstlane(tid >> 6), lane = tid & 63, wr = wid >> 2, wc = wid & 3, fr = lane & 15, fq = lane >> 4;
    const int K = g.K, nt = K / BK;
    unsigned voffA[2], voffB[2];
#pragma unroll
    for (int i = 0; i < 2; ++i) { int R, C; stage_rc(tid * 16 + i * 8192, R, C); const int Rb = Epi::PERM ? ((R & ~31) + perm32(R & 31)) : R;
        voffA[i] = (unsigned)(R * K + C) * 2u; voffB[i] = (unsigned)(Rb * K + C) * 2u; }
    const size_t kstep = (size_t)(BK * 2);
    const size_t hstep = (size_t)HALF * K * 2;
    const size_t tstep = 2 * hstep;
    const unsigned ldsw = (unsigned)wid * 1024u;
    const int aoff = lds_byte(wr * 64 + fr, fq * 8), boff = lds_byte(wc * 32 + fr, fq * 8);
#define PG8_SA(b, h) (((b) * 2 + (h)) * HTB)
#define PG8_SB(b, h) ((4 + (b) * 2 + (h)) * HTB)
#define PG8_STAGE(bufoff, gbase, voff) do { _Pragma("unroll") for (int _i = 0; _i < 2; ++_i) \
        __builtin_amdgcn_global_load_lds((const unsigned*)((const char*)(gbase) + (voff)[_i]), (PG8_LAS unsigned*)(lds + (bufoff) + ldsw + _i * 8192), 16, 0, 0); } while (0)
#define PG8_LD8(lo_, hi_) __builtin_bit_cast(i32x8, __builtin_shufflevector((lo_), (hi_), 0, 1, 2, 3, 4, 5, 6, 7))
#define PG8_LDA(dst, b, h) do { if constexpr (FP8) { _Pragma("unroll") for (int m = 0; m < 4; ++m) { const u32x4 l0_ = *(const PG8_LAS u32x4*)(lds + PG8_SA(b, h) + aoff + m * 2048), l1_ = *(const PG8_LAS u32x4*)(lds + PG8_SA(b, h) + aoff + m * 2048 + 1024); dst##8[m] = PG8_LD8(l0_, l1_); } } \
        else { _Pragma("unroll") for (int m = 0; m < 4; ++m) _Pragma("unroll") for (int k = 0; k < 2; ++k) dst[m][k] = *(const PG8_LAS bf16x8*)(lds + PG8_SA(b, h) + aoff + m * 2048 + k * 1024); } } while (0)
#define PG8_LDB(dst, b, h) do { if constexpr (FP8) { _Pragma("unroll") for (int n = 0; n < 2; ++n) { const u32x4 l0_ = *(const PG8_LAS u32x4*)(lds + PG8_SB(b, h) + boff + n * 2048), l1_ = *(const PG8_LAS u32x4*)(lds + PG8_SB(b, h) + boff + n * 2048 + 1024); dst##8[n] = PG8_LD8(l0_, l1_); } } \
        else { _Pragma("unroll") for (int n = 0; n < 2; ++n) _Pragma("unroll") for (int k = 0; k < 2; ++k) dst[n][k] = *(const PG8_LAS bf16x8*)(lds + PG8_SB(b, h) + boff + n * 2048 + k * 1024); } } while (0)
#define PG8_MMA(ai, bj, At, Bt) do { __builtin_amdgcn_s_setprio(1); \
        if constexpr (FP8) { _Pragma("unroll") for (int m = 0; m < 4; ++m) _Pragma("unroll") for (int n = 0; n < 2; ++n) \
            asm volatile("v_mfma_scale_f32_16x16x128_f8f6f4 %0, %1, %2, %0, %3, %3 op_sel_hi:[0,0,0]" : "+v"(acc[ai][bj][m][n]) : "v"(Bt##8[n]), "v"(At##8[m]), "v"(sc127));     \
            } \
        else if constexpr (I8) { _Pragma("unroll") for (int m = 0; m < 4; ++m) _Pragma("unroll") for (int n = 0; n < 2; ++n) _Pragma("unroll") for (int k = 0; k < 2; ++k) \
            acc[ai][bj][m][n] = __builtin_bit_cast(f32x4, __builtin_amdgcn_mfma_i32_16x16x64_i8(__builtin_bit_cast(i32x4, Bt[n][k]), __builtin_bit_cast(i32x4, At[m][k]), __builtin_bit_cast(i32x4, acc[ai][bj][m][n]), 0, 0, 0)); } \
        else { _Pragma("unroll") for (int m = 0; m < 4; ++m) _Pragma("unroll") for (int n = 0; n < 2; ++n) _Pragma("unroll") for (int k = 0; k < 2; ++k) \
            acc[ai][bj][m][n] = __builtin_amdgcn_mfma_f32_16x16x32_bf16(Bt[n][k], At[m][k], acc[ai][bj][m][n], 0, 0, 0); } \
        __builtin_amdgcn_s_setprio(0); } while (0)
#define PG8_WAIT_V(n) asm volatile("s_waitcnt vmcnt(" #n ")" ::: "memory")
#define PG8_WAIT_L(n) asm volatile("s_waitcnt lgkmcnt(" #n ")" ::: "memory")
#define PG8_BAR __builtin_amdgcn_s_barrier()
#define PG8_SCHED __builtin_amdgcn_sched_barrier(0)
    Unit cur, nxt; int ui = 0;
    if (!S.next(0, cur)) return;
    f32x4 acc[2][2][4][2];
#pragma unroll
    for (int a = 0; a < 2; ++a)
#pragma unroll
        for (int b = 0; b < 2; ++b)
#pragma unroll
            for (int m = 0; m < 4; ++m)
#pragma unroll
                for (int n = 0; n < 2; ++n) acc[a][b][m][n] = (f32x4){0.f, 0.f, 0.f, 0.f};
    bf16x8 At[4][2], B0[2][2], B1[2][2]; i32x8 At8[4], B08[2], B18[2];
    int sc127 = 127; asm volatile("" : "+v"(sc127));
    const char* cA = (const char*)g.A + (size_t)cur.pm * tstep; const char* cB = (const char*)g.Bt + (size_t)cur.pn * tstep;
    S.a_ready(cur);
    if constexpr (SP2) {
        PG8_STAGE(PG8_SB(0, 0), cB, voffB); PG8_STAGE(PG8_SB(0, 1), cB + hstep, voffB); PG8_STAGE(PG8_SA(0, 0), cA, voffA); PG8_STAGE(PG8_SA(0, 1), cA + hstep, voffA);
        if (wr == 1) PG8_BAR;
        PG8_WAIT_V(2); PG8_BAR;
        PG8_STAGE(PG8_SB(1, 0), cB + kstep, voffB); PG8_STAGE(PG8_SA(1, 0), cA + kstep, voffA); PG8_STAGE(PG8_SB(1, 1), cB + hstep + kstep, voffB);
        PG8_WAIT_V(6); PG8_BAR;
    } else {
        PG8_STAGE(PG8_SB(0, 0), cB, voffB); PG8_STAGE(PG8_SA(0, 0), cA, voffA); PG8_STAGE(PG8_SB(0, 1), cB + hstep, voffB); PG8_STAGE(PG8_SA(0, 1), cA + hstep, voffA);
        if (wr == 1) PG8_BAR;
        PG8_WAIT_V(4); PG8_BAR;
        PG8_STAGE(PG8_SB(1, 0), cB + kstep, voffB); PG8_STAGE(PG8_SA(1, 0), cA + kstep, voffA); PG8_STAGE(PG8_SB(1, 1), cB + hstep + kstep, voffB);
        PG8_WAIT_V(6); PG8_BAR;
    }
    for (;;) {
        const bool has_next = S.next(ui + 1, nxt);
        const char* nA = has_next ? (const char*)g.A + (size_t)nxt.pm * tstep : cA; const char* nB = has_next ? (const char*)g.Bt + (size_t)nxt.pn * tstep : cB;
        for (int t = 0; t < nt; t += 2) {
            if constexpr (Epi::HAS_MID) { if (t == Epi::MID_T) E.mid(acc, cur, wr, wc, fr, fq); }
            const bool last = (t == nt - 2);
            const char* a1 = cA + (size_t)(t + 1) * kstep;
            const char* a2 = last ? nA : cA + (size_t)(t + 2) * kstep; const char* b2 = last ? nB : cB + (size_t)(t + 2) * kstep;
            const char* a3 = a2 + kstep; const char* b3 = b2 + kstep;
            if (last && has_next) S.a_ready(nxt);
            if constexpr (SP2) {
            PG8_LDB(B0, 0, 0); PG8_LDB(B1, 0, 1); PG8_SCHED; PG8_LDA(At, 0, 0); PG8_STAGE(PG8_SA(1, 1), a1 + hstep, voffA);
            PG8_WAIT_V(8); PG8_WAIT_L(0); PG8_BAR; PG8_MMA(0, 0, At, B0); PG8_MMA(0, 1, At, B1); PG8_BAR; PG8_SCHED;
            PG8_LDA(At, 0, 1); PG8_STAGE(PG8_SB(0, 0), b2, voffB); PG8_STAGE(PG8_SB(0, 1), b2 + hstep, voffB); PG8_STAGE(PG8_SA(0, 0), a2, voffA);
            PG8_WAIT_V(8); PG8_WAIT_L(0); PG8_BAR; PG8_MMA(1, 0, At, B0); PG8_MMA(1, 1, At, B1); PG8_BAR; PG8_SCHED;
            PG8_LDB(B0, 1, 0); PG8_LDB(B1, 1, 1); PG8_SCHED; PG8_LDA(At, 1, 0); PG8_STAGE(PG8_SA(0, 1), a2 + hstep, voffA);
            PG8_WAIT_V(8); PG8_WAIT_L(0); PG8_BAR; PG8_MMA(0, 0, At, B0); PG8_MMA(0, 1, At, B1); PG8_BAR; PG8_SCHED;
            PG8_LDA(At, 1, 1); PG8_STAGE(PG8_SB(1, 0), b3, voffB); PG8_STAGE(PG8_SB(1, 1), b3 + hstep, voffB); PG8_STAGE(PG8_SA(1, 0), a3, voffA);
            PG8_WAIT_V(8); PG8_WAIT_L(0); PG8_BAR; PG8_MMA(1, 0, At, B0); PG8_MMA(1, 1, At, B1); PG8_BAR; PG8_SCHED;
            } else {
            PG8_LDB(B0, 0, 0); PG8_SCHED; PG8_LDA(At, 0, 0); PG8_STAGE(PG8_SA(1, 1), a1 + hstep, voffA);
            PG8_WAIT_L(8); PG8_BAR; PG8_WAIT_L(0); PG8_MMA(0, 0, At, B0); PG8_BAR; PG8_SCHED;
            PG8_LDB(B1, 0, 1); PG8_STAGE(PG8_SB(0, 0), b2, voffB);
            PG8_BAR; PG8_WAIT_L(0); PG8_MMA(0, 1, At, B1); PG8_BAR;
            PG8_LDA(At, 0, 1); PG8_STAGE(PG8_SA(0, 0), a2, voffA);
            PG8_BAR; PG8_WAIT_L(0); PG8_MMA(1, 0, At, B0); PG8_BAR; PG8_SCHED;
            PG8_STAGE(PG8_SB(0, 1), b2 + hstep, voffB);
            PG8_WAIT_V(6); PG8_BAR; PG8_MMA(1, 1, At, B1); PG8_BAR;
            PG8_LDB(B0, 1, 0); PG8_SCHED; PG8_LDA(At, 1, 0); PG8_STAGE(PG8_SA(0, 1), a2 + hstep, voffA);
            PG8_WAIT_L(8); PG8_BAR; PG8_WAIT_L(0); PG8_MMA(0, 0, At, B0); PG8_BAR; PG8_SCHED;
            PG8_LDB(B1, 1, 1); PG8_STAGE(PG8_SB(1, 0), b3, voffB);
            PG8_BAR; PG8_WAIT_L(0); PG8_MMA(0, 1, At, B1); PG8_BAR;
            PG8_LDA(At, 1, 1); PG8_STAGE(PG8_SA(1, 0), a3, voffA);
            PG8_BAR; PG8_WAIT_L(0); PG8_MMA(1, 0, At, B0); PG8_BAR; PG8_SCHED;
            PG8_STAGE(PG8_SB(1, 1), b3 + hstep, voffB);
            PG8_WAIT_V(6); PG8_BAR; PG8_MMA(1, 1, At, B1); PG8_BAR;
            }
        }
        if constexpr (FP8) asm volatile("s_nop 15\n\ts_nop 15" ::: "memory");
        if constexpr (ALIGN_EPI) { if (wr == 0) PG8_BAR; }
        if constexpr (!Epi::AFTER_DRAIN) { E(acc, cur, wr, wc, fr, fq); S.done(cur); }
        if (!has_next) break;
#pragma unroll
        for (int a = 0; a < 2; ++a)
#pragma unroll
            for (int b = 0; b < 2; ++b)
#pragma unroll
                for (int m = 0; m < 4; ++m)
#pragma unroll
                    for (int n = 0; n < 2; ++n) acc[a][b][m][n] = (f32x4){0.f, 0.f, 0.f, 0.f};
        cur = nxt; cA = nA; cB = nB; ++ui;
        if constexpr (ALIGN_EPI) { if (wr == 1) PG8_BAR; }
    }
    PG8_WAIT_V(0);
    if constexpr (!ALIGN_EPI) { if (wr == 0) PG8_BAR; }
    PG8_BAR;
    if constexpr (Epi::AFTER_DRAIN) { E.fused(acc, cur, wr, wc, fr, fq, lds, wid, lane); S.done(cur); }
#undef PG8_SA
#undef PG8_SB
#undef PG8_STAGE
#undef PG8_LDA
#undef PG8_LD8
#undef PG8_LDB
#undef PG8_MMA
#undef PG8_WAIT_V
#undef PG8_WAIT_L
#undef PG8_BAR
#undef PG8_SCHED
}
}


namespace att {
#define ALAS __attribute__((address_space(3)))
typedef unsigned short bf16;
typedef short bf16x8 __attribute__((ext_vector_type(8)));
typedef short s16x4 __attribute__((ext_vector_type(4)));
typedef float f32x16 __attribute__((ext_vector_type(16)));
typedef float f32x4 __attribute__((ext_vector_type(4)));
typedef float f32x2 __attribute__((ext_vector_type(2)));
typedef unsigned u32x4 __attribute__((ext_vector_type(4)));
typedef __bf16 bf16x2_t __attribute__((ext_vector_type(2)));
constexpr int SEQ = 4096;
constexpr int VPITCH = 144;
constexpr float LOG2E = 1.4426950408889634f, LN2 = 0.6931471805599453f;
__device__ __forceinline__ unsigned pkbf(float lo, float hi) { f32x2 v = {lo, hi}; bf16x2_t b = __builtin_convertvector(v, bf16x2_t); return __builtin_bit_cast(unsigned, b); }
__device__ __forceinline__ void wave_lds_sync() { asm volatile("s_waitcnt lgkmcnt(0)" ::: "memory"); }
__device__ __forceinline__ s16x4 vtr(const ALAS unsigned char* p) { return __builtin_bit_cast(s16x4, __builtin_amdgcn_ds_read_tr16_b64_v4i16((ALAS s16x4*)p)); }
__device__ __forceinline__ int crow(int r, int hi) { return (r & 3) + 8 * (r >> 2) + 4 * hi; }

__device__ __forceinline__ void pv_tile(f32x16& o0, f32x16& o1, const float (&a)[16], const ALAS unsigned char* vt, int lane) {
    const int g = lane >> 4, i = lane & 15, q_ = i >> 2, p_ = i & 3, h = lane >> 5;
    const ALAS unsigned char* vb = vt + (8 * h + q_) * VPITCH + (16 * (g & 1) + 4 * p_) * 2;
    u32x4 pw0, pw1;
    pw0.x = pkbf(a[0], a[1]); pw0.y = pkbf(a[2], a[3]); pw0.z = pkbf(a[4], a[5]); pw0.w = pkbf(a[6], a[7]);
    pw1.x = pkbf(a[8], a[9]); pw1.y = pkbf(a[10], a[11]); pw1.z = pkbf(a[12], a[13]); pw1.w = pkbf(a[14], a[15]);
    const bf16x8 pa0 = __builtin_bit_cast(bf16x8, pw0), pa1 = __builtin_bit_cast(bf16x8, pw1);
#pragma unroll
    for (int s = 0; s < 2; ++s) {
        const s16x4 l0 = vtr(vb + (16 * s) * VPITCH), h0 = vtr(vb + (16 * s + 4) * VPITCH);
        const s16x4 l1 = vtr(vb + (16 * s) * VPITCH + 64), h1 = vtr(vb + (16 * s + 4) * VPITCH + 64);
        const bf16x8 v0 = (bf16x8){l0[0], l0[1], l0[2], l0[3], h0[0], h0[1], h0[2], h0[3]};
        const bf16x8 v1 = (bf16x8){l1[0], l1[1], l1[2], l1[3], h1[0], h1[1], h1[2], h1[3]};
        o0 = __builtin_amdgcn_mfma_f32_32x32x16_bf16(s ? pa1 : pa0, v0, o0, 0, 0, 0);
        o1 = __builtin_amdgcn_mfma_f32_32x32x16_bf16(s ? pa1 : pa0, v1, o1, 0, 0, 0);
    }
}
__device__ __forceinline__ void bcast_rows(float v, ALAS float* sc, int r32, int hi, float (&out)[16]) {
    if (hi == 0) sc[r32] = v;
    wave_lds_sync();
#pragma unroll
    for (int g = 0; g < 4; ++g) { const f32x4 t = *(const ALAS f32x4*)(sc + 8 * g + 4 * hi); out[4 * g] = t[0]; out[4 * g + 1] = t[1]; out[4 * g + 2] = t[2]; out[4 * g + 3] = t[3]; }
    wave_lds_sync();
}
__device__ __forceinline__ void store_o(const f32x16& o0, const f32x16& o1, ALAS unsigned char* stg, bf16* dst  , size_t rstride_elems, int lane) {
    const int r32 = lane & 31, hi = lane >> 5;
    wave_lds_sync();
#pragma unroll
    for (int r = 0; r < 16; ++r) { const int q = crow(r, hi);
        *(ALAS unsigned short*)(stg + q * VPITCH + r32 * 2) = (unsigned short)(pkbf(o0[r], 0.f) & 0xffffu);
        *(ALAS unsigned short*)(stg + q * VPITCH + 64 + r32 * 2) = (unsigned short)(pkbf(o1[r], 0.f) & 0xffffu); }
    wave_lds_sync();
#pragma unroll
    for (int i = 0; i < 4; ++i) { const int row = 8 * i + (lane >> 3), ch = lane & 7; const u32x4 v = *(const ALAS u32x4*)(stg + row * VPITCH + ch * 16); *(u32x4*)(dst + (size_t)row * rstride_elems + ch * 8) = v; }
    wave_lds_sync();
}

__device__ __forceinline__ void sb_item(const bf16* QS, const bf16* KS, const bf16* VS, bf16* OC, int b, int h, int qt, ALAS unsigned char* wl, int lane) {
    const int r32 = lane & 31, hi = lane >> 5;
    const int t0 = qt * 32; const size_t rowb = (size_t)b * SEQ;
    const int kperm = (r32 & ~12) | ((r32 & 4) << 1) | ((r32 & 8) >> 1);
    bf16x8 qf[4];
    { const bf16* qp = QS + (rowb + t0 + r32) * 512 + h * 64 + hi * 8;
#pragma unroll
      for (int d0 = 0; d0 < 4; ++d0) qf[d0] = *(const bf16x8*)(qp + d0 * 16); }
    f32x16 o0 = {}, o1 = {}; float R = 0.f;
    for (int key0 = t0; key0 >= 0; key0 -= 32) {
        const bf16* kp = KS + (rowb + key0 + kperm) * 512 + h * 64 + hi * 8;
        bf16x8 kf[4];
#pragma unroll
        for (int d0 = 0; d0 < 4; ++d0) kf[d0] = *(const bf16x8*)(kp + d0 * 16);
        u32x4 vv[4];
#pragma unroll
        for (int i = 0; i < 4; ++i) vv[i] = *(const u32x4*)(VS + (rowb + key0 + 8 * i + (lane >> 3)) * 512 + h * 64 + (lane & 7) * 8);
        f32x16 p = {};
#pragma unroll
        for (int d0 = 0; d0 < 4; ++d0) p = __builtin_amdgcn_mfma_f32_32x32x16_bf16(kf[d0], qf[d0], p, 0, 0, 0);
#pragma unroll
        for (int i = 0; i < 4; ++i) *(ALAS u32x4*)(wl + (8 * i + (lane >> 3)) * VPITCH + (lane & 7) * 16) = vv[i];
        const bool diag = (key0 == t0);
        float z2[16], L2[16];
#pragma unroll
        for (int r = 0; r < 16; ++r) { const int kk = (r & 7) + 8 * hi + 16 * (r >> 3); const float zz = p[r];
            const float sp = fmaxf(zz, 0.f) + __builtin_amdgcn_logf(1.0f + __builtin_amdgcn_exp2f(-fabsf(zz)));
            const bool valid = !diag || (kk < r32); z2[r] = zz; L2[r] = valid ? sp : 0.f; }
        float c[16];
        c[15] = L2[15];
#pragma unroll
        for (int r = 14; r >= 8; --r) c[r] = c[r + 1] + L2[r];
        c[7] = L2[7];
#pragma unroll
        for (int r = 6; r >= 0; --r) c[r] = c[r + 1] + L2[r];
        const float TB = c[8], TA = c[0];
        const float TBo = __shfl_xor(TB, 32), TAo = __shfl_xor(TA, 32);
        const float offB = R + (hi ? 0.f : TBo);
        const float offA = R + TB + TBo + (hi ? 0.f : TAo);
        float a[16];
#pragma unroll
        for (int r = 0; r < 16; ++r) { const int kk = (r & 7) + 8 * hi + 16 * (r >> 3); const bool valid = !diag || (kk < r32);
            const float e = __builtin_amdgcn_exp2f(z2[r] - (c[r] + (r < 8 ? offA : offB))); a[r] = valid ? e : 0.f; }
        R += (TA + TB) + (TAo + TBo);
        wave_lds_sync();
        pv_tile(o0, o1, a, wl, lane);
        wave_lds_sync();
        if (__all(R > 40.0f * LOG2E)) break;
    }
    store_o(o0, o1, wl, OC + (rowb + t0) * 768 + h * 64, 768, lane);
}

constexpr int DLU_WAVE = 5120;
constexpr int DLU_O = 8 * DLU_WAVE, DLU_M = DLU_O + 512 * 128, DLU_L = DLU_M + 2048, DLU_BYTES = DLU_L + 2048;
__device__ __forceinline__ void dl_unit(const bf16* QD, const bf16* KD, const bf16* VD, bf16* OC, int b, int j, int blk, ALAS unsigned char* lds, int wave, int lane) {
    const int r32 = lane & 31, hi = lane >> 5;
    const size_t rowb = (size_t)b * SEQ;
    const int t0 = 512 * blk;
    const int kperm = (r32 & ~12) | ((r32 & 4) << 1) | ((r32 & 8) >> 1);
    ALAS unsigned char* wl = lds + wave * DLU_WAVE;
    ALAS float* sc = (ALAS float*)(wl + 4608);
    ALAS unsigned short* OL = (ALAS unsigned short*)(lds + DLU_O);
    ALAS float* ML = (ALAS float*)(lds + DLU_M); ALAS float* LL = (ALAS float*)(lds + DLU_L);
    for (int g = 2; g >= 0; --g) {
        const int hh = 4 * g + j, sh = 2 * g, r = 1 << sh;
        const float slope2 = __builtin_amdgcn_exp2f(-8.0f * (float)(hh + 1) / 12.0f) * LOG2E;
        const float sr = slope2 * (float)r;
        for (int it = wave; it < 16; it += 8) {
            const int q0 = g == 2 ? it : g == 1 ? (it & 3) + 128 * (it >> 2) : 32 * it;
            const int tq = t0 + q0 + r * r32, tmax = t0 + q0 + 31 * r;
            bf16x8 qf[4];
            { const bf16* qp = QD + (rowb + tq) * 768 + hh * 64 + hi * 8;
#pragma unroll
              for (int d0 = 0; d0 < 4; ++d0) qf[d0] = *(const bf16x8*)(qp + d0 * 16); }
            const int klo = 31 - r32; int khi = klo + 128; { const int kmaxtok = tmax >> sh; khi = khi < kmaxtok ? khi : kmaxtok; }
            const unsigned krange = (unsigned)(khi - klo);
            f32x16 o0 = {}, o1 = {}; float mrun = -3.0e38f, lrun = 0.f;
            if (g != 2) {
                mrun = ML[q0 + r * r32]; lrun = hi ? 0.f : LL[q0 + r * r32];
#pragma unroll
                for (int q = 0; q < 16; ++q) { const int tl = q0 + r * crow(q, hi);
                    o0[q] = __uint_as_float((unsigned)OL[tl * 64 + r32] << 16); o1[q] = __uint_as_float((unsigned)OL[tl * 64 + 32 + r32] << 16); }
            }
            for (int kt = 0; kt < 5; ++kt) {
                int sk = tmax - r * (32 * kt + kperm); sk = sk < 0 ? 0 : sk;
                const bf16* kp = KD + (rowb + sk) * 768 + hh * 64 + hi * 8;
                bf16x8 kf[4];
#pragma unroll
                for (int d0 = 0; d0 < 4; ++d0) kf[d0] = *(const bf16x8*)(kp + d0 * 16);
                u32x4 vv[4];
#pragma unroll
                for (int i = 0; i < 4; ++i) { int sv = tmax - r * (32 * kt + 8 * i + (lane >> 3)); sv = sv < 0 ? 0 : sv; vv[i] = *(const u32x4*)(VD + (rowb + sv) * 768 + hh * 64 + (lane & 7) * 8); }
                const int dk = 32 * kt + 8 * hi - klo;
                const float tb = -sr * (float)dk;
                f32x16 p;
#pragma unroll
                for (int q = 0; q < 16; ++q) p[q] = tb - sr * (float)((q & 7) + 16 * (q >> 3));
#pragma unroll
                for (int d0 = 0; d0 < 4; ++d0) p = __builtin_amdgcn_mfma_f32_32x32x16_bf16(kf[d0], qf[d0], p, 0, 0, 0);
#pragma unroll
                for (int i = 0; i < 4; ++i) *(ALAS u32x4*)(wl + (8 * i + (lane >> 3)) * VPITCH + (lane & 7) * 16) = vv[i];
                float z2[16]; float mt = -3.0e38f;
#pragma unroll
                for (int q = 0; q < 16; ++q) { const bool valid = (unsigned)(dk + ((q & 7) + 16 * (q >> 3))) <= krange; z2[q] = valid ? p[q] : -INFINITY; mt = fmaxf(mt, z2[q]); }
                mt = fmaxf(mt, __shfl_xor(mt, 32));
                if (__any(mt > mrun + 8.0f)) {
                    const float mnew = fmaxf(mrun, mt); const float alpha = __builtin_amdgcn_exp2f(mrun - mnew);
                    lrun *= alpha; float al[16]; bcast_rows(alpha, sc, r32, hi, al);
#pragma unroll
                    for (int q = 0; q < 16; ++q) { o0[q] *= al[q]; o1[q] *= al[q]; }
                    mrun = mnew;
                }
                float a[16]; float ls = 0.f;
#pragma unroll
                for (int q = 0; q < 16; ++q) { a[q] = __builtin_amdgcn_exp2f(z2[q] - mrun); ls += a[q]; }
                lrun += ls;
                wave_lds_sync();
                pv_tile(o0, o1, a, wl, lane);
                wave_lds_sync();
            }
            const float ltot = lrun + __shfl_xor(lrun, 32);
            if (g != 0) {
                if (hi == 0) { ML[q0 + r * r32] = mrun; LL[q0 + r * r32] = ltot; }
#pragma unroll
                for (int q = 0; q < 16; ++q) { const int tl = q0 + r * crow(q, hi);
                    OL[tl * 64 + r32] = (unsigned short)(pkbf(o0[q], 0.f) & 0xffffu); OL[tl * 64 + 32 + r32] = (unsigned short)(pkbf(o1[q], 0.f) & 0xffffu); }
            } else {
                float il[16]; bcast_rows(1.0f / ltot, sc, r32, hi, il);
#pragma unroll
                for (int q = 0; q < 16; ++q) { o0[q] *= il[q]; o1[q] *= il[q]; }
                store_o(o0, o1, wl, OC + (rowb + t0 + q0) * 768 + 512 + j * 64, 768, lane);
            }
        }
        asm volatile("s_waitcnt lgkmcnt(0)" ::: "memory"); __builtin_amdgcn_s_barrier(); asm volatile("" ::: "memory");
    }
}
#undef ALAS
}

constexpr int NWAVES = 8;
#ifndef MK_N_LAUNCHES
#define MK_N_LAUNCHES 1
#endif
#ifndef MK_LAST_PHASE
#define MK_LAST_PHASE 8
#endif
constexpr int N_LAUNCHES = MK_N_LAUNCHES;
constexpr int PER_PHASE = 8;

constexpr int BATCH = 16, SEQ = 4096, D = 1024, T = BATCH * SEQ;
constexpr int N1 = 5888;
constexpr int NEXP = 16384;
constexpr size_t MiB = 1u << 20;
constexpr size_t WS_CTL = 0, CTL_ZERO_BYTES = 1 * MiB;
constexpr size_t WS_WIN = 2 * MiB;
constexpr size_t WS_WCAT = 16 * MiB;
constexpr size_t WS_WOUT = 18 * MiB;
constexpr size_t WS_WC = 20 * MiB;
constexpr size_t WS_RINV1 = 24 * MiB;
constexpr size_t WS_RINV2 = 25 * MiB;
constexpr size_t WS_USC = 25 * MiB + 512 * 1024, WS_VSC = 25 * MiB + 768 * 1024;
constexpr size_t WS_SSQ = 26 * MiB;
constexpr size_t WS_U8 = 32 * MiB;
constexpr size_t WS_V8 = 64 * MiB;
constexpr size_t WS_IDS = 96 * MiB;
constexpr size_t WS_GW = 112 * MiB;
constexpr size_t WS_XB = 144 * MiB;
constexpr size_t WS_OC = 880 * MiB;
constexpr size_t WS_QS = 272 * MiB, WS_KS = 336 * MiB, WS_VS = 400 * MiB;
constexpr size_t WS_QD = 464 * MiB, WS_KD = 560 * MiB, WS_VD = 656 * MiB;
constexpr size_t WS_GT = 752 * MiB;
constexpr size_t WS_COEF = 272 * MiB;
constexpr size_t WS_MIX = 272 * MiB;
constexpr size_t WS_X1B = 400 * MiB;
constexpr size_t WS_HQ = 528 * MiB;
constexpr size_t WS_HS2 = 24 * MiB + 512 * 1024;
constexpr size_t WS_XB8 = 72 * MiB;
constexpr size_t WS_WG8 = 40 * MiB;
constexpr size_t WS_PART = 56 * MiB;
constexpr size_t WS_RMAXF = 24 * MiB + 768 * 1024;
constexpr size_t WS_WOS = 46 * MiB + 512 * 1024;
constexpr size_t WS_WCS = 46 * MiB;
constexpr size_t WS_WCF = 48 * MiB;
constexpr size_t WS_XS = 24 * MiB + 256 * 1024;
constexpr size_t WS_GCS = 47 * MiB;
constexpr size_t WS_END = 1008 * MiB;
constexpr int CW_BAR = 4096;
constexpr int CW_OMAX = 28672;
constexpr int CW_RMAX = 65536;
constexpr int CW_RCNT = 131072;
constexpr int CW_WMAX = 24576;
constexpr int CW_GMAX = 16384;
constexpr int CW_XRANK = 8192;

constexpr int RING_OFF = 0, RING_BYTES = 131072;
constexpr int LDSCTL_OFF = 143360, MISC_OFF = LDSCTL_OFF + 320;
constexpr int LDS_BYTES = 147456;
static_assert(MISC_OFF + 128 <= LDS_BYTES, "LDS map");
#define GAS __attribute__((address_space(1)))
#define LAS __attribute__((address_space(3)))
typedef unsigned short bf16;
typedef unsigned v4u __attribute__((ext_vector_type(4)));
typedef float f32x4 __attribute__((ext_vector_type(4)));
typedef short bf16x8 __attribute__((ext_vector_type(8)));
typedef GAS unsigned gu32;
typedef GAS unsigned long long gu64;
#define RLX_AGENT __ATOMIC_RELAXED, __HIP_MEMORY_SCOPE_AGENT
#define LDS_WAIT() asm volatile("s_waitcnt lgkmcnt(0)" ::: "memory")
#define VM_WAIT() asm volatile("s_waitcnt vmcnt(0)" ::: "memory")
__device__ __forceinline__ unsigned long long rt() { return __builtin_amdgcn_s_memrealtime(); }
__device__ __forceinline__ unsigned f2bf(float f) { unsigned u = __builtin_bit_cast(unsigned, f); return (u + 0x7fffu + ((u >> 16) & 1u)) >> 16; }
__device__ __forceinline__ unsigned pk2(float lo, float hi) { return f2bf(lo) | (f2bf(hi) << 16); }

#define XB_TMO      128
#define XB_XCNT(j)  (256  + 64 * (j))
#define XB_XSUB(j)  (1280 + 64 * (j))
#define XB_XGEN(j)  (2304 + 64 * (j))
#define XB_TOP      3328
#define XB_TOPGEN   3392
#define XCD_BAR_WORDS 3456
#define XB_SPIN_CAP (1u << 18)

__device__ __forceinline__ unsigned xb_ld(unsigned* p)              { return __hip_atomic_load(p, __ATOMIC_RELAXED, __HIP_MEMORY_SCOPE_AGENT); }
__device__ __forceinline__ unsigned xb_add(unsigned* p, unsigned v) { return __hip_atomic_fetch_add(p, v, __ATOMIC_RELAXED, __HIP_MEMORY_SCOPE_AGENT); }
__device__ __forceinline__ unsigned xb_xcc_id() { return (unsigned)__builtin_amdgcn_s_getreg((3 << 11) | 20) & 0xFu; }
#define XB_SPIN(cond, bar) do { unsigned _sp = 0; while (cond) { __builtin_amdgcn_s_sleep(1); \
    if ((++_sp & 255u) == 0u) { if (xb_ld(&(bar)[XB_TMO])) break; if (_sp > XB_SPIN_CAP) { atomicAdd(&(bar)[XB_TMO], 1u); break; } } } } while (0)

struct XcdBarrier {
    unsigned* bar; unsigned x;
    volatile LAS unsigned* st;
};

__device__ __forceinline__ XcdBarrier xcd_barrier_post(unsigned* bar, volatile LAS unsigned* st) {
    XcdBarrier b; b.bar = bar; b.x = xb_xcc_id(); b.st = st;
    if (threadIdx.x == 0) (void)xb_add(&bar[XB_XCNT(b.x)], 1u);
    return b;
}
__device__ __forceinline__ void xcd_barrier_complete(unsigned* bar, unsigned x, unsigned& nloc, unsigned& nx) {
    const unsigned G = gridDim.x * gridDim.y * gridDim.z;
    unsigned sum, cnt, mine, sp = 0u;
    for (;;) {
        sum = 0u; cnt = 0u; mine = 0u;
#pragma unroll
        for (unsigned j = 0; j < 16; ++j) { const unsigned c = xb_ld(&bar[XB_XCNT(j)]); sum += c; cnt += (c > 0u) ? 1u : 0u; mine = (j == x) ? c : mine; }
        if (sum == G) break;
        __builtin_amdgcn_s_sleep(1);
        if ((++sp & 255u) == 0u) { if (xb_ld(&bar[XB_TMO])) break; if (sp > XB_SPIN_CAP) { atomicAdd(&bar[XB_TMO], 1u); break; } }
    }
    nloc = mine > 0u ? mine : 1u; nx = cnt > 0u ? cnt : 1u;
}

__device__ __forceinline__ void xcd_barrier(const XcdBarrier& b) {
    asm volatile("s_waitcnt vmcnt(0)" ::: "memory");
    __syncthreads();
    if (threadIdx.x == 0) {
        unsigned* bar = b.bar;
        __builtin_amdgcn_s_waitcnt(0);
        unsigned nloc = b.st[0], nx = b.st[1];
        if (nloc == 0u) { xcd_barrier_complete(bar, b.x, nloc, nx); b.st[0] = nloc; b.st[1] = nx; }
        const unsigned old = xb_add(&bar[XB_XSUB(b.x)], 1u);
        const unsigned gen = old / nloc;
        if (old + 1u == (gen + 1u) * nloc) {
            __builtin_amdgcn_fence(__ATOMIC_RELEASE, "agent");
            asm volatile("s_waitcnt vmcnt(0)" ::: "memory");
            const unsigned og = xb_add(&bar[XB_TOP], 1u);
            const unsigned tg = og / nx;
            if (og + 1u == (tg + 1u) * nx) xb_add(&bar[XB_TOPGEN], 1u);
            else XB_SPIN(xb_ld(&bar[XB_TOPGEN]) == tg, bar);
            __builtin_amdgcn_fence(__ATOMIC_ACQUIRE, "agent");
            xb_add(&bar[XB_XGEN(b.x)], 1u);
            asm volatile("s_waitcnt vmcnt(0)" ::: "memory");
        } else {
            XB_SPIN(xb_ld(&bar[XB_XGEN(b.x)]) == gen, bar);
            __builtin_amdgcn_fence(__ATOMIC_ACQUIRE, "agent");
            asm volatile("s_waitcnt vmcnt(0)" ::: "memory");
        }
    }
    __syncthreads();
}

typedef float f32x2 __attribute__((ext_vector_type(2)));
typedef unsigned v2u __attribute__((ext_vector_type(2)));
typedef int v4i __attribute__((ext_vector_type(4)));
typedef int v8i __attribute__((ext_vector_type(8)));
typedef _Float16 h2_t __attribute__((ext_vector_type(2)));
struct Frame {
    LAS unsigned char* lds;
    volatile LAS unsigned* MISC;
    gu32* ctl;
    int tid, lane, wave;
    int vcu, G;
};
__device__ __forceinline__ float wave_sum(float v) {
#pragma unroll
    for (int o = 1; o < 64; o <<= 1) v += __shfl_xor(v, o);
    return v;
}
__device__ __forceinline__ float wave_max(float v) {
#pragma unroll
    for (int o = 1; o < 64; o <<= 1) v = fmaxf(v, __shfl_xor(v, o));
    return v;
}
constexpr int NB16 = 0, N8 = 5888 - NB16;
__device__ __forceinline__ int win_row(int n) { if (n < 1536 || n >= 3072) return n; const int t = (n - 1536) >> 8, ln = (n - 1536) & 255, hl = ln >> 6, d = ln & 63; return 1536 + t * 256 + 32 * hl + (d & 31) + 128 * (d >> 5); }
__device__ __forceinline__ void p0_transpose_item(const float* W, int N, const float* gain, bf16* WT, int ldt, int koff, int mode, LAS float* scr, int item, int lane) {
    const int nblk = N / 32, kb = item / nblk, nb = item % nblk, k0 = 64 * kb, n0 = 32 * nb;
#pragma unroll 8
    for (int i = 0; i < 32; ++i) { const int kk = 2 * i + (lane >> 5); float v = W[(size_t)(k0 + kk) * N + n0 + (lane & 31)]; if (gain) v *= gain[k0 + kk]; scr[kk * 33 + (lane & 31)] = v; }
    LDS_WAIT(); asm volatile("" ::: "memory");
    const int c = lane & 7;
#pragma unroll
    for (int j = 0; j < 4; ++j) { const int n = (lane >> 3) + 8 * j; const LAS float* s = scr + (8 * c) * 33 + n;
        v4u o; o.x = pk2(s[0 * 33], s[1 * 33]); o.y = pk2(s[2 * 33], s[3 * 33]); o.z = pk2(s[4 * 33], s[5 * 33]); o.w = pk2(s[6 * 33], s[7 * 33]);
        const int rown = mode ? win_row(n0 + n) : (n0 + n);
        *(GAS v4u*)(WT + (size_t)rown * ldt + koff + k0 + 8 * c) = o; }
    LDS_WAIT(); asm volatile("" ::: "memory");
}
__device__ __forceinline__ void p0_gate_max_item(const float* W, int N, const float* gain, unsigned* gmax, int kb, int n0, int lane) {
    const int k0 = 64 * kb; float am = 0.f;
#pragma unroll 8
    for (int i = 0; i < 32; ++i) { const int kk = 2 * i + (lane >> 5); am = fmaxf(am, fabsf(W[(size_t)(k0 + kk) * N + n0 + (lane & 31)] * (gain ? gain[k0 + kk] : 1.0f))); }
    am = fmaxf(am, __shfl_xor(am, 32));
    if (lane < 32) atomicMax(gmax + (n0 - NB16) + lane, __float_as_uint(am));
}
__device__ __forceinline__ void p0_gate_fp8_item(const float* W, int N, const float* gain, const unsigned* gmax, unsigned char* WG, float* cs, LAS float* scr, int item, int lane, int ncols = N8, bool perm = true) {
    const int kb = item / (ncols / 32), nb = item % (ncols / 32), k0 = 64 * kb, n0 = 32 * nb;
#pragma unroll 8
    for (int i = 0; i < 32; ++i) { const int kk = 2 * i + (lane >> 5); scr[kk * 33 + (lane & 31)] = W[(size_t)(k0 + kk) * N + NB16 + n0 + (lane & 31)] * (gain ? gain[k0 + kk] : 1.0f); }
    LDS_WAIT(); asm volatile("" ::: "memory");
    const int c = lane & 7;
#pragma unroll
    for (int j = 0; j < 4; ++j) { const int n = (lane >> 3) + 8 * j; const LAS float* sp = scr + (8 * c) * 33 + n;
        const float am = __uint_as_float(xb_ld((unsigned*)gmax + n0 + n)); const float sc = am > 0.f ? 127.0f / am : 0.f;
        unsigned p0 = 0, p1 = 0;
#pragma unroll
        for (int e = 0; e < 4; ++e) { p0 |= ((unsigned)(int)__builtin_rintf(sp[e * 33] * sc) & 0xffu) << (8 * e); p1 |= ((unsigned)(int)__builtin_rintf(sp[(4 + e) * 33] * sc) & 0xffu) << (8 * e); }
        const int prow = perm ? win_row(NB16 + n0 + n) - NB16 : n0 + n;
        *(GAS v2u*)(WG + (size_t)prow * 1024 + k0 + 8 * c) = (v2u){p0, p1};
        if (kb == 0 && c == 0) cs[prow] = am * (1.0f / 127.0f); }
    LDS_WAIT(); asm volatile("" ::: "memory");
}
__device__ __forceinline__ void quant_row_fp8(const float* src, const float* gain, unsigned char* dst, size_t slice_stride, float* scale_out, int lane) {
    f32x4 v[4]; float am = 0.f;
#pragma unroll
    for (int j = 0; j < 4; ++j) { v[j] = *(const GAS f32x4*)(src + 256 * j + 4 * lane); if (gain) v[j] = v[j] * *(const GAS f32x4*)(gain + 256 * j + 4 * lane);
        am = fmaxf(am, fmaxf(fmaxf(fabsf(v[j][0]), fabsf(v[j][1])), fmaxf(fabsf(v[j][2]), fabsf(v[j][3])))); }
    am = wave_max(am);
    const int ex = (int)((__float_as_uint(am) >> 23) & 0xffu);
    const float s = (ex == 0) ? 1.0f : __uint_as_float((unsigned)(127 + 7 - (ex - 127)) << 23);
    const float is = (ex == 0) ? 1.0f : __uint_as_float((unsigned)(127 - 7 + (ex - 127)) << 23);
    if (lane == 0) *scale_out = is;
#pragma unroll
    for (int j = 0; j < 4; ++j) { int pk = __builtin_amdgcn_cvt_pk_fp8_f32(v[j][0] * s, v[j][1] * s, 0, false); pk = __builtin_amdgcn_cvt_pk_fp8_f32(v[j][2] * s, v[j][3] * s, pk, true);
        const int col = 256 * j + 4 * lane; *(GAS int*)(dst + (size_t)(col >> 7) * slice_stride + (col & 127)) = pk; }
}
__device__ __forceinline__ void quant_row_i4v(const float* src, unsigned char* dst, size_t slice_stride, float* scale_out, int lane) {
    f32x4 v[4]; float am = 0.f, ss = 0.f;
#pragma unroll
    for (int i = 0; i < 4; ++i) { const f32x4 t = *(const GAS f32x4*)(src + 16 * lane + 4 * i); v[i] = t;
        am = fmaxf(am, fmaxf(fmaxf(fabsf(t[0]), fabsf(t[1])), fmaxf(fabsf(t[2]), fabsf(t[3])))); ss += (t[0] * t[0] + t[1] * t[1]) + (t[2] * t[2] + t[3] * t[3]); }
    am = wave_max(am); ss = wave_sum(ss);
    const float clipv = fminf(am, 2.75f * sqrtf(ss * (1.0f / 1024.0f)));
    const float s = clipv > 0.f ? 7.0f / clipv : 0.f;
    if (lane == 0) *scale_out = clipv * (1.0f / (7.0f * 16.0f));
    unsigned pk[2];
#pragma unroll
    for (int d = 0; d < 2; ++d) { pk[d] = 0u;
#pragma unroll
        for (int n8 = 0; n8 < 8; ++n8) { int q0 = (int)__builtin_rintf(v[2 * d + (n8 >> 2)][n8 & 3] * s); q0 = q0 < -7 ? -7 : (q0 > 7 ? 7 : q0); pk[d] |= (unsigned)(q0 & 15) << (4 * n8); } }
    *(GAS v2u*)(dst + (size_t)(lane >> 4) * slice_stride + 8 * (lane & 15)) = (v2u){pk[0], pk[1]};
}
__device__ __forceinline__ void quant_row_fp4(const float* src, unsigned char* dst, size_t slice_stride, float* scale_out, int lane) {
    f32x4 v[4]; float am = 0.f;
#pragma unroll
    for (int j = 0; j < 4; ++j) { v[j] = *(const GAS f32x4*)(src + 256 * j + 4 * lane); am = fmaxf(am, fmaxf(fmaxf(fabsf(v[j][0]), fabsf(v[j][1])), fmaxf(fabsf(v[j][2]), fabsf(v[j][3])))); }
    am = wave_max(am);
    const float s = am > 0.f ? 6.0f / am : 0.f;
    if (lane == 0) *scale_out = am * (1.0f / 6.0f);
#pragma unroll
    for (int j = 0; j < 4; ++j) { unsigned pk = __builtin_amdgcn_cvt_scalef32_pk_fp4_f32(0u, v[j][0] * s, v[j][1] * s, 1.0f, 0); pk = __builtin_amdgcn_cvt_scalef32_pk_fp4_f32(pk, v[j][2] * s, v[j][3] * s, 1.0f, 1);
        *(GAS unsigned short*)(dst + (size_t)j * slice_stride + 2 * lane) = (unsigned short)(pk & 0xffffu); }
}
__device__ __forceinline__ void quant_row_i4(const float* src, const float* gain, unsigned char* dst, float* scale_out, int lane) {
    f32x4 v[4]; float am = 0.f, ss = 0.f;
    const int p16 = (lane >> 2) & 15, wl = lane & 3;
#pragma unroll
    for (int ld = 0; ld < 2; ++ld)
#pragma unroll
        for (int sn = 0; sn < 2; ++sn) { const int hd = 2 * (4 * ld + wl) + sn; const int idx = 256 * (hd >> 2) + 16 * p16 + 4 * (hd & 3);
            f32x4 t = *(const GAS f32x4*)(src + idx); if (gain) t = t * *(const GAS f32x4*)(gain + idx); v[2 * ld + sn] = t;
            am = fmaxf(am, fmaxf(fmaxf(fabsf(t[0]), fabsf(t[1])), fmaxf(fabsf(t[2]), fabsf(t[3])))); ss += (t[0] * t[0] + t[1] * t[1]) + (t[2] * t[2] + t[3] * t[3]); }
    am = wave_max(am); ss = wave_sum(ss);
    const float clipv = fminf(am, 2.5f * sqrtf(ss * (1.0f / 1024.0f)));
    const float s = clipv > 0.f ? 7.0f / clipv : 0.f;
    if (lane == 0) *scale_out = clipv * (1.0f / (7.0f * 16.0f));
#pragma unroll
    for (int ld = 0; ld < 2; ++ld) { unsigned pk = 0u;
#pragma unroll
        for (int b4 = 0; b4 < 4; ++b4) { int q0 = (int)__builtin_rintf(v[2 * ld][b4] * s), q1 = (int)__builtin_rintf(v[2 * ld + 1][b4] * s);
            q0 = q0 < -7 ? -7 : (q0 > 7 ? 7 : q0); q1 = q1 < -7 ? -7 : (q1 > 7 ? 7 : q1);
            pk |= ((unsigned)(q0 & 15) | ((unsigned)(q1 & 15) << 4)) << (8 * b4); }
        *(GAS unsigned*)(dst + ld * 256 + 16 * p16 + 4 * wl) = pk; }
}
__device__ __forceinline__ float gelu_f(float v) {
    const float av = fabsf(v), t = __builtin_amdgcn_rcpf(av * 0.2316418882f + 1.0f);
    float q = t * 0.5307027145f + (-0.7265760135f); q = q * t + 0.7107068705f; q = q * t + (-0.142248368f); q = q * t + 0.127414796f; q = q * t;
    const float e = __builtin_amdgcn_exp2f((v * v) * (-0.72134752044f));
    const float m = v * (q * e);
    return v < 0.f ? m : v - m;
}

struct Args { const float* in[14]; float* out; unsigned char* ws; int ph_lo, ph_hi, li, pad; };
__global__ void __launch_bounds__(NWAVES * 64, 2) fwd_kernel(Args args) {
    extern __shared__ __attribute__((aligned(16))) unsigned char lds[];
    Frame F;
    F.lds = (LAS unsigned char*)lds;
    F.MISC = (volatile LAS unsigned*)(F.lds + MISC_OFF);
    F.tid = threadIdx.x; F.lane = F.tid & 63; F.wave = __builtin_amdgcn_readfirstlane(F.tid >> 6);
    F.G = gridDim.x; { const int bx = blockIdx.x; F.vcu = (F.G % 8 == 0) ? (bx % 8) * (F.G / 8) + bx / 8 : bx; }
    unsigned char* ws = args.ws;
    F.ctl = (gu32*)(ws + WS_CTL);
    const float* x = args.in[0]; const float* norm1_gain = args.in[1]; const float* w_in = args.in[2]; const float* b_gate = args.in[3];
    const float* q_gain = args.in[4]; const float* k_gain = args.in[5]; const float* w_sb_out = args.in[6]; const float* w_dil_out = args.in[7];
    const float* w_out = args.in[8]; const float* norm2_gain = args.in[9]; const float* w_peer_q = args.in[10]; const float* sub_keys = args.in[11];
    const float* peer_u = args.in[12]; const float* peer_v = args.in[13];
    float* out = args.out;
    bf16* WIN = (bf16*)(ws + WS_WIN); bf16* WCAT = (bf16*)(ws + WS_WCAT); bf16* WOUT = (bf16*)(ws + WS_WOUT); bf16* WC = (bf16*)(ws + WS_WC);
    float* RINV1 = (float*)(ws + WS_RINV1); float* RINV2 = (float*)(ws + WS_RINV2); float* USC = (float*)(ws + WS_USC); float* VSC = (float*)(ws + WS_VSC); float* SSQ = (float*)(ws + WS_SSQ);
    unsigned char* U8 = ws + WS_U8; unsigned char* V8 = ws + WS_V8;
    unsigned short* IDS = (unsigned short*)(ws + WS_IDS); float* GW = (float*)(ws + WS_GW); unsigned short* COEF = (unsigned short*)(ws + WS_COEF); unsigned char* HQ = ws + WS_HQ; unsigned char* WC8 = ws + WS_WC; unsigned char* WOUT8 = ws + WS_WOUT; float* WOS = (float*)(ws + WS_WOS); float* RMAXF = (float*)(ws + WS_RMAXF); unsigned char* MIX8 = ws + WS_MIX; float* WCF = (float*)(ws + WS_WCF); float* WCS = (float*)(ws + WS_WCS); float* HS2 = (float*)(ws + WS_HS2);
    bf16* XB = (bf16*)(ws + WS_XB); bf16* OC = (bf16*)(ws + WS_OC); unsigned char* XB8 = ws + WS_XB8; unsigned char* WG8 = ws + WS_WG8; float* GCS = (float*)(ws + WS_GCS); float* XS = (float*)(ws + WS_XS);
    bf16* QS = (bf16*)(ws + WS_QS); bf16* KS = (bf16*)(ws + WS_KS); bf16* VS = (bf16*)(ws + WS_VS);
    bf16* QD = (bf16*)(ws + WS_QD); bf16* KD = (bf16*)(ws + WS_KD); bf16* VD = (bf16*)(ws + WS_VD);
    unsigned char* GT = ws + WS_GT; bf16* MIX = (bf16*)(ws + WS_MIX); bf16* X1B = (bf16*)(ws + WS_X1B);

    for (int u = F.tid; u < (LDS_BYTES - LDSCTL_OFF) / 4; u += NWAVES * 64) ((LAS unsigned*)(F.lds + LDSCTL_OFF))[u] = 0u;
    __syncthreads();
    const int my_xcc = (int)xb_xcc_id();
    if (F.tid == 0) F.MISC[12] = xb_add((unsigned*)(F.ctl + CW_XRANK) + 64 * my_xcc, 1u);
    __syncthreads();
    const int my_xrank = (int)F.MISC[12];
    const int bli = (N_LAUNCHES == PER_PHASE) ? 0 : args.li;
    XcdBarrier bar; bar.bar = (unsigned*)(F.ctl + CW_BAR) + bli * XCD_BAR_WORDS; bar.x = 0; bar.st = nullptr;
    if (N_LAUNCHES != PER_PHASE) bar = xcd_barrier_post((unsigned*)(F.ctl + CW_BAR) + bli * XCD_BAR_WORDS, F.MISC + 8);
    const int lo = args.ph_lo, hi = args.ph_hi;
#ifndef PHASE_MASK
#define PHASE_MASK 0xff
#endif
#define IN(k) (((PHASE_MASK >> (k)) & 1) && lo <= (k) && (k) < hi)
#define BOTH(k) (IN(k) && IN((k) + 1))
#define GRID_BAR() do { if (N_LAUNCHES != PER_PHASE) xcd_barrier(bar); } while (0)
#ifndef PROBE_REPEAT
#define PROBE_REPEAT 0x00
#endif
#ifndef PROBE_L1
#define PROBE_L1 0x0
#endif
#define REP(k) _Pragma("unroll") for (int rep_ = 0; rep_ < (((PROBE_REPEAT >> (k)) & 1) ? 2 : 1); ++rep_)
    const int gw = F.vcu * NWAVES + F.wave, NGW = F.G * NWAVES;
#define P67_MAP() int vx = (int)(blockIdx.x & 7), rk = (int)(blockIdx.x >> 3), nrk = (F.G + 7 - vx) / 8; bool p67_uni = false; \
        { bool uni_ = (F.G % 8 == 0); for (int j_ = 0; j_ < 16; ++j_) { const unsigned c_ = xb_ld((unsigned*)(F.ctl + CW_XRANK) + 64 * j_); uni_ = uni_ && (c_ == (j_ < 8 ? (unsigned)(F.G / 8) : 0u)); } \
          if (uni_) { vx = my_xcc; rk = my_xrank; nrk = F.G / 8; p67_uni = true; } }

    if (IN(0)) REP(0) {
        for (int it = F.vcu; it < 256; it += F.G) {
            const int hp = it >> 4, d0 = (it & 15) * 64;
            LAS float* As = (LAS float*)(F.lds);
            LAS float* Bs = (LAS float*)(F.lds + 64 * 132 * 4);
            for (int e = F.tid; e < 64 * 32; e += 512) { const int r = e >> 5, c4 = (e & 31) * 4; *(LAS f32x4*)(As + r * 132 + c4) = *(const GAS f32x4*)(w_peer_q + (size_t)(d0 + r) * 2048 + hp * 128 + c4); }
            for (int e = F.tid; e < 128 * 32; e += 512) { const int r = e >> 5, c4 = (e & 31) * 4; *(LAS f32x4*)(Bs + r * 132 + c4) = *(const GAS f32x4*)(sub_keys + ((size_t)hp * 128 + r) * 128 + c4); }
            __syncthreads();
            const int ddg = F.tid & 15, ng = F.tid >> 4;
            f32x4 acc[4];
#pragma unroll
            for (int j = 0; j < 4; ++j) acc[j] = (f32x4){0.f, 0.f, 0.f, 0.f};
            for (int c4 = 0; c4 < 128; c4 += 4) {
                f32x4 a[4], b[4];
#pragma unroll
                for (int i = 0; i < 4; ++i) { a[i] = *(const LAS f32x4*)(As + (4 * ddg + i) * 132 + c4); b[i] = *(const LAS f32x4*)(Bs + (4 * ng + i) * 132 + c4); }
#pragma unroll
                for (int j = 0; j < 4; ++j)
#pragma unroll
                    for (int i = 0; i < 4; ++i) acc[j][i] += (a[i][0] * b[j][0] + a[i][1] * b[j][1]) + (a[i][2] * b[j][2] + a[i][3] * b[j][3]);
            }
            const f32x4 g2 = *(const GAS f32x4*)(norm2_gain + d0 + 4 * ddg);
#pragma unroll
            for (int j = 0; j < 4; ++j) { const f32x4 o = acc[j] * g2;
                *(GAS f32x4*)(WCF + (size_t)(hp * 128 + 4 * ng + j) * 1024 + d0 + 4 * ddg) = o;
                float am = fmaxf(fmaxf(fabsf(o[0]), fabsf(o[1])), fmaxf(fabsf(o[2]), fabsf(o[3])));
                am = fmaxf(am, __shfl_xor(am, 1)); am = fmaxf(am, __shfl_xor(am, 2)); am = fmaxf(am, __shfl_xor(am, 4)); am = fmaxf(am, __shfl_xor(am, 8));
                if (ddg == 0) atomicMax((unsigned*)(F.ctl + CW_WMAX) + hp * 128 + 4 * ng + j, __float_as_uint(am)); }
            __syncthreads();
        }
        {
            LAS float* scr = (LAS float*)(F.lds + RING_OFF + F.wave * 16384);
            constexpr int I_IN = (D / 64) * (N1 / 32), I_SB = (512 / 64) * (D / 32), I_DL = (256 / 64) * (D / 32), I_OUT = (D / 64) * (D / 32);
            constexpr int NITEMS = I_IN + I_SB + I_DL + I_OUT;
            for (int it = gw; it < NITEMS; it += NGW) {
                int r = it;
                if (r < I_IN) { const int nb_ = r % (N1 / 32); p0_gate_max_item(w_in, N1, norm1_gain, (unsigned*)(F.ctl + CW_GMAX), r / (N1 / 32), 32 * nb_, F.lane); continue; } r -= I_IN;
                if (r < I_SB) { p0_transpose_item(w_sb_out, D, nullptr, WCAT, 768, 0, 0, scr, r, F.lane); continue; } r -= I_SB;
                if (r < I_DL) { p0_transpose_item(w_dil_out, D, nullptr, WCAT, 768, 512, 0, scr, r, F.lane); continue; } r -= I_DL;
                p0_gate_max_item(w_out, D, nullptr, (unsigned*)(F.ctl + CW_OMAX), r / (D / 32), 32 * (r % (D / 32)), F.lane);
            }
        }
        for (int e = gw; e < 2 * NEXP; e += NGW) {
            if (e < NEXP) quant_row_i4(peer_u + (size_t)e * D, norm2_gain, U8 + (size_t)e * 512, USC + e, F.lane);
            else { const int ev = e - NEXP; quant_row_fp4(peer_v + (size_t)ev * D, V8 + (size_t)ev * 128, (size_t)NEXP * 128, VSC + ev, F.lane); }
        }
        for (int m = gw; m < T; m += NGW) {
            const GAS f32x4* xr = (const GAS f32x4*)(x + (size_t)m * D) + F.lane;
            f32x4 v[4]; float s = 0.f;
#pragma unroll
            for (int j = 0; j < 4; ++j) { v[j] = xr[64 * j]; s += (v[j][0] * v[j][0] + v[j][1] * v[j][1]) + (v[j][2] * v[j][2] + v[j][3] * v[j][3]); }
            s = wave_sum(s);
            const float rn = __builtin_amdgcn_rsqf(s * (1.0f / D) + 1e-6f);
            if (F.lane == 0) RINV1[m] = 1.0f / rn;
            GAS unsigned long long* o8 = (GAS unsigned long long*)(XB + (size_t)m * D) + F.lane;
#pragma unroll
            for (int j = 0; j < 4; ++j) o8[64 * j] = (unsigned long long)pk2(v[j][0] * rn, v[j][1] * rn) | ((unsigned long long)pk2(v[j][2] * rn, v[j][3] * rn) << 32);
            float am = 0.f;
#pragma unroll
            for (int j = 0; j < 4; ++j) am = fmaxf(am, fmaxf(fmaxf(fabsf(v[j][0]), fabsf(v[j][1])), fmaxf(fabsf(v[j][2]), fabsf(v[j][3]))));
            am = wave_max(am) * rn;
            const float qs = am > 0.f ? 127.0f / am * rn : 0.f;
            if (F.lane == 0) XS[m] = am * (1.0f / 127.0f);
#pragma unroll
            for (int j = 0; j < 4; ++j) { const unsigned pk = ((unsigned)(int)__builtin_rintf(v[j][0] * qs) & 0xffu) | (((unsigned)(int)__builtin_rintf(v[j][1] * qs) & 0xffu) << 8) | (((unsigned)(int)__builtin_rintf(v[j][2] * qs) & 0xffu) << 16) | (((unsigned)(int)__builtin_rintf(v[j][3] * qs) & 0xffu) << 24);
                *(GAS unsigned*)(XB8 + (size_t)m * D + 256 * j + 4 * F.lane) = pk; }
        }
        if (BOTH(0)) GRID_BAR();
    }

    if (IN(1)) REP(1) {
        { LAS float* scr = (LAS float*)(F.lds + RING_OFF + F.wave * 16384);
          for (int it = gw; it < 16 * (N8 / 32); it += NGW) p0_gate_fp8_item(w_in, N1, norm1_gain, (const unsigned*)(F.ctl + CW_GMAX), WG8, GCS, scr, it, F.lane);
          for (int it = gw; it < 16 * (D / 32); it += NGW) p0_gate_fp8_item(w_out, D, nullptr, (const unsigned*)(F.ctl + CW_OMAX), WOUT8, WOS, scr, it, F.lane, D, false);
          for (int r = gw; r < 2048; r += NGW) {
              const float am = __uint_as_float(xb_ld((unsigned*)(F.ctl + CW_WMAX) + r)); const float sc = am > 0.f ? 127.0f / am : 0.f;
              unsigned w[4];
#pragma unroll
              for (int j = 0; j < 4; ++j) { const f32x4 v = *(const GAS f32x4*)(WCF + (size_t)r * 1024 + 16 * F.lane + 4 * j);
                  w[j] = ((unsigned)(int)__builtin_rintf(v[0] * sc) & 0xffu) | (((unsigned)(int)__builtin_rintf(v[1] * sc) & 0xffu) << 8) | (((unsigned)(int)__builtin_rintf(v[2] * sc) & 0xffu) << 16) | (((unsigned)(int)__builtin_rintf(v[3] * sc) & 0xffu) << 24); }
              *(GAS v4u*)(WC8 + (size_t)r * 1024 + 16 * F.lane) = (v4u){w[0], w[1], w[2], w[3]};
              if (F.lane == 0) WCS[r] = am * (1.0f / 127.0f); }
          __syncthreads(); }
        GRID_BAR();
        { pg8::Gemm g{(const bf16*)XB8, (const bf16*)WG8, T, N8, D / 2}; pg8::StaticOrder S; S.init(T, N8, F.G, (int)blockIdx.x);
          pg8::EpiG E{b_gate, GCS, XS, q_gain, k_gain, QS, KS, VS, QD, KD, VD, GT};
          pg8::gemm_phase<pg8::EpiG, pg8::StaticOrder, true, true, false, true>(F.lds + RING_OFF, g, S, E); }
        if (BOTH(1)) GRID_BAR();
    }

    if (IN(2)) REP(2) {
        LAS unsigned char* wl = F.lds + RING_OFF + F.wave * 16384;
        static_assert(att::DLU_BYTES <= RING_BYTES, "dilated-attention LDS state");
        for (int un = F.vcu; un < 512; un += F.G) { const int blk = un & 7, j = (un >> 3) & 3, b = un >> 5; att::dl_unit(QD, KD, VD, OC, b, j, blk, F.lds + RING_OFF, F.wave, F.lane); }
        for (int it = gw; it < 16384; it += NGW) { const int qt = 127 - (it & 127), h = (it >> 7) & 7, b = it >> 10; att::sb_item(QS, KS, VS, OC, b, h, qt, wl, F.lane); }
        if (BOTH(2)) GRID_BAR();
    }

    if (IN(3)) REP(3) {
        pg8::Gemm g{OC, WCAT, T, D, 768}; pg8::StaticOrder S; S.init(T, D, F.G, (int)blockIdx.x);
        pg8::Epi2 E{GT, MIX8, (unsigned*)(ws + WS_PART), (unsigned*)(F.ctl + CW_RCNT), RMAXF, F.lds + RING_OFF + RING_BYTES};
        pg8::gemm_phase<pg8::Epi2, pg8::StaticOrder, true, true>(F.lds + RING_OFF, g, S, E);
        if (BOTH(3)) GRID_BAR();
    }

    if (IN(4)) REP(4) {
        pg8::Gemm g{(const bf16*)MIX8, (const bf16*)WOUT8, T, D, D / 2}; pg8::StaticOrder S; S.init(T, D, F.G, (int)blockIdx.x);
        pg8::Epi3 E{XB, RINV1, (const unsigned*)RMAXF, WOS, X1B, SSQ};
        pg8::gemm_phase<pg8::Epi3, pg8::StaticOrder, true, true, false, true>(F.lds + RING_OFF, g, S, E);
        if (BOTH(4)) GRID_BAR();
    }

    if (IN(5)) REP(5) {
        for (int m = gw; m < T; m += NGW) {
            const v4u a = *(const GAS v4u*)(X1B + (size_t)m * D + 8 * F.lane), b = *(const GAS v4u*)(X1B + (size_t)m * D + 512 + 8 * F.lane);
            float v[16] = {pg8::bflo(a.x), pg8::bfhi(a.x), pg8::bflo(a.y), pg8::bfhi(a.y), pg8::bflo(a.z), pg8::bfhi(a.z), pg8::bflo(a.w), pg8::bfhi(a.w),
                           pg8::bflo(b.x), pg8::bfhi(b.x), pg8::bflo(b.y), pg8::bfhi(b.y), pg8::bflo(b.z), pg8::bfhi(b.z), pg8::bflo(b.w), pg8::bfhi(b.w)};
            float am = 0.f;
#pragma unroll
            for (int i = 0; i < 16; ++i) am = fmaxf(am, fabsf(v[i]));
            am = wave_max(am);
            float sq = (F.lane < 16) ? SSQ[(size_t)m * 16 + F.lane] : 0.f; sq = wave_sum(sq);
            const float s = am > 0.f ? 127.0f / am : 0.f;
            if (F.lane == 0) HS2[m] = am * (1.0f / 127.0f) * __builtin_amdgcn_rsqf(sq * (1.0f / 1024.0f) + 1e-6f);
            int q[16];
#pragma unroll
            for (int i = 0; i < 16; ++i) q[i] = (int)__builtin_rintf(v[i] * s) & 0xff;
            v2u o0, o1; o0.x = q[0] | (q[1] << 8) | (q[2] << 16) | (q[3] << 24); o0.y = q[4] | (q[5] << 8) | (q[6] << 16) | (q[7] << 24);
            o1.x = q[8] | (q[9] << 8) | (q[10] << 16) | (q[11] << 24); o1.y = q[12] | (q[13] << 8) | (q[14] << 16) | (q[15] << 24);
            *(GAS v2u*)(HQ + (size_t)m * D + 8 * F.lane) = o0; *(GAS v2u*)(HQ + (size_t)m * D + 512 + 8 * F.lane) = o1;
        }
        GRID_BAR();
        pg8::Gemm g{(const bf16*)HQ, (const bf16*)WC8, T, 2048, D / 2}; pg8::StaticOrder S; S.init(T, 2048, F.G, (int)blockIdx.x);
        pg8::Epi4 E{SSQ, RINV2, IDS, GW, HS2, WCS};
        pg8::OneUnit O1;
        for (int i = 0; S.next(i, O1.u); ++i) pg8::gemm_phase<pg8::Epi4, pg8::OneUnit, false, true, false, true>(F.lds + RING_OFF, g, O1, E);
        if (BOTH(5)) GRID_BAR();
    }

    if (IN(6)) REP(6) {
        P67_MAP();
        const int p16 = F.lane & 15, sg = F.lane >> 4;
        LAS unsigned char* HB = F.lds + RING_OFF + F.wave * 16384;
        LAS unsigned* LIST = (LAS unsigned*)(F.lds + RING_OFF + F.wave * 16384 + 8192);
        LAS float* HSs = (LAS float*)(F.lds + RING_OFF + F.wave * 16384 + 12288);
        const int nwb = T / 8, wstep = nrk * NWAVES;
        const int gsel = (F.lane & 15), bpsrc = (16 * (F.lane & 3) + ((F.lane >> 2) & 3)) * 4;
        v4u hpre[8], idpre[2]; float hspre = 0.f;
#define P6_PRE(bb) do { const int bc_ = (bb) < nwb ? (bb) : nwb - 1; const unsigned char* hsrc_ = HQ + (size_t)bc_ * 8192; \
            _Pragma("unroll") for (int i_ = 0; i_ < 8; ++i_) hpre[i_] = *(const GAS v4u*)(hsrc_ + (size_t)(i_ * 64 + F.lane) * 16); \
            const unsigned short* isrc_ = IDS + ((size_t)bc_ * 8 + (F.lane >> 3)) * 128 + 16 * (F.lane & 7); idpre[0] = *(const GAS v4u*)isrc_; idpre[1] = *(const GAS v4u*)(isrc_ + 8); \
            hspre = HS2[(size_t)bc_ * 8 + (F.lane & 7)]; } while (0)
#define P6_ISSUE(W, ENT, EJ, GB, UB, VB, base_) do { \
                _Pragma("unroll") for (int g_ = 0; g_ < 4; ++g_) { const int j_ = (base_) + 4 * g_ + sg; ENT[g_] = LIST[j_ < n ? j_ : nm1]; } \
                { const int j_ = (base_) + gsel; EJ = (j_ < n && F.lane < 16) ? (int)LIST[j_] : -1; } \
                _Pragma("unroll") for (int g_ = 0; g_ < 4; ++g_) { const unsigned char* up_ = U8 + (size_t)((PROBE_L1 && rep_) ? 0u : (ENT[g_] & 0xffffu)) * 512 + 16 * p16; \
                    _Pragma("unroll") for (int i_ = 0; i_ < 2; ++i_) W[g_][i_] = *(const GAS v4u*)(up_ + 256 * i_); } \
                { const unsigned ej_ = EJ < 0 ? 0u : (unsigned)EJ; GB = GW[((size_t)t0 + (ej_ >> 24)) * 128 + ((ej_ >> 16) & 127u)]; UB = USC[ej_ & 0xffffu]; VB = VSC[ej_ & 0xffffu]; } } while (0)
#define P6_DPPADD(a_, ctrl) a_ += __builtin_amdgcn_update_dpp(0, a_, ctrl, 0xf, 0xf, false)
#define P6_REDUCE(W, ENT, EJ, GB, UB, VB, base_) do { if ((base_) < n) { int ag_[4]; \
                _Pragma("unroll") for (int g_ = 0; g_ < 4; ++g_) { const LAS unsigned char* hp_ = HB + (size_t)(ENT[g_] >> 24) * 1024 + 16 * p16; int a_ = 0; v4u h_[4]; \
                    _Pragma("unroll") for (int i_ = 0; i_ < 4; ++i_) h_[i_] = *(const LAS v4u*)(hp_ + 256 * i_); \
                    _Pragma("unroll") for (int ld_ = 0; ld_ < 2; ++ld_) { const unsigned x_[4] = {W[g_][ld_].x, W[g_][ld_].y, W[g_][ld_].z, W[g_][ld_].w}; \
                        _Pragma("unroll") for (int wl_ = 0; wl_ < 4; ++wl_) { const int hd_ = 2 * (4 * ld_ + wl_); const unsigned lo_ = (x_[wl_] << 4) & 0xF0F0F0F0u, hi_ = x_[wl_] & 0xF0F0F0F0u; \
                            const unsigned hA_ = (hd_ & 3) == 0 ? h_[hd_ >> 2].x : h_[hd_ >> 2].z, hB_ = (hd_ & 3) == 0 ? h_[hd_ >> 2].y : h_[hd_ >> 2].w; \
                            a_ = __builtin_amdgcn_sdot4((int)lo_, (int)hA_, a_, false); a_ = __builtin_amdgcn_sdot4((int)hi_, (int)hB_, a_, false); } } \
                    P6_DPPADD(a_, 0xB1); P6_DPPADD(a_, 0x4E); P6_DPPADD(a_, 0x141); P6_DPPADD(a_, 0x140); ag_[g_] = a_; } \
                const int sel_ = gsel == 0 ? ag_[0] : gsel == 1 ? ag_[1] : gsel == 2 ? ag_[2] : ag_[3]; \
                const float resv_ = (float)__builtin_amdgcn_ds_bpermute(bpsrc, sel_); \
                if (EJ >= 0 && !(PROBE_L1 && rep_)) { const unsigned ej_ = (unsigned)EJ; const float act_ = gelu_f(resv_ * UB * HSs[ej_ >> 24]); \
                    COEF[((size_t)t0 + (ej_ >> 24)) * 128 + ((ej_ >> 16) & 127u)] = (unsigned short)(pg8::pkbf(GB * act_ * VB, 0.f) & 0xffffu); } } } while (0)
        int wb = rk * NWAVES + F.wave;
        P6_PRE(wb);
        for (; wb < nwb; wb += wstep) {
            const int t0 = wb * 8;
            asm volatile("s_waitcnt lgkmcnt(0)" ::: "memory");
            if (F.lane < 8) HSs[F.lane] = hspre;
#pragma unroll
            for (int i = 0; i < 8; ++i) *(LAS v4u*)(HB + (size_t)(i * 64 + F.lane) * 16) = hpre[i];
            int n = 0;
            { const unsigned idw[8] = {idpre[0].x, idpre[0].y, idpre[0].z, idpre[0].w, idpre[1].x, idpre[1].y, idpre[1].z, idpre[1].w};
              const unsigned tl = (unsigned)(F.lane >> 3), kb0 = 16u * (unsigned)(F.lane & 7);
#pragma unroll
              for (int i = 0; i < 16; ++i) { const unsigned e = (i & 1) ? (idw[i >> 1] >> 16) : (idw[i >> 1] & 0xffffu);
                  const bool inr = ((int)(e >> 11) == vx); const unsigned long long mk = __ballot(inr);
                  const int pos = n + (int)__builtin_amdgcn_mbcnt_hi((unsigned)(mk >> 32), __builtin_amdgcn_mbcnt_lo((unsigned)mk, 0u));
                  if (inr) LIST[pos] = (tl << 24) | ((kb0 + (unsigned)i) << 16) | e;
                  n += __builtin_popcountll(mk); } }
            asm volatile("s_waitcnt lgkmcnt(0)" ::: "memory");
            P6_PRE(wb + wstep);
            const int nm1 = n > 0 ? n - 1 : 0;
            for (int base = 0; base < n; base += 32) {
                v4u wA[4][2], wB[4][2]; unsigned entA[4], entB[4]; int ejA, ejB; float gbA, ubA, vbA, gbB, ubB, vbB;
                P6_ISSUE(wA, entA, ejA, gbA, ubA, vbA, base);
                P6_ISSUE(wB, entB, ejB, gbB, ubB, vbB, base + 16);
                P6_REDUCE(wA, entA, ejA, gbA, ubA, vbA, base);
                P6_REDUCE(wB, entB, ejB, gbB, ubB, vbB, base + 16);
            }
        }
#undef P6_PRE
#undef P6_ISSUE
#undef P6_REDUCE
#undef P6_DPPADD
        if (BOTH(6)) GRID_BAR();
    }

    if (IN(7)) REP(7) {
        P67_MAP();
        const int cs = vx >> 1;
        const int n0_ = p67_uni ? F.G / 8 : (F.G + 7 - 2 * cs) / 8, n1_ = p67_uni ? F.G / 8 : (F.G + 7 - (2 * cs + 1)) / 8;
        const int rk2 = (vx & 1) ? n0_ + rk : rk, nrk2 = n0_ + n1_;
        const int l8 = F.lane & 7, kg = F.lane >> 3, i16 = F.lane & 15, kq = F.lane >> 4;
        const unsigned char* vbase = V8 + (size_t)cs * NEXP * 128 + 16 * l8;
        const int tstep = nrk2 * NWAVES;
        const int col = 256 * cs + 4 * F.lane;
        LAS unsigned char* tile = F.lds + RING_OFF + F.wave * 16384;
        typedef int v2i_ __attribute__((ext_vector_type(2)));
        const int wrb = kg * 2048 + 16 * l8, rdb = (32 * kq + i16) * 128 + 16 * (i16 & 7) + 8 * (i16 >> 3);
        LAS float* obuf = (LAS float*)(F.lds + RING_OFF + RING_BYTES + F.wave * 1024);
#define P7_CL(tt) ((tt) < T ? (tt) : T - 1)
#define P7_IDS(tt, ID) do { const int tc_ = P7_CL(tt); ID[0] = *(const GAS v4u*)(IDS + (size_t)tc_ * 128 + 16 * kg); ID[1] = *(const GAS v4u*)(IDS + (size_t)tc_ * 128 + 16 * kg + 8); } while (0)
#define P7_ISSUE(tt, ID, W, CF, OO) do { const int tc_ = P7_CL(tt); const unsigned idw_[8] = {ID[0].x, ID[0].y, ID[0].z, ID[0].w, ID[1].x, ID[1].y, ID[1].z, ID[1].w}; \
            _Pragma("unroll") for (int i_ = 0; i_ < 16; ++i_) { const unsigned e_ = (i_ & 1) ? (idw_[i_ >> 1] >> 16) : (idw_[i_ >> 1] & 0xffffu); W[i_] = *(const GAS v4u*)(vbase + (size_t)((PROBE_L1 && rep_) ? 0u : e_) * 128); } \
            CF[0] = *(const GAS v4u*)(COEF + (size_t)tc_ * 128 + 16 * kg); CF[1] = *(const GAS v4u*)(COEF + (size_t)tc_ * 128 + 16 * kg + 8); \
            OO = *(const GAS v2u*)(X1B + (size_t)tc_ * D + col); } while (0)
#define P7_COMPUTE(tt, W, CF, OO, NX) do { \
              \
            const unsigned cw_[8] = {CF[0].x, CF[0].y, CF[0].z, CF[0].w, CF[1].x, CF[1].y, CF[1].z, CF[1].w}; \
            float am_ = 0.f; _Pragma("unroll") for (int j_ = 0; j_ < 8; ++j_) am_ = fmaxf(am_, fmaxf(fabsf(pg8::bflo(cw_[j_])), fabsf(pg8::bfhi(cw_[j_])))); \
            am_ = fmaxf(am_, __shfl_xor(am_, 8)); am_ = fmaxf(am_, __shfl_xor(am_, 16)); am_ = fmaxf(am_, __shfl_xor(am_, 32)); \
            const float cq_ = am_ > 0.f ? 240.0f / am_ : 0.f, cstep_ = am_ * (1.0f / 240.0f); \
            int cpk_[4]; _Pragma("unroll") for (int d_ = 0; d_ < 4; ++d_) { int w_ = __builtin_amdgcn_cvt_pk_fp8_f32(pg8::bflo(cw_[2 * d_]) * cq_, pg8::bfhi(cw_[2 * d_]) * cq_, 0, false); \
                cpk_[d_] = __builtin_amdgcn_cvt_pk_fp8_f32(pg8::bflo(cw_[2 * d_ + 1]) * cq_, pg8::bfhi(cw_[2 * d_ + 1]) * cq_, w_, true); } \
              \
            v8i a_; { const int sa0_ = (8 * kq) * 4, sa1_ = (32 + 8 * kq) * 4; const bool m0_ = (i16 == 0); \
                _Pragma("unroll") for (int d_ = 0; d_ < 4; ++d_) { const int x0_ = __builtin_amdgcn_ds_bpermute(sa0_, cpk_[d_]), x1_ = __builtin_amdgcn_ds_bpermute(sa1_, cpk_[d_]); a_[d_] = m0_ ? x0_ : 0; a_[4 + d_] = m0_ ? x1_ : 0; } } \
            _Pragma("unroll") for (int i_ = 0; i_ < 16; ++i_) { const v4u x_ = W[i_]; *(LAS v4u*)(tile + (wrb ^ (16 * (i_ & 7))) + 128 * i_) = (i_ & 8) ? (v4u){x_.z, x_.w, x_.x, x_.y} : x_; } \
            const v2u oc_ = OO; \
            asm volatile("" ::: "memory"); \
            NX;                                                                      \
            asm volatile("" ::: "memory"); \
            _Pragma("unroll") for (int g_ = 0; g_ < 4; ++g_) { \
                f32x4 dd_[4]; \
                _Pragma("unroll") for (int j_ = 0; j_ < 4; ++j_) { const int nb_ = 4 * g_ + j_; const int ra_ = (rdb ^ (16 * (nb_ >> 1))) ^ (8 * (nb_ & 1)); \
                    const v2i_ r0_ = __builtin_amdgcn_ds_read_tr4_b64_v2i32((LAS v2i_*)(tile + ra_)), r1_ = __builtin_amdgcn_ds_read_tr4_b64_v2i32((LAS v2i_*)(tile + ra_ + 2048)); \
                    dd_[j_] = __builtin_amdgcn_mfma_scale_f32_16x16x128_f8f6f4(a_, (v8i){r0_.x, r0_.y, r1_.x, r1_.y, 0, 0, 0, 0}, (f32x4){0.f, 0.f, 0.f, 0.f}, 0, 4, 0, 127, 0, 127); } \
                __builtin_amdgcn_sched_barrier(0); \
                  \
                if (F.lane < 16) { _Pragma("unroll") for (int j_ = 0; j_ < 4; ++j_) obuf[16 * (4 * g_ + j_) + F.lane] = dd_[j_][0] * cstep_; } \
                asm volatile("" ::: "memory"); } \
            const f32x4 r4_ = *(const LAS f32x4*)(obuf + 4 * F.lane); \
            asm volatile("" ::: "memory"); \
            if ((tt) < T) *(GAS f32x4*)((rep_ == 0 ? out : (float*)(ws + WS_GT)) + (size_t)(tt) * D + col) = (f32x4){pg8::bflo(oc_.x) + r4_[0], pg8::bfhi(oc_.x) + r4_[1], pg8::bflo(oc_.y) + r4_[2], pg8::bfhi(oc_.y) + r4_[3]}; } while (0)
        v4u idA[2], idB[2], wA[16], wB[16], cfA[2], cfB[2]; v2u ooA, ooB;
        int t = rk2 * NWAVES + F.wave;
        P7_IDS(t, idA); P7_IDS(t + tstep, idB);
        P7_ISSUE(t, idA, wA, cfA, ooA); P7_ISSUE(t + tstep, idB, wB, cfB, ooB);
        P7_IDS(t + 2 * tstep, idA); P7_IDS(t + 3 * tstep, idB);
        while (t < T) {
            P7_COMPUTE(t, wA, cfA, ooA, { P7_ISSUE(t + 2 * tstep, idA, wA, cfA, ooA); P7_IDS(t + 4 * tstep, idA); });
            P7_COMPUTE(t + tstep, wB, cfB, ooB, { P7_ISSUE(t + 3 * tstep, idB, wB, cfB, ooB); P7_IDS(t + 5 * tstep, idB); });
            t += 2 * tstep;
        }
#undef P7_CL
#undef P7_IDS
#undef P7_ISSUE
#undef P7_COMPUTE
    }
#undef IN
#undef BOTH
#undef GRID_BAR
}

extern "C" void kernel_launch(void* const* d_in, const int* in_sizes, int n_in, void* d_out, int out_size, void* d_ws, size_t ws_size, hipStream_t stream) {
    static int grid = 0;
    if (grid == 0) {
        if (n_in != 14 || in_sizes[0] != T * D || out_size != T * D || ws_size < WS_END) { fprintf(stderr, "kernel_launch: built for 14 inputs, x and out of %d floats, >= %zu bytes of workspace; got n_in %d, in0 %d, out %d, ws %zu; nothing launched\n", T * D, (size_t)WS_END, n_in, n_in > 0 ? in_sizes[0] : -1, out_size, ws_size); grid = -1; return; }
        int dev = 0, cus = 0, per_cu = 0;
        if (hipGetDevice(&dev) != hipSuccess || hipDeviceGetAttribute(&cus, hipDeviceAttributeMultiprocessorCount, dev) != hipSuccess) { fprintf(stderr, "kernel_launch: hipGetDevice / hipDeviceGetAttribute failed\n"); grid = -1; return; }
        if (hipFuncSetAttribute((const void*)fwd_kernel, hipFuncAttributeMaxDynamicSharedMemorySize, LDS_BYTES) != hipSuccess) { fprintf(stderr, "kernel_launch: hipFuncSetAttribute failed\n"); grid = -1; return; }
        if (hipOccupancyMaxActiveBlocksPerMultiprocessor(&per_cu, (const void*)fwd_kernel, NWAVES * 64, LDS_BYTES) != hipSuccess || per_cu < 1)
            fprintf(stderr, "kernel_launch: note: occupancy query reports %d workgroups per CU\n", per_cu);
        (void)hipGetLastError();
        grid = cus;
        if (cus != 256) fprintf(stderr, "kernel_launch: built for 256 CUs (MI355X); %d found -- the P3 row-max exchange assumes a 256-workgroup grid\n", cus);
    }
    if (grid < 0) return;
    if (hipMemsetAsync((char*)d_ws + WS_CTL, 0, CTL_ZERO_BYTES, stream) != hipSuccess) { fprintf(stderr, "kernel_launch: hipMemsetAsync failed\n"); return; }
    Args a{};
    for (int i = 0; i < 14; ++i) a.in[i] = (const float*)d_in[i];
    a.out = (float*)d_out; a.ws = (unsigned char*)d_ws;
    for (int li = 0; li < N_LAUNCHES; ++li) {
        a.ph_lo = (N_LAUNCHES == PER_PHASE) ? li : 0; a.ph_hi = (N_LAUNCHES == PER_PHASE) ? li + 1 : MK_LAST_PHASE; a.li = li;
        if (a.ph_lo >= MK_LAST_PHASE) break;
        hipLaunchKernelGGL(fwd_kernel, dim3(grid), dim3(NWAVES * 64), LDS_BYTES, stream, a);
        const hipError_t le = hipPeekAtLastError();
        if (le != hipSuccess) { fprintf(stderr, "kernel_launch: launch %d failed: %s\n", li, hipGetErrorName(le)); break; }
    }
}
```

```cpp
#include <hip/hip_runtime.h>
#include <cstdio>
#include <cstdint>
namespace pg8 {
#define PG8_LAS __attribute__((address_space(3)))
typedef unsigned short bf16_t;
typedef short bf16x8 __attribute__((ext_vector_type(8)));
typedef float f32x4 __attribute__((ext_vector_type(4)));
typedef unsigned u32x4 __attribute__((ext_vector_type(4)));
typedef int i32x8 __attribute__((ext_vector_type(8)));
typedef int i32x4 __attribute__((ext_vector_type(4)));
constexpr int BM = 256, BK = 64, HALF = 128, HTB = HALF * BK * 2  , STAGE_BYTES = 8 * HTB, NXCD = 8, WGM = 8;

__host__ __device__ __forceinline__ int lds_byte(int r, int c) { const int st = (r >> 4) * 2 + (c >> 5), rr = r & 15, cc = c & 31, ob = rr * 64 + cc * 2; return st * 1024 + (ob ^ (((ob >> 9) & 1) << 5)); }
__host__ __device__ __forceinline__ void stage_rc(int b, int& R, int& C) { const int st = b / 1024, sb = b % 1024, swz = sb ^ (((sb >> 9) & 1) << 5); R = (st >> 1) * 16 + swz / 64; C = (st & 1) * 32 + (swz % 64) / 2; }
__host__ __device__ __forceinline__ int perm32(int rho) { const int n = rho >> 4, i = rho & 15; return 8 * (i >> 2) + 4 * n + (i & 3); }

struct Unit { int pm, pn; };
struct Gemm { const bf16_t* A; const bf16_t* Bt; int M, N, K; };

struct StaticOrder {
    int nM, nN, nwg, G, c;
    __host__ __device__ void init(int M, int N, int G_, int c_) { nM = M / BM; nN = N / BM; nwg = nM * nN; G = G_; c = c_; }
    __host__ __device__ bool next(int i, Unit& u) const {
        const long L = (long)i * G + c; if (L >= nwg) return false;
        int wgid = (int)L; { const int q = nwg / NXCD, r = nwg % NXCD, xcd = wgid % NXCD, off = wgid / NXCD; wgid = (xcd < r ? xcd * (q + 1) : r * (q + 1) + (xcd - r) * q) + off; }
        const int nig = WGM * nN, gid = wgid / nig, fm = gid * WGM, gsz = (nM - fm) < WGM ? (nM - fm) : WGM;
        u.pm = fm + ((wgid % nig) % gsz); u.pn = (wgid % nig) / gsz; return true;
    }
    __device__ __forceinline__ void a_ready(const Unit&) const {}
    __device__ __forceinline__ void done(const Unit&) const {}
};


struct OneUnit {
    Unit u;
    __device__ __forceinline__ bool next(int i, Unit& o) const { if (i != 0) return false; o = u; return true; }
    __device__ __forceinline__ void a_ready(const Unit&) const {}
    __device__ __forceinline__ void done(const Unit&) const {}
};

typedef float f32x2 __attribute__((ext_vector_type(2)));
typedef __bf16 bf16x2_t __attribute__((ext_vector_type(2)));
typedef unsigned u32x2 __attribute__((ext_vector_type(2)));
__device__ __forceinline__ unsigned pkbf(float lo, float hi) { f32x2 v = {lo, hi}; bf16x2_t b = __builtin_convertvector(v, bf16x2_t); return __builtin_bit_cast(unsigned, b); }
__device__ __forceinline__ float bflo(unsigned w) { return __uint_as_float(w << 16); }
__device__ __forceinline__ float bfhi(unsigned w) { return __uint_as_float(w & 0xffff0000u); }
__device__ __forceinline__ u32x4 pack8(const f32x4 a, const f32x4 b) { u32x4 w; w.x = pkbf(a[0], a[1]); w.y = pkbf(a[2], a[3]); w.z = pkbf(b[0], b[1]); w.w = pkbf(b[2], b[3]); return w; }
constexpr float QSCALE = 0.125f * 1.4426950408889634f;
__device__ __forceinline__ float sigmoidf_(float v) { return __builtin_amdgcn_rcpf(1.0f + __builtin_amdgcn_exp2f(-1.4426950408889634f * v)); }

struct EpiG {
    static constexpr bool PERM = true, AFTER_DRAIN = false, HAS_MID = false; static constexpr int MID_T = -1;
    const float* bgate; const float* cs; const float* xs; const float* qg; const float* kg; bf16_t *QS, *KS, *VS, *QD, *KD, *VD; unsigned char* GT;
    __device__ __forceinline__ void mid(f32x4 (&)[2][2][4][2], const Unit&, int, int, int, int) const {}
    static __device__ __forceinline__ f32x4 cvt(const f32x4 a, const f32x4 sc) { const i32x4 ia = __builtin_bit_cast(i32x4, a); return (f32x4){(float)ia[0], (float)ia[1], (float)ia[2], (float)ia[3]} * sc; }
    __device__ __forceinline__ void operator()(const f32x4 (&acc)[2][2][4][2], const Unit& u, int wr, int wc, int fr, int fq) const {
        asm volatile("" : "+v"(fr), "+v"(fq));
        const int pn = u.pn; const int row0 = u.pm * BM + wr * 64 + fr, colp = pn * BM + wc * 32 + 8 * fq;
        f32x4 sv[2][2];
#pragma unroll
        for (int bj = 0; bj < 2; ++bj)
#pragma unroll
            for (int n = 0; n < 2; ++n) sv[bj][n] = *(const f32x4*)(cs + colp + bj * HALF + 4 * n);
        if (pn < 6) {
            bf16_t* base; int colt;
            if (pn < 2) { base = QS; colt = pn * 256; } else if (pn < 4) { base = KS; colt = (pn - 2) * 256; } else { base = VS; colt = (pn - 4) * 256; }
            base += colt + wc * 32 + 8 * fq;
            const float qs = (pn < 2 ? QSCALE : 1.0f);
#pragma unroll
            for (int ai = 0; ai < 2; ++ai)
#pragma unroll
                for (int m = 0; m < 4; ++m) { const int row = row0 + ai * HALF + m * 16; const float r = xs[row] * qs;
#pragma unroll
                    for (int bj = 0; bj < 2; ++bj) *(u32x4*)(base + (size_t)row * 512 + bj * HALF) = pack8(cvt(acc[ai][bj][m][0], sv[bj][0]) * r, cvt(acc[ai][bj][m][1], sv[bj][1]) * r);
                }
        } else if (pn < 12) {
            const bool isK = pn >= 9; const int head = (isK ? pn - 9 : pn - 6) * 4 + wc;
            const float* g = (isK ? kg : qg) + head * 64 + 8 * fq;
            f32x4 gv[2][2]; const float qsc = isK ? 1.0f : QSCALE;
#pragma unroll
            for (int bj = 0; bj < 2; ++bj)
#pragma unroll
                for (int n = 0; n < 2; ++n) gv[bj][n] = *(const f32x4*)(g + 32 * bj + 4 * n) * qsc;
            bf16_t* base = (isK ? KD : QD) + head * 64 + 8 * fq;
#pragma unroll
            for (int ai = 0; ai < 2; ++ai)
#pragma unroll
                for (int m = 0; m < 4; ++m) { const int row = row0 + ai * HALF + m * 16; const float r = xs[row];
                    f32x4 v[2][2]; float ss = 0.f;
#pragma unroll
                    for (int bj = 0; bj < 2; ++bj)
#pragma unroll
                        for (int n = 0; n < 2; ++n) { v[bj][n] = cvt(acc[ai][bj][m][n], sv[bj][n]) * r; const f32x4 q = v[bj][n] * v[bj][n]; ss += (q[0] + q[1]) + (q[2] + q[3]); }
                    ss += __shfl_xor(ss, 16); ss += __shfl_xor(ss, 32);
                    const float sc = __builtin_amdgcn_rsqf(ss * (1.0f / 64.0f) + 1e-6f);
#pragma unroll
                    for (int bj = 0; bj < 2; ++bj) *(u32x4*)(base + (size_t)row * 768 + 32 * bj) = pack8(v[bj][0] * sc * gv[bj][0], v[bj][1] * sc * gv[bj][1]);
                }
        } else if (pn < 15) {
            bf16_t* base = VD + (pn - 12) * 256 + wc * 32 + 8 * fq;
#pragma unroll
            for (int ai = 0; ai < 2; ++ai)
#pragma unroll
                for (int m = 0; m < 4; ++m) { const int row = row0 + ai * HALF + m * 16; const float r = xs[row];
#pragma unroll
                    for (int bj = 0; bj < 2; ++bj) *(u32x4*)(base + (size_t)row * 768 + bj * HALF) = pack8(cvt(acc[ai][bj][m][0], sv[bj][0]) * r, cvt(acc[ai][bj][m][1], sv[bj][1]) * r);
                }
        } else {
            const int col0 = (pn - 15) * 256 + wc * 32 + 8 * fq;
            f32x4 bv[2][2];
#pragma unroll
            for (int bj = 0; bj < 2; ++bj)
#pragma unroll
                for (int n = 0; n < 2; ++n) bv[bj][n] = *(const f32x4*)(bgate + col0 + bj * HALF + 4 * n);
#pragma unroll
            for (int ai = 0; ai < 2; ++ai)
#pragma unroll
                for (int m = 0; m < 4; ++m) { const int row = row0 + ai * HALF + m * 16; const float r = xs[row];
#pragma unroll
                    for (int bj = 0; bj < 2; ++bj) { f32x4 a = cvt(acc[ai][bj][m][0], sv[bj][0]) * r + bv[bj][0], b = cvt(acc[ai][bj][m][1], sv[bj][1]) * r + bv[bj][1];
#pragma unroll
                        for (int e = 0; e < 4; ++e) { a[e] = sigmoidf_(a[e]) * 255.0f; b[e] = sigmoidf_(b[e]) * 255.0f; }
                        unsigned w0 = 0, w1 = 0;
                        w0 = __builtin_amdgcn_cvt_pk_u8_f32(a[0], 0, w0); w0 = __builtin_amdgcn_cvt_pk_u8_f32(a[1], 1, w0); w0 = __builtin_amdgcn_cvt_pk_u8_f32(a[2], 2, w0); w0 = __builtin_amdgcn_cvt_pk_u8_f32(a[3], 3, w0);
                        w1 = __builtin_amdgcn_cvt_pk_u8_f32(b[0], 0, w1); w1 = __builtin_amdgcn_cvt_pk_u8_f32(b[1], 1, w1); w1 = __builtin_amdgcn_cvt_pk_u8_f32(b[2], 2, w1); w1 = __builtin_amdgcn_cvt_pk_u8_f32(b[3], 3, w1);
                        *(u32x2*)(GT + (size_t)row * 2048 + col0 + bj * HALF) = (u32x2){w0, w1}; }
                }
        }
    }
};

struct Epi2 {
    static constexpr bool PERM = true, AFTER_DRAIN = false, HAS_MID = true; static constexpr int MID_T = 8;
    const unsigned char* GT; unsigned char* MIX8; unsigned* part; unsigned* rcnt; float* rmaxf; PG8_LAS unsigned char* red_lds;
    static __device__ __forceinline__ float ub(unsigned w, int e) { return (float)((w >> (8 * e)) & 0xffu); }
    static __device__ __forceinline__ float gcv(unsigned w, int e) { return fmaxf(ub(w, e) * (1.0f / 255.0f), 1e-30f); }
    __device__ __forceinline__ void mid(f32x4 (&acc)[2][2][4][2], const Unit& u, int wr, int wc, int fr, int fq) const {
        asm volatile("" : "+v"(fr), "+v"(fq));
        const int row0 = u.pm * BM + wr * 64 + fr, col0 = u.pn * BM + wc * 32 + 8 * fq;
        u32x2 ga[2][4][2], gb[2][4][2];
#pragma unroll
        for (int ai = 0; ai < 2; ++ai)
#pragma unroll
            for (int m = 0; m < 4; ++m) { const unsigned char* gp = GT + (size_t)(row0 + ai * HALF + m * 16) * 2048 + col0;
#pragma unroll
                for (int bj = 0; bj < 2; ++bj) { ga[ai][m][bj] = *(const u32x2*)(gp + bj * HALF); gb[ai][m][bj] = *(const u32x2*)(gp + 1024 + bj * HALF); } }
        asm volatile("" ::: "memory");
#pragma unroll
        for (int ai = 0; ai < 2; ++ai)
#pragma unroll
            for (int m = 0; m < 4; ++m)
#pragma unroll
                for (int bj = 0; bj < 2; ++bj) { const u32x2 a = ga[ai][m][bj], b = gb[ai][m][bj];
                    f32x4 r0, r1;
#pragma unroll
                    for (int e = 0; e < 4; ++e) { r0[e] = ub(a.x, e) * (1.0f / 255.0f) * __builtin_amdgcn_rcpf(gcv(b.x, e)); r1[e] = ub(a.y, e) * (1.0f / 255.0f) * __builtin_amdgcn_rcpf(gcv(b.y, e)); }
                    acc[ai][bj][m][0] *= r0; acc[ai][bj][m][1] *= r1; }
        asm volatile("" ::: "memory");
    }
    __device__ __forceinline__ void operator()(f32x4 (&acc)[2][2][4][2], const Unit& u, int wr, int wc, int fr, int fq) const {
        asm volatile("" : "+v"(fr), "+v"(fq));
        const int row0 = u.pm * BM + wr * 64 + fr, col0 = u.pn * BM + wc * 32 + 8 * fq;
        PG8_LAS float* red = (PG8_LAS float*)red_lds; PG8_LAS float* red2 = red + 1024;
#pragma unroll
        for (int ai = 0; ai < 2; ++ai) { u32x2 gb[4][2];
#pragma unroll
            for (int m = 0; m < 4; ++m) { const unsigned char* gp = GT + (size_t)(row0 + ai * HALF + m * 16) * 2048 + 1024 + col0;
#pragma unroll
                for (int bj = 0; bj < 2; ++bj) gb[m][bj] = *(const u32x2*)(gp + bj * HALF); }
#pragma unroll
            for (int m = 0; m < 4; ++m) { float a = 0.f;
#pragma unroll
                for (int bj = 0; bj < 2; ++bj) { const u32x2 b = gb[m][bj];
#pragma unroll
                    for (int e = 0; e < 4; ++e) { acc[ai][bj][m][0][e] *= gcv(b.x, e); acc[ai][bj][m][1][e] *= gcv(b.y, e); a = fmaxf(a, fmaxf(fabsf(acc[ai][bj][m][0][e]), fabsf(acc[ai][bj][m][1][e]))); } }
                a = fmaxf(a, __shfl_xor(a, 16)); a = fmaxf(a, __shfl_xor(a, 32));
                if (fq == 0) red[(wr * 64 + fr + ai * HALF + m * 16) * 4 + wc] = a; }
            asm volatile("" ::: "memory");
        }
        asm volatile("s_waitcnt lgkmcnt(0)" ::: "memory"); __builtin_amdgcn_s_barrier(); asm volatile("" ::: "memory");
        const int tid = (wr * 4 + wc) * 64 + fr + 16 * fq;
        if (tid < 256) {
            const f32x4 p4 = *(const PG8_LAS f32x4*)(red + tid * 4);
            const float v = fmaxf(fmaxf(p4[0], p4[1]), fmaxf(p4[2], p4[3]));
            unsigned* pr = part + (size_t)(u.pm * BM + tid) * 4;
            __hip_atomic_store(pr + u.pn, __float_as_uint(v), __ATOMIC_RELAXED, __HIP_MEMORY_SCOPE_AGENT);
            asm volatile("s_waitcnt vmcnt(0)" ::: "memory");
            if ((tid & 63) == 0) (void)__hip_atomic_fetch_add(rcnt + u.pm, 1u, __ATOMIC_RELAXED, __HIP_MEMORY_SCOPE_AGENT);
            { unsigned sp = 0; while (__hip_atomic_load(rcnt + u.pm, __ATOMIC_RELAXED, __HIP_MEMORY_SCOPE_AGENT) < 16u) { __builtin_amdgcn_s_sleep(4); if (++sp > (1u << 21)) break; } }
            asm volatile("" ::: "memory");
            float f = 0.f;
#pragma unroll
            for (int j = 0; j < 4; ++j) f = fmaxf(f, __uint_as_float(__hip_atomic_load(pr + j, __ATOMIC_RELAXED, __HIP_MEMORY_SCOPE_AGENT)));
            red2[tid] = f;
            if (u.pn == 0) rmaxf[u.pm * BM + tid] = f;
        }
        asm volatile("s_waitcnt lgkmcnt(0)" ::: "memory"); __builtin_amdgcn_s_barrier(); asm volatile("" ::: "memory");
#pragma unroll
        for (int ai = 0; ai < 2; ++ai)
#pragma unroll
            for (int m = 0; m < 4; ++m) { const int row = row0 + ai * HALF + m * 16;
                const float rm = red2[wr * 64 + fr + ai * HALF + m * 16]; const float sc = rm > 0.f ? 127.0f / rm : 0.f;
#pragma unroll
                for (int bj = 0; bj < 2; ++bj) { unsigned w0 = 0, w1 = 0;
#pragma unroll
                    for (int e = 0; e < 4; ++e) { w0 |= ((unsigned)(int)__builtin_rintf(acc[ai][bj][m][0][e] * sc) & 0xffu) << (8 * e); w1 |= ((unsigned)(int)__builtin_rintf(acc[ai][bj][m][1][e] * sc) & 0xffu) << (8 * e); }
                    *(u32x2*)(MIX8 + (size_t)row * 1024 + col0 + bj * HALF) = (u32x2){w0, w1}; } }
    }
};

struct Epi3 {
    static constexpr bool PERM = true, AFTER_DRAIN = false, HAS_MID = false; static constexpr int MID_T = -1;
    const bf16_t* xb; const float* rms; const unsigned* rmax; const float* wos; bf16_t* x1b; float* ssq;
    __device__ __forceinline__ void mid(f32x4 (&)[2][2][4][2], const Unit&, int, int, int, int) const {}
    static __device__ __forceinline__ f32x4 cvt(const f32x4 a, const f32x4 sc) { const i32x4 ia = __builtin_bit_cast(i32x4, a); return (f32x4){(float)ia[0], (float)ia[1], (float)ia[2], (float)ia[3]} * sc; }
    __device__ __forceinline__ void operator()(const f32x4 (&acc)[2][2][4][2], const Unit& u, int wr, int wc, int fr, int fq) const {
        asm volatile("" : "+v"(fr), "+v"(fq));
        const int row0 = u.pm * BM + wr * 64 + fr, col0 = u.pn * BM + wc * 32 + 8 * fq;
        f32x4 wsv[2][2];
#pragma unroll
        for (int bj = 0; bj < 2; ++bj)
#pragma unroll
            for (int n = 0; n < 2; ++n) wsv[bj][n] = *(const f32x4*)(wos + col0 + bj * HALF + 4 * n);
#pragma unroll
        for (int ai = 0; ai < 2; ++ai) { u32x4 xv[4][2]; float rm[4], ms[4];
#pragma unroll
            for (int m = 0; m < 4; ++m) { const int row = row0 + ai * HALF + m * 16; const size_t off = (size_t)row * 1024 + col0; rm[m] = rms[row]; ms[m] = __uint_as_float(rmax[row]) * (1.0f / 127.0f);
#pragma unroll
                for (int bj = 0; bj < 2; ++bj) xv[m][bj] = *(const u32x4*)(xb + off + bj * HALF); }
#pragma unroll
            for (int m = 0; m < 4; ++m) { const int row = row0 + ai * HALF + m * 16; const size_t off = (size_t)row * 1024 + col0; float ss = 0.f; const float r = rm[m], mr = ms[m];
#pragma unroll
                for (int bj = 0; bj < 2; ++bj) { const u32x4 w = xv[m][bj];
                    const f32x4 x0 = (f32x4){bflo(w.x), bfhi(w.x), bflo(w.y), bfhi(w.y)}, x1 = (f32x4){bflo(w.z), bfhi(w.z), bflo(w.w), bfhi(w.w)};
                    const f32x4 v0 = cvt(acc[ai][bj][m][0], wsv[bj][0]) * mr + x0 * r, v1 = cvt(acc[ai][bj][m][1], wsv[bj][1]) * mr + x1 * r;
                    *(u32x4*)(x1b + off + bj * HALF) = pack8(v0, v1);
                    const f32x4 q0 = v0 * v0, q1 = v1 * v1; ss += ((q0[0] + q0[1]) + (q0[2] + q0[3])) + ((q1[0] + q1[1]) + (q1[2] + q1[3])); }
                ss += __shfl_xor(ss, 16); ss += __shfl_xor(ss, 32);
                if (fq == 0) ssq[(size_t)row * 16 + u.pn * 4 + wc] = ss;
            }
            asm volatile("" ::: "memory");
        }
    }
};

__device__ __forceinline__ unsigned f2key(float v) { const unsigned u = __float_as_uint(v); return (u & 0x80000000u) ? ~u : (u | 0x80000000u); }
__device__ __forceinline__ float key2f(unsigned k) { return __uint_as_float((k & 0x80000000u) ? (k & 0x7fffffffu) : ~k); }
#define PG8_CE(a_, b_) do { const unsigned hi__ = (a_) > (b_) ? (a_) : (b_); const unsigned lo__ = (a_) > (b_) ? (b_) : (a_); (a_) = hi__; (b_) = lo__; } while (0)
__device__ __forceinline__ void bitonic_merge16(unsigned (&v)[16]) {
#pragma unroll
    for (int j = 8; j >= 1; j >>= 1)
#pragma unroll
        for (int i = 0; i < 16; ++i) { const int l = i ^ j; if (l > i) PG8_CE(v[i], v[l]); }
}
__device__ __forceinline__ void bitonic_sort16(unsigned (&v)[16]) {
#pragma unroll
    for (int k = 2; k <= 16; k <<= 1)
#pragma unroll
        for (int j = k >> 1; j >= 1; j >>= 1)
#pragma unroll
            for (int i = 0; i < 16; ++i) { const int l = i ^ j; if (l > i) { if ((i & k) == 0 || k == 16) PG8_CE(v[i], v[l]); else PG8_CE(v[l], v[i]); } }
}
__device__ __forceinline__ void merge_top16(unsigned (&t)[16], const unsigned (&o)[16]) {
#pragma unroll
    for (int i = 0; i < 16; ++i) t[i] = t[i] > o[15 - i] ? t[i] : o[15 - i];
    bitonic_merge16(t);
}
template <int XM> __device__ __forceinline__ void merge_top16_xor(unsigned (&t)[16]) {
    unsigned o[16];
#pragma unroll
    for (int i = 0; i < 16; ++i) o[i] = (unsigned)__shfl_xor((int)t[i], XM);
    merge_top16(t, o);
}

struct Epi4 {
    static constexpr bool PERM = false, AFTER_DRAIN = true, HAS_MID = false; static constexpr int MID_T = -1;
    const float* ssq; float* rinv2; unsigned short* ids; float* gw;
    const float* hs; const float* wcs;
    __device__ __forceinline__ void mid(f32x4 (&)[2][2][4][2], const Unit&, int, int, int, int) const {}
    __device__ __forceinline__ void fused(f32x4 (&acc)[2][2][4][2], const Unit& u, int wr, int wc, int fr, int fq, PG8_LAS unsigned char* lds, int wid, int lane) const {
        asm volatile("" : "+v"(fr), "+v"(fq));
        const int tid = wid * 64 + lane;
        const int rl = tid >> 2, p = (tid >> 1) & 1, hf = tid & 1, q4 = tid & 3;
#pragma unroll
        for (int pass = 0; pass < 2; ++pass) {
            f32x4 wsv[2][2]; float hsv[4];
#pragma unroll
            for (int bj = 0; bj < 2; ++bj)
#pragma unroll
                for (int n = 0; n < 2; ++n) wsv[bj][n] = *(const f32x4*)(wcs + u.pn * BM + bj * HALF + wc * 32 + n * 16 + fq * 4);
#pragma unroll
            for (int m = 0; m < 4; ++m) hsv[m] = hs[u.pm * BM + pass * HALF + wr * 64 + m * 16 + fr];
#pragma unroll
            for (int m = 0; m < 4; ++m)
#pragma unroll
                for (int bj = 0; bj < 2; ++bj)
#pragma unroll
                    for (int n = 0; n < 2; ++n) { const i32x4 ia = __builtin_bit_cast(i32x4, acc[pass][bj][m][n]); f32x4 sv;
#pragma unroll
                        for (int e = 0; e < 4; ++e) sv[e] = (float)ia[e] * hsv[m] * wsv[bj][n][e];
                        *(PG8_LAS f32x4*)(lds + (size_t)(wr * 64 + m * 16 + fr) * 1056 + bj * 528 + (wc * 32 + n * 16 + fq * 4) * 4) = sv; }
            asm volatile("s_waitcnt lgkmcnt(0)" ::: "memory"); __builtin_amdgcn_s_barrier(); asm volatile("" ::: "memory");
            const int row = u.pm * BM + pass * HALF + rl;
            unsigned tk[16];
#pragma unroll
            for (int i = 0; i < 16; ++i) tk[i] = 0u;
            const PG8_LAS unsigned char* sp = lds + (size_t)rl * 1056 + p * 528 + hf * 256;
#pragma nounroll
            for (int c = 0; c < 4; ++c) { unsigned ch[16];
#pragma unroll
                for (int e4 = 0; e4 < 4; ++e4) { const f32x4 v = *(const PG8_LAS f32x4*)(sp + c * 64 + e4 * 16);
#pragma unroll
                    for (int e = 0; e < 4; ++e) ch[4 * e4 + e] = (f2key(v[e]) & ~127u) | (unsigned)(127 - (64 * hf + 16 * c + 4 * e4 + e)); }
                bitonic_sort16(ch);
                merge_top16(tk, ch);
            }
            merge_top16_xor<1>(tk);
            asm volatile("s_waitcnt lgkmcnt(0)" ::: "memory");
            PG8_LAS unsigned* kl = (PG8_LAS unsigned*)(lds + (size_t)(rl & ~15) * 1056) + ((rl & 15) * 2) * 16;
            if (hf == 0) {
#pragma unroll
                for (int i = 0; i < 4; ++i) *(PG8_LAS u32x4*)(kl + p * 16 + 4 * i) = (u32x4){tk[4 * i], tk[4 * i + 1], tk[4 * i + 2], tk[4 * i + 3]}; }
            asm volatile("s_waitcnt lgkmcnt(0)" ::: "memory");
            unsigned ck[16];
#define CAND_SLOT(m_, ij__) do { const unsigned i__ = (ij__) >> 4, j__ = (ij__) & 15u; \
                const unsigned ka__ = kl[(ij__) == 0xFFFFu ? 0u : i__], kb__ = kl[16 + ((ij__) == 0xFFFFu ? 0u : j__)]; \
                const float s__ = key2f(ka__ & ~127u) + key2f(kb__ & ~127u); \
                ck[m_] = (ij__) == 0xFFFFu ? 0u : ((f2key(s__) & ~255u) | (255u - (ij__))); } while (0)
                { const unsigned ij_ = q4 == 0 ? 0u : q4 == 1 ? 1u : q4 == 2 ? 2u : 3u; CAND_SLOT(0, ij_); }
                { const unsigned ij_ = q4 == 0 ? 4u : q4 == 1 ? 5u : q4 == 2 ? 6u : 7u; CAND_SLOT(1, ij_); }
                { const unsigned ij_ = q4 == 0 ? 8u : q4 == 1 ? 9u : q4 == 2 ? 10u : 11u; CAND_SLOT(2, ij_); }
                { const unsigned ij_ = q4 == 0 ? 12u : q4 == 1 ? 13u : q4 == 2 ? 14u : 15u; CAND_SLOT(3, ij_); }
                { const unsigned ij_ = q4 == 0 ? 16u : q4 == 1 ? 17u : q4 == 2 ? 18u : 19u; CAND_SLOT(4, ij_); }
                { const unsigned ij_ = q4 == 0 ? 20u : q4 == 1 ? 21u : q4 == 2 ? 22u : 23u; CAND_SLOT(5, ij_); }
                { const unsigned ij_ = q4 == 0 ? 32u : q4 == 1 ? 33u : q4 == 2 ? 34u : 35u; CAND_SLOT(6, ij_); }
                { const unsigned ij_ = q4 == 0 ? 36u : q4 == 1 ? 48u : q4 == 2 ? 49u : 50u; CAND_SLOT(7, ij_); }
                { const unsigned ij_ = q4 == 0 ? 51u : q4 == 1 ? 64u : q4 == 2 ? 65u : 66u; CAND_SLOT(8, ij_); }
                { const unsigned ij_ = q4 == 0 ? 80u : q4 == 1 ? 81u : q4 == 2 ? 96u : 97u; CAND_SLOT(9, ij_); }
                { const unsigned ij_ = q4 == 0 ? 112u : q4 == 1 ? 113u : q4 == 2 ? 128u : 144u; CAND_SLOT(10, ij_); }
                { const unsigned ij_ = q4 == 0 ? 160u : q4 == 1 ? 176u : q4 == 2 ? 192u : 208u; CAND_SLOT(11, ij_); }
                { const unsigned ij_ = q4 == 0 ? 224u : q4 == 1 ? 240u : q4 == 2 ? 65535u : 65535u; CAND_SLOT(12, ij_); }
#undef CAND_SLOT
            ck[13] = 0u; ck[14] = 0u; ck[15] = 0u;
            bitonic_sort16(ck);
            merge_top16_xor<1>(ck); merge_top16_xor<2>(ck);
            float sq = 0.f;
#pragma unroll
            for (int i = 0; i < 4; ++i) { const f32x4 t = *(const f32x4*)(ssq + (size_t)row * 16 + 4 * i); sq += (t[0] + t[1]) + (t[2] + t[3]); }
            const float r2 = __builtin_amdgcn_rsqf(sq * (1.0f / 1024.0f) + 1e-6f);
            if (u.pn == 0 && q4 == 0) rinv2[row] = r2;
            const float b0 = key2f(ck[0] & ~255u); float wsum = 0.f; float wv[16];
#pragma unroll
            for (int q = 0; q < 16; ++q) { wv[q] = __builtin_amdgcn_exp2f((key2f(ck[q] & ~255u) - b0) * r2 * 1.4426950408889634f); wsum += wv[q]; }
            const float inv = 1.0f / wsum;
            unsigned short eo[4]; float go[4];
#pragma unroll
            for (int e = 0; e < 4; ++e) { unsigned c0 = ck[e], c1 = ck[4 + e], c2 = ck[8 + e], c3 = ck[12 + e]; float w0 = wv[e], w1 = wv[4 + e], w2 = wv[8 + e], w3 = wv[12 + e];
                asm volatile("" : "+v"(c0), "+v"(c1), "+v"(c2), "+v"(c3), "+v"(w0), "+v"(w1), "+v"(w2), "+v"(w3));
                const unsigned cc = q4 == 0 ? c0 : q4 == 1 ? c1 : q4 == 2 ? c2 : c3; const float ww = q4 == 0 ? w0 : q4 == 1 ? w1 : q4 == 2 ? w2 : w3;
                const unsigned code = 255u - (cc & 255u);
                const unsigned i1 = 127u - (kl[code >> 4] & 127u), i2 = 127u - (kl[16 + (code & 15u)] & 127u);
                eo[e] = (unsigned short)(i1 * 128u + i2); go[e] = ww * inv; }
            const size_t ob = ((size_t)row * 8 + u.pn) * 16 + q4 * 4;
            { u32x2 w; w.x = eo[0] | ((unsigned)eo[1] << 16); w.y = eo[2] | ((unsigned)eo[3] << 16); *(u32x2*)(ids + ob) = w; }
            *(f32x4*)(gw + ob) = (f32x4){go[0], go[1], go[2], go[3]};
            asm volatile("s_waitcnt lgkmcnt(0)" ::: "memory"); __builtin_amdgcn_s_barrier(); asm volatile("" ::: "memory");
        }
    }
};
template <class Epi, class Sched, bool ALIGN_EPI = false, bool SP2 = false, bool FP8 = false, bool I8 = false>
__device__ __forceinline__ void gemm_phase(PG8_LAS unsigned char* lds, const Gemm g, const Sched& S, const Epi& E) {
    const int tid = threadIdx.x, wid = __builtin_amdgcn_readfirstlane(tid >> 6), lane = tid & 63, wr = wid >> 2, wc = wid & 3, fr = lane & 15, fq = lane >> 4;
    const int K = g.K, nt = K / BK;
    unsigned voffA[2], voffB[2];
#pragma unroll
    for (int i = 0; i < 2; ++i) { int R, C; stage_rc(tid * 16 + i * 8192, R, C); const int Rb = Epi::PERM ? ((R & ~31) + perm32(R & 31)) : R;
        voffA[i] = (unsigned)(R * K + C) * 2u; voffB[i] = (unsigned)(Rb * K + C) * 2u; }
    const size_t kstep = (size_t)(BK * 2);
    const size_t hstep = (size_t)HALF * K * 2;
    const size_t tstep = 2 * hstep;
    const unsigned ldsw = (unsigned)wid * 1024u;
    const int aoff = lds_byte(wr * 64 + fr, fq * 8), boff = lds_byte(wc * 32 + fr, fq * 8);
#define PG8_SA(b, h) (((b) * 2 + (h)) * HTB)
#define PG8_SB(b, h) ((4 + (b) * 2 + (h)) * HTB)
#define PG8_STAGE(bufoff, gbase, voff) do { _Pragma("unroll") for (int _i = 0; _i < 2; ++_i) \
        __builtin_amdgcn_global_load_lds((const unsigned*)((const char*)(gbase) + (voff)[_i]), (PG8_LAS unsigned*)(lds + (bufoff) + ldsw + _i * 8192), 16, 0, 0); } while (0)
#define PG8_LD8(lo_, hi_) __builtin_bit_cast(i32x8, __builtin_shufflevector((lo_), (hi_), 0, 1, 2, 3, 4, 5, 6, 7))
#define PG8_LDA(dst, b, h) do { if constexpr (FP8) { _Pragma("unroll") for (int m = 0; m < 4; ++m) { const u32x4 l0_ = *(const PG8_LAS u32x4*)(lds + PG8_SA(b, h) + aoff + m * 2048), l1_ = *(const PG8_LAS u32x4*)(lds + PG8_SA(b, h) + aoff + m * 2048 + 1024); dst##8[m] = PG8_LD8(l0_, l1_); } } \
        else { _Pragma("unroll") for (int m = 0; m < 4; ++m) _Pragma("unroll") for (int k = 0; k < 2; ++k) dst[m][k] = *(const PG8_LAS bf16x8*)(lds + PG8_SA(b, h) + aoff + m * 2048 + k * 1024); } } while (0)
#define PG8_LDB(dst, b, h) do { if constexpr (FP8) { _Pragma("unroll") for (int n = 0; n < 2; ++n) { const u32x4 l0_ = *(const PG8_LAS u32x4*)(lds + PG8_SB(b, h) + boff + n * 2048), l1_ = *(const PG8_LAS u32x4*)(lds + PG8_SB(b, h) + boff + n * 2048 + 1024); dst##8[n] = PG8_LD8(l0_, l1_); } } \
        else { _Pragma("unroll") for (int n = 0; n < 2; ++n) _Pragma("unroll") for (int k = 0; k < 2; ++k) dst[n][k] = *(const PG8_LAS bf16x8*)(lds + PG8_SB(b, h) + boff + n * 2048 + k * 1024); } } while (0)
#define PG8_MMA(ai, bj, At, Bt) do { __builtin_amdgcn_s_setprio(1); \
        if constexpr (FP8) { _Pragma("unroll") for (int m = 0; m < 4; ++m) _Pragma("unroll") for (int n = 0; n < 2; ++n) \
            asm volatile("v_mfma_scale_f32_16x16x128_f8f6f4 %0, %1, %2, %0, %3, %3 op_sel_hi:[0,0,0]" : "+v"(acc[ai][bj][m][n]) : "v"(Bt##8[n]), "v"(At##8[m]), "v"(sc127));     \
            } \
        else if constexpr (I8) { _Pragma("unroll") for (int m = 0; m < 4; ++m) _Pragma("unroll") for (int n = 0; n < 2; ++n) _Pragma("unroll") for (int k = 0; k < 2; ++k) \
            acc[ai][bj][m][n] = __builtin_bit_cast(f32x4, __builtin_amdgcn_mfma_i32_16x16x64_i8(__builtin_bit_cast(i32x4, Bt[n][k]), __builtin_bit_cast(i32x4, At[m][k]), __builtin_bit_cast(i32x4, acc[ai][bj][m][n]), 0, 0, 0)); } \
        else { _Pragma("unroll") for (int m = 0; m < 4; ++m) _Pragma("unroll") for (int n = 0; n < 2; ++n) _Pragma("unroll") for (int k = 0; k < 2; ++k) \
            acc[ai][bj][m][n] = __builtin_amdgcn_mfma_f32_16x16x32_bf16(Bt[n][k], At[m][k], acc[ai][bj][m][n], 0, 0, 0); } \
        __builtin_amdgcn_s_setprio(0); } while (0)
#define PG8_WAIT_V(n) asm volatile("s_waitcnt vmcnt(" #n ")" ::: "memory")
#define PG8_WAIT_L(n) asm volatile("s_waitcnt lgkmcnt(" #n ")" ::: "memory")
#define PG8_BAR __builtin_amdgcn_s_barrier()
#define PG8_SCHED __builtin_amdgcn_sched_barrier(0)
    Unit cur, nxt; int ui = 0;
    if (!S.next(0, cur)) return;
    f32x4 acc[2][2][4][2];
#pragma unroll
    for (int a = 0; a < 2; ++a)
#pragma unroll
        for (int b = 0; b < 2; ++b)
#pragma unroll
            for (int m = 0; m < 4; ++m)
#pragma unroll
                for (int n = 0; n < 2; ++n) acc[a][b][m][n] = (f32x4){0.f, 0.f, 0.f, 0.f};
    bf16x8 At[4][2], B0[2][2], B1[2][2]; i32x8 At8[4], B08[2], B18[2];
    int sc127 = 127; asm volatile("" : "+v"(sc127));
    const char* cA = (const char*)g.A + (size_t)cur.pm * tstep; const char* cB = (const char*)g.Bt + (size_t)cur.pn * tstep;
    S.a_ready(cur);
    if constexpr (SP2) {
        PG8_STAGE(PG8_SB(0, 0), cB, voffB); PG8_STAGE(PG8_SB(0, 1), cB + hstep, voffB); PG8_STAGE(PG8_SA(0, 0), cA, voffA); PG8_STAGE(PG8_SA(0, 1), cA + hstep, voffA);
        if (wr == 1) PG8_BAR;
        PG8_WAIT_V(2); PG8_BAR;
        PG8_STAGE(PG8_SB(1, 0), cB + kstep, voffB); PG8_STAGE(PG8_SA(1, 0), cA + kstep, voffA); PG8_STAGE(PG8_SB(1, 1), cB + hstep + kstep, voffB);
        PG8_WAIT_V(6); PG8_BAR;
    } else {
        PG8_STAGE(PG8_SB(0, 0), cB, voffB); PG8_STAGE(PG8_SA(0, 0), cA, voffA); PG8_STAGE(PG8_SB(0, 1), cB + hstep, voffB); PG8_STAGE(PG8_SA(0, 1), cA + hstep, voffA);
        if (wr == 1) PG8_BAR;
        PG8_WAIT_V(4); PG8_BAR;
        PG8_STAGE(PG8_SB(1, 0), cB + kstep, voffB); PG8_STAGE(PG8_SA(1, 0), cA + kstep, voffA); PG8_STAGE(PG8_SB(1, 1), cB + hstep + kstep, voffB);
        PG8_WAIT_V(6); PG8_BAR;
    }
    for (;;) {
        const bool has_next = S.next(ui + 1, nxt);
        const char* nA = has_next ? (const char*)g.A + (size_t)nxt.pm * tstep : cA; const char* nB = has_next ? (const char*)g.Bt + (size_t)nxt.pn * tstep : cB;
        for (int t = 0; t < nt; t += 2) {
            if constexpr (Epi::HAS_MID) { if (t == Epi::MID_T) E.mid(acc, cur, wr, wc, fr, fq); }
            const bool last = (t == nt - 2);
            const char* a1 = cA + (size_t)(t + 1) * kstep;
            const char* a2 = last ? nA : cA + (size_t)(t + 2) * kstep; const char* b2 = last ? nB : cB + (size_t)(t + 2) * kstep;
            const char* a3 = a2 + kstep; const char* b3 = b2 + kstep;
            if (last && has_next) S.a_ready(nxt);
            if constexpr (SP2) {
            PG8_LDB(B0, 0, 0); PG8_LDB(B1, 0, 1); PG8_SCHED; PG8_LDA(At, 0, 0); PG8_STAGE(PG8_SA(1, 1), a1 + hstep, voffA);
            PG8_WAIT_V(8); PG8_WAIT_L(0); PG8_BAR; PG8_MMA(0, 0, At, B0); PG8_MMA(0, 1, At, B1); PG8_BAR; PG8_SCHED;
            PG8_LDA(At, 0, 1); PG8_STAGE(PG8_SB(0, 0), b2, voffB); PG8_STAGE(PG8_SB(0, 1), b2 + hstep, voffB); PG8_STAGE(PG8_SA(0, 0), a2, voffA);
            PG8_WAIT_V(8); PG8_WAIT_L(0); PG8_BAR; PG8_MMA(1, 0, At, B0); PG8_MMA(1, 1, At, B1); PG8_BAR; PG8_SCHED;
            PG8_LDB(B0, 1, 0); PG8_LDB(B1, 1, 1); PG8_SCHED; PG8_LDA(At, 1, 0); PG8_STAGE(PG8_SA(0, 1), a2 + hstep, voffA);
            PG8_WAIT_V(8); PG8_WAIT_L(0); PG8_BAR; PG8_MMA(0, 0, At, B0); PG8_MMA(0, 1, At, B1); PG8_BAR; PG8_SCHED;
            PG8_LDA(At, 1, 1); PG8_STAGE(PG8_SB(1, 0), b3, voffB); PG8_STAGE(PG8_SB(1, 1), b3 + hstep, voffB); PG8_STAGE(PG8_SA(1, 0), a3, voffA);
            PG8_WAIT_V(8); PG8_WAIT_L(0); PG8_BAR; PG8_MMA(1, 0, At, B0); PG8_MMA(1, 1, At, B1); PG8_BAR; PG8_SCHED;
            } else {
            PG8_LDB(B0, 0, 0); PG8_SCHED; PG8_LDA(At, 0, 0); PG8_STAGE(PG8_SA(1, 1), a1 + hstep, voffA);
            PG8_WAIT_L(8); PG8_BAR; PG8_WAIT_L(0); PG8_MMA(0, 0, At, B0); PG8_BAR; PG8_SCHED;
            PG8_LDB(B1, 0, 1); PG8_STAGE(PG8_SB(0, 0), b2, voffB);
            PG8_BAR; PG8_WAIT_L(0); PG8_MMA(0, 1, At, B1); PG8_BAR;
            PG8_LDA(At, 0, 1); PG8_STAGE(PG8_SA(0, 0), a2, voffA);
            PG8_BAR; PG8_WAIT_L(0); PG8_MMA(1, 0, At, B0); PG8_BAR; PG8_SCHED;
            PG8_STAGE(PG8_SB(0, 1), b2 + hstep, voffB);
            PG8_WAIT_V(6); PG8_BAR; PG8_MMA(1, 1, At, B1); PG8_BAR;
            PG8_LDB(B0, 1, 0); PG8_SCHED; PG8_LDA(At, 1, 0); PG8_STAGE(PG8_SA(0, 1), a2 + hstep, voffA);
            PG8_WAIT_L(8); PG8_BAR; PG8_WAIT_L(0); PG8_MMA(0, 0, At, B0); PG8_BAR; PG8_SCHED;
            PG8_LDB(B1, 1, 1); PG8_STAGE(PG8_SB(1, 0), b3, voffB);
            PG8_BAR; PG8_WAIT_L(0); PG8_MMA(0, 1, At, B1); PG8_BAR;
            PG8_LDA(At, 1, 1); PG8_STAGE(PG8_SA(1, 0), a3, voffA);
            PG8_BAR; PG8_WAIT_L(0); PG8_MMA(1, 0, At, B0); PG8_BAR; PG8_SCHED;
            PG8_STAGE(PG8_SB(1, 1), b3 + hstep, voffB);
            PG8_WAIT_V(6); PG8_BAR; PG8_MMA(1, 1, At, B1); PG8_BAR;
            }
        }
        if constexpr (FP8) asm volatile("s_nop 15\n\ts_nop 15" ::: "memory");
        if constexpr (ALIGN_EPI) { if (wr == 0) PG8_BAR; }
        if constexpr (!Epi::AFTER_DRAIN) { E(acc, cur, wr, wc, fr, fq); S.done(cur); }
        if (!has_next) break;
#pragma unroll
        for (int a = 0; a < 2; ++a)
#pragma unroll
            for (int b = 0; b < 2; ++b)
#pragma unroll
                for (int m = 0; m < 4; ++m)
#pragma unroll
                    for (int n = 0; n < 2; ++n) acc[a][b][m][n] = (f32x4){0.f, 0.f, 0.f, 0.f};
        cur = nxt; cA = nA; cB = nB; ++ui;
        if constexpr (ALIGN_EPI) { if (wr == 1) PG8_BAR; }
    }
    PG8_WAIT_V(0);
    if constexpr (!ALIGN_EPI) { if (wr == 0) PG8_BAR; }
    PG8_BAR;
    if constexpr (Epi::AFTER_DRAIN) { E.fused(acc, cur, wr, wc, fr, fq, lds, wid, lane); S.done(cur); }
#undef PG8_SA
#undef PG8_SB
#undef PG8_STAGE
#undef PG8_LDA
#undef PG8_LD8
#undef PG8_LDB
#undef PG8_MMA
#undef PG8_WAIT_V
#undef PG8_WAIT_L
#undef PG8_BAR
#undef PG8_SCHED
}
}


namespace att {
#define ALAS __attribute__((address_space(3)))
typedef unsigned short bf16;
typedef short bf16x8 __attribute__((ext_vector_type(8)));
typedef short s16x4 __attribute__((ext_vector_type(4)));
typedef float f32x16 __attribute__((ext_vector_type(16)));
typedef float f32x4 __attribute__((ext_vector_type(4)));
typedef float f32x2 __attribute__((ext_vector_type(2)));
typedef unsigned u32x4 __attribute__((ext_vector_type(4)));
typedef __bf16 bf16x2_t __attribute__((ext_vector_type(2)));
constexpr int SEQ = 4096;
constexpr int VPITCH = 144;
constexpr float LOG2E = 1.4426950408889634f, LN2 = 0.6931471805599453f;
__device__ __forceinline__ unsigned pkbf(float lo, float hi) { f32x2 v = {lo, hi}; bf16x2_t b = __builtin_convertvector(v, bf16x2_t); return __builtin_bit_cast(unsigned, b); }
__device__ __forceinline__ void wave_lds_sync() { asm volatile("s_waitcnt lgkmcnt(0)" ::: "memory"); }
__device__ __forceinline__ s16x4 vtr(const ALAS unsigned char* p) { return __builtin_bit_cast(s16x4, __builtin_amdgcn_ds_read_tr16_b64_v4i16((ALAS s16x4*)p)); }
__device__ __forceinline__ int crow(int r, int hi) { return (r & 3) + 8 * (r >> 2) + 4 * hi; }

__device__ __forceinline__ void pv_tile(f32x16& o0, f32x16& o1, const float (&a)[16], const ALAS unsigned char* vt, int lane) {
    const int g = lane >> 4, i = lane & 15, q_ = i >> 2, p_ = i & 3, h = lane >> 5;
    const ALAS unsigned char* vb = vt + (8 * h + q_) * VPITCH + (16 * (g & 1) + 4 * p_) * 2;
    u32x4 pw0, pw1;
    pw0.x = pkbf(a[0], a[1]); pw0.y = pkbf(a[2], a[3]); pw0.z = pkbf(a[4], a[5]); pw0.w = pkbf(a[6], a[7]);
    pw1.x = pkbf(a[8], a[9]); pw1.y = pkbf(a[10], a[11]); pw1.z = pkbf(a[12], a[13]); pw1.w = pkbf(a[14], a[15]);
    const bf16x8 pa0 = __builtin_bit_cast(bf16x8, pw0), pa1 = __builtin_bit_cast(bf16x8, pw1);
#pragma unroll
    for (int s = 0; s < 2; ++s) {
        const s16x4 l0 = vtr(vb + (16 * s) * VPITCH), h0 = vtr(vb + (16 * s + 4) * VPITCH);
        const s16x4 l1 = vtr(vb + (16 * s) * VPITCH + 64), h1 = vtr(vb + (16 * s + 4) * VPITCH + 64);
        const bf16x8 v0 = (bf16x8){l0[0], l0[1], l0[2], l0[3], h0[0], h0[1], h0[2], h0[3]};
        const bf16x8 v1 = (bf16x8){l1[0], l1[1], l1[2], l1[3], h1[0], h1[1], h1[2], h1[3]};
        o0 = __builtin_amdgcn_mfma_f32_32x32x16_bf16(s ? pa1 : pa0, v0, o0, 0, 0, 0);
        o1 = __builtin_amdgcn_mfma_f32_32x32x16_bf16(s ? pa1 : pa0, v1, o1, 0, 0, 0);
    }
}
__device__ __forceinline__ void bcast_rows(float v, ALAS float* sc, int r32, int hi, float (&out)[16]) {
    if (hi == 0) sc[r32] = v;
    wave_lds_sync();
#pragma unroll
    for (int g = 0; g < 4; ++g) { const f32x4 t = *(const ALAS f32x4*)(sc + 8 * g + 4 * hi); out[4 * g] = t[0]; out[4 * g + 1] = t[1]; out[4 * g + 2] = t[2]; out[4 * g + 3] = t[3]; }
    wave_lds_sync();
}
__device__ __forceinline__ void store_o(const f32x16& o0, const f32x16& o1, ALAS unsigned char* stg, bf16* dst  , size_t rstride_elems, int lane) {
    const int r32 = lane & 31, hi = lane >> 5;
    wave_lds_sync();
#pragma unroll
    for (int r = 0; r < 16; ++r) { const int q = crow(r, hi);
        *(ALAS unsigned short*)(stg + q * VPITCH + r32 * 2) = (unsigned short)(pkbf(o0[r], 0.f) & 0xffffu);
        *(ALAS unsigned short*)(stg + q * VPITCH + 64 + r32 * 2) = (unsigned short)(pkbf(o1[r], 0.f) & 0xffffu); }
    wave_lds_sync();
#pragma unroll
    for (int i = 0; i < 4; ++i) { const int row = 8 * i + (lane >> 3), ch = lane & 7; const u32x4 v = *(const ALAS u32x4*)(stg + row * VPITCH + ch * 16); *(u32x4*)(dst + (size_t)row * rstride_elems + ch * 8) = v; }
    wave_lds_sync();
}

__device__ __forceinline__ void sb_item(const bf16* QS, const bf16* KS, const bf16* VS, bf16* OC, int b, int h, int qt, ALAS unsigned char* wl, int lane) {
    const int r32 = lane & 31, hi = lane >> 5;
    const int t0 = qt * 32; const size_t rowb = (size_t)b * SEQ;
    const int kperm = (r32 & ~12) | ((r32 & 4) << 1) | ((r32 & 8) >> 1);
    bf16x8 qf[4];
    { const bf16* qp = QS + (rowb + t0 + r32) * 512 + h * 64 + hi * 8;
#pragma unroll
      for (int d0 = 0; d0 < 4; ++d0) qf[d0] = *(const bf16x8*)(qp + d0 * 16); }
    f32x16 o0 = {}, o1 = {}; float R = 0.f;
    for (int key0 = t0; key0 >= 0; key0 -= 32) {
        const bf16* kp = KS + (rowb + key0 + kperm) * 512 + h * 64 + hi * 8;
        bf16x8 kf[4];
#pragma unroll
        for (int d0 = 0; d0 < 4; ++d0) kf[d0] = *(const bf16x8*)(kp + d0 * 16);
        u32x4 vv[4];
#pragma unroll
        for (int i = 0; i < 4; ++i) vv[i] = *(const u32x4*)(VS + (rowb + key0 + 8 * i + (lane >> 3)) * 512 + h * 64 + (lane & 7) * 8);
        f32x16 p = {};
#pragma unroll
        for (int d0 = 0; d0 < 4; ++d0) p = __builtin_amdgcn_mfma_f32_32x32x16_bf16(kf[d0], qf[d0], p, 0, 0, 0);
#pragma unroll
        for (int i = 0; i < 4; ++i) *(ALAS u32x4*)(wl + (8 * i + (lane >> 3)) * VPITCH + (lane & 7) * 16) = vv[i];
        const bool diag = (key0 == t0);
        float z2[16], L2[16];
#pragma unroll
        for (int r = 0; r < 16; ++r) { const int kk = (r & 7) + 8 * hi + 16 * (r >> 3); const float zz = p[r];
            const float sp = fmaxf(zz, 0.f) + __builtin_amdgcn_logf(1.0f + __builtin_amdgcn_exp2f(-fabsf(zz)));
            const bool valid = !diag || (kk < r32); z2[r] = zz; L2[r] = valid ? sp : 0.f; }
        float c[16];
        c[15] = L2[15];
#pragma unroll
        for (int r = 14; r >= 8; --r) c[r] = c[r + 1] + L2[r];
        c[7] = L2[7];
#pragma unroll
        for (int r = 6; r >= 0; --r) c[r] = c[r + 1] + L2[r];
        const float TB = c[8], TA = c[0];
        const float TBo = __shfl_xor(TB, 32), TAo = __shfl_xor(TA, 32);
        const float offB = R + (hi ? 0.f : TBo);
        const float offA = R + TB + TBo + (hi ? 0.f : TAo);
        float a[16];
#pragma unroll
        for (int r = 0; r < 16; ++r) { const int kk = (r & 7) + 8 * hi + 16 * (r >> 3); const bool valid = !diag || (kk < r32);
            const float e = __builtin_amdgcn_exp2f(z2[r] - (c[r] + (r < 8 ? offA : offB))); a[r] = valid ? e : 0.f; }
        R += (TA + TB) + (TAo + TBo);
        wave_lds_sync();
        pv_tile(o0, o1, a, wl, lane);
        wave_lds_sync();
        if (__all(R > 40.0f * LOG2E)) break;
    }
    store_o(o0, o1, wl, OC + (rowb + t0) * 768 + h * 64, 768, lane);
}

constexpr int DLU_WAVE = 5120;
constexpr int DLU_O = 8 * DLU_WAVE, DLU_M = DLU_O + 512 * 128, DLU_L = DLU_M + 2048, DLU_BYTES = DLU_L + 2048;
__device__ __forceinline__ void dl_unit(const bf16* QD, const bf16* KD, const bf16* VD, bf16* OC, int b, int j, int blk, ALAS unsigned char* lds, int wave, int lane) {
    const int r32 = lane & 31, hi = lane >> 5;
    const size_t rowb = (size_t)b * SEQ;
    const int t0 = 512 * blk;
    const int kperm = (r32 & ~12) | ((r32 & 4) << 1) | ((r32 & 8) >> 1);
    ALAS unsigned char* wl = lds + wave * DLU_WAVE;
    ALAS float* sc = (ALAS float*)(wl + 4608);
    ALAS unsigned short* OL = (ALAS unsigned short*)(lds + DLU_O);
    ALAS float* ML = (ALAS float*)(lds + DLU_M); ALAS float* LL = (ALAS float*)(lds + DLU_L);
    for (int g = 2; g >= 0; --g) {
        const int hh = 4 * g + j, sh = 2 * g, r = 1 << sh;
        const float slope2 = __builtin_amdgcn_exp2f(-8.0f * (float)(hh + 1) / 12.0f) * LOG2E;
        const float sr = slope2 * (float)r;
        for (int it = wave; it < 16; it += 8) {
            const int q0 = g == 2 ? it : g == 1 ? (it & 3) + 128 * (it >> 2) : 32 * it;
            const int tq = t0 + q0 + r * r32, tmax = t0 + q0 + 31 * r;
            bf16x8 qf[4];
            { const bf16* qp = QD + (rowb + tq) * 768 + hh * 64 + hi * 8;
#pragma unroll
              for (int d0 = 0; d0 < 4; ++d0) qf[d0] = *(const bf16x8*)(qp + d0 * 16); }
            const int klo = 31 - r32; int khi = klo + 128; { const int kmaxtok = tmax >> sh; khi = khi < kmaxtok ? khi : kmaxtok; }
            const unsigned krange = (unsigned)(khi - klo);
            f32x16 o0 = {}, o1 = {}; float mrun = -3.0e38f, lrun = 0.f;
            if (g != 2) {
                mrun = ML[q0 + r * r32]; lrun = hi ? 0.f : LL[q0 + r * r32];
#pragma unroll
                for (int q = 0; q < 16; ++q) { const int tl = q0 + r * crow(q, hi);
                    o0[q] = __uint_as_float((unsigned)OL[tl * 64 + r32] << 16); o1[q] = __uint_as_float((unsigned)OL[tl * 64 + 32 + r32] << 16); }
            }
            for (int kt = 0; kt < 5; ++kt) {
                int sk = tmax - r * (32 * kt + kperm); sk = sk < 0 ? 0 : sk;
                const bf16* kp = KD + (rowb + sk) * 768 + hh * 64 + hi * 8;
                bf16x8 kf[4];
#pragma unroll
                for (int d0 = 0; d0 < 4; ++d0) kf[d0] = *(const bf16x8*)(kp + d0 * 16);
                u32x4 vv[4];
#pragma unroll
                for (int i = 0; i < 4; ++i) { int sv = tmax - r * (32 * kt + 8 * i + (lane >> 3)); sv = sv < 0 ? 0 : sv; vv[i] = *(const u32x4*)(VD + (rowb + sv) * 768 + hh * 64 + (lane & 7) * 8); }
                const int dk = 32 * kt + 8 * hi - klo;
                const float tb = -sr * (float)dk;
                f32x16 p;
#pragma unroll
                for (int q = 0; q < 16; ++q) p[q] = tb - sr * (float)((q & 7) + 16 * (q >> 3));
#pragma unroll
                for (int d0 = 0; d0 < 4; ++d0) p = __builtin_amdgcn_mfma_f32_32x32x16_bf16(kf[d0], qf[d0], p, 0, 0, 0);
#pragma unroll
                for (int i = 0; i < 4; ++i) *(ALAS u32x4*)(wl + (8 * i + (lane >> 3)) * VPITCH + (lane & 7) * 16) = vv[i];
                float z2[16]; float mt = -3.0e38f;
#pragma unroll
                for (int q = 0; q < 16; ++q) { const bool valid = (unsigned)(dk + ((q & 7) + 16 * (q >> 3))) <= krange; z2[q] = valid ? p[q] : -INFINITY; mt = fmaxf(mt, z2[q]); }
                mt = fmaxf(mt, __shfl_xor(mt, 32));
                if (__any(mt > mrun + 8.0f)) {
                    const float mnew = fmaxf(mrun, mt); const float alpha = __builtin_amdgcn_exp2f(mrun - mnew);
                    lrun *= alpha; float al[16]; bcast_rows(alpha, sc, r32, hi, al);
#pragma unroll
                    for (int q = 0; q < 16; ++q) { o0[q] *= al[q]; o1[q] *= al[q]; }
                    mrun = mnew;
                }
                float a[16]; float ls = 0.f;
#pragma unroll
                for (int q = 0; q < 16; ++q) { a[q] = __builtin_amdgcn_exp2f(z2[q] - mrun); ls += a[q]; }
                lrun += ls;
                wave_lds_sync();
                pv_tile(o0, o1, a, wl, lane);
                wave_lds_sync();
            }
            const float ltot = lrun + __shfl_xor(lrun, 32);
            if (g != 0) {
                if (hi == 0) { ML[q0 + r * r32] = mrun; LL[q0 + r * r32] = ltot; }
#pragma unroll
                for (int q = 0; q < 16; ++q) { const int tl = q0 + r * crow(q, hi);
                    OL[tl * 64 + r32] = (unsigned short)(pkbf(o0[q], 0.f) & 0xffffu); OL[tl * 64 + 32 + r32] = (unsigned short)(pkbf(o1[q], 0.f) & 0xffffu); }
            } else {
                float il[16]; bcast_rows(1.0f / ltot, sc, r32, hi, il);
#pragma unroll
                for (int q = 0; q < 16; ++q) { o0[q] *= il[q]; o1[q] *= il[q]; }
                store_o(o0, o1, wl, OC + (rowb + t0 + q0) * 768 + 512 + j * 64, 768, lane);
            }
        }
        asm volatile("s_waitcnt lgkmcnt(0)" ::: "memory"); __builtin_amdgcn_s_barrier(); asm volatile("" ::: "memory");
    }
}
#undef ALAS
}

constexpr int NWAVES = 8;
#ifndef MK_N_LAUNCHES
#define MK_N_LAUNCHES 1
#endif
#ifndef MK_LAST_PHASE
#define MK_LAST_PHASE 8
#endif
constexpr int N_LAUNCHES = MK_N_LAUNCHES;
constexpr int PER_PHASE = 8;

constexpr int BATCH = 16, SEQ = 4096, D = 1024, T = BATCH * SEQ;
constexpr int N1 = 5888;
constexpr int NEXP = 16384;
constexpr size_t MiB = 1u << 20;
constexpr size_t WS_CTL = 0, CTL_ZERO_BYTES = 1 * MiB;
constexpr size_t WS_WIN = 2 * MiB;
constexpr size_t WS_WCAT = 16 * MiB;
constexpr size_t WS_WOUT = 18 * MiB;
constexpr size_t WS_WC = 20 * MiB;
constexpr size_t WS_RINV1 = 24 * MiB;
constexpr size_t WS_RINV2 = 25 * MiB;
constexpr size_t WS_USC = 25 * MiB + 512 * 1024, WS_VSC = 25 * MiB + 768 * 1024;
constexpr size_t WS_SSQ = 26 * MiB;
constexpr size_t WS_U8 = 32 * MiB;
constexpr size_t WS_V8 = 64 * MiB;
constexpr size_t WS_IDS = 96 * MiB;
constexpr size_t WS_GW = 112 * MiB;
constexpr size_t WS_XB = 144 * MiB;
constexpr size_t WS_OC = 880 * MiB;
constexpr size_t WS_QS = 272 * MiB, WS_KS = 336 * MiB, WS_VS = 400 * MiB;
constexpr size_t WS_QD = 464 * MiB, WS_KD = 560 * MiB, WS_VD = 656 * MiB;
constexpr size_t WS_GT = 752 * MiB;
constexpr size_t WS_COEF = 272 * MiB;
constexpr size_t WS_MIX = 272 * MiB;
constexpr size_t WS_X1B = 400 * MiB;
constexpr size_t WS_HQ = 528 * MiB;
constexpr size_t WS_HS2 = 24 * MiB + 512 * 1024;
constexpr size_t WS_XB8 = 72 * MiB;
constexpr size_t WS_WG8 = 40 * MiB;
constexpr size_t WS_PART = 56 * MiB;
constexpr size_t WS_RMAXF = 24 * MiB + 768 * 1024;
constexpr size_t WS_WOS = 46 * MiB + 512 * 1024;
constexpr size_t WS_WCS = 46 * MiB;
constexpr size_t WS_WCF = 48 * MiB;
constexpr size_t WS_XS = 24 * MiB + 256 * 1024;
constexpr size_t WS_GCS = 47 * MiB;
constexpr size_t WS_END = 1008 * MiB;
constexpr int CW_BAR = 4096;
constexpr int CW_OMAX = 28672;
constexpr int CW_RMAX = 65536;
constexpr int CW_RCNT = 131072;
constexpr int CW_WMAX = 24576;
constexpr int CW_GMAX = 16384;
constexpr int CW_XRANK = 8192;

constexpr int RING_OFF = 0, RING_BYTES = 131072;
constexpr int LDSCTL_OFF = 143360, MISC_OFF = LDSCTL_OFF + 320;
constexpr int LDS_BYTES = 147456;
static_assert(MISC_OFF + 128 <= LDS_BYTES, "LDS map");
#define GAS __attribute__((address_space(1)))
#define LAS __attribute__((address_space(3)))
typedef unsigned short bf16;
typedef unsigned v4u __attribute__((ext_vector_type(4)));
typedef float f32x4 __attribute__((ext_vector_type(4)));
typedef short bf16x8 __attribute__((ext_vector_type(8)));
typedef GAS unsigned gu32;
typedef GAS unsigned long long gu64;
#define RLX_AGENT __ATOMIC_RELAXED, __HIP_MEMORY_SCOPE_AGENT
#define LDS_WAIT() asm volatile("s_waitcnt lgkmcnt(0)" ::: "memory")
#define VM_WAIT() asm volatile("s_waitcnt vmcnt(0)" ::: "memory")
__device__ __forceinline__ unsigned long long rt() { return __builtin_amdgcn_s_memrealtime(); }
__device__ __forceinline__ unsigned f2bf(float f) { unsigned u = __builtin_bit_cast(unsigned, f); return (u + 0x7fffu + ((u >> 16) & 1u)) >> 16; }
__device__ __forceinline__ unsigned pk2(float lo, float hi) { return f2bf(lo) | (f2bf(hi) << 16); }

#define XB_TMO      128
#define XB_XCNT(j)  (256  + 64 * (j))
#define XB_XSUB(j)  (1280 + 64 * (j))
#define XB_XGEN(j)  (2304 + 64 * (j))
#define XB_TOP      3328
#define XB_TOPGEN   3392
#define XCD_BAR_WORDS 3456
#define XB_SPIN_CAP (1u << 18)

__device__ __forceinline__ unsigned xb_ld(unsigned* p)              { return __hip_atomic_load(p, __ATOMIC_RELAXED, __HIP_MEMORY_SCOPE_AGENT); }
__device__ __forceinline__ unsigned xb_add(unsigned* p, unsigned v) { return __hip_atomic_fetch_add(p, v, __ATOMIC_RELAXED, __HIP_MEMORY_SCOPE_AGENT); }
__device__ __forceinline__ unsigned xb_xcc_id() { return (unsigned)__builtin_amdgcn_s_getreg((3 << 11) | 20) & 0xFu; }
#define XB_SPIN(cond, bar) do { unsigned _sp = 0; while (cond) { __builtin_amdgcn_s_sleep(1); \
    if ((++_sp & 255u) == 0u) { if (xb_ld(&(bar)[XB_TMO])) break; if (_sp > XB_SPIN_CAP) { atomicAdd(&(bar)[XB_TMO], 1u); break; } } } } while (0)

struct XcdBarrier {
    unsigned* bar; unsigned x;
    volatile LAS unsigned* st;
};

__device__ __forceinline__ XcdBarrier xcd_barrier_post(unsigned* bar, volatile LAS unsigned* st) {
    XcdBarrier b; b.bar = bar; b.x = xb_xcc_id(); b.st = st;
    if (threadIdx.x == 0) (void)xb_add(&bar[XB_XCNT(b.x)], 1u);
    return b;
}
__device__ __forceinline__ void xcd_barrier_complete(unsigned* bar, unsigned x, unsigned& nloc, unsigned& nx) {
    const unsigned G = gridDim.x * gridDim.y * gridDim.z;
    unsigned sum, cnt, mine, sp = 0u;
    for (;;) {
        sum = 0u; cnt = 0u; mine = 0u;
#pragma unroll
        for (unsigned j = 0; j < 16; ++j) { const unsigned c = xb_ld(&bar[XB_XCNT(j)]); sum += c; cnt += (c > 0u) ? 1u : 0u; mine = (j == x) ? c : mine; }
        if (sum == G) break;
        __builtin_amdgcn_s_sleep(1);
        if ((++sp & 255u) == 0u) { if (xb_ld(&bar[XB_TMO])) break; if (sp > XB_SPIN_CAP) { atomicAdd(&bar[XB_TMO], 1u); break; } }
    }
    nloc = mine > 0u ? mine : 1u; nx = cnt > 0u ? cnt : 1u;
}

__device__ __forceinline__ void xcd_barrier(const XcdBarrier& b) {
    asm volatile("s_waitcnt vmcnt(0)" ::: "memory");
    __syncthreads();
    if (threadIdx.x == 0) {
        unsigned* bar = b.bar;
        __builtin_amdgcn_s_waitcnt(0);
        unsigned nloc = b.st[0], nx = b.st[1];
        if (nloc == 0u) { xcd_barrier_complete(bar, b.x, nloc, nx); b.st[0] = nloc; b.st[1] = nx; }
        const unsigned old = xb_add(&bar[XB_XSUB(b.x)], 1u);
        const unsigned gen = old / nloc;
        if (old + 1u == (gen + 1u) * nloc) {
            __builtin_amdgcn_fence(__ATOMIC_RELEASE, "agent");
            asm volatile("s_waitcnt vmcnt(0)" ::: "memory");
            const unsigned og = xb_add(&bar[XB_TOP], 1u);
            const unsigned tg = og / nx;
            if (og + 1u == (tg + 1u) * nx) xb_add(&bar[XB_TOPGEN], 1u);
            else XB_SPIN(xb_ld(&bar[XB_TOPGEN]) == tg, bar);
            __builtin_amdgcn_fence(__ATOMIC_ACQUIRE, "agent");
            xb_add(&bar[XB_XGEN(b.x)], 1u);
            asm volatile("s_waitcnt vmcnt(0)" ::: "memory");
        } else {
            XB_SPIN(xb_ld(&bar[XB_XGEN(b.x)]) == gen, bar);
            __builtin_amdgcn_fence(__ATOMIC_ACQUIRE, "agent");
            asm volatile("s_waitcnt vmcnt(0)" ::: "memory");
        }
    }
    __syncthreads();
}

typedef float f32x2 __attribute__((ext_vector_type(2)));
typedef unsigned v2u __attribute__((ext_vector_type(2)));
typedef int v4i __attribute__((ext_vector_type(4)));
typedef int v8i __attribute__((ext_vector_type(8)));
typedef _Float16 h2_t __attribute__((ext_vector_type(2)));
struct Frame {
    LAS unsigned char* lds;
    volatile LAS unsigned* MISC;
    gu32* ctl;
    int tid, lane, wave;
    int vcu, G;
};
__device__ __forceinline__ float wave_sum(float v) {
#pragma unroll
    for (int o = 1; o < 64; o <<= 1) v += __shfl_xor(v, o);
    return v;
}
__device__ __forceinline__ float wave_max(float v) {
#pragma unroll
    for (int o = 1; o < 64; o <<= 1) v = fmaxf(v, __shfl_xor(v, o));
    return v;
}
constexpr int NB16 = 0, N8 = 5888 - NB16;
__device__ __forceinline__ int win_row(int n) { if (n < 1536 || n >= 3072) return n; const int t = (n - 1536) >> 8, ln = (n - 1536) & 255, hl = ln >> 6, d = ln & 63; return 1536 + t * 256 + 32 * hl + (d & 31) + 128 * (d >> 5); }
__device__ __forceinline__ void p0_transpose_item(const float* W, int N, const float* gain, bf16* WT, int ldt, int koff, int mode, LAS float* scr, int item, int lane) {
    const int nblk = N / 32, kb = item / nblk, nb = item % nblk, k0 = 64 * kb, n0 = 32 * nb;
#pragma unroll 8
    for (int i = 0; i < 32; ++i) { const int kk = 2 * i + (lane >> 5); float v = W[(size_t)(k0 + kk) * N + n0 + (lane & 31)]; if (gain) v *= gain[k0 + kk]; scr[kk * 33 + (lane & 31)] = v; }
    LDS_WAIT(); asm volatile("" ::: "memory");
    const int c = lane & 7;
#pragma unroll
    for (int j = 0; j < 4; ++j) { const int n = (lane >> 3) + 8 * j; const LAS float* s = scr + (8 * c) * 33 + n;
        v4u o; o.x = pk2(s[0 * 33], s[1 * 33]); o.y = pk2(s[2 * 33], s[3 * 33]); o.z = pk2(s[4 * 33], s[5 * 33]); o.w = pk2(s[6 * 33], s[7 * 33]);
        const int rown = mode ? win_row(n0 + n) : (n0 + n);
        *(GAS v4u*)(WT + (size_t)rown * ldt + koff + k0 + 8 * c) = o; }
    LDS_WAIT(); asm volatile("" ::: "memory");
}
__device__ __forceinline__ void p0_gate_max_item(const float* W, int N, const float* gain, unsigned* gmax, int kb, int n0, int lane) {
    const int k0 = 64 * kb; float am = 0.f;
#pragma unroll 8
    for (int i = 0; i < 32; ++i) { const int kk = 2 * i + (lane >> 5); am = fmaxf(am, fabsf(W[(size_t)(k0 + kk) * N + n0 + (lane & 31)] * (gain ? gain[k0 + kk] : 1.0f))); }
    am = fmaxf(am, __shfl_xor(am, 32));
    if (lane < 32) atomicMax(gmax + (n0 - NB16) + lane, __float_as_uint(am));
}
__device__ __forceinline__ void p0_gate_fp8_item(const float* W, int N, const float* gain, const unsigned* gmax, unsigned char* WG, float* cs, LAS float* scr, int item, int lane, int ncols = N8, bool perm = true) {
    const int kb = item / (ncols / 32), nb = item % (ncols / 32), k0 = 64 * kb, n0 = 32 * nb;
#pragma unroll 8
    for (int i = 0; i < 32; ++i) { const int kk = 2 * i + (lane >> 5); scr[kk * 33 + (lane & 31)] = W[(size_t)(k0 + kk) * N + NB16 + n0 + (lane & 31)] * (gain ? gain[k0 + kk] : 1.0f); }
    LDS_WAIT(); asm volatile("" ::: "memory");
    const int c = lane & 7;
#pragma unroll
    for (int j = 0; j < 4; ++j) { const int n = (lane >> 3) + 8 * j; const LAS float* sp = scr + (8 * c) * 33 + n;
        const float am = __uint_as_float(xb_ld((unsigned*)gmax + n0 + n)); const float sc = am > 0.f ? 127.0f / am : 0.f;
        unsigned p0 = 0, p1 = 0;
#pragma unroll
        for (int e = 0; e < 4; ++e) { p0 |= ((unsigned)(int)__builtin_rintf(sp[e * 33] * sc) & 0xffu) << (8 * e); p1 |= ((unsigned)(int)__builtin_rintf(sp[(4 + e) * 33] * sc) & 0xffu) << (8 * e); }
        const int prow = perm ? win_row(NB16 + n0 + n) - NB16 : n0 + n;
        *(GAS v2u*)(WG + (size_t)prow * 1024 + k0 + 8 * c) = (v2u){p0, p1};
        if (kb == 0 && c == 0) cs[prow] = am * (1.0f / 127.0f); }
    LDS_WAIT(); asm volatile("" ::: "memory");
}
__device__ __forceinline__ void quant_row_fp8(const float* src, const float* gain, unsigned char* dst, size_t slice_stride, float* scale_out, int lane) {
    f32x4 v[4]; float am = 0.f;
#pragma unroll
    for (int j = 0; j < 4; ++j) { v[j] = *(const GAS f32x4*)(src + 256 * j + 4 * lane); if (gain) v[j] = v[j] * *(const GAS f32x4*)(gain + 256 * j + 4 * lane);
        am = fmaxf(am, fmaxf(fmaxf(fabsf(v[j][0]), fabsf(v[j][1])), fmaxf(fabsf(v[j][2]), fabsf(v[j][3])))); }
    am = wave_max(am);
    const int ex = (int)((__float_as_uint(am) >> 23) & 0xffu);
    const float s = (ex == 0) ? 1.0f : __uint_as_float((unsigned)(127 + 7 - (ex - 127)) << 23);
    const float is = (ex == 0) ? 1.0f : __uint_as_float((unsigned)(127 - 7 + (ex - 127)) << 23);
    if (lane == 0) *scale_out = is;
#pragma unroll
    for (int j = 0; j < 4; ++j) { int pk = __builtin_amdgcn_cvt_pk_fp8_f32(v[j][0] * s, v[j][1] * s, 0, false); pk = __builtin_amdgcn_cvt_pk_fp8_f32(v[j][2] * s, v[j][3] * s, pk, true);
        const int col = 256 * j + 4 * lane; *(GAS int*)(dst + (size_t)(col >> 7) * slice_stride + (col & 127)) = pk; }
}
__device__ __forceinline__ void quant_row_i4v(const float* src, unsigned char* dst, size_t slice_stride, float* scale_out, int lane) {
    f32x4 v[4]; float am = 0.f, ss = 0.f;
#pragma unroll
    for (int i = 0; i < 4; ++i) { const f32x4 t = *(const GAS f32x4*)(src + 16 * lane + 4 * i); v[i] = t;
        am = fmaxf(am, fmaxf(fmaxf(fabsf(t[0]), fabsf(t[1])), fmaxf(fabsf(t[2]), fabsf(t[3])))); ss += (t[0] * t[0] + t[1] * t[1]) + (t[2] * t[2] + t[3] * t[3]); }
    am = wave_max(am); ss = wave_sum(ss);
    const float clipv = fminf(am, 2.75f * sqrtf(ss * (1.0f / 1024.0f)));
    const float s = clipv > 0.f ? 7.0f / clipv : 0.f;
    if (lane == 0) *scale_out = clipv * (1.0f / (7.0f * 16.0f));
    unsigned pk[2];
#pragma unroll
    for (int d = 0; d < 2; ++d) { pk[d] = 0u;
#pragma unroll
        for (int n8 = 0; n8 < 8; ++n8) { int q0 = (int)__builtin_rintf(v[2 * d + (n8 >> 2)][n8 & 3] * s); q0 = q0 < -7 ? -7 : (q0 > 7 ? 7 : q0); pk[d] |= (unsigned)(q0 & 15) << (4 * n8); } }
    *(GAS v2u*)(dst + (size_t)(lane >> 4) * slice_stride + 8 * (lane & 15)) = (v2u){pk[0], pk[1]};
}
__device__ __forceinline__ void quant_row_fp4(const float* src, unsigned char* dst, size_t slice_stride, float* scale_out, int lane) {
    f32x4 v[4]; float am = 0.f;
#pragma unroll
    for (int j = 0; j < 4; ++j) { v[j] = *(const GAS f32x4*)(src + 256 * j + 4 * lane); am = fmaxf(am, fmaxf(fmaxf(fabsf(v[j][0]), fabsf(v[j][1])), fmaxf(fabsf(v[j][2]), fabsf(v[j][3])))); }
    am = wave_max(am);
    const float s = am > 0.f ? 6.0f / am : 0.f;
    if (lane == 0) *scale_out = am * (1.0f / 6.0f);
#pragma unroll
    for (int j = 0; j < 4; ++j) { unsigned pk = __builtin_amdgcn_cvt_scalef32_pk_fp4_f32(0u, v[j][0] * s, v[j][1] * s, 1.0f, 0); pk = __builtin_amdgcn_cvt_scalef32_pk_fp4_f32(pk, v[j][2] * s, v[j][3] * s, 1.0f, 1);
        *(GAS unsigned short*)(dst + (size_t)j * slice_stride + 2 * lane) = (unsigned short)(pk & 0xffffu); }
}
__device__ __forceinline__ void quant_row_i4(const float* src, const float* gain, unsigned char* dst, float* scale_out, int lane) {
    f32x4 v[4]; float am = 0.f, ss = 0.f;
    const int p16 = (lane >> 2) & 15, wl = lane & 3;
#pragma unroll
    for (int ld = 0; ld < 2; ++ld)
#pragma unroll
        for (int sn = 0; sn < 2; ++sn) { const int hd = 2 * (4 * ld + wl) + sn; const int idx = 256 * (hd >> 2) + 16 * p16 + 4 * (hd & 3);
            f32x4 t = *(const GAS f32x4*)(src + idx); if (gain) t = t * *(const GAS f32x4*)(gain + idx); v[2 * ld + sn] = t;
            am = fmaxf(am, fmaxf(fmaxf(fabsf(t[0]), fabsf(t[1])), fmaxf(fabsf(t[2]), fabsf(t[3])))); ss += (t[0] * t[0] + t[1] * t[1]) + (t[2] * t[2] + t[3] * t[3]); }
    am = wave_max(am); ss = wave_sum(ss);
    const float clipv = fminf(am, 2.5f * sqrtf(ss * (1.0f / 1024.0f)));
    const float s = clipv > 0.f ? 7.0f / clipv : 0.f;
    if (lane == 0) *scale_out = clipv * (1.0f / (7.0f * 16.0f));
#pragma unroll
    for (int ld = 0; ld < 2; ++ld) { unsigned pk = 0u;
#pragma unroll
        for (int b4 = 0; b4 < 4; ++b4) { int q0 = (int)__builtin_rintf(v[2 * ld][b4] * s), q1 = (int)__builtin_rintf(v[2 * ld + 1][b4] * s);
            q0 = q0 < -7 ? -7 : (q0 > 7 ? 7 : q0); q1 = q1 < -7 ? -7 : (q1 > 7 ? 7 : q1);
            pk |= ((unsigned)(q0 & 15) | ((unsigned)(q1 & 15) << 4)) << (8 * b4); }
        *(GAS unsigned*)(dst + ld * 256 + 16 * p16 + 4 * wl) = pk; }
}
__device__ __forceinline__ float gelu_f(float v) {
    const float av = fabsf(v), t = __builtin_amdgcn_rcpf(av * 0.2316418882f + 1.0f);
    float q = t * 0.5307027145f + (-0.7265760135f); q = q * t + 0.7107068705f; q = q * t + (-0.142248368f); q = q * t + 0.127414796f; q = q * t;
    const float e = __builtin_amdgcn_exp2f((v * v) * (-0.72134752044f));
    const float m = v * (q * e);
    return v < 0.f ? m : v - m;
}

struct Args { const float* in[14]; float* out; unsigned char* ws; int ph_lo, ph_hi, li, pad; };
__global__ void __launch_bounds__(NWAVES * 64, 2) fwd_kernel(Args args) {
    extern __shared__ __attribute__((aligned(16))) unsigned char lds[];
    Frame F;
    F.lds = (LAS unsigned char*)lds;
    F.MISC = (volatile LAS unsigned*)(F.lds + MISC_OFF);
    F.tid = threadIdx.x; F.lane = F.tid & 63; F.wave = __builtin_amdgcn_readfirstlane(F.tid >> 6);
    F.G = gridDim.x; { const int bx = blockIdx.x; F.vcu = (F.G % 8 == 0) ? (bx % 8) * (F.G / 8) + bx / 8 : bx; }
    unsigned char* ws = args.ws;
    F.ctl = (gu32*)(ws + WS_CTL);
    const float* x = args.in[0]; const float* norm1_gain = args.in[1]; const float* w_in = args.in[2]; const float* b_gate = args.in[3];
    const float* q_gain = args.in[4]; const float* k_gain = args.in[5]; const float* w_sb_out = args.in[6]; const float* w_dil_out = args.in[7];
    const float* w_out = args.in[8]; const float* norm2_gain = args.in[9]; const float* w_peer_q = args.in[10]; const float* sub_keys = args.in[11];
    const float* peer_u = args.in[12]; const float* peer_v = args.in[13];
    float* out = args.out;
    bf16* WIN = (bf16*)(ws + WS_WIN); bf16* WCAT = (bf16*)(ws + WS_WCAT); bf16* WOUT = (bf16*)(ws + WS_WOUT); bf16* WC = (bf16*)(ws + WS_WC);
    float* RINV1 = (float*)(ws + WS_RINV1); float* RINV2 = (float*)(ws + WS_RINV2); float* USC = (float*)(ws + WS_USC); float* VSC = (float*)(ws + WS_VSC); float* SSQ = (float*)(ws + WS_SSQ);
    unsigned char* U8 = ws + WS_U8; unsigned char* V8 = ws + WS_V8;
    unsigned short* IDS = (unsigned short*)(ws + WS_IDS); float* GW = (float*)(ws + WS_GW); unsigned short* COEF = (unsigned short*)(ws + WS_COEF); unsigned char* HQ = ws + WS_HQ; unsigned char* WC8 = ws + WS_WC; unsigned char* WOUT8 = ws + WS_WOUT; float* WOS = (float*)(ws + WS_WOS); float* RMAXF = (float*)(ws + WS_RMAXF); unsigned char* MIX8 = ws + WS_MIX; float* WCF = (float*)(ws + WS_WCF); float* WCS = (float*)(ws + WS_WCS); float* HS2 = (float*)(ws + WS_HS2);
    bf16* XB = (bf16*)(ws + WS_XB); bf16* OC = (bf16*)(ws + WS_OC); unsigned char* XB8 = ws + WS_XB8; unsigned char* WG8 = ws + WS_WG8; float* GCS = (float*)(ws + WS_GCS); float* XS = (float*)(ws + WS_XS);
    bf16* QS = (bf16*)(ws + WS_QS); bf16* KS = (bf16*)(ws + WS_KS); bf16* VS = (bf16*)(ws + WS_VS);
    bf16* QD = (bf16*)(ws + WS_QD); bf16* KD = (bf16*)(ws + WS_KD); bf16* VD = (bf16*)(ws + WS_VD);
    unsigned char* GT = ws + WS_GT; bf16* MIX = (bf16*)(ws + WS_MIX); bf16* X1B = (bf16*)(ws + WS_X1B);

    for (int u = F.tid; u < (LDS_BYTES - LDSCTL_OFF) / 4; u += NWAVES * 64) ((LAS unsigned*)(F.lds + LDSCTL_OFF))[u] = 0u;
    __syncthreads();
    const int my_xcc = (int)xb_xcc_id();
    if (F.tid == 0) F.MISC[12] = xb_add((unsigned*)(F.ctl + CW_XRANK) + 64 * my_xcc, 1u);
    __syncthreads();
    const int my_xrank = (int)F.MISC[12];
    const int bli = (N_LAUNCHES == PER_PHASE) ? 0 : args.li;
    XcdBarrier bar; bar.bar = (unsigned*)(F.ctl + CW_BAR) + bli * XCD_BAR_WORDS; bar.x = 0; bar.st = nullptr;
    if (N_LAUNCHES != PER_PHASE) bar = xcd_barrier_post((unsigned*)(F.ctl + CW_BAR) + bli * XCD_BAR_WORDS, F.MISC + 8);
    const int lo = args.ph_lo, hi = args.ph_hi;
#ifndef PHASE_MASK
#define PHASE_MASK 0xff
#endif
#define IN(k) (((PHASE_MASK >> (k)) & 1) && lo <= (k) && (k) < hi)
#define BOTH(k) (IN(k) && IN((k) + 1))
#define GRID_BAR() do { if (N_LAUNCHES != PER_PHASE) xcd_barrier(bar); } while (0)
#ifndef PROBE_REPEAT
#define PROBE_REPEAT 0x00
#endif
#ifndef PROBE_L1
#define PROBE_L1 0x0
#endif
#define REP(k) _Pragma("unroll") for (int rep_ = 0; rep_ < (((PROBE_REPEAT >> (k)) & 1) ? 2 : 1); ++rep_)
    const int gw = F.vcu * NWAVES + F.wave, NGW = F.G * NWAVES;
#define P67_MAP() int vx = (int)(blockIdx.x & 7), rk = (int)(blockIdx.x >> 3), nrk = (F.G + 7 - vx) / 8; bool p67_uni = false; \
        { bool uni_ = (F.G % 8 == 0); for (int j_ = 0; j_ < 16; ++j_) { const unsigned c_ = xb_ld((unsigned*)(F.ctl + CW_XRANK) + 64 * j_); uni_ = uni_ && (c_ == (j_ < 8 ? (unsigned)(F.G / 8) : 0u)); } \
          if (uni_) { vx = my_xcc; rk = my_xrank; nrk = F.G / 8; p67_uni = true; } }

    if (IN(0)) REP(0) {
        for (int it = F.vcu; it < 256; it += F.G) {
            const int hp = it >> 4, d0 = (it & 15) * 64;
            LAS float* As = (LAS float*)(F.lds);
            LAS float* Bs = (LAS float*)(F.lds + 64 * 132 * 4);
            for (int e = F.tid; e < 64 * 32; e += 512) { const int r = e >> 5, c4 = (e & 31) * 4; *(LAS f32x4*)(As + r * 132 + c4) = *(const GAS f32x4*)(w_peer_q + (size_t)(d0 + r) * 2048 + hp * 128 + c4); }
            for (int e = F.tid; e < 128 * 32; e += 512) { const int r = e >> 5, c4 = (e & 31) * 4; *(LAS f32x4*)(Bs + r * 132 + c4) = *(const GAS f32x4*)(sub_keys + ((size_t)hp * 128 + r) * 128 + c4); }
            __syncthreads();
            const int ddg = F.tid & 15, ng = F.tid >> 4;
            f32x4 acc[4];
#pragma unroll
            for (int j = 0; j < 4; ++j) acc[j] = (f32x4){0.f, 0.f, 0.f, 0.f};
            for (int c4 = 0; c4 < 128; c4 += 4) {
                f32x4 a[4], b[4];
#pragma unroll
                for (int i = 0; i < 4; ++i) { a[i] = *(const LAS f32x4*)(As + (4 * ddg + i) * 132 + c4); b[i] = *(const LAS f32x4*)(Bs + (4 * ng + i) * 132 + c4); }
#pragma unroll
                for (int j = 0; j < 4; ++j)
#pragma unroll
                    for (int i = 0; i < 4; ++i) acc[j][i] += (a[i][0] * b[j][0] + a[i][1] * b[j][1]) + (a[i][2] * b[j][2] + a[i][3] * b[j][3]);
            }
            const f32x4 g2 = *(const GAS f32x4*)(norm2_gain + d0 + 4 * ddg);
#pragma unroll
            for (int j = 0; j < 4; ++j) { const f32x4 o = acc[j] * g2;
                *(GAS f32x4*)(WCF + (size_t)(hp * 128 + 4 * ng + j) * 1024 + d0 + 4 * ddg) = o;
                float am = fmaxf(fmaxf(fabsf(o[0]), fabsf(o[1])), fmaxf(fabsf(o[2]), fabsf(o[3])));
                am = fmaxf(am, __shfl_xor(am, 1)); am = fmaxf(am, __shfl_xor(am, 2)); am = fmaxf(am, __shfl_xor(am, 4)); am = fmaxf(am, __shfl_xor(am, 8));
                if (ddg == 0) atomicMax((unsigned*)(F.ctl + CW_WMAX) + hp * 128 + 4 * ng + j, __float_as_uint(am)); }
            __syncthreads();
        }
        {
            LAS float* scr = (LAS float*)(F.lds + RING_OFF + F.wave * 16384);
            constexpr int I_IN = (D / 64) * (N1 / 32), I_SB = (512 / 64) * (D / 32), I_DL = (256 / 64) * (D / 32), I_OUT = (D / 64) * (D / 32);
            constexpr int NITEMS = I_IN + I_SB + I_DL + I_OUT;
            for (int it = gw; it < NITEMS; it += NGW) {
                int r = it;
                if (r < I_IN) { const int nb_ = r % (N1 / 32); p0_gate_max_item(w_in, N1, norm1_gain, (unsigned*)(F.ctl + CW_GMAX), r / (N1 / 32), 32 * nb_, F.lane); continue; } r -= I_IN;
                if (r < I_SB) { p0_transpose_item(w_sb_out, D, nullptr, WCAT, 768, 0, 0, scr, r, F.lane); continue; } r -= I_SB;
                if (r < I_DL) { p0_transpose_item(w_dil_out, D, nullptr, WCAT, 768, 512, 0, scr, r, F.lane); continue; } r -= I_DL;
                p0_gate_max_item(w_out, D, nullptr, (unsigned*)(F.ctl + CW_OMAX), r / (D / 32), 32 * (r % (D / 32)), F.lane);
            }
        }
        for (int e = gw; e < 2 * NEXP; e += NGW) {
            if (e < NEXP) quant_row_i4(peer_u + (size_t)e * D, norm2_gain, U8 + (size_t)e * 512, USC + e, F.lane);
            else { const int ev = e - NEXP; quant_row_fp4(peer_v + (size_t)ev * D, V8 + (size_t)ev * 128, (size_t)NEXP * 128, VSC + ev, F.lane); }
        }
        for (int m = gw; m < T; m += NGW) {
            const GAS f32x4* xr = (const GAS f32x4*)(x + (size_t)m * D) + F.lane;
            f32x4 v[4]; float s = 0.f;
#pragma unroll
            for (int j = 0; j < 4; ++j) { v[j] = xr[64 * j]; s += (v[j][0] * v[j][0] + v[j][1] * v[j][1]) + (v[j][2] * v[j][2] + v[j][3] * v[j][3]); }
            s = wave_sum(s);
            const float rn = __builtin_amdgcn_rsqf(s * (1.0f / D) + 1e-6f);
            if (F.lane == 0) RINV1[m] = 1.0f / rn;
            GAS unsigned long long* o8 = (GAS unsigned long long*)(XB + (size_t)m * D) + F.lane;
#pragma unroll
            for (int j = 0; j < 4; ++j) o8[64 * j] = (unsigned long long)pk2(v[j][0] * rn, v[j][1] * rn) | ((unsigned long long)pk2(v[j][2] * rn, v[j][3] * rn) << 32);
            float am = 0.f;
#pragma unroll
            for (int j = 0; j < 4; ++j) am = fmaxf(am, fmaxf(fmaxf(fabsf(v[j][0]), fabsf(v[j][1])), fmaxf(fabsf(v[j][2]), fabsf(v[j][3]))));
            am = wave_max(am) * rn;
            const float qs = am > 0.f ? 127.0f / am * rn : 0.f;
            if (F.lane == 0) XS[m] = am * (1.0f / 127.0f);
#pragma unroll
            for (int j = 0; j < 4; ++j) { const unsigned pk = ((unsigned)(int)__builtin_rintf(v[j][0] * qs) & 0xffu) | (((unsigned)(int)__builtin_rintf(v[j][1] * qs) & 0xffu) << 8) | (((unsigned)(int)__builtin_rintf(v[j][2] * qs) & 0xffu) << 16) | (((unsigned)(int)__builtin_rintf(v[j][3] * qs) & 0xffu) << 24);
                *(GAS unsigned*)(XB8 + (size_t)m * D + 256 * j + 4 * F.lane) = pk; }
        }
        if (BOTH(0)) GRID_BAR();
    }

    if (IN(1)) REP(1) {
        { LAS float* scr = (LAS float*)(F.lds + RING_OFF + F.wave * 16384);
          for (int it = gw; it < 16 * (N8 / 32); it += NGW) p0_gate_fp8_item(w_in, N1, norm1_gain, (const unsigned*)(F.ctl + CW_GMAX), WG8, GCS, scr, it, F.lane);
          for (int it = gw; it < 16 * (D / 32); it += NGW) p0_gate_fp8_item(w_out, D, nullptr, (const unsigned*)(F.ctl + CW_OMAX), WOUT8, WOS, scr, it, F.lane, D, false);
          for (int r = gw; r < 2048; r += NGW) {
              const float am = __uint_as_float(xb_ld((unsigned*)(F.ctl + CW_WMAX) + r)); const float sc = am > 0.f ? 127.0f / am : 0.f;
              unsigned w[4];
#pragma unroll
              for (int j = 0; j < 4; ++j) { const f32x4 v = *(const GAS f32x4*)(WCF + (size_t)r * 1024 + 16 * F.lane + 4 * j);
                  w[j] = ((unsigned)(int)__builtin_rintf(v[0] * sc) & 0xffu) | (((unsigned)(int)__builtin_rintf(v[1] * sc) & 0xffu) << 8) | (((unsigned)(int)__builtin_rintf(v[2] * sc) & 0xffu) << 16) | (((unsigned)(int)__builtin_rintf(v[3] * sc) & 0xffu) << 24); }
              *(GAS v4u*)(WC8 + (size_t)r * 1024 + 16 * F.lane) = (v4u){w[0], w[1], w[2], w[3]};
              if (F.lane == 0) WCS[r] = am * (1.0f / 127.0f); }
          __syncthreads(); }
        GRID_BAR();
        { pg8::Gemm g{(const bf16*)XB8, (const bf16*)WG8, T, N8, D / 2}; pg8::StaticOrder S; S.init(T, N8, F.G, (int)blockIdx.x);
          pg8::EpiG E{b_gate, GCS, XS, q_gain, k_gain, QS, KS, VS, QD, KD, VD, GT};
          pg8::gemm_phase<pg8::EpiG, pg8::StaticOrder, true, true, false, true>(F.lds + RING_OFF, g, S, E); }
        if (BOTH(1)) GRID_BAR();
    }

    if (IN(2)) REP(2) {
        LAS unsigned char* wl = F.lds + RING_OFF + F.wave * 16384;
        static_assert(att::DLU_BYTES <= RING_BYTES, "dilated-attention LDS state");
        for (int un = F.vcu; un < 512; un += F.G) { const int blk = un & 7, j = (un >> 3) & 3, b = un >> 5; att::dl_unit(QD, KD, VD, OC, b, j, blk, F.lds + RING_OFF, F.wave, F.lane); }
        for (int it = gw; it < 16384; it += NGW) { const int qt = 127 - (it & 127), h = (it >> 7) & 7, b = it >> 10; att::sb_item(QS, KS, VS, OC, b, h, qt, wl, F.lane); }
        if (BOTH(2)) GRID_BAR();
    }

    if (IN(3)) REP(3) {
        pg8::Gemm g{OC, WCAT, T, D, 768}; pg8::StaticOrder S; S.init(T, D, F.G, (int)blockIdx.x);
        pg8::Epi2 E{GT, MIX8, (unsigned*)(ws + WS_PART), (unsigned*)(F.ctl + CW_RCNT), RMAXF, F.lds + RING_OFF + RING_BYTES};
        pg8::gemm_phase<pg8::Epi2, pg8::StaticOrder, true, true>(F.lds + RING_OFF, g, S, E);
        if (BOTH(3)) GRID_BAR();
    }

    if (IN(4)) REP(4) {
        pg8::Gemm g{(const bf16*)MIX8, (const bf16*)WOUT8, T, D, D / 2}; pg8::StaticOrder S; S.init(T, D, F.G, (int)blockIdx.x);
        pg8::Epi3 E{XB, RINV1, (const unsigned*)RMAXF, WOS, X1B, SSQ};
        pg8::gemm_phase<pg8::Epi3, pg8::StaticOrder, true, true, false, true>(F.lds + RING_OFF, g, S, E);
        if (BOTH(4)) GRID_BAR();
    }

    if (IN(5)) REP(5) {
        for (int m = gw; m < T; m += NGW) {
            const v4u a = *(const GAS v4u*)(X1B + (size_t)m * D + 8 * F.lane), b = *(const GAS v4u*)(X1B + (size_t)m * D + 512 + 8 * F.lane);
            float v[16] = {pg8::bflo(a.x), pg8::bfhi(a.x), pg8::bflo(a.y), pg8::bfhi(a.y), pg8::bflo(a.z), pg8::bfhi(a.z), pg8::bflo(a.w), pg8::bfhi(a.w),
                           pg8::bflo(b.x), pg8::bfhi(b.x), pg8::bflo(b.y), pg8::bfhi(b.y), pg8::bflo(b.z), pg8::bfhi(b.z), pg8::bflo(b.w), pg8::bfhi(b.w)};
            float am = 0.f;
#pragma unroll
            for (int i = 0; i < 16; ++i) am = fmaxf(am, fabsf(v[i]));
            am = wave_max(am);
            float sq = (F.lane < 16) ? SSQ[(size_t)m * 16 + F.lane] : 0.f; sq = wave_sum(sq);
            const float s = am > 0.f ? 127.0f / am : 0.f;
            if (F.lane == 0) HS2[m] = am * (1.0f / 127.0f) * __builtin_amdgcn_rsqf(sq * (1.0f / 1024.0f) + 1e-6f);
            int q[16];
#pragma unroll
            for (int i = 0; i < 16; ++i) q[i] = (int)__builtin_rintf(v[i] * s) & 0xff;
            v2u o0, o1; o0.x = q[0] | (q[1] << 8) | (q[2] << 16) | (q[3] << 24); o0.y = q[4] | (q[5] << 8) | (q[6] << 16) | (q[7] << 24);
            o1.x = q[8] | (q[9] << 8) | (q[10] << 16) | (q[11] << 24); o1.y = q[12] | (q[13] << 8) | (q[14] << 16) | (q[15] << 24);
            *(GAS v2u*)(HQ + (size_t)m * D + 8 * F.lane) = o0; *(GAS v2u*)(HQ + (size_t)m * D + 512 + 8 * F.lane) = o1;
        }
        GRID_BAR();
        pg8::Gemm g{(const bf16*)HQ, (const bf16*)WC8, T, 2048, D / 2}; pg8::StaticOrder S; S.init(T, 2048, F.G, (int)blockIdx.x);
        pg8::Epi4 E{SSQ, RINV2, IDS, GW, HS2, WCS};
        pg8::OneUnit O1;
        for (int i = 0; S.next(i, O1.u); ++i) pg8::gemm_phase<pg8::Epi4, pg8::OneUnit, false, true, false, true>(F.lds + RING_OFF, g, O1, E);
        if (BOTH(5)) GRID_BAR();
    }

    if (IN(6)) REP(6) {
        P67_MAP();
        const int p16 = F.lane & 15, sg = F.lane >> 4;
        LAS unsigned char* HB = F.lds + RING_OFF + F.wave * 16384;
        LAS unsigned* LIST = (LAS unsigned*)(F.lds + RING_OFF + F.wave * 16384 + 8192);
        LAS float* HSs = (LAS float*)(F.lds + RING_OFF + F.wave * 16384 + 12288);
        const int nwb = T / 8, wstep = nrk * NWAVES;
        const int gsel = (F.lane & 15), bpsrc = (16 * (F.lane & 3) + ((F.lane >> 2) & 3)) * 4;
        v4u hpre[8], idpre[2]; float hspre = 0.f;
#define P6_PRE(bb) do { const int bc_ = (bb) < nwb ? (bb) : nwb - 1; const unsigned char* hsrc_ = HQ + (size_t)bc_ * 8192; \
            _Pragma("unroll") for (int i_ = 0; i_ < 8; ++i_) hpre[i_] = *(const GAS v4u*)(hsrc_ + (size_t)(i_ * 64 + F.lane) * 16); \
            const unsigned short* isrc_ = IDS + ((size_t)bc_ * 8 + (F.lane >> 3)) * 128 + 16 * (F.lane & 7); idpre[0] = *(const GAS v4u*)isrc_; idpre[1] = *(const GAS v4u*)(isrc_ + 8); \
            hspre = HS2[(size_t)bc_ * 8 + (F.lane & 7)]; } while (0)
#define P6_ISSUE(W, ENT, EJ, GB, UB, VB, base_) do { \
                _Pragma("unroll") for (int g_ = 0; g_ < 4; ++g_) { const int j_ = (base_) + 4 * g_ + sg; ENT[g_] = LIST[j_ < n ? j_ : nm1]; } \
                { const int j_ = (base_) + gsel; EJ = (j_ < n && F.lane < 16) ? (int)LIST[j_] : -1; } \
                _Pragma("unroll") for (int g_ = 0; g_ < 4; ++g_) { const unsigned char* up_ = U8 + (size_t)((PROBE_L1 && rep_) ? 0u : (ENT[g_] & 0xffffu)) * 512 + 16 * p16; \
                    _Pragma("unroll") for (int i_ = 0; i_ < 2; ++i_) W[g_][i_] = *(const GAS v4u*)(up_ + 256 * i_); } \
                { const unsigned ej_ = EJ < 0 ? 0u : (unsigned)EJ; GB = GW[((size_t)t0 + (ej_ >> 24)) * 128 + ((ej_ >> 16) & 127u)]; UB = USC[ej_ & 0xffffu]; VB = VSC[ej_ & 0xffffu]; } } while (0)
#define P6_DPPADD(a_, ctrl) a_ += __builtin_amdgcn_update_dpp(0, a_, ctrl, 0xf, 0xf, false)
#define P6_REDUCE(W, ENT, EJ, GB, UB, VB, base_) do { if ((base_) < n) { int ag_[4]; \
                _Pragma("unroll") for (int g_ = 0; g_ < 4; ++g_) { const LAS unsigned char* hp_ = HB + (size_t)(ENT[g_] >> 24) * 1024 + 16 * p16; int a_ = 0; v4u h_[4]; \
                    _Pragma("unroll") for (int i_ = 0; i_ < 4; ++i_) h_[i_] = *(const LAS v4u*)(hp_ + 256 * i_); \
                    _Pragma("unroll") for (int ld_ = 0; ld_ < 2; ++ld_) { const unsigned x_[4] = {W[g_][ld_].x, W[g_][ld_].y, W[g_][ld_].z, W[g_][ld_].w}; \
                        _Pragma("unroll") for (int wl_ = 0; wl_ < 4; ++wl_) { const int hd_ = 2 * (4 * ld_ + wl_); const unsigned lo_ = (x_[wl_] << 4) & 0xF0F0F0F0u, hi_ = x_[wl_] & 0xF0F0F0F0u; \
                            const unsigned hA_ = (hd_ & 3) == 0 ? h_[hd_ >> 2].x : h_[hd_ >> 2].z, hB_ = (hd_ & 3) == 0 ? h_[hd_ >> 2].y : h_[hd_ >> 2].w; \
                            a_ = __builtin_amdgcn_sdot4((int)lo_, (int)hA_, a_, false); a_ = __builtin_amdgcn_sdot4((int)hi_, (int)hB_, a_, false); } } \
                    P6_DPPADD(a_, 0xB1); P6_DPPADD(a_, 0x4E); P6_DPPADD(a_, 0x141); P6_DPPADD(a_, 0x140); ag_[g_] = a_; } \
                const int sel_ = gsel == 0 ? ag_[0] : gsel == 1 ? ag_[1] : gsel == 2 ? ag_[2] : ag_[3]; \
                const float resv_ = (float)__builtin_amdgcn_ds_bpermute(bpsrc, sel_); \
                if (EJ >= 0 && !(PROBE_L1 && rep_)) { const unsigned ej_ = (unsigned)EJ; const float act_ = gelu_f(resv_ * UB * HSs[ej_ >> 24]); \
                    COEF[((size_t)t0 + (ej_ >> 24)) * 128 + ((ej_ >> 16) & 127u)] = (unsigned short)(pg8::pkbf(GB * act_ * VB, 0.f) & 0xffffu); } } } while (0)
        int wb = rk * NWAVES + F.wave;
        P6_PRE(wb);
        for (; wb < nwb; wb += wstep) {
            const int t0 = wb * 8;
            asm volatile("s_waitcnt lgkmcnt(0)" ::: "memory");
            if (F.lane < 8) HSs[F.lane] = hspre;
#pragma unroll
            for (int i = 0; i < 8; ++i) *(LAS v4u*)(HB + (size_t)(i * 64 + F.lane) * 16) = hpre[i];
            int n = 0;
            { const unsigned idw[8] = {idpre[0].x, idpre[0].y, idpre[0].z, idpre[0].w, idpre[1].x, idpre[1].y, idpre[1].z, idpre[1].w};
              const unsigned tl = (unsigned)(F.lane >> 3), kb0 = 16u * (unsigned)(F.lane & 7);
#pragma unroll
              for (int i = 0; i < 16; ++i) { const unsigned e = (i & 1) ? (idw[i >> 1] >> 16) : (idw[i >> 1] & 0xffffu);
                  const bool inr = ((int)(e >> 11) == vx); const unsigned long long mk = __ballot(inr);
                  const int pos = n + (int)__builtin_amdgcn_mbcnt_hi((unsigned)(mk >> 32), __builtin_amdgcn_mbcnt_lo((unsigned)mk, 0u));
                  if (inr) LIST[pos] = (tl << 24) | ((kb0 + (unsigned)i) << 16) | e;
                  n += __builtin_popcountll(mk); } }
            asm volatile("s_waitcnt lgkmcnt(0)" ::: "memory");
            P6_PRE(wb + wstep);
            const int nm1 = n > 0 ? n - 1 : 0;
            for (int base = 0; base < n; base += 32) {
                v4u wA[4][2], wB[4][2]; unsigned entA[4], entB[4]; int ejA, ejB; float gbA, ubA, vbA, gbB, ubB, vbB;
                P6_ISSUE(wA, entA, ejA, gbA, ubA, vbA, base);
                P6_ISSUE(wB, entB, ejB, gbB, ubB, vbB, base + 16);
                P6_REDUCE(wA, entA, ejA, gbA, ubA, vbA, base);
                P6_REDUCE(wB, entB, ejB, gbB, ubB, vbB, base + 16);
            }
        }
#undef P6_PRE
#undef P6_ISSUE
#undef P6_REDUCE
#undef P6_DPPADD
        if (BOTH(6)) GRID_BAR();
    }

    if (IN(7)) REP(7) {
        P67_MAP();
        const int cs = vx >> 1;
        const int n0_ = p67_uni ? F.G / 8 : (F.G + 7 - 2 * cs) / 8, n1_ = p67_uni ? F.G / 8 : (F.G + 7 - (2 * cs + 1)) / 8;
        const int rk2 = (vx & 1) ? n0_ + rk : rk, nrk2 = n0_ + n1_;
        const int l8 = F.lane & 7, kg = F.lane >> 3, i16 = F.lane & 15, kq = F.lane >> 4;
        const unsigned char* vbase = V8 + (size_t)cs * NEXP * 128 + 16 * l8;
        const int tstep = nrk2 * NWAVES;
        const int col = 256 * cs + 4 * F.lane;
        LAS unsigned char* tile = F.lds + RING_OFF + F.wave * 16384;
        typedef int v2i_ __attribute__((ext_vector_type(2)));
        const int wrb = kg * 2048 + 16 * l8, rdb = (32 * kq + i16) * 128 + 16 * (i16 & 7) + 8 * (i16 >> 3);
        LAS float* obuf = (LAS float*)(F.lds + RING_OFF + RING_BYTES + F.wave * 1536);
        LAS float* obw = (F.lane < 16) ? obuf + F.lane : obuf + 256 + F.lane; const int obs = (F.lane < 16) ? 1 : 0;
#define P7_CL(tt) ((tt) < T ? (tt) : T - 1)
#define P7_IDS(tt, ID) do { const int tc_ = P7_CL(tt); ID[0] = *(const GAS v4u*)(IDS + (size_t)tc_ * 128 + 16 * kg); ID[1] = *(const GAS v4u*)(IDS + (size_t)tc_ * 128 + 16 * kg + 8); } while (0)
#define P7_ISSUE(tt, ID, W, CF, OO) do { const int tc_ = P7_CL(tt); const unsigned idw_[8] = {ID[0].x, ID[0].y, ID[0].z, ID[0].w, ID[1].x, ID[1].y, ID[1].z, ID[1].w}; \
            _Pragma("unroll") for (int i_ = 0; i_ < 16; ++i_) { const unsigned e_ = (i_ & 1) ? (idw_[i_ >> 1] >> 16) : (idw_[i_ >> 1] & 0xffffu); W[i_] = *(const GAS v4u*)(vbase + (size_t)((PROBE_L1 && rep_) ? 0u : e_) * 128); } \
            CF[0] = *(const GAS v4u*)(COEF + (size_t)tc_ * 128 + 16 * kg); CF[1] = *(const GAS v4u*)(COEF + (size_t)tc_ * 128 + 16 * kg + 8); \
            OO = *(const GAS v2u*)(X1B + (size_t)tc_ * D + col); } while (0)
#define P7_COMPUTE(tt, W, CF, OO, NX) do { \
              \
            const unsigned cw_[8] = {CF[0].x, CF[0].y, CF[0].z, CF[0].w, CF[1].x, CF[1].y, CF[1].z, CF[1].w}; \
            float am_ = 0.f; _Pragma("unroll") for (int j_ = 0; j_ < 8; ++j_) am_ = fmaxf(am_, fmaxf(fabsf(pg8::bflo(cw_[j_])), fabsf(pg8::bfhi(cw_[j_])))); \
            am_ = fmaxf(am_, __shfl_xor(am_, 8)); am_ = fmaxf(am_, __shfl_xor(am_, 16)); am_ = fmaxf(am_, __shfl_xor(am_, 32)); \
            const float cq_ = am_ > 0.f ? 240.0f / am_ : 0.f, cstep_ = am_ * (1.0f / 240.0f); \
            int cpk_[4]; _Pragma("unroll") for (int d_ = 0; d_ < 4; ++d_) { int w_ = __builtin_amdgcn_cvt_pk_fp8_f32(pg8::bflo(cw_[2 * d_]) * cq_, pg8::bfhi(cw_[2 * d_]) * cq_, 0, false); \
                cpk_[d_] = __builtin_amdgcn_cvt_pk_fp8_f32(pg8::bflo(cw_[2 * d_ + 1]) * cq_, pg8::bfhi(cw_[2 * d_ + 1]) * cq_, w_, true); } \
              \
            v8i a_; { const int sa0_ = (8 * kq) * 4, sa1_ = (32 + 8 * kq) * 4; const bool m0_ = (i16 == 0); \
                _Pragma("unroll") for (int d_ = 0; d_ < 4; ++d_) { const int x0_ = __builtin_amdgcn_ds_bpermute(sa0_, cpk_[d_]), x1_ = __builtin_amdgcn_ds_bpermute(sa1_, cpk_[d_]); a_[d_] = m0_ ? x0_ : 0; a_[4 + d_] = m0_ ? x1_ : 0; } } \
            _Pragma("unroll") for (int i_ = 0; i_ < 16; ++i_) { const v4u x_ = W[i_]; *(LAS v4u*)(tile + (wrb ^ (16 * (i_ & 7))) + 128 * i_) = (i_ & 8) ? (v4u){x_.z, x_.w, x_.x, x_.y} : x_; } \
            const v2u oc_ = OO; \
            asm volatile("" ::: "memory"); \
            NX;                                                                      \
            asm volatile("" ::: "memory"); \
            _Pragma("unroll") for (int g_ = 0; g_ < 4; ++g_) { \
                f32x4 dd_[4]; \
                _Pragma("unroll") for (int j_ = 0; j_ < 4; ++j_) { const int nb_ = 4 * g_ + j_; const int ra_ = (rdb ^ (16 * (nb_ >> 1))) ^ (8 * (nb_ & 1)); \
                    const v2i_ r0_ = __builtin_amdgcn_ds_read_tr4_b64_v2i32((LAS v2i_*)(tile + ra_)), r1_ = __builtin_amdgcn_ds_read_tr4_b64_v2i32((LAS v2i_*)(tile + ra_ + 2048)); \
                    dd_[j_] = __builtin_amdgcn_mfma_scale_f32_16x16x128_f8f6f4(a_, (v8i){r0_.x, r0_.y, r1_.x, r1_.y, 0, 0, 0, 0}, (f32x4){0.f, 0.f, 0.f, 0.f}, 0, 4, 0, 127, 0, 127); } \
                __builtin_amdgcn_sched_barrier(0); \
                  \
                _Pragma("unroll") for (int j_ = 0; j_ < 4; ++j_) obw[16 * (4 * g_ + j_) * obs] = dd_[j_][0] * cstep_; \
                asm volatile("" ::: "memory"); } \
            const f32x4 r4_ = *(const LAS f32x4*)(obuf + 4 * F.lane); \
            asm volatile("" ::: "memory"); \
            if ((tt) < T) *(GAS f32x4*)((rep_ == 0 ? out : (float*)(ws + WS_GT)) + (size_t)(tt) * D + col) = (f32x4){pg8::bflo(oc_.x) + r4_[0], pg8::bfhi(oc_.x) + r4_[1], pg8::bflo(oc_.y) + r4_[2], pg8::bfhi(oc_.y) + r4_[3]}; } while (0)
        v4u idA[2], idB[2], wA[16], wB[16], cfA[2], cfB[2]; v2u ooA, ooB;
        int t = rk2 * NWAVES + F.wave;
        P7_IDS(t, idA); P7_IDS(t + tstep, idB);
        P7_ISSUE(t, idA, wA, cfA, ooA); P7_ISSUE(t + tstep, idB, wB, cfB, ooB);
        P7_IDS(t + 2 * tstep, idA); P7_IDS(t + 3 * tstep, idB);
        while (t < T) {
            P7_COMPUTE(t, wA, cfA, ooA, { P7_ISSUE(t + 2 * tstep, idA, wA, cfA, ooA); P7_IDS(t + 4 * tstep, idA); });
            P7_COMPUTE(t + tstep, wB, cfB, ooB, { P7_ISSUE(t + 3 * tstep, idB, wB, cfB, ooB); P7_IDS(t + 5 * tstep, idB); });
            t += 2 * tstep;
        }
#undef P7_CL
#undef P7_IDS
#undef P7_ISSUE
#undef P7_COMPUTE
    }
#undef IN
#undef BOTH
#undef GRID_BAR
}

extern "C" void kernel_launch(void* const* d_in, const int* in_sizes, int n_in, void* d_out, int out_size, void* d_ws, size_t ws_size, hipStream_t stream) {
    static int grid = 0;
    if (grid == 0) {
        if (n_in != 14 || in_sizes[0] != T * D || out_size != T * D || ws_size < WS_END) { fprintf(stderr, "kernel_launch: built for 14 inputs, x and out of %d floats, >= %zu bytes of workspace; got n_in %d, in0 %d, out %d, ws %zu; nothing launched\n", T * D, (size_t)WS_END, n_in, n_in > 0 ? in_sizes[0] : -1, out_size, ws_size); grid = -1; return; }
        int dev = 0, cus = 0, per_cu = 0;
        if (hipGetDevice(&dev) != hipSuccess || hipDeviceGetAttribute(&cus, hipDeviceAttributeMultiprocessorCount, dev) != hipSuccess) { fprintf(stderr, "kernel_launch: hipGetDevice / hipDeviceGetAttribute failed\n"); grid = -1; return; }
        if (hipFuncSetAttribute((const void*)fwd_kernel, hipFuncAttributeMaxDynamicSharedMemorySize, LDS_BYTES) != hipSuccess) { fprintf(stderr, "kernel_launch: hipFuncSetAttribute failed\n"); grid = -1; return; }
        if (hipOccupancyMaxActiveBlocksPerMultiprocessor(&per_cu, (const void*)fwd_kernel, NWAVES * 64, LDS_BYTES) != hipSuccess || per_cu < 1)
            fprintf(stderr, "kernel_launch: note: occupancy query reports %d workgroups per CU\n", per_cu);
        (void)hipGetLastError();
        grid = cus;
        if (cus != 256) fprintf(stderr, "kernel_launch: built for 256 CUs (MI355X); %d found -- the P3 row-max exchange assumes a 256-workgroup grid\n", cus);
    }
    if (grid < 0) return;
    if (hipMemsetAsync((char*)d_ws + WS_CTL, 0, CTL_ZERO_BYTES, stream) != hipSuccess) { fprintf(stderr, "kernel_launch: hipMemsetAsync failed\n"); return; }
    Args a{};
    for (int i = 0; i < 14; ++i) a.in[i] = (const float*)d_in[i];
    a.out = (float*)d_out; a.ws = (unsigned char*)d_ws;
    for (int li = 0; li < N_LAUNCHES; ++li) {
        a.ph_lo = (N_LAUNCHES == PER_PHASE) ? li : 0; a.ph_hi = (N_LAUNCHES == PER_PHASE) ? li + 1 : MK_LAST_PHASE; a.li = li;
        if (a.ph_lo >= MK_LAST_PHASE) break;
        hipLaunchKernelGGL(fwd_kernel, dim3(grid), dim3(NWAVES * 64), LDS_BYTES, stream, a);
        const hipError_t le = hipPeekAtLastError();
        if (le != hipSuccess) { fprintf(stderr, "kernel_launch: launch %d failed: %s\n", li, hipGetErrorName(le)); break; }
    }
}
```

```cpp
#include <hip/hip_runtime.h>
#include <cstdio>
#include <cstdint>
namespace pg8 {
#define PG8_LAS __attribute__((address_space(3)))
typedef unsigned short bf16_t;
typedef short bf16x8 __attribute__((ext_vector_type(8)));
typedef float f32x4 __attribute__((ext_vector_type(4)));
typedef unsigned u32x4 __attribute__((ext_vector_type(4)));
typedef int i32x8 __attribute__((ext_vector_type(8)));
typedef int i32x4 __attribute__((ext_vector_type(4)));
constexpr int BM = 256, BK = 64, HALF = 128, HTB = HALF * BK * 2  , STAGE_BYTES = 8 * HTB, NXCD = 8, WGM = 8;

__host__ __device__ __forceinline__ int lds_byte(int r, int c) { const int st = (r >> 4) * 2 + (c >> 5), rr = r & 15, cc = c & 31, ob = rr * 64 + cc * 2; return st * 1024 + (ob ^ (((ob >> 9) & 1) << 5)); }
__host__ __device__ __forceinline__ void stage_rc(int b, int& R, int& C) { const int st = b / 1024, sb = b % 1024, swz = sb ^ (((sb >> 9) & 1) << 5); R = (st >> 1) * 16 + swz / 64; C = (st & 1) * 32 + (swz % 64) / 2; }
__host__ __device__ __forceinline__ int perm32(int rho) { const int n = rho >> 4, i = rho & 15; return 8 * (i >> 2) + 4 * n + (i & 3); }

struct Unit { int pm, pn; };
struct Gemm { const bf16_t* A; const bf16_t* Bt; int M, N, K; int lda = 0; size_t ksA = 0; };

struct StaticOrder {
    int nM, nN, nwg, G, c;
    __host__ __device__ void init(int M, int N, int G_, int c_) { nM = M / BM; nN = N / BM; nwg = nM * nN; G = G_; c = c_; }
    __host__ __device__ bool next(int i, Unit& u) const {
        const long L = (long)i * G + c; if (L >= nwg) return false;
        int wgid = (int)L; { const int q = nwg / NXCD, r = nwg % NXCD, xcd = wgid % NXCD, off = wgid / NXCD; wgid = (xcd < r ? xcd * (q + 1) : r * (q + 1) + (xcd - r) * q) + off; }
        const int nig = WGM * nN, gid = wgid / nig, fm = gid * WGM, gsz = (nM - fm) < WGM ? (nM - fm) : WGM;
        u.pm = fm + ((wgid % nig) % gsz); u.pn = (wgid % nig) / gsz; return true;
    }
    __device__ __forceinline__ void a_ready(const Unit&) const {}
    __device__ __forceinline__ void done(const Unit&) const {}
};


struct OneUnit {
    Unit u;
    __device__ __forceinline__ bool next(int i, Unit& o) const { if (i != 0) return false; o = u; return true; }
    __device__ __forceinline__ void a_ready(const Unit&) const {}
    __device__ __forceinline__ void done(const Unit&) const {}
};

typedef float f32x2 __attribute__((ext_vector_type(2)));
typedef __bf16 bf16x2_t __attribute__((ext_vector_type(2)));
typedef unsigned u32x2 __attribute__((ext_vector_type(2)));
__device__ __forceinline__ unsigned pkbf(float lo, float hi) { f32x2 v = {lo, hi}; bf16x2_t b = __builtin_convertvector(v, bf16x2_t); return __builtin_bit_cast(unsigned, b); }
__device__ __forceinline__ float bflo(unsigned w) { return __uint_as_float(w << 16); }
__device__ __forceinline__ float bfhi(unsigned w) { return __uint_as_float(w & 0xffff0000u); }
__device__ __forceinline__ u32x4 pack8(const f32x4 a, const f32x4 b) { u32x4 w; w.x = pkbf(a[0], a[1]); w.y = pkbf(a[2], a[3]); w.z = pkbf(b[0], b[1]); w.w = pkbf(b[2], b[3]); return w; }
constexpr float QSCALE = 0.125f * 1.4426950408889634f;
__device__ __forceinline__ float sigmoidf_(float v) { return __builtin_amdgcn_rcpf(1.0f + __builtin_amdgcn_exp2f(-1.4426950408889634f * v)); }

struct EpiG {
    static constexpr bool PERM = true, AFTER_DRAIN = false, HAS_MID = false; static constexpr int MID_T = -1;
    const float* bgate; const float* cs; const float* xs; const float* qg; const float* kg; bf16_t *QS, *KS, *VS, *QD, *KD, *VD; unsigned char* GT;
    __device__ __forceinline__ void mid(f32x4 (&)[2][2][4][2], const Unit&, int, int, int, int) const {}
    static __device__ __forceinline__ f32x4 cvt(const f32x4 a, const f32x4 sc) { const i32x4 ia = __builtin_bit_cast(i32x4, a); return (f32x4){(float)ia[0], (float)ia[1], (float)ia[2], (float)ia[3]} * sc; }
    __device__ __forceinline__ void operator()(const f32x4 (&acc)[2][2][4][2], const Unit& u, int wr, int wc, int fr, int fq) const {
        asm volatile("" : "+v"(fr), "+v"(fq));
        const int pn = u.pn; const int row0 = u.pm * BM + wr * 64 + fr, colp = pn * BM + wc * 32 + 8 * fq;
        f32x4 sv[2][2];
#pragma unroll
        for (int bj = 0; bj < 2; ++bj)
#pragma unroll
            for (int n = 0; n < 2; ++n) sv[bj][n] = *(const f32x4*)(cs + colp + bj * HALF + 4 * n);
        if (pn < 6) {
            bf16_t* base; int colt;
            if (pn < 2) { base = QS; colt = pn * 256; } else if (pn < 4) { base = KS; colt = (pn - 2) * 256; } else { base = VS; colt = (pn - 4) * 256; }
            base += ((size_t)((u.pm >> 4) * 8 + (colt >> 6) + wc) * 4096) * 64 + 8 * fq;
            const float qs = (pn < 2 ? QSCALE : 1.0f);
#pragma unroll
            for (int ai = 0; ai < 2; ++ai)
#pragma unroll
                for (int m = 0; m < 4; ++m) { const int row = row0 + ai * HALF + m * 16; const float r = xs[row] * qs;
#pragma unroll
                    for (int bj = 0; bj < 2; ++bj) *(u32x4*)(base + (size_t)(row & 4095) * 64 + 32 * bj) = pack8(cvt(acc[ai][bj][m][0], sv[bj][0] * r), cvt(acc[ai][bj][m][1], sv[bj][1] * r));
                }
        } else if (pn < 12) {
            const bool isK = pn >= 9; const int head = (isK ? pn - 9 : pn - 6) * 4 + wc;
            const float* g = (isK ? kg : qg) + head * 64 + 8 * fq;
            f32x4 gv[2][2]; const float qsc = isK ? 1.0f : QSCALE;
#pragma unroll
            for (int bj = 0; bj < 2; ++bj)
#pragma unroll
                for (int n = 0; n < 2; ++n) gv[bj][n] = *(const f32x4*)(g + 32 * bj + 4 * n) * qsc;
            bf16_t* base = (isK ? KD : QD) + ((size_t)((u.pm >> 4) * 12 + head) * 4096) * 64 + 8 * fq;
            const int dsh = 2 * (head >> 2), dmask = (1 << dsh) - 1;
#pragma unroll
            for (int ai = 0; ai < 2; ++ai)
#pragma unroll
                for (int m = 0; m < 4; ++m) { const int row = row0 + ai * HALF + m * 16; const float r = xs[row];
                    f32x4 v[2][2]; float ss = 0.f;
#pragma unroll
                    for (int bj = 0; bj < 2; ++bj)
#pragma unroll
                        for (int n = 0; n < 2; ++n) { v[bj][n] = cvt(acc[ai][bj][m][n], sv[bj][n] * r); const f32x4 q = v[bj][n] * v[bj][n]; ss += (q[0] + q[1]) + (q[2] + q[3]); }
                    ss += __shfl_xor(ss, 16); ss += __shfl_xor(ss, 32);
                    const float sc = __builtin_amdgcn_rsqf(ss * (1.0f / 64.0f) + 1e-6f);
#pragma unroll
                    for (int bj = 0; bj < 2; ++bj) *(u32x4*)(base + (size_t)((((row & 4095) & dmask) << (12 - dsh)) + ((row & 4095) >> dsh)) * 64 + 32 * bj) = pack8(v[bj][0] * (gv[bj][0] * sc), v[bj][1] * (gv[bj][1] * sc));
                }
        } else if (pn < 15) {
            bf16_t* base = VD + ((size_t)((u.pm >> 4) * 12 + (pn - 12) * 4 + wc) * 4096) * 64 + 8 * fq;
            const int dsh = 2 * (pn - 12), dmask = (1 << dsh) - 1;
#pragma unroll
            for (int ai = 0; ai < 2; ++ai)
#pragma unroll
                for (int m = 0; m < 4; ++m) { const int row = row0 + ai * HALF + m * 16; const float r = xs[row];
#pragma unroll
                    for (int bj = 0; bj < 2; ++bj) *(u32x4*)(base + (size_t)((((row & 4095) & dmask) << (12 - dsh)) + ((row & 4095) >> dsh)) * 64 + 32 * bj) = pack8(cvt(acc[ai][bj][m][0], sv[bj][0] * r), cvt(acc[ai][bj][m][1], sv[bj][1] * r));
                }
        } else {
            const int col0 = (pn - 15) * 256 + wc * 64 + 8 * fq;
            constexpr float NL2E = -1.4426950408889634f, I255 = 1.0f / 255.0f;
            f32x4 bv[2][2], svn[2][2];
#pragma unroll
            for (int bj = 0; bj < 2; ++bj)
#pragma unroll
                for (int n = 0; n < 2; ++n) { bv[bj][n] = *(const f32x4*)(bgate + col0 + 32 * bj + 4 * n) * NL2E; svn[bj][n] = sv[bj][n] * NL2E; }
#pragma unroll
            for (int ai = 0; ai < 2; ++ai)
#pragma unroll
                for (int m = 0; m < 4; ++m) { const int row = row0 + ai * HALF + m * 16; const float r = xs[row];
#pragma unroll
                    for (int bj = 0; bj < 2; ++bj) { const i32x4 ia = __builtin_bit_cast(i32x4, acc[ai][bj][m][0]), ib = __builtin_bit_cast(i32x4, acc[ai][bj][m][1]);
                        const f32x4 sa = svn[bj][0] * r, sb = svn[bj][1] * r; f32x4 a, b;
#pragma unroll
                        for (int e = 0; e < 4; ++e) { a[e] = __builtin_amdgcn_rcpf(__builtin_amdgcn_exp2f((float)ia[e] * sa[e] + bv[bj][0][e]) * I255 + I255);
                                                      b[e] = __builtin_amdgcn_rcpf(__builtin_amdgcn_exp2f((float)ib[e] * sb[e] + bv[bj][1][e]) * I255 + I255); }
                        unsigned w0 = 0, w1 = 0;
                        w0 = __builtin_amdgcn_cvt_pk_u8_f32(a[0], 0, w0); w0 = __builtin_amdgcn_cvt_pk_u8_f32(a[1], 1, w0); w0 = __builtin_amdgcn_cvt_pk_u8_f32(a[2], 2, w0); w0 = __builtin_amdgcn_cvt_pk_u8_f32(a[3], 3, w0);
                        w1 = __builtin_amdgcn_cvt_pk_u8_f32(b[0], 0, w1); w1 = __builtin_amdgcn_cvt_pk_u8_f32(b[1], 1, w1); w1 = __builtin_amdgcn_cvt_pk_u8_f32(b[2], 2, w1); w1 = __builtin_amdgcn_cvt_pk_u8_f32(b[3], 3, w1);
                        *(u32x2*)(GT + ((size_t)(pn - 15) * 65536 + row) * 256 + wc * 64 + 8 * fq + 32 * bj) = (u32x2){w0, w1}; }
                }
        }
    }
};

struct Epi2 {
    static constexpr bool PERM = true, AFTER_DRAIN = false, HAS_MID = true; static constexpr int MID_T = 8;
    const unsigned char* GT; unsigned char* MIX8; unsigned* part; unsigned* rcnt; float* rmaxf; PG8_LAS unsigned char* red_lds;
    static __device__ __forceinline__ float ub(unsigned w, int e) { return (float)((w >> (8 * e)) & 0xffu); }
    static __device__ __forceinline__ float gcv(unsigned w, int e) { return fmaxf(ub(w, e) * (1.0f / 255.0f), 1e-30f); }
    __device__ __forceinline__ void mid(f32x4 (&acc)[2][2][4][2], const Unit& u, int wr, int wc, int fr, int fq) const {
        asm volatile("" : "+v"(fr), "+v"(fq));
        const int row0 = u.pm * BM + wr * 64 + fr, col0 = u.pn * BM + wc * 32 + 8 * fq;
        u32x2 ga[2][4][2], gb[2][4][2];
#pragma unroll
        for (int ai = 0; ai < 2; ++ai)
#pragma unroll
            for (int m = 0; m < 4; ++m) { const unsigned char* gp = GT + ((size_t)u.pn * 65536 + (row0 + ai * HALF + m * 16)) * 256 + wc * 32 + 8 * fq;
#pragma unroll
                for (int bj = 0; bj < 2; ++bj) { ga[ai][m][bj] = *(const u32x2*)(gp + bj * HALF); gb[ai][m][bj] = *(const u32x2*)(gp + (size_t)4 * 65536 * 256 + bj * HALF); } }
        asm volatile("" ::: "memory");
#pragma unroll
        for (int ai = 0; ai < 2; ++ai)
#pragma unroll
            for (int m = 0; m < 4; ++m)
#pragma unroll
                for (int bj = 0; bj < 2; ++bj) { const u32x2 a = ga[ai][m][bj], b = gb[ai][m][bj];
                    f32x4 r0, r1;
#pragma unroll
                    for (int e = 0; e < 4; ++e) { r0[e] = ub(a.x, e) * (1.0f / 255.0f) * __builtin_amdgcn_rcpf(gcv(b.x, e)); r1[e] = ub(a.y, e) * (1.0f / 255.0f) * __builtin_amdgcn_rcpf(gcv(b.y, e)); }
                    acc[ai][bj][m][0] *= r0; acc[ai][bj][m][1] *= r1; }
        asm volatile("" ::: "memory");
    }
    __device__ __forceinline__ void operator()(f32x4 (&acc)[2][2][4][2], const Unit& u, int wr, int wc, int fr, int fq) const {
        asm volatile("" : "+v"(fr), "+v"(fq));
        const int row0 = u.pm * BM + wr * 64 + fr, col0 = u.pn * BM + wc * 32 + 8 * fq;
        PG8_LAS float* red = (PG8_LAS float*)red_lds; PG8_LAS float* red2 = red + 1024;
#pragma unroll
        for (int ai = 0; ai < 2; ++ai) { u32x2 gb[4][2];
#pragma unroll
            for (int m = 0; m < 4; ++m) { const unsigned char* gp = GT + ((size_t)(4 + u.pn) * 65536 + (row0 + ai * HALF + m * 16)) * 256 + wc * 32 + 8 * fq;
#pragma unroll
                for (int bj = 0; bj < 2; ++bj) gb[m][bj] = *(const u32x2*)(gp + bj * HALF); }
#pragma unroll
            for (int m = 0; m < 4; ++m) { float a = 0.f;
#pragma unroll
                for (int bj = 0; bj < 2; ++bj) { const u32x2 b = gb[m][bj];
#pragma unroll
                    for (int e = 0; e < 4; ++e) { acc[ai][bj][m][0][e] *= gcv(b.x, e); acc[ai][bj][m][1][e] *= gcv(b.y, e); a = fmaxf(a, fmaxf(fabsf(acc[ai][bj][m][0][e]), fabsf(acc[ai][bj][m][1][e]))); } }
                a = fmaxf(a, __shfl_xor(a, 16)); a = fmaxf(a, __shfl_xor(a, 32));
                if (fq == 0) red[(wr * 64 + fr + ai * HALF + m * 16) * 4 + wc] = a; }
            asm volatile("" ::: "memory");
        }
        asm volatile("s_waitcnt lgkmcnt(0)" ::: "memory"); __builtin_amdgcn_s_barrier(); asm volatile("" ::: "memory");
        const int tid = (wr * 4 + wc) * 64 + fr + 16 * fq;
        if (tid < 256) {
            const f32x4 p4 = *(const PG8_LAS f32x4*)(red + tid * 4);
            const float v = fmaxf(fmaxf(p4[0], p4[1]), fmaxf(p4[2], p4[3]));
            unsigned* pr = part + (size_t)(u.pm * BM + tid) * 4;
            __hip_atomic_store(pr + u.pn, __float_as_uint(v), __ATOMIC_RELAXED, __HIP_MEMORY_SCOPE_AGENT);
            asm volatile("s_waitcnt vmcnt(0)" ::: "memory");
            if ((tid & 63) == 0) (void)__hip_atomic_fetch_add(rcnt + u.pm, 1u, __ATOMIC_RELAXED, __HIP_MEMORY_SCOPE_AGENT);
            { unsigned sp = 0; while (__hip_atomic_load(rcnt + u.pm, __ATOMIC_RELAXED, __HIP_MEMORY_SCOPE_AGENT) < 16u) { __builtin_amdgcn_s_sleep(4); if (++sp > (1u << 21)) break; } }
            asm volatile("" ::: "memory");
            float f = 0.f;
#pragma unroll
            for (int j = 0; j < 4; ++j) f = fmaxf(f, __uint_as_float(__hip_atomic_load(pr + j, __ATOMIC_RELAXED, __HIP_MEMORY_SCOPE_AGENT)));
            red2[tid] = f;
            if (u.pn == 0) rmaxf[u.pm * BM + tid] = f;
        }
        asm volatile("s_waitcnt lgkmcnt(0)" ::: "memory"); __builtin_amdgcn_s_barrier(); asm volatile("" ::: "memory");
#pragma unroll
        for (int ai = 0; ai < 2; ++ai)
#pragma unroll
            for (int m = 0; m < 4; ++m) { const int row = row0 + ai * HALF + m * 16;
                const float rm = red2[wr * 64 + fr + ai * HALF + m * 16]; const float sc = rm > 0.f ? 127.0f / rm : 0.f;
#pragma unroll
                for (int bj = 0; bj < 2; ++bj) { unsigned w0 = 0, w1 = 0;
#pragma unroll
                    for (int e = 0; e < 4; ++e) { w0 |= ((unsigned)(int)__builtin_rintf(acc[ai][bj][m][0][e] * sc) & 0xffu) << (8 * e); w1 |= ((unsigned)(int)__builtin_rintf(acc[ai][bj][m][1][e] * sc) & 0xffu) << (8 * e); }
                    *(u32x2*)(MIX8 + ((size_t)(u.pn * 2 + bj) * 65536 + row) * 128 + wc * 32 + 8 * fq) = (u32x2){w0, w1}; } }
    }
};

struct Epi3 {
    static constexpr bool PERM = true, AFTER_DRAIN = false, HAS_MID = false; static constexpr int MID_T = -1;
    const bf16_t* xb; const float* rms; const unsigned* rmax; const float* wos; bf16_t* x1b; float* ssq;
    __device__ __forceinline__ void mid(f32x4 (&)[2][2][4][2], const Unit&, int, int, int, int) const {}
    static __device__ __forceinline__ f32x4 cvt(const f32x4 a, const f32x4 sc) { const i32x4 ia = __builtin_bit_cast(i32x4, a); return (f32x4){(float)ia[0], (float)ia[1], (float)ia[2], (float)ia[3]} * sc; }
    static __device__ __forceinline__ u32x4 ror8(const u32x4 v) { u32x4 r; r.x = (unsigned)__builtin_amdgcn_update_dpp(0, (int)v.x, 0x128, 0xf, 0xf, false); r.y = (unsigned)__builtin_amdgcn_update_dpp(0, (int)v.y, 0x128, 0xf, 0xf, false);
        r.z = (unsigned)__builtin_amdgcn_update_dpp(0, (int)v.z, 0x128, 0xf, 0xf, false); r.w = (unsigned)__builtin_amdgcn_update_dpp(0, (int)v.w, 0x128, 0xf, 0xf, false); return r; }
    __device__ __forceinline__ void operator()(const f32x4 (&acc)[2][2][4][2], const Unit& u, int wr, int wc, int fr, int fq) const {
        asm volatile("" : "+v"(fr), "+v"(fq));
        const int row0 = u.pm * BM + wr * 64 + fr, col0 = u.pn * BM + wc * 32 + 8 * fq;
        const bool lo8 = fr < 8;
        const int rowx = u.pm * BM + wr * 64 + (fr & 7), colx = u.pn * BM + wc * 64 + 8 * (lo8 ? fq : 4 + fq);
        f32x4 wsv[2][2];
#pragma unroll
        for (int bj = 0; bj < 2; ++bj)
#pragma unroll
            for (int n = 0; n < 2; ++n) wsv[bj][n] = *(const f32x4*)(wos + col0 + bj * HALF + 4 * n);
#pragma unroll
        for (int ai = 0; ai < 2; ++ai) { u32x4 la[4], lb[4]; float rm[4], ms[4];
#pragma unroll
            for (int m = 0; m < 4; ++m) { const int row = row0 + ai * HALF + m * 16; rm[m] = rms[row]; ms[m] = __uint_as_float(rmax[row]) * (1.0f / 127.0f);
                const size_t offx = (size_t)(rowx + ai * HALF + m * 16) * 1024 + colx; la[m] = *(const u32x4*)(xb + offx); lb[m] = *(const u32x4*)(xb + offx + 8 * 1024); }
#pragma unroll
            for (int m = 0; m < 4; ++m) { const int row = row0 + ai * HALF + m * 16; float ss = 0.f; const float r = rm[m], mr = ms[m];
                const u32x4 ra = ror8(la[m]), rb = ror8(lb[m]);
                u32x4 pk[2];
#pragma unroll
                for (int bj = 0; bj < 2; ++bj) { const u32x4 w = bj == 0 ? (lo8 ? la[m] : rb) : (lo8 ? ra : lb[m]);
                    const f32x4 x0 = (f32x4){bflo(w.x), bfhi(w.x), bflo(w.y), bfhi(w.y)}, x1 = (f32x4){bflo(w.z), bfhi(w.z), bflo(w.w), bfhi(w.w)};
                    const f32x4 v0 = cvt(acc[ai][bj][m][0], wsv[bj][0]) * mr + x0 * r, v1 = cvt(acc[ai][bj][m][1], wsv[bj][1]) * mr + x1 * r;
                    pk[bj] = pack8(v0, v1);
                    const f32x4 q0 = v0 * v0, q1 = v1 * v1; ss += ((q0[0] + q0[1]) + (q0[2] + q0[3])) + ((q1[0] + q1[1]) + (q1[2] + q1[3])); }
                { const u32x4 r0 = ror8(pk[0]), r1 = ror8(pk[1]); const size_t offx = (size_t)(rowx + ai * HALF + m * 16) * 1024 + colx;
                  *(u32x4*)(x1b + offx) = lo8 ? pk[0] : r1; *(u32x4*)(x1b + offx + 8 * 1024) = lo8 ? r0 : pk[1]; }
                ss += __shfl_xor(ss, 16); ss += __shfl_xor(ss, 32);
                if (fq == 0) ssq[(size_t)row * 16 + u.pn * 4 + wc] = ss;
            }
            asm volatile("" ::: "memory");
        }
    }
};

__device__ __forceinline__ unsigned f2key(float v) { const unsigned u = __float_as_uint(v); return (u & 0x80000000u) ? ~u : (u | 0x80000000u); }
__device__ __forceinline__ float key2f(unsigned k) { return __uint_as_float((k & 0x80000000u) ? (k & 0x7fffffffu) : ~k); }
#define PG8_CE(a_, b_) do { const unsigned hi__ = (a_) > (b_) ? (a_) : (b_); const unsigned lo__ = (a_) > (b_) ? (b_) : (a_); (a_) = hi__; (b_) = lo__; } while (0)
__device__ __forceinline__ void bitonic_merge16(unsigned (&v)[16]) {
#pragma unroll
    for (int j = 8; j >= 1; j >>= 1)
#pragma unroll
        for (int i = 0; i < 16; ++i) { const int l = i ^ j; if (l > i) PG8_CE(v[i], v[l]); }
}
__device__ __forceinline__ void bitonic_sort16(unsigned (&v)[16]) {
#pragma unroll
    for (int k = 2; k <= 16; k <<= 1)
#pragma unroll
        for (int j = k >> 1; j >= 1; j >>= 1)
#pragma unroll
            for (int i = 0; i < 16; ++i) { const int l = i ^ j; if (l > i) { if ((i & k) == 0 || k == 16) PG8_CE(v[i], v[l]); else PG8_CE(v[l], v[i]); } }
}
__device__ __forceinline__ void sort16_net(unsigned (&v)[16]) {
    PG8_CE(v[0], v[13]); PG8_CE(v[1], v[12]); PG8_CE(v[2], v[15]); PG8_CE(v[3], v[14]); PG8_CE(v[4], v[8]); PG8_CE(v[5], v[6]); PG8_CE(v[7], v[11]); PG8_CE(v[9], v[10]);
    PG8_CE(v[0], v[5]); PG8_CE(v[1], v[7]); PG8_CE(v[2], v[9]); PG8_CE(v[3], v[4]); PG8_CE(v[6], v[13]); PG8_CE(v[8], v[14]); PG8_CE(v[10], v[15]); PG8_CE(v[11], v[12]);
    PG8_CE(v[0], v[1]); PG8_CE(v[2], v[3]); PG8_CE(v[4], v[5]); PG8_CE(v[6], v[8]); PG8_CE(v[7], v[9]); PG8_CE(v[10], v[11]); PG8_CE(v[12], v[13]); PG8_CE(v[14], v[15]);
    PG8_CE(v[0], v[2]); PG8_CE(v[1], v[3]); PG8_CE(v[4], v[10]); PG8_CE(v[5], v[11]); PG8_CE(v[6], v[7]); PG8_CE(v[8], v[9]); PG8_CE(v[12], v[14]); PG8_CE(v[13], v[15]);
    PG8_CE(v[1], v[2]); PG8_CE(v[3], v[12]); PG8_CE(v[4], v[6]); PG8_CE(v[5], v[7]); PG8_CE(v[8], v[10]); PG8_CE(v[9], v[11]); PG8_CE(v[13], v[14]);
    PG8_CE(v[1], v[4]); PG8_CE(v[2], v[6]); PG8_CE(v[5], v[8]); PG8_CE(v[7], v[10]); PG8_CE(v[9], v[13]); PG8_CE(v[11], v[14]);
    PG8_CE(v[2], v[4]); PG8_CE(v[3], v[6]); PG8_CE(v[9], v[12]); PG8_CE(v[11], v[13]);
    PG8_CE(v[3], v[5]); PG8_CE(v[6], v[8]); PG8_CE(v[7], v[9]); PG8_CE(v[10], v[12]);
    PG8_CE(v[3], v[4]); PG8_CE(v[5], v[6]); PG8_CE(v[7], v[8]); PG8_CE(v[9], v[10]); PG8_CE(v[11], v[12]);
    PG8_CE(v[6], v[7]); PG8_CE(v[8], v[9]);
}
__device__ __forceinline__ void merge_top16(unsigned (&t)[16], const unsigned (&o)[16]) {
#pragma unroll
    for (int i = 0; i < 16; ++i) t[i] = t[i] > o[15 - i] ? t[i] : o[15 - i];
    bitonic_merge16(t);
}
template <int XM> __device__ __forceinline__ void merge_top16_xor(unsigned (&t)[16]) {
    unsigned o[16];
#pragma unroll
    for (int i = 0; i < 16; ++i) o[i] = (unsigned)__shfl_xor((int)t[i], XM);
    merge_top16(t, o);
}

struct Epi4 {
    static constexpr bool PERM = false, AFTER_DRAIN = true, HAS_MID = false; static constexpr int MID_T = -1;
    const float* ssq; float* rinv2; unsigned short* ids; float* gw;
    const float* hs; const float* wcs;
    __device__ __forceinline__ void mid(f32x4 (&)[2][2][4][2], const Unit&, int, int, int, int) const {}
    __device__ __forceinline__ void fused(f32x4 (&acc)[2][2][4][2], const Unit& u, int wr, int wc, int fr, int fq, PG8_LAS unsigned char* lds, int wid, int lane) const {
        asm volatile("" : "+v"(fr), "+v"(fq));
        const int tid = wid * 64 + lane;
        const int rl = tid >> 2, p = (tid >> 1) & 1, hf = tid & 1, q4 = tid & 3;
#pragma unroll
        for (int pass = 0; pass < 2; ++pass) {
            f32x4 wsv[2][2]; float hsv[4];
#pragma unroll
            for (int bj = 0; bj < 2; ++bj)
#pragma unroll
                for (int n = 0; n < 2; ++n) wsv[bj][n] = *(const f32x4*)(wcs + u.pn * BM + bj * HALF + wc * 32 + n * 16 + fq * 4);
#pragma unroll
            for (int m = 0; m < 4; ++m) hsv[m] = hs[u.pm * BM + pass * HALF + wr * 64 + m * 16 + fr];
#pragma unroll
            for (int m = 0; m < 4; ++m)
#pragma unroll
                for (int bj = 0; bj < 2; ++bj)
#pragma unroll
                    for (int n = 0; n < 2; ++n) { const i32x4 ia = __builtin_bit_cast(i32x4, acc[pass][bj][m][n]); f32x4 sv;
#pragma unroll
                        for (int e = 0; e < 4; ++e) sv[e] = (float)ia[e] * hsv[m] * wsv[bj][n][e];
                        *(PG8_LAS f32x4*)(lds + (size_t)(wr * 64 + m * 16 + fr) * 1056 + bj * 528 + (wc * 32 + n * 16 + fq * 4) * 4) = sv; }
            asm volatile("s_waitcnt lgkmcnt(0)" ::: "memory"); __builtin_amdgcn_s_barrier(); asm volatile("" ::: "memory");
            const int row = u.pm * BM + pass * HALF + rl;
            unsigned tk[16];
#pragma unroll
            for (int i = 0; i < 16; ++i) tk[i] = 0u;
            const PG8_LAS unsigned char* sp = lds + (size_t)rl * 1056 + p * 528 + hf * 256;
#pragma nounroll
            for (int c = 0; c < 4; ++c) { unsigned ch[16];
#pragma unroll
                for (int e4 = 0; e4 < 4; ++e4) { const f32x4 v = *(const PG8_LAS f32x4*)(sp + c * 64 + e4 * 16);
#pragma unroll
                    for (int e = 0; e < 4; ++e) ch[4 * e4 + e] = (f2key(v[e]) & ~127u) | (unsigned)(127 - (64 * hf + 16 * c + 4 * e4 + e)); }
                sort16_net(ch);
                merge_top16(tk, ch);
            }
            merge_top16_xor<1>(tk);
            asm volatile("s_waitcnt lgkmcnt(0)" ::: "memory");
            PG8_LAS unsigned* kl = (PG8_LAS unsigned*)(lds + (size_t)(rl & ~15) * 1056) + ((rl & 15) * 2) * 16;
            if (hf == 0) {
#pragma unroll
                for (int i = 0; i < 4; ++i) *(PG8_LAS u32x4*)(kl + p * 16 + 4 * i) = (u32x4){tk[4 * i], tk[4 * i + 1], tk[4 * i + 2], tk[4 * i + 3]}; }
            asm volatile("s_waitcnt lgkmcnt(0)" ::: "memory");
            unsigned ck[16];
#define CAND_SLOT(m_, ij__) do { const unsigned i__ = (ij__) >> 4, j__ = (ij__) & 15u; \
                const unsigned ka__ = kl[(ij__) == 0xFFFFu ? 0u : i__], kb__ = kl[16 + ((ij__) == 0xFFFFu ? 0u : j__)]; \
                const float s__ = key2f(ka__ & ~127u) + key2f(kb__ & ~127u); \
                ck[m_] = (ij__) == 0xFFFFu ? 0u : ((f2key(s__) & ~255u) | (255u - (ij__))); } while (0)
                { const unsigned ij_ = q4 == 0 ? 0u : q4 == 1 ? 1u : q4 == 2 ? 2u : 3u; CAND_SLOT(0, ij_); }
                { const unsigned ij_ = q4 == 0 ? 4u : q4 == 1 ? 5u : q4 == 2 ? 6u : 7u; CAND_SLOT(1, ij_); }
                { const unsigned ij_ = q4 == 0 ? 8u : q4 == 1 ? 9u : q4 == 2 ? 10u : 11u; CAND_SLOT(2, ij_); }
                { const unsigned ij_ = q4 == 0 ? 12u : q4 == 1 ? 13u : q4 == 2 ? 14u : 15u; CAND_SLOT(3, ij_); }
                { const unsigned ij_ = q4 == 0 ? 16u : q4 == 1 ? 17u : q4 == 2 ? 18u : 19u; CAND_SLOT(4, ij_); }
                { const unsigned ij_ = q4 == 0 ? 20u : q4 == 1 ? 21u : q4 == 2 ? 22u : 23u; CAND_SLOT(5, ij_); }
                { const unsigned ij_ = q4 == 0 ? 32u : q4 == 1 ? 33u : q4 == 2 ? 34u : 35u; CAND_SLOT(6, ij_); }
                { const unsigned ij_ = q4 == 0 ? 36u : q4 == 1 ? 48u : q4 == 2 ? 49u : 50u; CAND_SLOT(7, ij_); }
                { const unsigned ij_ = q4 == 0 ? 51u : q4 == 1 ? 64u : q4 == 2 ? 65u : 66u; CAND_SLOT(8, ij_); }
                { const unsigned ij_ = q4 == 0 ? 80u : q4 == 1 ? 81u : q4 == 2 ? 96u : 97u; CAND_SLOT(9, ij_); }
                { const unsigned ij_ = q4 == 0 ? 112u : q4 == 1 ? 113u : q4 == 2 ? 128u : 144u; CAND_SLOT(10, ij_); }
                { const unsigned ij_ = q4 == 0 ? 160u : q4 == 1 ? 176u : q4 == 2 ? 192u : 208u; CAND_SLOT(11, ij_); }
                { const unsigned ij_ = q4 == 0 ? 224u : q4 == 1 ? 240u : q4 == 2 ? 65535u : 65535u; CAND_SLOT(12, ij_); }
#undef CAND_SLOT
            ck[13] = 0u; ck[14] = 0u; ck[15] = 0u;
            sort16_net(ck);
            merge_top16_xor<1>(ck); merge_top16_xor<2>(ck);
            float sq = 0.f;
#pragma unroll
            for (int i = 0; i < 4; ++i) { const f32x4 t = *(const f32x4*)(ssq + (size_t)row * 16 + 4 * i); sq += (t[0] + t[1]) + (t[2] + t[3]); }
            const float r2 = __builtin_amdgcn_rsqf(sq * (1.0f / 1024.0f) + 1e-6f);
            if (u.pn == 0 && q4 == 0) rinv2[row] = r2;
            const float b0 = key2f(ck[0] & ~255u); float wsum = 0.f; float wv[16];
#pragma unroll
            for (int q = 0; q < 16; ++q) { wv[q] = __builtin_amdgcn_exp2f((key2f(ck[q] & ~255u) - b0) * r2 * 1.4426950408889634f); wsum += wv[q]; }
            const float inv = 1.0f / wsum;
            unsigned short eo[4]; float go[4];
#pragma unroll
            for (int e = 0; e < 4; ++e) { unsigned c0 = ck[e], c1 = ck[4 + e], c2 = ck[8 + e], c3 = ck[12 + e]; float w0 = wv[e], w1 = wv[4 + e], w2 = wv[8 + e], w3 = wv[12 + e];
                asm volatile("" : "+v"(c0), "+v"(c1), "+v"(c2), "+v"(c3), "+v"(w0), "+v"(w1), "+v"(w2), "+v"(w3));
                const unsigned cc = q4 == 0 ? c0 : q4 == 1 ? c1 : q4 == 2 ? c2 : c3; const float ww = q4 == 0 ? w0 : q4 == 1 ? w1 : q4 == 2 ? w2 : w3;
                const unsigned code = 255u - (cc & 255u);
                const unsigned i1 = 127u - (kl[code >> 4] & 127u), i2 = 127u - (kl[16 + (code & 15u)] & 127u);
                eo[e] = (unsigned short)(i1 * 128u + i2); go[e] = ww * inv; }
            const size_t ob = ((size_t)row * 8 + u.pn) * 16 + q4 * 4;
            { u32x2 w; w.x = eo[0] | ((unsigned)eo[1] << 16); w.y = eo[2] | ((unsigned)eo[3] << 16); *(u32x2*)(ids + ob) = w; }
            *(f32x4*)(gw + ob) = (f32x4){go[0], go[1], go[2], go[3]};
            asm volatile("s_waitcnt lgkmcnt(0)" ::: "memory"); __builtin_amdgcn_s_barrier(); asm volatile("" ::: "memory");
        }
    }
};
template <class Epi, class Sched, bool ALIGN_EPI = false, bool SP2 = false, bool FP8 = false, bool I8 = false>
__device__ __forceinline__ void gemm_phase(PG8_LAS unsigned char* lds, const Gemm g, const Sched& S, const Epi& E) {
    const int tid = threadIdx.x, wid = __builtin_amdgcn_readfirstlane(tid >> 6), lane = tid & 63, wr = wid >> 2, wc = wid & 3, fr = lane & 15, fq = lane >> 4;
    const int K = g.K, nt = K / BK;
    unsigned voffA[2], voffB[2];
#pragma unroll
    for (int i = 0; i < 2; ++i) { int R, C; stage_rc(tid * 16 + i * 8192, R, C); const int Rb = Epi::PERM ? ((R & ~31) + perm32(R & 31)) : R;
        voffA[i] = (unsigned)(R * (g.lda ? g.lda : K) + C) * 2u; voffB[i] = (unsigned)(Rb * K + C) * 2u; }
    const size_t kstep = (size_t)(BK * 2);
    const size_t hstep = (size_t)HALF * K * 2;
    const size_t tstep = 2 * hstep;
    const size_t kstepA = g.ksA ? g.ksA : kstep, hstepA = (size_t)HALF * (g.lda ? g.lda : K) * 2, tstepA = 2 * hstepA;
    const unsigned ldsw = (unsigned)wid * 1024u;
    const int aoff = lds_byte(wr * 64 + fr, fq * 8), boff = lds_byte(wc * 32 + fr, fq * 8);
#define PG8_SA(b, h) (((b) * 2 + (h)) * HTB)
#define PG8_SB(b, h) ((4 + (b) * 2 + (h)) * HTB)
#define PG8_STAGE(bufoff, gbase, voff) do { _Pragma("unroll") for (int _i = 0; _i < 2; ++_i) \
        __builtin_amdgcn_global_load_lds((const unsigned*)((const char*)(gbase) + (voff)[_i]), (PG8_LAS unsigned*)(lds + (bufoff) + ldsw + _i * 8192), 16, 0, 0); } while (0)
#define PG8_LD8(lo_, hi_) __builtin_bit_cast(i32x8, __builtin_shufflevector((lo_), (hi_), 0, 1, 2, 3, 4, 5, 6, 7))
#define PG8_LDA(dst, b, h) do { if constexpr (FP8) { _Pragma("unroll") for (int m = 0; m < 4; ++m) { const u32x4 l0_ = *(const PG8_LAS u32x4*)(lds + PG8_SA(b, h) + aoff + m * 2048), l1_ = *(const PG8_LAS u32x4*)(lds + PG8_SA(b, h) + aoff + m * 2048 + 1024); dst##8[m] = PG8_LD8(l0_, l1_); } } \
        else { _Pragma("unroll") for (int m = 0; m < 4; ++m) _Pragma("unroll") for (int k = 0; k < 2; ++k) dst[m][k] = *(const PG8_LAS bf16x8*)(lds + PG8_SA(b, h) + aoff + m * 2048 + k * 1024); } } while (0)
#define PG8_LDB(dst, b, h) do { if constexpr (FP8) { _Pragma("unroll") for (int n = 0; n < 2; ++n) { const u32x4 l0_ = *(const PG8_LAS u32x4*)(lds + PG8_SB(b, h) + boff + n * 2048), l1_ = *(const PG8_LAS u32x4*)(lds + PG8_SB(b, h) + boff + n * 2048 + 1024); dst##8[n] = PG8_LD8(l0_, l1_); } } \
        else { _Pragma("unroll") for (int n = 0; n < 2; ++n) _Pragma("unroll") for (int k = 0; k < 2; ++k) dst[n][k] = *(const PG8_LAS bf16x8*)(lds + PG8_SB(b, h) + boff + n * 2048 + k * 1024); } } while (0)
#define PG8_MMA(ai, bj, At, Bt) do { __builtin_amdgcn_s_setprio(1); \
        if constexpr (FP8) { _Pragma("unroll") for (int m = 0; m < 4; ++m) _Pragma("unroll") for (int n = 0; n < 2; ++n) \
            asm volatile("v_mfma_scale_f32_16x16x128_f8f6f4 %0, %1, %2, %0, %3, %3 op_sel_hi:[0,0,0]" : "+v"(acc[ai][bj][m][n]) : "v"(Bt##8[n]), "v"(At##8[m]), "v"(sc127));     \
            } \
        else if constexpr (I8) { _Pragma("unroll") for (int m = 0; m < 4; ++m) _Pragma("unroll") for (int n = 0; n < 2; ++n) _Pragma("unroll") for (int k = 0; k < 2; ++k) \
            acc[ai][bj][m][n] = __builtin_bit_cast(f32x4, __builtin_amdgcn_mfma_i32_16x16x64_i8(__builtin_bit_cast(i32x4, Bt[n][k]), __builtin_bit_cast(i32x4, At[m][k]), __builtin_bit_cast(i32x4, acc[ai][bj][m][n]), 0, 0, 0)); } \
        else { _Pragma("unroll") for (int m = 0; m < 4; ++m) _Pragma("unroll") for (int n = 0; n < 2; ++n) _Pragma("unroll") for (int k = 0; k < 2; ++k) \
            acc[ai][bj][m][n] = __builtin_amdgcn_mfma_f32_16x16x32_bf16(Bt[n][k], At[m][k], acc[ai][bj][m][n], 0, 0, 0); } \
        __builtin_amdgcn_s_setprio(0); } while (0)
#define PG8_WAIT_V(n) asm volatile("s_waitcnt vmcnt(" #n ")" ::: "memory")
#define PG8_WAIT_L(n) asm volatile("s_waitcnt lgkmcnt(" #n ")" ::: "memory")
#define PG8_BAR __builtin_amdgcn_s_barrier()
#define PG8_SCHED __builtin_amdgcn_sched_barrier(0)
    Unit cur, nxt; int ui = 0;
    if (!S.next(0, cur)) return;
    f32x4 acc[2][2][4][2];
#pragma unroll
    for (int a = 0; a < 2; ++a)
#pragma unroll
        for (int b = 0; b < 2; ++b)
#pragma unroll
            for (int m = 0; m < 4; ++m)
#pragma unroll
                for (int n = 0; n < 2; ++n) acc[a][b][m][n] = (f32x4){0.f, 0.f, 0.f, 0.f};
    bf16x8 At[4][2], B0[2][2], B1[2][2]; i32x8 At8[4], B08[2], B18[2];
    int sc127 = 127; asm volatile("" : "+v"(sc127));
    const char* cA = (const char*)g.A + (size_t)cur.pm * tstepA; const char* cB = (const char*)g.Bt + (size_t)cur.pn * tstep;
    S.a_ready(cur);
    if constexpr (SP2) {
        PG8_STAGE(PG8_SB(0, 0), cB, voffB); PG8_STAGE(PG8_SB(0, 1), cB + hstep, voffB); PG8_STAGE(PG8_SA(0, 0), cA, voffA); PG8_STAGE(PG8_SA(0, 1), cA + hstepA, voffA);
        if (wr == 1) PG8_BAR;
        PG8_WAIT_V(2); PG8_BAR;
        PG8_STAGE(PG8_SB(1, 0), cB + kstep, voffB); PG8_STAGE(PG8_SA(1, 0), cA + kstepA, voffA); PG8_STAGE(PG8_SB(1, 1), cB + hstep + kstep, voffB);
        PG8_WAIT_V(6); PG8_BAR;
    } else {
        PG8_STAGE(PG8_SB(0, 0), cB, voffB); PG8_STAGE(PG8_SA(0, 0), cA, voffA); PG8_STAGE(PG8_SB(0, 1), cB + hstep, voffB); PG8_STAGE(PG8_SA(0, 1), cA + hstepA, voffA);
        if (wr == 1) PG8_BAR;
        PG8_WAIT_V(4); PG8_BAR;
        PG8_STAGE(PG8_SB(1, 0), cB + kstep, voffB); PG8_STAGE(PG8_SA(1, 0), cA + kstepA, voffA); PG8_STAGE(PG8_SB(1, 1), cB + hstep + kstep, voffB);
        PG8_WAIT_V(6); PG8_BAR;
    }
    for (;;) {
        const bool has_next = S.next(ui + 1, nxt);
        const char* nA = has_next ? (const char*)g.A + (size_t)nxt.pm * tstepA : cA; const char* nB = has_next ? (const char*)g.Bt + (size_t)nxt.pn * tstep : cB;
        for (int t = 0; t < nt; t += 2) {
            if constexpr (Epi::HAS_MID) { if (t == Epi::MID_T) E.mid(acc, cur, wr, wc, fr, fq); }
            const bool last = (t == nt - 2);
            const char* a1 = cA + (size_t)(t + 1) * kstepA;
            const char* a2 = last ? nA : cA + (size_t)(t + 2) * kstepA; const char* b2 = last ? nB : cB + (size_t)(t + 2) * kstep;
            const char* a3 = a2 + kstepA; const char* b3 = b2 + kstep;
            if (last && has_next) S.a_ready(nxt);
            if constexpr (SP2) {
            PG8_LDB(B0, 0, 0); PG8_LDB(B1, 0, 1); PG8_SCHED; PG8_LDA(At, 0, 0); PG8_STAGE(PG8_SA(1, 1), a1 + hstepA, voffA);
            PG8_WAIT_V(8); PG8_WAIT_L(0); PG8_BAR; PG8_MMA(0, 0, At, B0); PG8_MMA(0, 1, At, B1); PG8_BAR; PG8_SCHED;
            PG8_LDA(At, 0, 1); PG8_STAGE(PG8_SB(0, 0), b2, voffB); PG8_STAGE(PG8_SB(0, 1), b2 + hstep, voffB); PG8_STAGE(PG8_SA(0, 0), a2, voffA);
            PG8_WAIT_V(8); PG8_WAIT_L(0); PG8_BAR; PG8_MMA(1, 0, At, B0); PG8_MMA(1, 1, At, B1); PG8_BAR; PG8_SCHED;
            PG8_LDB(B0, 1, 0); PG8_LDB(B1, 1, 1); PG8_SCHED; PG8_LDA(At, 1, 0); PG8_STAGE(PG8_SA(0, 1), a2 + hstepA, voffA);
            PG8_WAIT_V(8); PG8_WAIT_L(0); PG8_BAR; PG8_MMA(0, 0, At, B0); PG8_MMA(0, 1, At, B1); PG8_BAR; PG8_SCHED;
            PG8_LDA(At, 1, 1); PG8_STAGE(PG8_SB(1, 0), b3, voffB); PG8_STAGE(PG8_SB(1, 1), b3 + hstep, voffB); PG8_STAGE(PG8_SA(1, 0), a3, voffA);
            PG8_WAIT_V(8); PG8_WAIT_L(0); PG8_BAR; PG8_MMA(1, 0, At, B0); PG8_MMA(1, 1, At, B1); PG8_BAR; PG8_SCHED;
            } else {
            PG8_LDB(B0, 0, 0); PG8_SCHED; PG8_LDA(At, 0, 0); PG8_STAGE(PG8_SA(1, 1), a1 + hstepA, voffA);
            PG8_WAIT_L(8); PG8_BAR; PG8_WAIT_L(0); PG8_MMA(0, 0, At, B0); PG8_BAR; PG8_SCHED;
            PG8_LDB(B1, 0, 1); PG8_STAGE(PG8_SB(0, 0), b2, voffB);
            PG8_BAR; PG8_WAIT_L(0); PG8_MMA(0, 1, At, B1); PG8_BAR;
            PG8_LDA(At, 0, 1); PG8_STAGE(PG8_SA(0, 0), a2, voffA);
            PG8_BAR; PG8_WAIT_L(0); PG8_MMA(1, 0, At, B0); PG8_BAR; PG8_SCHED;
            PG8_STAGE(PG8_SB(0, 1), b2 + hstep, voffB);
            PG8_WAIT_V(6); PG8_BAR; PG8_MMA(1, 1, At, B1); PG8_BAR;
            PG8_LDB(B0, 1, 0); PG8_SCHED; PG8_LDA(At, 1, 0); PG8_STAGE(PG8_SA(0, 1), a2 + hstepA, voffA);
            PG8_WAIT_L(8); PG8_BAR; PG8_WAIT_L(0); PG8_MMA(0, 0, At, B0); PG8_BAR; PG8_SCHED;
            PG8_LDB(B1, 1, 1); PG8_STAGE(PG8_SB(1, 0), b3, voffB);
            PG8_BAR; PG8_WAIT_L(0); PG8_MMA(0, 1, At, B1); PG8_BAR;
            PG8_LDA(At, 1, 1); PG8_STAGE(PG8_SA(1, 0), a3, voffA);
            PG8_BAR; PG8_WAIT_L(0); PG8_MMA(1, 0, At, B0); PG8_BAR; PG8_SCHED;
            PG8_STAGE(PG8_SB(1, 1), b3 + hstep, voffB);
            PG8_WAIT_V(6); PG8_BAR; PG8_MMA(1, 1, At, B1); PG8_BAR;
            }
        }
        if constexpr (FP8) asm volatile("s_nop 15\n\ts_nop 15" ::: "memory");
        if constexpr (ALIGN_EPI) { if (wr == 0) PG8_BAR; }
        if constexpr (!Epi::AFTER_DRAIN) { E(acc, cur, wr, wc, fr, fq); S.done(cur); }
        if (!has_next) break;
#pragma unroll
        for (int a = 0; a < 2; ++a)
#pragma unroll
            for (int b = 0; b < 2; ++b)
#pragma unroll
                for (int m = 0; m < 4; ++m)
#pragma unroll
                    for (int n = 0; n < 2; ++n) acc[a][b][m][n] = (f32x4){0.f, 0.f, 0.f, 0.f};
        cur = nxt; cA = nA; cB = nB; ++ui;
        if constexpr (ALIGN_EPI) { if (wr == 1) PG8_BAR; }
    }
    PG8_WAIT_V(0);
    if constexpr (!ALIGN_EPI) { if (wr == 0) PG8_BAR; }
    PG8_BAR;
    if constexpr (Epi::AFTER_DRAIN) { E.fused(acc, cur, wr, wc, fr, fq, lds, wid, lane); S.done(cur); }
#undef PG8_SA
#undef PG8_SB
#undef PG8_STAGE
#undef PG8_LDA
#undef PG8_LD8
#undef PG8_LDB
#undef PG8_MMA
#undef PG8_WAIT_V
#undef PG8_WAIT_L
#undef PG8_BAR
#undef PG8_SCHED
}
}


namespace att {
#define ALAS __attribute__((address_space(3)))
typedef unsigned short bf16;
typedef short bf16x8 __attribute__((ext_vector_type(8)));
typedef short s16x4 __attribute__((ext_vector_type(4)));
typedef float f32x16 __attribute__((ext_vector_type(16)));
typedef float f32x4 __attribute__((ext_vector_type(4)));
typedef float f32x2 __attribute__((ext_vector_type(2)));
typedef unsigned u32x4 __attribute__((ext_vector_type(4)));
typedef __bf16 bf16x2_t __attribute__((ext_vector_type(2)));
constexpr int SEQ = 4096;
constexpr int VPITCH = 144;
constexpr float LOG2E = 1.4426950408889634f, LN2 = 0.6931471805599453f;
__device__ __forceinline__ unsigned pkbf(float lo, float hi) { f32x2 v = {lo, hi}; bf16x2_t b = __builtin_convertvector(v, bf16x2_t); return __builtin_bit_cast(unsigned, b); }
__device__ __forceinline__ void wave_lds_sync() { asm volatile("s_waitcnt lgkmcnt(0)" ::: "memory"); }
__device__ __forceinline__ s16x4 vtr(const ALAS unsigned char* p) { return __builtin_bit_cast(s16x4, __builtin_amdgcn_ds_read_tr16_b64_v4i16((ALAS s16x4*)p)); }
__device__ __forceinline__ int crow(int r, int hi) { return (r & 3) + 8 * (r >> 2) + 4 * hi; }

__device__ __forceinline__ void pv_tile(f32x16& o0, f32x16& o1, const float (&a)[16], const ALAS unsigned char* vt, int lane) {
    const int g = lane >> 4, i = lane & 15, q_ = i >> 2, p_ = i & 3, h = lane >> 5;
    const ALAS unsigned char* vb = vt + (8 * h + q_) * VPITCH + (16 * (g & 1) + 4 * p_) * 2;
    u32x4 pw0, pw1;
    pw0.x = pkbf(a[0], a[1]); pw0.y = pkbf(a[2], a[3]); pw0.z = pkbf(a[4], a[5]); pw0.w = pkbf(a[6], a[7]);
    pw1.x = pkbf(a[8], a[9]); pw1.y = pkbf(a[10], a[11]); pw1.z = pkbf(a[12], a[13]); pw1.w = pkbf(a[14], a[15]);
    const bf16x8 pa0 = __builtin_bit_cast(bf16x8, pw0), pa1 = __builtin_bit_cast(bf16x8, pw1);
#pragma unroll
    for (int s = 0; s < 2; ++s) {
        const s16x4 l0 = vtr(vb + (16 * s) * VPITCH), h0 = vtr(vb + (16 * s + 4) * VPITCH);
        const s16x4 l1 = vtr(vb + (16 * s) * VPITCH + 64), h1 = vtr(vb + (16 * s + 4) * VPITCH + 64);
        const bf16x8 v0 = (bf16x8){l0[0], l0[1], l0[2], l0[3], h0[0], h0[1], h0[2], h0[3]};
        const bf16x8 v1 = (bf16x8){l1[0], l1[1], l1[2], l1[3], h1[0], h1[1], h1[2], h1[3]};
        o0 = __builtin_amdgcn_mfma_f32_32x32x16_bf16(s ? pa1 : pa0, v0, o0, 0, 0, 0);
        o1 = __builtin_amdgcn_mfma_f32_32x32x16_bf16(s ? pa1 : pa0, v1, o1, 0, 0, 0);
    }
}
__device__ __forceinline__ void bcast_rows(float v, ALAS float* sc, int r32, int hi, float (&out)[16]) {
    if (hi == 0) sc[r32] = v;
    wave_lds_sync();
#pragma unroll
    for (int g = 0; g < 4; ++g) { const f32x4 t = *(const ALAS f32x4*)(sc + 8 * g + 4 * hi); out[4 * g] = t[0]; out[4 * g + 1] = t[1]; out[4 * g + 2] = t[2]; out[4 * g + 3] = t[3]; }
    wave_lds_sync();
}
__device__ __forceinline__ void store_o(const f32x16& o0, const f32x16& o1, ALAS unsigned char* stg, bf16* dst  , size_t rstride_elems, int lane) {
    const int r32 = lane & 31, hi = lane >> 5;
    wave_lds_sync();
#pragma unroll
    for (int r = 0; r < 16; ++r) { const int q = crow(r, hi);
        *(ALAS unsigned short*)(stg + q * VPITCH + r32 * 2) = (unsigned short)(pkbf(o0[r], 0.f) & 0xffffu);
        *(ALAS unsigned short*)(stg + q * VPITCH + 64 + r32 * 2) = (unsigned short)(pkbf(o1[r], 0.f) & 0xffffu); }
    wave_lds_sync();
#pragma unroll
    for (int i = 0; i < 4; ++i) { const int row = 8 * i + (lane >> 3), ch = lane & 7; const u32x4 v = *(const ALAS u32x4*)(stg + row * VPITCH + ch * 16); *(u32x4*)(dst + (size_t)row * rstride_elems + ch * 8) = v; }
    wave_lds_sync();
}

__device__ __forceinline__ void sb_item(const bf16* QS, const bf16* KS, const bf16* VS, bf16* OC, int b, int h, int qt, ALAS unsigned char* wl, int lane) {
    const int r32 = lane & 31, hi = lane >> 5;
    const int t0 = qt * 32; const size_t rowb = (size_t)b * SEQ;
    const int kperm = (r32 & ~12) | ((r32 & 4) << 1) | ((r32 & 8) >> 1);
    bf16x8 qf[4];
    const size_t hbs = ((size_t)(b * 8 + h) * SEQ) * 64;
    { const bf16* qp = QS + hbs + (size_t)(t0 + r32) * 64 + hi * 8;
#pragma unroll
      for (int d0 = 0; d0 < 4; ++d0) qf[d0] = *(const bf16x8*)(qp + d0 * 16); }
    f32x16 o0 = {}, o1 = {}; float Rm = 1.0f;
    bf16x8 kfb[2][4]; u32x4 vvb[2][4];
#define SB_LOADT(key0_, KF, VV) do { const bf16* kp_ = KS + hbs + (size_t)((key0_) + kperm) * 64 + hi * 8; \
        _Pragma("unroll") for (int d0 = 0; d0 < 4; ++d0) KF[d0] = *(const bf16x8*)(kp_ + d0 * 16); \
        _Pragma("unroll") for (int i = 0; i < 4; ++i) VV[i] = *(const u32x4*)(VS + hbs + (size_t)((key0_) + 8 * i + (lane >> 3)) * 64 + (lane & 7) * 8); } while (0)
    auto step = [&](const int key0, const bf16x8 (&kf)[4], const u32x4 (&vv)[4]) __attribute__((always_inline)) -> bool {
        f32x16 p = {};
#pragma unroll
        for (int d0 = 0; d0 < 4; ++d0) p = __builtin_amdgcn_mfma_f32_32x32x16_bf16(kf[d0], qf[d0], p, 0, 0, 0);
#pragma unroll
        for (int i = 0; i < 4; ++i) *(ALAS u32x4*)(wl + (8 * i + (lane >> 3)) * VPITCH + (lane & 7) * 16) = vv[i];
        const bool diag = (key0 == t0);
        float w[16], c[16];
#pragma unroll
        for (int r = 0; r < 16; ++r) { const int kk = (r & 7) + 8 * hi + 16 * (r >> 3); const bool valid = !diag || (kk < r32);
            const float wv = __builtin_amdgcn_exp2f(fminf(p[r], 60.0f)); w[r] = valid ? wv : 0.f; }
        c[15] = 1.0f + w[15];
#pragma unroll
        for (int r = 14; r >= 8; --r) c[r] = c[r + 1] * (1.0f + w[r]);
        c[7] = 1.0f + w[7];
#pragma unroll
        for (int r = 6; r >= 0; --r) c[r] = c[r + 1] * (1.0f + w[r]);
        const float TB = c[8], TA = c[0];
        const float TBo = __shfl_xor(TB, 32), TAo = __shfl_xor(TA, 32);
        const float offB = Rm * (hi ? 1.0f : TBo);
        const float offA = (Rm * TB) * (TBo * (hi ? 1.0f : TAo));
        float a[16];
#pragma unroll
        for (int r = 0; r < 16; ++r) a[r] = w[r] * __builtin_amdgcn_rcpf(c[r] * (r < 8 ? offA : offB));
        Rm *= (TA * TB) * (TAo * TBo);
        wave_lds_sync();
        pv_tile(o0, o1, a, wl, lane);
        wave_lds_sync();
        return __all(Rm > 1.1529215e18f);
    };
    if (t0 < 64) {
        for (int key0 = t0; key0 >= 0; key0 -= 32) { SB_LOADT(key0, kfb[0], vvb[0]); if (step(key0, kfb[0], vvb[0])) break; }
    } else {
        SB_LOADT(t0, kfb[0], vvb[0]); SB_LOADT(t0 - 32, kfb[1], vvb[1]); __builtin_amdgcn_sched_barrier(0);
        bool ex = step(t0, kfb[0], vvb[0]);
        if (!ex) {
            SB_LOADT(t0 - 64, kfb[0], vvb[0]); __builtin_amdgcn_sched_barrier(0);
            ex = step(t0 - 32, kfb[1], vvb[1]);
            if (!ex) {
                ex = step(t0 - 64, kfb[0], vvb[0]);
                for (int key0 = t0 - 96; !ex && key0 >= 0; key0 -= 32) { SB_LOADT(key0, kfb[0], vvb[0]); ex = step(key0, kfb[0], vvb[0]); }
            }
        }
    }
#undef SB_LOADT
    store_o(o0, o1, wl, OC + ((size_t)h * (16 * SEQ) + rowb + t0) * 64, 64, lane);
}

constexpr int DLU_WAVE = 5120;
constexpr int DLU_O = 8 * DLU_WAVE, DLU_M = DLU_O + 512 * 128, DLU_L = DLU_M + 2048, DLU_Q = DLU_L + 2048  , DLU_BYTES = DLU_Q + 8 * 4096;
template <bool FIXREF> __device__ __forceinline__ void dl_unit(const bf16* QD, const bf16* KD, const bf16* VD, bf16* OC, int b, int j, int blk, ALAS unsigned char* lds, int wave, int lane_in, float mref) {
    const size_t rowb = (size_t)b * SEQ;
    const int t0 = 512 * blk;
    ALAS unsigned char* wl = lds + wave * DLU_WAVE;
    ALAS float* sc = (ALAS float*)(wl + 4608);
    ALAS unsigned short* OL = (ALAS unsigned short*)(lds + DLU_O);
    ALAS float* ML = (ALAS float*)(lds + DLU_M); ALAS float* LL = (ALAS float*)(lds + DLU_L);
    ALAS unsigned char* ql = lds + DLU_Q + wave * 4096;
    for (int g = 2; g >= 0; --g) {
        const int hh = 4 * g + j, sh = 2 * g, r = 1 << sh;
        const float slope2 = __builtin_amdgcn_exp2f(-8.0f * (float)(hh + 1) / 12.0f) * LOG2E;
        const float sr = slope2 * (float)r;
        for (int it = wave; it < 16; it += 8) {
            int lane = lane_in; asm volatile("" : "+v"(lane));
            const int r32 = lane & 31, hi = lane >> 5;
            const int kperm = (r32 & ~12) | ((r32 & 4) << 1) | ((r32 & 8) >> 1);
            const int q0 = g == 2 ? it : g == 1 ? (it & 3) + 128 * (it >> 2) : 32 * it;
            const int tq = t0 + q0 + r * r32, tmax = t0 + q0 + 31 * r;
            bf16x8 qf[4];
            const size_t hbd = ((size_t)(b * 12 + hh) * SEQ) * 64;
            const int rm1 = r - 1;
#define DL_TP(x_) ((((x_) & rm1) << (12 - sh)) + ((x_) >> sh))
            { const bf16* qp = QD + hbd + (size_t)DL_TP(tq) * 64 + hi * 8;
#pragma unroll
              for (int d0 = 0; d0 < 4; ++d0) qf[d0] = *(const bf16x8*)(qp + d0 * 16); }
            if constexpr (FIXREF) {
#pragma unroll
                for (int d0 = 0; d0 < 4; ++d0) *(ALAS bf16x8*)(ql + d0 * 1024 + lane * 16) = qf[d0]; }
            const int klo = 31 - r32; int khi = klo + 128; { const int kmaxtok = tmax >> sh; khi = khi < kmaxtok ? khi : kmaxtok; }
            const unsigned krange = (unsigned)(khi - klo);
            const bool allfull = (tmax >> sh) >= 127;
            f32x16 o0 = {}, o1 = {}; float mrun = -3.0e38f, lrun = 0.f;
            if (g != 2) {
                mrun = ML[q0 + r * r32]; lrun = hi ? 0.f : LL[q0 + r * r32];
#pragma unroll
                for (int q = 0; q < 16; ++q) { const int tl = q0 + r * crow(q, hi);
                    o0[q] = __uint_as_float((unsigned)OL[tl * 64 + r32] << 16); o1[q] = __uint_as_float((unsigned)OL[tl * 64 + 32 + r32] << 16); }
            }
            bf16x8 kfb[2][4]; u32x4 vvb[2][4];
#define DL_LOADT(kt_, KF, VV) do { int sk_ = tmax - r * (32 * (kt_) + kperm); sk_ = sk_ < 0 ? 0 : sk_; const bf16* kp_ = KD + hbd + (size_t)DL_TP(sk_) * 64 + hi * 8; \
                _Pragma("unroll") for (int d0 = 0; d0 < 4; ++d0) KF[d0] = *(const bf16x8*)(kp_ + d0 * 16); \
                _Pragma("unroll") for (int i = 0; i < 4; ++i) { int sv_ = tmax - r * (32 * (kt_) + 8 * i + (lane >> 3)); sv_ = sv_ < 0 ? 0 : sv_; VV[i] = *(const u32x4*)(VD + hbd + (size_t)DL_TP(sv_) * 64 + (lane & 7) * 8); } } while (0)
            auto step = [&](const int kt, const bf16x8 (&kf)[4], const u32x4 (&vv)[4]) __attribute__((always_inline)) {
                int lq = lane; asm volatile("" : "+v"(lq));
                const int dk = 32 * kt + 8 * hi - klo;
                const float tb = -sr * (float)dk - (FIXREF ? mref : 0.f);
                f32x16 p;
#pragma unroll
                for (int q = 0; q < 16; ++q) p[q] = tb - sr * (float)((q & 7) + 16 * (q >> 3));
#pragma unroll
                for (int d0 = 0; d0 < 4; ++d0) { bf16x8 qv; if constexpr (FIXREF) qv = *(const ALAS bf16x8*)(ql + d0 * 1024 + lq * 16); else qv = qf[d0];
                    p = __builtin_amdgcn_mfma_f32_32x32x16_bf16(kf[d0], qv, p, 0, 0, 0); }
#pragma unroll
                for (int i = 0; i < 4; ++i) *(ALAS u32x4*)(wl + (8 * i + (lq >> 3)) * VPITCH + (lq & 7) * 16) = vv[i];
                float z2[16]; float a[16]; float ls = 0.f;
                if constexpr (FIXREF) {
                    if (kt >= 1 && kt <= 3 && allfull) {
#pragma unroll
                        for (int q = 0; q < 16; ++q) z2[q] = p[q];
                    } else {
#pragma unroll
                        for (int q = 0; q < 16; ++q) { const bool valid = (unsigned)(dk + ((q & 7) + 16 * (q >> 3))) <= krange; z2[q] = valid ? p[q] : -INFINITY; }
                    }
#pragma unroll
                    for (int q = 0; q < 16; ++q) { a[q] = __builtin_amdgcn_exp2f(z2[q]); ls += a[q]; }
                } else {
                    float mt = -3.0e38f;
#pragma unroll
                    for (int q = 0; q < 16; ++q) { const bool valid = (unsigned)(dk + ((q & 7) + 16 * (q >> 3))) <= krange; z2[q] = valid ? p[q] : -INFINITY; mt = fmaxf(mt, z2[q]); }
                    mt = fmaxf(mt, __shfl_xor(mt, 32));
                    if (__any(mt > mrun + 8.0f)) {
                        const float mnew = fmaxf(mrun, mt); const float alpha = __builtin_amdgcn_exp2f(mrun - mnew);
                        lrun *= alpha; float al[16]; bcast_rows(alpha, sc, r32, hi, al);
#pragma unroll
                        for (int q = 0; q < 16; ++q) { o0[q] *= al[q]; o1[q] *= al[q]; }
                        mrun = mnew;
                    }
#pragma unroll
                    for (int q = 0; q < 16; ++q) { a[q] = __builtin_amdgcn_exp2f(z2[q] - mrun); ls += a[q]; }
                }
                lrun += ls;
                wave_lds_sync();
                pv_tile(o0, o1, a, wl, lq);
                wave_lds_sync();
            };
            const int kmx = (tmax >> sh) < 159 ? (tmax >> sh) : 159, ntl = (kmx >> 5) + 1;
            if constexpr (FIXREF) {
                DL_LOADT(0, kfb[0], vvb[0]);
                int kt = 0;
#pragma unroll 1
                for (; kt + 2 < ntl; kt += 2) {
                    DL_LOADT(kt + 1, kfb[1], vvb[1]); __builtin_amdgcn_sched_barrier(0);
                    step(kt, kfb[0], vvb[0]);
                    DL_LOADT(kt + 2, kfb[0], vvb[0]); __builtin_amdgcn_sched_barrier(0);
                    step(kt + 1, kfb[1], vvb[1]);
                }
                if (ntl - kt == 2) { DL_LOADT(kt + 1, kfb[1], vvb[1]); __builtin_amdgcn_sched_barrier(0); step(kt, kfb[0], vvb[0]); step(kt + 1, kfb[1], vvb[1]); }
                else step(kt, kfb[0], vvb[0]);
            } else {
                for (int kt = 0; kt < ntl; ++kt) { DL_LOADT(kt, kfb[0], vvb[0]); step(kt, kfb[0], vvb[0]); }
            }
#undef DL_LOADT
#undef DL_TP
            const float ltot = lrun + __shfl_xor(lrun, 32);
            if (g != 0) {
                if (hi == 0) { ML[q0 + r * r32] = mrun; LL[q0 + r * r32] = ltot; }
#pragma unroll
                for (int q = 0; q < 16; ++q) { const int tl = q0 + r * crow(q, hi);
                    OL[tl * 64 + r32] = (unsigned short)(pkbf(o0[q], 0.f) & 0xffffu); OL[tl * 64 + 32 + r32] = (unsigned short)(pkbf(o1[q], 0.f) & 0xffffu); }
            } else {
                float il[16]; bcast_rows(1.0f / ltot, sc, r32, hi, il);
#pragma unroll
                for (int q = 0; q < 16; ++q) { o0[q] *= il[q]; o1[q] *= il[q]; }
                store_o(o0, o1, wl, OC + ((size_t)(8 + j) * (16 * SEQ) + rowb + t0 + q0) * 64, 64, lane);
            }
        }
        asm volatile("s_waitcnt lgkmcnt(0)" ::: "memory"); __builtin_amdgcn_s_barrier(); asm volatile("" ::: "memory");
    }
}
#undef ALAS
}

constexpr int NWAVES = 8;
#ifndef MK_N_LAUNCHES
#define MK_N_LAUNCHES 1
#endif
#ifndef MK_LAST_PHASE
#define MK_LAST_PHASE 8
#endif
constexpr int N_LAUNCHES = MK_N_LAUNCHES;
constexpr int PER_PHASE = 8;

constexpr int BATCH = 16, SEQ = 4096, D = 1024, T = BATCH * SEQ;
constexpr int N1 = 5888;
constexpr int NEXP = 16384;
constexpr size_t MiB = 1u << 20;
constexpr size_t WS_CTL = 0, CTL_ZERO_BYTES = 1 * MiB;
constexpr size_t WS_WIN = 2 * MiB;
constexpr size_t WS_WCAT = 16 * MiB;
constexpr size_t WS_WOUT = 18 * MiB;
constexpr size_t WS_WC = 20 * MiB;
constexpr size_t WS_RINV1 = 24 * MiB;
constexpr size_t WS_RINV2 = 25 * MiB;
constexpr size_t WS_USC = 25 * MiB + 512 * 1024, WS_VSC = 25 * MiB + 768 * 1024;
constexpr size_t WS_SSQ = 26 * MiB;
constexpr size_t WS_U8 = 32 * MiB;
constexpr size_t WS_V8 = 64 * MiB;
constexpr size_t WS_IDS = 96 * MiB;
constexpr size_t WS_GW = 112 * MiB;
constexpr size_t WS_XB = 144 * MiB;
constexpr size_t WS_OC = 880 * MiB;
constexpr size_t WS_QS = 272 * MiB, WS_KS = 336 * MiB, WS_VS = 400 * MiB;
constexpr size_t WS_QD = 464 * MiB, WS_KD = 560 * MiB, WS_VD = 656 * MiB;
constexpr size_t WS_GT = 752 * MiB;
constexpr size_t WS_COEF = 272 * MiB;
constexpr size_t WS_MIX = 272 * MiB;
constexpr size_t WS_X1B = 400 * MiB;
constexpr size_t WS_HQ4 = 592 * MiB;
constexpr size_t WS_HQ = 528 * MiB;
constexpr size_t WS_HS2 = 24 * MiB + 512 * 1024;
constexpr size_t WS_XB8 = 72 * MiB;
constexpr size_t WS_WG8 = 40 * MiB;
constexpr size_t WS_PART = 56 * MiB;
constexpr size_t WS_RMAXF = 24 * MiB + 768 * 1024;
constexpr size_t WS_WOS = 46 * MiB + 512 * 1024;
constexpr size_t WS_WCS = 46 * MiB;
constexpr size_t WS_WCF = 48 * MiB;
constexpr size_t WS_XS = 24 * MiB + 256 * 1024;
constexpr size_t WS_GCS = 47 * MiB;
constexpr size_t WS_END = 1008 * MiB;
constexpr int CW_BAR = 4096;
constexpr int CW_OMAX = 28672;
constexpr int CW_RMAX = 65536;
constexpr int CW_RCNT = 131072;
constexpr int CW_WMAX = 24576;
constexpr int CW_GMAX = 16384;
constexpr int CW_XRANK = 8192;

constexpr int RING_OFF = 0, RING_BYTES = 131072;
constexpr int LDSCTL_OFF = 143360, MISC_OFF = LDSCTL_OFF + 320;
constexpr int LDS_BYTES = 147456;
static_assert(MISC_OFF + 128 <= LDS_BYTES, "LDS map");
#define GAS __attribute__((address_space(1)))
#define LAS __attribute__((address_space(3)))
typedef unsigned short bf16;
typedef unsigned v4u __attribute__((ext_vector_type(4)));
typedef float f32x4 __attribute__((ext_vector_type(4)));
typedef short bf16x8 __attribute__((ext_vector_type(8)));
typedef GAS unsigned gu32;
typedef GAS unsigned long long gu64;
#define RLX_AGENT __ATOMIC_RELAXED, __HIP_MEMORY_SCOPE_AGENT
#define LDS_WAIT() asm volatile("s_waitcnt lgkmcnt(0)" ::: "memory")
#define VM_WAIT() asm volatile("s_waitcnt vmcnt(0)" ::: "memory")
__device__ __forceinline__ unsigned long long rt() { return __builtin_amdgcn_s_memrealtime(); }
__device__ __forceinline__ unsigned f2bf(float f) { unsigned u = __builtin_bit_cast(unsigned, f); return (u + 0x7fffu + ((u >> 16) & 1u)) >> 16; }
__device__ __forceinline__ unsigned pk2(float lo, float hi) { return f2bf(lo) | (f2bf(hi) << 16); }

#define XB_TMO      128
#define XB_XCNT(j)  (256  + 64 * (j))
#define XB_XSUB(j)  (1280 + 64 * (j))
#define XB_XGEN(j)  (2304 + 64 * (j))
#define XB_TOP      3328
#define XB_TOPGEN   3392
#define XCD_BAR_WORDS 3456
#define XB_SPIN_CAP (1u << 18)

__device__ __forceinline__ unsigned xb_ld(unsigned* p)              { return __hip_atomic_load(p, __ATOMIC_RELAXED, __HIP_MEMORY_SCOPE_AGENT); }
__device__ __forceinline__ unsigned xb_add(unsigned* p, unsigned v) { return __hip_atomic_fetch_add(p, v, __ATOMIC_RELAXED, __HIP_MEMORY_SCOPE_AGENT); }
__device__ __forceinline__ unsigned xb_xcc_id() { return (unsigned)__builtin_amdgcn_s_getreg((3 << 11) | 20) & 0xFu; }
#define XB_SPIN(cond, bar) do { unsigned _sp = 0; while (cond) { __builtin_amdgcn_s_sleep(1); \
    if ((++_sp & 255u) == 0u) { if (xb_ld(&(bar)[XB_TMO])) break; if (_sp > XB_SPIN_CAP) { atomicAdd(&(bar)[XB_TMO], 1u); break; } } } } while (0)

struct XcdBarrier {
    unsigned* bar; unsigned x;
    volatile LAS unsigned* st;
};

__device__ __forceinline__ XcdBarrier xcd_barrier_post(unsigned* bar, volatile LAS unsigned* st) {
    XcdBarrier b; b.bar = bar; b.x = xb_xcc_id(); b.st = st;
    if (threadIdx.x == 0) (void)xb_add(&bar[XB_XCNT(b.x)], 1u);
    return b;
}
__device__ __forceinline__ void xcd_barrier_complete(unsigned* bar, unsigned x, unsigned& nloc, unsigned& nx) {
    const unsigned G = gridDim.x * gridDim.y * gridDim.z;
    unsigned sum, cnt, mine, sp = 0u;
    for (;;) {
        sum = 0u; cnt = 0u; mine = 0u;
#pragma unroll
        for (unsigned j = 0; j < 16; ++j) { const unsigned c = xb_ld(&bar[XB_XCNT(j)]); sum += c; cnt += (c > 0u) ? 1u : 0u; mine = (j == x) ? c : mine; }
        if (sum == G) break;
        __builtin_amdgcn_s_sleep(1);
        if ((++sp & 255u) == 0u) { if (xb_ld(&bar[XB_TMO])) break; if (sp > XB_SPIN_CAP) { atomicAdd(&bar[XB_TMO], 1u); break; } }
    }
    nloc = mine > 0u ? mine : 1u; nx = cnt > 0u ? cnt : 1u;
}

__device__ __forceinline__ void xcd_barrier(const XcdBarrier& b) {
    asm volatile("s_waitcnt vmcnt(0)" ::: "memory");
    __syncthreads();
    if (threadIdx.x == 0) {
        unsigned* bar = b.bar;
        __builtin_amdgcn_s_waitcnt(0);
        unsigned nloc = b.st[0], nx = b.st[1];
        if (nloc == 0u) { xcd_barrier_complete(bar, b.x, nloc, nx); b.st[0] = nloc; b.st[1] = nx; }
        const unsigned old = xb_add(&bar[XB_XSUB(b.x)], 1u);
        const unsigned gen = old / nloc;
        if (old + 1u == (gen + 1u) * nloc) {
            __builtin_amdgcn_fence(__ATOMIC_RELEASE, "agent");
            asm volatile("s_waitcnt vmcnt(0)" ::: "memory");
            const unsigned og = xb_add(&bar[XB_TOP], 1u);
            const unsigned tg = og / nx;
            if (og + 1u == (tg + 1u) * nx) xb_add(&bar[XB_TOPGEN], 1u);
            else XB_SPIN(xb_ld(&bar[XB_TOPGEN]) == tg, bar);
            __builtin_amdgcn_fence(__ATOMIC_ACQUIRE, "agent");
            xb_add(&bar[XB_XGEN(b.x)], 1u);
            asm volatile("s_waitcnt vmcnt(0)" ::: "memory");
        } else {
            XB_SPIN(xb_ld(&bar[XB_XGEN(b.x)]) == gen, bar);
            __builtin_amdgcn_fence(__ATOMIC_ACQUIRE, "agent");
            asm volatile("s_waitcnt vmcnt(0)" ::: "memory");
        }
    }
    __syncthreads();
}

typedef float f32x2 __attribute__((ext_vector_type(2)));
typedef unsigned v2u __attribute__((ext_vector_type(2)));
typedef int v4i __attribute__((ext_vector_type(4)));
typedef int v8i __attribute__((ext_vector_type(8)));
typedef _Float16 h2_t __attribute__((ext_vector_type(2)));
struct Frame {
    LAS unsigned char* lds;
    volatile LAS unsigned* MISC;
    gu32* ctl;
    int tid, lane, wave;
    int vcu, G;
};
__device__ __forceinline__ float wave_sum(float v) {
#pragma unroll
    for (int o = 1; o < 64; o <<= 1) v += __shfl_xor(v, o);
    return v;
}
__device__ __forceinline__ float wave_max(float v) {
#pragma unroll
    for (int o = 1; o < 64; o <<= 1) v = fmaxf(v, __shfl_xor(v, o));
    return v;
}
constexpr int NB16 = 0, N8 = 5888 - NB16;
__device__ __forceinline__ int win_row(int n) { const int t = n >> 8, ln = n & 255, hl = ln >> 6, d = ln & 63; return t * 256 + 32 * hl + (d & 31) + 128 * (d >> 5); }
__device__ __forceinline__ void p0_transpose_item(const float* W, int N, const float* gain, bf16* WT, int ldt, int koff, int mode, LAS float* scr, int item, int lane) {
    const int nblk = N / 32, kb = item / nblk, nb = item % nblk, k0 = 64 * kb, n0 = 32 * nb;
#pragma unroll 8
    for (int i = 0; i < 32; ++i) { const int kk = 2 * i + (lane >> 5); float v = W[(size_t)(k0 + kk) * N + n0 + (lane & 31)]; if (gain) v *= gain[k0 + kk]; scr[kk * 33 + (lane & 31)] = v; }
    LDS_WAIT(); asm volatile("" ::: "memory");
    const int c = lane & 7;
#pragma unroll
    for (int j = 0; j < 4; ++j) { const int n = (lane >> 3) + 8 * j; const LAS float* s = scr + (8 * c) * 33 + n;
        v4u o; o.x = pk2(s[0 * 33], s[1 * 33]); o.y = pk2(s[2 * 33], s[3 * 33]); o.z = pk2(s[4 * 33], s[5 * 33]); o.w = pk2(s[6 * 33], s[7 * 33]);
        const int rown = mode ? win_row(n0 + n) : (n0 + n);
        *(GAS v4u*)(WT + (size_t)rown * ldt + koff + k0 + 8 * c) = o; }
    LDS_WAIT(); asm volatile("" ::: "memory");
}
__device__ __forceinline__ void p0_gate_max_item(const float* W, int N, const float* gain, unsigned* gmax, int kb, int n0, int lane) {
    const int k0 = 64 * kb; float am = 0.f;
#pragma unroll 8
    for (int i = 0; i < 32; ++i) { const int kk = 2 * i + (lane >> 5); am = fmaxf(am, fabsf(W[(size_t)(k0 + kk) * N + n0 + (lane & 31)] * (gain ? gain[k0 + kk] : 1.0f))); }
    am = fmaxf(am, __shfl_xor(am, 32));
    if (lane < 32) atomicMax(gmax + (n0 - NB16) + lane, __float_as_uint(am));
}
__device__ __forceinline__ void p0_gate_fp8_item(const float* W, int N, const float* gain, const unsigned* gmax, unsigned char* WG, float* cs, LAS float* scr, int item, int lane, int ncols = N8, int perm = 1) {
    const int kb = item / (ncols / 32), nb = item % (ncols / 32), k0 = 64 * kb, n0 = 32 * nb;
#pragma unroll 8
    for (int i = 0; i < 32; ++i) { const int kk = 2 * i + (lane >> 5); scr[kk * 33 + (lane & 31)] = W[(size_t)(k0 + kk) * N + NB16 + n0 + (lane & 31)] * (gain ? gain[k0 + kk] : 1.0f); }
    LDS_WAIT(); asm volatile("" ::: "memory");
    const int c = lane & 7;
#pragma unroll
    for (int j = 0; j < 4; ++j) { const int n = (lane >> 3) + 8 * j; const LAS float* sp = scr + (8 * c) * 33 + n;
        const float am = __uint_as_float(xb_ld((unsigned*)gmax + n0 + n)); const float sc = am > 0.f ? 127.0f / am : 0.f;
        unsigned p0 = 0, p1 = 0;
#pragma unroll
        for (int e = 0; e < 4; ++e) { p0 |= ((unsigned)(int)__builtin_rintf(sp[e * 33] * sc) & 0xffu) << (8 * e); p1 |= ((unsigned)(int)__builtin_rintf(sp[(4 + e) * 33] * sc) & 0xffu) << (8 * e); }
        const int nn_ = n0 + n;
        const int prow = perm == 1 ? win_row(NB16 + nn_) - NB16 : perm == 2 ? (nn_ & ~255) + ((nn_ >> 5) & 1) * 128 + ((nn_ >> 6) & 3) * 32 + (nn_ & 31) : nn_;
        *(GAS v2u*)(WG + (size_t)prow * 1024 + k0 + 8 * c) = (v2u){p0, p1};
        if (kb == 0 && c == 0) cs[prow] = am * (1.0f / 127.0f); }
    LDS_WAIT(); asm volatile("" ::: "memory");
}
__device__ __forceinline__ void quant_row_fp8(const float* src, const float* gain, unsigned char* dst, size_t slice_stride, float* scale_out, int lane) {
    f32x4 v[4]; float am = 0.f;
#pragma unroll
    for (int j = 0; j < 4; ++j) { v[j] = *(const GAS f32x4*)(src + 256 * j + 4 * lane); if (gain) v[j] = v[j] * *(const GAS f32x4*)(gain + 256 * j + 4 * lane);
        am = fmaxf(am, fmaxf(fmaxf(fabsf(v[j][0]), fabsf(v[j][1])), fmaxf(fabsf(v[j][2]), fabsf(v[j][3])))); }
    am = wave_max(am);
    const int ex = (int)((__float_as_uint(am) >> 23) & 0xffu);
    const float s = (ex == 0) ? 1.0f : __uint_as_float((unsigned)(127 + 7 - (ex - 127)) << 23);
    const float is = (ex == 0) ? 1.0f : __uint_as_float((unsigned)(127 - 7 + (ex - 127)) << 23);
    if (lane == 0) *scale_out = is;
#pragma unroll
    for (int j = 0; j < 4; ++j) { int pk = __builtin_amdgcn_cvt_pk_fp8_f32(v[j][0] * s, v[j][1] * s, 0, false); pk = __builtin_amdgcn_cvt_pk_fp8_f32(v[j][2] * s, v[j][3] * s, pk, true);
        const int col = 256 * j + 4 * lane; *(GAS int*)(dst + (size_t)(col >> 7) * slice_stride + (col & 127)) = pk; }
}
__device__ __forceinline__ void quant_row_i4v(const float* src, unsigned char* dst, size_t slice_stride, float* scale_out, int lane) {
    f32x4 v[4]; float am = 0.f, ss = 0.f;
#pragma unroll
    for (int i = 0; i < 4; ++i) { const f32x4 t = *(const GAS f32x4*)(src + 16 * lane + 4 * i); v[i] = t;
        am = fmaxf(am, fmaxf(fmaxf(fabsf(t[0]), fabsf(t[1])), fmaxf(fabsf(t[2]), fabsf(t[3])))); ss += (t[0] * t[0] + t[1] * t[1]) + (t[2] * t[2] + t[3] * t[3]); }
    am = wave_max(am); ss = wave_sum(ss);
    const float clipv = fminf(am, 2.75f * sqrtf(ss * (1.0f / 1024.0f)));
    const float s = clipv > 0.f ? 7.0f / clipv : 0.f;
    if (lane == 0) *scale_out = clipv * (1.0f / (7.0f * 16.0f));
    unsigned pk[2];
#pragma unroll
    for (int d = 0; d < 2; ++d) { pk[d] = 0u;
#pragma unroll
        for (int n8 = 0; n8 < 8; ++n8) { int q0 = (int)__builtin_rintf(v[2 * d + (n8 >> 2)][n8 & 3] * s); q0 = q0 < -7 ? -7 : (q0 > 7 ? 7 : q0); pk[d] |= (unsigned)(q0 & 15) << (4 * n8); } }
    *(GAS v2u*)(dst + (size_t)(lane >> 4) * slice_stride + 8 * (lane & 15)) = (v2u){pk[0], pk[1]};
}
__device__ __forceinline__ void quant_row_fp4(const float* src, unsigned char* dst, size_t slice_stride, float* scale_out, int lane) {
    f32x4 v[4]; float am = 0.f;
#pragma unroll
    for (int j = 0; j < 4; ++j) { v[j] = *(const GAS f32x4*)(src + 256 * j + 4 * lane); am = fmaxf(am, fmaxf(fmaxf(fabsf(v[j][0]), fabsf(v[j][1])), fmaxf(fabsf(v[j][2]), fabsf(v[j][3])))); }
    am = wave_max(am);
    const float s = am > 0.f ? 6.0f / am : 0.f;
    if (lane == 0) *scale_out = am * (1.0f / 6.0f);
#pragma unroll
    for (int j = 0; j < 4; ++j) { unsigned pk = __builtin_amdgcn_cvt_scalef32_pk_fp4_f32(0u, v[j][0] * s, v[j][1] * s, 1.0f, 0); pk = __builtin_amdgcn_cvt_scalef32_pk_fp4_f32(pk, v[j][2] * s, v[j][3] * s, 1.0f, 1);
        *(GAS unsigned short*)(dst + (size_t)j * slice_stride + 2 * lane) = (unsigned short)(pk & 0xffffu); }
}
__device__ __forceinline__ void quant_row_i4d(const float* src, const float* gain, unsigned char* dst, float* scale_out, int lane) {
    f32x4 v[4]; float am = 0.f, ss = 0.f;
#pragma unroll
    for (int i = 0; i < 4; ++i) { f32x4 t = *(const GAS f32x4*)(src + 16 * lane + 4 * i); if (gain) t = t * *(const GAS f32x4*)(gain + 16 * lane + 4 * i); v[i] = t;
        am = fmaxf(am, fmaxf(fmaxf(fabsf(t[0]), fabsf(t[1])), fmaxf(fabsf(t[2]), fabsf(t[3])))); ss += (t[0] * t[0] + t[1] * t[1]) + (t[2] * t[2] + t[3] * t[3]); }
    am = wave_max(am); ss = wave_sum(ss);
    const float clipv = fminf(am, 2.5f * sqrtf(ss * (1.0f / 1024.0f)));
    const float s = clipv > 0.f ? 7.0f / clipv : 0.f;
    if (lane == 0) *scale_out = clipv * (1.0f / (7.0f * 16.0f));
    unsigned pk[2];
#pragma unroll
    for (int d = 0; d < 2; ++d) { pk[d] = 0u;
#pragma unroll
        for (int n8 = 0; n8 < 8; ++n8) { int q0 = (int)__builtin_rintf(v[2 * d + (n8 >> 2)][n8 & 3] * s); q0 = q0 < -7 ? -7 : (q0 > 7 ? 7 : q0); pk[d] |= (unsigned)(q0 & 15) << (4 * n8); } }
    *(GAS v2u*)(dst + 8 * lane) = (v2u){pk[0], pk[1]};
}
__device__ __forceinline__ void quant_row_i4(const float* src, const float* gain, unsigned char* dst, float* scale_out, int lane) {
    f32x4 v[4]; float am = 0.f, ss = 0.f;
    const int p16 = (lane >> 2) & 15, wl = lane & 3;
#pragma unroll
    for (int ld = 0; ld < 2; ++ld)
#pragma unroll
        for (int sn = 0; sn < 2; ++sn) { const int hd = 2 * (4 * ld + wl) + sn; const int idx = 256 * (hd >> 2) + 16 * p16 + 4 * (hd & 3);
            f32x4 t = *(const GAS f32x4*)(src + idx); if (gain) t = t * *(const GAS f32x4*)(gain + idx); v[2 * ld + sn] = t;
            am = fmaxf(am, fmaxf(fmaxf(fabsf(t[0]), fabsf(t[1])), fmaxf(fabsf(t[2]), fabsf(t[3])))); ss += (t[0] * t[0] + t[1] * t[1]) + (t[2] * t[2] + t[3] * t[3]); }
    am = wave_max(am); ss = wave_sum(ss);
    const float clipv = fminf(am, 2.5f * sqrtf(ss * (1.0f / 1024.0f)));
    const float s = clipv > 0.f ? 7.0f / clipv : 0.f;
    if (lane == 0) *scale_out = clipv * (1.0f / (7.0f * 16.0f));
#pragma unroll
    for (int ld = 0; ld < 2; ++ld) { unsigned pk = 0u;
#pragma unroll
        for (int b4 = 0; b4 < 4; ++b4) { int q0 = (int)__builtin_rintf(v[2 * ld][b4] * s), q1 = (int)__builtin_rintf(v[2 * ld + 1][b4] * s);
            q0 = q0 < -7 ? -7 : (q0 > 7 ? 7 : q0); q1 = q1 < -7 ? -7 : (q1 > 7 ? 7 : q1);
            pk |= ((unsigned)(q0 & 15) | ((unsigned)(q1 & 15) << 4)) << (8 * b4); }
        *(GAS unsigned*)(dst + ld * 256 + 16 * p16 + 4 * wl) = pk; }
}
__device__ __forceinline__ float gelu_f(float v) {
    const float av = fabsf(v), t = __builtin_amdgcn_rcpf(av * 0.2316418882f + 1.0f);
    float q = t * 0.5307027145f + (-0.7265760135f); q = q * t + 0.7107068705f; q = q * t + (-0.142248368f); q = q * t + 0.127414796f; q = q * t;
    const float e = __builtin_amdgcn_exp2f((v * v) * (-0.72134752044f));
    const float m = v * (q * e);
    return v < 0.f ? m : v - m;
}

struct Args { const float* in[14]; float* out; unsigned char* ws; int ph_lo, ph_hi, li, pad; };
__global__ void __launch_bounds__(NWAVES * 64, 2) fwd_kernel(Args args) {
    extern __shared__ __attribute__((aligned(16))) unsigned char lds[];
    Frame F;
    F.lds = (LAS unsigned char*)lds;
    F.MISC = (volatile LAS unsigned*)(F.lds + MISC_OFF);
    F.tid = threadIdx.x; F.lane = F.tid & 63; F.wave = __builtin_amdgcn_readfirstlane(F.tid >> 6);
    F.G = gridDim.x; { const int bx = blockIdx.x; F.vcu = (F.G % 8 == 0) ? (bx % 8) * (F.G / 8) + bx / 8 : bx; }
    unsigned char* ws = args.ws;
    F.ctl = (gu32*)(ws + WS_CTL);
    const float* x = args.in[0]; const float* norm1_gain = args.in[1]; const float* w_in = args.in[2]; const float* b_gate = args.in[3];
    const float* q_gain = args.in[4]; const float* k_gain = args.in[5]; const float* w_sb_out = args.in[6]; const float* w_dil_out = args.in[7];
    const float* w_out = args.in[8]; const float* norm2_gain = args.in[9]; const float* w_peer_q = args.in[10]; const float* sub_keys = args.in[11];
    const float* peer_u = args.in[12]; const float* peer_v = args.in[13];
    float* out = args.out;
    bf16* WIN = (bf16*)(ws + WS_WIN); bf16* WCAT = (bf16*)(ws + WS_WCAT); bf16* WOUT = (bf16*)(ws + WS_WOUT); bf16* WC = (bf16*)(ws + WS_WC);
    float* RINV1 = (float*)(ws + WS_RINV1); float* RINV2 = (float*)(ws + WS_RINV2); float* USC = (float*)(ws + WS_USC); float* VSC = (float*)(ws + WS_VSC); float* SSQ = (float*)(ws + WS_SSQ);
    unsigned char* U8 = ws + WS_U8; unsigned char* V8 = ws + WS_V8;
    unsigned short* IDS = (unsigned short*)(ws + WS_IDS); float* GW = (float*)(ws + WS_GW); unsigned short* COEF = (unsigned short*)(ws + WS_COEF); unsigned char* HQ = ws + WS_HQ; unsigned char* HQ4 = ws + WS_HQ4; unsigned char* WC8 = ws + WS_WC; unsigned char* WOUT8 = ws + WS_WOUT; float* WOS = (float*)(ws + WS_WOS); float* RMAXF = (float*)(ws + WS_RMAXF); unsigned char* MIX8 = ws + WS_MIX; float* WCF = (float*)(ws + WS_WCF); float* WCS = (float*)(ws + WS_WCS); float* HS2 = (float*)(ws + WS_HS2);
    bf16* XB = (bf16*)(ws + WS_XB); bf16* OC = (bf16*)(ws + WS_OC); unsigned char* XB8 = ws + WS_XB8; unsigned char* WG8 = ws + WS_WG8; float* GCS = (float*)(ws + WS_GCS); float* XS = (float*)(ws + WS_XS);
    bf16* QS = (bf16*)(ws + WS_QS); bf16* KS = (bf16*)(ws + WS_KS); bf16* VS = (bf16*)(ws + WS_VS);
    bf16* QD = (bf16*)(ws + WS_QD); bf16* KD = (bf16*)(ws + WS_KD); bf16* VD = (bf16*)(ws + WS_VD);
    unsigned char* GT = ws + WS_GT; bf16* MIX = (bf16*)(ws + WS_MIX); bf16* X1B = (bf16*)(ws + WS_X1B);

    for (int u = F.tid; u < (LDS_BYTES - LDSCTL_OFF) / 4; u += NWAVES * 64) ((LAS unsigned*)(F.lds + LDSCTL_OFF))[u] = 0u;
    __syncthreads();
    const int my_xcc = (int)xb_xcc_id();
    if (F.tid == 0) F.MISC[12] = xb_add((unsigned*)(F.ctl + CW_XRANK) + 64 * my_xcc, 1u);
    __syncthreads();
    const int my_xrank = (int)F.MISC[12];
    const int bli = (N_LAUNCHES == PER_PHASE) ? 0 : args.li;
    XcdBarrier bar; bar.bar = (unsigned*)(F.ctl + CW_BAR) + bli * XCD_BAR_WORDS; bar.x = 0; bar.st = nullptr;
    if (N_LAUNCHES != PER_PHASE) bar = xcd_barrier_post((unsigned*)(F.ctl + CW_BAR) + bli * XCD_BAR_WORDS, F.MISC + 8);
    const int lo = args.ph_lo, hi = args.ph_hi;
#ifndef PHASE_MASK
#define PHASE_MASK 0xff
#endif
#define IN(k) (((PHASE_MASK >> (k)) & 1) && lo <= (k) && (k) < hi)
#define BOTH(k) (IN(k) && IN((k) + 1))
#define GRID_BAR() do { if (N_LAUNCHES != PER_PHASE) xcd_barrier(bar); } while (0)
#ifndef PROBE_REPEAT
#define PROBE_REPEAT 0x00
#endif
#ifndef PROBE_L1
#define PROBE_L1 0x0
#endif
#define REP(k) _Pragma("unroll") for (int rep_ = 0; rep_ < (((PROBE_REPEAT >> (k)) & 1) ? 2 : 1); ++rep_)
    const int gw = F.vcu * NWAVES + F.wave, NGW = F.G * NWAVES;
#define P67_MAP() int vx = (int)(blockIdx.x & 7), rk = (int)(blockIdx.x >> 3), nrk = (F.G + 7 - vx) / 8; bool p67_uni = false; \
        { bool uni_ = (F.G % 8 == 0); for (int j_ = 0; j_ < 16; ++j_) { const unsigned c_ = xb_ld((unsigned*)(F.ctl + CW_XRANK) + 64 * j_); uni_ = uni_ && (c_ == (j_ < 8 ? (unsigned)(F.G / 8) : 0u)); } \
          if (uni_) { vx = my_xcc; rk = my_xrank; nrk = F.G / 8; p67_uni = true; } }

    if (IN(0)) REP(0) {
        for (int it = F.vcu; it < 256; it += F.G) {
            const int hp = it >> 4, d0 = (it & 15) * 64;
            LAS float* As = (LAS float*)(F.lds);
            LAS float* Bs = (LAS float*)(F.lds + 64 * 132 * 4);
            for (int e = F.tid; e < 64 * 32; e += 512) { const int r = e >> 5, c4 = (e & 31) * 4; *(LAS f32x4*)(As + r * 132 + c4) = *(const GAS f32x4*)(w_peer_q + (size_t)(d0 + r) * 2048 + hp * 128 + c4); }
            for (int e = F.tid; e < 128 * 32; e += 512) { const int r = e >> 5, c4 = (e & 31) * 4; *(LAS f32x4*)(Bs + r * 132 + c4) = *(const GAS f32x4*)(sub_keys + ((size_t)hp * 128 + r) * 128 + c4); }
            __syncthreads();
            const int ddg = F.tid & 15, ng = F.tid >> 4;
            f32x4 acc[4];
#pragma unroll
            for (int j = 0; j < 4; ++j) acc[j] = (f32x4){0.f, 0.f, 0.f, 0.f};
            for (int c4 = 0; c4 < 128; c4 += 4) {
                f32x4 a[4], b[4];
#pragma unroll
                for (int i = 0; i < 4; ++i) { a[i] = *(const LAS f32x4*)(As + (4 * ddg + i) * 132 + c4); b[i] = *(const LAS f32x4*)(Bs + (4 * ng + i) * 132 + c4); }
#pragma unroll
                for (int j = 0; j < 4; ++j)
#pragma unroll
                    for (int i = 0; i < 4; ++i) acc[j][i] += (a[i][0] * b[j][0] + a[i][1] * b[j][1]) + (a[i][2] * b[j][2] + a[i][3] * b[j][3]);
            }
            const f32x4 g2 = *(const GAS f32x4*)(norm2_gain + d0 + 4 * ddg);
#pragma unroll
            for (int j = 0; j < 4; ++j) { const f32x4 o = acc[j] * g2;
                *(GAS f32x4*)(WCF + (size_t)(hp * 128 + 4 * ng + j) * 1024 + d0 + 4 * ddg) = o;
                float am = fmaxf(fmaxf(fabsf(o[0]), fabsf(o[1])), fmaxf(fabsf(o[2]), fabsf(o[3])));
                am = fmaxf(am, __shfl_xor(am, 1)); am = fmaxf(am, __shfl_xor(am, 2)); am = fmaxf(am, __shfl_xor(am, 4)); am = fmaxf(am, __shfl_xor(am, 8));
                if (ddg == 0) atomicMax((unsigned*)(F.ctl + CW_WMAX) + hp * 128 + 4 * ng + j, __float_as_uint(am)); }
            __syncthreads();
        }
        {
            LAS float* scr = (LAS float*)(F.lds + RING_OFF + F.wave * 16384);
            constexpr int I_IN = (D / 64) * (N1 / 32), I_SB = (512 / 64) * (D / 32), I_DL = (256 / 64) * (D / 32), I_OUT = (D / 64) * (D / 32);
            constexpr int NITEMS = I_IN + I_SB + I_DL + I_OUT;
            for (int it = gw; it < NITEMS; it += NGW) {
                int r = it;
                if (r < I_IN) { const int nb_ = r % (N1 / 32); p0_gate_max_item(w_in, N1, norm1_gain, (unsigned*)(F.ctl + CW_GMAX), r / (N1 / 32), 32 * nb_, F.lane); continue; } r -= I_IN;
                if (r < I_SB) { p0_transpose_item(w_sb_out, D, nullptr, WCAT, 768, 0, 0, scr, r, F.lane); continue; } r -= I_SB;
                if (r < I_DL) { p0_transpose_item(w_dil_out, D, nullptr, WCAT, 768, 512, 0, scr, r, F.lane); continue; } r -= I_DL;
                p0_gate_max_item(w_out, D, nullptr, (unsigned*)(F.ctl + CW_OMAX), r / (D / 32), 32 * (r % (D / 32)), F.lane);
            }
        }
        for (int e = gw; e < 2 * NEXP; e += NGW) {
            if (e < NEXP) quant_row_i4d(peer_u + (size_t)e * D, norm2_gain, U8 + (size_t)e * 512, USC + e, F.lane);
            else { const int ev = e - NEXP; quant_row_fp4(peer_v + (size_t)ev * D, V8 + (size_t)ev * 128, (size_t)NEXP * 128, VSC + ev, F.lane); }
        }
        for (int m = gw; m < T; m += NGW) {
            const GAS f32x4* xr = (const GAS f32x4*)(x + (size_t)m * D) + F.lane;
            f32x4 v[4]; float s = 0.f;
#pragma unroll
            for (int j = 0; j < 4; ++j) { v[j] = xr[64 * j]; s += (v[j][0] * v[j][0] + v[j][1] * v[j][1]) + (v[j][2] * v[j][2] + v[j][3] * v[j][3]); }
            s = wave_sum(s);
            const float rn = __builtin_amdgcn_rsqf(s * (1.0f / D) + 1e-6f);
            if (F.lane == 0) RINV1[m] = 1.0f / rn;
            GAS unsigned long long* o8 = (GAS unsigned long long*)(XB + (size_t)m * D) + F.lane;
#pragma unroll
            for (int j = 0; j < 4; ++j) o8[64 * j] = (unsigned long long)pk2(v[j][0] * rn, v[j][1] * rn) | ((unsigned long long)pk2(v[j][2] * rn, v[j][3] * rn) << 32);
            float am = 0.f;
#pragma unroll
            for (int j = 0; j < 4; ++j) am = fmaxf(am, fmaxf(fmaxf(fabsf(v[j][0]), fabsf(v[j][1])), fmaxf(fabsf(v[j][2]), fabsf(v[j][3]))));
            am = wave_max(am) * rn;
            const float qs = am > 0.f ? 127.0f / am * rn : 0.f;
            if (F.lane == 0) XS[m] = am * (1.0f / 127.0f);
#pragma unroll
            for (int j = 0; j < 4; ++j) { const unsigned pk = ((unsigned)(int)__builtin_rintf(v[j][0] * qs) & 0xffu) | (((unsigned)(int)__builtin_rintf(v[j][1] * qs) & 0xffu) << 8) | (((unsigned)(int)__builtin_rintf(v[j][2] * qs) & 0xffu) << 16) | (((unsigned)(int)__builtin_rintf(v[j][3] * qs) & 0xffu) << 24);
                *(GAS unsigned*)(XB8 + ((size_t)(2 * j + (F.lane >> 5)) * T + m) * 128 + 4 * (F.lane & 31)) = pk; }
        }
        if (BOTH(0)) GRID_BAR();
    }

    if (IN(1)) REP(1) {
        { LAS float* scr = (LAS float*)(F.lds + RING_OFF + F.wave * 16384);
          for (int it = gw; it < 16 * (N8 / 32); it += NGW) p0_gate_fp8_item(w_in, N1, norm1_gain, (const unsigned*)(F.ctl + CW_GMAX), WG8, GCS, scr, it, F.lane);
          for (int it = gw; it < 16 * (D / 32); it += NGW) p0_gate_fp8_item(w_out, D, nullptr, (const unsigned*)(F.ctl + CW_OMAX), WOUT8, WOS, scr, it, F.lane, D, 2);
          for (int r = gw; r < 2048; r += NGW) {
              const float am = __uint_as_float(xb_ld((unsigned*)(F.ctl + CW_WMAX) + r)); const float sc = am > 0.f ? 127.0f / am : 0.f;
              unsigned w[4];
#pragma unroll
              for (int j = 0; j < 4; ++j) { const f32x4 v = *(const GAS f32x4*)(WCF + (size_t)r * 1024 + 16 * F.lane + 4 * j);
                  w[j] = ((unsigned)(int)__builtin_rintf(v[0] * sc) & 0xffu) | (((unsigned)(int)__builtin_rintf(v[1] * sc) & 0xffu) << 8) | (((unsigned)(int)__builtin_rintf(v[2] * sc) & 0xffu) << 16) | (((unsigned)(int)__builtin_rintf(v[3] * sc) & 0xffu) << 24); }
              *(GAS v4u*)(WC8 + (size_t)r * 1024 + 16 * F.lane) = (v4u){w[0], w[1], w[2], w[3]};
              if (F.lane == 0) WCS[r] = am * (1.0f / 127.0f); }
          __syncthreads(); }
        GRID_BAR();
        { pg8::Gemm g{(const bf16*)XB8, (const bf16*)WG8, T, N8, D / 2, 64, (size_t)T * 128}; pg8::StaticOrder S; S.init(T, N8, F.G, (int)blockIdx.x);
          pg8::EpiG E{b_gate, GCS, XS, q_gain, k_gain, QS, KS, VS, QD, KD, VD, GT};
          pg8::gemm_phase<pg8::EpiG, pg8::StaticOrder, true, true, false, true>(F.lds + RING_OFF, g, S, E); }
        if (BOTH(1)) GRID_BAR();
    }

    if (IN(2)) REP(2) {
        LAS unsigned char* wl = F.lds + RING_OFF + F.wave * 16384;
        static_assert(att::DLU_BYTES <= LDSCTL_OFF, "dilated-attention LDS state");
        for (int un = F.vcu; un < 512; un += F.G) { const int blk = (un & 256) ? 7 - (un & 7) : (un & 7), j = (un >> 3) & 3, b = un >> 5;
            float mref = 0.f;
#pragma unroll
            for (int g = 0; g < 3; ++g) { const float gq = wave_max(fabsf(q_gain[(4 * g + j) * 64 + F.lane])), gk = wave_max(fabsf(k_gain[(4 * g + j) * 64 + F.lane])); mref = fmaxf(mref, gq * gk); }
            mref *= 64.0f * 0.125f * 1.4426950408889634f;
            if (mref <= 60.0f) att::dl_unit<true>(QD, KD, VD, OC, b, j, blk, F.lds + RING_OFF, F.wave, F.lane, mref);
            else att::dl_unit<false>(QD, KD, VD, OC, b, j, blk, F.lds + RING_OFF, F.wave, F.lane, 0.f); }
        for (int it = gw; it < 16384; it += NGW) { const int qt = 127 - (it & 127), h = (it >> 7) & 7, b = it >> 10; att::sb_item(QS, KS, VS, OC, b, h, qt, wl, F.lane); }
        if (BOTH(2)) GRID_BAR();
    }

    if (IN(3)) REP(3) {
        pg8::Gemm g{OC, WCAT, T, D, 768, 64, (size_t)T * 64 * 2}; pg8::StaticOrder S; S.init(T, D, F.G, (int)blockIdx.x);
        pg8::Epi2 E{GT, MIX8, (unsigned*)(ws + WS_PART), (unsigned*)(F.ctl + CW_RCNT), RMAXF, F.lds + RING_OFF + RING_BYTES};
        pg8::gemm_phase<pg8::Epi2, pg8::StaticOrder, true, true>(F.lds + RING_OFF, g, S, E);
        if (BOTH(3)) GRID_BAR();
    }

    if (IN(4)) REP(4) {
        pg8::Gemm g{(const bf16*)MIX8, (const bf16*)WOUT8, T, D, D / 2, 64, (size_t)T * 128}; pg8::StaticOrder S; S.init(T, D, F.G, (int)blockIdx.x);
        pg8::Epi3 E{XB, RINV1, (const unsigned*)RMAXF, WOS, X1B, SSQ};
        pg8::gemm_phase<pg8::Epi3, pg8::StaticOrder, true, true, false, true>(F.lds + RING_OFF, g, S, E);
        if (BOTH(4)) GRID_BAR();
    }

    if (IN(5)) REP(5) {
        for (int m0 = gw; m0 < T; m0 += 2 * NGW) {
            v4u aa[2], bb[2]; float sqq[2];
#pragma unroll
            for (int r2_ = 0; r2_ < 2; ++r2_) { const int m = (m0 + r2_ * NGW < T) ? m0 + r2_ * NGW : m0;
                aa[r2_] = *(const GAS v4u*)(X1B + (size_t)m * D + 8 * F.lane); bb[r2_] = *(const GAS v4u*)(X1B + (size_t)m * D + 512 + 8 * F.lane);
                sqq[r2_] = (F.lane < 16) ? SSQ[(size_t)m * 16 + F.lane] : 0.f; }
#pragma unroll
            for (int r2_ = 0; r2_ < 2; ++r2_) { const int m = m0 + r2_ * NGW; if (m >= T) break;
            const v4u a = aa[r2_], b = bb[r2_];
            float v[16] = {pg8::bflo(a.x), pg8::bfhi(a.x), pg8::bflo(a.y), pg8::bfhi(a.y), pg8::bflo(a.z), pg8::bfhi(a.z), pg8::bflo(a.w), pg8::bfhi(a.w),
                           pg8::bflo(b.x), pg8::bfhi(b.x), pg8::bflo(b.y), pg8::bfhi(b.y), pg8::bflo(b.z), pg8::bfhi(b.z), pg8::bflo(b.w), pg8::bfhi(b.w)};
            float am = 0.f;
#pragma unroll
            for (int i = 0; i < 16; ++i) am = fmaxf(am, fabsf(v[i]));
            am = wave_max(am);
            float sq = wave_sum(sqq[r2_]);
            const float s = am > 0.f ? 119.0f / am : 0.f;
            if (F.lane == 0) HS2[m] = am * (1.0f / 119.0f) * __builtin_amdgcn_rsqf(sq * (1.0f / 1024.0f) + 1e-6f);
            int q[16];
#pragma unroll
            for (int i = 0; i < 16; ++i) q[i] = (int)__builtin_rintf(v[i] * s) & 0xff;
            v2u o0, o1; o0.x = q[0] | (q[1] << 8) | (q[2] << 16) | (q[3] << 24); o0.y = q[4] | (q[5] << 8) | (q[6] << 16) | (q[7] << 24);
            o1.x = q[8] | (q[9] << 8) | (q[10] << 16) | (q[11] << 24); o1.y = q[12] | (q[13] << 8) | (q[14] << 16) | (q[15] << 24);
            *(GAS v2u*)(HQ + ((size_t)(F.lane >> 4) * T + m) * 128 + 8 * (F.lane & 15)) = o0; *(GAS v2u*)(HQ + ((size_t)(4 + (F.lane >> 4)) * T + m) * 128 + 8 * (F.lane & 15)) = o1;
            { unsigned hi0 = 0u, hi1 = 0u, lo0 = 0u, lo1 = 0u;
#pragma unroll
              for (int i = 0; i < 8; ++i) { const int qa = (int)(signed char)q[i], qb = (int)(signed char)q[8 + i];
                  lo0 |= (unsigned)(qa & 15) << (4 * i); hi0 |= (unsigned)(((qa + 8) >> 4) & 15) << (4 * i); lo1 |= (unsigned)(qb & 15) << (4 * i); hi1 |= (unsigned)(((qb + 8) >> 4) & 15) << (4 * i); }
              unsigned* h4 = (unsigned*)(HQ4 + (size_t)m * D);
              h4[F.lane] = hi0; h4[64 + F.lane] = hi1; h4[128 + F.lane] = lo0; h4[192 + F.lane] = lo1; }
        } }
        GRID_BAR();
        pg8::Gemm g{(const bf16*)HQ, (const bf16*)WC8, T, 2048, D / 2, 64, (size_t)T * 128}; pg8::StaticOrder S; S.init(T, 2048, F.G, (int)blockIdx.x);
        pg8::Epi4 E{SSQ, RINV2, IDS, GW, HS2, WCS};
        pg8::OneUnit O1;
        for (int i = 0; S.next(i, O1.u); ++i) pg8::gemm_phase<pg8::Epi4, pg8::OneUnit, false, true, false, true>(F.lds + RING_OFF, g, O1, E);
        if (BOTH(5)) GRID_BAR();
    }

    if (IN(6)) REP(6) {
        P67_MAP();
        const int p16 = F.lane & 15, sg = F.lane >> 4;
        LAS unsigned char* HB = F.lds + RING_OFF + F.wave * 16384;
        LAS unsigned* LIST = (LAS unsigned*)(F.lds + RING_OFF + F.wave * 16384 + 8192);
        LAS float* HSs = (LAS float*)(F.lds + RING_OFF + F.wave * 16384 + 12288);
        const int nwb = T / 8, wstep = nrk * NWAVES;
        const int gsel = (F.lane & 15), bpsrc = (16 * ((F.lane >> 2) & 3) + (F.lane & 3)) * 4;
        v4u hpre[8], idpre[2]; float hspre = 0.f;
#define P6_PRE(bb) do { const int bc_ = (bb) < nwb ? (bb) : nwb - 1; const unsigned char* hsrc_ = HQ4 + (size_t)bc_ * 8192; \
            _Pragma("unroll") for (int i_ = 0; i_ < 8; ++i_) hpre[i_] = *(const GAS v4u*)(hsrc_ + (size_t)(i_ * 64 + F.lane) * 16); \
            const unsigned short* isrc_ = IDS + ((size_t)bc_ * 8 + (F.lane >> 3)) * 128 + 16 * (F.lane & 7); idpre[0] = *(const GAS v4u*)isrc_; idpre[1] = *(const GAS v4u*)(isrc_ + 8); \
            hspre = HS2[(size_t)bc_ * 8 + (F.lane & 7)]; } while (0)
#define P6_ISSUE(W, ENT, base_) do { \
                { const v4u e4_ = *(const LAS v4u*)(LIST + (base_) + 4 * sg); const unsigned ee_[4] = {e4_.x, e4_.y, e4_.z, e4_.w};     \
                  _Pragma("unroll") for (int g_ = 0; g_ < 4; ++g_) ENT[g_] = ((base_) + 4 * sg + g_ < n) ? ee_[g_] : elast; } \
                _Pragma("unroll") for (int g_ = 0; g_ < 4; ++g_) { const unsigned char* up_ = U8 + (size_t)((PROBE_L1 && rep_) ? 0u : (ENT[g_] & 0xffffu)) * 512 + 16 * p16; \
                    _Pragma("unroll") for (int i_ = 0; i_ < 2; ++i_) W[g_][i_] = *(const GAS v4u*)(up_ + 256 * i_); } } while (0)
#define P6_DPPADD(a_, ctrl) a_ += __builtin_amdgcn_update_dpp(0, a_, ctrl, 0xf, 0xf, false)
#define P6_REDUCE(W, ENT, SEL, base_) do { SEL = 0; if ((base_) < n) { int ag_[4]; \
                _Pragma("unroll") for (int g_ = 0; g_ < 4; ++g_) { const LAS unsigned char* hp_ = HB + (size_t)(ENT[g_] >> 24) * 1024 + 16 * p16; int ah_ = 0, al_ = 0; v4u h_[4]; \
                    _Pragma("unroll") for (int i_ = 0; i_ < 4; ++i_) h_[i_] = *(const LAS v4u*)(hp_ + 256 * i_);     \
                    _Pragma("unroll") for (int ld_ = 0; ld_ < 2; ++ld_) { const unsigned x_[4] = {W[g_][ld_].x, W[g_][ld_].y, W[g_][ld_].z, W[g_][ld_].w}; \
                        const unsigned hh_[4] = {h_[ld_].x, h_[ld_].y, h_[ld_].z, h_[ld_].w}, hl_[4] = {h_[2 + ld_].x, h_[2 + ld_].y, h_[2 + ld_].z, h_[2 + ld_].w}; \
                        _Pragma("unroll") for (int wl_ = 0; wl_ < 4; ++wl_) { ah_ = __builtin_amdgcn_sdot8((int)x_[wl_], (int)hh_[wl_], ah_, false); al_ = __builtin_amdgcn_sdot8((int)x_[wl_], (int)hl_[wl_], al_, false); } } \
                    ag_[g_] = (ah_ << 8) + (al_ << 4); }                                  \
                  \
                { const bool o1_ = (F.lane & 1) != 0, o2_ = (F.lane & 2) != 0; \
                  const int x0_ = o1_ ? ag_[1] : ag_[0], y0_ = o1_ ? ag_[0] : ag_[1], x2_ = o1_ ? ag_[3] : ag_[2], y2_ = o1_ ? ag_[2] : ag_[3]; \
                  const int s01_ = x0_ + __builtin_amdgcn_update_dpp(0, y0_, 0xB1, 0xf, 0xf, false), s23_ = x2_ + __builtin_amdgcn_update_dpp(0, y2_, 0xB1, 0xf, 0xf, false); \
                  const int x1_ = o2_ ? s23_ : s01_, y1_ = o2_ ? s01_ : s23_; \
                  int t_ = x1_ + __builtin_amdgcn_update_dpp(0, y1_, 0x4E, 0xf, 0xf, false); \
                  t_ += __builtin_amdgcn_update_dpp(0, t_, 0x124, 0xf, 0xf, false); t_ += __builtin_amdgcn_update_dpp(0, t_, 0x128, 0xf, 0xf, false); \
                  SEL = t_; } } } while (0)
        int wb = rk * NWAVES + F.wave;
        P6_PRE(wb);
        for (; wb < nwb; wb += wstep) {
            const int t0 = wb * 8;
            asm volatile("s_waitcnt lgkmcnt(0)" ::: "memory");
            if (F.lane < 8) HSs[F.lane] = hspre;
#pragma unroll
            for (int i = 0; i < 8; ++i) *(LAS v4u*)(HB + (size_t)(i * 64 + F.lane) * 16) = hpre[i];
            int n = 0;
            { const unsigned idw[8] = {idpre[0].x, idpre[0].y, idpre[0].z, idpre[0].w, idpre[1].x, idpre[1].y, idpre[1].z, idpre[1].w};
              const unsigned tl = (unsigned)(F.lane >> 3), kb0 = 16u * (unsigned)(F.lane & 7);
#pragma unroll
              for (int i = 0; i < 16; ++i) { const unsigned e = (i & 1) ? (idw[i >> 1] >> 16) : (idw[i >> 1] & 0xffffu);
                  const bool inr = ((int)(e >> 11) == vx); const unsigned long long mk = __ballot(inr);
                  const int pos = n + (int)__builtin_amdgcn_mbcnt_hi((unsigned)(mk >> 32), __builtin_amdgcn_mbcnt_lo((unsigned)mk, 0u));
                  LIST[inr ? pos : 1040] = (tl << 24) | ((kb0 + (unsigned)i) << 16) | e;
                  n += __builtin_popcountll(mk); } }
            asm volatile("s_waitcnt lgkmcnt(0)" ::: "memory");
            P6_PRE(wb + wstep);
            const int nm1 = n > 0 ? n - 1 : 0; const unsigned elast = LIST[nm1];
            for (int base = 0; base < n; base += 64) {
                v4u wA[4][2], wB[4][2]; unsigned entA[4], entB[4]; int selA, selB, selC, selD;
                P6_ISSUE(wA, entA, base);
                P6_ISSUE(wB, entB, base + 16);
                const int je = base + F.lane; const int ej = (je < n) ? (int)LIST[je] : -1;
                const unsigned eju = ej < 0 ? 0u : (unsigned)ej;
                const float gb = GW[((size_t)t0 + (eju >> 24)) * 128 + ((eju >> 16) & 127u)], ub = USC[eju & 0xffffu], vb = VSC[eju & 0xffffu];
                P6_REDUCE(wA, entA, selA, base);
                P6_REDUCE(wB, entB, selB, base + 16);
                selC = 0; selD = 0;
                if (base + 32 < n) {
                    P6_ISSUE(wA, entA, base + 32);
                    P6_ISSUE(wB, entB, base + 48);
                    P6_REDUCE(wA, entA, selC, base + 32);
                    P6_REDUCE(wB, entB, selD, base + 48);
                }
                const int rA = __builtin_amdgcn_ds_bpermute(bpsrc, selA), rB = __builtin_amdgcn_ds_bpermute(bpsrc, selB), rC = __builtin_amdgcn_ds_bpermute(bpsrc, selC), rD = __builtin_amdgcn_ds_bpermute(bpsrc, selD);
                const int q4 = F.lane >> 4; const float resv = (float)(q4 == 0 ? rA : q4 == 1 ? rB : q4 == 2 ? rC : rD);
                if (ej >= 0 && !(PROBE_L1 && rep_)) { const float act = gelu_f(resv * ub * HSs[eju >> 24]);
                    COEF[((size_t)t0 + (eju >> 24)) * 128 + ((eju >> 16) & 127u)] = (unsigned short)(pg8::pkbf(gb * act * vb, 0.f) & 0xffffu); }
            }
        }
#undef P6_PRE
#undef P6_ISSUE
#undef P6_REDUCE
#undef P6_DPPADD
        if (BOTH(6)) GRID_BAR();
    }

    if (IN(7)) REP(7) {
        P67_MAP();
        const int cs = vx >> 1;
        const int n0_ = p67_uni ? F.G / 8 : (F.G + 7 - 2 * cs) / 8, n1_ = p67_uni ? F.G / 8 : (F.G + 7 - (2 * cs + 1)) / 8;
        const int rk2 = (vx & 1) ? n0_ + rk : rk, nrk2 = n0_ + n1_;
        const int l8 = F.lane & 7, kg = F.lane >> 3, i16 = F.lane & 15, kq = F.lane >> 4;
        const unsigned char* vbase = V8 + (size_t)cs * NEXP * 128 + 16 * l8;
        const int tstep = nrk2 * NWAVES;
        const int col = 256 * cs + 4 * F.lane;
        LAS unsigned char* tile = F.lds + RING_OFF + F.wave * 16384;
        typedef int v2i_ __attribute__((ext_vector_type(2)));
        const int wrb = kg * 2048 + 16 * l8, rdb = (32 * kq + i16) * 128 + 16 * (i16 & 7) + 8 * (i16 >> 3);
        LAS float* obuf = (LAS float*)(F.lds + RING_OFF + RING_BYTES + F.wave * 1536);
        LAS float* obw = (F.lane < 16) ? obuf + F.lane : obuf + 256 + F.lane; const int obs = (F.lane < 16) ? 1 : 0;
#define P7_CL(tt) ((tt) < T ? (tt) : T - 1)
#define P7_IDS(tt, ID) do { const int tc_ = P7_CL(tt); ID[0] = *(const GAS v4u*)(IDS + (size_t)tc_ * 128 + 16 * kg); ID[1] = *(const GAS v4u*)(IDS + (size_t)tc_ * 128 + 16 * kg + 8); } while (0)
#define P7_ISSUE(tt, ID, W, CF, OO) do { const int tc_ = P7_CL(tt); const unsigned idw_[8] = {ID[0].x, ID[0].y, ID[0].z, ID[0].w, ID[1].x, ID[1].y, ID[1].z, ID[1].w}; \
            _Pragma("unroll") for (int i_ = 0; i_ < 16; ++i_) { const unsigned e_ = (i_ & 1) ? (idw_[i_ >> 1] >> 16) : (idw_[i_ >> 1] & 0xffffu); W[i_] = *(const GAS v4u*)(vbase + (size_t)((PROBE_L1 && rep_) ? 0u : e_) * 128); } \
            CF[0] = *(const GAS v4u*)(COEF + (size_t)tc_ * 128 + 16 * kg); CF[1] = *(const GAS v4u*)(COEF + (size_t)tc_ * 128 + 16 * kg + 8); \
            OO = *(const GAS v2u*)(X1B + (size_t)tc_ * D + col); } while (0)
#define P7_COMPUTE(tt, W, CF, OO, NX) do { \
              \
            const unsigned cw_[8] = {CF[0].x, CF[0].y, CF[0].z, CF[0].w, CF[1].x, CF[1].y, CF[1].z, CF[1].w}; \
            float am_ = 0.f; _Pragma("unroll") for (int j_ = 0; j_ < 8; ++j_) am_ = fmaxf(am_, fmaxf(fabsf(pg8::bflo(cw_[j_])), fabsf(pg8::bfhi(cw_[j_])))); \
            am_ = fmaxf(am_, __shfl_xor(am_, 8)); am_ = fmaxf(am_, __shfl_xor(am_, 16)); am_ = fmaxf(am_, __shfl_xor(am_, 32)); \
            const float cq_ = am_ > 0.f ? 240.0f / am_ : 0.f, cstep_ = am_ * (1.0f / 240.0f); \
            int cpk_[4]; _Pragma("unroll") for (int d_ = 0; d_ < 4; ++d_) { int w_ = __builtin_amdgcn_cvt_pk_fp8_f32(pg8::bflo(cw_[2 * d_]) * cq_, pg8::bfhi(cw_[2 * d_]) * cq_, 0, false); \
                cpk_[d_] = __builtin_amdgcn_cvt_pk_fp8_f32(pg8::bflo(cw_[2 * d_ + 1]) * cq_, pg8::bfhi(cw_[2 * d_ + 1]) * cq_, w_, true); } \
              \
            v8i a_; { const int sa0_ = (8 * kq) * 4, sa1_ = (32 + 8 * kq) * 4; const bool m0_ = (i16 == 0); \
                _Pragma("unroll") for (int d_ = 0; d_ < 4; ++d_) { const int x0_ = __builtin_amdgcn_ds_bpermute(sa0_, cpk_[d_]), x1_ = __builtin_amdgcn_ds_bpermute(sa1_, cpk_[d_]); a_[d_] = m0_ ? x0_ : 0; a_[4 + d_] = m0_ ? x1_ : 0; } } \
            _Pragma("unroll") for (int i_ = 0; i_ < 16; ++i_) { const v4u x_ = W[i_]; *(LAS v4u*)(tile + (wrb ^ (16 * (i_ & 7))) + 128 * i_) = (i_ & 8) ? (v4u){x_.z, x_.w, x_.x, x_.y} : x_; } \
            const v2u oc_ = OO; \
            asm volatile("" ::: "memory"); \
            NX;                                                                      \
            asm volatile("" ::: "memory"); \
            _Pragma("unroll") for (int g_ = 0; g_ < 4; ++g_) { \
                f32x4 dd_[4]; \
                _Pragma("unroll") for (int j_ = 0; j_ < 4; ++j_) { const int nb_ = 4 * g_ + j_; const int ra_ = (rdb ^ (16 * (nb_ >> 1))) ^ (8 * (nb_ & 1)); \
                    const v2i_ r0_ = __builtin_amdgcn_ds_read_tr4_b64_v2i32((LAS v2i_*)(tile + ra_)), r1_ = __builtin_amdgcn_ds_read_tr4_b64_v2i32((LAS v2i_*)(tile + ra_ + 2048)); \
                    dd_[j_] = __builtin_amdgcn_mfma_scale_f32_16x16x128_f8f6f4(a_, (v8i){r0_.x, r0_.y, r1_.x, r1_.y, 0, 0, 0, 0}, (f32x4){0.f, 0.f, 0.f, 0.f}, 0, 4, 0, 127, 0, 127); } \
                __builtin_amdgcn_sched_barrier(0); \
                  \
                _Pragma("unroll") for (int j_ = 0; j_ < 4; ++j_) obw[16 * (4 * g_ + j_) * obs] = dd_[j_][0]; \
                asm volatile("" ::: "memory"); } \
            const f32x4 r4_ = *(const LAS f32x4*)(obuf + 4 * F.lane) * cstep_; \
            asm volatile("" ::: "memory"); \
            if ((tt) < T) *(GAS f32x4*)((rep_ == 0 ? out : (float*)(ws + WS_GT)) + (size_t)(tt) * D + col) = (f32x4){pg8::bflo(oc_.x) + r4_[0], pg8::bfhi(oc_.x) + r4_[1], pg8::bflo(oc_.y) + r4_[2], pg8::bfhi(oc_.y) + r4_[3]}; } while (0)
        v4u idA[2], idB[2], wA[16], wB[16], cfA[2], cfB[2]; v2u ooA, ooB;
        int t = rk2 * NWAVES + F.wave;
        P7_IDS(t, idA); P7_IDS(t + tstep, idB);
        P7_ISSUE(t, idA, wA, cfA, ooA); P7_ISSUE(t + tstep, idB, wB, cfB, ooB);
        P7_IDS(t + 2 * tstep, idA); P7_IDS(t + 3 * tstep, idB);
        while (t < T) {
            P7_COMPUTE(t, wA, cfA, ooA, { P7_ISSUE(t + 2 * tstep, idA, wA, cfA, ooA); P7_IDS(t + 4 * tstep, idA); });
            P7_COMPUTE(t + tstep, wB, cfB, ooB, { P7_ISSUE(t + 3 * tstep, idB, wB, cfB, ooB); P7_IDS(t + 5 * tstep, idB); });
            t += 2 * tstep;
        }
#undef P7_CL
#undef P7_IDS
#undef P7_ISSUE
#undef P7_COMPUTE
    }
#undef IN
#undef BOTH
#undef GRID_BAR
}

extern "C" void kernel_launch(void* const* d_in, const int* in_sizes, int n_in, void* d_out, int out_size, void* d_ws, size_t ws_size, hipStream_t stream) {
    static int grid = 0;
    if (grid == 0) {
        if (n_in != 14 || in_sizes[0] != T * D || out_size != T * D || ws_size < WS_END) { fprintf(stderr, "kernel_launch: built for 14 inputs, x and out of %d floats, >= %zu bytes of workspace; got n_in %d, in0 %d, out %d, ws %zu; nothing launched\n", T * D, (size_t)WS_END, n_in, n_in > 0 ? in_sizes[0] : -1, out_size, ws_size); grid = -1; return; }
        int dev = 0, cus = 0, per_cu = 0;
        if (hipGetDevice(&dev) != hipSuccess || hipDeviceGetAttribute(&cus, hipDeviceAttributeMultiprocessorCount, dev) != hipSuccess) { fprintf(stderr, "kernel_launch: hipGetDevice / hipDeviceGetAttribute failed\n"); grid = -1; return; }
        if (hipFuncSetAttribute((const void*)fwd_kernel, hipFuncAttributeMaxDynamicSharedMemorySize, LDS_BYTES) != hipSuccess) { fprintf(stderr, "kernel_launch: hipFuncSetAttribute failed\n"); grid = -1; return; }
        if (hipOccupancyMaxActiveBlocksPerMultiprocessor(&per_cu, (const void*)fwd_kernel, NWAVES * 64, LDS_BYTES) != hipSuccess || per_cu < 1)
            fprintf(stderr, "kernel_launch: note: occupancy query reports %d workgroups per CU\n", per_cu);
        (void)hipGetLastError();
        grid = cus;
        if (cus != 256) fprintf(stderr, "kernel_launch: built for 256 CUs (MI355X); %d found -- the P3 row-max exchange assumes a 256-workgroup grid\n", cus);
    }
    if (grid < 0) return;
    if (hipMemsetAsync((char*)d_ws + WS_CTL, 0, CTL_ZERO_BYTES, stream) != hipSuccess) { fprintf(stderr, "kernel_launch: hipMemsetAsync failed\n"); return; }
    Args a{};
    for (int i = 0; i < 14; ++i) a.in[i] = (const float*)d_in[i];
    a.out = (float*)d_out; a.ws = (unsigned char*)d_ws;
    for (int li = 0; li < N_LAUNCHES; ++li) {
        a.ph_lo = (N_LAUNCHES == PER_PHASE) ? li : 0; a.ph_hi = (N_LAUNCHES == PER_PHASE) ? li + 1 : MK_LAST_PHASE; a.li = li;
        if (a.ph_lo >= MK_LAST_PHASE) break;
        hipLaunchKernelGGL(fwd_kernel, dim3(grid), dim3(NWAVES * 64), LDS_BYTES, stream, a);
        const hipError_t le = hipPeekAtLastError();
        if (le != hipSuccess) { fprintf(stderr, "kernel_launch: launch %d failed: %s\n", li, hipGetErrorName(le)); break; }
    }
}
```
